# Optimizing an MI355X kernel written in HIP

```python
import math
import jax
import jax.numpy as jnp
from jax import lax
import numpy as np

D_MODEL = 1024
BATCH = 16
SEQ = 2048
DEPTH = 4

PLE_DIM = 256
QBLK = 128
NEG_INF = -1e30
EPS = 1e-6

DA_DH = 64
DA_HEADS = (D_MODEL // 2) // (2 * DA_DH)
NS_DH = 64
NS_HEADS = (D_MODEL // 2) // NS_DH
NS_KV = 2
CMP_LEN = 32
CMP_STRIDE = 16
CMP_HID = 256
SEL_LEN = 64
SEL_TOPN = 16
WINDOW = 512
FORCE_BONUS = 1e4
RET_DK = 256
RET_HEADS = D_MODEL // RET_DK
RET_DV = 2 * RET_DK
RET_CHUNK = 128
N_EXPERTS = 32
TOP_K = 4
D_FF = D_MODEL
SWIGLU_ALPHA = 1.702
SWIGLU_LIMIT = 7.0
MOE_BLK = 128

N_EVEN = (DEPTH + 1) // 2
N_ODD = DEPTH // 2
EV_SPLITS = [DA_HEADS * DA_DH] * 4 + [DA_HEADS * 2 * DA_DH, NS_HEADS * NS_DH] + [NS_KV * NS_DH] * 6 + [NS_HEADS * 3]
EV_IN = sum(EV_SPLITS)
EV_OUT = DA_HEADS * 2 * DA_DH + NS_HEADS * NS_DH
OD_SPLITS = [RET_HEADS * RET_DK, RET_HEADS * RET_DK, RET_HEADS * RET_DV, RET_HEADS * RET_DV]
OD_IN = sum(OD_SPLITS)
OD_OUT = RET_HEADS * RET_DV

kernel_name = 'hybrid_diffattn_nsa_retnet_moe'


def rms_norm(x, g=None):
    xf = x.astype(jnp.float32)
    y = xf * lax.rsqrt(jnp.mean(xf * xf, axis=-1, keepdims=True) + EPS)
    if g is not None:
        y = y * g.astype(jnp.float32)
    return y.astype(x.dtype)


def split_cols(z, sizes):
    return jnp.split(z, np.cumsum(sizes)[:-1].tolist(), axis=-1)


def alibi_slopes(n):
    return jnp.asarray([2.0 ** (-8.0 * (h + 1) / n) for h in range(n)], jnp.float32)


def diff_attention(q1, q2, k1, k2, v, slopes, lam):
    B, S, H, dh = q1.shape
    scale = dh ** -0.5
    kpos = jnp.arange(S)

    def one_block(qb):
        q0 = qb * QBLK
        a1 = lax.dynamic_slice_in_dim(q1, q0, QBLK, 1)
        a2 = lax.dynamic_slice_in_dim(q2, q0, QBLK, 1)
        dist = (q0 + jnp.arange(QBLK))[:, None] - kpos[None, :]
        bias = jnp.where(dist >= 0, -slopes[:, None, None] * dist.astype(jnp.float32), NEG_INF)
        s1 = jnp.einsum('bqhd,bkhd->bhqk', a1, k1, preferred_element_type=jnp.float32) * scale + bias
        s2 = jnp.einsum('bqhd,bkhd->bhqk', a2, k2, preferred_element_type=jnp.float32) * scale + bias
        pdiff = jax.nn.softmax(s1, axis=-1) - lam * jax.nn.softmax(s2, axis=-1)
        return jnp.einsum('bhqk,bkhe->bqhe', pdiff.astype(v.dtype), v)

    out = lax.map(one_block, jnp.arange(S // QBLK))
    return jnp.moveaxis(out, 0, 1).reshape(B, S, H, v.shape[-1])


def nsa_attention(q, kc, vc, ks, vs, kw, vw, gates, slopes, kn_g, cmp_pe, cmp_w1, cmp_w2):
    B, S, H, dh = q.shape
    G = kc.shape[2]
    R = H // G
    f32 = jnp.float32
    scale = dh ** -0.5
    pos = jnp.arange(S)
    qg = q.reshape(B, S, G, R, dh)
    slope_gr = slopes.reshape(G, R)

    nc = (S - CMP_LEN) // CMP_STRIDE + 1
    cstart = jnp.arange(nc) * CMP_STRIDE
    cidx = cstart[:, None] + jnp.arange(CMP_LEN)[None, :]

    def compress(t, pe, w1, w2):
        blk = t[:, cidx] + pe[None, None, :, None, :]
        blk = jnp.moveaxis(blk, 3, 2).reshape(B, nc, G, CMP_LEN * dh)
        return jax.nn.silu(blk @ w1) @ w2

    k_cmp = rms_norm(compress(kc, cmp_pe[0], cmp_w1[0], cmp_w2[0]), kn_g)
    v_cmp = compress(vc, cmp_pe[1], cmp_w1[1], cmp_w2[1])
    c_valid = (cstart + CMP_LEN - 1)[None, :] <= pos[:, None]
    s_c = jnp.einsum('bsgrd,bngd->bgrsn', qg, k_cmp, preferred_element_type=f32) * scale
    p_c = jax.nn.softmax(jnp.where(c_valid, s_c, NEG_INF), axis=-1) * c_valid.any(-1)[:, None]
    o_c = jnp.einsum('bgrsn,bngd->bsgrd', p_c.astype(vc.dtype), v_cmp)

    nb = S // SEL_LEN
    bstart = jnp.arange(nb) * SEL_LEN
    lo = jnp.maximum(cstart[:, None], bstart[None, :])
    hi = jnp.minimum(cstart[:, None] + CMP_LEN, bstart[None, :] + SEL_LEN)
    overlap = jnp.maximum(hi - lo, 0).astype(f32) / CMP_LEN
    imp = jnp.einsum('bgrsn,nj->bgsj', p_c, overlap)
    cur = pos // SEL_LEN
    jb = jnp.arange(nb)
    forced = (jb[None, :] == 0) | (jb[None, :] == cur[:, None]) | (jb[None, :] == cur[:, None] - 1)
    score = jnp.where(jb[None, :] > cur[:, None], NEG_INF, imp + FORCE_BONUS * forced)
    n_sel = min(SEL_TOPN, nb)
    _, sel_idx = lax.top_k(score, n_sel)

    ks_blk = jnp.moveaxis(ks.reshape(B, nb, SEL_LEN, G, dh), 3, 1)
    vs_blk = jnp.moveaxis(vs.reshape(B, nb, SEL_LEN, G, dh), 3, 1)
    kw_pad = jnp.pad(kw, ((0, 0), (WINDOW, 0), (0, 0), (0, 0)))
    vw_pad = jnp.pad(vw, ((0, 0), (WINDOW, 0), (0, 0), (0, 0)))
    gather = jax.vmap(jax.vmap(lambda t, i: t[i]))

    def one_block(qb):
        q0 = qb * QBLK
        tq = q0 + jnp.arange(QBLK)
        qblk = lax.dynamic_slice_in_dim(qg, q0, QBLK, 1)
        ib = lax.dynamic_slice_in_dim(sel_idx, q0, QBLK, 2)
        k_s = gather(ks_blk, ib)
        v_s = gather(vs_blk, ib)
        spos = ib[..., None] * SEL_LEN + jnp.arange(SEL_LEN)
        sdist = (tq[:, None, None] - spos).astype(f32)
        s_s = jnp.einsum('bqgrd,bgqnld->bgrqnl', qblk, k_s, preferred_element_type=f32) * scale
        s_s = jnp.where((sdist >= 0)[:, :, None],
                        s_s - slope_gr[None, :, :, None, None, None] * sdist[:, :, None], NEG_INF)
        p_s = jax.nn.softmax(s_s.reshape(B, G, R, QBLK, n_sel * SEL_LEN), axis=-1).reshape(s_s.shape)
        o_s = jnp.einsum('bgrqnl,bgqnld->bqgrd', p_s.astype(v_s.dtype), v_s)
        k_w = lax.dynamic_slice_in_dim(kw_pad, q0, WINDOW + QBLK, 1)
        v_w = lax.dynamic_slice_in_dim(vw_pad, q0, WINDOW + QBLK, 1)
        wpos = q0 - WINDOW + jnp.arange(WINDOW + QBLK)
        wdist = tq[:, None] - wpos[None, :]
        w_ok = (wdist >= 0) & (wdist < WINDOW) & (wpos >= 0)[None, :]
        s_w = jnp.einsum('bqgrd,bkgd->bgrqk', qblk, k_w, preferred_element_type=f32) * scale
        s_w = jnp.where(w_ok, s_w - slope_gr[:, :, None, None] * wdist.astype(f32), NEG_INF)
        o_w = jnp.einsum('bgrqk,bkgd->bqgrd', jax.nn.softmax(s_w, axis=-1).astype(v_w.dtype), v_w)
        return o_s, o_w

    o_s, o_w = lax.map(one_block, jnp.arange(S // QBLK))
    o_s = jnp.moveaxis(o_s, 0, 1).reshape(B, S, G, R, dh)
    o_w = jnp.moveaxis(o_w, 0, 1).reshape(B, S, G, R, dh)
    gg = gates.reshape(B, S, G, R, 3)
    o = gg[..., 0:1] * o_c + gg[..., 1:2] * o_s + gg[..., 2:3] * o_w
    return o.reshape(B, S, H * dh)


def even_mixer(xn, w_in, w_out, da_qn_g, da_kn_g, da_lam, da_out_g,
               ns_qn_g, ns_kn_g, ns_cmp_pe, ns_cmp_w1, ns_cmp_w2, layer):
    B, S, _ = xn.shape
    z = xn @ w_in
    (q1, q2, k1, k2, va, qn, kc, vc, ks, vs, kw, vw, gl) = split_cols(z, EV_SPLITS)
    hd = lambda t, n: t.reshape(B, S, n, -1)
    q1 = rms_norm(hd(q1, DA_HEADS), da_qn_g)
    q2 = rms_norm(hd(q2, DA_HEADS), da_qn_g)
    k1 = rms_norm(hd(k1, DA_HEADS), da_kn_g)
    k2 = rms_norm(hd(k2, DA_HEADS), da_kn_g)
    lam_init = 0.8 - 0.6 * math.exp(-0.3 * layer)
    lam = (jnp.exp(jnp.sum(da_lam[0] * da_lam[1]).astype(jnp.float32))
           - jnp.exp(jnp.sum(da_lam[2] * da_lam[3]).astype(jnp.float32)) + lam_init)
    oa = diff_attention(q1, q2, k1, k2, hd(va, DA_HEADS), alibi_slopes(DA_HEADS), lam)
    oa = (rms_norm(oa, da_out_g) * (1.0 - lam_init)).reshape(B, S, -1)
    ob = nsa_attention(rms_norm(hd(qn, NS_HEADS), ns_qn_g),
                       hd(kc, NS_KV), hd(vc, NS_KV),
                       rms_norm(hd(ks, NS_KV), ns_kn_g), hd(vs, NS_KV),
                       rms_norm(hd(kw, NS_KV), ns_kn_g), hd(vw, NS_KV),
                       jax.nn.sigmoid(gl).reshape(B, S, NS_HEADS, 3), alibi_slopes(NS_HEADS),
                       ns_kn_g, ns_cmp_pe, ns_cmp_w1, ns_cmp_w2)
    return jnp.concatenate([oa, ob], axis=-1) @ w_out


def retention_chunkwise(q, k, v):
    B, S, H, dk = q.shape
    dv = v.shape[-1]
    C = RET_CHUNK
    n = S // C
    f32 = jnp.float32
    lg = jnp.log(1.0 - 2.0 ** (-5.0 - jnp.arange(H, dtype=f32)))
    j = jnp.arange(C, dtype=f32)
    rel = j[:, None] - j[None, :]
    inner = jnp.where(rel >= 0, jnp.exp(lg[:, None, None] * jnp.maximum(rel, 0.0)), 0.0)
    xi = jnp.exp(lg[:, None] * (j + 1.0))[:, :, None]
    zeta = jnp.exp(lg[:, None] * (C - 1.0 - j))[:, :, None]
    decay_c = jnp.exp(lg * C)[:, None, None]
    to_chunks = lambda t: t.astype(f32).reshape(B, n, C, H, t.shape[-1]).transpose(1, 0, 3, 2, 4)

    def step(state, inp):
        qi, ki, vi = inp
        att = jnp.einsum('bhcd,bhed->bhce', qi, ki) * inner
        y = jnp.einsum('bhce,bhef->bhcf', att, vi) + jnp.einsum('bhcd,bhdf->bhcf', qi * xi, state)
        state = decay_c * state + jnp.einsum('bhcd,bhcf->bhdf', ki * zeta, vi)
        return state, y

    state0 = jnp.zeros((B, H, dk, dv), f32)
    _, ys = lax.scan(step, state0, (to_chunks(q), to_chunks(k), to_chunks(v)))
    return ys.transpose(1, 0, 3, 2, 4).reshape(B, S, H, dv).astype(v.dtype)


def retention_mixer(xn, w_in, w_out, out_g):
    B, S, _ = xn.shape
    q, k, v, g = split_cols(xn @ w_in, OD_SPLITS)
    q = q.reshape(B, S, RET_HEADS, RET_DK)
    k = k.reshape(B, S, RET_HEADS, RET_DK) * (RET_DK ** -0.5)
    v = v.reshape(B, S, RET_HEADS, RET_DV)
    y = rms_norm(retention_chunkwise(q, k, v), out_g).reshape(B, S, OD_OUT)
    return (jax.nn.silu(g) * y) @ w_out


def moe_ffn(x, router_w, router_b, w_gu, b_gu, w_down, b_down):
    B, S, D = x.shape
    T = B * S
    xt = x.reshape(T, D)
    logits = jnp.matmul(xt, router_w, preferred_element_type=jnp.float32) + router_b.astype(jnp.float32)
    top_v, top_e = lax.top_k(logits, TOP_K)
    gate = jax.nn.softmax(top_v, axis=-1)
    flat_e = top_e.reshape(-1)
    order = jnp.argsort(flat_e)
    e_sorted = flat_e[order]
    tok = (order // TOP_K).astype(jnp.int32)
    counts = jnp.bincount(flat_e, length=N_EXPERTS)
    padded = (counts + MOE_BLK - 1) // MOE_BLK * MOE_BLK
    pad_end = jnp.cumsum(padded)
    pad_start = pad_end - padded
    start = jnp.cumsum(counts) - counts
    dest = pad_start[e_sorted] + jnp.arange(T * TOP_K) - start[e_sorted]
    n_blocks = -(-(T * TOP_K) // MOE_BLK) + N_EXPERTS
    cap = n_blocks * MOE_BLK
    slot_tok = jnp.full((cap,), T, jnp.int32).at[dest].set(tok)
    x_pad = jnp.concatenate([xt, jnp.zeros((1, D), xt.dtype)], axis=0)
    xb = x_pad[slot_tok].reshape(n_blocks, MOE_BLK, D)
    blk_e = jnp.minimum(jnp.searchsorted(pad_end, jnp.arange(n_blocks) * MOE_BLK, side='right'), N_EXPERTS - 1)

    def expert_block(args):
        xblk, e = args
        h = xblk @ w_gu[e] + b_gu[e]
        hg, hl = jnp.split(h, 2, axis=-1)
        hg = jnp.minimum(hg, SWIGLU_LIMIT)
        hl = jnp.clip(hl, -SWIGLU_LIMIT, SWIGLU_LIMIT)
        a = hg * jax.nn.sigmoid(SWIGLU_ALPHA * hg) * (hl + 1.0)
        return a @ w_down[e] + b_down[e]

    yb = lax.map(expert_block, (xb, blk_e)).reshape(cap, D)
    y_rows = yb[dest] * gate.reshape(-1)[order][:, None].astype(yb.dtype)
    return jax.ops.segment_sum(y_rows, tok, num_segments=T).reshape(B, S, D)


def setup_inputs(seed: int = 0) -> dict:
    key = jax.random.key(seed)
    keys = iter(jax.random.split(key, 40))
    f32 = jnp.float32
    res_mult = (2.0 * DEPTH) ** -0.5

    def w(shape, fan_in, mult=1.0):
        return jax.random.normal(next(keys), shape, f32) * (mult * fan_in ** -0.5)

    def g(shape):
        return 1.0 + 0.05 * jax.random.normal(next(keys), shape, f32)

    def b(shape, s=0.01):
        return s * jax.random.normal(next(keys), shape, f32)

    return {
        'x': jax.random.normal(next(keys), (BATCH, SEQ, D_MODEL), f32),
        'p': jax.random.normal(next(keys), (DEPTH, BATCH, SEQ, PLE_DIM), f32),
        'norm1_g': g((DEPTH, D_MODEL)),
        'norm2_g': g((DEPTH, D_MODEL)),
        'ev_w_in': w((N_EVEN, D_MODEL, EV_IN), D_MODEL),
        'ev_w_out': w((N_EVEN, EV_OUT, D_MODEL), EV_OUT, res_mult),
        'da_qn_g': g((N_EVEN, DA_DH)),
        'da_kn_g': g((N_EVEN, DA_DH)),
        'da_lam': b((N_EVEN, 4, DA_DH), 0.1),
        'da_out_g': g((N_EVEN, 2 * DA_DH)),
        'ns_qn_g': g((N_EVEN, NS_DH)),
        'ns_kn_g': g((N_EVEN, NS_DH)),
        'ns_cmp_pe': b((N_EVEN, 2, CMP_LEN, NS_DH), 0.1),
        'ns_cmp_w1': w((N_EVEN, 2, CMP_LEN * NS_DH, CMP_HID), CMP_LEN * NS_DH),
        'ns_cmp_w2': w((N_EVEN, 2, CMP_HID, NS_DH), CMP_HID),
        'od_w_in': w((N_ODD, D_MODEL, OD_IN), D_MODEL),
        'od_w_out': w((N_ODD, OD_OUT, D_MODEL), OD_OUT, res_mult),
        'ret_out_g': g((N_ODD, RET_DV)),
        'router_w': w((DEPTH, D_MODEL, N_EXPERTS), D_MODEL),
        'router_b': b((DEPTH, N_EXPERTS), 0.01),
        'moe_w_gu': w((DEPTH, N_EXPERTS, D_MODEL, 2 * D_FF), D_MODEL),
        'moe_b_gu': b((DEPTH, N_EXPERTS, 2 * D_FF), 0.01),
        'moe_w_down': w((DEPTH, N_EXPERTS, D_FF, D_MODEL), D_FF, res_mult),
        'moe_b_down': b((DEPTH, N_EXPERTS, D_MODEL), 0.01),
        'ple_w_proj': w((DEPTH, PLE_DIM, D_MODEL), PLE_DIM, res_mult),
        'ple_w_gate': w((DEPTH, D_MODEL, D_MODEL), D_MODEL),
    }


def reference(x, p, norm1_g, norm2_g, ev_w_in, ev_w_out, da_qn_g, da_kn_g, da_lam, da_out_g,
              ns_qn_g, ns_kn_g, ns_cmp_pe, ns_cmp_w1, ns_cmp_w2, od_w_in, od_w_out, ret_out_g,
              router_w, router_b, moe_w_gu, moe_b_gu, moe_w_down, moe_b_down, ple_w_proj, ple_w_gate):
    h = x
    for i in range(DEPTH):
        hn = rms_norm(h, norm1_g[i])
        if i % 2 == 0:
            e = i // 2
            mix = even_mixer(hn, ev_w_in[e], ev_w_out[e], da_qn_g[e], da_kn_g[e], da_lam[e], da_out_g[e],
                             ns_qn_g[e], ns_kn_g[e], ns_cmp_pe[e], ns_cmp_w1[e], ns_cmp_w2[e], i)
        else:
            o = i // 2
            mix = retention_mixer(hn, od_w_in[o], od_w_out[o], ret_out_g[o])
        h = h + mix
        h = h + moe_ffn(rms_norm(h, norm2_g[i]), router_w[i], router_b[i],
                        moe_w_gu[i], moe_b_gu[i], moe_w_down[i], moe_b_down[i])
        gate = jax.nn.sigmoid(rms_norm(h) @ ple_w_gate[i])
        h = h + gate * (p[i] @ ple_w_proj[i])
    return h
```

```cpp
#include <hip/hip_runtime.h>
#include <cstdio>
#include <cstdint>
#include <cstring>

#define LAS __attribute__((address_space(3)))
#define DI __device__ __forceinline__
typedef unsigned short bf16_t;
typedef short bf16x8 __attribute__((ext_vector_type(8)));
typedef short s16x4 __attribute__((ext_vector_type(4)));
typedef float f32x2 __attribute__((ext_vector_type(2)));
typedef float f32x4 __attribute__((ext_vector_type(4)));
typedef float f32x16 __attribute__((ext_vector_type(16)));
typedef unsigned u32x2 __attribute__((ext_vector_type(2)));
typedef unsigned u32x4 __attribute__((ext_vector_type(4)));
typedef __bf16 bfv2 __attribute__((ext_vector_type(2)));

#ifndef MK_SINGLE
#define MK_SINGLE 0
#endif
#ifndef DBG_ONLY
#define DBG_ONLY -1
#endif
#ifndef DBG_LAST_PHASE
#define DBG_LAST_PHASE 100000
#endif

constexpr int T = 32768, D = 1024, SEQ = 2048, NBATCH = 16, DEPTH = 4;
constexpr int EVIN = 2840, ODIN = 6144;
constexpr float EPS = 1e-6f, NEGF = -1e30f;
constexpr int NTB = 256;
constexpr int MOE_ROWS = (512 + 32) * 256;

constexpr size_t MiB = 1u << 20;
constexpr size_t WS_CTL = 0, CTL_BYTES = 1 * MiB;
constexpr int CW_BAR = 4096;
constexpr size_t WS_EVNAT = 2 * MiB, WS_EVSW = 10 * MiB, WS_EVOUT = 13 * MiB, WS_CMP1 = 17 * MiB, WS_ODNAT = 21 * MiB, WS_ODSW = 37 * MiB,
                 WS_ODOUT = 49 * MiB, WS_WPP = 57 * MiB, WS_WPG = 59 * MiB, WS_BIAS1 = 67 * MiB, WS_GAINS = 67 * MiB + 16384, WS_BCNT = 67 * MiB + 65536,
                 WS_WGU = 68 * MiB, WS_WDN = 580 * MiB;
constexpr size_t WS_XN = 840 * MiB, WS_PBF = 904 * MiB, WS_PP = 968 * MiB, WS_GATES = 1032 * MiB, WS_TOPE = 1035 * MiB, WS_POSB = 1036 * MiB,
                 WS_DEST = 1037 * MiB, WS_GATEW = 1038 * MiB, WS_SELM = 1039 * MiB;
constexpr size_t RA = 1040 * MiB;
constexpr size_t WS_QD = RA, WS_KD = RA + 32 * MiB, WS_QN = RA + 64 * MiB, WS_KCB = RA + 96 * MiB, WS_VCB = RA + 105 * MiB, WS_KSB = RA + 114 * MiB,
                 WS_KWB = RA + 122 * MiB, WS_VAT = RA + 130 * MiB, WS_VST = RA + 162 * MiB, WS_VWT = RA + 170 * MiB, WS_HID = RA + 178 * MiB,
                 WS_KCMP = RA + 182 * MiB, WS_VCMPT = RA + 183 * MiB, WS_OC = RA + 184 * MiB, WS_IMPH = RA + 216 * MiB, WS_OD = RA + 248 * MiB,
                 WS_OS = RA + 312 * MiB, WS_OW = RA + 344 * MiB, WS_AMIX = RA + 376 * MiB;
constexpr size_t WS_AQ = RA, WS_KP = RA + 128 * MiB, WS_KT = RA + 192 * MiB, WS_VS = RA + 256 * MiB, WS_GG = RA + 512 * MiB, WS_UT = RA + 640 * MiB,
                 WS_Y = RA + 896 * MiB, WS_YG = RA + 1024 * MiB;
constexpr size_t WS_XB = 2192 * MiB, WS_ACT = 2464 * MiB, WS_YB = 2736 * MiB, WS_END = 3008 * MiB;

constexpr int MISC_OFF = 139264, LDS_BYTES = 155648;
static_assert(MISC_OFF + 5888 + 4096 <= LDS_BYTES, "misc LDS words");
constexpr int MO_WCNT = 256, MO_ENT = 1280, MO_GAT = 3328, MO_TOT = 5376, MO_BASE = 5504, MO_TS = 5632, MO_RED = 5888;

DI int opaque_tid(int wid0) { int t = (wid0 << 6) | (int)__builtin_amdgcn_mbcnt_hi(~0u, __builtin_amdgcn_mbcnt_lo(~0u, 0u)); asm volatile("" : "+v"(t) :: "memory"); return t; }
DI unsigned pk2(float lo, float hi) { f32x2 v = {lo, hi}; return __builtin_bit_cast(unsigned, __builtin_convertvector(v, bfv2)); }
DI float bf2f(unsigned short b) { return __uint_as_float(((unsigned)b) << 16); }
DI float bflo(unsigned w) { return __uint_as_float(w << 16); }
DI float bfhi(unsigned w) { return __uint_as_float(w & 0xffff0000u); }
DI float wave_sum(float v) {
#pragma unroll
    for (int o = 1; o < 64; o <<= 1) v += __shfl_xor(v, o);
    return v;
}
DI float sigm(float x) { return 1.0f / (1.0f + __expf(-x)); }
DI u32x4 pack8(const f32x4& a, const f32x4& b) { u32x4 w; w.x = pk2(a[0], a[1]); w.y = pk2(a[2], a[3]); w.z = pk2(b[0], b[1]); w.w = pk2(b[2], b[3]); return w; }

#define XB_TMO      128
#define XB_XCNT(j)  (256  + 64 * (j))
#define XB_XSUB(j)  (1280 + 64 * (j))
#define XB_XGEN(j)  (2304 + 64 * (j))
#define XB_TOP      3328
#define XB_TOPGEN   3392
#define XCD_BAR_WORDS 3456
#define XB_SPIN_CAP (1u << 22)
DI unsigned xb_ld(unsigned* p)              { return __hip_atomic_load(p, __ATOMIC_RELAXED, __HIP_MEMORY_SCOPE_AGENT); }
DI unsigned xb_add(unsigned* p, unsigned v) { return __hip_atomic_fetch_add(p, v, __ATOMIC_RELAXED, __HIP_MEMORY_SCOPE_AGENT); }
DI unsigned xb_xcc_id() { return (unsigned)__builtin_amdgcn_s_getreg((3 << 11) | 20) & 0xFu; }
#define XB_SPIN(cond, bar) do { unsigned _sp = 0; while (cond) { __builtin_amdgcn_s_sleep(1); \
    if ((++_sp & 255u) == 0u) { if (xb_ld(&(bar)[XB_TMO])) break; if (_sp > XB_SPIN_CAP) { atomicAdd(&(bar)[XB_TMO], 1u); break; } } } } while (0)
struct XcdBarrier { unsigned* bar; unsigned x; volatile LAS unsigned* st; };
DI XcdBarrier xcd_barrier_post(const int WID, unsigned* bar, volatile LAS unsigned* st) {
    XcdBarrier b; b.bar = bar; b.x = xb_xcc_id(); b.st = st;
    if (opaque_tid(WID) == 0) (void)xb_add(&bar[XB_XCNT(b.x)], 1u);
    return b;
}
DI void xcd_barrier_complete(unsigned* bar, unsigned x, unsigned& nloc, unsigned& nx) {
    const unsigned G = gridDim.x * gridDim.y * gridDim.z;
    unsigned sum, cnt, mine, sp = 0u;
    for (;;) {
        sum = 0u; cnt = 0u; mine = 0u;
#pragma unroll
        for (unsigned j = 0; j < 16; ++j) { const unsigned c = xb_ld(&bar[XB_XCNT(j)]); sum += c; cnt += (c > 0u) ? 1u : 0u; mine = (j == x) ? c : mine; }
        if (sum == G) break;
        __builtin_amdgcn_s_sleep(1);
        if ((++sp & 255u) == 0u) { if (xb_ld(&bar[XB_TMO])) break; if (sp > XB_SPIN_CAP) { atomicAdd(&bar[XB_TMO], 1u); break; } }
    }
    nloc = mine > 0u ? mine : 1u; nx = cnt > 0u ? cnt : 1u;
}
DI void xcd_barrier(const int WID, const XcdBarrier& b) {
    asm volatile("s_waitcnt vmcnt(0)" ::: "memory");
    __syncthreads();
    if (opaque_tid(WID) == 0) {
        unsigned* bar = b.bar; asm volatile("" : "+s"(bar));
        __builtin_amdgcn_s_waitcnt(0);
        unsigned nloc = b.st[0], nx = b.st[1];
        if (nloc == 0u) { xcd_barrier_complete(bar, b.x, nloc, nx); b.st[0] = nloc; b.st[1] = nx; }
        const unsigned old = xb_add(&bar[XB_XSUB(b.x)], 1u);
        const unsigned gen = old / nloc;
        if (old + 1u == (gen + 1u) * nloc) {
            __builtin_amdgcn_fence(__ATOMIC_RELEASE, "agent");
            asm volatile("s_waitcnt vmcnt(0)" ::: "memory");
            const unsigned og = xb_add(&bar[XB_TOP], 1u);
            const unsigned tg = og / nx;
            if (og + 1u == (tg + 1u) * nx) xb_add(&bar[XB_TOPGEN], 1u);
            else XB_SPIN(xb_ld(&bar[XB_TOPGEN]) == tg, bar);
            __builtin_amdgcn_fence(__ATOMIC_ACQUIRE, "agent");
            xb_add(&bar[XB_XGEN(b.x)], 1u);
            asm volatile("s_waitcnt vmcnt(0)" ::: "memory");
        } else {
            XB_SPIN(xb_ld(&bar[XB_XGEN(b.x)]) == gen, bar);
            __builtin_amdgcn_fence(__ATOMIC_ACQUIRE, "agent");
            asm volatile("s_waitcnt vmcnt(0)" ::: "memory");
        }
    }
    __syncthreads();
}

namespace pg8 {
constexpr int BM = 256, BK = 64, HALF = 128, HTB = HALF * BK * 2, STAGE_BYTES = 8 * HTB, NXCD = 8, WGM = 8;
DI int lds_byte(int r, int c) { const int st = (r >> 4) * 2 + (c >> 5), rr = r & 15, cc = c & 31, ob = rr * 64 + cc * 2; return st * 1024 + (ob ^ (((ob >> 9) & 1) << 5)); }
DI void stage_rc(int b, int& R, int& C) { const int st = b / 1024, sb = b % 1024, swz = sb ^ (((sb >> 9) & 1) << 5); R = (st >> 1) * 16 + swz / 64; C = (st & 1) * 32 + (swz % 64) / 2; }
DI int perm32(int rho) { const int n = rho >> 4, i = rho & 15; return 8 * (i >> 2) + 4 * n + (i & 3); }
struct Unit { int pm, pn; };
struct Sched {
    int nM, nN, nwg, G, c;
    DI void init(int nM_, int nN_, int G_, int c_) { nM = nM_; nN = nN_; nwg = nM * nN; G = G_; c = c_; }
    DI bool next(int i, Unit& u) const {
        const long L = (long)i * G + c; if (L >= nwg) return false;
        int wgid = (int)L; { const int q = nwg / NXCD, r = nwg % NXCD, xcd = wgid % NXCD, off = wgid / NXCD; wgid = (xcd < r ? xcd * (q + 1) : r * (q + 1) + (xcd - r) * q) + off; }
        const int nig = WGM * nN, gid = wgid / nig, fm = gid * WGM, gsz = (nM - fm) < WGM ? (nM - fm) : WGM;
        u.pm = fm + ((wgid % nig) % gsz); u.pn = (wgid % nig) / gsz; return true;
    }
};
template <class Epi, class Prob>
DI void gemm_phase(const int WID, LAS unsigned char* lds, const Prob& P, const Sched& S, const Epi& E) {
    const int tid = opaque_tid(WID), wid = __builtin_amdgcn_readfirstlane(tid >> 6), lane = tid & 63, wr = wid >> 2, wc = wid & 3, fr = lane & 15, fq = lane >> 4;
    const int K = P.K, nt = K / BK;
    unsigned voffA[2], voffB[2];
#pragma unroll
    for (int i = 0; i < 2; ++i) { int R, C; stage_rc(tid * 16 + i * 8192, R, C); const int Rb = Epi::PERM ? ((R & ~31) + perm32(R & 31)) : R;
        voffA[i] = (unsigned)(R * P.lda + C) * 2u; voffB[i] = (unsigned)(Rb * P.ldb + C) * 2u; }
    const size_t kstep = (size_t)(BK * 2);
    const size_t hstepA = (size_t)HALF * P.lda * 2, hstepB = (size_t)HALF * P.ldb * 2;
    const unsigned ldsw = (unsigned)wid * 1024u;
    const int aoff = lds_byte(wr * 64 + fr, fq * 8), boff = lds_byte(wc * 32 + fr, fq * 8);
#define PG8_SA(b, h) (((b) * 2 + (h)) * HTB)
#define PG8_SB(b, h) ((4 + (b) * 2 + (h)) * HTB)
#define PG8_STAGE(bufoff, gbase, voff) do { _Pragma("unroll") for (int _i = 0; _i < 2; ++_i) \
        __builtin_amdgcn_global_load_lds((const unsigned*)((const char*)(gbase) + (voff)[_i]), (LAS unsigned*)(lds + (bufoff) + ldsw + _i * 8192), 16, 0, 0); } while (0)
#define PG8_LDA(dst, b, h) do { _Pragma("unroll") for (int m = 0; m < 4; ++m) _Pragma("unroll") for (int k = 0; k < 2; ++k) dst[m][k] = *(const LAS bf16x8*)(lds + PG8_SA(b, h) + aoff + m * 2048 + k * 1024); } while (0)
#define PG8_LDB(dst, b, h) do { _Pragma("unroll") for (int n = 0; n < 2; ++n) _Pragma("unroll") for (int k = 0; k < 2; ++k) dst[n][k] = *(const LAS bf16x8*)(lds + PG8_SB(b, h) + boff + n * 2048 + k * 1024); } while (0)
#define PG8_MMA(ai, bj, At, Bt) do { __builtin_amdgcn_s_setprio(1); _Pragma("unroll") for (int m = 0; m < 4; ++m) _Pragma("unroll") for (int n = 0; n < 2; ++n) _Pragma("unroll") for (int k = 0; k < 2; ++k) \
        acc[ai][bj][m][n] = __builtin_amdgcn_mfma_f32_16x16x32_bf16(Bt[n][k], At[m][k], acc[ai][bj][m][n], 0, 0, 0); __builtin_amdgcn_s_setprio(0); } while (0)
#define PG8_WAIT_V(n) asm volatile("s_waitcnt vmcnt(" #n ")" ::: "memory")
#define PG8_WAIT_L(n) asm volatile("s_waitcnt lgkmcnt(" #n ")" ::: "memory")
#define PG8_BAR __builtin_amdgcn_s_barrier()
#define PG8_SCHED __builtin_amdgcn_sched_barrier(0)
    Unit cur, nxt; int ui = 0;
    if (!S.next(0, cur)) return;
    f32x4 acc[2][2][4][2];
#pragma unroll
    for (int a = 0; a < 2; ++a)
#pragma unroll
        for (int b = 0; b < 2; ++b)
#pragma unroll
            for (int m = 0; m < 4; ++m)
#pragma unroll
                for (int n = 0; n < 2; ++n) acc[a][b][m][n] = (f32x4){0.f, 0.f, 0.f, 0.f};
    bf16x8 At[4][2], B0[2][2], B1[2][2];
    const char* cA = P.a_base(cur); const char* cB = P.b_base(cur);
    PG8_STAGE(PG8_SB(0, 0), cB, voffB); PG8_STAGE(PG8_SA(0, 0), cA, voffA); PG8_STAGE(PG8_SB(0, 1), cB + hstepB, voffB); PG8_STAGE(PG8_SA(0, 1), cA + hstepA, voffA);
    if (wr == 1) PG8_BAR;
    PG8_WAIT_V(4); PG8_BAR;
    PG8_STAGE(PG8_SB(1, 0), cB + kstep, voffB); PG8_STAGE(PG8_SA(1, 0), cA + kstep, voffA); PG8_STAGE(PG8_SB(1, 1), cB + hstepB + kstep, voffB);
    PG8_WAIT_V(6); PG8_BAR;
    for (;;) {
        const bool has_next = S.next(ui + 1, nxt);
        const char* nA = has_next ? P.a_base(nxt) : cA; const char* nB = has_next ? P.b_base(nxt) : cB;
        for (int t = 0; t < nt; t += 2) {
            const bool last = (t == nt - 2);
            const char* a1 = cA + (size_t)(t + 1) * kstep;
            const char* a2 = last ? nA : cA + (size_t)(t + 2) * kstep; const char* b2 = last ? nB : cB + (size_t)(t + 2) * kstep;
            const char* a3 = a2 + kstep; const char* b3 = b2 + kstep;
            PG8_LDB(B0, 0, 0); PG8_SCHED; PG8_LDA(At, 0, 0); PG8_STAGE(PG8_SA(1, 1), a1 + hstepA, voffA);
            PG8_WAIT_L(8); PG8_BAR; PG8_WAIT_L(0); PG8_MMA(0, 0, At, B0); PG8_BAR; PG8_SCHED;
            PG8_LDB(B1, 0, 1); PG8_STAGE(PG8_SB(0, 0), b2, voffB);
            PG8_BAR; PG8_WAIT_L(0); PG8_MMA(0, 1, At, B1); PG8_BAR;
            PG8_LDA(At, 0, 1); PG8_STAGE(PG8_SA(0, 0), a2, voffA);
            PG8_BAR; PG8_WAIT_L(0); PG8_MMA(1, 0, At, B0); PG8_BAR; PG8_SCHED;
            PG8_STAGE(PG8_SB(0, 1), b2 + hstepB, voffB);
            PG8_WAIT_V(6); PG8_BAR; PG8_MMA(1, 1, At, B1); PG8_BAR;
            PG8_LDB(B0, 1, 0); PG8_SCHED; PG8_LDA(At, 1, 0); PG8_STAGE(PG8_SA(0, 1), a2 + hstepA, voffA);
            PG8_WAIT_L(8); PG8_BAR; PG8_WAIT_L(0); PG8_MMA(0, 0, At, B0); PG8_BAR; PG8_SCHED;
            PG8_LDB(B1, 1, 1); PG8_STAGE(PG8_SB(1, 0), b3, voffB);
            PG8_BAR; PG8_WAIT_L(0); PG8_MMA(0, 1, At, B1); PG8_BAR;
            PG8_LDA(At, 1, 1); PG8_STAGE(PG8_SA(1, 0), a3, voffA);
            PG8_BAR; PG8_WAIT_L(0); PG8_MMA(1, 0, At, B0); PG8_BAR; PG8_SCHED;
            PG8_STAGE(PG8_SB(1, 1), b3 + hstepB, voffB);
            PG8_WAIT_V(6); PG8_BAR; PG8_MMA(1, 1, At, B1); PG8_BAR;
        }
        { int fr_ = fr, fq_ = fq, wr_ = wr, wc_ = wc; asm volatile("" : "+v"(fr_), "+v"(fq_), "+s"(wr_), "+s"(wc_));
          E(acc, cur, wr_, wc_, fr_, fq_); }
        if (!has_next) break;
#pragma unroll
        for (int a = 0; a < 2; ++a)
#pragma unroll
            for (int b = 0; b < 2; ++b)
#pragma unroll
                for (int m = 0; m < 4; ++m)
#pragma unroll
                    for (int n = 0; n < 2; ++n) acc[a][b][m][n] = (f32x4){0.f, 0.f, 0.f, 0.f};
        cur = nxt; cA = nA; cB = nB; ++ui;
    }
    PG8_WAIT_V(0);
    if (wr == 0) PG8_BAR;
    PG8_BAR;
#undef PG8_SA
#undef PG8_SB
#undef PG8_STAGE
#undef PG8_LDA
#undef PG8_LDB
#undef PG8_MMA
#undef PG8_WAIT_V
#undef PG8_WAIT_L
#undef PG8_BAR
#undef PG8_SCHED
}
}
using pg8::Unit;
typedef f32x4 Acc[2][2][4][2];

struct ProbPlain { const bf16_t* A; const bf16_t* Bt; int lda, ldb, K;
    DI const char* a_base(const Unit& u) const { return (const char*)(A + (size_t)u.pm * 256 * lda); }
    DI const char* b_base(const Unit& u) const { return (const char*)(Bt + (size_t)u.pn * 256 * ldb); } };
struct ProbCmp1 { const bf16_t* KCB; const bf16_t* VCB; const bf16_t* W; int lda, ldb, K;
    DI const char* a_base(const Unit& u) const { const int kv = u.pm >> 4, rt = u.pm & 15; return (const char*)((kv ? VCB : KCB) + (size_t)rt * 256 * 1024); }
    DI const char* b_base(const Unit& u) const { const int kv = u.pm >> 4; return (const char*)(W + (size_t)kv * 256 * 2048); } };
struct ProbAtt { const bf16_t* AQ; const bf16_t* KP; int lda, ldb, K;
    DI const char* a_base(const Unit& u) const { const int z = u.pm, n = z & 7, h = (z >> 3) & 3, b = z >> 5; const size_t t0 = (size_t)b * 2048 + n * 256; return (const char*)(AQ + (t0 * 4 + h) * 512 + 256); }
    DI const char* b_base(const Unit& u) const { const int z = u.pm, n = z & 7, h = (z >> 3) & 3, b = z >> 5; const size_t t0 = (size_t)b * 2048 + n * 256; return (const char*)(KP + t0 * 1024 + h * 256); } };
struct ProbUT { const bf16_t* VS; const bf16_t* KT; int lda, ldb, K;
    DI const char* a_base(const Unit& u) const { const int z = u.pm >> 1, half = u.pm & 1; return (const char*)(VS + (size_t)z * 262144 + (size_t)half * 256 * 512); }
    DI const char* b_base(const Unit& u) const { const int z = u.pm >> 1; return (const char*)(KT + (size_t)z * 65536); } };
struct ProbY { const bf16_t* AQ; const bf16_t* VS; int lda, ldb, K;
    DI const char* a_base(const Unit& u) const { const int z = u.pm, n = z & 7, h = (z >> 3) & 3, b = z >> 5; const size_t t0 = (size_t)b * 2048 + n * 256; return (const char*)(AQ + (t0 * 4 + h) * 512); }
    DI const char* b_base(const Unit& u) const { return (const char*)(VS + (size_t)u.pm * 262144 + (size_t)u.pn * 256 * 512); } };
DI int moe_tile_expert(const LAS int* ts, int rt) { int e = 0;
#pragma unroll 8
    for (int i = 1; i < 32; ++i) e += (rt >= ts[i]) ? 1 : 0;
    return e; }
struct ProbMoe { const bf16_t* A; const bf16_t* W; const LAS int* ts; int nper; int lda, ldb, K;
    DI const char* a_base(const Unit& u) const { return (const char*)(A + (size_t)u.pm * 256 * 1024); }
    DI const char* b_base(const Unit& u) const { const int e = moe_tile_expert(ts, u.pm); return (const char*)(W + ((size_t)e * nper + (size_t)u.pn * 256) * 1024); } };

#define EPI_ROWS(ai, m) (128 * (ai) + 64 * wr + 16 * (m) + fr)
struct EpiEvNat { static constexpr bool PERM = true;
    unsigned char* ws; const float* gains;
    DI void operator()(const Acc& acc, const Unit& u, int wr, int wc, int fr, int fq) const {
        const int pn = u.pn; const bool norm = (pn != 6);
        const int gi = pn < 2 ? 0 : pn < 4 ? 1 : pn < 6 ? 2 : 3;
        const float* g = gains + gi * 64;
        f32x4 gv[2][2];
#pragma unroll
        for (int bj = 0; bj < 2; ++bj)
#pragma unroll
            for (int n = 0; n < 2; ++n) { const f32x4 t4 = *(const f32x4*)(g + 32 * bj + 8 * fq + 4 * n); gv[bj][n] = norm ? t4 : (f32x4){1.f, 1.f, 1.f, 1.f}; }
        size_t boff; int rowmul, hoff; bool panel = false;
        if (pn < 2) { boff = WS_QD; rowmul = 512; hoff = (pn * 4 + wc) * 64; }
        else if (pn < 4) { boff = WS_KD; rowmul = 512; hoff = ((pn - 2) * 4 + wc) * 64; }
        else if (pn < 6) { boff = WS_QN; rowmul = 512; hoff = ((pn - 4) * 4 + wc) * 64; }
        else { panel = true; rowmul = 64; hoff = 0; boff = (pn == 6) ? (wc < 2 ? WS_KCB : WS_VCB) : (wc < 2 ? WS_KSB : WS_KWB); }
        bf16_t* base = (bf16_t*)(ws + boff);
#pragma unroll
        for (int ai = 0; ai < 2; ++ai)
#pragma unroll
            for (int m = 0; m < 4; ++m) {
                const int t = u.pm * 256 + EPI_ROWS(ai, m), b = t >> 11, sq = t & 2047;
                float ss = 0.f;
#pragma unroll
                for (int bj = 0; bj < 2; ++bj)
#pragma unroll
                    for (int n = 0; n < 2; ++n) { const f32x4 x = acc[ai][bj][m][n]; ss += (x[0] * x[0] + x[1] * x[1]) + (x[2] * x[2] + x[3] * x[3]); }
                ss += __shfl_xor(ss, 16); ss += __shfl_xor(ss, 32);
                const float rstd = norm ? rsqrtf(ss * (1.0f / 64.0f) + EPS) : 1.0f;
                const size_t rowi = panel ? ((size_t)(b * 2 + (wc & 1)) * 2048 + sq) : (size_t)t;
#pragma unroll
                for (int bj = 0; bj < 2; ++bj) {
                    const f32x4 v0 = acc[ai][bj][m][0] * rstd * gv[bj][0], v1 = acc[ai][bj][m][1] * rstd * gv[bj][1];
                    *(u32x4*)(base + rowi * rowmul + hoff + 32 * bj + 8 * fq) = pack8(v0, v1);
                }
            }
    }
};
struct EpiEvSw { static constexpr bool PERM = true;
    unsigned char* ws;
    DI void operator()(const Acc& acc, const Unit& u, int wr, int wc, int fr, int fq) const {
        const int b = u.pn >> 3, sb = (u.pn & 7) * 256;
#pragma unroll
        for (int ai = 0; ai < 2; ++ai)
#pragma unroll
            for (int m = 0; m < 4; ++m) {
                const int rl = EPI_ROWS(ai, m);
                size_t boff, rowi;
                if (u.pm < 2) { const int fg = u.pm * 256 + rl; boff = WS_VAT; rowi = (size_t)(b * 4 + (fg >> 7)) * 128 + (fg & 127); }
                else { const int r2 = rl & 127; boff = (rl < 128) ? WS_VST : WS_VWT; rowi = (size_t)(b * 2 + (r2 >> 6)) * 64 + (r2 & 63); }
                bf16_t* rowp = (bf16_t*)(ws + boff) + rowi * 2048;
#pragma unroll
                for (int bj = 0; bj < 2; ++bj) *(u32x4*)(rowp + sb + 128 * bj + 32 * wc + 8 * fq) = pack8(acc[ai][bj][m][0], acc[ai][bj][m][1]);
            }
    }
};
struct EpiCmp1 { static constexpr bool PERM = true;
    bf16_t* HID; const float* bias1;
    DI void operator()(const Acc& acc, const Unit& u, int wr, int wc, int fr, int fq) const {
        const int kv = u.pm >> 4, rt = u.pm & 15;
#pragma unroll
        for (int bj = 0; bj < 2; ++bj) {
            const int col = 128 * bj + 32 * wc + 8 * fq;
            const f32x4 b0 = *(const f32x4*)(bias1 + kv * 256 + col), b1 = *(const f32x4*)(bias1 + kv * 256 + col + 4);
#pragma unroll
            for (int ai = 0; ai < 2; ++ai)
#pragma unroll
                for (int m = 0; m < 4; ++m) {
                    f32x4 v0 = acc[ai][bj][m][0] + b0, v1 = acc[ai][bj][m][1] + b1;
#pragma unroll
                    for (int j = 0; j < 4; ++j) { v0[j] = v0[j] * sigm(v0[j]); v1[j] = v1[j] * sigm(v1[j]); }
                    *(u32x4*)(HID + ((size_t)kv * 4096 + rt * 256 + EPI_ROWS(ai, m)) * 256 + col) = pack8(v0, v1);
                }
        }
    }
};
struct EpiResid { static constexpr bool PERM = false;
    const float* Hin; float* Hout;
    DI void operator()(const Acc& acc, const Unit& u, int wr, int wc, int fr, int fq) const {
#pragma unroll
        for (int ai = 0; ai < 2; ++ai)
#pragma unroll
            for (int m = 0; m < 4; ++m) {
                const size_t off = (size_t)(u.pm * 256 + EPI_ROWS(ai, m)) * 1024 + u.pn * 256 + 32 * wc + 4 * fq;
#pragma unroll
                for (int bj = 0; bj < 2; ++bj)
#pragma unroll
                    for (int n = 0; n < 2; ++n) { const size_t o = off + 128 * bj + 16 * n; *(f32x4*)(Hout + o) = *(const f32x4*)(Hin + o) + acc[ai][bj][m][n]; }
            }
    }
};
DI float ret_lg2(int h) { return __log2f(1.0f - exp2f(-5.0f - (float)h)); }
struct EpiOdNat { static constexpr bool PERM = true;
    unsigned char* ws;
    DI void operator()(const Acc& acc, const Unit& u, int wr, int wc, int fr, int fq) const {
        const int pn = u.pn; const int h = pn & 3; const float lg = ret_lg2(h);
        const size_t boff = pn < 4 ? WS_AQ : pn < 8 ? WS_KP : WS_GG;
        const int rowmul = pn < 4 ? 2048 : pn < 8 ? 1024 : 2048;
        const int coff = pn < 4 ? (h * 512 + 256) : pn < 8 ? (h * 256) : ((pn - 8) * 256);
        bf16_t* base = (bf16_t*)(ws + boff) + coff;
#pragma unroll
        for (int ai = 0; ai < 2; ++ai)
#pragma unroll
            for (int m = 0; m < 4; ++m) {
                const int cl = EPI_ROWS(ai, m); const size_t t = (size_t)u.pm * 256 + cl;
                float sc = 1.f;
                if (pn < 4) sc = exp2f(lg * (float)(cl + 1)); else if (pn < 8) sc = 0.0625f * exp2f(-lg * (float)(cl + 1));
#pragma unroll
                for (int bj = 0; bj < 2; ++bj) {
                    const int d = 128 * bj + 32 * wc + 8 * fq;
                    f32x4 v0 = acc[ai][bj][m][0] * sc, v1 = acc[ai][bj][m][1] * sc;
                    if (pn >= 8) {
#pragma unroll
                        for (int j = 0; j < 4; ++j) { v0[j] = v0[j] * sigm(v0[j]); v1[j] = v1[j] * sigm(v1[j]); } }
                    *(u32x4*)(base + t * rowmul + d) = pack8(v0, v1);
                }
            }
    }
};
struct EpiOdSw { static constexpr bool PERM = true;
    unsigned char* ws;
    DI void operator()(const Acc& acc, const Unit& u, int wr, int wc, int fr, int fq) const {
        const int b = u.pn >> 3, n = u.pn & 7;
        const bool isk = u.pm < 4; const int h = isk ? u.pm : ((u.pm - 4) >> 1);
        const size_t z = (size_t)(b * 4 + h) * 8 + n; const float lg = ret_lg2(h);
        bf16_t* base = (bf16_t*)(ws + (isk ? WS_KT : WS_VS)) + (isk ? z * 65536 : z * 262144 + (size_t)((u.pm - 4) & 1) * 256 * 512);
        const int rowmul = isk ? 256 : 512;
#pragma unroll
        for (int bj = 0; bj < 2; ++bj) {
            const int cl = 128 * bj + 32 * wc + 8 * fq;
            f32x4 s0 = {1.f, 1.f, 1.f, 1.f}, s1 = s0;
            if (isk) {
#pragma unroll
                for (int j = 0; j < 4; ++j) { s0[j] = 0.0625f * exp2f(-lg * (float)(cl + j + 1)); s1[j] = 0.0625f * exp2f(-lg * (float)(cl + 4 + j + 1)); } }
#pragma unroll
            for (int ai = 0; ai < 2; ++ai)
#pragma unroll
                for (int m = 0; m < 4; ++m)
                    *(u32x4*)(base + (size_t)EPI_ROWS(ai, m) * rowmul + cl) = pack8(acc[ai][bj][m][0] * s0, acc[ai][bj][m][1] * s1);
        }
    }
};
struct EpiAtt { static constexpr bool PERM = true;
    bf16_t* AQ;
    DI void operator()(const Acc& acc, const Unit& u, int wr, int wc, int fr, int fq) const {
        const int z = u.pm, n = z & 7, h = (z >> 3) & 3, b = z >> 5; const size_t t0 = (size_t)b * 2048 + n * 256;
#pragma unroll
        for (int ai = 0; ai < 2; ++ai)
#pragma unroll
            for (int m = 0; m < 4; ++m) {
                const int c = EPI_ROWS(ai, m);
#pragma unroll
                for (int bj = 0; bj < 2; ++bj) {
                    const int e0 = 128 * bj + 32 * wc + 8 * fq;
                    f32x4 v0 = acc[ai][bj][m][0], v1 = acc[ai][bj][m][1];
#pragma unroll
                    for (int j = 0; j < 4; ++j) { v0[j] = (c >= e0 + j) ? v0[j] : 0.f; v1[j] = (c >= e0 + 4 + j) ? v1[j] : 0.f; }
                    *(u32x4*)(AQ + ((t0 + c) * 4 + h) * 512 + e0) = pack8(v0, v1);
                }
            }
    }
};
struct EpiUT { static constexpr bool PERM = false;
    float* UT;
    DI void operator()(const Acc& acc, const Unit& u, int wr, int wc, int fr, int fq) const {
        const size_t z = (size_t)(u.pm >> 1); const int half = u.pm & 1;
#pragma unroll
        for (int ai = 0; ai < 2; ++ai)
#pragma unroll
            for (int m = 0; m < 4; ++m) {
                float* rowp = UT + z * 131072 + (size_t)(half * 256 + EPI_ROWS(ai, m)) * 256 + 32 * wc + 4 * fq;
#pragma unroll
                for (int bj = 0; bj < 2; ++bj)
#pragma unroll
                    for (int n = 0; n < 2; ++n) *(f32x4*)(rowp + 128 * bj + 16 * n) = acc[ai][bj][m][n];
            }
    }
};
struct EpiY { static constexpr bool PERM = true;
    bf16_t* Y;
    DI void operator()(const Acc& acc, const Unit& u, int wr, int wc, int fr, int fq) const {
        const int z = u.pm, n = z & 7, h = (z >> 3) & 3, b = z >> 5; const size_t t0 = (size_t)b * 2048 + n * 256;
#pragma unroll
        for (int ai = 0; ai < 2; ++ai)
#pragma unroll
            for (int m = 0; m < 4; ++m) {
                bf16_t* rowp = Y + (t0 + EPI_ROWS(ai, m)) * 2048 + h * 512 + u.pn * 256 + 32 * wc + 8 * fq;
#pragma unroll
                for (int bj = 0; bj < 2; ++bj) *(u32x4*)(rowp + 128 * bj) = pack8(acc[ai][bj][m][0], acc[ai][bj][m][1]);
            }
    }
};
struct EpiGU { static constexpr bool PERM = true;
    bf16_t* ACT; const float* bgu; const LAS int* ts;
    DI void operator()(const Acc& acc, const Unit& u, int wr, int wc, int fr, int fq) const {
        const int e = moe_tile_expert(ts, u.pm); const int w = 32 * wc + 8 * fq;
        const float* bp = bgu + (size_t)e * 2048 + 128 * u.pn + w;
        const f32x4 bg0 = *(const f32x4*)bp, bg1 = *(const f32x4*)(bp + 4), bl0 = *(const f32x4*)(bp + 1024), bl1 = *(const f32x4*)(bp + 1028);
#pragma unroll
        for (int ai = 0; ai < 2; ++ai)
#pragma unroll
            for (int m = 0; m < 4; ++m) {
                f32x4 g0 = acc[ai][0][m][0] + bg0, g1 = acc[ai][0][m][1] + bg1, l0 = acc[ai][1][m][0] + bl0, l1 = acc[ai][1][m][1] + bl1;
#pragma unroll
                for (int j = 0; j < 4; ++j) {
                    const float a = fminf(g0[j], 7.0f), c = fminf(g1[j], 7.0f);
                    const float la = fminf(fmaxf(l0[j], -7.0f), 7.0f), lc = fminf(fmaxf(l1[j], -7.0f), 7.0f);
                    g0[j] = a * sigm(1.702f * a) * (la + 1.0f); g1[j] = c * sigm(1.702f * c) * (lc + 1.0f); }
                *(u32x4*)(ACT + ((size_t)u.pm * 256 + EPI_ROWS(ai, m)) * 1024 + 128 * u.pn + w) = pack8(g0, g1);
            }
    }
};
struct EpiDN { static constexpr bool PERM = true;
    bf16_t* YB; const float* bdn; const LAS int* ts;
    DI void operator()(const Acc& acc, const Unit& u, int wr, int wc, int fr, int fq) const {
        const int e = moe_tile_expert(ts, u.pm);
#pragma unroll
        for (int bj = 0; bj < 2; ++bj) {
            const int col = 256 * u.pn + 128 * bj + 32 * wc + 8 * fq;
            const f32x4 b0 = *(const f32x4*)(bdn + (size_t)e * 1024 + col), b1 = *(const f32x4*)(bdn + (size_t)e * 1024 + col + 4);
#pragma unroll
            for (int ai = 0; ai < 2; ++ai)
#pragma unroll
                for (int m = 0; m < 4; ++m)
                    *(u32x4*)(YB + ((size_t)u.pm * 256 + EPI_ROWS(ai, m)) * 1024 + col) = pack8(acc[ai][bj][m][0] + b0, acc[ai][bj][m][1] + b1);
        }
    }
};
struct EpiPP { static constexpr bool PERM = true;
    bf16_t* PP;
    DI void operator()(const Acc& acc, const Unit& u, int wr, int wc, int fr, int fq) const {
#pragma unroll
        for (int ai = 0; ai < 2; ++ai)
#pragma unroll
            for (int m = 0; m < 4; ++m) {
                bf16_t* rowp = PP + ((size_t)u.pm * 256 + EPI_ROWS(ai, m)) * 1024 + u.pn * 256 + 32 * wc + 8 * fq;
#pragma unroll
                for (int bj = 0; bj < 2; ++bj) *(u32x4*)(rowp + 128 * bj) = pack8(acc[ai][bj][m][0], acc[ai][bj][m][1]);
            }
    }
};
struct EpiPLE { static constexpr bool PERM = false;
    float* H; const bf16_t* PP;
    DI void operator()(const Acc& acc, const Unit& u, int wr, int wc, int fr, int fq) const {
#pragma unroll
        for (int ai = 0; ai < 2; ++ai)
#pragma unroll
            for (int m = 0; m < 4; ++m) {
                const size_t off = (size_t)(u.pm * 256 + EPI_ROWS(ai, m)) * 1024 + u.pn * 256 + 32 * wc + 4 * fq;
#pragma unroll
                for (int bj = 0; bj < 2; ++bj)
#pragma unroll
                    for (int n = 0; n < 2; ++n) {
                        const size_t o = off + 128 * bj + 16 * n;
                        const u32x2 pw = *(const u32x2*)(PP + o); const f32x4 a = acc[ai][bj][m][n]; f32x4 hv = *(const f32x4*)(H + o);
                        hv[0] += sigm(a[0]) * bflo(pw.x); hv[1] += sigm(a[1]) * bfhi(pw.x); hv[2] += sigm(a[2]) * bflo(pw.y); hv[3] += sigm(a[3]) * bfhi(pw.y);
                        *(f32x4*)(H + o) = hv;
                    }
            }
    }
};

constexpr int AT_KSTR = 144;
template <int DV, int MODE>
DI void attn_unit(const int WID, LAS unsigned char* lds, const bf16_t* Qp, int ldq, const bf16_t* Kp, int ldk, const bf16_t* Vt, int ldvt, int q0, float slope,
                  const unsigned* selp, bf16_t* Op, int ldo, float* impp) {
    constexpr int NRB = DV / 32, VPIECES = DV * 8;
    constexpr int KB0 = 0, KB1 = 64 * AT_KSTR, VB0 = 2 * 64 * AT_KSTR, VB1 = VB0 + DV * AT_KSTR;
    const int tid = opaque_tid(WID), w = __builtin_amdgcn_readfirstlane(tid >> 6), lane = tid & 63, r = lane & 31, hh = lane >> 5;
    const int qrow = q0 + 32 * w + r, qw_first = q0 + 32 * w, qw_last = qw_first + 31;
    const float LOG2E = 1.44269504089f, sc = 0.125f * LOG2E, slope2 = slope * LOG2E;
    bf16x8 qf[4];
#pragma unroll
    for (int ks = 0; ks < 4; ++ks) qf[ks] = *(const bf16x8*)(Qp + (size_t)(32 * w + r) * ldq + 16 * ks + 8 * hh);
    unsigned selm = 0xffffffffu, orm = 0xffffffffu;
    if (MODE == 1) { selm = selp[32 * w + r]; orm = selm;
#pragma unroll
        for (int o = 1; o < 32; o <<= 1) orm |= __shfl_xor(orm, o); }
    const int nv = (MODE == 3) ? (qrow >= 31 ? ((qrow - 15) >> 4) : 0) : 0;
    const int nv_wmax = (MODE == 3) ? (qw_last >= 31 ? ((qw_last - 15) >> 4) : 0) : 0;
    int kt_lo = 0, kt_hi;
    if (MODE == 0 || MODE == 1) kt_hi = (q0 >> 6) + 4;
    else if (MODE == 2) { kt_hi = (q0 >> 6) + 4; const int lk = q0 - 511; kt_lo = lk > 0 ? (lk >> 6) : 0; }
    else kt_hi = 2;
    f32x16 O[NRB];
#pragma unroll
    for (int rb = 0; rb < NRB; ++rb)
#pragma unroll
        for (int i = 0; i < 16; ++i) O[rb][i] = 0.f;
    float mrun = NEGF, lrun = 0.f;
    u32x4 kreg, vreg[2];
    const int krow = tid >> 3, kpc = tid & 7;
#define AT_GLOAD(kt) do { kreg = *(const u32x4*)(Kp + (size_t)(64 * (kt) + krow) * ldk + 8 * kpc); \
        _Pragma("unroll") for (int i_ = 0; i_ < 2; ++i_) { const int idx = tid + 512 * i_; if (idx < VPIECES) vreg[i_] = *(const u32x4*)(Vt + (size_t)(idx >> 3) * ldvt + 64 * (kt) + 8 * (idx & 7)); } } while (0)
#define AT_LWRITE(buf) do { *(LAS u32x4*)(lds + ((buf) ? KB1 : KB0) + krow * AT_KSTR + kpc * 16) = kreg; \
        _Pragma("unroll") for (int i_ = 0; i_ < 2; ++i_) { const int idx = tid + 512 * i_; if (idx < VPIECES) *(LAS u32x4*)(lds + ((buf) ? VB1 : VB0) + (idx >> 3) * AT_KSTR + (idx & 7) * 16) = vreg[i_]; } } while (0)
    AT_GLOAD(kt_lo); AT_LWRITE(0);
    __syncthreads();
    const int ntile = kt_hi - kt_lo;
    for (int it = 0; it < ntile; ++it) {
        const int kt = kt_lo + it, buf = it & 1, key0 = 64 * kt;
        if (it + 1 < ntile) AT_GLOAD(kt + 1);
        bool skip;
        if (MODE == 0) skip = key0 > qw_last;
        else if (MODE == 1) skip = (key0 > qw_last) || !((orm >> kt) & 1u);
        else if (MODE == 2) skip = (key0 > qw_last) || (key0 + 63 < qw_first - 511);
        else skip = key0 >= nv_wmax;
        if (!skip) {
            const LAS unsigned char* kb = lds + (buf ? KB1 : KB0); const LAS unsigned char* vb = lds + (buf ? VB1 : VB0);
            f32x16 S[2];
#pragma unroll
            for (int kk = 0; kk < 2; ++kk) {
#pragma unroll
                for (int i = 0; i < 16; ++i) S[kk][i] = 0.f;
#pragma unroll
                for (int ks = 0; ks < 4; ++ks) { const bf16x8 a = *(const LAS bf16x8*)(kb + (32 * kk + r) * AT_KSTR + (16 * ks + 8 * hh) * 2);
                    S[kk] = __builtin_amdgcn_mfma_f32_32x32x16_bf16(a, qf[ks], S[kk], 0, 0, 0); }
            }
            float mx = NEGF;
#pragma unroll
            for (int kk = 0; kk < 2; ++kk)
#pragma unroll
                for (int i = 0; i < 16; ++i) {
                    const int key = key0 + 32 * kk + (i & 3) + 8 * (i >> 2) + 4 * hh;
                    const int dist = qrow - key; float v = S[kk][i] * sc; bool valid;
                    if (MODE == 0) { valid = dist >= 0; v -= slope2 * (float)dist; }
                    else if (MODE == 1) { valid = (dist >= 0) && ((selm >> kt) & 1u); v -= slope2 * (float)dist; }
                    else if (MODE == 2) { valid = (dist >= 0) && (dist < 512); v -= slope2 * (float)dist; }
                    else valid = key < nv;
                    v = valid ? v : NEGF; S[kk][i] = v; mx = fmaxf(mx, v);
                }
            mx = fmaxf(mx, __shfl_xor(mx, 32));
            const float mnew = fmaxf(mrun, mx), alpha = __builtin_amdgcn_exp2f(mrun - mnew); mrun = mnew;
            float ps = 0.f;
#pragma unroll
            for (int kk = 0; kk < 2; ++kk)
#pragma unroll
                for (int i = 0; i < 16; ++i) { const float p = __builtin_amdgcn_exp2f(S[kk][i] - mnew); S[kk][i] = p; ps += p; }
            lrun = lrun * alpha + ps;
#pragma unroll
            for (int rb = 0; rb < NRB; ++rb)
#pragma unroll
                for (int i = 0; i < 16; ++i) O[rb][i] *= alpha;
#pragma unroll
            for (int kk = 0; kk < 2; ++kk)
#pragma unroll
                for (int s = 0; s < 2; ++s) {
                    u32x4 pw; pw.x = pk2(S[kk][8 * s + 0], S[kk][8 * s + 1]); pw.y = pk2(S[kk][8 * s + 2], S[kk][8 * s + 3]);
                    pw.z = pk2(S[kk][8 * s + 4], S[kk][8 * s + 5]); pw.w = pk2(S[kk][8 * s + 6], S[kk][8 * s + 7]);
                    const bf16x8 pf = __builtin_bit_cast(bf16x8, pw);
                    const int k1 = 32 * kk + 16 * s + 4 * hh;
#pragma unroll
                    for (int rb = 0; rb < NRB; ++rb) {
                        const LAS unsigned char* vp = vb + (32 * rb + r) * AT_KSTR + k1 * 2;
                        const s16x4 lo = *(const LAS s16x4*)vp, hi = *(const LAS s16x4*)(vp + 16);
                        const bf16x8 a = __builtin_shufflevector(lo, hi, 0, 1, 2, 3, 4, 5, 6, 7);
                        O[rb] = __builtin_amdgcn_mfma_f32_32x32x16_bf16(a, pf, O[rb], 0, 0, 0);
                    }
                }
        }
        if (it + 1 < ntile) AT_LWRITE(buf ^ 1);
        __syncthreads();
    }
#undef AT_GLOAD
#undef AT_LWRITE
    const float ltot = lrun + __shfl_xor(lrun, 32);
    float inv = 1.0f / ltot;
    if (MODE == 3) inv = (nv > 0) ? inv : 0.f;
#pragma unroll
    for (int rb = 0; rb < NRB; ++rb)
#pragma unroll
        for (int g4 = 0; g4 < 4; ++g4) {
            const float a = O[rb][4 * g4] * inv, b = O[rb][4 * g4 + 1] * inv, c = O[rb][4 * g4 + 2] * inv, d = O[rb][4 * g4 + 3] * inv;
            const int dv = 32 * rb + 8 * g4 + 4 * hh;
            if (MODE == 3 && rb == 2) { *(f32x4*)(impp + (size_t)(32 * w + r) * 256 + (dv - 64)) = (f32x4){a, b, c, d}; }
            else { u32x2 o; o.x = pk2(a, b); o.y = pk2(c, d); *(u32x2*)(Op + (size_t)(32 * w + r) * ldo + dv) = o; }
        }
}

struct Args { const float* in[26]; float* out; unsigned char* ws; int ph_lo, ph_hi; };
typedef const __attribute__((address_space(4))) Args* ArgsP;
DI ArgsP opaque_args() { auto p = __builtin_amdgcn_kernarg_segment_ptr(); asm volatile("" : "+s"(p)); return (ArgsP)p; }
enum { I_X = 0, I_P, I_N1G, I_N2G, I_EVWIN, I_EVWOUT, I_DAQN, I_DAKN, I_DALAM, I_DAOUTG, I_NSQN, I_NSKN, I_CMPPE, I_CMPW1, I_CMPW2, I_ODWIN, I_ODWOUT,
       I_RETG, I_ROUTW, I_ROUTB, I_WGU, I_BGU, I_WDN, I_BDN, I_PLEP, I_PLEG };

struct CvtJob { int in_idx, ldsrc, K, col0, ncols, dstrow0, perm, nmat; size_t src_stride, dst_off, dst_stride; };
constexpr int NJOBS = 19;
__constant__ CvtJob c_jobs[NJOBS] = {
    {I_EVWIN, EVIN, 1024, 0,    1024, 0,    1, 2, (size_t)1024 * EVIN, WS_EVNAT, (size_t)2048 * 1024},
    {I_EVWIN, EVIN, 1024, 1536, 512,  1024, 1, 2, (size_t)1024 * EVIN, WS_EVNAT, (size_t)2048 * 1024},
    {I_EVWIN, EVIN, 1024, 2048, 128,  1536, 1, 2, (size_t)1024 * EVIN, WS_EVNAT, (size_t)2048 * 1024},
    {I_EVWIN, EVIN, 1024, 2176, 128,  1664, 1, 2, (size_t)1024 * EVIN, WS_EVNAT, (size_t)2048 * 1024},
    {I_EVWIN, EVIN, 1024, 2304, 128,  1792, 1, 2, (size_t)1024 * EVIN, WS_EVNAT, (size_t)2048 * 1024},
    {I_EVWIN, EVIN, 1024, 2560, 128,  1920, 1, 2, (size_t)1024 * EVIN, WS_EVNAT, (size_t)2048 * 1024},
    {I_EVWIN, EVIN, 1024, 1024, 512,  0,    0, 2, (size_t)1024 * EVIN, WS_EVSW,  (size_t)768 * 1024},
    {I_EVWIN, EVIN, 1024, 2432, 128,  512,  0, 2, (size_t)1024 * EVIN, WS_EVSW,  (size_t)768 * 1024},
    {I_EVWIN, EVIN, 1024, 2688, 128,  640,  0, 2, (size_t)1024 * EVIN, WS_EVSW,  (size_t)768 * 1024},
    {I_EVWOUT, 1024, 1024, 0, 1024, 0, 0, 2, (size_t)1024 * 1024, WS_EVOUT, (size_t)1024 * 1024},
    {I_CMPW1, 256, 2048, 0, 256, 0, 0, 4, (size_t)2048 * 256, WS_CMP1, (size_t)256 * 2048},
    {I_ODWIN, ODIN, 1024, 0,    2048, 0,    0, 2, (size_t)1024 * ODIN, WS_ODNAT, (size_t)4096 * 1024},
    {I_ODWIN, ODIN, 1024, 4096, 2048, 2048, 0, 2, (size_t)1024 * ODIN, WS_ODNAT, (size_t)4096 * 1024},
    {I_ODWIN, ODIN, 1024, 1024, 3072, 0,    0, 2, (size_t)1024 * ODIN, WS_ODSW,  (size_t)3072 * 1024},
    {I_ODWOUT, 1024, 2048, 0, 1024, 0, 0, 2, (size_t)2048 * 1024, WS_ODOUT, (size_t)1024 * 2048},
    {I_WGU, 2048, 1024, 0, 2048, 0, 2, 128, (size_t)1024 * 2048, WS_WGU, (size_t)2048 * 1024},
    {I_WDN, 1024, 1024, 0, 1024, 0, 0, 128, (size_t)1024 * 1024, WS_WDN, (size_t)1024 * 1024},
    {I_PLEP, 1024, 256, 0, 1024, 0, 0, 4, (size_t)256 * 1024, WS_WPP, (size_t)1024 * 256},
    {I_PLEG, 1024, 1024, 0, 1024, 0, 0, 4, (size_t)1024 * 1024, WS_WPG, (size_t)1024 * 1024},
};
DI int cvt_dstrow(int perm, int L) {
    if (perm == 1) { const int pn = L >> 8, lc = L & 255; return pn * 256 + 128 * ((lc & 63) >> 5) + 32 * (lc >> 6) + (lc & 31); }
    if (perm == 2) { const int bj = L >> 10, cc = L & 1023; return 256 * (cc >> 7) + 128 * bj + (cc & 127); }
    return L;
}
DI void phase_prologue(const int WID, ArgsP a, LAS unsigned char* lds) {
    const int tid = opaque_tid(WID), lane = tid & 63, wv = tid >> 6;
    const int gw = blockIdx.x * 8 + wv, NGW = gridDim.x * 8;
    LAS float* scr = (LAS float*)(lds + wv * 16640);
    int total = 0;
    for (int j = 0; j < NJOBS; ++j) total += c_jobs[j].nmat * (c_jobs[j].K >> 6) * (c_jobs[j].ncols >> 6);
    for (int it = gw; it < total; it += NGW) {
        int r = it, j = 0;
        for (; j < NJOBS; ++j) { const int n = c_jobs[j].nmat * (c_jobs[j].K >> 6) * (c_jobs[j].ncols >> 6); if (r < n) break; r -= n; }
        const CvtJob J = c_jobs[j];
        const int nkb = J.K >> 6, nnb = J.ncols >> 6, per = nkb * nnb;
        const int mat = r / per, rr = r % per, kb = rr / nnb, nb = rr % nnb, k0 = kb * 64, n0 = nb * 64;
        const float* src = a->in[J.in_idx] + (size_t)mat * J.src_stride + (size_t)k0 * J.ldsrc + J.col0 + n0 + lane;
#pragma unroll 8
        for (int i = 0; i < 64; ++i) scr[i * 65 + lane] = src[(size_t)i * J.ldsrc];
        asm volatile("s_waitcnt lgkmcnt(0)" ::: "memory");
        bf16_t* dst = (bf16_t*)(a->ws + J.dst_off) + (size_t)mat * J.dst_stride;
        const int c = lane & 7, nsub = lane >> 3;
#pragma unroll
        for (int jj = 0; jj < 8; ++jj) {
            const int n = nsub + 8 * jj; const LAS float* s = scr + (8 * c) * 65 + n;
            u32x4 o; o.x = pk2(s[0], s[65]); o.y = pk2(s[2 * 65], s[3 * 65]); o.z = pk2(s[4 * 65], s[5 * 65]); o.w = pk2(s[6 * 65], s[7 * 65]);
            const int drow = cvt_dstrow(J.perm, J.dstrow0 + n0 + n);
            *(u32x4*)(dst + (size_t)drow * J.K + k0 + 8 * c) = o;
        }
        asm volatile("s_waitcnt lgkmcnt(0)" ::: "memory");
    }
    {
        const float* p = a->in[I_P]; bf16_t* pb = (bf16_t*)(a->ws + WS_PBF);
        const size_t n8 = (size_t)DEPTH * T * 256 / 8;
        for (size_t i = (size_t)blockIdx.x * 512 + tid; i < n8; i += (size_t)gridDim.x * 512) {
            const f32x4 v0 = *(const f32x4*)(p + i * 8), v1 = *(const f32x4*)(p + i * 8 + 4);
            *(u32x4*)(pb + i * 8) = pack8(v0, v1);
        }
    }
    if (blockIdx.x == 4 && tid < 512) { const int ev = tid >> 8, gi = (tid >> 6) & 3, d = tid & 63;
        const float* src = a->in[gi == 0 ? I_DAQN : gi == 1 ? I_DAKN : gi == 2 ? I_NSQN : I_NSKN];
        ((float*)(a->ws + WS_GAINS))[tid] = src[ev * 64 + d]; }
    if (blockIdx.x < 4 && tid < 256) {
        const int m = blockIdx.x; const float* pe = a->in[I_CMPPE] + (size_t)m * 2048; const float* w1 = a->in[I_CMPW1] + (size_t)m * 2048 * 256;
        float s = 0.f;
        for (int k = 0; k < 2048; ++k) s += pe[k] * w1[(size_t)k * 256 + tid];
        ((float*)(a->ws + WS_BIAS1))[m * 256 + tid] = s;
    }
}

DI float row_load_ss(const float* row, int lane, f32x4 (&v)[4]) {
    float ss = 0.f;
#pragma unroll
    for (int j = 0; j < 4; ++j) { v[j] = *(const f32x4*)(row + 4 * lane + 256 * j); ss += (v[j][0] * v[j][0] + v[j][1] * v[j][1]) + (v[j][2] * v[j][2] + v[j][3] * v[j][3]); }
    return wave_sum(ss);
}
DI void row_store_bf16(bf16_t* row, int lane, const f32x4 (&v)[4]) {
#pragma unroll
    for (int j = 0; j < 4; ++j) { u32x2 o; o.x = pk2(v[j][0], v[j][1]); o.y = pk2(v[j][2], v[j][3]); *(u32x2*)(row + 4 * lane + 256 * j) = o; }
}
template <int MODE>
DI void phase_norm(const int WID, ArgsP a, LAS unsigned char* lds, int layer, const float* Hin) {
    const int tid = opaque_tid(WID), lane = tid & 63, wv = tid >> 6;
    LAS float* wt = (LAS float*)lds;
    LAS int* wcnt = (LAS int*)(lds + MISC_OFF + MO_WCNT); LAS int* ent = (LAS int*)(lds + MISC_OFF + MO_ENT); LAS float* gat = (LAS float*)(lds + MISC_OFF + MO_GAT);
    bf16_t* XN = (bf16_t*)(a->ws + WS_XN);
    const float* gain = a->in[MODE == 2 ? I_N2G : I_N1G] + layer * 1024;
    constexpr int NQ = MODE == 0 ? 24 : (MODE == 2 ? 32 : 0);
    if (MODE == 0) { const float* w = a->in[I_EVWIN] + (size_t)(layer >> 1) * 1024 * EVIN + 2816;
        for (int i = tid; i < 24 * 1024; i += 512) { const int k = i / 24, q = i % 24; wt[q * 1024 + k] = w[(size_t)k * EVIN + q]; } }
    if (MODE == 2) { const float* w = a->in[I_ROUTW] + (size_t)layer * 1024 * 32;
        for (int i = tid; i < 32 * 1024; i += 512) { const int k = i >> 5, q = i & 31; wt[q * 1024 + k] = w[i]; } }
    f32x4 gn[4];
#pragma unroll
    for (int j = 0; j < 4; ++j) gn[j] = *(const f32x4*)(gain + 4 * lane + 256 * j);
    __syncthreads();
    for (int vb = blockIdx.x; vb < NTB; vb += gridDim.x) {
        if (MODE == 2) { if (tid < 256) wcnt[tid] = 0; __syncthreads(); }
#pragma unroll 1
        for (int i = 0; i < 16; ++i) {
            const int t = vb * 128 + wv * 16 + i;
            f32x4 v[4];
            const float ss = row_load_ss(Hin + (size_t)t * 1024, lane, v);
            const float rstd = rsqrtf(ss * (1.0f / 1024.0f) + EPS);
#pragma unroll
            for (int j = 0; j < 4; ++j) v[j] = v[j] * rstd * gn[j];
            row_store_bf16(XN + (size_t)t * 1024, lane, v);
            if (NQ > 0) {
                float lg[NQ > 0 ? NQ : 1];
#pragma unroll
                for (int q = 0; q < NQ; ++q) { float s = 0.f;
#pragma unroll
                    for (int j = 0; j < 4; ++j) { const f32x4 ww = *(const LAS f32x4*)(wt + q * 1024 + 4 * lane + 256 * j); s += (v[j][0] * ww[0] + v[j][1] * ww[1]) + (v[j][2] * ww[2] + v[j][3] * ww[3]); }
                    lg[q] = wave_sum(s);
                    if ((q & 3) == 3) asm volatile("" ::: "memory"); }
                if (MODE == 0) {
                    float mine = 0.f;
#pragma unroll
                    for (int q = 0; q < NQ; ++q) mine = (lane == q) ? lg[q] : mine;
                    if (lane < 24) ((float*)(a->ws + WS_GATES))[(size_t)t * 24 + lane] = sigm(mine);
                }
                if (MODE == 2) {
                    const float* rb = a->in[I_ROUTB] + layer * 32;
#pragma unroll
                    for (int q = 0; q < NQ; ++q) lg[q] += rb[q];
                    unsigned used = 0u; int te[4]; float tv[4];
#pragma unroll
                    for (int k = 0; k < 4; ++k) { float best = -3.0e38f; int bi = 0;
#pragma unroll
                        for (int q = 0; q < NQ; ++q) { const bool ok = !((used >> q) & 1u) && (lg[q] > best); best = ok ? lg[q] : best; bi = ok ? q : bi; }
                        used |= 1u << bi; te[k] = bi; tv[k] = best; }
                    float ex[4], sum = 0.f;
#pragma unroll
                    for (int k = 0; k < 4; ++k) { ex[k] = __expf(tv[k] - tv[0]); sum += ex[k]; }
                    if (lane == 0) {
#pragma unroll
                        for (int k = 0; k < 4; ++k) { const int e = te[k]; const int lp = wcnt[wv * 32 + e]; wcnt[wv * 32 + e] = lp + 1; ent[wv * 64 + i * 4 + k] = e | (lp << 8); gat[wv * 64 + i * 4 + k] = ex[k] / sum; }
                    }
                }
            }
        }
        if (MODE == 2) {
            __syncthreads();
            { const int en = ent[wv * 64 + lane], e = en & 255; int pos = en >> 8;
              for (int w2 = 0; w2 < wv; ++w2) pos += wcnt[w2 * 32 + e];
              const size_t idx = (size_t)(vb * 128 + wv * 16) * 4 + lane;
              ((int*)(a->ws + WS_TOPE))[idx] = e; ((int*)(a->ws + WS_POSB))[idx] = pos; ((float*)(a->ws + WS_GATEW))[idx] = gat[wv * 64 + lane]; }
            if (tid < 32) { int s = 0;
#pragma unroll
                for (int w2 = 0; w2 < 8; ++w2) s += wcnt[w2 * 32 + tid];
                ((int*)(a->ws + WS_BCNT))[((size_t)layer * NTB + vb) * 32 + tid] = s; }
            __syncthreads();
        }
    }
}
DI void moe_tables(const int WID, ArgsP a, LAS unsigned char* lds, int layer, int vb) {
    const int tid = opaque_tid(WID);
    LAS int* tot = (LAS int*)(lds + MISC_OFF + MO_TOT); LAS int* base = (LAS int*)(lds + MISC_OFF + MO_BASE); LAS int* ts = (LAS int*)(lds + MISC_OFF + MO_TS);
    LAS int* red = (LAS int*)(lds + MISC_OFF + MO_RED);
    const int* bc = (const int*)(a->ws + WS_BCNT) + (size_t)layer * NTB * 32;
    { const int e = tid & 31, part = tid >> 5; int st = 0, sp = 0;
      for (int blk = part; blk < NTB; blk += 16) { const int v = bc[blk * 32 + e]; st += v; sp += (blk < vb) ? v : 0; }
      red[part * 32 + e] = st; red[512 + part * 32 + e] = sp; }
    __syncthreads();
    if (tid < 32) { int st = 0, sp = 0;
#pragma unroll
        for (int p = 0; p < 16; ++p) { st += red[p * 32 + tid]; sp += red[512 + p * 32 + tid]; }
        tot[tid] = st; base[tid] = sp; }
    __syncthreads();
    if (tid == 0) { int acc = 0; for (int e = 0; e < 32; ++e) { ts[e] = acc; acc += (tot[e] + 255) >> 8; } ts[32] = acc; }
    __syncthreads();
}
DI void phase_moe_slots(const int WID, ArgsP a, LAS unsigned char* lds, int layer) {
    const int tid = opaque_tid(WID), lane = tid & 63, wv = tid >> 6;
    LAS int* base = (LAS int*)(lds + MISC_OFF + MO_BASE); LAS int* ts = (LAS int*)(lds + MISC_OFF + MO_TS);
    const bf16_t* XN = (const bf16_t*)(a->ws + WS_XN); bf16_t* XB = (bf16_t*)(a->ws + WS_XB);
    for (int vb = blockIdx.x; vb < NTB; vb += gridDim.x) {
        moe_tables(WID, a, lds, layer, vb);
#pragma unroll 1
        for (int i = 0; i < 16; ++i) {
            const int t = vb * 128 + wv * 16 + i;
            int dest = 0;
            if (lane < 4) { const int e = ((const int*)(a->ws + WS_TOPE))[(size_t)t * 4 + lane], pos = ((const int*)(a->ws + WS_POSB))[(size_t)t * 4 + lane];
                dest = ts[e] * 256 + base[e] + pos; ((int*)(a->ws + WS_DEST))[(size_t)t * 4 + lane] = dest; }
            const u32x4 r0 = *(const u32x4*)(XN + (size_t)t * 1024 + 8 * lane), r1 = *(const u32x4*)(XN + (size_t)t * 1024 + 512 + 8 * lane);
#pragma unroll
            for (int k = 0; k < 4; ++k) { const int d = __shfl(dest, k); bf16_t* o = XB + (size_t)d * 1024; *(u32x4*)(o + 8 * lane) = r0; *(u32x4*)(o + 512 + 8 * lane) = r1; }
        }
        __syncthreads();
    }
}
DI void phase_combine(const int WID, ArgsP a, float* H) {
    const int tid = opaque_tid(WID), lane = tid & 63, wv = tid >> 6;
    const bf16_t* YB = (const bf16_t*)(a->ws + WS_YB); bf16_t* XN = (bf16_t*)(a->ws + WS_XN);
    for (int t = blockIdx.x * 8 + wv; t < T; t += gridDim.x * 8) {
        int dest = 0; float gw = 0.f;
        if (lane < 4) { dest = ((const int*)(a->ws + WS_DEST))[(size_t)t * 4 + lane]; gw = ((const float*)(a->ws + WS_GATEW))[(size_t)t * 4 + lane]; }
        f32x4 v[4];
#pragma unroll
        for (int j = 0; j < 4; ++j) v[j] = *(const f32x4*)(H + (size_t)t * 1024 + 4 * lane + 256 * j);
#pragma unroll
        for (int k = 0; k < 4; ++k) { const int d = __shfl(dest, k); const float g = __shfl(gw, k); const bf16_t* y = YB + (size_t)d * 1024;
#pragma unroll
            for (int j = 0; j < 4; ++j) { const u32x2 w = *(const u32x2*)(y + 4 * lane + 256 * j); v[j][0] += g * bflo(w.x); v[j][1] += g * bfhi(w.x); v[j][2] += g * bflo(w.y); v[j][3] += g * bfhi(w.y); } }
        float ss = 0.f;
#pragma unroll
        for (int j = 0; j < 4; ++j) { *(f32x4*)(H + (size_t)t * 1024 + 4 * lane + 256 * j) = v[j]; ss += (v[j][0] * v[j][0] + v[j][1] * v[j][1]) + (v[j][2] * v[j][2] + v[j][3] * v[j][3]); }
        ss = wave_sum(ss);
        const float rstd = rsqrtf(ss * (1.0f / 1024.0f) + EPS);
#pragma unroll
        for (int j = 0; j < 4; ++j) v[j] = v[j] * rstd;
        row_store_bf16(XN + (size_t)t * 1024, lane, v);
    }
}
DI void phase_cmp2(const int WID, ArgsP a, int ev) {
    const int tid = opaque_tid(WID), lane = tid & 63, wv = tid >> 6;
    const bf16_t* HID = (const bf16_t*)(a->ws + WS_HID); bf16_t* KCMP = (bf16_t*)(a->ws + WS_KCMP); bf16_t* VCMPT = (bf16_t*)(a->ws + WS_VCMPT);
    const float* kng = a->in[I_NSKN] + ev * 64;
    for (int it = blockIdx.x * 8 + wv; it < 8192; it += gridDim.x * 8) {
        const int kv = it >> 12, row = it & 4095, bg = row >> 7, n = row & 127;
        const float* w2 = a->in[I_CMPW2] + (size_t)(ev * 2 + kv) * 256 * 64;
        const bf16_t* hrow = HID + ((size_t)kv * 4096 + row) * 256;
        float s = 0.f;
        for (int k = 0; k < 256; k += 8) { const u32x4 hw = *(const u32x4*)(hrow + k);
            s += bflo(hw.x) * w2[(k + 0) * 64 + lane] + bfhi(hw.x) * w2[(k + 1) * 64 + lane] + bflo(hw.y) * w2[(k + 2) * 64 + lane] + bfhi(hw.y) * w2[(k + 3) * 64 + lane]
               + bflo(hw.z) * w2[(k + 4) * 64 + lane] + bfhi(hw.z) * w2[(k + 5) * 64 + lane] + bflo(hw.w) * w2[(k + 6) * 64 + lane] + bfhi(hw.w) * w2[(k + 7) * 64 + lane]; }
        if (n == 127) s = 0.f;
        if (kv == 0) { const float ss = wave_sum(s * s); const float o = s * rsqrtf(ss * (1.0f / 64.0f) + EPS) * kng[lane];
            KCMP[((size_t)bg * 128 + n) * 64 + lane] = (bf16_t)(pk2(o, 0.f) & 0xffffu); }
        else VCMPT[((size_t)bg * 96 + lane) * 128 + n] = (bf16_t)(pk2(s, 0.f) & 0xffffu);
    }
    for (int i = blockIdx.x * 512 + tid; i < 32 * 32 * 128; i += gridDim.x * 512) {
        const int n = i & 127, j = (i >> 7) & 31, bg = i >> 12;
        float o = 0.f;
        if (n < 127) { const int d = n - 4 * j; if (d >= 0 && d <= 2) o = 1.0f; else if (d == 3 || d == -1) o = 0.5f; }
        VCMPT[((size_t)bg * 96 + 64 + j) * 128 + n] = (bf16_t)(pk2(o, 0.f) & 0xffffu);
    }
}
DI void phase_topk(const int WID, ArgsP a) {
    const float* IMPH = (const float*)(a->ws + WS_IMPH); unsigned* SELM = (unsigned*)(a->ws + WS_SELM);
    for (int i = blockIdx.x * 512 + opaque_tid(WID); i < T * 2; i += gridDim.x * 512) {
        const int t = i >> 1, g = i & 1, b = t >> 11, s = t & 2047, cur = s >> 6;
        float sc[32];
#pragma unroll
        for (int j4 = 0; j4 < 8; ++j4) { f32x4 acc = {0.f, 0.f, 0.f, 0.f};
#pragma unroll
            for (int r = 0; r < 4; ++r) acc += *(const f32x4*)(IMPH + ((size_t)t * 8 + g * 4 + r) * 32 + 4 * j4);
#pragma unroll
            for (int q = 0; q < 4; ++q) sc[4 * j4 + q] = acc[q]; }
        unsigned mask;
        if (cur < 16) mask = (cur == 31) ? 0xffffffffu : ((2u << cur) - 1u);
        else {
#pragma unroll
            for (int j = 0; j < 32; ++j) { const bool forced = (j == 0) || (j == cur) || (j == cur - 1); sc[j] = (j > cur) ? NEGF : (sc[j] + (forced ? 1e4f : 0.f)); }
            mask = 0u;
#pragma unroll
            for (int j = 0; j < 32; ++j) { int rank = 0;
#pragma unroll
                for (int k = 0; k < 32; ++k) rank += ((sc[k] > sc[j]) || (sc[k] == sc[j] && k < j)) ? 1 : 0;
                mask |= (rank < 16) ? (1u << j) : 0u; }
        }
        SELM[((size_t)(b * 2 + g)) * 2048 + s] = mask;
    }
}
DI void phase_mixprep(const int WID, ArgsP a, int layer) {
    const int tid = opaque_tid(WID), lane = tid & 63, wv = tid >> 6, ev = layer >> 1;
    const float* dl = a->in[I_DALAM] + ev * 256;
    const float s1 = wave_sum(dl[lane] * dl[64 + lane]), s2 = wave_sum(dl[128 + lane] * dl[192 + lane]);
    const float lam_init = 0.8f - 0.6f * expf(-0.3f * (float)layer);
    const float lam = expf(s1) - expf(s2) + lam_init;
    const float* og = a->in[I_DAOUTG] + ev * 128;
    const bf16_t* OD = (const bf16_t*)(a->ws + WS_OD); const bf16_t* OC = (const bf16_t*)(a->ws + WS_OC); const bf16_t* OS = (const bf16_t*)(a->ws + WS_OS); const bf16_t* OW = (const bf16_t*)(a->ws + WS_OW);
    const float* GT = (const float*)(a->ws + WS_GATES); bf16_t* AMIX = (bf16_t*)(a->ws + WS_AMIX);
    const int h = lane >> 4, dv = (lane & 15) * 8;
    f32x4 g0 = *(const f32x4*)(og + dv), g1 = *(const f32x4*)(og + dv + 4);
    for (int t = blockIdx.x * 8 + wv; t < T; t += gridDim.x * 8) {
        { const u32x4 w1 = *(const u32x4*)(OD + (size_t)t * 1024 + h * 128 + dv), w2 = *(const u32x4*)(OD + (size_t)t * 1024 + (4 + h) * 128 + dv);
          f32x4 d0, d1;
          d0[0] = bflo(w1.x) - lam * bflo(w2.x); d0[1] = bfhi(w1.x) - lam * bfhi(w2.x); d0[2] = bflo(w1.y) - lam * bflo(w2.y); d0[3] = bfhi(w1.y) - lam * bfhi(w2.y);
          d1[0] = bflo(w1.z) - lam * bflo(w2.z); d1[1] = bfhi(w1.z) - lam * bfhi(w2.z); d1[2] = bflo(w1.w) - lam * bflo(w2.w); d1[3] = bfhi(w1.w) - lam * bfhi(w2.w);
          float ss = (d0[0] * d0[0] + d0[1] * d0[1]) + (d0[2] * d0[2] + d0[3] * d0[3]) + (d1[0] * d1[0] + d1[1] * d1[1]) + (d1[2] * d1[2] + d1[3] * d1[3]);
          ss += __shfl_xor(ss, 1); ss += __shfl_xor(ss, 2); ss += __shfl_xor(ss, 4); ss += __shfl_xor(ss, 8);
          const float rs = rsqrtf(ss * (1.0f / 128.0f) + EPS) * (1.0f - lam_init);
          *(u32x4*)(AMIX + (size_t)t * 1024 + h * 128 + dv) = pack8(d0 * rs * g0, d1 * rs * g1); }
        { const int hd = lane >> 3, dq = (lane & 7) * 8; const size_t o = (size_t)t * 512 + hd * 64 + dq;
          const float ga = GT[(size_t)t * 24 + hd * 3], gb = GT[(size_t)t * 24 + hd * 3 + 1], gc = GT[(size_t)t * 24 + hd * 3 + 2];
          const u32x4 c = *(const u32x4*)(OC + o), s = *(const u32x4*)(OS + o), w = *(const u32x4*)(OW + o);
          f32x4 r0, r1;
          r0[0] = ga * bflo(c.x) + gb * bflo(s.x) + gc * bflo(w.x); r0[1] = ga * bfhi(c.x) + gb * bfhi(s.x) + gc * bfhi(w.x);
          r0[2] = ga * bflo(c.y) + gb * bflo(s.y) + gc * bflo(w.y); r0[3] = ga * bfhi(c.y) + gb * bfhi(s.y) + gc * bfhi(w.y);
          r1[0] = ga * bflo(c.z) + gb * bflo(s.z) + gc * bflo(w.z); r1[1] = ga * bfhi(c.z) + gb * bfhi(s.z) + gc * bfhi(w.z);
          r1[2] = ga * bflo(c.w) + gb * bflo(s.w) + gc * bflo(w.w); r1[3] = ga * bfhi(c.w) + gb * bfhi(s.w) + gc * bfhi(w.w);
          *(u32x4*)(AMIX + (size_t)t * 1024 + 512 + hd * 64 + dq) = pack8(r0, r1); }
    }
}
DI void phase_scan(const int WID, ArgsP a) {
    const float* UT = (const float*)(a->ws + WS_UT); bf16_t* VS = (bf16_t*)(a->ws + WS_VS);
    for (int i = blockIdx.x * 512 + opaque_tid(WID); i < 64 * 512 * 64; i += gridDim.x * 512) {
        const int d4 = i & 63, f = (i >> 6) & 511, bh = i >> 15, h = bh & 3;
        const float dec = exp2f(256.0f * ret_lg2(h));
        f32x4 S = {0.f, 0.f, 0.f, 0.f};
#pragma unroll 1
        for (int n = 0; n < 8; ++n) {
            const size_t z = (size_t)bh * 8 + n;
            u32x2 o; o.x = pk2(S[0], S[1]); o.y = pk2(S[2], S[3]);
            *(u32x2*)(VS + (z * 512 + f) * 512 + 256 + 4 * d4) = o;
            const f32x4 u = *(const f32x4*)(UT + z * 131072 + (size_t)f * 256 + 4 * d4);
            S = (S + u) * dec;
        }
    }
}
DI void phase_normgate(const int WID, ArgsP a, int od) {
    const int tid = opaque_tid(WID), lane = tid & 63, wv = tid >> 6;
    const bf16_t* Y = (const bf16_t*)(a->ws + WS_Y); const bf16_t* GG = (const bf16_t*)(a->ws + WS_GG); bf16_t* YG = (bf16_t*)(a->ws + WS_YG);
    const float* og = a->in[I_RETG] + od * 512;
    const f32x4 g0 = *(const f32x4*)(og + 8 * lane), g1 = *(const f32x4*)(og + 8 * lane + 4);
    for (int t = blockIdx.x * 8 + wv; t < T; t += gridDim.x * 8) {
#pragma unroll
        for (int h = 0; h < 4; ++h) {
            const size_t o = (size_t)t * 2048 + h * 512 + 8 * lane;
            const u32x4 yw = *(const u32x4*)(Y + o), gw = *(const u32x4*)(GG + o);
            f32x4 y0 = {bflo(yw.x), bfhi(yw.x), bflo(yw.y), bfhi(yw.y)}, y1 = {bflo(yw.z), bfhi(yw.z), bflo(yw.w), bfhi(yw.w)};
            const f32x4 q0 = {bflo(gw.x), bfhi(gw.x), bflo(gw.y), bfhi(gw.y)}, q1 = {bflo(gw.z), bfhi(gw.z), bflo(gw.w), bfhi(gw.w)};
            float ss = (y0[0] * y0[0] + y0[1] * y0[1]) + (y0[2] * y0[2] + y0[3] * y0[3]) + (y1[0] * y1[0] + y1[1] * y1[1]) + (y1[2] * y1[2] + y1[3] * y1[3]);
            ss = wave_sum(ss);
            const float rs = rsqrtf(ss * (1.0f / 512.0f) + EPS);
            *(u32x4*)(YG + o) = pack8(y0 * rs * g0 * q0, y1 * rs * g1 * q1);
        }
    }
}
DI int snake_unit(int rnd, int G, int c) { return (rnd & 1) ? rnd * G + (G - 1 - c) : rnd * G + c; }
template <int MODE>
DI void phase_attn(const int WID, ArgsP a, LAS unsigned char* lds) {
    const int G = gridDim.x, c = blockIdx.x;
    const bf16_t* QD = (const bf16_t*)(a->ws + WS_QD); const bf16_t* KD = (const bf16_t*)(a->ws + WS_KD); const bf16_t* QN = (const bf16_t*)(a->ws + WS_QN);
    for (int rnd = 0;; ++rnd) {
        const int L = snake_unit(rnd, G, c); if (L >= 1024) { if (rnd * G >= 1024) break; else continue; }
        const int qb = 7 - (L >> 7), bh = L & 127, b = bh >> 3, hd = bh & 7, q0 = qb * 256; const size_t t0 = (size_t)b * 2048 + q0;
        if (MODE == 0) {
            const float slope = exp2f(-2.0f * (float)((hd & 3) + 1));
            attn_unit<128, 0>(WID, lds, QD + t0 * 512 + hd * 64, 512, KD + (size_t)b * 2048 * 512 + hd * 64, 512,
                              (const bf16_t*)(a->ws + WS_VAT) + (size_t)(b * 4 + (hd & 3)) * 128 * 2048, 2048, q0, slope, nullptr,
                              (bf16_t*)(a->ws + WS_OD) + t0 * 1024 + hd * 128, 1024, nullptr);
        } else if (MODE == 1 || MODE == 2) {
            const int g = hd >> 2; const float slope = exp2f(-(float)(hd + 1));
            const bf16_t* Kb = (const bf16_t*)(a->ws + (MODE == 1 ? WS_KSB : WS_KWB)) + (size_t)(b * 2 + g) * 2048 * 64;
            const bf16_t* Vb = (const bf16_t*)(a->ws + (MODE == 1 ? WS_VST : WS_VWT)) + (size_t)(b * 2 + g) * 64 * 2048;
            attn_unit<64, MODE>(WID, lds, QN + t0 * 512 + hd * 64, 512, Kb, 64, Vb, 2048, q0, slope,
                                (const unsigned*)(a->ws + WS_SELM) + (size_t)(b * 2 + g) * 2048 + q0,
                                (bf16_t*)(a->ws + (MODE == 1 ? WS_OS : WS_OW)) + t0 * 512 + hd * 64, 512, nullptr);
        } else {
            const int g = hd >> 2;
            attn_unit<96, 3>(WID, lds, QN + t0 * 512 + hd * 64, 512, (const bf16_t*)(a->ws + WS_KCMP) + (size_t)(b * 2 + g) * 128 * 64, 64,
                             (const bf16_t*)(a->ws + WS_VCMPT) + (size_t)(b * 2 + g) * 96 * 128, 128, q0, 0.f, nullptr,
                             (bf16_t*)(a->ws + WS_OC) + t0 * 512 + hd * 64, 512, (float*)(a->ws + WS_IMPH) + (t0 * 8 + hd) * 32);
        }
    }
}

constexpr int PPL = 15;
constexpr int NPHASE = 1 + DEPTH * PPL;
__global__ void __launch_bounds__(512, 2) mk_fwd(Args a_unused) {
    ArgsP a = opaque_args();
    extern __shared__ __attribute__((aligned(16))) unsigned char lds_raw[];
    LAS unsigned char* lds = (LAS unsigned char*)lds_raw;
    const int tid = threadIdx.x, G = gridDim.x, c = blockIdx.x;
    const int WID = __builtin_amdgcn_readfirstlane(tid >> 6);
    volatile LAS unsigned* misc = (volatile LAS unsigned*)(lds + MISC_OFF);
    if (tid < 4) misc[tid] = 0u;
    __syncthreads();
    unsigned* ctl = (unsigned*)(a->ws + WS_CTL);
    XcdBarrier bar; bar.bar = ctl + CW_BAR; bar.x = 0; bar.st = misc;
    const int ph_lo = a->ph_lo, ph_hi = a->ph_hi;
    const bool multi = (ph_hi - ph_lo) > 1;
    if (multi) bar = xcd_barrier_post(WID, ctl + CW_BAR, misc);
    bool first = true;
#define PHASE_BEGIN(k, id) if ((DBG_ONLY < 0 || DBG_ONLY == (id)) && (k) >= ph_lo && (k) < ph_hi && (k) <= DBG_LAST_PHASE) { if (!first) xcd_barrier(WID, bar); first = false; \
        ArgsP a = opaque_args(); unsigned char* ws = a->ws; bf16_t* XN = (bf16_t*)(ws + WS_XN); float* H = a->out; const float* Hin = (layer == 0) ? a->in[I_X] : (const float*)H; \
        const LAS int* ts = (const LAS int*)(lds + MISC_OFF + MO_TS); (void)XN; (void)H; (void)Hin; (void)ts;
#define PHASE_END }
    { const int layer = 0; PHASE_BEGIN(0, 0) phase_prologue(WID, a, lds); PHASE_END }
#pragma unroll 1
    for (int layer = 0; layer < DEPTH; ++layer) {
        const int pb = 1 + layer * PPL; const bool even = (layer & 1) == 0; const int ev = layer >> 1, od = layer >> 1;
        if (even) {
            PHASE_BEGIN(pb + 0, 1) phase_norm<0>(WID, a, lds, layer, Hin); PHASE_END
            PHASE_BEGIN(pb + 1, 2) {
                { ProbPlain P{XN, (const bf16_t*)(ws + WS_EVNAT) + (size_t)ev * 2048 * 1024, 1024, 1024, 1024}; pg8::Sched S; S.init(T / 256, 8, G, c);
                  EpiEvNat E{ws, (const float*)(ws + WS_GAINS) + ev * 256};
                  pg8::gemm_phase(WID, lds, P, S, E); }
                { ProbPlain P{(const bf16_t*)(ws + WS_EVSW) + (size_t)ev * 768 * 1024, XN, 1024, 1024, 1024}; pg8::Sched S; S.init(3, T / 256, G, c);
                  EpiEvSw E{ws};
                  pg8::gemm_phase(WID, lds, P, S, E); }
            } PHASE_END
            PHASE_BEGIN(pb + 2, 3) {
                { ProbCmp1 P{(const bf16_t*)(ws + WS_KCB), (const bf16_t*)(ws + WS_VCB), (const bf16_t*)(ws + WS_CMP1) + (size_t)ev * 2 * 256 * 2048, 1024, 2048, 2048}; pg8::Sched S; S.init(32, 1, G, c);
                  EpiCmp1 E{(bf16_t*)(ws + WS_HID), (const float*)(ws + WS_BIAS1) + ev * 512};
                  pg8::gemm_phase(WID, lds, P, S, E); }
                phase_attn<0>(WID, a, lds);
                phase_attn<2>(WID, a, lds);
            } PHASE_END
            PHASE_BEGIN(pb + 3, 4) phase_cmp2(WID, a, ev); PHASE_END
            PHASE_BEGIN(pb + 4, 5) phase_attn<3>(WID, a, lds); PHASE_END
            PHASE_BEGIN(pb + 5, 6) phase_topk(WID, a); PHASE_END
            PHASE_BEGIN(pb + 6, 7) phase_attn<1>(WID, a, lds); PHASE_END
            PHASE_BEGIN(pb + 7, 8) phase_mixprep(WID, a, layer); PHASE_END
            PHASE_BEGIN(pb + 8, 9) {
                ProbPlain P{(const bf16_t*)(ws + WS_AMIX), (const bf16_t*)(ws + WS_EVOUT) + (size_t)ev * 1024 * 1024, 1024, 1024, 1024}; pg8::Sched S; S.init(T / 256, 4, G, c);
                EpiResid E{Hin, H}; pg8::gemm_phase(WID, lds, P, S, E);
            } PHASE_END
        } else {
            PHASE_BEGIN(pb + 0, 11) phase_norm<1>(WID, a, lds, layer, Hin); PHASE_END
            PHASE_BEGIN(pb + 1, 12) {
                { ProbPlain P{XN, (const bf16_t*)(ws + WS_ODNAT) + (size_t)od * 4096 * 1024, 1024, 1024, 1024}; pg8::Sched S; S.init(T / 256, 16, G, c);
                  EpiOdNat E{ws}; pg8::gemm_phase(WID, lds, P, S, E); }
                { ProbPlain P{(const bf16_t*)(ws + WS_ODSW) + (size_t)od * 3072 * 1024, XN, 1024, 1024, 1024}; pg8::Sched S; S.init(12, T / 256, G, c);
                  EpiOdSw E{ws}; pg8::gemm_phase(WID, lds, P, S, E); }
            } PHASE_END
            PHASE_BEGIN(pb + 2, 13) {
                { ProbAtt P{(const bf16_t*)(ws + WS_AQ), (const bf16_t*)(ws + WS_KP), 2048, 1024, 256}; pg8::Sched S; S.init(512, 1, G, c);
                  EpiAtt E{(bf16_t*)(ws + WS_AQ)}; pg8::gemm_phase(WID, lds, P, S, E); }
                { ProbUT P{(const bf16_t*)(ws + WS_VS), (const bf16_t*)(ws + WS_KT), 512, 256, 256}; pg8::Sched S; S.init(1024, 1, G, c);
                  EpiUT E{(float*)(ws + WS_UT)}; pg8::gemm_phase(WID, lds, P, S, E); }
            } PHASE_END
            PHASE_BEGIN(pb + 3, 14) phase_scan(WID, a); PHASE_END
            PHASE_BEGIN(pb + 4, 15) {
                ProbY P{(const bf16_t*)(ws + WS_AQ), (const bf16_t*)(ws + WS_VS), 2048, 512, 512}; pg8::Sched S; S.init(512, 2, G, c);
                EpiY E{(bf16_t*)(ws + WS_Y)}; pg8::gemm_phase(WID, lds, P, S, E);
            } PHASE_END
            PHASE_BEGIN(pb + 5, 16) phase_normgate(WID, a, od); PHASE_END
            PHASE_BEGIN(pb + 8, 19) {
                ProbPlain P{(const bf16_t*)(ws + WS_YG), (const bf16_t*)(ws + WS_ODOUT) + (size_t)od * 1024 * 2048, 2048, 2048, 2048}; pg8::Sched S; S.init(T / 256, 4, G, c);
                EpiResid E{Hin, H}; pg8::gemm_phase(WID, lds, P, S, E);
            } PHASE_END
        }
        PHASE_BEGIN(pb + 9, 20) phase_norm<2>(WID, a, lds, layer, H); PHASE_END
        PHASE_BEGIN(pb + 10, 21) phase_moe_slots(WID, a, lds, layer); PHASE_END
        PHASE_BEGIN(pb + 11, 22) {
            moe_tables(WID, a, lds, layer, -1);
            { ProbMoe P{(const bf16_t*)(ws + WS_XB), (const bf16_t*)(ws + WS_WGU) + (size_t)layer * 32 * 2048 * 1024, ts, 2048, 1024, 1024, 1024}; pg8::Sched S; S.init(ts[32], 8, G, c);
              EpiGU E{(bf16_t*)(ws + WS_ACT), a->in[I_BGU] + (size_t)layer * 32 * 2048, ts}; pg8::gemm_phase(WID, lds, P, S, E); }
            { ProbPlain P{(const bf16_t*)(ws + WS_PBF) + (size_t)layer * T * 256, (const bf16_t*)(ws + WS_WPP) + (size_t)layer * 1024 * 256, 256, 256, 256}; pg8::Sched S; S.init(T / 256, 4, G, c);
              EpiPP E{(bf16_t*)(ws + WS_PP)}; pg8::gemm_phase(WID, lds, P, S, E); }
        } PHASE_END
        PHASE_BEGIN(pb + 12, 23) {
            moe_tables(WID, a, lds, layer, -1);
            ProbMoe P{(const bf16_t*)(ws + WS_ACT), (const bf16_t*)(ws + WS_WDN) + (size_t)layer * 32 * 1024 * 1024, ts, 1024, 1024, 1024, 1024}; pg8::Sched S; S.init(ts[32], 4, G, c);
            EpiDN E{(bf16_t*)(ws + WS_YB), a->in[I_BDN] + (size_t)layer * 32 * 1024, ts}; pg8::gemm_phase(WID, lds, P, S, E);
        } PHASE_END
        PHASE_BEGIN(pb + 13, 24) phase_combine(WID, a, H); PHASE_END
        PHASE_BEGIN(pb + 14, 25) {
            ProbPlain P{XN, (const bf16_t*)(ws + WS_WPG) + (size_t)layer * 1024 * 1024, 1024, 1024, 1024}; pg8::Sched S; S.init(T / 256, 4, G, c);
            EpiPLE E{H, (const bf16_t*)(ws + WS_PP)}; pg8::gemm_phase(WID, lds, P, S, E);
        } PHASE_END
    }
#undef PHASE_BEGIN
#undef PHASE_END
}

extern "C" void kernel_launch(void* const* d_in, const int* in_sizes, int n_in, void* d_out, int out_size, void* d_ws, size_t ws_size, hipStream_t stream) {
    static int grid = 0;
    if (grid == 0) {
        if (n_in != 26 || out_size != T * D || ws_size < WS_END) { fprintf(stderr, "kernel_launch: unexpected problem (n_in %d, out %d, ws %zu < %zu); nothing launched\n", n_in, out_size, ws_size, (size_t)WS_END); grid = -1; return; }
        int dev = 0, cus = 0, per_cu = 0;
        if (hipGetDevice(&dev) != hipSuccess || hipDeviceGetAttribute(&cus, hipDeviceAttributeMultiprocessorCount, dev) != hipSuccess) { grid = -1; return; }
        if (hipFuncSetAttribute((const void*)mk_fwd, hipFuncAttributeMaxDynamicSharedMemorySize, LDS_BYTES) != hipSuccess) { fprintf(stderr, "kernel_launch: hipFuncSetAttribute failed\n"); grid = -1; return; }
        if (hipOccupancyMaxActiveBlocksPerMultiprocessor(&per_cu, (const void*)mk_fwd, 512, LDS_BYTES) != hipSuccess || per_cu < 1) fprintf(stderr, "kernel_launch: occupancy query reports %d\n", per_cu);
        (void)hipGetLastError();
        grid = cus > 256 ? 256 : cus;
    }
    if (grid < 0) return;
    (void)hipMemsetAsync((char*)d_ws + WS_CTL, 0, CTL_BYTES, stream);
    Args a; memset(&a, 0, sizeof(a));
    for (int i = 0; i < 26; ++i) a.in[i] = (const float*)d_in[i];
    a.out = (float*)d_out; a.ws = (unsigned char*)d_ws;
#if MK_SINGLE
    a.ph_lo = 0; a.ph_hi = NPHASE;
    hipLaunchKernelGGL(mk_fwd, dim3(grid), dim3(512), LDS_BYTES, stream, a);
#else
    for (int ph = 0; ph < NPHASE && ph <= DBG_LAST_PHASE; ++ph) {
        const int l = (ph - 1) / PPL, k = (ph - 1) % PPL;
        if (ph > 0 && (l & 1) && (k == 6 || k == 7)) continue;
        a.ph_lo = ph; a.ph_hi = ph + 1;
        hipLaunchKernelGGL(mk_fwd, dim3(grid), dim3(512), LDS_BYTES, stream, a);
    }
#endif
}
```

```cpp
#include <hip/hip_runtime.h>
#include <cstdio>
#include <cstdint>
#include <cstring>

#define LAS __attribute__((address_space(3)))
#define DI __device__ __forceinline__
typedef unsigned short bf16_t;
typedef short bf16x8 __attribute__((ext_vector_type(8)));
typedef short s16x4 __attribute__((ext_vector_type(4)));
typedef float f32x2 __attribute__((ext_vector_type(2)));
typedef float f32x4 __attribute__((ext_vector_type(4)));
typedef float f32x16 __attribute__((ext_vector_type(16)));
typedef unsigned u32x2 __attribute__((ext_vector_type(2)));
typedef unsigned u32x4 __attribute__((ext_vector_type(4)));
typedef __bf16 bfv2 __attribute__((ext_vector_type(2)));

#ifndef MK_SINGLE
#define MK_SINGLE 1
#endif
#ifndef DBG_ONLY
#define DBG_ONLY -1
#endif
#ifndef DBG_LAST_PHASE
#define DBG_LAST_PHASE 100000
#endif

constexpr int T = 32768, D = 1024, SEQ = 2048, NBATCH = 16, DEPTH = 4;
constexpr int EVIN = 2840, ODIN = 6144;
constexpr float EPS = 1e-6f, NEGF = -1e30f;
constexpr int NTB = 256;
constexpr int MOE_ROWS = (512 + 32) * 256;

constexpr size_t MiB = 1u << 20;
constexpr size_t WS_CTL = 0, CTL_BYTES = 1 * MiB;
constexpr int CW_BAR = 4096;
constexpr size_t WS_EVNAT = 2 * MiB, WS_EVSW = 10 * MiB, WS_EVOUT = 13 * MiB, WS_CMP1 = 17 * MiB, WS_ODNAT = 21 * MiB, WS_ODSW = 37 * MiB,
                 WS_ODOUT = 49 * MiB, WS_WPP = 57 * MiB, WS_WPG = 59 * MiB, WS_BIAS1 = 67 * MiB, WS_GAINS = 67 * MiB + 16384, WS_BCNT = 67 * MiB + 65536,
                 WS_WGU = 68 * MiB, WS_WDN = 580 * MiB;
constexpr size_t WS_XN = 840 * MiB, WS_PBF = 904 * MiB, WS_PP = 968 * MiB, WS_GATES = 1032 * MiB, WS_TOPE = 1035 * MiB, WS_POSB = 1036 * MiB,
                 WS_DEST = 1037 * MiB, WS_GATEW = 1038 * MiB, WS_SELM = 1039 * MiB;
constexpr size_t RA = 1040 * MiB;
constexpr size_t WS_QD = RA, WS_KD = RA + 32 * MiB, WS_QN = RA + 64 * MiB, WS_KCB = RA + 96 * MiB, WS_VCB = RA + 105 * MiB, WS_KSB = RA + 114 * MiB,
                 WS_KWB = RA + 122 * MiB, WS_VAT = RA + 130 * MiB, WS_VST = RA + 162 * MiB, WS_VWT = RA + 170 * MiB, WS_HID = RA + 178 * MiB,
                 WS_KCMP = RA + 182 * MiB, WS_VCMPT = RA + 183 * MiB, WS_OC = RA + 184 * MiB, WS_IMPH = RA + 216 * MiB, WS_OD = RA + 248 * MiB,
                 WS_OS = RA + 312 * MiB, WS_OW = RA + 344 * MiB, WS_AMIX = RA + 376 * MiB;
constexpr size_t WS_AQ = RA, WS_KP = RA + 128 * MiB, WS_KT = RA + 192 * MiB, WS_VS = RA + 256 * MiB, WS_GG = RA + 512 * MiB, WS_UT = RA + 640 * MiB,
                 WS_Y = RA + 896 * MiB, WS_YG = RA + 1024 * MiB;
constexpr size_t WS_XB = 2192 * MiB, WS_ACT = 2464 * MiB, WS_YB = 2736 * MiB, WS_END = 3008 * MiB;

constexpr int MISC_OFF = 139264, LDS_BYTES = 155648;
static_assert(MISC_OFF + 5888 + 4096 <= LDS_BYTES, "misc LDS words");
constexpr int MO_WCNT = 256, MO_ENT = 1280, MO_GAT = 3328, MO_TOT = 5376, MO_BASE = 5504, MO_TS = 5632, MO_RED = 5888;

DI int opaque_tid(int wid0) { int t = (wid0 << 6) | (int)__builtin_amdgcn_mbcnt_hi(~0u, __builtin_amdgcn_mbcnt_lo(~0u, 0u)); asm volatile("" : "+v"(t) :: "memory"); return t; }
DI unsigned pk2(float lo, float hi) { f32x2 v = {lo, hi}; return __builtin_bit_cast(unsigned, __builtin_convertvector(v, bfv2)); }
DI float bf2f(unsigned short b) { return __uint_as_float(((unsigned)b) << 16); }
DI float bflo(unsigned w) { return __uint_as_float(w << 16); }
DI float bfhi(unsigned w) { return __uint_as_float(w & 0xffff0000u); }
DI float wave_sum(float v) {
#pragma unroll
    for (int o = 1; o < 64; o <<= 1) v += __shfl_xor(v, o);
    return v;
}
DI float sigm(float x) { return 1.0f / (1.0f + __expf(-x)); }
DI u32x4 pack8(const f32x4& a, const f32x4& b) { u32x4 w; w.x = pk2(a[0], a[1]); w.y = pk2(a[2], a[3]); w.z = pk2(b[0], b[1]); w.w = pk2(b[2], b[3]); return w; }

#define XB_TMO      128
#define XB_XCNT(j)  (256  + 64 * (j))
#define XB_XSUB(j)  (1280 + 64 * (j))
#define XB_XGEN(j)  (2304 + 64 * (j))
#define XB_TOP      3328
#define XB_TOPGEN   3392
#define XCD_BAR_WORDS 3456
#define XB_SPIN_CAP (1u << 22)
DI unsigned xb_ld(unsigned* p)              { return __hip_atomic_load(p, __ATOMIC_RELAXED, __HIP_MEMORY_SCOPE_AGENT); }
DI unsigned xb_add(unsigned* p, unsigned v) { return __hip_atomic_fetch_add(p, v, __ATOMIC_RELAXED, __HIP_MEMORY_SCOPE_AGENT); }
DI unsigned xb_xcc_id() { return (unsigned)__builtin_amdgcn_s_getreg((3 << 11) | 20) & 0xFu; }
#define XB_SPIN(cond, bar) do { unsigned _sp = 0; while (cond) { __builtin_amdgcn_s_sleep(1); \
    if ((++_sp & 255u) == 0u) { if (xb_ld(&(bar)[XB_TMO])) break; if (_sp > XB_SPIN_CAP) { atomicAdd(&(bar)[XB_TMO], 1u); break; } } } } while (0)
struct XcdBarrier { unsigned* bar; unsigned x; volatile LAS unsigned* st; };
DI XcdBarrier xcd_barrier_post(const int WID, unsigned* bar, volatile LAS unsigned* st) {
    XcdBarrier b; b.bar = bar; b.x = xb_xcc_id(); b.st = st;
    if (opaque_tid(WID) == 0) (void)xb_add(&bar[XB_XCNT(b.x)], 1u);
    return b;
}
DI void xcd_barrier_complete(unsigned* bar, unsigned x, unsigned& nloc, unsigned& nx) {
    const unsigned G = gridDim.x * gridDim.y * gridDim.z;
    unsigned sum, cnt, mine, sp = 0u;
    for (;;) {
        sum = 0u; cnt = 0u; mine = 0u;
#pragma unroll
        for (unsigned j = 0; j < 16; ++j) { const unsigned c = xb_ld(&bar[XB_XCNT(j)]); sum += c; cnt += (c > 0u) ? 1u : 0u; mine = (j == x) ? c : mine; }
        if (sum == G) break;
        __builtin_amdgcn_s_sleep(1);
        if ((++sp & 255u) == 0u) { if (xb_ld(&bar[XB_TMO])) break; if (sp > XB_SPIN_CAP) { atomicAdd(&bar[XB_TMO], 1u); break; } }
    }
    nloc = mine > 0u ? mine : 1u; nx = cnt > 0u ? cnt : 1u;
}
DI void xcd_barrier(const int WID, const XcdBarrier& b) {
    asm volatile("s_waitcnt vmcnt(0)" ::: "memory");
    __syncthreads();
    if (opaque_tid(WID) == 0) {
        unsigned* bar = b.bar; asm volatile("" : "+s"(bar));
        __builtin_amdgcn_s_waitcnt(0);
        unsigned nloc = b.st[0], nx = b.st[1];
        if (nloc == 0u) { xcd_barrier_complete(bar, b.x, nloc, nx); b.st[0] = nloc; b.st[1] = nx; }
        const unsigned old = xb_add(&bar[XB_XSUB(b.x)], 1u);
        const unsigned gen = old / nloc;
        if (old + 1u == (gen + 1u) * nloc) {
            __builtin_amdgcn_fence(__ATOMIC_RELEASE, "agent");
            asm volatile("s_waitcnt vmcnt(0)" ::: "memory");
            const unsigned og = xb_add(&bar[XB_TOP], 1u);
            const unsigned tg = og / nx;
            if (og + 1u == (tg + 1u) * nx) xb_add(&bar[XB_TOPGEN], 1u);
            else XB_SPIN(xb_ld(&bar[XB_TOPGEN]) == tg, bar);
            __builtin_amdgcn_fence(__ATOMIC_ACQUIRE, "agent");
            xb_add(&bar[XB_XGEN(b.x)], 1u);
            asm volatile("s_waitcnt vmcnt(0)" ::: "memory");
        } else {
            XB_SPIN(xb_ld(&bar[XB_XGEN(b.x)]) == gen, bar);
            __builtin_amdgcn_fence(__ATOMIC_ACQUIRE, "agent");
            asm volatile("s_waitcnt vmcnt(0)" ::: "memory");
        }
    }
    __syncthreads();
}

namespace pg8 {
constexpr int BM = 256, BK = 64, HALF = 128, HTB = HALF * BK * 2, STAGE_BYTES = 8 * HTB, NXCD = 8, WGM = 8;
DI int lds_byte(int r, int c) { const int st = (r >> 4) * 2 + (c >> 5), rr = r & 15, cc = c & 31, ob = rr * 64 + cc * 2; return st * 1024 + (ob ^ (((ob >> 9) & 1) << 5)); }
DI void stage_rc(int b, int& R, int& C) { const int st = b / 1024, sb = b % 1024, swz = sb ^ (((sb >> 9) & 1) << 5); R = (st >> 1) * 16 + swz / 64; C = (st & 1) * 32 + (swz % 64) / 2; }
DI int perm32(int rho) { const int n = rho >> 4, i = rho & 15; return 8 * (i >> 2) + 4 * n + (i & 3); }
struct Unit { int pm, pn; };
struct Sched {
    int nM, nN, nwg, G, c;
    DI void init(int nM_, int nN_, int G_, int c_) { nM = nM_; nN = nN_; nwg = nM * nN; G = G_; c = c_; }
    DI bool next(int i, Unit& u) const {
        const long L = (long)i * G + c; if (L >= nwg) return false;
        int wgid = (int)L; { const int q = nwg / NXCD, r = nwg % NXCD, xcd = wgid % NXCD, off = wgid / NXCD; wgid = (xcd < r ? xcd * (q + 1) : r * (q + 1) + (xcd - r) * q) + off; }
        const int nig = WGM * nN, gid = wgid / nig, fm = gid * WGM, gsz = (nM - fm) < WGM ? (nM - fm) : WGM;
        u.pm = fm + ((wgid % nig) % gsz); u.pn = (wgid % nig) / gsz; return true;
    }
};
template <class Epi, class Prob>
DI void gemm_phase(const int WID, LAS unsigned char* lds, const Prob& P, const Sched& S, const Epi& E) {
    const int tid = opaque_tid(WID), wid = __builtin_amdgcn_readfirstlane(tid >> 6), lane = tid & 63, wr = wid >> 2, wc = wid & 3, fr = lane & 15, fq = lane >> 4;
    const int K = P.K, nt = K / BK;
    unsigned voffA[2], voffB[2];
#pragma unroll
    for (int i = 0; i < 2; ++i) { int R, C; stage_rc(tid * 16 + i * 8192, R, C); const int Rb = Epi::PERM ? ((R & ~31) + perm32(R & 31)) : R;
        voffA[i] = (unsigned)(R * P.lda + C) * 2u; voffB[i] = (unsigned)(Rb * P.ldb + C) * 2u; }
    const size_t kstep = (size_t)(BK * 2);
    const size_t hstepA = (size_t)HALF * P.lda * 2, hstepB = (size_t)HALF * P.ldb * 2;
    const unsigned ldsw = (unsigned)wid * 1024u;
    const int aoff = lds_byte(wr * 64 + fr, fq * 8), boff = lds_byte(wc * 32 + fr, fq * 8);
#define PG8_SA(b, h) (((b) * 2 + (h)) * HTB)
#define PG8_SB(b, h) ((4 + (b) * 2 + (h)) * HTB)
#define PG8_STAGE(bufoff, gbase, voff) do { _Pragma("unroll") for (int _i = 0; _i < 2; ++_i) \
        __builtin_amdgcn_global_load_lds((const unsigned*)((const char*)(gbase) + (voff)[_i]), (LAS unsigned*)(lds + (bufoff) + ldsw + _i * 8192), 16, 0, 0); } while (0)
#define PG8_LDA(dst, b, h) do { _Pragma("unroll") for (int m = 0; m < 4; ++m) _Pragma("unroll") for (int k = 0; k < 2; ++k) dst[m][k] = *(const LAS bf16x8*)(lds + PG8_SA(b, h) + aoff + m * 2048 + k * 1024); } while (0)
#define PG8_LDB(dst, b, h) do { _Pragma("unroll") for (int n = 0; n < 2; ++n) _Pragma("unroll") for (int k = 0; k < 2; ++k) dst[n][k] = *(const LAS bf16x8*)(lds + PG8_SB(b, h) + boff + n * 2048 + k * 1024); } while (0)
#define PG8_MMA(ai, bj, At, Bt) do { __builtin_amdgcn_s_setprio(1); _Pragma("unroll") for (int m = 0; m < 4; ++m) _Pragma("unroll") for (int n = 0; n < 2; ++n) _Pragma("unroll") for (int k = 0; k < 2; ++k) \
        acc[ai][bj][m][n] = __builtin_amdgcn_mfma_f32_16x16x32_bf16(Bt[n][k], At[m][k], acc[ai][bj][m][n], 0, 0, 0); __builtin_amdgcn_s_setprio(0); } while (0)
#define PG8_WAIT_V(n) asm volatile("s_waitcnt vmcnt(" #n ")" ::: "memory")
#define PG8_WAIT_L(n) asm volatile("s_waitcnt lgkmcnt(" #n ")" ::: "memory")
#define PG8_BAR __builtin_amdgcn_s_barrier()
#define PG8_SCHED __builtin_amdgcn_sched_barrier(0)
    Unit cur, nxt; int ui = 0;
    if (!S.next(0, cur)) return;
    f32x4 acc[2][2][4][2];
#pragma unroll
    for (int a = 0; a < 2; ++a)
#pragma unroll
        for (int b = 0; b < 2; ++b)
#pragma unroll
            for (int m = 0; m < 4; ++m)
#pragma unroll
                for (int n = 0; n < 2; ++n) acc[a][b][m][n] = (f32x4){0.f, 0.f, 0.f, 0.f};
    bf16x8 At[4][2], B0[2][2], B1[2][2];
    const char* cA = P.a_base(cur); const char* cB = P.b_base(cur);
    PG8_STAGE(PG8_SB(0, 0), cB, voffB); PG8_STAGE(PG8_SA(0, 0), cA, voffA); PG8_STAGE(PG8_SB(0, 1), cB + hstepB, voffB); PG8_STAGE(PG8_SA(0, 1), cA + hstepA, voffA);
    if (wr == 1) PG8_BAR;
    PG8_WAIT_V(4); PG8_BAR;
    PG8_STAGE(PG8_SB(1, 0), cB + kstep, voffB); PG8_STAGE(PG8_SA(1, 0), cA + kstep, voffA); PG8_STAGE(PG8_SB(1, 1), cB + hstepB + kstep, voffB);
    PG8_WAIT_V(6); PG8_BAR;
    for (;;) {
        const bool has_next = S.next(ui + 1, nxt);
        const char* nA = has_next ? P.a_base(nxt) : cA; const char* nB = has_next ? P.b_base(nxt) : cB;
        for (int t = 0; t < nt; t += 2) {
            const bool last = (t == nt - 2);
            const char* a1 = cA + (size_t)(t + 1) * kstep;
            const char* a2 = last ? nA : cA + (size_t)(t + 2) * kstep; const char* b2 = last ? nB : cB + (size_t)(t + 2) * kstep;
            const char* a3 = a2 + kstep; const char* b3 = b2 + kstep;
            PG8_LDB(B0, 0, 0); PG8_SCHED; PG8_LDA(At, 0, 0); PG8_STAGE(PG8_SA(1, 1), a1 + hstepA, voffA);
            PG8_WAIT_L(8); PG8_BAR; PG8_WAIT_L(0); PG8_MMA(0, 0, At, B0); PG8_BAR; PG8_SCHED;
            PG8_LDB(B1, 0, 1); PG8_STAGE(PG8_SB(0, 0), b2, voffB);
            PG8_BAR; PG8_WAIT_L(0); PG8_MMA(0, 1, At, B1); PG8_BAR;
            PG8_LDA(At, 0, 1); PG8_STAGE(PG8_SA(0, 0), a2, voffA);
            PG8_BAR; PG8_WAIT_L(0); PG8_MMA(1, 0, At, B0); PG8_BAR; PG8_SCHED;
            PG8_STAGE(PG8_SB(0, 1), b2 + hstepB, voffB);
            PG8_WAIT_V(6); PG8_BAR; PG8_MMA(1, 1, At, B1); PG8_BAR;
            PG8_LDB(B0, 1, 0); PG8_SCHED; PG8_LDA(At, 1, 0); PG8_STAGE(PG8_SA(0, 1), a2 + hstepA, voffA);
            PG8_WAIT_L(8); PG8_BAR; PG8_WAIT_L(0); PG8_MMA(0, 0, At, B0); PG8_BAR; PG8_SCHED;
            PG8_LDB(B1, 1, 1); PG8_STAGE(PG8_SB(1, 0), b3, voffB);
            PG8_BAR; PG8_WAIT_L(0); PG8_MMA(0, 1, At, B1); PG8_BAR;
            PG8_LDA(At, 1, 1); PG8_STAGE(PG8_SA(1, 0), a3, voffA);
            PG8_BAR; PG8_WAIT_L(0); PG8_MMA(1, 0, At, B0); PG8_BAR; PG8_SCHED;
            PG8_STAGE(PG8_SB(1, 1), b3 + hstepB, voffB);
            PG8_WAIT_V(6); PG8_BAR; PG8_MMA(1, 1, At, B1); PG8_BAR;
        }
        { int fr_ = fr, fq_ = fq, wr_ = wr, wc_ = wc; asm volatile("" : "+v"(fr_), "+v"(fq_), "+s"(wr_), "+s"(wc_));
          E(acc, cur, wr_, wc_, fr_, fq_); }
        if (!has_next) break;
#pragma unroll
        for (int a = 0; a < 2; ++a)
#pragma unroll
            for (int b = 0; b < 2; ++b)
#pragma unroll
                for (int m = 0; m < 4; ++m)
#pragma unroll
                    for (int n = 0; n < 2; ++n) acc[a][b][m][n] = (f32x4){0.f, 0.f, 0.f, 0.f};
        cur = nxt; cA = nA; cB = nB; ++ui;
    }
    PG8_WAIT_V(0);
    if (wr == 0) PG8_BAR;
    PG8_BAR;
#undef PG8_SA
#undef PG8_SB
#undef PG8_STAGE
#undef PG8_LDA
#undef PG8_LDB
#undef PG8_MMA
#undef PG8_WAIT_V
#undef PG8_WAIT_L
#undef PG8_BAR
#undef PG8_SCHED
}
}
using pg8::Unit;
typedef f32x4 Acc[2][2][4][2];

struct ProbPlain { const bf16_t* A; const bf16_t* Bt; int lda, ldb, K;
    DI const char* a_base(const Unit& u) const { return (const char*)(A + (size_t)u.pm * 256 * lda); }
    DI const char* b_base(const Unit& u) const { return (const char*)(Bt + (size_t)u.pn * 256 * ldb); } };
struct ProbCmp1 { const bf16_t* KCB; const bf16_t* VCB; const bf16_t* W; int lda, ldb, K;
    DI const char* a_base(const Unit& u) const { const int kv = u.pm >> 4, rt = u.pm & 15; return (const char*)((kv ? VCB : KCB) + (size_t)rt * 256 * 1024); }
    DI const char* b_base(const Unit& u) const { const int kv = u.pm >> 4; return (const char*)(W + (size_t)kv * 256 * 2048); } };
struct ProbAtt { const bf16_t* AQ; const bf16_t* KP; int lda, ldb, K;
    DI const char* a_base(const Unit& u) const { const int z = u.pm, n = z & 7, h = (z >> 3) & 3, b = z >> 5; const size_t t0 = (size_t)b * 2048 + n * 256; return (const char*)(AQ + (t0 * 4 + h) * 512 + 256); }
    DI const char* b_base(const Unit& u) const { const int z = u.pm, n = z & 7, h = (z >> 3) & 3, b = z >> 5; const size_t t0 = (size_t)b * 2048 + n * 256; return (const char*)(KP + t0 * 1024 + h * 256); } };
struct ProbUT { const bf16_t* VS; const bf16_t* KT; int lda, ldb, K;
    DI const char* a_base(const Unit& u) const { const int z = u.pm >> 1, half = u.pm & 1; return (const char*)(VS + (size_t)z * 262144 + (size_t)half * 256 * 512); }
    DI const char* b_base(const Unit& u) const { const int z = u.pm >> 1; return (const char*)(KT + (size_t)z * 65536); } };
struct ProbY { const bf16_t* AQ; const bf16_t* VS; int lda, ldb, K;
    DI const char* a_base(const Unit& u) const { const int z = u.pm, n = z & 7, h = (z >> 3) & 3, b = z >> 5; const size_t t0 = (size_t)b * 2048 + n * 256; return (const char*)(AQ + (t0 * 4 + h) * 512); }
    DI const char* b_base(const Unit& u) const { return (const char*)(VS + (size_t)u.pm * 262144 + (size_t)u.pn * 256 * 512); } };
DI int moe_tile_expert(const LAS int* ts, int rt) { int e = 0;
#pragma unroll 8
    for (int i = 1; i < 32; ++i) e += (rt >= ts[i]) ? 1 : 0;
    return e; }
struct ProbMoe { const bf16_t* A; const bf16_t* W; const LAS int* ts; int nper; int lda, ldb, K;
    DI const char* a_base(const Unit& u) const { return (const char*)(A + (size_t)u.pm * 256 * 1024); }
    DI const char* b_base(const Unit& u) const { const int e = moe_tile_expert(ts, u.pm); return (const char*)(W + ((size_t)e * nper + (size_t)u.pn * 256) * 1024); } };

#define EPI_ROWS(ai, m) (128 * (ai) + 64 * wr + 16 * (m) + fr)
struct EpiEvNat { static constexpr bool PERM = true;
    unsigned char* ws; const float* gains;
    DI void operator()(const Acc& acc, const Unit& u, int wr, int wc, int fr, int fq) const {
        const int pn = u.pn; const bool norm = (pn != 6);
        const int gi = pn < 2 ? 0 : pn < 4 ? 1 : pn < 6 ? 2 : 3;
        const float* g = gains + gi * 64;
        f32x4 gv[2][2];
#pragma unroll
        for (int bj = 0; bj < 2; ++bj)
#pragma unroll
            for (int n = 0; n < 2; ++n) { const f32x4 t4 = *(const f32x4*)(g + 32 * bj + 8 * fq + 4 * n); gv[bj][n] = norm ? t4 : (f32x4){1.f, 1.f, 1.f, 1.f}; }
        size_t boff; int rowmul, hoff; bool panel = false;
        if (pn < 2) { boff = WS_QD; rowmul = 512; hoff = (pn * 4 + wc) * 64; }
        else if (pn < 4) { boff = WS_KD; rowmul = 512; hoff = ((pn - 2) * 4 + wc) * 64; }
        else if (pn < 6) { boff = WS_QN; rowmul = 512; hoff = ((pn - 4) * 4 + wc) * 64; }
        else { panel = true; rowmul = 64; hoff = 0; boff = (pn == 6) ? (wc < 2 ? WS_KCB : WS_VCB) : (wc < 2 ? WS_KSB : WS_KWB); }
        bf16_t* base = (bf16_t*)(ws + boff);
#pragma unroll
        for (int ai = 0; ai < 2; ++ai)
#pragma unroll
            for (int m = 0; m < 4; ++m) {
                const int t = u.pm * 256 + EPI_ROWS(ai, m), b = t >> 11, sq = t & 2047;
                float ss = 0.f;
#pragma unroll
                for (int bj = 0; bj < 2; ++bj)
#pragma unroll
                    for (int n = 0; n < 2; ++n) { const f32x4 x = acc[ai][bj][m][n]; ss += (x[0] * x[0] + x[1] * x[1]) + (x[2] * x[2] + x[3] * x[3]); }
                ss += __shfl_xor(ss, 16); ss += __shfl_xor(ss, 32);
                const float rstd = norm ? rsqrtf(ss * (1.0f / 64.0f) + EPS) : 1.0f;
                const size_t rowi = panel ? ((size_t)(b * 2 + (wc & 1)) * 2048 + sq) : (size_t)t;
#pragma unroll
                for (int bj = 0; bj < 2; ++bj) {
                    const f32x4 v0 = acc[ai][bj][m][0] * rstd * gv[bj][0], v1 = acc[ai][bj][m][1] * rstd * gv[bj][1];
                    *(u32x4*)(base + rowi * rowmul + hoff + 32 * bj + 8 * fq) = pack8(v0, v1);
                }
            }
    }
};
struct EpiEvSw { static constexpr bool PERM = true;
    unsigned char* ws;
    DI void operator()(const Acc& acc, const Unit& u, int wr, int wc, int fr, int fq) const {
        const int b = u.pn >> 3, sb = (u.pn & 7) * 256;
#pragma unroll
        for (int ai = 0; ai < 2; ++ai)
#pragma unroll
            for (int m = 0; m < 4; ++m) {
                const int rl = EPI_ROWS(ai, m);
                size_t boff, rowi;
                if (u.pm < 2) { const int fg = u.pm * 256 + rl; boff = WS_VAT; rowi = (size_t)(b * 4 + (fg >> 7)) * 128 + (fg & 127); }
                else { const int r2 = rl & 127; boff = (rl < 128) ? WS_VST : WS_VWT; rowi = (size_t)(b * 2 + (r2 >> 6)) * 64 + (r2 & 63); }
                bf16_t* rowp = (bf16_t*)(ws + boff) + rowi * 2048;
#pragma unroll
                for (int bj = 0; bj < 2; ++bj) *(u32x4*)(rowp + sb + 128 * bj + 32 * wc + 8 * fq) = pack8(acc[ai][bj][m][0], acc[ai][bj][m][1]);
            }
    }
};
struct EpiCmp1 { static constexpr bool PERM = true;
    bf16_t* HID; const float* bias1;
    DI void operator()(const Acc& acc, const Unit& u, int wr, int wc, int fr, int fq) const {
        const int kv = u.pm >> 4, rt = u.pm & 15;
#pragma unroll
        for (int bj = 0; bj < 2; ++bj) {
            const int col = 128 * bj + 32 * wc + 8 * fq;
            const f32x4 b0 = *(const f32x4*)(bias1 + kv * 256 + col), b1 = *(const f32x4*)(bias1 + kv * 256 + col + 4);
#pragma unroll
            for (int ai = 0; ai < 2; ++ai)
#pragma unroll
                for (int m = 0; m < 4; ++m) {
                    f32x4 v0 = acc[ai][bj][m][0] + b0, v1 = acc[ai][bj][m][1] + b1;
#pragma unroll
                    for (int j = 0; j < 4; ++j) { v0[j] = v0[j] * sigm(v0[j]); v1[j] = v1[j] * sigm(v1[j]); }
                    *(u32x4*)(HID + ((size_t)kv * 4096 + rt * 256 + EPI_ROWS(ai, m)) * 256 + col) = pack8(v0, v1);
                }
        }
    }
};
struct EpiResid { static constexpr bool PERM = false;
    const float* Hin; float* Hout;
    DI void operator()(const Acc& acc, const Unit& u, int wr, int wc, int fr, int fq) const {
#pragma unroll
        for (int ai = 0; ai < 2; ++ai)
#pragma unroll
            for (int m = 0; m < 4; ++m) {
                const size_t off = (size_t)(u.pm * 256 + EPI_ROWS(ai, m)) * 1024 + u.pn * 256 + 32 * wc + 4 * fq;
#pragma unroll
                for (int bj = 0; bj < 2; ++bj)
#pragma unroll
                    for (int n = 0; n < 2; ++n) { const size_t o = off + 128 * bj + 16 * n; *(f32x4*)(Hout + o) = *(const f32x4*)(Hin + o) + acc[ai][bj][m][n]; }
            }
    }
};
DI float ret_lg2(int h) { return __log2f(1.0f - exp2f(-5.0f - (float)h)); }
struct EpiOdNat { static constexpr bool PERM = true;
    unsigned char* ws;
    DI void operator()(const Acc& acc, const Unit& u, int wr, int wc, int fr, int fq) const {
        const int pn = u.pn; const int h = pn & 3; const float lg = ret_lg2(h);
        const size_t boff = pn < 4 ? WS_AQ : pn < 8 ? WS_KP : WS_GG;
        const int rowmul = pn < 4 ? 2048 : pn < 8 ? 1024 : 2048;
        const int coff = pn < 4 ? (h * 512 + 256) : pn < 8 ? (h * 256) : ((pn - 8) * 256);
        bf16_t* base = (bf16_t*)(ws + boff) + coff;
#pragma unroll
        for (int ai = 0; ai < 2; ++ai)
#pragma unroll
            for (int m = 0; m < 4; ++m) {
                const int cl = EPI_ROWS(ai, m); const size_t t = (size_t)u.pm * 256 + cl;
                float sc = 1.f;
                if (pn < 4) sc = exp2f(lg * (float)(cl + 1)); else if (pn < 8) sc = 0.0625f * exp2f(-lg * (float)(cl + 1));
#pragma unroll
                for (int bj = 0; bj < 2; ++bj) {
                    const int d = 128 * bj + 32 * wc + 8 * fq;
                    f32x4 v0 = acc[ai][bj][m][0] * sc, v1 = acc[ai][bj][m][1] * sc;
                    if (pn >= 8) {
#pragma unroll
                        for (int j = 0; j < 4; ++j) { v0[j] = v0[j] * sigm(v0[j]); v1[j] = v1[j] * sigm(v1[j]); } }
                    *(u32x4*)(base + t * rowmul + d) = pack8(v0, v1);
                }
            }
    }
};
struct EpiOdSw { static constexpr bool PERM = true;
    unsigned char* ws;
    DI void operator()(const Acc& acc, const Unit& u, int wr, int wc, int fr, int fq) const {
        const int b = u.pn >> 3, n = u.pn & 7;
        const bool isk = u.pm < 4; const int h = isk ? u.pm : ((u.pm - 4) >> 1);
        const size_t z = (size_t)(b * 4 + h) * 8 + n; const float lg = ret_lg2(h);
        bf16_t* base = (bf16_t*)(ws + (isk ? WS_KT : WS_VS)) + (isk ? z * 65536 : z * 262144 + (size_t)((u.pm - 4) & 1) * 256 * 512);
        const int rowmul = isk ? 256 : 512;
#pragma unroll
        for (int bj = 0; bj < 2; ++bj) {
            const int cl = 128 * bj + 32 * wc + 8 * fq;
            f32x4 s0 = {1.f, 1.f, 1.f, 1.f}, s1 = s0;
            if (isk) {
#pragma unroll
                for (int j = 0; j < 4; ++j) { s0[j] = 0.0625f * exp2f(-lg * (float)(cl + j + 1)); s1[j] = 0.0625f * exp2f(-lg * (float)(cl + 4 + j + 1)); } }
#pragma unroll
            for (int ai = 0; ai < 2; ++ai)
#pragma unroll
                for (int m = 0; m < 4; ++m)
                    *(u32x4*)(base + (size_t)EPI_ROWS(ai, m) * rowmul + cl) = pack8(acc[ai][bj][m][0] * s0, acc[ai][bj][m][1] * s1);
        }
    }
};
struct EpiAtt { static constexpr bool PERM = true;
    bf16_t* AQ;
    DI void operator()(const Acc& acc, const Unit& u, int wr, int wc, int fr, int fq) const {
        const int z = u.pm, n = z & 7, h = (z >> 3) & 3, b = z >> 5; const size_t t0 = (size_t)b * 2048 + n * 256;
#pragma unroll
        for (int ai = 0; ai < 2; ++ai)
#pragma unroll
            for (int m = 0; m < 4; ++m) {
                const int c = EPI_ROWS(ai, m);
#pragma unroll
                for (int bj = 0; bj < 2; ++bj) {
                    const int e0 = 128 * bj + 32 * wc + 8 * fq;
                    f32x4 v0 = acc[ai][bj][m][0], v1 = acc[ai][bj][m][1];
#pragma unroll
                    for (int j = 0; j < 4; ++j) { v0[j] = (c >= e0 + j) ? v0[j] : 0.f; v1[j] = (c >= e0 + 4 + j) ? v1[j] : 0.f; }
                    *(u32x4*)(AQ + ((t0 + c) * 4 + h) * 512 + e0) = pack8(v0, v1);
                }
            }
    }
};
struct EpiUT { static constexpr bool PERM = false;
    float* UT;
    DI void operator()(const Acc& acc, const Unit& u, int wr, int wc, int fr, int fq) const {
        const size_t z = (size_t)(u.pm >> 1); const int half = u.pm & 1;
#pragma unroll
        for (int ai = 0; ai < 2; ++ai)
#pragma unroll
            for (int m = 0; m < 4; ++m) {
                float* rowp = UT + z * 131072 + (size_t)(half * 256 + EPI_ROWS(ai, m)) * 256 + 32 * wc + 4 * fq;
#pragma unroll
                for (int bj = 0; bj < 2; ++bj)
#pragma unroll
                    for (int n = 0; n < 2; ++n) *(f32x4*)(rowp + 128 * bj + 16 * n) = acc[ai][bj][m][n];
            }
    }
};
struct EpiY { static constexpr bool PERM = true;
    bf16_t* Y;
    DI void operator()(const Acc& acc, const Unit& u, int wr, int wc, int fr, int fq) const {
        const int z = u.pm, n = z & 7, h = (z >> 3) & 3, b = z >> 5; const size_t t0 = (size_t)b * 2048 + n * 256;
#pragma unroll
        for (int ai = 0; ai < 2; ++ai)
#pragma unroll
            for (int m = 0; m < 4; ++m) {
                bf16_t* rowp = Y + (t0 + EPI_ROWS(ai, m)) * 2048 + h * 512 + u.pn * 256 + 32 * wc + 8 * fq;
#pragma unroll
                for (int bj = 0; bj < 2; ++bj) *(u32x4*)(rowp + 128 * bj) = pack8(acc[ai][bj][m][0], acc[ai][bj][m][1]);
            }
    }
};
struct EpiGU { static constexpr bool PERM = true;
    bf16_t* ACT; const float* bgu; const LAS int* ts;
    DI void operator()(const Acc& acc, const Unit& u, int wr, int wc, int fr, int fq) const {
        const int e = moe_tile_expert(ts, u.pm); const int w = 32 * wc + 8 * fq;
        const float* bp = bgu + (size_t)e * 2048 + 128 * u.pn + w;
        const f32x4 bg0 = *(const f32x4*)bp, bg1 = *(const f32x4*)(bp + 4), bl0 = *(const f32x4*)(bp + 1024), bl1 = *(const f32x4*)(bp + 1028);
#pragma unroll
        for (int ai = 0; ai < 2; ++ai)
#pragma unroll
            for (int m = 0; m < 4; ++m) {
                f32x4 g0 = acc[ai][0][m][0] + bg0, g1 = acc[ai][0][m][1] + bg1, l0 = acc[ai][1][m][0] + bl0, l1 = acc[ai][1][m][1] + bl1;
#pragma unroll
                for (int j = 0; j < 4; ++j) {
                    const float a = fminf(g0[j], 7.0f), c = fminf(g1[j], 7.0f);
                    const float la = fminf(fmaxf(l0[j], -7.0f), 7.0f), lc = fminf(fmaxf(l1[j], -7.0f), 7.0f);
                    g0[j] = a * sigm(1.702f * a) * (la + 1.0f); g1[j] = c * sigm(1.702f * c) * (lc + 1.0f); }
                *(u32x4*)(ACT + ((size_t)u.pm * 256 + EPI_ROWS(ai, m)) * 1024 + 128 * u.pn + w) = pack8(g0, g1);
            }
    }
};
struct EpiDN { static constexpr bool PERM = true;
    bf16_t* YB; const float* bdn; const LAS int* ts;
    DI void operator()(const Acc& acc, const Unit& u, int wr, int wc, int fr, int fq) const {
        const int e = moe_tile_expert(ts, u.pm);
#pragma unroll
        for (int bj = 0; bj < 2; ++bj) {
            const int col = 256 * u.pn + 128 * bj + 32 * wc + 8 * fq;
            const f32x4 b0 = *(const f32x4*)(bdn + (size_t)e * 1024 + col), b1 = *(const f32x4*)(bdn + (size_t)e * 1024 + col + 4);
#pragma unroll
            for (int ai = 0; ai < 2; ++ai)
#pragma unroll
                for (int m = 0; m < 4; ++m)
                    *(u32x4*)(YB + ((size_t)u.pm * 256 + EPI_ROWS(ai, m)) * 1024 + col) = pack8(acc[ai][bj][m][0] + b0, acc[ai][bj][m][1] + b1);
        }
    }
};
struct EpiPP { static constexpr bool PERM = true;
    bf16_t* PP;
    DI void operator()(const Acc& acc, const Unit& u, int wr, int wc, int fr, int fq) const {
#pragma unroll
        for (int ai = 0; ai < 2; ++ai)
#pragma unroll
            for (int m = 0; m < 4; ++m) {
                bf16_t* rowp = PP + ((size_t)u.pm * 256 + EPI_ROWS(ai, m)) * 1024 + u.pn * 256 + 32 * wc + 8 * fq;
#pragma unroll
                for (int bj = 0; bj < 2; ++bj) *(u32x4*)(rowp + 128 * bj) = pack8(acc[ai][bj][m][0], acc[ai][bj][m][1]);
            }
    }
};
struct EpiPLE { static constexpr bool PERM = false;
    float* H; const bf16_t* PP;
    DI void operator()(const Acc& acc, const Unit& u, int wr, int wc, int fr, int fq) const {
#pragma unroll
        for (int ai = 0; ai < 2; ++ai)
#pragma unroll
            for (int m = 0; m < 4; ++m) {
                const size_t off = (size_t)(u.pm * 256 + EPI_ROWS(ai, m)) * 1024 + u.pn * 256 + 32 * wc + 4 * fq;
#pragma unroll
                for (int bj = 0; bj < 2; ++bj)
#pragma unroll
                    for (int n = 0; n < 2; ++n) {
                        const size_t o = off + 128 * bj + 16 * n;
                        const u32x2 pw = *(const u32x2*)(PP + o); const f32x4 a = acc[ai][bj][m][n]; f32x4 hv = *(const f32x4*)(H + o);
                        hv[0] += sigm(a[0]) * bflo(pw.x); hv[1] += sigm(a[1]) * bfhi(pw.x); hv[2] += sigm(a[2]) * bflo(pw.y); hv[3] += sigm(a[3]) * bfhi(pw.y);
                        *(f32x4*)(H + o) = hv;
                    }
            }
    }
};

constexpr int AT_KSTR = 144;
template <int DV, int MODE>
DI void attn_unit(const int WID, LAS unsigned char* lds, const bf16_t* Qp, int ldq, const bf16_t* Kp, int ldk, const bf16_t* Vt, int ldvt, int q0, float slope,
                  const unsigned* selp, bf16_t* Op, int ldo, float* impp) {
    constexpr int NRB = DV / 32, VPIECES = DV * 8;
    constexpr int KB0 = 0, KB1 = 64 * AT_KSTR, VB0 = 2 * 64 * AT_KSTR, VB1 = VB0 + DV * AT_KSTR;
    const int tid = opaque_tid(WID), w = __builtin_amdgcn_readfirstlane(tid >> 6), lane = tid & 63, r = lane & 31, hh = lane >> 5;
    const int qrow = q0 + 32 * w + r, qw_first = q0 + 32 * w, qw_last = qw_first + 31;
    const float LOG2E = 1.44269504089f, sc = 0.125f * LOG2E, slope2 = slope * LOG2E;
    bf16x8 qf[4];
#pragma unroll
    for (int ks = 0; ks < 4; ++ks) qf[ks] = *(const bf16x8*)(Qp + (size_t)(32 * w + r) * ldq + 16 * ks + 8 * hh);
    unsigned selm = 0xffffffffu, orm = 0xffffffffu;
    if (MODE == 1) { selm = selp[32 * w + r]; orm = selm;
#pragma unroll
        for (int o = 1; o < 32; o <<= 1) orm |= __shfl_xor(orm, o); }
    const int nv = (MODE == 3) ? (qrow >= 31 ? ((qrow - 15) >> 4) : 0) : 0;
    const int nv_wmax = (MODE == 3) ? (qw_last >= 31 ? ((qw_last - 15) >> 4) : 0) : 0;
    int kt_lo = 0, kt_hi;
    if (MODE == 0 || MODE == 1) kt_hi = (q0 >> 6) + 4;
    else if (MODE == 2) { kt_hi = (q0 >> 6) + 4; const int lk = q0 - 511; kt_lo = lk > 0 ? (lk >> 6) : 0; }
    else kt_hi = 2;
    f32x16 O[NRB];
#pragma unroll
    for (int rb = 0; rb < NRB; ++rb)
#pragma unroll
        for (int i = 0; i < 16; ++i) O[rb][i] = 0.f;
    float mrun = NEGF, lrun = 0.f;
    u32x4 kreg, vreg[2];
    const int krow = tid >> 3, kpc = tid & 7;
#define AT_GLOAD(kt) do { kreg = *(const u32x4*)(Kp + (size_t)(64 * (kt) + krow) * ldk + 8 * kpc); \
        _Pragma("unroll") for (int i_ = 0; i_ < 2; ++i_) { const int idx = tid + 512 * i_; if (idx < VPIECES) vreg[i_] = *(const u32x4*)(Vt + (size_t)(idx >> 3) * ldvt + 64 * (kt) + 8 * (idx & 7)); } } while (0)
#define AT_LWRITE(buf) do { *(LAS u32x4*)(lds + ((buf) ? KB1 : KB0) + krow * AT_KSTR + kpc * 16) = kreg; \
        _Pragma("unroll") for (int i_ = 0; i_ < 2; ++i_) { const int idx = tid + 512 * i_; if (idx < VPIECES) *(LAS u32x4*)(lds + ((buf) ? VB1 : VB0) + (idx >> 3) * AT_KSTR + (idx & 7) * 16) = vreg[i_]; } } while (0)
    AT_GLOAD(kt_lo); AT_LWRITE(0);
    __syncthreads();
    const int ntile = kt_hi - kt_lo;
    for (int it = 0; it < ntile; ++it) {
        const int kt = kt_lo + it, buf = it & 1, key0 = 64 * kt;
        if (it + 1 < ntile) AT_GLOAD(kt + 1);
        bool skip;
        if (MODE == 0) skip = key0 > qw_last;
        else if (MODE == 1) skip = (key0 > qw_last) || !((orm >> kt) & 1u);
        else if (MODE == 2) skip = (key0 > qw_last) || (key0 + 63 < qw_first - 511);
        else skip = key0 >= nv_wmax;
        if (!skip) {
            const LAS unsigned char* kb = lds + (buf ? KB1 : KB0); const LAS unsigned char* vb = lds + (buf ? VB1 : VB0);
            f32x16 S[2];
#pragma unroll
            for (int kk = 0; kk < 2; ++kk) {
#pragma unroll
                for (int i = 0; i < 16; ++i) S[kk][i] = 0.f;
#pragma unroll
                for (int ks = 0; ks < 4; ++ks) { const bf16x8 a = *(const LAS bf16x8*)(kb + (32 * kk + r) * AT_KSTR + (16 * ks + 8 * hh) * 2);
                    S[kk] = __builtin_amdgcn_mfma_f32_32x32x16_bf16(a, qf[ks], S[kk], 0, 0, 0); }
            }
            float mx = NEGF;
#pragma unroll
            for (int kk = 0; kk < 2; ++kk)
#pragma unroll
                for (int i = 0; i < 16; ++i) {
                    const int key = key0 + 32 * kk + (i & 3) + 8 * (i >> 2) + 4 * hh;
                    const int dist = qrow - key; float v = S[kk][i] * sc; bool valid;
                    if (MODE == 0) { valid = dist >= 0; v -= slope2 * (float)dist; }
                    else if (MODE == 1) { valid = (dist >= 0) && ((selm >> kt) & 1u); v -= slope2 * (float)dist; }
                    else if (MODE == 2) { valid = (dist >= 0) && (dist < 512); v -= slope2 * (float)dist; }
                    else valid = key < nv;
                    v = valid ? v : NEGF; S[kk][i] = v; mx = fmaxf(mx, v);
                }
            mx = fmaxf(mx, __shfl_xor(mx, 32));
            const float mnew = fmaxf(mrun, mx), alpha = __builtin_amdgcn_exp2f(mrun - mnew); mrun = mnew;
            float ps = 0.f;
#pragma unroll
            for (int kk = 0; kk < 2; ++kk)
#pragma unroll
                for (int i = 0; i < 16; ++i) { const float p = __builtin_amdgcn_exp2f(S[kk][i] - mnew); S[kk][i] = p; ps += p; }
            lrun = lrun * alpha + ps;
#pragma unroll
            for (int rb = 0; rb < NRB; ++rb)
#pragma unroll
                for (int i = 0; i < 16; ++i) O[rb][i] *= alpha;
#pragma unroll
            for (int kk = 0; kk < 2; ++kk)
#pragma unroll
                for (int s = 0; s < 2; ++s) {
                    u32x4 pw; pw.x = pk2(S[kk][8 * s + 0], S[kk][8 * s + 1]); pw.y = pk2(S[kk][8 * s + 2], S[kk][8 * s + 3]);
                    pw.z = pk2(S[kk][8 * s + 4], S[kk][8 * s + 5]); pw.w = pk2(S[kk][8 * s + 6], S[kk][8 * s + 7]);
                    const bf16x8 pf = __builtin_bit_cast(bf16x8, pw);
                    const int k1 = 32 * kk + 16 * s + 4 * hh;
#pragma unroll
                    for (int rb = 0; rb < NRB; ++rb) {
                        const LAS unsigned char* vp = vb + (32 * rb + r) * AT_KSTR + k1 * 2;
                        const s16x4 lo = *(const LAS s16x4*)vp, hi = *(const LAS s16x4*)(vp + 16);
                        const bf16x8 a = __builtin_shufflevector(lo, hi, 0, 1, 2, 3, 4, 5, 6, 7);
                        O[rb] = __builtin_amdgcn_mfma_f32_32x32x16_bf16(a, pf, O[rb], 0, 0, 0);
                    }
                }
        }
        if (it + 1 < ntile) AT_LWRITE(buf ^ 1);
        __syncthreads();
    }
#undef AT_GLOAD
#undef AT_LWRITE
    const float ltot = lrun + __shfl_xor(lrun, 32);
    float inv = 1.0f / ltot;
    if (MODE == 3) inv = (nv > 0) ? inv : 0.f;
#pragma unroll
    for (int rb = 0; rb < NRB; ++rb)
#pragma unroll
        for (int g4 = 0; g4 < 4; ++g4) {
            const float a = O[rb][4 * g4] * inv, b = O[rb][4 * g4 + 1] * inv, c = O[rb][4 * g4 + 2] * inv, d = O[rb][4 * g4 + 3] * inv;
            const int dv = 32 * rb + 8 * g4 + 4 * hh;
            if (MODE == 3 && rb == 2) { *(f32x4*)(impp + (size_t)(32 * w + r) * 256 + (dv - 64)) = (f32x4){a, b, c, d}; }
            else { u32x2 o; o.x = pk2(a, b); o.y = pk2(c, d); *(u32x2*)(Op + (size_t)(32 * w + r) * ldo + dv) = o; }
        }
}

struct Args { const float* in[26]; float* out; unsigned char* ws; int ph_lo, ph_hi; };
typedef const __attribute__((address_space(4))) Args* ArgsP;
DI ArgsP opaque_args() { auto p = __builtin_amdgcn_kernarg_segment_ptr(); asm volatile("" : "+s"(p)); return (ArgsP)p; }
enum { I_X = 0, I_P, I_N1G, I_N2G, I_EVWIN, I_EVWOUT, I_DAQN, I_DAKN, I_DALAM, I_DAOUTG, I_NSQN, I_NSKN, I_CMPPE, I_CMPW1, I_CMPW2, I_ODWIN, I_ODWOUT,
       I_RETG, I_ROUTW, I_ROUTB, I_WGU, I_BGU, I_WDN, I_BDN, I_PLEP, I_PLEG };

struct CvtJob { int in_idx, ldsrc, K, col0, ncols, dstrow0, perm, nmat; size_t src_stride, dst_off, dst_stride; };
constexpr int NJOBS = 19;
__constant__ CvtJob c_jobs[NJOBS] = {
    {I_EVWIN, EVIN, 1024, 0,    1024, 0,    1, 2, (size_t)1024 * EVIN, WS_EVNAT, (size_t)2048 * 1024},
    {I_EVWIN, EVIN, 1024, 1536, 512,  1024, 1, 2, (size_t)1024 * EVIN, WS_EVNAT, (size_t)2048 * 1024},
    {I_EVWIN, EVIN, 1024, 2048, 128,  1536, 1, 2, (size_t)1024 * EVIN, WS_EVNAT, (size_t)2048 * 1024},
    {I_EVWIN, EVIN, 1024, 2176, 128,  1664, 1, 2, (size_t)1024 * EVIN, WS_EVNAT, (size_t)2048 * 1024},
    {I_EVWIN, EVIN, 1024, 2304, 128,  1792, 1, 2, (size_t)1024 * EVIN, WS_EVNAT, (size_t)2048 * 1024},
    {I_EVWIN, EVIN, 1024, 2560, 128,  1920, 1, 2, (size_t)1024 * EVIN, WS_EVNAT, (size_t)2048 * 1024},
    {I_EVWIN, EVIN, 1024, 1024, 512,  0,    0, 2, (size_t)1024 * EVIN, WS_EVSW,  (size_t)768 * 1024},
    {I_EVWIN, EVIN, 1024, 2432, 128,  512,  0, 2, (size_t)1024 * EVIN, WS_EVSW,  (size_t)768 * 1024},
    {I_EVWIN, EVIN, 1024, 2688, 128,  640,  0, 2, (size_t)1024 * EVIN, WS_EVSW,  (size_t)768 * 1024},
    {I_EVWOUT, 1024, 1024, 0, 1024, 0, 0, 2, (size_t)1024 * 1024, WS_EVOUT, (size_t)1024 * 1024},
    {I_CMPW1, 256, 2048, 0, 256, 0, 0, 4, (size_t)2048 * 256, WS_CMP1, (size_t)256 * 2048},
    {I_ODWIN, ODIN, 1024, 0,    2048, 0,    0, 2, (size_t)1024 * ODIN, WS_ODNAT, (size_t)4096 * 1024},
    {I_ODWIN, ODIN, 1024, 4096, 2048, 2048, 0, 2, (size_t)1024 * ODIN, WS_ODNAT, (size_t)4096 * 1024},
    {I_ODWIN, ODIN, 1024, 1024, 3072, 0,    0, 2, (size_t)1024 * ODIN, WS_ODSW,  (size_t)3072 * 1024},
    {I_ODWOUT, 1024, 2048, 0, 1024, 0, 0, 2, (size_t)2048 * 1024, WS_ODOUT, (size_t)1024 * 2048},
    {I_WGU, 2048, 1024, 0, 2048, 0, 2, 128, (size_t)1024 * 2048, WS_WGU, (size_t)2048 * 1024},
    {I_WDN, 1024, 1024, 0, 1024, 0, 0, 128, (size_t)1024 * 1024, WS_WDN, (size_t)1024 * 1024},
    {I_PLEP, 1024, 256, 0, 1024, 0, 0, 4, (size_t)256 * 1024, WS_WPP, (size_t)1024 * 256},
    {I_PLEG, 1024, 1024, 0, 1024, 0, 0, 4, (size_t)1024 * 1024, WS_WPG, (size_t)1024 * 1024},
};
DI int cvt_dstrow(int perm, int L) {
    if (perm == 1) { const int pn = L >> 8, lc = L & 255; return pn * 256 + 128 * ((lc & 63) >> 5) + 32 * (lc >> 6) + (lc & 31); }
    if (perm == 2) { const int bj = L >> 10, cc = L & 1023; return 256 * (cc >> 7) + 128 * bj + (cc & 127); }
    return L;
}
DI void phase_prologue(const int WID, ArgsP a, LAS unsigned char* lds) {
    const int tid = opaque_tid(WID), lane = tid & 63, wv = tid >> 6;
    const int gw = blockIdx.x * 8 + wv, NGW = gridDim.x * 8;
    LAS float* scr = (LAS float*)(lds + wv * 16640);
    int total = 0;
    for (int j = 0; j < NJOBS; ++j) total += c_jobs[j].nmat * (c_jobs[j].K >> 6) * (c_jobs[j].ncols >> 6);
    for (int it = gw; it < total; it += NGW) {
        int r = it, j = 0;
        for (; j < NJOBS; ++j) { const int n = c_jobs[j].nmat * (c_jobs[j].K >> 6) * (c_jobs[j].ncols >> 6); if (r < n) break; r -= n; }
        const CvtJob J = c_jobs[j];
        const int nkb = J.K >> 6, nnb = J.ncols >> 6, per = nkb * nnb;
        const int mat = r / per, rr = r % per, kb = rr / nnb, nb = rr % nnb, k0 = kb * 64, n0 = nb * 64;
        const float* src = a->in[J.in_idx] + (size_t)mat * J.src_stride + (size_t)k0 * J.ldsrc + J.col0 + n0 + lane;
#pragma unroll 8
        for (int i = 0; i < 64; ++i) scr[i * 65 + lane] = src[(size_t)i * J.ldsrc];
        asm volatile("s_waitcnt lgkmcnt(0)" ::: "memory");
        bf16_t* dst = (bf16_t*)(a->ws + J.dst_off) + (size_t)mat * J.dst_stride;
        const int c = lane & 7, nsub = lane >> 3;
#pragma unroll
        for (int jj = 0; jj < 8; ++jj) {
            const int n = nsub + 8 * jj; const LAS float* s = scr + (8 * c) * 65 + n;
            u32x4 o; o.x = pk2(s[0], s[65]); o.y = pk2(s[2 * 65], s[3 * 65]); o.z = pk2(s[4 * 65], s[5 * 65]); o.w = pk2(s[6 * 65], s[7 * 65]);
            const int drow = cvt_dstrow(J.perm, J.dstrow0 + n0 + n);
            *(u32x4*)(dst + (size_t)drow * J.K + k0 + 8 * c) = o;
        }
        asm volatile("s_waitcnt lgkmcnt(0)" ::: "memory");
    }
    {
        const float* p = a->in[I_P]; bf16_t* pb = (bf16_t*)(a->ws + WS_PBF);
        const size_t n8 = (size_t)DEPTH * T * 256 / 8;
        for (size_t i = (size_t)blockIdx.x * 512 + tid; i < n8; i += (size_t)gridDim.x * 512) {
            const f32x4 v0 = *(const f32x4*)(p + i * 8), v1 = *(const f32x4*)(p + i * 8 + 4);
            *(u32x4*)(pb + i * 8) = pack8(v0, v1);
        }
    }
    if (blockIdx.x == 4 && tid < 512) { const int ev = tid >> 8, gi = (tid >> 6) & 3, d = tid & 63;
        const float* src = a->in[gi == 0 ? I_DAQN : gi == 1 ? I_DAKN : gi == 2 ? I_NSQN : I_NSKN];
        ((float*)(a->ws + WS_GAINS))[tid] = src[ev * 64 + d]; }
    if (blockIdx.x < 4 && tid < 256) {
        const int m = blockIdx.x; const float* pe = a->in[I_CMPPE] + (size_t)m * 2048; const float* w1 = a->in[I_CMPW1] + (size_t)m * 2048 * 256;
        float s = 0.f;
        for (int k = 0; k < 2048; ++k) s += pe[k] * w1[(size_t)k * 256 + tid];
        ((float*)(a->ws + WS_BIAS1))[m * 256 + tid] = s;
    }
}

DI float row_load_ss(const float* row, int lane, f32x4 (&v)[4]) {
    float ss = 0.f;
#pragma unroll
    for (int j = 0; j < 4; ++j) { v[j] = *(const f32x4*)(row + 4 * lane + 256 * j); ss += (v[j][0] * v[j][0] + v[j][1] * v[j][1]) + (v[j][2] * v[j][2] + v[j][3] * v[j][3]); }
    return wave_sum(ss);
}
DI void row_store_bf16(bf16_t* row, int lane, const f32x4 (&v)[4]) {
#pragma unroll
    for (int j = 0; j < 4; ++j) { u32x2 o; o.x = pk2(v[j][0], v[j][1]); o.y = pk2(v[j][2], v[j][3]); *(u32x2*)(row + 4 * lane + 256 * j) = o; }
}
template <int MODE>
DI void phase_norm(const int WID, ArgsP a, LAS unsigned char* lds, int layer, const float* Hin) {
    const int tid = opaque_tid(WID), lane = tid & 63, wv = tid >> 6;
    LAS float* wt = (LAS float*)lds;
    LAS int* wcnt = (LAS int*)(lds + MISC_OFF + MO_WCNT); LAS int* ent = (LAS int*)(lds + MISC_OFF + MO_ENT); LAS float* gat = (LAS float*)(lds + MISC_OFF + MO_GAT);
    bf16_t* XN = (bf16_t*)(a->ws + WS_XN);
    const float* gain = a->in[MODE == 2 ? I_N2G : I_N1G] + layer * 1024;
    constexpr int NQ = MODE == 0 ? 24 : (MODE == 2 ? 32 : 0);
    if (MODE == 0) { const float* w = a->in[I_EVWIN] + (size_t)(layer >> 1) * 1024 * EVIN + 2816;
        for (int i = tid; i < 24 * 1024; i += 512) { const int k = i / 24, q = i % 24; wt[q * 1024 + k] = w[(size_t)k * EVIN + q]; } }
    if (MODE == 2) { const float* w = a->in[I_ROUTW] + (size_t)layer * 1024 * 32;
        for (int i = tid; i < 32 * 1024; i += 512) { const int k = i >> 5, q = i & 31; wt[q * 1024 + k] = w[i]; } }
    f32x4 gn[4];
#pragma unroll
    for (int j = 0; j < 4; ++j) gn[j] = *(const f32x4*)(gain + 4 * lane + 256 * j);
    __syncthreads();
    for (int vb = blockIdx.x; vb < NTB; vb += gridDim.x) {
        if (MODE == 2) { if (tid < 256) wcnt[tid] = 0; __syncthreads(); }
#pragma unroll 1
        for (int i = 0; i < 16; ++i) {
            const int t = vb * 128 + wv * 16 + i;
            f32x4 v[4];
            const float ss = row_load_ss(Hin + (size_t)t * 1024, lane, v);
            const float rstd = rsqrtf(ss * (1.0f / 1024.0f) + EPS);
#pragma unroll
            for (int j = 0; j < 4; ++j) v[j] = v[j] * rstd * gn[j];
            row_store_bf16(XN + (size_t)t * 1024, lane, v);
            if (NQ > 0) {
                float lg[NQ > 0 ? NQ : 1];
#pragma unroll
                for (int q = 0; q < NQ; ++q) { float s = 0.f;
#pragma unroll
                    for (int j = 0; j < 4; ++j) { const f32x4 ww = *(const LAS f32x4*)(wt + q * 1024 + 4 * lane + 256 * j); s += (v[j][0] * ww[0] + v[j][1] * ww[1]) + (v[j][2] * ww[2] + v[j][3] * ww[3]); }
                    lg[q] = wave_sum(s);
                    if ((q & 3) == 3) asm volatile("" ::: "memory"); }
                if (MODE == 0) {
                    float mine = 0.f;
#pragma unroll
                    for (int q = 0; q < NQ; ++q) mine = (lane == q) ? lg[q] : mine;
                    if (lane < 24) ((float*)(a->ws + WS_GATES))[(size_t)t * 24 + lane] = sigm(mine);
                }
                if (MODE == 2) {
                    const float* rb = a->in[I_ROUTB] + layer * 32;
#pragma unroll
                    for (int q = 0; q < NQ; ++q) lg[q] += rb[q];
                    unsigned used = 0u; int te[4]; float tv[4];
#pragma unroll
                    for (int k = 0; k < 4; ++k) { float best = -3.0e38f; int bi = 0;
#pragma unroll
                        for (int q = 0; q < NQ; ++q) { const bool ok = !((used >> q) & 1u) && (lg[q] > best); best = ok ? lg[q] : best; bi = ok ? q : bi; }
                        used |= 1u << bi; te[k] = bi; tv[k] = best; }
                    float ex[4], sum = 0.f;
#pragma unroll
                    for (int k = 0; k < 4; ++k) { ex[k] = __expf(tv[k] - tv[0]); sum += ex[k]; }
                    if (lane == 0) {
#pragma unroll
                        for (int k = 0; k < 4; ++k) { const int e = te[k]; const int lp = wcnt[wv * 32 + e]; wcnt[wv * 32 + e] = lp + 1; ent[wv * 64 + i * 4 + k] = e | (lp << 8); gat[wv * 64 + i * 4 + k] = ex[k] / sum; }
                    }
                }
            }
        }
        if (MODE == 2) {
            __syncthreads();
            { const int en = ent[wv * 64 + lane], e = en & 255; int pos = en >> 8;
              for (int w2 = 0; w2 < wv; ++w2) pos += wcnt[w2 * 32 + e];
              const size_t idx = (size_t)(vb * 128 + wv * 16) * 4 + lane;
              ((int*)(a->ws + WS_TOPE))[idx] = e; ((int*)(a->ws + WS_POSB))[idx] = pos; ((float*)(a->ws + WS_GATEW))[idx] = gat[wv * 64 + lane]; }
            if (tid < 32) { int s = 0;
#pragma unroll
                for (int w2 = 0; w2 < 8; ++w2) s += wcnt[w2 * 32 + tid];
                ((int*)(a->ws + WS_BCNT))[((size_t)layer * NTB + vb) * 32 + tid] = s; }
            __syncthreads();
        }
    }
}
DI void moe_tables(const int WID, ArgsP a, LAS unsigned char* lds, int layer, int vb) {
    const int tid = opaque_tid(WID);
    LAS int* tot = (LAS int*)(lds + MISC_OFF + MO_TOT); LAS int* base = (LAS int*)(lds + MISC_OFF + MO_BASE); LAS int* ts = (LAS int*)(lds + MISC_OFF + MO_TS);
    LAS int* red = (LAS int*)(lds + MISC_OFF + MO_RED);
    const int* bc = (const int*)(a->ws + WS_BCNT) + (size_t)layer * NTB * 32;
    { const int e = tid & 31, part = tid >> 5; int st = 0, sp = 0;
      for (int blk = part; blk < NTB; blk += 16) { const int v = bc[blk * 32 + e]; st += v; sp += (blk < vb) ? v : 0; }
      red[part * 32 + e] = st; red[512 + part * 32 + e] = sp; }
    __syncthreads();
    if (tid < 32) { int st = 0, sp = 0;
#pragma unroll
        for (int p = 0; p < 16; ++p) { st += red[p * 32 + tid]; sp += red[512 + p * 32 + tid]; }
        tot[tid] = st; base[tid] = sp; }
    __syncthreads();
    if (tid == 0) { int acc = 0; for (int e = 0; e < 32; ++e) { ts[e] = acc; acc += (tot[e] + 255) >> 8; } ts[32] = acc; }
    __syncthreads();
}
DI void phase_moe_slots(const int WID, ArgsP a, LAS unsigned char* lds, int layer) {
    const int tid = opaque_tid(WID), lane = tid & 63, wv = tid >> 6;
    LAS int* base = (LAS int*)(lds + MISC_OFF + MO_BASE); LAS int* ts = (LAS int*)(lds + MISC_OFF + MO_TS);
    const bf16_t* XN = (const bf16_t*)(a->ws + WS_XN); bf16_t* XB = (bf16_t*)(a->ws + WS_XB);
    for (int vb = blockIdx.x; vb < NTB; vb += gridDim.x) {
        moe_tables(WID, a, lds, layer, vb);
#pragma unroll 1
        for (int i = 0; i < 16; ++i) {
            const int t = vb * 128 + wv * 16 + i;
            int dest = 0;
            if (lane < 4) { const int e = ((const int*)(a->ws + WS_TOPE))[(size_t)t * 4 + lane], pos = ((const int*)(a->ws + WS_POSB))[(size_t)t * 4 + lane];
                dest = ts[e] * 256 + base[e] + pos; ((int*)(a->ws + WS_DEST))[(size_t)t * 4 + lane] = dest; }
            const u32x4 r0 = *(const u32x4*)(XN + (size_t)t * 1024 + 8 * lane), r1 = *(const u32x4*)(XN + (size_t)t * 1024 + 512 + 8 * lane);
#pragma unroll
            for (int k = 0; k < 4; ++k) { const int d = __shfl(dest, k); bf16_t* o = XB + (size_t)d * 1024; *(u32x4*)(o + 8 * lane) = r0; *(u32x4*)(o + 512 + 8 * lane) = r1; }
        }
        __syncthreads();
    }
}
DI void phase_combine(const int WID, ArgsP a, float* H) {
    const int tid = opaque_tid(WID), lane = tid & 63, wv = tid >> 6;
    const bf16_t* YB = (const bf16_t*)(a->ws + WS_YB); bf16_t* XN = (bf16_t*)(a->ws + WS_XN);
    for (int t = blockIdx.x * 8 + wv; t < T; t += gridDim.x * 8) {
        int dest = 0; float gw = 0.f;
        if (lane < 4) { dest = ((const int*)(a->ws + WS_DEST))[(size_t)t * 4 + lane]; gw = ((const float*)(a->ws + WS_GATEW))[(size_t)t * 4 + lane]; }
        f32x4 v[4];
#pragma unroll
        for (int j = 0; j < 4; ++j) v[j] = *(const f32x4*)(H + (size_t)t * 1024 + 4 * lane + 256 * j);
#pragma unroll
        for (int k = 0; k < 4; ++k) { const int d = __shfl(dest, k); const float g = __shfl(gw, k); const bf16_t* y = YB + (size_t)d * 1024;
#pragma unroll
            for (int j = 0; j < 4; ++j) { const u32x2 w = *(const u32x2*)(y + 4 * lane + 256 * j); v[j][0] += g * bflo(w.x); v[j][1] += g * bfhi(w.x); v[j][2] += g * bflo(w.y); v[j][3] += g * bfhi(w.y); } }
        float ss = 0.f;
#pragma unroll
        for (int j = 0; j < 4; ++j) { *(f32x4*)(H + (size_t)t * 1024 + 4 * lane + 256 * j) = v[j]; ss += (v[j][0] * v[j][0] + v[j][1] * v[j][1]) + (v[j][2] * v[j][2] + v[j][3] * v[j][3]); }
        ss = wave_sum(ss);
        const float rstd = rsqrtf(ss * (1.0f / 1024.0f) + EPS);
#pragma unroll
        for (int j = 0; j < 4; ++j) v[j] = v[j] * rstd;
        row_store_bf16(XN + (size_t)t * 1024, lane, v);
    }
}
DI void phase_cmp2(const int WID, ArgsP a, int ev) {
    const int tid = opaque_tid(WID), lane = tid & 63, wv = tid >> 6;
    const bf16_t* HID = (const bf16_t*)(a->ws + WS_HID); bf16_t* KCMP = (bf16_t*)(a->ws + WS_KCMP); bf16_t* VCMPT = (bf16_t*)(a->ws + WS_VCMPT);
    const float* kng = a->in[I_NSKN] + ev * 64;
    for (int it = blockIdx.x * 8 + wv; it < 8192; it += gridDim.x * 8) {
        const int kv = it >> 12, row = it & 4095, bg = row >> 7, n = row & 127;
        const float* w2 = a->in[I_CMPW2] + (size_t)(ev * 2 + kv) * 256 * 64;
        const bf16_t* hrow = HID + ((size_t)kv * 4096 + row) * 256;
        float s = 0.f;
        for (int k = 0; k < 256; k += 8) { const u32x4 hw = *(const u32x4*)(hrow + k);
            s += bflo(hw.x) * w2[(k + 0) * 64 + lane] + bfhi(hw.x) * w2[(k + 1) * 64 + lane] + bflo(hw.y) * w2[(k + 2) * 64 + lane] + bfhi(hw.y) * w2[(k + 3) * 64 + lane]
               + bflo(hw.z) * w2[(k + 4) * 64 + lane] + bfhi(hw.z) * w2[(k + 5) * 64 + lane] + bflo(hw.w) * w2[(k + 6) * 64 + lane] + bfhi(hw.w) * w2[(k + 7) * 64 + lane]; }
        if (n == 127) s = 0.f;
        if (kv == 0) { const float ss = wave_sum(s * s); const float o = s * rsqrtf(ss * (1.0f / 64.0f) + EPS) * kng[lane];
            KCMP[((size_t)bg * 128 + n) * 64 + lane] = (bf16_t)(pk2(o, 0.f) & 0xffffu); }
        else VCMPT[((size_t)bg * 96 + lane) * 128 + n] = (bf16_t)(pk2(s, 0.f) & 0xffffu);
    }
    for (int i = blockIdx.x * 512 + tid; i < 32 * 32 * 128; i += gridDim.x * 512) {
        const int n = i & 127, j = (i >> 7) & 31, bg = i >> 12;
        float o = 0.f;
        if (n < 127) { const int d = n - 4 * j; if (d >= 0 && d <= 2) o = 1.0f; else if (d == 3 || d == -1) o = 0.5f; }
        VCMPT[((size_t)bg * 96 + 64 + j) * 128 + n] = (bf16_t)(pk2(o, 0.f) & 0xffffu);
    }
}
DI void phase_topk(const int WID, ArgsP a) {
    const float* IMPH = (const float*)(a->ws + WS_IMPH); unsigned* SELM = (unsigned*)(a->ws + WS_SELM);
    for (int i = blockIdx.x * 512 + opaque_tid(WID); i < T * 2; i += gridDim.x * 512) {
        const int t = i >> 1, g = i & 1, b = t >> 11, s = t & 2047, cur = s >> 6;
        float sc[32];
#pragma unroll
        for (int j4 = 0; j4 < 8; ++j4) { f32x4 acc = {0.f, 0.f, 0.f, 0.f};
#pragma unroll
            for (int r = 0; r < 4; ++r) acc += *(const f32x4*)(IMPH + ((size_t)t * 8 + g * 4 + r) * 32 + 4 * j4);
#pragma unroll
            for (int q = 0; q < 4; ++q) sc[4 * j4 + q] = acc[q]; }
        unsigned mask;
        if (cur < 16) mask = (cur == 31) ? 0xffffffffu : ((2u << cur) - 1u);
        else {
#pragma unroll
            for (int j = 0; j < 32; ++j) { const bool forced = (j == 0) || (j == cur) || (j == cur - 1); sc[j] = (j > cur) ? NEGF : (sc[j] + (forced ? 1e4f : 0.f)); }
            mask = 0u;
#pragma unroll
            for (int j = 0; j < 32; ++j) { int rank = 0;
#pragma unroll
                for (int k = 0; k < 32; ++k) rank += ((sc[k] > sc[j]) || (sc[k] == sc[j] && k < j)) ? 1 : 0;
                mask |= (rank < 16) ? (1u << j) : 0u; }
        }
        SELM[((size_t)(b * 2 + g)) * 2048 + s] = mask;
    }
}
DI void phase_mixprep(const int WID, ArgsP a, int layer) {
    const int tid = opaque_tid(WID), lane = tid & 63, wv = tid >> 6, ev = layer >> 1;
    const float* dl = a->in[I_DALAM] + ev * 256;
    const float s1 = wave_sum(dl[lane] * dl[64 + lane]), s2 = wave_sum(dl[128 + lane] * dl[192 + lane]);
    const float lam_init = 0.8f - 0.6f * expf(-0.3f * (float)layer);
    const float lam = expf(s1) - expf(s2) + lam_init;
    const float* og = a->in[I_DAOUTG] + ev * 128;
    const bf16_t* OD = (const bf16_t*)(a->ws + WS_OD); const bf16_t* OC = (const bf16_t*)(a->ws + WS_OC); const bf16_t* OS = (const bf16_t*)(a->ws + WS_OS); const bf16_t* OW = (const bf16_t*)(a->ws + WS_OW);
    const float* GT = (const float*)(a->ws + WS_GATES); bf16_t* AMIX = (bf16_t*)(a->ws + WS_AMIX);
    const int h = lane >> 4, dv = (lane & 15) * 8;
    f32x4 g0 = *(const f32x4*)(og + dv), g1 = *(const f32x4*)(og + dv + 4);
    for (int t = blockIdx.x * 8 + wv; t < T; t += gridDim.x * 8) {
        { const u32x4 w1 = *(const u32x4*)(OD + (size_t)t * 1024 + h * 128 + dv), w2 = *(const u32x4*)(OD + (size_t)t * 1024 + (4 + h) * 128 + dv);
          f32x4 d0, d1;
          d0[0] = bflo(w1.x) - lam * bflo(w2.x); d0[1] = bfhi(w1.x) - lam * bfhi(w2.x); d0[2] = bflo(w1.y) - lam * bflo(w2.y); d0[3] = bfhi(w1.y) - lam * bfhi(w2.y);
          d1[0] = bflo(w1.z) - lam * bflo(w2.z); d1[1] = bfhi(w1.z) - lam * bfhi(w2.z); d1[2] = bflo(w1.w) - lam * bflo(w2.w); d1[3] = bfhi(w1.w) - lam * bfhi(w2.w);
          float ss = (d0[0] * d0[0] + d0[1] * d0[1]) + (d0[2] * d0[2] + d0[3] * d0[3]) + (d1[0] * d1[0] + d1[1] * d1[1]) + (d1[2] * d1[2] + d1[3] * d1[3]);
          ss += __shfl_xor(ss, 1); ss += __shfl_xor(ss, 2); ss += __shfl_xor(ss, 4); ss += __shfl_xor(ss, 8);
          const float rs = rsqrtf(ss * (1.0f / 128.0f) + EPS) * (1.0f - lam_init);
          *(u32x4*)(AMIX + (size_t)t * 1024 + h * 128 + dv) = pack8(d0 * rs * g0, d1 * rs * g1); }
        { const int hd = lane >> 3, dq = (lane & 7) * 8; const size_t o = (size_t)t * 512 + hd * 64 + dq;
          const float ga = GT[(size_t)t * 24 + hd * 3], gb = GT[(size_t)t * 24 + hd * 3 + 1], gc = GT[(size_t)t * 24 + hd * 3 + 2];
          const u32x4 c = *(const u32x4*)(OC + o), s = *(const u32x4*)(OS + o), w = *(const u32x4*)(OW + o);
          f32x4 r0, r1;
          r0[0] = ga * bflo(c.x) + gb * bflo(s.x) + gc * bflo(w.x); r0[1] = ga * bfhi(c.x) + gb * bfhi(s.x) + gc * bfhi(w.x);
          r0[2] = ga * bflo(c.y) + gb * bflo(s.y) + gc * bflo(w.y); r0[3] = ga * bfhi(c.y) + gb * bfhi(s.y) + gc * bfhi(w.y);
          r1[0] = ga * bflo(c.z) + gb * bflo(s.z) + gc * bflo(w.z); r1[1] = ga * bfhi(c.z) + gb * bfhi(s.z) + gc * bfhi(w.z);
          r1[2] = ga * bflo(c.w) + gb * bflo(s.w) + gc * bflo(w.w); r1[3] = ga * bfhi(c.w) + gb * bfhi(s.w) + gc * bfhi(w.w);
          *(u32x4*)(AMIX + (size_t)t * 1024 + 512 + hd * 64 + dq) = pack8(r0, r1); }
    }
}
DI void phase_scan(const int WID, ArgsP a) {
    const float* UT = (const float*)(a->ws + WS_UT); bf16_t* VS = (bf16_t*)(a->ws + WS_VS);
    for (int i = blockIdx.x * 512 + opaque_tid(WID); i < 64 * 512 * 64; i += gridDim.x * 512) {
        const int d4 = i & 63, f = (i >> 6) & 511, bh = i >> 15, h = bh & 3;
        const float dec = exp2f(256.0f * ret_lg2(h));
        f32x4 S = {0.f, 0.f, 0.f, 0.f};
#pragma unroll 1
        for (int n = 0; n < 8; ++n) {
            const size_t z = (size_t)bh * 8 + n;
            u32x2 o; o.x = pk2(S[0], S[1]); o.y = pk2(S[2], S[3]);
            *(u32x2*)(VS + (z * 512 + f) * 512 + 256 + 4 * d4) = o;
            const f32x4 u = *(const f32x4*)(UT + z * 131072 + (size_t)f * 256 + 4 * d4);
            S = (S + u) * dec;
        }
    }
}
DI void phase_normgate(const int WID, ArgsP a, int od) {
    const int tid = opaque_tid(WID), lane = tid & 63, wv = tid >> 6;
    const bf16_t* Y = (const bf16_t*)(a->ws + WS_Y); const bf16_t* GG = (const bf16_t*)(a->ws + WS_GG); bf16_t* YG = (bf16_t*)(a->ws + WS_YG);
    const float* og = a->in[I_RETG] + od * 512;
    const f32x4 g0 = *(const f32x4*)(og + 8 * lane), g1 = *(const f32x4*)(og + 8 * lane + 4);
    for (int t = blockIdx.x * 8 + wv; t < T; t += gridDim.x * 8) {
#pragma unroll
        for (int h = 0; h < 4; ++h) {
            const size_t o = (size_t)t * 2048 + h * 512 + 8 * lane;
            const u32x4 yw = *(const u32x4*)(Y + o), gw = *(const u32x4*)(GG + o);
            f32x4 y0 = {bflo(yw.x), bfhi(yw.x), bflo(yw.y), bfhi(yw.y)}, y1 = {bflo(yw.z), bfhi(yw.z), bflo(yw.w), bfhi(yw.w)};
            const f32x4 q0 = {bflo(gw.x), bfhi(gw.x), bflo(gw.y), bfhi(gw.y)}, q1 = {bflo(gw.z), bfhi(gw.z), bflo(gw.w), bfhi(gw.w)};
            float ss = (y0[0] * y0[0] + y0[1] * y0[1]) + (y0[2] * y0[2] + y0[3] * y0[3]) + (y1[0] * y1[0] + y1[1] * y1[1]) + (y1[2] * y1[2] + y1[3] * y1[3]);
            ss = wave_sum(ss);
            const float rs = rsqrtf(ss * (1.0f / 512.0f) + EPS);
            *(u32x4*)(YG + o) = pack8(y0 * rs * g0 * q0, y1 * rs * g1 * q1);
        }
    }
}
DI int snake_unit(int rnd, int G, int c) { return (rnd & 1) ? rnd * G + (G - 1 - c) : rnd * G + c; }
template <int MODE>
DI void phase_attn(const int WID, ArgsP a, LAS unsigned char* lds) {
    const int G = gridDim.x, c = blockIdx.x;
    const bf16_t* QD = (const bf16_t*)(a->ws + WS_QD); const bf16_t* KD = (const bf16_t*)(a->ws + WS_KD); const bf16_t* QN = (const bf16_t*)(a->ws + WS_QN);
    for (int rnd = 0;; ++rnd) {
        const int L = snake_unit(rnd, G, c); if (L >= 1024) { if (rnd * G >= 1024) break; else continue; }
        const int qb = 7 - (L >> 7), bh = L & 127, b = bh >> 3, hd = bh & 7, q0 = qb * 256; const size_t t0 = (size_t)b * 2048 + q0;
        if (MODE == 0) {
            const float slope = exp2f(-2.0f * (float)((hd & 3) + 1));
            attn_unit<128, 0>(WID, lds, QD + t0 * 512 + hd * 64, 512, KD + (size_t)b * 2048 * 512 + hd * 64, 512,
                              (const bf16_t*)(a->ws + WS_VAT) + (size_t)(b * 4 + (hd & 3)) * 128 * 2048, 2048, q0, slope, nullptr,
                              (bf16_t*)(a->ws + WS_OD) + t0 * 1024 + hd * 128, 1024, nullptr);
        } else if (MODE == 1 || MODE == 2) {
            const int g = hd >> 2; const float slope = exp2f(-(float)(hd + 1));
            const bf16_t* Kb = (const bf16_t*)(a->ws + (MODE == 1 ? WS_KSB : WS_KWB)) + (size_t)(b * 2 + g) * 2048 * 64;
            const bf16_t* Vb = (const bf16_t*)(a->ws + (MODE == 1 ? WS_VST : WS_VWT)) + (size_t)(b * 2 + g) * 64 * 2048;
            attn_unit<64, MODE>(WID, lds, QN + t0 * 512 + hd * 64, 512, Kb, 64, Vb, 2048, q0, slope,
                                (const unsigned*)(a->ws + WS_SELM) + (size_t)(b * 2 + g) * 2048 + q0,
                                (bf16_t*)(a->ws + (MODE == 1 ? WS_OS : WS_OW)) + t0 * 512 + hd * 64, 512, nullptr);
        } else {
            const int g = hd >> 2;
            attn_unit<96, 3>(WID, lds, QN + t0 * 512 + hd * 64, 512, (const bf16_t*)(a->ws + WS_KCMP) + (size_t)(b * 2 + g) * 128 * 64, 64,
                             (const bf16_t*)(a->ws + WS_VCMPT) + (size_t)(b * 2 + g) * 96 * 128, 128, q0, 0.f, nullptr,
                             (bf16_t*)(a->ws + WS_OC) + t0 * 512 + hd * 64, 512, (float*)(a->ws + WS_IMPH) + (t0 * 8 + hd) * 32);
        }
    }
}

constexpr int PPL = 15;
constexpr int NPHASE = 1 + DEPTH * PPL;
__global__ void __launch_bounds__(512, 2) mk_fwd(Args a_unused) {
    ArgsP a = opaque_args();
    extern __shared__ __attribute__((aligned(16))) unsigned char lds_raw[];
    LAS unsigned char* lds = (LAS unsigned char*)lds_raw;
    const int tid = threadIdx.x, G = gridDim.x, c = blockIdx.x;
    const int WID = __builtin_amdgcn_readfirstlane(tid >> 6);
    volatile LAS unsigned* misc = (volatile LAS unsigned*)(lds + MISC_OFF);
    if (tid < 4) misc[tid] = 0u;
    __syncthreads();
    unsigned* ctl = (unsigned*)(a->ws + WS_CTL);
    XcdBarrier bar; bar.bar = ctl + CW_BAR; bar.x = 0; bar.st = misc;
    const int ph_lo = a->ph_lo, ph_hi = a->ph_hi;
    const bool multi = (ph_hi - ph_lo) > 1;
    if (multi) bar = xcd_barrier_post(WID, ctl + CW_BAR, misc);
    bool first = true;
#define PHASE_BEGIN(k, id) if ((DBG_ONLY < 0 || DBG_ONLY == (id)) && (k) >= ph_lo && (k) < ph_hi && (k) <= DBG_LAST_PHASE) { if (!first) xcd_barrier(WID, bar); first = false; \
        ArgsP a = opaque_args(); unsigned char* ws = a->ws; bf16_t* XN = (bf16_t*)(ws + WS_XN); float* H = a->out; const float* Hin = (layer == 0) ? a->in[I_X] : (const float*)H; \
        const LAS int* ts = (const LAS int*)(lds + MISC_OFF + MO_TS); (void)XN; (void)H; (void)Hin; (void)ts;
#define PHASE_END }
    { const int layer = 0; PHASE_BEGIN(0, 0) phase_prologue(WID, a, lds); PHASE_END }
#pragma unroll 1
    for (int layer = 0; layer < DEPTH; ++layer) {
        const int pb = 1 + layer * PPL; const bool even = (layer & 1) == 0; const int ev = layer >> 1, od = layer >> 1;
        if (even) {
            PHASE_BEGIN(pb + 0, 1) phase_norm<0>(WID, a, lds, layer, Hin); PHASE_END
            PHASE_BEGIN(pb + 1, 2) {
                { ProbPlain P{XN, (const bf16_t*)(ws + WS_EVNAT) + (size_t)ev * 2048 * 1024, 1024, 1024, 1024}; pg8::Sched S; S.init(T / 256, 8, G, c);
                  EpiEvNat E{ws, (const float*)(ws + WS_GAINS) + ev * 256};
                  pg8::gemm_phase(WID, lds, P, S, E); }
                { ProbPlain P{(const bf16_t*)(ws + WS_EVSW) + (size_t)ev * 768 * 1024, XN, 1024, 1024, 1024}; pg8::Sched S; S.init(3, T / 256, G, c);
                  EpiEvSw E{ws};
                  pg8::gemm_phase(WID, lds, P, S, E); }
            } PHASE_END
            PHASE_BEGIN(pb + 2, 3) {
                { ProbCmp1 P{(const bf16_t*)(ws + WS_KCB), (const bf16_t*)(ws + WS_VCB), (const bf16_t*)(ws + WS_CMP1) + (size_t)ev * 2 * 256 * 2048, 1024, 2048, 2048}; pg8::Sched S; S.init(32, 1, G, c);
                  EpiCmp1 E{(bf16_t*)(ws + WS_HID), (const float*)(ws + WS_BIAS1) + ev * 512};
                  pg8::gemm_phase(WID, lds, P, S, E); }
                phase_attn<0>(WID, a, lds);
                phase_attn<2>(WID, a, lds);
            } PHASE_END
            PHASE_BEGIN(pb + 3, 4) phase_cmp2(WID, a, ev); PHASE_END
            PHASE_BEGIN(pb + 4, 5) phase_attn<3>(WID, a, lds); PHASE_END
            PHASE_BEGIN(pb + 5, 6) phase_topk(WID, a); PHASE_END
            PHASE_BEGIN(pb + 6, 7) phase_attn<1>(WID, a, lds); PHASE_END
            PHASE_BEGIN(pb + 7, 8) phase_mixprep(WID, a, layer); PHASE_END
            PHASE_BEGIN(pb + 8, 9) {
                ProbPlain P{(const bf16_t*)(ws + WS_AMIX), (const bf16_t*)(ws + WS_EVOUT) + (size_t)ev * 1024 * 1024, 1024, 1024, 1024}; pg8::Sched S; S.init(T / 256, 4, G, c);
                EpiResid E{Hin, H}; pg8::gemm_phase(WID, lds, P, S, E);
            } PHASE_END
        } else {
            PHASE_BEGIN(pb + 0, 11) phase_norm<1>(WID, a, lds, layer, Hin); PHASE_END
            PHASE_BEGIN(pb + 1, 12) {
                { ProbPlain P{XN, (const bf16_t*)(ws + WS_ODNAT) + (size_t)od * 4096 * 1024, 1024, 1024, 1024}; pg8::Sched S; S.init(T / 256, 16, G, c);
                  EpiOdNat E{ws}; pg8::gemm_phase(WID, lds, P, S, E); }
                { ProbPlain P{(const bf16_t*)(ws + WS_ODSW) + (size_t)od * 3072 * 1024, XN, 1024, 1024, 1024}; pg8::Sched S; S.init(12, T / 256, G, c);
                  EpiOdSw E{ws}; pg8::gemm_phase(WID, lds, P, S, E); }
            } PHASE_END
            PHASE_BEGIN(pb + 2, 13) {
                { ProbAtt P{(const bf16_t*)(ws + WS_AQ), (const bf16_t*)(ws + WS_KP), 2048, 1024, 256}; pg8::Sched S; S.init(512, 1, G, c);
                  EpiAtt E{(bf16_t*)(ws + WS_AQ)}; pg8::gemm_phase(WID, lds, P, S, E); }
                { ProbUT P{(const bf16_t*)(ws + WS_VS), (const bf16_t*)(ws + WS_KT), 512, 256, 256}; pg8::Sched S; S.init(1024, 1, G, c);
                  EpiUT E{(float*)(ws + WS_UT)}; pg8::gemm_phase(WID, lds, P, S, E); }
            } PHASE_END
            PHASE_BEGIN(pb + 3, 14) phase_scan(WID, a); PHASE_END
            PHASE_BEGIN(pb + 4, 15) {
                ProbY P{(const bf16_t*)(ws + WS_AQ), (const bf16_t*)(ws + WS_VS), 2048, 512, 512}; pg8::Sched S; S.init(512, 2, G, c);
                EpiY E{(bf16_t*)(ws + WS_Y)}; pg8::gemm_phase(WID, lds, P, S, E);
            } PHASE_END
            PHASE_BEGIN(pb + 5, 16) phase_normgate(WID, a, od); PHASE_END
            PHASE_BEGIN(pb + 8, 19) {
                ProbPlain P{(const bf16_t*)(ws + WS_YG), (const bf16_t*)(ws + WS_ODOUT) + (size_t)od * 1024 * 2048, 2048, 2048, 2048}; pg8::Sched S; S.init(T / 256, 4, G, c);
                EpiResid E{Hin, H}; pg8::gemm_phase(WID, lds, P, S, E);
            } PHASE_END
        }
        PHASE_BEGIN(pb + 9, 20) phase_norm<2>(WID, a, lds, layer, H); PHASE_END
        PHASE_BEGIN(pb + 10, 21) phase_moe_slots(WID, a, lds, layer); PHASE_END
        PHASE_BEGIN(pb + 11, 22) {
            moe_tables(WID, a, lds, layer, -1);
            { ProbMoe P{(const bf16_t*)(ws + WS_XB), (const bf16_t*)(ws + WS_WGU) + (size_t)layer * 32 * 2048 * 1024, ts, 2048, 1024, 1024, 1024}; pg8::Sched S; S.init(ts[32], 8, G, c);
              EpiGU E{(bf16_t*)(ws + WS_ACT), a->in[I_BGU] + (size_t)layer * 32 * 2048, ts}; pg8::gemm_phase(WID, lds, P, S, E); }
            { ProbPlain P{(const bf16_t*)(ws + WS_PBF) + (size_t)layer * T * 256, (const bf16_t*)(ws + WS_WPP) + (size_t)layer * 1024 * 256, 256, 256, 256}; pg8::Sched S; S.init(T / 256, 4, G, c);
              EpiPP E{(bf16_t*)(ws + WS_PP)}; pg8::gemm_phase(WID, lds, P, S, E); }
        } PHASE_END
        PHASE_BEGIN(pb + 12, 23) {
            moe_tables(WID, a, lds, layer, -1);
            ProbMoe P{(const bf16_t*)(ws + WS_ACT), (const bf16_t*)(ws + WS_WDN) + (size_t)layer * 32 * 1024 * 1024, ts, 1024, 1024, 1024, 1024}; pg8::Sched S; S.init(ts[32], 4, G, c);
            EpiDN E{(bf16_t*)(ws + WS_YB), a->in[I_BDN] + (size_t)layer * 32 * 1024, ts}; pg8::gemm_phase(WID, lds, P, S, E);
        } PHASE_END
        PHASE_BEGIN(pb + 13, 24) phase_combine(WID, a, H); PHASE_END
        PHASE_BEGIN(pb + 14, 25) {
            ProbPlain P{XN, (const bf16_t*)(ws + WS_WPG) + (size_t)layer * 1024 * 1024, 1024, 1024, 1024}; pg8::Sched S; S.init(T / 256, 4, G, c);
            EpiPLE E{H, (const bf16_t*)(ws + WS_PP)}; pg8::gemm_phase(WID, lds, P, S, E);
        } PHASE_END
    }
#undef PHASE_BEGIN
#undef PHASE_END
}

extern "C" void kernel_launch(void* const* d_in, const int* in_sizes, int n_in, void* d_out, int out_size, void* d_ws, size_t ws_size, hipStream_t stream) {
    static int grid = 0;
    if (grid == 0) {
        if (n_in != 26 || out_size != T * D || ws_size < WS_END) { fprintf(stderr, "kernel_launch: unexpected problem (n_in %d, out %d, ws %zu < %zu); nothing launched\n", n_in, out_size, ws_size, (size_t)WS_END); grid = -1; return; }
        int dev = 0, cus = 0, per_cu = 0;
        if (hipGetDevice(&dev) != hipSuccess || hipDeviceGetAttribute(&cus, hipDeviceAttributeMultiprocessorCount, dev) != hipSuccess) { grid = -1; return; }
        if (hipFuncSetAttribute((const void*)mk_fwd, hipFuncAttributeMaxDynamicSharedMemorySize, LDS_BYTES) != hipSuccess) { fprintf(stderr, "kernel_launch: hipFuncSetAttribute failed\n"); grid = -1; return; }
        if (hipOccupancyMaxActiveBlocksPerMultiprocessor(&per_cu, (const void*)mk_fwd, 512, LDS_BYTES) != hipSuccess || per_cu < 1) fprintf(stderr, "kernel_launch: occupancy query reports %d\n", per_cu);
        (void)hipGetLastError();
        grid = cus > 256 ? 256 : cus;
    }
    if (grid < 0) return;
    (void)hipMemsetAsync((char*)d_ws + WS_CTL, 0, CTL_BYTES, stream);
    Args a; memset(&a, 0, sizeof(a));
    for (int i = 0; i < 26; ++i) a.in[i] = (const float*)d_in[i];
    a.out = (float*)d_out; a.ws = (unsigned char*)d_ws;
#if MK_SINGLE
    a.ph_lo = 0; a.ph_hi = NPHASE;
    hipLaunchKernelGGL(mk_fwd, dim3(grid), dim3(512), LDS_BYTES, stream, a);
#else
    for (int ph = 0; ph < NPHASE && ph <= DBG_LAST_PHASE; ++ph) {
        const int l = (ph - 1) / PPL, k = (ph - 1) % PPL;
        if (ph > 0 && (l & 1) && (k == 6 || k == 7)) continue;
        a.ph_lo = ph; a.ph_hi = ph + 1;
        hipLaunchKernelGGL(mk_fwd, dim3(grid), dim3(512), LDS_BYTES, stream, a);
    }
#endif
}
```

```cpp
#include <hip/hip_runtime.h>
#include <cstdio>
#include <cstdint>
#include <cstring>

#define LAS __attribute__((address_space(3)))
#define DI __device__ __forceinline__
typedef unsigned short bf16_t;
typedef short bf16x8 __attribute__((ext_vector_type(8)));
typedef short s16x4 __attribute__((ext_vector_type(4)));
typedef float f32x2 __attribute__((ext_vector_type(2)));
typedef float f32x4 __attribute__((ext_vector_type(4)));
typedef float f32x16 __attribute__((ext_vector_type(16)));
typedef unsigned u32x2 __attribute__((ext_vector_type(2)));
typedef unsigned u32x4 __attribute__((ext_vector_type(4)));
typedef __bf16 bfv2 __attribute__((ext_vector_type(2)));

#ifndef MK_SINGLE
#define MK_SINGLE 1
#endif
#ifndef DBG_ONLY
#define DBG_ONLY -1
#endif
#ifndef PROBE_MASK
#define PROBE_MASK 0u
#endif
#ifndef DBG_LAST_PHASE
#define DBG_LAST_PHASE 100000
#endif

constexpr int T = 32768, D = 1024, SEQ = 2048, NBATCH = 16, DEPTH = 4;
constexpr int EVIN = 2840, ODIN = 6144;
constexpr float EPS = 1e-6f, NEGF = -1e30f;
constexpr int NTB = 256;
constexpr int MOE_ROWS = (512 + 32) * 256;

constexpr size_t MiB = 1u << 20;
constexpr size_t WS_CTL = 0, CTL_BYTES = 1 * MiB;
constexpr int CW_BAR = 4096;
constexpr size_t WS_EVNAT = 2 * MiB, WS_EVSW = 10 * MiB, WS_EVOUT = 13 * MiB, WS_CMP1 = 17 * MiB, WS_ODNAT = 21 * MiB, WS_ODSW = 37 * MiB,
                 WS_ODOUT = 49 * MiB, WS_WPP = 57 * MiB, WS_WPG = 59 * MiB, WS_BIAS1 = 67 * MiB, WS_GAINS = 67 * MiB + 16384, WS_BCNT = 67 * MiB + 65536,
                 WS_WGU = 68 * MiB, WS_WDN = 580 * MiB;
constexpr size_t WS_XN = 840 * MiB, WS_PBF = 904 * MiB, WS_PP = 968 * MiB, WS_GATES = 1032 * MiB, WS_TOPE = 1035 * MiB, WS_POSB = 1036 * MiB,
                 WS_DEST = 1037 * MiB, WS_GATEW = 1038 * MiB, WS_SELM = 1039 * MiB;
constexpr size_t RA = 1040 * MiB;
constexpr size_t WS_QD = RA, WS_KD = RA + 32 * MiB, WS_QN = RA + 64 * MiB, WS_KCB = RA + 96 * MiB, WS_VCB = RA + 105 * MiB, WS_KSB = RA + 114 * MiB,
                 WS_KWB = RA + 122 * MiB, WS_VAT = RA + 130 * MiB, WS_VST = RA + 162 * MiB, WS_VWT = RA + 170 * MiB, WS_HID = RA + 178 * MiB,
                 WS_KCMP = RA + 182 * MiB, WS_VCMPT = RA + 183 * MiB, WS_OC = RA + 184 * MiB, WS_IMPH = RA + 216 * MiB, WS_OD = RA + 248 * MiB,
                 WS_OS = RA + 312 * MiB, WS_OW = RA + 344 * MiB, WS_AMIX = RA + 376 * MiB;
constexpr size_t WS_AQ = RA, WS_KP = RA + 128 * MiB, WS_KT = RA + 192 * MiB, WS_VS = RA + 256 * MiB, WS_GG = RA + 512 * MiB, WS_UT = RA + 640 * MiB,
                 WS_Y = RA + 896 * MiB, WS_YG = RA + 1024 * MiB;
constexpr size_t WS_XB = 2192 * MiB, WS_ACT = 2464 * MiB, WS_YB = 2736 * MiB, WS_END = 3008 * MiB;

constexpr int MISC_OFF = 139264, LDS_BYTES = 155648;
static_assert(MISC_OFF + 5888 + 4096 <= LDS_BYTES, "misc LDS words");
constexpr int MO_WCNT = 256, MO_ENT = 1280, MO_GAT = 3328, MO_TOT = 5376, MO_BASE = 5504, MO_TS = 5632, MO_RED = 5888;

DI int opaque_tid(int wid0) { int t = (wid0 << 6) | (int)__builtin_amdgcn_mbcnt_hi(~0u, __builtin_amdgcn_mbcnt_lo(~0u, 0u)); asm volatile("" : "+v"(t) :: "memory"); return t; }
DI unsigned pk2(float lo, float hi) { f32x2 v = {lo, hi}; return __builtin_bit_cast(unsigned, __builtin_convertvector(v, bfv2)); }
DI float bf2f(unsigned short b) { return __uint_as_float(((unsigned)b) << 16); }
DI float bflo(unsigned w) { return __uint_as_float(w << 16); }
DI float bfhi(unsigned w) { return __uint_as_float(w & 0xffff0000u); }
DI float wave_sum(float v) {
#pragma unroll
    for (int o = 1; o < 64; o <<= 1) v += __shfl_xor(v, o);
    return v;
}
DI float sigm(float x) { return 1.0f / (1.0f + __expf(-x)); }
DI u32x4 pack8(const f32x4& a, const f32x4& b) { u32x4 w; w.x = pk2(a[0], a[1]); w.y = pk2(a[2], a[3]); w.z = pk2(b[0], b[1]); w.w = pk2(b[2], b[3]); return w; }

#define XB_TMO      128
#define XB_XCNT(j)  (256  + 64 * (j))
#define XB_XSUB(j)  (1280 + 64 * (j))
#define XB_XGEN(j)  (2304 + 64 * (j))
#define XB_TOP      3328
#define XB_TOPGEN   3392
#define XCD_BAR_WORDS 3456
#define XB_SPIN_CAP (1u << 22)
DI unsigned xb_ld(unsigned* p)              { return __hip_atomic_load(p, __ATOMIC_RELAXED, __HIP_MEMORY_SCOPE_AGENT); }
DI unsigned xb_add(unsigned* p, unsigned v) { return __hip_atomic_fetch_add(p, v, __ATOMIC_RELAXED, __HIP_MEMORY_SCOPE_AGENT); }
DI unsigned xb_xcc_id() { return (unsigned)__builtin_amdgcn_s_getreg((3 << 11) | 20) & 0xFu; }
#define XB_SPIN(cond, bar) do { unsigned _sp = 0; while (cond) { __builtin_amdgcn_s_sleep(1); \
    if ((++_sp & 255u) == 0u) { if (xb_ld(&(bar)[XB_TMO])) break; if (_sp > XB_SPIN_CAP) { atomicAdd(&(bar)[XB_TMO], 1u); break; } } } } while (0)
struct XcdBarrier { unsigned* bar; unsigned x; volatile LAS unsigned* st; };
DI XcdBarrier xcd_barrier_post(const int WID, unsigned* bar, volatile LAS unsigned* st) {
    XcdBarrier b; b.bar = bar; b.x = xb_xcc_id(); b.st = st;
    if (opaque_tid(WID) == 0) (void)xb_add(&bar[XB_XCNT(b.x)], 1u);
    return b;
}
DI void xcd_barrier_complete(unsigned* bar, unsigned x, unsigned& nloc, unsigned& nx) {
    const unsigned G = gridDim.x * gridDim.y * gridDim.z;
    unsigned sum, cnt, mine, sp = 0u;
    for (;;) {
        sum = 0u; cnt = 0u; mine = 0u;
#pragma unroll
        for (unsigned j = 0; j < 16; ++j) { const unsigned c = xb_ld(&bar[XB_XCNT(j)]); sum += c; cnt += (c > 0u) ? 1u : 0u; mine = (j == x) ? c : mine; }
        if (sum == G) break;
        __builtin_amdgcn_s_sleep(1);
        if ((++sp & 255u) == 0u) { if (xb_ld(&bar[XB_TMO])) break; if (sp > XB_SPIN_CAP) { atomicAdd(&bar[XB_TMO], 1u); break; } }
    }
    nloc = mine > 0u ? mine : 1u; nx = cnt > 0u ? cnt : 1u;
}
DI void xcd_barrier(const int WID, const XcdBarrier& b) {
    asm volatile("s_waitcnt vmcnt(0)" ::: "memory");
    __syncthreads();
    if (opaque_tid(WID) == 0) {
        unsigned* bar = b.bar; asm volatile("" : "+s"(bar));
        __builtin_amdgcn_s_waitcnt(0);
        unsigned nloc = b.st[0], nx = b.st[1];
        if (nloc == 0u) { xcd_barrier_complete(bar, b.x, nloc, nx); b.st[0] = nloc; b.st[1] = nx; }
        const unsigned old = xb_add(&bar[XB_XSUB(b.x)], 1u);
        const unsigned gen = old / nloc;
        if (old + 1u == (gen + 1u) * nloc) {
            __builtin_amdgcn_fence(__ATOMIC_RELEASE, "agent");
            asm volatile("s_waitcnt vmcnt(0)" ::: "memory");
            const unsigned og = xb_add(&bar[XB_TOP], 1u);
            const unsigned tg = og / nx;
            if (og + 1u == (tg + 1u) * nx) xb_add(&bar[XB_TOPGEN], 1u);
            else XB_SPIN(xb_ld(&bar[XB_TOPGEN]) == tg, bar);
            __builtin_amdgcn_fence(__ATOMIC_ACQUIRE, "agent");
            xb_add(&bar[XB_XGEN(b.x)], 1u);
            asm volatile("s_waitcnt vmcnt(0)" ::: "memory");
        } else {
            XB_SPIN(xb_ld(&bar[XB_XGEN(b.x)]) == gen, bar);
            __builtin_amdgcn_fence(__ATOMIC_ACQUIRE, "agent");
            asm volatile("s_waitcnt vmcnt(0)" ::: "memory");
        }
    }
    __syncthreads();
}

namespace pg8 {
constexpr int BM = 256, BK = 64, HALF = 128, HTB = HALF * BK * 2, STAGE_BYTES = 8 * HTB, NXCD = 8, WGM = 8;
DI int lds_byte(int r, int c) { const int st = (r >> 4) * 2 + (c >> 5), rr = r & 15, cc = c & 31, ob = rr * 64 + cc * 2; return st * 1024 + (ob ^ (((ob >> 9) & 1) << 5)); }
DI void stage_rc(int b, int& R, int& C) { const int st = b / 1024, sb = b % 1024, swz = sb ^ (((sb >> 9) & 1) << 5); R = (st >> 1) * 16 + swz / 64; C = (st & 1) * 32 + (swz % 64) / 2; }
DI int perm32(int rho) { const int n = rho >> 4, i = rho & 15; return 8 * (i >> 2) + 4 * n + (i & 3); }
struct Unit { int pm, pn; };
struct Sched {
    int nM, nN, nwg, G, c;
    DI void init(int nM_, int nN_, int G_, int c_) { nM = nM_; nN = nN_; nwg = nM * nN; G = G_; c = c_; }
    DI bool next(int i, Unit& u) const {
        const long L = (long)i * G + c; if (L >= nwg) return false;
        int wgid = (int)L; { const int q = nwg / NXCD, r = nwg % NXCD, xcd = wgid % NXCD, off = wgid / NXCD; wgid = (xcd < r ? xcd * (q + 1) : r * (q + 1) + (xcd - r) * q) + off; }
        const int nig = WGM * nN, gid = wgid / nig, fm = gid * WGM, gsz = (nM - fm) < WGM ? (nM - fm) : WGM;
        u.pm = fm + ((wgid % nig) % gsz); u.pn = (wgid % nig) / gsz; return true;
    }
};
template <class Epi, class Prob>
DI void gemm_phase(const int WID, LAS unsigned char* lds, const Prob& P, const Sched& S, const Epi& E) {
    const int tid = opaque_tid(WID), wid = __builtin_amdgcn_readfirstlane(tid >> 6), lane = tid & 63, wr = wid >> 2, wc = wid & 3, fr = lane & 15, fq = lane >> 4;
    const int K = P.K, nt = K / BK;
    unsigned voffA[2], voffB[2];
#pragma unroll
    for (int i = 0; i < 2; ++i) { int R, C; stage_rc(tid * 16 + i * 8192, R, C); const int Rb = Epi::PERM ? ((R & ~31) + perm32(R & 31)) : R;
        voffA[i] = (unsigned)(R * P.lda + C) * 2u; voffB[i] = (unsigned)(Rb * P.ldb + C) * 2u; }
    const size_t kstep = (size_t)(BK * 2);
    const size_t hstepA = (size_t)HALF * P.lda * 2, hstepB = (size_t)HALF * P.ldb * 2;
    const unsigned ldsw = (unsigned)wid * 1024u;
    const int aoff = lds_byte(wr * 64 + fr, fq * 8), boff = lds_byte(wc * 32 + fr, fq * 8);
#define PG8_SA(b, h) (((b) * 2 + (h)) * HTB)
#define PG8_SB(b, h) ((4 + (b) * 2 + (h)) * HTB)
#define PG8_STAGE(bufoff, gbase, voff) do { _Pragma("unroll") for (int _i = 0; _i < 2; ++_i) \
        __builtin_amdgcn_global_load_lds((const unsigned*)((const char*)(gbase) + (voff)[_i]), (LAS unsigned*)(lds + (bufoff) + ldsw + _i * 8192), 16, 0, 0); } while (0)
#define PG8_LDA(dst, b, h) do { _Pragma("unroll") for (int m = 0; m < 4; ++m) _Pragma("unroll") for (int k = 0; k < 2; ++k) dst[m][k] = *(const LAS bf16x8*)(lds + PG8_SA(b, h) + aoff + m * 2048 + k * 1024); } while (0)
#define PG8_LDB(dst, b, h) do { _Pragma("unroll") for (int n = 0; n < 2; ++n) _Pragma("unroll") for (int k = 0; k < 2; ++k) dst[n][k] = *(const LAS bf16x8*)(lds + PG8_SB(b, h) + boff + n * 2048 + k * 1024); } while (0)
#define PG8_MMA(ai, bj, At, Bt) do { __builtin_amdgcn_s_setprio(1); _Pragma("unroll") for (int m = 0; m < 4; ++m) _Pragma("unroll") for (int n = 0; n < 2; ++n) _Pragma("unroll") for (int k = 0; k < 2; ++k) \
        acc[ai][bj][m][n] = __builtin_amdgcn_mfma_f32_16x16x32_bf16(Bt[n][k], At[m][k], acc[ai][bj][m][n], 0, 0, 0); __builtin_amdgcn_s_setprio(0); } while (0)
#define PG8_WAIT_V(n) asm volatile("s_waitcnt vmcnt(" #n ")" ::: "memory")
#define PG8_WAIT_L(n) asm volatile("s_waitcnt lgkmcnt(" #n ")" ::: "memory")
#define PG8_BAR __builtin_amdgcn_s_barrier()
#define PG8_SCHED __builtin_amdgcn_sched_barrier(0)
    Unit cur, nxt; int ui = 0;
    if (!S.next(0, cur)) return;
    f32x4 acc[2][2][4][2];
#pragma unroll
    for (int a = 0; a < 2; ++a)
#pragma unroll
        for (int b = 0; b < 2; ++b)
#pragma unroll
            for (int m = 0; m < 4; ++m)
#pragma unroll
                for (int n = 0; n < 2; ++n) acc[a][b][m][n] = (f32x4){0.f, 0.f, 0.f, 0.f};
    bf16x8 At[4][2], B0[2][2], B1[2][2];
    const char* cA = P.a_base(cur); const char* cB = P.b_base(cur);
    PG8_STAGE(PG8_SB(0, 0), cB, voffB); PG8_STAGE(PG8_SA(0, 0), cA, voffA); PG8_STAGE(PG8_SB(0, 1), cB + hstepB, voffB); PG8_STAGE(PG8_SA(0, 1), cA + hstepA, voffA);
    if (wr == 1) PG8_BAR;
    PG8_WAIT_V(4); PG8_BAR;
    PG8_STAGE(PG8_SB(1, 0), cB + kstep, voffB); PG8_STAGE(PG8_SA(1, 0), cA + kstep, voffA); PG8_STAGE(PG8_SB(1, 1), cB + hstepB + kstep, voffB);
    PG8_WAIT_V(6); PG8_BAR;
    for (;;) {
        const bool has_next = S.next(ui + 1, nxt);
        const char* nA = has_next ? P.a_base(nxt) : cA; const char* nB = has_next ? P.b_base(nxt) : cB;
        for (int t = 0; t < nt; t += 2) {
            const bool last = (t == nt - 2);
            const char* a1 = cA + (size_t)(t + 1) * kstep;
            const char* a2 = last ? nA : cA + (size_t)(t + 2) * kstep; const char* b2 = last ? nB : cB + (size_t)(t + 2) * kstep;
            const char* a3 = a2 + kstep; const char* b3 = b2 + kstep;
            PG8_LDB(B0, 0, 0); PG8_SCHED; PG8_LDA(At, 0, 0); PG8_STAGE(PG8_SA(1, 1), a1 + hstepA, voffA);
            PG8_WAIT_L(8); PG8_BAR; PG8_WAIT_L(0); PG8_MMA(0, 0, At, B0); PG8_BAR; PG8_SCHED;
            PG8_LDB(B1, 0, 1); PG8_STAGE(PG8_SB(0, 0), b2, voffB);
            PG8_BAR; PG8_WAIT_L(0); PG8_MMA(0, 1, At, B1); PG8_BAR;
            PG8_LDA(At, 0, 1); PG8_STAGE(PG8_SA(0, 0), a2, voffA);
            PG8_BAR; PG8_WAIT_L(0); PG8_MMA(1, 0, At, B0); PG8_BAR; PG8_SCHED;
            PG8_STAGE(PG8_SB(0, 1), b2 + hstepB, voffB);
            PG8_WAIT_V(6); PG8_BAR; PG8_MMA(1, 1, At, B1); PG8_BAR;
            PG8_LDB(B0, 1, 0); PG8_SCHED; PG8_LDA(At, 1, 0); PG8_STAGE(PG8_SA(0, 1), a2 + hstepA, voffA);
            PG8_WAIT_L(8); PG8_BAR; PG8_WAIT_L(0); PG8_MMA(0, 0, At, B0); PG8_BAR; PG8_SCHED;
            PG8_LDB(B1, 1, 1); PG8_STAGE(PG8_SB(1, 0), b3, voffB);
            PG8_BAR; PG8_WAIT_L(0); PG8_MMA(0, 1, At, B1); PG8_BAR;
            PG8_LDA(At, 1, 1); PG8_STAGE(PG8_SA(1, 0), a3, voffA);
            PG8_BAR; PG8_WAIT_L(0); PG8_MMA(1, 0, At, B0); PG8_BAR; PG8_SCHED;
            PG8_STAGE(PG8_SB(1, 1), b3 + hstepB, voffB);
            PG8_WAIT_V(6); PG8_BAR; PG8_MMA(1, 1, At, B1); PG8_BAR;
        }
        { int fr_ = fr, fq_ = fq, wr_ = wr, wc_ = wc; asm volatile("" : "+v"(fr_), "+v"(fq_), "+s"(wr_), "+s"(wc_));
          E(acc, cur, wr_, wc_, fr_, fq_); }
        if (!has_next) break;
#pragma unroll
        for (int a = 0; a < 2; ++a)
#pragma unroll
            for (int b = 0; b < 2; ++b)
#pragma unroll
                for (int m = 0; m < 4; ++m)
#pragma unroll
                    for (int n = 0; n < 2; ++n) acc[a][b][m][n] = (f32x4){0.f, 0.f, 0.f, 0.f};
        cur = nxt; cA = nA; cB = nB; ++ui;
    }
    PG8_WAIT_V(0);
    if (wr == 0) PG8_BAR;
    PG8_BAR;
#undef PG8_SA
#undef PG8_SB
#undef PG8_STAGE
#undef PG8_LDA
#undef PG8_LDB
#undef PG8_MMA
#undef PG8_WAIT_V
#undef PG8_WAIT_L
#undef PG8_BAR
#undef PG8_SCHED
}
}
using pg8::Unit;
typedef f32x4 Acc[2][2][4][2];

struct ProbPlain { const bf16_t* A; const bf16_t* Bt; int lda, ldb, K;
    DI const char* a_base(const Unit& u) const { return (const char*)(A + (size_t)u.pm * 256 * lda); }
    DI const char* b_base(const Unit& u) const { return (const char*)(Bt + (size_t)u.pn * 256 * ldb); } };
struct ProbCmp1 { const bf16_t* KCB; const bf16_t* VCB; const bf16_t* W; int lda, ldb, K;
    DI const char* a_base(const Unit& u) const { const int kv = u.pm >> 4, rt = u.pm & 15; return (const char*)((kv ? VCB : KCB) + (size_t)rt * 256 * 1024); }
    DI const char* b_base(const Unit& u) const { const int kv = u.pm >> 4; return (const char*)(W + (size_t)kv * 256 * 2048); } };
struct ProbAtt { const bf16_t* AQ; const bf16_t* KP; int lda, ldb, K;
    DI const char* a_base(const Unit& u) const { const int z = u.pm, n = z & 7, h = (z >> 3) & 3, b = z >> 5; const size_t t0 = (size_t)b * 2048 + n * 256; return (const char*)(AQ + (t0 * 4 + h) * 512 + 256); }
    DI const char* b_base(const Unit& u) const { const int z = u.pm, n = z & 7, h = (z >> 3) & 3, b = z >> 5; const size_t t0 = (size_t)b * 2048 + n * 256; return (const char*)(KP + t0 * 1024 + h * 256); } };
struct ProbUT { const bf16_t* VS; const bf16_t* KT; int lda, ldb, K;
    DI const char* a_base(const Unit& u) const { const int z = u.pm >> 1, half = u.pm & 1; return (const char*)(VS + (size_t)z * 262144 + (size_t)half * 256 * 512); }
    DI const char* b_base(const Unit& u) const { const int z = u.pm >> 1; return (const char*)(KT + (size_t)z * 65536); } };
struct ProbY { const bf16_t* AQ; const bf16_t* VS; int lda, ldb, K;
    DI const char* a_base(const Unit& u) const { const int z = u.pm, n = z & 7, h = (z >> 3) & 3, b = z >> 5; const size_t t0 = (size_t)b * 2048 + n * 256; return (const char*)(AQ + (t0 * 4 + h) * 512); }
    DI const char* b_base(const Unit& u) const { return (const char*)(VS + (size_t)u.pm * 262144 + (size_t)u.pn * 256 * 512); } };
DI int moe_tile_expert(const LAS int* ts, int rt) { int e = 0;
#pragma unroll 8
    for (int i = 1; i < 32; ++i) e += (rt >= ts[i]) ? 1 : 0;
    return e; }
struct ProbMoe { const bf16_t* A; const bf16_t* W; const LAS int* ts; int nper; int lda, ldb, K;
    DI const char* a_base(const Unit& u) const { return (const char*)(A + (size_t)u.pm * 256 * 1024); }
    DI const char* b_base(const Unit& u) const { const int e = moe_tile_expert(ts, u.pm); return (const char*)(W + ((size_t)e * nper + (size_t)u.pn * 256) * 1024); } };

#define EPI_ROWS(ai, m) (128 * (ai) + 64 * wr + 16 * (m) + fr)
struct EpiEvNat { static constexpr bool PERM = true;
    unsigned char* ws; const float* gains;
    DI void operator()(const Acc& acc, const Unit& u, int wr, int wc, int fr, int fq) const {
        const int pn = u.pn; const bool norm = (pn != 6);
        const int gi = pn < 2 ? 0 : pn < 4 ? 1 : pn < 6 ? 2 : 3;
        const float* g = gains + gi * 64;
        f32x4 gv[2][2];
#pragma unroll
        for (int bj = 0; bj < 2; ++bj)
#pragma unroll
            for (int n = 0; n < 2; ++n) { const f32x4 t4 = *(const f32x4*)(g + 32 * bj + 8 * fq + 4 * n); gv[bj][n] = norm ? t4 : (f32x4){1.f, 1.f, 1.f, 1.f}; }
        size_t boff; int rowmul, hoff; bool panel = false;
        if (pn < 2) { boff = WS_QD; rowmul = 512; hoff = (pn * 4 + wc) * 64; }
        else if (pn < 4) { boff = WS_KD; rowmul = 512; hoff = ((pn - 2) * 4 + wc) * 64; }
        else if (pn < 6) { boff = WS_QN; rowmul = 512; hoff = ((pn - 4) * 4 + wc) * 64; }
        else { panel = true; rowmul = 64; hoff = 0; boff = (pn == 6) ? (wc < 2 ? WS_KCB : WS_VCB) : (wc < 2 ? WS_KSB : WS_KWB); }
        bf16_t* base = (bf16_t*)(ws + boff);
#pragma unroll
        for (int ai = 0; ai < 2; ++ai)
#pragma unroll
            for (int m = 0; m < 4; ++m) {
                const int t = u.pm * 256 + EPI_ROWS(ai, m), b = t >> 11, sq = t & 2047;
                float ss = 0.f;
#pragma unroll
                for (int bj = 0; bj < 2; ++bj)
#pragma unroll
                    for (int n = 0; n < 2; ++n) { const f32x4 x = acc[ai][bj][m][n]; ss += (x[0] * x[0] + x[1] * x[1]) + (x[2] * x[2] + x[3] * x[3]); }
                ss += __shfl_xor(ss, 16); ss += __shfl_xor(ss, 32);
                const float rstd = norm ? rsqrtf(ss * (1.0f / 64.0f) + EPS) : 1.0f;
                const size_t rowi = panel ? ((size_t)(b * 2 + (wc & 1)) * 2048 + sq) : (size_t)t;
#pragma unroll
                for (int bj = 0; bj < 2; ++bj) {
                    const f32x4 v0 = acc[ai][bj][m][0] * rstd * gv[bj][0], v1 = acc[ai][bj][m][1] * rstd * gv[bj][1];
                    *(u32x4*)(base + rowi * rowmul + hoff + 32 * bj + 8 * fq) = pack8(v0, v1);
                }
            }
    }
};
struct EpiEvSw { static constexpr bool PERM = true;
    unsigned char* ws;
    DI void operator()(const Acc& acc, const Unit& u, int wr, int wc, int fr, int fq) const {
        const int b = u.pn >> 3, sb = (u.pn & 7) * 256;
#pragma unroll
        for (int ai = 0; ai < 2; ++ai)
#pragma unroll
            for (int m = 0; m < 4; ++m) {
                const int rl = EPI_ROWS(ai, m);
                size_t boff, rowi;
                if (u.pm < 2) { const int fg = u.pm * 256 + rl; boff = WS_VAT; rowi = (size_t)(b * 4 + (fg >> 7)) * 128 + (fg & 127); }
                else { const int r2 = rl & 127; boff = (rl < 128) ? WS_VST : WS_VWT; rowi = (size_t)(b * 2 + (r2 >> 6)) * 64 + (r2 & 63); }
                bf16_t* rowp = (bf16_t*)(ws + boff) + rowi * 2048;
#pragma unroll
                for (int bj = 0; bj < 2; ++bj) *(u32x4*)(rowp + sb + 128 * bj + 32 * wc + 8 * fq) = pack8(acc[ai][bj][m][0], acc[ai][bj][m][1]);
            }
    }
};
struct EpiCmp1 { static constexpr bool PERM = true;
    bf16_t* HID; const float* bias1;
    DI void operator()(const Acc& acc, const Unit& u, int wr, int wc, int fr, int fq) const {
        const int kv = u.pm >> 4, rt = u.pm & 15;
#pragma unroll
        for (int bj = 0; bj < 2; ++bj) {
            const int col = 128 * bj + 32 * wc + 8 * fq;
            const f32x4 b0 = *(const f32x4*)(bias1 + kv * 256 + col), b1 = *(const f32x4*)(bias1 + kv * 256 + col + 4);
#pragma unroll
            for (int ai = 0; ai < 2; ++ai)
#pragma unroll
                for (int m = 0; m < 4; ++m) {
                    f32x4 v0 = acc[ai][bj][m][0] + b0, v1 = acc[ai][bj][m][1] + b1;
#pragma unroll
                    for (int j = 0; j < 4; ++j) { v0[j] = v0[j] * sigm(v0[j]); v1[j] = v1[j] * sigm(v1[j]); }
                    *(u32x4*)(HID + ((size_t)kv * 4096 + rt * 256 + EPI_ROWS(ai, m)) * 256 + col) = pack8(v0, v1);
                }
        }
    }
};
struct EpiResid { static constexpr bool PERM = false;
    const float* Hin; float* Hout;
    DI void operator()(const Acc& acc, const Unit& u, int wr, int wc, int fr, int fq) const {
#pragma unroll
        for (int ai = 0; ai < 2; ++ai)
#pragma unroll
            for (int m = 0; m < 4; ++m) {
                const size_t off = (size_t)(u.pm * 256 + EPI_ROWS(ai, m)) * 1024 + u.pn * 256 + 32 * wc + 4 * fq;
#pragma unroll
                for (int bj = 0; bj < 2; ++bj)
#pragma unroll
                    for (int n = 0; n < 2; ++n) { const size_t o = off + 128 * bj + 16 * n; *(f32x4*)(Hout + o) = *(const f32x4*)(Hin + o) + acc[ai][bj][m][n]; }
            }
    }
};
DI float ret_lg2(int h) { return __log2f(1.0f - exp2f(-5.0f - (float)h)); }
struct EpiOdNat { static constexpr bool PERM = true;
    unsigned char* ws;
    DI void operator()(const Acc& acc, const Unit& u, int wr, int wc, int fr, int fq) const {
        const int pn = u.pn; const int h = pn & 3; const float lg = ret_lg2(h);
        const size_t boff = pn < 4 ? WS_AQ : pn < 8 ? WS_KP : WS_GG;
        const int rowmul = pn < 4 ? 2048 : pn < 8 ? 1024 : 2048;
        const int coff = pn < 4 ? (h * 512 + 256) : pn < 8 ? (h * 256) : ((pn - 8) * 256);
        bf16_t* base = (bf16_t*)(ws + boff) + coff;
#pragma unroll
        for (int ai = 0; ai < 2; ++ai)
#pragma unroll
            for (int m = 0; m < 4; ++m) {
                const int cl = EPI_ROWS(ai, m); const size_t t = (size_t)u.pm * 256 + cl;
                float sc = 1.f;
                if (pn < 4) sc = exp2f(lg * (float)(cl + 1)); else if (pn < 8) sc = 0.0625f * exp2f(-lg * (float)(cl + 1));
#pragma unroll
                for (int bj = 0; bj < 2; ++bj) {
                    const int d = 128 * bj + 32 * wc + 8 * fq;
                    f32x4 v0 = acc[ai][bj][m][0] * sc, v1 = acc[ai][bj][m][1] * sc;
                    if (pn >= 8) {
#pragma unroll
                        for (int j = 0; j < 4; ++j) { v0[j] = v0[j] * sigm(v0[j]); v1[j] = v1[j] * sigm(v1[j]); } }
                    *(u32x4*)(base + t * rowmul + d) = pack8(v0, v1);
                }
            }
    }
};
struct EpiOdSw { static constexpr bool PERM = true;
    unsigned char* ws;
    DI void operator()(const Acc& acc, const Unit& u, int wr, int wc, int fr, int fq) const {
        const int b = u.pn >> 3, n = u.pn & 7;
        const bool isk = u.pm < 4; const int h = isk ? u.pm : ((u.pm - 4) >> 1);
        const size_t z = (size_t)(b * 4 + h) * 8 + n; const float lg = ret_lg2(h);
        bf16_t* base = (bf16_t*)(ws + (isk ? WS_KT : WS_VS)) + (isk ? z * 65536 : z * 262144 + (size_t)((u.pm - 4) & 1) * 256 * 512);
        const int rowmul = isk ? 256 : 512;
#pragma unroll
        for (int bj = 0; bj < 2; ++bj) {
            const int cl = 128 * bj + 32 * wc + 8 * fq;
            f32x4 s0 = {1.f, 1.f, 1.f, 1.f}, s1 = s0;
            if (isk) {
#pragma unroll
                for (int j = 0; j < 4; ++j) { s0[j] = 0.0625f * exp2f(-lg * (float)(cl + j + 1)); s1[j] = 0.0625f * exp2f(-lg * (float)(cl + 4 + j + 1)); } }
#pragma unroll
            for (int ai = 0; ai < 2; ++ai)
#pragma unroll
                for (int m = 0; m < 4; ++m)
                    *(u32x4*)(base + (size_t)EPI_ROWS(ai, m) * rowmul + cl) = pack8(acc[ai][bj][m][0] * s0, acc[ai][bj][m][1] * s1);
        }
    }
};
struct EpiAtt { static constexpr bool PERM = true;
    bf16_t* AQ;
    DI void operator()(const Acc& acc, const Unit& u, int wr, int wc, int fr, int fq) const {
        const int z = u.pm, n = z & 7, h = (z >> 3) & 3, b = z >> 5; const size_t t0 = (size_t)b * 2048 + n * 256;
#pragma unroll
        for (int ai = 0; ai < 2; ++ai)
#pragma unroll
            for (int m = 0; m < 4; ++m) {
                const int c = EPI_ROWS(ai, m);
#pragma unroll
                for (int bj = 0; bj < 2; ++bj) {
                    const int e0 = 128 * bj + 32 * wc + 8 * fq;
                    f32x4 v0 = acc[ai][bj][m][0], v1 = acc[ai][bj][m][1];
#pragma unroll
                    for (int j = 0; j < 4; ++j) { v0[j] = (c >= e0 + j) ? v0[j] : 0.f; v1[j] = (c >= e0 + 4 + j) ? v1[j] : 0.f; }
                    *(u32x4*)(AQ + ((t0 + c) * 4 + h) * 512 + e0) = pack8(v0, v1);
                }
            }
    }
};
struct EpiUT { static constexpr bool PERM = false;
    float* UT;
    DI void operator()(const Acc& acc, const Unit& u, int wr, int wc, int fr, int fq) const {
        const size_t z = (size_t)(u.pm >> 1); const int half = u.pm & 1;
#pragma unroll
        for (int ai = 0; ai < 2; ++ai)
#pragma unroll
            for (int m = 0; m < 4; ++m) {
                float* rowp = UT + z * 131072 + (size_t)(half * 256 + EPI_ROWS(ai, m)) * 256 + 32 * wc + 4 * fq;
#pragma unroll
                for (int bj = 0; bj < 2; ++bj)
#pragma unroll
                    for (int n = 0; n < 2; ++n) *(f32x4*)(rowp + 128 * bj + 16 * n) = acc[ai][bj][m][n];
            }
    }
};
struct EpiY { static constexpr bool PERM = true;
    bf16_t* Y;
    DI void operator()(const Acc& acc, const Unit& u, int wr, int wc, int fr, int fq) const {
        const int z = u.pm, n = z & 7, h = (z >> 3) & 3, b = z >> 5; const size_t t0 = (size_t)b * 2048 + n * 256;
#pragma unroll
        for (int ai = 0; ai < 2; ++ai)
#pragma unroll
            for (int m = 0; m < 4; ++m) {
                bf16_t* rowp = Y + (t0 + EPI_ROWS(ai, m)) * 2048 + h * 512 + u.pn * 256 + 32 * wc + 8 * fq;
#pragma unroll
                for (int bj = 0; bj < 2; ++bj) *(u32x4*)(rowp + 128 * bj) = pack8(acc[ai][bj][m][0], acc[ai][bj][m][1]);
            }
    }
};
struct EpiGU { static constexpr bool PERM = true;
    bf16_t* ACT; const float* bgu; const LAS int* ts;
    DI void operator()(const Acc& acc, const Unit& u, int wr, int wc, int fr, int fq) const {
        const int e = moe_tile_expert(ts, u.pm); const int w = 32 * wc + 8 * fq;
        const float* bp = bgu + (size_t)e * 2048 + 128 * u.pn + w;
        const f32x4 bg0 = *(const f32x4*)bp, bg1 = *(const f32x4*)(bp + 4), bl0 = *(const f32x4*)(bp + 1024), bl1 = *(const f32x4*)(bp + 1028);
#pragma unroll
        for (int ai = 0; ai < 2; ++ai)
#pragma unroll
            for (int m = 0; m < 4; ++m) {
                f32x4 g0 = acc[ai][0][m][0] + bg0, g1 = acc[ai][0][m][1] + bg1, l0 = acc[ai][1][m][0] + bl0, l1 = acc[ai][1][m][1] + bl1;
#pragma unroll
                for (int j = 0; j < 4; ++j) {
                    const float a = fminf(g0[j], 7.0f), c = fminf(g1[j], 7.0f);
                    const float la = fminf(fmaxf(l0[j], -7.0f), 7.0f), lc = fminf(fmaxf(l1[j], -7.0f), 7.0f);
                    g0[j] = a * sigm(1.702f * a) * (la + 1.0f); g1[j] = c * sigm(1.702f * c) * (lc + 1.0f); }
                *(u32x4*)(ACT + ((size_t)u.pm * 256 + EPI_ROWS(ai, m)) * 1024 + 128 * u.pn + w) = pack8(g0, g1);
            }
    }
};
struct EpiDN { static constexpr bool PERM = true;
    bf16_t* YB; const float* bdn; const LAS int* ts;
    DI void operator()(const Acc& acc, const Unit& u, int wr, int wc, int fr, int fq) const {
        const int e = moe_tile_expert(ts, u.pm);
#pragma unroll
        for (int bj = 0; bj < 2; ++bj) {
            const int col = 256 * u.pn + 128 * bj + 32 * wc + 8 * fq;
            const f32x4 b0 = *(const f32x4*)(bdn + (size_t)e * 1024 + col), b1 = *(const f32x4*)(bdn + (size_t)e * 1024 + col + 4);
#pragma unroll
            for (int ai = 0; ai < 2; ++ai)
#pragma unroll
                for (int m = 0; m < 4; ++m)
                    *(u32x4*)(YB + ((size_t)u.pm * 256 + EPI_ROWS(ai, m)) * 1024 + col) = pack8(acc[ai][bj][m][0] + b0, acc[ai][bj][m][1] + b1);
        }
    }
};
struct EpiPP { static constexpr bool PERM = true;
    bf16_t* PP;
    DI void operator()(const Acc& acc, const Unit& u, int wr, int wc, int fr, int fq) const {
#pragma unroll
        for (int ai = 0; ai < 2; ++ai)
#pragma unroll
            for (int m = 0; m < 4; ++m) {
                bf16_t* rowp = PP + ((size_t)u.pm * 256 + EPI_ROWS(ai, m)) * 1024 + u.pn * 256 + 32 * wc + 8 * fq;
#pragma unroll
                for (int bj = 0; bj < 2; ++bj) *(u32x4*)(rowp + 128 * bj) = pack8(acc[ai][bj][m][0], acc[ai][bj][m][1]);
            }
    }
};
struct EpiPLE { static constexpr bool PERM = false;
    float* H; const bf16_t* PP;
    DI void operator()(const Acc& acc, const Unit& u, int wr, int wc, int fr, int fq) const {
#pragma unroll
        for (int ai = 0; ai < 2; ++ai)
#pragma unroll
            for (int m = 0; m < 4; ++m) {
                const size_t off = (size_t)(u.pm * 256 + EPI_ROWS(ai, m)) * 1024 + u.pn * 256 + 32 * wc + 4 * fq;
#pragma unroll
                for (int bj = 0; bj < 2; ++bj)
#pragma unroll
                    for (int n = 0; n < 2; ++n) {
                        const size_t o = off + 128 * bj + 16 * n;
                        const u32x2 pw = *(const u32x2*)(PP + o); const f32x4 a = acc[ai][bj][m][n]; f32x4 hv = *(const f32x4*)(H + o);
                        hv[0] += sigm(a[0]) * bflo(pw.x); hv[1] += sigm(a[1]) * bfhi(pw.x); hv[2] += sigm(a[2]) * bflo(pw.y); hv[3] += sigm(a[3]) * bfhi(pw.y);
                        *(f32x4*)(H + o) = hv;
                    }
            }
    }
};

constexpr int AT_KSTR = 144;
template <int DV, int MODE>
DI void attn_unit(const int WID, LAS unsigned char* lds, const bf16_t* Qp, int ldq, const bf16_t* Kp, int ldk, const bf16_t* Vt, int ldvt, int q0, float slope,
                  const unsigned* selp, bf16_t* Op, int ldo, float* impp) {
    constexpr int NRB = DV / 32, VPIECES = DV * 8;
    constexpr int KB0 = 0, KB1 = 64 * AT_KSTR, VB0 = 2 * 64 * AT_KSTR, VB1 = VB0 + DV * AT_KSTR;
    const int tid = opaque_tid(WID), w = __builtin_amdgcn_readfirstlane(tid >> 6), lane = tid & 63, r = lane & 31, hh = lane >> 5;
    const int qrow = q0 + 32 * w + r, qw_first = q0 + 32 * w, qw_last = qw_first + 31;
    const float LOG2E = 1.44269504089f, sc = 0.125f * LOG2E, slope2 = slope * LOG2E;
    bf16x8 qf[4];
#pragma unroll
    for (int ks = 0; ks < 4; ++ks) qf[ks] = *(const bf16x8*)(Qp + (size_t)(32 * w + r) * ldq + 16 * ks + 8 * hh);
    unsigned selm = 0xffffffffu, orm = 0xffffffffu;
    if (MODE == 1) { selm = selp[32 * w + r]; orm = selm;
#pragma unroll
        for (int o = 1; o < 32; o <<= 1) orm |= __shfl_xor(orm, o); }
    const int nv = (MODE == 3) ? (qrow >= 31 ? ((qrow - 15) >> 4) : 0) : 0;
    const int nv_wmax = (MODE == 3) ? (qw_last >= 31 ? ((qw_last - 15) >> 4) : 0) : 0;
    int kt_lo = 0, kt_hi;
    if (MODE == 0 || MODE == 1) kt_hi = (q0 >> 6) + 4;
    else if (MODE == 2) { kt_hi = (q0 >> 6) + 4; const int lk = q0 - 511; kt_lo = lk > 0 ? (lk >> 6) : 0; }
    else kt_hi = 2;
    f32x16 O[NRB];
#pragma unroll
    for (int rb = 0; rb < NRB; ++rb)
#pragma unroll
        for (int i = 0; i < 16; ++i) O[rb][i] = 0.f;
    float mrun = NEGF, lrun = 0.f;
    u32x4 kreg, vreg[2];
    const int krow = tid >> 3, kpc = tid & 7;
#define AT_GLOAD(kt) do { kreg = *(const u32x4*)(Kp + (size_t)(64 * (kt) + krow) * ldk + 8 * kpc); \
        _Pragma("unroll") for (int i_ = 0; i_ < 2; ++i_) { const int idx = tid + 512 * i_; if (idx < VPIECES) vreg[i_] = *(const u32x4*)(Vt + (size_t)(idx >> 3) * ldvt + 64 * (kt) + 8 * (idx & 7)); } } while (0)
#define AT_LWRITE(buf) do { *(LAS u32x4*)(lds + ((buf) ? KB1 : KB0) + krow * AT_KSTR + kpc * 16) = kreg; \
        _Pragma("unroll") for (int i_ = 0; i_ < 2; ++i_) { const int idx = tid + 512 * i_; if (idx < VPIECES) *(LAS u32x4*)(lds + ((buf) ? VB1 : VB0) + (idx >> 3) * AT_KSTR + (idx & 7) * 16) = vreg[i_]; } } while (0)
    AT_GLOAD(kt_lo); AT_LWRITE(0);
    __syncthreads();
    const int ntile = kt_hi - kt_lo;
    for (int it = 0; it < ntile; ++it) {
        const int kt = kt_lo + it, buf = it & 1, key0 = 64 * kt;
        if (it + 1 < ntile) AT_GLOAD(kt + 1);
        bool skip;
        if (MODE == 0) skip = key0 > qw_last;
        else if (MODE == 1) skip = (key0 > qw_last) || !((orm >> kt) & 1u);
        else if (MODE == 2) skip = (key0 > qw_last) || (key0 + 63 < qw_first - 511);
        else skip = key0 >= nv_wmax;
        if (!skip) {
            const LAS unsigned char* kb = lds + (buf ? KB1 : KB0); const LAS unsigned char* vb = lds + (buf ? VB1 : VB0);
            f32x16 S[2];
#pragma unroll
            for (int kk = 0; kk < 2; ++kk) {
#pragma unroll
                for (int i = 0; i < 16; ++i) S[kk][i] = 0.f;
#pragma unroll
                for (int ks = 0; ks < 4; ++ks) { const bf16x8 a = *(const LAS bf16x8*)(kb + (32 * kk + r) * AT_KSTR + (16 * ks + 8 * hh) * 2);
                    S[kk] = __builtin_amdgcn_mfma_f32_32x32x16_bf16(a, qf[ks], S[kk], 0, 0, 0); }
            }
            float mx = NEGF;
#pragma unroll
            for (int kk = 0; kk < 2; ++kk)
#pragma unroll
                for (int i = 0; i < 16; ++i) {
                    const int key = key0 + 32 * kk + (i & 3) + 8 * (i >> 2) + 4 * hh;
                    const int dist = qrow - key; float v = S[kk][i] * sc; bool valid;
                    if (MODE == 0) { valid = dist >= 0; v -= slope2 * (float)dist; }
                    else if (MODE == 1) { valid = (dist >= 0) && ((selm >> kt) & 1u); v -= slope2 * (float)dist; }
                    else if (MODE == 2) { valid = (dist >= 0) && (dist < 512); v -= slope2 * (float)dist; }
                    else valid = key < nv;
                    v = valid ? v : NEGF; S[kk][i] = v; mx = fmaxf(mx, v);
                }
            mx = fmaxf(mx, __shfl_xor(mx, 32));
            const float mnew = fmaxf(mrun, mx), alpha = __builtin_amdgcn_exp2f(mrun - mnew); mrun = mnew;
            float ps = 0.f;
#pragma unroll
            for (int kk = 0; kk < 2; ++kk)
#pragma unroll
                for (int i = 0; i < 16; ++i) { const float p = __builtin_amdgcn_exp2f(S[kk][i] - mnew); S[kk][i] = p; ps += p; }
            lrun = lrun * alpha + ps;
#pragma unroll
            for (int rb = 0; rb < NRB; ++rb)
#pragma unroll
                for (int i = 0; i < 16; ++i) O[rb][i] *= alpha;
#pragma unroll
            for (int kk = 0; kk < 2; ++kk)
#pragma unroll
                for (int s = 0; s < 2; ++s) {
                    u32x4 pw; pw.x = pk2(S[kk][8 * s + 0], S[kk][8 * s + 1]); pw.y = pk2(S[kk][8 * s + 2], S[kk][8 * s + 3]);
                    pw.z = pk2(S[kk][8 * s + 4], S[kk][8 * s + 5]); pw.w = pk2(S[kk][8 * s + 6], S[kk][8 * s + 7]);
                    const bf16x8 pf = __builtin_bit_cast(bf16x8, pw);
                    const int k1 = 32 * kk + 16 * s + 4 * hh;
#pragma unroll
                    for (int rb = 0; rb < NRB; ++rb) {
                        const LAS unsigned char* vp = vb + (32 * rb + r) * AT_KSTR + k1 * 2;
                        const s16x4 lo = *(const LAS s16x4*)vp, hi = *(const LAS s16x4*)(vp + 16);
                        const bf16x8 a = __builtin_shufflevector(lo, hi, 0, 1, 2, 3, 4, 5, 6, 7);
                        O[rb] = __builtin_amdgcn_mfma_f32_32x32x16_bf16(a, pf, O[rb], 0, 0, 0);
                    }
                }
        }
        if (it + 1 < ntile) AT_LWRITE(buf ^ 1);
        __syncthreads();
    }
#undef AT_GLOAD
#undef AT_LWRITE
    const float ltot = lrun + __shfl_xor(lrun, 32);
    float inv = 1.0f / ltot;
    if (MODE == 3) inv = (nv > 0) ? inv : 0.f;
#pragma unroll
    for (int rb = 0; rb < NRB; ++rb)
#pragma unroll
        for (int g4 = 0; g4 < 4; ++g4) {
            const float a = O[rb][4 * g4] * inv, b = O[rb][4 * g4 + 1] * inv, c = O[rb][4 * g4 + 2] * inv, d = O[rb][4 * g4 + 3] * inv;
            const int dv = 32 * rb + 8 * g4 + 4 * hh;
            if (MODE == 3 && rb == 2) { *(f32x4*)(impp + (size_t)(32 * w + r) * 256 + (dv - 64)) = (f32x4){a, b, c, d}; }
            else { u32x2 o; o.x = pk2(a, b); o.y = pk2(c, d); *(u32x2*)(Op + (size_t)(32 * w + r) * ldo + dv) = o; }
        }
}

struct Args { const float* in[26]; float* out; unsigned char* ws; int ph_lo, ph_hi; };
typedef const __attribute__((address_space(4))) Args* ArgsP;
DI ArgsP opaque_args() { auto p = __builtin_amdgcn_kernarg_segment_ptr(); asm volatile("" : "+s"(p)); return (ArgsP)p; }
enum { I_X = 0, I_P, I_N1G, I_N2G, I_EVWIN, I_EVWOUT, I_DAQN, I_DAKN, I_DALAM, I_DAOUTG, I_NSQN, I_NSKN, I_CMPPE, I_CMPW1, I_CMPW2, I_ODWIN, I_ODWOUT,
       I_RETG, I_ROUTW, I_ROUTB, I_WGU, I_BGU, I_WDN, I_BDN, I_PLEP, I_PLEG };

struct CvtJob { int in_idx, ldsrc, K, col0, ncols, dstrow0, perm, nmat; size_t src_stride, dst_off, dst_stride; };
constexpr int NJOBS = 19;
__constant__ CvtJob c_jobs[NJOBS] = {
    {I_EVWIN, EVIN, 1024, 0,    1024, 0,    1, 2, (size_t)1024 * EVIN, WS_EVNAT, (size_t)2048 * 1024},
    {I_EVWIN, EVIN, 1024, 1536, 512,  1024, 1, 2, (size_t)1024 * EVIN, WS_EVNAT, (size_t)2048 * 1024},
    {I_EVWIN, EVIN, 1024, 2048, 128,  1536, 1, 2, (size_t)1024 * EVIN, WS_EVNAT, (size_t)2048 * 1024},
    {I_EVWIN, EVIN, 1024, 2176, 128,  1664, 1, 2, (size_t)1024 * EVIN, WS_EVNAT, (size_t)2048 * 1024},
    {I_EVWIN, EVIN, 1024, 2304, 128,  1792, 1, 2, (size_t)1024 * EVIN, WS_EVNAT, (size_t)2048 * 1024},
    {I_EVWIN, EVIN, 1024, 2560, 128,  1920, 1, 2, (size_t)1024 * EVIN, WS_EVNAT, (size_t)2048 * 1024},
    {I_EVWIN, EVIN, 1024, 1024, 512,  0,    0, 2, (size_t)1024 * EVIN, WS_EVSW,  (size_t)768 * 1024},
    {I_EVWIN, EVIN, 1024, 2432, 128,  512,  0, 2, (size_t)1024 * EVIN, WS_EVSW,  (size_t)768 * 1024},
    {I_EVWIN, EVIN, 1024, 2688, 128,  640,  0, 2, (size_t)1024 * EVIN, WS_EVSW,  (size_t)768 * 1024},
    {I_EVWOUT, 1024, 1024, 0, 1024, 0, 0, 2, (size_t)1024 * 1024, WS_EVOUT, (size_t)1024 * 1024},
    {I_CMPW1, 256, 2048, 0, 256, 0, 0, 4, (size_t)2048 * 256, WS_CMP1, (size_t)256 * 2048},
    {I_ODWIN, ODIN, 1024, 0,    2048, 0,    0, 2, (size_t)1024 * ODIN, WS_ODNAT, (size_t)4096 * 1024},
    {I_ODWIN, ODIN, 1024, 4096, 2048, 2048, 0, 2, (size_t)1024 * ODIN, WS_ODNAT, (size_t)4096 * 1024},
    {I_ODWIN, ODIN, 1024, 1024, 3072, 0,    0, 2, (size_t)1024 * ODIN, WS_ODSW,  (size_t)3072 * 1024},
    {I_ODWOUT, 1024, 2048, 0, 1024, 0, 0, 2, (size_t)2048 * 1024, WS_ODOUT, (size_t)1024 * 2048},
    {I_WGU, 2048, 1024, 0, 2048, 0, 2, 128, (size_t)1024 * 2048, WS_WGU, (size_t)2048 * 1024},
    {I_WDN, 1024, 1024, 0, 1024, 0, 0, 128, (size_t)1024 * 1024, WS_WDN, (size_t)1024 * 1024},
    {I_PLEP, 1024, 256, 0, 1024, 0, 0, 4, (size_t)256 * 1024, WS_WPP, (size_t)1024 * 256},
    {I_PLEG, 1024, 1024, 0, 1024, 0, 0, 4, (size_t)1024 * 1024, WS_WPG, (size_t)1024 * 1024},
};
DI int cvt_dstrow(int perm, int L) {
    if (perm == 1) { const int pn = L >> 8, lc = L & 255; return pn * 256 + 128 * ((lc & 63) >> 5) + 32 * (lc >> 6) + (lc & 31); }
    if (perm == 2) { const int bj = L >> 10, cc = L & 1023; return 256 * (cc >> 7) + 128 * bj + (cc & 127); }
    return L;
}
DI void phase_prologue(const int WID, ArgsP a, LAS unsigned char* lds) {
    const int tid = opaque_tid(WID), lane = tid & 63, wv = tid >> 6;
    const int gw = blockIdx.x * 8 + wv, NGW = gridDim.x * 8;
    LAS float* scr = (LAS float*)(lds + wv * 16640);
    int total = 0;
    for (int j = 0; j < NJOBS; ++j) total += c_jobs[j].nmat * (c_jobs[j].K >> 6) * (c_jobs[j].ncols >> 6);
    for (int it = gw; it < total; it += NGW) {
        int r = it, j = 0;
        for (; j < NJOBS; ++j) { const int n = c_jobs[j].nmat * (c_jobs[j].K >> 6) * (c_jobs[j].ncols >> 6); if (r < n) break; r -= n; }
        const CvtJob J = c_jobs[j];
        const int nkb = J.K >> 6, nnb = J.ncols >> 6, per = nkb * nnb;
        const int mat = r / per, rr = r % per, kb = rr / nnb, nb = rr % nnb, k0 = kb * 64, n0 = nb * 64;
        const float* src = a->in[J.in_idx] + (size_t)mat * J.src_stride + (size_t)k0 * J.ldsrc + J.col0 + n0 + lane;
        { float tv[64];
#pragma unroll
          for (int i = 0; i < 64; ++i) tv[i] = src[(size_t)i * J.ldsrc];
#pragma unroll
          for (int i = 0; i < 64; ++i) scr[i * 65 + lane] = tv[i]; }
        asm volatile("s_waitcnt lgkmcnt(0)" ::: "memory");
        bf16_t* dst = (bf16_t*)(a->ws + J.dst_off) + (size_t)mat * J.dst_stride;
        const int c = lane & 7, nsub = lane >> 3;
#pragma unroll
        for (int jj = 0; jj < 8; ++jj) {
            const int n = nsub + 8 * jj; const LAS float* s = scr + (8 * c) * 65 + n;
            u32x4 o; o.x = pk2(s[0], s[65]); o.y = pk2(s[2 * 65], s[3 * 65]); o.z = pk2(s[4 * 65], s[5 * 65]); o.w = pk2(s[6 * 65], s[7 * 65]);
            const int drow = cvt_dstrow(J.perm, J.dstrow0 + n0 + n);
            *(u32x4*)(dst + (size_t)drow * J.K + k0 + 8 * c) = o;
        }
        asm volatile("s_waitcnt lgkmcnt(0)" ::: "memory");
    }
    {
        const float* p = a->in[I_P]; bf16_t* pb = (bf16_t*)(a->ws + WS_PBF);
        const size_t n8 = (size_t)DEPTH * T * 256 / 8;
        for (size_t i = (size_t)blockIdx.x * 512 + tid; i < n8; i += (size_t)gridDim.x * 512) {
            const f32x4 v0 = *(const f32x4*)(p + i * 8), v1 = *(const f32x4*)(p + i * 8 + 4);
            *(u32x4*)(pb + i * 8) = pack8(v0, v1);
        }
    }
    if (blockIdx.x == 4 && tid < 512) { const int ev = tid >> 8, gi = (tid >> 6) & 3, d = tid & 63;
        const float* src = a->in[gi == 0 ? I_DAQN : gi == 1 ? I_DAKN : gi == 2 ? I_NSQN : I_NSKN];
        ((float*)(a->ws + WS_GAINS))[tid] = src[ev * 64 + d]; }
    if (blockIdx.x < 4 && tid < 256) {
        const int m = blockIdx.x; const float* pe = a->in[I_CMPPE] + (size_t)m * 2048; const float* w1 = a->in[I_CMPW1] + (size_t)m * 2048 * 256;
        float s = 0.f;
        for (int k = 0; k < 2048; ++k) s += pe[k] * w1[(size_t)k * 256 + tid];
        ((float*)(a->ws + WS_BIAS1))[m * 256 + tid] = s;
    }
}

DI float row_load_ss(const float* row, int lane, f32x4 (&v)[4]) {
    float ss = 0.f;
#pragma unroll
    for (int j = 0; j < 4; ++j) { v[j] = *(const f32x4*)(row + 4 * lane + 256 * j); ss += (v[j][0] * v[j][0] + v[j][1] * v[j][1]) + (v[j][2] * v[j][2] + v[j][3] * v[j][3]); }
    return wave_sum(ss);
}
DI void row_store_bf16(bf16_t* row, int lane, const f32x4 (&v)[4]) {
#pragma unroll
    for (int j = 0; j < 4; ++j) { u32x2 o; o.x = pk2(v[j][0], v[j][1]); o.y = pk2(v[j][2], v[j][3]); *(u32x2*)(row + 4 * lane + 256 * j) = o; }
}
template <int MODE>
DI void phase_norm(const int WID, ArgsP a, LAS unsigned char* lds, int layer, const float* Hin) {
    const int tid = opaque_tid(WID), lane = tid & 63, wv = __builtin_amdgcn_readfirstlane(tid >> 6);
    LAS float* wt = (LAS float*)lds;
    LAS int* bcl = (LAS int*)(lds + MISC_OFF + MO_WCNT); LAS int* ent = (LAS int*)(lds + MISC_OFF + MO_ENT); LAS float* gat = (LAS float*)(lds + MISC_OFF + MO_GAT);
    LAS float* lgb = (LAS float*)(lds + MISC_OFF + MO_RED);
    bf16_t* XN = (bf16_t*)(a->ws + WS_XN);
    const float* gain = a->in[MODE == 2 ? I_N2G : I_N1G] + layer * 1024;
    constexpr int NQ = MODE == 0 ? 24 : (MODE == 2 ? 32 : 0);
    if (NQ > 0) {
        const float* w = (MODE == 0) ? a->in[I_EVWIN] + (size_t)(layer >> 1) * 1024 * EVIN + 2816 : a->in[I_ROUTW] + (size_t)layer * 1024 * 32;
        const int ldw = (MODE == 0) ? EVIN : 32;
        for (int i = tid; i < 256 * 32; i += 512) { const int q = i & 31, g = i >> 5;
            if (q < NQ) { f32x4 v; v[0] = w[(size_t)(4 * g) * ldw + q]; v[1] = w[(size_t)(4 * g + 1) * ldw + q]; v[2] = w[(size_t)(4 * g + 2) * ldw + q]; v[3] = w[(size_t)(4 * g + 3) * ldw + q];
                *(LAS f32x4*)(wt + q * 1024 + 4 * (g ^ q)) = v; } }
    }
    f32x4 gn[4];
#pragma unroll
    for (int j = 0; j < 4; ++j) gn[j] = *(const f32x4*)(gain + 4 * lane + 256 * j);
    const float rbias = (MODE == 2) ? a->in[I_ROUTB][layer * 32 + (lane & 31)] : 0.f;
    __syncthreads();
    for (int vb = blockIdx.x; vb < NTB; vb += gridDim.x) {
        if (MODE == 2) { if (tid < 32) bcl[tid] = 0; }
        const int t0 = vb * 128 + wv * 16;
        f32x4 na[4], nb[4];
#pragma unroll
        for (int j = 0; j < 4; ++j) { na[j] = *(const f32x4*)(Hin + (size_t)t0 * 1024 + 4 * lane + 256 * j); nb[j] = *(const f32x4*)(Hin + (size_t)(t0 + 1) * 1024 + 4 * lane + 256 * j); }
#pragma unroll 1
        for (int it = 0; it < 8; ++it) {
            const int ta = t0 + 2 * it;
            f32x4 va[4], vc[4];
#pragma unroll
            for (int j = 0; j < 4; ++j) { va[j] = na[j]; vc[j] = nb[j]; }
            if (it < 7) {
#pragma unroll
                for (int j = 0; j < 4; ++j) { na[j] = *(const f32x4*)(Hin + (size_t)(ta + 2) * 1024 + 4 * lane + 256 * j); nb[j] = *(const f32x4*)(Hin + (size_t)(ta + 3) * 1024 + 4 * lane + 256 * j); }
            }
            float sa = 0.f, sb = 0.f;
#pragma unroll
            for (int j = 0; j < 4; ++j) { sa += (va[j][0] * va[j][0] + va[j][1] * va[j][1]) + (va[j][2] * va[j][2] + va[j][3] * va[j][3]); sb += (vc[j][0] * vc[j][0] + vc[j][1] * vc[j][1]) + (vc[j][2] * vc[j][2] + vc[j][3] * vc[j][3]); }
#pragma unroll
            for (int o = 1; o < 64; o <<= 1) { sa += __shfl_xor(sa, o); sb += __shfl_xor(sb, o); }
            const float ra = rsqrtf(sa * (1.0f / 1024.0f) + EPS), rb2 = rsqrtf(sb * (1.0f / 1024.0f) + EPS);
#pragma unroll
            for (int j = 0; j < 4; ++j) { va[j] = va[j] * ra * gn[j]; vc[j] = vc[j] * rb2 * gn[j]; }
            row_store_bf16(XN + (size_t)ta * 1024, lane, va); row_store_bf16(XN + (size_t)(ta + 1) * 1024, lane, vc);
            if (NQ > 0) {
                float x[64];
#pragma unroll
                for (int q = 0; q < 32; ++q) {
                    if (q < NQ) { float s0 = 0.f, s1 = 0.f;
#pragma unroll
                        for (int j = 0; j < 4; ++j) { const f32x4 ww = *(const LAS f32x4*)(wt + q * 1024 + 4 * ((lane + 64 * j) ^ q));
                            s0 += (va[j][0] * ww[0] + va[j][1] * ww[1]) + (va[j][2] * ww[2] + va[j][3] * ww[3]); s1 += (vc[j][0] * ww[0] + vc[j][1] * ww[1]) + (vc[j][2] * ww[2] + vc[j][3] * ww[3]); }
                        x[q] = s0; x[32 + q] = s1;
                        if ((q & 3) == 3) asm volatile("" ::: "memory");
                    } else { x[q] = 0.f; x[32 + q] = 0.f; }
                }
#define RS_STEP(N, BIT) _Pragma("unroll") for (int i = 0; i < (N); ++i) { const bool up = (lane & (BIT)) != 0; const float keep = up ? x[(N) + i] : x[i], send = up ? x[i] : x[(N) + i]; x[i] = keep + __shfl_xor(send, (BIT)); }
                RS_STEP(32, 32) RS_STEP(16, 16) RS_STEP(8, 8) RS_STEP(4, 4) RS_STEP(2, 2) RS_STEP(1, 1)
#undef RS_STEP
                const float val = x[0];
                if (MODE == 0) { if ((lane & 31) < 24) ((float*)(a->ws + WS_GATES))[(size_t)(ta + (lane >> 5)) * 24 + (lane & 31)] = sigm(val); }
                if (MODE == 2) {
                    lgb[wv * 64 + lane] = val + rbias;
                    asm volatile("s_waitcnt lgkmcnt(0)" ::: "memory");
                    float lg[32];
#pragma unroll
                    for (int q4 = 0; q4 < 8; ++q4) { const f32x4 t4 = *(const LAS f32x4*)(lgb + wv * 64 + (lane & 32) + 4 * q4); lg[4 * q4] = t4[0]; lg[4 * q4 + 1] = t4[1]; lg[4 * q4 + 2] = t4[2]; lg[4 * q4 + 3] = t4[3]; }
                    unsigned used = 0u; int te[4]; float tv[4];
#pragma unroll
                    for (int k = 0; k < 4; ++k) { float best = -3.0e38f; int bi = 0;
#pragma unroll
                        for (int q = 0; q < 32; ++q) { const bool ok = !((used >> q) & 1u) && (lg[q] > best); best = ok ? lg[q] : best; bi = ok ? q : bi; }
                        used |= 1u << bi; te[k] = bi; tv[k] = best; }
                    float ex[4], sum = 0.f;
#pragma unroll
                    for (int k = 0; k < 4; ++k) { ex[k] = __expf(tv[k] - tv[0]); sum += ex[k]; }
                    const float rs = 1.0f / sum;
                    if ((lane & 31) == 0) {
                        const int eb = wv * 64 + (2 * it + (lane >> 5)) * 4;
#pragma unroll
                        for (int k = 0; k < 4; ++k) { ent[eb + k] = te[k]; gat[eb + k] = ex[k] * rs; }
                    }
                    asm volatile("s_waitcnt lgkmcnt(0)" ::: "memory");
                }
            }
        }
        if (MODE == 2) {
            __syncthreads();
            { const int e = ent[wv * 64 + lane];
              const int pos = __hip_atomic_fetch_add(bcl + e, 1, __ATOMIC_RELAXED, __HIP_MEMORY_SCOPE_WORKGROUP);
              const size_t idx = (size_t)(vb * 128 + wv * 16) * 4 + lane;
              ((int*)(a->ws + WS_TOPE))[idx] = e; ((int*)(a->ws + WS_POSB))[idx] = pos; ((float*)(a->ws + WS_GATEW))[idx] = gat[wv * 64 + lane]; }
            __syncthreads();
            if (tid < 32) ((int*)(a->ws + WS_BCNT))[((size_t)layer * NTB + vb) * 32 + tid] = bcl[tid];
            __syncthreads();
        }
    }
}
DI void moe_tables(const int WID, ArgsP a, LAS unsigned char* lds, int layer, int vb) {
    const int tid = opaque_tid(WID);
    LAS int* tot = (LAS int*)(lds + MISC_OFF + MO_TOT); LAS int* base = (LAS int*)(lds + MISC_OFF + MO_BASE); LAS int* ts = (LAS int*)(lds + MISC_OFF + MO_TS);
    LAS int* red = (LAS int*)(lds + MISC_OFF + MO_RED);
    const int* bc = (const int*)(a->ws + WS_BCNT) + (size_t)layer * NTB * 32;
    { const int e = tid & 31, part = tid >> 5; int st = 0, sp = 0;
      for (int blk = part; blk < NTB; blk += 16) { const int v = bc[blk * 32 + e]; st += v; sp += (blk < vb) ? v : 0; }
      red[part * 32 + e] = st; red[512 + part * 32 + e] = sp; }
    __syncthreads();
    if (tid < 32) { int st = 0, sp = 0;
#pragma unroll
        for (int p = 0; p < 16; ++p) { st += red[p * 32 + tid]; sp += red[512 + p * 32 + tid]; }
        tot[tid] = st; base[tid] = sp; }
    __syncthreads();
    if (tid == 0) { int acc = 0; for (int e = 0; e < 32; ++e) { ts[e] = acc; acc += (tot[e] + 255) >> 8; } ts[32] = acc; }
    __syncthreads();
}
DI void phase_moe_slots(const int WID, ArgsP a, LAS unsigned char* lds, int layer) {
    const int tid = opaque_tid(WID), lane = tid & 63, wv = tid >> 6;
    LAS int* base = (LAS int*)(lds + MISC_OFF + MO_BASE); LAS int* ts = (LAS int*)(lds + MISC_OFF + MO_TS);
    const bf16_t* XN = (const bf16_t*)(a->ws + WS_XN); bf16_t* XB = (bf16_t*)(a->ws + WS_XB);
    for (int vb = blockIdx.x; vb < NTB; vb += gridDim.x) {
        moe_tables(WID, a, lds, layer, vb);
#pragma unroll 1
        for (int i = 0; i < 16; ++i) {
            const int t = vb * 128 + wv * 16 + i;
            int dest = 0;
            if (lane < 4) { const int e = ((const int*)(a->ws + WS_TOPE))[(size_t)t * 4 + lane], pos = ((const int*)(a->ws + WS_POSB))[(size_t)t * 4 + lane];
                dest = ts[e] * 256 + base[e] + pos; ((int*)(a->ws + WS_DEST))[(size_t)t * 4 + lane] = dest; }
            const u32x4 r0 = *(const u32x4*)(XN + (size_t)t * 1024 + 8 * lane), r1 = *(const u32x4*)(XN + (size_t)t * 1024 + 512 + 8 * lane);
#pragma unroll
            for (int k = 0; k < 4; ++k) { const int d = __shfl(dest, k); bf16_t* o = XB + (size_t)d * 1024; *(u32x4*)(o + 8 * lane) = r0; *(u32x4*)(o + 512 + 8 * lane) = r1; }
        }
        __syncthreads();
    }
}
DI void phase_combine(const int WID, ArgsP a, float* H) {
    const int tid = opaque_tid(WID), lane = tid & 63, wv = tid >> 6;
    const bf16_t* YB = (const bf16_t*)(a->ws + WS_YB); bf16_t* XN = (bf16_t*)(a->ws + WS_XN);
    for (int t = blockIdx.x * 8 + wv; t < T; t += gridDim.x * 8) {
        int dest = 0; float gw = 0.f;
        if (lane < 4) { dest = ((const int*)(a->ws + WS_DEST))[(size_t)t * 4 + lane]; gw = ((const float*)(a->ws + WS_GATEW))[(size_t)t * 4 + lane]; }
        f32x4 v[4];
#pragma unroll
        for (int j = 0; j < 4; ++j) v[j] = *(const f32x4*)(H + (size_t)t * 1024 + 4 * lane + 256 * j);
#pragma unroll
        for (int k = 0; k < 4; ++k) { const int d = __shfl(dest, k); const float g = __shfl(gw, k); const bf16_t* y = YB + (size_t)d * 1024;
#pragma unroll
            for (int j = 0; j < 4; ++j) { const u32x2 w = *(const u32x2*)(y + 4 * lane + 256 * j); v[j][0] += g * bflo(w.x); v[j][1] += g * bfhi(w.x); v[j][2] += g * bflo(w.y); v[j][3] += g * bfhi(w.y); } }
        float ss = 0.f;
#pragma unroll
        for (int j = 0; j < 4; ++j) { *(f32x4*)(H + (size_t)t * 1024 + 4 * lane + 256 * j) = v[j]; ss += (v[j][0] * v[j][0] + v[j][1] * v[j][1]) + (v[j][2] * v[j][2] + v[j][3] * v[j][3]); }
        ss = wave_sum(ss);
        const float rstd = rsqrtf(ss * (1.0f / 1024.0f) + EPS);
#pragma unroll
        for (int j = 0; j < 4; ++j) v[j] = v[j] * rstd;
        row_store_bf16(XN + (size_t)t * 1024, lane, v);
    }
}
DI void phase_cmp2(const int WID, ArgsP a, LAS unsigned char* lds, int ev) {
    const int tid = opaque_tid(WID), lane = tid & 63, wv = __builtin_amdgcn_readfirstlane(tid >> 6);
    const bf16_t* HID = (const bf16_t*)(a->ws + WS_HID); bf16_t* KCMP = (bf16_t*)(a->ws + WS_KCMP); bf16_t* VCMPT = (bf16_t*)(a->ws + WS_VCMPT);
    const float kg = a->in[I_NSKN][ev * 64 + lane];
    LAS float* wl = (LAS float*)lds;
    for (int i = tid; i < 2 * 256 * 64 / 4; i += 512) *(LAS f32x4*)(wl + 4 * i) = *(const f32x4*)(a->in[I_CMPW2] + (size_t)ev * 2 * 256 * 64 + 4 * i);
    __syncthreads();
    for (int gi = blockIdx.x * 8 + wv; gi < 2048; gi += gridDim.x * 8) {
        const int kv = gi >> 10, row0 = (gi & 1023) * 4;
        const bf16_t* hrow = HID + ((size_t)kv * 4096 + row0) * 256;
        const LAS float* w2 = wl + kv * 256 * 64 + lane;
        float s[4] = {0.f, 0.f, 0.f, 0.f};
#pragma unroll 2
        for (int k = 0; k < 256; k += 8) {
            u32x4 hw[4];
#pragma unroll
            for (int r = 0; r < 4; ++r) hw[r] = *(const u32x4*)(hrow + r * 256 + k);
            float wv8[8];
#pragma unroll
            for (int j = 0; j < 8; ++j) wv8[j] = w2[(k + j) * 64];
#pragma unroll
            for (int r = 0; r < 4; ++r)
                s[r] += bflo(hw[r].x) * wv8[0] + bfhi(hw[r].x) * wv8[1] + bflo(hw[r].y) * wv8[2] + bfhi(hw[r].y) * wv8[3] + bflo(hw[r].z) * wv8[4] + bfhi(hw[r].z) * wv8[5] + bflo(hw[r].w) * wv8[6] + bfhi(hw[r].w) * wv8[7];
        }
#pragma unroll
        for (int r = 0; r < 4; ++r) {
            const int row = row0 + r, bg = row >> 7, n = row & 127;
            float v = (n == 127) ? 0.f : s[r];
            if (kv == 0) { const float ss = wave_sum(v * v); const float o = v * rsqrtf(ss * (1.0f / 64.0f) + EPS) * kg;
                KCMP[((size_t)bg * 128 + n) * 64 + lane] = (bf16_t)(pk2(o, 0.f) & 0xffffu); }
            else VCMPT[((size_t)bg * 96 + lane) * 128 + n] = (bf16_t)(pk2(v, 0.f) & 0xffffu);
        }
    }
    for (int i = blockIdx.x * 512 + tid; i < 32 * 32 * 128; i += gridDim.x * 512) {
        const int n = i & 127, j = (i >> 7) & 31, bg = i >> 12;
        float o = 0.f;
        if (n < 127) { const int d = n - 4 * j; if (d >= 0 && d <= 2) o = 1.0f; else if (d == 3 || d == -1) o = 0.5f; }
        VCMPT[((size_t)bg * 96 + 64 + j) * 128 + n] = (bf16_t)(pk2(o, 0.f) & 0xffffu);
    }
}
DI void phase_topk(const int WID, ArgsP a) {
    const float* IMPH = (const float*)(a->ws + WS_IMPH); unsigned* SELM = (unsigned*)(a->ws + WS_SELM);
    for (int i = blockIdx.x * 512 + opaque_tid(WID); i < T * 2; i += gridDim.x * 512) {
        const int t = i >> 1, g = i & 1, b = t >> 11, s = t & 2047, cur = s >> 6;
        float sc[32];
#pragma unroll
        for (int j4 = 0; j4 < 8; ++j4) { f32x4 acc = {0.f, 0.f, 0.f, 0.f};
#pragma unroll
            for (int r = 0; r < 4; ++r) acc += *(const f32x4*)(IMPH + ((size_t)t * 8 + g * 4 + r) * 32 + 4 * j4);
#pragma unroll
            for (int q = 0; q < 4; ++q) sc[4 * j4 + q] = acc[q]; }
        unsigned mask;
        if (cur < 16) mask = (cur == 31) ? 0xffffffffu : ((2u << cur) - 1u);
        else {
#pragma unroll
            for (int j = 0; j < 32; ++j) { const bool forced = (j == 0) || (j == cur) || (j == cur - 1); sc[j] = (j > cur) ? NEGF : (sc[j] + (forced ? 1e4f : 0.f)); }
            mask = 0u;
#pragma unroll
            for (int j = 0; j < 32; ++j) { int rank = 0;
#pragma unroll
                for (int k = 0; k < 32; ++k) rank += ((sc[k] > sc[j]) || (sc[k] == sc[j] && k < j)) ? 1 : 0;
                mask |= (rank < 16) ? (1u << j) : 0u; }
        }
        SELM[((size_t)(b * 2 + g)) * 2048 + s] = mask;
    }
}
DI void phase_mixprep(const int WID, ArgsP a, int layer) {
    const int tid = opaque_tid(WID), lane = tid & 63, wv = tid >> 6, ev = layer >> 1;
    const float* dl = a->in[I_DALAM] + ev * 256;
    const float s1 = wave_sum(dl[lane] * dl[64 + lane]), s2 = wave_sum(dl[128 + lane] * dl[192 + lane]);
    const float lam_init = 0.8f - 0.6f * expf(-0.3f * (float)layer);
    const float lam = expf(s1) - expf(s2) + lam_init;
    const float* og = a->in[I_DAOUTG] + ev * 128;
    const bf16_t* OD = (const bf16_t*)(a->ws + WS_OD); const bf16_t* OC = (const bf16_t*)(a->ws + WS_OC); const bf16_t* OS = (const bf16_t*)(a->ws + WS_OS); const bf16_t* OW = (const bf16_t*)(a->ws + WS_OW);
    const float* GT = (const float*)(a->ws + WS_GATES); bf16_t* AMIX = (bf16_t*)(a->ws + WS_AMIX);
    const int h = lane >> 4, dv = (lane & 15) * 8;
    f32x4 g0 = *(const f32x4*)(og + dv), g1 = *(const f32x4*)(og + dv + 4);
    for (int t = blockIdx.x * 8 + wv; t < T; t += gridDim.x * 8) {
        { const u32x4 w1 = *(const u32x4*)(OD + (size_t)t * 1024 + h * 128 + dv), w2 = *(const u32x4*)(OD + (size_t)t * 1024 + (4 + h) * 128 + dv);
          f32x4 d0, d1;
          d0[0] = bflo(w1.x) - lam * bflo(w2.x); d0[1] = bfhi(w1.x) - lam * bfhi(w2.x); d0[2] = bflo(w1.y) - lam * bflo(w2.y); d0[3] = bfhi(w1.y) - lam * bfhi(w2.y);
          d1[0] = bflo(w1.z) - lam * bflo(w2.z); d1[1] = bfhi(w1.z) - lam * bfhi(w2.z); d1[2] = bflo(w1.w) - lam * bflo(w2.w); d1[3] = bfhi(w1.w) - lam * bfhi(w2.w);
          float ss = (d0[0] * d0[0] + d0[1] * d0[1]) + (d0[2] * d0[2] + d0[3] * d0[3]) + (d1[0] * d1[0] + d1[1] * d1[1]) + (d1[2] * d1[2] + d1[3] * d1[3]);
          ss += __shfl_xor(ss, 1); ss += __shfl_xor(ss, 2); ss += __shfl_xor(ss, 4); ss += __shfl_xor(ss, 8);
          const float rs = rsqrtf(ss * (1.0f / 128.0f) + EPS) * (1.0f - lam_init);
          *(u32x4*)(AMIX + (size_t)t * 1024 + h * 128 + dv) = pack8(d0 * rs * g0, d1 * rs * g1); }
        { const int hd = lane >> 3, dq = (lane & 7) * 8; const size_t o = (size_t)t * 512 + hd * 64 + dq;
          const float ga = GT[(size_t)t * 24 + hd * 3], gb = GT[(size_t)t * 24 + hd * 3 + 1], gc = GT[(size_t)t * 24 + hd * 3 + 2];
          const u32x4 c = *(const u32x4*)(OC + o), s = *(const u32x4*)(OS + o), w = *(const u32x4*)(OW + o);
          f32x4 r0, r1;
          r0[0] = ga * bflo(c.x) + gb * bflo(s.x) + gc * bflo(w.x); r0[1] = ga * bfhi(c.x) + gb * bfhi(s.x) + gc * bfhi(w.x);
          r0[2] = ga * bflo(c.y) + gb * bflo(s.y) + gc * bflo(w.y); r0[3] = ga * bfhi(c.y) + gb * bfhi(s.y) + gc * bfhi(w.y);
          r1[0] = ga * bflo(c.z) + gb * bflo(s.z) + gc * bflo(w.z); r1[1] = ga * bfhi(c.z) + gb * bfhi(s.z) + gc * bfhi(w.z);
          r1[2] = ga * bflo(c.w) + gb * bflo(s.w) + gc * bflo(w.w); r1[3] = ga * bfhi(c.w) + gb * bfhi(s.w) + gc * bfhi(w.w);
          *(u32x4*)(AMIX + (size_t)t * 1024 + 512 + hd * 64 + dq) = pack8(r0, r1); }
    }
}
DI void phase_scan(const int WID, ArgsP a) {
    const float* UT = (const float*)(a->ws + WS_UT); bf16_t* VS = (bf16_t*)(a->ws + WS_VS);
    for (int i = blockIdx.x * 512 + opaque_tid(WID); i < 64 * 512 * 64; i += gridDim.x * 512) {
        const int d4 = i & 63, f = (i >> 6) & 511, bh = i >> 15, h = bh & 3;
        const float dec = exp2f(256.0f * ret_lg2(h));
        f32x4 S = {0.f, 0.f, 0.f, 0.f};
#pragma unroll 1
        for (int n = 0; n < 8; ++n) {
            const size_t z = (size_t)bh * 8 + n;
            u32x2 o; o.x = pk2(S[0], S[1]); o.y = pk2(S[2], S[3]);
            *(u32x2*)(VS + (z * 512 + f) * 512 + 256 + 4 * d4) = o;
            const f32x4 u = *(const f32x4*)(UT + z * 131072 + (size_t)f * 256 + 4 * d4);
            S = (S + u) * dec;
        }
    }
}
DI void phase_normgate(const int WID, ArgsP a, int od) {
    const int tid = opaque_tid(WID), lane = tid & 63, wv = tid >> 6;
    const bf16_t* Y = (const bf16_t*)(a->ws + WS_Y); const bf16_t* GG = (const bf16_t*)(a->ws + WS_GG); bf16_t* YG = (bf16_t*)(a->ws + WS_YG);
    const float* og = a->in[I_RETG] + od * 512;
    const f32x4 g0 = *(const f32x4*)(og + 8 * lane), g1 = *(const f32x4*)(og + 8 * lane + 4);
    for (int t = blockIdx.x * 8 + wv; t < T; t += gridDim.x * 8) {
#pragma unroll
        for (int h = 0; h < 4; ++h) {
            const size_t o = (size_t)t * 2048 + h * 512 + 8 * lane;
            const u32x4 yw = *(const u32x4*)(Y + o), gw = *(const u32x4*)(GG + o);
            f32x4 y0 = {bflo(yw.x), bfhi(yw.x), bflo(yw.y), bfhi(yw.y)}, y1 = {bflo(yw.z), bfhi(yw.z), bflo(yw.w), bfhi(yw.w)};
            const f32x4 q0 = {bflo(gw.x), bfhi(gw.x), bflo(gw.y), bfhi(gw.y)}, q1 = {bflo(gw.z), bfhi(gw.z), bflo(gw.w), bfhi(gw.w)};
            float ss = (y0[0] * y0[0] + y0[1] * y0[1]) + (y0[2] * y0[2] + y0[3] * y0[3]) + (y1[0] * y1[0] + y1[1] * y1[1]) + (y1[2] * y1[2] + y1[3] * y1[3]);
            ss = wave_sum(ss);
            const float rs = rsqrtf(ss * (1.0f / 512.0f) + EPS);
            *(u32x4*)(YG + o) = pack8(y0 * rs * g0 * q0, y1 * rs * g1 * q1);
        }
    }
}
DI int snake_unit(int rnd, int G, int c) { return (rnd & 1) ? rnd * G + (G - 1 - c) : rnd * G + c; }
template <int MODE>
DI void phase_attn(const int WID, ArgsP a, LAS unsigned char* lds) {
    const int G = gridDim.x, c = blockIdx.x;
    const bf16_t* QD = (const bf16_t*)(a->ws + WS_QD); const bf16_t* KD = (const bf16_t*)(a->ws + WS_KD); const bf16_t* QN = (const bf16_t*)(a->ws + WS_QN);
    for (int rnd = 0;; ++rnd) {
        const int L = snake_unit(rnd, G, c); if (L >= 1024) { if (rnd * G >= 1024) break; else continue; }
        const int qb = 7 - (L >> 7), bh = L & 127, b = bh >> 3, hd = bh & 7, q0 = qb * 256; const size_t t0 = (size_t)b * 2048 + q0;
        if (MODE == 0) {
            const float slope = exp2f(-2.0f * (float)((hd & 3) + 1));
            attn_unit<128, 0>(WID, lds, QD + t0 * 512 + hd * 64, 512, KD + (size_t)b * 2048 * 512 + hd * 64, 512,
                              (const bf16_t*)(a->ws + WS_VAT) + (size_t)(b * 4 + (hd & 3)) * 128 * 2048, 2048, q0, slope, nullptr,
                              (bf16_t*)(a->ws + WS_OD) + t0 * 1024 + hd * 128, 1024, nullptr);
        } else if (MODE == 1 || MODE == 2) {
            const int g = hd >> 2; const float slope = exp2f(-(float)(hd + 1));
            const bf16_t* Kb = (const bf16_t*)(a->ws + (MODE == 1 ? WS_KSB : WS_KWB)) + (size_t)(b * 2 + g) * 2048 * 64;
            const bf16_t* Vb = (const bf16_t*)(a->ws + (MODE == 1 ? WS_VST : WS_VWT)) + (size_t)(b * 2 + g) * 64 * 2048;
            attn_unit<64, MODE>(WID, lds, QN + t0 * 512 + hd * 64, 512, Kb, 64, Vb, 2048, q0, slope,
                                (const unsigned*)(a->ws + WS_SELM) + (size_t)(b * 2 + g) * 2048 + q0,
                                (bf16_t*)(a->ws + (MODE == 1 ? WS_OS : WS_OW)) + t0 * 512 + hd * 64, 512, nullptr);
        } else {
            const int g = hd >> 2;
            attn_unit<96, 3>(WID, lds, QN + t0 * 512 + hd * 64, 512, (const bf16_t*)(a->ws + WS_KCMP) + (size_t)(b * 2 + g) * 128 * 64, 64,
                             (const bf16_t*)(a->ws + WS_VCMPT) + (size_t)(b * 2 + g) * 96 * 128, 128, q0, 0.f, nullptr,
                             (bf16_t*)(a->ws + WS_OC) + t0 * 512 + hd * 64, 512, (float*)(a->ws + WS_IMPH) + (t0 * 8 + hd) * 32);
        }
    }
}

constexpr int PPL = 15;
constexpr int NPHASE = 1 + DEPTH * PPL;
__global__ void __launch_bounds__(512, 2) mk_fwd(Args a_unused) {
    ArgsP a = opaque_args();
    extern __shared__ __attribute__((aligned(16))) unsigned char lds_raw[];
    LAS unsigned char* lds = (LAS unsigned char*)lds_raw;
    const int tid = threadIdx.x, G = gridDim.x, c = blockIdx.x;
    const int WID = __builtin_amdgcn_readfirstlane(tid >> 6);
    volatile LAS unsigned* misc = (volatile LAS unsigned*)(lds + MISC_OFF);
    if (tid < 4) misc[tid] = 0u;
    __syncthreads();
    unsigned* ctl = (unsigned*)(a->ws + WS_CTL);
    XcdBarrier bar; bar.bar = ctl + CW_BAR; bar.x = 0; bar.st = misc;
    const int ph_lo = a->ph_lo, ph_hi = a->ph_hi;
    const bool multi = (ph_hi - ph_lo) > 1;
    if (multi) bar = xcd_barrier_post(WID, ctl + CW_BAR, misc);
    bool first = true;
#define PHASE_BEGIN(k, id) if ((DBG_ONLY < 0 || DBG_ONLY == (id)) && (k) >= ph_lo && (k) < ph_hi && (k) <= DBG_LAST_PHASE) { if (!first) { xcd_barrier(WID, bar); if (PROBE_MASK >> 31) xcd_barrier(WID, bar); } first = false; \
        ArgsP a = opaque_args(); unsigned char* ws = a->ws; bf16_t* XN = (bf16_t*)(ws + WS_XN); float* H = a->out; const float* Hin = (layer == 0) ? a->in[I_X] : (const float*)H; \
        const LAS int* ts = (const LAS int*)(lds + MISC_OFF + MO_TS); (void)XN; (void)H; (void)Hin; (void)ts; \
        const bool probe_ = ((PROBE_MASK >> (id)) & 1u) != 0u; const unsigned long long pt0_ = probe_ ? __builtin_amdgcn_s_memrealtime() : 0ull;
#define PHASE_END if (probe_) { const unsigned long long pt1_ = __builtin_amdgcn_s_memrealtime(), pd_ = pt1_ - pt0_; while (__builtin_amdgcn_s_memrealtime() - pt1_ < pd_) __builtin_amdgcn_s_sleep(8); } }
    { const int layer = 0; PHASE_BEGIN(0, 0) phase_prologue(WID, a, lds); PHASE_END }
#pragma unroll 1
    for (int layer = 0; layer < DEPTH; ++layer) {
        const int pb = 1 + layer * PPL; const bool even = (layer & 1) == 0; const int ev = layer >> 1, od = layer >> 1;
        if (even) {
            PHASE_BEGIN(pb + 0, 1) phase_norm<0>(WID, a, lds, layer, Hin); PHASE_END
            PHASE_BEGIN(pb + 1, 2) {
                { ProbPlain P{XN, (const bf16_t*)(ws + WS_EVNAT) + (size_t)ev * 2048 * 1024, 1024, 1024, 1024}; pg8::Sched S; S.init(T / 256, 8, G, c);
                  EpiEvNat E{ws, (const float*)(ws + WS_GAINS) + ev * 256};
                  pg8::gemm_phase(WID, lds, P, S, E); }
                { ProbPlain P{(const bf16_t*)(ws + WS_EVSW) + (size_t)ev * 768 * 1024, XN, 1024, 1024, 1024}; pg8::Sched S; S.init(3, T / 256, G, c);
                  EpiEvSw E{ws};
                  pg8::gemm_phase(WID, lds, P, S, E); }
            } PHASE_END
            PHASE_BEGIN(pb + 2, 3) {
                { ProbCmp1 P{(const bf16_t*)(ws + WS_KCB), (const bf16_t*)(ws + WS_VCB), (const bf16_t*)(ws + WS_CMP1) + (size_t)ev * 2 * 256 * 2048, 1024, 2048, 2048}; pg8::Sched S; S.init(32, 1, G, c);
                  EpiCmp1 E{(bf16_t*)(ws + WS_HID), (const float*)(ws + WS_BIAS1) + ev * 512};
                  pg8::gemm_phase(WID, lds, P, S, E); }
                phase_attn<0>(WID, a, lds);
                phase_attn<2>(WID, a, lds);
            } PHASE_END
            PHASE_BEGIN(pb + 3, 4) phase_cmp2(WID, a, lds, ev); PHASE_END
            PHASE_BEGIN(pb + 4, 5) phase_attn<3>(WID, a, lds); PHASE_END
            PHASE_BEGIN(pb + 5, 6) phase_topk(WID, a); PHASE_END
            PHASE_BEGIN(pb + 6, 7) phase_attn<1>(WID, a, lds); PHASE_END
            PHASE_BEGIN(pb + 7, 8) phase_mixprep(WID, a, layer); PHASE_END
            PHASE_BEGIN(pb + 8, 9) {
                ProbPlain P{(const bf16_t*)(ws + WS_AMIX), (const bf16_t*)(ws + WS_EVOUT) + (size_t)ev * 1024 * 1024, 1024, 1024, 1024}; pg8::Sched S; S.init(T / 256, 4, G, c);
                EpiResid E{Hin, H}; pg8::gemm_phase(WID, lds, P, S, E);
            } PHASE_END
        } else {
            PHASE_BEGIN(pb + 0, 11) phase_norm<1>(WID, a, lds, layer, Hin); PHASE_END
            PHASE_BEGIN(pb + 1, 12) {
                { ProbPlain P{XN, (const bf16_t*)(ws + WS_ODNAT) + (size_t)od * 4096 * 1024, 1024, 1024, 1024}; pg8::Sched S; S.init(T / 256, 16, G, c);
                  EpiOdNat E{ws}; pg8::gemm_phase(WID, lds, P, S, E); }
                { ProbPlain P{(const bf16_t*)(ws + WS_ODSW) + (size_t)od * 3072 * 1024, XN, 1024, 1024, 1024}; pg8::Sched S; S.init(12, T / 256, G, c);
                  EpiOdSw E{ws}; pg8::gemm_phase(WID, lds, P, S, E); }
            } PHASE_END
            PHASE_BEGIN(pb + 2, 13) {
                { ProbAtt P{(const bf16_t*)(ws + WS_AQ), (const bf16_t*)(ws + WS_KP), 2048, 1024, 256}; pg8::Sched S; S.init(512, 1, G, c);
                  EpiAtt E{(bf16_t*)(ws + WS_AQ)}; pg8::gemm_phase(WID, lds, P, S, E); }
                { ProbUT P{(const bf16_t*)(ws + WS_VS), (const bf16_t*)(ws + WS_KT), 512, 256, 256}; pg8::Sched S; S.init(1024, 1, G, c);
                  EpiUT E{(float*)(ws + WS_UT)}; pg8::gemm_phase(WID, lds, P, S, E); }
            } PHASE_END
            PHASE_BEGIN(pb + 3, 14) phase_scan(WID, a); PHASE_END
            PHASE_BEGIN(pb + 4, 15) {
                ProbY P{(const bf16_t*)(ws + WS_AQ), (const bf16_t*)(ws + WS_VS), 2048, 512, 512}; pg8::Sched S; S.init(512, 2, G, c);
                EpiY E{(bf16_t*)(ws + WS_Y)}; pg8::gemm_phase(WID, lds, P, S, E);
            } PHASE_END
            PHASE_BEGIN(pb + 5, 16) phase_normgate(WID, a, od); PHASE_END
            PHASE_BEGIN(pb + 8, 19) {
                ProbPlain P{(const bf16_t*)(ws + WS_YG), (const bf16_t*)(ws + WS_ODOUT) + (size_t)od * 1024 * 2048, 2048, 2048, 2048}; pg8::Sched S; S.init(T / 256, 4, G, c);
                EpiResid E{Hin, H}; pg8::gemm_phase(WID, lds, P, S, E);
            } PHASE_END
        }
        PHASE_BEGIN(pb + 9, 20) phase_norm<2>(WID, a, lds, layer, H); PHASE_END
        PHASE_BEGIN(pb + 10, 21) phase_moe_slots(WID, a, lds, layer); PHASE_END
        PHASE_BEGIN(pb + 11, 22) {
            moe_tables(WID, a, lds, layer, -1);
            { ProbMoe P{(const bf16_t*)(ws + WS_XB), (const bf16_t*)(ws + WS_WGU) + (size_t)layer * 32 * 2048 * 1024, ts, 2048, 1024, 1024, 1024}; pg8::Sched S; S.init(ts[32], 8, G, c);
              EpiGU E{(bf16_t*)(ws + WS_ACT), a->in[I_BGU] + (size_t)layer * 32 * 2048, ts}; pg8::gemm_phase(WID, lds, P, S, E); }
            { ProbPlain P{(const bf16_t*)(ws + WS_PBF) + (size_t)layer * T * 256, (const bf16_t*)(ws + WS_WPP) + (size_t)layer * 1024 * 256, 256, 256, 256}; pg8::Sched S; S.init(T / 256, 4, G, c);
              EpiPP E{(bf16_t*)(ws + WS_PP)}; pg8::gemm_phase(WID, lds, P, S, E); }
        } PHASE_END
        PHASE_BEGIN(pb + 12, 23) {
            moe_tables(WID, a, lds, layer, -1);
            ProbMoe P{(const bf16_t*)(ws + WS_ACT), (const bf16_t*)(ws + WS_WDN) + (size_t)layer * 32 * 1024 * 1024, ts, 1024, 1024, 1024, 1024}; pg8::Sched S; S.init(ts[32], 4, G, c);
            EpiDN E{(bf16_t*)(ws + WS_YB), a->in[I_BDN] + (size_t)layer * 32 * 1024, ts}; pg8::gemm_phase(WID, lds, P, S, E);
        } PHASE_END
        PHASE_BEGIN(pb + 13, 24) phase_combine(WID, a, H); PHASE_END
        PHASE_BEGIN(pb + 14, 25) {
            ProbPlain P{XN, (const bf16_t*)(ws + WS_WPG) + (size_t)layer * 1024 * 1024, 1024, 1024, 1024}; pg8::Sched S; S.init(T / 256, 4, G, c);
            EpiPLE E{H, (const bf16_t*)(ws + WS_PP)}; pg8::gemm_phase(WID, lds, P, S, E);
        } PHASE_END
    }
#undef PHASE_BEGIN
#undef PHASE_END
}

extern "C" void kernel_launch(void* const* d_in, const int* in_sizes, int n_in, void* d_out, int out_size, void* d_ws, size_t ws_size, hipStream_t stream) {
    static int grid = 0;
    if (grid == 0) {
        if (n_in != 26 || out_size != T * D || ws_size < WS_END) { fprintf(stderr, "kernel_launch: unexpected problem (n_in %d, out %d, ws %zu < %zu); nothing launched\n", n_in, out_size, ws_size, (size_t)WS_END); grid = -1; return; }
        int dev = 0, cus = 0, per_cu = 0;
        if (hipGetDevice(&dev) != hipSuccess || hipDeviceGetAttribute(&cus, hipDeviceAttributeMultiprocessorCount, dev) != hipSuccess) { grid = -1; return; }
        if (hipFuncSetAttribute((const void*)mk_fwd, hipFuncAttributeMaxDynamicSharedMemorySize, LDS_BYTES) != hipSuccess) { fprintf(stderr, "kernel_launch: hipFuncSetAttribute failed\n"); grid = -1; return; }
        if (hipOccupancyMaxActiveBlocksPerMultiprocessor(&per_cu, (const void*)mk_fwd, 512, LDS_BYTES) != hipSuccess || per_cu < 1) fprintf(stderr, "kernel_launch: occupancy query reports %d\n", per_cu);
        (void)hipGetLastError();
        grid = cus > 256 ? 256 : cus;
    }
    if (grid < 0) return;
    (void)hipMemsetAsync((char*)d_ws + WS_CTL, 0, CTL_BYTES, stream);
    Args a; memset(&a, 0, sizeof(a));
    for (int i = 0; i < 26; ++i) a.in[i] = (const float*)d_in[i];
    a.out = (float*)d_out; a.ws = (unsigned char*)d_ws;
#if MK_SINGLE
    a.ph_lo = 0; a.ph_hi = NPHASE;
    hipLaunchKernelGGL(mk_fwd, dim3(grid), dim3(512), LDS_BYTES, stream, a);
#else
    for (int ph = 0; ph < NPHASE && ph <= DBG_LAST_PHASE; ++ph) {
        const int l = (ph - 1) / PPL, k = (ph - 1) % PPL;
        if (ph > 0 && (l & 1) && (k == 6 || k == 7)) continue;
        a.ph_lo = ph; a.ph_hi = ph + 1;
        hipLaunchKernelGGL(mk_fwd, dim3(grid), dim3(512), LDS_BYTES, stream, a);
    }
#endif
}
```

```cpp
#include <hip/hip_runtime.h>
#include <cstdio>
#include <cstdint>
#include <cstring>

#define LAS __attribute__((address_space(3)))
#define DI __device__ __forceinline__
typedef unsigned short bf16_t;
typedef short bf16x8 __attribute__((ext_vector_type(8)));
typedef short s16x4 __attribute__((ext_vector_type(4)));
typedef float f32x2 __attribute__((ext_vector_type(2)));
typedef float f32x4 __attribute__((ext_vector_type(4)));
typedef float f32x16 __attribute__((ext_vector_type(16)));
typedef unsigned u32x2 __attribute__((ext_vector_type(2)));
typedef unsigned u32x4 __attribute__((ext_vector_type(4)));
typedef __bf16 bfv2 __attribute__((ext_vector_type(2)));

#ifndef MK_SINGLE
#define MK_SINGLE 1
#endif
#ifndef DBG_ONLY
#define DBG_ONLY -1
#endif
#ifndef PROBE_MASK
#define PROBE_MASK 0u
#endif
#ifndef DBG_LAST_PHASE
#define DBG_LAST_PHASE 100000
#endif

constexpr int T = 32768, D = 1024, SEQ = 2048, NBATCH = 16, DEPTH = 4;
constexpr int EVIN = 2840, ODIN = 6144;
constexpr float EPS = 1e-6f, NEGF = -1e30f;
constexpr int NTB = 256;
constexpr int MOE_ROWS = (512 + 32) * 256;

constexpr size_t MiB = 1u << 20;
constexpr size_t WS_CTL = 0, CTL_BYTES = 1 * MiB;
constexpr int CW_BAR = 4096;
constexpr size_t WS_EVNAT = 2 * MiB, WS_EVSW = 10 * MiB, WS_EVOUT = 13 * MiB, WS_CMP1 = 17 * MiB, WS_ODNAT = 21 * MiB, WS_ODSW = 37 * MiB,
                 WS_ODOUT = 49 * MiB, WS_WPP = 57 * MiB, WS_WPG = 59 * MiB, WS_BIAS1 = 67 * MiB, WS_GAINS = 67 * MiB + 16384, WS_BCNT = 67 * MiB + 65536,
                 WS_WGU = 68 * MiB, WS_WDN = 580 * MiB;
constexpr size_t WS_XN = 840 * MiB, WS_PBF = 904 * MiB, WS_PP = 968 * MiB, WS_GATES = 1032 * MiB, WS_TOPE = 1035 * MiB, WS_POSB = 1036 * MiB,
                 WS_DEST = 1037 * MiB, WS_GATEW = 1038 * MiB, WS_SELM = 1039 * MiB;
constexpr size_t RA = 1040 * MiB;
constexpr size_t WS_QD = RA, WS_KD = RA + 32 * MiB, WS_QN = RA + 64 * MiB, WS_KCB = RA + 96 * MiB, WS_VCB = RA + 105 * MiB, WS_KSB = RA + 114 * MiB,
                 WS_KWB = RA + 122 * MiB, WS_VAT = RA + 130 * MiB, WS_VST = RA + 162 * MiB, WS_VWT = RA + 170 * MiB, WS_HID = RA + 178 * MiB,
                 WS_KCMP = RA + 182 * MiB, WS_VCMPT = RA + 183 * MiB, WS_OC = RA + 184 * MiB, WS_IMPH = RA + 216 * MiB, WS_OD = RA + 248 * MiB,
                 WS_OS = RA + 312 * MiB, WS_OW = RA + 344 * MiB, WS_AMIX = RA + 376 * MiB;
constexpr size_t WS_AQ = RA, WS_KP = RA + 128 * MiB, WS_KT = RA + 192 * MiB, WS_VS = RA + 256 * MiB, WS_GG = RA + 512 * MiB, WS_UT = RA + 640 * MiB,
                 WS_Y = RA + 896 * MiB, WS_YG = RA + 1024 * MiB;
constexpr size_t WS_XB = 2192 * MiB, WS_ACT = 2464 * MiB, WS_YB = 2736 * MiB, WS_END = 3008 * MiB;

constexpr int MISC_OFF = 139264, LDS_BYTES = 155648;
static_assert(MISC_OFF + 5888 + 4096 <= LDS_BYTES, "misc LDS words");
constexpr int MO_WCNT = 256, MO_ENT = 1280, MO_GAT = 3328, MO_TOT = 5376, MO_BASE = 5504, MO_TS = 5632, MO_RED = 5888;

DI int opaque_tid(int wid0) { int t = (wid0 << 6) | (int)__builtin_amdgcn_mbcnt_hi(~0u, __builtin_amdgcn_mbcnt_lo(~0u, 0u)); asm volatile("" : "+v"(t) :: "memory"); return t; }
DI unsigned pk2(float lo, float hi) { f32x2 v = {lo, hi}; return __builtin_bit_cast(unsigned, __builtin_convertvector(v, bfv2)); }
DI float bf2f(unsigned short b) { return __uint_as_float(((unsigned)b) << 16); }
DI float bflo(unsigned w) { return __uint_as_float(w << 16); }
DI float bfhi(unsigned w) { return __uint_as_float(w & 0xffff0000u); }
DI float wave_sum(float v) {
#pragma unroll
    for (int o = 1; o < 64; o <<= 1) v += __shfl_xor(v, o);
    return v;
}
DI float sigm(float x) { return 1.0f / (1.0f + __expf(-x)); }
DI u32x4 pack8(const f32x4& a, const f32x4& b) { u32x4 w; w.x = pk2(a[0], a[1]); w.y = pk2(a[2], a[3]); w.z = pk2(b[0], b[1]); w.w = pk2(b[2], b[3]); return w; }

#define XB_TMO      128
#define XB_XCNT(j)  (256  + 64 * (j))
#define XB_XSUB(j)  (1280 + 64 * (j))
#define XB_XGEN(j)  (2304 + 64 * (j))
#define XB_TOP      3328
#define XB_TOPGEN   3392
#define XCD_BAR_WORDS 3456
#define XB_SPIN_CAP (1u << 22)
DI unsigned xb_ld(unsigned* p)              { return __hip_atomic_load(p, __ATOMIC_RELAXED, __HIP_MEMORY_SCOPE_AGENT); }
DI unsigned xb_add(unsigned* p, unsigned v) { return __hip_atomic_fetch_add(p, v, __ATOMIC_RELAXED, __HIP_MEMORY_SCOPE_AGENT); }
DI unsigned xb_xcc_id() { return (unsigned)__builtin_amdgcn_s_getreg((3 << 11) | 20) & 0xFu; }
#define XB_SPIN(cond, bar) do { unsigned _sp = 0; while (cond) { __builtin_amdgcn_s_sleep(1); \
    if ((++_sp & 255u) == 0u) { if (xb_ld(&(bar)[XB_TMO])) break; if (_sp > XB_SPIN_CAP) { atomicAdd(&(bar)[XB_TMO], 1u); break; } } } } while (0)
struct XcdBarrier { unsigned* bar; unsigned x; volatile LAS unsigned* st; };
DI XcdBarrier xcd_barrier_post(const int WID, unsigned* bar, volatile LAS unsigned* st) {
    XcdBarrier b; b.bar = bar; b.x = xb_xcc_id(); b.st = st;
    if (opaque_tid(WID) == 0) (void)xb_add(&bar[XB_XCNT(b.x)], 1u);
    return b;
}
DI void xcd_barrier_complete(unsigned* bar, unsigned x, unsigned& nloc, unsigned& nx) {
    const unsigned G = gridDim.x * gridDim.y * gridDim.z;
    unsigned sum, cnt, mine, sp = 0u;
    for (;;) {
        sum = 0u; cnt = 0u; mine = 0u;
#pragma unroll
        for (unsigned j = 0; j < 16; ++j) { const unsigned c = xb_ld(&bar[XB_XCNT(j)]); sum += c; cnt += (c > 0u) ? 1u : 0u; mine = (j == x) ? c : mine; }
        if (sum == G) break;
        __builtin_amdgcn_s_sleep(1);
        if ((++sp & 255u) == 0u) { if (xb_ld(&bar[XB_TMO])) break; if (sp > XB_SPIN_CAP) { atomicAdd(&bar[XB_TMO], 1u); break; } }
    }
    nloc = mine > 0u ? mine : 1u; nx = cnt > 0u ? cnt : 1u;
}
DI void xcd_barrier(const int WID, const XcdBarrier& b) {
    asm volatile("s_waitcnt vmcnt(0)" ::: "memory");
    __syncthreads();
    if (opaque_tid(WID) == 0) {
        unsigned* bar = b.bar; asm volatile("" : "+s"(bar));
        __builtin_amdgcn_s_waitcnt(0);
        unsigned nloc = b.st[0], nx = b.st[1];
        if (nloc == 0u) { xcd_barrier_complete(bar, b.x, nloc, nx); b.st[0] = nloc; b.st[1] = nx; }
        const unsigned old = xb_add(&bar[XB_XSUB(b.x)], 1u);
        const unsigned gen = old / nloc;
        if (old + 1u == (gen + 1u) * nloc) {
            __builtin_amdgcn_fence(__ATOMIC_RELEASE, "agent");
            asm volatile("s_waitcnt vmcnt(0)" ::: "memory");
            const unsigned og = xb_add(&bar[XB_TOP], 1u);
            const unsigned tg = og / nx;
            if (og + 1u == (tg + 1u) * nx) xb_add(&bar[XB_TOPGEN], 1u);
            else XB_SPIN(xb_ld(&bar[XB_TOPGEN]) == tg, bar);
            __builtin_amdgcn_fence(__ATOMIC_ACQUIRE, "agent");
            xb_add(&bar[XB_XGEN(b.x)], 1u);
            asm volatile("s_waitcnt vmcnt(0)" ::: "memory");
        } else {
            XB_SPIN(xb_ld(&bar[XB_XGEN(b.x)]) == gen, bar);
            __builtin_amdgcn_fence(__ATOMIC_ACQUIRE, "agent");
            asm volatile("s_waitcnt vmcnt(0)" ::: "memory");
        }
    }
    __syncthreads();
}

namespace pg8 {
constexpr int BM = 256, BK = 64, HALF = 128, HTB = HALF * BK * 2, STAGE_BYTES = 8 * HTB, NXCD = 8, WGM = 8;
DI int lds_byte(int r, int c) { const int st = (r >> 4) * 2 + (c >> 5), rr = r & 15, cc = c & 31, ob = rr * 64 + cc * 2; return st * 1024 + (ob ^ (((ob >> 9) & 1) << 5)); }
DI void stage_rc(int b, int& R, int& C) { const int st = b / 1024, sb = b % 1024, swz = sb ^ (((sb >> 9) & 1) << 5); R = (st >> 1) * 16 + swz / 64; C = (st & 1) * 32 + (swz % 64) / 2; }
DI int perm32(int rho) { const int n = rho >> 4, i = rho & 15; return 8 * (i >> 2) + 4 * n + (i & 3); }
struct Unit { int pm, pn; };
struct Sched {
    int nM, nN, nwg, G, c;
    DI void init(int nM_, int nN_, int G_, int c_) { nM = nM_; nN = nN_; nwg = nM * nN; G = G_; c = c_; }
    DI bool next(int i, Unit& u) const {
        const long L = (long)i * G + c; if (L >= nwg) return false;
        int wgid = (int)L; { const int q = nwg / NXCD, r = nwg % NXCD, xcd = wgid % NXCD, off = wgid / NXCD; wgid = (xcd < r ? xcd * (q + 1) : r * (q + 1) + (xcd - r) * q) + off; }
        const int nig = WGM * nN, gid = wgid / nig, fm = gid * WGM, gsz = (nM - fm) < WGM ? (nM - fm) : WGM;
        u.pm = fm + ((wgid % nig) % gsz); u.pn = (wgid % nig) / gsz; return true;
    }
};
template <class Epi, class Prob>
DI void gemm_phase(const int WID, LAS unsigned char* lds, const Prob& P, const Sched& S, const Epi& E) {
    const int tid = opaque_tid(WID), wid = __builtin_amdgcn_readfirstlane(tid >> 6), lane = tid & 63, wr = wid >> 2, wc = wid & 3, fr = lane & 15, fq = lane >> 4;
    const int K = P.K, nt = K / BK;
    unsigned voffA[2], voffB[2];
#pragma unroll
    for (int i = 0; i < 2; ++i) { int R, C; stage_rc(tid * 16 + i * 8192, R, C); const int Rb = Epi::PERM ? ((R & ~31) + perm32(R & 31)) : R;
        voffA[i] = (unsigned)(R * P.lda + C) * 2u; voffB[i] = (unsigned)(Rb * P.ldb + C) * 2u; }
    const size_t kstep = (size_t)(BK * 2);
    const size_t hstepA = (size_t)HALF * P.lda * 2, hstepB = (size_t)HALF * P.ldb * 2;
    const unsigned ldsw = (unsigned)wid * 1024u;
    const int aoff = lds_byte(wr * 64 + fr, fq * 8), boff = lds_byte(wc * 32 + fr, fq * 8);
#define PG8_SA(b, h) (((b) * 2 + (h)) * HTB)
#define PG8_SB(b, h) ((4 + (b) * 2 + (h)) * HTB)
#define PG8_STAGE(bufoff, gbase, voff) do { _Pragma("unroll") for (int _i = 0; _i < 2; ++_i) \
        __builtin_amdgcn_global_load_lds((const unsigned*)((const char*)(gbase) + (voff)[_i]), (LAS unsigned*)(lds + (bufoff) + ldsw + _i * 8192), 16, 0, 0); } while (0)
#define PG8_LDA(dst, b, h) do { _Pragma("unroll") for (int m = 0; m < 4; ++m) _Pragma("unroll") for (int k = 0; k < 2; ++k) dst[m][k] = *(const LAS bf16x8*)(lds + PG8_SA(b, h) + aoff + m * 2048 + k * 1024); } while (0)
#define PG8_LDB(dst, b, h) do { _Pragma("unroll") for (int n = 0; n < 2; ++n) _Pragma("unroll") for (int k = 0; k < 2; ++k) dst[n][k] = *(const LAS bf16x8*)(lds + PG8_SB(b, h) + boff + n * 2048 + k * 1024); } while (0)
#define PG8_MMA(ai, bj, At, Bt) do { __builtin_amdgcn_s_setprio(1); _Pragma("unroll") for (int m = 0; m < 4; ++m) _Pragma("unroll") for (int n = 0; n < 2; ++n) _Pragma("unroll") for (int k = 0; k < 2; ++k) \
        acc[ai][bj][m][n] = __builtin_amdgcn_mfma_f32_16x16x32_bf16(Bt[n][k], At[m][k], acc[ai][bj][m][n], 0, 0, 0); __builtin_amdgcn_s_setprio(0); } while (0)
#define PG8_WAIT_V(n) asm volatile("s_waitcnt vmcnt(" #n ")" ::: "memory")
#define PG8_WAIT_L(n) asm volatile("s_waitcnt lgkmcnt(" #n ")" ::: "memory")
#define PG8_BAR __builtin_amdgcn_s_barrier()
#define PG8_SCHED __builtin_amdgcn_sched_barrier(0)
    Unit cur, nxt; int ui = 0;
    if (!S.next(0, cur)) return;
    f32x4 acc[2][2][4][2];
#pragma unroll
    for (int a = 0; a < 2; ++a)
#pragma unroll
        for (int b = 0; b < 2; ++b)
#pragma unroll
            for (int m = 0; m < 4; ++m)
#pragma unroll
                for (int n = 0; n < 2; ++n) acc[a][b][m][n] = (f32x4){0.f, 0.f, 0.f, 0.f};
    bf16x8 At[4][2], B0[2][2], B1[2][2];
    const char* cA = P.a_base(cur); const char* cB = P.b_base(cur);
    PG8_STAGE(PG8_SB(0, 0), cB, voffB); PG8_STAGE(PG8_SA(0, 0), cA, voffA); PG8_STAGE(PG8_SB(0, 1), cB + hstepB, voffB); PG8_STAGE(PG8_SA(0, 1), cA + hstepA, voffA);
    if (wr == 1) PG8_BAR;
    PG8_WAIT_V(4); PG8_BAR;
    PG8_STAGE(PG8_SB(1, 0), cB + kstep, voffB); PG8_STAGE(PG8_SA(1, 0), cA + kstep, voffA); PG8_STAGE(PG8_SB(1, 1), cB + hstepB + kstep, voffB);
    PG8_WAIT_V(6); PG8_BAR;
    for (;;) {
        const bool has_next = S.next(ui + 1, nxt);
        const char* nA = has_next ? P.a_base(nxt) : cA; const char* nB = has_next ? P.b_base(nxt) : cB;
        for (int t = 0; t < nt; t += 2) {
            const bool last = (t == nt - 2);
            const char* a1 = cA + (size_t)(t + 1) * kstep;
            const char* a2 = last ? nA : cA + (size_t)(t + 2) * kstep; const char* b2 = last ? nB : cB + (size_t)(t + 2) * kstep;
            const char* a3 = a2 + kstep; const char* b3 = b2 + kstep;
            PG8_LDB(B0, 0, 0); PG8_SCHED; PG8_LDA(At, 0, 0); PG8_STAGE(PG8_SA(1, 1), a1 + hstepA, voffA);
            PG8_WAIT_L(8); PG8_BAR; PG8_WAIT_L(0); PG8_MMA(0, 0, At, B0); PG8_BAR; PG8_SCHED;
            PG8_LDB(B1, 0, 1); PG8_STAGE(PG8_SB(0, 0), b2, voffB);
            PG8_BAR; PG8_WAIT_L(0); PG8_MMA(0, 1, At, B1); PG8_BAR;
            PG8_LDA(At, 0, 1); PG8_STAGE(PG8_SA(0, 0), a2, voffA);
            PG8_BAR; PG8_WAIT_L(0); PG8_MMA(1, 0, At, B0); PG8_BAR; PG8_SCHED;
            PG8_STAGE(PG8_SB(0, 1), b2 + hstepB, voffB);
            PG8_WAIT_V(6); PG8_BAR; PG8_MMA(1, 1, At, B1); PG8_BAR;
            PG8_LDB(B0, 1, 0); PG8_SCHED; PG8_LDA(At, 1, 0); PG8_STAGE(PG8_SA(0, 1), a2 + hstepA, voffA);
            PG8_WAIT_L(8); PG8_BAR; PG8_WAIT_L(0); PG8_MMA(0, 0, At, B0); PG8_BAR; PG8_SCHED;
            PG8_LDB(B1, 1, 1); PG8_STAGE(PG8_SB(1, 0), b3, voffB);
            PG8_BAR; PG8_WAIT_L(0); PG8_MMA(0, 1, At, B1); PG8_BAR;
            PG8_LDA(At, 1, 1); PG8_STAGE(PG8_SA(1, 0), a3, voffA);
            PG8_BAR; PG8_WAIT_L(0); PG8_MMA(1, 0, At, B0); PG8_BAR; PG8_SCHED;
            PG8_STAGE(PG8_SB(1, 1), b3 + hstepB, voffB);
            PG8_WAIT_V(6); PG8_BAR; PG8_MMA(1, 1, At, B1); PG8_BAR;
        }
        { int fr_ = fr, fq_ = fq, wr_ = wr, wc_ = wc; asm volatile("" : "+v"(fr_), "+v"(fq_), "+s"(wr_), "+s"(wc_));
          E(acc, cur, wr_, wc_, fr_, fq_); }
        if (!has_next) break;
#pragma unroll
        for (int a = 0; a < 2; ++a)
#pragma unroll
            for (int b = 0; b < 2; ++b)
#pragma unroll
                for (int m = 0; m < 4; ++m)
#pragma unroll
                    for (int n = 0; n < 2; ++n) acc[a][b][m][n] = (f32x4){0.f, 0.f, 0.f, 0.f};
        cur = nxt; cA = nA; cB = nB; ++ui;
    }
    PG8_WAIT_V(0);
    if (wr == 0) PG8_BAR;
    PG8_BAR;
#undef PG8_SA
#undef PG8_SB
#undef PG8_STAGE
#undef PG8_LDA
#undef PG8_LDB
#undef PG8_MMA
#undef PG8_WAIT_V
#undef PG8_WAIT_L
#undef PG8_BAR
#undef PG8_SCHED
}
}
using pg8::Unit;
typedef f32x4 Acc[2][2][4][2];

struct ProbPlain { const bf16_t* A; const bf16_t* Bt; int lda, ldb, K;
    DI const char* a_base(const Unit& u) const { return (const char*)(A + (size_t)u.pm * 256 * lda); }
    DI const char* b_base(const Unit& u) const { return (const char*)(Bt + (size_t)u.pn * 256 * ldb); } };
struct ProbCmp1 { const bf16_t* KCB; const bf16_t* VCB; const bf16_t* W; int lda, ldb, K;
    DI const char* a_base(const Unit& u) const { const int kv = u.pm >> 4, rt = u.pm & 15; return (const char*)((kv ? VCB : KCB) + (size_t)rt * 256 * 1024); }
    DI const char* b_base(const Unit& u) const { const int kv = u.pm >> 4; return (const char*)(W + (size_t)kv * 256 * 2048); } };
struct ProbAtt { const bf16_t* AQ; const bf16_t* KP; int lda, ldb, K;
    DI const char* a_base(const Unit& u) const { const int z = u.pm, n = z & 7, h = (z >> 3) & 3, b = z >> 5; const size_t t0 = (size_t)b * 2048 + n * 256; return (const char*)(AQ + (t0 * 4 + h) * 512 + 256); }
    DI const char* b_base(const Unit& u) const { const int z = u.pm, n = z & 7, h = (z >> 3) & 3, b = z >> 5; const size_t t0 = (size_t)b * 2048 + n * 256; return (const char*)(KP + t0 * 1024 + h * 256); } };
struct ProbUT { const bf16_t* VS; const bf16_t* KT; int lda, ldb, K;
    DI const char* a_base(const Unit& u) const { const int z = u.pm >> 1, half = u.pm & 1; return (const char*)(VS + (size_t)z * 262144 + (size_t)half * 256 * 512); }
    DI const char* b_base(const Unit& u) const { const int z = u.pm >> 1; return (const char*)(KT + (size_t)z * 65536); } };
struct ProbY { const bf16_t* AQ; const bf16_t* VS; int lda, ldb, K;
    DI const char* a_base(const Unit& u) const { const int z = u.pm, n = z & 7, h = (z >> 3) & 3, b = z >> 5; const size_t t0 = (size_t)b * 2048 + n * 256; return (const char*)(AQ + (t0 * 4 + h) * 512); }
    DI const char* b_base(const Unit& u) const { return (const char*)(VS + (size_t)u.pm * 262144 + (size_t)u.pn * 256 * 512); } };
DI int moe_tile_expert(const LAS int* ts, int rt) { int e = 0;
#pragma unroll 8
    for (int i = 1; i < 32; ++i) e += (rt >= ts[i]) ? 1 : 0;
    return e; }
struct ProbMoe { const bf16_t* A; const bf16_t* W; const LAS int* ts; int nper; int lda, ldb, K;
    DI const char* a_base(const Unit& u) const { return (const char*)(A + (size_t)u.pm * 256 * 1024); }
    DI const char* b_base(const Unit& u) const { const int e = moe_tile_expert(ts, u.pm); return (const char*)(W + ((size_t)e * nper + (size_t)u.pn * 256) * 1024); } };

#define EPI_ROWS(ai, m) (128 * (ai) + 64 * wr + 16 * (m) + fr)
struct EpiEvNat { static constexpr bool PERM = true;
    unsigned char* ws; const float* gains;
    DI void operator()(const Acc& acc, const Unit& u, int wr, int wc, int fr, int fq) const {
        const int pn = u.pn; const bool norm = (pn != 6);
        const int gi = pn < 2 ? 0 : pn < 4 ? 1 : pn < 6 ? 2 : 3;
        const float* g = gains + gi * 64;
        f32x4 gv[2][2];
#pragma unroll
        for (int bj = 0; bj < 2; ++bj)
#pragma unroll
            for (int n = 0; n < 2; ++n) { const f32x4 t4 = *(const f32x4*)(g + 32 * bj + 8 * fq + 4 * n); gv[bj][n] = norm ? t4 : (f32x4){1.f, 1.f, 1.f, 1.f}; }
        size_t boff; int rowmul, hoff; bool panel = false;
        if (pn < 2) { boff = WS_QD; rowmul = 512; hoff = (pn * 4 + wc) * 64; }
        else if (pn < 4) { boff = WS_KD; rowmul = 512; hoff = ((pn - 2) * 4 + wc) * 64; }
        else if (pn < 6) { boff = WS_QN; rowmul = 512; hoff = ((pn - 4) * 4 + wc) * 64; }
        else { panel = true; rowmul = 64; hoff = 0; boff = (pn == 6) ? (wc < 2 ? WS_KCB : WS_VCB) : (wc < 2 ? WS_KSB : WS_KWB); }
        bf16_t* base = (bf16_t*)(ws + boff);
#pragma unroll
        for (int ai = 0; ai < 2; ++ai)
#pragma unroll
            for (int m = 0; m < 4; ++m) {
                const int t = u.pm * 256 + EPI_ROWS(ai, m), b = t >> 11, sq = t & 2047;
                float ss = 0.f;
#pragma unroll
                for (int bj = 0; bj < 2; ++bj)
#pragma unroll
                    for (int n = 0; n < 2; ++n) { const f32x4 x = acc[ai][bj][m][n]; ss += (x[0] * x[0] + x[1] * x[1]) + (x[2] * x[2] + x[3] * x[3]); }
                ss += __shfl_xor(ss, 16); ss += __shfl_xor(ss, 32);
                const float rstd = norm ? rsqrtf(ss * (1.0f / 64.0f) + EPS) * ((pn < 2 || pn == 4 || pn == 5) ? 0.125f : 1.0f) : 1.0f;
                const size_t rowi = panel ? ((size_t)(b * 2 + (wc & 1)) * 2048 + sq) : (size_t)t;
#pragma unroll
                for (int bj = 0; bj < 2; ++bj) {
                    const f32x4 v0 = acc[ai][bj][m][0] * rstd * gv[bj][0], v1 = acc[ai][bj][m][1] * rstd * gv[bj][1];
                    *(u32x4*)(base + rowi * rowmul + hoff + 32 * bj + 8 * fq) = pack8(v0, v1);
                }
            }
    }
};
struct EpiEvSw { static constexpr bool PERM = true;
    unsigned char* ws;
    DI void operator()(const Acc& acc, const Unit& u, int wr, int wc, int fr, int fq) const {
        const int b = u.pn >> 3, sb = (u.pn & 7) * 256;
#pragma unroll
        for (int ai = 0; ai < 2; ++ai)
#pragma unroll
            for (int m = 0; m < 4; ++m) {
                const int rl = EPI_ROWS(ai, m);
                size_t boff, rowi;
                if (u.pm < 2) { const int fg = u.pm * 256 + rl; boff = WS_VAT; rowi = (size_t)(b * 4 + (fg >> 7)) * 128 + (fg & 127); }
                else { const int r2 = rl & 127; boff = (rl < 128) ? WS_VST : WS_VWT; rowi = (size_t)(b * 2 + (r2 >> 6)) * 64 + (r2 & 63); }
                bf16_t* rowp = (bf16_t*)(ws + boff) + rowi * 2048;
#pragma unroll
                for (int bj = 0; bj < 2; ++bj) *(u32x4*)(rowp + sb + 128 * bj + 32 * wc + 8 * fq) = pack8(acc[ai][bj][m][0], acc[ai][bj][m][1]);
            }
    }
};
struct EpiCmp1 { static constexpr bool PERM = true;
    bf16_t* HID; const float* bias1;
    DI void operator()(const Acc& acc, const Unit& u, int wr, int wc, int fr, int fq) const {
        const int kv = u.pm >> 4, rt = u.pm & 15;
#pragma unroll
        for (int bj = 0; bj < 2; ++bj) {
            const int col = 128 * bj + 32 * wc + 8 * fq;
            const f32x4 b0 = *(const f32x4*)(bias1 + kv * 256 + col), b1 = *(const f32x4*)(bias1 + kv * 256 + col + 4);
#pragma unroll
            for (int ai = 0; ai < 2; ++ai)
#pragma unroll
                for (int m = 0; m < 4; ++m) {
                    f32x4 v0 = acc[ai][bj][m][0] + b0, v1 = acc[ai][bj][m][1] + b1;
#pragma unroll
                    for (int j = 0; j < 4; ++j) { v0[j] = v0[j] * sigm(v0[j]); v1[j] = v1[j] * sigm(v1[j]); }
                    *(u32x4*)(HID + ((size_t)kv * 4096 + rt * 256 + EPI_ROWS(ai, m)) * 256 + col) = pack8(v0, v1);
                }
        }
    }
};
struct EpiResid { static constexpr bool PERM = false;
    const float* Hin; float* Hout;
    DI void operator()(const Acc& acc, const Unit& u, int wr, int wc, int fr, int fq) const {
#pragma unroll
        for (int ai = 0; ai < 2; ++ai)
#pragma unroll
            for (int m = 0; m < 4; ++m) {
                const size_t off = (size_t)(u.pm * 256 + EPI_ROWS(ai, m)) * 1024 + u.pn * 256 + 32 * wc + 4 * fq;
#pragma unroll
                for (int bj = 0; bj < 2; ++bj)
#pragma unroll
                    for (int n = 0; n < 2; ++n) { const size_t o = off + 128 * bj + 16 * n; *(f32x4*)(Hout + o) = *(const f32x4*)(Hin + o) + acc[ai][bj][m][n]; }
            }
    }
};
DI float ret_lg2(int h) { return __log2f(1.0f - exp2f(-5.0f - (float)h)); }
struct EpiOdNat { static constexpr bool PERM = true;
    unsigned char* ws;
    DI void operator()(const Acc& acc, const Unit& u, int wr, int wc, int fr, int fq) const {
        const int pn = u.pn; const int h = pn & 3; const float lg = ret_lg2(h);
        const size_t boff = pn < 4 ? WS_AQ : pn < 8 ? WS_KP : WS_GG;
        const int rowmul = pn < 4 ? 2048 : pn < 8 ? 1024 : 2048;
        const int coff = pn < 4 ? (h * 512 + 256) : pn < 8 ? (h * 256) : ((pn - 8) * 256);
        bf16_t* base = (bf16_t*)(ws + boff) + coff;
#pragma unroll
        for (int ai = 0; ai < 2; ++ai)
#pragma unroll
            for (int m = 0; m < 4; ++m) {
                const int cl = EPI_ROWS(ai, m); const size_t t = (size_t)u.pm * 256 + cl;
                float sc = 1.f;
                if (pn < 4) sc = exp2f(lg * (float)(cl + 1)); else if (pn < 8) sc = 0.0625f * exp2f(-lg * (float)(cl + 1));
#pragma unroll
                for (int bj = 0; bj < 2; ++bj) {
                    const int d = 128 * bj + 32 * wc + 8 * fq;
                    f32x4 v0 = acc[ai][bj][m][0] * sc, v1 = acc[ai][bj][m][1] * sc;
                    if (pn >= 8) {
#pragma unroll
                        for (int j = 0; j < 4; ++j) { v0[j] = v0[j] * sigm(v0[j]); v1[j] = v1[j] * sigm(v1[j]); } }
                    *(u32x4*)(base + t * rowmul + d) = pack8(v0, v1);
                }
            }
    }
};
struct EpiOdSw { static constexpr bool PERM = true;
    unsigned char* ws;
    DI void operator()(const Acc& acc, const Unit& u, int wr, int wc, int fr, int fq) const {
        const int b = u.pn >> 3, n = u.pn & 7;
        const bool isk = u.pm < 4; const int h = isk ? u.pm : ((u.pm - 4) >> 1);
        const size_t z = (size_t)(b * 4 + h) * 8 + n; const float lg = ret_lg2(h);
        bf16_t* base = (bf16_t*)(ws + (isk ? WS_KT : WS_VS)) + (isk ? z * 65536 : z * 262144 + (size_t)((u.pm - 4) & 1) * 256 * 512);
        const int rowmul = isk ? 256 : 512;
#pragma unroll
        for (int bj = 0; bj < 2; ++bj) {
            const int cl = 128 * bj + 32 * wc + 8 * fq;
            f32x4 s0 = {1.f, 1.f, 1.f, 1.f}, s1 = s0;
            if (isk) {
#pragma unroll
                for (int j = 0; j < 4; ++j) { s0[j] = 0.0625f * exp2f(-lg * (float)(cl + j + 1)); s1[j] = 0.0625f * exp2f(-lg * (float)(cl + 4 + j + 1)); } }
#pragma unroll
            for (int ai = 0; ai < 2; ++ai)
#pragma unroll
                for (int m = 0; m < 4; ++m)
                    *(u32x4*)(base + (size_t)EPI_ROWS(ai, m) * rowmul + cl) = pack8(acc[ai][bj][m][0] * s0, acc[ai][bj][m][1] * s1);
        }
    }
};
struct EpiAtt { static constexpr bool PERM = true;
    bf16_t* AQ;
    DI void operator()(const Acc& acc, const Unit& u, int wr, int wc, int fr, int fq) const {
        const int z = u.pm, n = z & 7, h = (z >> 3) & 3, b = z >> 5; const size_t t0 = (size_t)b * 2048 + n * 256;
#pragma unroll
        for (int ai = 0; ai < 2; ++ai)
#pragma unroll
            for (int m = 0; m < 4; ++m) {
                const int c = EPI_ROWS(ai, m);
#pragma unroll
                for (int bj = 0; bj < 2; ++bj) {
                    const int e0 = 128 * bj + 32 * wc + 8 * fq;
                    f32x4 v0 = acc[ai][bj][m][0], v1 = acc[ai][bj][m][1];
#pragma unroll
                    for (int j = 0; j < 4; ++j) { v0[j] = (c >= e0 + j) ? v0[j] : 0.f; v1[j] = (c >= e0 + 4 + j) ? v1[j] : 0.f; }
                    *(u32x4*)(AQ + ((t0 + c) * 4 + h) * 512 + e0) = pack8(v0, v1);
                }
            }
    }
};
struct EpiUT { static constexpr bool PERM = false;
    float* UT;
    DI void operator()(const Acc& acc, const Unit& u, int wr, int wc, int fr, int fq) const {
        const size_t z = (size_t)(u.pm >> 1); const int half = u.pm & 1;
#pragma unroll
        for (int ai = 0; ai < 2; ++ai)
#pragma unroll
            for (int m = 0; m < 4; ++m) {
                float* rowp = UT + z * 131072 + (size_t)(half * 256 + EPI_ROWS(ai, m)) * 256 + 32 * wc + 4 * fq;
#pragma unroll
                for (int bj = 0; bj < 2; ++bj)
#pragma unroll
                    for (int n = 0; n < 2; ++n) *(f32x4*)(rowp + 128 * bj + 16 * n) = acc[ai][bj][m][n];
            }
    }
};
struct EpiY { static constexpr bool PERM = true;
    bf16_t* Y;
    DI void operator()(const Acc& acc, const Unit& u, int wr, int wc, int fr, int fq) const {
        const int z = u.pm, n = z & 7, h = (z >> 3) & 3, b = z >> 5; const size_t t0 = (size_t)b * 2048 + n * 256;
#pragma unroll
        for (int ai = 0; ai < 2; ++ai)
#pragma unroll
            for (int m = 0; m < 4; ++m) {
                bf16_t* rowp = Y + (t0 + EPI_ROWS(ai, m)) * 2048 + h * 512 + u.pn * 256 + 32 * wc + 8 * fq;
#pragma unroll
                for (int bj = 0; bj < 2; ++bj) *(u32x4*)(rowp + 128 * bj) = pack8(acc[ai][bj][m][0], acc[ai][bj][m][1]);
            }
    }
};
struct EpiGU { static constexpr bool PERM = true;
    bf16_t* ACT; const float* bgu; const LAS int* ts;
    DI void operator()(const Acc& acc, const Unit& u, int wr, int wc, int fr, int fq) const {
        const int e = moe_tile_expert(ts, u.pm); const int w = 32 * wc + 8 * fq;
        const float* bp = bgu + (size_t)e * 2048 + 128 * u.pn + w;
        const f32x4 bg0 = *(const f32x4*)bp, bg1 = *(const f32x4*)(bp + 4), bl0 = *(const f32x4*)(bp + 1024), bl1 = *(const f32x4*)(bp + 1028);
#pragma unroll
        for (int ai = 0; ai < 2; ++ai)
#pragma unroll
            for (int m = 0; m < 4; ++m) {
                f32x4 g0 = acc[ai][0][m][0] + bg0, g1 = acc[ai][0][m][1] + bg1, l0 = acc[ai][1][m][0] + bl0, l1 = acc[ai][1][m][1] + bl1;
#pragma unroll
                for (int j = 0; j < 4; ++j) {
                    const float a = fminf(g0[j], 7.0f), c = fminf(g1[j], 7.0f);
                    const float la = fminf(fmaxf(l0[j], -7.0f), 7.0f), lc = fminf(fmaxf(l1[j], -7.0f), 7.0f);
                    g0[j] = a * sigm(1.702f * a) * (la + 1.0f); g1[j] = c * sigm(1.702f * c) * (lc + 1.0f); }
                *(u32x4*)(ACT + ((size_t)u.pm * 256 + EPI_ROWS(ai, m)) * 1024 + 128 * u.pn + w) = pack8(g0, g1);
            }
    }
};
struct EpiDN { static constexpr bool PERM = true;
    bf16_t* YB; const float* bdn; const LAS int* ts;
    DI void operator()(const Acc& acc, const Unit& u, int wr, int wc, int fr, int fq) const {
        const int e = moe_tile_expert(ts, u.pm);
#pragma unroll
        for (int bj = 0; bj < 2; ++bj) {
            const int col = 256 * u.pn + 128 * bj + 32 * wc + 8 * fq;
            const f32x4 b0 = *(const f32x4*)(bdn + (size_t)e * 1024 + col), b1 = *(const f32x4*)(bdn + (size_t)e * 1024 + col + 4);
#pragma unroll
            for (int ai = 0; ai < 2; ++ai)
#pragma unroll
                for (int m = 0; m < 4; ++m)
                    *(u32x4*)(YB + ((size_t)u.pm * 256 + EPI_ROWS(ai, m)) * 1024 + col) = pack8(acc[ai][bj][m][0] + b0, acc[ai][bj][m][1] + b1);
        }
    }
};
struct EpiPP { static constexpr bool PERM = true;
    bf16_t* PP;
    DI void operator()(const Acc& acc, const Unit& u, int wr, int wc, int fr, int fq) const {
#pragma unroll
        for (int ai = 0; ai < 2; ++ai)
#pragma unroll
            for (int m = 0; m < 4; ++m) {
                bf16_t* rowp = PP + ((size_t)u.pm * 256 + EPI_ROWS(ai, m)) * 1024 + u.pn * 256 + 32 * wc + 8 * fq;
#pragma unroll
                for (int bj = 0; bj < 2; ++bj) *(u32x4*)(rowp + 128 * bj) = pack8(acc[ai][bj][m][0], acc[ai][bj][m][1]);
            }
    }
};
struct EpiPLE { static constexpr bool PERM = false;
    float* H; const bf16_t* PP;
    DI void operator()(const Acc& acc, const Unit& u, int wr, int wc, int fr, int fq) const {
#pragma unroll
        for (int ai = 0; ai < 2; ++ai)
#pragma unroll
            for (int m = 0; m < 4; ++m) {
                const size_t off = (size_t)(u.pm * 256 + EPI_ROWS(ai, m)) * 1024 + u.pn * 256 + 32 * wc + 4 * fq;
#pragma unroll
                for (int bj = 0; bj < 2; ++bj)
#pragma unroll
                    for (int n = 0; n < 2; ++n) {
                        const size_t o = off + 128 * bj + 16 * n;
                        const u32x2 pw = *(const u32x2*)(PP + o); const f32x4 a = acc[ai][bj][m][n]; f32x4 hv = *(const f32x4*)(H + o);
                        hv[0] += sigm(a[0]) * bflo(pw.x); hv[1] += sigm(a[1]) * bfhi(pw.x); hv[2] += sigm(a[2]) * bflo(pw.y); hv[3] += sigm(a[3]) * bfhi(pw.y);
                        *(f32x4*)(H + o) = hv;
                    }
            }
    }
};

constexpr int AT_KSTR = 144;
template <int DV, int MODE>
DI void attn_unit(const int WID, LAS unsigned char* lds, const bf16_t* Qp, int ldq, const bf16_t* Kp, int ldk, const bf16_t* Vt, int ldvt, int q0, float slope,
                  const unsigned* selp, bf16_t* Op, int ldo, float* impp) {
    constexpr int NRB = DV / 32, VPIECES = DV * 8;
    constexpr int KB0 = 0, KB1 = 64 * AT_KSTR, VB0 = 2 * 64 * AT_KSTR, VB1 = VB0 + DV * AT_KSTR;
    const int tid = opaque_tid(WID), w = __builtin_amdgcn_readfirstlane(tid >> 6), lane = tid & 63, r = lane & 31, hh = lane >> 5;
    const int qrow = q0 + 32 * w + r, qw_first = q0 + 32 * w, qw_last = qw_first + 31;
    const float LOG2E = 1.44269504089f;
    bf16x8 qf[4];
#pragma unroll
    for (int ks = 0; ks < 4; ++ks) qf[ks] = *(const bf16x8*)(Qp + (size_t)(32 * w + r) * ldq + 16 * ks + 8 * hh);
    unsigned selm = 0xffffffffu, orm = 0xffffffffu;
    if (MODE == 1) { selm = selp[32 * w + r]; orm = selm;
#pragma unroll
        for (int o = 1; o < 32; o <<= 1) orm |= __shfl_xor(orm, o); }
    const int nv = (MODE == 3) ? (qrow >= 31 ? ((qrow - 15) >> 4) : 0) : 0;
    const int nv_wmax = (MODE == 3) ? (qw_last >= 31 ? ((qw_last - 15) >> 4) : 0) : 0;
    int kt_lo = 0, kt_hi;
    if (MODE == 0 || MODE == 1) kt_hi = (q0 >> 6) + 4;
    else if (MODE == 2) { kt_hi = (q0 >> 6) + 4; const int lk = q0 - 511; kt_lo = lk > 0 ? (lk >> 6) : 0; }
    else kt_hi = 2;
    f32x16 cb[2];
#pragma unroll
    for (int kk = 0; kk < 2; ++kk)
#pragma unroll
        for (int i = 0; i < 16; ++i) cb[kk][i] = (MODE == 3) ? 0.f : slope * (float)(32 * kk + 8 * (i >> 2) + (i & 3) + 4 * hh);
    f32x16 O[NRB];
#pragma unroll
    for (int rb = 0; rb < NRB; ++rb)
#pragma unroll
        for (int i = 0; i < 16; ++i) O[rb][i] = 0.f;
    float mrun = NEGF, lrun = 0.f;
    u32x4 kreg, vreg[2];
    const int krow = tid >> 3, kpc = tid & 7;
#define AT_GLOAD(kt) do { kreg = *(const u32x4*)(Kp + (size_t)(64 * (kt) + krow) * ldk + 8 * kpc); \
        _Pragma("unroll") for (int i_ = 0; i_ < 2; ++i_) { const int idx = tid + 512 * i_; if (idx < VPIECES) vreg[i_] = *(const u32x4*)(Vt + (size_t)(idx >> 3) * ldvt + 64 * (kt) + 8 * (idx & 7)); } } while (0)
#define AT_LWRITE(buf) do { *(LAS u32x4*)(lds + ((buf) ? KB1 : KB0) + krow * AT_KSTR + kpc * 16) = kreg; \
        _Pragma("unroll") for (int i_ = 0; i_ < 2; ++i_) { const int idx = tid + 512 * i_; if (idx < VPIECES) { const int p_ = idx & 7; \
            LAS unsigned char* d_ = lds + ((buf) ? VB1 : VB0) + (idx >> 3) * AT_KSTR + (p_ >> 1) * 32 + (p_ & 1) * 8; \
            *(LAS u32x2*)d_ = (u32x2){vreg[i_].x, vreg[i_].y}; *(LAS u32x2*)(d_ + 16) = (u32x2){vreg[i_].z, vreg[i_].w}; } } } while (0)
    AT_GLOAD(kt_hi - 1); AT_LWRITE(0);
    __syncthreads();
    const int ntile = kt_hi - kt_lo;
    for (int it = 0; it < ntile; ++it) {
        const int kt = kt_hi - 1 - it, buf = it & 1, key0 = 64 * kt;
        if (it + 1 < ntile) AT_GLOAD(kt - 1);
        bool skip;
        if (MODE == 0) skip = key0 > qw_last;
        else if (MODE == 1) skip = (key0 > qw_last) || !((orm >> kt) & 1u);
        else if (MODE == 2) skip = (key0 > qw_last) || (key0 + 63 < qw_first - 511);
        else skip = key0 >= nv_wmax;
        if (!skip) {
            const LAS unsigned char* kb = lds + (buf ? KB1 : KB0); const LAS unsigned char* vb = lds + (buf ? VB1 : VB0);
            f32x16 S[2];
#pragma unroll
            for (int kk = 0; kk < 2; ++kk) {
                S[kk] = cb[kk];
#pragma unroll
                for (int ks = 0; ks < 4; ++ks) { const bf16x8 a = *(const LAS bf16x8*)(kb + (32 * kk + r) * AT_KSTR + (16 * ks + 8 * hh) * 2);
                    S[kk] = __builtin_amdgcn_mfma_f32_32x32x16_bf16(a, qf[ks], S[kk], 0, 0, 0); }
            }
            const bool bnd = (MODE == 3) ? true : ((key0 + 63 > qw_first) || (MODE == 2 && key0 < qw_last - 511));
            if (bnd) {
                const int lim = (MODE == 3) ? (nv - key0 - 4 * hh) : (qrow - key0 - 4 * hh);
#pragma unroll
                for (int kk = 0; kk < 2; ++kk)
#pragma unroll
                    for (int i = 0; i < 16; ++i) { const int cki = 32 * kk + 8 * (i >> 2) + (i & 3);
                        bool valid;
                        if (MODE == 3) valid = cki < lim; else if (MODE == 2) valid = (cki <= lim) && (cki > lim - 512); else valid = cki <= lim;
                        S[kk][i] = valid ? S[kk][i] : NEGF; }
            }
            float mx = NEGF;
#pragma unroll
            for (int kk = 0; kk < 2; ++kk)
#pragma unroll
                for (int i = 0; i < 16; ++i) mx = fmaxf(mx, S[kk][i]);
            mx = fmaxf(mx, __shfl_xor(mx, 32));
            const float off = (MODE == 3) ? 0.f : slope * (float)key0;
            mx += off;
            bool selok = true;
            if (MODE == 1) { selok = ((selm >> kt) & 1u) != 0u; mx = selok ? mx : NEGF; }
            const float mnew = fmaxf(mrun, mx);
            const float meff = (mnew < -1e29f) ? 0.f : mnew;
            float c = (off - meff) * LOG2E;
            if (MODE == 1) c = selok ? c : NEGF;
            float ps = 0.f;
#pragma unroll
            for (int kk = 0; kk < 2; ++kk)
#pragma unroll
                for (int i = 0; i < 16; ++i) { const float p = __builtin_amdgcn_exp2f(__builtin_fmaf(S[kk][i], LOG2E, c)); S[kk][i] = p; ps += p; }
            if (__any(mnew > mrun)) {
                const float alpha = __builtin_amdgcn_exp2f((mrun - mnew) * LOG2E);
                lrun *= alpha;
#pragma unroll
                for (int rb = 0; rb < NRB; ++rb)
#pragma unroll
                    for (int i = 0; i < 16; ++i) O[rb][i] *= alpha;
            }
            mrun = mnew; lrun += ps;
#pragma unroll
            for (int kk = 0; kk < 2; ++kk)
#pragma unroll
                for (int s2 = 0; s2 < 2; ++s2) {
                    u32x4 pw; pw.x = pk2(S[kk][8 * s2 + 0], S[kk][8 * s2 + 1]); pw.y = pk2(S[kk][8 * s2 + 2], S[kk][8 * s2 + 3]);
                    pw.z = pk2(S[kk][8 * s2 + 4], S[kk][8 * s2 + 5]); pw.w = pk2(S[kk][8 * s2 + 6], S[kk][8 * s2 + 7]);
                    const bf16x8 pf = __builtin_bit_cast(bf16x8, pw);
#pragma unroll
                    for (int rb = 0; rb < NRB; ++rb) {
                        const bf16x8 a = *(const LAS bf16x8*)(vb + (32 * rb + r) * AT_KSTR + (2 * kk + s2) * 32 + hh * 16);
                        O[rb] = __builtin_amdgcn_mfma_f32_32x32x16_bf16(a, pf, O[rb], 0, 0, 0);
                    }
                }
        }
        if (it + 1 < ntile) AT_LWRITE(buf ^ 1);
        __syncthreads();
    }
#undef AT_GLOAD
#undef AT_LWRITE
    const float ltot = lrun + __shfl_xor(lrun, 32);
    float inv = 1.0f / ltot;
    if (MODE == 3) inv = (nv > 0) ? inv : 0.f;
#pragma unroll
    for (int rb = 0; rb < NRB; ++rb)
#pragma unroll
        for (int g4 = 0; g4 < 4; ++g4) {
            const float a = O[rb][4 * g4] * inv, b = O[rb][4 * g4 + 1] * inv, c = O[rb][4 * g4 + 2] * inv, d = O[rb][4 * g4 + 3] * inv;
            const int dv = 32 * rb + 8 * g4 + 4 * hh;
            if (MODE == 3 && rb == 2) { *(f32x4*)(impp + (size_t)(32 * w + r) * 256 + (dv - 64)) = (f32x4){a, b, c, d}; }
            else { u32x2 o; o.x = pk2(a, b); o.y = pk2(c, d); *(u32x2*)(Op + (size_t)(32 * w + r) * ldo + dv) = o; }
        }
}

struct Args { const float* in[26]; float* out; unsigned char* ws; int ph_lo, ph_hi; };
typedef const __attribute__((address_space(4))) Args* ArgsP;
DI ArgsP opaque_args() { auto p = __builtin_amdgcn_kernarg_segment_ptr(); asm volatile("" : "+s"(p)); return (ArgsP)p; }
enum { I_X = 0, I_P, I_N1G, I_N2G, I_EVWIN, I_EVWOUT, I_DAQN, I_DAKN, I_DALAM, I_DAOUTG, I_NSQN, I_NSKN, I_CMPPE, I_CMPW1, I_CMPW2, I_ODWIN, I_ODWOUT,
       I_RETG, I_ROUTW, I_ROUTB, I_WGU, I_BGU, I_WDN, I_BDN, I_PLEP, I_PLEG };

struct CvtJob { int in_idx, ldsrc, K, col0, ncols, dstrow0, perm, nmat; size_t src_stride, dst_off, dst_stride; };
constexpr int NJOBS = 19;
__constant__ CvtJob c_jobs[NJOBS] = {
    {I_EVWIN, EVIN, 1024, 0,    1024, 0,    1, 2, (size_t)1024 * EVIN, WS_EVNAT, (size_t)2048 * 1024},
    {I_EVWIN, EVIN, 1024, 1536, 512,  1024, 1, 2, (size_t)1024 * EVIN, WS_EVNAT, (size_t)2048 * 1024},
    {I_EVWIN, EVIN, 1024, 2048, 128,  1536, 1, 2, (size_t)1024 * EVIN, WS_EVNAT, (size_t)2048 * 1024},
    {I_EVWIN, EVIN, 1024, 2176, 128,  1664, 1, 2, (size_t)1024 * EVIN, WS_EVNAT, (size_t)2048 * 1024},
    {I_EVWIN, EVIN, 1024, 2304, 128,  1792, 1, 2, (size_t)1024 * EVIN, WS_EVNAT, (size_t)2048 * 1024},
    {I_EVWIN, EVIN, 1024, 2560, 128,  1920, 1, 2, (size_t)1024 * EVIN, WS_EVNAT, (size_t)2048 * 1024},
    {I_EVWIN, EVIN, 1024, 1024, 512,  0,    0, 2, (size_t)1024 * EVIN, WS_EVSW,  (size_t)768 * 1024},
    {I_EVWIN, EVIN, 1024, 2432, 128,  512,  0, 2, (size_t)1024 * EVIN, WS_EVSW,  (size_t)768 * 1024},
    {I_EVWIN, EVIN, 1024, 2688, 128,  640,  0, 2, (size_t)1024 * EVIN, WS_EVSW,  (size_t)768 * 1024},
    {I_EVWOUT, 1024, 1024, 0, 1024, 0, 0, 2, (size_t)1024 * 1024, WS_EVOUT, (size_t)1024 * 1024},
    {I_CMPW1, 256, 2048, 0, 256, 0, 0, 4, (size_t)2048 * 256, WS_CMP1, (size_t)256 * 2048},
    {I_ODWIN, ODIN, 1024, 0,    2048, 0,    0, 2, (size_t)1024 * ODIN, WS_ODNAT, (size_t)4096 * 1024},
    {I_ODWIN, ODIN, 1024, 4096, 2048, 2048, 0, 2, (size_t)1024 * ODIN, WS_ODNAT, (size_t)4096 * 1024},
    {I_ODWIN, ODIN, 1024, 1024, 3072, 0,    0, 2, (size_t)1024 * ODIN, WS_ODSW,  (size_t)3072 * 1024},
    {I_ODWOUT, 1024, 2048, 0, 1024, 0, 0, 2, (size_t)2048 * 1024, WS_ODOUT, (size_t)1024 * 2048},
    {I_WGU, 2048, 1024, 0, 2048, 0, 2, 128, (size_t)1024 * 2048, WS_WGU, (size_t)2048 * 1024},
    {I_WDN, 1024, 1024, 0, 1024, 0, 0, 128, (size_t)1024 * 1024, WS_WDN, (size_t)1024 * 1024},
    {I_PLEP, 1024, 256, 0, 1024, 0, 0, 4, (size_t)256 * 1024, WS_WPP, (size_t)1024 * 256},
    {I_PLEG, 1024, 1024, 0, 1024, 0, 0, 4, (size_t)1024 * 1024, WS_WPG, (size_t)1024 * 1024},
};
DI int cvt_dstrow(int perm, int L) {
    if (perm == 1) { const int pn = L >> 8, lc = L & 255; return pn * 256 + 128 * ((lc & 63) >> 5) + 32 * (lc >> 6) + (lc & 31); }
    if (perm == 2) { const int bj = L >> 10, cc = L & 1023; return 256 * (cc >> 7) + 128 * bj + (cc & 127); }
    return L;
}
DI void phase_prologue(const int WID, ArgsP a, LAS unsigned char* lds) {
    const int tid = opaque_tid(WID), lane = tid & 63, wv = tid >> 6;
    const int gw = blockIdx.x * 8 + wv, NGW = gridDim.x * 8;
    LAS float* scr = (LAS float*)(lds + wv * 16640);
    int total = 0;
    for (int j = 0; j < NJOBS; ++j) total += c_jobs[j].nmat * (c_jobs[j].K >> 6) * (c_jobs[j].ncols >> 6);
    for (int it = gw; it < total; it += NGW) {
        int r = it, j = 0;
        for (; j < NJOBS; ++j) { const int n = c_jobs[j].nmat * (c_jobs[j].K >> 6) * (c_jobs[j].ncols >> 6); if (r < n) break; r -= n; }
        const CvtJob J = c_jobs[j];
        const int nkb = J.K >> 6, nnb = J.ncols >> 6, per = nkb * nnb;
        const int mat = r / per, rr = r % per, kb = rr / nnb, nb = rr % nnb, k0 = kb * 64, n0 = nb * 64;
        const float* src = a->in[J.in_idx] + (size_t)mat * J.src_stride + (size_t)k0 * J.ldsrc + J.col0 + n0 + lane;
        { float tv[64];
#pragma unroll
          for (int i = 0; i < 64; ++i) tv[i] = src[(size_t)i * J.ldsrc];
#pragma unroll
          for (int i = 0; i < 64; ++i) scr[i * 65 + lane] = tv[i]; }
        asm volatile("s_waitcnt lgkmcnt(0)" ::: "memory");
        bf16_t* dst = (bf16_t*)(a->ws + J.dst_off) + (size_t)mat * J.dst_stride;
        const int c = lane & 7, nsub = lane >> 3;
#pragma unroll
        for (int jj = 0; jj < 8; ++jj) {
            const int n = nsub + 8 * jj; const LAS float* s = scr + (8 * c) * 65 + n;
            u32x4 o; o.x = pk2(s[0], s[65]); o.y = pk2(s[2 * 65], s[3 * 65]); o.z = pk2(s[4 * 65], s[5 * 65]); o.w = pk2(s[6 * 65], s[7 * 65]);
            const int drow = cvt_dstrow(J.perm, J.dstrow0 + n0 + n);
            *(u32x4*)(dst + (size_t)drow * J.K + k0 + 8 * c) = o;
        }
        asm volatile("s_waitcnt lgkmcnt(0)" ::: "memory");
    }
    {
        const float* p = a->in[I_P]; bf16_t* pb = (bf16_t*)(a->ws + WS_PBF);
        const size_t n8 = (size_t)DEPTH * T * 256 / 8;
        for (size_t i = (size_t)blockIdx.x * 512 + tid; i < n8; i += (size_t)gridDim.x * 512) {
            const f32x4 v0 = *(const f32x4*)(p + i * 8), v1 = *(const f32x4*)(p + i * 8 + 4);
            *(u32x4*)(pb + i * 8) = pack8(v0, v1);
        }
    }
    if (blockIdx.x == 4 && tid < 512) { const int ev = tid >> 8, gi = (tid >> 6) & 3, d = tid & 63;
        const float* src = a->in[gi == 0 ? I_DAQN : gi == 1 ? I_DAKN : gi == 2 ? I_NSQN : I_NSKN];
        ((float*)(a->ws + WS_GAINS))[tid] = src[ev * 64 + d]; }
    if (blockIdx.x < 4 && tid < 256) {
        const int m = blockIdx.x; const float* pe = a->in[I_CMPPE] + (size_t)m * 2048; const float* w1 = a->in[I_CMPW1] + (size_t)m * 2048 * 256;
        float s = 0.f;
        for (int k = 0; k < 2048; ++k) s += pe[k] * w1[(size_t)k * 256 + tid];
        ((float*)(a->ws + WS_BIAS1))[m * 256 + tid] = s;
    }
}

DI float row_load_ss(const float* row, int lane, f32x4 (&v)[4]) {
    float ss = 0.f;
#pragma unroll
    for (int j = 0; j < 4; ++j) { v[j] = *(const f32x4*)(row + 4 * lane + 256 * j); ss += (v[j][0] * v[j][0] + v[j][1] * v[j][1]) + (v[j][2] * v[j][2] + v[j][3] * v[j][3]); }
    return wave_sum(ss);
}
DI void row_store_bf16(bf16_t* row, int lane, const f32x4 (&v)[4]) {
#pragma unroll
    for (int j = 0; j < 4; ++j) { u32x2 o; o.x = pk2(v[j][0], v[j][1]); o.y = pk2(v[j][2], v[j][3]); *(u32x2*)(row + 4 * lane + 256 * j) = o; }
}
template <int MODE>
DI void phase_norm(const int WID, ArgsP a, LAS unsigned char* lds, int layer, const float* Hin) {
    const int tid = opaque_tid(WID), lane = tid & 63, wv = __builtin_amdgcn_readfirstlane(tid >> 6);
    LAS float* wt = (LAS float*)lds;
    LAS int* bcl = (LAS int*)(lds + MISC_OFF + MO_WCNT); LAS int* ent = (LAS int*)(lds + MISC_OFF + MO_ENT); LAS float* gat = (LAS float*)(lds + MISC_OFF + MO_GAT);
    LAS float* lgb = (LAS float*)(lds + MISC_OFF + MO_RED);
    bf16_t* XN = (bf16_t*)(a->ws + WS_XN);
    const float* gain = a->in[MODE == 2 ? I_N2G : I_N1G] + layer * 1024;
    constexpr int NQ = MODE == 0 ? 24 : (MODE == 2 ? 32 : 0);
    if (NQ > 0) {
        const float* w = (MODE == 0) ? a->in[I_EVWIN] + (size_t)(layer >> 1) * 1024 * EVIN + 2816 : a->in[I_ROUTW] + (size_t)layer * 1024 * 32;
        const int ldw = (MODE == 0) ? EVIN : 32;
        for (int i = tid; i < 256 * 32; i += 512) { const int q = i & 31, g = i >> 5;
            if (q < NQ) { f32x4 v; v[0] = w[(size_t)(4 * g) * ldw + q]; v[1] = w[(size_t)(4 * g + 1) * ldw + q]; v[2] = w[(size_t)(4 * g + 2) * ldw + q]; v[3] = w[(size_t)(4 * g + 3) * ldw + q];
                *(LAS f32x4*)(wt + q * 1024 + 4 * (g ^ q)) = v; } }
    }
    f32x4 gn[4];
#pragma unroll
    for (int j = 0; j < 4; ++j) gn[j] = *(const f32x4*)(gain + 4 * lane + 256 * j);
    const float rbias = (MODE == 2) ? a->in[I_ROUTB][layer * 32 + (lane & 31)] : 0.f;
    __syncthreads();
    for (int vb = blockIdx.x; vb < NTB; vb += gridDim.x) {
        if (MODE == 2) { if (tid < 32) bcl[tid] = 0; }
        const int t0 = vb * 128 + wv * 16;
        f32x4 na[4], nb[4];
#pragma unroll
        for (int j = 0; j < 4; ++j) { na[j] = *(const f32x4*)(Hin + (size_t)t0 * 1024 + 4 * lane + 256 * j); nb[j] = *(const f32x4*)(Hin + (size_t)(t0 + 1) * 1024 + 4 * lane + 256 * j); }
#pragma unroll 1
        for (int it = 0; it < 8; ++it) {
            const int ta = t0 + 2 * it;
            f32x4 va[4], vc[4];
#pragma unroll
            for (int j = 0; j < 4; ++j) { va[j] = na[j]; vc[j] = nb[j]; }
            if (it < 7) {
#pragma unroll
                for (int j = 0; j < 4; ++j) { na[j] = *(const f32x4*)(Hin + (size_t)(ta + 2) * 1024 + 4 * lane + 256 * j); nb[j] = *(const f32x4*)(Hin + (size_t)(ta + 3) * 1024 + 4 * lane + 256 * j); }
            }
            float sa = 0.f, sb = 0.f;
#pragma unroll
            for (int j = 0; j < 4; ++j) { sa += (va[j][0] * va[j][0] + va[j][1] * va[j][1]) + (va[j][2] * va[j][2] + va[j][3] * va[j][3]); sb += (vc[j][0] * vc[j][0] + vc[j][1] * vc[j][1]) + (vc[j][2] * vc[j][2] + vc[j][3] * vc[j][3]); }
#pragma unroll
            for (int o = 1; o < 64; o <<= 1) { sa += __shfl_xor(sa, o); sb += __shfl_xor(sb, o); }
            const float ra = rsqrtf(sa * (1.0f / 1024.0f) + EPS), rb2 = rsqrtf(sb * (1.0f / 1024.0f) + EPS);
#pragma unroll
            for (int j = 0; j < 4; ++j) { va[j] = va[j] * ra * gn[j]; vc[j] = vc[j] * rb2 * gn[j]; }
            row_store_bf16(XN + (size_t)ta * 1024, lane, va); row_store_bf16(XN + (size_t)(ta + 1) * 1024, lane, vc);
            if (NQ > 0) {
                float x[64];
#pragma unroll
                for (int q = 0; q < 32; ++q) {
                    if (q < NQ) { float s0 = 0.f, s1 = 0.f;
#pragma unroll
                        for (int j = 0; j < 4; ++j) { const f32x4 ww = *(const LAS f32x4*)(wt + q * 1024 + 4 * ((lane + 64 * j) ^ q));
                            s0 += (va[j][0] * ww[0] + va[j][1] * ww[1]) + (va[j][2] * ww[2] + va[j][3] * ww[3]); s1 += (vc[j][0] * ww[0] + vc[j][1] * ww[1]) + (vc[j][2] * ww[2] + vc[j][3] * ww[3]); }
                        x[q] = s0; x[32 + q] = s1;
                        if ((q & 3) == 3) asm volatile("" ::: "memory");
                    } else { x[q] = 0.f; x[32 + q] = 0.f; }
                }
#define RS_STEP(N, BIT) _Pragma("unroll") for (int i = 0; i < (N); ++i) { const bool up = (lane & (BIT)) != 0; const float keep = up ? x[(N) + i] : x[i], send = up ? x[i] : x[(N) + i]; x[i] = keep + __shfl_xor(send, (BIT)); }
                RS_STEP(32, 32) RS_STEP(16, 16) RS_STEP(8, 8) RS_STEP(4, 4) RS_STEP(2, 2) RS_STEP(1, 1)
#undef RS_STEP
                const float val = x[0];
                if (MODE == 0) { if ((lane & 31) < 24) ((float*)(a->ws + WS_GATES))[(size_t)(ta + (lane >> 5)) * 24 + (lane & 31)] = sigm(val); }
                if (MODE == 2) {
                    lgb[wv * 64 + lane] = val + rbias;
                    asm volatile("s_waitcnt lgkmcnt(0)" ::: "memory");
                    float lg[32];
#pragma unroll
                    for (int q4 = 0; q4 < 8; ++q4) { const f32x4 t4 = *(const LAS f32x4*)(lgb + wv * 64 + (lane & 32) + 4 * q4); lg[4 * q4] = t4[0]; lg[4 * q4 + 1] = t4[1]; lg[4 * q4 + 2] = t4[2]; lg[4 * q4 + 3] = t4[3]; }
                    unsigned used = 0u; int te[4]; float tv[4];
#pragma unroll
                    for (int k = 0; k < 4; ++k) { float best = -3.0e38f; int bi = 0;
#pragma unroll
                        for (int q = 0; q < 32; ++q) { const bool ok = !((used >> q) & 1u) && (lg[q] > best); best = ok ? lg[q] : best; bi = ok ? q : bi; }
                        used |= 1u << bi; te[k] = bi; tv[k] = best; }
                    float ex[4], sum = 0.f;
#pragma unroll
                    for (int k = 0; k < 4; ++k) { ex[k] = __expf(tv[k] - tv[0]); sum += ex[k]; }
                    const float rs = 1.0f / sum;
                    if ((lane & 31) == 0) {
                        const int eb = wv * 64 + (2 * it + (lane >> 5)) * 4;
#pragma unroll
                        for (int k = 0; k < 4; ++k) { ent[eb + k] = te[k]; gat[eb + k] = ex[k] * rs; }
                    }
                    asm volatile("s_waitcnt lgkmcnt(0)" ::: "memory");
                }
            }
        }
        if (MODE == 2) {
            __syncthreads();
            { const int e = ent[wv * 64 + lane];
              const int pos = __hip_atomic_fetch_add(bcl + e, 1, __ATOMIC_RELAXED, __HIP_MEMORY_SCOPE_WORKGROUP);
              const size_t idx = (size_t)(vb * 128 + wv * 16) * 4 + lane;
              ((int*)(a->ws + WS_TOPE))[idx] = e; ((int*)(a->ws + WS_POSB))[idx] = pos; ((float*)(a->ws + WS_GATEW))[idx] = gat[wv * 64 + lane]; }
            __syncthreads();
            if (tid < 32) ((int*)(a->ws + WS_BCNT))[((size_t)layer * NTB + vb) * 32 + tid] = bcl[tid];
            __syncthreads();
        }
    }
}
DI void moe_tables(const int WID, ArgsP a, LAS unsigned char* lds, int layer, int vb) {
    const int tid = opaque_tid(WID);
    LAS int* tot = (LAS int*)(lds + MISC_OFF + MO_TOT); LAS int* base = (LAS int*)(lds + MISC_OFF + MO_BASE); LAS int* ts = (LAS int*)(lds + MISC_OFF + MO_TS);
    LAS int* red = (LAS int*)(lds + MISC_OFF + MO_RED);
    const int* bc = (const int*)(a->ws + WS_BCNT) + (size_t)layer * NTB * 32;
    { const int e = tid & 31, part = tid >> 5; int st = 0, sp = 0;
      for (int blk = part; blk < NTB; blk += 16) { const int v = bc[blk * 32 + e]; st += v; sp += (blk < vb) ? v : 0; }
      red[part * 32 + e] = st; red[512 + part * 32 + e] = sp; }
    __syncthreads();
    if (tid < 32) { int st = 0, sp = 0;
#pragma unroll
        for (int p = 0; p < 16; ++p) { st += red[p * 32 + tid]; sp += red[512 + p * 32 + tid]; }
        tot[tid] = st; base[tid] = sp; }
    __syncthreads();
    if (tid == 0) { int acc = 0; for (int e = 0; e < 32; ++e) { ts[e] = acc; acc += (tot[e] + 255) >> 8; } ts[32] = acc; }
    __syncthreads();
}
DI void phase_moe_slots(const int WID, ArgsP a, LAS unsigned char* lds, int layer) {
    const int tid = opaque_tid(WID), lane = tid & 63, wv = tid >> 6;
    LAS int* base = (LAS int*)(lds + MISC_OFF + MO_BASE); LAS int* ts = (LAS int*)(lds + MISC_OFF + MO_TS);
    const bf16_t* XN = (const bf16_t*)(a->ws + WS_XN); bf16_t* XB = (bf16_t*)(a->ws + WS_XB);
    for (int vb = blockIdx.x; vb < NTB; vb += gridDim.x) {
        moe_tables(WID, a, lds, layer, vb);
#pragma unroll 1
        for (int i = 0; i < 16; ++i) {
            const int t = vb * 128 + wv * 16 + i;
            int dest = 0;
            if (lane < 4) { const int e = ((const int*)(a->ws + WS_TOPE))[(size_t)t * 4 + lane], pos = ((const int*)(a->ws + WS_POSB))[(size_t)t * 4 + lane];
                dest = ts[e] * 256 + base[e] + pos; ((int*)(a->ws + WS_DEST))[(size_t)t * 4 + lane] = dest; }
            const u32x4 r0 = *(const u32x4*)(XN + (size_t)t * 1024 + 8 * lane), r1 = *(const u32x4*)(XN + (size_t)t * 1024 + 512 + 8 * lane);
#pragma unroll
            for (int k = 0; k < 4; ++k) { const int d = __shfl(dest, k); bf16_t* o = XB + (size_t)d * 1024; *(u32x4*)(o + 8 * lane) = r0; *(u32x4*)(o + 512 + 8 * lane) = r1; }
        }
        __syncthreads();
    }
}
DI void phase_combine(const int WID, ArgsP a, float* H) {
    const int tid = opaque_tid(WID), lane = tid & 63, wv = tid >> 6;
    const bf16_t* YB = (const bf16_t*)(a->ws + WS_YB); bf16_t* XN = (bf16_t*)(a->ws + WS_XN);
    for (int t = blockIdx.x * 8 + wv; t < T; t += gridDim.x * 8) {
        int dest = 0; float gw = 0.f;
        if (lane < 4) { dest = ((const int*)(a->ws + WS_DEST))[(size_t)t * 4 + lane]; gw = ((const float*)(a->ws + WS_GATEW))[(size_t)t * 4 + lane]; }
        f32x4 v[4];
#pragma unroll
        for (int j = 0; j < 4; ++j) v[j] = *(const f32x4*)(H + (size_t)t * 1024 + 4 * lane + 256 * j);
#pragma unroll
        for (int k = 0; k < 4; ++k) { const int d = __shfl(dest, k); const float g = __shfl(gw, k); const bf16_t* y = YB + (size_t)d * 1024;
#pragma unroll
            for (int j = 0; j < 4; ++j) { const u32x2 w = *(const u32x2*)(y + 4 * lane + 256 * j); v[j][0] += g * bflo(w.x); v[j][1] += g * bfhi(w.x); v[j][2] += g * bflo(w.y); v[j][3] += g * bfhi(w.y); } }
        float ss = 0.f;
#pragma unroll
        for (int j = 0; j < 4; ++j) { *(f32x4*)(H + (size_t)t * 1024 + 4 * lane + 256 * j) = v[j]; ss += (v[j][0] * v[j][0] + v[j][1] * v[j][1]) + (v[j][2] * v[j][2] + v[j][3] * v[j][3]); }
        ss = wave_sum(ss);
        const float rstd = rsqrtf(ss * (1.0f / 1024.0f) + EPS);
#pragma unroll
        for (int j = 0; j < 4; ++j) v[j] = v[j] * rstd;
        row_store_bf16(XN + (size_t)t * 1024, lane, v);
    }
}
DI void phase_cmp2(const int WID, ArgsP a, LAS unsigned char* lds, int ev) {
    const int tid = opaque_tid(WID), lane = tid & 63, wv = __builtin_amdgcn_readfirstlane(tid >> 6);
    const bf16_t* HID = (const bf16_t*)(a->ws + WS_HID); bf16_t* KCMP = (bf16_t*)(a->ws + WS_KCMP); bf16_t* VCMPT = (bf16_t*)(a->ws + WS_VCMPT);
    const float kg = a->in[I_NSKN][ev * 64 + lane];
    LAS float* wl = (LAS float*)lds;
    for (int i = tid; i < 2 * 256 * 64 / 4; i += 512) *(LAS f32x4*)(wl + 4 * i) = *(const f32x4*)(a->in[I_CMPW2] + (size_t)ev * 2 * 256 * 64 + 4 * i);
    __syncthreads();
    for (int gi = blockIdx.x * 8 + wv; gi < 2048; gi += gridDim.x * 8) {
        const int kv = gi >> 10, row0 = (gi & 1023) * 4;
        const bf16_t* hrow = HID + ((size_t)kv * 4096 + row0) * 256;
        const LAS float* w2 = wl + kv * 256 * 64 + lane;
        float s[4] = {0.f, 0.f, 0.f, 0.f};
#pragma unroll 2
        for (int k = 0; k < 256; k += 8) {
            u32x4 hw[4];
#pragma unroll
            for (int r = 0; r < 4; ++r) hw[r] = *(const u32x4*)(hrow + r * 256 + k);
            float wv8[8];
#pragma unroll
            for (int j = 0; j < 8; ++j) wv8[j] = w2[(k + j) * 64];
#pragma unroll
            for (int r = 0; r < 4; ++r)
                s[r] += bflo(hw[r].x) * wv8[0] + bfhi(hw[r].x) * wv8[1] + bflo(hw[r].y) * wv8[2] + bfhi(hw[r].y) * wv8[3] + bflo(hw[r].z) * wv8[4] + bfhi(hw[r].z) * wv8[5] + bflo(hw[r].w) * wv8[6] + bfhi(hw[r].w) * wv8[7];
        }
#pragma unroll
        for (int r = 0; r < 4; ++r) {
            const int row = row0 + r, bg = row >> 7, n = row & 127;
            float v = (n == 127) ? 0.f : s[r];
            if (kv == 0) { const float ss = wave_sum(v * v); const float o = v * rsqrtf(ss * (1.0f / 64.0f) + EPS) * kg;
                KCMP[((size_t)bg * 128 + n) * 64 + lane] = (bf16_t)(pk2(o, 0.f) & 0xffffu); }
            else VCMPT[((size_t)bg * 96 + lane) * 128 + n] = (bf16_t)(pk2(v, 0.f) & 0xffffu);
        }
    }
    for (int i = blockIdx.x * 512 + tid; i < 32 * 32 * 128; i += gridDim.x * 512) {
        const int n = i & 127, j = (i >> 7) & 31, bg = i >> 12;
        float o = 0.f;
        if (n < 127) { const int d = n - 4 * j; if (d >= 0 && d <= 2) o = 1.0f; else if (d == 3 || d == -1) o = 0.5f; }
        VCMPT[((size_t)bg * 96 + 64 + j) * 128 + n] = (bf16_t)(pk2(o, 0.f) & 0xffffu);
    }
}
DI void phase_topk(const int WID, ArgsP a) {
    const float* IMPH = (const float*)(a->ws + WS_IMPH); unsigned* SELM = (unsigned*)(a->ws + WS_SELM);
    for (int i = blockIdx.x * 512 + opaque_tid(WID); i < T * 2; i += gridDim.x * 512) {
        const int t = i >> 1, g = i & 1, b = t >> 11, s = t & 2047, cur = s >> 6;
        float sc[32];
#pragma unroll
        for (int j4 = 0; j4 < 8; ++j4) { f32x4 acc = {0.f, 0.f, 0.f, 0.f};
#pragma unroll
            for (int r = 0; r < 4; ++r) acc += *(const f32x4*)(IMPH + ((size_t)t * 8 + g * 4 + r) * 32 + 4 * j4);
#pragma unroll
            for (int q = 0; q < 4; ++q) sc[4 * j4 + q] = acc[q]; }
        unsigned mask;
        if (cur < 16) mask = (cur == 31) ? 0xffffffffu : ((2u << cur) - 1u);
        else {
#pragma unroll
            for (int j = 0; j < 32; ++j) { const bool forced = (j == 0) || (j == cur) || (j == cur - 1); sc[j] = (j > cur) ? NEGF : (sc[j] + (forced ? 1e4f : 0.f)); }
            mask = 0u;
#pragma unroll
            for (int j = 0; j < 32; ++j) { int rank = 0;
#pragma unroll
                for (int k = 0; k < 32; ++k) rank += ((sc[k] > sc[j]) || (sc[k] == sc[j] && k < j)) ? 1 : 0;
                mask |= (rank < 16) ? (1u << j) : 0u; }
        }
        SELM[((size_t)(b * 2 + g)) * 2048 + s] = mask;
    }
}
DI void phase_mixprep(const int WID, ArgsP a, int layer) {
    const int tid = opaque_tid(WID), lane = tid & 63, wv = tid >> 6, ev = layer >> 1;
    const float* dl = a->in[I_DALAM] + ev * 256;
    const float s1 = wave_sum(dl[lane] * dl[64 + lane]), s2 = wave_sum(dl[128 + lane] * dl[192 + lane]);
    const float lam_init = 0.8f - 0.6f * expf(-0.3f * (float)layer);
    const float lam = expf(s1) - expf(s2) + lam_init;
    const float* og = a->in[I_DAOUTG] + ev * 128;
    const bf16_t* OD = (const bf16_t*)(a->ws + WS_OD); const bf16_t* OC = (const bf16_t*)(a->ws + WS_OC); const bf16_t* OS = (const bf16_t*)(a->ws + WS_OS); const bf16_t* OW = (const bf16_t*)(a->ws + WS_OW);
    const float* GT = (const float*)(a->ws + WS_GATES); bf16_t* AMIX = (bf16_t*)(a->ws + WS_AMIX);
    const int h = lane >> 4, dv = (lane & 15) * 8;
    f32x4 g0 = *(const f32x4*)(og + dv), g1 = *(const f32x4*)(og + dv + 4);
    for (int t = blockIdx.x * 8 + wv; t < T; t += gridDim.x * 8) {
        { const u32x4 w1 = *(const u32x4*)(OD + (size_t)t * 1024 + h * 128 + dv), w2 = *(const u32x4*)(OD + (size_t)t * 1024 + (4 + h) * 128 + dv);
          f32x4 d0, d1;
          d0[0] = bflo(w1.x) - lam * bflo(w2.x); d0[1] = bfhi(w1.x) - lam * bfhi(w2.x); d0[2] = bflo(w1.y) - lam * bflo(w2.y); d0[3] = bfhi(w1.y) - lam * bfhi(w2.y);
          d1[0] = bflo(w1.z) - lam * bflo(w2.z); d1[1] = bfhi(w1.z) - lam * bfhi(w2.z); d1[2] = bflo(w1.w) - lam * bflo(w2.w); d1[3] = bfhi(w1.w) - lam * bfhi(w2.w);
          float ss = (d0[0] * d0[0] + d0[1] * d0[1]) + (d0[2] * d0[2] + d0[3] * d0[3]) + (d1[0] * d1[0] + d1[1] * d1[1]) + (d1[2] * d1[2] + d1[3] * d1[3]);
          ss += __shfl_xor(ss, 1); ss += __shfl_xor(ss, 2); ss += __shfl_xor(ss, 4); ss += __shfl_xor(ss, 8);
          const float rs = rsqrtf(ss * (1.0f / 128.0f) + EPS) * (1.0f - lam_init);
          *(u32x4*)(AMIX + (size_t)t * 1024 + h * 128 + dv) = pack8(d0 * rs * g0, d1 * rs * g1); }
        { const int hd = lane >> 3, dq = (lane & 7) * 8; const size_t o = (size_t)t * 512 + hd * 64 + dq;
          const float ga = GT[(size_t)t * 24 + hd * 3], gb = GT[(size_t)t * 24 + hd * 3 + 1], gc = GT[(size_t)t * 24 + hd * 3 + 2];
          const u32x4 c = *(const u32x4*)(OC + o), s = *(const u32x4*)(OS + o), w = *(const u32x4*)(OW + o);
          f32x4 r0, r1;
          r0[0] = ga * bflo(c.x) + gb * bflo(s.x) + gc * bflo(w.x); r0[1] = ga * bfhi(c.x) + gb * bfhi(s.x) + gc * bfhi(w.x);
          r0[2] = ga * bflo(c.y) + gb * bflo(s.y) + gc * bflo(w.y); r0[3] = ga * bfhi(c.y) + gb * bfhi(s.y) + gc * bfhi(w.y);
          r1[0] = ga * bflo(c.z) + gb * bflo(s.z) + gc * bflo(w.z); r1[1] = ga * bfhi(c.z) + gb * bfhi(s.z) + gc * bfhi(w.z);
          r1[2] = ga * bflo(c.w) + gb * bflo(s.w) + gc * bflo(w.w); r1[3] = ga * bfhi(c.w) + gb * bfhi(s.w) + gc * bfhi(w.w);
          *(u32x4*)(AMIX + (size_t)t * 1024 + 512 + hd * 64 + dq) = pack8(r0, r1); }
    }
}
DI void phase_scan(const int WID, ArgsP a) {
    const float* UT = (const float*)(a->ws + WS_UT); bf16_t* VS = (bf16_t*)(a->ws + WS_VS);
    for (int i = blockIdx.x * 512 + opaque_tid(WID); i < 64 * 512 * 64; i += gridDim.x * 512) {
        const int d4 = i & 63, f = (i >> 6) & 511, bh = i >> 15, h = bh & 3;
        const float dec = exp2f(256.0f * ret_lg2(h));
        f32x4 S = {0.f, 0.f, 0.f, 0.f};
#pragma unroll 1
        for (int n = 0; n < 8; ++n) {
            const size_t z = (size_t)bh * 8 + n;
            u32x2 o; o.x = pk2(S[0], S[1]); o.y = pk2(S[2], S[3]);
            *(u32x2*)(VS + (z * 512 + f) * 512 + 256 + 4 * d4) = o;
            const f32x4 u = *(const f32x4*)(UT + z * 131072 + (size_t)f * 256 + 4 * d4);
            S = (S + u) * dec;
        }
    }
}
DI void phase_normgate(const int WID, ArgsP a, int od) {
    const int tid = opaque_tid(WID), lane = tid & 63, wv = tid >> 6;
    const bf16_t* Y = (const bf16_t*)(a->ws + WS_Y); const bf16_t* GG = (const bf16_t*)(a->ws + WS_GG); bf16_t* YG = (bf16_t*)(a->ws + WS_YG);
    const float* og = a->in[I_RETG] + od * 512;
    const f32x4 g0 = *(const f32x4*)(og + 8 * lane), g1 = *(const f32x4*)(og + 8 * lane + 4);
    for (int t = blockIdx.x * 8 + wv; t < T; t += gridDim.x * 8) {
#pragma unroll
        for (int h = 0; h < 4; ++h) {
            const size_t o = (size_t)t * 2048 + h * 512 + 8 * lane;
            const u32x4 yw = *(const u32x4*)(Y + o), gw = *(const u32x4*)(GG + o);
            f32x4 y0 = {bflo(yw.x), bfhi(yw.x), bflo(yw.y), bfhi(yw.y)}, y1 = {bflo(yw.z), bfhi(yw.z), bflo(yw.w), bfhi(yw.w)};
            const f32x4 q0 = {bflo(gw.x), bfhi(gw.x), bflo(gw.y), bfhi(gw.y)}, q1 = {bflo(gw.z), bfhi(gw.z), bflo(gw.w), bfhi(gw.w)};
            float ss = (y0[0] * y0[0] + y0[1] * y0[1]) + (y0[2] * y0[2] + y0[3] * y0[3]) + (y1[0] * y1[0] + y1[1] * y1[1]) + (y1[2] * y1[2] + y1[3] * y1[3]);
            ss = wave_sum(ss);
            const float rs = rsqrtf(ss * (1.0f / 512.0f) + EPS);
            *(u32x4*)(YG + o) = pack8(y0 * rs * g0 * q0, y1 * rs * g1 * q1);
        }
    }
}
DI int snake_unit(int rnd, int G, int c) { return (rnd & 1) ? rnd * G + (G - 1 - c) : rnd * G + c; }
template <int MODE>
DI void phase_attn(const int WID, ArgsP a, LAS unsigned char* lds) {
    const int G = gridDim.x, c = blockIdx.x;
    const bf16_t* QD = (const bf16_t*)(a->ws + WS_QD); const bf16_t* KD = (const bf16_t*)(a->ws + WS_KD); const bf16_t* QN = (const bf16_t*)(a->ws + WS_QN);
    for (int rnd = 0;; ++rnd) {
        const int L = snake_unit(rnd, G, c); if (L >= 1024) { if (rnd * G >= 1024) break; else continue; }
        const int qb = 7 - (L >> 7), bh = L & 127, b = bh >> 3, hd = bh & 7, q0 = qb * 256; const size_t t0 = (size_t)b * 2048 + q0;
        if (MODE == 0) {
            const float slope = exp2f(-2.0f * (float)((hd & 3) + 1));
            attn_unit<128, 0>(WID, lds, QD + t0 * 512 + hd * 64, 512, KD + (size_t)b * 2048 * 512 + hd * 64, 512,
                              (const bf16_t*)(a->ws + WS_VAT) + (size_t)(b * 4 + (hd & 3)) * 128 * 2048, 2048, q0, slope, nullptr,
                              (bf16_t*)(a->ws + WS_OD) + t0 * 1024 + hd * 128, 1024, nullptr);
        } else if (MODE == 1 || MODE == 2) {
            const int g = hd >> 2; const float slope = exp2f(-(float)(hd + 1));
            const bf16_t* Kb = (const bf16_t*)(a->ws + (MODE == 1 ? WS_KSB : WS_KWB)) + (size_t)(b * 2 + g) * 2048 * 64;
            const bf16_t* Vb = (const bf16_t*)(a->ws + (MODE == 1 ? WS_VST : WS_VWT)) + (size_t)(b * 2 + g) * 64 * 2048;
            attn_unit<64, MODE>(WID, lds, QN + t0 * 512 + hd * 64, 512, Kb, 64, Vb, 2048, q0, slope,
                                (const unsigned*)(a->ws + WS_SELM) + (size_t)(b * 2 + g) * 2048 + q0,
                                (bf16_t*)(a->ws + (MODE == 1 ? WS_OS : WS_OW)) + t0 * 512 + hd * 64, 512, nullptr);
        } else {
            const int g = hd >> 2;
            attn_unit<96, 3>(WID, lds, QN + t0 * 512 + hd * 64, 512, (const bf16_t*)(a->ws + WS_KCMP) + (size_t)(b * 2 + g) * 128 * 64, 64,
                             (const bf16_t*)(a->ws + WS_VCMPT) + (size_t)(b * 2 + g) * 96 * 128, 128, q0, 0.f, nullptr,
                             (bf16_t*)(a->ws + WS_OC) + t0 * 512 + hd * 64, 512, (float*)(a->ws + WS_IMPH) + (t0 * 8 + hd) * 32);
        }
    }
}

constexpr int PPL = 15;
constexpr int NPHASE = 1 + DEPTH * PPL;
__global__ void __launch_bounds__(512, 2) mk_fwd(Args a_unused) {
    ArgsP a = opaque_args();
    extern __shared__ __attribute__((aligned(16))) unsigned char lds_raw[];
    LAS unsigned char* lds = (LAS unsigned char*)lds_raw;
    const int tid = threadIdx.x, G = gridDim.x, c = blockIdx.x;
    const int WID = __builtin_amdgcn_readfirstlane(tid >> 6);
    volatile LAS unsigned* misc = (volatile LAS unsigned*)(lds + MISC_OFF);
    if (tid < 4) misc[tid] = 0u;
    __syncthreads();
    unsigned* ctl = (unsigned*)(a->ws + WS_CTL);
    XcdBarrier bar; bar.bar = ctl + CW_BAR; bar.x = 0; bar.st = misc;
    const int ph_lo = a->ph_lo, ph_hi = a->ph_hi;
    const bool multi = (ph_hi - ph_lo) > 1;
    if (multi) bar = xcd_barrier_post(WID, ctl + CW_BAR, misc);
    bool first = true;
#define PHASE_BEGIN(k, id) if ((DBG_ONLY < 0 || DBG_ONLY == (id)) && (k) >= ph_lo && (k) < ph_hi && (k) <= DBG_LAST_PHASE) { if (!first) { xcd_barrier(WID, bar); if (PROBE_MASK >> 31) xcd_barrier(WID, bar); } first = false; \
        ArgsP a = opaque_args(); unsigned char* ws = a->ws; bf16_t* XN = (bf16_t*)(ws + WS_XN); float* H = a->out; const float* Hin = (layer == 0) ? a->in[I_X] : (const float*)H; \
        const LAS int* ts = (const LAS int*)(lds + MISC_OFF + MO_TS); (void)XN; (void)H; (void)Hin; (void)ts; \
        const bool probe_ = ((PROBE_MASK >> (id)) & 1u) != 0u; const unsigned long long pt0_ = probe_ ? __builtin_amdgcn_s_memrealtime() : 0ull;
#define PHASE_END if (probe_) { const unsigned long long pt1_ = __builtin_amdgcn_s_memrealtime(), pd_ = pt1_ - pt0_; while (__builtin_amdgcn_s_memrealtime() - pt1_ < pd_) __builtin_amdgcn_s_sleep(8); } }
    { const int layer = 0; PHASE_BEGIN(0, 0) phase_prologue(WID, a, lds); PHASE_END }
#pragma unroll 1
    for (int layer = 0; layer < DEPTH; ++layer) {
        const int pb = 1 + layer * PPL; const bool even = (layer & 1) == 0; const int ev = layer >> 1, od = layer >> 1;
        if (even) {
            PHASE_BEGIN(pb + 0, 1) phase_norm<0>(WID, a, lds, layer, Hin); PHASE_END
            PHASE_BEGIN(pb + 1, 2) {
                { ProbPlain P{XN, (const bf16_t*)(ws + WS_EVNAT) + (size_t)ev * 2048 * 1024, 1024, 1024, 1024}; pg8::Sched S; S.init(T / 256, 8, G, c);
                  EpiEvNat E{ws, (const float*)(ws + WS_GAINS) + ev * 256};
                  pg8::gemm_phase(WID, lds, P, S, E); }
                { ProbPlain P{(const bf16_t*)(ws + WS_EVSW) + (size_t)ev * 768 * 1024, XN, 1024, 1024, 1024}; pg8::Sched S; S.init(3, T / 256, G, c);
                  EpiEvSw E{ws};
                  pg8::gemm_phase(WID, lds, P, S, E); }
            } PHASE_END
            PHASE_BEGIN(pb + 2, 3) {
                { ProbCmp1 P{(const bf16_t*)(ws + WS_KCB), (const bf16_t*)(ws + WS_VCB), (const bf16_t*)(ws + WS_CMP1) + (size_t)ev * 2 * 256 * 2048, 1024, 2048, 2048}; pg8::Sched S; S.init(32, 1, G, c);
                  EpiCmp1 E{(bf16_t*)(ws + WS_HID), (const float*)(ws + WS_BIAS1) + ev * 512};
                  pg8::gemm_phase(WID, lds, P, S, E); }
                phase_attn<0>(WID, a, lds);
                phase_attn<2>(WID, a, lds);
            } PHASE_END
            PHASE_BEGIN(pb + 3, 4) phase_cmp2(WID, a, lds, ev); PHASE_END
            PHASE_BEGIN(pb + 4, 5) phase_attn<3>(WID, a, lds); PHASE_END
            PHASE_BEGIN(pb + 5, 6) phase_topk(WID, a); PHASE_END
            PHASE_BEGIN(pb + 6, 7) phase_attn<1>(WID, a, lds); PHASE_END
            PHASE_BEGIN(pb + 7, 8) phase_mixprep(WID, a, layer); PHASE_END
            PHASE_BEGIN(pb + 8, 9) {
                ProbPlain P{(const bf16_t*)(ws + WS_AMIX), (const bf16_t*)(ws + WS_EVOUT) + (size_t)ev * 1024 * 1024, 1024, 1024, 1024}; pg8::Sched S; S.init(T / 256, 4, G, c);
                EpiResid E{Hin, H}; pg8::gemm_phase(WID, lds, P, S, E);
            } PHASE_END
        } else {
            PHASE_BEGIN(pb + 0, 11) phase_norm<1>(WID, a, lds, layer, Hin); PHASE_END
            PHASE_BEGIN(pb + 1, 12) {
                { ProbPlain P{XN, (const bf16_t*)(ws + WS_ODNAT) + (size_t)od * 4096 * 1024, 1024, 1024, 1024}; pg8::Sched S; S.init(T / 256, 16, G, c);
                  EpiOdNat E{ws}; pg8::gemm_phase(WID, lds, P, S, E); }
                { ProbPlain P{(const bf16_t*)(ws + WS_ODSW) + (size_t)od * 3072 * 1024, XN, 1024, 1024, 1024}; pg8::Sched S; S.init(12, T / 256, G, c);
                  EpiOdSw E{ws}; pg8::gemm_phase(WID, lds, P, S, E); }
            } PHASE_END
            PHASE_BEGIN(pb + 2, 13) {
                { ProbAtt P{(const bf16_t*)(ws + WS_AQ), (const bf16_t*)(ws + WS_KP), 2048, 1024, 256}; pg8::Sched S; S.init(512, 1, G, c);
                  EpiAtt E{(bf16_t*)(ws + WS_AQ)}; pg8::gemm_phase(WID, lds, P, S, E); }
                { ProbUT P{(const bf16_t*)(ws + WS_VS), (const bf16_t*)(ws + WS_KT), 512, 256, 256}; pg8::Sched S; S.init(1024, 1, G, c);
                  EpiUT E{(float*)(ws + WS_UT)}; pg8::gemm_phase(WID, lds, P, S, E); }
            } PHASE_END
            PHASE_BEGIN(pb + 3, 14) phase_scan(WID, a); PHASE_END
            PHASE_BEGIN(pb + 4, 15) {
                ProbY P{(const bf16_t*)(ws + WS_AQ), (const bf16_t*)(ws + WS_VS), 2048, 512, 512}; pg8::Sched S; S.init(512, 2, G, c);
                EpiY E{(bf16_t*)(ws + WS_Y)}; pg8::gemm_phase(WID, lds, P, S, E);
            } PHASE_END
            PHASE_BEGIN(pb + 5, 16) phase_normgate(WID, a, od); PHASE_END
            PHASE_BEGIN(pb + 8, 19) {
                ProbPlain P{(const bf16_t*)(ws + WS_YG), (const bf16_t*)(ws + WS_ODOUT) + (size_t)od * 1024 * 2048, 2048, 2048, 2048}; pg8::Sched S; S.init(T / 256, 4, G, c);
                EpiResid E{Hin, H}; pg8::gemm_phase(WID, lds, P, S, E);
            } PHASE_END
        }
        PHASE_BEGIN(pb + 9, 20) phase_norm<2>(WID, a, lds, layer, H); PHASE_END
        PHASE_BEGIN(pb + 10, 21) phase_moe_slots(WID, a, lds, layer); PHASE_END
        PHASE_BEGIN(pb + 11, 22) {
            moe_tables(WID, a, lds, layer, -1);
            { ProbMoe P{(const bf16_t*)(ws + WS_XB), (const bf16_t*)(ws + WS_WGU) + (size_t)layer * 32 * 2048 * 1024, ts, 2048, 1024, 1024, 1024}; pg8::Sched S; S.init(ts[32], 8, G, c);
              EpiGU E{(bf16_t*)(ws + WS_ACT), a->in[I_BGU] + (size_t)layer * 32 * 2048, ts}; pg8::gemm_phase(WID, lds, P, S, E); }
            { ProbPlain P{(const bf16_t*)(ws + WS_PBF) + (size_t)layer * T * 256, (const bf16_t*)(ws + WS_WPP) + (size_t)layer * 1024 * 256, 256, 256, 256}; pg8::Sched S; S.init(T / 256, 4, G, c);
              EpiPP E{(bf16_t*)(ws + WS_PP)}; pg8::gemm_phase(WID, lds, P, S, E); }
        } PHASE_END
        PHASE_BEGIN(pb + 12, 23) {
            moe_tables(WID, a, lds, layer, -1);
            ProbMoe P{(const bf16_t*)(ws + WS_ACT), (const bf16_t*)(ws + WS_WDN) + (size_t)layer * 32 * 1024 * 1024, ts, 1024, 1024, 1024, 1024}; pg8::Sched S; S.init(ts[32], 4, G, c);
            EpiDN E{(bf16_t*)(ws + WS_YB), a->in[I_BDN] + (size_t)layer * 32 * 1024, ts}; pg8::gemm_phase(WID, lds, P, S, E);
        } PHASE_END
        PHASE_BEGIN(pb + 13, 24) phase_combine(WID, a, H); PHASE_END
        PHASE_BEGIN(pb + 14, 25) {
            ProbPlain P{XN, (const bf16_t*)(ws + WS_WPG) + (size_t)layer * 1024 * 1024, 1024, 1024, 1024}; pg8::Sched S; S.init(T / 256, 4, G, c);
            EpiPLE E{H, (const bf16_t*)(ws + WS_PP)}; pg8::gemm_phase(WID, lds, P, S, E);
        } PHASE_END
    }
#undef PHASE_BEGIN
#undef PHASE_END
}

extern "C" void kernel_launch(void* const* d_in, const int* in_sizes, int n_in, void* d_out, int out_size, void* d_ws, size_t ws_size, hipStream_t stream) {
    static int grid = 0;
    if (grid == 0) {
        if (n_in != 26 || out_size != T * D || ws_size < WS_END) { fprintf(stderr, "kernel_launch: unexpected problem (n_in %d, out %d, ws %zu < %zu); nothing launched\n", n_in, out_size, ws_size, (size_t)WS_END); grid = -1; return; }
        int dev = 0, cus = 0, per_cu = 0;
        if (hipGetDevice(&dev) != hipSuccess || hipDeviceGetAttribute(&cus, hipDeviceAttributeMultiprocessorCount, dev) != hipSuccess) { grid = -1; return; }
        if (hipFuncSetAttribute((const void*)mk_fwd, hipFuncAttributeMaxDynamicSharedMemorySize, LDS_BYTES) != hipSuccess) { fprintf(stderr, "kernel_launch: hipFuncSetAttribute failed\n"); grid = -1; return; }
        if (hipOccupancyMaxActiveBlocksPerMultiprocessor(&per_cu, (const void*)mk_fwd, 512, LDS_BYTES) != hipSuccess || per_cu < 1) fprintf(stderr, "kernel_launch: occupancy query reports %d\n", per_cu);
        (void)hipGetLastError();
        grid = cus > 256 ? 256 : cus;
    }
    if (grid < 0) return;
    (void)hipMemsetAsync((char*)d_ws + WS_CTL, 0, CTL_BYTES, stream);
    Args a; memset(&a, 0, sizeof(a));
    for (int i = 0; i < 26; ++i) a.in[i] = (const float*)d_in[i];
    a.out = (float*)d_out; a.ws = (unsigned char*)d_ws;
#if MK_SINGLE
    a.ph_lo = 0; a.ph_hi = NPHASE;
    hipLaunchKernelGGL(mk_fwd, dim3(grid), dim3(512), LDS_BYTES, stream, a);
#else
    for (int ph = 0; ph < NPHASE && ph <= DBG_LAST_PHASE; ++ph) {
        const int l = (ph - 1) / PPL, k = (ph - 1) % PPL;
        if (ph > 0 && (l & 1) && (k == 6 || k == 7)) continue;
        a.ph_lo = ph; a.ph_hi = ph + 1;
        hipLaunchKernelGGL(mk_fwd, dim3(grid), dim3(512), LDS_BYTES, stream, a);
    }
#endif
}
```

```cpp
#include <hip/hip_runtime.h>
#include <cstdio>
#include <cstdint>
#include <cstring>

#define LAS __attribute__((address_space(3)))
#define DI __device__ __forceinline__
typedef unsigned short bf16_t;
typedef short bf16x8 __attribute__((ext_vector_type(8)));
typedef short s16x4 __attribute__((ext_vector_type(4)));
typedef float f32x2 __attribute__((ext_vector_type(2)));
typedef float f32x4 __attribute__((ext_vector_type(4)));
typedef float f32x16 __attribute__((ext_vector_type(16)));
typedef unsigned u32x2 __attribute__((ext_vector_type(2)));
typedef unsigned u32x4 __attribute__((ext_vector_type(4)));
typedef __bf16 bfv2 __attribute__((ext_vector_type(2)));
typedef int i32x4 __attribute__((ext_vector_type(4)));
typedef int i32x8 __attribute__((ext_vector_type(8)));

#ifndef MK_SINGLE
#define MK_SINGLE 1
#endif
#ifndef DBG_ONLY
#define DBG_ONLY -1
#endif
#ifndef PROBE_MASK
#define PROBE_MASK 0u
#endif
#ifndef DBG_LAST_PHASE
#define DBG_LAST_PHASE 100000
#endif

constexpr int T = 32768, D = 1024, SEQ = 2048, NBATCH = 16, DEPTH = 4;
constexpr int EVIN = 2840, ODIN = 6144;
constexpr float EPS = 1e-6f, NEGF = -1e30f;
constexpr int NTB = 256;
constexpr int MOE_ROWS = (512 + 32) * 256;

constexpr size_t MiB = 1u << 20;
constexpr size_t WS_CTL = 0, CTL_BYTES = 1 * MiB;
constexpr int CW_BAR = 4096;
constexpr size_t WS_EVNAT = 2 * MiB, WS_EVSW = 10 * MiB, WS_EVOUT = 13 * MiB, WS_CMP1 = 17 * MiB, WS_ODNAT = 21 * MiB, WS_ODSW = 37 * MiB,
                 WS_ODOUT = 49 * MiB, WS_WPP = 57 * MiB, WS_WPG = 59 * MiB, WS_BIAS1 = 67 * MiB, WS_GAINS = 67 * MiB + 16384, WS_BCNT = 67 * MiB + 65536,
                 WS_WGU = 68 * MiB, WS_WDN = 580 * MiB;
constexpr size_t WS_XN = 840 * MiB, WS_PBF = 904 * MiB, WS_PP = 968 * MiB, WS_GATES = 1032 * MiB, WS_TOPE = 1035 * MiB, WS_POSB = 1036 * MiB,
                 WS_DEST = 1037 * MiB, WS_GATEW = 1038 * MiB, WS_SELM = 1039 * MiB;
constexpr size_t RA = 1040 * MiB;
constexpr size_t WS_QD = RA, WS_KD = RA + 32 * MiB, WS_QN = RA + 64 * MiB, WS_KCB = RA + 96 * MiB, WS_VCB = RA + 105 * MiB, WS_KSB = RA + 114 * MiB,
                 WS_KWB = RA + 122 * MiB, WS_VAT = RA + 130 * MiB, WS_VST = RA + 162 * MiB, WS_VWT = RA + 170 * MiB, WS_HID = RA + 178 * MiB,
                 WS_KCMP = RA + 182 * MiB, WS_VCMPT = RA + 183 * MiB, WS_OC = RA + 184 * MiB, WS_IMPH = RA + 216 * MiB, WS_OD = RA + 248 * MiB,
                 WS_OS = RA + 312 * MiB, WS_OW = RA + 344 * MiB, WS_AMIX = RA + 376 * MiB;
constexpr size_t WS_AQ = RA, WS_KP = RA + 128 * MiB, WS_KT = RA + 192 * MiB, WS_VS = RA + 256 * MiB, WS_GG = RA + 512 * MiB, WS_UT = RA + 640 * MiB,
                 WS_Y = RA + 896 * MiB, WS_YG = RA + 1024 * MiB;
constexpr size_t WS_XB = 2192 * MiB, WS_ACT = 2464 * MiB, WS_YB = 2736 * MiB, WS_END = 3008 * MiB;

constexpr int MISC_OFF = 139264, LDS_BYTES = 155648;
static_assert(MISC_OFF + 5888 + 4096 <= LDS_BYTES, "misc LDS words");
constexpr int MO_WCNT = 256, MO_ENT = 1280, MO_GAT = 3328, MO_TOT = 5376, MO_BASE = 5504, MO_TS = 5632, MO_RED = 5888;

DI int opaque_tid(int wid0) { int t = (wid0 << 6) | (int)__builtin_amdgcn_mbcnt_hi(~0u, __builtin_amdgcn_mbcnt_lo(~0u, 0u)); asm volatile("" : "+v"(t) :: "memory"); return t; }
DI unsigned pk2(float lo, float hi) { f32x2 v = {lo, hi}; return __builtin_bit_cast(unsigned, __builtin_convertvector(v, bfv2)); }
DI unsigned pk4_fp8(float a, float b, float c, float d) { int w = 0; w = __builtin_amdgcn_cvt_pk_fp8_f32(a, b, w, false); w = __builtin_amdgcn_cvt_pk_fp8_f32(c, d, w, true); return (unsigned)w; }
DI float bf2f(unsigned short b) { return __uint_as_float(((unsigned)b) << 16); }
DI float bflo(unsigned w) { return __uint_as_float(w << 16); }
DI float bfhi(unsigned w) { return __uint_as_float(w & 0xffff0000u); }
DI float wave_sum(float v) {
#pragma unroll
    for (int o = 1; o < 64; o <<= 1) v += __shfl_xor(v, o);
    return v;
}
DI float sigm(float x) { return 1.0f / (1.0f + __expf(-x)); }
DI u32x4 pack8(const f32x4& a, const f32x4& b) { u32x4 w; w.x = pk2(a[0], a[1]); w.y = pk2(a[2], a[3]); w.z = pk2(b[0], b[1]); w.w = pk2(b[2], b[3]); return w; }

#define XB_TMO      128
#define XB_XCNT(j)  (256  + 64 * (j))
#define XB_XSUB(j)  (1280 + 64 * (j))
#define XB_XGEN(j)  (2304 + 64 * (j))
#define XB_TOP      3328
#define XB_TOPGEN   3392
#define XCD_BAR_WORDS 3456
#define XB_SPIN_CAP (1u << 22)
DI unsigned xb_ld(unsigned* p)              { return __hip_atomic_load(p, __ATOMIC_RELAXED, __HIP_MEMORY_SCOPE_AGENT); }
DI unsigned xb_add(unsigned* p, unsigned v) { return __hip_atomic_fetch_add(p, v, __ATOMIC_RELAXED, __HIP_MEMORY_SCOPE_AGENT); }
DI unsigned xb_xcc_id() { return (unsigned)__builtin_amdgcn_s_getreg((3 << 11) | 20) & 0xFu; }
#define XB_SPIN(cond, bar) do { unsigned _sp = 0; while (cond) { __builtin_amdgcn_s_sleep(1); \
    if ((++_sp & 255u) == 0u) { if (xb_ld(&(bar)[XB_TMO])) break; if (_sp > XB_SPIN_CAP) { atomicAdd(&(bar)[XB_TMO], 1u); break; } } } } while (0)
struct XcdBarrier { unsigned* bar; unsigned x; volatile LAS unsigned* st; };
DI XcdBarrier xcd_barrier_post(const int WID, unsigned* bar, volatile LAS unsigned* st) {
    XcdBarrier b; b.bar = bar; b.x = xb_xcc_id(); b.st = st;
    if (opaque_tid(WID) == 0) (void)xb_add(&bar[XB_XCNT(b.x)], 1u);
    return b;
}
DI void xcd_barrier_complete(unsigned* bar, unsigned x, unsigned& nloc, unsigned& nx) {
    const unsigned G = gridDim.x * gridDim.y * gridDim.z;
    unsigned sum, cnt, mine, sp = 0u;
    for (;;) {
        sum = 0u; cnt = 0u; mine = 0u;
#pragma unroll
        for (unsigned j = 0; j < 16; ++j) { const unsigned c = xb_ld(&bar[XB_XCNT(j)]); sum += c; cnt += (c > 0u) ? 1u : 0u; mine = (j == x) ? c : mine; }
        if (sum == G) break;
        __builtin_amdgcn_s_sleep(1);
        if ((++sp & 255u) == 0u) { if (xb_ld(&bar[XB_TMO])) break; if (sp > XB_SPIN_CAP) { atomicAdd(&bar[XB_TMO], 1u); break; } }
    }
    nloc = mine > 0u ? mine : 1u; nx = cnt > 0u ? cnt : 1u;
}
DI void xcd_barrier(const int WID, const XcdBarrier& b) {
    asm volatile("s_waitcnt vmcnt(0)" ::: "memory");
    __syncthreads();
    if (opaque_tid(WID) == 0) {
        unsigned* bar = b.bar; asm volatile("" : "+s"(bar));
        __builtin_amdgcn_s_waitcnt(0);
        unsigned nloc = b.st[0], nx = b.st[1];
        if (nloc == 0u) { xcd_barrier_complete(bar, b.x, nloc, nx); b.st[0] = nloc; b.st[1] = nx; }
        const unsigned old = xb_add(&bar[XB_XSUB(b.x)], 1u);
        const unsigned gen = old / nloc;
        if (old + 1u == (gen + 1u) * nloc) {
            __builtin_amdgcn_fence(__ATOMIC_RELEASE, "agent");
            asm volatile("s_waitcnt vmcnt(0)" ::: "memory");
            const unsigned og = xb_add(&bar[XB_TOP], 1u);
            const unsigned tg = og / nx;
            if (og + 1u == (tg + 1u) * nx) xb_add(&bar[XB_TOPGEN], 1u);
            else XB_SPIN(xb_ld(&bar[XB_TOPGEN]) == tg, bar);
            __builtin_amdgcn_fence(__ATOMIC_ACQUIRE, "agent");
            xb_add(&bar[XB_XGEN(b.x)], 1u);
            asm volatile("s_waitcnt vmcnt(0)" ::: "memory");
        } else {
            XB_SPIN(xb_ld(&bar[XB_XGEN(b.x)]) == gen, bar);
            __builtin_amdgcn_fence(__ATOMIC_ACQUIRE, "agent");
            asm volatile("s_waitcnt vmcnt(0)" ::: "memory");
        }
    }
    __syncthreads();
}

namespace pg8 {
constexpr int BM = 256, BK = 64, HALF = 128, HTB = HALF * BK * 2, STAGE_BYTES = 8 * HTB, NXCD = 8, WGM = 8;
DI int lds_byte(int r, int c) { const int st = (r >> 4) * 2 + (c >> 5), rr = r & 15, cc = c & 31, ob = rr * 64 + cc * 2; return st * 1024 + (ob ^ (((ob >> 9) & 1) << 5)); }
DI void stage_rc(int b, int& R, int& C) { const int st = b / 1024, sb = b % 1024, swz = sb ^ (((sb >> 9) & 1) << 5); R = (st >> 1) * 16 + swz / 64; C = (st & 1) * 32 + (swz % 64) / 2; }
DI int perm32(int rho) { const int n = rho >> 4, i = rho & 15; return 8 * (i >> 2) + 4 * n + (i & 3); }
struct Unit { int pm, pn; };
struct Sched {
    int nM, nN, nwg, G, c;
    DI void init(int nM_, int nN_, int G_, int c_) { nM = nM_; nN = nN_; nwg = nM * nN; G = G_; c = c_; }
    DI bool next(int i, Unit& u) const {
        const long L = (long)i * G + c; if (L >= nwg) return false;
        int wgid = (int)L; { const int q = nwg / NXCD, r = nwg % NXCD, xcd = wgid % NXCD, off = wgid / NXCD; wgid = (xcd < r ? xcd * (q + 1) : r * (q + 1) + (xcd - r) * q) + off; }
        const int nig = WGM * nN, gid = wgid / nig, fm = gid * WGM, gsz = (nM - fm) < WGM ? (nM - fm) : WGM;
        u.pm = fm + ((wgid % nig) % gsz); u.pn = (wgid % nig) / gsz; return true;
    }
};
template <class Epi, class Prob>
DI void gemm_phase(const int WID, LAS unsigned char* lds, const Prob& P, const Sched& S, const Epi& E) {
    const int tid = opaque_tid(WID), wid = __builtin_amdgcn_readfirstlane(tid >> 6), lane = tid & 63, wr = wid >> 2, wc = wid & 3, fr = lane & 15, fq = lane >> 4;
    const int K = P.K, nt = K / BK;
    unsigned voffA[2], voffB[2];
#pragma unroll
    for (int i = 0; i < 2; ++i) { int R, C; stage_rc(tid * 16 + i * 8192, R, C); const int Rb = Epi::PERM ? ((R & ~31) + perm32(R & 31)) : R;
        voffA[i] = (unsigned)(R * P.lda + C) * 2u; voffB[i] = (unsigned)(Rb * P.ldb + C) * 2u; }
    const size_t kstep = (size_t)(BK * 2);
    const size_t hstepA = (size_t)HALF * P.lda * 2, hstepB = (size_t)HALF * P.ldb * 2;
    const unsigned ldsw = (unsigned)wid * 1024u;
    const int aoff = lds_byte(wr * 64 + fr, fq * 8), boff = lds_byte(wc * 32 + fr, fq * 8);
#define PG8_SA(b, h) (((b) * 2 + (h)) * HTB)
#define PG8_SB(b, h) ((4 + (b) * 2 + (h)) * HTB)
#define PG8_STAGE(bufoff, gbase, voff) do { _Pragma("unroll") for (int _i = 0; _i < 2; ++_i) \
        __builtin_amdgcn_global_load_lds((const unsigned*)((const char*)(gbase) + (voff)[_i]), (LAS unsigned*)(lds + (bufoff) + ldsw + _i * 8192), 16, 0, 0); } while (0)
#define PG8_LD16(off) (*(const LAS i32x4*)(lds + (off)))
#define PG8_LDA(dst, b, h) do { _Pragma("unroll") for (int m = 0; m < 4; ++m) { const i32x4 lo_ = PG8_LD16(PG8_SA(b, h) + aoff + m * 2048), hi_ = PG8_LD16(PG8_SA(b, h) + aoff + m * 2048 + 1024); dst[m] = __builtin_shufflevector(lo_, hi_, 0, 1, 2, 3, 4, 5, 6, 7); } } while (0)
#define PG8_LDB(dst, b, h) do { _Pragma("unroll") for (int n = 0; n < 2; ++n) { const i32x4 lo_ = PG8_LD16(PG8_SB(b, h) + boff + n * 2048), hi_ = PG8_LD16(PG8_SB(b, h) + boff + n * 2048 + 1024); dst[n] = __builtin_shufflevector(lo_, hi_, 0, 1, 2, 3, 4, 5, 6, 7); } } while (0)
#define PG8_LOH(X) __builtin_bit_cast(bf16x8, __builtin_shufflevector((X), (X), 0, 1, 2, 3))
#define PG8_HIH(X) __builtin_bit_cast(bf16x8, __builtin_shufflevector((X), (X), 4, 5, 6, 7))
#define PG8_MMA(ai, bj, At, Bt) do { __builtin_amdgcn_s_setprio(1); \
        if constexpr (Prob::FP8) { _Pragma("unroll") for (int m = 0; m < 4; ++m) _Pragma("unroll") for (int n = 0; n < 2; ++n) \
            asm volatile("v_mfma_scale_f32_16x16x128_f8f6f4 %0, %1, %2, %0, %3, %3 op_sel_hi:[0,0,0]" : "+v"(acc[ai][bj][m][n]) : "v"(Bt[n]), "v"(At[m]), "v"(sc1)); } \
        else { _Pragma("unroll") for (int m = 0; m < 4; ++m) _Pragma("unroll") for (int n = 0; n < 2; ++n) { \
            acc[ai][bj][m][n] = __builtin_amdgcn_mfma_f32_16x16x32_bf16(PG8_LOH(Bt[n]), PG8_LOH(At[m]), acc[ai][bj][m][n], 0, 0, 0); \
            acc[ai][bj][m][n] = __builtin_amdgcn_mfma_f32_16x16x32_bf16(PG8_HIH(Bt[n]), PG8_HIH(At[m]), acc[ai][bj][m][n], 0, 0, 0); } } \
        __builtin_amdgcn_s_setprio(0); } while (0)
#define PG8_WAIT_V(n) asm volatile("s_waitcnt vmcnt(" #n ")" ::: "memory")
#define PG8_WAIT_L(n) asm volatile("s_waitcnt lgkmcnt(" #n ")" ::: "memory")
#define PG8_BAR __builtin_amdgcn_s_barrier()
#define PG8_SCHED __builtin_amdgcn_sched_barrier(0)
    Unit cur, nxt; int ui = 0;
    if (!S.next(0, cur)) return;
    f32x4 acc[2][2][4][2];
#pragma unroll
    for (int a = 0; a < 2; ++a)
#pragma unroll
        for (int b = 0; b < 2; ++b)
#pragma unroll
            for (int m = 0; m < 4; ++m)
#pragma unroll
                for (int n = 0; n < 2; ++n) acc[a][b][m][n] = (f32x4){0.f, 0.f, 0.f, 0.f};
    i32x8 At[4], B0[2], B1[2];
    const int sc1 = 0x7f7f7f7f;
    const char* cA = P.a_base(cur); const char* cB = P.b_base(cur);
    PG8_STAGE(PG8_SB(0, 0), cB, voffB); PG8_STAGE(PG8_SA(0, 0), cA, voffA); PG8_STAGE(PG8_SB(0, 1), cB + hstepB, voffB); PG8_STAGE(PG8_SA(0, 1), cA + hstepA, voffA);
    if (wr == 1) PG8_BAR;
    PG8_WAIT_V(4); PG8_BAR;
    PG8_STAGE(PG8_SB(1, 0), cB + kstep, voffB); PG8_STAGE(PG8_SA(1, 0), cA + kstep, voffA); PG8_STAGE(PG8_SB(1, 1), cB + hstepB + kstep, voffB);
    PG8_WAIT_V(6); PG8_BAR;
    for (;;) {
        const bool has_next = S.next(ui + 1, nxt);
        const char* nA = has_next ? P.a_base(nxt) : cA; const char* nB = has_next ? P.b_base(nxt) : cB;
        for (int t = 0; t < nt; t += 2) {
            const bool last = (t == nt - 2);
            const char* a1 = cA + (size_t)(t + 1) * kstep;
            const char* a2 = last ? nA : cA + (size_t)(t + 2) * kstep; const char* b2 = last ? nB : cB + (size_t)(t + 2) * kstep;
            const char* a3 = a2 + kstep; const char* b3 = b2 + kstep;
            PG8_LDB(B0, 0, 0); PG8_SCHED; PG8_LDA(At, 0, 0); PG8_STAGE(PG8_SA(1, 1), a1 + hstepA, voffA);
            PG8_WAIT_L(8); PG8_BAR; PG8_WAIT_L(0); PG8_MMA(0, 0, At, B0); PG8_BAR; PG8_SCHED;
            PG8_LDB(B1, 0, 1); PG8_STAGE(PG8_SB(0, 0), b2, voffB);
            PG8_BAR; PG8_WAIT_L(0); PG8_MMA(0, 1, At, B1); PG8_BAR;
            PG8_LDA(At, 0, 1); PG8_STAGE(PG8_SA(0, 0), a2, voffA);
            PG8_BAR; PG8_WAIT_L(0); PG8_MMA(1, 0, At, B0); PG8_BAR; PG8_SCHED;
            PG8_STAGE(PG8_SB(0, 1), b2 + hstepB, voffB);
            PG8_WAIT_V(6); PG8_BAR; PG8_MMA(1, 1, At, B1); PG8_BAR;
            PG8_LDB(B0, 1, 0); PG8_SCHED; PG8_LDA(At, 1, 0); PG8_STAGE(PG8_SA(0, 1), a2 + hstepA, voffA);
            PG8_WAIT_L(8); PG8_BAR; PG8_WAIT_L(0); PG8_MMA(0, 0, At, B0); PG8_BAR; PG8_SCHED;
            PG8_LDB(B1, 1, 1); PG8_STAGE(PG8_SB(1, 0), b3, voffB);
            PG8_BAR; PG8_WAIT_L(0); PG8_MMA(0, 1, At, B1); PG8_BAR;
            PG8_LDA(At, 1, 1); PG8_STAGE(PG8_SA(1, 0), a3, voffA);
            PG8_BAR; PG8_WAIT_L(0); PG8_MMA(1, 0, At, B0); PG8_BAR; PG8_SCHED;
            PG8_STAGE(PG8_SB(1, 1), b3 + hstepB, voffB);
            PG8_WAIT_V(6); PG8_BAR; PG8_MMA(1, 1, At, B1); PG8_BAR;
        }
        if constexpr (Prob::FP8) {
            asm volatile("s_nop 15\n\ts_nop 15" ::: "memory");
#pragma unroll
            for (int a_ = 0; a_ < 2; ++a_)
#pragma unroll
                for (int b_ = 0; b_ < 2; ++b_)
#pragma unroll
                    for (int m_ = 0; m_ < 4; ++m_)
#pragma unroll
                        for (int n_ = 0; n_ < 2; ++n_) asm volatile("" : "+v"(acc[a_][b_][m_][n_]));
        }
        { int fr_ = fr, fq_ = fq, wr_ = wr, wc_ = wc; asm volatile("" : "+v"(fr_), "+v"(fq_), "+s"(wr_), "+s"(wc_));
          E(acc, cur, wr_, wc_, fr_, fq_); }
        if (!has_next) break;
#pragma unroll
        for (int a = 0; a < 2; ++a)
#pragma unroll
            for (int b = 0; b < 2; ++b)
#pragma unroll
                for (int m = 0; m < 4; ++m)
#pragma unroll
                    for (int n = 0; n < 2; ++n) acc[a][b][m][n] = (f32x4){0.f, 0.f, 0.f, 0.f};
        cur = nxt; cA = nA; cB = nB; ++ui;
    }
    PG8_WAIT_V(0);
    if (wr == 0) PG8_BAR;
    PG8_BAR;
#undef PG8_SA
#undef PG8_SB
#undef PG8_STAGE
#undef PG8_LDA
#undef PG8_LDB
#undef PG8_MMA
#undef PG8_LD16
#undef PG8_LOH
#undef PG8_HIH
#undef PG8_WAIT_V
#undef PG8_WAIT_L
#undef PG8_BAR
#undef PG8_SCHED
}
}
using pg8::Unit;
typedef f32x4 Acc[2][2][4][2];

struct ProbPlain { static constexpr bool FP8 = false; const bf16_t* A; const bf16_t* Bt; int lda, ldb, K;
    DI const char* a_base(const Unit& u) const { return (const char*)(A + (size_t)u.pm * 256 * lda); }
    DI const char* b_base(const Unit& u) const { return (const char*)(Bt + (size_t)u.pn * 256 * ldb); } };
struct ProbCmp1 { static constexpr bool FP8 = false; const bf16_t* KCB; const bf16_t* VCB; const bf16_t* W; int lda, ldb, K;
    DI const char* a_base(const Unit& u) const { const int kv = u.pm >> 4, rt = u.pm & 15; return (const char*)((kv ? VCB : KCB) + (size_t)rt * 256 * 1024); }
    DI const char* b_base(const Unit& u) const { const int kv = u.pm >> 4; return (const char*)(W + (size_t)kv * 256 * 2048); } };
struct ProbAtt { static constexpr bool FP8 = false; const bf16_t* AQ; const bf16_t* KP; int lda, ldb, K;
    DI const char* a_base(const Unit& u) const { const int z = u.pm, n = z & 7, h = (z >> 3) & 3, b = z >> 5; const size_t t0 = (size_t)b * 2048 + n * 256; return (const char*)(AQ + (t0 * 4 + h) * 512 + 256); }
    DI const char* b_base(const Unit& u) const { const int z = u.pm, n = z & 7, h = (z >> 3) & 3, b = z >> 5; const size_t t0 = (size_t)b * 2048 + n * 256; return (const char*)(KP + t0 * 1024 + h * 256); } };
struct ProbUT { static constexpr bool FP8 = false; const bf16_t* VS; const bf16_t* KT; int lda, ldb, K;
    DI const char* a_base(const Unit& u) const { const int z = u.pm >> 1, half = u.pm & 1; return (const char*)(VS + (size_t)z * 262144 + (size_t)half * 256 * 512); }
    DI const char* b_base(const Unit& u) const { const int z = u.pm >> 1; return (const char*)(KT + (size_t)z * 65536); } };
struct ProbY { static constexpr bool FP8 = false; const bf16_t* AQ; const bf16_t* VS; int lda, ldb, K;
    DI const char* a_base(const Unit& u) const { const int z = u.pm, n = z & 7, h = (z >> 3) & 3, b = z >> 5; const size_t t0 = (size_t)b * 2048 + n * 256; return (const char*)(AQ + (t0 * 4 + h) * 512); }
    DI const char* b_base(const Unit& u) const { return (const char*)(VS + (size_t)u.pm * 262144 + (size_t)u.pn * 256 * 512); } };
DI int moe_tile_expert(const LAS int* ts, int rt) { int e = 0;
#pragma unroll 8
    for (int i = 1; i < 32; ++i) e += (rt >= ts[i]) ? 1 : 0;
    return e; }
struct ProbMoe { static constexpr bool FP8 = false; const bf16_t* A; const bf16_t* W; const LAS int* ts; int nper; int lda, ldb, K;
    DI const char* a_base(const Unit& u) const { return (const char*)(A + (size_t)u.pm * 256 * 1024); }
    DI const char* b_base(const Unit& u) const { const int e = moe_tile_expert(ts, u.pm); return (const char*)(W + ((size_t)e * nper + (size_t)u.pn * 256) * 1024); } };

struct ProbMoe8 { static constexpr bool FP8 = true; const unsigned char* A; const unsigned char* W; const LAS int* ts; int lda, ldb, K;
    DI const char* a_base(const Unit& u) const { return (const char*)(A + (size_t)u.pm * 256 * 1024); }
    DI const char* b_base(const Unit& u) const { const int e = moe_tile_expert(ts, u.pm); return (const char*)(W + ((size_t)e * 2048 + (size_t)u.pn * 256) * 1024); } };

#define EPI_ROWS(ai, m) (128 * (ai) + 64 * wr + 16 * (m) + fr)
struct EpiEvNat { static constexpr bool PERM = true;
    unsigned char* ws; const float* gains;
    DI void operator()(const Acc& acc, const Unit& u, int wr, int wc, int fr, int fq) const {
        const int pn = u.pn; const bool norm = (pn != 6);
        const int gi = pn < 2 ? 0 : pn < 4 ? 1 : pn < 6 ? 2 : 3;
        const float* g = gains + gi * 64;
        f32x4 gv[2][2];
#pragma unroll
        for (int bj = 0; bj < 2; ++bj)
#pragma unroll
            for (int n = 0; n < 2; ++n) { const f32x4 t4 = *(const f32x4*)(g + 32 * bj + 8 * fq + 4 * n); gv[bj][n] = norm ? t4 : (f32x4){1.f, 1.f, 1.f, 1.f}; }
        size_t boff; int rowmul, hoff; bool panel = false;
        if (pn < 2) { boff = WS_QD; rowmul = 512; hoff = (pn * 4 + wc) * 64; }
        else if (pn < 4) { boff = WS_KD; rowmul = 512; hoff = ((pn - 2) * 4 + wc) * 64; }
        else if (pn < 6) { boff = WS_QN; rowmul = 512; hoff = ((pn - 4) * 4 + wc) * 64; }
        else { panel = true; rowmul = 64; hoff = 0; boff = (pn == 6) ? (wc < 2 ? WS_KCB : WS_VCB) : (wc < 2 ? WS_KSB : WS_KWB); }
        bf16_t* base = (bf16_t*)(ws + boff);
#pragma unroll
        for (int ai = 0; ai < 2; ++ai)
#pragma unroll
            for (int m = 0; m < 4; ++m) {
                const int t = u.pm * 256 + EPI_ROWS(ai, m), b = t >> 11, sq = t & 2047;
                float ss = 0.f;
#pragma unroll
                for (int bj = 0; bj < 2; ++bj)
#pragma unroll
                    for (int n = 0; n < 2; ++n) { const f32x4 x = acc[ai][bj][m][n]; ss += (x[0] * x[0] + x[1] * x[1]) + (x[2] * x[2] + x[3] * x[3]); }
                ss += __shfl_xor(ss, 16); ss += __shfl_xor(ss, 32);
                const float rstd = norm ? rsqrtf(ss * (1.0f / 64.0f) + EPS) * ((pn < 2 || pn == 4 || pn == 5) ? 0.125f : 1.0f) : 1.0f;
                const size_t rowi = panel ? ((size_t)(b * 2 + (wc & 1)) * 2048 + sq) : (size_t)t;
#pragma unroll
                for (int bj = 0; bj < 2; ++bj) {
                    const f32x4 v0 = acc[ai][bj][m][0] * rstd * gv[bj][0], v1 = acc[ai][bj][m][1] * rstd * gv[bj][1];
                    *(u32x4*)(base + rowi * rowmul + hoff + 32 * bj + 8 * fq) = pack8(v0, v1);
                }
            }
    }
};
struct EpiEvSw { static constexpr bool PERM = true;
    unsigned char* ws;
    DI void operator()(const Acc& acc, const Unit& u, int wr, int wc, int fr, int fq) const {
        const int b = u.pn >> 3, sb = (u.pn & 7) * 256;
#pragma unroll
        for (int ai = 0; ai < 2; ++ai)
#pragma unroll
            for (int m = 0; m < 4; ++m) {
                const int rl = EPI_ROWS(ai, m);
                size_t boff, rowi;
                if (u.pm < 2) { const int fg = u.pm * 256 + rl; boff = WS_VAT; rowi = (size_t)(b * 4 + (fg >> 7)) * 128 + (fg & 127); }
                else { const int r2 = rl & 127; boff = (rl < 128) ? WS_VST : WS_VWT; rowi = (size_t)(b * 2 + (r2 >> 6)) * 64 + (r2 & 63); }
                bf16_t* rowp = (bf16_t*)(ws + boff) + rowi * 2048;
#pragma unroll
                for (int bj = 0; bj < 2; ++bj) *(u32x4*)(rowp + sb + 128 * bj + 32 * wc + 8 * fq) = pack8(acc[ai][bj][m][0], acc[ai][bj][m][1]);
            }
    }
};
struct EpiCmp1 { static constexpr bool PERM = true;
    bf16_t* HID; const float* bias1;
    DI void operator()(const Acc& acc, const Unit& u, int wr, int wc, int fr, int fq) const {
        const int kv = u.pm >> 4, rt = u.pm & 15;
#pragma unroll
        for (int bj = 0; bj < 2; ++bj) {
            const int col = 128 * bj + 32 * wc + 8 * fq;
            const f32x4 b0 = *(const f32x4*)(bias1 + kv * 256 + col), b1 = *(const f32x4*)(bias1 + kv * 256 + col + 4);
#pragma unroll
            for (int ai = 0; ai < 2; ++ai)
#pragma unroll
                for (int m = 0; m < 4; ++m) {
                    f32x4 v0 = acc[ai][bj][m][0] + b0, v1 = acc[ai][bj][m][1] + b1;
#pragma unroll
                    for (int j = 0; j < 4; ++j) { v0[j] = v0[j] * sigm(v0[j]); v1[j] = v1[j] * sigm(v1[j]); }
                    *(u32x4*)(HID + ((size_t)kv * 4096 + rt * 256 + EPI_ROWS(ai, m)) * 256 + col) = pack8(v0, v1);
                }
        }
    }
};
struct EpiResid { static constexpr bool PERM = false;
    const float* Hin; float* Hout;
    DI void operator()(const Acc& acc, const Unit& u, int wr, int wc, int fr, int fq) const {
#pragma unroll
        for (int ai = 0; ai < 2; ++ai)
#pragma unroll
            for (int m = 0; m < 4; ++m) {
                const size_t off = (size_t)(u.pm * 256 + EPI_ROWS(ai, m)) * 1024 + u.pn * 256 + 32 * wc + 4 * fq;
#pragma unroll
                for (int bj = 0; bj < 2; ++bj)
#pragma unroll
                    for (int n = 0; n < 2; ++n) { const size_t o = off + 128 * bj + 16 * n; *(f32x4*)(Hout + o) = *(const f32x4*)(Hin + o) + acc[ai][bj][m][n]; }
            }
    }
};
DI float ret_lg2(int h) { return __log2f(1.0f - exp2f(-5.0f - (float)h)); }
struct EpiOdNat { static constexpr bool PERM = true;
    unsigned char* ws;
    DI void operator()(const Acc& acc, const Unit& u, int wr, int wc, int fr, int fq) const {
        const int pn = u.pn; const int h = pn & 3; const float lg = ret_lg2(h);
        const size_t boff = pn < 4 ? WS_AQ : pn < 8 ? WS_KP : WS_GG;
        const int rowmul = pn < 4 ? 2048 : pn < 8 ? 1024 : 2048;
        const int coff = pn < 4 ? (h * 512 + 256) : pn < 8 ? (h * 256) : ((pn - 8) * 256);
        bf16_t* base = (bf16_t*)(ws + boff) + coff;
#pragma unroll
        for (int ai = 0; ai < 2; ++ai)
#pragma unroll
            for (int m = 0; m < 4; ++m) {
                const int cl = EPI_ROWS(ai, m); const size_t t = (size_t)u.pm * 256 + cl;
                float sc = 1.f;
                if (pn < 4) sc = exp2f(lg * (float)(cl + 1)); else if (pn < 8) sc = 0.0625f * exp2f(-lg * (float)(cl + 1));
#pragma unroll
                for (int bj = 0; bj < 2; ++bj) {
                    const int d = 128 * bj + 32 * wc + 8 * fq;
                    f32x4 v0 = acc[ai][bj][m][0] * sc, v1 = acc[ai][bj][m][1] * sc;
                    if (pn >= 8) {
#pragma unroll
                        for (int j = 0; j < 4; ++j) { v0[j] = v0[j] * sigm(v0[j]); v1[j] = v1[j] * sigm(v1[j]); } }
                    *(u32x4*)(base + t * rowmul + d) = pack8(v0, v1);
                }
            }
    }
};
struct EpiOdSw { static constexpr bool PERM = true;
    unsigned char* ws;
    DI void operator()(const Acc& acc, const Unit& u, int wr, int wc, int fr, int fq) const {
        const int b = u.pn >> 3, n = u.pn & 7;
        const bool isk = u.pm < 4; const int h = isk ? u.pm : ((u.pm - 4) >> 1);
        const size_t z = (size_t)(b * 4 + h) * 8 + n; const float lg = ret_lg2(h);
        bf16_t* base = (bf16_t*)(ws + (isk ? WS_KT : WS_VS)) + (isk ? z * 65536 : z * 262144 + (size_t)((u.pm - 4) & 1) * 256 * 512);
        const int rowmul = isk ? 256 : 512;
#pragma unroll
        for (int bj = 0; bj < 2; ++bj) {
            const int cl = 128 * bj + 32 * wc + 8 * fq;
            f32x4 s0 = {1.f, 1.f, 1.f, 1.f}, s1 = s0;
            if (isk) {
#pragma unroll
                for (int j = 0; j < 4; ++j) { s0[j] = 0.0625f * exp2f(-lg * (float)(cl + j + 1)); s1[j] = 0.0625f * exp2f(-lg * (float)(cl + 4 + j + 1)); } }
#pragma unroll
            for (int ai = 0; ai < 2; ++ai)
#pragma unroll
                for (int m = 0; m < 4; ++m)
                    *(u32x4*)(base + (size_t)EPI_ROWS(ai, m) * rowmul + cl) = pack8(acc[ai][bj][m][0] * s0, acc[ai][bj][m][1] * s1);
        }
    }
};
struct EpiAtt { static constexpr bool PERM = true;
    bf16_t* AQ;
    DI void operator()(const Acc& acc, const Unit& u, int wr, int wc, int fr, int fq) const {
        const int z = u.pm, n = z & 7, h = (z >> 3) & 3, b = z >> 5; const size_t t0 = (size_t)b * 2048 + n * 256;
#pragma unroll
        for (int ai = 0; ai < 2; ++ai)
#pragma unroll
            for (int m = 0; m < 4; ++m) {
                const int c = EPI_ROWS(ai, m);
#pragma unroll
                for (int bj = 0; bj < 2; ++bj) {
                    const int e0 = 128 * bj + 32 * wc + 8 * fq;
                    f32x4 v0 = acc[ai][bj][m][0], v1 = acc[ai][bj][m][1];
#pragma unroll
                    for (int j = 0; j < 4; ++j) { v0[j] = (c >= e0 + j) ? v0[j] : 0.f; v1[j] = (c >= e0 + 4 + j) ? v1[j] : 0.f; }
                    *(u32x4*)(AQ + ((t0 + c) * 4 + h) * 512 + e0) = pack8(v0, v1);
                }
            }
    }
};
struct EpiUT { static constexpr bool PERM = false;
    float* UT;
    DI void operator()(const Acc& acc, const Unit& u, int wr, int wc, int fr, int fq) const {
        const size_t z = (size_t)(u.pm >> 1); const int half = u.pm & 1;
#pragma unroll
        for (int ai = 0; ai < 2; ++ai)
#pragma unroll
            for (int m = 0; m < 4; ++m) {
                float* rowp = UT + z * 131072 + (size_t)(half * 256 + EPI_ROWS(ai, m)) * 256 + 32 * wc + 4 * fq;
#pragma unroll
                for (int bj = 0; bj < 2; ++bj)
#pragma unroll
                    for (int n = 0; n < 2; ++n) *(f32x4*)(rowp + 128 * bj + 16 * n) = acc[ai][bj][m][n];
            }
    }
};
struct EpiY { static constexpr bool PERM = true;
    bf16_t* Y;
    DI void operator()(const Acc& acc, const Unit& u, int wr, int wc, int fr, int fq) const {
        const int z = u.pm, n = z & 7, h = (z >> 3) & 3, b = z >> 5; const size_t t0 = (size_t)b * 2048 + n * 256;
#pragma unroll
        for (int ai = 0; ai < 2; ++ai)
#pragma unroll
            for (int m = 0; m < 4; ++m) {
                bf16_t* rowp = Y + (t0 + EPI_ROWS(ai, m)) * 2048 + h * 512 + u.pn * 256 + 32 * wc + 8 * fq;
#pragma unroll
                for (int bj = 0; bj < 2; ++bj) *(u32x4*)(rowp + 128 * bj) = pack8(acc[ai][bj][m][0], acc[ai][bj][m][1]);
            }
    }
};
constexpr float W8_SCALE = 32.0f, WSC = 1.0f / W8_SCALE;
struct EpiGU { static constexpr bool PERM = true;
    bf16_t* ACT; const float* bgu; const LAS int* ts;
    DI void operator()(const Acc& acc, const Unit& u, int wr, int wc, int fr, int fq) const {
        const int e = moe_tile_expert(ts, u.pm); const int w = 32 * wc + 8 * fq;
        const float* bp = bgu + (size_t)e * 2048 + 128 * u.pn + w;
        const f32x4 bg0 = *(const f32x4*)bp, bg1 = *(const f32x4*)(bp + 4), bl0 = *(const f32x4*)(bp + 1024), bl1 = *(const f32x4*)(bp + 1028);
#pragma unroll
        for (int ai = 0; ai < 2; ++ai)
#pragma unroll
            for (int m = 0; m < 4; ++m) {
                f32x4 g0 = acc[ai][0][m][0] * WSC + bg0, g1 = acc[ai][0][m][1] * WSC + bg1, l0 = acc[ai][1][m][0] * WSC + bl0, l1 = acc[ai][1][m][1] * WSC + bl1;
#pragma unroll
                for (int j = 0; j < 4; ++j) {
                    const float a = fminf(g0[j], 7.0f), c = fminf(g1[j], 7.0f);
                    const float la = fminf(fmaxf(l0[j], -7.0f), 7.0f), lc = fminf(fmaxf(l1[j], -7.0f), 7.0f);
                    g0[j] = a * sigm(1.702f * a) * (la + 1.0f); g1[j] = c * sigm(1.702f * c) * (lc + 1.0f); }
                *(u32x4*)(ACT + ((size_t)u.pm * 256 + EPI_ROWS(ai, m)) * 1024 + 128 * u.pn + w) = pack8(g0, g1);
            }
    }
};
struct EpiDN { static constexpr bool PERM = true;
    bf16_t* YB; const float* bdn; const LAS int* ts;
    DI void operator()(const Acc& acc, const Unit& u, int wr, int wc, int fr, int fq) const {
        const int e = moe_tile_expert(ts, u.pm);
#pragma unroll
        for (int bj = 0; bj < 2; ++bj) {
            const int col = 256 * u.pn + 128 * bj + 32 * wc + 8 * fq;
            const f32x4 b0 = *(const f32x4*)(bdn + (size_t)e * 1024 + col), b1 = *(const f32x4*)(bdn + (size_t)e * 1024 + col + 4);
#pragma unroll
            for (int ai = 0; ai < 2; ++ai)
#pragma unroll
                for (int m = 0; m < 4; ++m)
                    *(u32x4*)(YB + ((size_t)u.pm * 256 + EPI_ROWS(ai, m)) * 1024 + col) = pack8(acc[ai][bj][m][0] + b0, acc[ai][bj][m][1] + b1);
        }
    }
};
struct EpiPP { static constexpr bool PERM = true;
    bf16_t* PP;
    DI void operator()(const Acc& acc, const Unit& u, int wr, int wc, int fr, int fq) const {
#pragma unroll
        for (int ai = 0; ai < 2; ++ai)
#pragma unroll
            for (int m = 0; m < 4; ++m) {
                bf16_t* rowp = PP + ((size_t)u.pm * 256 + EPI_ROWS(ai, m)) * 1024 + u.pn * 256 + 32 * wc + 8 * fq;
#pragma unroll
                for (int bj = 0; bj < 2; ++bj) *(u32x4*)(rowp + 128 * bj) = pack8(acc[ai][bj][m][0], acc[ai][bj][m][1]);
            }
    }
};
struct EpiPLE { static constexpr bool PERM = false;
    float* H; const bf16_t* PP;
    DI void operator()(const Acc& acc, const Unit& u, int wr, int wc, int fr, int fq) const {
#pragma unroll
        for (int ai = 0; ai < 2; ++ai)
#pragma unroll
            for (int m = 0; m < 4; ++m) {
                const size_t off = (size_t)(u.pm * 256 + EPI_ROWS(ai, m)) * 1024 + u.pn * 256 + 32 * wc + 4 * fq;
#pragma unroll
                for (int bj = 0; bj < 2; ++bj)
#pragma unroll
                    for (int n = 0; n < 2; ++n) {
                        const size_t o = off + 128 * bj + 16 * n;
                        const u32x2 pw = *(const u32x2*)(PP + o); const f32x4 a = acc[ai][bj][m][n]; f32x4 hv = *(const f32x4*)(H + o);
                        hv[0] += sigm(a[0]) * bflo(pw.x); hv[1] += sigm(a[1]) * bfhi(pw.x); hv[2] += sigm(a[2]) * bflo(pw.y); hv[3] += sigm(a[3]) * bfhi(pw.y);
                        *(f32x4*)(H + o) = hv;
                    }
            }
    }
};

constexpr int AT_KSTR = 144;
template <int DV, int MODE>
DI void attn_unit(const int WID, LAS unsigned char* lds, const bf16_t* Qp, int ldq, const bf16_t* Kp, int ldk, const bf16_t* Vt, int ldvt, int q0, float slope,
                  const unsigned* selp, bf16_t* Op, int ldo, float* impp) {
    constexpr int NRB = DV / 32, VPIECES = DV * 8;
    constexpr int KB0 = 0, KB1 = 64 * AT_KSTR, VB0 = 2 * 64 * AT_KSTR, VB1 = VB0 + DV * AT_KSTR;
    const int tid = opaque_tid(WID), w = __builtin_amdgcn_readfirstlane(tid >> 6), lane = tid & 63, r = lane & 31, hh = lane >> 5;
    const int qrow = q0 + 32 * w + r, qw_first = q0 + 32 * w, qw_last = qw_first + 31;
    const float LOG2E = 1.44269504089f;
    bf16x8 qf[4];
#pragma unroll
    for (int ks = 0; ks < 4; ++ks) qf[ks] = *(const bf16x8*)(Qp + (size_t)(32 * w + r) * ldq + 16 * ks + 8 * hh);
    unsigned selm = 0xffffffffu, orm = 0xffffffffu;
    if (MODE == 1) { selm = selp[32 * w + r]; orm = selm;
#pragma unroll
        for (int o = 1; o < 32; o <<= 1) orm |= __shfl_xor(orm, o); }
    const int nv = (MODE == 3) ? (qrow >= 31 ? ((qrow - 15) >> 4) : 0) : 0;
    const int nv_wmax = (MODE == 3) ? (qw_last >= 31 ? ((qw_last - 15) >> 4) : 0) : 0;
    int kt_lo = 0, kt_hi;
    if (MODE == 0 || MODE == 1) kt_hi = (q0 >> 6) + 4;
    else if (MODE == 2) { kt_hi = (q0 >> 6) + 4; const int lk = q0 - 511; kt_lo = lk > 0 ? (lk >> 6) : 0; }
    else kt_hi = 2;
    f32x16 cb[2];
#pragma unroll
    for (int kk = 0; kk < 2; ++kk)
#pragma unroll
        for (int i = 0; i < 16; ++i) cb[kk][i] = (MODE == 3) ? 0.f : slope * (float)(32 * kk + 8 * (i >> 2) + (i & 3) + 4 * hh);
    f32x16 O[NRB];
#pragma unroll
    for (int rb = 0; rb < NRB; ++rb)
#pragma unroll
        for (int i = 0; i < 16; ++i) O[rb][i] = 0.f;
    float mrun = NEGF, lrun = 0.f;
    u32x4 kreg, vreg[2];
    const int krow = tid >> 3, kpc = tid & 7;
#define AT_GLOAD(kt) do { kreg = *(const u32x4*)(Kp + (size_t)(64 * (kt) + krow) * ldk + 8 * kpc); \
        _Pragma("unroll") for (int i_ = 0; i_ < 2; ++i_) { const int idx = tid + 512 * i_; if (idx < VPIECES) vreg[i_] = *(const u32x4*)(Vt + (size_t)(idx >> 3) * ldvt + 64 * (kt) + 8 * (idx & 7)); } } while (0)
#define AT_LWRITE(buf) do { *(LAS u32x4*)(lds + ((buf) ? KB1 : KB0) + krow * AT_KSTR + kpc * 16) = kreg; \
        _Pragma("unroll") for (int i_ = 0; i_ < 2; ++i_) { const int idx = tid + 512 * i_; if (idx < VPIECES) { const int p_ = idx & 7; \
            LAS unsigned char* d_ = lds + ((buf) ? VB1 : VB0) + (idx >> 3) * AT_KSTR + (p_ >> 1) * 32 + (p_ & 1) * 8; \
            *(LAS u32x2*)d_ = (u32x2){vreg[i_].x, vreg[i_].y}; *(LAS u32x2*)(d_ + 16) = (u32x2){vreg[i_].z, vreg[i_].w}; } } } while (0)
    AT_GLOAD(kt_hi - 1); AT_LWRITE(0);
    __syncthreads();
    const int ntile = kt_hi - kt_lo;
    for (int it = 0; it < ntile; ++it) {
        const int kt = kt_hi - 1 - it, buf = it & 1, key0 = 64 * kt;
        if (it + 1 < ntile) AT_GLOAD(kt - 1);
        bool skip;
        if (MODE == 0) skip = key0 > qw_last;
        else if (MODE == 1) skip = (key0 > qw_last) || !((orm >> kt) & 1u);
        else if (MODE == 2) skip = (key0 > qw_last) || (key0 + 63 < qw_first - 511);
        else skip = key0 >= nv_wmax;
        if (!skip) {
            const LAS unsigned char* kb = lds + (buf ? KB1 : KB0); const LAS unsigned char* vb = lds + (buf ? VB1 : VB0);
            f32x16 S[2];
#pragma unroll
            for (int kk = 0; kk < 2; ++kk) {
                S[kk] = cb[kk];
#pragma unroll
                for (int ks = 0; ks < 4; ++ks) { const bf16x8 a = *(const LAS bf16x8*)(kb + (32 * kk + r) * AT_KSTR + (16 * ks + 8 * hh) * 2);
                    S[kk] = __builtin_amdgcn_mfma_f32_32x32x16_bf16(a, qf[ks], S[kk], 0, 0, 0); }
            }
            const bool bnd = (MODE == 3) ? true : ((key0 + 63 > qw_first) || (MODE == 2 && key0 < qw_last - 511));
            if (bnd) {
                const int lim = (MODE == 3) ? (nv - key0 - 4 * hh) : (qrow - key0 - 4 * hh);
#pragma unroll
                for (int kk = 0; kk < 2; ++kk)
#pragma unroll
                    for (int i = 0; i < 16; ++i) { const int cki = 32 * kk + 8 * (i >> 2) + (i & 3);
                        bool valid;
                        if (MODE == 3) valid = cki < lim; else if (MODE == 2) valid = (cki <= lim) && (cki > lim - 512); else valid = cki <= lim;
                        S[kk][i] = valid ? S[kk][i] : NEGF; }
            }
            float mx = NEGF;
#pragma unroll
            for (int kk = 0; kk < 2; ++kk)
#pragma unroll
                for (int i = 0; i < 16; ++i) mx = fmaxf(mx, S[kk][i]);
            mx = fmaxf(mx, __shfl_xor(mx, 32));
            const float off = (MODE == 3) ? 0.f : slope * (float)key0;
            mx += off;
            bool selok = true;
            if (MODE == 1) { selok = ((selm >> kt) & 1u) != 0u; mx = selok ? mx : NEGF; }
            const float mnew = fmaxf(mrun, mx);
            const float meff = (mnew < -1e29f) ? 0.f : mnew;
            float c = (off - meff) * LOG2E;
            if (MODE == 1) c = selok ? c : NEGF;
            float ps = 0.f;
#pragma unroll
            for (int kk = 0; kk < 2; ++kk)
#pragma unroll
                for (int i = 0; i < 16; ++i) { const float p = __builtin_amdgcn_exp2f(__builtin_fmaf(S[kk][i], LOG2E, c)); S[kk][i] = p; ps += p; }
            if (__any(mnew > mrun)) {
                const float alpha = __builtin_amdgcn_exp2f((mrun - mnew) * LOG2E);
                lrun *= alpha;
#pragma unroll
                for (int rb = 0; rb < NRB; ++rb)
#pragma unroll
                    for (int i = 0; i < 16; ++i) O[rb][i] *= alpha;
            }
            mrun = mnew; lrun += ps;
#pragma unroll
            for (int kk = 0; kk < 2; ++kk)
#pragma unroll
                for (int s2 = 0; s2 < 2; ++s2) {
                    u32x4 pw; pw.x = pk2(S[kk][8 * s2 + 0], S[kk][8 * s2 + 1]); pw.y = pk2(S[kk][8 * s2 + 2], S[kk][8 * s2 + 3]);
                    pw.z = pk2(S[kk][8 * s2 + 4], S[kk][8 * s2 + 5]); pw.w = pk2(S[kk][8 * s2 + 6], S[kk][8 * s2 + 7]);
                    const bf16x8 pf = __builtin_bit_cast(bf16x8, pw);
#pragma unroll
                    for (int rb = 0; rb < NRB; ++rb) {
                        const bf16x8 a = *(const LAS bf16x8*)(vb + (32 * rb + r) * AT_KSTR + (2 * kk + s2) * 32 + hh * 16);
                        O[rb] = __builtin_amdgcn_mfma_f32_32x32x16_bf16(a, pf, O[rb], 0, 0, 0);
                    }
                }
        }
        if (it + 1 < ntile) AT_LWRITE(buf ^ 1);
        __syncthreads();
    }
#undef AT_GLOAD
#undef AT_LWRITE
    const float ltot = lrun + __shfl_xor(lrun, 32);
    float inv = 1.0f / ltot;
    if (MODE == 3) inv = (nv > 0) ? inv : 0.f;
#pragma unroll
    for (int rb = 0; rb < NRB; ++rb)
#pragma unroll
        for (int g4 = 0; g4 < 4; ++g4) {
            const float a = O[rb][4 * g4] * inv, b = O[rb][4 * g4 + 1] * inv, c = O[rb][4 * g4 + 2] * inv, d = O[rb][4 * g4 + 3] * inv;
            const int dv = 32 * rb + 8 * g4 + 4 * hh;
            if (MODE == 3 && rb == 2) { *(f32x4*)(impp + (size_t)(32 * w + r) * 256 + (dv - 64)) = (f32x4){a, b, c, d}; }
            else { u32x2 o; o.x = pk2(a, b); o.y = pk2(c, d); *(u32x2*)(Op + (size_t)(32 * w + r) * ldo + dv) = o; }
        }
}

struct Args { const float* in[26]; float* out; unsigned char* ws; int ph_lo, ph_hi; };
typedef const __attribute__((address_space(4))) Args* ArgsP;
DI ArgsP opaque_args() { auto p = __builtin_amdgcn_kernarg_segment_ptr(); asm volatile("" : "+s"(p)); return (ArgsP)p; }
enum { I_X = 0, I_P, I_N1G, I_N2G, I_EVWIN, I_EVWOUT, I_DAQN, I_DAKN, I_DALAM, I_DAOUTG, I_NSQN, I_NSKN, I_CMPPE, I_CMPW1, I_CMPW2, I_ODWIN, I_ODWOUT,
       I_RETG, I_ROUTW, I_ROUTB, I_WGU, I_BGU, I_WDN, I_BDN, I_PLEP, I_PLEG };

struct CvtJob { int in_idx, ldsrc, K, col0, ncols, dstrow0, perm, nmat; size_t src_stride, dst_off, dst_stride; int fp8, pad; };
constexpr int NJOBS = 19;
__constant__ CvtJob c_jobs[NJOBS] = {
    {I_EVWIN, EVIN, 1024, 0,    1024, 0,    1, 2, (size_t)1024 * EVIN, WS_EVNAT, (size_t)2048 * 1024, 0, 0},
    {I_EVWIN, EVIN, 1024, 1536, 512,  1024, 1, 2, (size_t)1024 * EVIN, WS_EVNAT, (size_t)2048 * 1024, 0, 0},
    {I_EVWIN, EVIN, 1024, 2048, 128,  1536, 1, 2, (size_t)1024 * EVIN, WS_EVNAT, (size_t)2048 * 1024, 0, 0},
    {I_EVWIN, EVIN, 1024, 2176, 128,  1664, 1, 2, (size_t)1024 * EVIN, WS_EVNAT, (size_t)2048 * 1024, 0, 0},
    {I_EVWIN, EVIN, 1024, 2304, 128,  1792, 1, 2, (size_t)1024 * EVIN, WS_EVNAT, (size_t)2048 * 1024, 0, 0},
    {I_EVWIN, EVIN, 1024, 2560, 128,  1920, 1, 2, (size_t)1024 * EVIN, WS_EVNAT, (size_t)2048 * 1024, 0, 0},
    {I_EVWIN, EVIN, 1024, 1024, 512,  0,    0, 2, (size_t)1024 * EVIN, WS_EVSW,  (size_t)768 * 1024, 0, 0},
    {I_EVWIN, EVIN, 1024, 2432, 128,  512,  0, 2, (size_t)1024 * EVIN, WS_EVSW,  (size_t)768 * 1024, 0, 0},
    {I_EVWIN, EVIN, 1024, 2688, 128,  640,  0, 2, (size_t)1024 * EVIN, WS_EVSW,  (size_t)768 * 1024, 0, 0},
    {I_EVWOUT, 1024, 1024, 0, 1024, 0, 0, 2, (size_t)1024 * 1024, WS_EVOUT, (size_t)1024 * 1024, 0, 0},
    {I_CMPW1, 256, 2048, 0, 256, 0, 0, 4, (size_t)2048 * 256, WS_CMP1, (size_t)256 * 2048, 0, 0},
    {I_ODWIN, ODIN, 1024, 0,    2048, 0,    0, 2, (size_t)1024 * ODIN, WS_ODNAT, (size_t)4096 * 1024, 0, 0},
    {I_ODWIN, ODIN, 1024, 4096, 2048, 2048, 0, 2, (size_t)1024 * ODIN, WS_ODNAT, (size_t)4096 * 1024, 0, 0},
    {I_ODWIN, ODIN, 1024, 1024, 3072, 0,    0, 2, (size_t)1024 * ODIN, WS_ODSW,  (size_t)3072 * 1024, 0, 0},
    {I_ODWOUT, 1024, 2048, 0, 1024, 0, 0, 2, (size_t)2048 * 1024, WS_ODOUT, (size_t)1024 * 2048, 0, 0},
    {I_WGU, 2048, 1024, 0, 2048, 0, 2, 128, (size_t)1024 * 2048, WS_WGU, (size_t)2048 * 1024, 1, 0},
    {I_WDN, 1024, 1024, 0, 1024, 0, 0, 128, (size_t)1024 * 1024, WS_WDN, (size_t)1024 * 1024, 0, 0},
    {I_PLEP, 1024, 256, 0, 1024, 0, 0, 4, (size_t)256 * 1024, WS_WPP, (size_t)1024 * 256, 0, 0},
    {I_PLEG, 1024, 1024, 0, 1024, 0, 0, 4, (size_t)1024 * 1024, WS_WPG, (size_t)1024 * 1024, 0, 0},
};
DI int cvt_dstrow(int perm, int L) {
    if (perm == 1) { const int pn = L >> 8, lc = L & 255; return pn * 256 + 128 * ((lc & 63) >> 5) + 32 * (lc >> 6) + (lc & 31); }
    if (perm == 2) { const int bj = L >> 10, cc = L & 1023; return 256 * (cc >> 7) + 128 * bj + (cc & 127); }
    return L;
}
DI void phase_prologue(const int WID, ArgsP a, LAS unsigned char* lds) {
    const int tid = opaque_tid(WID), lane = tid & 63, wv = tid >> 6;
    const int gw = blockIdx.x * 8 + wv, NGW = gridDim.x * 8;
    LAS float* scr = (LAS float*)(lds + wv * 16640);
    int total = 0;
    for (int j = 0; j < NJOBS; ++j) total += c_jobs[j].nmat * (c_jobs[j].K >> 6) * (c_jobs[j].ncols >> 6);
    for (int it = gw; it < total; it += NGW) {
        int r = it, j = 0;
        for (; j < NJOBS; ++j) { const int n = c_jobs[j].nmat * (c_jobs[j].K >> 6) * (c_jobs[j].ncols >> 6); if (r < n) break; r -= n; }
        const CvtJob J = c_jobs[j];
        const int nkb = J.K >> 6, nnb = J.ncols >> 6, per = nkb * nnb;
        const int mat = r / per, rr = r % per, kb = rr / nnb, nb = rr % nnb, k0 = kb * 64, n0 = nb * 64;
        const float* src = a->in[J.in_idx] + (size_t)mat * J.src_stride + (size_t)k0 * J.ldsrc + J.col0 + n0 + lane;
        { float tv[64];
#pragma unroll
          for (int i = 0; i < 64; ++i) tv[i] = src[(size_t)i * J.ldsrc];
#pragma unroll
          for (int i = 0; i < 64; ++i) scr[i * 65 + lane] = tv[i]; }
        asm volatile("s_waitcnt lgkmcnt(0)" ::: "memory");
        if (J.fp8) {
            unsigned char* dst = (unsigned char*)(a->ws + J.dst_off) + (size_t)mat * J.dst_stride;
            const int c = lane & 3, nsub = lane >> 2;
#pragma unroll
            for (int jj = 0; jj < 4; ++jj) {
                const int n = nsub + 16 * jj; const LAS float* s = scr + (16 * c) * 65 + n;
                u32x4 o;
                o.x = pk4_fp8(s[0] * W8_SCALE, s[65] * W8_SCALE, s[2 * 65] * W8_SCALE, s[3 * 65] * W8_SCALE); o.y = pk4_fp8(s[4 * 65] * W8_SCALE, s[5 * 65] * W8_SCALE, s[6 * 65] * W8_SCALE, s[7 * 65] * W8_SCALE);
                o.z = pk4_fp8(s[8 * 65] * W8_SCALE, s[9 * 65] * W8_SCALE, s[10 * 65] * W8_SCALE, s[11 * 65] * W8_SCALE); o.w = pk4_fp8(s[12 * 65] * W8_SCALE, s[13 * 65] * W8_SCALE, s[14 * 65] * W8_SCALE, s[15 * 65] * W8_SCALE);
                const int drow = cvt_dstrow(J.perm, J.dstrow0 + n0 + n);
                *(u32x4*)(dst + (size_t)drow * J.K + k0 + 16 * c) = o;
            }
        } else {
        bf16_t* dst = (bf16_t*)(a->ws + J.dst_off) + (size_t)mat * J.dst_stride;
        const int c = lane & 7, nsub = lane >> 3;
#pragma unroll
        for (int jj = 0; jj < 8; ++jj) {
            const int n = nsub + 8 * jj; const LAS float* s = scr + (8 * c) * 65 + n;
            u32x4 o; o.x = pk2(s[0], s[65]); o.y = pk2(s[2 * 65], s[3 * 65]); o.z = pk2(s[4 * 65], s[5 * 65]); o.w = pk2(s[6 * 65], s[7 * 65]);
            const int drow = cvt_dstrow(J.perm, J.dstrow0 + n0 + n);
            *(u32x4*)(dst + (size_t)drow * J.K + k0 + 8 * c) = o;
        }
        }
        asm volatile("s_waitcnt lgkmcnt(0)" ::: "memory");
    }
    {
        const float* p = a->in[I_P]; bf16_t* pb = (bf16_t*)(a->ws + WS_PBF);
        const size_t n8 = (size_t)DEPTH * T * 256 / 8;
        for (size_t i = (size_t)blockIdx.x * 512 + tid; i < n8; i += (size_t)gridDim.x * 512) {
            const f32x4 v0 = *(const f32x4*)(p + i * 8), v1 = *(const f32x4*)(p + i * 8 + 4);
            *(u32x4*)(pb + i * 8) = pack8(v0, v1);
        }
    }
    if (blockIdx.x == 4 && tid < 512) { const int ev = tid >> 8, gi = (tid >> 6) & 3, d = tid & 63;
        const float* src = a->in[gi == 0 ? I_DAQN : gi == 1 ? I_DAKN : gi == 2 ? I_NSQN : I_NSKN];
        ((float*)(a->ws + WS_GAINS))[tid] = src[ev * 64 + d]; }
    if (blockIdx.x < 4 && tid < 256) {
        const int m = blockIdx.x; const float* pe = a->in[I_CMPPE] + (size_t)m * 2048; const float* w1 = a->in[I_CMPW1] + (size_t)m * 2048 * 256;
        float s = 0.f;
        for (int k = 0; k < 2048; ++k) s += pe[k] * w1[(size_t)k * 256 + tid];
        ((float*)(a->ws + WS_BIAS1))[m * 256 + tid] = s;
    }
}

DI float row_load_ss(const float* row, int lane, f32x4 (&v)[4]) {
    float ss = 0.f;
#pragma unroll
    for (int j = 0; j < 4; ++j) { v[j] = *(const f32x4*)(row + 4 * lane + 256 * j); ss += (v[j][0] * v[j][0] + v[j][1] * v[j][1]) + (v[j][2] * v[j][2] + v[j][3] * v[j][3]); }
    return wave_sum(ss);
}
DI void row_store_bf16(bf16_t* row, int lane, const f32x4 (&v)[4]) {
#pragma unroll
    for (int j = 0; j < 4; ++j) { u32x2 o; o.x = pk2(v[j][0], v[j][1]); o.y = pk2(v[j][2], v[j][3]); *(u32x2*)(row + 4 * lane + 256 * j) = o; }
}
template <int MODE>
DI void phase_norm(const int WID, ArgsP a, LAS unsigned char* lds, int layer, const float* Hin) {
    const int tid = opaque_tid(WID), lane = tid & 63, wv = __builtin_amdgcn_readfirstlane(tid >> 6);
    LAS float* wt = (LAS float*)lds;
    LAS int* bcl = (LAS int*)(lds + MISC_OFF + MO_WCNT); LAS int* ent = (LAS int*)(lds + MISC_OFF + MO_ENT); LAS float* gat = (LAS float*)(lds + MISC_OFF + MO_GAT);
    LAS float* lgb = (LAS float*)(lds + MISC_OFF + MO_RED);
    bf16_t* XN = (bf16_t*)(a->ws + WS_XN);
    const float* gain = a->in[MODE == 2 ? I_N2G : I_N1G] + layer * 1024;
    constexpr int NQ = MODE == 0 ? 24 : (MODE == 2 ? 32 : 0);
    if (NQ > 0) {
        const float* w = (MODE == 0) ? a->in[I_EVWIN] + (size_t)(layer >> 1) * 1024 * EVIN + 2816 : a->in[I_ROUTW] + (size_t)layer * 1024 * 32;
        const int ldw = (MODE == 0) ? EVIN : 32;
        for (int i = tid; i < 256 * 32; i += 512) { const int q = i & 31, g = i >> 5;
            if (q < NQ) { f32x4 v; v[0] = w[(size_t)(4 * g) * ldw + q]; v[1] = w[(size_t)(4 * g + 1) * ldw + q]; v[2] = w[(size_t)(4 * g + 2) * ldw + q]; v[3] = w[(size_t)(4 * g + 3) * ldw + q];
                *(LAS f32x4*)(wt + q * 1024 + 4 * (g ^ q)) = v; } }
    }
    f32x4 gn[4];
#pragma unroll
    for (int j = 0; j < 4; ++j) gn[j] = *(const f32x4*)(gain + 4 * lane + 256 * j);
    const float rbias = (MODE == 2) ? a->in[I_ROUTB][layer * 32 + (lane & 31)] : 0.f;
    __syncthreads();
    for (int vb = blockIdx.x; vb < NTB; vb += gridDim.x) {
        if (MODE == 2) { if (tid < 32) bcl[tid] = 0; }
        const int t0 = vb * 128 + wv * 16;
        f32x4 na[4], nb[4];
#pragma unroll
        for (int j = 0; j < 4; ++j) { na[j] = *(const f32x4*)(Hin + (size_t)t0 * 1024 + 4 * lane + 256 * j); nb[j] = *(const f32x4*)(Hin + (size_t)(t0 + 1) * 1024 + 4 * lane + 256 * j); }
#pragma unroll 1
        for (int it = 0; it < 8; ++it) {
            const int ta = t0 + 2 * it;
            f32x4 va[4], vc[4];
#pragma unroll
            for (int j = 0; j < 4; ++j) { va[j] = na[j]; vc[j] = nb[j]; }
            if (it < 7) {
#pragma unroll
                for (int j = 0; j < 4; ++j) { na[j] = *(const f32x4*)(Hin + (size_t)(ta + 2) * 1024 + 4 * lane + 256 * j); nb[j] = *(const f32x4*)(Hin + (size_t)(ta + 3) * 1024 + 4 * lane + 256 * j); }
            }
            float sa = 0.f, sb = 0.f;
#pragma unroll
            for (int j = 0; j < 4; ++j) { sa += (va[j][0] * va[j][0] + va[j][1] * va[j][1]) + (va[j][2] * va[j][2] + va[j][3] * va[j][3]); sb += (vc[j][0] * vc[j][0] + vc[j][1] * vc[j][1]) + (vc[j][2] * vc[j][2] + vc[j][3] * vc[j][3]); }
#pragma unroll
            for (int o = 1; o < 64; o <<= 1) { sa += __shfl_xor(sa, o); sb += __shfl_xor(sb, o); }
            const float ra = rsqrtf(sa * (1.0f / 1024.0f) + EPS), rb2 = rsqrtf(sb * (1.0f / 1024.0f) + EPS);
#pragma unroll
            for (int j = 0; j < 4; ++j) { va[j] = va[j] * ra * gn[j]; vc[j] = vc[j] * rb2 * gn[j]; }
            row_store_bf16(XN + (size_t)ta * 1024, lane, va); row_store_bf16(XN + (size_t)(ta + 1) * 1024, lane, vc);
            if (NQ > 0) {
                float x[64];
#pragma unroll
                for (int q = 0; q < 32; ++q) {
                    if (q < NQ) { float s0 = 0.f, s1 = 0.f;
#pragma unroll
                        for (int j = 0; j < 4; ++j) { const f32x4 ww = *(const LAS f32x4*)(wt + q * 1024 + 4 * ((lane + 64 * j) ^ q));
                            s0 += (va[j][0] * ww[0] + va[j][1] * ww[1]) + (va[j][2] * ww[2] + va[j][3] * ww[3]); s1 += (vc[j][0] * ww[0] + vc[j][1] * ww[1]) + (vc[j][2] * ww[2] + vc[j][3] * ww[3]); }
                        x[q] = s0; x[32 + q] = s1;
                        if ((q & 3) == 3) asm volatile("" ::: "memory");
                    } else { x[q] = 0.f; x[32 + q] = 0.f; }
                }
#define RS_STEP(N, BIT) _Pragma("unroll") for (int i = 0; i < (N); ++i) { const bool up = (lane & (BIT)) != 0; const float keep = up ? x[(N) + i] : x[i], send = up ? x[i] : x[(N) + i]; x[i] = keep + __shfl_xor(send, (BIT)); }
                RS_STEP(32, 32) RS_STEP(16, 16) RS_STEP(8, 8) RS_STEP(4, 4) RS_STEP(2, 2) RS_STEP(1, 1)
#undef RS_STEP
                const float val = x[0];
                if (MODE == 0) { if ((lane & 31) < 24) ((float*)(a->ws + WS_GATES))[(size_t)(ta + (lane >> 5)) * 24 + (lane & 31)] = sigm(val); }
                if (MODE == 2) {
                    lgb[wv * 64 + lane] = val + rbias;
                    asm volatile("s_waitcnt lgkmcnt(0)" ::: "memory");
                    float lg[32];
#pragma unroll
                    for (int q4 = 0; q4 < 8; ++q4) { const f32x4 t4 = *(const LAS f32x4*)(lgb + wv * 64 + (lane & 32) + 4 * q4); lg[4 * q4] = t4[0]; lg[4 * q4 + 1] = t4[1]; lg[4 * q4 + 2] = t4[2]; lg[4 * q4 + 3] = t4[3]; }
                    unsigned used = 0u; int te[4]; float tv[4];
#pragma unroll
                    for (int k = 0; k < 4; ++k) { float best = -3.0e38f; int bi = 0;
#pragma unroll
                        for (int q = 0; q < 32; ++q) { const bool ok = !((used >> q) & 1u) && (lg[q] > best); best = ok ? lg[q] : best; bi = ok ? q : bi; }
                        used |= 1u << bi; te[k] = bi; tv[k] = best; }
                    float ex[4], sum = 0.f;
#pragma unroll
                    for (int k = 0; k < 4; ++k) { ex[k] = __expf(tv[k] - tv[0]); sum += ex[k]; }
                    const float rs = 1.0f / sum;
                    if ((lane & 31) == 0) {
                        const int eb = wv * 64 + (2 * it + (lane >> 5)) * 4;
#pragma unroll
                        for (int k = 0; k < 4; ++k) { ent[eb + k] = te[k]; gat[eb + k] = ex[k] * rs; }
                    }
                    asm volatile("s_waitcnt lgkmcnt(0)" ::: "memory");
                }
            }
        }
        if (MODE == 2) {
            __syncthreads();
            { const int e = ent[wv * 64 + lane];
              const int pos = __hip_atomic_fetch_add(bcl + e, 1, __ATOMIC_RELAXED, __HIP_MEMORY_SCOPE_WORKGROUP);
              const size_t idx = (size_t)(vb * 128 + wv * 16) * 4 + lane;
              ((int*)(a->ws + WS_TOPE))[idx] = e; ((int*)(a->ws + WS_POSB))[idx] = pos; ((float*)(a->ws + WS_GATEW))[idx] = gat[wv * 64 + lane]; }
            __syncthreads();
            if (tid < 32) ((int*)(a->ws + WS_BCNT))[((size_t)layer * NTB + vb) * 32 + tid] = bcl[tid];
            __syncthreads();
        }
    }
}
DI void moe_tables(const int WID, ArgsP a, LAS unsigned char* lds, int layer, int vb) {
    const int tid = opaque_tid(WID);
    LAS int* tot = (LAS int*)(lds + MISC_OFF + MO_TOT); LAS int* base = (LAS int*)(lds + MISC_OFF + MO_BASE); LAS int* ts = (LAS int*)(lds + MISC_OFF + MO_TS);
    LAS int* red = (LAS int*)(lds + MISC_OFF + MO_RED);
    const int* bc = (const int*)(a->ws + WS_BCNT) + (size_t)layer * NTB * 32;
    { const int e = tid & 31, part = tid >> 5; int st = 0, sp = 0;
      for (int blk = part; blk < NTB; blk += 16) { const int v = bc[blk * 32 + e]; st += v; sp += (blk < vb) ? v : 0; }
      red[part * 32 + e] = st; red[512 + part * 32 + e] = sp; }
    __syncthreads();
    if (tid < 32) { int st = 0, sp = 0;
#pragma unroll
        for (int p = 0; p < 16; ++p) { st += red[p * 32 + tid]; sp += red[512 + p * 32 + tid]; }
        tot[tid] = st; base[tid] = sp; }
    __syncthreads();
    if (tid == 0) { int acc = 0; for (int e = 0; e < 32; ++e) { ts[e] = acc; acc += (tot[e] + 255) >> 8; } ts[32] = acc; }
    __syncthreads();
}
DI void phase_moe_slots(const int WID, ArgsP a, LAS unsigned char* lds, int layer) {
    const int tid = opaque_tid(WID), lane = tid & 63, wv = tid >> 6;
    LAS int* base = (LAS int*)(lds + MISC_OFF + MO_BASE); LAS int* ts = (LAS int*)(lds + MISC_OFF + MO_TS);
    const bf16_t* XN = (const bf16_t*)(a->ws + WS_XN); unsigned char* XB = (unsigned char*)(a->ws + WS_XB);
    for (int vb = blockIdx.x; vb < NTB; vb += gridDim.x) {
        moe_tables(WID, a, lds, layer, vb);
#pragma unroll 1
        for (int i = 0; i < 16; ++i) {
            const int t = vb * 128 + wv * 16 + i;
            int dest = 0;
            if (lane < 4) { const int e = ((const int*)(a->ws + WS_TOPE))[(size_t)t * 4 + lane], pos = ((const int*)(a->ws + WS_POSB))[(size_t)t * 4 + lane];
                dest = ts[e] * 256 + base[e] + pos; ((int*)(a->ws + WS_DEST))[(size_t)t * 4 + lane] = dest; }
            const u32x4 r0 = *(const u32x4*)(XN + (size_t)t * 1024 + 8 * lane), r1 = *(const u32x4*)(XN + (size_t)t * 1024 + 512 + 8 * lane);
            u32x2 q0, q1;
            q0.x = pk4_fp8(bflo(r0.x), bfhi(r0.x), bflo(r0.y), bfhi(r0.y)); q0.y = pk4_fp8(bflo(r0.z), bfhi(r0.z), bflo(r0.w), bfhi(r0.w));
            q1.x = pk4_fp8(bflo(r1.x), bfhi(r1.x), bflo(r1.y), bfhi(r1.y)); q1.y = pk4_fp8(bflo(r1.z), bfhi(r1.z), bflo(r1.w), bfhi(r1.w));
#pragma unroll
            for (int k = 0; k < 4; ++k) { const int d = __shfl(dest, k); unsigned char* o = XB + (size_t)d * 1024; *(u32x2*)(o + 8 * lane) = q0; *(u32x2*)(o + 512 + 8 * lane) = q1; }
        }
        __syncthreads();
    }
}
DI void phase_combine(const int WID, ArgsP a, float* H) {
    const int tid = opaque_tid(WID), lane = tid & 63, wv = tid >> 6;
    const bf16_t* YB = (const bf16_t*)(a->ws + WS_YB); bf16_t* XN = (bf16_t*)(a->ws + WS_XN);
    for (int t = blockIdx.x * 8 + wv; t < T; t += gridDim.x * 8) {
        int dest = 0; float gw = 0.f;
        if (lane < 4) { dest = ((const int*)(a->ws + WS_DEST))[(size_t)t * 4 + lane]; gw = ((const float*)(a->ws + WS_GATEW))[(size_t)t * 4 + lane]; }
        f32x4 v[4];
#pragma unroll
        for (int j = 0; j < 4; ++j) v[j] = *(const f32x4*)(H + (size_t)t * 1024 + 4 * lane + 256 * j);
#pragma unroll
        for (int k = 0; k < 4; ++k) { const int d = __shfl(dest, k); const float g = __shfl(gw, k); const bf16_t* y = YB + (size_t)d * 1024;
#pragma unroll
            for (int j = 0; j < 4; ++j) { const u32x2 w = *(const u32x2*)(y + 4 * lane + 256 * j); v[j][0] += g * bflo(w.x); v[j][1] += g * bfhi(w.x); v[j][2] += g * bflo(w.y); v[j][3] += g * bfhi(w.y); } }
        float ss = 0.f;
#pragma unroll
        for (int j = 0; j < 4; ++j) { *(f32x4*)(H + (size_t)t * 1024 + 4 * lane + 256 * j) = v[j]; ss += (v[j][0] * v[j][0] + v[j][1] * v[j][1]) + (v[j][2] * v[j][2] + v[j][3] * v[j][3]); }
        ss = wave_sum(ss);
        const float rstd = rsqrtf(ss * (1.0f / 1024.0f) + EPS);
#pragma unroll
        for (int j = 0; j < 4; ++j) v[j] = v[j] * rstd;
        row_store_bf16(XN + (size_t)t * 1024, lane, v);
    }
}
DI void phase_cmp2(const int WID, ArgsP a, LAS unsigned char* lds, int ev) {
    const int tid = opaque_tid(WID), lane = tid & 63, wv = __builtin_amdgcn_readfirstlane(tid >> 6);
    const bf16_t* HID = (const bf16_t*)(a->ws + WS_HID); bf16_t* KCMP = (bf16_t*)(a->ws + WS_KCMP); bf16_t* VCMPT = (bf16_t*)(a->ws + WS_VCMPT);
    const float kg = a->in[I_NSKN][ev * 64 + lane];
    LAS float* wl = (LAS float*)lds;
    for (int i = tid; i < 2 * 256 * 64 / 4; i += 512) *(LAS f32x4*)(wl + 4 * i) = *(const f32x4*)(a->in[I_CMPW2] + (size_t)ev * 2 * 256 * 64 + 4 * i);
    __syncthreads();
    for (int gi = blockIdx.x * 8 + wv; gi < 2048; gi += gridDim.x * 8) {
        const int kv = gi >> 10, row0 = (gi & 1023) * 4;
        const bf16_t* hrow = HID + ((size_t)kv * 4096 + row0) * 256;
        const LAS float* w2 = wl + kv * 256 * 64 + lane;
        float s[4] = {0.f, 0.f, 0.f, 0.f};
#pragma unroll 2
        for (int k = 0; k < 256; k += 8) {
            u32x4 hw[4];
#pragma unroll
            for (int r = 0; r < 4; ++r) hw[r] = *(const u32x4*)(hrow + r * 256 + k);
            float wv8[8];
#pragma unroll
            for (int j = 0; j < 8; ++j) wv8[j] = w2[(k + j) * 64];
#pragma unroll
            for (int r = 0; r < 4; ++r)
                s[r] += bflo(hw[r].x) * wv8[0] + bfhi(hw[r].x) * wv8[1] + bflo(hw[r].y) * wv8[2] + bfhi(hw[r].y) * wv8[3] + bflo(hw[r].z) * wv8[4] + bfhi(hw[r].z) * wv8[5] + bflo(hw[r].w) * wv8[6] + bfhi(hw[r].w) * wv8[7];
        }
#pragma unroll
        for (int r = 0; r < 4; ++r) {
            const int row = row0 + r, bg = row >> 7, n = row & 127;
            float v = (n == 127) ? 0.f : s[r];
            if (kv == 0) { const float ss = wave_sum(v * v); const float o = v * rsqrtf(ss * (1.0f / 64.0f) + EPS) * kg;
                KCMP[((size_t)bg * 128 + n) * 64 + lane] = (bf16_t)(pk2(o, 0.f) & 0xffffu); }
            else VCMPT[((size_t)bg * 96 + lane) * 128 + n] = (bf16_t)(pk2(v, 0.f) & 0xffffu);
        }
    }
    for (int i = blockIdx.x * 512 + tid; i < 32 * 32 * 128; i += gridDim.x * 512) {
        const int n = i & 127, j = (i >> 7) & 31, bg = i >> 12;
        float o = 0.f;
        if (n < 127) { const int d = n - 4 * j; if (d >= 0 && d <= 2) o = 1.0f; else if (d == 3 || d == -1) o = 0.5f; }
        VCMPT[((size_t)bg * 96 + 64 + j) * 128 + n] = (bf16_t)(pk2(o, 0.f) & 0xffffu);
    }
}
DI void phase_topk(const int WID, ArgsP a) {
    const float* IMPH = (const float*)(a->ws + WS_IMPH); unsigned* SELM = (unsigned*)(a->ws + WS_SELM);
    for (int i = blockIdx.x * 512 + opaque_tid(WID); i < T * 2; i += gridDim.x * 512) {
        const int t = i >> 1, g = i & 1, b = t >> 11, s = t & 2047, cur = s >> 6;
        float sc[32];
#pragma unroll
        for (int j4 = 0; j4 < 8; ++j4) { f32x4 acc = {0.f, 0.f, 0.f, 0.f};
#pragma unroll
            for (int r = 0; r < 4; ++r) acc += *(const f32x4*)(IMPH + ((size_t)t * 8 + g * 4 + r) * 32 + 4 * j4);
#pragma unroll
            for (int q = 0; q < 4; ++q) sc[4 * j4 + q] = acc[q]; }
        unsigned mask;
        if (cur < 16) mask = (cur == 31) ? 0xffffffffu : ((2u << cur) - 1u);
        else {
#pragma unroll
            for (int j = 0; j < 32; ++j) { const bool forced = (j == 0) || (j == cur) || (j == cur - 1); sc[j] = (j > cur) ? NEGF : (sc[j] + (forced ? 1e4f : 0.f)); }
            mask = 0u;
#pragma unroll
            for (int j = 0; j < 32; ++j) { int rank = 0;
#pragma unroll
                for (int k = 0; k < 32; ++k) rank += ((sc[k] > sc[j]) || (sc[k] == sc[j] && k < j)) ? 1 : 0;
                mask |= (rank < 16) ? (1u << j) : 0u; }
        }
        SELM[((size_t)(b * 2 + g)) * 2048 + s] = mask;
    }
}
DI void phase_mixprep(const int WID, ArgsP a, int layer) {
    const int tid = opaque_tid(WID), lane = tid & 63, wv = tid >> 6, ev = layer >> 1;
    const float* dl = a->in[I_DALAM] + ev * 256;
    const float s1 = wave_sum(dl[lane] * dl[64 + lane]), s2 = wave_sum(dl[128 + lane] * dl[192 + lane]);
    const float lam_init = 0.8f - 0.6f * expf(-0.3f * (float)layer);
    const float lam = expf(s1) - expf(s2) + lam_init;
    const float* og = a->in[I_DAOUTG] + ev * 128;
    const bf16_t* OD = (const bf16_t*)(a->ws + WS_OD); const bf16_t* OC = (const bf16_t*)(a->ws + WS_OC); const bf16_t* OS = (const bf16_t*)(a->ws + WS_OS); const bf16_t* OW = (const bf16_t*)(a->ws + WS_OW);
    const float* GT = (const float*)(a->ws + WS_GATES); bf16_t* AMIX = (bf16_t*)(a->ws + WS_AMIX);
    const int h = lane >> 4, dv = (lane & 15) * 8;
    f32x4 g0 = *(const f32x4*)(og + dv), g1 = *(const f32x4*)(og + dv + 4);
    for (int t = blockIdx.x * 8 + wv; t < T; t += gridDim.x * 8) {
        { const u32x4 w1 = *(const u32x4*)(OD + (size_t)t * 1024 + h * 128 + dv), w2 = *(const u32x4*)(OD + (size_t)t * 1024 + (4 + h) * 128 + dv);
          f32x4 d0, d1;
          d0[0] = bflo(w1.x) - lam * bflo(w2.x); d0[1] = bfhi(w1.x) - lam * bfhi(w2.x); d0[2] = bflo(w1.y) - lam * bflo(w2.y); d0[3] = bfhi(w1.y) - lam * bfhi(w2.y);
          d1[0] = bflo(w1.z) - lam * bflo(w2.z); d1[1] = bfhi(w1.z) - lam * bfhi(w2.z); d1[2] = bflo(w1.w) - lam * bflo(w2.w); d1[3] = bfhi(w1.w) - lam * bfhi(w2.w);
          float ss = (d0[0] * d0[0] + d0[1] * d0[1]) + (d0[2] * d0[2] + d0[3] * d0[3]) + (d1[0] * d1[0] + d1[1] * d1[1]) + (d1[2] * d1[2] + d1[3] * d1[3]);
          ss += __shfl_xor(ss, 1); ss += __shfl_xor(ss, 2); ss += __shfl_xor(ss, 4); ss += __shfl_xor(ss, 8);
          const float rs = rsqrtf(ss * (1.0f / 128.0f) + EPS) * (1.0f - lam_init);
          *(u32x4*)(AMIX + (size_t)t * 1024 + h * 128 + dv) = pack8(d0 * rs * g0, d1 * rs * g1); }
        { const int hd = lane >> 3, dq = (lane & 7) * 8; const size_t o = (size_t)t * 512 + hd * 64 + dq;
          const float ga = GT[(size_t)t * 24 + hd * 3], gb = GT[(size_t)t * 24 + hd * 3 + 1], gc = GT[(size_t)t * 24 + hd * 3 + 2];
          const u32x4 c = *(const u32x4*)(OC + o), s = *(const u32x4*)(OS + o), w = *(const u32x4*)(OW + o);
          f32x4 r0, r1;
          r0[0] = ga * bflo(c.x) + gb * bflo(s.x) + gc * bflo(w.x); r0[1] = ga * bfhi(c.x) + gb * bfhi(s.x) + gc * bfhi(w.x);
          r0[2] = ga * bflo(c.y) + gb * bflo(s.y) + gc * bflo(w.y); r0[3] = ga * bfhi(c.y) + gb * bfhi(s.y) + gc * bfhi(w.y);
          r1[0] = ga * bflo(c.z) + gb * bflo(s.z) + gc * bflo(w.z); r1[1] = ga * bfhi(c.z) + gb * bfhi(s.z) + gc * bfhi(w.z);
          r1[2] = ga * bflo(c.w) + gb * bflo(s.w) + gc * bflo(w.w); r1[3] = ga * bfhi(c.w) + gb * bfhi(s.w) + gc * bfhi(w.w);
          *(u32x4*)(AMIX + (size_t)t * 1024 + 512 + hd * 64 + dq) = pack8(r0, r1); }
    }
}
DI void phase_scan(const int WID, ArgsP a) {
    const float* UT = (const float*)(a->ws + WS_UT); bf16_t* VS = (bf16_t*)(a->ws + WS_VS);
    for (int i = blockIdx.x * 512 + opaque_tid(WID); i < 64 * 512 * 64; i += gridDim.x * 512) {
        const int d4 = i & 63, f = (i >> 6) & 511, bh = i >> 15, h = bh & 3;
        const float dec = exp2f(256.0f * ret_lg2(h));
        f32x4 S = {0.f, 0.f, 0.f, 0.f};
#pragma unroll 1
        for (int n = 0; n < 8; ++n) {
            const size_t z = (size_t)bh * 8 + n;
            u32x2 o; o.x = pk2(S[0], S[1]); o.y = pk2(S[2], S[3]);
            *(u32x2*)(VS + (z * 512 + f) * 512 + 256 + 4 * d4) = o;
            const f32x4 u = *(const f32x4*)(UT + z * 131072 + (size_t)f * 256 + 4 * d4);
            S = (S + u) * dec;
        }
    }
}
DI void phase_normgate(const int WID, ArgsP a, int od) {
    const int tid = opaque_tid(WID), lane = tid & 63, wv = tid >> 6;
    const bf16_t* Y = (const bf16_t*)(a->ws + WS_Y); const bf16_t* GG = (const bf16_t*)(a->ws + WS_GG); bf16_t* YG = (bf16_t*)(a->ws + WS_YG);
    const float* og = a->in[I_RETG] + od * 512;
    const f32x4 g0 = *(const f32x4*)(og + 8 * lane), g1 = *(const f32x4*)(og + 8 * lane + 4);
    for (int t = blockIdx.x * 8 + wv; t < T; t += gridDim.x * 8) {
#pragma unroll
        for (int h = 0; h < 4; ++h) {
            const size_t o = (size_t)t * 2048 + h * 512 + 8 * lane;
            const u32x4 yw = *(const u32x4*)(Y + o), gw = *(const u32x4*)(GG + o);
            f32x4 y0 = {bflo(yw.x), bfhi(yw.x), bflo(yw.y), bfhi(yw.y)}, y1 = {bflo(yw.z), bfhi(yw.z), bflo(yw.w), bfhi(yw.w)};
            const f32x4 q0 = {bflo(gw.x), bfhi(gw.x), bflo(gw.y), bfhi(gw.y)}, q1 = {bflo(gw.z), bfhi(gw.z), bflo(gw.w), bfhi(gw.w)};
            float ss = (y0[0] * y0[0] + y0[1] * y0[1]) + (y0[2] * y0[2] + y0[3] * y0[3]) + (y1[0] * y1[0] + y1[1] * y1[1]) + (y1[2] * y1[2] + y1[3] * y1[3]);
            ss = wave_sum(ss);
            const float rs = rsqrtf(ss * (1.0f / 512.0f) + EPS);
            *(u32x4*)(YG + o) = pack8(y0 * rs * g0 * q0, y1 * rs * g1 * q1);
        }
    }
}
DI int snake_unit(int rnd, int G, int c) { return (rnd & 1) ? rnd * G + (G - 1 - c) : rnd * G + c; }
template <int MODE>
DI void phase_attn(const int WID, ArgsP a, LAS unsigned char* lds) {
    const int G = gridDim.x, c = blockIdx.x;
    const bf16_t* QD = (const bf16_t*)(a->ws + WS_QD); const bf16_t* KD = (const bf16_t*)(a->ws + WS_KD); const bf16_t* QN = (const bf16_t*)(a->ws + WS_QN);
    for (int rnd = 0;; ++rnd) {
        const int L = snake_unit(rnd, G, c); if (L >= 1024) { if (rnd * G >= 1024) break; else continue; }
        const int qb = 7 - (L >> 7), bh = L & 127, b = bh >> 3, hd = bh & 7, q0 = qb * 256; const size_t t0 = (size_t)b * 2048 + q0;
        if (MODE == 0) {
            const float slope = exp2f(-2.0f * (float)((hd & 3) + 1));
            attn_unit<128, 0>(WID, lds, QD + t0 * 512 + hd * 64, 512, KD + (size_t)b * 2048 * 512 + hd * 64, 512,
                              (const bf16_t*)(a->ws + WS_VAT) + (size_t)(b * 4 + (hd & 3)) * 128 * 2048, 2048, q0, slope, nullptr,
                              (bf16_t*)(a->ws + WS_OD) + t0 * 1024 + hd * 128, 1024, nullptr);
        } else if (MODE == 1 || MODE == 2) {
            const int g = hd >> 2; const float slope = exp2f(-(float)(hd + 1));
            const bf16_t* Kb = (const bf16_t*)(a->ws + (MODE == 1 ? WS_KSB : WS_KWB)) + (size_t)(b * 2 + g) * 2048 * 64;
            const bf16_t* Vb = (const bf16_t*)(a->ws + (MODE == 1 ? WS_VST : WS_VWT)) + (size_t)(b * 2 + g) * 64 * 2048;
            attn_unit<64, MODE>(WID, lds, QN + t0 * 512 + hd * 64, 512, Kb, 64, Vb, 2048, q0, slope,
                                (const unsigned*)(a->ws + WS_SELM) + (size_t)(b * 2 + g) * 2048 + q0,
                                (bf16_t*)(a->ws + (MODE == 1 ? WS_OS : WS_OW)) + t0 * 512 + hd * 64, 512, nullptr);
        } else {
            const int g = hd >> 2;
            attn_unit<96, 3>(WID, lds, QN + t0 * 512 + hd * 64, 512, (const bf16_t*)(a->ws + WS_KCMP) + (size_t)(b * 2 + g) * 128 * 64, 64,
                             (const bf16_t*)(a->ws + WS_VCMPT) + (size_t)(b * 2 + g) * 96 * 128, 128, q0, 0.f, nullptr,
                             (bf16_t*)(a->ws + WS_OC) + t0 * 512 + hd * 64, 512, (float*)(a->ws + WS_IMPH) + (t0 * 8 + hd) * 32);
        }
    }
}

constexpr int PPL = 15;
constexpr int NPHASE = 1 + DEPTH * PPL;
__global__ void __launch_bounds__(512, 2) mk_fwd(Args a_unused) {
    ArgsP a = opaque_args();
    extern __shared__ __attribute__((aligned(16))) unsigned char lds_raw[];
    LAS unsigned char* lds = (LAS unsigned char*)lds_raw;
    const int tid = threadIdx.x, G = gridDim.x, c = blockIdx.x;
    const int WID = __builtin_amdgcn_readfirstlane(tid >> 6);
    volatile LAS unsigned* misc = (volatile LAS unsigned*)(lds + MISC_OFF);
    if (tid < 4) misc[tid] = 0u;
    __syncthreads();
    unsigned* ctl = (unsigned*)(a->ws + WS_CTL);
    XcdBarrier bar; bar.bar = ctl + CW_BAR; bar.x = 0; bar.st = misc;
    const int ph_lo = a->ph_lo, ph_hi = a->ph_hi;
    const bool multi = (ph_hi - ph_lo) > 1;
    if (multi) bar = xcd_barrier_post(WID, ctl + CW_BAR, misc);
    bool first = true;
#define PHASE_BEGIN(k, id) if ((DBG_ONLY < 0 || DBG_ONLY == (id)) && (k) >= ph_lo && (k) < ph_hi && (k) <= DBG_LAST_PHASE) { if (!first) { xcd_barrier(WID, bar); if (PROBE_MASK >> 31) xcd_barrier(WID, bar); } first = false; \
        ArgsP a = opaque_args(); unsigned char* ws = a->ws; bf16_t* XN = (bf16_t*)(ws + WS_XN); float* H = a->out; const float* Hin = (layer == 0) ? a->in[I_X] : (const float*)H; \
        const LAS int* ts = (const LAS int*)(lds + MISC_OFF + MO_TS); (void)XN; (void)H; (void)Hin; (void)ts; \
        const bool probe_ = ((PROBE_MASK >> (id)) & 1u) != 0u; const unsigned long long pt0_ = probe_ ? __builtin_amdgcn_s_memrealtime() : 0ull;
#define PHASE_END if (probe_) { const unsigned long long pt1_ = __builtin_amdgcn_s_memrealtime(), pd_ = pt1_ - pt0_; while (__builtin_amdgcn_s_memrealtime() - pt1_ < pd_) __builtin_amdgcn_s_sleep(8); } }
    { const int layer = 0; PHASE_BEGIN(0, 0) phase_prologue(WID, a, lds); PHASE_END }
#pragma unroll 1
    for (int layer = 0; layer < DEPTH; ++layer) {
        const int pb = 1 + layer * PPL; const bool even = (layer & 1) == 0; const int ev = layer >> 1, od = layer >> 1;
        if (even) {
            PHASE_BEGIN(pb + 0, 1) phase_norm<0>(WID, a, lds, layer, Hin); PHASE_END
            PHASE_BEGIN(pb + 1, 2) {
                { ProbPlain P{XN, (const bf16_t*)(ws + WS_EVNAT) + (size_t)ev * 2048 * 1024, 1024, 1024, 1024}; pg8::Sched S; S.init(T / 256, 8, G, c);
                  EpiEvNat E{ws, (const float*)(ws + WS_GAINS) + ev * 256};
                  pg8::gemm_phase(WID, lds, P, S, E); }
                { ProbPlain P{(const bf16_t*)(ws + WS_EVSW) + (size_t)ev * 768 * 1024, XN, 1024, 1024, 1024}; pg8::Sched S; S.init(3, T / 256, G, c);
                  EpiEvSw E{ws};
                  pg8::gemm_phase(WID, lds, P, S, E); }
            } PHASE_END
            PHASE_BEGIN(pb + 2, 3) {
                { ProbCmp1 P{(const bf16_t*)(ws + WS_KCB), (const bf16_t*)(ws + WS_VCB), (const bf16_t*)(ws + WS_CMP1) + (size_t)ev * 2 * 256 * 2048, 1024, 2048, 2048}; pg8::Sched S; S.init(32, 1, G, c);
                  EpiCmp1 E{(bf16_t*)(ws + WS_HID), (const float*)(ws + WS_BIAS1) + ev * 512};
                  pg8::gemm_phase(WID, lds, P, S, E); }
                phase_attn<0>(WID, a, lds);
                phase_attn<2>(WID, a, lds);
            } PHASE_END
            PHASE_BEGIN(pb + 3, 4) phase_cmp2(WID, a, lds, ev); PHASE_END
            PHASE_BEGIN(pb + 4, 5) phase_attn<3>(WID, a, lds); PHASE_END
            PHASE_BEGIN(pb + 5, 6) phase_topk(WID, a); PHASE_END
            PHASE_BEGIN(pb + 6, 7) phase_attn<1>(WID, a, lds); PHASE_END
            PHASE_BEGIN(pb + 7, 8) phase_mixprep(WID, a, layer); PHASE_END
            PHASE_BEGIN(pb + 8, 9) {
                ProbPlain P{(const bf16_t*)(ws + WS_AMIX), (const bf16_t*)(ws + WS_EVOUT) + (size_t)ev * 1024 * 1024, 1024, 1024, 1024}; pg8::Sched S; S.init(T / 256, 4, G, c);
                EpiResid E{Hin, H}; pg8::gemm_phase(WID, lds, P, S, E);
            } PHASE_END
        } else {
            PHASE_BEGIN(pb + 0, 11) phase_norm<1>(WID, a, lds, layer, Hin); PHASE_END
            PHASE_BEGIN(pb + 1, 12) {
                { ProbPlain P{XN, (const bf16_t*)(ws + WS_ODNAT) + (size_t)od * 4096 * 1024, 1024, 1024, 1024}; pg8::Sched S; S.init(T / 256, 16, G, c);
                  EpiOdNat E{ws}; pg8::gemm_phase(WID, lds, P, S, E); }
                { ProbPlain P{(const bf16_t*)(ws + WS_ODSW) + (size_t)od * 3072 * 1024, XN, 1024, 1024, 1024}; pg8::Sched S; S.init(12, T / 256, G, c);
                  EpiOdSw E{ws}; pg8::gemm_phase(WID, lds, P, S, E); }
            } PHASE_END
            PHASE_BEGIN(pb + 2, 13) {
                { ProbAtt P{(const bf16_t*)(ws + WS_AQ), (const bf16_t*)(ws + WS_KP), 2048, 1024, 256}; pg8::Sched S; S.init(512, 1, G, c);
                  EpiAtt E{(bf16_t*)(ws + WS_AQ)}; pg8::gemm_phase(WID, lds, P, S, E); }
                { ProbUT P{(const bf16_t*)(ws + WS_VS), (const bf16_t*)(ws + WS_KT), 512, 256, 256}; pg8::Sched S; S.init(1024, 1, G, c);
                  EpiUT E{(float*)(ws + WS_UT)}; pg8::gemm_phase(WID, lds, P, S, E); }
            } PHASE_END
            PHASE_BEGIN(pb + 3, 14) phase_scan(WID, a); PHASE_END
            PHASE_BEGIN(pb + 4, 15) {
                ProbY P{(const bf16_t*)(ws + WS_AQ), (const bf16_t*)(ws + WS_VS), 2048, 512, 512}; pg8::Sched S; S.init(512, 2, G, c);
                EpiY E{(bf16_t*)(ws + WS_Y)}; pg8::gemm_phase(WID, lds, P, S, E);
            } PHASE_END
            PHASE_BEGIN(pb + 5, 16) phase_normgate(WID, a, od); PHASE_END
            PHASE_BEGIN(pb + 8, 19) {
                ProbPlain P{(const bf16_t*)(ws + WS_YG), (const bf16_t*)(ws + WS_ODOUT) + (size_t)od * 1024 * 2048, 2048, 2048, 2048}; pg8::Sched S; S.init(T / 256, 4, G, c);
                EpiResid E{Hin, H}; pg8::gemm_phase(WID, lds, P, S, E);
            } PHASE_END
        }
        PHASE_BEGIN(pb + 9, 20) phase_norm<2>(WID, a, lds, layer, H); PHASE_END
        PHASE_BEGIN(pb + 10, 21) phase_moe_slots(WID, a, lds, layer); PHASE_END
        PHASE_BEGIN(pb + 11, 22) {
            moe_tables(WID, a, lds, layer, -1);
            { ProbMoe8 P{(const unsigned char*)(ws + WS_XB), (const unsigned char*)(ws + WS_WGU) + (size_t)layer * 32 * 2048 * 1024, ts, 512, 512, 512}; pg8::Sched S; S.init(ts[32], 8, G, c);
              EpiGU E{(bf16_t*)(ws + WS_ACT), a->in[I_BGU] + (size_t)layer * 32 * 2048, ts}; pg8::gemm_phase(WID, lds, P, S, E); }
            { ProbPlain P{(const bf16_t*)(ws + WS_PBF) + (size_t)layer * T * 256, (const bf16_t*)(ws + WS_WPP) + (size_t)layer * 1024 * 256, 256, 256, 256}; pg8::Sched S; S.init(T / 256, 4, G, c);
              EpiPP E{(bf16_t*)(ws + WS_PP)}; pg8::gemm_phase(WID, lds, P, S, E); }
        } PHASE_END
        PHASE_BEGIN(pb + 12, 23) {
            moe_tables(WID, a, lds, layer, -1);
            ProbMoe P{(const bf16_t*)(ws + WS_ACT), (const bf16_t*)(ws + WS_WDN) + (size_t)layer * 32 * 1024 * 1024, ts, 1024, 1024, 1024, 1024}; pg8::Sched S; S.init(ts[32], 4, G, c);
            EpiDN E{(bf16_t*)(ws + WS_YB), a->in[I_BDN] + (size_t)layer * 32 * 1024, ts}; pg8::gemm_phase(WID, lds, P, S, E);
        } PHASE_END
        PHASE_BEGIN(pb + 13, 24) phase_combine(WID, a, H); PHASE_END
        PHASE_BEGIN(pb + 14, 25) {
            ProbPlain P{XN, (const bf16_t*)(ws + WS_WPG) + (size_t)layer * 1024 * 1024, 1024, 1024, 1024}; pg8::Sched S; S.init(T / 256, 4, G, c);
            EpiPLE E{H, (const bf16_t*)(ws + WS_PP)}; pg8::gemm_phase(WID, lds, P, S, E);
        } PHASE_END
    }
#undef PHASE_BEGIN
#undef PHASE_END
}

extern "C" void kernel_launch(void* const* d_in, const int* in_sizes, int n_in, void* d_out, int out_size, void* d_ws, size_t ws_size, hipStream_t stream) {
    static int grid = 0;
    if (grid == 0) {
        if (n_in != 26 || out_size != T * D || ws_size < WS_END) { fprintf(stderr, "kernel_launch: unexpected problem (n_in %d, out %d, ws %zu < %zu); nothing launched\n", n_in, out_size, ws_size, (size_t)WS_END); grid = -1; return; }
        int dev = 0, cus = 0, per_cu = 0;
        if (hipGetDevice(&dev) != hipSuccess || hipDeviceGetAttribute(&cus, hipDeviceAttributeMultiprocessorCount, dev) != hipSuccess) { grid = -1; return; }
        if (hipFuncSetAttribute((const void*)mk_fwd, hipFuncAttributeMaxDynamicSharedMemorySize, LDS_BYTES) != hipSuccess) { fprintf(stderr, "kernel_launch: hipFuncSetAttribute failed\n"); grid = -1; return; }
        if (hipOccupancyMaxActiveBlocksPerMultiprocessor(&per_cu, (const void*)mk_fwd, 512, LDS_BYTES) != hipSuccess || per_cu < 1) fprintf(stderr, "kernel_launch: occupancy query reports %d\n", per_cu);
        (void)hipGetLastError();
        grid = cus > 256 ? 256 : cus;
    }
    if (grid < 0) return;
    (void)hipMemsetAsync((char*)d_ws + WS_CTL, 0, CTL_BYTES, stream);
    Args a; memset(&a, 0, sizeof(a));
    for (int i = 0; i < 26; ++i) a.in[i] = (const float*)d_in[i];
    a.out = (float*)d_out; a.ws = (unsigned char*)d_ws;
#if MK_SINGLE
    a.ph_lo = 0; a.ph_hi = NPHASE;
    hipLaunchKernelGGL(mk_fwd, dim3(grid), dim3(512), LDS_BYTES, stream, a);
#else
    for (int ph = 0; ph < NPHASE && ph <= DBG_LAST_PHASE; ++ph) {
        const int l = (ph - 1) / PPL, k = (ph - 1) % PPL;
        if (ph > 0 && (l & 1) && (k == 6 || k == 7)) continue;
        a.ph_lo = ph; a.ph_hi = ph + 1;
        hipLaunchKernelGGL(mk_fwd, dim3(grid), dim3(512), LDS_BYTES, stream, a);
    }
#endif
}
```

```cpp
#include <hip/hip_runtime.h>
#include <cstdio>
#include <cstdint>
#include <cstring>

#define LAS __attribute__((address_space(3)))
#define DI __device__ __forceinline__
typedef unsigned short bf16_t;
typedef short bf16x8 __attribute__((ext_vector_type(8)));
typedef short s16x4 __attribute__((ext_vector_type(4)));
typedef float f32x2 __attribute__((ext_vector_type(2)));
typedef float f32x4 __attribute__((ext_vector_type(4)));
typedef float f32x16 __attribute__((ext_vector_type(16)));
typedef unsigned u32x2 __attribute__((ext_vector_type(2)));
typedef unsigned u32x4 __attribute__((ext_vector_type(4)));
typedef __bf16 bfv2 __attribute__((ext_vector_type(2)));
typedef int i32x4 __attribute__((ext_vector_type(4)));
typedef int i32x8 __attribute__((ext_vector_type(8)));

#ifndef MK_SINGLE
#define MK_SINGLE 1
#endif
#ifndef DBG_ONLY
#define DBG_ONLY -1
#endif
#ifndef PROBE_MASK
#define PROBE_MASK 0u
#endif
#ifndef DBG_LAST_PHASE
#define DBG_LAST_PHASE 100000
#endif

constexpr int T = 32768, D = 1024, SEQ = 2048, NBATCH = 16, DEPTH = 4;
constexpr int EVIN = 2840, ODIN = 6144;
constexpr float EPS = 1e-6f, NEGF = -1e30f;
constexpr int NTB = 256;
constexpr int MOE_ROWS = (512 + 32) * 256;

constexpr size_t MiB = 1u << 20;
constexpr size_t WS_CTL = 0, CTL_BYTES = 1 * MiB;
constexpr int CW_BAR = 4096;
constexpr size_t WS_EVNAT = 2 * MiB, WS_EVSW = 10 * MiB, WS_EVOUT = 13 * MiB, WS_CMP1 = 17 * MiB, WS_ODNAT = 21 * MiB, WS_ODSW = 37 * MiB,
                 WS_ODOUT = 49 * MiB, WS_WPP = 57 * MiB, WS_WPG = 59 * MiB, WS_BIAS1 = 67 * MiB, WS_GAINS = 67 * MiB + 16384, WS_BCNT = 67 * MiB + 65536,
                 WS_WGU = 68 * MiB, WS_WDN = 580 * MiB;
constexpr size_t WS_XN = 840 * MiB, WS_PBF = 904 * MiB, WS_PP = 968 * MiB, WS_GATES = 1032 * MiB, WS_TOPE = 1035 * MiB, WS_POSB = 1036 * MiB,
                 WS_DEST = 1037 * MiB, WS_GATEW = 1038 * MiB, WS_SELM = 1039 * MiB;
constexpr size_t RA = 1040 * MiB;
constexpr size_t WS_QD = RA, WS_KD = RA + 32 * MiB, WS_QN = RA + 64 * MiB, WS_KCB = RA + 96 * MiB, WS_VCB = RA + 105 * MiB, WS_KSB = RA + 114 * MiB,
                 WS_KWB = RA + 122 * MiB, WS_VAT = RA + 130 * MiB, WS_VST = RA + 162 * MiB, WS_VWT = RA + 170 * MiB, WS_HID = RA + 178 * MiB,
                 WS_KCMP = RA + 182 * MiB, WS_VCMPT = RA + 183 * MiB, WS_OC = RA + 184 * MiB, WS_IMPH = RA + 216 * MiB, WS_OD = RA + 248 * MiB,
                 WS_OS = RA + 312 * MiB, WS_OW = RA + 344 * MiB, WS_AMIX = RA + 376 * MiB;
constexpr size_t WS_AQ = RA, WS_KP = RA + 128 * MiB, WS_KT = RA + 192 * MiB, WS_VS = RA + 256 * MiB, WS_GG = RA + 512 * MiB, WS_UT = RA + 640 * MiB,
                 WS_Y = RA + 896 * MiB, WS_YG = RA + 1024 * MiB;
constexpr size_t WS_XB = 2192 * MiB, WS_ACT = 2464 * MiB, WS_YB = 2736 * MiB, WS_END = 3008 * MiB;

constexpr int MISC_OFF = 139264, LDS_BYTES = 155648;
static_assert(MISC_OFF + 5888 + 4096 <= LDS_BYTES, "misc LDS words");
constexpr int MO_WCNT = 256, MO_ENT = 1280, MO_GAT = 3328, MO_TOT = 5376, MO_BASE = 5504, MO_TS = 5632, MO_RED = 5888;

DI int opaque_tid(int wid0) { int t = (wid0 << 6) | (int)__builtin_amdgcn_mbcnt_hi(~0u, __builtin_amdgcn_mbcnt_lo(~0u, 0u)); asm volatile("" : "+v"(t) :: "memory"); return t; }
DI unsigned pk2(float lo, float hi) { f32x2 v = {lo, hi}; return __builtin_bit_cast(unsigned, __builtin_convertvector(v, bfv2)); }
DI unsigned pk4_fp8(float a, float b, float c, float d) { int w = 0; w = __builtin_amdgcn_cvt_pk_fp8_f32(a, b, w, false); w = __builtin_amdgcn_cvt_pk_fp8_f32(c, d, w, true); return (unsigned)w; }
DI float bf2f(unsigned short b) { return __uint_as_float(((unsigned)b) << 16); }
DI float bflo(unsigned w) { return __uint_as_float(w << 16); }
DI float bfhi(unsigned w) { return __uint_as_float(w & 0xffff0000u); }
DI float wave_sum(float v) {
#pragma unroll
    for (int o = 1; o < 64; o <<= 1) v += __shfl_xor(v, o);
    return v;
}
DI float sigm(float x) { return 1.0f / (1.0f + __expf(-x)); }
DI u32x4 pack8(const f32x4& a, const f32x4& b) { u32x4 w; w.x = pk2(a[0], a[1]); w.y = pk2(a[2], a[3]); w.z = pk2(b[0], b[1]); w.w = pk2(b[2], b[3]); return w; }

#define XB_TMO      128
#define XB_XCNT(j)  (256  + 64 * (j))
#define XB_XSUB(j)  (1280 + 64 * (j))
#define XB_XGEN(j)  (2304 + 64 * (j))
#define XB_TOP      3328
#define XB_TOPGEN   3392
#define XCD_BAR_WORDS 3456
#define XB_SPIN_CAP (1u << 22)
DI unsigned xb_ld(unsigned* p)              { return __hip_atomic_load(p, __ATOMIC_RELAXED, __HIP_MEMORY_SCOPE_AGENT); }
DI unsigned xb_add(unsigned* p, unsigned v) { return __hip_atomic_fetch_add(p, v, __ATOMIC_RELAXED, __HIP_MEMORY_SCOPE_AGENT); }
DI unsigned xb_xcc_id() { return (unsigned)__builtin_amdgcn_s_getreg((3 << 11) | 20) & 0xFu; }
#define XB_SPIN(cond, bar) do { unsigned _sp = 0; while (cond) { __builtin_amdgcn_s_sleep(1); \
    if ((++_sp & 255u) == 0u) { if (xb_ld(&(bar)[XB_TMO])) break; if (_sp > XB_SPIN_CAP) { atomicAdd(&(bar)[XB_TMO], 1u); break; } } } } while (0)
struct XcdBarrier { unsigned* bar; unsigned x; volatile LAS unsigned* st; };
DI XcdBarrier xcd_barrier_post(const int WID, unsigned* bar, volatile LAS unsigned* st) {
    XcdBarrier b; b.bar = bar; b.x = xb_xcc_id(); b.st = st;
    if (opaque_tid(WID) == 0) (void)xb_add(&bar[XB_XCNT(b.x)], 1u);
    return b;
}
DI void xcd_barrier_complete(unsigned* bar, unsigned x, unsigned& nloc, unsigned& nx) {
    const unsigned G = gridDim.x * gridDim.y * gridDim.z;
    unsigned sum, cnt, mine, sp = 0u;
    for (;;) {
        sum = 0u; cnt = 0u; mine = 0u;
#pragma unroll
        for (unsigned j = 0; j < 16; ++j) { const unsigned c = xb_ld(&bar[XB_XCNT(j)]); sum += c; cnt += (c > 0u) ? 1u : 0u; mine = (j == x) ? c : mine; }
        if (sum == G) break;
        __builtin_amdgcn_s_sleep(1);
        if ((++sp & 255u) == 0u) { if (xb_ld(&bar[XB_TMO])) break; if (sp > XB_SPIN_CAP) { atomicAdd(&bar[XB_TMO], 1u); break; } }
    }
    nloc = mine > 0u ? mine : 1u; nx = cnt > 0u ? cnt : 1u;
}
DI void xcd_barrier(const int WID, const XcdBarrier& b) {
    asm volatile("s_waitcnt vmcnt(0)" ::: "memory");
    __syncthreads();
    if (opaque_tid(WID) == 0) {
        unsigned* bar = b.bar; asm volatile("" : "+s"(bar));
        __builtin_amdgcn_s_waitcnt(0);
        unsigned nloc = b.st[0], nx = b.st[1];
        if (nloc == 0u) { xcd_barrier_complete(bar, b.x, nloc, nx); b.st[0] = nloc; b.st[1] = nx; }
        const unsigned old = xb_add(&bar[XB_XSUB(b.x)], 1u);
        const unsigned gen = old / nloc;
        if (old + 1u == (gen + 1u) * nloc) {
            __builtin_amdgcn_fence(__ATOMIC_RELEASE, "agent");
            asm volatile("s_waitcnt vmcnt(0)" ::: "memory");
            const unsigned og = xb_add(&bar[XB_TOP], 1u);
            const unsigned tg = og / nx;
            if (og + 1u == (tg + 1u) * nx) xb_add(&bar[XB_TOPGEN], 1u);
            else XB_SPIN(xb_ld(&bar[XB_TOPGEN]) == tg, bar);
            __builtin_amdgcn_fence(__ATOMIC_ACQUIRE, "agent");
            xb_add(&bar[XB_XGEN(b.x)], 1u);
            asm volatile("s_waitcnt vmcnt(0)" ::: "memory");
        } else {
            XB_SPIN(xb_ld(&bar[XB_XGEN(b.x)]) == gen, bar);
            __builtin_amdgcn_fence(__ATOMIC_ACQUIRE, "agent");
            asm volatile("s_waitcnt vmcnt(0)" ::: "memory");
        }
    }
    __syncthreads();
}

namespace pg8 {
constexpr int BM = 256, BK = 64, HALF = 128, HTB = HALF * BK * 2, STAGE_BYTES = 8 * HTB, NXCD = 8, WGM = 8;
DI int lds_byte(int r, int c) { const int st = (r >> 4) * 2 + (c >> 5), rr = r & 15, cc = c & 31, ob = rr * 64 + cc * 2; return st * 1024 + (ob ^ (((ob >> 9) & 1) << 5)); }
DI void stage_rc(int b, int& R, int& C) { const int st = b / 1024, sb = b % 1024, swz = sb ^ (((sb >> 9) & 1) << 5); R = (st >> 1) * 16 + swz / 64; C = (st & 1) * 32 + (swz % 64) / 2; }
DI int perm32(int rho) { const int n = rho >> 4, i = rho & 15; return 8 * (i >> 2) + 4 * n + (i & 3); }
struct Unit { int pm, pn; };
struct Sched {
    int nM, nN, nwg, G, c;
    DI void init(int nM_, int nN_, int G_, int c_) { nM = nM_; nN = nN_; nwg = nM * nN; G = G_; c = c_; }
    DI bool next(int i, Unit& u) const {
        const long L = (long)i * G + c; if (L >= nwg) return false;
        int wgid = (int)L; { const int q = nwg / NXCD, r = nwg % NXCD, xcd = wgid % NXCD, off = wgid / NXCD; wgid = (xcd < r ? xcd * (q + 1) : r * (q + 1) + (xcd - r) * q) + off; }
        const int nig = WGM * nN, gid = wgid / nig, fm = gid * WGM, gsz = (nM - fm) < WGM ? (nM - fm) : WGM;
        u.pm = fm + ((wgid % nig) % gsz); u.pn = (wgid % nig) / gsz; return true;
    }
};
template <class Epi, class Prob>
DI void gemm_phase(const int WID, LAS unsigned char* lds, const Prob& P, const Sched& S, const Epi& E) {
    const int tid = opaque_tid(WID), wid = __builtin_amdgcn_readfirstlane(tid >> 6), lane = tid & 63, wr = wid >> 2, wc = wid & 3, fr = lane & 15, fq = lane >> 4;
    const int K = P.K, nt = K / BK;
    unsigned voffA[2], voffB[2];
#pragma unroll
    for (int i = 0; i < 2; ++i) { int R, C; stage_rc(tid * 16 + i * 8192, R, C); const int Rb = Epi::PERM ? ((R & ~31) + perm32(R & 31)) : R;
        voffA[i] = (unsigned)(R * P.lda + C) * 2u; voffB[i] = (unsigned)(Rb * P.ldb + C) * 2u; }
    const size_t kstep = (size_t)(BK * 2);
    const size_t hstepA = (size_t)HALF * P.lda * 2, hstepB = (size_t)HALF * P.ldb * 2;
    const unsigned ldsw = (unsigned)wid * 1024u;
    const int aoff = lds_byte(wr * 64 + fr, fq * 8), boff = lds_byte(wc * 32 + fr, fq * 8);
#define PG8_SA(b, h) (((b) * 2 + (h)) * HTB)
#define PG8_SB(b, h) ((4 + (b) * 2 + (h)) * HTB)
#define PG8_STAGE(bufoff, gbase, voff) do { _Pragma("unroll") for (int _i = 0; _i < 2; ++_i) \
        __builtin_amdgcn_global_load_lds((const unsigned*)((const char*)(gbase) + (voff)[_i]), (LAS unsigned*)(lds + (bufoff) + ldsw + _i * 8192), 16, 0, 0); } while (0)
#define PG8_LD16(off) (*(const LAS i32x4*)(lds + (off)))
#define PG8_LDA(dst, b, h) do { _Pragma("unroll") for (int m = 0; m < 4; ++m) { const i32x4 lo_ = PG8_LD16(PG8_SA(b, h) + aoff + m * 2048), hi_ = PG8_LD16(PG8_SA(b, h) + aoff + m * 2048 + 1024); dst[m] = __builtin_shufflevector(lo_, hi_, 0, 1, 2, 3, 4, 5, 6, 7); } } while (0)
#define PG8_LDB(dst, b, h) do { _Pragma("unroll") for (int n = 0; n < 2; ++n) { const i32x4 lo_ = PG8_LD16(PG8_SB(b, h) + boff + n * 2048), hi_ = PG8_LD16(PG8_SB(b, h) + boff + n * 2048 + 1024); dst[n] = __builtin_shufflevector(lo_, hi_, 0, 1, 2, 3, 4, 5, 6, 7); } } while (0)
#define PG8_LOH(X) __builtin_bit_cast(bf16x8, __builtin_shufflevector((X), (X), 0, 1, 2, 3))
#define PG8_HIH(X) __builtin_bit_cast(bf16x8, __builtin_shufflevector((X), (X), 4, 5, 6, 7))
#define PG8_MMA(ai, bj, At, Bt) do { __builtin_amdgcn_s_setprio(1); \
        if constexpr (Prob::FP8) { _Pragma("unroll") for (int m = 0; m < 4; ++m) _Pragma("unroll") for (int n = 0; n < 2; ++n) \
            asm volatile("v_mfma_scale_f32_16x16x128_f8f6f4 %0, %1, %2, %0, %3, %3 op_sel_hi:[0,0,0]" : "+v"(acc[ai][bj][m][n]) : "v"(Bt[n]), "v"(At[m]), "v"(sc1)); } \
        else { _Pragma("unroll") for (int m = 0; m < 4; ++m) _Pragma("unroll") for (int n = 0; n < 2; ++n) { \
            acc[ai][bj][m][n] = __builtin_amdgcn_mfma_f32_16x16x32_bf16(PG8_LOH(Bt[n]), PG8_LOH(At[m]), acc[ai][bj][m][n], 0, 0, 0); \
            acc[ai][bj][m][n] = __builtin_amdgcn_mfma_f32_16x16x32_bf16(PG8_HIH(Bt[n]), PG8_HIH(At[m]), acc[ai][bj][m][n], 0, 0, 0); } } \
        __builtin_amdgcn_s_setprio(0); } while (0)
#define PG8_WAIT_V(n) asm volatile("s_waitcnt vmcnt(" #n ")" ::: "memory")
#define PG8_WAIT_L(n) asm volatile("s_waitcnt lgkmcnt(" #n ")" ::: "memory")
#define PG8_BAR __builtin_amdgcn_s_barrier()
#define PG8_SCHED __builtin_amdgcn_sched_barrier(0)
    Unit cur, nxt; int ui = 0;
    if (!S.next(0, cur)) return;
    f32x4 acc[2][2][4][2];
#pragma unroll
    for (int a = 0; a < 2; ++a)
#pragma unroll
        for (int b = 0; b < 2; ++b)
#pragma unroll
            for (int m = 0; m < 4; ++m)
#pragma unroll
                for (int n = 0; n < 2; ++n) acc[a][b][m][n] = (f32x4){0.f, 0.f, 0.f, 0.f};
    i32x8 At[4], B0[2], B1[2];
    const int sc1 = 0x7f7f7f7f;
    const char* cA = P.a_base(cur); const char* cB = P.b_base(cur);
    PG8_STAGE(PG8_SB(0, 0), cB, voffB); PG8_STAGE(PG8_SA(0, 0), cA, voffA); PG8_STAGE(PG8_SB(0, 1), cB + hstepB, voffB); PG8_STAGE(PG8_SA(0, 1), cA + hstepA, voffA);
    if (wr == 1) PG8_BAR;
    PG8_WAIT_V(4); PG8_BAR;
    PG8_STAGE(PG8_SB(1, 0), cB + kstep, voffB); PG8_STAGE(PG8_SA(1, 0), cA + kstep, voffA); PG8_STAGE(PG8_SB(1, 1), cB + hstepB + kstep, voffB);
    PG8_WAIT_V(6); PG8_BAR;
    for (;;) {
        const bool has_next = S.next(ui + 1, nxt);
        const char* nA = has_next ? P.a_base(nxt) : cA; const char* nB = has_next ? P.b_base(nxt) : cB;
        for (int t = 0; t < nt; t += 2) {
            const bool last = (t == nt - 2);
            const char* a1 = cA + (size_t)(t + 1) * kstep;
            const char* a2 = last ? nA : cA + (size_t)(t + 2) * kstep; const char* b2 = last ? nB : cB + (size_t)(t + 2) * kstep;
            const char* a3 = a2 + kstep; const char* b3 = b2 + kstep;
            PG8_LDB(B0, 0, 0); PG8_SCHED; PG8_LDA(At, 0, 0); PG8_STAGE(PG8_SA(1, 1), a1 + hstepA, voffA);
            PG8_WAIT_L(8); PG8_BAR; PG8_WAIT_L(0); PG8_MMA(0, 0, At, B0); PG8_BAR; PG8_SCHED;
            PG8_LDB(B1, 0, 1); PG8_STAGE(PG8_SB(0, 0), b2, voffB);
            PG8_BAR; PG8_WAIT_L(0); PG8_MMA(0, 1, At, B1); PG8_BAR;
            PG8_LDA(At, 0, 1); PG8_STAGE(PG8_SA(0, 0), a2, voffA);
            PG8_BAR; PG8_WAIT_L(0); PG8_MMA(1, 0, At, B0); PG8_BAR; PG8_SCHED;
            PG8_STAGE(PG8_SB(0, 1), b2 + hstepB, voffB);
            PG8_WAIT_V(6); PG8_BAR; PG8_MMA(1, 1, At, B1); PG8_BAR;
            PG8_LDB(B0, 1, 0); PG8_SCHED; PG8_LDA(At, 1, 0); PG8_STAGE(PG8_SA(0, 1), a2 + hstepA, voffA);
            PG8_WAIT_L(8); PG8_BAR; PG8_WAIT_L(0); PG8_MMA(0, 0, At, B0); PG8_BAR; PG8_SCHED;
            PG8_LDB(B1, 1, 1); PG8_STAGE(PG8_SB(1, 0), b3, voffB);
            PG8_BAR; PG8_WAIT_L(0); PG8_MMA(0, 1, At, B1); PG8_BAR;
            PG8_LDA(At, 1, 1); PG8_STAGE(PG8_SA(1, 0), a3, voffA);
            PG8_BAR; PG8_WAIT_L(0); PG8_MMA(1, 0, At, B0); PG8_BAR; PG8_SCHED;
            PG8_STAGE(PG8_SB(1, 1), b3 + hstepB, voffB);
            PG8_WAIT_V(6); PG8_BAR; PG8_MMA(1, 1, At, B1); PG8_BAR;
        }
        if constexpr (Prob::FP8) {
            asm volatile("s_nop 15\n\ts_nop 15" ::: "memory");
#pragma unroll
            for (int a_ = 0; a_ < 2; ++a_)
#pragma unroll
                for (int b_ = 0; b_ < 2; ++b_)
#pragma unroll
                    for (int m_ = 0; m_ < 4; ++m_)
#pragma unroll
                        for (int n_ = 0; n_ < 2; ++n_) asm volatile("" : "+v"(acc[a_][b_][m_][n_]));
        }
        { int fr_ = fr, fq_ = fq, wr_ = wr, wc_ = wc; asm volatile("" : "+v"(fr_), "+v"(fq_), "+s"(wr_), "+s"(wc_));
          E(acc, cur, wr_, wc_, fr_, fq_); }
        if (!has_next) break;
#pragma unroll
        for (int a = 0; a < 2; ++a)
#pragma unroll
            for (int b = 0; b < 2; ++b)
#pragma unroll
                for (int m = 0; m < 4; ++m)
#pragma unroll
                    for (int n = 0; n < 2; ++n) acc[a][b][m][n] = (f32x4){0.f, 0.f, 0.f, 0.f};
        cur = nxt; cA = nA; cB = nB; ++ui;
    }
    PG8_WAIT_V(0);
    if (wr == 0) PG8_BAR;
    PG8_BAR;
#undef PG8_SA
#undef PG8_SB
#undef PG8_STAGE
#undef PG8_LDA
#undef PG8_LDB
#undef PG8_MMA
#undef PG8_LD16
#undef PG8_LOH
#undef PG8_HIH
#undef PG8_WAIT_V
#undef PG8_WAIT_L
#undef PG8_BAR
#undef PG8_SCHED
}
}
using pg8::Unit;
typedef f32x4 Acc[2][2][4][2];

struct ProbPlain { static constexpr bool FP8 = false; const bf16_t* A; const bf16_t* Bt; int lda, ldb, K;
    DI const char* a_base(const Unit& u) const { return (const char*)(A + (size_t)u.pm * 256 * lda); }
    DI const char* b_base(const Unit& u) const { return (const char*)(Bt + (size_t)u.pn * 256 * ldb); } };
struct ProbCmp1 { static constexpr bool FP8 = false; const bf16_t* KCB; const bf16_t* VCB; const bf16_t* W; int lda, ldb, K;
    DI const char* a_base(const Unit& u) const { const int kv = u.pm >> 4, rt = u.pm & 15; return (const char*)((kv ? VCB : KCB) + (size_t)rt * 256 * 1024); }
    DI const char* b_base(const Unit& u) const { const int kv = u.pm >> 4; return (const char*)(W + (size_t)kv * 256 * 2048); } };
struct ProbAtt { static constexpr bool FP8 = false; const bf16_t* AQ; const bf16_t* KP; int lda, ldb, K;
    DI const char* a_base(const Unit& u) const { const int z = u.pm, n = z & 7, h = (z >> 3) & 3, b = z >> 5; const size_t t0 = (size_t)b * 2048 + n * 256; return (const char*)(AQ + (t0 * 4 + h) * 512 + 256); }
    DI const char* b_base(const Unit& u) const { const int z = u.pm, n = z & 7, h = (z >> 3) & 3, b = z >> 5; const size_t t0 = (size_t)b * 2048 + n * 256; return (const char*)(KP + t0 * 1024 + h * 256); } };
struct ProbUT { static constexpr bool FP8 = false; const bf16_t* VS; const bf16_t* KT; int lda, ldb, K;
    DI const char* a_base(const Unit& u) const { const int z = u.pm >> 1, half = u.pm & 1; return (const char*)(VS + (size_t)z * 262144 + (size_t)half * 256 * 512); }
    DI const char* b_base(const Unit& u) const { const int z = u.pm >> 1; return (const char*)(KT + (size_t)z * 65536); } };
struct ProbY { static constexpr bool FP8 = false; const bf16_t* AQ; const bf16_t* VS; int lda, ldb, K;
    DI const char* a_base(const Unit& u) const { const int z = u.pm, n = z & 7, h = (z >> 3) & 3, b = z >> 5; const size_t t0 = (size_t)b * 2048 + n * 256; return (const char*)(AQ + (t0 * 4 + h) * 512); }
    DI const char* b_base(const Unit& u) const { return (const char*)(VS + (size_t)u.pm * 262144 + (size_t)u.pn * 256 * 512); } };
DI int moe_tile_expert(const LAS int* ts, int rt) { int e = 0;
#pragma unroll 8
    for (int i = 1; i < 32; ++i) e += (rt >= ts[i]) ? 1 : 0;
    return e; }
struct ProbMoe { static constexpr bool FP8 = false; const bf16_t* A; const bf16_t* W; const LAS int* ts; int nper; int lda, ldb, K;
    DI const char* a_base(const Unit& u) const { return (const char*)(A + (size_t)u.pm * 256 * 1024); }
    DI const char* b_base(const Unit& u) const { const int e = moe_tile_expert(ts, u.pm); return (const char*)(W + ((size_t)e * nper + (size_t)u.pn * 256) * 1024); } };

struct ProbMoe8 { static constexpr bool FP8 = true; const unsigned char* A; const unsigned char* W; const LAS int* ts; int nper; int lda, ldb, K;
    DI const char* a_base(const Unit& u) const { return (const char*)(A + (size_t)u.pm * 256 * 1024); }
    DI const char* b_base(const Unit& u) const { const int e = moe_tile_expert(ts, u.pm); return (const char*)(W + ((size_t)e * nper + (size_t)u.pn * 256) * 1024); } };

#define EPI_ROWS(ai, m) (128 * (ai) + 64 * wr + 16 * (m) + fr)
struct EpiEvNat { static constexpr bool PERM = true;
    unsigned char* ws; const float* gains;
    DI void operator()(const Acc& acc, const Unit& u, int wr, int wc, int fr, int fq) const {
        const int pn = u.pn; const bool norm = (pn != 6);
        const int gi = pn < 2 ? 0 : pn < 4 ? 1 : pn < 6 ? 2 : 3;
        const float* g = gains + gi * 64;
        f32x4 gv[2][2];
#pragma unroll
        for (int bj = 0; bj < 2; ++bj)
#pragma unroll
            for (int n = 0; n < 2; ++n) { const f32x4 t4 = *(const f32x4*)(g + 32 * bj + 8 * fq + 4 * n); gv[bj][n] = norm ? t4 : (f32x4){1.f, 1.f, 1.f, 1.f}; }
        size_t boff; int rowmul, hoff; bool panel = false;
        if (pn < 2) { boff = WS_QD; rowmul = 512; hoff = (pn * 4 + wc) * 64; }
        else if (pn < 4) { boff = WS_KD; rowmul = 512; hoff = ((pn - 2) * 4 + wc) * 64; }
        else if (pn < 6) { boff = WS_QN; rowmul = 512; hoff = ((pn - 4) * 4 + wc) * 64; }
        else { panel = true; rowmul = 64; hoff = 0; boff = (pn == 6) ? (wc < 2 ? WS_KCB : WS_VCB) : (wc < 2 ? WS_KSB : WS_KWB); }
        bf16_t* base = (bf16_t*)(ws + boff);
#pragma unroll
        for (int ai = 0; ai < 2; ++ai)
#pragma unroll
            for (int m = 0; m < 4; ++m) {
                const int t = u.pm * 256 + EPI_ROWS(ai, m), b = t >> 11, sq = t & 2047;
                float ss = 0.f;
#pragma unroll
                for (int bj = 0; bj < 2; ++bj)
#pragma unroll
                    for (int n = 0; n < 2; ++n) { const f32x4 x = acc[ai][bj][m][n]; ss += (x[0] * x[0] + x[1] * x[1]) + (x[2] * x[2] + x[3] * x[3]); }
                ss += __shfl_xor(ss, 16); ss += __shfl_xor(ss, 32);
                const float rstd = norm ? rsqrtf(ss * (1.0f / 64.0f) + EPS) * ((pn < 2 || pn == 4 || pn == 5) ? 0.125f : 1.0f) : 1.0f;
                const size_t rowi = panel ? ((size_t)(b * 2 + (wc & 1)) * 2048 + sq) : (size_t)t;
#pragma unroll
                for (int bj = 0; bj < 2; ++bj) {
                    const f32x4 v0 = acc[ai][bj][m][0] * rstd * gv[bj][0], v1 = acc[ai][bj][m][1] * rstd * gv[bj][1];
                    *(u32x4*)(base + rowi * rowmul + hoff + 32 * bj + 8 * fq) = pack8(v0, v1);
                }
            }
    }
};
struct EpiEvSw { static constexpr bool PERM = true;
    unsigned char* ws;
    DI void operator()(const Acc& acc, const Unit& u, int wr, int wc, int fr, int fq) const {
        const int b = u.pn >> 3, sb = (u.pn & 7) * 256;
#pragma unroll
        for (int ai = 0; ai < 2; ++ai)
#pragma unroll
            for (int m = 0; m < 4; ++m) {
                const int rl = EPI_ROWS(ai, m);
                size_t boff, rowi;
                if (u.pm < 2) { const int fg = u.pm * 256 + rl; boff = WS_VAT; rowi = (size_t)(b * 4 + (fg >> 7)) * 128 + (fg & 127); }
                else { const int r2 = rl & 127; boff = (rl < 128) ? WS_VST : WS_VWT; rowi = (size_t)(b * 2 + (r2 >> 6)) * 64 + (r2 & 63); }
                bf16_t* rowp = (bf16_t*)(ws + boff) + rowi * 2048;
#pragma unroll
                for (int bj = 0; bj < 2; ++bj) *(u32x4*)(rowp + sb + 128 * bj + 32 * wc + 8 * fq) = pack8(acc[ai][bj][m][0], acc[ai][bj][m][1]);
            }
    }
};
struct EpiCmp1 { static constexpr bool PERM = true;
    bf16_t* HID; const float* bias1;
    DI void operator()(const Acc& acc, const Unit& u, int wr, int wc, int fr, int fq) const {
        const int kv = u.pm >> 4, rt = u.pm & 15;
#pragma unroll
        for (int bj = 0; bj < 2; ++bj) {
            const int col = 128 * bj + 32 * wc + 8 * fq;
            const f32x4 b0 = *(const f32x4*)(bias1 + kv * 256 + col), b1 = *(const f32x4*)(bias1 + kv * 256 + col + 4);
#pragma unroll
            for (int ai = 0; ai < 2; ++ai)
#pragma unroll
                for (int m = 0; m < 4; ++m) {
                    f32x4 v0 = acc[ai][bj][m][0] + b0, v1 = acc[ai][bj][m][1] + b1;
#pragma unroll
                    for (int j = 0; j < 4; ++j) { v0[j] = v0[j] * sigm(v0[j]); v1[j] = v1[j] * sigm(v1[j]); }
                    *(u32x4*)(HID + ((size_t)kv * 4096 + rt * 256 + EPI_ROWS(ai, m)) * 256 + col) = pack8(v0, v1);
                }
        }
    }
};
struct EpiResid { static constexpr bool PERM = false;
    const float* Hin; float* Hout;
    DI void operator()(const Acc& acc, const Unit& u, int wr, int wc, int fr, int fq) const {
#pragma unroll
        for (int ai = 0; ai < 2; ++ai)
#pragma unroll
            for (int m = 0; m < 4; ++m) {
                const size_t off = (size_t)(u.pm * 256 + EPI_ROWS(ai, m)) * 1024 + u.pn * 256 + 32 * wc + 4 * fq;
#pragma unroll
                for (int bj = 0; bj < 2; ++bj)
#pragma unroll
                    for (int n = 0; n < 2; ++n) { const size_t o = off + 128 * bj + 16 * n; *(f32x4*)(Hout + o) = *(const f32x4*)(Hin + o) + acc[ai][bj][m][n]; }
            }
    }
};
DI float ret_lg2(int h) { return __log2f(1.0f - exp2f(-5.0f - (float)h)); }
struct EpiOdNat { static constexpr bool PERM = true;
    unsigned char* ws;
    DI void operator()(const Acc& acc, const Unit& u, int wr, int wc, int fr, int fq) const {
        const int pn = u.pn; const int h = pn & 3; const float lg = ret_lg2(h);
        const size_t boff = pn < 4 ? WS_AQ : pn < 8 ? WS_KP : WS_GG;
        const int rowmul = pn < 4 ? 2048 : pn < 8 ? 1024 : 2048;
        const int coff = pn < 4 ? (h * 512 + 256) : pn < 8 ? (h * 256) : ((pn - 8) * 256);
        bf16_t* base = (bf16_t*)(ws + boff) + coff;
#pragma unroll
        for (int ai = 0; ai < 2; ++ai)
#pragma unroll
            for (int m = 0; m < 4; ++m) {
                const int cl = EPI_ROWS(ai, m); const size_t t = (size_t)u.pm * 256 + cl;
                float sc = 1.f;
                if (pn < 4) sc = exp2f(lg * (float)(cl + 1)); else if (pn < 8) sc = 0.0625f * exp2f(-lg * (float)(cl + 1));
#pragma unroll
                for (int bj = 0; bj < 2; ++bj) {
                    const int d = 128 * bj + 32 * wc + 8 * fq;
                    f32x4 v0 = acc[ai][bj][m][0] * sc, v1 = acc[ai][bj][m][1] * sc;
                    if (pn >= 8) {
#pragma unroll
                        for (int j = 0; j < 4; ++j) { v0[j] = v0[j] * sigm(v0[j]); v1[j] = v1[j] * sigm(v1[j]); } }
                    *(u32x4*)(base + t * rowmul + d) = pack8(v0, v1);
                }
            }
    }
};
struct EpiOdSw { static constexpr bool PERM = true;
    unsigned char* ws;
    DI void operator()(const Acc& acc, const Unit& u, int wr, int wc, int fr, int fq) const {
        const int b = u.pn >> 3, n = u.pn & 7;
        const bool isk = u.pm < 4; const int h = isk ? u.pm : ((u.pm - 4) >> 1);
        const size_t z = (size_t)(b * 4 + h) * 8 + n; const float lg = ret_lg2(h);
        bf16_t* base = (bf16_t*)(ws + (isk ? WS_KT : WS_VS)) + (isk ? z * 65536 : z * 262144 + (size_t)((u.pm - 4) & 1) * 256 * 512);
        const int rowmul = isk ? 256 : 512;
#pragma unroll
        for (int bj = 0; bj < 2; ++bj) {
            const int cl = 128 * bj + 32 * wc + 8 * fq;
            f32x4 s0 = {1.f, 1.f, 1.f, 1.f}, s1 = s0;
            if (isk) {
#pragma unroll
                for (int j = 0; j < 4; ++j) { s0[j] = 0.0625f * exp2f(-lg * (float)(cl + j + 1)); s1[j] = 0.0625f * exp2f(-lg * (float)(cl + 4 + j + 1)); } }
#pragma unroll
            for (int ai = 0; ai < 2; ++ai)
#pragma unroll
                for (int m = 0; m < 4; ++m)
                    *(u32x4*)(base + (size_t)EPI_ROWS(ai, m) * rowmul + cl) = pack8(acc[ai][bj][m][0] * s0, acc[ai][bj][m][1] * s1);
        }
    }
};
struct EpiAtt { static constexpr bool PERM = true;
    bf16_t* AQ;
    DI void operator()(const Acc& acc, const Unit& u, int wr, int wc, int fr, int fq) const {
        const int z = u.pm, n = z & 7, h = (z >> 3) & 3, b = z >> 5; const size_t t0 = (size_t)b * 2048 + n * 256;
#pragma unroll
        for (int ai = 0; ai < 2; ++ai)
#pragma unroll
            for (int m = 0; m < 4; ++m) {
                const int c = EPI_ROWS(ai, m);
#pragma unroll
                for (int bj = 0; bj < 2; ++bj) {
                    const int e0 = 128 * bj + 32 * wc + 8 * fq;
                    f32x4 v0 = acc[ai][bj][m][0], v1 = acc[ai][bj][m][1];
#pragma unroll
                    for (int j = 0; j < 4; ++j) { v0[j] = (c >= e0 + j) ? v0[j] : 0.f; v1[j] = (c >= e0 + 4 + j) ? v1[j] : 0.f; }
                    *(u32x4*)(AQ + ((t0 + c) * 4 + h) * 512 + e0) = pack8(v0, v1);
                }
            }
    }
};
struct EpiUT { static constexpr bool PERM = false;
    float* UT;
    DI void operator()(const Acc& acc, const Unit& u, int wr, int wc, int fr, int fq) const {
        const size_t z = (size_t)(u.pm >> 1); const int half = u.pm & 1;
#pragma unroll
        for (int ai = 0; ai < 2; ++ai)
#pragma unroll
            for (int m = 0; m < 4; ++m) {
                float* rowp = UT + z * 131072 + (size_t)(half * 256 + EPI_ROWS(ai, m)) * 256 + 32 * wc + 4 * fq;
#pragma unroll
                for (int bj = 0; bj < 2; ++bj)
#pragma unroll
                    for (int n = 0; n < 2; ++n) *(f32x4*)(rowp + 128 * bj + 16 * n) = acc[ai][bj][m][n];
            }
    }
};
struct EpiY { static constexpr bool PERM = true;
    bf16_t* Y;
    DI void operator()(const Acc& acc, const Unit& u, int wr, int wc, int fr, int fq) const {
        const int z = u.pm, n = z & 7, h = (z >> 3) & 3, b = z >> 5; const size_t t0 = (size_t)b * 2048 + n * 256;
#pragma unroll
        for (int ai = 0; ai < 2; ++ai)
#pragma unroll
            for (int m = 0; m < 4; ++m) {
                bf16_t* rowp = Y + (t0 + EPI_ROWS(ai, m)) * 2048 + h * 512 + u.pn * 256 + 32 * wc + 8 * fq;
#pragma unroll
                for (int bj = 0; bj < 2; ++bj) *(u32x4*)(rowp + 128 * bj) = pack8(acc[ai][bj][m][0], acc[ai][bj][m][1]);
            }
    }
};
constexpr float W8_SCALE = 32.0f, WSC = 1.0f / W8_SCALE;
struct EpiGU { static constexpr bool PERM = true;
    unsigned char* ACT; const float* bgu; const LAS int* ts;
    DI void operator()(const Acc& acc, const Unit& u, int wr, int wc, int fr, int fq) const {
        const int e = moe_tile_expert(ts, u.pm); const int w = 32 * wc + 8 * fq;
        const float* bp = bgu + (size_t)e * 2048 + 128 * u.pn + w;
        const f32x4 bg0 = *(const f32x4*)bp, bg1 = *(const f32x4*)(bp + 4), bl0 = *(const f32x4*)(bp + 1024), bl1 = *(const f32x4*)(bp + 1028);
#pragma unroll
        for (int ai = 0; ai < 2; ++ai)
#pragma unroll
            for (int m = 0; m < 4; ++m) {
                f32x4 g0 = acc[ai][0][m][0] * WSC + bg0, g1 = acc[ai][0][m][1] * WSC + bg1, l0 = acc[ai][1][m][0] * WSC + bl0, l1 = acc[ai][1][m][1] * WSC + bl1;
#pragma unroll
                for (int j = 0; j < 4; ++j) {
                    const float a = fminf(g0[j], 7.0f), c = fminf(g1[j], 7.0f);
                    const float la = fminf(fmaxf(l0[j], -7.0f), 7.0f), lc = fminf(fmaxf(l1[j], -7.0f), 7.0f);
                    g0[j] = a * sigm(1.702f * a) * (la + 1.0f); g1[j] = c * sigm(1.702f * c) * (lc + 1.0f); }
                u32x2 o8; o8.x = pk4_fp8(g0[0], g0[1], g0[2], g0[3]); o8.y = pk4_fp8(g1[0], g1[1], g1[2], g1[3]);
                *(u32x2*)(ACT + ((size_t)u.pm * 256 + EPI_ROWS(ai, m)) * 1024 + 128 * u.pn + w) = o8;
            }
    }
};
struct EpiDN { static constexpr bool PERM = true;
    bf16_t* YB; const float* bdn; const LAS int* ts;
    DI void operator()(const Acc& acc, const Unit& u, int wr, int wc, int fr, int fq) const {
        const int e = moe_tile_expert(ts, u.pm);
#pragma unroll
        for (int bj = 0; bj < 2; ++bj) {
            const int col = 256 * u.pn + 128 * bj + 32 * wc + 8 * fq;
            const f32x4 b0 = *(const f32x4*)(bdn + (size_t)e * 1024 + col), b1 = *(const f32x4*)(bdn + (size_t)e * 1024 + col + 4);
#pragma unroll
            for (int ai = 0; ai < 2; ++ai)
#pragma unroll
                for (int m = 0; m < 4; ++m)
                    *(u32x4*)(YB + ((size_t)u.pm * 256 + EPI_ROWS(ai, m)) * 1024 + col) = pack8(acc[ai][bj][m][0] * (1.0f / 64.0f) + b0, acc[ai][bj][m][1] * (1.0f / 64.0f) + b1);
        }
    }
};
struct EpiPP { static constexpr bool PERM = true;
    bf16_t* PP;
    DI void operator()(const Acc& acc, const Unit& u, int wr, int wc, int fr, int fq) const {
#pragma unroll
        for (int ai = 0; ai < 2; ++ai)
#pragma unroll
            for (int m = 0; m < 4; ++m) {
                bf16_t* rowp = PP + ((size_t)u.pm * 256 + EPI_ROWS(ai, m)) * 1024 + u.pn * 256 + 32 * wc + 8 * fq;
#pragma unroll
                for (int bj = 0; bj < 2; ++bj) *(u32x4*)(rowp + 128 * bj) = pack8(acc[ai][bj][m][0], acc[ai][bj][m][1]);
            }
    }
};
struct EpiPLE { static constexpr bool PERM = false;
    float* H; const bf16_t* PP;
    DI void operator()(const Acc& acc, const Unit& u, int wr, int wc, int fr, int fq) const {
#pragma unroll
        for (int ai = 0; ai < 2; ++ai)
#pragma unroll
            for (int m = 0; m < 4; ++m) {
                const size_t off = (size_t)(u.pm * 256 + EPI_ROWS(ai, m)) * 1024 + u.pn * 256 + 32 * wc + 4 * fq;
#pragma unroll
                for (int bj = 0; bj < 2; ++bj)
#pragma unroll
                    for (int n = 0; n < 2; ++n) {
                        const size_t o = off + 128 * bj + 16 * n;
                        const u32x2 pw = *(const u32x2*)(PP + o); const f32x4 a = acc[ai][bj][m][n]; f32x4 hv = *(const f32x4*)(H + o);
                        hv[0] += sigm(a[0]) * bflo(pw.x); hv[1] += sigm(a[1]) * bfhi(pw.x); hv[2] += sigm(a[2]) * bflo(pw.y); hv[3] += sigm(a[3]) * bfhi(pw.y);
                        *(f32x4*)(H + o) = hv;
                    }
            }
    }
};

constexpr int AT_KSTR = 144;
template <int DV, int MODE>
DI void attn_unit(const int WID, LAS unsigned char* lds, const bf16_t* Qp, int ldq, const bf16_t* Kp, int ldk, const bf16_t* Vt, int ldvt, int q0, float slope,
                  const unsigned* selp, bf16_t* Op, int ldo, float* impp) {
    constexpr int NRB = DV / 32, VPIECES = DV * 8;
    constexpr int KB0 = 0, KB1 = 64 * AT_KSTR, VB0 = 2 * 64 * AT_KSTR, VB1 = VB0 + DV * AT_KSTR;
    const int tid = opaque_tid(WID), w = __builtin_amdgcn_readfirstlane(tid >> 6), lane = tid & 63, r = lane & 31, hh = lane >> 5;
    const int qrow = q0 + 32 * w + r, qw_first = q0 + 32 * w, qw_last = qw_first + 31;
    const float LOG2E = 1.44269504089f;
    bf16x8 qf[4];
#pragma unroll
    for (int ks = 0; ks < 4; ++ks) qf[ks] = *(const bf16x8*)(Qp + (size_t)(32 * w + r) * ldq + 16 * ks + 8 * hh);
    unsigned selm = 0xffffffffu, orm = 0xffffffffu;
    if (MODE == 1) { selm = selp[32 * w + r]; orm = selm;
#pragma unroll
        for (int o = 1; o < 32; o <<= 1) orm |= __shfl_xor(orm, o); }
    const int nv = (MODE == 3) ? (qrow >= 31 ? ((qrow - 15) >> 4) : 0) : 0;
    const int nv_wmax = (MODE == 3) ? (qw_last >= 31 ? ((qw_last - 15) >> 4) : 0) : 0;
    int kt_lo = 0, kt_hi;
    if (MODE == 0 || MODE == 1) kt_hi = (q0 >> 6) + 4;
    else if (MODE == 2) { kt_hi = (q0 >> 6) + 4; const int lk = q0 - 511; kt_lo = lk > 0 ? (lk >> 6) : 0; }
    else kt_hi = 2;
    f32x16 cb[2];
#pragma unroll
    for (int kk = 0; kk < 2; ++kk)
#pragma unroll
        for (int i = 0; i < 16; ++i) cb[kk][i] = (MODE == 3) ? 0.f : slope * (float)(32 * kk + 8 * (i >> 2) + (i & 3) + 4 * hh);
    f32x16 O[NRB];
#pragma unroll
    for (int rb = 0; rb < NRB; ++rb)
#pragma unroll
        for (int i = 0; i < 16; ++i) O[rb][i] = 0.f;
    float mrun = NEGF, lrun = 0.f;
    u32x4 kreg, vreg[2];
    const int krow = tid >> 3, kpc = tid & 7;
#define AT_GLOAD(kt) do { kreg = *(const u32x4*)(Kp + (size_t)(64 * (kt) + krow) * ldk + 8 * kpc); \
        _Pragma("unroll") for (int i_ = 0; i_ < 2; ++i_) { const int idx = tid + 512 * i_; if (idx < VPIECES) vreg[i_] = *(const u32x4*)(Vt + (size_t)(idx >> 3) * ldvt + 64 * (kt) + 8 * (idx & 7)); } } while (0)
#define AT_LWRITE(buf) do { *(LAS u32x4*)(lds + ((buf) ? KB1 : KB0) + krow * AT_KSTR + kpc * 16) = kreg; \
        _Pragma("unroll") for (int i_ = 0; i_ < 2; ++i_) { const int idx = tid + 512 * i_; if (idx < VPIECES) { const int p_ = idx & 7; \
            LAS unsigned char* d_ = lds + ((buf) ? VB1 : VB0) + (idx >> 3) * AT_KSTR + (p_ >> 1) * 32 + (p_ & 1) * 8; \
            *(LAS u32x2*)d_ = (u32x2){vreg[i_].x, vreg[i_].y}; *(LAS u32x2*)(d_ + 16) = (u32x2){vreg[i_].z, vreg[i_].w}; } } } while (0)
    AT_GLOAD(kt_hi - 1); AT_LWRITE(0);
    __syncthreads();
    const int ntile = kt_hi - kt_lo;
    for (int it = 0; it < ntile; ++it) {
        const int kt = kt_hi - 1 - it, buf = it & 1, key0 = 64 * kt;
        if (it + 1 < ntile) AT_GLOAD(kt - 1);
        bool skip;
        if (MODE == 0) skip = key0 > qw_last;
        else if (MODE == 1) skip = (key0 > qw_last) || !((orm >> kt) & 1u);
        else if (MODE == 2) skip = (key0 > qw_last) || (key0 + 63 < qw_first - 511);
        else skip = key0 >= nv_wmax;
        if (!skip) {
            const LAS unsigned char* kb = lds + (buf ? KB1 : KB0); const LAS unsigned char* vb = lds + (buf ? VB1 : VB0);
            f32x16 S[2];
#pragma unroll
            for (int kk = 0; kk < 2; ++kk) {
                S[kk] = cb[kk];
#pragma unroll
                for (int ks = 0; ks < 4; ++ks) { const bf16x8 a = *(const LAS bf16x8*)(kb + (32 * kk + r) * AT_KSTR + (16 * ks + 8 * hh) * 2);
                    S[kk] = __builtin_amdgcn_mfma_f32_32x32x16_bf16(a, qf[ks], S[kk], 0, 0, 0); }
            }
            const bool bnd = (MODE == 3) ? true : ((key0 + 63 > qw_first) || (MODE == 2 && key0 < qw_last - 511));
            if (bnd) {
                const int lim = (MODE == 3) ? (nv - key0 - 4 * hh) : (qrow - key0 - 4 * hh);
#pragma unroll
                for (int kk = 0; kk < 2; ++kk)
#pragma unroll
                    for (int i = 0; i < 16; ++i) { const int cki = 32 * kk + 8 * (i >> 2) + (i & 3);
                        bool valid;
                        if (MODE == 3) valid = cki < lim; else if (MODE == 2) valid = (cki <= lim) && (cki > lim - 512); else valid = cki <= lim;
                        S[kk][i] = valid ? S[kk][i] : NEGF; }
            }
            float mx = NEGF;
#pragma unroll
            for (int kk = 0; kk < 2; ++kk)
#pragma unroll
                for (int i = 0; i < 16; ++i) mx = fmaxf(mx, S[kk][i]);
            mx = fmaxf(mx, __shfl_xor(mx, 32));
            const float off = (MODE == 3) ? 0.f : slope * (float)key0;
            mx += off;
            bool selok = true;
            if (MODE == 1) { selok = ((selm >> kt) & 1u) != 0u; mx = selok ? mx : NEGF; }
            const float mnew = fmaxf(mrun, mx);
            const float meff = (mnew < -1e29f) ? 0.f : mnew;
            float c = (off - meff) * LOG2E;
            if (MODE == 1) c = selok ? c : NEGF;
            float ps = 0.f;
#pragma unroll
            for (int kk = 0; kk < 2; ++kk)
#pragma unroll
                for (int i = 0; i < 16; ++i) { const float p = __builtin_amdgcn_exp2f(__builtin_fmaf(S[kk][i], LOG2E, c)); S[kk][i] = p; ps += p; }
            if (__any(mnew > mrun)) {
                const float alpha = __builtin_amdgcn_exp2f((mrun - mnew) * LOG2E);
                lrun *= alpha;
#pragma unroll
                for (int rb = 0; rb < NRB; ++rb)
#pragma unroll
                    for (int i = 0; i < 16; ++i) O[rb][i] *= alpha;
            }
            mrun = mnew; lrun += ps;
#pragma unroll
            for (int kk = 0; kk < 2; ++kk)
#pragma unroll
                for (int s2 = 0; s2 < 2; ++s2) {
                    u32x4 pw; pw.x = pk2(S[kk][8 * s2 + 0], S[kk][8 * s2 + 1]); pw.y = pk2(S[kk][8 * s2 + 2], S[kk][8 * s2 + 3]);
                    pw.z = pk2(S[kk][8 * s2 + 4], S[kk][8 * s2 + 5]); pw.w = pk2(S[kk][8 * s2 + 6], S[kk][8 * s2 + 7]);
                    const bf16x8 pf = __builtin_bit_cast(bf16x8, pw);
#pragma unroll
                    for (int rb = 0; rb < NRB; ++rb) {
                        const bf16x8 a = *(const LAS bf16x8*)(vb + (32 * rb + r) * AT_KSTR + (2 * kk + s2) * 32 + hh * 16);
                        O[rb] = __builtin_amdgcn_mfma_f32_32x32x16_bf16(a, pf, O[rb], 0, 0, 0);
                    }
                }
        }
        if (it + 1 < ntile) AT_LWRITE(buf ^ 1);
        __syncthreads();
    }
#undef AT_GLOAD
#undef AT_LWRITE
    const float ltot = lrun + __shfl_xor(lrun, 32);
    float inv = 1.0f / ltot;
    if (MODE == 3) inv = (nv > 0) ? inv : 0.f;
#pragma unroll
    for (int rb = 0; rb < NRB; ++rb)
#pragma unroll
        for (int g4 = 0; g4 < 4; ++g4) {
            const float a = O[rb][4 * g4] * inv, b = O[rb][4 * g4 + 1] * inv, c = O[rb][4 * g4 + 2] * inv, d = O[rb][4 * g4 + 3] * inv;
            const int dv = 32 * rb + 8 * g4 + 4 * hh;
            if (MODE == 3 && rb == 2) { *(f32x4*)(impp + (size_t)(32 * w + r) * 256 + (dv - 64)) = (f32x4){a, b, c, d}; }
            else { u32x2 o; o.x = pk2(a, b); o.y = pk2(c, d); *(u32x2*)(Op + (size_t)(32 * w + r) * ldo + dv) = o; }
        }
}

struct Args { const float* in[26]; float* out; unsigned char* ws; int ph_lo, ph_hi; };
typedef const __attribute__((address_space(4))) Args* ArgsP;
DI ArgsP opaque_args() { auto p = __builtin_amdgcn_kernarg_segment_ptr(); asm volatile("" : "+s"(p)); return (ArgsP)p; }
enum { I_X = 0, I_P, I_N1G, I_N2G, I_EVWIN, I_EVWOUT, I_DAQN, I_DAKN, I_DALAM, I_DAOUTG, I_NSQN, I_NSKN, I_CMPPE, I_CMPW1, I_CMPW2, I_ODWIN, I_ODWOUT,
       I_RETG, I_ROUTW, I_ROUTB, I_WGU, I_BGU, I_WDN, I_BDN, I_PLEP, I_PLEG };

struct CvtJob { int in_idx, ldsrc, K, col0, ncols, dstrow0, perm, nmat; size_t src_stride, dst_off, dst_stride; int fp8, pad; };
constexpr int NJOBS = 19;
__constant__ CvtJob c_jobs[NJOBS] = {
    {I_EVWIN, EVIN, 1024, 0,    1024, 0,    1, 2, (size_t)1024 * EVIN, WS_EVNAT, (size_t)2048 * 1024, 0, 0},
    {I_EVWIN, EVIN, 1024, 1536, 512,  1024, 1, 2, (size_t)1024 * EVIN, WS_EVNAT, (size_t)2048 * 1024, 0, 0},
    {I_EVWIN, EVIN, 1024, 2048, 128,  1536, 1, 2, (size_t)1024 * EVIN, WS_EVNAT, (size_t)2048 * 1024, 0, 0},
    {I_EVWIN, EVIN, 1024, 2176, 128,  1664, 1, 2, (size_t)1024 * EVIN, WS_EVNAT, (size_t)2048 * 1024, 0, 0},
    {I_EVWIN, EVIN, 1024, 2304, 128,  1792, 1, 2, (size_t)1024 * EVIN, WS_EVNAT, (size_t)2048 * 1024, 0, 0},
    {I_EVWIN, EVIN, 1024, 2560, 128,  1920, 1, 2, (size_t)1024 * EVIN, WS_EVNAT, (size_t)2048 * 1024, 0, 0},
    {I_EVWIN, EVIN, 1024, 1024, 512,  0,    0, 2, (size_t)1024 * EVIN, WS_EVSW,  (size_t)768 * 1024, 0, 0},
    {I_EVWIN, EVIN, 1024, 2432, 128,  512,  0, 2, (size_t)1024 * EVIN, WS_EVSW,  (size_t)768 * 1024, 0, 0},
    {I_EVWIN, EVIN, 1024, 2688, 128,  640,  0, 2, (size_t)1024 * EVIN, WS_EVSW,  (size_t)768 * 1024, 0, 0},
    {I_EVWOUT, 1024, 1024, 0, 1024, 0, 0, 2, (size_t)1024 * 1024, WS_EVOUT, (size_t)1024 * 1024, 0, 0},
    {I_CMPW1, 256, 2048, 0, 256, 0, 0, 4, (size_t)2048 * 256, WS_CMP1, (size_t)256 * 2048, 0, 0},
    {I_ODWIN, ODIN, 1024, 0,    2048, 0,    0, 2, (size_t)1024 * ODIN, WS_ODNAT, (size_t)4096 * 1024, 0, 0},
    {I_ODWIN, ODIN, 1024, 4096, 2048, 2048, 0, 2, (size_t)1024 * ODIN, WS_ODNAT, (size_t)4096 * 1024, 0, 0},
    {I_ODWIN, ODIN, 1024, 1024, 3072, 0,    0, 2, (size_t)1024 * ODIN, WS_ODSW,  (size_t)3072 * 1024, 0, 0},
    {I_ODWOUT, 1024, 2048, 0, 1024, 0, 0, 2, (size_t)2048 * 1024, WS_ODOUT, (size_t)1024 * 2048, 0, 0},
    {I_WGU, 2048, 1024, 0, 2048, 0, 2, 128, (size_t)1024 * 2048, WS_WGU, (size_t)2048 * 1024, 32, 0},
    {I_WDN, 1024, 1024, 0, 1024, 0, 0, 128, (size_t)1024 * 1024, WS_WDN, (size_t)1024 * 1024, 64, 0},
    {I_PLEP, 1024, 256, 0, 1024, 0, 0, 4, (size_t)256 * 1024, WS_WPP, (size_t)1024 * 256, 0, 0},
    {I_PLEG, 1024, 1024, 0, 1024, 0, 0, 4, (size_t)1024 * 1024, WS_WPG, (size_t)1024 * 1024, 0, 0},
};
DI int cvt_dstrow(int perm, int L) {
    if (perm == 1) { const int pn = L >> 8, lc = L & 255; return pn * 256 + 128 * ((lc & 63) >> 5) + 32 * (lc >> 6) + (lc & 31); }
    if (perm == 2) { const int bj = L >> 10, cc = L & 1023; return 256 * (cc >> 7) + 128 * bj + (cc & 127); }
    return L;
}
DI void phase_prologue(const int WID, ArgsP a, LAS unsigned char* lds) {
    const int tid = opaque_tid(WID), lane = tid & 63, wv = tid >> 6;
    const int gw = blockIdx.x * 8 + wv, NGW = gridDim.x * 8;
    LAS float* scr = (LAS float*)(lds + wv * 16640);
    int total = 0;
    for (int j = 0; j < NJOBS; ++j) total += c_jobs[j].nmat * (c_jobs[j].K >> 6) * (c_jobs[j].ncols >> 6);
    for (int it = gw; it < total; it += NGW) {
        int r = it, j = 0;
        for (; j < NJOBS; ++j) { const int n = c_jobs[j].nmat * (c_jobs[j].K >> 6) * (c_jobs[j].ncols >> 6); if (r < n) break; r -= n; }
        const CvtJob J = c_jobs[j];
        const int nkb = J.K >> 6, nnb = J.ncols >> 6, per = nkb * nnb;
        const int mat = r / per, rr = r % per, kb = rr / nnb, nb = rr % nnb, k0 = kb * 64, n0 = nb * 64;
        const float* src = a->in[J.in_idx] + (size_t)mat * J.src_stride + (size_t)k0 * J.ldsrc + J.col0 + n0 + lane;
        { float tv[64];
#pragma unroll
          for (int i = 0; i < 64; ++i) tv[i] = src[(size_t)i * J.ldsrc];
#pragma unroll
          for (int i = 0; i < 64; ++i) scr[i * 65 + lane] = tv[i]; }
        asm volatile("s_waitcnt lgkmcnt(0)" ::: "memory");
        if (J.fp8) {
            unsigned char* dst = (unsigned char*)(a->ws + J.dst_off) + (size_t)mat * J.dst_stride;
            const int c = lane & 3, nsub = lane >> 2; const float W8_S = (float)J.fp8;
#pragma unroll
            for (int jj = 0; jj < 4; ++jj) {
                const int n = nsub + 16 * jj; const LAS float* s = scr + (16 * c) * 65 + n;
                u32x4 o;
                o.x = pk4_fp8(s[0] * W8_S, s[65] * W8_S, s[2 * 65] * W8_S, s[3 * 65] * W8_S); o.y = pk4_fp8(s[4 * 65] * W8_S, s[5 * 65] * W8_S, s[6 * 65] * W8_S, s[7 * 65] * W8_S);
                o.z = pk4_fp8(s[8 * 65] * W8_S, s[9 * 65] * W8_S, s[10 * 65] * W8_S, s[11 * 65] * W8_S); o.w = pk4_fp8(s[12 * 65] * W8_S, s[13 * 65] * W8_S, s[14 * 65] * W8_S, s[15 * 65] * W8_S);
                const int drow = cvt_dstrow(J.perm, J.dstrow0 + n0 + n);
                *(u32x4*)(dst + (size_t)drow * J.K + k0 + 16 * c) = o;
            }
        } else {
        bf16_t* dst = (bf16_t*)(a->ws + J.dst_off) + (size_t)mat * J.dst_stride;
        const int c = lane & 7, nsub = lane >> 3;
#pragma unroll
        for (int jj = 0; jj < 8; ++jj) {
            const int n = nsub + 8 * jj; const LAS float* s = scr + (8 * c) * 65 + n;
            u32x4 o; o.x = pk2(s[0], s[65]); o.y = pk2(s[2 * 65], s[3 * 65]); o.z = pk2(s[4 * 65], s[5 * 65]); o.w = pk2(s[6 * 65], s[7 * 65]);
            const int drow = cvt_dstrow(J.perm, J.dstrow0 + n0 + n);
            *(u32x4*)(dst + (size_t)drow * J.K + k0 + 8 * c) = o;
        }
        }
        asm volatile("s_waitcnt lgkmcnt(0)" ::: "memory");
    }
    {
        const float* p = a->in[I_P]; bf16_t* pb = (bf16_t*)(a->ws + WS_PBF);
        const size_t n8 = (size_t)DEPTH * T * 256 / 8;
        for (size_t i = (size_t)blockIdx.x * 512 + tid; i < n8; i += (size_t)gridDim.x * 512) {
            const f32x4 v0 = *(const f32x4*)(p + i * 8), v1 = *(const f32x4*)(p + i * 8 + 4);
            *(u32x4*)(pb + i * 8) = pack8(v0, v1);
        }
    }
    if (blockIdx.x == 4 && tid < 512) { const int ev = tid >> 8, gi = (tid >> 6) & 3, d = tid & 63;
        const float* src = a->in[gi == 0 ? I_DAQN : gi == 1 ? I_DAKN : gi == 2 ? I_NSQN : I_NSKN];
        ((float*)(a->ws + WS_GAINS))[tid] = src[ev * 64 + d]; }
    if (blockIdx.x < 4 && tid < 256) {
        const int m = blockIdx.x; const float* pe = a->in[I_CMPPE] + (size_t)m * 2048; const float* w1 = a->in[I_CMPW1] + (size_t)m * 2048 * 256;
        float s = 0.f;
        for (int k = 0; k < 2048; ++k) s += pe[k] * w1[(size_t)k * 256 + tid];
        ((float*)(a->ws + WS_BIAS1))[m * 256 + tid] = s;
    }
}

DI float row_load_ss(const float* row, int lane, f32x4 (&v)[4]) {
    float ss = 0.f;
#pragma unroll
    for (int j = 0; j < 4; ++j) { v[j] = *(const f32x4*)(row + 4 * lane + 256 * j); ss += (v[j][0] * v[j][0] + v[j][1] * v[j][1]) + (v[j][2] * v[j][2] + v[j][3] * v[j][3]); }
    return wave_sum(ss);
}
DI void row_store_bf16(bf16_t* row, int lane, const f32x4 (&v)[4]) {
#pragma unroll
    for (int j = 0; j < 4; ++j) { u32x2 o; o.x = pk2(v[j][0], v[j][1]); o.y = pk2(v[j][2], v[j][3]); *(u32x2*)(row + 4 * lane + 256 * j) = o; }
}
template <int MODE>
DI void phase_norm(const int WID, ArgsP a, LAS unsigned char* lds, int layer, const float* Hin) {
    const int tid = opaque_tid(WID), lane = tid & 63, wv = __builtin_amdgcn_readfirstlane(tid >> 6);
    LAS float* wt = (LAS float*)lds;
    LAS int* bcl = (LAS int*)(lds + MISC_OFF + MO_WCNT); LAS int* ent = (LAS int*)(lds + MISC_OFF + MO_ENT); LAS float* gat = (LAS float*)(lds + MISC_OFF + MO_GAT);
    LAS float* lgb = (LAS float*)(lds + MISC_OFF + MO_RED);
    bf16_t* XN = (bf16_t*)(a->ws + WS_XN);
    const float* gain = a->in[MODE == 2 ? I_N2G : I_N1G] + layer * 1024;
    constexpr int NQ = MODE == 0 ? 24 : (MODE == 2 ? 32 : 0);
    if (NQ > 0) {
        const float* w = (MODE == 0) ? a->in[I_EVWIN] + (size_t)(layer >> 1) * 1024 * EVIN + 2816 : a->in[I_ROUTW] + (size_t)layer * 1024 * 32;
        const int ldw = (MODE == 0) ? EVIN : 32;
        for (int i = tid; i < 256 * 32; i += 512) { const int q = i & 31, g = i >> 5;
            if (q < NQ) { f32x4 v; v[0] = w[(size_t)(4 * g) * ldw + q]; v[1] = w[(size_t)(4 * g + 1) * ldw + q]; v[2] = w[(size_t)(4 * g + 2) * ldw + q]; v[3] = w[(size_t)(4 * g + 3) * ldw + q];
                *(LAS f32x4*)(wt + q * 1024 + 4 * (g ^ q)) = v; } }
    }
    f32x4 gn[4];
#pragma unroll
    for (int j = 0; j < 4; ++j) gn[j] = *(const f32x4*)(gain + 4 * lane + 256 * j);
    const float rbias = (MODE == 2) ? a->in[I_ROUTB][layer * 32 + (lane & 31)] : 0.f;
    __syncthreads();
    for (int vb = blockIdx.x; vb < NTB; vb += gridDim.x) {
        if (MODE == 2) { if (tid < 32) bcl[tid] = 0; }
        const int t0 = vb * 128 + wv * 16;
        f32x4 na[4], nb[4];
#pragma unroll
        for (int j = 0; j < 4; ++j) { na[j] = *(const f32x4*)(Hin + (size_t)t0 * 1024 + 4 * lane + 256 * j); nb[j] = *(const f32x4*)(Hin + (size_t)(t0 + 1) * 1024 + 4 * lane + 256 * j); }
#pragma unroll 1
        for (int it = 0; it < 8; ++it) {
            const int ta = t0 + 2 * it;
            f32x4 va[4], vc[4];
#pragma unroll
            for (int j = 0; j < 4; ++j) { va[j] = na[j]; vc[j] = nb[j]; }
            if (it < 7) {
#pragma unroll
                for (int j = 0; j < 4; ++j) { na[j] = *(const f32x4*)(Hin + (size_t)(ta + 2) * 1024 + 4 * lane + 256 * j); nb[j] = *(const f32x4*)(Hin + (size_t)(ta + 3) * 1024 + 4 * lane + 256 * j); }
            }
            float sa = 0.f, sb = 0.f;
#pragma unroll
            for (int j = 0; j < 4; ++j) { sa += (va[j][0] * va[j][0] + va[j][1] * va[j][1]) + (va[j][2] * va[j][2] + va[j][3] * va[j][3]); sb += (vc[j][0] * vc[j][0] + vc[j][1] * vc[j][1]) + (vc[j][2] * vc[j][2] + vc[j][3] * vc[j][3]); }
#pragma unroll
            for (int o = 1; o < 64; o <<= 1) { sa += __shfl_xor(sa, o); sb += __shfl_xor(sb, o); }
            const float ra = rsqrtf(sa * (1.0f / 1024.0f) + EPS), rb2 = rsqrtf(sb * (1.0f / 1024.0f) + EPS);
#pragma unroll
            for (int j = 0; j < 4; ++j) { va[j] = va[j] * ra * gn[j]; vc[j] = vc[j] * rb2 * gn[j]; }
            row_store_bf16(XN + (size_t)ta * 1024, lane, va); row_store_bf16(XN + (size_t)(ta + 1) * 1024, lane, vc);
            if (NQ > 0) {
                float x[64];
#pragma unroll
                for (int q = 0; q < 32; ++q) {
                    if (q < NQ) { float s0 = 0.f, s1 = 0.f;
#pragma unroll
                        for (int j = 0; j < 4; ++j) { const f32x4 ww = *(const LAS f32x4*)(wt + q * 1024 + 4 * ((lane + 64 * j) ^ q));
                            s0 += (va[j][0] * ww[0] + va[j][1] * ww[1]) + (va[j][2] * ww[2] + va[j][3] * ww[3]); s1 += (vc[j][0] * ww[0] + vc[j][1] * ww[1]) + (vc[j][2] * ww[2] + vc[j][3] * ww[3]); }
                        x[q] = s0; x[32 + q] = s1;
                        if ((q & 3) == 3) asm volatile("" ::: "memory");
                    } else { x[q] = 0.f; x[32 + q] = 0.f; }
                }
#define RS_STEP(N, BIT) _Pragma("unroll") for (int i = 0; i < (N); ++i) { const bool up = (lane & (BIT)) != 0; const float keep = up ? x[(N) + i] : x[i], send = up ? x[i] : x[(N) + i]; x[i] = keep + __shfl_xor(send, (BIT)); }
                RS_STEP(32, 32) RS_STEP(16, 16) RS_STEP(8, 8) RS_STEP(4, 4) RS_STEP(2, 2) RS_STEP(1, 1)
#undef RS_STEP
                const float val = x[0];
                if (MODE == 0) { if ((lane & 31) < 24) ((float*)(a->ws + WS_GATES))[(size_t)(ta + (lane >> 5)) * 24 + (lane & 31)] = sigm(val); }
                if (MODE == 2) {
                    lgb[wv * 64 + lane] = val + rbias;
                    asm volatile("s_waitcnt lgkmcnt(0)" ::: "memory");
                    float lg[32];
#pragma unroll
                    for (int q4 = 0; q4 < 8; ++q4) { const f32x4 t4 = *(const LAS f32x4*)(lgb + wv * 64 + (lane & 32) + 4 * q4); lg[4 * q4] = t4[0]; lg[4 * q4 + 1] = t4[1]; lg[4 * q4 + 2] = t4[2]; lg[4 * q4 + 3] = t4[3]; }
                    unsigned used = 0u; int te[4]; float tv[4];
#pragma unroll
                    for (int k = 0; k < 4; ++k) { float best = -3.0e38f; int bi = 0;
#pragma unroll
                        for (int q = 0; q < 32; ++q) { const bool ok = !((used >> q) & 1u) && (lg[q] > best); best = ok ? lg[q] : best; bi = ok ? q : bi; }
                        used |= 1u << bi; te[k] = bi; tv[k] = best; }
                    float ex[4], sum = 0.f;
#pragma unroll
                    for (int k = 0; k < 4; ++k) { ex[k] = __expf(tv[k] - tv[0]); sum += ex[k]; }
                    const float rs = 1.0f / sum;
                    if ((lane & 31) == 0) {
                        const int eb = wv * 64 + (2 * it + (lane >> 5)) * 4;
#pragma unroll
                        for (int k = 0; k < 4; ++k) { ent[eb + k] = te[k]; gat[eb + k] = ex[k] * rs; }
                    }
                    asm volatile("s_waitcnt lgkmcnt(0)" ::: "memory");
                }
            }
        }
        if (MODE == 2) {
            __syncthreads();
            { const int e = ent[wv * 64 + lane];
              const int pos = __hip_atomic_fetch_add(bcl + e, 1, __ATOMIC_RELAXED, __HIP_MEMORY_SCOPE_WORKGROUP);
              const size_t idx = (size_t)(vb * 128 + wv * 16) * 4 + lane;
              ((int*)(a->ws + WS_TOPE))[idx] = e; ((int*)(a->ws + WS_POSB))[idx] = pos; ((float*)(a->ws + WS_GATEW))[idx] = gat[wv * 64 + lane]; }
            __syncthreads();
            if (tid < 32) ((int*)(a->ws + WS_BCNT))[((size_t)layer * NTB + vb) * 32 + tid] = bcl[tid];
            __syncthreads();
        }
    }
}
DI void moe_tables(const int WID, ArgsP a, LAS unsigned char* lds, int layer, int vb) {
    const int tid = opaque_tid(WID);
    LAS int* tot = (LAS int*)(lds + MISC_OFF + MO_TOT); LAS int* base = (LAS int*)(lds + MISC_OFF + MO_BASE); LAS int* ts = (LAS int*)(lds + MISC_OFF + MO_TS);
    LAS int* red = (LAS int*)(lds + MISC_OFF + MO_RED);
    const int* bc = (const int*)(a->ws + WS_BCNT) + (size_t)layer * NTB * 32;
    { const int e = tid & 31, part = tid >> 5; int st = 0, sp = 0;
      for (int blk = part; blk < NTB; blk += 16) { const int v = bc[blk * 32 + e]; st += v; sp += (blk < vb) ? v : 0; }
      red[part * 32 + e] = st; red[512 + part * 32 + e] = sp; }
    __syncthreads();
    if (tid < 32) { int st = 0, sp = 0;
#pragma unroll
        for (int p = 0; p < 16; ++p) { st += red[p * 32 + tid]; sp += red[512 + p * 32 + tid]; }
        tot[tid] = st; base[tid] = sp; }
    __syncthreads();
    if (tid == 0) { int acc = 0; for (int e = 0; e < 32; ++e) { ts[e] = acc; acc += (tot[e] + 255) >> 8; } ts[32] = acc; }
    __syncthreads();
}
DI void phase_moe_slots(const int WID, ArgsP a, LAS unsigned char* lds, int layer) {
    const int tid = opaque_tid(WID), lane = tid & 63, wv = tid >> 6;
    LAS int* base = (LAS int*)(lds + MISC_OFF + MO_BASE); LAS int* ts = (LAS int*)(lds + MISC_OFF + MO_TS);
    const bf16_t* XN = (const bf16_t*)(a->ws + WS_XN); unsigned char* XB = (unsigned char*)(a->ws + WS_XB);
    for (int vb = blockIdx.x; vb < NTB; vb += gridDim.x) {
        moe_tables(WID, a, lds, layer, vb);
#pragma unroll 1
        for (int i = 0; i < 16; ++i) {
            const int t = vb * 128 + wv * 16 + i;
            int dest = 0;
            if (lane < 4) { const int e = ((const int*)(a->ws + WS_TOPE))[(size_t)t * 4 + lane], pos = ((const int*)(a->ws + WS_POSB))[(size_t)t * 4 + lane];
                dest = ts[e] * 256 + base[e] + pos; ((int*)(a->ws + WS_DEST))[(size_t)t * 4 + lane] = dest; }
            const u32x4 r0 = *(const u32x4*)(XN + (size_t)t * 1024 + 8 * lane), r1 = *(const u32x4*)(XN + (size_t)t * 1024 + 512 + 8 * lane);
            u32x2 q0, q1;
            q0.x = pk4_fp8(bflo(r0.x), bfhi(r0.x), bflo(r0.y), bfhi(r0.y)); q0.y = pk4_fp8(bflo(r0.z), bfhi(r0.z), bflo(r0.w), bfhi(r0.w));
            q1.x = pk4_fp8(bflo(r1.x), bfhi(r1.x), bflo(r1.y), bfhi(r1.y)); q1.y = pk4_fp8(bflo(r1.z), bfhi(r1.z), bflo(r1.w), bfhi(r1.w));
#pragma unroll
            for (int k = 0; k < 4; ++k) { const int d = __shfl(dest, k); unsigned char* o = XB + (size_t)d * 1024; *(u32x2*)(o + 8 * lane) = q0; *(u32x2*)(o + 512 + 8 * lane) = q1; }
        }
        __syncthreads();
    }
}
DI void phase_combine(const int WID, ArgsP a, float* H) {
    const int tid = opaque_tid(WID), lane = tid & 63, wv = tid >> 6;
    const bf16_t* YB = (const bf16_t*)(a->ws + WS_YB); bf16_t* XN = (bf16_t*)(a->ws + WS_XN);
    for (int t = blockIdx.x * 8 + wv; t < T; t += gridDim.x * 8) {
        int dest = 0; float gw = 0.f;
        if (lane < 4) { dest = ((const int*)(a->ws + WS_DEST))[(size_t)t * 4 + lane]; gw = ((const float*)(a->ws + WS_GATEW))[(size_t)t * 4 + lane]; }
        f32x4 v[4];
#pragma unroll
        for (int j = 0; j < 4; ++j) v[j] = *(const f32x4*)(H + (size_t)t * 1024 + 4 * lane + 256 * j);
#pragma unroll
        for (int k = 0; k < 4; ++k) { const int d = __shfl(dest, k); const float g = __shfl(gw, k); const bf16_t* y = YB + (size_t)d * 1024;
#pragma unroll
            for (int j = 0; j < 4; ++j) { const u32x2 w = *(const u32x2*)(y + 4 * lane + 256 * j); v[j][0] += g * bflo(w.x); v[j][1] += g * bfhi(w.x); v[j][2] += g * bflo(w.y); v[j][3] += g * bfhi(w.y); } }
        float ss = 0.f;
#pragma unroll
        for (int j = 0; j < 4; ++j) { *(f32x4*)(H + (size_t)t * 1024 + 4 * lane + 256 * j) = v[j]; ss += (v[j][0] * v[j][0] + v[j][1] * v[j][1]) + (v[j][2] * v[j][2] + v[j][3] * v[j][3]); }
        ss = wave_sum(ss);
        const float rstd = rsqrtf(ss * (1.0f / 1024.0f) + EPS);
#pragma unroll
        for (int j = 0; j < 4; ++j) v[j] = v[j] * rstd;
        row_store_bf16(XN + (size_t)t * 1024, lane, v);
    }
}
DI void phase_cmp2(const int WID, ArgsP a, LAS unsigned char* lds, int ev) {
    const int tid = opaque_tid(WID), lane = tid & 63, wv = __builtin_amdgcn_readfirstlane(tid >> 6);
    const bf16_t* HID = (const bf16_t*)(a->ws + WS_HID); bf16_t* KCMP = (bf16_t*)(a->ws + WS_KCMP); bf16_t* VCMPT = (bf16_t*)(a->ws + WS_VCMPT);
    const float kg = a->in[I_NSKN][ev * 64 + lane];
    LAS float* wl = (LAS float*)lds;
    for (int i = tid; i < 2 * 256 * 64 / 4; i += 512) *(LAS f32x4*)(wl + 4 * i) = *(const f32x4*)(a->in[I_CMPW2] + (size_t)ev * 2 * 256 * 64 + 4 * i);
    __syncthreads();
    for (int gi = blockIdx.x * 8 + wv; gi < 2048; gi += gridDim.x * 8) {
        const int kv = gi >> 10, row0 = (gi & 1023) * 4;
        const bf16_t* hrow = HID + ((size_t)kv * 4096 + row0) * 256;
        const LAS float* w2 = wl + kv * 256 * 64 + lane;
        float s[4] = {0.f, 0.f, 0.f, 0.f};
#pragma unroll 2
        for (int k = 0; k < 256; k += 8) {
            u32x4 hw[4];
#pragma unroll
            for (int r = 0; r < 4; ++r) hw[r] = *(const u32x4*)(hrow + r * 256 + k);
            float wv8[8];
#pragma unroll
            for (int j = 0; j < 8; ++j) wv8[j] = w2[(k + j) * 64];
#pragma unroll
            for (int r = 0; r < 4; ++r)
                s[r] += bflo(hw[r].x) * wv8[0] + bfhi(hw[r].x) * wv8[1] + bflo(hw[r].y) * wv8[2] + bfhi(hw[r].y) * wv8[3] + bflo(hw[r].z) * wv8[4] + bfhi(hw[r].z) * wv8[5] + bflo(hw[r].w) * wv8[6] + bfhi(hw[r].w) * wv8[7];
        }
#pragma unroll
        for (int r = 0; r < 4; ++r) {
            const int row = row0 + r, bg = row >> 7, n = row & 127;
            float v = (n == 127) ? 0.f : s[r];
            if (kv == 0) { const float ss = wave_sum(v * v); const float o = v * rsqrtf(ss * (1.0f / 64.0f) + EPS) * kg;
                KCMP[((size_t)bg * 128 + n) * 64 + lane] = (bf16_t)(pk2(o, 0.f) & 0xffffu); }
            else VCMPT[((size_t)bg * 96 + lane) * 128 + n] = (bf16_t)(pk2(v, 0.f) & 0xffffu);
        }
    }
    for (int i = blockIdx.x * 512 + tid; i < 32 * 32 * 128; i += gridDim.x * 512) {
        const int n = i & 127, j = (i >> 7) & 31, bg = i >> 12;
        float o = 0.f;
        if (n < 127) { const int d = n - 4 * j; if (d >= 0 && d <= 2) o = 1.0f; else if (d == 3 || d == -1) o = 0.5f; }
        VCMPT[((size_t)bg * 96 + 64 + j) * 128 + n] = (bf16_t)(pk2(o, 0.f) & 0xffffu);
    }
}
DI void phase_topk(const int WID, ArgsP a) {
    const float* IMPH = (const float*)(a->ws + WS_IMPH); unsigned* SELM = (unsigned*)(a->ws + WS_SELM);
    for (int i = blockIdx.x * 512 + opaque_tid(WID); i < T * 2; i += gridDim.x * 512) {
        const int t = i >> 1, g = i & 1, b = t >> 11, s = t & 2047, cur = s >> 6;
        float sc[32];
#pragma unroll
        for (int j4 = 0; j4 < 8; ++j4) { f32x4 acc = {0.f, 0.f, 0.f, 0.f};
#pragma unroll
            for (int r = 0; r < 4; ++r) acc += *(const f32x4*)(IMPH + ((size_t)t * 8 + g * 4 + r) * 32 + 4 * j4);
#pragma unroll
            for (int q = 0; q < 4; ++q) sc[4 * j4 + q] = acc[q]; }
        unsigned mask;
        if (cur < 16) mask = (cur == 31) ? 0xffffffffu : ((2u << cur) - 1u);
        else {
#pragma unroll
            for (int j = 0; j < 32; ++j) { const bool forced = (j == 0) || (j == cur) || (j == cur - 1); sc[j] = (j > cur) ? NEGF : (sc[j] + (forced ? 1e4f : 0.f)); }
            mask = 0u;
#pragma unroll
            for (int j = 0; j < 32; ++j) { int rank = 0;
#pragma unroll
                for (int k = 0; k < 32; ++k) rank += ((sc[k] > sc[j]) || (sc[k] == sc[j] && k < j)) ? 1 : 0;
                mask |= (rank < 16) ? (1u << j) : 0u; }
        }
        SELM[((size_t)(b * 2 + g)) * 2048 + s] = mask;
    }
}
DI void phase_mixprep(const int WID, ArgsP a, int layer) {
    const int tid = opaque_tid(WID), lane = tid & 63, wv = tid >> 6, ev = layer >> 1;
    const float* dl = a->in[I_DALAM] + ev * 256;
    const float s1 = wave_sum(dl[lane] * dl[64 + lane]), s2 = wave_sum(dl[128 + lane] * dl[192 + lane]);
    const float lam_init = 0.8f - 0.6f * expf(-0.3f * (float)layer);
    const float lam = expf(s1) - expf(s2) + lam_init;
    const float* og = a->in[I_DAOUTG] + ev * 128;
    const bf16_t* OD = (const bf16_t*)(a->ws + WS_OD); const bf16_t* OC = (const bf16_t*)(a->ws + WS_OC); const bf16_t* OS = (const bf16_t*)(a->ws + WS_OS); const bf16_t* OW = (const bf16_t*)(a->ws + WS_OW);
    const float* GT = (const float*)(a->ws + WS_GATES); bf16_t* AMIX = (bf16_t*)(a->ws + WS_AMIX);
    const int h = lane >> 4, dv = (lane & 15) * 8;
    f32x4 g0 = *(const f32x4*)(og + dv), g1 = *(const f32x4*)(og + dv + 4);
    for (int t = blockIdx.x * 8 + wv; t < T; t += gridDim.x * 8) {
        { const u32x4 w1 = *(const u32x4*)(OD + (size_t)t * 1024 + h * 128 + dv), w2 = *(const u32x4*)(OD + (size_t)t * 1024 + (4 + h) * 128 + dv);
          f32x4 d0, d1;
          d0[0] = bflo(w1.x) - lam * bflo(w2.x); d0[1] = bfhi(w1.x) - lam * bfhi(w2.x); d0[2] = bflo(w1.y) - lam * bflo(w2.y); d0[3] = bfhi(w1.y) - lam * bfhi(w2.y);
          d1[0] = bflo(w1.z) - lam * bflo(w2.z); d1[1] = bfhi(w1.z) - lam * bfhi(w2.z); d1[2] = bflo(w1.w) - lam * bflo(w2.w); d1[3] = bfhi(w1.w) - lam * bfhi(w2.w);
          float ss = (d0[0] * d0[0] + d0[1] * d0[1]) + (d0[2] * d0[2] + d0[3] * d0[3]) + (d1[0] * d1[0] + d1[1] * d1[1]) + (d1[2] * d1[2] + d1[3] * d1[3]);
          ss += __shfl_xor(ss, 1); ss += __shfl_xor(ss, 2); ss += __shfl_xor(ss, 4); ss += __shfl_xor(ss, 8);
          const float rs = rsqrtf(ss * (1.0f / 128.0f) + EPS) * (1.0f - lam_init);
          *(u32x4*)(AMIX + (size_t)t * 1024 + h * 128 + dv) = pack8(d0 * rs * g0, d1 * rs * g1); }
        { const int hd = lane >> 3, dq = (lane & 7) * 8; const size_t o = (size_t)t * 512 + hd * 64 + dq;
          const float ga = GT[(size_t)t * 24 + hd * 3], gb = GT[(size_t)t * 24 + hd * 3 + 1], gc = GT[(size_t)t * 24 + hd * 3 + 2];
          const u32x4 c = *(const u32x4*)(OC + o), s = *(const u32x4*)(OS + o), w = *(const u32x4*)(OW + o);
          f32x4 r0, r1;
          r0[0] = ga * bflo(c.x) + gb * bflo(s.x) + gc * bflo(w.x); r0[1] = ga * bfhi(c.x) + gb * bfhi(s.x) + gc * bfhi(w.x);
          r0[2] = ga * bflo(c.y) + gb * bflo(s.y) + gc * bflo(w.y); r0[3] = ga * bfhi(c.y) + gb * bfhi(s.y) + gc * bfhi(w.y);
          r1[0] = ga * bflo(c.z) + gb * bflo(s.z) + gc * bflo(w.z); r1[1] = ga * bfhi(c.z) + gb * bfhi(s.z) + gc * bfhi(w.z);
          r1[2] = ga * bflo(c.w) + gb * bflo(s.w) + gc * bflo(w.w); r1[3] = ga * bfhi(c.w) + gb * bfhi(s.w) + gc * bfhi(w.w);
          *(u32x4*)(AMIX + (size_t)t * 1024 + 512 + hd * 64 + dq) = pack8(r0, r1); }
    }
}
DI void phase_scan(const int WID, ArgsP a) {
    const float* UT = (const float*)(a->ws + WS_UT); bf16_t* VS = (bf16_t*)(a->ws + WS_VS);
    for (int i = blockIdx.x * 512 + opaque_tid(WID); i < 64 * 512 * 64; i += gridDim.x * 512) {
        const int d4 = i & 63, f = (i >> 6) & 511, bh = i >> 15, h = bh & 3;
        const float dec = exp2f(256.0f * ret_lg2(h));
        f32x4 S = {0.f, 0.f, 0.f, 0.f};
#pragma unroll 1
        for (int n = 0; n < 8; ++n) {
            const size_t z = (size_t)bh * 8 + n;
            u32x2 o; o.x = pk2(S[0], S[1]); o.y = pk2(S[2], S[3]);
            *(u32x2*)(VS + (z * 512 + f) * 512 + 256 + 4 * d4) = o;
            const f32x4 u = *(const f32x4*)(UT + z * 131072 + (size_t)f * 256 + 4 * d4);
            S = (S + u) * dec;
        }
    }
}
DI void phase_normgate(const int WID, ArgsP a, int od) {
    const int tid = opaque_tid(WID), lane = tid & 63, wv = tid >> 6;
    const bf16_t* Y = (const bf16_t*)(a->ws + WS_Y); const bf16_t* GG = (const bf16_t*)(a->ws + WS_GG); bf16_t* YG = (bf16_t*)(a->ws + WS_YG);
    const float* og = a->in[I_RETG] + od * 512;
    const f32x4 g0 = *(const f32x4*)(og + 8 * lane), g1 = *(const f32x4*)(og + 8 * lane + 4);
    for (int t = blockIdx.x * 8 + wv; t < T; t += gridDim.x * 8) {
#pragma unroll
        for (int h = 0; h < 4; ++h) {
            const size_t o = (size_t)t * 2048 + h * 512 + 8 * lane;
            const u32x4 yw = *(const u32x4*)(Y + o), gw = *(const u32x4*)(GG + o);
            f32x4 y0 = {bflo(yw.x), bfhi(yw.x), bflo(yw.y), bfhi(yw.y)}, y1 = {bflo(yw.z), bfhi(yw.z), bflo(yw.w), bfhi(yw.w)};
            const f32x4 q0 = {bflo(gw.x), bfhi(gw.x), bflo(gw.y), bfhi(gw.y)}, q1 = {bflo(gw.z), bfhi(gw.z), bflo(gw.w), bfhi(gw.w)};
            float ss = (y0[0] * y0[0] + y0[1] * y0[1]) + (y0[2] * y0[2] + y0[3] * y0[3]) + (y1[0] * y1[0] + y1[1] * y1[1]) + (y1[2] * y1[2] + y1[3] * y1[3]);
            ss = wave_sum(ss);
            const float rs = rsqrtf(ss * (1.0f / 512.0f) + EPS);
            *(u32x4*)(YG + o) = pack8(y0 * rs * g0 * q0, y1 * rs * g1 * q1);
        }
    }
}
DI int snake_unit(int rnd, int G, int c) { return (rnd & 1) ? rnd * G + (G - 1 - c) : rnd * G + c; }
template <int MODE>
DI void phase_attn(const int WID, ArgsP a, LAS unsigned char* lds) {
    const int G = gridDim.x, c = blockIdx.x;
    const bf16_t* QD = (const bf16_t*)(a->ws + WS_QD); const bf16_t* KD = (const bf16_t*)(a->ws + WS_KD); const bf16_t* QN = (const bf16_t*)(a->ws + WS_QN);
    for (int rnd = 0;; ++rnd) {
        const int L = snake_unit(rnd, G, c); if (L >= 1024) { if (rnd * G >= 1024) break; else continue; }
        const int qb = 7 - (L >> 7), bh = L & 127, b = bh >> 3, hd = bh & 7, q0 = qb * 256; const size_t t0 = (size_t)b * 2048 + q0;
        if (MODE == 0) {
            const float slope = exp2f(-2.0f * (float)((hd & 3) + 1));
            attn_unit<128, 0>(WID, lds, QD + t0 * 512 + hd * 64, 512, KD + (size_t)b * 2048 * 512 + hd * 64, 512,
                              (const bf16_t*)(a->ws + WS_VAT) + (size_t)(b * 4 + (hd & 3)) * 128 * 2048, 2048, q0, slope, nullptr,
                              (bf16_t*)(a->ws + WS_OD) + t0 * 1024 + hd * 128, 1024, nullptr);
        } else if (MODE == 1 || MODE == 2) {
            const int g = hd >> 2; const float slope = exp2f(-(float)(hd + 1));
            const bf16_t* Kb = (const bf16_t*)(a->ws + (MODE == 1 ? WS_KSB : WS_KWB)) + (size_t)(b * 2 + g) * 2048 * 64;
            const bf16_t* Vb = (const bf16_t*)(a->ws + (MODE == 1 ? WS_VST : WS_VWT)) + (size_t)(b * 2 + g) * 64 * 2048;
            attn_unit<64, MODE>(WID, lds, QN + t0 * 512 + hd * 64, 512, Kb, 64, Vb, 2048, q0, slope,
                                (const unsigned*)(a->ws + WS_SELM) + (size_t)(b * 2 + g) * 2048 + q0,
                                (bf16_t*)(a->ws + (MODE == 1 ? WS_OS : WS_OW)) + t0 * 512 + hd * 64, 512, nullptr);
        } else {
            const int g = hd >> 2;
            attn_unit<96, 3>(WID, lds, QN + t0 * 512 + hd * 64, 512, (const bf16_t*)(a->ws + WS_KCMP) + (size_t)(b * 2 + g) * 128 * 64, 64,
                             (const bf16_t*)(a->ws + WS_VCMPT) + (size_t)(b * 2 + g) * 96 * 128, 128, q0, 0.f, nullptr,
                             (bf16_t*)(a->ws + WS_OC) + t0 * 512 + hd * 64, 512, (float*)(a->ws + WS_IMPH) + (t0 * 8 + hd) * 32);
        }
    }
}

constexpr int PPL = 15;
constexpr int NPHASE = 1 + DEPTH * PPL;
__global__ void __launch_bounds__(512, 2) mk_fwd(Args a_unused) {
    ArgsP a = opaque_args();
    extern __shared__ __attribute__((aligned(16))) unsigned char lds_raw[];
    LAS unsigned char* lds = (LAS unsigned char*)lds_raw;
    const int tid = threadIdx.x, G = gridDim.x, c = blockIdx.x;
    const int WID = __builtin_amdgcn_readfirstlane(tid >> 6);
    volatile LAS unsigned* misc = (volatile LAS unsigned*)(lds + MISC_OFF);
    if (tid < 4) misc[tid] = 0u;
    __syncthreads();
    unsigned* ctl = (unsigned*)(a->ws + WS_CTL);
    XcdBarrier bar; bar.bar = ctl + CW_BAR; bar.x = 0; bar.st = misc;
    const int ph_lo = a->ph_lo, ph_hi = a->ph_hi;
    const bool multi = (ph_hi - ph_lo) > 1;
    if (multi) bar = xcd_barrier_post(WID, ctl + CW_BAR, misc);
    bool first = true;
#define PHASE_BEGIN(k, id) if ((DBG_ONLY < 0 || DBG_ONLY == (id)) && (k) >= ph_lo && (k) < ph_hi && (k) <= DBG_LAST_PHASE) { if (!first) { xcd_barrier(WID, bar); if (PROBE_MASK >> 31) xcd_barrier(WID, bar); } first = false; \
        ArgsP a = opaque_args(); unsigned char* ws = a->ws; bf16_t* XN = (bf16_t*)(ws + WS_XN); float* H = a->out; const float* Hin = (layer == 0) ? a->in[I_X] : (const float*)H; \
        const LAS int* ts = (const LAS int*)(lds + MISC_OFF + MO_TS); (void)XN; (void)H; (void)Hin; (void)ts; \
        const bool probe_ = ((PROBE_MASK >> (id)) & 1u) != 0u; const unsigned long long pt0_ = probe_ ? __builtin_amdgcn_s_memrealtime() : 0ull;
#define PHASE_END if (probe_) { const unsigned long long pt1_ = __builtin_amdgcn_s_memrealtime(), pd_ = pt1_ - pt0_; while (__builtin_amdgcn_s_memrealtime() - pt1_ < pd_) __builtin_amdgcn_s_sleep(8); } }
    { const int layer = 0; PHASE_BEGIN(0, 0) phase_prologue(WID, a, lds); PHASE_END }
#pragma unroll 1
    for (int layer = 0; layer < DEPTH; ++layer) {
        const int pb = 1 + layer * PPL; const bool even = (layer & 1) == 0; const int ev = layer >> 1, od = layer >> 1;
        if (even) {
            PHASE_BEGIN(pb + 0, 1) phase_norm<0>(WID, a, lds, layer, Hin); PHASE_END
            PHASE_BEGIN(pb + 1, 2) {
                { ProbPlain P{XN, (const bf16_t*)(ws + WS_EVNAT) + (size_t)ev * 2048 * 1024, 1024, 1024, 1024}; pg8::Sched S; S.init(T / 256, 8, G, c);
                  EpiEvNat E{ws, (const float*)(ws + WS_GAINS) + ev * 256};
                  pg8::gemm_phase(WID, lds, P, S, E); }
                { ProbPlain P{(const bf16_t*)(ws + WS_EVSW) + (size_t)ev * 768 * 1024, XN, 1024, 1024, 1024}; pg8::Sched S; S.init(3, T / 256, G, c);
                  EpiEvSw E{ws};
                  pg8::gemm_phase(WID, lds, P, S, E); }
            } PHASE_END
            PHASE_BEGIN(pb + 2, 3) {
                { ProbCmp1 P{(const bf16_t*)(ws + WS_KCB), (const bf16_t*)(ws + WS_VCB), (const bf16_t*)(ws + WS_CMP1) + (size_t)ev * 2 * 256 * 2048, 1024, 2048, 2048}; pg8::Sched S; S.init(32, 1, G, c);
                  EpiCmp1 E{(bf16_t*)(ws + WS_HID), (const float*)(ws + WS_BIAS1) + ev * 512};
                  pg8::gemm_phase(WID, lds, P, S, E); }
                phase_attn<0>(WID, a, lds);
                phase_attn<2>(WID, a, lds);
            } PHASE_END
            PHASE_BEGIN(pb + 3, 4) phase_cmp2(WID, a, lds, ev); PHASE_END
            PHASE_BEGIN(pb + 4, 5) phase_attn<3>(WID, a, lds); PHASE_END
            PHASE_BEGIN(pb + 5, 6) phase_topk(WID, a); PHASE_END
            PHASE_BEGIN(pb + 6, 7) phase_attn<1>(WID, a, lds); PHASE_END
            PHASE_BEGIN(pb + 7, 8) phase_mixprep(WID, a, layer); PHASE_END
            PHASE_BEGIN(pb + 8, 9) {
                ProbPlain P{(const bf16_t*)(ws + WS_AMIX), (const bf16_t*)(ws + WS_EVOUT) + (size_t)ev * 1024 * 1024, 1024, 1024, 1024}; pg8::Sched S; S.init(T / 256, 4, G, c);
                EpiResid E{Hin, H}; pg8::gemm_phase(WID, lds, P, S, E);
            } PHASE_END
        } else {
            PHASE_BEGIN(pb + 0, 11) phase_norm<1>(WID, a, lds, layer, Hin); PHASE_END
            PHASE_BEGIN(pb + 1, 12) {
                { ProbPlain P{XN, (const bf16_t*)(ws + WS_ODNAT) + (size_t)od * 4096 * 1024, 1024, 1024, 1024}; pg8::Sched S; S.init(T / 256, 16, G, c);
                  EpiOdNat E{ws}; pg8::gemm_phase(WID, lds, P, S, E); }
                { ProbPlain P{(const bf16_t*)(ws + WS_ODSW) + (size_t)od * 3072 * 1024, XN, 1024, 1024, 1024}; pg8::Sched S; S.init(12, T / 256, G, c);
                  EpiOdSw E{ws}; pg8::gemm_phase(WID, lds, P, S, E); }
            } PHASE_END
            PHASE_BEGIN(pb + 2, 13) {
                { ProbAtt P{(const bf16_t*)(ws + WS_AQ), (const bf16_t*)(ws + WS_KP), 2048, 1024, 256}; pg8::Sched S; S.init(512, 1, G, c);
                  EpiAtt E{(bf16_t*)(ws + WS_AQ)}; pg8::gemm_phase(WID, lds, P, S, E); }
                { ProbUT P{(const bf16_t*)(ws + WS_VS), (const bf16_t*)(ws + WS_KT), 512, 256, 256}; pg8::Sched S; S.init(1024, 1, G, c);
                  EpiUT E{(float*)(ws + WS_UT)}; pg8::gemm_phase(WID, lds, P, S, E); }
            } PHASE_END
            PHASE_BEGIN(pb + 3, 14) phase_scan(WID, a); PHASE_END
            PHASE_BEGIN(pb + 4, 15) {
                ProbY P{(const bf16_t*)(ws + WS_AQ), (const bf16_t*)(ws + WS_VS), 2048, 512, 512}; pg8::Sched S; S.init(512, 2, G, c);
                EpiY E{(bf16_t*)(ws + WS_Y)}; pg8::gemm_phase(WID, lds, P, S, E);
            } PHASE_END
            PHASE_BEGIN(pb + 5, 16) phase_normgate(WID, a, od); PHASE_END
            PHASE_BEGIN(pb + 8, 19) {
                ProbPlain P{(const bf16_t*)(ws + WS_YG), (const bf16_t*)(ws + WS_ODOUT) + (size_t)od * 1024 * 2048, 2048, 2048, 2048}; pg8::Sched S; S.init(T / 256, 4, G, c);
                EpiResid E{Hin, H}; pg8::gemm_phase(WID, lds, P, S, E);
            } PHASE_END
        }
        PHASE_BEGIN(pb + 9, 20) phase_norm<2>(WID, a, lds, layer, H); PHASE_END
        PHASE_BEGIN(pb + 10, 21) phase_moe_slots(WID, a, lds, layer); PHASE_END
        PHASE_BEGIN(pb + 11, 22) {
            moe_tables(WID, a, lds, layer, -1);
            { ProbMoe8 P{(const unsigned char*)(ws + WS_XB), (const unsigned char*)(ws + WS_WGU) + (size_t)layer * 32 * 2048 * 1024, ts, 2048, 512, 512, 512}; pg8::Sched S; S.init(ts[32], 8, G, c);
              EpiGU E{(unsigned char*)(ws + WS_ACT), a->in[I_BGU] + (size_t)layer * 32 * 2048, ts}; pg8::gemm_phase(WID, lds, P, S, E); }
            { ProbPlain P{(const bf16_t*)(ws + WS_PBF) + (size_t)layer * T * 256, (const bf16_t*)(ws + WS_WPP) + (size_t)layer * 1024 * 256, 256, 256, 256}; pg8::Sched S; S.init(T / 256, 4, G, c);
              EpiPP E{(bf16_t*)(ws + WS_PP)}; pg8::gemm_phase(WID, lds, P, S, E); }
        } PHASE_END
        PHASE_BEGIN(pb + 12, 23) {
            moe_tables(WID, a, lds, layer, -1);
            ProbMoe8 P{(const unsigned char*)(ws + WS_ACT), (const unsigned char*)(ws + WS_WDN) + (size_t)layer * 32 * 1024 * 1024, ts, 1024, 512, 512, 512}; pg8::Sched S; S.init(ts[32], 4, G, c);
            EpiDN E{(bf16_t*)(ws + WS_YB), a->in[I_BDN] + (size_t)layer * 32 * 1024, ts}; pg8::gemm_phase(WID, lds, P, S, E);
        } PHASE_END
        PHASE_BEGIN(pb + 13, 24) phase_combine(WID, a, H); PHASE_END
        PHASE_BEGIN(pb + 14, 25) {
            ProbPlain P{XN, (const bf16_t*)(ws + WS_WPG) + (size_t)layer * 1024 * 1024, 1024, 1024, 1024}; pg8::Sched S; S.init(T / 256, 4, G, c);
            EpiPLE E{H, (const bf16_t*)(ws + WS_PP)}; pg8::gemm_phase(WID, lds, P, S, E);
        } PHASE_END
    }
#undef PHASE_BEGIN
#undef PHASE_END
}

extern "C" void kernel_launch(void* const* d_in, const int* in_sizes, int n_in, void* d_out, int out_size, void* d_ws, size_t ws_size, hipStream_t stream) {
    static int grid = 0;
    if (grid == 0) {
        if (n_in != 26 || out_size != T * D || ws_size < WS_END) { fprintf(stderr, "kernel_launch: unexpected problem (n_in %d, out %d, ws %zu < %zu); nothing launched\n", n_in, out_size, ws_size, (size_t)WS_END); grid = -1; return; }
        int dev = 0, cus = 0, per_cu = 0;
        if (hipGetDevice(&dev) != hipSuccess || hipDeviceGetAttribute(&cus, hipDeviceAttributeMultiprocessorCount, dev) != hipSuccess) { grid = -1; return; }
        if (hipFuncSetAttribute((const void*)mk_fwd, hipFuncAttributeMaxDynamicSharedMemorySize, LDS_BYTES) != hipSuccess) { fprintf(stderr, "kernel_launch: hipFuncSetAttribute failed\n"); grid = -1; return; }
        if (hipOccupancyMaxActiveBlocksPerMultiprocessor(&per_cu, (const void*)mk_fwd, 512, LDS_BYTES) != hipSuccess || per_cu < 1) fprintf(stderr, "kernel_launch: occupancy query reports %d\n", per_cu);
        (void)hipGetLastError();
        grid = cus > 256 ? 256 : cus;
    }
    if (grid < 0) return;
    (void)hipMemsetAsync((char*)d_ws + WS_CTL, 0, CTL_BYTES, stream);
    Args a; memset(&a, 0, sizeof(a));
    for (int i = 0; i < 26; ++i) a.in[i] = (const float*)d_in[i];
    a.out = (float*)d_out; a.ws = (unsigned char*)d_ws;
#if MK_SINGLE
    a.ph_lo = 0; a.ph_hi = NPHASE;
    hipLaunchKernelGGL(mk_fwd, dim3(grid), dim3(512), LDS_BYTES, stream, a);
#else
    for (int ph = 0; ph < NPHASE && ph <= DBG_LAST_PHASE; ++ph) {
        const int l = (ph - 1) / PPL, k = (ph - 1) % PPL;
        if (ph > 0 && (l & 1) && (k == 6 || k == 7)) continue;
        a.ph_lo = ph; a.ph_hi = ph + 1;
        hipLaunchKernelGGL(mk_fwd, dim3(grid), dim3(512), LDS_BYTES, stream, a);
    }
#endif
}
```

```cpp
#include <hip/hip_runtime.h>
#include <cstdio>
#include <cstdint>
#include <cstring>

#define LAS __attribute__((address_space(3)))
#define DI __device__ __forceinline__
typedef unsigned short bf16_t;
typedef short bf16x8 __attribute__((ext_vector_type(8)));
typedef short s16x4 __attribute__((ext_vector_type(4)));
typedef float f32x2 __attribute__((ext_vector_type(2)));
typedef float f32x4 __attribute__((ext_vector_type(4)));
typedef float f32x16 __attribute__((ext_vector_type(16)));
typedef unsigned u32x2 __attribute__((ext_vector_type(2)));
typedef unsigned u32x4 __attribute__((ext_vector_type(4)));
typedef __bf16 bfv2 __attribute__((ext_vector_type(2)));
typedef int i32x4 __attribute__((ext_vector_type(4)));
typedef int i32x8 __attribute__((ext_vector_type(8)));

#ifndef MK_SINGLE
#define MK_SINGLE 1
#endif
#ifndef DBG_ONLY
#define DBG_ONLY -1
#endif
#ifndef PROBE_MASK
#define PROBE_MASK 0u
#endif
#ifndef DBG_LAST_PHASE
#define DBG_LAST_PHASE 100000
#endif

constexpr int T = 32768, D = 1024, SEQ = 2048, NBATCH = 16, DEPTH = 4;
constexpr int EVIN = 2840, ODIN = 6144;
constexpr float EPS = 1e-6f, NEGF = -1e30f;
constexpr int NTB = 256;
constexpr int MOE_ROWS = (512 + 32) * 256;

constexpr size_t MiB = 1u << 20;
constexpr size_t WS_CTL = 0, CTL_BYTES = 1 * MiB;
constexpr int CW_BAR = 4096;
constexpr size_t WS_EVNAT = 2 * MiB, WS_EVSW = 10 * MiB, WS_EVOUT = 13 * MiB, WS_CMP1 = 17 * MiB, WS_ODNAT = 21 * MiB, WS_ODSW = 37 * MiB,
                 WS_ODOUT = 49 * MiB, WS_WPP = 57 * MiB, WS_WPG = 59 * MiB, WS_BIAS1 = 67 * MiB, WS_GAINS = 67 * MiB + 16384, WS_BCNT = 67 * MiB + 65536,
                 WS_WGU = 68 * MiB, WS_WDN = 580 * MiB;
constexpr size_t WS_XN = 840 * MiB, WS_PBF = 904 * MiB, WS_PP = 968 * MiB, WS_GATES = 1032 * MiB, WS_TOPE = 1035 * MiB, WS_POSB = 1036 * MiB,
                 WS_DEST = 1037 * MiB, WS_GATEW = 1038 * MiB, WS_SELM = 1039 * MiB;
constexpr size_t RA = 1040 * MiB;
constexpr size_t WS_QD = RA, WS_KD = RA + 32 * MiB, WS_QN = RA + 64 * MiB, WS_KCB = RA + 96 * MiB, WS_VCB = RA + 105 * MiB, WS_KSB = RA + 114 * MiB,
                 WS_KWB = RA + 122 * MiB, WS_VAT = RA + 130 * MiB, WS_VST = RA + 162 * MiB, WS_VWT = RA + 170 * MiB, WS_HID = RA + 178 * MiB,
                 WS_KCMP = RA + 182 * MiB, WS_VCMPT = RA + 183 * MiB, WS_OC = RA + 184 * MiB, WS_IMPH = RA + 216 * MiB, WS_OD = RA + 248 * MiB,
                 WS_OS = RA + 312 * MiB, WS_OW = RA + 344 * MiB, WS_AMIX = RA + 376 * MiB;
constexpr size_t WS_AQ = RA, WS_KP = RA + 128 * MiB, WS_KT = RA + 192 * MiB, WS_VS = RA + 256 * MiB, WS_GG = RA + 512 * MiB, WS_UT = RA + 640 * MiB,
                 WS_Y = RA + 896 * MiB, WS_YG = RA + 1024 * MiB;
constexpr size_t WS_XB = 2192 * MiB, WS_ACT = 2464 * MiB, WS_YB = 2736 * MiB, WS_END = 3008 * MiB;

constexpr int MISC_OFF = 139264, LDS_BYTES = 155648;
static_assert(MISC_OFF + 5888 + 4096 <= LDS_BYTES, "misc LDS words");
constexpr int MO_WCNT = 256, MO_ENT = 1280, MO_GAT = 3328, MO_TOT = 5376, MO_BASE = 5504, MO_TS = 5632, MO_RED = 5888;

DI int opaque_tid(int wid0) { int l; asm volatile("v_mbcnt_lo_u32_b32 %0, -1, 0\n\tv_mbcnt_hi_u32_b32 %0, -1, %0" : "=v"(l) :: "memory"); return (wid0 << 6) | l; }
DI unsigned pk2(float lo, float hi) { f32x2 v = {lo, hi}; return __builtin_bit_cast(unsigned, __builtin_convertvector(v, bfv2)); }
DI unsigned pk4_fp8(float a, float b, float c, float d) { int w = 0; w = __builtin_amdgcn_cvt_pk_fp8_f32(a, b, w, false); w = __builtin_amdgcn_cvt_pk_fp8_f32(c, d, w, true); return (unsigned)w; }
DI float bf2f(unsigned short b) { return __uint_as_float(((unsigned)b) << 16); }
DI float bflo(unsigned w) { return __uint_as_float(w << 16); }
DI float bfhi(unsigned w) { return __uint_as_float(w & 0xffff0000u); }
DI float wave_sum(float v) {
#pragma unroll
    for (int o = 1; o < 64; o <<= 1) v += __shfl_xor(v, o);
    return v;
}
DI float sigm(float x) { return 1.0f / (1.0f + __expf(-x)); }
DI u32x4 pack8(const f32x4& a, const f32x4& b) { u32x4 w; w.x = pk2(a[0], a[1]); w.y = pk2(a[2], a[3]); w.z = pk2(b[0], b[1]); w.w = pk2(b[2], b[3]); return w; }

#define XB_TMO      128
#define XB_XCNT(j)  (256  + 64 * (j))
#define XB_XSUB(j)  (1280 + 64 * (j))
#define XB_XGEN(j)  (2304 + 64 * (j))
#define XB_TOP      3328
#define XB_TOPGEN   3392
#define XCD_BAR_WORDS 3456
#define XB_SPIN_CAP (1u << 22)
DI unsigned xb_ld(unsigned* p)              { return __hip_atomic_load(p, __ATOMIC_RELAXED, __HIP_MEMORY_SCOPE_AGENT); }
DI unsigned xb_add(unsigned* p, unsigned v) { return __hip_atomic_fetch_add(p, v, __ATOMIC_RELAXED, __HIP_MEMORY_SCOPE_AGENT); }
DI unsigned xb_xcc_id() { return (unsigned)__builtin_amdgcn_s_getreg((3 << 11) | 20) & 0xFu; }
#define XB_SPIN(cond, bar) do { unsigned _sp = 0; while (cond) { __builtin_amdgcn_s_sleep(1); \
    if ((++_sp & 255u) == 0u) { if (xb_ld(&(bar)[XB_TMO])) break; if (_sp > XB_SPIN_CAP) { atomicAdd(&(bar)[XB_TMO], 1u); break; } } } } while (0)
struct XcdBarrier { unsigned* bar; unsigned x; volatile LAS unsigned* st; };
DI XcdBarrier xcd_barrier_post(const int WID, unsigned* bar, volatile LAS unsigned* st) {
    XcdBarrier b; b.bar = bar; b.x = xb_xcc_id(); b.st = st;
    if (opaque_tid(WID) == 0) (void)xb_add(&bar[XB_XCNT(b.x)], 1u);
    return b;
}
DI void xcd_barrier_complete(unsigned* bar, unsigned x, unsigned& nloc, unsigned& nx) {
    const unsigned G = gridDim.x * gridDim.y * gridDim.z;
    unsigned sum, cnt, mine, sp = 0u;
    for (;;) {
        sum = 0u; cnt = 0u; mine = 0u;
#pragma unroll
        for (unsigned j = 0; j < 16; ++j) { const unsigned c = xb_ld(&bar[XB_XCNT(j)]); sum += c; cnt += (c > 0u) ? 1u : 0u; mine = (j == x) ? c : mine; }
        if (sum == G) break;
        __builtin_amdgcn_s_sleep(1);
        if ((++sp & 255u) == 0u) { if (xb_ld(&bar[XB_TMO])) break; if (sp > XB_SPIN_CAP) { atomicAdd(&bar[XB_TMO], 1u); break; } }
    }
    nloc = mine > 0u ? mine : 1u; nx = cnt > 0u ? cnt : 1u;
}
DI void xcd_barrier(const int WID, const XcdBarrier& b) {
    asm volatile("s_waitcnt vmcnt(0)" ::: "memory");
    __syncthreads();
    if (opaque_tid(WID) == 0) {
        unsigned* bar = b.bar; asm volatile("" : "+s"(bar));
        __builtin_amdgcn_s_waitcnt(0);
        unsigned nloc = b.st[0], nx = b.st[1];
        if (nloc == 0u) { xcd_barrier_complete(bar, b.x, nloc, nx); b.st[0] = nloc; b.st[1] = nx; }
        const unsigned old = xb_add(&bar[XB_XSUB(b.x)], 1u);
        const unsigned gen = old / nloc;
        if (old + 1u == (gen + 1u) * nloc) {
            __builtin_amdgcn_fence(__ATOMIC_RELEASE, "agent");
            asm volatile("s_waitcnt vmcnt(0)" ::: "memory");
            const unsigned og = xb_add(&bar[XB_TOP], 1u);
            const unsigned tg = og / nx;
            if (og + 1u == (tg + 1u) * nx) xb_add(&bar[XB_TOPGEN], 1u);
            else XB_SPIN(xb_ld(&bar[XB_TOPGEN]) == tg, bar);
            __builtin_amdgcn_fence(__ATOMIC_ACQUIRE, "agent");
            xb_add(&bar[XB_XGEN(b.x)], 1u);
            asm volatile("s_waitcnt vmcnt(0)" ::: "memory");
        } else {
            XB_SPIN(xb_ld(&bar[XB_XGEN(b.x)]) == gen, bar);
            __builtin_amdgcn_fence(__ATOMIC_ACQUIRE, "agent");
            asm volatile("s_waitcnt vmcnt(0)" ::: "memory");
        }
    }
    __syncthreads();
}

namespace pg8 {
constexpr int BM = 256, BK = 64, HALF = 128, HTB = HALF * BK * 2, STAGE_BYTES = 8 * HTB, NXCD = 8, WGM = 8;
DI int lds_byte(int r, int c) { const int st = (r >> 4) * 2 + (c >> 5), rr = r & 15, cc = c & 31, ob = rr * 64 + cc * 2; return st * 1024 + (ob ^ (((ob >> 9) & 1) << 5)); }
DI void stage_rc(int b, int& R, int& C) { const int st = b / 1024, sb = b % 1024, swz = sb ^ (((sb >> 9) & 1) << 5); R = (st >> 1) * 16 + swz / 64; C = (st & 1) * 32 + (swz % 64) / 2; }
DI int perm32(int rho) { const int n = rho >> 4, i = rho & 15; return 8 * (i >> 2) + 4 * n + (i & 3); }
struct Unit { int pm, pn; };
struct Sched {
    int nM, nN, nwg, G, c;
    DI void init(int nM_, int nN_, int G_, int c_) { nM = nM_; nN = nN_; nwg = nM * nN; G = G_; c = c_; }
    DI bool next(int i, Unit& u) const {
        const long L = (long)i * G + c; if (L >= nwg) return false;
        int wgid = (int)L; { const int q = nwg / NXCD, r = nwg % NXCD, xcd = wgid % NXCD, off = wgid / NXCD; wgid = (xcd < r ? xcd * (q + 1) : r * (q + 1) + (xcd - r) * q) + off; }
        const int nig = WGM * nN, gid = wgid / nig, fm = gid * WGM, gsz = (nM - fm) < WGM ? (nM - fm) : WGM;
        u.pm = fm + ((wgid % nig) % gsz); u.pn = (wgid % nig) / gsz; return true;
    }
};
template <class Epi, class Prob>
DI void gemm_phase(const int WID, LAS unsigned char* lds, const Prob& P, const Sched& S, const Epi& E) {
    const int tid = opaque_tid(WID), wid = __builtin_amdgcn_readfirstlane(tid >> 6), lane = tid & 63, wr = wid >> 2, wc = wid & 3, fr = lane & 15, fq = lane >> 4;
    const int K = P.K, nt = K / BK;
    unsigned voffA[2], voffB[2];
#pragma unroll
    for (int i = 0; i < 2; ++i) { int R, C; stage_rc(tid * 16 + i * 8192, R, C); const int Rb = Epi::PERM ? ((R & ~31) + perm32(R & 31)) : R;
        voffA[i] = (unsigned)(R * P.lda + C) * 2u; voffB[i] = (unsigned)(Rb * P.ldb + C) * 2u; }
    const size_t kstep = (size_t)(BK * 2);
    const size_t hstepA = (size_t)HALF * P.lda * 2, hstepB = (size_t)HALF * P.ldb * 2;
    const unsigned ldsw = (unsigned)wid * 1024u;
    const int aoff = lds_byte(wr * 64 + fr, fq * 8), boff = lds_byte(wc * 32 + fr, fq * 8);
#define PG8_SA(b, h) (((b) * 2 + (h)) * HTB)
#define PG8_SB(b, h) ((4 + (b) * 2 + (h)) * HTB)
#define PG8_STAGE(bufoff, gbase, voff) do { _Pragma("unroll") for (int _i = 0; _i < 2; ++_i) \
        __builtin_amdgcn_global_load_lds((const unsigned*)((const char*)(gbase) + (voff)[_i]), (LAS unsigned*)(lds + (bufoff) + ldsw + _i * 8192), 16, 0, 0); } while (0)
#define PG8_LD16(off) (*(const LAS i32x4*)(lds + (off)))
#define PG8_LDA(dst, b, h) do { _Pragma("unroll") for (int m = 0; m < 4; ++m) { const i32x4 lo_ = PG8_LD16(PG8_SA(b, h) + aoff + m * 2048), hi_ = PG8_LD16(PG8_SA(b, h) + aoff + m * 2048 + 1024); dst[m] = __builtin_shufflevector(lo_, hi_, 0, 1, 2, 3, 4, 5, 6, 7); } } while (0)
#define PG8_LDB(dst, b, h) do { _Pragma("unroll") for (int n = 0; n < 2; ++n) { const i32x4 lo_ = PG8_LD16(PG8_SB(b, h) + boff + n * 2048), hi_ = PG8_LD16(PG8_SB(b, h) + boff + n * 2048 + 1024); dst[n] = __builtin_shufflevector(lo_, hi_, 0, 1, 2, 3, 4, 5, 6, 7); } } while (0)
#define PG8_LOH(X) __builtin_bit_cast(bf16x8, __builtin_shufflevector((X), (X), 0, 1, 2, 3))
#define PG8_HIH(X) __builtin_bit_cast(bf16x8, __builtin_shufflevector((X), (X), 4, 5, 6, 7))
#define PG8_MMA(ai, bj, At, Bt) do { __builtin_amdgcn_s_setprio(1); \
        if constexpr (Prob::FP8) { _Pragma("unroll") for (int m = 0; m < 4; ++m) _Pragma("unroll") for (int n = 0; n < 2; ++n) \
            asm volatile("v_mfma_scale_f32_16x16x128_f8f6f4 %0, %1, %2, %0, %3, %3 op_sel_hi:[0,0,0]" : "+v"(acc[ai][bj][m][n]) : "v"(Bt[n]), "v"(At[m]), "v"(sc1)); } \
        else { _Pragma("unroll") for (int m = 0; m < 4; ++m) _Pragma("unroll") for (int n = 0; n < 2; ++n) { \
            acc[ai][bj][m][n] = __builtin_amdgcn_mfma_f32_16x16x32_bf16(PG8_LOH(Bt[n]), PG8_LOH(At[m]), acc[ai][bj][m][n], 0, 0, 0); \
            acc[ai][bj][m][n] = __builtin_amdgcn_mfma_f32_16x16x32_bf16(PG8_HIH(Bt[n]), PG8_HIH(At[m]), acc[ai][bj][m][n], 0, 0, 0); } } \
        __builtin_amdgcn_s_setprio(0); } while (0)
#define PG8_WAIT_V(n) asm volatile("s_waitcnt vmcnt(" #n ")" ::: "memory")
#define PG8_WAIT_L(n) asm volatile("s_waitcnt lgkmcnt(" #n ")" ::: "memory")
#define PG8_BAR __builtin_amdgcn_s_barrier()
#define PG8_SCHED __builtin_amdgcn_sched_barrier(0)
    Unit cur, nxt; int ui = 0;
    if (!S.next(0, cur)) return;
    f32x4 acc[2][2][4][2];
#pragma unroll
    for (int a = 0; a < 2; ++a)
#pragma unroll
        for (int b = 0; b < 2; ++b)
#pragma unroll
            for (int m = 0; m < 4; ++m)
#pragma unroll
                for (int n = 0; n < 2; ++n) acc[a][b][m][n] = (f32x4){0.f, 0.f, 0.f, 0.f};
    i32x8 At[4], B0[2], B1[2];
    const int sc1 = 0x7f7f7f7f;
    const char* cA = P.a_base(cur); const char* cB = P.b_base(cur);
    PG8_STAGE(PG8_SB(0, 0), cB, voffB); PG8_STAGE(PG8_SA(0, 0), cA, voffA); PG8_STAGE(PG8_SB(0, 1), cB + hstepB, voffB); PG8_STAGE(PG8_SA(0, 1), cA + hstepA, voffA);
    if (wr == 1) PG8_BAR;
    PG8_WAIT_V(4); PG8_BAR;
    PG8_STAGE(PG8_SB(1, 0), cB + kstep, voffB); PG8_STAGE(PG8_SA(1, 0), cA + kstep, voffA); PG8_STAGE(PG8_SB(1, 1), cB + hstepB + kstep, voffB);
    PG8_WAIT_V(6); PG8_BAR;
    for (;;) {
        const bool has_next = S.next(ui + 1, nxt);
        const char* nA = has_next ? P.a_base(nxt) : cA; const char* nB = has_next ? P.b_base(nxt) : cB;
        for (int t = 0; t < nt; t += 2) {
            const bool last = (t == nt - 2);
            const char* a1 = cA + (size_t)(t + 1) * kstep;
            const char* a2 = last ? nA : cA + (size_t)(t + 2) * kstep; const char* b2 = last ? nB : cB + (size_t)(t + 2) * kstep;
            const char* a3 = a2 + kstep; const char* b3 = b2 + kstep;
            PG8_LDB(B0, 0, 0); PG8_SCHED; PG8_LDA(At, 0, 0); PG8_STAGE(PG8_SA(1, 1), a1 + hstepA, voffA);
            PG8_WAIT_L(8); PG8_BAR; PG8_WAIT_L(0); PG8_MMA(0, 0, At, B0); PG8_BAR; PG8_SCHED;
            PG8_LDB(B1, 0, 1); PG8_STAGE(PG8_SB(0, 0), b2, voffB);
            PG8_BAR; PG8_WAIT_L(0); PG8_MMA(0, 1, At, B1); PG8_BAR;
            PG8_LDA(At, 0, 1); PG8_STAGE(PG8_SA(0, 0), a2, voffA);
            PG8_BAR; PG8_WAIT_L(0); PG8_MMA(1, 0, At, B0); PG8_BAR; PG8_SCHED;
            PG8_STAGE(PG8_SB(0, 1), b2 + hstepB, voffB);
            PG8_WAIT_V(6); PG8_BAR; PG8_MMA(1, 1, At, B1); PG8_BAR;
            PG8_LDB(B0, 1, 0); PG8_SCHED; PG8_LDA(At, 1, 0); PG8_STAGE(PG8_SA(0, 1), a2 + hstepA, voffA);
            PG8_WAIT_L(8); PG8_BAR; PG8_WAIT_L(0); PG8_MMA(0, 0, At, B0); PG8_BAR; PG8_SCHED;
            PG8_LDB(B1, 1, 1); PG8_STAGE(PG8_SB(1, 0), b3, voffB);
            PG8_BAR; PG8_WAIT_L(0); PG8_MMA(0, 1, At, B1); PG8_BAR;
            PG8_LDA(At, 1, 1); PG8_STAGE(PG8_SA(1, 0), a3, voffA);
            PG8_BAR; PG8_WAIT_L(0); PG8_MMA(1, 0, At, B0); PG8_BAR; PG8_SCHED;
            PG8_STAGE(PG8_SB(1, 1), b3 + hstepB, voffB);
            PG8_WAIT_V(6); PG8_BAR; PG8_MMA(1, 1, At, B1); PG8_BAR;
        }
        if constexpr (Prob::FP8) {
            asm volatile("s_nop 15\n\ts_nop 15" ::: "memory");
#pragma unroll
            for (int a_ = 0; a_ < 2; ++a_)
#pragma unroll
                for (int b_ = 0; b_ < 2; ++b_)
#pragma unroll
                    for (int m_ = 0; m_ < 4; ++m_)
#pragma unroll
                        for (int n_ = 0; n_ < 2; ++n_) asm volatile("" : "+v"(acc[a_][b_][m_][n_]));
        }
        { int fr_ = fr, fq_ = fq, wr_ = wr, wc_ = wc; asm volatile("" : "+v"(fr_), "+v"(fq_), "+s"(wr_), "+s"(wc_));
          E(acc, cur, wr_, wc_, fr_, fq_); }
        if (!has_next) break;
#pragma unroll
        for (int a = 0; a < 2; ++a)
#pragma unroll
            for (int b = 0; b < 2; ++b)
#pragma unroll
                for (int m = 0; m < 4; ++m)
#pragma unroll
                    for (int n = 0; n < 2; ++n) acc[a][b][m][n] = (f32x4){0.f, 0.f, 0.f, 0.f};
        cur = nxt; cA = nA; cB = nB; ++ui;
    }
    PG8_WAIT_V(0);
    if (wr == 0) PG8_BAR;
    PG8_BAR;
#undef PG8_SA
#undef PG8_SB
#undef PG8_STAGE
#undef PG8_LDA
#undef PG8_LDB
#undef PG8_MMA
#undef PG8_LD16
#undef PG8_LOH
#undef PG8_HIH
#undef PG8_WAIT_V
#undef PG8_WAIT_L
#undef PG8_BAR
#undef PG8_SCHED
}
}
using pg8::Unit;
typedef f32x4 Acc[2][2][4][2];

struct ProbPlain { static constexpr bool FP8 = false; const bf16_t* A; const bf16_t* Bt; int lda, ldb, K;
    DI const char* a_base(const Unit& u) const { return (const char*)(A + (size_t)u.pm * 256 * lda); }
    DI const char* b_base(const Unit& u) const { return (const char*)(Bt + (size_t)u.pn * 256 * ldb); } };
struct ProbCmp1 { static constexpr bool FP8 = false; const bf16_t* KCB; const bf16_t* VCB; const bf16_t* W; int lda, ldb, K;
    DI const char* a_base(const Unit& u) const { const int kv = u.pm >> 4, rt = u.pm & 15; return (const char*)((kv ? VCB : KCB) + (size_t)rt * 256 * 1024); }
    DI const char* b_base(const Unit& u) const { const int kv = u.pm >> 4; return (const char*)(W + (size_t)kv * 256 * 2048); } };
struct ProbAtt { static constexpr bool FP8 = false; const bf16_t* AQ; const bf16_t* KP; int lda, ldb, K;
    DI const char* a_base(const Unit& u) const { const int z = u.pm, n = z & 7, h = (z >> 3) & 3, b = z >> 5; const size_t t0 = (size_t)b * 2048 + n * 256; return (const char*)(AQ + (t0 * 4 + h) * 512 + 256); }
    DI const char* b_base(const Unit& u) const { const int z = u.pm, n = z & 7, h = (z >> 3) & 3, b = z >> 5; const size_t t0 = (size_t)b * 2048 + n * 256; return (const char*)(KP + t0 * 1024 + h * 256); } };
struct ProbUT { static constexpr bool FP8 = false; const bf16_t* VS; const bf16_t* KT; int lda, ldb, K;
    DI const char* a_base(const Unit& u) const { const int z = u.pm >> 1, half = u.pm & 1; return (const char*)(VS + (size_t)z * 262144 + (size_t)half * 256 * 512); }
    DI const char* b_base(const Unit& u) const { const int z = u.pm >> 1; return (const char*)(KT + (size_t)z * 65536); } };
struct ProbY { static constexpr bool FP8 = false; const bf16_t* AQ; const bf16_t* VS; int lda, ldb, K;
    DI const char* a_base(const Unit& u) const { const int z = u.pm, n = z & 7, h = (z >> 3) & 3, b = z >> 5; const size_t t0 = (size_t)b * 2048 + n * 256; return (const char*)(AQ + (t0 * 4 + h) * 512); }
    DI const char* b_base(const Unit& u) const { return (const char*)(VS + (size_t)u.pm * 262144 + (size_t)u.pn * 256 * 512); } };
DI int moe_tile_expert(const LAS int* ts, int rt) { int e = 0;
#pragma unroll 8
    for (int i = 1; i < 32; ++i) e += (rt >= ts[i]) ? 1 : 0;
    return e; }
struct ProbMoe { static constexpr bool FP8 = false; const bf16_t* A; const bf16_t* W; const LAS int* ts; int nper; int lda, ldb, K;
    DI const char* a_base(const Unit& u) const { return (const char*)(A + (size_t)u.pm * 256 * 1024); }
    DI const char* b_base(const Unit& u) const { const int e = moe_tile_expert(ts, u.pm); return (const char*)(W + ((size_t)e * nper + (size_t)u.pn * 256) * 1024); } };

struct ProbMoe8 { static constexpr bool FP8 = true; const unsigned char* A; const unsigned char* W; const LAS int* ts; int nper; int lda, ldb, K;
    DI const char* a_base(const Unit& u) const { return (const char*)(A + (size_t)u.pm * 256 * 1024); }
    DI const char* b_base(const Unit& u) const { const int e = moe_tile_expert(ts, u.pm); return (const char*)(W + ((size_t)e * nper + (size_t)u.pn * 256) * 1024); } };

#define EPI_ROWS(ai, m) (128 * (ai) + 64 * wr + 16 * (m) + fr)
struct EpiEvNat { static constexpr bool PERM = true;
    unsigned char* ws; const float* gains;
    DI void operator()(const Acc& acc, const Unit& u, int wr, int wc, int fr, int fq) const {
        const int pn = u.pn; const bool norm = (pn != 6);
        const int gi = pn < 2 ? 0 : pn < 4 ? 1 : pn < 6 ? 2 : 3;
        const float* g = gains + gi * 64;
        f32x4 gv[2][2];
#pragma unroll
        for (int bj = 0; bj < 2; ++bj)
#pragma unroll
            for (int n = 0; n < 2; ++n) { const f32x4 t4 = *(const f32x4*)(g + 32 * bj + 8 * fq + 4 * n); gv[bj][n] = norm ? t4 : (f32x4){1.f, 1.f, 1.f, 1.f}; }
        size_t boff; int rowmul, hoff; bool panel = false;
        if (pn < 2) { boff = WS_QD; rowmul = 512; hoff = (pn * 4 + wc) * 64; }
        else if (pn < 4) { boff = WS_KD; rowmul = 512; hoff = ((pn - 2) * 4 + wc) * 64; }
        else if (pn < 6) { boff = WS_QN; rowmul = 512; hoff = ((pn - 4) * 4 + wc) * 64; }
        else { panel = true; rowmul = 64; hoff = 0; boff = (pn == 6) ? (wc < 2 ? WS_KCB : WS_VCB) : (wc < 2 ? WS_KSB : WS_KWB); }
        bf16_t* base = (bf16_t*)(ws + boff);
#pragma unroll
        for (int ai = 0; ai < 2; ++ai)
#pragma unroll
            for (int m = 0; m < 4; ++m) {
                const int t = u.pm * 256 + EPI_ROWS(ai, m), b = t >> 11, sq = t & 2047;
                float ss = 0.f;
#pragma unroll
                for (int bj = 0; bj < 2; ++bj)
#pragma unroll
                    for (int n = 0; n < 2; ++n) { const f32x4 x = acc[ai][bj][m][n]; ss += (x[0] * x[0] + x[1] * x[1]) + (x[2] * x[2] + x[3] * x[3]); }
                ss += __shfl_xor(ss, 16); ss += __shfl_xor(ss, 32);
                const float rstd = norm ? rsqrtf(ss * (1.0f / 64.0f) + EPS) * ((pn < 2 || pn == 4 || pn == 5) ? 0.125f : 1.0f) : 1.0f;
                const size_t rowi = panel ? ((size_t)(b * 2 + (wc & 1)) * 2048 + sq) : (size_t)t;
#pragma unroll
                for (int bj = 0; bj < 2; ++bj) {
                    const f32x4 v0 = acc[ai][bj][m][0] * rstd * gv[bj][0], v1 = acc[ai][bj][m][1] * rstd * gv[bj][1];
                    *(u32x4*)(base + rowi * rowmul + hoff + 32 * bj + 8 * fq) = pack8(v0, v1);
                }
            }
    }
};
struct EpiEvSw { static constexpr bool PERM = true;
    unsigned char* ws;
    DI void operator()(const Acc& acc, const Unit& u, int wr, int wc, int fr, int fq) const {
        const int b = u.pn >> 3, sb = (u.pn & 7) * 256;
#pragma unroll
        for (int ai = 0; ai < 2; ++ai)
#pragma unroll
            for (int m = 0; m < 4; ++m) {
                const int rl = EPI_ROWS(ai, m);
                size_t boff, rowi;
                if (u.pm < 2) { const int fg = u.pm * 256 + rl; boff = WS_VAT; rowi = (size_t)(b * 4 + (fg >> 7)) * 128 + (fg & 127); }
                else { const int r2 = rl & 127; boff = (rl < 128) ? WS_VST : WS_VWT; rowi = (size_t)(b * 2 + (r2 >> 6)) * 64 + (r2 & 63); }
                bf16_t* rowp = (bf16_t*)(ws + boff) + rowi * 2048;
#pragma unroll
                for (int bj = 0; bj < 2; ++bj) *(u32x4*)(rowp + sb + 128 * bj + 32 * wc + 8 * fq) = pack8(acc[ai][bj][m][0], acc[ai][bj][m][1]);
            }
    }
};
struct EpiCmp1 { static constexpr bool PERM = true;
    bf16_t* HID; const float* bias1;
    DI void operator()(const Acc& acc, const Unit& u, int wr, int wc, int fr, int fq) const {
        const int kv = u.pm >> 4, rt = u.pm & 15;
#pragma unroll
        for (int bj = 0; bj < 2; ++bj) {
            const int col = 128 * bj + 32 * wc + 8 * fq;
            const f32x4 b0 = *(const f32x4*)(bias1 + kv * 256 + col), b1 = *(const f32x4*)(bias1 + kv * 256 + col + 4);
#pragma unroll
            for (int ai = 0; ai < 2; ++ai)
#pragma unroll
                for (int m = 0; m < 4; ++m) {
                    f32x4 v0 = acc[ai][bj][m][0] + b0, v1 = acc[ai][bj][m][1] + b1;
#pragma unroll
                    for (int j = 0; j < 4; ++j) { v0[j] = v0[j] * sigm(v0[j]); v1[j] = v1[j] * sigm(v1[j]); }
                    *(u32x4*)(HID + ((size_t)kv * 4096 + rt * 256 + EPI_ROWS(ai, m)) * 256 + col) = pack8(v0, v1);
                }
        }
    }
};
struct EpiResid { static constexpr bool PERM = false;
    const float* Hin; float* Hout;
    DI void operator()(const Acc& acc, const Unit& u, int wr, int wc, int fr, int fq) const {
#pragma unroll
        for (int ai = 0; ai < 2; ++ai)
#pragma unroll
            for (int m = 0; m < 4; ++m) {
                const size_t off = (size_t)(u.pm * 256 + EPI_ROWS(ai, m)) * 1024 + u.pn * 256 + 32 * wc + 4 * fq;
#pragma unroll
                for (int bj = 0; bj < 2; ++bj)
#pragma unroll
                    for (int n = 0; n < 2; ++n) { const size_t o = off + 128 * bj + 16 * n; *(f32x4*)(Hout + o) = *(const f32x4*)(Hin + o) + acc[ai][bj][m][n]; }
            }
    }
};
DI float ret_lg2(int h) { return __log2f(1.0f - exp2f(-5.0f - (float)h)); }
struct EpiOdNat { static constexpr bool PERM = true;
    unsigned char* ws;
    DI void operator()(const Acc& acc, const Unit& u, int wr, int wc, int fr, int fq) const {
        const int pn = u.pn; const int h = pn & 3; const float lg = ret_lg2(h);
        const size_t boff = pn < 4 ? WS_AQ : pn < 8 ? WS_KP : WS_GG;
        const int rowmul = pn < 4 ? 2048 : pn < 8 ? 1024 : 2048;
        const int coff = pn < 4 ? (h * 512 + 256) : pn < 8 ? (h * 256) : ((pn - 8) * 256);
        bf16_t* base = (bf16_t*)(ws + boff) + coff;
#pragma unroll
        for (int ai = 0; ai < 2; ++ai)
#pragma unroll
            for (int m = 0; m < 4; ++m) {
                const int cl = EPI_ROWS(ai, m); const size_t t = (size_t)u.pm * 256 + cl;
                float sc = 1.f;
                if (pn < 4) sc = exp2f(lg * (float)(cl + 1)); else if (pn < 8) sc = 0.0625f * exp2f(-lg * (float)(cl + 1));
#pragma unroll
                for (int bj = 0; bj < 2; ++bj) {
                    const int d = 128 * bj + 32 * wc + 8 * fq;
                    f32x4 v0 = acc[ai][bj][m][0] * sc, v1 = acc[ai][bj][m][1] * sc;
                    if (pn >= 8) {
#pragma unroll
                        for (int j = 0; j < 4; ++j) { v0[j] = v0[j] * sigm(v0[j]); v1[j] = v1[j] * sigm(v1[j]); } }
                    *(u32x4*)(base + t * rowmul + d) = pack8(v0, v1);
                }
            }
    }
};
struct EpiOdSw { static constexpr bool PERM = true;
    unsigned char* ws;
    DI void operator()(const Acc& acc, const Unit& u, int wr, int wc, int fr, int fq) const {
        const int b = u.pn >> 3, n = u.pn & 7;
        const bool isk = u.pm < 4; const int h = isk ? u.pm : ((u.pm - 4) >> 1);
        const size_t z = (size_t)(b * 4 + h) * 8 + n; const float lg = ret_lg2(h);
        bf16_t* base = (bf16_t*)(ws + (isk ? WS_KT : WS_VS)) + (isk ? z * 65536 : z * 262144 + (size_t)((u.pm - 4) & 1) * 256 * 512);
        const int rowmul = isk ? 256 : 512;
#pragma unroll
        for (int bj = 0; bj < 2; ++bj) {
            const int cl = 128 * bj + 32 * wc + 8 * fq;
            f32x4 s0 = {1.f, 1.f, 1.f, 1.f}, s1 = s0;
            if (isk) {
#pragma unroll
                for (int j = 0; j < 4; ++j) { s0[j] = 0.0625f * exp2f(-lg * (float)(cl + j + 1)); s1[j] = 0.0625f * exp2f(-lg * (float)(cl + 4 + j + 1)); } }
#pragma unroll
            for (int ai = 0; ai < 2; ++ai)
#pragma unroll
                for (int m = 0; m < 4; ++m)
                    *(u32x4*)(base + (size_t)EPI_ROWS(ai, m) * rowmul + cl) = pack8(acc[ai][bj][m][0] * s0, acc[ai][bj][m][1] * s1);
        }
    }
};
struct EpiAtt { static constexpr bool PERM = true;
    bf16_t* AQ;
    DI void operator()(const Acc& acc, const Unit& u, int wr, int wc, int fr, int fq) const {
        const int z = u.pm, n = z & 7, h = (z >> 3) & 3, b = z >> 5; const size_t t0 = (size_t)b * 2048 + n * 256;
#pragma unroll
        for (int ai = 0; ai < 2; ++ai)
#pragma unroll
            for (int m = 0; m < 4; ++m) {
                const int c = EPI_ROWS(ai, m);
#pragma unroll
                for (int bj = 0; bj < 2; ++bj) {
                    const int e0 = 128 * bj + 32 * wc + 8 * fq;
                    f32x4 v0 = acc[ai][bj][m][0], v1 = acc[ai][bj][m][1];
#pragma unroll
                    for (int j = 0; j < 4; ++j) { v0[j] = (c >= e0 + j) ? v0[j] : 0.f; v1[j] = (c >= e0 + 4 + j) ? v1[j] : 0.f; }
                    *(u32x4*)(AQ + ((t0 + c) * 4 + h) * 512 + e0) = pack8(v0, v1);
                }
            }
    }
};
struct EpiUT { static constexpr bool PERM = false;
    float* UT;
    DI void operator()(const Acc& acc, const Unit& u, int wr, int wc, int fr, int fq) const {
        const size_t z = (size_t)(u.pm >> 1); const int half = u.pm & 1;
#pragma unroll
        for (int ai = 0; ai < 2; ++ai)
#pragma unroll
            for (int m = 0; m < 4; ++m) {
                float* rowp = UT + z * 131072 + (size_t)(half * 256 + EPI_ROWS(ai, m)) * 256 + 32 * wc + 4 * fq;
#pragma unroll
                for (int bj = 0; bj < 2; ++bj)
#pragma unroll
                    for (int n = 0; n < 2; ++n) *(f32x4*)(rowp + 128 * bj + 16 * n) = acc[ai][bj][m][n];
            }
    }
};
struct EpiY { static constexpr bool PERM = true;
    bf16_t* Y;
    DI void operator()(const Acc& acc, const Unit& u, int wr, int wc, int fr, int fq) const {
        const int z = u.pm, n = z & 7, h = (z >> 3) & 3, b = z >> 5; const size_t t0 = (size_t)b * 2048 + n * 256;
#pragma unroll
        for (int ai = 0; ai < 2; ++ai)
#pragma unroll
            for (int m = 0; m < 4; ++m) {
                bf16_t* rowp = Y + (t0 + EPI_ROWS(ai, m)) * 2048 + h * 512 + u.pn * 256 + 32 * wc + 8 * fq;
#pragma unroll
                for (int bj = 0; bj < 2; ++bj) *(u32x4*)(rowp + 128 * bj) = pack8(acc[ai][bj][m][0], acc[ai][bj][m][1]);
            }
    }
};
constexpr float W8_SCALE = 32.0f, WSC = 1.0f / W8_SCALE;
struct EpiGU { static constexpr bool PERM = true;
    unsigned char* ACT; const float* bgu; const LAS int* ts;
    DI void operator()(const Acc& acc, const Unit& u, int wr, int wc, int fr, int fq) const {
        const int e = moe_tile_expert(ts, u.pm); const int w = 32 * wc + 8 * fq;
        const float* bp = bgu + (size_t)e * 2048 + 128 * u.pn + w;
        const f32x4 bg0 = *(const f32x4*)bp, bg1 = *(const f32x4*)(bp + 4), bl0 = *(const f32x4*)(bp + 1024), bl1 = *(const f32x4*)(bp + 1028);
#pragma unroll
        for (int ai = 0; ai < 2; ++ai)
#pragma unroll
            for (int m = 0; m < 4; ++m) {
                f32x4 g0 = acc[ai][0][m][0] * WSC + bg0, g1 = acc[ai][0][m][1] * WSC + bg1, l0 = acc[ai][1][m][0] * WSC + bl0, l1 = acc[ai][1][m][1] * WSC + bl1;
#pragma unroll
                for (int j = 0; j < 4; ++j) {
                    const float a = fminf(g0[j], 7.0f), c = fminf(g1[j], 7.0f);
                    const float la = fminf(fmaxf(l0[j], -7.0f), 7.0f), lc = fminf(fmaxf(l1[j], -7.0f), 7.0f);
                    g0[j] = a * sigm(1.702f * a) * (la + 1.0f); g1[j] = c * sigm(1.702f * c) * (lc + 1.0f); }
                u32x2 o8; o8.x = pk4_fp8(g0[0], g0[1], g0[2], g0[3]); o8.y = pk4_fp8(g1[0], g1[1], g1[2], g1[3]);
                *(u32x2*)(ACT + ((size_t)u.pm * 256 + EPI_ROWS(ai, m)) * 1024 + 128 * u.pn + w) = o8;
            }
    }
};
struct EpiDN { static constexpr bool PERM = true;
    bf16_t* YB; const float* bdn; const LAS int* ts;
    DI void operator()(const Acc& acc, const Unit& u, int wr, int wc, int fr, int fq) const {
        const int e = moe_tile_expert(ts, u.pm);
#pragma unroll
        for (int bj = 0; bj < 2; ++bj) {
            const int col = 256 * u.pn + 128 * bj + 32 * wc + 8 * fq;
            const f32x4 b0 = *(const f32x4*)(bdn + (size_t)e * 1024 + col), b1 = *(const f32x4*)(bdn + (size_t)e * 1024 + col + 4);
#pragma unroll
            for (int ai = 0; ai < 2; ++ai)
#pragma unroll
                for (int m = 0; m < 4; ++m)
                    *(u32x4*)(YB + ((size_t)u.pm * 256 + EPI_ROWS(ai, m)) * 1024 + col) = pack8(acc[ai][bj][m][0] * (1.0f / 64.0f) + b0, acc[ai][bj][m][1] * (1.0f / 64.0f) + b1);
        }
    }
};
struct EpiPP { static constexpr bool PERM = true;
    bf16_t* PP;
    DI void operator()(const Acc& acc, const Unit& u, int wr, int wc, int fr, int fq) const {
#pragma unroll
        for (int ai = 0; ai < 2; ++ai)
#pragma unroll
            for (int m = 0; m < 4; ++m) {
                bf16_t* rowp = PP + ((size_t)u.pm * 256 + EPI_ROWS(ai, m)) * 1024 + u.pn * 256 + 32 * wc + 8 * fq;
#pragma unroll
                for (int bj = 0; bj < 2; ++bj) *(u32x4*)(rowp + 128 * bj) = pack8(acc[ai][bj][m][0], acc[ai][bj][m][1]);
            }
    }
};
struct EpiPLE { static constexpr bool PERM = false;
    float* H; const bf16_t* PP;
    DI void operator()(const Acc& acc, const Unit& u, int wr, int wc, int fr, int fq) const {
#pragma unroll
        for (int ai = 0; ai < 2; ++ai)
#pragma unroll
            for (int m = 0; m < 4; ++m) {
                const size_t off = (size_t)(u.pm * 256 + EPI_ROWS(ai, m)) * 1024 + u.pn * 256 + 32 * wc + 4 * fq;
#pragma unroll
                for (int bj = 0; bj < 2; ++bj)
#pragma unroll
                    for (int n = 0; n < 2; ++n) {
                        const size_t o = off + 128 * bj + 16 * n;
                        const u32x2 pw = *(const u32x2*)(PP + o); const f32x4 a = acc[ai][bj][m][n]; f32x4 hv = *(const f32x4*)(H + o);
                        hv[0] += sigm(a[0]) * bflo(pw.x); hv[1] += sigm(a[1]) * bfhi(pw.x); hv[2] += sigm(a[2]) * bflo(pw.y); hv[3] += sigm(a[3]) * bfhi(pw.y);
                        *(f32x4*)(H + o) = hv;
                    }
            }
    }
};

constexpr int AT_KSTR = 144;
template <int DV, int MODE>
DI void attn_unit(const int WID, LAS unsigned char* lds, const bf16_t* Qp, int ldq, const bf16_t* Kp, int ldk, const bf16_t* Vt, int ldvt, int q0, float slope, int dcut,
                  const unsigned* selp, bf16_t* Op, int ldo, float* impp) {
    constexpr int NRB = DV / 32, VPIECES = DV * 8;
    constexpr int KB0 = 0, KB1 = 64 * AT_KSTR, VB0 = 2 * 64 * AT_KSTR, VB1 = VB0 + DV * AT_KSTR;
    const int tid = opaque_tid(WID), w = __builtin_amdgcn_readfirstlane(tid >> 6), lane = tid & 63, r = lane & 31, hh = lane >> 5;
    const int qrow = q0 + 32 * w + r, qw_first = q0 + 32 * w, qw_last = qw_first + 31;
    const float LOG2E = 1.44269504089f;
    bf16x8 qf[4];
#pragma unroll
    for (int ks = 0; ks < 4; ++ks) qf[ks] = *(const bf16x8*)(Qp + (size_t)(32 * w + r) * ldq + 16 * ks + 8 * hh);
    unsigned selm = 0xffffffffu, orm = 0xffffffffu;
    if (MODE == 1) { selm = selp[32 * w + r]; orm = selm;
#pragma unroll
        for (int o = 1; o < 32; o <<= 1) orm |= __shfl_xor(orm, o); }
    const int nv = (MODE == 3) ? (qrow >= 31 ? ((qrow - 15) >> 4) : 0) : 0;
    const int nv_wmax = (MODE == 3) ? (qw_last >= 31 ? ((qw_last - 15) >> 4) : 0) : 0;
    int kt_lo = 0, kt_hi;
    if (MODE == 0 || MODE == 1) kt_hi = (q0 >> 6) + 4;
    else if (MODE == 2) { kt_hi = (q0 >> 6) + 4; const int lk = q0 - 511; kt_lo = lk > 0 ? (lk >> 6) : 0; }
    else kt_hi = 2;
    if (MODE != 3) { const int kmin = q0 - dcut; const int lo2 = kmin > 0 ? (kmin >> 6) : 0; kt_lo = lo2 > kt_lo ? lo2 : kt_lo; }
    f32x16 cb[2];
#pragma unroll
    for (int kk = 0; kk < 2; ++kk)
#pragma unroll
        for (int i = 0; i < 16; ++i) cb[kk][i] = (MODE == 3) ? 0.f : slope * (float)(32 * kk + 8 * (i >> 2) + (i & 3) + 4 * hh);
    f32x16 O[NRB];
#pragma unroll
    for (int rb = 0; rb < NRB; ++rb)
#pragma unroll
        for (int i = 0; i < 16; ++i) O[rb][i] = 0.f;
    float mrun = NEGF, lrun = 0.f;
    u32x4 kreg, vreg[2];
    const int krow = tid >> 3, kpc = tid & 7;
#define AT_GLOAD(kt) do { kreg = *(const u32x4*)(Kp + (size_t)(64 * (kt) + krow) * ldk + 8 * kpc); \
        _Pragma("unroll") for (int i_ = 0; i_ < 2; ++i_) { const int idx = tid + 512 * i_; if (idx < VPIECES) vreg[i_] = *(const u32x4*)(Vt + (size_t)(idx >> 3) * ldvt + 64 * (kt) + 8 * (idx & 7)); } } while (0)
#define AT_LWRITE(buf) do { *(LAS u32x4*)(lds + ((buf) ? KB1 : KB0) + krow * AT_KSTR + kpc * 16) = kreg; \
        _Pragma("unroll") for (int i_ = 0; i_ < 2; ++i_) { const int idx = tid + 512 * i_; if (idx < VPIECES) { const int p_ = idx & 7; \
            LAS unsigned char* d_ = lds + ((buf) ? VB1 : VB0) + (idx >> 3) * AT_KSTR + (p_ >> 1) * 32 + (p_ & 1) * 8; \
            *(LAS u32x2*)d_ = (u32x2){vreg[i_].x, vreg[i_].y}; *(LAS u32x2*)(d_ + 16) = (u32x2){vreg[i_].z, vreg[i_].w}; } } } while (0)
    AT_GLOAD(kt_hi - 1); AT_LWRITE(0);
    __syncthreads();
    const int ntile = kt_hi - kt_lo;
    for (int it = 0; it < ntile; ++it) {
        const int kt = kt_hi - 1 - it, buf = it & 1, key0 = 64 * kt;
        if (it + 1 < ntile) AT_GLOAD(kt - 1);
        bool skip;
        if (MODE == 0) skip = key0 > qw_last;
        else if (MODE == 1) skip = (key0 > qw_last) || !((orm >> kt) & 1u);
        else if (MODE == 2) skip = (key0 > qw_last) || (key0 + 63 < qw_first - 511);
        else skip = key0 >= nv_wmax;
        if (!skip) {
            const LAS unsigned char* kb = lds + (buf ? KB1 : KB0); const LAS unsigned char* vb = lds + (buf ? VB1 : VB0);
            f32x16 S[2];
#pragma unroll
            for (int kk = 0; kk < 2; ++kk) {
                S[kk] = cb[kk];
#pragma unroll
                for (int ks = 0; ks < 4; ++ks) { const bf16x8 a = *(const LAS bf16x8*)(kb + (32 * kk + r) * AT_KSTR + (16 * ks + 8 * hh) * 2);
                    S[kk] = __builtin_amdgcn_mfma_f32_32x32x16_bf16(a, qf[ks], S[kk], 0, 0, 0); }
            }
            const bool bnd = (MODE == 3) ? true : ((key0 + 63 > qw_first) || (MODE == 2 && key0 < qw_last - 511));
            if (bnd) {
                const int lim = (MODE == 3) ? (nv - key0 - 4 * hh) : (qrow - key0 - 4 * hh);
#pragma unroll
                for (int kk = 0; kk < 2; ++kk)
#pragma unroll
                    for (int i = 0; i < 16; ++i) { const int cki = 32 * kk + 8 * (i >> 2) + (i & 3);
                        bool valid;
                        if (MODE == 3) valid = cki < lim; else if (MODE == 2) valid = (cki <= lim) && (cki > lim - 512); else valid = cki <= lim;
                        S[kk][i] = valid ? S[kk][i] : NEGF; }
            }
            float mx = NEGF;
#pragma unroll
            for (int kk = 0; kk < 2; ++kk)
#pragma unroll
                for (int i = 0; i < 16; ++i) mx = fmaxf(mx, S[kk][i]);
            mx = fmaxf(mx, __shfl_xor(mx, 32));
            const float off = (MODE == 3) ? 0.f : slope * (float)key0;
            mx += off;
            bool selok = true;
            if (MODE == 1) { selok = ((selm >> kt) & 1u) != 0u; mx = selok ? mx : NEGF; }
            const float mnew = fmaxf(mrun, mx);
            const float meff = (mnew < -1e29f) ? 0.f : mnew;
            float c = (off - meff) * LOG2E;
            if (MODE == 1) c = selok ? c : NEGF;
            float ps = 0.f;
#pragma unroll
            for (int kk = 0; kk < 2; ++kk)
#pragma unroll
                for (int i = 0; i < 16; ++i) { const float p = __builtin_amdgcn_exp2f(__builtin_fmaf(S[kk][i], LOG2E, c)); S[kk][i] = p; ps += p; }
            if (__any(mnew > mrun)) {
                const float alpha = __builtin_amdgcn_exp2f((mrun - mnew) * LOG2E);
                lrun *= alpha;
#pragma unroll
                for (int rb = 0; rb < NRB; ++rb)
#pragma unroll
                    for (int i = 0; i < 16; ++i) O[rb][i] *= alpha;
            }
            mrun = mnew; lrun += ps;
#pragma unroll
            for (int kk = 0; kk < 2; ++kk)
#pragma unroll
                for (int s2 = 0; s2 < 2; ++s2) {
                    u32x4 pw; pw.x = pk2(S[kk][8 * s2 + 0], S[kk][8 * s2 + 1]); pw.y = pk2(S[kk][8 * s2 + 2], S[kk][8 * s2 + 3]);
                    pw.z = pk2(S[kk][8 * s2 + 4], S[kk][8 * s2 + 5]); pw.w = pk2(S[kk][8 * s2 + 6], S[kk][8 * s2 + 7]);
                    const bf16x8 pf = __builtin_bit_cast(bf16x8, pw);
#pragma unroll
                    for (int rb = 0; rb < NRB; ++rb) {
                        const bf16x8 a = *(const LAS bf16x8*)(vb + (32 * rb + r) * AT_KSTR + (2 * kk + s2) * 32 + hh * 16);
                        O[rb] = __builtin_amdgcn_mfma_f32_32x32x16_bf16(a, pf, O[rb], 0, 0, 0);
                    }
                }
        }
        if (it + 1 < ntile) AT_LWRITE(buf ^ 1);
        __syncthreads();
    }
#undef AT_GLOAD
#undef AT_LWRITE
    const float ltot = lrun + __shfl_xor(lrun, 32);
    float inv = 1.0f / ltot;
    if (MODE == 3) inv = (nv > 0) ? inv : 0.f;
#pragma unroll
    for (int rb = 0; rb < NRB; ++rb)
#pragma unroll
        for (int g4 = 0; g4 < 4; ++g4) {
            const float a = O[rb][4 * g4] * inv, b = O[rb][4 * g4 + 1] * inv, c = O[rb][4 * g4 + 2] * inv, d = O[rb][4 * g4 + 3] * inv;
            const int dv = 32 * rb + 8 * g4 + 4 * hh;
            if (MODE == 3 && rb == 2) { *(f32x4*)(impp + (size_t)(32 * w + r) * 256 + (dv - 64)) = (f32x4){a, b, c, d}; }
            else { u32x2 o; o.x = pk2(a, b); o.y = pk2(c, d); *(u32x2*)(Op + (size_t)(32 * w + r) * ldo + dv) = o; }
        }
}

struct Args { const float* in[26]; float* out; unsigned char* ws; int ph_lo, ph_hi; };
typedef const __attribute__((address_space(4))) Args* ArgsP;
DI ArgsP opaque_args() { auto p = __builtin_amdgcn_kernarg_segment_ptr(); asm volatile("" : "+s"(p)); return (ArgsP)p; }
enum { I_X = 0, I_P, I_N1G, I_N2G, I_EVWIN, I_EVWOUT, I_DAQN, I_DAKN, I_DALAM, I_DAOUTG, I_NSQN, I_NSKN, I_CMPPE, I_CMPW1, I_CMPW2, I_ODWIN, I_ODWOUT,
       I_RETG, I_ROUTW, I_ROUTB, I_WGU, I_BGU, I_WDN, I_BDN, I_PLEP, I_PLEG };

struct CvtJob { int in_idx, ldsrc, K, col0, ncols, dstrow0, perm, nmat; size_t src_stride, dst_off, dst_stride; int fp8, pad; };
constexpr int NJOBS = 19;
__constant__ CvtJob c_jobs[NJOBS] = {
    {I_EVWIN, EVIN, 1024, 0,    1024, 0,    1, 2, (size_t)1024 * EVIN, WS_EVNAT, (size_t)2048 * 1024, 0, 0},
    {I_EVWIN, EVIN, 1024, 1536, 512,  1024, 1, 2, (size_t)1024 * EVIN, WS_EVNAT, (size_t)2048 * 1024, 0, 0},
    {I_EVWIN, EVIN, 1024, 2048, 128,  1536, 1, 2, (size_t)1024 * EVIN, WS_EVNAT, (size_t)2048 * 1024, 0, 0},
    {I_EVWIN, EVIN, 1024, 2176, 128,  1664, 1, 2, (size_t)1024 * EVIN, WS_EVNAT, (size_t)2048 * 1024, 0, 0},
    {I_EVWIN, EVIN, 1024, 2304, 128,  1792, 1, 2, (size_t)1024 * EVIN, WS_EVNAT, (size_t)2048 * 1024, 0, 0},
    {I_EVWIN, EVIN, 1024, 2560, 128,  1920, 1, 2, (size_t)1024 * EVIN, WS_EVNAT, (size_t)2048 * 1024, 0, 0},
    {I_EVWIN, EVIN, 1024, 1024, 512,  0,    0, 2, (size_t)1024 * EVIN, WS_EVSW,  (size_t)768 * 1024, 0, 0},
    {I_EVWIN, EVIN, 1024, 2432, 128,  512,  0, 2, (size_t)1024 * EVIN, WS_EVSW,  (size_t)768 * 1024, 0, 0},
    {I_EVWIN, EVIN, 1024, 2688, 128,  640,  0, 2, (size_t)1024 * EVIN, WS_EVSW,  (size_t)768 * 1024, 0, 0},
    {I_EVWOUT, 1024, 1024, 0, 1024, 0, 0, 2, (size_t)1024 * 1024, WS_EVOUT, (size_t)1024 * 1024, 0, 0},
    {I_CMPW1, 256, 2048, 0, 256, 0, 0, 4, (size_t)2048 * 256, WS_CMP1, (size_t)256 * 2048, 0, 0},
    {I_ODWIN, ODIN, 1024, 0,    2048, 0,    0, 2, (size_t)1024 * ODIN, WS_ODNAT, (size_t)4096 * 1024, 0, 0},
    {I_ODWIN, ODIN, 1024, 4096, 2048, 2048, 0, 2, (size_t)1024 * ODIN, WS_ODNAT, (size_t)4096 * 1024, 0, 0},
    {I_ODWIN, ODIN, 1024, 1024, 3072, 0,    0, 2, (size_t)1024 * ODIN, WS_ODSW,  (size_t)3072 * 1024, 0, 0},
    {I_ODWOUT, 1024, 2048, 0, 1024, 0, 0, 2, (size_t)2048 * 1024, WS_ODOUT, (size_t)1024 * 2048, 0, 0},
    {I_WGU, 2048, 1024, 0, 2048, 0, 2, 128, (size_t)1024 * 2048, WS_WGU, (size_t)2048 * 1024, 32, 0},
    {I_WDN, 1024, 1024, 0, 1024, 0, 0, 128, (size_t)1024 * 1024, WS_WDN, (size_t)1024 * 1024, 64, 0},
    {I_PLEP, 1024, 256, 0, 1024, 0, 0, 4, (size_t)256 * 1024, WS_WPP, (size_t)1024 * 256, 0, 0},
    {I_PLEG, 1024, 1024, 0, 1024, 0, 0, 4, (size_t)1024 * 1024, WS_WPG, (size_t)1024 * 1024, 0, 0},
};
DI int cvt_dstrow(int perm, int L) {
    if (perm == 1) { const int pn = L >> 8, lc = L & 255; return pn * 256 + 128 * ((lc & 63) >> 5) + 32 * (lc >> 6) + (lc & 31); }
    if (perm == 2) { const int bj = L >> 10, cc = L & 1023; return 256 * (cc >> 7) + 128 * bj + (cc & 127); }
    return L;
}
DI void phase_prologue(const int WID, ArgsP a, LAS unsigned char* lds) {
    const int tid = opaque_tid(WID), lane = tid & 63, wv = tid >> 6;
    const int gw = blockIdx.x * 8 + wv, NGW = gridDim.x * 8;
    LAS float* scr = (LAS float*)(lds + wv * 16640);
    int total = 0;
    for (int j = 0; j < NJOBS; ++j) total += c_jobs[j].nmat * (c_jobs[j].K >> 6) * (c_jobs[j].ncols >> 6);
    for (int it = gw; it < total; it += NGW) {
        int r = it, j = 0;
        for (; j < NJOBS; ++j) { const int n = c_jobs[j].nmat * (c_jobs[j].K >> 6) * (c_jobs[j].ncols >> 6); if (r < n) break; r -= n; }
        const CvtJob J = c_jobs[j];
        const int nkb = J.K >> 6, nnb = J.ncols >> 6, per = nkb * nnb;
        const int mat = r / per, rr = r % per, kb = rr / nnb, nb = rr % nnb, k0 = kb * 64, n0 = nb * 64;
        const float* src = a->in[J.in_idx] + (size_t)mat * J.src_stride + (size_t)k0 * J.ldsrc + J.col0 + n0 + lane;
        { float tv[64];
#pragma unroll
          for (int i = 0; i < 64; ++i) tv[i] = src[(size_t)i * J.ldsrc];
#pragma unroll
          for (int i = 0; i < 64; ++i) scr[i * 65 + lane] = tv[i]; }
        asm volatile("s_waitcnt lgkmcnt(0)" ::: "memory");
        if (J.fp8) {
            unsigned char* dst = (unsigned char*)(a->ws + J.dst_off) + (size_t)mat * J.dst_stride;
            const int c = lane & 3, nsub = lane >> 2; const float W8_S = (float)J.fp8;
#pragma unroll
            for (int jj = 0; jj < 4; ++jj) {
                const int n = nsub + 16 * jj; const LAS float* s = scr + (16 * c) * 65 + n;
                u32x4 o;
                o.x = pk4_fp8(s[0] * W8_S, s[65] * W8_S, s[2 * 65] * W8_S, s[3 * 65] * W8_S); o.y = pk4_fp8(s[4 * 65] * W8_S, s[5 * 65] * W8_S, s[6 * 65] * W8_S, s[7 * 65] * W8_S);
                o.z = pk4_fp8(s[8 * 65] * W8_S, s[9 * 65] * W8_S, s[10 * 65] * W8_S, s[11 * 65] * W8_S); o.w = pk4_fp8(s[12 * 65] * W8_S, s[13 * 65] * W8_S, s[14 * 65] * W8_S, s[15 * 65] * W8_S);
                const int drow = cvt_dstrow(J.perm, J.dstrow0 + n0 + n);
                *(u32x4*)(dst + (size_t)drow * J.K + k0 + 16 * c) = o;
            }
        } else {
        bf16_t* dst = (bf16_t*)(a->ws + J.dst_off) + (size_t)mat * J.dst_stride;
        const int c = lane & 7, nsub = lane >> 3;
#pragma unroll
        for (int jj = 0; jj < 8; ++jj) {
            const int n = nsub + 8 * jj; const LAS float* s = scr + (8 * c) * 65 + n;
            u32x4 o; o.x = pk2(s[0], s[65]); o.y = pk2(s[2 * 65], s[3 * 65]); o.z = pk2(s[4 * 65], s[5 * 65]); o.w = pk2(s[6 * 65], s[7 * 65]);
            const int drow = cvt_dstrow(J.perm, J.dstrow0 + n0 + n);
            *(u32x4*)(dst + (size_t)drow * J.K + k0 + 8 * c) = o;
        }
        }
        asm volatile("s_waitcnt lgkmcnt(0)" ::: "memory");
    }
    {
        const float* p = a->in[I_P]; bf16_t* pb = (bf16_t*)(a->ws + WS_PBF);
        const size_t n8 = (size_t)DEPTH * T * 256 / 8;
        for (size_t i = (size_t)blockIdx.x * 512 + tid; i < n8; i += (size_t)gridDim.x * 512) {
            const f32x4 v0 = *(const f32x4*)(p + i * 8), v1 = *(const f32x4*)(p + i * 8 + 4);
            *(u32x4*)(pb + i * 8) = pack8(v0, v1);
        }
    }
    if (blockIdx.x == 4 && tid < 512) { const int ev = tid >> 8, gi = (tid >> 6) & 3, d = tid & 63;
        const float* src = a->in[gi == 0 ? I_DAQN : gi == 1 ? I_DAKN : gi == 2 ? I_NSQN : I_NSKN];
        ((float*)(a->ws + WS_GAINS))[tid] = src[ev * 64 + d]; }
    if (blockIdx.x < 4 && tid < 256) {
        const int m = blockIdx.x; const float* pe = a->in[I_CMPPE] + (size_t)m * 2048; const float* w1 = a->in[I_CMPW1] + (size_t)m * 2048 * 256;
        float s = 0.f;
        for (int k = 0; k < 2048; ++k) s += pe[k] * w1[(size_t)k * 256 + tid];
        ((float*)(a->ws + WS_BIAS1))[m * 256 + tid] = s;
    }
}

DI float row_load_ss(const float* row, int lane, f32x4 (&v)[4]) {
    float ss = 0.f;
#pragma unroll
    for (int j = 0; j < 4; ++j) { v[j] = *(const f32x4*)(row + 4 * lane + 256 * j); ss += (v[j][0] * v[j][0] + v[j][1] * v[j][1]) + (v[j][2] * v[j][2] + v[j][3] * v[j][3]); }
    return wave_sum(ss);
}
DI void row_store_bf16(bf16_t* row, int lane, const f32x4 (&v)[4]) {
#pragma unroll
    for (int j = 0; j < 4; ++j) { u32x2 o; o.x = pk2(v[j][0], v[j][1]); o.y = pk2(v[j][2], v[j][3]); *(u32x2*)(row + 4 * lane + 256 * j) = o; }
}
template <int MODE>
DI void phase_norm(const int WID, ArgsP a, LAS unsigned char* lds, int layer, const float* Hin) {
    const int tid = opaque_tid(WID), lane = tid & 63, wv = __builtin_amdgcn_readfirstlane(tid >> 6);
    LAS float* wt = (LAS float*)lds;
    LAS int* bcl = (LAS int*)(lds + MISC_OFF + MO_WCNT); LAS int* ent = (LAS int*)(lds + MISC_OFF + MO_ENT); LAS float* gat = (LAS float*)(lds + MISC_OFF + MO_GAT);
    LAS float* lgb = (LAS float*)(lds + MISC_OFF + MO_RED);
    bf16_t* XN = (bf16_t*)(a->ws + WS_XN);
    const float* gain = a->in[MODE == 2 ? I_N2G : I_N1G] + layer * 1024;
    constexpr int NQ = MODE == 0 ? 24 : (MODE == 2 ? 32 : 0);
    if (NQ > 0) {
        const float* w = (MODE == 0) ? a->in[I_EVWIN] + (size_t)(layer >> 1) * 1024 * EVIN + 2816 : a->in[I_ROUTW] + (size_t)layer * 1024 * 32;
        const int ldw = (MODE == 0) ? EVIN : 32;
        for (int i = tid; i < 256 * 32; i += 512) { const int q = i & 31, g = i >> 5;
            if (q < NQ) { f32x4 v; v[0] = w[(size_t)(4 * g) * ldw + q]; v[1] = w[(size_t)(4 * g + 1) * ldw + q]; v[2] = w[(size_t)(4 * g + 2) * ldw + q]; v[3] = w[(size_t)(4 * g + 3) * ldw + q];
                *(LAS f32x4*)(wt + q * 1024 + 4 * (g ^ q)) = v; } }
    }
    f32x4 gn[4];
#pragma unroll
    for (int j = 0; j < 4; ++j) gn[j] = *(const f32x4*)(gain + 4 * lane + 256 * j);
    const float rbias = (MODE == 2) ? a->in[I_ROUTB][layer * 32 + (lane & 31)] : 0.f;
    __syncthreads();
    for (int vb = blockIdx.x; vb < NTB; vb += gridDim.x) {
        if (MODE == 2) { if (tid < 32) bcl[tid] = 0; }
        const int t0 = vb * 128 + wv * 16;
        f32x4 na[4], nb[4];
#pragma unroll
        for (int j = 0; j < 4; ++j) { na[j] = *(const f32x4*)(Hin + (size_t)t0 * 1024 + 4 * lane + 256 * j); nb[j] = *(const f32x4*)(Hin + (size_t)(t0 + 1) * 1024 + 4 * lane + 256 * j); }
#pragma unroll 1
        for (int it = 0; it < 8; ++it) {
            const int ta = t0 + 2 * it;
            f32x4 va[4], vc[4];
#pragma unroll
            for (int j = 0; j < 4; ++j) { va[j] = na[j]; vc[j] = nb[j]; }
            if (it < 7) {
#pragma unroll
                for (int j = 0; j < 4; ++j) { na[j] = *(const f32x4*)(Hin + (size_t)(ta + 2) * 1024 + 4 * lane + 256 * j); nb[j] = *(const f32x4*)(Hin + (size_t)(ta + 3) * 1024 + 4 * lane + 256 * j); }
            }
            float sa = 0.f, sb = 0.f;
#pragma unroll
            for (int j = 0; j < 4; ++j) { sa += (va[j][0] * va[j][0] + va[j][1] * va[j][1]) + (va[j][2] * va[j][2] + va[j][3] * va[j][3]); sb += (vc[j][0] * vc[j][0] + vc[j][1] * vc[j][1]) + (vc[j][2] * vc[j][2] + vc[j][3] * vc[j][3]); }
#pragma unroll
            for (int o = 1; o < 64; o <<= 1) { sa += __shfl_xor(sa, o); sb += __shfl_xor(sb, o); }
            const float ra = rsqrtf(sa * (1.0f / 1024.0f) + EPS), rb2 = rsqrtf(sb * (1.0f / 1024.0f) + EPS);
#pragma unroll
            for (int j = 0; j < 4; ++j) { va[j] = va[j] * ra * gn[j]; vc[j] = vc[j] * rb2 * gn[j]; }
            row_store_bf16(XN + (size_t)ta * 1024, lane, va); row_store_bf16(XN + (size_t)(ta + 1) * 1024, lane, vc);
            if (NQ > 0) {
                float x[64];
#pragma unroll
                for (int q = 0; q < 32; ++q) {
                    if (q < NQ) { float s0 = 0.f, s1 = 0.f;
#pragma unroll
                        for (int j = 0; j < 4; ++j) { const f32x4 ww = *(const LAS f32x4*)(wt + q * 1024 + 4 * ((lane + 64 * j) ^ q));
                            s0 += (va[j][0] * ww[0] + va[j][1] * ww[1]) + (va[j][2] * ww[2] + va[j][3] * ww[3]); s1 += (vc[j][0] * ww[0] + vc[j][1] * ww[1]) + (vc[j][2] * ww[2] + vc[j][3] * ww[3]); }
                        x[q] = s0; x[32 + q] = s1;
                        if ((q & 3) == 3) asm volatile("" ::: "memory");
                    } else { x[q] = 0.f; x[32 + q] = 0.f; }
                }
#define RS_STEP(N, BIT) _Pragma("unroll") for (int i = 0; i < (N); ++i) { const bool up = (lane & (BIT)) != 0; const float keep = up ? x[(N) + i] : x[i], send = up ? x[i] : x[(N) + i]; x[i] = keep + __shfl_xor(send, (BIT)); }
                RS_STEP(32, 32) RS_STEP(16, 16) RS_STEP(8, 8) RS_STEP(4, 4) RS_STEP(2, 2) RS_STEP(1, 1)
#undef RS_STEP
                const float val = x[0];
                if (MODE == 0) { if ((lane & 31) < 24) ((float*)(a->ws + WS_GATES))[(size_t)(ta + (lane >> 5)) * 24 + (lane & 31)] = sigm(val); }
                if (MODE == 2) {
                    lgb[wv * 64 + lane] = val + rbias;
                    asm volatile("s_waitcnt lgkmcnt(0)" ::: "memory");
                    float lg[32];
#pragma unroll
                    for (int q4 = 0; q4 < 8; ++q4) { const f32x4 t4 = *(const LAS f32x4*)(lgb + wv * 64 + (lane & 32) + 4 * q4); lg[4 * q4] = t4[0]; lg[4 * q4 + 1] = t4[1]; lg[4 * q4 + 2] = t4[2]; lg[4 * q4 + 3] = t4[3]; }
                    unsigned used = 0u; int te[4]; float tv[4];
#pragma unroll
                    for (int k = 0; k < 4; ++k) { float best = -3.0e38f; int bi = 0;
#pragma unroll
                        for (int q = 0; q < 32; ++q) { const bool ok = !((used >> q) & 1u) && (lg[q] > best); best = ok ? lg[q] : best; bi = ok ? q : bi; }
                        used |= 1u << bi; te[k] = bi; tv[k] = best; }
                    float ex[4], sum = 0.f;
#pragma unroll
                    for (int k = 0; k < 4; ++k) { ex[k] = __expf(tv[k] - tv[0]); sum += ex[k]; }
                    const float rs = 1.0f / sum;
                    if ((lane & 31) == 0) {
                        const int eb = wv * 64 + (2 * it + (lane >> 5)) * 4;
#pragma unroll
                        for (int k = 0; k < 4; ++k) { ent[eb + k] = te[k]; gat[eb + k] = ex[k] * rs; }
                    }
                    asm volatile("s_waitcnt lgkmcnt(0)" ::: "memory");
                }
            }
        }
        if (MODE == 2) {
            __syncthreads();
            { const int e = ent[wv * 64 + lane];
              const int pos = __hip_atomic_fetch_add(bcl + e, 1, __ATOMIC_RELAXED, __HIP_MEMORY_SCOPE_WORKGROUP);
              const size_t idx = (size_t)(vb * 128 + wv * 16) * 4 + lane;
              ((int*)(a->ws + WS_TOPE))[idx] = e; ((int*)(a->ws + WS_POSB))[idx] = pos; ((float*)(a->ws + WS_GATEW))[idx] = gat[wv * 64 + lane]; }
            __syncthreads();
            if (tid < 32) ((int*)(a->ws + WS_BCNT))[((size_t)layer * NTB + vb) * 32 + tid] = bcl[tid];
            __syncthreads();
        }
    }
}
DI void moe_tables(const int WID, ArgsP a, LAS unsigned char* lds, int layer, int vb) {
    const int tid = opaque_tid(WID);
    LAS int* tot = (LAS int*)(lds + MISC_OFF + MO_TOT); LAS int* base = (LAS int*)(lds + MISC_OFF + MO_BASE); LAS int* ts = (LAS int*)(lds + MISC_OFF + MO_TS);
    LAS int* red = (LAS int*)(lds + MISC_OFF + MO_RED);
    const int* bc = (const int*)(a->ws + WS_BCNT) + (size_t)layer * NTB * 32;
    { const int e = tid & 31, part = tid >> 5; int st = 0, sp = 0;
      for (int blk = part; blk < NTB; blk += 16) { const int v = bc[blk * 32 + e]; st += v; sp += (blk < vb) ? v : 0; }
      red[part * 32 + e] = st; red[512 + part * 32 + e] = sp; }
    __syncthreads();
    if (tid < 32) { int st = 0, sp = 0;
#pragma unroll
        for (int p = 0; p < 16; ++p) { st += red[p * 32 + tid]; sp += red[512 + p * 32 + tid]; }
        tot[tid] = st; base[tid] = sp; }
    __syncthreads();
    if (tid == 0) { int acc = 0; for (int e = 0; e < 32; ++e) { ts[e] = acc; acc += (tot[e] + 255) >> 8; } ts[32] = acc; }
    __syncthreads();
}
DI void phase_moe_slots(const int WID, ArgsP a, LAS unsigned char* lds, int layer) {
    const int tid = opaque_tid(WID), lane = tid & 63, wv = tid >> 6;
    LAS int* base = (LAS int*)(lds + MISC_OFF + MO_BASE); LAS int* ts = (LAS int*)(lds + MISC_OFF + MO_TS);
    const bf16_t* XN = (const bf16_t*)(a->ws + WS_XN); unsigned char* XB = (unsigned char*)(a->ws + WS_XB);
    for (int vb = blockIdx.x; vb < NTB; vb += gridDim.x) {
        moe_tables(WID, a, lds, layer, vb);
#pragma unroll 1
        for (int i = 0; i < 16; ++i) {
            const int t = vb * 128 + wv * 16 + i;
            int dest = 0;
            if (lane < 4) { const int e = ((const int*)(a->ws + WS_TOPE))[(size_t)t * 4 + lane], pos = ((const int*)(a->ws + WS_POSB))[(size_t)t * 4 + lane];
                dest = ts[e] * 256 + base[e] + pos; ((int*)(a->ws + WS_DEST))[(size_t)t * 4 + lane] = dest; }
            const u32x4 r0 = *(const u32x4*)(XN + (size_t)t * 1024 + 8 * lane), r1 = *(const u32x4*)(XN + (size_t)t * 1024 + 512 + 8 * lane);
            u32x2 q0, q1;
            q0.x = pk4_fp8(bflo(r0.x), bfhi(r0.x), bflo(r0.y), bfhi(r0.y)); q0.y = pk4_fp8(bflo(r0.z), bfhi(r0.z), bflo(r0.w), bfhi(r0.w));
            q1.x = pk4_fp8(bflo(r1.x), bfhi(r1.x), bflo(r1.y), bfhi(r1.y)); q1.y = pk4_fp8(bflo(r1.z), bfhi(r1.z), bflo(r1.w), bfhi(r1.w));
#pragma unroll
            for (int k = 0; k < 4; ++k) { const int d = __shfl(dest, k); unsigned char* o = XB + (size_t)d * 1024; *(u32x2*)(o + 8 * lane) = q0; *(u32x2*)(o + 512 + 8 * lane) = q1; }
        }
        __syncthreads();
    }
}
DI void phase_combine(const int WID, ArgsP a, float* H) {
    const int tid = opaque_tid(WID), lane = tid & 63, wv = tid >> 6;
    const bf16_t* YB = (const bf16_t*)(a->ws + WS_YB); bf16_t* XN = (bf16_t*)(a->ws + WS_XN);
    for (int t = blockIdx.x * 8 + wv; t < T; t += gridDim.x * 8) {
        int dest = 0; float gw = 0.f;
        if (lane < 4) { dest = ((const int*)(a->ws + WS_DEST))[(size_t)t * 4 + lane]; gw = ((const float*)(a->ws + WS_GATEW))[(size_t)t * 4 + lane]; }
        f32x4 v[4];
#pragma unroll
        for (int j = 0; j < 4; ++j) v[j] = *(const f32x4*)(H + (size_t)t * 1024 + 4 * lane + 256 * j);
#pragma unroll
        for (int k = 0; k < 4; ++k) { const int d = __shfl(dest, k); const float g = __shfl(gw, k); const bf16_t* y = YB + (size_t)d * 1024;
#pragma unroll
            for (int j = 0; j < 4; ++j) { const u32x2 w = *(const u32x2*)(y + 4 * lane + 256 * j); v[j][0] += g * bflo(w.x); v[j][1] += g * bfhi(w.x); v[j][2] += g * bflo(w.y); v[j][3] += g * bfhi(w.y); } }
        float ss = 0.f;
#pragma unroll
        for (int j = 0; j < 4; ++j) { *(f32x4*)(H + (size_t)t * 1024 + 4 * lane + 256 * j) = v[j]; ss += (v[j][0] * v[j][0] + v[j][1] * v[j][1]) + (v[j][2] * v[j][2] + v[j][3] * v[j][3]); }
        ss = wave_sum(ss);
        const float rstd = rsqrtf(ss * (1.0f / 1024.0f) + EPS);
#pragma unroll
        for (int j = 0; j < 4; ++j) v[j] = v[j] * rstd;
        row_store_bf16(XN + (size_t)t * 1024, lane, v);
    }
}
DI void phase_cmp2(const int WID, ArgsP a, LAS unsigned char* lds, int ev) {
    const int tid = opaque_tid(WID), lane = tid & 63, wv = __builtin_amdgcn_readfirstlane(tid >> 6);
    const bf16_t* HID = (const bf16_t*)(a->ws + WS_HID); bf16_t* KCMP = (bf16_t*)(a->ws + WS_KCMP); bf16_t* VCMPT = (bf16_t*)(a->ws + WS_VCMPT);
    const float kg = a->in[I_NSKN][ev * 64 + lane];
    LAS float* wl = (LAS float*)lds;
    for (int i = tid; i < 2 * 256 * 64 / 4; i += 512) *(LAS f32x4*)(wl + 4 * i) = *(const f32x4*)(a->in[I_CMPW2] + (size_t)ev * 2 * 256 * 64 + 4 * i);
    __syncthreads();
    for (int gi = blockIdx.x * 8 + wv; gi < 2048; gi += gridDim.x * 8) {
        const int kv = gi >> 10, row0 = (gi & 1023) * 4;
        const bf16_t* hrow = HID + ((size_t)kv * 4096 + row0) * 256;
        const LAS float* w2 = wl + kv * 256 * 64 + lane;
        float s[4] = {0.f, 0.f, 0.f, 0.f};
#pragma unroll 2
        for (int k = 0; k < 256; k += 8) {
            u32x4 hw[4];
#pragma unroll
            for (int r = 0; r < 4; ++r) hw[r] = *(const u32x4*)(hrow + r * 256 + k);
            float wv8[8];
#pragma unroll
            for (int j = 0; j < 8; ++j) wv8[j] = w2[(k + j) * 64];
#pragma unroll
            for (int r = 0; r < 4; ++r)
                s[r] += bflo(hw[r].x) * wv8[0] + bfhi(hw[r].x) * wv8[1] + bflo(hw[r].y) * wv8[2] + bfhi(hw[r].y) * wv8[3] + bflo(hw[r].z) * wv8[4] + bfhi(hw[r].z) * wv8[5] + bflo(hw[r].w) * wv8[6] + bfhi(hw[r].w) * wv8[7];
        }
#pragma unroll
        for (int r = 0; r < 4; ++r) {
            const int row = row0 + r, bg = row >> 7, n = row & 127;
            float v = (n == 127) ? 0.f : s[r];
            if (kv == 0) { const float ss = wave_sum(v * v); const float o = v * rsqrtf(ss * (1.0f / 64.0f) + EPS) * kg;
                KCMP[((size_t)bg * 128 + n) * 64 + lane] = (bf16_t)(pk2(o, 0.f) & 0xffffu); }
            else VCMPT[((size_t)bg * 96 + lane) * 128 + n] = (bf16_t)(pk2(v, 0.f) & 0xffffu);
        }
    }
    for (int i = blockIdx.x * 512 + tid; i < 32 * 32 * 128; i += gridDim.x * 512) {
        const int n = i & 127, j = (i >> 7) & 31, bg = i >> 12;
        float o = 0.f;
        if (n < 127) { const int d = n - 4 * j; if (d >= 0 && d <= 2) o = 1.0f; else if (d == 3 || d == -1) o = 0.5f; }
        VCMPT[((size_t)bg * 96 + 64 + j) * 128 + n] = (bf16_t)(pk2(o, 0.f) & 0xffffu);
    }
}
DI void phase_topk(const int WID, ArgsP a) {
    const float* IMPH = (const float*)(a->ws + WS_IMPH); unsigned* SELM = (unsigned*)(a->ws + WS_SELM);
    for (int i = blockIdx.x * 512 + opaque_tid(WID); i < T * 2; i += gridDim.x * 512) {
        const int t = i >> 1, g = i & 1, b = t >> 11, s = t & 2047, cur = s >> 6;
        float sc[32];
#pragma unroll
        for (int j4 = 0; j4 < 8; ++j4) { f32x4 acc = {0.f, 0.f, 0.f, 0.f};
#pragma unroll
            for (int r = 0; r < 4; ++r) acc += *(const f32x4*)(IMPH + ((size_t)t * 8 + g * 4 + r) * 32 + 4 * j4);
#pragma unroll
            for (int q = 0; q < 4; ++q) sc[4 * j4 + q] = acc[q]; }
        unsigned mask;
        if (cur < 16) mask = (cur == 31) ? 0xffffffffu : ((2u << cur) - 1u);
        else {
#pragma unroll
            for (int j = 0; j < 32; ++j) { const bool forced = (j == 0) || (j == cur) || (j == cur - 1); sc[j] = (j > cur) ? NEGF : (sc[j] + (forced ? 1e4f : 0.f)); }
            mask = 0u;
#pragma unroll
            for (int j = 0; j < 32; ++j) { int rank = 0;
#pragma unroll
                for (int k = 0; k < 32; ++k) rank += ((sc[k] > sc[j]) || (sc[k] == sc[j] && k < j)) ? 1 : 0;
                mask |= (rank < 16) ? (1u << j) : 0u; }
        }
        SELM[((size_t)(b * 2 + g)) * 2048 + s] = mask;
    }
}
DI void phase_mixprep(const int WID, ArgsP a, int layer) {
    const int tid = opaque_tid(WID), lane = tid & 63, wv = tid >> 6, ev = layer >> 1;
    const float* dl = a->in[I_DALAM] + ev * 256;
    const float s1 = wave_sum(dl[lane] * dl[64 + lane]), s2 = wave_sum(dl[128 + lane] * dl[192 + lane]);
    const float lam_init = 0.8f - 0.6f * expf(-0.3f * (float)layer);
    const float lam = expf(s1) - expf(s2) + lam_init;
    const float* og = a->in[I_DAOUTG] + ev * 128;
    const bf16_t* OD = (const bf16_t*)(a->ws + WS_OD); const bf16_t* OC = (const bf16_t*)(a->ws + WS_OC); const bf16_t* OS = (const bf16_t*)(a->ws + WS_OS); const bf16_t* OW = (const bf16_t*)(a->ws + WS_OW);
    const float* GT = (const float*)(a->ws + WS_GATES); bf16_t* AMIX = (bf16_t*)(a->ws + WS_AMIX);
    const int h = lane >> 4, dv = (lane & 15) * 8;
    f32x4 g0 = *(const f32x4*)(og + dv), g1 = *(const f32x4*)(og + dv + 4);
    for (int t = blockIdx.x * 8 + wv; t < T; t += gridDim.x * 8) {
        { const u32x4 w1 = *(const u32x4*)(OD + (size_t)t * 1024 + h * 128 + dv), w2 = *(const u32x4*)(OD + (size_t)t * 1024 + (4 + h) * 128 + dv);
          f32x4 d0, d1;
          d0[0] = bflo(w1.x) - lam * bflo(w2.x); d0[1] = bfhi(w1.x) - lam * bfhi(w2.x); d0[2] = bflo(w1.y) - lam * bflo(w2.y); d0[3] = bfhi(w1.y) - lam * bfhi(w2.y);
          d1[0] = bflo(w1.z) - lam * bflo(w2.z); d1[1] = bfhi(w1.z) - lam * bfhi(w2.z); d1[2] = bflo(w1.w) - lam * bflo(w2.w); d1[3] = bfhi(w1.w) - lam * bfhi(w2.w);
          float ss = (d0[0] * d0[0] + d0[1] * d0[1]) + (d0[2] * d0[2] + d0[3] * d0[3]) + (d1[0] * d1[0] + d1[1] * d1[1]) + (d1[2] * d1[2] + d1[3] * d1[3]);
          ss += __shfl_xor(ss, 1); ss += __shfl_xor(ss, 2); ss += __shfl_xor(ss, 4); ss += __shfl_xor(ss, 8);
          const float rs = rsqrtf(ss * (1.0f / 128.0f) + EPS) * (1.0f - lam_init);
          *(u32x4*)(AMIX + (size_t)t * 1024 + h * 128 + dv) = pack8(d0 * rs * g0, d1 * rs * g1); }
        { const int hd = lane >> 3, dq = (lane & 7) * 8; const size_t o = (size_t)t * 512 + hd * 64 + dq;
          const float ga = GT[(size_t)t * 24 + hd * 3], gb = GT[(size_t)t * 24 + hd * 3 + 1], gc = GT[(size_t)t * 24 + hd * 3 + 2];
          const u32x4 c = *(const u32x4*)(OC + o), s = *(const u32x4*)(OS + o), w = *(const u32x4*)(OW + o);
          f32x4 r0, r1;
          r0[0] = ga * bflo(c.x) + gb * bflo(s.x) + gc * bflo(w.x); r0[1] = ga * bfhi(c.x) + gb * bfhi(s.x) + gc * bfhi(w.x);
          r0[2] = ga * bflo(c.y) + gb * bflo(s.y) + gc * bflo(w.y); r0[3] = ga * bfhi(c.y) + gb * bfhi(s.y) + gc * bfhi(w.y);
          r1[0] = ga * bflo(c.z) + gb * bflo(s.z) + gc * bflo(w.z); r1[1] = ga * bfhi(c.z) + gb * bfhi(s.z) + gc * bfhi(w.z);
          r1[2] = ga * bflo(c.w) + gb * bflo(s.w) + gc * bflo(w.w); r1[3] = ga * bfhi(c.w) + gb * bfhi(s.w) + gc * bfhi(w.w);
          *(u32x4*)(AMIX + (size_t)t * 1024 + 512 + hd * 64 + dq) = pack8(r0, r1); }
    }
}
DI void phase_scan(const int WID, ArgsP a) {
    const float* UT = (const float*)(a->ws + WS_UT); bf16_t* VS = (bf16_t*)(a->ws + WS_VS);
    for (int i = blockIdx.x * 512 + opaque_tid(WID); i < 64 * 512 * 64; i += gridDim.x * 512) {
        const int d4 = i & 63, f = (i >> 6) & 511, bh = i >> 15, h = bh & 3;
        const float dec = exp2f(256.0f * ret_lg2(h));
        f32x4 S = {0.f, 0.f, 0.f, 0.f};
#pragma unroll 1
        for (int n = 0; n < 8; ++n) {
            const size_t z = (size_t)bh * 8 + n;
            u32x2 o; o.x = pk2(S[0], S[1]); o.y = pk2(S[2], S[3]);
            *(u32x2*)(VS + (z * 512 + f) * 512 + 256 + 4 * d4) = o;
            const f32x4 u = *(const f32x4*)(UT + z * 131072 + (size_t)f * 256 + 4 * d4);
            S = (S + u) * dec;
        }
    }
}
DI void phase_normgate(const int WID, ArgsP a, int od) {
    const int tid = opaque_tid(WID), lane = tid & 63, wv = tid >> 6;
    const bf16_t* Y = (const bf16_t*)(a->ws + WS_Y); const bf16_t* GG = (const bf16_t*)(a->ws + WS_GG); bf16_t* YG = (bf16_t*)(a->ws + WS_YG);
    const float* og = a->in[I_RETG] + od * 512;
    const f32x4 g0 = *(const f32x4*)(og + 8 * lane), g1 = *(const f32x4*)(og + 8 * lane + 4);
    for (int t = blockIdx.x * 8 + wv; t < T; t += gridDim.x * 8) {
#pragma unroll
        for (int h = 0; h < 4; ++h) {
            const size_t o = (size_t)t * 2048 + h * 512 + 8 * lane;
            const u32x4 yw = *(const u32x4*)(Y + o), gw = *(const u32x4*)(GG + o);
            f32x4 y0 = {bflo(yw.x), bfhi(yw.x), bflo(yw.y), bfhi(yw.y)}, y1 = {bflo(yw.z), bfhi(yw.z), bflo(yw.w), bfhi(yw.w)};
            const f32x4 q0 = {bflo(gw.x), bfhi(gw.x), bflo(gw.y), bfhi(gw.y)}, q1 = {bflo(gw.z), bfhi(gw.z), bflo(gw.w), bfhi(gw.w)};
            float ss = (y0[0] * y0[0] + y0[1] * y0[1]) + (y0[2] * y0[2] + y0[3] * y0[3]) + (y1[0] * y1[0] + y1[1] * y1[1]) + (y1[2] * y1[2] + y1[3] * y1[3]);
            ss = wave_sum(ss);
            const float rs = rsqrtf(ss * (1.0f / 512.0f) + EPS);
            *(u32x4*)(YG + o) = pack8(y0 * rs * g0 * q0, y1 * rs * g1 * q1);
        }
    }
}
DI int snake_unit(int rnd, int G, int c) { return (rnd & 1) ? rnd * G + (G - 1 - c) : rnd * G + c; }
DI float absmax64(const float* g, int lane) { float m = fabsf(g[lane]);
#pragma unroll
    for (int o = 1; o < 64; o <<= 1) m = fmaxf(m, __shfl_xor(m, o));
    return m; }
constexpr int CW_AQ = 8192;
template <int MODE>
DI void phase_attn(const int WID, ArgsP a, LAS unsigned char* lds, int ev) {
    const int tid = opaque_tid(WID), lane = tid & 63;
    const bf16_t* QD = (const bf16_t*)(a->ws + WS_QD); const bf16_t* KD = (const bf16_t*)(a->ws + WS_KD); const bf16_t* QN = (const bf16_t*)(a->ws + WS_QN);
    LAS int* ord = (LAS int*)(lds + MISC_OFF + MO_ENT); LAS int* cst = (LAS int*)(lds + MISC_OFF + MO_GAT); volatile LAS int* cur = (volatile LAS int*)(lds + MISC_OFF + MO_TOT);
    float sb2 = 0.f;
    if (MODE != 3) { const float gq = absmax64(a->in[MODE == 0 ? I_DAQN : I_NSQN] + ev * 64, lane), gk = absmax64(a->in[MODE == 0 ? I_DAKN : I_NSKN] + ev * 64, lane);
        sb2 = 16.0f * gq * gk + 28.0f; }
    if (tid < 64) { const int qb = tid >> 3, hd = tid & 7, q0 = qb * 256; int lo = 0, hi = 4 * qb + 4;
        if (MODE == 3) { lo = 0; hi = 2; }
        else { const float slope = (MODE == 0) ? exp2f(-2.0f * (float)((hd & 3) + 1)) : exp2f(-(float)(hd + 1)); const int dcut = (int)fminf(sb2 / slope + 1.0f, 100000.0f);
            const int kmin = q0 - dcut; lo = kmin > 0 ? (kmin >> 6) : 0;
            if (MODE == 2) { const int lk = q0 - 511; const int lw = lk > 0 ? (lk >> 6) : 0; lo = lw > lo ? lw : lo; } }
        cst[tid] = hi - lo; }
    __syncthreads();
    if (tid < 64) { const int mine = cst[tid]; int rank = 0;
        for (int j = 0; j < 64; ++j) { const int o = cst[j]; rank += (o > mine || (o == mine && j < tid)) ? 1 : 0; }
        ord[rank] = tid; }
    __syncthreads();
    unsigned* ctr = (unsigned*)(a->ws + WS_CTL) + CW_AQ + 64 * (ev * 4 + MODE);
    for (;;) {
        if (tid == 0) *cur = (int)__hip_atomic_fetch_add(ctr, 1u, __ATOMIC_RELAXED, __HIP_MEMORY_SCOPE_AGENT);
        __syncthreads();
        const int u = *cur; if (u >= 1024) break;
        const int combo = ord[u >> 4], b = u & 15, qb = combo >> 3, hd = combo & 7, q0 = qb * 256; const size_t t0 = (size_t)b * 2048 + q0;
        if (MODE == 0) {
            const float slope = exp2f(-2.0f * (float)((hd & 3) + 1)); const int dcut = (int)fminf(sb2 / slope + 1.0f, 100000.0f);
            attn_unit<128, 0>(WID, lds, QD + t0 * 512 + hd * 64, 512, KD + (size_t)b * 2048 * 512 + hd * 64, 512,
                              (const bf16_t*)(a->ws + WS_VAT) + (size_t)(b * 4 + (hd & 3)) * 128 * 2048, 2048, q0, slope, dcut, nullptr,
                              (bf16_t*)(a->ws + WS_OD) + t0 * 1024 + hd * 128, 1024, nullptr);
        } else if (MODE == 1 || MODE == 2) {
            const int g = hd >> 2; const float slope = exp2f(-(float)(hd + 1)); const int dcut = (int)fminf(sb2 / slope + 1.0f, 100000.0f);
            const bf16_t* Kb = (const bf16_t*)(a->ws + (MODE == 1 ? WS_KSB : WS_KWB)) + (size_t)(b * 2 + g) * 2048 * 64;
            const bf16_t* Vb = (const bf16_t*)(a->ws + (MODE == 1 ? WS_VST : WS_VWT)) + (size_t)(b * 2 + g) * 64 * 2048;
            attn_unit<64, MODE>(WID, lds, QN + t0 * 512 + hd * 64, 512, Kb, 64, Vb, 2048, q0, slope, dcut,
                                (const unsigned*)(a->ws + WS_SELM) + (size_t)(b * 2 + g) * 2048 + q0,
                                (bf16_t*)(a->ws + (MODE == 1 ? WS_OS : WS_OW)) + t0 * 512 + hd * 64, 512, nullptr);
        } else {
            const int g = hd >> 2;
            attn_unit<96, 3>(WID, lds, QN + t0 * 512 + hd * 64, 512, (const bf16_t*)(a->ws + WS_KCMP) + (size_t)(b * 2 + g) * 128 * 64, 64,
                             (const bf16_t*)(a->ws + WS_VCMPT) + (size_t)(b * 2 + g) * 96 * 128, 128, q0, 0.f, 0, nullptr,
                             (bf16_t*)(a->ws + WS_OC) + t0 * 512 + hd * 64, 512, (float*)(a->ws + WS_IMPH) + (t0 * 8 + hd) * 32);
        }
    }
}

constexpr int PPL = 15;
constexpr int NPHASE = 1 + DEPTH * PPL;
__global__ void __launch_bounds__(512, 2) mk_fwd(Args a_unused) {
    ArgsP a = opaque_args();
    extern __shared__ __attribute__((aligned(16))) unsigned char lds_raw[];
    LAS unsigned char* lds = (LAS unsigned char*)lds_raw;
    const int tid = threadIdx.x, G = gridDim.x, c = blockIdx.x;
    const int WID = __builtin_amdgcn_readfirstlane(tid >> 6);
    volatile LAS unsigned* misc = (volatile LAS unsigned*)(lds + MISC_OFF);
    if (tid < 4) misc[tid] = 0u;
    __syncthreads();
    unsigned* ctl = (unsigned*)(a->ws + WS_CTL);
    XcdBarrier bar; bar.bar = ctl + CW_BAR; bar.x = 0; bar.st = misc;
    const int ph_lo = a->ph_lo, ph_hi = a->ph_hi;
    const bool multi = (ph_hi - ph_lo) > 1;
    if (multi) bar = xcd_barrier_post(WID, ctl + CW_BAR, misc);
    bool first = true;
#define PHASE_BEGIN(k, id) if ((DBG_ONLY < 0 || DBG_ONLY == (id)) && (k) >= ph_lo && (k) < ph_hi && (k) <= DBG_LAST_PHASE) { if (!first) { xcd_barrier(WID, bar); if (PROBE_MASK >> 31) xcd_barrier(WID, bar); } first = false; \
        ArgsP a = opaque_args(); unsigned char* ws = a->ws; bf16_t* XN = (bf16_t*)(ws + WS_XN); float* H = a->out; const float* Hin = (layer == 0) ? a->in[I_X] : (const float*)H; \
        const LAS int* ts = (const LAS int*)(lds + MISC_OFF + MO_TS); (void)XN; (void)H; (void)Hin; (void)ts; \
        const bool probe_ = ((PROBE_MASK >> (id)) & 1u) != 0u; const unsigned long long pt0_ = probe_ ? __builtin_amdgcn_s_memrealtime() : 0ull;
#define PHASE_END if (probe_) { const unsigned long long pt1_ = __builtin_amdgcn_s_memrealtime(), pd_ = pt1_ - pt0_; while (__builtin_amdgcn_s_memrealtime() - pt1_ < pd_) __builtin_amdgcn_s_sleep(8); } }
    { const int layer = 0; PHASE_BEGIN(0, 0) phase_prologue(WID, a, lds); PHASE_END }
#pragma unroll 1
    for (int layer = 0; layer < DEPTH; ++layer) {
        const int pb = 1 + layer * PPL; const bool even = (layer & 1) == 0; const int ev = layer >> 1, od = layer >> 1;
        if (even) {
            PHASE_BEGIN(pb + 0, 1) phase_norm<0>(WID, a, lds, layer, Hin); PHASE_END
            PHASE_BEGIN(pb + 1, 2) {
                { ProbPlain P{XN, (const bf16_t*)(ws + WS_EVNAT) + (size_t)ev * 2048 * 1024, 1024, 1024, 1024}; pg8::Sched S; S.init(T / 256, 8, G, c);
                  EpiEvNat E{ws, (const float*)(ws + WS_GAINS) + ev * 256};
                  pg8::gemm_phase(WID, lds, P, S, E); }
                { ProbPlain P{(const bf16_t*)(ws + WS_EVSW) + (size_t)ev * 768 * 1024, XN, 1024, 1024, 1024}; pg8::Sched S; S.init(3, T / 256, G, c);
                  EpiEvSw E{ws};
                  pg8::gemm_phase(WID, lds, P, S, E); }
            } PHASE_END
            PHASE_BEGIN(pb + 2, 3) {
                { ProbCmp1 P{(const bf16_t*)(ws + WS_KCB), (const bf16_t*)(ws + WS_VCB), (const bf16_t*)(ws + WS_CMP1) + (size_t)ev * 2 * 256 * 2048, 1024, 2048, 2048}; pg8::Sched S; S.init(32, 1, G, c);
                  EpiCmp1 E{(bf16_t*)(ws + WS_HID), (const float*)(ws + WS_BIAS1) + ev * 512};
                  pg8::gemm_phase(WID, lds, P, S, E); }
                phase_attn<0>(WID, a, lds, ev);
                phase_attn<2>(WID, a, lds, ev);
            } PHASE_END
            PHASE_BEGIN(pb + 3, 4) phase_cmp2(WID, a, lds, ev); PHASE_END
            PHASE_BEGIN(pb + 4, 5) phase_attn<3>(WID, a, lds, ev); PHASE_END
            PHASE_BEGIN(pb + 5, 6) phase_topk(WID, a); PHASE_END
            PHASE_BEGIN(pb + 6, 7) phase_attn<1>(WID, a, lds, ev); PHASE_END
            PHASE_BEGIN(pb + 7, 8) phase_mixprep(WID, a, layer); PHASE_END
            PHASE_BEGIN(pb + 8, 9) {
                ProbPlain P{(const bf16_t*)(ws + WS_AMIX), (const bf16_t*)(ws + WS_EVOUT) + (size_t)ev * 1024 * 1024, 1024, 1024, 1024}; pg8::Sched S; S.init(T / 256, 4, G, c);
                EpiResid E{Hin, H}; pg8::gemm_phase(WID, lds, P, S, E);
            } PHASE_END
        } else {
            PHASE_BEGIN(pb + 0, 11) phase_norm<1>(WID, a, lds, layer, Hin); PHASE_END
            PHASE_BEGIN(pb + 1, 12) {
                { ProbPlain P{XN, (const bf16_t*)(ws + WS_ODNAT) + (size_t)od * 4096 * 1024, 1024, 1024, 1024}; pg8::Sched S; S.init(T / 256, 16, G, c);
                  EpiOdNat E{ws}; pg8::gemm_phase(WID, lds, P, S, E); }
                { ProbPlain P{(const bf16_t*)(ws + WS_ODSW) + (size_t)od * 3072 * 1024, XN, 1024, 1024, 1024}; pg8::Sched S; S.init(12, T / 256, G, c);
                  EpiOdSw E{ws}; pg8::gemm_phase(WID, lds, P, S, E); }
            } PHASE_END
            PHASE_BEGIN(pb + 2, 13) {
                { ProbAtt P{(const bf16_t*)(ws + WS_AQ), (const bf16_t*)(ws + WS_KP), 2048, 1024, 256}; pg8::Sched S; S.init(512, 1, G, c);
                  EpiAtt E{(bf16_t*)(ws + WS_AQ)}; pg8::gemm_phase(WID, lds, P, S, E); }
                { ProbUT P{(const bf16_t*)(ws + WS_VS), (const bf16_t*)(ws + WS_KT), 512, 256, 256}; pg8::Sched S; S.init(1024, 1, G, c);
                  EpiUT E{(float*)(ws + WS_UT)}; pg8::gemm_phase(WID, lds, P, S, E); }
            } PHASE_END
            PHASE_BEGIN(pb + 3, 14) phase_scan(WID, a); PHASE_END
            PHASE_BEGIN(pb + 4, 15) {
                ProbY P{(const bf16_t*)(ws + WS_AQ), (const bf16_t*)(ws + WS_VS), 2048, 512, 512}; pg8::Sched S; S.init(512, 2, G, c);
                EpiY E{(bf16_t*)(ws + WS_Y)}; pg8::gemm_phase(WID, lds, P, S, E);
            } PHASE_END
            PHASE_BEGIN(pb + 5, 16) phase_normgate(WID, a, od); PHASE_END
            PHASE_BEGIN(pb + 8, 19) {
                ProbPlain P{(const bf16_t*)(ws + WS_YG), (const bf16_t*)(ws + WS_ODOUT) + (size_t)od * 1024 * 2048, 2048, 2048, 2048}; pg8::Sched S; S.init(T / 256, 4, G, c);
                EpiResid E{Hin, H}; pg8::gemm_phase(WID, lds, P, S, E);
            } PHASE_END
        }
        PHASE_BEGIN(pb + 9, 20) phase_norm<2>(WID, a, lds, layer, H); PHASE_END
        PHASE_BEGIN(pb + 10, 21) phase_moe_slots(WID, a, lds, layer); PHASE_END
        PHASE_BEGIN(pb + 11, 22) {
            moe_tables(WID, a, lds, layer, -1);
            { ProbMoe8 P{(const unsigned char*)(ws + WS_XB), (const unsigned char*)(ws + WS_WGU) + (size_t)layer * 32 * 2048 * 1024, ts, 2048, 512, 512, 512}; pg8::Sched S; S.init(ts[32], 8, G, c);
              EpiGU E{(unsigned char*)(ws + WS_ACT), a->in[I_BGU] + (size_t)layer * 32 * 2048, ts}; pg8::gemm_phase(WID, lds, P, S, E); }
            { ProbPlain P{(const bf16_t*)(ws + WS_PBF) + (size_t)layer * T * 256, (const bf16_t*)(ws + WS_WPP) + (size_t)layer * 1024 * 256, 256, 256, 256}; pg8::Sched S; S.init(T / 256, 4, G, c);
              EpiPP E{(bf16_t*)(ws + WS_PP)}; pg8::gemm_phase(WID, lds, P, S, E); }
        } PHASE_END
        PHASE_BEGIN(pb + 12, 23) {
            moe_tables(WID, a, lds, layer, -1);
            ProbMoe8 P{(const unsigned char*)(ws + WS_ACT), (const unsigned char*)(ws + WS_WDN) + (size_t)layer * 32 * 1024 * 1024, ts, 1024, 512, 512, 512}; pg8::Sched S; S.init(ts[32], 4, G, c);
            EpiDN E{(bf16_t*)(ws + WS_YB), a->in[I_BDN] + (size_t)layer * 32 * 1024, ts}; pg8::gemm_phase(WID, lds, P, S, E);
        } PHASE_END
        PHASE_BEGIN(pb + 13, 24) phase_combine(WID, a, H); PHASE_END
        PHASE_BEGIN(pb + 14, 25) {
            ProbPlain P{XN, (const bf16_t*)(ws + WS_WPG) + (size_t)layer * 1024 * 1024, 1024, 1024, 1024}; pg8::Sched S; S.init(T / 256, 4, G, c);
            EpiPLE E{H, (const bf16_t*)(ws + WS_PP)}; pg8::gemm_phase(WID, lds, P, S, E);
        } PHASE_END
    }
#undef PHASE_BEGIN
#undef PHASE_END
}

extern "C" void kernel_launch(void* const* d_in, const int* in_sizes, int n_in, void* d_out, int out_size, void* d_ws, size_t ws_size, hipStream_t stream) {
    static int grid = 0;
    if (grid == 0) {
        if (n_in != 26 || out_size != T * D || ws_size < WS_END) { fprintf(stderr, "kernel_launch: unexpected problem (n_in %d, out %d, ws %zu < %zu); nothing launched\n", n_in, out_size, ws_size, (size_t)WS_END); grid = -1; return; }
        int dev = 0, cus = 0, per_cu = 0;
        if (hipGetDevice(&dev) != hipSuccess || hipDeviceGetAttribute(&cus, hipDeviceAttributeMultiprocessorCount, dev) != hipSuccess) { grid = -1; return; }
        if (hipFuncSetAttribute((const void*)mk_fwd, hipFuncAttributeMaxDynamicSharedMemorySize, LDS_BYTES) != hipSuccess) { fprintf(stderr, "kernel_launch: hipFuncSetAttribute failed\n"); grid = -1; return; }
        if (hipOccupancyMaxActiveBlocksPerMultiprocessor(&per_cu, (const void*)mk_fwd, 512, LDS_BYTES) != hipSuccess || per_cu < 1) fprintf(stderr, "kernel_launch: occupancy query reports %d\n", per_cu);
        (void)hipGetLastError();
        grid = cus > 256 ? 256 : cus;
    }
    if (grid < 0) return;
    (void)hipMemsetAsync((char*)d_ws + WS_CTL, 0, CTL_BYTES, stream);
    Args a; memset(&a, 0, sizeof(a));
    for (int i = 0; i < 26; ++i) a.in[i] = (const float*)d_in[i];
    a.out = (float*)d_out; a.ws = (unsigned char*)d_ws;
#if MK_SINGLE
    a.ph_lo = 0; a.ph_hi = NPHASE;
    hipLaunchKernelGGL(mk_fwd, dim3(grid), dim3(512), LDS_BYTES, stream, a);
#else
    for (int ph = 0; ph < NPHASE && ph <= DBG_LAST_PHASE; ++ph) {
        const int l = (ph - 1) / PPL, k = (ph - 1) % PPL;
        if (ph > 0 && (l & 1) && (k == 6 || k == 7)) continue;
        a.ph_lo = ph; a.ph_hi = ph + 1;
        hipLaunchKernelGGL(mk_fwd, dim3(grid), dim3(512), LDS_BYTES, stream, a);
    }
#endif
}
```

```cpp
#include <hip/hip_runtime.h>
#include <cstdio>
#include <cstdint>
#include <cstring>

#define LAS __attribute__((address_space(3)))
#define DI __device__ __forceinline__
typedef unsigned short bf16_t;
typedef short bf16x8 __attribute__((ext_vector_type(8)));
typedef short s16x4 __attribute__((ext_vector_type(4)));
typedef float f32x2 __attribute__((ext_vector_type(2)));
typedef float f32x4 __attribute__((ext_vector_type(4)));
typedef float f32x16 __attribute__((ext_vector_type(16)));
typedef unsigned u32x2 __attribute__((ext_vector_type(2)));
typedef unsigned u32x4 __attribute__((ext_vector_type(4)));
typedef __bf16 bfv2 __attribute__((ext_vector_type(2)));
typedef int i32x4 __attribute__((ext_vector_type(4)));
typedef int i32x8 __attribute__((ext_vector_type(8)));

#ifndef MK_SINGLE
#define MK_SINGLE 1
#endif
#ifndef DBG_ONLY
#define DBG_ONLY -1
#endif
#ifndef PROBE_MASK
#define PROBE_MASK 0u
#endif
#ifndef DBG_LAST_PHASE
#define DBG_LAST_PHASE 100000
#endif

constexpr int T = 32768, D = 1024, SEQ = 2048, NBATCH = 16, DEPTH = 4;
constexpr int EVIN = 2840, ODIN = 6144;
constexpr float EPS = 1e-6f, NEGF = -1e30f;
constexpr int NTB = 256;
constexpr int MOE_ROWS = (512 + 32) * 256;

constexpr size_t MiB = 1u << 20;
constexpr size_t WS_CTL = 0, CTL_BYTES = 1 * MiB;
constexpr int CW_BAR = 4096;
constexpr size_t WS_EVNAT = 2 * MiB, WS_EVSW = 10 * MiB, WS_EVOUT = 13 * MiB, WS_CMP1 = 17 * MiB, WS_ODNAT = 21 * MiB, WS_ODSW = 37 * MiB,
                 WS_ODOUT = 49 * MiB, WS_WPP = 57 * MiB, WS_WPG = 59 * MiB, WS_BIAS1 = 67 * MiB, WS_GAINS = 67 * MiB + 16384, WS_BCNT = 67 * MiB + 65536,
                 WS_WGU = 68 * MiB, WS_WDN = 580 * MiB;
constexpr size_t WS_XN = 840 * MiB, WS_PBF = 904 * MiB, WS_PP = 968 * MiB, WS_GATES = 1032 * MiB, WS_TOPE = 1035 * MiB, WS_POSB = 1036 * MiB,
                 WS_DEST = 1037 * MiB, WS_GATEW = 1038 * MiB, WS_SELM = 1039 * MiB;
constexpr size_t RA = 1040 * MiB;
constexpr size_t WS_QD = RA, WS_KD = RA + 32 * MiB, WS_QN = RA + 64 * MiB, WS_KCB = RA + 96 * MiB, WS_VCB = RA + 105 * MiB, WS_KSB = RA + 114 * MiB,
                 WS_KWB = RA + 122 * MiB, WS_VAT = RA + 130 * MiB, WS_VST = RA + 162 * MiB, WS_VWT = RA + 170 * MiB, WS_HID = RA + 178 * MiB,
                 WS_KCMP = RA + 182 * MiB, WS_VCMPT = RA + 183 * MiB, WS_OC = RA + 184 * MiB, WS_IMPH = RA + 216 * MiB, WS_OD = RA + 248 * MiB,
                 WS_OS = RA + 312 * MiB, WS_OW = RA + 344 * MiB, WS_AMIX = RA + 376 * MiB;
constexpr size_t WS_AQ = RA, WS_KP = RA + 128 * MiB, WS_KT = RA + 192 * MiB, WS_VS = RA + 256 * MiB, WS_GG = RA + 512 * MiB, WS_UT = RA + 640 * MiB,
                 WS_Y = RA + 896 * MiB, WS_YG = RA + 1024 * MiB;
constexpr size_t WS_XB = 2192 * MiB, WS_ACT = 2464 * MiB, WS_YB = 2736 * MiB, WS_END = 3008 * MiB;

constexpr int MISC_OFF = 139264, LDS_BYTES = 155648;
static_assert(MISC_OFF + 5888 + 4096 <= LDS_BYTES, "misc LDS words");
constexpr int MO_WCNT = 256, MO_ENT = 1280, MO_GAT = 3328, MO_TOT = 5376, MO_BASE = 5504, MO_TS = 5632, MO_RED = 5888;

DI int opaque_tid(int wid0) { int l; asm volatile("v_mbcnt_lo_u32_b32 %0, -1, 0\n\tv_mbcnt_hi_u32_b32 %0, -1, %0" : "=v"(l) :: "memory"); return (wid0 << 6) | l; }
DI unsigned pk2(float lo, float hi) { f32x2 v = {lo, hi}; return __builtin_bit_cast(unsigned, __builtin_convertvector(v, bfv2)); }
DI unsigned pk4_fp8(float a, float b, float c, float d) { int w = 0; w = __builtin_amdgcn_cvt_pk_fp8_f32(a, b, w, false); w = __builtin_amdgcn_cvt_pk_fp8_f32(c, d, w, true); return (unsigned)w; }
DI float bf2f(unsigned short b) { return __uint_as_float(((unsigned)b) << 16); }
DI float bflo(unsigned w) { return __uint_as_float(w << 16); }
DI float bfhi(unsigned w) { return __uint_as_float(w & 0xffff0000u); }
DI float wave_sum(float v) {
#pragma unroll
    for (int o = 1; o < 64; o <<= 1) v += __shfl_xor(v, o);
    return v;
}
DI float sigm(float x) { return 1.0f / (1.0f + __expf(-x)); }
DI u32x4 pack8(const f32x4& a, const f32x4& b) { u32x4 w; w.x = pk2(a[0], a[1]); w.y = pk2(a[2], a[3]); w.z = pk2(b[0], b[1]); w.w = pk2(b[2], b[3]); return w; }

#define XB_TMO      128
#define XB_XCNT(j)  (256  + 64 * (j))
#define XB_XSUB(j)  (1280 + 64 * (j))
#define XB_XGEN(j)  (2304 + 64 * (j))
#define XB_TOP      3328
#define XB_TOPGEN   3392
#define XCD_BAR_WORDS 3456
#define XB_SPIN_CAP (1u << 22)
DI unsigned xb_ld(unsigned* p)              { return __hip_atomic_load(p, __ATOMIC_RELAXED, __HIP_MEMORY_SCOPE_AGENT); }
DI unsigned xb_add(unsigned* p, unsigned v) { return __hip_atomic_fetch_add(p, v, __ATOMIC_RELAXED, __HIP_MEMORY_SCOPE_AGENT); }
DI unsigned xb_xcc_id() { return (unsigned)__builtin_amdgcn_s_getreg((3 << 11) | 20) & 0xFu; }
#define XB_SPIN(cond, bar) do { unsigned _sp = 0; while (cond) { __builtin_amdgcn_s_sleep(1); \
    if ((++_sp & 255u) == 0u) { if (xb_ld(&(bar)[XB_TMO])) break; if (_sp > XB_SPIN_CAP) { atomicAdd(&(bar)[XB_TMO], 1u); break; } } } } while (0)
struct XcdBarrier { unsigned* bar; unsigned x; volatile LAS unsigned* st; };
DI XcdBarrier xcd_barrier_post(const int WID, unsigned* bar, volatile LAS unsigned* st) {
    XcdBarrier b; b.bar = bar; b.x = xb_xcc_id(); b.st = st;
    if (opaque_tid(WID) == 0) (void)xb_add(&bar[XB_XCNT(b.x)], 1u);
    return b;
}
DI void xcd_barrier_complete(unsigned* bar, unsigned x, unsigned& nloc, unsigned& nx) {
    const unsigned G = gridDim.x * gridDim.y * gridDim.z;
    unsigned sum, cnt, mine, sp = 0u;
    for (;;) {
        sum = 0u; cnt = 0u; mine = 0u;
#pragma unroll
        for (unsigned j = 0; j < 16; ++j) { const unsigned c = xb_ld(&bar[XB_XCNT(j)]); sum += c; cnt += (c > 0u) ? 1u : 0u; mine = (j == x) ? c : mine; }
        if (sum == G) break;
        __builtin_amdgcn_s_sleep(1);
        if ((++sp & 255u) == 0u) { if (xb_ld(&bar[XB_TMO])) break; if (sp > XB_SPIN_CAP) { atomicAdd(&bar[XB_TMO], 1u); break; } }
    }
    nloc = mine > 0u ? mine : 1u; nx = cnt > 0u ? cnt : 1u;
}
DI void xcd_barrier(const int WID, const XcdBarrier& b) {
    asm volatile("s_waitcnt vmcnt(0)" ::: "memory");
    __syncthreads();
    if (opaque_tid(WID) == 0) {
        unsigned* bar = b.bar; asm volatile("" : "+s"(bar));
        __builtin_amdgcn_s_waitcnt(0);
        unsigned nloc = b.st[0], nx = b.st[1];
        if (nloc == 0u) { xcd_barrier_complete(bar, b.x, nloc, nx); b.st[0] = nloc; b.st[1] = nx; }
        const unsigned old = xb_add(&bar[XB_XSUB(b.x)], 1u);
        const unsigned gen = old / nloc;
        if (old + 1u == (gen + 1u) * nloc) {
            __builtin_amdgcn_fence(__ATOMIC_RELEASE, "agent");
            asm volatile("s_waitcnt vmcnt(0)" ::: "memory");
            const unsigned og = xb_add(&bar[XB_TOP], 1u);
            const unsigned tg = og / nx;
            if (og + 1u == (tg + 1u) * nx) xb_add(&bar[XB_TOPGEN], 1u);
            else XB_SPIN(xb_ld(&bar[XB_TOPGEN]) == tg, bar);
            __builtin_amdgcn_fence(__ATOMIC_ACQUIRE, "agent");
            xb_add(&bar[XB_XGEN(b.x)], 1u);
            asm volatile("s_waitcnt vmcnt(0)" ::: "memory");
        } else {
            XB_SPIN(xb_ld(&bar[XB_XGEN(b.x)]) == gen, bar);
            __builtin_amdgcn_fence(__ATOMIC_ACQUIRE, "agent");
            asm volatile("s_waitcnt vmcnt(0)" ::: "memory");
        }
    }
    __syncthreads();
}

namespace pg8 {
constexpr int BM = 256, BK = 64, HALF = 128, HTB = HALF * BK * 2, STAGE_BYTES = 8 * HTB, NXCD = 8, WGM = 8;
DI int lds_byte(int r, int c) { const int st = (r >> 4) * 2 + (c >> 5), rr = r & 15, cc = c & 31, ob = rr * 64 + cc * 2; return st * 1024 + (ob ^ (((ob >> 9) & 1) << 5)); }
DI void stage_rc(int b, int& R, int& C) { const int st = b / 1024, sb = b % 1024, swz = sb ^ (((sb >> 9) & 1) << 5); R = (st >> 1) * 16 + swz / 64; C = (st & 1) * 32 + (swz % 64) / 2; }
DI int perm32(int rho) { const int n = rho >> 4, i = rho & 15; return 8 * (i >> 2) + 4 * n + (i & 3); }
struct Unit { int pm, pn; };
struct Sched {
    int nM, nN, nwg, G, c;
    DI void init(int nM_, int nN_, int G_, int c_) { nM = nM_; nN = nN_; nwg = nM * nN; G = G_; c = c_; }
    DI bool next(int i, Unit& u) const {
        const long L = (long)i * G + c; if (L >= nwg) return false;
        int wgid = (int)L; { const int q = nwg / NXCD, r = nwg % NXCD, xcd = wgid % NXCD, off = wgid / NXCD; wgid = (xcd < r ? xcd * (q + 1) : r * (q + 1) + (xcd - r) * q) + off; }
        const int nig = WGM * nN, gid = wgid / nig, fm = gid * WGM, gsz = (nM - fm) < WGM ? (nM - fm) : WGM;
        u.pm = fm + ((wgid % nig) % gsz); u.pn = (wgid % nig) / gsz; return true;
    }
};
template <class Epi, class Prob>
DI void gemm_phase(const int WID, LAS unsigned char* lds, const Prob& P, const Sched& S, const Epi& E) {
    const int tid = opaque_tid(WID), wid = __builtin_amdgcn_readfirstlane(tid >> 6), lane = tid & 63, wr = wid >> 2, wc = wid & 3, fr = lane & 15, fq = lane >> 4;
    const int K = P.K, nt = K / BK;
    unsigned voffA[2], voffB[2];
#pragma unroll
    for (int i = 0; i < 2; ++i) { int R, C; stage_rc(tid * 16 + i * 8192, R, C); const int Rb = Epi::PERM ? ((R & ~31) + perm32(R & 31)) : R;
        voffA[i] = (unsigned)(R * P.lda + C) * 2u; voffB[i] = (unsigned)(Rb * P.ldb + C) * 2u; }
    const size_t kstep = (size_t)(BK * 2);
    const size_t hstepA = (size_t)HALF * P.lda * 2, hstepB = (size_t)HALF * P.ldb * 2;
    const unsigned ldsw = (unsigned)wid * 1024u;
    const int aoff = lds_byte(wr * 64 + fr, fq * 8), boff = lds_byte(wc * 32 + fr, fq * 8);
#define PG8_SA(b, h) (((b) * 2 + (h)) * HTB)
#define PG8_SB(b, h) ((4 + (b) * 2 + (h)) * HTB)
#define PG8_STAGE(bufoff, gbase, voff) do { _Pragma("unroll") for (int _i = 0; _i < 2; ++_i) \
        __builtin_amdgcn_global_load_lds((const unsigned*)((const char*)(gbase) + (voff)[_i]), (LAS unsigned*)(lds + (bufoff) + ldsw + _i * 8192), 16, 0, 0); } while (0)
#define PG8_LD16(off) (*(const LAS i32x4*)(lds + (off)))
#define PG8_LDA(dst, b, h) do { _Pragma("unroll") for (int m = 0; m < 4; ++m) { const i32x4 lo_ = PG8_LD16(PG8_SA(b, h) + aoff + m * 2048), hi_ = PG8_LD16(PG8_SA(b, h) + aoff + m * 2048 + 1024); dst[m] = __builtin_shufflevector(lo_, hi_, 0, 1, 2, 3, 4, 5, 6, 7); } } while (0)
#define PG8_LDB(dst, b, h) do { _Pragma("unroll") for (int n = 0; n < 2; ++n) { const i32x4 lo_ = PG8_LD16(PG8_SB(b, h) + boff + n * 2048), hi_ = PG8_LD16(PG8_SB(b, h) + boff + n * 2048 + 1024); dst[n] = __builtin_shufflevector(lo_, hi_, 0, 1, 2, 3, 4, 5, 6, 7); } } while (0)
#define PG8_LOH(X) __builtin_bit_cast(bf16x8, __builtin_shufflevector((X), (X), 0, 1, 2, 3))
#define PG8_HIH(X) __builtin_bit_cast(bf16x8, __builtin_shufflevector((X), (X), 4, 5, 6, 7))
#define PG8_MMA(ai, bj, At, Bt) do { __builtin_amdgcn_s_setprio(1); \
        if constexpr (Prob::FP8) { _Pragma("unroll") for (int m = 0; m < 4; ++m) _Pragma("unroll") for (int n = 0; n < 2; ++n) \
            asm volatile("v_mfma_scale_f32_16x16x128_f8f6f4 %0, %1, %2, %0, %3, %3 op_sel_hi:[0,0,0]" : "+v"(acc[ai][bj][m][n]) : "v"(Bt[n]), "v"(At[m]), "v"(sc1)); } \
        else { _Pragma("unroll") for (int m = 0; m < 4; ++m) _Pragma("unroll") for (int n = 0; n < 2; ++n) { \
            acc[ai][bj][m][n] = __builtin_amdgcn_mfma_f32_16x16x32_bf16(PG8_LOH(Bt[n]), PG8_LOH(At[m]), acc[ai][bj][m][n], 0, 0, 0); \
            acc[ai][bj][m][n] = __builtin_amdgcn_mfma_f32_16x16x32_bf16(PG8_HIH(Bt[n]), PG8_HIH(At[m]), acc[ai][bj][m][n], 0, 0, 0); } } \
        __builtin_amdgcn_s_setprio(0); } while (0)
#define PG8_WAIT_V(n) asm volatile("s_waitcnt vmcnt(" #n ")" ::: "memory")
#define PG8_WAIT_L(n) asm volatile("s_waitcnt lgkmcnt(" #n ")" ::: "memory")
#define PG8_BAR __builtin_amdgcn_s_barrier()
#define PG8_SCHED __builtin_amdgcn_sched_barrier(0)
    Unit cur, nxt; int ui = 0;
    if (!S.next(0, cur)) return;
    f32x4 acc[2][2][4][2];
#pragma unroll
    for (int a = 0; a < 2; ++a)
#pragma unroll
        for (int b = 0; b < 2; ++b)
#pragma unroll
            for (int m = 0; m < 4; ++m)
#pragma unroll
                for (int n = 0; n < 2; ++n) acc[a][b][m][n] = (f32x4){0.f, 0.f, 0.f, 0.f};
    i32x8 At[4], B0[2], B1[2];
    const int sc1 = 0x7f7f7f7f;
    const char* cA = P.a_base(cur); const char* cB = P.b_base(cur);
    PG8_STAGE(PG8_SB(0, 0), cB, voffB); PG8_STAGE(PG8_SA(0, 0), cA, voffA); PG8_STAGE(PG8_SB(0, 1), cB + hstepB, voffB); PG8_STAGE(PG8_SA(0, 1), cA + hstepA, voffA);
    if (wr == 1) PG8_BAR;
    PG8_WAIT_V(4); PG8_BAR;
    PG8_STAGE(PG8_SB(1, 0), cB + kstep, voffB); PG8_STAGE(PG8_SA(1, 0), cA + kstep, voffA); PG8_STAGE(PG8_SB(1, 1), cB + hstepB + kstep, voffB);
    PG8_WAIT_V(6); PG8_BAR;
    for (;;) {
        const bool has_next = S.next(ui + 1, nxt);
        const char* nA = has_next ? P.a_base(nxt) : cA; const char* nB = has_next ? P.b_base(nxt) : cB;
        for (int t = 0; t < nt; t += 2) {
            const bool last = (t == nt - 2);
            const char* a1 = cA + (size_t)(t + 1) * kstep;
            const char* a2 = last ? nA : cA + (size_t)(t + 2) * kstep; const char* b2 = last ? nB : cB + (size_t)(t + 2) * kstep;
            const char* a3 = a2 + kstep; const char* b3 = b2 + kstep;
            PG8_LDB(B0, 0, 0); PG8_SCHED; PG8_LDA(At, 0, 0); PG8_STAGE(PG8_SA(1, 1), a1 + hstepA, voffA);
            PG8_WAIT_L(8); PG8_BAR; PG8_WAIT_L(0); PG8_MMA(0, 0, At, B0); PG8_BAR; PG8_SCHED;
            PG8_LDB(B1, 0, 1); PG8_STAGE(PG8_SB(0, 0), b2, voffB);
            PG8_BAR; PG8_WAIT_L(0); PG8_MMA(0, 1, At, B1); PG8_BAR;
            PG8_LDA(At, 0, 1); PG8_STAGE(PG8_SA(0, 0), a2, voffA);
            PG8_BAR; PG8_WAIT_L(0); PG8_MMA(1, 0, At, B0); PG8_BAR; PG8_SCHED;
            PG8_STAGE(PG8_SB(0, 1), b2 + hstepB, voffB);
            PG8_WAIT_V(6); PG8_BAR; PG8_MMA(1, 1, At, B1); PG8_BAR;
            PG8_LDB(B0, 1, 0); PG8_SCHED; PG8_LDA(At, 1, 0); PG8_STAGE(PG8_SA(0, 1), a2 + hstepA, voffA);
            PG8_WAIT_L(8); PG8_BAR; PG8_WAIT_L(0); PG8_MMA(0, 0, At, B0); PG8_BAR; PG8_SCHED;
            PG8_LDB(B1, 1, 1); PG8_STAGE(PG8_SB(1, 0), b3, voffB);
            PG8_BAR; PG8_WAIT_L(0); PG8_MMA(0, 1, At, B1); PG8_BAR;
            PG8_LDA(At, 1, 1); PG8_STAGE(PG8_SA(1, 0), a3, voffA);
            PG8_BAR; PG8_WAIT_L(0); PG8_MMA(1, 0, At, B0); PG8_BAR; PG8_SCHED;
            PG8_STAGE(PG8_SB(1, 1), b3 + hstepB, voffB);
            PG8_WAIT_V(6); PG8_BAR; PG8_MMA(1, 1, At, B1); PG8_BAR;
        }
        if constexpr (Prob::FP8) {
            asm volatile("s_nop 15\n\ts_nop 15" ::: "memory");
#pragma unroll
            for (int a_ = 0; a_ < 2; ++a_)
#pragma unroll
                for (int b_ = 0; b_ < 2; ++b_)
#pragma unroll
                    for (int m_ = 0; m_ < 4; ++m_)
#pragma unroll
                        for (int n_ = 0; n_ < 2; ++n_) asm volatile("" : "+v"(acc[a_][b_][m_][n_]));
        }
        { int fr_ = fr, fq_ = fq, wr_ = wr, wc_ = wc; asm volatile("" : "+v"(fr_), "+v"(fq_), "+s"(wr_), "+s"(wc_));
          E(acc, cur, wr_, wc_, fr_, fq_); }
        if (!has_next) break;
#pragma unroll
        for (int a = 0; a < 2; ++a)
#pragma unroll
            for (int b = 0; b < 2; ++b)
#pragma unroll
                for (int m = 0; m < 4; ++m)
#pragma unroll
                    for (int n = 0; n < 2; ++n) acc[a][b][m][n] = (f32x4){0.f, 0.f, 0.f, 0.f};
        cur = nxt; cA = nA; cB = nB; ++ui;
    }
    PG8_WAIT_V(0);
    if (wr == 0) PG8_BAR;
    PG8_BAR;
#undef PG8_SA
#undef PG8_SB
#undef PG8_STAGE
#undef PG8_LDA
#undef PG8_LDB
#undef PG8_MMA
#undef PG8_LD16
#undef PG8_LOH
#undef PG8_HIH
#undef PG8_WAIT_V
#undef PG8_WAIT_L
#undef PG8_BAR
#undef PG8_SCHED
}
}
using pg8::Unit;
typedef f32x4 Acc[2][2][4][2];

struct ProbPlain { static constexpr bool FP8 = false; const bf16_t* A; const bf16_t* Bt; int lda, ldb, K;
    DI const char* a_base(const Unit& u) const { return (const char*)(A + (size_t)u.pm * 256 * lda); }
    DI const char* b_base(const Unit& u) const { return (const char*)(Bt + (size_t)u.pn * 256 * ldb); } };
struct ProbCmp1 { static constexpr bool FP8 = false; const bf16_t* KCB; const bf16_t* VCB; const bf16_t* W; int lda, ldb, K;
    DI const char* a_base(const Unit& u) const { const int kv = u.pm >> 4, rt = u.pm & 15; return (const char*)((kv ? VCB : KCB) + (size_t)rt * 256 * 1024); }
    DI const char* b_base(const Unit& u) const { const int kv = u.pm >> 4; return (const char*)(W + (size_t)kv * 256 * 2048); } };
struct ProbAtt { static constexpr bool FP8 = false; const bf16_t* AQ; const bf16_t* KP; int lda, ldb, K;
    DI const char* a_base(const Unit& u) const { const int z = u.pm, n = z & 7, h = (z >> 3) & 3, b = z >> 5; const size_t t0 = (size_t)b * 2048 + n * 256; return (const char*)(AQ + (t0 * 4 + h) * 512 + 256); }
    DI const char* b_base(const Unit& u) const { const int z = u.pm, n = z & 7, h = (z >> 3) & 3, b = z >> 5; const size_t t0 = (size_t)b * 2048 + n * 256; return (const char*)(KP + t0 * 1024 + h * 256); } };
struct ProbUT { static constexpr bool FP8 = false; const bf16_t* VS; const bf16_t* KT; int lda, ldb, K;
    DI const char* a_base(const Unit& u) const { const int z = u.pm >> 1, half = u.pm & 1; return (const char*)(VS + (size_t)z * 262144 + (size_t)half * 256 * 512); }
    DI const char* b_base(const Unit& u) const { const int z = u.pm >> 1; return (const char*)(KT + (size_t)z * 65536); } };
struct ProbY { static constexpr bool FP8 = false; const bf16_t* AQ; const bf16_t* VS; int lda, ldb, K;
    DI const char* a_base(const Unit& u) const { const int z = u.pm, n = z & 7, h = (z >> 3) & 3, b = z >> 5; const size_t t0 = (size_t)b * 2048 + n * 256; return (const char*)(AQ + (t0 * 4 + h) * 512); }
    DI const char* b_base(const Unit& u) const { return (const char*)(VS + (size_t)u.pm * 262144 + (size_t)u.pn * 256 * 512); } };
DI int moe_tile_expert(const LAS int* ts, int rt) { int e = 0;
#pragma unroll 8
    for (int i = 1; i < 32; ++i) e += (rt >= ts[i]) ? 1 : 0;
    return e; }
struct ProbMoe { static constexpr bool FP8 = false; const bf16_t* A; const bf16_t* W; const LAS int* ts; int nper; int lda, ldb, K;
    DI const char* a_base(const Unit& u) const { return (const char*)(A + (size_t)u.pm * 256 * 1024); }
    DI const char* b_base(const Unit& u) const { const int e = moe_tile_expert(ts, u.pm); return (const char*)(W + ((size_t)e * nper + (size_t)u.pn * 256) * 1024); } };

struct ProbPlain8 { static constexpr bool FP8 = true; const unsigned char* A; const unsigned char* Bt; int lda, ldb, K;
    DI const char* a_base(const Unit& u) const { return (const char*)(A + (size_t)u.pm * 256 * lda * 2); }
    DI const char* b_base(const Unit& u) const { return (const char*)(Bt + (size_t)u.pn * 256 * ldb * 2); } };
struct ProbMoe8 { static constexpr bool FP8 = true; const unsigned char* A; const unsigned char* W; const LAS int* ts; int nper; int lda, ldb, K;
    DI const char* a_base(const Unit& u) const { return (const char*)(A + (size_t)u.pm * 256 * 1024); }
    DI const char* b_base(const Unit& u) const { const int e = moe_tile_expert(ts, u.pm); return (const char*)(W + ((size_t)e * nper + (size_t)u.pn * 256) * 1024); } };

#define EPI_ROWS(ai, m) (128 * (ai) + 64 * wr + 16 * (m) + fr)
struct EpiEvNat { static constexpr bool PERM = true;
    unsigned char* ws; const float* gains;
    DI void operator()(const Acc& acc, const Unit& u, int wr, int wc, int fr, int fq) const {
        const int pn = u.pn; const bool norm = (pn != 6);
        const int gi = pn < 2 ? 0 : pn < 4 ? 1 : pn < 6 ? 2 : 3;
        const float* g = gains + gi * 64;
        f32x4 gv[2][2];
#pragma unroll
        for (int bj = 0; bj < 2; ++bj)
#pragma unroll
            for (int n = 0; n < 2; ++n) { const f32x4 t4 = *(const f32x4*)(g + 32 * bj + 8 * fq + 4 * n); gv[bj][n] = norm ? t4 : (f32x4){1.f, 1.f, 1.f, 1.f}; }
        size_t boff; int rowmul, hoff; bool panel = false;
        if (pn < 2) { boff = WS_QD; rowmul = 512; hoff = (pn * 4 + wc) * 64; }
        else if (pn < 4) { boff = WS_KD; rowmul = 512; hoff = ((pn - 2) * 4 + wc) * 64; }
        else if (pn < 6) { boff = WS_QN; rowmul = 512; hoff = ((pn - 4) * 4 + wc) * 64; }
        else { panel = true; rowmul = 64; hoff = 0; boff = (pn == 6) ? (wc < 2 ? WS_KCB : WS_VCB) : (wc < 2 ? WS_KSB : WS_KWB); }
        bf16_t* base = (bf16_t*)(ws + boff);
#pragma unroll
        for (int ai = 0; ai < 2; ++ai)
#pragma unroll
            for (int m = 0; m < 4; ++m) {
                const int t = u.pm * 256 + EPI_ROWS(ai, m), b = t >> 11, sq = t & 2047;
                float ss = 0.f;
#pragma unroll
                for (int bj = 0; bj < 2; ++bj)
#pragma unroll
                    for (int n = 0; n < 2; ++n) { const f32x4 x = acc[ai][bj][m][n]; ss += (x[0] * x[0] + x[1] * x[1]) + (x[2] * x[2] + x[3] * x[3]); }
                ss += __shfl_xor(ss, 16); ss += __shfl_xor(ss, 32);
                const float rstd = norm ? rsqrtf(ss * (1.0f / 64.0f) + EPS) * ((pn < 2 || pn == 4 || pn == 5) ? 0.125f : 1.0f) : 1.0f;
                const size_t rowi = panel ? ((size_t)(b * 2 + (wc & 1)) * 2048 + sq) : (size_t)t;
#pragma unroll
                for (int bj = 0; bj < 2; ++bj) {
                    const f32x4 v0 = acc[ai][bj][m][0] * rstd * gv[bj][0], v1 = acc[ai][bj][m][1] * rstd * gv[bj][1];
                    *(u32x4*)(base + rowi * rowmul + hoff + 32 * bj + 8 * fq) = pack8(v0, v1);
                }
            }
    }
};
struct EpiEvSw { static constexpr bool PERM = true;
    unsigned char* ws;
    DI void operator()(const Acc& acc, const Unit& u, int wr, int wc, int fr, int fq) const {
        const int b = u.pn >> 3, sb = (u.pn & 7) * 256;
#pragma unroll
        for (int ai = 0; ai < 2; ++ai)
#pragma unroll
            for (int m = 0; m < 4; ++m) {
                const int rl = EPI_ROWS(ai, m);
                size_t boff, rowi;
                if (u.pm < 2) { const int fg = u.pm * 256 + rl; boff = WS_VAT; rowi = (size_t)(b * 4 + (fg >> 7)) * 128 + (fg & 127); }
                else { const int r2 = rl & 127; boff = (rl < 128) ? WS_VST : WS_VWT; rowi = (size_t)(b * 2 + (r2 >> 6)) * 64 + (r2 & 63); }
                bf16_t* rowp = (bf16_t*)(ws + boff) + rowi * 2048;
#pragma unroll
                for (int bj = 0; bj < 2; ++bj) *(u32x4*)(rowp + sb + 128 * bj + 32 * wc + 8 * fq) = pack8(acc[ai][bj][m][0], acc[ai][bj][m][1]);
            }
    }
};
struct EpiCmp1 { static constexpr bool PERM = true;
    bf16_t* HID; const float* bias1;
    DI void operator()(const Acc& acc, const Unit& u, int wr, int wc, int fr, int fq) const {
        const int kv = u.pm >> 4, rt = u.pm & 15;
#pragma unroll
        for (int bj = 0; bj < 2; ++bj) {
            const int col = 128 * bj + 32 * wc + 8 * fq;
            const f32x4 b0 = *(const f32x4*)(bias1 + kv * 256 + col), b1 = *(const f32x4*)(bias1 + kv * 256 + col + 4);
#pragma unroll
            for (int ai = 0; ai < 2; ++ai)
#pragma unroll
                for (int m = 0; m < 4; ++m) {
                    f32x4 v0 = acc[ai][bj][m][0] + b0, v1 = acc[ai][bj][m][1] + b1;
#pragma unroll
                    for (int j = 0; j < 4; ++j) { v0[j] = v0[j] * sigm(v0[j]); v1[j] = v1[j] * sigm(v1[j]); }
                    *(u32x4*)(HID + ((size_t)kv * 4096 + rt * 256 + EPI_ROWS(ai, m)) * 256 + col) = pack8(v0, v1);
                }
        }
    }
};
struct EpiResid { static constexpr bool PERM = false;
    const float* Hin; float* Hout;
    DI void operator()(const Acc& acc, const Unit& u, int wr, int wc, int fr, int fq) const {
#pragma unroll
        for (int ai = 0; ai < 2; ++ai)
#pragma unroll
            for (int m = 0; m < 4; ++m) {
                const size_t off = (size_t)(u.pm * 256 + EPI_ROWS(ai, m)) * 1024 + u.pn * 256 + 32 * wc + 4 * fq;
#pragma unroll
                for (int bj = 0; bj < 2; ++bj)
#pragma unroll
                    for (int n = 0; n < 2; ++n) { const size_t o = off + 128 * bj + 16 * n; *(f32x4*)(Hout + o) = *(const f32x4*)(Hin + o) + acc[ai][bj][m][n]; }
            }
    }
};
DI float ret_lg2(int h) { return __log2f(1.0f - exp2f(-5.0f - (float)h)); }
struct EpiOdNat { static constexpr bool PERM = true;
    unsigned char* ws;
    DI void operator()(const Acc& acc, const Unit& u, int wr, int wc, int fr, int fq) const {
        const int pn = u.pn; const int h = pn & 3; const float lg = ret_lg2(h);
        const size_t boff = pn < 4 ? WS_AQ : pn < 8 ? WS_KP : WS_GG;
        const int rowmul = pn < 4 ? 2048 : pn < 8 ? 1024 : 2048;
        const int coff = pn < 4 ? (h * 512 + 256) : pn < 8 ? (h * 256) : ((pn - 8) * 256);
        bf16_t* base = (bf16_t*)(ws + boff) + coff;
#pragma unroll
        for (int ai = 0; ai < 2; ++ai)
#pragma unroll
            for (int m = 0; m < 4; ++m) {
                const int cl = EPI_ROWS(ai, m); const size_t t = (size_t)u.pm * 256 + cl;
                float sc = 1.f;
                if (pn < 4) sc = exp2f(lg * (float)(cl + 1)); else if (pn < 8) sc = 0.0625f * exp2f(-lg * (float)(cl + 1));
#pragma unroll
                for (int bj = 0; bj < 2; ++bj) {
                    const int d = 128 * bj + 32 * wc + 8 * fq;
                    f32x4 v0 = acc[ai][bj][m][0] * sc, v1 = acc[ai][bj][m][1] * sc;
                    if (pn >= 8) {
#pragma unroll
                        for (int j = 0; j < 4; ++j) { v0[j] = v0[j] * sigm(v0[j]); v1[j] = v1[j] * sigm(v1[j]); } }
                    *(u32x4*)(base + t * rowmul + d) = pack8(v0, v1);
                }
            }
    }
};
struct EpiOdSw { static constexpr bool PERM = true;
    unsigned char* ws;
    DI void operator()(const Acc& acc, const Unit& u, int wr, int wc, int fr, int fq) const {
        const int b = u.pn >> 3, n = u.pn & 7;
        const bool isk = u.pm < 4; const int h = isk ? u.pm : ((u.pm - 4) >> 1);
        const size_t z = (size_t)(b * 4 + h) * 8 + n; const float lg = ret_lg2(h);
        bf16_t* base = (bf16_t*)(ws + (isk ? WS_KT : WS_VS)) + (isk ? z * 65536 : z * 262144 + (size_t)((u.pm - 4) & 1) * 256 * 512);
        const int rowmul = isk ? 256 : 512;
#pragma unroll
        for (int bj = 0; bj < 2; ++bj) {
            const int cl = 128 * bj + 32 * wc + 8 * fq;
            f32x4 s0 = {1.f, 1.f, 1.f, 1.f}, s1 = s0;
            if (isk) {
#pragma unroll
                for (int j = 0; j < 4; ++j) { s0[j] = 0.0625f * exp2f(-lg * (float)(cl + j + 1)); s1[j] = 0.0625f * exp2f(-lg * (float)(cl + 4 + j + 1)); } }
#pragma unroll
            for (int ai = 0; ai < 2; ++ai)
#pragma unroll
                for (int m = 0; m < 4; ++m)
                    *(u32x4*)(base + (size_t)EPI_ROWS(ai, m) * rowmul + cl) = pack8(acc[ai][bj][m][0] * s0, acc[ai][bj][m][1] * s1);
        }
    }
};
struct EpiAtt { static constexpr bool PERM = true;
    bf16_t* AQ;
    DI void operator()(const Acc& acc, const Unit& u, int wr, int wc, int fr, int fq) const {
        const int z = u.pm, n = z & 7, h = (z >> 3) & 3, b = z >> 5; const size_t t0 = (size_t)b * 2048 + n * 256;
#pragma unroll
        for (int ai = 0; ai < 2; ++ai)
#pragma unroll
            for (int m = 0; m < 4; ++m) {
                const int c = EPI_ROWS(ai, m);
#pragma unroll
                for (int bj = 0; bj < 2; ++bj) {
                    const int e0 = 128 * bj + 32 * wc + 8 * fq;
                    f32x4 v0 = acc[ai][bj][m][0], v1 = acc[ai][bj][m][1];
#pragma unroll
                    for (int j = 0; j < 4; ++j) { v0[j] = (c >= e0 + j) ? v0[j] : 0.f; v1[j] = (c >= e0 + 4 + j) ? v1[j] : 0.f; }
                    *(u32x4*)(AQ + ((t0 + c) * 4 + h) * 512 + e0) = pack8(v0, v1);
                }
            }
    }
};
struct EpiUT { static constexpr bool PERM = true;
    bf16_t* UT;
    DI void operator()(const Acc& acc, const Unit& u, int wr, int wc, int fr, int fq) const {
        const size_t z = (size_t)(u.pm >> 1); const int half = u.pm & 1;
#pragma unroll
        for (int ai = 0; ai < 2; ++ai)
#pragma unroll
            for (int m = 0; m < 4; ++m) {
                bf16_t* rowp = UT + z * 131072 + (size_t)(half * 256 + EPI_ROWS(ai, m)) * 256 + 32 * wc + 8 * fq;
#pragma unroll
                for (int bj = 0; bj < 2; ++bj) *(u32x4*)(rowp + 128 * bj) = pack8(acc[ai][bj][m][0], acc[ai][bj][m][1]);
            }
    }
};
struct EpiY { static constexpr bool PERM = true;
    bf16_t* Y;
    DI void operator()(const Acc& acc, const Unit& u, int wr, int wc, int fr, int fq) const {
        const int z = u.pm, n = z & 7, h = (z >> 3) & 3, b = z >> 5; const size_t t0 = (size_t)b * 2048 + n * 256;
#pragma unroll
        for (int ai = 0; ai < 2; ++ai)
#pragma unroll
            for (int m = 0; m < 4; ++m) {
                bf16_t* rowp = Y + (t0 + EPI_ROWS(ai, m)) * 2048 + h * 512 + u.pn * 256 + 32 * wc + 8 * fq;
#pragma unroll
                for (int bj = 0; bj < 2; ++bj) *(u32x4*)(rowp + 128 * bj) = pack8(acc[ai][bj][m][0], acc[ai][bj][m][1]);
            }
    }
};
constexpr float W8_SCALE = 32.0f, WSC = 1.0f / W8_SCALE;
struct EpiGU { static constexpr bool PERM = true;
    unsigned char* ACT; const float* bgu; const LAS int* ts;
    DI void operator()(const Acc& acc, const Unit& u, int wr, int wc, int fr, int fq) const {
        const int e = moe_tile_expert(ts, u.pm); const int w = 32 * wc + 8 * fq;
        const float* bp = bgu + (size_t)e * 2048 + 128 * u.pn + w;
        const f32x4 bg0 = *(const f32x4*)bp, bg1 = *(const f32x4*)(bp + 4), bl0 = *(const f32x4*)(bp + 1024), bl1 = *(const f32x4*)(bp + 1028);
#pragma unroll
        for (int ai = 0; ai < 2; ++ai)
#pragma unroll
            for (int m = 0; m < 4; ++m) {
                f32x4 g0 = acc[ai][0][m][0] * WSC + bg0, g1 = acc[ai][0][m][1] * WSC + bg1, l0 = acc[ai][1][m][0] * WSC + bl0, l1 = acc[ai][1][m][1] * WSC + bl1;
#pragma unroll
                for (int j = 0; j < 4; ++j) {
                    const float a = fminf(g0[j], 7.0f), c = fminf(g1[j], 7.0f);
                    const float la = fminf(fmaxf(l0[j], -7.0f), 7.0f), lc = fminf(fmaxf(l1[j], -7.0f), 7.0f);
                    g0[j] = a * sigm(1.702f * a) * (la + 1.0f); g1[j] = c * sigm(1.702f * c) * (lc + 1.0f); }
                u32x2 o8; o8.x = pk4_fp8(g0[0], g0[1], g0[2], g0[3]); o8.y = pk4_fp8(g1[0], g1[1], g1[2], g1[3]);
                *(u32x2*)(ACT + ((size_t)u.pm * 256 + EPI_ROWS(ai, m)) * 1024 + 128 * u.pn + w) = o8;
            }
    }
};
struct EpiDN { static constexpr bool PERM = true;
    bf16_t* YB; const float* bdn; const LAS int* ts;
    DI void operator()(const Acc& acc, const Unit& u, int wr, int wc, int fr, int fq) const {
        const int e = moe_tile_expert(ts, u.pm);
#pragma unroll
        for (int bj = 0; bj < 2; ++bj) {
            const int col = 256 * u.pn + 128 * bj + 32 * wc + 8 * fq;
            const f32x4 b0 = *(const f32x4*)(bdn + (size_t)e * 1024 + col), b1 = *(const f32x4*)(bdn + (size_t)e * 1024 + col + 4);
#pragma unroll
            for (int ai = 0; ai < 2; ++ai)
#pragma unroll
                for (int m = 0; m < 4; ++m)
                    *(u32x4*)(YB + ((size_t)u.pm * 256 + EPI_ROWS(ai, m)) * 1024 + col) = pack8(acc[ai][bj][m][0] * (1.0f / 64.0f) + b0, acc[ai][bj][m][1] * (1.0f / 64.0f) + b1);
        }
    }
};
struct EpiPP { static constexpr bool PERM = true;
    bf16_t* PP;
    DI void operator()(const Acc& acc, const Unit& u, int wr, int wc, int fr, int fq) const {
#pragma unroll
        for (int ai = 0; ai < 2; ++ai)
#pragma unroll
            for (int m = 0; m < 4; ++m) {
                bf16_t* rowp = PP + ((size_t)u.pm * 256 + EPI_ROWS(ai, m)) * 1024 + u.pn * 256 + 32 * wc + 8 * fq;
#pragma unroll
                for (int bj = 0; bj < 2; ++bj) *(u32x4*)(rowp + 128 * bj) = pack8(acc[ai][bj][m][0], acc[ai][bj][m][1]);
            }
    }
};
struct EpiPLE { static constexpr bool PERM = false;
    float* H; const bf16_t* PP;
    DI void operator()(const Acc& acc, const Unit& u, int wr, int wc, int fr, int fq) const {
#pragma unroll
        for (int ai = 0; ai < 2; ++ai)
#pragma unroll
            for (int m = 0; m < 4; ++m) {
                const size_t off = (size_t)(u.pm * 256 + EPI_ROWS(ai, m)) * 1024 + u.pn * 256 + 32 * wc + 4 * fq;
#pragma unroll
                for (int bj = 0; bj < 2; ++bj)
#pragma unroll
                    for (int n = 0; n < 2; ++n) {
                        const size_t o = off + 128 * bj + 16 * n;
                        const u32x2 pw = *(const u32x2*)(PP + o); const f32x4 a = acc[ai][bj][m][n]; f32x4 hv = *(const f32x4*)(H + o);
                        hv[0] += sigm(a[0] * WSC) * bflo(pw.x); hv[1] += sigm(a[1] * WSC) * bfhi(pw.x); hv[2] += sigm(a[2] * WSC) * bflo(pw.y); hv[3] += sigm(a[3] * WSC) * bfhi(pw.y);
                        *(f32x4*)(H + o) = hv;
                    }
            }
    }
};

constexpr int AT_KSTR = 144;
template <int DV, int MODE>
DI void attn_unit(const int WID, LAS unsigned char* lds, const bf16_t* Qp, int ldq, const bf16_t* Kp, int ldk, const bf16_t* Vt, int ldvt, int q0, float slope, int dcut,
                  const unsigned* selp, bf16_t* Op, int ldo, float* impp) {
    constexpr int NRB = DV / 32, VPIECES = DV * 8;
    constexpr int KB0 = 0, KB1 = 64 * AT_KSTR, VB0 = 2 * 64 * AT_KSTR, VB1 = VB0 + DV * AT_KSTR;
    const int tid = opaque_tid(WID), w = __builtin_amdgcn_readfirstlane(tid >> 6), lane = tid & 63, r = lane & 31, hh = lane >> 5;
    const int qrow = q0 + 32 * w + r, qw_first = q0 + 32 * w, qw_last = qw_first + 31;
    const float LOG2E = 1.44269504089f;
    bf16x8 qf[4];
#pragma unroll
    for (int ks = 0; ks < 4; ++ks) qf[ks] = *(const bf16x8*)(Qp + (size_t)(32 * w + r) * ldq + 16 * ks + 8 * hh);
    unsigned selm = 0xffffffffu, orm = 0xffffffffu;
    if (MODE == 1) { selm = selp[32 * w + r]; orm = selm;
#pragma unroll
        for (int o = 1; o < 32; o <<= 1) orm |= __shfl_xor(orm, o); }
    const int nv = (MODE == 3) ? (qrow >= 31 ? ((qrow - 15) >> 4) : 0) : 0;
    const int nv_wmax = (MODE == 3) ? (qw_last >= 31 ? ((qw_last - 15) >> 4) : 0) : 0;
    int kt_lo = 0, kt_hi;
    if (MODE == 0 || MODE == 1) kt_hi = (q0 >> 6) + 4;
    else if (MODE == 2) { kt_hi = (q0 >> 6) + 4; const int lk = q0 - 511; kt_lo = lk > 0 ? (lk >> 6) : 0; }
    else kt_hi = 2;
    if (MODE != 3) { const int kmin = q0 - dcut; const int lo2 = kmin > 0 ? (kmin >> 6) : 0; kt_lo = lo2 > kt_lo ? lo2 : kt_lo; }
    f32x16 cb[2];
#pragma unroll
    for (int kk = 0; kk < 2; ++kk)
#pragma unroll
        for (int i = 0; i < 16; ++i) cb[kk][i] = (MODE == 3) ? 0.f : slope * (float)(32 * kk + 8 * (i >> 2) + (i & 3) + 4 * hh);
    f32x16 O[NRB];
#pragma unroll
    for (int rb = 0; rb < NRB; ++rb)
#pragma unroll
        for (int i = 0; i < 16; ++i) O[rb][i] = 0.f;
    float mrun = NEGF, lrun = 0.f;
    u32x4 kreg, vreg[2];
    const int krow = tid >> 3, kpc = tid & 7;
#define AT_GLOAD(kt) do { kreg = *(const u32x4*)(Kp + (size_t)(64 * (kt) + krow) * ldk + 8 * kpc); \
        _Pragma("unroll") for (int i_ = 0; i_ < 2; ++i_) { const int idx = tid + 512 * i_; if (idx < VPIECES) vreg[i_] = *(const u32x4*)(Vt + (size_t)(idx >> 3) * ldvt + 64 * (kt) + 8 * (idx & 7)); } } while (0)
#define AT_LWRITE(buf) do { *(LAS u32x4*)(lds + ((buf) ? KB1 : KB0) + krow * AT_KSTR + kpc * 16) = kreg; \
        _Pragma("unroll") for (int i_ = 0; i_ < 2; ++i_) { const int idx = tid + 512 * i_; if (idx < VPIECES) { const int p_ = idx & 7; \
            LAS unsigned char* d_ = lds + ((buf) ? VB1 : VB0) + (idx >> 3) * AT_KSTR + (p_ >> 1) * 32 + (p_ & 1) * 8; \
            *(LAS u32x2*)d_ = (u32x2){vreg[i_].x, vreg[i_].y}; *(LAS u32x2*)(d_ + 16) = (u32x2){vreg[i_].z, vreg[i_].w}; } } } while (0)
    AT_GLOAD(kt_hi - 1); AT_LWRITE(0);
    __syncthreads();
    const int ntile = kt_hi - kt_lo;
    for (int it = 0; it < ntile; ++it) {
        const int kt = kt_hi - 1 - it, buf = it & 1, key0 = 64 * kt;
        if (it + 1 < ntile) AT_GLOAD(kt - 1);
        bool skip;
        if (MODE == 0) skip = key0 > qw_last;
        else if (MODE == 1) skip = (key0 > qw_last) || !((orm >> kt) & 1u);
        else if (MODE == 2) skip = (key0 > qw_last) || (key0 + 63 < qw_first - 511);
        else skip = key0 >= nv_wmax;
        if (!skip) {
            const LAS unsigned char* kb = lds + (buf ? KB1 : KB0); const LAS unsigned char* vb = lds + (buf ? VB1 : VB0);
            f32x16 S[2];
#pragma unroll
            for (int kk = 0; kk < 2; ++kk) {
                S[kk] = cb[kk];
#pragma unroll
                for (int ks = 0; ks < 4; ++ks) { const bf16x8 a = *(const LAS bf16x8*)(kb + (32 * kk + r) * AT_KSTR + (16 * ks + 8 * hh) * 2);
                    S[kk] = __builtin_amdgcn_mfma_f32_32x32x16_bf16(a, qf[ks], S[kk], 0, 0, 0); }
            }
            const bool bnd = (MODE == 3) ? true : ((key0 + 63 > qw_first) || (MODE == 2 && key0 < qw_last - 511));
            if (bnd) {
                const int lim = (MODE == 3) ? (nv - key0 - 4 * hh) : (qrow - key0 - 4 * hh);
#pragma unroll
                for (int kk = 0; kk < 2; ++kk)
#pragma unroll
                    for (int i = 0; i < 16; ++i) { const int cki = 32 * kk + 8 * (i >> 2) + (i & 3);
                        bool valid;
                        if (MODE == 3) valid = cki < lim; else if (MODE == 2) valid = (cki <= lim) && (cki > lim - 512); else valid = cki <= lim;
                        S[kk][i] = valid ? S[kk][i] : NEGF; }
            }
            float mx = NEGF;
#pragma unroll
            for (int kk = 0; kk < 2; ++kk)
#pragma unroll
                for (int i = 0; i < 16; ++i) mx = fmaxf(mx, S[kk][i]);
            mx = fmaxf(mx, __shfl_xor(mx, 32));
            const float off = (MODE == 3) ? 0.f : slope * (float)key0;
            mx += off;
            bool selok = true;
            if (MODE == 1) { selok = ((selm >> kt) & 1u) != 0u; mx = selok ? mx : NEGF; }
            const float mnew = fmaxf(mrun, mx);
            const float meff = (mnew < -1e29f) ? 0.f : mnew;
            float c = (off - meff) * LOG2E;
            if (MODE == 1) c = selok ? c : NEGF;
            float ps = 0.f;
#pragma unroll
            for (int kk = 0; kk < 2; ++kk)
#pragma unroll
                for (int i = 0; i < 16; ++i) { const float p = __builtin_amdgcn_exp2f(__builtin_fmaf(S[kk][i], LOG2E, c)); S[kk][i] = p; ps += p; }
            if (__any(mnew > mrun)) {
                const float alpha = __builtin_amdgcn_exp2f((mrun - mnew) * LOG2E);
                lrun *= alpha;
#pragma unroll
                for (int rb = 0; rb < NRB; ++rb)
#pragma unroll
                    for (int i = 0; i < 16; ++i) O[rb][i] *= alpha;
            }
            mrun = mnew; lrun += ps;
#pragma unroll
            for (int kk = 0; kk < 2; ++kk)
#pragma unroll
                for (int s2 = 0; s2 < 2; ++s2) {
                    u32x4 pw; pw.x = pk2(S[kk][8 * s2 + 0], S[kk][8 * s2 + 1]); pw.y = pk2(S[kk][8 * s2 + 2], S[kk][8 * s2 + 3]);
                    pw.z = pk2(S[kk][8 * s2 + 4], S[kk][8 * s2 + 5]); pw.w = pk2(S[kk][8 * s2 + 6], S[kk][8 * s2 + 7]);
                    const bf16x8 pf = __builtin_bit_cast(bf16x8, pw);
#pragma unroll
                    for (int rb = 0; rb < NRB; ++rb) {
                        const bf16x8 a = *(const LAS bf16x8*)(vb + (32 * rb + r) * AT_KSTR + (2 * kk + s2) * 32 + hh * 16);
                        O[rb] = __builtin_amdgcn_mfma_f32_32x32x16_bf16(a, pf, O[rb], 0, 0, 0);
                    }
                }
        }
        if (it + 1 < ntile) AT_LWRITE(buf ^ 1);
        __syncthreads();
    }
#undef AT_GLOAD
#undef AT_LWRITE
    const float ltot = lrun + __shfl_xor(lrun, 32);
    float inv = 1.0f / ltot;
    if (MODE == 3) inv = (nv > 0) ? inv : 0.f;
#pragma unroll
    for (int rb = 0; rb < NRB; ++rb)
#pragma unroll
        for (int g4 = 0; g4 < 4; ++g4) {
            const float a = O[rb][4 * g4] * inv, b = O[rb][4 * g4 + 1] * inv, c = O[rb][4 * g4 + 2] * inv, d = O[rb][4 * g4 + 3] * inv;
            const int dv = 32 * rb + 8 * g4 + 4 * hh;
            if (MODE == 3 && rb == 2) { *(f32x4*)(impp + (size_t)(32 * w + r) * 256 + (dv - 64)) = (f32x4){a, b, c, d}; }
            else { u32x2 o; o.x = pk2(a, b); o.y = pk2(c, d); *(u32x2*)(Op + (size_t)(32 * w + r) * ldo + dv) = o; }
        }
}

struct Args { const float* in[26]; float* out; unsigned char* ws; int ph_lo, ph_hi; };
typedef const __attribute__((address_space(4))) Args* ArgsP;
DI ArgsP opaque_args() { auto p = __builtin_amdgcn_kernarg_segment_ptr(); asm volatile("" : "+s"(p)); return (ArgsP)p; }
enum { I_X = 0, I_P, I_N1G, I_N2G, I_EVWIN, I_EVWOUT, I_DAQN, I_DAKN, I_DALAM, I_DAOUTG, I_NSQN, I_NSKN, I_CMPPE, I_CMPW1, I_CMPW2, I_ODWIN, I_ODWOUT,
       I_RETG, I_ROUTW, I_ROUTB, I_WGU, I_BGU, I_WDN, I_BDN, I_PLEP, I_PLEG };

struct CvtJob { int in_idx, ldsrc, K, col0, ncols, dstrow0, perm, nmat; size_t src_stride, dst_off, dst_stride; int fp8, pad; };
constexpr int NJOBS = 19;
__constant__ CvtJob c_jobs[NJOBS] = {
    {I_EVWIN, EVIN, 1024, 0,    1024, 0,    1, 2, (size_t)1024 * EVIN, WS_EVNAT, (size_t)2048 * 1024, 0, 0},
    {I_EVWIN, EVIN, 1024, 1536, 512,  1024, 1, 2, (size_t)1024 * EVIN, WS_EVNAT, (size_t)2048 * 1024, 0, 0},
    {I_EVWIN, EVIN, 1024, 2048, 128,  1536, 1, 2, (size_t)1024 * EVIN, WS_EVNAT, (size_t)2048 * 1024, 0, 0},
    {I_EVWIN, EVIN, 1024, 2176, 128,  1664, 1, 2, (size_t)1024 * EVIN, WS_EVNAT, (size_t)2048 * 1024, 0, 0},
    {I_EVWIN, EVIN, 1024, 2304, 128,  1792, 1, 2, (size_t)1024 * EVIN, WS_EVNAT, (size_t)2048 * 1024, 0, 0},
    {I_EVWIN, EVIN, 1024, 2560, 128,  1920, 1, 2, (size_t)1024 * EVIN, WS_EVNAT, (size_t)2048 * 1024, 0, 0},
    {I_EVWIN, EVIN, 1024, 1024, 512,  0,    0, 2, (size_t)1024 * EVIN, WS_EVSW,  (size_t)768 * 1024, 0, 0},
    {I_EVWIN, EVIN, 1024, 2432, 128,  512,  0, 2, (size_t)1024 * EVIN, WS_EVSW,  (size_t)768 * 1024, 0, 0},
    {I_EVWIN, EVIN, 1024, 2688, 128,  640,  0, 2, (size_t)1024 * EVIN, WS_EVSW,  (size_t)768 * 1024, 0, 0},
    {I_EVWOUT, 1024, 1024, 0, 1024, 0, 0, 2, (size_t)1024 * 1024, WS_EVOUT, (size_t)1024 * 1024, 0, 0},
    {I_CMPW1, 256, 2048, 0, 256, 0, 0, 4, (size_t)2048 * 256, WS_CMP1, (size_t)256 * 2048, 0, 0},
    {I_ODWIN, ODIN, 1024, 0,    2048, 0,    0, 2, (size_t)1024 * ODIN, WS_ODNAT, (size_t)4096 * 1024, 0, 0},
    {I_ODWIN, ODIN, 1024, 4096, 2048, 2048, 0, 2, (size_t)1024 * ODIN, WS_ODNAT, (size_t)4096 * 1024, 0, 0},
    {I_ODWIN, ODIN, 1024, 1024, 3072, 0,    0, 2, (size_t)1024 * ODIN, WS_ODSW,  (size_t)3072 * 1024, 0, 0},
    {I_ODWOUT, 1024, 2048, 0, 1024, 0, 0, 2, (size_t)2048 * 1024, WS_ODOUT, (size_t)1024 * 2048, 0, 0},
    {I_WGU, 2048, 1024, 0, 2048, 0, 2, 128, (size_t)1024 * 2048, WS_WGU, (size_t)2048 * 1024, 32, 0},
    {I_WDN, 1024, 1024, 0, 1024, 0, 0, 128, (size_t)1024 * 1024, WS_WDN, (size_t)1024 * 1024, 64, 0},
    {I_PLEP, 1024, 256, 0, 1024, 0, 0, 4, (size_t)256 * 1024, WS_WPP, (size_t)1024 * 256, 0, 0},
    {I_PLEG, 1024, 1024, 0, 1024, 0, 0, 4, (size_t)1024 * 1024, WS_WPG, (size_t)1024 * 1024, 32, 0},
};
DI int cvt_dstrow(int perm, int L) {
    if (perm == 1) { const int pn = L >> 8, lc = L & 255; return pn * 256 + 128 * ((lc & 63) >> 5) + 32 * (lc >> 6) + (lc & 31); }
    if (perm == 2) { const int bj = L >> 10, cc = L & 1023; return 256 * (cc >> 7) + 128 * bj + (cc & 127); }
    return L;
}
DI void phase_prologue(const int WID, ArgsP a, LAS unsigned char* lds) {
    const int tid = opaque_tid(WID), lane = tid & 63, wv = tid >> 6;
    const int gw = blockIdx.x * 8 + wv, NGW = gridDim.x * 8;
    LAS float* scr = (LAS float*)(lds + wv * 16640);
    int total = 0;
    for (int j = 0; j < NJOBS; ++j) total += c_jobs[j].nmat * (c_jobs[j].K >> 6) * (c_jobs[j].ncols >> 6);
#define PRO_DECODE(IT, JJ, MAT, K0, N0, SRC) do { int r_ = (IT), j_ = 0; \
        for (; j_ < NJOBS; ++j_) { const int n_ = c_jobs[j_].nmat * (c_jobs[j_].K >> 6) * (c_jobs[j_].ncols >> 6); if (r_ < n_) break; r_ -= n_; } \
        JJ = j_; const int nkb_ = c_jobs[j_].K >> 6, nnb_ = c_jobs[j_].ncols >> 6, per_ = nkb_ * nnb_; MAT = r_ / per_; const int rr_ = r_ % per_; K0 = (rr_ / nnb_) * 64; N0 = (rr_ % nnb_) * 64; \
        SRC = a->in[c_jobs[j_].in_idx] + (size_t)MAT * c_jobs[j_].src_stride + (size_t)K0 * c_jobs[j_].ldsrc + c_jobs[j_].col0 + N0 + lane; } while (0)
    float tv[64];
    int jn = 0, matn = 0, k0n = 0, n0n = 0; const float* srcn = nullptr;
    if (gw < total) { PRO_DECODE(gw, jn, matn, k0n, n0n, srcn); const int lds_ = c_jobs[jn].ldsrc;
#pragma unroll
        for (int i = 0; i < 64; ++i) tv[i] = srcn[(size_t)i * lds_]; }
    for (int it = gw; it < total; it += NGW) {
        const CvtJob J = c_jobs[jn]; const int mat = matn, k0 = k0n, n0 = n0n;
#pragma unroll
        for (int i = 0; i < 64; ++i) scr[i * 65 + lane] = tv[i];
        if (it + NGW < total) { PRO_DECODE(it + NGW, jn, matn, k0n, n0n, srcn); const int lds_ = c_jobs[jn].ldsrc;
#pragma unroll
            for (int i = 0; i < 64; ++i) tv[i] = srcn[(size_t)i * lds_]; }
        asm volatile("s_waitcnt lgkmcnt(0)" ::: "memory");
        if (J.fp8) {
            unsigned char* dst = (unsigned char*)(a->ws + J.dst_off) + (size_t)mat * J.dst_stride;
            const int c = lane & 3, nsub = lane >> 2; const float W8_S = (float)J.fp8;
#pragma unroll
            for (int jj = 0; jj < 4; ++jj) {
                const int n = nsub + 16 * jj; const LAS float* s = scr + (16 * c) * 65 + n;
                u32x4 o;
                o.x = pk4_fp8(s[0] * W8_S, s[65] * W8_S, s[2 * 65] * W8_S, s[3 * 65] * W8_S); o.y = pk4_fp8(s[4 * 65] * W8_S, s[5 * 65] * W8_S, s[6 * 65] * W8_S, s[7 * 65] * W8_S);
                o.z = pk4_fp8(s[8 * 65] * W8_S, s[9 * 65] * W8_S, s[10 * 65] * W8_S, s[11 * 65] * W8_S); o.w = pk4_fp8(s[12 * 65] * W8_S, s[13 * 65] * W8_S, s[14 * 65] * W8_S, s[15 * 65] * W8_S);
                const int drow = cvt_dstrow(J.perm, J.dstrow0 + n0 + n);
                *(u32x4*)(dst + (size_t)drow * J.K + k0 + 16 * c) = o;
            }
        } else {
            bf16_t* dst = (bf16_t*)(a->ws + J.dst_off) + (size_t)mat * J.dst_stride;
            const int c = lane & 7, nsub = lane >> 3;
#pragma unroll
            for (int jj = 0; jj < 8; ++jj) {
                const int n = nsub + 8 * jj; const LAS float* s = scr + (8 * c) * 65 + n;
                u32x4 o; o.x = pk2(s[0], s[65]); o.y = pk2(s[2 * 65], s[3 * 65]); o.z = pk2(s[4 * 65], s[5 * 65]); o.w = pk2(s[6 * 65], s[7 * 65]);
                const int drow = cvt_dstrow(J.perm, J.dstrow0 + n0 + n);
                *(u32x4*)(dst + (size_t)drow * J.K + k0 + 8 * c) = o;
            }
        }
        asm volatile("s_waitcnt lgkmcnt(0)" ::: "memory");
    }
#undef PRO_DECODE
    {
        const float* p = a->in[I_P]; bf16_t* pb = (bf16_t*)(a->ws + WS_PBF);
        const size_t n8 = (size_t)DEPTH * T * 256 / 8;
        for (size_t i = (size_t)blockIdx.x * 512 + tid; i < n8; i += (size_t)gridDim.x * 512) {
            const f32x4 v0 = *(const f32x4*)(p + i * 8), v1 = *(const f32x4*)(p + i * 8 + 4);
            *(u32x4*)(pb + i * 8) = pack8(v0, v1);
        }
    }
    if (blockIdx.x == 4 && tid < 512) { const int ev = tid >> 8, gi = (tid >> 6) & 3, d = tid & 63;
        const float* src = a->in[gi == 0 ? I_DAQN : gi == 1 ? I_DAKN : gi == 2 ? I_NSQN : I_NSKN];
        ((float*)(a->ws + WS_GAINS))[tid] = src[ev * 64 + d]; }
    if (blockIdx.x < 4 && tid < 256) {
        const int m = blockIdx.x; const float* pe = a->in[I_CMPPE] + (size_t)m * 2048; const float* w1 = a->in[I_CMPW1] + (size_t)m * 2048 * 256;
        float s = 0.f;
        for (int k = 0; k < 2048; ++k) s += pe[k] * w1[(size_t)k * 256 + tid];
        ((float*)(a->ws + WS_BIAS1))[m * 256 + tid] = s;
    }
}

DI float row_load_ss(const float* row, int lane, f32x4 (&v)[4]) {
    float ss = 0.f;
#pragma unroll
    for (int j = 0; j < 4; ++j) { v[j] = *(const f32x4*)(row + 4 * lane + 256 * j); ss += (v[j][0] * v[j][0] + v[j][1] * v[j][1]) + (v[j][2] * v[j][2] + v[j][3] * v[j][3]); }
    return wave_sum(ss);
}
DI void row_store_bf16(bf16_t* row, int lane, const f32x4 (&v)[4]) {
#pragma unroll
    for (int j = 0; j < 4; ++j) { u32x2 o; o.x = pk2(v[j][0], v[j][1]); o.y = pk2(v[j][2], v[j][3]); *(u32x2*)(row + 4 * lane + 256 * j) = o; }
}
template <int MODE>
DI void phase_norm(const int WID, ArgsP a, LAS unsigned char* lds, int layer, const float* Hin) {
    const int tid = opaque_tid(WID), lane = tid & 63, wv = __builtin_amdgcn_readfirstlane(tid >> 6);
    LAS float* wt = (LAS float*)lds;
    LAS int* bcl = (LAS int*)(lds + MISC_OFF + MO_WCNT); LAS int* ent = (LAS int*)(lds + MISC_OFF + MO_ENT); LAS float* gat = (LAS float*)(lds + MISC_OFF + MO_GAT);
    LAS float* lgb = (LAS float*)(lds + MISC_OFF + MO_RED);
    bf16_t* XN = (bf16_t*)(a->ws + WS_XN);
    const float* gain = a->in[MODE == 2 ? I_N2G : I_N1G] + layer * 1024;
    constexpr int NQ = MODE == 0 ? 24 : (MODE == 2 ? 32 : 0);
    if (NQ > 0) {
        const float* w = (MODE == 0) ? a->in[I_EVWIN] + (size_t)(layer >> 1) * 1024 * EVIN + 2816 : a->in[I_ROUTW] + (size_t)layer * 1024 * 32;
        const int ldw = (MODE == 0) ? EVIN : 32;
        for (int i = tid; i < 256 * 32; i += 512) { const int q = i & 31, g = i >> 5;
            if (q < NQ) { f32x4 v; v[0] = w[(size_t)(4 * g) * ldw + q]; v[1] = w[(size_t)(4 * g + 1) * ldw + q]; v[2] = w[(size_t)(4 * g + 2) * ldw + q]; v[3] = w[(size_t)(4 * g + 3) * ldw + q];
                *(LAS f32x4*)(wt + q * 1024 + 4 * (g ^ q)) = v; } }
    }
    f32x4 gn[4];
#pragma unroll
    for (int j = 0; j < 4; ++j) gn[j] = *(const f32x4*)(gain + 4 * lane + 256 * j);
    const float rbias = (MODE == 2) ? a->in[I_ROUTB][layer * 32 + (lane & 31)] : 0.f;
    __syncthreads();
    for (int vb = blockIdx.x; vb < NTB; vb += gridDim.x) {
        if (MODE == 2) { if (tid < 32) bcl[tid] = 0; }
        const int t0 = vb * 128 + wv * 16;
        f32x4 na[4], nb[4];
#pragma unroll
        for (int j = 0; j < 4; ++j) { na[j] = *(const f32x4*)(Hin + (size_t)t0 * 1024 + 4 * lane + 256 * j); nb[j] = *(const f32x4*)(Hin + (size_t)(t0 + 1) * 1024 + 4 * lane + 256 * j); }
#pragma unroll 1
        for (int it = 0; it < 8; ++it) {
            const int ta = t0 + 2 * it;
            f32x4 va[4], vc[4];
#pragma unroll
            for (int j = 0; j < 4; ++j) { va[j] = na[j]; vc[j] = nb[j]; }
            if (it < 7) {
#pragma unroll
                for (int j = 0; j < 4; ++j) { na[j] = *(const f32x4*)(Hin + (size_t)(ta + 2) * 1024 + 4 * lane + 256 * j); nb[j] = *(const f32x4*)(Hin + (size_t)(ta + 3) * 1024 + 4 * lane + 256 * j); }
            }
            float sa = 0.f, sb = 0.f;
#pragma unroll
            for (int j = 0; j < 4; ++j) { sa += (va[j][0] * va[j][0] + va[j][1] * va[j][1]) + (va[j][2] * va[j][2] + va[j][3] * va[j][3]); sb += (vc[j][0] * vc[j][0] + vc[j][1] * vc[j][1]) + (vc[j][2] * vc[j][2] + vc[j][3] * vc[j][3]); }
#pragma unroll
            for (int o = 1; o < 64; o <<= 1) { sa += __shfl_xor(sa, o); sb += __shfl_xor(sb, o); }
            const float ra = rsqrtf(sa * (1.0f / 1024.0f) + EPS), rb2 = rsqrtf(sb * (1.0f / 1024.0f) + EPS);
#pragma unroll
            for (int j = 0; j < 4; ++j) { va[j] = va[j] * ra * gn[j]; vc[j] = vc[j] * rb2 * gn[j]; }
            row_store_bf16(XN + (size_t)ta * 1024, lane, va); row_store_bf16(XN + (size_t)(ta + 1) * 1024, lane, vc);
            if (NQ > 0) {
                float x[64];
#pragma unroll
                for (int q = 0; q < 32; ++q) {
                    if (q < NQ) { float s0 = 0.f, s1 = 0.f;
#pragma unroll
                        for (int j = 0; j < 4; ++j) { const f32x4 ww = *(const LAS f32x4*)(wt + q * 1024 + 4 * ((lane + 64 * j) ^ q));
                            s0 += (va[j][0] * ww[0] + va[j][1] * ww[1]) + (va[j][2] * ww[2] + va[j][3] * ww[3]); s1 += (vc[j][0] * ww[0] + vc[j][1] * ww[1]) + (vc[j][2] * ww[2] + vc[j][3] * ww[3]); }
                        x[q] = s0; x[32 + q] = s1;
                        if ((q & 3) == 3) asm volatile("" ::: "memory");
                    } else { x[q] = 0.f; x[32 + q] = 0.f; }
                }
#define RS_STEP(N, BIT) _Pragma("unroll") for (int i = 0; i < (N); ++i) { const bool up = (lane & (BIT)) != 0; const float keep = up ? x[(N) + i] : x[i], send = up ? x[i] : x[(N) + i]; x[i] = keep + __shfl_xor(send, (BIT)); }
                RS_STEP(32, 32) RS_STEP(16, 16) RS_STEP(8, 8) RS_STEP(4, 4) RS_STEP(2, 2) RS_STEP(1, 1)
#undef RS_STEP
                const float val = x[0];
                if (MODE == 0) { if ((lane & 31) < 24) ((float*)(a->ws + WS_GATES))[(size_t)(ta + (lane >> 5)) * 24 + (lane & 31)] = sigm(val); }
                if (MODE == 2) {
                    lgb[wv * 64 + lane] = val + rbias;
                    asm volatile("s_waitcnt lgkmcnt(0)" ::: "memory");
                    float lg[32];
#pragma unroll
                    for (int q4 = 0; q4 < 8; ++q4) { const f32x4 t4 = *(const LAS f32x4*)(lgb + wv * 64 + (lane & 32) + 4 * q4); lg[4 * q4] = t4[0]; lg[4 * q4 + 1] = t4[1]; lg[4 * q4 + 2] = t4[2]; lg[4 * q4 + 3] = t4[3]; }
                    unsigned used = 0u; int te[4]; float tv[4];
#pragma unroll
                    for (int k = 0; k < 4; ++k) { float best = -3.0e38f; int bi = 0;
#pragma unroll
                        for (int q = 0; q < 32; ++q) { const bool ok = !((used >> q) & 1u) && (lg[q] > best); best = ok ? lg[q] : best; bi = ok ? q : bi; }
                        used |= 1u << bi; te[k] = bi; tv[k] = best; }
                    float ex[4], sum = 0.f;
#pragma unroll
                    for (int k = 0; k < 4; ++k) { ex[k] = __expf(tv[k] - tv[0]); sum += ex[k]; }
                    const float rs = 1.0f / sum;
                    if ((lane & 31) == 0) {
                        const int eb = wv * 64 + (2 * it + (lane >> 5)) * 4;
#pragma unroll
                        for (int k = 0; k < 4; ++k) { ent[eb + k] = te[k]; gat[eb + k] = ex[k] * rs; }
                    }
                    asm volatile("s_waitcnt lgkmcnt(0)" ::: "memory");
                }
            }
        }
        if (MODE == 2) {
            __syncthreads();
            { const int e = ent[wv * 64 + lane];
              const int pos = __hip_atomic_fetch_add(bcl + e, 1, __ATOMIC_RELAXED, __HIP_MEMORY_SCOPE_WORKGROUP);
              const size_t idx = (size_t)(vb * 128 + wv * 16) * 4 + lane;
              ((int*)(a->ws + WS_TOPE))[idx] = e; ((int*)(a->ws + WS_POSB))[idx] = pos; ((float*)(a->ws + WS_GATEW))[idx] = gat[wv * 64 + lane]; }
            __syncthreads();
            if (tid < 32) ((int*)(a->ws + WS_BCNT))[((size_t)layer * NTB + vb) * 32 + tid] = bcl[tid];
            __syncthreads();
        }
    }
}
DI void moe_tables(const int WID, ArgsP a, LAS unsigned char* lds, int layer, int vb) {
    const int tid = opaque_tid(WID);
    LAS int* tot = (LAS int*)(lds + MISC_OFF + MO_TOT); LAS int* base = (LAS int*)(lds + MISC_OFF + MO_BASE); LAS int* ts = (LAS int*)(lds + MISC_OFF + MO_TS);
    LAS int* red = (LAS int*)(lds + MISC_OFF + MO_RED);
    const int* bc = (const int*)(a->ws + WS_BCNT) + (size_t)layer * NTB * 32;
    { const int e = tid & 31, part = tid >> 5; int st = 0, sp = 0;
      for (int blk = part; blk < NTB; blk += 16) { const int v = bc[blk * 32 + e]; st += v; sp += (blk < vb) ? v : 0; }
      red[part * 32 + e] = st; red[512 + part * 32 + e] = sp; }
    __syncthreads();
    if (tid < 32) { int st = 0, sp = 0;
#pragma unroll
        for (int p = 0; p < 16; ++p) { st += red[p * 32 + tid]; sp += red[512 + p * 32 + tid]; }
        tot[tid] = st; base[tid] = sp; }
    __syncthreads();
    if (tid == 0) { int acc = 0; for (int e = 0; e < 32; ++e) { ts[e] = acc; acc += (tot[e] + 255) >> 8; } ts[32] = acc; }
    __syncthreads();
}
DI void phase_moe_slots(const int WID, ArgsP a, LAS unsigned char* lds, int layer) {
    const int tid = opaque_tid(WID), lane = tid & 63, wv = tid >> 6;
    LAS int* base = (LAS int*)(lds + MISC_OFF + MO_BASE); LAS int* ts = (LAS int*)(lds + MISC_OFF + MO_TS);
    const bf16_t* XN = (const bf16_t*)(a->ws + WS_XN); unsigned char* XB = (unsigned char*)(a->ws + WS_XB);
    for (int vb = blockIdx.x; vb < NTB; vb += gridDim.x) {
        moe_tables(WID, a, lds, layer, vb);
#pragma unroll 1
        for (int i = 0; i < 16; ++i) {
            const int t = vb * 128 + wv * 16 + i;
            int dest = 0;
            if (lane < 4) { const int e = ((const int*)(a->ws + WS_TOPE))[(size_t)t * 4 + lane], pos = ((const int*)(a->ws + WS_POSB))[(size_t)t * 4 + lane];
                dest = ts[e] * 256 + base[e] + pos; ((int*)(a->ws + WS_DEST))[(size_t)t * 4 + lane] = dest; }
            const u32x4 r0 = *(const u32x4*)(XN + (size_t)t * 1024 + 8 * lane), r1 = *(const u32x4*)(XN + (size_t)t * 1024 + 512 + 8 * lane);
            u32x2 q0, q1;
            q0.x = pk4_fp8(bflo(r0.x), bfhi(r0.x), bflo(r0.y), bfhi(r0.y)); q0.y = pk4_fp8(bflo(r0.z), bfhi(r0.z), bflo(r0.w), bfhi(r0.w));
            q1.x = pk4_fp8(bflo(r1.x), bfhi(r1.x), bflo(r1.y), bfhi(r1.y)); q1.y = pk4_fp8(bflo(r1.z), bfhi(r1.z), bflo(r1.w), bfhi(r1.w));
#pragma unroll
            for (int k = 0; k < 4; ++k) { const int d = __shfl(dest, k); unsigned char* o = XB + (size_t)d * 1024; *(u32x2*)(o + 8 * lane) = q0; *(u32x2*)(o + 512 + 8 * lane) = q1; }
        }
        __syncthreads();
    }
}
DI void phase_combine(const int WID, ArgsP a, float* H) {
    const int tid = opaque_tid(WID), lane = tid & 63, wv = tid >> 6;
    const bf16_t* YB = (const bf16_t*)(a->ws + WS_YB); unsigned char* XN8 = (unsigned char*)(a->ws + WS_XN);
    for (int t = blockIdx.x * 8 + wv; t < T; t += gridDim.x * 8) {
        int dest = 0; float gw = 0.f;
        if (lane < 4) { dest = ((const int*)(a->ws + WS_DEST))[(size_t)t * 4 + lane]; gw = ((const float*)(a->ws + WS_GATEW))[(size_t)t * 4 + lane]; }
        f32x4 v[4];
#pragma unroll
        for (int j = 0; j < 4; ++j) v[j] = *(const f32x4*)(H + (size_t)t * 1024 + 4 * lane + 256 * j);
#pragma unroll
        for (int k = 0; k < 4; ++k) { const int d = __shfl(dest, k); const float g = __shfl(gw, k); const bf16_t* y = YB + (size_t)d * 1024;
#pragma unroll
            for (int j = 0; j < 4; ++j) { const u32x2 w = *(const u32x2*)(y + 4 * lane + 256 * j); v[j][0] += g * bflo(w.x); v[j][1] += g * bfhi(w.x); v[j][2] += g * bflo(w.y); v[j][3] += g * bfhi(w.y); } }
        float ss = 0.f;
#pragma unroll
        for (int j = 0; j < 4; ++j) { *(f32x4*)(H + (size_t)t * 1024 + 4 * lane + 256 * j) = v[j]; ss += (v[j][0] * v[j][0] + v[j][1] * v[j][1]) + (v[j][2] * v[j][2] + v[j][3] * v[j][3]); }
        ss = wave_sum(ss);
        const float rstd = rsqrtf(ss * (1.0f / 1024.0f) + EPS);
#pragma unroll
        for (int j = 0; j < 4; ++j) v[j] = v[j] * rstd;
#pragma unroll
        for (int j = 0; j < 4; ++j) *(unsigned*)(XN8 + (size_t)t * 1024 + 4 * lane + 256 * j) = pk4_fp8(v[j][0], v[j][1], v[j][2], v[j][3]);
    }
}
DI void phase_cmp2(const int WID, ArgsP a, LAS unsigned char* lds, int ev) {
    const int tid = opaque_tid(WID), lane = tid & 63, wv = __builtin_amdgcn_readfirstlane(tid >> 6);
    const bf16_t* HID = (const bf16_t*)(a->ws + WS_HID); bf16_t* KCMP = (bf16_t*)(a->ws + WS_KCMP); bf16_t* VCMPT = (bf16_t*)(a->ws + WS_VCMPT);
    const float kg = a->in[I_NSKN][ev * 64 + lane];
    LAS float* wl = (LAS float*)lds;
    for (int i = tid; i < 2 * 256 * 64 / 4; i += 512) *(LAS f32x4*)(wl + 4 * i) = *(const f32x4*)(a->in[I_CMPW2] + (size_t)ev * 2 * 256 * 64 + 4 * i);
    __syncthreads();
    for (int gi = blockIdx.x * 8 + wv; gi < 2048; gi += gridDim.x * 8) {
        const int kv = gi >> 10, row0 = (gi & 1023) * 4;
        const bf16_t* hrow = HID + ((size_t)kv * 4096 + row0) * 256;
        const LAS float* w2 = wl + kv * 256 * 64 + lane;
        float s[4] = {0.f, 0.f, 0.f, 0.f};
#pragma unroll 2
        for (int k = 0; k < 256; k += 8) {
            u32x4 hw[4];
#pragma unroll
            for (int r = 0; r < 4; ++r) hw[r] = *(const u32x4*)(hrow + r * 256 + k);
            float wv8[8];
#pragma unroll
            for (int j = 0; j < 8; ++j) wv8[j] = w2[(k + j) * 64];
#pragma unroll
            for (int r = 0; r < 4; ++r)
                s[r] += bflo(hw[r].x) * wv8[0] + bfhi(hw[r].x) * wv8[1] + bflo(hw[r].y) * wv8[2] + bfhi(hw[r].y) * wv8[3] + bflo(hw[r].z) * wv8[4] + bfhi(hw[r].z) * wv8[5] + bflo(hw[r].w) * wv8[6] + bfhi(hw[r].w) * wv8[7];
        }
#pragma unroll
        for (int r = 0; r < 4; ++r) {
            const int row = row0 + r, bg = row >> 7, n = row & 127;
            float v = (n == 127) ? 0.f : s[r];
            if (kv == 0) { const float ss = wave_sum(v * v); const float o = v * rsqrtf(ss * (1.0f / 64.0f) + EPS) * kg;
                KCMP[((size_t)bg * 128 + n) * 64 + lane] = (bf16_t)(pk2(o, 0.f) & 0xffffu); }
            else VCMPT[((size_t)bg * 96 + lane) * 128 + n] = (bf16_t)(pk2(v, 0.f) & 0xffffu);
        }
    }
    for (int i = blockIdx.x * 512 + tid; i < 32 * 32 * 128; i += gridDim.x * 512) {
        const int n = i & 127, j = (i >> 7) & 31, bg = i >> 12;
        float o = 0.f;
        if (n < 127) { const int d = n - 4 * j; if (d >= 0 && d <= 2) o = 1.0f; else if (d == 3 || d == -1) o = 0.5f; }
        VCMPT[((size_t)bg * 96 + 64 + j) * 128 + n] = (bf16_t)(pk2(o, 0.f) & 0xffffu);
    }
}
DI void phase_topk(const int WID, ArgsP a) {
    const float* IMPH = (const float*)(a->ws + WS_IMPH); unsigned* SELM = (unsigned*)(a->ws + WS_SELM);
    for (int i = blockIdx.x * 512 + opaque_tid(WID); i < T * 2; i += gridDim.x * 512) {
        const int t = i >> 1, g = i & 1, b = t >> 11, s = t & 2047, cur = s >> 6;
        float sc[32];
#pragma unroll
        for (int j4 = 0; j4 < 8; ++j4) { f32x4 acc = {0.f, 0.f, 0.f, 0.f};
#pragma unroll
            for (int r = 0; r < 4; ++r) acc += *(const f32x4*)(IMPH + ((size_t)t * 8 + g * 4 + r) * 32 + 4 * j4);
#pragma unroll
            for (int q = 0; q < 4; ++q) sc[4 * j4 + q] = acc[q]; }
        unsigned mask;
        if (cur < 16) mask = (cur == 31) ? 0xffffffffu : ((2u << cur) - 1u);
        else {
#pragma unroll
            for (int j = 0; j < 32; ++j) { const bool forced = (j == 0) || (j == cur) || (j == cur - 1); sc[j] = (j > cur) ? NEGF : (sc[j] + (forced ? 1e4f : 0.f)); }
            mask = 0u;
#pragma unroll
            for (int j = 0; j < 32; ++j) { int rank = 0;
#pragma unroll
                for (int k = 0; k < 32; ++k) rank += ((sc[k] > sc[j]) || (sc[k] == sc[j] && k < j)) ? 1 : 0;
                mask |= (rank < 16) ? (1u << j) : 0u; }
        }
        SELM[((size_t)(b * 2 + g)) * 2048 + s] = mask;
    }
}
DI void phase_mixprep(const int WID, ArgsP a, int layer) {
    const int tid = opaque_tid(WID), lane = tid & 63, wv = tid >> 6, ev = layer >> 1;
    const float* dl = a->in[I_DALAM] + ev * 256;
    const float s1 = wave_sum(dl[lane] * dl[64 + lane]), s2 = wave_sum(dl[128 + lane] * dl[192 + lane]);
    const float lam_init = 0.8f - 0.6f * expf(-0.3f * (float)layer);
    const float lam = expf(s1) - expf(s2) + lam_init;
    const float* og = a->in[I_DAOUTG] + ev * 128;
    const bf16_t* OD = (const bf16_t*)(a->ws + WS_OD); const bf16_t* OC = (const bf16_t*)(a->ws + WS_OC); const bf16_t* OS = (const bf16_t*)(a->ws + WS_OS); const bf16_t* OW = (const bf16_t*)(a->ws + WS_OW);
    const float* GT = (const float*)(a->ws + WS_GATES); bf16_t* AMIX = (bf16_t*)(a->ws + WS_AMIX);
    const int h = lane >> 4, dv = (lane & 15) * 8;
    f32x4 g0 = *(const f32x4*)(og + dv), g1 = *(const f32x4*)(og + dv + 4);
    for (int t = blockIdx.x * 8 + wv; t < T; t += gridDim.x * 8) {
        { const u32x4 w1 = *(const u32x4*)(OD + (size_t)t * 1024 + h * 128 + dv), w2 = *(const u32x4*)(OD + (size_t)t * 1024 + (4 + h) * 128 + dv);
          f32x4 d0, d1;
          d0[0] = bflo(w1.x) - lam * bflo(w2.x); d0[1] = bfhi(w1.x) - lam * bfhi(w2.x); d0[2] = bflo(w1.y) - lam * bflo(w2.y); d0[3] = bfhi(w1.y) - lam * bfhi(w2.y);
          d1[0] = bflo(w1.z) - lam * bflo(w2.z); d1[1] = bfhi(w1.z) - lam * bfhi(w2.z); d1[2] = bflo(w1.w) - lam * bflo(w2.w); d1[3] = bfhi(w1.w) - lam * bfhi(w2.w);
          float ss = (d0[0] * d0[0] + d0[1] * d0[1]) + (d0[2] * d0[2] + d0[3] * d0[3]) + (d1[0] * d1[0] + d1[1] * d1[1]) + (d1[2] * d1[2] + d1[3] * d1[3]);
          ss += __shfl_xor(ss, 1); ss += __shfl_xor(ss, 2); ss += __shfl_xor(ss, 4); ss += __shfl_xor(ss, 8);
          const float rs = rsqrtf(ss * (1.0f / 128.0f) + EPS) * (1.0f - lam_init);
          *(u32x4*)(AMIX + (size_t)t * 1024 + h * 128 + dv) = pack8(d0 * rs * g0, d1 * rs * g1); }
        { const int hd = lane >> 3, dq = (lane & 7) * 8; const size_t o = (size_t)t * 512 + hd * 64 + dq;
          const float ga = GT[(size_t)t * 24 + hd * 3], gb = GT[(size_t)t * 24 + hd * 3 + 1], gc = GT[(size_t)t * 24 + hd * 3 + 2];
          const u32x4 c = *(const u32x4*)(OC + o), s = *(const u32x4*)(OS + o), w = *(const u32x4*)(OW + o);
          f32x4 r0, r1;
          r0[0] = ga * bflo(c.x) + gb * bflo(s.x) + gc * bflo(w.x); r0[1] = ga * bfhi(c.x) + gb * bfhi(s.x) + gc * bfhi(w.x);
          r0[2] = ga * bflo(c.y) + gb * bflo(s.y) + gc * bflo(w.y); r0[3] = ga * bfhi(c.y) + gb * bfhi(s.y) + gc * bfhi(w.y);
          r1[0] = ga * bflo(c.z) + gb * bflo(s.z) + gc * bflo(w.z); r1[1] = ga * bfhi(c.z) + gb * bfhi(s.z) + gc * bfhi(w.z);
          r1[2] = ga * bflo(c.w) + gb * bflo(s.w) + gc * bflo(w.w); r1[3] = ga * bfhi(c.w) + gb * bfhi(s.w) + gc * bfhi(w.w);
          *(u32x4*)(AMIX + (size_t)t * 1024 + 512 + hd * 64 + dq) = pack8(r0, r1); }
    }
}
DI void phase_scan(const int WID, ArgsP a) {
    const bf16_t* UT = (const bf16_t*)(a->ws + WS_UT); bf16_t* VS = (bf16_t*)(a->ws + WS_VS);
    for (int i = blockIdx.x * 512 + opaque_tid(WID); i < 64 * 512 * 32; i += gridDim.x * 512) {
        const int d8 = i & 31, f = (i >> 5) & 511, bh = i >> 14, h = bh & 3;
        const float dec = exp2f(256.0f * ret_lg2(h));
        f32x4 S0 = {0.f, 0.f, 0.f, 0.f}, S1 = S0;
        u32x4 un = *(const u32x4*)(UT + ((size_t)bh * 8) * 131072 + (size_t)f * 256 + 8 * d8);
#pragma unroll 1
        for (int n = 0; n < 8; ++n) {
            const size_t z = (size_t)bh * 8 + n;
            const u32x4 u = un;
            if (n < 7) un = *(const u32x4*)(UT + (z + 1) * 131072 + (size_t)f * 256 + 8 * d8);
            *(u32x4*)(VS + (z * 512 + f) * 512 + 256 + 8 * d8) = pack8(S0, S1);
            S0[0] = (S0[0] + bflo(u.x)) * dec; S0[1] = (S0[1] + bfhi(u.x)) * dec; S0[2] = (S0[2] + bflo(u.y)) * dec; S0[3] = (S0[3] + bfhi(u.y)) * dec;
            S1[0] = (S1[0] + bflo(u.z)) * dec; S1[1] = (S1[1] + bfhi(u.z)) * dec; S1[2] = (S1[2] + bflo(u.w)) * dec; S1[3] = (S1[3] + bfhi(u.w)) * dec;
        }
    }
}
DI void phase_normgate(const int WID, ArgsP a, int od) {
    const int tid = opaque_tid(WID), lane = tid & 63, wv = tid >> 6;
    const bf16_t* Y = (const bf16_t*)(a->ws + WS_Y); const bf16_t* GG = (const bf16_t*)(a->ws + WS_GG); bf16_t* YG = (bf16_t*)(a->ws + WS_YG);
    const float* og = a->in[I_RETG] + od * 512;
    const f32x4 g0 = *(const f32x4*)(og + 8 * lane), g1 = *(const f32x4*)(og + 8 * lane + 4);
    for (int t = blockIdx.x * 8 + wv; t < T; t += gridDim.x * 8) {
#pragma unroll
        for (int h = 0; h < 4; ++h) {
            const size_t o = (size_t)t * 2048 + h * 512 + 8 * lane;
            const u32x4 yw = *(const u32x4*)(Y + o), gw = *(const u32x4*)(GG + o);
            f32x4 y0 = {bflo(yw.x), bfhi(yw.x), bflo(yw.y), bfhi(yw.y)}, y1 = {bflo(yw.z), bfhi(yw.z), bflo(yw.w), bfhi(yw.w)};
            const f32x4 q0 = {bflo(gw.x), bfhi(gw.x), bflo(gw.y), bfhi(gw.y)}, q1 = {bflo(gw.z), bfhi(gw.z), bflo(gw.w), bfhi(gw.w)};
            float ss = (y0[0] * y0[0] + y0[1] * y0[1]) + (y0[2] * y0[2] + y0[3] * y0[3]) + (y1[0] * y1[0] + y1[1] * y1[1]) + (y1[2] * y1[2] + y1[3] * y1[3]);
            ss = wave_sum(ss);
            const float rs = rsqrtf(ss * (1.0f / 512.0f) + EPS);
            *(u32x4*)(YG + o) = pack8(y0 * rs * g0 * q0, y1 * rs * g1 * q1);
        }
    }
}
DI int snake_unit(int rnd, int G, int c) { return (rnd & 1) ? rnd * G + (G - 1 - c) : rnd * G + c; }
DI float absmax64(const float* g, int lane) { float m = fabsf(g[lane]);
#pragma unroll
    for (int o = 1; o < 64; o <<= 1) m = fmaxf(m, __shfl_xor(m, o));
    return m; }
constexpr int CW_AQ = 8192;
template <int MODE>
DI void phase_attn(const int WID, ArgsP a, LAS unsigned char* lds, int ev) {
    const int tid = opaque_tid(WID), lane = tid & 63;
    const bf16_t* QD = (const bf16_t*)(a->ws + WS_QD); const bf16_t* KD = (const bf16_t*)(a->ws + WS_KD); const bf16_t* QN = (const bf16_t*)(a->ws + WS_QN);
    LAS int* ord = (LAS int*)(lds + MISC_OFF + MO_ENT); LAS int* cst = (LAS int*)(lds + MISC_OFF + MO_GAT); volatile LAS int* cur = (volatile LAS int*)(lds + MISC_OFF + MO_TOT);
    float sb2 = 0.f;
    if (MODE != 3) { const float gq = absmax64(a->in[MODE == 0 ? I_DAQN : I_NSQN] + ev * 64, lane), gk = absmax64(a->in[MODE == 0 ? I_DAKN : I_NSKN] + ev * 64, lane);
        sb2 = 16.0f * gq * gk + 28.0f; }
    if (tid < 64) { const int qb = tid >> 3, hd = tid & 7, q0 = qb * 256; int lo = 0, hi = 4 * qb + 4;
        if (MODE == 3) { lo = 0; hi = 2; }
        else { const float slope = (MODE == 0) ? exp2f(-2.0f * (float)((hd & 3) + 1)) : exp2f(-(float)(hd + 1)); const int dcut = (int)fminf(sb2 / slope + 1.0f, 100000.0f);
            const int kmin = q0 - dcut; lo = kmin > 0 ? (kmin >> 6) : 0;
            if (MODE == 2) { const int lk = q0 - 511; const int lw = lk > 0 ? (lk >> 6) : 0; lo = lw > lo ? lw : lo; } }
        cst[tid] = hi - lo; }
    __syncthreads();
    if (tid < 64) { const int mine = cst[tid]; int rank = 0;
        for (int j = 0; j < 64; ++j) { const int o = cst[j]; rank += (o > mine || (o == mine && j < tid)) ? 1 : 0; }
        ord[rank] = tid; }
    __syncthreads();
    unsigned* ctr = (unsigned*)(a->ws + WS_CTL) + CW_AQ + 64 * (ev * 4 + MODE);
    for (;;) {
        if (tid == 0) *cur = (int)__hip_atomic_fetch_add(ctr, 1u, __ATOMIC_RELAXED, __HIP_MEMORY_SCOPE_AGENT);
        __syncthreads();
        const int u = *cur; if (u >= 1024) break;
        const int combo = ord[u >> 4], b = u & 15, qb = combo >> 3, hd = combo & 7, q0 = qb * 256; const size_t t0 = (size_t)b * 2048 + q0;
        if (MODE == 0) {
            const float slope = exp2f(-2.0f * (float)((hd & 3) + 1)); const int dcut = (int)fminf(sb2 / slope + 1.0f, 100000.0f);
            attn_unit<128, 0>(WID, lds, QD + t0 * 512 + hd * 64, 512, KD + (size_t)b * 2048 * 512 + hd * 64, 512,
                              (const bf16_t*)(a->ws + WS_VAT) + (size_t)(b * 4 + (hd & 3)) * 128 * 2048, 2048, q0, slope, dcut, nullptr,
                              (bf16_t*)(a->ws + WS_OD) + t0 * 1024 + hd * 128, 1024, nullptr);
        } else if (MODE == 1 || MODE == 2) {
            const int g = hd >> 2; const float slope = exp2f(-(float)(hd + 1)); const int dcut = (int)fminf(sb2 / slope + 1.0f, 100000.0f);
            const bf16_t* Kb = (const bf16_t*)(a->ws + (MODE == 1 ? WS_KSB : WS_KWB)) + (size_t)(b * 2 + g) * 2048 * 64;
            const bf16_t* Vb = (const bf16_t*)(a->ws + (MODE == 1 ? WS_VST : WS_VWT)) + (size_t)(b * 2 + g) * 64 * 2048;
            attn_unit<64, MODE>(WID, lds, QN + t0 * 512 + hd * 64, 512, Kb, 64, Vb, 2048, q0, slope, dcut,
                                (const unsigned*)(a->ws + WS_SELM) + (size_t)(b * 2 + g) * 2048 + q0,
                                (bf16_t*)(a->ws + (MODE == 1 ? WS_OS : WS_OW)) + t0 * 512 + hd * 64, 512, nullptr);
        } else {
            const int g = hd >> 2;
            attn_unit<96, 3>(WID, lds, QN + t0 * 512 + hd * 64, 512, (const bf16_t*)(a->ws + WS_KCMP) + (size_t)(b * 2 + g) * 128 * 64, 64,
                             (const bf16_t*)(a->ws + WS_VCMPT) + (size_t)(b * 2 + g) * 96 * 128, 128, q0, 0.f, 0, nullptr,
                             (bf16_t*)(a->ws + WS_OC) + t0 * 512 + hd * 64, 512, (float*)(a->ws + WS_IMPH) + (t0 * 8 + hd) * 32);
        }
    }
}

constexpr int PPL = 15;
constexpr int NPHASE = 1 + DEPTH * PPL;
__global__ void __launch_bounds__(512, 2) mk_fwd(Args a_unused) {
    ArgsP a = opaque_args();
    extern __shared__ __attribute__((aligned(16))) unsigned char lds_raw[];
    LAS unsigned char* lds = (LAS unsigned char*)lds_raw;
    const int tid = threadIdx.x, G = gridDim.x, c = blockIdx.x;
    const int WID = __builtin_amdgcn_readfirstlane(tid >> 6);
    volatile LAS unsigned* misc = (volatile LAS unsigned*)(lds + MISC_OFF);
    if (tid < 4) misc[tid] = 0u;
    __syncthreads();
    unsigned* ctl = (unsigned*)(a->ws + WS_CTL);
    XcdBarrier bar; bar.bar = ctl + CW_BAR; bar.x = 0; bar.st = misc;
    const int ph_lo = a->ph_lo, ph_hi = a->ph_hi;
    const bool multi = (ph_hi - ph_lo) > 1;
    if (multi) bar = xcd_barrier_post(WID, ctl + CW_BAR, misc);
    bool first = true;
#define PHASE_BEGIN(k, id) if ((DBG_ONLY < 0 || DBG_ONLY == (id)) && (k) >= ph_lo && (k) < ph_hi && (k) <= DBG_LAST_PHASE) { if (!first) { xcd_barrier(WID, bar); if (PROBE_MASK >> 31) xcd_barrier(WID, bar); } first = false; \
        ArgsP a = opaque_args(); unsigned char* ws = a->ws; bf16_t* XN = (bf16_t*)(ws + WS_XN); float* H = a->out; const float* Hin = (layer == 0) ? a->in[I_X] : (const float*)H; \
        const LAS int* ts = (const LAS int*)(lds + MISC_OFF + MO_TS); (void)XN; (void)H; (void)Hin; (void)ts; \
        const bool probe_ = ((PROBE_MASK >> (id)) & 1u) != 0u; const unsigned long long pt0_ = probe_ ? __builtin_amdgcn_s_memrealtime() : 0ull;
#define PHASE_END if (probe_) { const unsigned long long pt1_ = __builtin_amdgcn_s_memrealtime(), pd_ = pt1_ - pt0_; while (__builtin_amdgcn_s_memrealtime() - pt1_ < pd_) __builtin_amdgcn_s_sleep(8); } }
    { const int layer = 0; PHASE_BEGIN(0, 0) phase_prologue(WID, a, lds); PHASE_END }
#pragma unroll 1
    for (int layer = 0; layer < DEPTH; ++layer) {
        const int pb = 1 + layer * PPL; const bool even = (layer & 1) == 0; const int ev = layer >> 1, od = layer >> 1;
        if (even) {
            PHASE_BEGIN(pb + 0, 1) phase_norm<0>(WID, a, lds, layer, Hin); PHASE_END
            PHASE_BEGIN(pb + 1, 2) {
                { ProbPlain P{XN, (const bf16_t*)(ws + WS_EVNAT) + (size_t)ev * 2048 * 1024, 1024, 1024, 1024}; pg8::Sched S; S.init(T / 256, 8, G, c);
                  EpiEvNat E{ws, (const float*)(ws + WS_GAINS) + ev * 256};
                  pg8::gemm_phase(WID, lds, P, S, E); }
                { ProbPlain P{(const bf16_t*)(ws + WS_EVSW) + (size_t)ev * 768 * 1024, XN, 1024, 1024, 1024}; pg8::Sched S; S.init(3, T / 256, G, c);
                  EpiEvSw E{ws};
                  pg8::gemm_phase(WID, lds, P, S, E); }
            } PHASE_END
            PHASE_BEGIN(pb + 2, 3) {
                { ProbCmp1 P{(const bf16_t*)(ws + WS_KCB), (const bf16_t*)(ws + WS_VCB), (const bf16_t*)(ws + WS_CMP1) + (size_t)ev * 2 * 256 * 2048, 1024, 2048, 2048}; pg8::Sched S; S.init(32, 1, G, c);
                  EpiCmp1 E{(bf16_t*)(ws + WS_HID), (const float*)(ws + WS_BIAS1) + ev * 512};
                  pg8::gemm_phase(WID, lds, P, S, E); }
                phase_attn<0>(WID, a, lds, ev);
                phase_attn<2>(WID, a, lds, ev);
            } PHASE_END
            PHASE_BEGIN(pb + 3, 4) phase_cmp2(WID, a, lds, ev); PHASE_END
            PHASE_BEGIN(pb + 4, 5) phase_attn<3>(WID, a, lds, ev); PHASE_END
            PHASE_BEGIN(pb + 5, 6) phase_topk(WID, a); PHASE_END
            PHASE_BEGIN(pb + 6, 7) phase_attn<1>(WID, a, lds, ev); PHASE_END
            PHASE_BEGIN(pb + 7, 8) phase_mixprep(WID, a, layer); PHASE_END
            PHASE_BEGIN(pb + 8, 9) {
                ProbPlain P{(const bf16_t*)(ws + WS_AMIX), (const bf16_t*)(ws + WS_EVOUT) + (size_t)ev * 1024 * 1024, 1024, 1024, 1024}; pg8::Sched S; S.init(T / 256, 4, G, c);
                EpiResid E{Hin, H}; pg8::gemm_phase(WID, lds, P, S, E);
            } PHASE_END
        } else {
            PHASE_BEGIN(pb + 0, 11) phase_norm<1>(WID, a, lds, layer, Hin); PHASE_END
            PHASE_BEGIN(pb + 1, 12) {
                { ProbPlain P{XN, (const bf16_t*)(ws + WS_ODNAT) + (size_t)od * 4096 * 1024, 1024, 1024, 1024}; pg8::Sched S; S.init(T / 256, 16, G, c);
                  EpiOdNat E{ws}; pg8::gemm_phase(WID, lds, P, S, E); }
                { ProbPlain P{(const bf16_t*)(ws + WS_ODSW) + (size_t)od * 3072 * 1024, XN, 1024, 1024, 1024}; pg8::Sched S; S.init(12, T / 256, G, c);
                  EpiOdSw E{ws}; pg8::gemm_phase(WID, lds, P, S, E); }
            } PHASE_END
            PHASE_BEGIN(pb + 2, 13) {
                { ProbAtt P{(const bf16_t*)(ws + WS_AQ), (const bf16_t*)(ws + WS_KP), 2048, 1024, 256}; pg8::Sched S; S.init(512, 1, G, c);
                  EpiAtt E{(bf16_t*)(ws + WS_AQ)}; pg8::gemm_phase(WID, lds, P, S, E); }
                { ProbUT P{(const bf16_t*)(ws + WS_VS), (const bf16_t*)(ws + WS_KT), 512, 256, 256}; pg8::Sched S; S.init(1024, 1, G, c);
                  EpiUT E{(bf16_t*)(ws + WS_UT)}; pg8::gemm_phase(WID, lds, P, S, E); }
            } PHASE_END
            PHASE_BEGIN(pb + 3, 14) phase_scan(WID, a); PHASE_END
            PHASE_BEGIN(pb + 4, 15) {
                ProbY P{(const bf16_t*)(ws + WS_AQ), (const bf16_t*)(ws + WS_VS), 2048, 512, 512}; pg8::Sched S; S.init(512, 2, G, c);
                EpiY E{(bf16_t*)(ws + WS_Y)}; pg8::gemm_phase(WID, lds, P, S, E);
            } PHASE_END
            PHASE_BEGIN(pb + 5, 16) phase_normgate(WID, a, od); PHASE_END
            PHASE_BEGIN(pb + 8, 19) {
                ProbPlain P{(const bf16_t*)(ws + WS_YG), (const bf16_t*)(ws + WS_ODOUT) + (size_t)od * 1024 * 2048, 2048, 2048, 2048}; pg8::Sched S; S.init(T / 256, 4, G, c);
                EpiResid E{Hin, H}; pg8::gemm_phase(WID, lds, P, S, E);
            } PHASE_END
        }
        PHASE_BEGIN(pb + 9, 20) phase_norm<2>(WID, a, lds, layer, H); PHASE_END
        PHASE_BEGIN(pb + 10, 21) phase_moe_slots(WID, a, lds, layer); PHASE_END
        PHASE_BEGIN(pb + 11, 22) {
            moe_tables(WID, a, lds, layer, -1);
            { ProbMoe8 P{(const unsigned char*)(ws + WS_XB), (const unsigned char*)(ws + WS_WGU) + (size_t)layer * 32 * 2048 * 1024, ts, 2048, 512, 512, 512}; pg8::Sched S; S.init(ts[32], 8, G, c);
              EpiGU E{(unsigned char*)(ws + WS_ACT), a->in[I_BGU] + (size_t)layer * 32 * 2048, ts}; pg8::gemm_phase(WID, lds, P, S, E); }
            { ProbPlain P{(const bf16_t*)(ws + WS_PBF) + (size_t)layer * T * 256, (const bf16_t*)(ws + WS_WPP) + (size_t)layer * 1024 * 256, 256, 256, 256}; pg8::Sched S; S.init(T / 256, 4, G, c);
              EpiPP E{(bf16_t*)(ws + WS_PP)}; pg8::gemm_phase(WID, lds, P, S, E); }
        } PHASE_END
        PHASE_BEGIN(pb + 12, 23) {
            moe_tables(WID, a, lds, layer, -1);
            ProbMoe8 P{(const unsigned char*)(ws + WS_ACT), (const unsigned char*)(ws + WS_WDN) + (size_t)layer * 32 * 1024 * 1024, ts, 1024, 512, 512, 512}; pg8::Sched S; S.init(ts[32], 4, G, c);
            EpiDN E{(bf16_t*)(ws + WS_YB), a->in[I_BDN] + (size_t)layer * 32 * 1024, ts}; pg8::gemm_phase(WID, lds, P, S, E);
        } PHASE_END
        PHASE_BEGIN(pb + 13, 24) phase_combine(WID, a, H); PHASE_END
        PHASE_BEGIN(pb + 14, 25) {
            ProbPlain8 P{(const unsigned char*)(ws + WS_XN), (const unsigned char*)(ws + WS_WPG) + (size_t)layer * 1024 * 1024, 512, 512, 512}; pg8::Sched S; S.init(T / 256, 4, G, c);
            EpiPLE E{H, (const bf16_t*)(ws + WS_PP)}; pg8::gemm_phase(WID, lds, P, S, E);
        } PHASE_END
    }
#undef PHASE_BEGIN
#undef PHASE_END
}

extern "C" void kernel_launch(void* const* d_in, const int* in_sizes, int n_in, void* d_out, int out_size, void* d_ws, size_t ws_size, hipStream_t stream) {
    static int grid = 0;
    if (grid == 0) {
        if (n_in != 26 || out_size != T * D || ws_size < WS_END) { fprintf(stderr, "kernel_launch: unexpected problem (n_in %d, out %d, ws %zu < %zu); nothing launched\n", n_in, out_size, ws_size, (size_t)WS_END); grid = -1; return; }
        int dev = 0, cus = 0, per_cu = 0;
        if (hipGetDevice(&dev) != hipSuccess || hipDeviceGetAttribute(&cus, hipDeviceAttributeMultiprocessorCount, dev) != hipSuccess) { grid = -1; return; }
        if (hipFuncSetAttribute((const void*)mk_fwd, hipFuncAttributeMaxDynamicSharedMemorySize, LDS_BYTES) != hipSuccess) { fprintf(stderr, "kernel_launch: hipFuncSetAttribute failed\n"); grid = -1; return; }
        if (hipOccupancyMaxActiveBlocksPerMultiprocessor(&per_cu, (const void*)mk_fwd, 512, LDS_BYTES) != hipSuccess || per_cu < 1) fprintf(stderr, "kernel_launch: occupancy query reports %d\n", per_cu);
        (void)hipGetLastError();
        grid = cus > 256 ? 256 : cus;
    }
    if (grid < 0) return;
    (void)hipMemsetAsync((char*)d_ws + WS_CTL, 0, CTL_BYTES, stream);
    Args a; memset(&a, 0, sizeof(a));
    for (int i = 0; i < 26; ++i) a.in[i] = (const float*)d_in[i];
    a.out = (float*)d_out; a.ws = (unsigned char*)d_ws;
#if MK_SINGLE
    a.ph_lo = 0; a.ph_hi = NPHASE;
    hipLaunchKernelGGL(mk_fwd, dim3(grid), dim3(512), LDS_BYTES, stream, a);
#else
    for (int ph = 0; ph < NPHASE && ph <= DBG_LAST_PHASE; ++ph) {
        const int l = (ph - 1) / PPL, k = (ph - 1) % PPL;
        if (ph > 0 && (l & 1) && (k == 6 || k == 7)) continue;
        a.ph_lo = ph; a.ph_hi = ph + 1;
        hipLaunchKernelGGL(mk_fwd, dim3(grid), dim3(512), LDS_BYTES, stream, a);
    }
#endif
}
```

```cpp
#include <hip/hip_runtime.h>
#include <cstdio>
#include <cstdint>
#include <cstring>

#define LAS __attribute__((address_space(3)))
#define DI __device__ __forceinline__
typedef unsigned short bf16_t;
typedef short bf16x8 __attribute__((ext_vector_type(8)));
typedef short s16x4 __attribute__((ext_vector_type(4)));
typedef float f32x2 __attribute__((ext_vector_type(2)));
typedef float f32x4 __attribute__((ext_vector_type(4)));
typedef float f32x16 __attribute__((ext_vector_type(16)));
typedef unsigned u32x2 __attribute__((ext_vector_type(2)));
typedef unsigned u32x4 __attribute__((ext_vector_type(4)));
typedef __bf16 bfv2 __attribute__((ext_vector_type(2)));
typedef int i32x4 __attribute__((ext_vector_type(4)));
typedef int i32x8 __attribute__((ext_vector_type(8)));

#ifndef MK_SINGLE
#define MK_SINGLE 1
#endif
#ifndef DBG_ONLY
#define DBG_ONLY -1
#endif
#ifndef PROBE_MASK
#define PROBE_MASK 0u
#endif
#ifndef DBG_LAST_PHASE
#define DBG_LAST_PHASE 100000
#endif

constexpr int T = 32768, D = 1024, SEQ = 2048, NBATCH = 16, DEPTH = 4;
constexpr int EVIN = 2840, ODIN = 6144;
constexpr float EPS = 1e-6f, NEGF = -1e30f;
constexpr int NTB = 256;
constexpr int MOE_ROWS = (512 + 32) * 256;

constexpr size_t MiB = 1u << 20;
constexpr size_t WS_CTL = 0, CTL_BYTES = 1 * MiB;
constexpr int CW_BAR = 4096;
constexpr size_t WS_EVNAT = 2 * MiB, WS_EVSW = 10 * MiB, WS_EVOUT = 13 * MiB, WS_CMP1 = 17 * MiB, WS_ODNAT = 21 * MiB, WS_ODSW = 37 * MiB,
                 WS_ODOUT = 49 * MiB, WS_WPP = 57 * MiB, WS_WPG = 59 * MiB, WS_BIAS1 = 67 * MiB, WS_GAINS = 67 * MiB + 16384, WS_BCNT = 67 * MiB + 65536,
                 WS_WGU = 68 * MiB, WS_WDN = 580 * MiB;
constexpr size_t WS_XN = 840 * MiB, WS_PBF = 904 * MiB, WS_PP = 968 * MiB, WS_GATES = 1032 * MiB, WS_TOPE = 1035 * MiB, WS_POSB = 1036 * MiB,
                 WS_DEST = 1037 * MiB, WS_GATEW = 1038 * MiB, WS_SELM = 1039 * MiB;
constexpr size_t RA = 1040 * MiB;
constexpr size_t WS_QD = RA, WS_KD = RA + 32 * MiB, WS_QN = RA + 64 * MiB, WS_KCB = RA + 96 * MiB, WS_VCB = RA + 105 * MiB, WS_KSB = RA + 114 * MiB,
                 WS_KWB = RA + 122 * MiB, WS_VAT = RA + 130 * MiB, WS_VST = RA + 162 * MiB, WS_VWT = RA + 170 * MiB, WS_HID = RA + 178 * MiB,
                 WS_KCMP = RA + 182 * MiB, WS_VCMPT = RA + 183 * MiB, WS_OC = RA + 184 * MiB, WS_IMPH = RA + 216 * MiB, WS_OD = RA + 248 * MiB,
                 WS_OS = RA + 312 * MiB, WS_OW = RA + 344 * MiB, WS_AMIX = RA + 376 * MiB;
constexpr size_t WS_AQ = RA, WS_KP = RA + 128 * MiB, WS_KT = RA + 192 * MiB, WS_VS = RA + 256 * MiB, WS_GG = RA + 512 * MiB, WS_UT = RA + 640 * MiB,
                 WS_Y = RA + 896 * MiB, WS_YG = RA + 1024 * MiB;
constexpr size_t WS_XB = 2192 * MiB, WS_ACT = 2464 * MiB, WS_YB = 2736 * MiB, WS_END = 3008 * MiB;

constexpr int MISC_OFF = 139264, LDS_BYTES = 155648;
static_assert(MISC_OFF + 5888 + 4096 <= LDS_BYTES, "misc LDS words");
constexpr int MO_WCNT = 256, MO_ENT = 1280, MO_GAT = 3328, MO_TOT = 5376, MO_BASE = 5504, MO_TS = 5632, MO_RED = 5888;

DI int opaque_tid(int wid0) { int l; asm volatile("v_mbcnt_lo_u32_b32 %0, -1, 0\n\tv_mbcnt_hi_u32_b32 %0, -1, %0" : "=v"(l) :: "memory"); return (wid0 << 6) | l; }
DI int lane_now() { int l; asm volatile("v_mbcnt_lo_u32_b32 %0, -1, 0\n\tv_mbcnt_hi_u32_b32 %0, -1, %0" : "=v"(l)); return l; }
DI float shx(float v, int m) { return __builtin_bit_cast(float, __builtin_amdgcn_ds_bpermute((lane_now() ^ m) << 2, __builtin_bit_cast(int, v))); }
DI unsigned shxu(unsigned v, int m) { return (unsigned)__builtin_amdgcn_ds_bpermute((lane_now() ^ m) << 2, (int)v); }
DI unsigned pk2(float lo, float hi) { f32x2 v = {lo, hi}; return __builtin_bit_cast(unsigned, __builtin_convertvector(v, bfv2)); }
DI unsigned pk4_fp8(float a, float b, float c, float d) { int w = 0; w = __builtin_amdgcn_cvt_pk_fp8_f32(a, b, w, false); w = __builtin_amdgcn_cvt_pk_fp8_f32(c, d, w, true); return (unsigned)w; }
DI float bf2f(unsigned short b) { return __uint_as_float(((unsigned)b) << 16); }
DI float bflo(unsigned w) { return __uint_as_float(w << 16); }
DI float bfhi(unsigned w) { return __uint_as_float(w & 0xffff0000u); }
DI float wave_sum(float v) {
#pragma unroll
    for (int o = 1; o < 64; o <<= 1) v += shx(v, o);
    return v;
}
DI float sigm(float x) { return 1.0f / (1.0f + __expf(-x)); }
DI u32x4 pack8(const f32x4& a, const f32x4& b) { u32x4 w; w.x = pk2(a[0], a[1]); w.y = pk2(a[2], a[3]); w.z = pk2(b[0], b[1]); w.w = pk2(b[2], b[3]); return w; }

#define XB_TMO      128
#define XB_XCNT(j)  (256  + 64 * (j))
#define XB_XSUB(j)  (1280 + 64 * (j))
#define XB_XGEN(j)  (2304 + 64 * (j))
#define XB_TOP      3328
#define XB_TOPGEN   3392
#define XCD_BAR_WORDS 3456
#define XB_SPIN_CAP (1u << 22)
DI unsigned xb_ld(unsigned* p)              { return __hip_atomic_load(p, __ATOMIC_RELAXED, __HIP_MEMORY_SCOPE_AGENT); }
DI unsigned xb_add(unsigned* p, unsigned v) { return __hip_atomic_fetch_add(p, v, __ATOMIC_RELAXED, __HIP_MEMORY_SCOPE_AGENT); }
DI unsigned xb_xcc_id() { return (unsigned)__builtin_amdgcn_s_getreg((3 << 11) | 20) & 0xFu; }
#define XB_SPIN(cond, bar) do { unsigned _sp = 0; while (cond) { __builtin_amdgcn_s_sleep(1); \
    if ((++_sp & 255u) == 0u) { if (xb_ld(&(bar)[XB_TMO])) break; if (_sp > XB_SPIN_CAP) { atomicAdd(&(bar)[XB_TMO], 1u); break; } } } } while (0)
struct XcdBarrier { unsigned* bar; unsigned x; volatile LAS unsigned* st; };
DI XcdBarrier xcd_barrier_post(const int WID, unsigned* bar, volatile LAS unsigned* st) {
    XcdBarrier b; b.bar = bar; b.x = xb_xcc_id(); b.st = st;
    if (opaque_tid(WID) == 0) (void)xb_add(&bar[XB_XCNT(b.x)], 1u);
    return b;
}
DI void xcd_barrier_complete(unsigned* bar, unsigned x, unsigned& nloc, unsigned& nx) {
    const unsigned G = gridDim.x * gridDim.y * gridDim.z;
    unsigned sum, cnt, mine, sp = 0u;
    for (;;) {
        sum = 0u; cnt = 0u; mine = 0u;
#pragma unroll
        for (unsigned j = 0; j < 16; ++j) { const unsigned c = xb_ld(&bar[XB_XCNT(j)]); sum += c; cnt += (c > 0u) ? 1u : 0u; mine = (j == x) ? c : mine; }
        if (sum == G) break;
        __builtin_amdgcn_s_sleep(1);
        if ((++sp & 255u) == 0u) { if (xb_ld(&bar[XB_TMO])) break; if (sp > XB_SPIN_CAP) { atomicAdd(&bar[XB_TMO], 1u); break; } }
    }
    nloc = mine > 0u ? mine : 1u; nx = cnt > 0u ? cnt : 1u;
}
DI void xcd_barrier(const int WID, const XcdBarrier& b) {
    asm volatile("s_waitcnt vmcnt(0)" ::: "memory");
    __syncthreads();
    if (opaque_tid(WID) == 0) {
        unsigned* bar = b.bar; asm volatile("" : "+s"(bar));
        __builtin_amdgcn_s_waitcnt(0);
        unsigned nloc = b.st[0], nx = b.st[1];
        if (nloc == 0u) { xcd_barrier_complete(bar, b.x, nloc, nx); b.st[0] = nloc; b.st[1] = nx; }
        const unsigned old = xb_add(&bar[XB_XSUB(b.x)], 1u);
        const unsigned gen = old / nloc;
        if (old + 1u == (gen + 1u) * nloc) {
            __builtin_amdgcn_fence(__ATOMIC_RELEASE, "agent");
            asm volatile("s_waitcnt vmcnt(0)" ::: "memory");
            const unsigned og = xb_add(&bar[XB_TOP], 1u);
            const unsigned tg = og / nx;
            if (og + 1u == (tg + 1u) * nx) xb_add(&bar[XB_TOPGEN], 1u);
            else XB_SPIN(xb_ld(&bar[XB_TOPGEN]) == tg, bar);
            __builtin_amdgcn_fence(__ATOMIC_ACQUIRE, "agent");
            xb_add(&bar[XB_XGEN(b.x)], 1u);
            asm volatile("s_waitcnt vmcnt(0)" ::: "memory");
        } else {
            XB_SPIN(xb_ld(&bar[XB_XGEN(b.x)]) == gen, bar);
            __builtin_amdgcn_fence(__ATOMIC_ACQUIRE, "agent");
            asm volatile("s_waitcnt vmcnt(0)" ::: "memory");
        }
    }
    __syncthreads();
}

namespace pg8 {
constexpr int BM = 256, BK = 64, HALF = 128, HTB = HALF * BK * 2, STAGE_BYTES = 8 * HTB, NXCD = 8, WGM = 8;
DI int lds_byte(int r, int c) { const int st = (r >> 4) * 2 + (c >> 5), rr = r & 15, cc = c & 31, ob = rr * 64 + cc * 2; return st * 1024 + (ob ^ (((ob >> 9) & 1) << 5)); }
DI void stage_rc(int b, int& R, int& C) { const int st = b / 1024, sb = b % 1024, swz = sb ^ (((sb >> 9) & 1) << 5); R = (st >> 1) * 16 + swz / 64; C = (st & 1) * 32 + (swz % 64) / 2; }
DI int perm32(int rho) { const int n = rho >> 4, i = rho & 15; return 8 * (i >> 2) + 4 * n + (i & 3); }
struct Unit { int pm, pn; };
struct Sched {
    int nM, nN, nwg, G, c;
    DI void init(int nM_, int nN_, int G_, int c_) { nM = nM_; nN = nN_; nwg = nM * nN; G = G_; c = c_; }
    DI bool next(int i, Unit& u) const {
        const long L = (long)i * G + c; if (L >= nwg) return false;
        int wgid = (int)L; { const int q = nwg / NXCD, r = nwg % NXCD, xcd = wgid % NXCD, off = wgid / NXCD; wgid = (xcd < r ? xcd * (q + 1) : r * (q + 1) + (xcd - r) * q) + off; }
        const int nig = WGM * nN, gid = wgid / nig, fm = gid * WGM, gsz = (nM - fm) < WGM ? (nM - fm) : WGM;
        u.pm = fm + ((wgid % nig) % gsz); u.pn = (wgid % nig) / gsz; return true;
    }
};
template <class Epi, class Prob, class SchedT>
DI void gemm_phase(const int WID, LAS unsigned char* lds, const Prob& P, const SchedT& S, const Epi& E) {
    const int tid = opaque_tid(WID), wid = __builtin_amdgcn_readfirstlane(tid >> 6), lane = tid & 63, wr = wid >> 2, wc = wid & 3, fr = lane & 15, fq = lane >> 4;
    const int K = P.K, nt = K / BK;
    unsigned voffA[2], voffB[2];
#pragma unroll
    for (int i = 0; i < 2; ++i) { int R, C; stage_rc(tid * 16 + i * 8192, R, C); const int Rb = Epi::PERM ? ((R & ~31) + perm32(R & 31)) : R;
        voffA[i] = (unsigned)(R * P.lda + C) * 2u; voffB[i] = (unsigned)(Rb * P.ldb + C) * 2u; }
    const size_t kstep = (size_t)(BK * 2);
    const size_t hstepA = (size_t)HALF * P.lda * 2, hstepB = (size_t)HALF * P.ldb * 2;
    const unsigned ldsw = (unsigned)wid * 1024u;
    const int aoff = lds_byte(wr * 64 + fr, fq * 8), boff = lds_byte(wc * 32 + fr, fq * 8);
#define PG8_SA(b, h) (((b) * 2 + (h)) * HTB)
#define PG8_SB(b, h) ((4 + (b) * 2 + (h)) * HTB)
#define PG8_STAGE(bufoff, gbase, voff) do { _Pragma("unroll") for (int _i = 0; _i < 2; ++_i) \
        __builtin_amdgcn_global_load_lds((const unsigned*)((const char*)(gbase) + (voff)[_i]), (LAS unsigned*)(lds + (bufoff) + ldsw + _i * 8192), 16, 0, 0); } while (0)
#define PG8_LD16(off) (*(const LAS i32x4*)(lds + (off)))
#define PG8_LDA(dst, b, h) do { _Pragma("unroll") for (int m = 0; m < 4; ++m) { const i32x4 lo_ = PG8_LD16(PG8_SA(b, h) + aoff + m * 2048), hi_ = PG8_LD16(PG8_SA(b, h) + aoff + m * 2048 + 1024); dst[m] = __builtin_shufflevector(lo_, hi_, 0, 1, 2, 3, 4, 5, 6, 7); } } while (0)
#define PG8_LDB(dst, b, h) do { _Pragma("unroll") for (int n = 0; n < 2; ++n) { const i32x4 lo_ = PG8_LD16(PG8_SB(b, h) + boff + n * 2048), hi_ = PG8_LD16(PG8_SB(b, h) + boff + n * 2048 + 1024); dst[n] = __builtin_shufflevector(lo_, hi_, 0, 1, 2, 3, 4, 5, 6, 7); } } while (0)
#define PG8_LOH(X) __builtin_bit_cast(bf16x8, __builtin_shufflevector((X), (X), 0, 1, 2, 3))
#define PG8_HIH(X) __builtin_bit_cast(bf16x8, __builtin_shufflevector((X), (X), 4, 5, 6, 7))
#define PG8_MMA(ai, bj, At, Bt) do { __builtin_amdgcn_s_setprio(1); \
        if constexpr (Prob::FP8) { _Pragma("unroll") for (int m = 0; m < 4; ++m) _Pragma("unroll") for (int n = 0; n < 2; ++n) \
            asm volatile("v_mfma_scale_f32_16x16x128_f8f6f4 %0, %1, %2, %0, %3, %3 op_sel_hi:[0,0,0]" : "+v"(acc[ai][bj][m][n]) : "v"(Bt[n]), "v"(At[m]), "v"(sc1)); } \
        else { _Pragma("unroll") for (int m = 0; m < 4; ++m) _Pragma("unroll") for (int n = 0; n < 2; ++n) { \
            acc[ai][bj][m][n] = __builtin_amdgcn_mfma_f32_16x16x32_bf16(PG8_LOH(Bt[n]), PG8_LOH(At[m]), acc[ai][bj][m][n], 0, 0, 0); \
            acc[ai][bj][m][n] = __builtin_amdgcn_mfma_f32_16x16x32_bf16(PG8_HIH(Bt[n]), PG8_HIH(At[m]), acc[ai][bj][m][n], 0, 0, 0); } } \
        __builtin_amdgcn_s_setprio(0); } while (0)
#define PG8_WAIT_V(n) asm volatile("s_waitcnt vmcnt(" #n ")" ::: "memory")
#define PG8_WAIT_L(n) asm volatile("s_waitcnt lgkmcnt(" #n ")" ::: "memory")
#define PG8_BAR __builtin_amdgcn_s_barrier()
#define PG8_SCHED __builtin_amdgcn_sched_barrier(0)
    Unit cur, nxt; int ui = 0;
    if (!S.next(0, cur)) return;
    f32x4 acc[2][2][4][2];
#pragma unroll
    for (int a = 0; a < 2; ++a)
#pragma unroll
        for (int b = 0; b < 2; ++b)
#pragma unroll
            for (int m = 0; m < 4; ++m)
#pragma unroll
                for (int n = 0; n < 2; ++n) acc[a][b][m][n] = (f32x4){0.f, 0.f, 0.f, 0.f};
    i32x8 At[4], B0[2], B1[2];
    const int sc1 = 0x7f7f7f7f;
    const char* cA = P.a_base(cur); const char* cB = P.b_base(cur);
    PG8_STAGE(PG8_SB(0, 0), cB, voffB); PG8_STAGE(PG8_SA(0, 0), cA, voffA); PG8_STAGE(PG8_SB(0, 1), cB + hstepB, voffB); PG8_STAGE(PG8_SA(0, 1), cA + hstepA, voffA);
    if (wr == 1) PG8_BAR;
    PG8_WAIT_V(4); PG8_BAR;
    PG8_STAGE(PG8_SB(1, 0), cB + kstep, voffB); PG8_STAGE(PG8_SA(1, 0), cA + kstep, voffA); PG8_STAGE(PG8_SB(1, 1), cB + hstepB + kstep, voffB);
    PG8_WAIT_V(6); PG8_BAR;
    for (;;) {
        const bool has_next = S.next(ui + 1, nxt);
        const char* nA = has_next ? P.a_base(nxt) : cA; const char* nB = has_next ? P.b_base(nxt) : cB;
        for (int t = 0; t < nt; t += 2) {
            const bool last = (t == nt - 2);
            const char* a1 = cA + (size_t)(t + 1) * kstep;
            const char* a2 = last ? nA : cA + (size_t)(t + 2) * kstep; const char* b2 = last ? nB : cB + (size_t)(t + 2) * kstep;
            const char* a3 = a2 + kstep; const char* b3 = b2 + kstep;
            PG8_LDB(B0, 0, 0); PG8_SCHED; PG8_LDA(At, 0, 0); PG8_STAGE(PG8_SA(1, 1), a1 + hstepA, voffA);
            PG8_WAIT_L(8); PG8_BAR; PG8_WAIT_L(0); PG8_MMA(0, 0, At, B0); PG8_BAR; PG8_SCHED;
            PG8_LDB(B1, 0, 1); PG8_STAGE(PG8_SB(0, 0), b2, voffB);
            PG8_BAR; PG8_WAIT_L(0); PG8_MMA(0, 1, At, B1); PG8_BAR;
            PG8_LDA(At, 0, 1); PG8_STAGE(PG8_SA(0, 0), a2, voffA);
            PG8_BAR; PG8_WAIT_L(0); PG8_MMA(1, 0, At, B0); PG8_BAR; PG8_SCHED;
            PG8_STAGE(PG8_SB(0, 1), b2 + hstepB, voffB);
            PG8_WAIT_V(6); PG8_BAR; PG8_MMA(1, 1, At, B1); PG8_BAR;
            PG8_LDB(B0, 1, 0); PG8_SCHED; PG8_LDA(At, 1, 0); PG8_STAGE(PG8_SA(0, 1), a2 + hstepA, voffA);
            PG8_WAIT_L(8); PG8_BAR; PG8_WAIT_L(0); PG8_MMA(0, 0, At, B0); PG8_BAR; PG8_SCHED;
            PG8_LDB(B1, 1, 1); PG8_STAGE(PG8_SB(1, 0), b3, voffB);
            PG8_BAR; PG8_WAIT_L(0); PG8_MMA(0, 1, At, B1); PG8_BAR;
            PG8_LDA(At, 1, 1); PG8_STAGE(PG8_SA(1, 0), a3, voffA);
            PG8_BAR; PG8_WAIT_L(0); PG8_MMA(1, 0, At, B0); PG8_BAR; PG8_SCHED;
            PG8_STAGE(PG8_SB(1, 1), b3 + hstepB, voffB);
            PG8_WAIT_V(6); PG8_BAR; PG8_MMA(1, 1, At, B1); PG8_BAR;
        }
        if constexpr (Prob::FP8) {
            asm volatile("s_nop 15\n\ts_nop 15" ::: "memory");
#pragma unroll
            for (int a_ = 0; a_ < 2; ++a_)
#pragma unroll
                for (int b_ = 0; b_ < 2; ++b_)
#pragma unroll
                    for (int m_ = 0; m_ < 4; ++m_)
#pragma unroll
                        for (int n_ = 0; n_ < 2; ++n_) asm volatile("" : "+v"(acc[a_][b_][m_][n_]));
        }
        { int fr_ = fr, fq_ = fq, wr_ = wr, wc_ = wc; asm volatile("" : "+v"(fr_), "+v"(fq_), "+s"(wr_), "+s"(wc_));
          E(acc, cur, wr_, wc_, fr_, fq_); }
        if (!has_next) break;
        const float carry = Epi::carry(cur);
#pragma unroll
        for (int a = 0; a < 2; ++a)
#pragma unroll
            for (int b = 0; b < 2; ++b)
#pragma unroll
                for (int m = 0; m < 4; ++m)
#pragma unroll
                    for (int n = 0; n < 2; ++n) acc[a][b][m][n] = Epi::CARRY ? acc[a][b][m][n] * carry : (f32x4){0.f, 0.f, 0.f, 0.f};
        cur = nxt; cA = nA; cB = nB; ++ui;
    }
    PG8_WAIT_V(0);
    if (wr == 0) PG8_BAR;
    PG8_BAR;
#undef PG8_SA
#undef PG8_SB
#undef PG8_STAGE
#undef PG8_LDA
#undef PG8_LDB
#undef PG8_MMA
#undef PG8_LD16
#undef PG8_LOH
#undef PG8_HIH
#undef PG8_WAIT_V
#undef PG8_WAIT_L
#undef PG8_BAR
#undef PG8_SCHED
}
}
using pg8::Unit;
typedef f32x4 Acc[2][2][4][2];

struct ProbPlain { static constexpr bool FP8 = false; const bf16_t* A; const bf16_t* Bt; int lda, ldb, K;
    DI const char* a_base(const Unit& u) const { return (const char*)(A + (size_t)u.pm * 256 * lda); }
    DI const char* b_base(const Unit& u) const { return (const char*)(Bt + (size_t)u.pn * 256 * ldb); } };
struct ProbCmp1 { static constexpr bool FP8 = false; const bf16_t* KCB; const bf16_t* VCB; const bf16_t* W; int lda, ldb, K;
    DI const char* a_base(const Unit& u) const { const int kv = u.pm >> 4, rt = u.pm & 15; return (const char*)((kv ? VCB : KCB) + (size_t)rt * 256 * 1024); }
    DI const char* b_base(const Unit& u) const { const int kv = u.pm >> 4; return (const char*)(W + (size_t)kv * 256 * 2048); } };
struct ProbAtt { static constexpr bool FP8 = false; const bf16_t* AQ; const bf16_t* KP; int lda, ldb, K;
    DI const char* a_base(const Unit& u) const { const int z = u.pm, n = z & 7, h = (z >> 3) & 3, b = z >> 5; const size_t t0 = (size_t)b * 2048 + n * 256; return (const char*)(AQ + (t0 * 4 + h) * 512 + 256); }
    DI const char* b_base(const Unit& u) const { const int z = u.pm, n = z & 7, h = (z >> 3) & 3, b = z >> 5; const size_t t0 = (size_t)b * 2048 + n * 256; return (const char*)(KP + t0 * 1024 + h * 256); } };
struct ProbUT { static constexpr bool FP8 = false; const bf16_t* VS; const bf16_t* KT; int lda, ldb, K;
    DI const char* a_base(const Unit& u) const { const int z = u.pm >> 1, half = u.pm & 1; return (const char*)(VS + (size_t)z * 262144 + (size_t)half * 256 * 512); }
    DI const char* b_base(const Unit& u) const { const int z = u.pm >> 1; return (const char*)(KT + (size_t)z * 65536); } };
struct ProbY { static constexpr bool FP8 = false; const bf16_t* AQ; const bf16_t* VS; int lda, ldb, K;
    DI const char* a_base(const Unit& u) const { const int z = u.pm, n = z & 7, h = (z >> 3) & 3, b = z >> 5; const size_t t0 = (size_t)b * 2048 + n * 256; return (const char*)(AQ + (t0 * 4 + h) * 512); }
    DI const char* b_base(const Unit& u) const { return (const char*)(VS + (size_t)u.pm * 262144 + (size_t)u.pn * 256 * 512); } };
DI int moe_tile_expert(const LAS int* ts, int rt) { int e = 0;
#pragma unroll 8
    for (int i = 1; i < 32; ++i) e += (rt >= ts[i]) ? 1 : 0;
    return e; }
struct ProbMoe { static constexpr bool FP8 = false; const bf16_t* A; const bf16_t* W; const LAS int* ts; int nper; int lda, ldb, K;
    DI const char* a_base(const Unit& u) const { return (const char*)(A + (size_t)u.pm * 256 * 1024); }
    DI const char* b_base(const Unit& u) const { const int e = moe_tile_expert(ts, u.pm); return (const char*)(W + ((size_t)e * nper + (size_t)u.pn * 256) * 1024); } };

struct ProbPlain8 { static constexpr bool FP8 = true; const unsigned char* A; const unsigned char* Bt; int lda, ldb, K;
    DI const char* a_base(const Unit& u) const { return (const char*)(A + (size_t)u.pm * 256 * lda * 2); }
    DI const char* b_base(const Unit& u) const { return (const char*)(Bt + (size_t)u.pn * 256 * ldb * 2); } };
struct ProbMoe8 { static constexpr bool FP8 = true; const unsigned char* A; const unsigned char* W; const LAS int* ts; int nper; int lda, ldb, K;
    DI const char* a_base(const Unit& u) const { return (const char*)(A + (size_t)u.pm * 256 * 1024); }
    DI const char* b_base(const Unit& u) const { const int e = moe_tile_expert(ts, u.pm); return (const char*)(W + ((size_t)e * nper + (size_t)u.pn * 256) * 1024); } };

#define EPI_ROWS(ai, m) (128 * (ai) + 64 * wr + 16 * (m) + fr)
struct EpiEvNat { static constexpr bool CARRY = false; static DI float carry(const Unit&) { return 0.f; } static constexpr bool PERM = true;
    unsigned char* ws; const float* gains;
    DI void operator()(const Acc& acc, const Unit& u, int wr, int wc, int fr, int fq) const {
        const int pn = u.pn; const bool norm = (pn != 6);
        const int gi = pn < 2 ? 0 : pn < 4 ? 1 : pn < 6 ? 2 : 3;
        const float* g = gains + gi * 64;
        f32x4 gv[2][2];
#pragma unroll
        for (int bj = 0; bj < 2; ++bj)
#pragma unroll
            for (int n = 0; n < 2; ++n) { const f32x4 t4 = *(const f32x4*)(g + 32 * bj + 8 * fq + 4 * n); gv[bj][n] = norm ? t4 : (f32x4){1.f, 1.f, 1.f, 1.f}; }
        size_t boff; int rowmul, hoff; bool panel = false;
        if (pn < 2) { boff = WS_QD; rowmul = 512; hoff = (pn * 4 + wc) * 64; }
        else if (pn < 4) { boff = WS_KD; rowmul = 512; hoff = ((pn - 2) * 4 + wc) * 64; }
        else if (pn < 6) { boff = WS_QN; rowmul = 512; hoff = ((pn - 4) * 4 + wc) * 64; }
        else { panel = true; rowmul = 64; hoff = 0; boff = (pn == 6) ? (wc < 2 ? WS_KCB : WS_VCB) : (wc < 2 ? WS_KSB : WS_KWB); }
        bf16_t* base = (bf16_t*)(ws + boff);
#pragma unroll
        for (int ai = 0; ai < 2; ++ai)
#pragma unroll
            for (int m = 0; m < 4; ++m) {
                const int t = u.pm * 256 + EPI_ROWS(ai, m), b = t >> 11, sq = t & 2047;
                float ss = 0.f;
#pragma unroll
                for (int bj = 0; bj < 2; ++bj)
#pragma unroll
                    for (int n = 0; n < 2; ++n) { const f32x4 x = acc[ai][bj][m][n]; ss += (x[0] * x[0] + x[1] * x[1]) + (x[2] * x[2] + x[3] * x[3]); }
                ss += shx(ss, 16); ss += shx(ss, 32);
                const float rstd = norm ? rsqrtf(ss * (1.0f / 64.0f) + EPS) * ((pn < 2 || pn == 4 || pn == 5) ? 0.125f : 1.0f) : 1.0f;
                const size_t rowi = panel ? ((size_t)(b * 2 + (wc & 1)) * 2048 + sq) : (size_t)t;
#pragma unroll
                for (int bj = 0; bj < 2; ++bj) {
                    const f32x4 v0 = acc[ai][bj][m][0] * rstd * gv[bj][0], v1 = acc[ai][bj][m][1] * rstd * gv[bj][1];
                    *(u32x4*)(base + rowi * rowmul + hoff + 32 * bj + 8 * fq) = pack8(v0, v1);
                }
            }
    }
};
struct EpiEvSw { static constexpr bool CARRY = false; static DI float carry(const Unit&) { return 0.f; } static constexpr bool PERM = true;
    unsigned char* ws;
    DI void operator()(const Acc& acc, const Unit& u, int wr, int wc, int fr, int fq) const {
        const int b = u.pn >> 3, sb = (u.pn & 7) * 256;
#pragma unroll
        for (int ai = 0; ai < 2; ++ai)
#pragma unroll
            for (int m = 0; m < 4; ++m) {
                const int rl = EPI_ROWS(ai, m);
                size_t boff, rowi;
                if (u.pm < 2) { const int fg = u.pm * 256 + rl; boff = WS_VAT; rowi = (size_t)(b * 4 + (fg >> 7)) * 128 + (fg & 127); }
                else { const int r2 = rl & 127; boff = (rl < 128) ? WS_VST : WS_VWT; rowi = (size_t)(b * 2 + (r2 >> 6)) * 64 + (r2 & 63); }
                bf16_t* rowp = (bf16_t*)(ws + boff) + rowi * 2048;
#pragma unroll
                for (int bj = 0; bj < 2; ++bj) *(u32x4*)(rowp + sb + 128 * bj + 32 * wc + 8 * fq) = pack8(acc[ai][bj][m][0], acc[ai][bj][m][1]);
            }
    }
};
struct EpiCmp1 { static constexpr bool CARRY = false; static DI float carry(const Unit&) { return 0.f; } static constexpr bool PERM = true;
    bf16_t* HID; const float* bias1;
    DI void operator()(const Acc& acc, const Unit& u, int wr, int wc, int fr, int fq) const {
        const int kv = u.pm >> 4, rt = u.pm & 15;
#pragma unroll
        for (int bj = 0; bj < 2; ++bj) {
            const int col = 128 * bj + 32 * wc + 8 * fq;
            const f32x4 b0 = *(const f32x4*)(bias1 + kv * 256 + col), b1 = *(const f32x4*)(bias1 + kv * 256 + col + 4);
#pragma unroll
            for (int ai = 0; ai < 2; ++ai)
#pragma unroll
                for (int m = 0; m < 4; ++m) {
                    f32x4 v0 = acc[ai][bj][m][0] + b0, v1 = acc[ai][bj][m][1] + b1;
#pragma unroll
                    for (int j = 0; j < 4; ++j) { v0[j] = v0[j] * sigm(v0[j]); v1[j] = v1[j] * sigm(v1[j]); }
                    *(u32x4*)(HID + ((size_t)kv * 4096 + rt * 256 + EPI_ROWS(ai, m)) * 256 + col) = pack8(v0, v1);
                }
        }
    }
};
struct EpiResid { static constexpr bool CARRY = false; static DI float carry(const Unit&) { return 0.f; } static constexpr bool PERM = false;
    const float* Hin; float* Hout;
    DI void operator()(const Acc& acc, const Unit& u, int wr, int wc, int fr, int fq) const {
#pragma unroll
        for (int ai = 0; ai < 2; ++ai)
#pragma unroll
            for (int m = 0; m < 4; ++m) {
                const size_t off = (size_t)(u.pm * 256 + EPI_ROWS(ai, m)) * 1024 + u.pn * 256 + 32 * wc + 4 * fq;
#pragma unroll
                for (int bj = 0; bj < 2; ++bj)
#pragma unroll
                    for (int n = 0; n < 2; ++n) { const size_t o = off + 128 * bj + 16 * n; *(f32x4*)(Hout + o) = *(const f32x4*)(Hin + o) + acc[ai][bj][m][n]; }
            }
    }
};
DI float ret_lg2(int h) { return __log2f(1.0f - exp2f(-5.0f - (float)h)); }
struct EpiOdNat { static constexpr bool CARRY = false; static DI float carry(const Unit&) { return 0.f; } static constexpr bool PERM = true;
    unsigned char* ws;
    DI void operator()(const Acc& acc, const Unit& u, int wr, int wc, int fr, int fq) const {
        const int pn = u.pn; const int h = pn & 3; const float lg = ret_lg2(h);
        const size_t boff = pn < 4 ? WS_AQ : pn < 8 ? WS_KP : WS_GG;
        const int rowmul = pn < 4 ? 2048 : pn < 8 ? 1024 : 2048;
        const int coff = pn < 4 ? (h * 512 + 256) : pn < 8 ? (h * 256) : ((pn - 8) * 256);
        bf16_t* base = (bf16_t*)(ws + boff) + coff;
#pragma unroll
        for (int ai = 0; ai < 2; ++ai)
#pragma unroll
            for (int m = 0; m < 4; ++m) {
                const int cl = EPI_ROWS(ai, m); const size_t t = (size_t)u.pm * 256 + cl;
                float sc = 1.f;
                if (pn < 4) sc = exp2f(lg * (float)(cl + 1)); else if (pn < 8) sc = 0.0625f * exp2f(-lg * (float)(cl + 1));
#pragma unroll
                for (int bj = 0; bj < 2; ++bj) {
                    const int d = 128 * bj + 32 * wc + 8 * fq;
                    f32x4 v0 = acc[ai][bj][m][0] * sc, v1 = acc[ai][bj][m][1] * sc;
                    if (pn >= 8) {
#pragma unroll
                        for (int j = 0; j < 4; ++j) { v0[j] = v0[j] * sigm(v0[j]); v1[j] = v1[j] * sigm(v1[j]); } }
                    *(u32x4*)(base + t * rowmul + d) = pack8(v0, v1);
                }
            }
    }
};
struct EpiOdSw { static constexpr bool CARRY = false; static DI float carry(const Unit&) { return 0.f; } static constexpr bool PERM = true;
    unsigned char* ws;
    DI void operator()(const Acc& acc, const Unit& u, int wr, int wc, int fr, int fq) const {
        const int b = u.pn >> 3, n = u.pn & 7;
        const bool isk = u.pm < 4; const int h = isk ? u.pm : ((u.pm - 4) >> 1);
        const size_t z = (size_t)(b * 4 + h) * 8 + n; const float lg = ret_lg2(h);
        bf16_t* base = (bf16_t*)(ws + (isk ? WS_KT : WS_VS)) + (isk ? z * 65536 : z * 262144 + (size_t)((u.pm - 4) & 1) * 256 * 512);
        const int rowmul = isk ? 256 : 512;
#pragma unroll
        for (int bj = 0; bj < 2; ++bj) {
            const int cl = 128 * bj + 32 * wc + 8 * fq;
            f32x4 s0 = {1.f, 1.f, 1.f, 1.f}, s1 = s0;
            if (isk) {
#pragma unroll
                for (int j = 0; j < 4; ++j) { s0[j] = 0.0625f * exp2f(-lg * (float)(cl + j + 1)); s1[j] = 0.0625f * exp2f(-lg * (float)(cl + 4 + j + 1)); } }
#pragma unroll
            for (int ai = 0; ai < 2; ++ai)
#pragma unroll
                for (int m = 0; m < 4; ++m)
                    *(u32x4*)(base + (size_t)EPI_ROWS(ai, m) * rowmul + cl) = pack8(acc[ai][bj][m][0] * s0, acc[ai][bj][m][1] * s1);
        }
    }
};
struct EpiAtt { static constexpr bool CARRY = false; static DI float carry(const Unit&) { return 0.f; } static constexpr bool PERM = true;
    bf16_t* AQ;
    DI void operator()(const Acc& acc, const Unit& u, int wr, int wc, int fr, int fq) const {
        const int z = u.pm, n = z & 7, h = (z >> 3) & 3, b = z >> 5; const size_t t0 = (size_t)b * 2048 + n * 256;
#pragma unroll
        for (int ai = 0; ai < 2; ++ai)
#pragma unroll
            for (int m = 0; m < 4; ++m) {
                const int c = EPI_ROWS(ai, m);
#pragma unroll
                for (int bj = 0; bj < 2; ++bj) {
                    const int e0 = 128 * bj + 32 * wc + 8 * fq;
                    f32x4 v0 = acc[ai][bj][m][0], v1 = acc[ai][bj][m][1];
#pragma unroll
                    for (int j = 0; j < 4; ++j) { v0[j] = (c >= e0 + j) ? v0[j] : 0.f; v1[j] = (c >= e0 + 4 + j) ? v1[j] : 0.f; }
                    *(u32x4*)(AQ + ((t0 + c) * 4 + h) * 512 + e0) = pack8(v0, v1);
                }
            }
    }
};
struct EpiUT { static constexpr bool CARRY = false; static DI float carry(const Unit&) { return 0.f; } static constexpr bool PERM = true;
    bf16_t* UT;
    DI void operator()(const Acc& acc, const Unit& u, int wr, int wc, int fr, int fq) const {
        const size_t z = (size_t)(u.pm >> 1); const int half = u.pm & 1;
#pragma unroll
        for (int ai = 0; ai < 2; ++ai)
#pragma unroll
            for (int m = 0; m < 4; ++m) {
                bf16_t* rowp = UT + z * 131072 + (size_t)(half * 256 + EPI_ROWS(ai, m)) * 256 + 32 * wc + 8 * fq;
#pragma unroll
                for (int bj = 0; bj < 2; ++bj) *(u32x4*)(rowp + 128 * bj) = pack8(acc[ai][bj][m][0], acc[ai][bj][m][1]);
            }
    }
};
struct EpiUTScan { static constexpr bool CARRY = true; static constexpr bool PERM = true;
    static DI float carry(const Unit& u) { const int z = u.pm >> 1, n = z & 7, h = (z >> 3) & 3; return n == 7 ? 0.f : exp2f(256.0f * ret_lg2(h)); }
    bf16_t* VS;
    DI void operator()(const Acc& acc, const Unit& u, int wr, int wc, int fr, int fq) const {
        const size_t z = (size_t)(u.pm >> 1); const int half = u.pm & 1, n = (int)(z & 7), h = (int)((z >> 3) & 3);
        const float dec = exp2f(256.0f * ret_lg2(h));
#pragma unroll
        for (int ai = 0; ai < 2; ++ai)
#pragma unroll
            for (int m = 0; m < 4; ++m) {
                bf16_t* rowp = VS + (z * 512 + half * 256 + EPI_ROWS(ai, m)) * 512 + 256 + 32 * wc + 8 * fq;
#pragma unroll
                for (int bj = 0; bj < 2; ++bj) {
                    if (n == 0) { unsigned z0; asm volatile("v_mov_b32 %0, 0" : "=v"(z0)); *(u32x4*)(rowp + 128 * bj) = (u32x4){z0, z0, z0, z0}; }
                    if (n < 7) *(u32x4*)(rowp + (size_t)512 * 512 + 128 * bj) = pack8(acc[ai][bj][m][0] * dec, acc[ai][bj][m][1] * dec);
                }
            }
    }
};
struct SchedSeq { int nb, c;
    DI void init(int G, int c_) { nb = G / 2 > 0 ? G / 2 : 1; c = c_; }
    DI bool next(int i, Unit& u) const { if (c >= nb) return false; const int seq = c + (i >> 3) * nb; if (seq >= 128) return false;
        const int bh = seq >> 1, half = seq & 1, n = i & 7; u.pm = (bh * 8 + n) * 2 + half; u.pn = 0; return true; } };
struct EpiY { static constexpr bool CARRY = false; static DI float carry(const Unit&) { return 0.f; } static constexpr bool PERM = true;
    bf16_t* Y;
    DI void operator()(const Acc& acc, const Unit& u, int wr, int wc, int fr, int fq) const {
        const int z = u.pm, n = z & 7, h = (z >> 3) & 3, b = z >> 5; const size_t t0 = (size_t)b * 2048 + n * 256;
#pragma unroll
        for (int ai = 0; ai < 2; ++ai)
#pragma unroll
            for (int m = 0; m < 4; ++m) {
                bf16_t* rowp = Y + (t0 + EPI_ROWS(ai, m)) * 2048 + h * 512 + u.pn * 256 + 32 * wc + 8 * fq;
#pragma unroll
                for (int bj = 0; bj < 2; ++bj) *(u32x4*)(rowp + 128 * bj) = pack8(acc[ai][bj][m][0], acc[ai][bj][m][1]);
            }
    }
};
constexpr float W8_SCALE = 32.0f, WSC = 1.0f / W8_SCALE;
struct EpiGU { static constexpr bool CARRY = false; static DI float carry(const Unit&) { return 0.f; } static constexpr bool PERM = true;
    unsigned char* ACT; const float* bgu; const LAS int* ts;
    DI void operator()(const Acc& acc, const Unit& u, int wr, int wc, int fr, int fq) const {
        const int e = moe_tile_expert(ts, u.pm); const int w = 32 * wc + 8 * fq;
        const float* bp = bgu + (size_t)e * 2048 + 128 * u.pn + w;
        const f32x4 bg0 = *(const f32x4*)bp, bg1 = *(const f32x4*)(bp + 4), bl0 = *(const f32x4*)(bp + 1024), bl1 = *(const f32x4*)(bp + 1028);
#pragma unroll
        for (int ai = 0; ai < 2; ++ai)
#pragma unroll
            for (int m = 0; m < 4; ++m) {
                f32x4 g0 = acc[ai][0][m][0] * WSC + bg0, g1 = acc[ai][0][m][1] * WSC + bg1, l0 = acc[ai][1][m][0] * WSC + bl0, l1 = acc[ai][1][m][1] * WSC + bl1;
#pragma unroll
                for (int j = 0; j < 4; ++j) {
                    const float a = fminf(g0[j], 7.0f), c = fminf(g1[j], 7.0f);
                    const float la = fminf(fmaxf(l0[j], -7.0f), 7.0f), lc = fminf(fmaxf(l1[j], -7.0f), 7.0f);
                    g0[j] = a * sigm(1.702f * a) * (la + 1.0f); g1[j] = c * sigm(1.702f * c) * (lc + 1.0f); }
                u32x2 o8; o8.x = pk4_fp8(g0[0], g0[1], g0[2], g0[3]); o8.y = pk4_fp8(g1[0], g1[1], g1[2], g1[3]);
                *(u32x2*)(ACT + ((size_t)u.pm * 256 + EPI_ROWS(ai, m)) * 1024 + 128 * u.pn + w) = o8;
            }
    }
};
struct EpiDN { static constexpr bool CARRY = false; static DI float carry(const Unit&) { return 0.f; } static constexpr bool PERM = true;
    bf16_t* YB; const float* bdn; const LAS int* ts;
    DI void operator()(const Acc& acc, const Unit& u, int wr, int wc, int fr, int fq) const {
        const int e = moe_tile_expert(ts, u.pm);
#pragma unroll
        for (int bj = 0; bj < 2; ++bj) {
            const int col = 256 * u.pn + 128 * bj + 32 * wc + 8 * fq;
            const f32x4 b0 = *(const f32x4*)(bdn + (size_t)e * 1024 + col), b1 = *(const f32x4*)(bdn + (size_t)e * 1024 + col + 4);
#pragma unroll
            for (int ai = 0; ai < 2; ++ai)
#pragma unroll
                for (int m = 0; m < 4; ++m)
                    *(u32x4*)(YB + ((size_t)u.pm * 256 + EPI_ROWS(ai, m)) * 1024 + col) = pack8(acc[ai][bj][m][0] * (1.0f / 64.0f) + b0, acc[ai][bj][m][1] * (1.0f / 64.0f) + b1);
        }
    }
};
struct EpiPP { static constexpr bool CARRY = false; static DI float carry(const Unit&) { return 0.f; } static constexpr bool PERM = true;
    bf16_t* PP;
    DI void operator()(const Acc& acc, const Unit& u, int wr, int wc, int fr, int fq) const {
#pragma unroll
        for (int ai = 0; ai < 2; ++ai)
#pragma unroll
            for (int m = 0; m < 4; ++m) {
                bf16_t* rowp = PP + ((size_t)u.pm * 256 + EPI_ROWS(ai, m)) * 1024 + u.pn * 256 + 32 * wc + 8 * fq;
#pragma unroll
                for (int bj = 0; bj < 2; ++bj) *(u32x4*)(rowp + 128 * bj) = pack8(acc[ai][bj][m][0], acc[ai][bj][m][1]);
            }
    }
};
struct EpiPLE { static constexpr bool CARRY = false; static DI float carry(const Unit&) { return 0.f; } static constexpr bool PERM = false;
    float* H; const bf16_t* PP;
    DI void operator()(const Acc& acc, const Unit& u, int wr, int wc, int fr, int fq) const {
#pragma unroll
        for (int ai = 0; ai < 2; ++ai)
#pragma unroll
            for (int m = 0; m < 4; ++m) {
                const size_t off = (size_t)(u.pm * 256 + EPI_ROWS(ai, m)) * 1024 + u.pn * 256 + 32 * wc + 4 * fq;
#pragma unroll
                for (int bj = 0; bj < 2; ++bj)
#pragma unroll
                    for (int n = 0; n < 2; ++n) {
                        const size_t o = off + 128 * bj + 16 * n;
                        const u32x2 pw = *(const u32x2*)(PP + o); const f32x4 a = acc[ai][bj][m][n]; f32x4 hv = *(const f32x4*)(H + o);
                        hv[0] += sigm(a[0] * WSC) * bflo(pw.x); hv[1] += sigm(a[1] * WSC) * bfhi(pw.x); hv[2] += sigm(a[2] * WSC) * bflo(pw.y); hv[3] += sigm(a[3] * WSC) * bfhi(pw.y);
                        *(f32x4*)(H + o) = hv;
                    }
            }
    }
};

constexpr int AT_KSTR = 144;
template <int DV, int MODE>
DI void attn_unit(const int WID, LAS unsigned char* lds, const bf16_t* Qp, int ldq, const bf16_t* Kp, int ldk, const bf16_t* Vt, int ldvt, int q0, float slope, int dcut,
                  const unsigned* selp, bf16_t* Op, int ldo, float* impp) {
    constexpr int NRB = DV / 32, VPIECES = DV * 8;
    constexpr int KB0 = 0, KB1 = 64 * AT_KSTR, VB0 = 2 * 64 * AT_KSTR, VB1 = VB0 + DV * AT_KSTR;
    const int tid = opaque_tid(WID), w = __builtin_amdgcn_readfirstlane(tid >> 6), lane = tid & 63, r = lane & 31, hh = lane >> 5;
    const int qrow = q0 + 32 * w + r, qw_first = q0 + 32 * w, qw_last = qw_first + 31;
    const float LOG2E = 1.44269504089f;
    bf16x8 qf[4];
#pragma unroll
    for (int ks = 0; ks < 4; ++ks) qf[ks] = *(const bf16x8*)(Qp + (size_t)(32 * w + r) * ldq + 16 * ks + 8 * hh);
    unsigned selm = 0xffffffffu, orm = 0xffffffffu;
    if (MODE == 1) { selm = selp[32 * w + r]; orm = selm;
#pragma unroll
        for (int o = 1; o < 32; o <<= 1) orm |= shxu(orm, o); }
    const int nv = (MODE == 3) ? (qrow >= 31 ? ((qrow - 15) >> 4) : 0) : 0;
    const int nv_wmax = (MODE == 3) ? (qw_last >= 31 ? ((qw_last - 15) >> 4) : 0) : 0;
    int kt_lo = 0, kt_hi;
    if (MODE == 0 || MODE == 1) kt_hi = (q0 >> 6) + 4;
    else if (MODE == 2) { kt_hi = (q0 >> 6) + 4; const int lk = q0 - 511; kt_lo = lk > 0 ? (lk >> 6) : 0; }
    else kt_hi = 2;
    if (MODE != 3) { const int kmin = q0 - dcut; const int lo2 = kmin > 0 ? (kmin >> 6) : 0; kt_lo = lo2 > kt_lo ? lo2 : kt_lo; }
    f32x16 cb[2];
#pragma unroll
    for (int kk = 0; kk < 2; ++kk)
#pragma unroll
        for (int i = 0; i < 16; ++i) cb[kk][i] = (MODE == 3) ? 0.f : slope * (float)(32 * kk + 8 * (i >> 2) + (i & 3) + 4 * hh);
    f32x16 O[NRB];
#pragma unroll
    for (int rb = 0; rb < NRB; ++rb)
#pragma unroll
        for (int i = 0; i < 16; ++i) O[rb][i] = 0.f;
    float mrun = NEGF, lrun = 0.f;
    u32x4 kreg, vreg[2];
    const int krow = tid >> 3, kpc = tid & 7;
#define AT_GLOAD(kt) do { kreg = *(const u32x4*)(Kp + (size_t)(64 * (kt) + krow) * ldk + 8 * kpc); \
        _Pragma("unroll") for (int i_ = 0; i_ < 2; ++i_) { const int idx = tid + 512 * i_; if (idx < VPIECES) vreg[i_] = *(const u32x4*)(Vt + (size_t)(idx >> 3) * ldvt + 64 * (kt) + 8 * (idx & 7)); } } while (0)
#define AT_LWRITE(buf) do { *(LAS u32x4*)(lds + ((buf) ? KB1 : KB0) + krow * AT_KSTR + kpc * 16) = kreg; \
        _Pragma("unroll") for (int i_ = 0; i_ < 2; ++i_) { const int idx = tid + 512 * i_; if (idx < VPIECES) { const int p_ = idx & 7; \
            LAS unsigned char* d_ = lds + ((buf) ? VB1 : VB0) + (idx >> 3) * AT_KSTR + (p_ >> 1) * 32 + (p_ & 1) * 8; \
            *(LAS u32x2*)d_ = (u32x2){vreg[i_].x, vreg[i_].y}; *(LAS u32x2*)(d_ + 16) = (u32x2){vreg[i_].z, vreg[i_].w}; } } } while (0)
    AT_GLOAD(kt_hi - 1); AT_LWRITE(0);
    __syncthreads();
    const int ntile = kt_hi - kt_lo;
    for (int it = 0; it < ntile; ++it) {
        const int kt = kt_hi - 1 - it, buf = it & 1, key0 = 64 * kt;
        if (it + 1 < ntile) AT_GLOAD(kt - 1);
        bool skip;
        if (MODE == 0) skip = key0 > qw_last;
        else if (MODE == 1) skip = (key0 > qw_last) || !((orm >> kt) & 1u);
        else if (MODE == 2) skip = (key0 > qw_last) || (key0 + 63 < qw_first - 511);
        else skip = key0 >= nv_wmax;
        if (!skip) {
            const LAS unsigned char* kb = lds + (buf ? KB1 : KB0); const LAS unsigned char* vb = lds + (buf ? VB1 : VB0);
            f32x16 S[2];
#pragma unroll
            for (int kk = 0; kk < 2; ++kk) {
                S[kk] = cb[kk];
#pragma unroll
                for (int ks = 0; ks < 4; ++ks) { const bf16x8 a = *(const LAS bf16x8*)(kb + (32 * kk + r) * AT_KSTR + (16 * ks + 8 * hh) * 2);
                    S[kk] = __builtin_amdgcn_mfma_f32_32x32x16_bf16(a, qf[ks], S[kk], 0, 0, 0); }
            }
            const bool bnd = (MODE == 3) ? true : ((key0 + 63 > qw_first) || (MODE == 2 && key0 < qw_last - 511));
            if (bnd) {
                const int lim = (MODE == 3) ? (nv - key0 - 4 * hh) : (qrow - key0 - 4 * hh);
#pragma unroll
                for (int kk = 0; kk < 2; ++kk)
#pragma unroll
                    for (int i = 0; i < 16; ++i) { const int cki = 32 * kk + 8 * (i >> 2) + (i & 3);
                        bool valid;
                        if (MODE == 3) valid = cki < lim; else if (MODE == 2) valid = (cki <= lim) && (cki > lim - 512); else valid = cki <= lim;
                        S[kk][i] = valid ? S[kk][i] : NEGF; }
            }
            float mx = NEGF;
#pragma unroll
            for (int kk = 0; kk < 2; ++kk)
#pragma unroll
                for (int i = 0; i < 16; ++i) mx = fmaxf(mx, S[kk][i]);
            mx = fmaxf(mx, shx(mx, 32));
            const float off = (MODE == 3) ? 0.f : slope * (float)key0;
            mx += off;
            bool selok = true;
            if (MODE == 1) { selok = ((selm >> kt) & 1u) != 0u; mx = selok ? mx : NEGF; }
            const float mnew = fmaxf(mrun, mx);
            const float meff = (mnew < -1e29f) ? 0.f : mnew;
            float c = (off - meff) * LOG2E;
            if (MODE == 1) c = selok ? c : NEGF;
            float ps = 0.f;
#pragma unroll
            for (int kk = 0; kk < 2; ++kk)
#pragma unroll
                for (int i = 0; i < 16; ++i) { const float p = __builtin_amdgcn_exp2f(__builtin_fmaf(S[kk][i], LOG2E, c)); S[kk][i] = p; ps += p; }
            if (__any(mnew > mrun)) {
                const float alpha = __builtin_amdgcn_exp2f((mrun - mnew) * LOG2E);
                lrun *= alpha;
#pragma unroll
                for (int rb = 0; rb < NRB; ++rb)
#pragma unroll
                    for (int i = 0; i < 16; ++i) O[rb][i] *= alpha;
            }
            mrun = mnew; lrun += ps;
#pragma unroll
            for (int kk = 0; kk < 2; ++kk)
#pragma unroll
                for (int s2 = 0; s2 < 2; ++s2) {
                    u32x4 pw; pw.x = pk2(S[kk][8 * s2 + 0], S[kk][8 * s2 + 1]); pw.y = pk2(S[kk][8 * s2 + 2], S[kk][8 * s2 + 3]);
                    pw.z = pk2(S[kk][8 * s2 + 4], S[kk][8 * s2 + 5]); pw.w = pk2(S[kk][8 * s2 + 6], S[kk][8 * s2 + 7]);
                    const bf16x8 pf = __builtin_bit_cast(bf16x8, pw);
#pragma unroll
                    for (int rb = 0; rb < NRB; ++rb) {
                        const bf16x8 a = *(const LAS bf16x8*)(vb + (32 * rb + r) * AT_KSTR + (2 * kk + s2) * 32 + hh * 16);
                        O[rb] = __builtin_amdgcn_mfma_f32_32x32x16_bf16(a, pf, O[rb], 0, 0, 0);
                    }
                }
        }
        if (it + 1 < ntile) AT_LWRITE(buf ^ 1);
        __syncthreads();
    }
#undef AT_GLOAD
#undef AT_LWRITE
    const float ltot = lrun + shx(lrun, 32);
    float inv = 1.0f / ltot;
    if (MODE == 3) inv = (nv > 0) ? inv : 0.f;
#pragma unroll
    for (int rb = 0; rb < NRB; ++rb)
#pragma unroll
        for (int g4 = 0; g4 < 4; ++g4) {
            const float a = O[rb][4 * g4] * inv, b = O[rb][4 * g4 + 1] * inv, c = O[rb][4 * g4 + 2] * inv, d = O[rb][4 * g4 + 3] * inv;
            const int dv = 32 * rb + 8 * g4 + 4 * hh;
            if (MODE == 3 && rb == 2) { *(f32x4*)(impp + (size_t)(32 * w + r) * 256 + (dv - 64)) = (f32x4){a, b, c, d}; }
            else { u32x2 o; o.x = pk2(a, b); o.y = pk2(c, d); *(u32x2*)(Op + (size_t)(32 * w + r) * ldo + dv) = o; }
        }
}

struct Args { const float* in[26]; float* out; unsigned char* ws; int ph_lo, ph_hi; };
typedef const __attribute__((address_space(4))) Args* ArgsP;
DI ArgsP opaque_args() { auto p = __builtin_amdgcn_kernarg_segment_ptr(); asm volatile("" : "+s"(p)); return (ArgsP)p; }
enum { I_X = 0, I_P, I_N1G, I_N2G, I_EVWIN, I_EVWOUT, I_DAQN, I_DAKN, I_DALAM, I_DAOUTG, I_NSQN, I_NSKN, I_CMPPE, I_CMPW1, I_CMPW2, I_ODWIN, I_ODWOUT,
       I_RETG, I_ROUTW, I_ROUTB, I_WGU, I_BGU, I_WDN, I_BDN, I_PLEP, I_PLEG };

struct CvtJob { int in_idx, ldsrc, K, col0, ncols, dstrow0, perm, nmat; size_t src_stride, dst_off, dst_stride; int fp8, pad; };
constexpr int NJOBS = 19;
__constant__ CvtJob c_jobs[NJOBS] = {
    {I_EVWIN, EVIN, 1024, 0,    1024, 0,    1, 2, (size_t)1024 * EVIN, WS_EVNAT, (size_t)2048 * 1024, 0, 0},
    {I_EVWIN, EVIN, 1024, 1536, 512,  1024, 1, 2, (size_t)1024 * EVIN, WS_EVNAT, (size_t)2048 * 1024, 0, 0},
    {I_EVWIN, EVIN, 1024, 2048, 128,  1536, 1, 2, (size_t)1024 * EVIN, WS_EVNAT, (size_t)2048 * 1024, 0, 0},
    {I_EVWIN, EVIN, 1024, 2176, 128,  1664, 1, 2, (size_t)1024 * EVIN, WS_EVNAT, (size_t)2048 * 1024, 0, 0},
    {I_EVWIN, EVIN, 1024, 2304, 128,  1792, 1, 2, (size_t)1024 * EVIN, WS_EVNAT, (size_t)2048 * 1024, 0, 0},
    {I_EVWIN, EVIN, 1024, 2560, 128,  1920, 1, 2, (size_t)1024 * EVIN, WS_EVNAT, (size_t)2048 * 1024, 0, 0},
    {I_EVWIN, EVIN, 1024, 1024, 512,  0,    0, 2, (size_t)1024 * EVIN, WS_EVSW,  (size_t)768 * 1024, 0, 0},
    {I_EVWIN, EVIN, 1024, 2432, 128,  512,  0, 2, (size_t)1024 * EVIN, WS_EVSW,  (size_t)768 * 1024, 0, 0},
    {I_EVWIN, EVIN, 1024, 2688, 128,  640,  0, 2, (size_t)1024 * EVIN, WS_EVSW,  (size_t)768 * 1024, 0, 0},
    {I_EVWOUT, 1024, 1024, 0, 1024, 0, 0, 2, (size_t)1024 * 1024, WS_EVOUT, (size_t)1024 * 1024, 0, 0},
    {I_CMPW1, 256, 2048, 0, 256, 0, 0, 4, (size_t)2048 * 256, WS_CMP1, (size_t)256 * 2048, 0, 0},
    {I_ODWIN, ODIN, 1024, 0,    2048, 0,    0, 2, (size_t)1024 * ODIN, WS_ODNAT, (size_t)4096 * 1024, 0, 0},
    {I_ODWIN, ODIN, 1024, 4096, 2048, 2048, 0, 2, (size_t)1024 * ODIN, WS_ODNAT, (size_t)4096 * 1024, 0, 0},
    {I_ODWIN, ODIN, 1024, 1024, 3072, 0,    0, 2, (size_t)1024 * ODIN, WS_ODSW,  (size_t)3072 * 1024, 0, 0},
    {I_ODWOUT, 1024, 2048, 0, 1024, 0, 0, 2, (size_t)2048 * 1024, WS_ODOUT, (size_t)1024 * 2048, 0, 0},
    {I_WGU, 2048, 1024, 0, 2048, 0, 2, 128, (size_t)1024 * 2048, WS_WGU, (size_t)2048 * 1024, 32, 0},
    {I_WDN, 1024, 1024, 0, 1024, 0, 0, 128, (size_t)1024 * 1024, WS_WDN, (size_t)1024 * 1024, 64, 0},
    {I_PLEP, 1024, 256, 0, 1024, 0, 0, 4, (size_t)256 * 1024, WS_WPP, (size_t)1024 * 256, 0, 0},
    {I_PLEG, 1024, 1024, 0, 1024, 0, 0, 4, (size_t)1024 * 1024, WS_WPG, (size_t)1024 * 1024, 32, 0},
};
DI int cvt_dstrow(int perm, int L) {
    if (perm == 1) { const int pn = L >> 8, lc = L & 255; return pn * 256 + 128 * ((lc & 63) >> 5) + 32 * (lc >> 6) + (lc & 31); }
    if (perm == 2) { const int bj = L >> 10, cc = L & 1023; return 256 * (cc >> 7) + 128 * bj + (cc & 127); }
    return L;
}
DI void phase_prologue(const int WID, ArgsP a, LAS unsigned char* lds) {
    const int tid = opaque_tid(WID), lane = tid & 63, wv = tid >> 6;
    const int gw = blockIdx.x * 8 + wv, NGW = gridDim.x * 8;
    LAS float* scr = (LAS float*)(lds + wv * 16640);
    int total = 0;
    for (int j = 0; j < NJOBS; ++j) total += c_jobs[j].nmat * (c_jobs[j].K >> 6) * (c_jobs[j].ncols >> 6);
#define PRO_DECODE(IT, JJ, MAT, K0, N0, SRC) do { int r_ = (IT), j_ = 0; \
        for (; j_ < NJOBS; ++j_) { const int n_ = c_jobs[j_].nmat * (c_jobs[j_].K >> 6) * (c_jobs[j_].ncols >> 6); if (r_ < n_) break; r_ -= n_; } \
        JJ = j_; const int nkb_ = c_jobs[j_].K >> 6, nnb_ = c_jobs[j_].ncols >> 6, per_ = nkb_ * nnb_; MAT = r_ / per_; const int rr_ = r_ % per_; K0 = (rr_ / nnb_) * 64; N0 = (rr_ % nnb_) * 64; \
        SRC = a->in[c_jobs[j_].in_idx] + (size_t)MAT * c_jobs[j_].src_stride + (size_t)K0 * c_jobs[j_].ldsrc + c_jobs[j_].col0 + N0 + lane; } while (0)
    float tv[64];
    int jn = 0, matn = 0, k0n = 0, n0n = 0; const float* srcn = nullptr;
    if (gw < total) { PRO_DECODE(gw, jn, matn, k0n, n0n, srcn); const int lds_ = c_jobs[jn].ldsrc;
#pragma unroll
        for (int i = 0; i < 64; ++i) tv[i] = srcn[(size_t)i * lds_]; }
    for (int it = gw; it < total; it += NGW) {
        const CvtJob J = c_jobs[jn]; const int mat = matn, k0 = k0n, n0 = n0n;
#pragma unroll
        for (int i = 0; i < 64; ++i) scr[i * 65 + lane] = tv[i];
        if (it + NGW < total) { PRO_DECODE(it + NGW, jn, matn, k0n, n0n, srcn); const int lds_ = c_jobs[jn].ldsrc;
#pragma unroll
            for (int i = 0; i < 64; ++i) tv[i] = srcn[(size_t)i * lds_]; }
        asm volatile("s_waitcnt lgkmcnt(0)" ::: "memory");
        if (J.fp8) {
            unsigned char* dst = (unsigned char*)(a->ws + J.dst_off) + (size_t)mat * J.dst_stride;
            const int c = lane & 3, nsub = lane >> 2; const float W8_S = (float)J.fp8;
#pragma unroll
            for (int jj = 0; jj < 4; ++jj) {
                const int n = nsub + 16 * jj; const LAS float* s = scr + (16 * c) * 65 + n;
                u32x4 o;
                o.x = pk4_fp8(s[0] * W8_S, s[65] * W8_S, s[2 * 65] * W8_S, s[3 * 65] * W8_S); o.y = pk4_fp8(s[4 * 65] * W8_S, s[5 * 65] * W8_S, s[6 * 65] * W8_S, s[7 * 65] * W8_S);
                o.z = pk4_fp8(s[8 * 65] * W8_S, s[9 * 65] * W8_S, s[10 * 65] * W8_S, s[11 * 65] * W8_S); o.w = pk4_fp8(s[12 * 65] * W8_S, s[13 * 65] * W8_S, s[14 * 65] * W8_S, s[15 * 65] * W8_S);
                const int drow = cvt_dstrow(J.perm, J.dstrow0 + n0 + n);
                *(u32x4*)(dst + (size_t)drow * J.K + k0 + 16 * c) = o;
            }
        } else {
            bf16_t* dst = (bf16_t*)(a->ws + J.dst_off) + (size_t)mat * J.dst_stride;
            const int c = lane & 7, nsub = lane >> 3;
#pragma unroll
            for (int jj = 0; jj < 8; ++jj) {
                const int n = nsub + 8 * jj; const LAS float* s = scr + (8 * c) * 65 + n;
                u32x4 o; o.x = pk2(s[0], s[65]); o.y = pk2(s[2 * 65], s[3 * 65]); o.z = pk2(s[4 * 65], s[5 * 65]); o.w = pk2(s[6 * 65], s[7 * 65]);
                const int drow = cvt_dstrow(J.perm, J.dstrow0 + n0 + n);
                *(u32x4*)(dst + (size_t)drow * J.K + k0 + 8 * c) = o;
            }
        }
        asm volatile("s_waitcnt lgkmcnt(0)" ::: "memory");
    }
#undef PRO_DECODE
    {
        const float* p = a->in[I_P]; bf16_t* pb = (bf16_t*)(a->ws + WS_PBF);
        const size_t n8 = (size_t)DEPTH * T * 256 / 8;
        for (size_t i = (size_t)blockIdx.x * 512 + tid; i < n8; i += (size_t)gridDim.x * 512) {
            const f32x4 v0 = *(const f32x4*)(p + i * 8), v1 = *(const f32x4*)(p + i * 8 + 4);
            *(u32x4*)(pb + i * 8) = pack8(v0, v1);
        }
    }
    if (blockIdx.x == 4 && tid < 512) { const int ev = tid >> 8, gi = (tid >> 6) & 3, d = tid & 63;
        const float* src = a->in[gi == 0 ? I_DAQN : gi == 1 ? I_DAKN : gi == 2 ? I_NSQN : I_NSKN];
        ((float*)(a->ws + WS_GAINS))[tid] = src[ev * 64 + d]; }
    if (blockIdx.x < 4 && tid < 256) {
        const int m = blockIdx.x; const float* pe = a->in[I_CMPPE] + (size_t)m * 2048; const float* w1 = a->in[I_CMPW1] + (size_t)m * 2048 * 256;
        float s = 0.f;
        for (int k = 0; k < 2048; ++k) s += pe[k] * w1[(size_t)k * 256 + tid];
        ((float*)(a->ws + WS_BIAS1))[m * 256 + tid] = s;
    }
}

DI float row_load_ss(const float* row, int lane, f32x4 (&v)[4]) {
    float ss = 0.f;
#pragma unroll
    for (int j = 0; j < 4; ++j) { v[j] = *(const f32x4*)(row + 4 * lane + 256 * j); ss += (v[j][0] * v[j][0] + v[j][1] * v[j][1]) + (v[j][2] * v[j][2] + v[j][3] * v[j][3]); }
    return wave_sum(ss);
}
DI void row_store_bf16(bf16_t* row, int lane, const f32x4 (&v)[4]) {
#pragma unroll
    for (int j = 0; j < 4; ++j) { u32x2 o; o.x = pk2(v[j][0], v[j][1]); o.y = pk2(v[j][2], v[j][3]); *(u32x2*)(row + 4 * lane + 256 * j) = o; }
}
template <int MODE>
DI void phase_norm(const int WID, ArgsP a, LAS unsigned char* lds, int layer, const float* Hin) {
    const int tid = opaque_tid(WID), lane = tid & 63, wv = __builtin_amdgcn_readfirstlane(tid >> 6);
    LAS float* wt = (LAS float*)lds;
    LAS int* bcl = (LAS int*)(lds + MISC_OFF + MO_WCNT); LAS int* ent = (LAS int*)(lds + MISC_OFF + MO_ENT); LAS float* gat = (LAS float*)(lds + MISC_OFF + MO_GAT);
    LAS float* lgb = (LAS float*)(lds + MISC_OFF + MO_RED);
    bf16_t* XN = (bf16_t*)(a->ws + WS_XN);
    const float* gain = a->in[MODE == 2 ? I_N2G : I_N1G] + layer * 1024;
    constexpr int NQ = MODE == 0 ? 24 : (MODE == 2 ? 32 : 0);
    if (NQ > 0) {
        const float* w = (MODE == 0) ? a->in[I_EVWIN] + (size_t)(layer >> 1) * 1024 * EVIN + 2816 : a->in[I_ROUTW] + (size_t)layer * 1024 * 32;
        const int ldw = (MODE == 0) ? EVIN : 32;
        for (int i = tid; i < 256 * 32; i += 512) { const int q = i & 31, g = i >> 5;
            if (q < NQ) { f32x4 v; v[0] = w[(size_t)(4 * g) * ldw + q]; v[1] = w[(size_t)(4 * g + 1) * ldw + q]; v[2] = w[(size_t)(4 * g + 2) * ldw + q]; v[3] = w[(size_t)(4 * g + 3) * ldw + q];
                *(LAS f32x4*)(wt + q * 1024 + 4 * (g ^ q)) = v; } }
    }
    f32x4 gn[4];
#pragma unroll
    for (int j = 0; j < 4; ++j) gn[j] = *(const f32x4*)(gain + 4 * lane + 256 * j);
    const float rbias = (MODE == 2) ? a->in[I_ROUTB][layer * 32 + (lane & 31)] : 0.f;
    __syncthreads();
    for (int vb = blockIdx.x; vb < NTB; vb += gridDim.x) {
        if (MODE == 2) { if (tid < 32) bcl[tid] = 0; }
        const int t0 = vb * 128 + wv * 16;
        f32x4 na[4], nb[4];
#pragma unroll
        for (int j = 0; j < 4; ++j) { na[j] = *(const f32x4*)(Hin + (size_t)t0 * 1024 + 4 * lane + 256 * j); nb[j] = *(const f32x4*)(Hin + (size_t)(t0 + 1) * 1024 + 4 * lane + 256 * j); }
#pragma unroll 1
        for (int it = 0; it < 8; ++it) {
            const int ta = t0 + 2 * it;
            f32x4 va[4], vc[4];
#pragma unroll
            for (int j = 0; j < 4; ++j) { va[j] = na[j]; vc[j] = nb[j]; }
            if (it < 7) {
#pragma unroll
                for (int j = 0; j < 4; ++j) { na[j] = *(const f32x4*)(Hin + (size_t)(ta + 2) * 1024 + 4 * lane + 256 * j); nb[j] = *(const f32x4*)(Hin + (size_t)(ta + 3) * 1024 + 4 * lane + 256 * j); }
            }
            float sa = 0.f, sb = 0.f;
#pragma unroll
            for (int j = 0; j < 4; ++j) { sa += (va[j][0] * va[j][0] + va[j][1] * va[j][1]) + (va[j][2] * va[j][2] + va[j][3] * va[j][3]); sb += (vc[j][0] * vc[j][0] + vc[j][1] * vc[j][1]) + (vc[j][2] * vc[j][2] + vc[j][3] * vc[j][3]); }
#pragma unroll
            for (int o = 1; o < 64; o <<= 1) { sa += shx(sa, o); sb += shx(sb, o); }
            const float ra = rsqrtf(sa * (1.0f / 1024.0f) + EPS), rb2 = rsqrtf(sb * (1.0f / 1024.0f) + EPS);
#pragma unroll
            for (int j = 0; j < 4; ++j) { va[j] = va[j] * ra * gn[j]; vc[j] = vc[j] * rb2 * gn[j]; }
            row_store_bf16(XN + (size_t)ta * 1024, lane, va); row_store_bf16(XN + (size_t)(ta + 1) * 1024, lane, vc);
            if (NQ > 0) {
                float x[64];
#pragma unroll
                for (int q = 0; q < 32; ++q) {
                    if (q < NQ) { float s0 = 0.f, s1 = 0.f;
#pragma unroll
                        for (int j = 0; j < 4; ++j) { const f32x4 ww = *(const LAS f32x4*)(wt + q * 1024 + 4 * ((lane + 64 * j) ^ q));
                            s0 += (va[j][0] * ww[0] + va[j][1] * ww[1]) + (va[j][2] * ww[2] + va[j][3] * ww[3]); s1 += (vc[j][0] * ww[0] + vc[j][1] * ww[1]) + (vc[j][2] * ww[2] + vc[j][3] * ww[3]); }
                        x[q] = s0; x[32 + q] = s1;
                        if ((q & 3) == 3) asm volatile("" ::: "memory");
                    } else { x[q] = 0.f; x[32 + q] = 0.f; }
                }
#define RS_STEP(N, BIT) _Pragma("unroll") for (int i = 0; i < (N); ++i) { const bool up = (lane & (BIT)) != 0; const float keep = up ? x[(N) + i] : x[i], send = up ? x[i] : x[(N) + i]; x[i] = keep + shx(send, (BIT)); }
                RS_STEP(32, 32) RS_STEP(16, 16) RS_STEP(8, 8) RS_STEP(4, 4) RS_STEP(2, 2) RS_STEP(1, 1)
#undef RS_STEP
                const float val = x[0];
                if (MODE == 0) { if ((lane & 31) < 24) ((float*)(a->ws + WS_GATES))[(size_t)(ta + (lane >> 5)) * 24 + (lane & 31)] = sigm(val); }
                if (MODE == 2) {
                    lgb[wv * 64 + lane] = val + rbias;
                    asm volatile("s_waitcnt lgkmcnt(0)" ::: "memory");
                    float lg[32];
#pragma unroll
                    for (int q4 = 0; q4 < 8; ++q4) { const f32x4 t4 = *(const LAS f32x4*)(lgb + wv * 64 + (lane & 32) + 4 * q4); lg[4 * q4] = t4[0]; lg[4 * q4 + 1] = t4[1]; lg[4 * q4 + 2] = t4[2]; lg[4 * q4 + 3] = t4[3]; }
                    unsigned used = 0u; int te[4]; float tv[4];
#pragma unroll
                    for (int k = 0; k < 4; ++k) { float best = -3.0e38f; int bi = 0;
#pragma unroll
                        for (int q = 0; q < 32; ++q) { const bool ok = !((used >> q) & 1u) && (lg[q] > best); best = ok ? lg[q] : best; bi = ok ? q : bi; }
                        used |= 1u << bi; te[k] = bi; tv[k] = best; }
                    float ex[4], sum = 0.f;
#pragma unroll
                    for (int k = 0; k < 4; ++k) { ex[k] = __expf(tv[k] - tv[0]); sum += ex[k]; }
                    const float rs = 1.0f / sum;
                    if ((lane & 31) == 0) {
                        const int eb = wv * 64 + (2 * it + (lane >> 5)) * 4;
#pragma unroll
                        for (int k = 0; k < 4; ++k) { ent[eb + k] = te[k]; gat[eb + k] = ex[k] * rs; }
                    }
                    asm volatile("s_waitcnt lgkmcnt(0)" ::: "memory");
                }
            }
        }
        if (MODE == 2) {
            __syncthreads();
            { const int e = ent[wv * 64 + lane];
              const int pos = __hip_atomic_fetch_add(bcl + e, 1, __ATOMIC_RELAXED, __HIP_MEMORY_SCOPE_WORKGROUP);
              const size_t idx = (size_t)(vb * 128 + wv * 16) * 4 + lane;
              ((int*)(a->ws + WS_TOPE))[idx] = e; ((int*)(a->ws + WS_POSB))[idx] = pos; ((float*)(a->ws + WS_GATEW))[idx] = gat[wv * 64 + lane]; }
            __syncthreads();
            if (tid < 32) ((int*)(a->ws + WS_BCNT))[((size_t)layer * NTB + vb) * 32 + tid] = bcl[tid];
            __syncthreads();
        }
    }
}
DI void moe_tables(const int WID, ArgsP a, LAS unsigned char* lds, int layer, int vb) {
    const int tid = opaque_tid(WID);
    LAS int* tot = (LAS int*)(lds + MISC_OFF + MO_TOT); LAS int* base = (LAS int*)(lds + MISC_OFF + MO_BASE); LAS int* ts = (LAS int*)(lds + MISC_OFF + MO_TS);
    LAS int* red = (LAS int*)(lds + MISC_OFF + MO_RED);
    const int* bc = (const int*)(a->ws + WS_BCNT) + (size_t)layer * NTB * 32;
    { const int e = tid & 31, part = tid >> 5; int st = 0, sp = 0;
      for (int blk = part; blk < NTB; blk += 16) { const int v = bc[blk * 32 + e]; st += v; sp += (blk < vb) ? v : 0; }
      red[part * 32 + e] = st; red[512 + part * 32 + e] = sp; }
    __syncthreads();
    if (tid < 32) { int st = 0, sp = 0;
#pragma unroll
        for (int p = 0; p < 16; ++p) { st += red[p * 32 + tid]; sp += red[512 + p * 32 + tid]; }
        tot[tid] = st; base[tid] = sp; }
    __syncthreads();
    if (tid == 0) { int acc = 0; for (int e = 0; e < 32; ++e) { ts[e] = acc; acc += (tot[e] + 255) >> 8; } ts[32] = acc; }
    __syncthreads();
}
DI void phase_moe_slots(const int WID, ArgsP a, LAS unsigned char* lds, int layer) {
    const int tid = opaque_tid(WID), lane = tid & 63, wv = tid >> 6;
    LAS int* base = (LAS int*)(lds + MISC_OFF + MO_BASE); LAS int* ts = (LAS int*)(lds + MISC_OFF + MO_TS);
    const bf16_t* XN = (const bf16_t*)(a->ws + WS_XN); unsigned char* XB = (unsigned char*)(a->ws + WS_XB);
    for (int vb = blockIdx.x; vb < NTB; vb += gridDim.x) {
        moe_tables(WID, a, lds, layer, vb);
#pragma unroll 1
        for (int i = 0; i < 16; ++i) {
            const int t = vb * 128 + wv * 16 + i;
            int dest = 0;
            if (lane < 4) { const int e = ((const int*)(a->ws + WS_TOPE))[(size_t)t * 4 + lane], pos = ((const int*)(a->ws + WS_POSB))[(size_t)t * 4 + lane];
                dest = ts[e] * 256 + base[e] + pos; ((int*)(a->ws + WS_DEST))[(size_t)t * 4 + lane] = dest; }
            const u32x4 r0 = *(const u32x4*)(XN + (size_t)t * 1024 + 8 * lane), r1 = *(const u32x4*)(XN + (size_t)t * 1024 + 512 + 8 * lane);
            u32x2 q0, q1;
            q0.x = pk4_fp8(bflo(r0.x), bfhi(r0.x), bflo(r0.y), bfhi(r0.y)); q0.y = pk4_fp8(bflo(r0.z), bfhi(r0.z), bflo(r0.w), bfhi(r0.w));
            q1.x = pk4_fp8(bflo(r1.x), bfhi(r1.x), bflo(r1.y), bfhi(r1.y)); q1.y = pk4_fp8(bflo(r1.z), bfhi(r1.z), bflo(r1.w), bfhi(r1.w));
#pragma unroll
            for (int k = 0; k < 4; ++k) { const int d = __builtin_amdgcn_readlane(dest, k); unsigned char* o = XB + (size_t)d * 1024; *(u32x2*)(o + 8 * lane) = q0; *(u32x2*)(o + 512 + 8 * lane) = q1; }
        }
        __syncthreads();
    }
}
DI void phase_combine(const int WID, ArgsP a, float* H) {
    const int tid = opaque_tid(WID), lane = tid & 63, wv = tid >> 6;
    const bf16_t* YB = (const bf16_t*)(a->ws + WS_YB); unsigned char* XN8 = (unsigned char*)(a->ws + WS_XN);
    for (int t = blockIdx.x * 8 + wv; t < T; t += gridDim.x * 8) {
        int dest = 0; float gw = 0.f;
        if (lane < 4) { dest = ((const int*)(a->ws + WS_DEST))[(size_t)t * 4 + lane]; gw = ((const float*)(a->ws + WS_GATEW))[(size_t)t * 4 + lane]; }
        f32x4 v[4];
#pragma unroll
        for (int j = 0; j < 4; ++j) v[j] = *(const f32x4*)(H + (size_t)t * 1024 + 4 * lane + 256 * j);
#pragma unroll
        for (int k = 0; k < 4; ++k) { const int d = __builtin_amdgcn_readlane(dest, k); const float g = __builtin_bit_cast(float, __builtin_amdgcn_readlane(__builtin_bit_cast(int, gw), k)); const bf16_t* y = YB + (size_t)d * 1024;
#pragma unroll
            for (int j = 0; j < 4; ++j) { const u32x2 w = *(const u32x2*)(y + 4 * lane + 256 * j); v[j][0] += g * bflo(w.x); v[j][1] += g * bfhi(w.x); v[j][2] += g * bflo(w.y); v[j][3] += g * bfhi(w.y); } }
        float ss = 0.f;
#pragma unroll
        for (int j = 0; j < 4; ++j) { *(f32x4*)(H + (size_t)t * 1024 + 4 * lane + 256 * j) = v[j]; ss += (v[j][0] * v[j][0] + v[j][1] * v[j][1]) + (v[j][2] * v[j][2] + v[j][3] * v[j][3]); }
        ss = wave_sum(ss);
        const float rstd = rsqrtf(ss * (1.0f / 1024.0f) + EPS);
#pragma unroll
        for (int j = 0; j < 4; ++j) v[j] = v[j] * rstd;
#pragma unroll
        for (int j = 0; j < 4; ++j) *(unsigned*)(XN8 + (size_t)t * 1024 + 4 * lane + 256 * j) = pk4_fp8(v[j][0], v[j][1], v[j][2], v[j][3]);
    }
}
DI void phase_cmp2(const int WID, ArgsP a, LAS unsigned char* lds, int ev) {
    const int tid = opaque_tid(WID), lane = tid & 63, wv = __builtin_amdgcn_readfirstlane(tid >> 6);
    const bf16_t* HID = (const bf16_t*)(a->ws + WS_HID); bf16_t* KCMP = (bf16_t*)(a->ws + WS_KCMP); bf16_t* VCMPT = (bf16_t*)(a->ws + WS_VCMPT);
    const float kg = a->in[I_NSKN][ev * 64 + lane];
    LAS float* wl = (LAS float*)lds;
    for (int i = tid; i < 2 * 256 * 64 / 4; i += 512) *(LAS f32x4*)(wl + 4 * i) = *(const f32x4*)(a->in[I_CMPW2] + (size_t)ev * 2 * 256 * 64 + 4 * i);
    __syncthreads();
    for (int gi = blockIdx.x * 8 + wv; gi < 2048; gi += gridDim.x * 8) {
        const int kv = gi >> 10, row0 = (gi & 1023) * 4;
        const bf16_t* hrow = HID + ((size_t)kv * 4096 + row0) * 256;
        const LAS float* w2 = wl + kv * 256 * 64 + lane;
        float s[4] = {0.f, 0.f, 0.f, 0.f};
#pragma unroll 2
        for (int k = 0; k < 256; k += 8) {
            u32x4 hw[4];
#pragma unroll
            for (int r = 0; r < 4; ++r) hw[r] = *(const u32x4*)(hrow + r * 256 + k);
            float wv8[8];
#pragma unroll
            for (int j = 0; j < 8; ++j) wv8[j] = w2[(k + j) * 64];
#pragma unroll
            for (int r = 0; r < 4; ++r)
                s[r] += bflo(hw[r].x) * wv8[0] + bfhi(hw[r].x) * wv8[1] + bflo(hw[r].y) * wv8[2] + bfhi(hw[r].y) * wv8[3] + bflo(hw[r].z) * wv8[4] + bfhi(hw[r].z) * wv8[5] + bflo(hw[r].w) * wv8[6] + bfhi(hw[r].w) * wv8[7];
        }
#pragma unroll
        for (int r = 0; r < 4; ++r) {
            const int row = row0 + r, bg = row >> 7, n = row & 127;
            float v = (n == 127) ? 0.f : s[r];
            if (kv == 0) { const float ss = wave_sum(v * v); const float o = v * rsqrtf(ss * (1.0f / 64.0f) + EPS) * kg;
                KCMP[((size_t)bg * 128 + n) * 64 + lane] = (bf16_t)(pk2(o, 0.f) & 0xffffu); }
            else VCMPT[((size_t)bg * 96 + lane) * 128 + n] = (bf16_t)(pk2(v, 0.f) & 0xffffu);
        }
    }
    for (int i = blockIdx.x * 512 + tid; i < 32 * 32 * 128; i += gridDim.x * 512) {
        const int n = i & 127, j = (i >> 7) & 31, bg = i >> 12;
        float o = 0.f;
        if (n < 127) { const int d = n - 4 * j; if (d >= 0 && d <= 2) o = 1.0f; else if (d == 3 || d == -1) o = 0.5f; }
        VCMPT[((size_t)bg * 96 + 64 + j) * 128 + n] = (bf16_t)(pk2(o, 0.f) & 0xffffu);
    }
}
DI void phase_topk(const int WID, ArgsP a) {
    const float* IMPH = (const float*)(a->ws + WS_IMPH); unsigned* SELM = (unsigned*)(a->ws + WS_SELM);
    for (int i = blockIdx.x * 512 + opaque_tid(WID); i < T * 2; i += gridDim.x * 512) {
        const int t = i >> 1, g = i & 1, b = t >> 11, s = t & 2047, cur = s >> 6;
        float sc[32];
#pragma unroll
        for (int j4 = 0; j4 < 8; ++j4) { f32x4 acc = {0.f, 0.f, 0.f, 0.f};
#pragma unroll
            for (int r = 0; r < 4; ++r) acc += *(const f32x4*)(IMPH + ((size_t)t * 8 + g * 4 + r) * 32 + 4 * j4);
#pragma unroll
            for (int q = 0; q < 4; ++q) sc[4 * j4 + q] = acc[q]; }
        unsigned mask;
        if (cur < 16) mask = (cur == 31) ? 0xffffffffu : ((2u << cur) - 1u);
        else {
#pragma unroll
            for (int j = 0; j < 32; ++j) { const bool forced = (j == 0) || (j == cur) || (j == cur - 1); sc[j] = (j > cur) ? NEGF : (sc[j] + (forced ? 1e4f : 0.f)); }
            mask = 0u;
#pragma unroll
            for (int j = 0; j < 32; ++j) { int rank = 0;
#pragma unroll
                for (int k = 0; k < 32; ++k) rank += ((sc[k] > sc[j]) || (sc[k] == sc[j] && k < j)) ? 1 : 0;
                mask |= (rank < 16) ? (1u << j) : 0u; }
        }
        SELM[((size_t)(b * 2 + g)) * 2048 + s] = mask;
    }
}
DI void phase_mixprep(const int WID, ArgsP a, int layer) {
    const int tid = opaque_tid(WID), lane = tid & 63, wv = tid >> 6, ev = layer >> 1;
    const float* dl = a->in[I_DALAM] + ev * 256;
    const float s1 = wave_sum(dl[lane] * dl[64 + lane]), s2 = wave_sum(dl[128 + lane] * dl[192 + lane]);
    const float lam_init = 0.8f - 0.6f * expf(-0.3f * (float)layer);
    const float lam = expf(s1) - expf(s2) + lam_init;
    const float* og = a->in[I_DAOUTG] + ev * 128;
    const bf16_t* OD = (const bf16_t*)(a->ws + WS_OD); const bf16_t* OC = (const bf16_t*)(a->ws + WS_OC); const bf16_t* OS = (const bf16_t*)(a->ws + WS_OS); const bf16_t* OW = (const bf16_t*)(a->ws + WS_OW);
    const float* GT = (const float*)(a->ws + WS_GATES); bf16_t* AMIX = (bf16_t*)(a->ws + WS_AMIX);
    const int h = lane >> 4, dv = (lane & 15) * 8;
    f32x4 g0 = *(const f32x4*)(og + dv), g1 = *(const f32x4*)(og + dv + 4);
    for (int t = blockIdx.x * 8 + wv; t < T; t += gridDim.x * 8) {
        { const u32x4 w1 = *(const u32x4*)(OD + (size_t)t * 1024 + h * 128 + dv), w2 = *(const u32x4*)(OD + (size_t)t * 1024 + (4 + h) * 128 + dv);
          f32x4 d0, d1;
          d0[0] = bflo(w1.x) - lam * bflo(w2.x); d0[1] = bfhi(w1.x) - lam * bfhi(w2.x); d0[2] = bflo(w1.y) - lam * bflo(w2.y); d0[3] = bfhi(w1.y) - lam * bfhi(w2.y);
          d1[0] = bflo(w1.z) - lam * bflo(w2.z); d1[1] = bfhi(w1.z) - lam * bfhi(w2.z); d1[2] = bflo(w1.w) - lam * bflo(w2.w); d1[3] = bfhi(w1.w) - lam * bfhi(w2.w);
          float ss = (d0[0] * d0[0] + d0[1] * d0[1]) + (d0[2] * d0[2] + d0[3] * d0[3]) + (d1[0] * d1[0] + d1[1] * d1[1]) + (d1[2] * d1[2] + d1[3] * d1[3]);
          ss += shx(ss, 1); ss += shx(ss, 2); ss += shx(ss, 4); ss += shx(ss, 8);
          const float rs = rsqrtf(ss * (1.0f / 128.0f) + EPS) * (1.0f - lam_init);
          *(u32x4*)(AMIX + (size_t)t * 1024 + h * 128 + dv) = pack8(d0 * rs * g0, d1 * rs * g1); }
        { const int hd = lane >> 3, dq = (lane & 7) * 8; const size_t o = (size_t)t * 512 + hd * 64 + dq;
          const float ga = GT[(size_t)t * 24 + hd * 3], gb = GT[(size_t)t * 24 + hd * 3 + 1], gc = GT[(size_t)t * 24 + hd * 3 + 2];
          const u32x4 c = *(const u32x4*)(OC + o), s = *(const u32x4*)(OS + o), w = *(const u32x4*)(OW + o);
          f32x4 r0, r1;
          r0[0] = ga * bflo(c.x) + gb * bflo(s.x) + gc * bflo(w.x); r0[1] = ga * bfhi(c.x) + gb * bfhi(s.x) + gc * bfhi(w.x);
          r0[2] = ga * bflo(c.y) + gb * bflo(s.y) + gc * bflo(w.y); r0[3] = ga * bfhi(c.y) + gb * bfhi(s.y) + gc * bfhi(w.y);
          r1[0] = ga * bflo(c.z) + gb * bflo(s.z) + gc * bflo(w.z); r1[1] = ga * bfhi(c.z) + gb * bfhi(s.z) + gc * bfhi(w.z);
          r1[2] = ga * bflo(c.w) + gb * bflo(s.w) + gc * bflo(w.w); r1[3] = ga * bfhi(c.w) + gb * bfhi(s.w) + gc * bfhi(w.w);
          *(u32x4*)(AMIX + (size_t)t * 1024 + 512 + hd * 64 + dq) = pack8(r0, r1); }
    }
}
DI void phase_scan(const int WID, ArgsP a) {
    const bf16_t* UT = (const bf16_t*)(a->ws + WS_UT); bf16_t* VS = (bf16_t*)(a->ws + WS_VS);
    for (int i = blockIdx.x * 512 + opaque_tid(WID); i < 64 * 512 * 32; i += gridDim.x * 512) {
        const int d8 = i & 31, f = (i >> 5) & 511, bh = i >> 14, h = bh & 3;
        const float dec = exp2f(256.0f * ret_lg2(h));
        f32x4 S0 = {0.f, 0.f, 0.f, 0.f}, S1 = S0;
        u32x4 un = *(const u32x4*)(UT + ((size_t)bh * 8) * 131072 + (size_t)f * 256 + 8 * d8);
#pragma unroll 1
        for (int n = 0; n < 8; ++n) {
            const size_t z = (size_t)bh * 8 + n;
            const u32x4 u = un;
            if (n < 7) un = *(const u32x4*)(UT + (z + 1) * 131072 + (size_t)f * 256 + 8 * d8);
            *(u32x4*)(VS + (z * 512 + f) * 512 + 256 + 8 * d8) = pack8(S0, S1);
            S0[0] = (S0[0] + bflo(u.x)) * dec; S0[1] = (S0[1] + bfhi(u.x)) * dec; S0[2] = (S0[2] + bflo(u.y)) * dec; S0[3] = (S0[3] + bfhi(u.y)) * dec;
            S1[0] = (S1[0] + bflo(u.z)) * dec; S1[1] = (S1[1] + bfhi(u.z)) * dec; S1[2] = (S1[2] + bflo(u.w)) * dec; S1[3] = (S1[3] + bfhi(u.w)) * dec;
        }
    }
}
DI void phase_normgate(const int WID, ArgsP a, int od) {
    const int tid = opaque_tid(WID), lane = tid & 63, wv = tid >> 6;
    const bf16_t* Y = (const bf16_t*)(a->ws + WS_Y); const bf16_t* GG = (const bf16_t*)(a->ws + WS_GG); bf16_t* YG = (bf16_t*)(a->ws + WS_YG);
    const float* og = a->in[I_RETG] + od * 512;
    const f32x4 g0 = *(const f32x4*)(og + 8 * lane), g1 = *(const f32x4*)(og + 8 * lane + 4);
    for (int t = blockIdx.x * 8 + wv; t < T; t += gridDim.x * 8) {
#pragma unroll
        for (int h = 0; h < 4; ++h) {
            const size_t o = (size_t)t * 2048 + h * 512 + 8 * lane;
            const u32x4 yw = *(const u32x4*)(Y + o), gw = *(const u32x4*)(GG + o);
            f32x4 y0 = {bflo(yw.x), bfhi(yw.x), bflo(yw.y), bfhi(yw.y)}, y1 = {bflo(yw.z), bfhi(yw.z), bflo(yw.w), bfhi(yw.w)};
            const f32x4 q0 = {bflo(gw.x), bfhi(gw.x), bflo(gw.y), bfhi(gw.y)}, q1 = {bflo(gw.z), bfhi(gw.z), bflo(gw.w), bfhi(gw.w)};
            float ss = (y0[0] * y0[0] + y0[1] * y0[1]) + (y0[2] * y0[2] + y0[3] * y0[3]) + (y1[0] * y1[0] + y1[1] * y1[1]) + (y1[2] * y1[2] + y1[3] * y1[3]);
            ss = wave_sum(ss);
            const float rs = rsqrtf(ss * (1.0f / 512.0f) + EPS);
            *(u32x4*)(YG + o) = pack8(y0 * rs * g0 * q0, y1 * rs * g1 * q1);
        }
    }
}
DI int snake_unit(int rnd, int G, int c) { return (rnd & 1) ? rnd * G + (G - 1 - c) : rnd * G + c; }
DI float absmax64(const float* g, int lane) { float m = fabsf(g[lane]);
#pragma unroll
    for (int o = 1; o < 64; o <<= 1) m = fmaxf(m, shx(m, o));
    return m; }
constexpr int CW_AQ = 8192;
template <int MODE>
DI void phase_attn(const int WID, ArgsP a, LAS unsigned char* lds, int ev) {
    const int tid = opaque_tid(WID), lane = tid & 63;
    const bf16_t* QD = (const bf16_t*)(a->ws + WS_QD); const bf16_t* KD = (const bf16_t*)(a->ws + WS_KD); const bf16_t* QN = (const bf16_t*)(a->ws + WS_QN);
    LAS int* ord = (LAS int*)(lds + MISC_OFF + MO_ENT); LAS int* cst = (LAS int*)(lds + MISC_OFF + MO_GAT); volatile LAS int* cur = (volatile LAS int*)(lds + MISC_OFF + MO_TOT);
    float sb2 = 0.f;
    if (MODE != 3) { const float gq = absmax64(a->in[MODE == 0 ? I_DAQN : I_NSQN] + ev * 64, lane), gk = absmax64(a->in[MODE == 0 ? I_DAKN : I_NSKN] + ev * 64, lane);
        sb2 = 16.0f * gq * gk + 28.0f; }
    if (tid < 64) { const int qb = tid >> 3, hd = tid & 7, q0 = qb * 256; int lo = 0, hi = 4 * qb + 4;
        if (MODE == 3) { lo = 0; hi = 2; }
        else { const float slope = (MODE == 0) ? exp2f(-2.0f * (float)((hd & 3) + 1)) : exp2f(-(float)(hd + 1)); const int dcut = (int)fminf(sb2 / slope + 1.0f, 100000.0f);
            const int kmin = q0 - dcut; lo = kmin > 0 ? (kmin >> 6) : 0;
            if (MODE == 2) { const int lk = q0 - 511; const int lw = lk > 0 ? (lk >> 6) : 0; lo = lw > lo ? lw : lo; } }
        cst[tid] = hi - lo; }
    __syncthreads();
    if (tid < 64) { const int mine = cst[tid]; int rank = 0;
        for (int j = 0; j < 64; ++j) { const int o = cst[j]; rank += (o > mine || (o == mine && j < tid)) ? 1 : 0; }
        ord[rank] = tid; }
    __syncthreads();
    unsigned* ctr = (unsigned*)(a->ws + WS_CTL) + CW_AQ + 64 * (ev * 4 + MODE);
    for (;;) {
        if (tid == 0) *cur = (int)__hip_atomic_fetch_add(ctr, 1u, __ATOMIC_RELAXED, __HIP_MEMORY_SCOPE_AGENT);
        __syncthreads();
        const int u = *cur; if (u >= 1024) break;
        const int combo = ord[u >> 4], b = u & 15, qb = combo >> 3, hd = combo & 7, q0 = qb * 256; const size_t t0 = (size_t)b * 2048 + q0;
        if (MODE == 0) {
            const float slope = exp2f(-2.0f * (float)((hd & 3) + 1)); const int dcut = (int)fminf(sb2 / slope + 1.0f, 100000.0f);
            attn_unit<128, 0>(WID, lds, QD + t0 * 512 + hd * 64, 512, KD + (size_t)b * 2048 * 512 + hd * 64, 512,
                              (const bf16_t*)(a->ws + WS_VAT) + (size_t)(b * 4 + (hd & 3)) * 128 * 2048, 2048, q0, slope, dcut, nullptr,
                              (bf16_t*)(a->ws + WS_OD) + t0 * 1024 + hd * 128, 1024, nullptr);
        } else if (MODE == 1 || MODE == 2) {
            const int g = hd >> 2; const float slope = exp2f(-(float)(hd + 1)); const int dcut = (int)fminf(sb2 / slope + 1.0f, 100000.0f);
            const bf16_t* Kb = (const bf16_t*)(a->ws + (MODE == 1 ? WS_KSB : WS_KWB)) + (size_t)(b * 2 + g) * 2048 * 64;
            const bf16_t* Vb = (const bf16_t*)(a->ws + (MODE == 1 ? WS_VST : WS_VWT)) + (size_t)(b * 2 + g) * 64 * 2048;
            attn_unit<64, MODE>(WID, lds, QN + t0 * 512 + hd * 64, 512, Kb, 64, Vb, 2048, q0, slope, dcut,
                                (const unsigned*)(a->ws + WS_SELM) + (size_t)(b * 2 + g) * 2048 + q0,
                                (bf16_t*)(a->ws + (MODE == 1 ? WS_OS : WS_OW)) + t0 * 512 + hd * 64, 512, nullptr);
        } else {
            const int g = hd >> 2;
            attn_unit<96, 3>(WID, lds, QN + t0 * 512 + hd * 64, 512, (const bf16_t*)(a->ws + WS_KCMP) + (size_t)(b * 2 + g) * 128 * 64, 64,
                             (const bf16_t*)(a->ws + WS_VCMPT) + (size_t)(b * 2 + g) * 96 * 128, 128, q0, 0.f, 0, nullptr,
                             (bf16_t*)(a->ws + WS_OC) + t0 * 512 + hd * 64, 512, (float*)(a->ws + WS_IMPH) + (t0 * 8 + hd) * 32);
        }
    }
}

constexpr int PPL = 15;
constexpr int NPHASE = 1 + DEPTH * PPL;
__global__ void __launch_bounds__(512, 2) mk_fwd(Args a_unused) {
    ArgsP a = opaque_args();
    extern __shared__ __attribute__((aligned(16))) unsigned char lds_raw[];
    LAS unsigned char* lds = (LAS unsigned char*)lds_raw;
    const int tid = threadIdx.x, G = gridDim.x, c = blockIdx.x;
    const int WID = __builtin_amdgcn_readfirstlane(tid >> 6);
    volatile LAS unsigned* misc = (volatile LAS unsigned*)(lds + MISC_OFF);
    if (tid < 4) misc[tid] = 0u;
    __syncthreads();
    unsigned* ctl = (unsigned*)(a->ws + WS_CTL);
    XcdBarrier bar; bar.bar = ctl + CW_BAR; bar.x = 0; bar.st = misc;
    const int ph_lo = a->ph_lo, ph_hi = a->ph_hi;
    const bool multi = (ph_hi - ph_lo) > 1;
    if (multi) bar = xcd_barrier_post(WID, ctl + CW_BAR, misc);
    bool first = true;
#define PHASE_BEGIN(k, id) if ((DBG_ONLY < 0 || DBG_ONLY == (id)) && (k) >= ph_lo && (k) < ph_hi && (k) <= DBG_LAST_PHASE) { if (!first) { xcd_barrier(WID, bar); if (PROBE_MASK >> 31) xcd_barrier(WID, bar); } first = false; \
        ArgsP a = opaque_args(); unsigned char* ws = a->ws; bf16_t* XN = (bf16_t*)(ws + WS_XN); float* H = a->out; const float* Hin = (layer == 0) ? a->in[I_X] : (const float*)H; \
        const LAS int* ts = (const LAS int*)(lds + MISC_OFF + MO_TS); (void)XN; (void)H; (void)Hin; (void)ts; \
        const bool probe_ = ((PROBE_MASK >> (id)) & 1u) != 0u; const unsigned long long pt0_ = probe_ ? __builtin_amdgcn_s_memrealtime() : 0ull;
#define PHASE_END if (probe_) { const unsigned long long pt1_ = __builtin_amdgcn_s_memrealtime(), pd_ = pt1_ - pt0_; while (__builtin_amdgcn_s_memrealtime() - pt1_ < pd_) __builtin_amdgcn_s_sleep(8); } }
    { const int layer = 0; PHASE_BEGIN(0, 0) phase_prologue(WID, a, lds); PHASE_END }
#pragma unroll 1
    for (int layer = 0; layer < DEPTH; ++layer) {
        const int pb = 1 + layer * PPL; const bool even = (layer & 1) == 0; const int ev = layer >> 1, od = layer >> 1;
        if (even) {
            PHASE_BEGIN(pb + 0, 1) phase_norm<0>(WID, a, lds, layer, Hin); PHASE_END
            PHASE_BEGIN(pb + 1, 2) {
                { ProbPlain P{XN, (const bf16_t*)(ws + WS_EVNAT) + (size_t)ev * 2048 * 1024, 1024, 1024, 1024}; pg8::Sched S; S.init(T / 256, 8, G, c);
                  EpiEvNat E{ws, (const float*)(ws + WS_GAINS) + ev * 256};
                  pg8::gemm_phase(WID, lds, P, S, E); }
                { ProbPlain P{(const bf16_t*)(ws + WS_EVSW) + (size_t)ev * 768 * 1024, XN, 1024, 1024, 1024}; pg8::Sched S; S.init(3, T / 256, G, c);
                  EpiEvSw E{ws};
                  pg8::gemm_phase(WID, lds, P, S, E); }
            } PHASE_END
            PHASE_BEGIN(pb + 2, 3) {
                { ProbCmp1 P{(const bf16_t*)(ws + WS_KCB), (const bf16_t*)(ws + WS_VCB), (const bf16_t*)(ws + WS_CMP1) + (size_t)ev * 2 * 256 * 2048, 1024, 2048, 2048}; pg8::Sched S; S.init(32, 1, G, c);
                  EpiCmp1 E{(bf16_t*)(ws + WS_HID), (const float*)(ws + WS_BIAS1) + ev * 512};
                  pg8::gemm_phase(WID, lds, P, S, E); }
                phase_attn<0>(WID, a, lds, ev);
                phase_attn<2>(WID, a, lds, ev);
            } PHASE_END
            PHASE_BEGIN(pb + 3, 4) phase_cmp2(WID, a, lds, ev); PHASE_END
            PHASE_BEGIN(pb + 4, 5) phase_attn<3>(WID, a, lds, ev); PHASE_END
            PHASE_BEGIN(pb + 5, 6) phase_topk(WID, a); PHASE_END
            PHASE_BEGIN(pb + 6, 7) phase_attn<1>(WID, a, lds, ev); PHASE_END
            PHASE_BEGIN(pb + 7, 8) phase_mixprep(WID, a, layer); PHASE_END
            PHASE_BEGIN(pb + 8, 9) {
                ProbPlain P{(const bf16_t*)(ws + WS_AMIX), (const bf16_t*)(ws + WS_EVOUT) + (size_t)ev * 1024 * 1024, 1024, 1024, 1024}; pg8::Sched S; S.init(T / 256, 4, G, c);
                EpiResid E{Hin, H}; pg8::gemm_phase(WID, lds, P, S, E);
            } PHASE_END
        } else {
            PHASE_BEGIN(pb + 0, 11) phase_norm<1>(WID, a, lds, layer, Hin); PHASE_END
            PHASE_BEGIN(pb + 1, 12) {
                { ProbPlain P{XN, (const bf16_t*)(ws + WS_ODNAT) + (size_t)od * 4096 * 1024, 1024, 1024, 1024}; pg8::Sched S; S.init(T / 256, 16, G, c);
                  EpiOdNat E{ws}; pg8::gemm_phase(WID, lds, P, S, E); }
                { ProbPlain P{(const bf16_t*)(ws + WS_ODSW) + (size_t)od * 3072 * 1024, XN, 1024, 1024, 1024}; pg8::Sched S; S.init(12, T / 256, G, c);
                  EpiOdSw E{ws}; pg8::gemm_phase(WID, lds, P, S, E); }
            } PHASE_END
            PHASE_BEGIN(pb + 2, 13) {
                { ProbUT P{(const bf16_t*)(ws + WS_VS), (const bf16_t*)(ws + WS_KT), 512, 256, 256}; SchedSeq S; S.init(G, c);
                  EpiUTScan E{(bf16_t*)(ws + WS_VS)}; pg8::gemm_phase(WID, lds, P, S, E); }
                { ProbAtt P{(const bf16_t*)(ws + WS_AQ), (const bf16_t*)(ws + WS_KP), 2048, 1024, 256}; pg8::Sched S; const int nb = G / 2 > 0 ? G / 2 : 1;
                  if (c >= nb || G < 2) S.init(512, 1, G < 2 ? 1 : G - nb, G < 2 ? 0 : c - nb); else S.init(0, 1, 1, 0);
                  EpiAtt E{(bf16_t*)(ws + WS_AQ)}; pg8::gemm_phase(WID, lds, P, S, E); }
            } PHASE_END
            PHASE_BEGIN(pb + 4, 15) {
                ProbY P{(const bf16_t*)(ws + WS_AQ), (const bf16_t*)(ws + WS_VS), 2048, 512, 512}; pg8::Sched S; S.init(512, 2, G, c);
                EpiY E{(bf16_t*)(ws + WS_Y)}; pg8::gemm_phase(WID, lds, P, S, E);
            } PHASE_END
            PHASE_BEGIN(pb + 5, 16) phase_normgate(WID, a, od); PHASE_END
            PHASE_BEGIN(pb + 8, 19) {
                ProbPlain P{(const bf16_t*)(ws + WS_YG), (const bf16_t*)(ws + WS_ODOUT) + (size_t)od * 1024 * 2048, 2048, 2048, 2048}; pg8::Sched S; S.init(T / 256, 4, G, c);
                EpiResid E{Hin, H}; pg8::gemm_phase(WID, lds, P, S, E);
            } PHASE_END
        }
        PHASE_BEGIN(pb + 9, 20) phase_norm<2>(WID, a, lds, layer, H); PHASE_END
        PHASE_BEGIN(pb + 10, 21) phase_moe_slots(WID, a, lds, layer); PHASE_END
        PHASE_BEGIN(pb + 11, 22) {
            moe_tables(WID, a, lds, layer, -1);
            { ProbMoe8 P{(const unsigned char*)(ws + WS_XB), (const unsigned char*)(ws + WS_WGU) + (size_t)layer * 32 * 2048 * 1024, ts, 2048, 512, 512, 512}; pg8::Sched S; S.init(ts[32], 8, G, c);
              EpiGU E{(unsigned char*)(ws + WS_ACT), a->in[I_BGU] + (size_t)layer * 32 * 2048, ts}; pg8::gemm_phase(WID, lds, P, S, E); }
            { ProbPlain P{(const bf16_t*)(ws + WS_PBF) + (size_t)layer * T * 256, (const bf16_t*)(ws + WS_WPP) + (size_t)layer * 1024 * 256, 256, 256, 256}; pg8::Sched S; S.init(T / 256, 4, G, c);
              EpiPP E{(bf16_t*)(ws + WS_PP)}; pg8::gemm_phase(WID, lds, P, S, E); }
        } PHASE_END
        PHASE_BEGIN(pb + 12, 23) {
            moe_tables(WID, a, lds, layer, -1);
            ProbMoe8 P{(const unsigned char*)(ws + WS_ACT), (const unsigned char*)(ws + WS_WDN) + (size_t)layer * 32 * 1024 * 1024, ts, 1024, 512, 512, 512}; pg8::Sched S; S.init(ts[32], 4, G, c);
            EpiDN E{(bf16_t*)(ws + WS_YB), a->in[I_BDN] + (size_t)layer * 32 * 1024, ts}; pg8::gemm_phase(WID, lds, P, S, E);
        } PHASE_END
        PHASE_BEGIN(pb + 13, 24) phase_combine(WID, a, H); PHASE_END
        PHASE_BEGIN(pb + 14, 25) {
            ProbPlain8 P{(const unsigned char*)(ws + WS_XN), (const unsigned char*)(ws + WS_WPG) + (size_t)layer * 1024 * 1024, 512, 512, 512}; pg8::Sched S; S.init(T / 256, 4, G, c);
            EpiPLE E{H, (const bf16_t*)(ws + WS_PP)}; pg8::gemm_phase(WID, lds, P, S, E);
        } PHASE_END
    }
#undef PHASE_BEGIN
#undef PHASE_END
}

extern "C" void kernel_launch(void* const* d_in, const int* in_sizes, int n_in, void* d_out, int out_size, void* d_ws, size_t ws_size, hipStream_t stream) {
    static int grid = 0;
    if (grid == 0) {
        if (n_in != 26 || out_size != T * D || ws_size < WS_END) { fprintf(stderr, "kernel_launch: unexpected problem (n_in %d, out %d, ws %zu < %zu); nothing launched\n", n_in, out_size, ws_size, (size_t)WS_END); grid = -1; return; }
        int dev = 0, cus = 0, per_cu = 0;
        if (hipGetDevice(&dev) != hipSuccess || hipDeviceGetAttribute(&cus, hipDeviceAttributeMultiprocessorCount, dev) != hipSuccess) { grid = -1; return; }
        if (hipFuncSetAttribute((const void*)mk_fwd, hipFuncAttributeMaxDynamicSharedMemorySize, LDS_BYTES) != hipSuccess) { fprintf(stderr, "kernel_launch: hipFuncSetAttribute failed\n"); grid = -1; return; }
        if (hipOccupancyMaxActiveBlocksPerMultiprocessor(&per_cu, (const void*)mk_fwd, 512, LDS_BYTES) != hipSuccess || per_cu < 1) fprintf(stderr, "kernel_launch: occupancy query reports %d\n", per_cu);
        (void)hipGetLastError();
        grid = cus > 256 ? 256 : cus;
    }
    if (grid < 0) return;
    (void)hipMemsetAsync((char*)d_ws + WS_CTL, 0, CTL_BYTES, stream);
    Args a; memset(&a, 0, sizeof(a));
    for (int i = 0; i < 26; ++i) a.in[i] = (const float*)d_in[i];
    a.out = (float*)d_out; a.ws = (unsigned char*)d_ws;
#if MK_SINGLE
    a.ph_lo = 0; a.ph_hi = NPHASE;
    hipLaunchKernelGGL(mk_fwd, dim3(grid), dim3(512), LDS_BYTES, stream, a);
#else
    for (int ph = 0; ph < NPHASE && ph <= DBG_LAST_PHASE; ++ph) {
        const int l = (ph - 1) / PPL, k = (ph - 1) % PPL;
        if (ph > 0 && (l & 1) && (k == 6 || k == 7)) continue;
        a.ph_lo = ph; a.ph_hi = ph + 1;
        hipLaunchKernelGGL(mk_fwd, dim3(grid), dim3(512), LDS_BYTES, stream, a);
    }
#endif
}
```

```cpp
#include <hip/hip_runtime.h>
#include <cstdio>
#include <cstdint>
#include <cstring>

#define LAS __attribute__((address_space(3)))
#define DI __device__ __forceinline__
typedef unsigned short bf16_t;
typedef short bf16x8 __attribute__((ext_vector_type(8)));
typedef short s16x4 __attribute__((ext_vector_type(4)));
typedef float f32x2 __attribute__((ext_vector_type(2)));
typedef float f32x4 __attribute__((ext_vector_type(4)));
typedef float f32x16 __attribute__((ext_vector_type(16)));
typedef unsigned u32x2 __attribute__((ext_vector_type(2)));
typedef unsigned u32x4 __attribute__((ext_vector_type(4)));
typedef __bf16 bfv2 __attribute__((ext_vector_type(2)));
typedef int i32x4 __attribute__((ext_vector_type(4)));
typedef int i32x8 __attribute__((ext_vector_type(8)));

#ifndef MK_SINGLE
#define MK_SINGLE 1
#endif
#ifndef DBG_ONLY
#define DBG_ONLY -1
#endif
#ifndef PROBE_MASK
#define PROBE_MASK 0u
#endif
#ifndef PROBE_KREP
#define PROBE_KREP 1
#endif
#ifndef DBG_LAST_PHASE
#define DBG_LAST_PHASE 100000
#endif

constexpr int T = 32768, D = 1024, SEQ = 2048, NBATCH = 16, DEPTH = 4;
constexpr int EVIN = 2840, ODIN = 6144;
constexpr float EPS = 1e-6f, NEGF = -1e30f;
constexpr int NTB = 256;
constexpr int MOE_ROWS = (512 + 32) * 256;

constexpr size_t MiB = 1u << 20;
constexpr size_t WS_CTL = 0, CTL_BYTES = 1 * MiB;
constexpr int CW_BAR = 4096;
constexpr size_t WS_EVNAT = 2 * MiB, WS_EVSW = 10 * MiB, WS_EVOUT = 13 * MiB, WS_CMP1 = 17 * MiB, WS_ODNAT = 21 * MiB, WS_ODSW = 37 * MiB,
                 WS_ODOUT = 49 * MiB, WS_WPP = 57 * MiB, WS_WPG = 59 * MiB, WS_BIAS1 = 67 * MiB, WS_GAINS = 67 * MiB + 16384, WS_BCNT = 67 * MiB + 65536,
                 WS_WGU = 68 * MiB, WS_WDN = 580 * MiB;
constexpr size_t WS_XN = 840 * MiB, WS_PBF = 904 * MiB, WS_PP = 968 * MiB, WS_GATES = 1032 * MiB, WS_TOPE = 1035 * MiB, WS_POSB = 1036 * MiB,
                 WS_DEST = 1037 * MiB, WS_GATEW = 1038 * MiB, WS_SELM = 1039 * MiB;
constexpr size_t RA = 1040 * MiB;
constexpr size_t WS_QD = RA, WS_KD = RA + 32 * MiB, WS_QN = RA + 64 * MiB, WS_KCB = RA + 96 * MiB, WS_VCB = RA + 105 * MiB, WS_KSB = RA + 114 * MiB,
                 WS_KWB = RA + 122 * MiB, WS_VAT = RA + 130 * MiB, WS_VST = RA + 162 * MiB, WS_VWT = RA + 170 * MiB, WS_HID = RA + 178 * MiB,
                 WS_KCMP = RA + 182 * MiB, WS_VCMPT = RA + 183 * MiB, WS_OC = RA + 184 * MiB, WS_IMPH = RA + 216 * MiB, WS_OD = RA + 248 * MiB,
                 WS_OS = RA + 312 * MiB, WS_OW = RA + 344 * MiB, WS_AMIX = RA + 376 * MiB;
constexpr size_t WS_AQ = RA, WS_KP = RA + 128 * MiB, WS_KT = RA + 192 * MiB, WS_VS = RA + 256 * MiB, WS_GG = RA + 512 * MiB, WS_UT = RA + 640 * MiB,
                 WS_Y = RA + 896 * MiB, WS_YG = RA + 1024 * MiB;
constexpr size_t WS_XB = 2192 * MiB, WS_ACT = 2464 * MiB, WS_YB = 2736 * MiB, WS_END = 3008 * MiB;

constexpr int MISC_OFF = 139264, LDS_BYTES = 155648;
static_assert(MISC_OFF + 5888 + 4096 <= LDS_BYTES, "misc LDS words");
constexpr int MO_WCNT = 256, MO_ENT = 1280, MO_GAT = 3328, MO_TOT = 5376, MO_BASE = 5504, MO_TS = 5632, MO_RED = 5888;

DI int opaque_tid(int wid0) { int l; asm volatile("v_mbcnt_lo_u32_b32 %0, -1, 0\n\tv_mbcnt_hi_u32_b32 %0, -1, %0" : "=v"(l) :: "memory"); return (wid0 << 6) | l; }
DI int lane_now() { int l; asm volatile("v_mbcnt_lo_u32_b32 %0, -1, 0\n\tv_mbcnt_hi_u32_b32 %0, -1, %0" : "=v"(l)); return l; }
DI float shx(float v, int m) { return __builtin_bit_cast(float, __builtin_amdgcn_ds_bpermute((lane_now() ^ m) << 2, __builtin_bit_cast(int, v))); }
DI unsigned shxu(unsigned v, int m) { return (unsigned)__builtin_amdgcn_ds_bpermute((lane_now() ^ m) << 2, (int)v); }
DI unsigned pk2(float lo, float hi) { f32x2 v = {lo, hi}; return __builtin_bit_cast(unsigned, __builtin_convertvector(v, bfv2)); }
DI unsigned pk4_fp8(float a, float b, float c, float d) { int w = 0; w = __builtin_amdgcn_cvt_pk_fp8_f32(a, b, w, false); w = __builtin_amdgcn_cvt_pk_fp8_f32(c, d, w, true); return (unsigned)w; }
DI float bf2f(unsigned short b) { return __uint_as_float(((unsigned)b) << 16); }
DI float bflo(unsigned w) { return __uint_as_float(w << 16); }
DI float bfhi(unsigned w) { return __uint_as_float(w & 0xffff0000u); }
DI float wave_sum(float v) {
#pragma unroll
    for (int o = 1; o < 64; o <<= 1) v += shx(v, o);
    return v;
}
DI float sigm(float x) { return __builtin_amdgcn_rcpf(1.0f + __builtin_amdgcn_exp2f(-1.44269504089f * x)); }
DI u32x4 pack8(const f32x4& a, const f32x4& b) { u32x4 w; w.x = pk2(a[0], a[1]); w.y = pk2(a[2], a[3]); w.z = pk2(b[0], b[1]); w.w = pk2(b[2], b[3]); return w; }

#define XB_TMO      128
#define XB_XCNT(j)  (256  + 64 * (j))
#define XB_XSUB(j)  (1280 + 64 * (j))
#define XB_XGEN(j)  (2304 + 64 * (j))
#define XB_TOP      3328
#define XB_TOPGEN   3392
#define XCD_BAR_WORDS 3456
#define XB_SPIN_CAP (1u << 22)
DI unsigned xb_ld(unsigned* p)              { return __hip_atomic_load(p, __ATOMIC_RELAXED, __HIP_MEMORY_SCOPE_AGENT); }
DI unsigned xb_add(unsigned* p, unsigned v) { return __hip_atomic_fetch_add(p, v, __ATOMIC_RELAXED, __HIP_MEMORY_SCOPE_AGENT); }
DI unsigned xb_xcc_id() { return (unsigned)__builtin_amdgcn_s_getreg((3 << 11) | 20) & 0xFu; }
#define XB_SPIN(cond, bar) do { unsigned _sp = 0; while (cond) { __builtin_amdgcn_s_sleep(1); \
    if ((++_sp & 255u) == 0u) { if (xb_ld(&(bar)[XB_TMO])) break; if (_sp > XB_SPIN_CAP) { atomicAdd(&(bar)[XB_TMO], 1u); break; } } } } while (0)
struct XcdBarrier { unsigned* bar; unsigned x; volatile LAS unsigned* st; };
DI XcdBarrier xcd_barrier_post(const int WID, unsigned* bar, volatile LAS unsigned* st) {
    XcdBarrier b; b.bar = bar; b.x = xb_xcc_id(); b.st = st;
    if (opaque_tid(WID) == 0) (void)xb_add(&bar[XB_XCNT(b.x)], 1u);
    return b;
}
DI void xcd_barrier_complete(unsigned* bar, unsigned x, unsigned& nloc, unsigned& nx) {
    const unsigned G = gridDim.x * gridDim.y * gridDim.z;
    unsigned sum, cnt, mine, sp = 0u;
    for (;;) {
        sum = 0u; cnt = 0u; mine = 0u;
#pragma unroll
        for (unsigned j = 0; j < 16; ++j) { const unsigned c = xb_ld(&bar[XB_XCNT(j)]); sum += c; cnt += (c > 0u) ? 1u : 0u; mine = (j == x) ? c : mine; }
        if (sum == G) break;
        __builtin_amdgcn_s_sleep(1);
        if ((++sp & 255u) == 0u) { if (xb_ld(&bar[XB_TMO])) break; if (sp > XB_SPIN_CAP) { atomicAdd(&bar[XB_TMO], 1u); break; } }
    }
    nloc = mine > 0u ? mine : 1u; nx = cnt > 0u ? cnt : 1u;
}
DI void xcd_barrier(const int WID, const XcdBarrier& b) {
    asm volatile("s_waitcnt vmcnt(0)" ::: "memory");
    __syncthreads();
    if (opaque_tid(WID) == 0) {
        unsigned* bar = b.bar; asm volatile("" : "+s"(bar));
        __builtin_amdgcn_s_waitcnt(0);
        unsigned nloc = b.st[0], nx = b.st[1];
        if (nloc == 0u) { xcd_barrier_complete(bar, b.x, nloc, nx); b.st[0] = nloc; b.st[1] = nx; }
        const unsigned old = xb_add(&bar[XB_XSUB(b.x)], 1u);
        const unsigned gen = old / nloc;
        if (old + 1u == (gen + 1u) * nloc) {
            __builtin_amdgcn_fence(__ATOMIC_RELEASE, "agent");
            asm volatile("s_waitcnt vmcnt(0)" ::: "memory");
            const unsigned og = xb_add(&bar[XB_TOP], 1u);
            const unsigned tg = og / nx;
            if (og + 1u == (tg + 1u) * nx) xb_add(&bar[XB_TOPGEN], 1u);
            else XB_SPIN(xb_ld(&bar[XB_TOPGEN]) == tg, bar);
            __builtin_amdgcn_fence(__ATOMIC_ACQUIRE, "agent");
            xb_add(&bar[XB_XGEN(b.x)], 1u);
            asm volatile("s_waitcnt vmcnt(0)" ::: "memory");
        } else {
            XB_SPIN(xb_ld(&bar[XB_XGEN(b.x)]) == gen, bar);
            __builtin_amdgcn_fence(__ATOMIC_ACQUIRE, "agent");
            asm volatile("s_waitcnt vmcnt(0)" ::: "memory");
        }
    }
    __syncthreads();
}

namespace pg8 {
constexpr int BM = 256, BK = 64, HALF = 128, HTB = HALF * BK * 2, STAGE_BYTES = 8 * HTB, NXCD = 8, WGM = 8;
DI int lds_byte(int r, int c) { const int st = (r >> 4) * 2 + (c >> 5), rr = r & 15, cc = c & 31, ob = rr * 64 + cc * 2; return st * 1024 + (ob ^ (((ob >> 9) & 1) << 5)); }
DI void stage_rc(int b, int& R, int& C) { const int st = b / 1024, sb = b % 1024, swz = sb ^ (((sb >> 9) & 1) << 5); R = (st >> 1) * 16 + swz / 64; C = (st & 1) * 32 + (swz % 64) / 2; }
DI int perm32(int rho) { const int n = rho >> 4, i = rho & 15; return 8 * (i >> 2) + 4 * n + (i & 3); }
struct Unit { int pm, pn; };
struct Sched {
    int nM, nN, nwg, G, c;
    DI void init(int nM_, int nN_, int G_, int c_) { nM = nM_; nN = nN_; nwg = nM * nN; G = G_; c = c_; }
    DI bool next(int i, Unit& u) const {
        const long L = (long)i * G + c; if (L >= nwg) return false;
        int wgid = (int)L; { const int q = nwg / NXCD, r = nwg % NXCD, xcd = wgid % NXCD, off = wgid / NXCD; wgid = (xcd < r ? xcd * (q + 1) : r * (q + 1) + (xcd - r) * q) + off; }
        const int nig = WGM * nN, gid = wgid / nig, fm = gid * WGM, gsz = (nM - fm) < WGM ? (nM - fm) : WGM;
        u.pm = fm + ((wgid % nig) % gsz); u.pn = (wgid % nig) / gsz; return true;
    }
};
template <class Epi, class Prob, class SchedT>
DI void gemm_phase(const int WID, LAS unsigned char* lds, const Prob& P, const SchedT& S, const Epi& E) {
    const int tid = opaque_tid(WID), wid = __builtin_amdgcn_readfirstlane(tid >> 6), lane = tid & 63, wr = wid >> 2, wc = wid & 3, fr = lane & 15, fq = lane >> 4;
    const int K = P.K, nt = K / BK;
    constexpr int KREP = Epi::CARRY ? 1 : PROBE_KREP;
    unsigned voffA[2], voffB[2];
#pragma unroll
    for (int i = 0; i < 2; ++i) { int R, C; stage_rc(tid * 16 + i * 8192, R, C); const int Rb = Epi::PERM ? ((R & ~31) + perm32(R & 31)) : R;
        voffA[i] = (unsigned)(R * P.lda + C) * 2u; voffB[i] = (unsigned)(Rb * P.ldb + C) * 2u; }
    const size_t kstep = (size_t)(BK * 2);
    const size_t hstepA = (size_t)HALF * P.lda * 2, hstepB = (size_t)HALF * P.ldb * 2;
    const unsigned ldsw = (unsigned)wid * 1024u;
    const int aoff = lds_byte(wr * 64 + fr, fq * 8), boff = lds_byte(wc * 32 + fr, fq * 8);
#define PG8_SA(b, h) (((b) * 2 + (h)) * HTB)
#define PG8_SB(b, h) ((4 + (b) * 2 + (h)) * HTB)
#define PG8_STAGE(bufoff, gbase, voff) do { _Pragma("unroll") for (int _i = 0; _i < 2; ++_i) \
        __builtin_amdgcn_global_load_lds((const unsigned*)((const char*)(gbase) + (voff)[_i]), (LAS unsigned*)(lds + (bufoff) + ldsw + _i * 8192), 16, 0, 0); } while (0)
#define PG8_LD16(off) (*(const LAS i32x4*)(lds + (off)))
#define PG8_LDA(dst, b, h) do { _Pragma("unroll") for (int m = 0; m < 4; ++m) { const i32x4 lo_ = PG8_LD16(PG8_SA(b, h) + aoff + m * 2048), hi_ = PG8_LD16(PG8_SA(b, h) + aoff + m * 2048 + 1024); dst[m] = __builtin_shufflevector(lo_, hi_, 0, 1, 2, 3, 4, 5, 6, 7); } } while (0)
#define PG8_LDB(dst, b, h) do { _Pragma("unroll") for (int n = 0; n < 2; ++n) { const i32x4 lo_ = PG8_LD16(PG8_SB(b, h) + boff + n * 2048), hi_ = PG8_LD16(PG8_SB(b, h) + boff + n * 2048 + 1024); dst[n] = __builtin_shufflevector(lo_, hi_, 0, 1, 2, 3, 4, 5, 6, 7); } } while (0)
#define PG8_LOH(X) __builtin_bit_cast(bf16x8, __builtin_shufflevector((X), (X), 0, 1, 2, 3))
#define PG8_HIH(X) __builtin_bit_cast(bf16x8, __builtin_shufflevector((X), (X), 4, 5, 6, 7))
#define PG8_MMA(ai, bj, At, Bt) do { __builtin_amdgcn_s_setprio(1); \
        if constexpr (Prob::FP8) { _Pragma("unroll") for (int m = 0; m < 4; ++m) _Pragma("unroll") for (int n = 0; n < 2; ++n) \
            asm volatile("v_mfma_scale_f32_16x16x128_f8f6f4 %0, %1, %2, %0, %3, %3 op_sel_hi:[0,0,0]" : "+v"(acc[ai][bj][m][n]) : "v"(Bt[n]), "v"(At[m]), "v"(sc1)); } \
        else { _Pragma("unroll") for (int m = 0; m < 4; ++m) _Pragma("unroll") for (int n = 0; n < 2; ++n) { \
            acc[ai][bj][m][n] = __builtin_amdgcn_mfma_f32_16x16x32_bf16(PG8_LOH(Bt[n]), PG8_LOH(At[m]), acc[ai][bj][m][n], 0, 0, 0); \
            acc[ai][bj][m][n] = __builtin_amdgcn_mfma_f32_16x16x32_bf16(PG8_HIH(Bt[n]), PG8_HIH(At[m]), acc[ai][bj][m][n], 0, 0, 0); } } \
        __builtin_amdgcn_s_setprio(0); } while (0)
#define PG8_WAIT_V(n) asm volatile("s_waitcnt vmcnt(" #n ")" ::: "memory")
#define PG8_WAIT_L(n) asm volatile("s_waitcnt lgkmcnt(" #n ")" ::: "memory")
#define PG8_BAR __builtin_amdgcn_s_barrier()
#define PG8_SCHED __builtin_amdgcn_sched_barrier(0)
    Unit cur, nxt; int ui = 0;
    if (!S.next(0, cur)) return;
    f32x4 acc[2][2][4][2];
#pragma unroll
    for (int a = 0; a < 2; ++a)
#pragma unroll
        for (int b = 0; b < 2; ++b)
#pragma unroll
            for (int m = 0; m < 4; ++m)
#pragma unroll
                for (int n = 0; n < 2; ++n) acc[a][b][m][n] = (f32x4){0.f, 0.f, 0.f, 0.f};
    i32x8 At[4], B0[2], B1[2];
    const int sc1 = 0x7f7f7f7f;
    const char* cA = P.a_base(cur); const char* cB = P.b_base(cur);
    PG8_STAGE(PG8_SB(0, 0), cB, voffB); PG8_STAGE(PG8_SA(0, 0), cA, voffA); PG8_STAGE(PG8_SB(0, 1), cB + hstepB, voffB); PG8_STAGE(PG8_SA(0, 1), cA + hstepA, voffA);
    if (wr == 1) PG8_BAR;
    PG8_WAIT_V(4); PG8_BAR;
    PG8_STAGE(PG8_SB(1, 0), cB + kstep, voffB); PG8_STAGE(PG8_SA(1, 0), cA + kstep, voffA); PG8_STAGE(PG8_SB(1, 1), cB + hstepB + kstep, voffB);
    PG8_WAIT_V(6); PG8_BAR;
    for (;;) {
        const bool has_next = S.next(ui + 1, nxt);
        const char* nA = has_next ? P.a_base(nxt) : cA; const char* nB = has_next ? P.b_base(nxt) : cB;
        for (int rep_ = 0; rep_ < KREP; ++rep_)
        for (int t = 0; t < nt; t += 2) {
            const bool last = (t == nt - 2);
            const char* a1 = cA + (size_t)(t + 1) * kstep;
            const char* a2 = last ? (rep_ + 1 < KREP ? cA : nA) : cA + (size_t)(t + 2) * kstep; const char* b2 = last ? (rep_ + 1 < KREP ? cB : nB) : cB + (size_t)(t + 2) * kstep;
            const char* a3 = a2 + kstep; const char* b3 = b2 + kstep;
            PG8_LDB(B0, 0, 0); PG8_SCHED; PG8_LDA(At, 0, 0); PG8_STAGE(PG8_SA(1, 1), a1 + hstepA, voffA);
            PG8_WAIT_L(8); PG8_BAR; PG8_WAIT_L(0); PG8_MMA(0, 0, At, B0); PG8_BAR; PG8_SCHED;
            PG8_LDB(B1, 0, 1); PG8_STAGE(PG8_SB(0, 0), b2, voffB);
            PG8_BAR; PG8_WAIT_L(0); PG8_MMA(0, 1, At, B1); PG8_BAR;
            PG8_LDA(At, 0, 1); PG8_STAGE(PG8_SA(0, 0), a2, voffA);
            PG8_BAR; PG8_WAIT_L(0); PG8_MMA(1, 0, At, B0); PG8_BAR; PG8_SCHED;
            PG8_STAGE(PG8_SB(0, 1), b2 + hstepB, voffB);
            PG8_WAIT_V(6); PG8_BAR; PG8_MMA(1, 1, At, B1); PG8_BAR;
            PG8_LDB(B0, 1, 0); PG8_SCHED; PG8_LDA(At, 1, 0); PG8_STAGE(PG8_SA(0, 1), a2 + hstepA, voffA);
            PG8_WAIT_L(8); PG8_BAR; PG8_WAIT_L(0); PG8_MMA(0, 0, At, B0); PG8_BAR; PG8_SCHED;
            PG8_LDB(B1, 1, 1); PG8_STAGE(PG8_SB(1, 0), b3, voffB);
            PG8_BAR; PG8_WAIT_L(0); PG8_MMA(0, 1, At, B1); PG8_BAR;
            PG8_LDA(At, 1, 1); PG8_STAGE(PG8_SA(1, 0), a3, voffA);
            PG8_BAR; PG8_WAIT_L(0); PG8_MMA(1, 0, At, B0); PG8_BAR; PG8_SCHED;
            PG8_STAGE(PG8_SB(1, 1), b3 + hstepB, voffB);
            PG8_WAIT_V(6); PG8_BAR; PG8_MMA(1, 1, At, B1); PG8_BAR;
        }
        if constexpr (Prob::FP8) {
            asm volatile("s_nop 15\n\ts_nop 15" ::: "memory");
#pragma unroll
            for (int a_ = 0; a_ < 2; ++a_)
#pragma unroll
                for (int b_ = 0; b_ < 2; ++b_)
#pragma unroll
                    for (int m_ = 0; m_ < 4; ++m_)
#pragma unroll
                        for (int n_ = 0; n_ < 2; ++n_) asm volatile("" : "+v"(acc[a_][b_][m_][n_]));
        }
        if constexpr (KREP > 1) {
#pragma unroll
        for (int a_ = 0; a_ < 2; ++a_)
#pragma unroll
            for (int b_ = 0; b_ < 2; ++b_)
#pragma unroll
                for (int m_ = 0; m_ < 4; ++m_)
#pragma unroll
                    for (int n_ = 0; n_ < 2; ++n_) acc[a_][b_][m_][n_] *= (1.0f / KREP); }
        { const int t2_ = opaque_tid(WID); const int fr_ = t2_ & 15, fq_ = (t2_ >> 4) & 3; int wr_ = WID >> 2, wc_ = WID & 3; asm volatile("" : "+s"(wr_), "+s"(wc_));
          E(acc, cur, wr_, wc_, fr_, fq_); }
        if (!has_next) break;
        const float carry = Epi::carry(cur);
#pragma unroll
        for (int a = 0; a < 2; ++a)
#pragma unroll
            for (int b = 0; b < 2; ++b)
#pragma unroll
                for (int m = 0; m < 4; ++m)
#pragma unroll
                    for (int n = 0; n < 2; ++n) acc[a][b][m][n] = Epi::CARRY ? acc[a][b][m][n] * carry : (f32x4){0.f, 0.f, 0.f, 0.f};
        cur = nxt; cA = nA; cB = nB; ++ui;
    }
    PG8_WAIT_V(0);
    if (wr == 0) PG8_BAR;
    PG8_BAR;
#undef PG8_SA
#undef PG8_SB
#undef PG8_STAGE
#undef PG8_LDA
#undef PG8_LDB
#undef PG8_MMA
#undef PG8_LD16
#undef PG8_LOH
#undef PG8_HIH
#undef PG8_WAIT_V
#undef PG8_WAIT_L
#undef PG8_BAR
#undef PG8_SCHED
}
}
using pg8::Unit;
typedef f32x4 Acc[2][2][4][2];

struct ProbPlain { static constexpr bool FP8 = false; const bf16_t* A; const bf16_t* Bt; int lda, ldb, K;
    DI const char* a_base(const Unit& u) const { return (const char*)(A + (size_t)u.pm * 256 * lda); }
    DI const char* b_base(const Unit& u) const { return (const char*)(Bt + (size_t)u.pn * 256 * ldb); } };
struct ProbCmp1 { static constexpr bool FP8 = false; const bf16_t* KCB; const bf16_t* VCB; const bf16_t* W; int lda, ldb, K;
    DI const char* a_base(const Unit& u) const { const int kv = u.pm >> 4, rt = u.pm & 15; return (const char*)((kv ? VCB : KCB) + (size_t)rt * 256 * 1024); }
    DI const char* b_base(const Unit& u) const { const int kv = u.pm >> 4; return (const char*)(W + (size_t)kv * 256 * 2048); } };
struct ProbAtt { static constexpr bool FP8 = false; const bf16_t* AQ; const bf16_t* KP; int lda, ldb, K;
    DI const char* a_base(const Unit& u) const { const int z = u.pm, n = z & 7, h = (z >> 3) & 3, b = z >> 5; const size_t t0 = (size_t)b * 2048 + n * 256; return (const char*)(AQ + (t0 * 4 + h) * 512 + 256); }
    DI const char* b_base(const Unit& u) const { const int z = u.pm, n = z & 7, h = (z >> 3) & 3, b = z >> 5; const size_t t0 = (size_t)b * 2048 + n * 256; return (const char*)(KP + t0 * 1024 + h * 256); } };
struct ProbUT { static constexpr bool FP8 = false; const bf16_t* VS; const bf16_t* KT; int lda, ldb, K;
    DI const char* a_base(const Unit& u) const { const int z = u.pm >> 1, half = u.pm & 1; return (const char*)(VS + (size_t)z * 262144 + (size_t)half * 256 * 512); }
    DI const char* b_base(const Unit& u) const { const int z = u.pm >> 1; return (const char*)(KT + (size_t)z * 65536); } };
struct ProbY { static constexpr bool FP8 = false; const bf16_t* AQ; const bf16_t* VS; int lda, ldb, K;
    DI const char* a_base(const Unit& u) const { const int z = u.pm, n = z & 7, h = (z >> 3) & 3, b = z >> 5; const size_t t0 = (size_t)b * 2048 + n * 256; return (const char*)(AQ + (t0 * 4 + h) * 512); }
    DI const char* b_base(const Unit& u) const { return (const char*)(VS + (size_t)u.pm * 262144 + (size_t)u.pn * 256 * 512); } };
DI int moe_tile_expert(const LAS int* ts, int rt) { int e = 0;
#pragma unroll 8
    for (int i = 1; i < 32; ++i) e += (rt >= ts[i]) ? 1 : 0;
    return e; }
struct ProbMoe { static constexpr bool FP8 = false; const bf16_t* A; const bf16_t* W; const LAS int* ts; int nper; int lda, ldb, K;
    DI const char* a_base(const Unit& u) const { return (const char*)(A + (size_t)u.pm * 256 * 1024); }
    DI const char* b_base(const Unit& u) const { const int e = moe_tile_expert(ts, u.pm); return (const char*)(W + ((size_t)e * nper + (size_t)u.pn * 256) * 1024); } };

struct ProbPlain8 { static constexpr bool FP8 = true; const unsigned char* A; const unsigned char* Bt; int lda, ldb, K;
    DI const char* a_base(const Unit& u) const { return (const char*)(A + (size_t)u.pm * 256 * lda * 2); }
    DI const char* b_base(const Unit& u) const { return (const char*)(Bt + (size_t)u.pn * 256 * ldb * 2); } };
struct ProbMoe8 { static constexpr bool FP8 = true; const unsigned char* A; const unsigned char* W; const LAS int* ts; int nper; int lda, ldb, K;
    DI const char* a_base(const Unit& u) const { return (const char*)(A + (size_t)u.pm * 256 * 1024); }
    DI const char* b_base(const Unit& u) const { const int e = moe_tile_expert(ts, u.pm); return (const char*)(W + ((size_t)e * nper + (size_t)u.pn * 256) * 1024); } };

#define EPI_ROWS(ai, m) (128 * (ai) + 64 * wr + 16 * (m) + fr)
struct EpiEvNat { static constexpr bool CARRY = false; static DI float carry(const Unit&) { return 0.f; } static constexpr bool PERM = true;
    unsigned char* ws; const float* gains;
    DI void operator()(const Acc& acc, const Unit& u, int wr, int wc, int fr, int fq) const {
        const int pn = u.pn; const bool norm = (pn != 6);
        const int gi = pn < 2 ? 0 : pn < 4 ? 1 : pn < 6 ? 2 : 3;
        const float* g = gains + gi * 64;
        f32x4 gv[2][2];
#pragma unroll
        for (int bj = 0; bj < 2; ++bj)
#pragma unroll
            for (int n = 0; n < 2; ++n) { const f32x4 t4 = *(const f32x4*)(g + 32 * bj + 8 * fq + 4 * n); gv[bj][n] = norm ? t4 : (f32x4){1.f, 1.f, 1.f, 1.f}; }
        size_t boff; int rowmul, hoff; bool panel = false;
        if (pn < 2) { boff = WS_QD; rowmul = 512; hoff = (pn * 4 + wc) * 64; }
        else if (pn < 4) { boff = WS_KD; rowmul = 512; hoff = ((pn - 2) * 4 + wc) * 64; }
        else if (pn < 6) { boff = WS_QN; rowmul = 512; hoff = ((pn - 4) * 4 + wc) * 64; }
        else { panel = true; rowmul = 64; hoff = 0; boff = (pn == 6) ? (wc < 2 ? WS_KCB : WS_VCB) : (wc < 2 ? WS_KSB : WS_KWB); }
        bf16_t* base = (bf16_t*)(ws + boff);
#pragma unroll
        for (int ai = 0; ai < 2; ++ai)
#pragma unroll
            for (int m = 0; m < 4; ++m) {
                const int t = u.pm * 256 + EPI_ROWS(ai, m), b = t >> 11, sq = t & 2047;
                float ss = 0.f;
#pragma unroll
                for (int bj = 0; bj < 2; ++bj)
#pragma unroll
                    for (int n = 0; n < 2; ++n) { const f32x4 x = acc[ai][bj][m][n]; ss += (x[0] * x[0] + x[1] * x[1]) + (x[2] * x[2] + x[3] * x[3]); }
                ss += shx(ss, 16); ss += shx(ss, 32);
                const float rstd = norm ? rsqrtf(ss * (1.0f / 64.0f) + EPS) * ((pn < 2 || pn == 4 || pn == 5) ? 0.125f : 1.0f) : 1.0f;
                const size_t rowi = panel ? ((size_t)(b * 2 + (wc & 1)) * 2048 + sq) : (size_t)t;
#pragma unroll
                for (int bj = 0; bj < 2; ++bj) {
                    const f32x4 v0 = acc[ai][bj][m][0] * rstd * gv[bj][0], v1 = acc[ai][bj][m][1] * rstd * gv[bj][1];
                    *(u32x4*)(base + rowi * rowmul + hoff + 32 * bj + 8 * fq) = pack8(v0, v1);
                }
            }
    }
};
struct EpiEvSw { static constexpr bool CARRY = false; static DI float carry(const Unit&) { return 0.f; } static constexpr bool PERM = true;
    unsigned char* ws;
    DI void operator()(const Acc& acc, const Unit& u, int wr, int wc, int fr, int fq) const {
        const int b = u.pn >> 3, sb = (u.pn & 7) * 256;
#pragma unroll
        for (int ai = 0; ai < 2; ++ai)
#pragma unroll
            for (int m = 0; m < 4; ++m) {
                const int rl = EPI_ROWS(ai, m);
                size_t boff, rowi;
                if (u.pm < 2) { const int fg = u.pm * 256 + rl; boff = WS_VAT; rowi = (size_t)(b * 4 + (fg >> 7)) * 128 + (fg & 127); }
                else { const int r2 = rl & 127; boff = (rl < 128) ? WS_VST : WS_VWT; rowi = (size_t)(b * 2 + (r2 >> 6)) * 64 + (r2 & 63); }
                bf16_t* rowp = (bf16_t*)(ws + boff) + rowi * 2048;
#pragma unroll
                for (int bj = 0; bj < 2; ++bj) *(u32x4*)(rowp + sb + 128 * bj + 32 * wc + 8 * fq) = pack8(acc[ai][bj][m][0], acc[ai][bj][m][1]);
            }
    }
};
struct EpiCmp1 { static constexpr bool CARRY = false; static DI float carry(const Unit&) { return 0.f; } static constexpr bool PERM = true;
    bf16_t* HID; const float* bias1;
    DI void operator()(const Acc& acc, const Unit& u, int wr, int wc, int fr, int fq) const {
        const int kv = u.pm >> 4, rt = u.pm & 15;
#pragma unroll
        for (int bj = 0; bj < 2; ++bj) {
            const int col = 128 * bj + 32 * wc + 8 * fq;
            const f32x4 b0 = *(const f32x4*)(bias1 + kv * 256 + col), b1 = *(const f32x4*)(bias1 + kv * 256 + col + 4);
#pragma unroll
            for (int ai = 0; ai < 2; ++ai)
#pragma unroll
                for (int m = 0; m < 4; ++m) {
                    f32x4 v0 = acc[ai][bj][m][0] + b0, v1 = acc[ai][bj][m][1] + b1;
#pragma unroll
                    for (int j = 0; j < 4; ++j) { v0[j] = v0[j] * sigm(v0[j]); v1[j] = v1[j] * sigm(v1[j]); }
                    *(u32x4*)(HID + ((size_t)kv * 4096 + rt * 256 + EPI_ROWS(ai, m)) * 256 + col) = pack8(v0, v1);
                }
        }
    }
};
struct EpiResid { static constexpr bool CARRY = false; static DI float carry(const Unit&) { return 0.f; } static constexpr bool PERM = false;
    const float* Hin; float* Hout;
    DI void operator()(const Acc& acc, const Unit& u, int wr, int wc, int fr, int fq) const {
#pragma unroll
        for (int ai = 0; ai < 2; ++ai)
#pragma unroll
            for (int m = 0; m < 4; ++m) {
                const size_t off = (size_t)(u.pm * 256 + EPI_ROWS(ai, m)) * 1024 + u.pn * 256 + 32 * wc + 4 * fq;
#pragma unroll
                for (int bj = 0; bj < 2; ++bj)
#pragma unroll
                    for (int n = 0; n < 2; ++n) { const size_t o = off + 128 * bj + 16 * n; *(f32x4*)(Hout + o) = *(const f32x4*)(Hin + o) + acc[ai][bj][m][n]; }
            }
    }
};
DI float ret_lg2(int h) { return __log2f(1.0f - exp2f(-5.0f - (float)h)); }
struct EpiOdNat { static constexpr bool CARRY = false; static DI float carry(const Unit&) { return 0.f; } static constexpr bool PERM = true;
    unsigned char* ws;
    DI void operator()(const Acc& acc, const Unit& u, int wr, int wc, int fr, int fq) const {
        const int pn = u.pn; const int h = pn & 3; const float lg = ret_lg2(h);
        const size_t boff = pn < 4 ? WS_AQ : pn < 8 ? WS_KP : WS_GG;
        const int rowmul = pn < 4 ? 2048 : pn < 8 ? 1024 : 2048;
        const int coff = pn < 4 ? (h * 512 + 256) : pn < 8 ? (h * 256) : ((pn - 8) * 256);
        bf16_t* base = (bf16_t*)(ws + boff) + coff;
#pragma unroll
        for (int ai = 0; ai < 2; ++ai)
#pragma unroll
            for (int m = 0; m < 4; ++m) {
                const int cl = EPI_ROWS(ai, m); const size_t t = (size_t)u.pm * 256 + cl;
                float sc = 1.f;
                if (pn < 4) sc = exp2f(lg * (float)(cl + 1)); else if (pn < 8) sc = 0.0625f * exp2f(-lg * (float)(cl + 1));
#pragma unroll
                for (int bj = 0; bj < 2; ++bj) {
                    const int d = 128 * bj + 32 * wc + 8 * fq;
                    f32x4 v0 = acc[ai][bj][m][0] * sc, v1 = acc[ai][bj][m][1] * sc;
                    if (pn >= 8) {
#pragma unroll
                        for (int j = 0; j < 4; ++j) { v0[j] = v0[j] * sigm(v0[j]); v1[j] = v1[j] * sigm(v1[j]); } }
                    *(u32x4*)(base + t * rowmul + d) = pack8(v0, v1);
                }
            }
    }
};
struct EpiOdSw { static constexpr bool CARRY = false; static DI float carry(const Unit&) { return 0.f; } static constexpr bool PERM = true;
    unsigned char* ws;
    DI void operator()(const Acc& acc, const Unit& u, int wr, int wc, int fr, int fq) const {
        const int b = u.pn >> 3, n = u.pn & 7;
        const bool isk = u.pm < 4; const int h = isk ? u.pm : ((u.pm - 4) >> 1);
        const size_t z = (size_t)(b * 4 + h) * 8 + n; const float lg = ret_lg2(h);
        bf16_t* base = (bf16_t*)(ws + (isk ? WS_KT : WS_VS)) + (isk ? z * 65536 : z * 262144 + (size_t)((u.pm - 4) & 1) * 256 * 512);
        const int rowmul = isk ? 256 : 512;
#pragma unroll
        for (int bj = 0; bj < 2; ++bj) {
            const int cl = 128 * bj + 32 * wc + 8 * fq;
            f32x4 s0 = {1.f, 1.f, 1.f, 1.f}, s1 = s0;
            if (isk) {
#pragma unroll
                for (int j = 0; j < 4; ++j) { s0[j] = 0.0625f * exp2f(-lg * (float)(cl + j + 1)); s1[j] = 0.0625f * exp2f(-lg * (float)(cl + 4 + j + 1)); } }
#pragma unroll
            for (int ai = 0; ai < 2; ++ai)
#pragma unroll
                for (int m = 0; m < 4; ++m)
                    *(u32x4*)(base + (size_t)EPI_ROWS(ai, m) * rowmul + cl) = pack8(acc[ai][bj][m][0] * s0, acc[ai][bj][m][1] * s1);
        }
    }
};
struct EpiAtt { static constexpr bool CARRY = false; static DI float carry(const Unit&) { return 0.f; } static constexpr bool PERM = true;
    bf16_t* AQ;
    DI void operator()(const Acc& acc, const Unit& u, int wr, int wc, int fr, int fq) const {
        const int z = u.pm, n = z & 7, h = (z >> 3) & 3, b = z >> 5; const size_t t0 = (size_t)b * 2048 + n * 256;
#pragma unroll
        for (int ai = 0; ai < 2; ++ai)
#pragma unroll
            for (int m = 0; m < 4; ++m) {
                const int c = EPI_ROWS(ai, m);
#pragma unroll
                for (int bj = 0; bj < 2; ++bj) {
                    const int e0 = 128 * bj + 32 * wc + 8 * fq;
                    f32x4 v0 = acc[ai][bj][m][0], v1 = acc[ai][bj][m][1];
#pragma unroll
                    for (int j = 0; j < 4; ++j) { v0[j] = (c >= e0 + j) ? v0[j] : 0.f; v1[j] = (c >= e0 + 4 + j) ? v1[j] : 0.f; }
                    *(u32x4*)(AQ + ((t0 + c) * 4 + h) * 512 + e0) = pack8(v0, v1);
                }
            }
    }
};
struct EpiUT { static constexpr bool CARRY = false; static DI float carry(const Unit&) { return 0.f; } static constexpr bool PERM = true;
    bf16_t* UT;
    DI void operator()(const Acc& acc, const Unit& u, int wr, int wc, int fr, int fq) const {
        const size_t z = (size_t)(u.pm >> 1); const int half = u.pm & 1;
#pragma unroll
        for (int ai = 0; ai < 2; ++ai)
#pragma unroll
            for (int m = 0; m < 4; ++m) {
                bf16_t* rowp = UT + z * 131072 + (size_t)(half * 256 + EPI_ROWS(ai, m)) * 256 + 32 * wc + 8 * fq;
#pragma unroll
                for (int bj = 0; bj < 2; ++bj) *(u32x4*)(rowp + 128 * bj) = pack8(acc[ai][bj][m][0], acc[ai][bj][m][1]);
            }
    }
};
struct EpiUTScan { static constexpr bool CARRY = true; static constexpr bool PERM = true;
    static DI float carry(const Unit& u) { const int z = u.pm >> 1, n = z & 7, h = (z >> 3) & 3; return n == 7 ? 0.f : exp2f(256.0f * ret_lg2(h)); }
    bf16_t* VS;
    DI void operator()(const Acc& acc, const Unit& u, int wr, int wc, int fr, int fq) const {
        const size_t z = (size_t)(u.pm >> 1); const int half = u.pm & 1, n = (int)(z & 7), h = (int)((z >> 3) & 3);
        const float dec = exp2f(256.0f * ret_lg2(h));
#pragma unroll
        for (int ai = 0; ai < 2; ++ai)
#pragma unroll
            for (int m = 0; m < 4; ++m) {
                bf16_t* rowp = VS + (z * 512 + half * 256 + EPI_ROWS(ai, m)) * 512 + 256 + 32 * wc + 8 * fq;
#pragma unroll
                for (int bj = 0; bj < 2; ++bj) {
                    if (n == 0) { unsigned z0; asm volatile("v_mov_b32 %0, 0" : "=v"(z0)); *(u32x4*)(rowp + 128 * bj) = (u32x4){z0, z0, z0, z0}; }
                    if (n < 7) *(u32x4*)(rowp + (size_t)512 * 512 + 128 * bj) = pack8(acc[ai][bj][m][0] * dec, acc[ai][bj][m][1] * dec);
                }
            }
    }
};
struct SchedSeq { int nb, c;
    DI void init(int G, int c_) { nb = G / 2 > 0 ? G / 2 : 1; c = c_; }
    DI bool next(int i, Unit& u) const { if (c >= nb) return false; const int seq = c + (i >> 3) * nb; if (seq >= 128) return false;
        const int bh = seq >> 1, half = seq & 1, n = i & 7; u.pm = (bh * 8 + n) * 2 + half; u.pn = 0; return true; } };
struct EpiY { static constexpr bool CARRY = false; static DI float carry(const Unit&) { return 0.f; } static constexpr bool PERM = true;
    bf16_t* Y;
    DI void operator()(const Acc& acc, const Unit& u, int wr, int wc, int fr, int fq) const {
        const int z = u.pm, n = z & 7, h = (z >> 3) & 3, b = z >> 5; const size_t t0 = (size_t)b * 2048 + n * 256;
#pragma unroll
        for (int ai = 0; ai < 2; ++ai)
#pragma unroll
            for (int m = 0; m < 4; ++m) {
                bf16_t* rowp = Y + (t0 + EPI_ROWS(ai, m)) * 2048 + h * 512 + u.pn * 256 + 32 * wc + 8 * fq;
#pragma unroll
                for (int bj = 0; bj < 2; ++bj) *(u32x4*)(rowp + 128 * bj) = pack8(acc[ai][bj][m][0], acc[ai][bj][m][1]);
            }
    }
};
constexpr float W8_SCALE = 32.0f, WSC = 1.0f / W8_SCALE;
struct EpiGU { static constexpr bool CARRY = false; static DI float carry(const Unit&) { return 0.f; } static constexpr bool PERM = true;
    unsigned char* ACT; const float* bgu; const LAS int* ts;
    DI void operator()(const Acc& acc, const Unit& u, int wr, int wc, int fr, int fq) const {
        const int e = moe_tile_expert(ts, u.pm); const int w = 32 * wc + 8 * fq;
        const float* bp = bgu + (size_t)e * 2048 + 128 * u.pn + w;
        const f32x4 bg0 = *(const f32x4*)bp, bg1 = *(const f32x4*)(bp + 4), bl0 = *(const f32x4*)(bp + 1024), bl1 = *(const f32x4*)(bp + 1028);
#pragma unroll
        for (int ai = 0; ai < 2; ++ai)
#pragma unroll
            for (int m = 0; m < 4; ++m) {
                f32x4 g0 = acc[ai][0][m][0] * WSC + bg0, g1 = acc[ai][0][m][1] * WSC + bg1, l0 = acc[ai][1][m][0] * WSC + bl0, l1 = acc[ai][1][m][1] * WSC + bl1;
#pragma unroll
                for (int j = 0; j < 4; ++j) {
                    const float a = fminf(g0[j], 7.0f), c = fminf(g1[j], 7.0f);
                    const float la = fminf(fmaxf(l0[j], -7.0f), 7.0f), lc = fminf(fmaxf(l1[j], -7.0f), 7.0f);
                    g0[j] = a * sigm(1.702f * a) * (la + 1.0f); g1[j] = c * sigm(1.702f * c) * (lc + 1.0f); }
                u32x2 o8; o8.x = pk4_fp8(g0[0], g0[1], g0[2], g0[3]); o8.y = pk4_fp8(g1[0], g1[1], g1[2], g1[3]);
                *(u32x2*)(ACT + ((size_t)u.pm * 256 + EPI_ROWS(ai, m)) * 1024 + 128 * u.pn + w) = o8;
            }
    }
};
struct EpiDN { static constexpr bool CARRY = false; static DI float carry(const Unit&) { return 0.f; } static constexpr bool PERM = true;
    bf16_t* YB; const float* bdn; const LAS int* ts;
    DI void operator()(const Acc& acc, const Unit& u, int wr, int wc, int fr, int fq) const {
        const int e = moe_tile_expert(ts, u.pm);
#pragma unroll
        for (int bj = 0; bj < 2; ++bj) {
            const int col = 256 * u.pn + 128 * bj + 32 * wc + 8 * fq;
            const f32x4 b0 = *(const f32x4*)(bdn + (size_t)e * 1024 + col), b1 = *(const f32x4*)(bdn + (size_t)e * 1024 + col + 4);
#pragma unroll
            for (int ai = 0; ai < 2; ++ai)
#pragma unroll
                for (int m = 0; m < 4; ++m)
                    *(u32x4*)(YB + ((size_t)u.pm * 256 + EPI_ROWS(ai, m)) * 1024 + col) = pack8(acc[ai][bj][m][0] * (1.0f / 64.0f) + b0, acc[ai][bj][m][1] * (1.0f / 64.0f) + b1);
        }
    }
};
struct EpiPP { static constexpr bool CARRY = false; static DI float carry(const Unit&) { return 0.f; } static constexpr bool PERM = true;
    bf16_t* PP;
    DI void operator()(const Acc& acc, const Unit& u, int wr, int wc, int fr, int fq) const {
#pragma unroll
        for (int ai = 0; ai < 2; ++ai)
#pragma unroll
            for (int m = 0; m < 4; ++m) {
                bf16_t* rowp = PP + ((size_t)u.pm * 256 + EPI_ROWS(ai, m)) * 1024 + u.pn * 256 + 32 * wc + 8 * fq;
#pragma unroll
                for (int bj = 0; bj < 2; ++bj) *(u32x4*)(rowp + 128 * bj) = pack8(acc[ai][bj][m][0], acc[ai][bj][m][1]);
            }
    }
};
struct EpiPLE { static constexpr bool CARRY = false; static DI float carry(const Unit&) { return 0.f; } static constexpr bool PERM = false;
    float* H; const bf16_t* PP;
    DI void operator()(const Acc& acc, const Unit& u, int wr, int wc, int fr, int fq) const {
#pragma unroll
        for (int ai = 0; ai < 2; ++ai)
#pragma unroll
            for (int m = 0; m < 4; ++m) {
                const size_t off = (size_t)(u.pm * 256 + EPI_ROWS(ai, m)) * 1024 + u.pn * 256 + 32 * wc + 4 * fq;
#pragma unroll
                for (int bj = 0; bj < 2; ++bj)
#pragma unroll
                    for (int n = 0; n < 2; ++n) {
                        const size_t o = off + 128 * bj + 16 * n;
                        const u32x2 pw = *(const u32x2*)(PP + o); const f32x4 a = acc[ai][bj][m][n]; f32x4 hv = *(const f32x4*)(H + o);
                        hv[0] += sigm(a[0] * WSC) * bflo(pw.x); hv[1] += sigm(a[1] * WSC) * bfhi(pw.x); hv[2] += sigm(a[2] * WSC) * bflo(pw.y); hv[3] += sigm(a[3] * WSC) * bfhi(pw.y);
                        *(f32x4*)(H + o) = hv;
                    }
            }
    }
};

constexpr int AT_KSTR = 144;
template <int DV, int MODE>
DI void attn_unit(const int WID, LAS unsigned char* lds, const bf16_t* Qp, int ldq, const bf16_t* Kp, int ldk, const bf16_t* Vt, int ldvt, int q0, float slope, int dcut,
                  const unsigned* selp, bf16_t* Op, int ldo, float* impp) {
    constexpr int NRB = DV / 32, VPIECES = DV * 8;
    constexpr int KB0 = 0, KB1 = 64 * AT_KSTR, VB0 = 2 * 64 * AT_KSTR, VB1 = VB0 + DV * AT_KSTR;
    const int tid = opaque_tid(WID), w = __builtin_amdgcn_readfirstlane(tid >> 6), lane = tid & 63, r = lane & 31, hh = lane >> 5;
    const int qrow = q0 + 32 * w + r, qw_first = q0 + 32 * w, qw_last = qw_first + 31;
    const float LOG2E = 1.44269504089f;
    bf16x8 qf[4];
#pragma unroll
    for (int ks = 0; ks < 4; ++ks) qf[ks] = *(const bf16x8*)(Qp + (size_t)(32 * w + r) * ldq + 16 * ks + 8 * hh);
    unsigned selm = 0xffffffffu, orm = 0xffffffffu;
    if (MODE == 1) { selm = selp[32 * w + r]; orm = selm;
#pragma unroll
        for (int o = 1; o < 32; o <<= 1) orm |= shxu(orm, o); }
    const int nv = (MODE == 3) ? (qrow >= 31 ? ((qrow - 15) >> 4) : 0) : 0;
    const int nv_wmax = (MODE == 3) ? (qw_last >= 31 ? ((qw_last - 15) >> 4) : 0) : 0;
    int kt_lo = 0, kt_hi;
    if (MODE == 0 || MODE == 1) kt_hi = (q0 >> 6) + 4;
    else if (MODE == 2) { kt_hi = (q0 >> 6) + 4; const int lk = q0 - 511; kt_lo = lk > 0 ? (lk >> 6) : 0; }
    else kt_hi = 2;
    if (MODE != 3) { const int kmin = q0 - dcut; const int lo2 = kmin > 0 ? (kmin >> 6) : 0; kt_lo = lo2 > kt_lo ? lo2 : kt_lo; }
    f32x16 cb[2];
#pragma unroll
    for (int kk = 0; kk < 2; ++kk)
#pragma unroll
        for (int i = 0; i < 16; ++i) cb[kk][i] = (MODE == 3) ? 0.f : slope * (float)(32 * kk + 8 * (i >> 2) + (i & 3) + 4 * hh);
    f32x16 O[NRB];
#pragma unroll
    for (int rb = 0; rb < NRB; ++rb)
#pragma unroll
        for (int i = 0; i < 16; ++i) O[rb][i] = 0.f;
    float mrun = NEGF, lrun = 0.f;
    u32x4 kreg, vreg[2];
    const int krow = tid >> 3, kpc = tid & 7;
#define AT_GLOAD(kt) do { kreg = *(const u32x4*)(Kp + (size_t)(64 * (kt) + krow) * ldk + 8 * kpc); \
        _Pragma("unroll") for (int i_ = 0; i_ < 2; ++i_) { const int idx = tid + 512 * i_; if (idx < VPIECES) vreg[i_] = *(const u32x4*)(Vt + (size_t)(idx >> 3) * ldvt + 64 * (kt) + 8 * (idx & 7)); } } while (0)
#define AT_LWRITE(buf) do { *(LAS u32x4*)(lds + ((buf) ? KB1 : KB0) + krow * AT_KSTR + kpc * 16) = kreg; \
        _Pragma("unroll") for (int i_ = 0; i_ < 2; ++i_) { const int idx = tid + 512 * i_; if (idx < VPIECES) { const int p_ = idx & 7; \
            LAS unsigned char* d_ = lds + ((buf) ? VB1 : VB0) + (idx >> 3) * AT_KSTR + (p_ >> 1) * 32 + (p_ & 1) * 8; \
            *(LAS u32x2*)d_ = (u32x2){vreg[i_].x, vreg[i_].y}; *(LAS u32x2*)(d_ + 16) = (u32x2){vreg[i_].z, vreg[i_].w}; } } } while (0)
    AT_GLOAD(kt_hi - 1); AT_LWRITE(0);
    __syncthreads();
    const int ntile = kt_hi - kt_lo;
    for (int it = 0; it < ntile; ++it) {
        const int kt = kt_hi - 1 - it, buf = it & 1, key0 = 64 * kt;
        if (it + 1 < ntile) AT_GLOAD(kt - 1);
        bool skip;
        if (MODE == 0) skip = key0 > qw_last;
        else if (MODE == 1) skip = (key0 > qw_last) || !((orm >> kt) & 1u);
        else if (MODE == 2) skip = (key0 > qw_last) || (key0 + 63 < qw_first - 511);
        else skip = key0 >= nv_wmax;
        if (!skip) {
            const LAS unsigned char* kb = lds + (buf ? KB1 : KB0); const LAS unsigned char* vb = lds + (buf ? VB1 : VB0);
            f32x16 S[2];
#pragma unroll
            for (int kk = 0; kk < 2; ++kk) {
                S[kk] = cb[kk];
#pragma unroll
                for (int ks = 0; ks < 4; ++ks) { const bf16x8 a = *(const LAS bf16x8*)(kb + (32 * kk + r) * AT_KSTR + (16 * ks + 8 * hh) * 2);
                    S[kk] = __builtin_amdgcn_mfma_f32_32x32x16_bf16(a, qf[ks], S[kk], 0, 0, 0); }
            }
            const bool bnd = (MODE == 3) ? true : ((key0 + 63 > qw_first) || (MODE == 2 && key0 < qw_last - 511));
            if (bnd) {
                const int lim = (MODE == 3) ? (nv - key0 - 4 * hh) : (qrow - key0 - 4 * hh);
#pragma unroll
                for (int kk = 0; kk < 2; ++kk)
#pragma unroll
                    for (int i = 0; i < 16; ++i) { const int cki = 32 * kk + 8 * (i >> 2) + (i & 3);
                        bool valid;
                        if (MODE == 3) valid = cki < lim; else if (MODE == 2) valid = (cki <= lim) && (cki > lim - 512); else valid = cki <= lim;
                        S[kk][i] = valid ? S[kk][i] : NEGF; }
            }
            float mx = NEGF;
#pragma unroll
            for (int kk = 0; kk < 2; ++kk)
#pragma unroll
                for (int i = 0; i < 16; ++i) mx = fmaxf(mx, S[kk][i]);
            mx = fmaxf(mx, shx(mx, 32));
            const float off = (MODE == 3) ? 0.f : slope * (float)key0;
            mx += off;
            bool selok = true;
            if (MODE == 1) { selok = ((selm >> kt) & 1u) != 0u; mx = selok ? mx : NEGF; }
            const float mnew = fmaxf(mrun, mx);
            const float meff = (mnew < -1e29f) ? 0.f : mnew;
            float c = (off - meff) * LOG2E;
            if (MODE == 1) c = selok ? c : NEGF;
            float ps = 0.f;
#pragma unroll
            for (int kk = 0; kk < 2; ++kk)
#pragma unroll
                for (int i = 0; i < 16; ++i) { const float p = __builtin_amdgcn_exp2f(__builtin_fmaf(S[kk][i], LOG2E, c)); S[kk][i] = p; ps += p; }
            if (__any(mnew > mrun)) {
                const float alpha = __builtin_amdgcn_exp2f((mrun - mnew) * LOG2E);
                lrun *= alpha;
#pragma unroll
                for (int rb = 0; rb < NRB; ++rb)
#pragma unroll
                    for (int i = 0; i < 16; ++i) O[rb][i] *= alpha;
            }
            mrun = mnew; lrun += ps;
#pragma unroll
            for (int kk = 0; kk < 2; ++kk)
#pragma unroll
                for (int s2 = 0; s2 < 2; ++s2) {
                    u32x4 pw; pw.x = pk2(S[kk][8 * s2 + 0], S[kk][8 * s2 + 1]); pw.y = pk2(S[kk][8 * s2 + 2], S[kk][8 * s2 + 3]);
                    pw.z = pk2(S[kk][8 * s2 + 4], S[kk][8 * s2 + 5]); pw.w = pk2(S[kk][8 * s2 + 6], S[kk][8 * s2 + 7]);
                    const bf16x8 pf = __builtin_bit_cast(bf16x8, pw);
#pragma unroll
                    for (int rb = 0; rb < NRB; ++rb) {
                        const bf16x8 a = *(const LAS bf16x8*)(vb + (32 * rb + r) * AT_KSTR + (2 * kk + s2) * 32 + hh * 16);
                        O[rb] = __builtin_amdgcn_mfma_f32_32x32x16_bf16(a, pf, O[rb], 0, 0, 0);
                    }
                }
        }
        if (it + 1 < ntile) AT_LWRITE(buf ^ 1);
        __syncthreads();
    }
#undef AT_GLOAD
#undef AT_LWRITE
    const float ltot = lrun + shx(lrun, 32);
    float inv = 1.0f / ltot;
    if (MODE == 3) inv = (nv > 0) ? inv : 0.f;
#pragma unroll
    for (int rb = 0; rb < NRB; ++rb)
#pragma unroll
        for (int g4 = 0; g4 < 4; ++g4) {
            const float a = O[rb][4 * g4] * inv, b = O[rb][4 * g4 + 1] * inv, c = O[rb][4 * g4 + 2] * inv, d = O[rb][4 * g4 + 3] * inv;
            const int dv = 32 * rb + 8 * g4 + 4 * hh;
            if (MODE == 3 && rb == 2) { *(f32x4*)(impp + (size_t)(32 * w + r) * 256 + (dv - 64)) = (f32x4){a, b, c, d}; }
            else { u32x2 o; o.x = pk2(a, b); o.y = pk2(c, d); *(u32x2*)(Op + (size_t)(32 * w + r) * ldo + dv) = o; }
        }
}

struct Args { const float* in[26]; float* out; unsigned char* ws; int ph_lo, ph_hi; };
typedef const __attribute__((address_space(4))) Args* ArgsP;
DI ArgsP opaque_args() { auto p = __builtin_amdgcn_kernarg_segment_ptr(); asm volatile("" : "+s"(p)); return (ArgsP)p; }
enum { I_X = 0, I_P, I_N1G, I_N2G, I_EVWIN, I_EVWOUT, I_DAQN, I_DAKN, I_DALAM, I_DAOUTG, I_NSQN, I_NSKN, I_CMPPE, I_CMPW1, I_CMPW2, I_ODWIN, I_ODWOUT,
       I_RETG, I_ROUTW, I_ROUTB, I_WGU, I_BGU, I_WDN, I_BDN, I_PLEP, I_PLEG };

struct CvtJob { int in_idx, ldsrc, K, col0, ncols, dstrow0, perm, nmat; size_t src_stride, dst_off, dst_stride; int fp8, pad; };
constexpr int NJOBS = 19;
__constant__ CvtJob c_jobs[NJOBS] = {
    {I_EVWIN, EVIN, 1024, 0,    1024, 0,    1, 2, (size_t)1024 * EVIN, WS_EVNAT, (size_t)2048 * 1024, 0, 0},
    {I_EVWIN, EVIN, 1024, 1536, 512,  1024, 1, 2, (size_t)1024 * EVIN, WS_EVNAT, (size_t)2048 * 1024, 0, 0},
    {I_EVWIN, EVIN, 1024, 2048, 128,  1536, 1, 2, (size_t)1024 * EVIN, WS_EVNAT, (size_t)2048 * 1024, 0, 0},
    {I_EVWIN, EVIN, 1024, 2176, 128,  1664, 1, 2, (size_t)1024 * EVIN, WS_EVNAT, (size_t)2048 * 1024, 0, 0},
    {I_EVWIN, EVIN, 1024, 2304, 128,  1792, 1, 2, (size_t)1024 * EVIN, WS_EVNAT, (size_t)2048 * 1024, 0, 0},
    {I_EVWIN, EVIN, 1024, 2560, 128,  1920, 1, 2, (size_t)1024 * EVIN, WS_EVNAT, (size_t)2048 * 1024, 0, 0},
    {I_EVWIN, EVIN, 1024, 1024, 512,  0,    0, 2, (size_t)1024 * EVIN, WS_EVSW,  (size_t)768 * 1024, 0, 0},
    {I_EVWIN, EVIN, 1024, 2432, 128,  512,  0, 2, (size_t)1024 * EVIN, WS_EVSW,  (size_t)768 * 1024, 0, 0},
    {I_EVWIN, EVIN, 1024, 2688, 128,  640,  0, 2, (size_t)1024 * EVIN, WS_EVSW,  (size_t)768 * 1024, 0, 0},
    {I_EVWOUT, 1024, 1024, 0, 1024, 0, 0, 2, (size_t)1024 * 1024, WS_EVOUT, (size_t)1024 * 1024, 0, 0},
    {I_CMPW1, 256, 2048, 0, 256, 0, 0, 4, (size_t)2048 * 256, WS_CMP1, (size_t)256 * 2048, 0, 0},
    {I_ODWIN, ODIN, 1024, 0,    2048, 0,    0, 2, (size_t)1024 * ODIN, WS_ODNAT, (size_t)4096 * 1024, 0, 0},
    {I_ODWIN, ODIN, 1024, 4096, 2048, 2048, 0, 2, (size_t)1024 * ODIN, WS_ODNAT, (size_t)4096 * 1024, 0, 0},
    {I_ODWIN, ODIN, 1024, 1024, 3072, 0,    0, 2, (size_t)1024 * ODIN, WS_ODSW,  (size_t)3072 * 1024, 0, 0},
    {I_ODWOUT, 1024, 2048, 0, 1024, 0, 0, 2, (size_t)2048 * 1024, WS_ODOUT, (size_t)1024 * 2048, 0, 0},
    {I_WGU, 2048, 1024, 0, 2048, 0, 2, 128, (size_t)1024 * 2048, WS_WGU, (size_t)2048 * 1024, 32, 0},
    {I_WDN, 1024, 1024, 0, 1024, 0, 0, 128, (size_t)1024 * 1024, WS_WDN, (size_t)1024 * 1024, 64, 0},
    {I_PLEP, 1024, 256, 0, 1024, 0, 0, 4, (size_t)256 * 1024, WS_WPP, (size_t)1024 * 256, 0, 0},
    {I_PLEG, 1024, 1024, 0, 1024, 0, 0, 4, (size_t)1024 * 1024, WS_WPG, (size_t)1024 * 1024, 32, 0},
};
DI int cvt_dstrow(int perm, int L) {
    if (perm == 1) { const int pn = L >> 8, lc = L & 255; return pn * 256 + 128 * ((lc & 63) >> 5) + 32 * (lc >> 6) + (lc & 31); }
    if (perm == 2) { const int bj = L >> 10, cc = L & 1023; return 256 * (cc >> 7) + 128 * bj + (cc & 127); }
    return L;
}
DI void phase_prologue(const int WID, ArgsP a, LAS unsigned char* lds) {
    const int tid = opaque_tid(WID), lane = tid & 63, wv = tid >> 6;
    const int gw = blockIdx.x * 8 + wv, NGW = gridDim.x * 8;
    LAS float* scr = (LAS float*)(lds + wv * 16640);
    int total = 0;
    for (int j = 0; j < NJOBS; ++j) total += c_jobs[j].nmat * (c_jobs[j].K >> 6) * (c_jobs[j].ncols >> 6);
#define PRO_DECODE(IT, JJ, MAT, K0, N0, SRC) do { int r_ = (IT), j_ = 0; \
        for (; j_ < NJOBS; ++j_) { const int n_ = c_jobs[j_].nmat * (c_jobs[j_].K >> 6) * (c_jobs[j_].ncols >> 6); if (r_ < n_) break; r_ -= n_; } \
        JJ = j_; const int nkb_ = c_jobs[j_].K >> 6, nnb_ = c_jobs[j_].ncols >> 6, per_ = nkb_ * nnb_; MAT = r_ / per_; const int rr_ = r_ % per_; K0 = (rr_ / nnb_) * 64; N0 = (rr_ % nnb_) * 64; \
        SRC = a->in[c_jobs[j_].in_idx] + (size_t)MAT * c_jobs[j_].src_stride + (size_t)K0 * c_jobs[j_].ldsrc + c_jobs[j_].col0 + N0 + lane; } while (0)
    float tv[64];
    int jn = 0, matn = 0, k0n = 0, n0n = 0; const float* srcn = nullptr;
    if (gw < total) { PRO_DECODE(gw, jn, matn, k0n, n0n, srcn); const int lds_ = c_jobs[jn].ldsrc;
#pragma unroll
        for (int i = 0; i < 64; ++i) tv[i] = srcn[(size_t)i * lds_]; }
    for (int it = gw; it < total; it += NGW) {
        const CvtJob J = c_jobs[jn]; const int mat = matn, k0 = k0n, n0 = n0n;
#pragma unroll
        for (int i = 0; i < 64; ++i) scr[i * 65 + lane] = tv[i];
        if (it + NGW < total) { PRO_DECODE(it + NGW, jn, matn, k0n, n0n, srcn); const int lds_ = c_jobs[jn].ldsrc;
#pragma unroll
            for (int i = 0; i < 64; ++i) tv[i] = srcn[(size_t)i * lds_]; }
        asm volatile("s_waitcnt lgkmcnt(0)" ::: "memory");
        if (J.fp8) {
            unsigned char* dst = (unsigned char*)(a->ws + J.dst_off) + (size_t)mat * J.dst_stride;
            const int c = lane & 3, nsub = lane >> 2; const float W8_S = (float)J.fp8;
#pragma unroll
            for (int jj = 0; jj < 4; ++jj) {
                const int n = nsub + 16 * jj; const LAS float* s = scr + (16 * c) * 65 + n;
                u32x4 o;
                o.x = pk4_fp8(s[0] * W8_S, s[65] * W8_S, s[2 * 65] * W8_S, s[3 * 65] * W8_S); o.y = pk4_fp8(s[4 * 65] * W8_S, s[5 * 65] * W8_S, s[6 * 65] * W8_S, s[7 * 65] * W8_S);
                o.z = pk4_fp8(s[8 * 65] * W8_S, s[9 * 65] * W8_S, s[10 * 65] * W8_S, s[11 * 65] * W8_S); o.w = pk4_fp8(s[12 * 65] * W8_S, s[13 * 65] * W8_S, s[14 * 65] * W8_S, s[15 * 65] * W8_S);
                const int drow = cvt_dstrow(J.perm, J.dstrow0 + n0 + n);
                *(u32x4*)(dst + (size_t)drow * J.K + k0 + 16 * c) = o;
            }
        } else {
            bf16_t* dst = (bf16_t*)(a->ws + J.dst_off) + (size_t)mat * J.dst_stride;
            const int c = lane & 7, nsub = lane >> 3;
#pragma unroll
            for (int jj = 0; jj < 8; ++jj) {
                const int n = nsub + 8 * jj; const LAS float* s = scr + (8 * c) * 65 + n;
                u32x4 o; o.x = pk2(s[0], s[65]); o.y = pk2(s[2 * 65], s[3 * 65]); o.z = pk2(s[4 * 65], s[5 * 65]); o.w = pk2(s[6 * 65], s[7 * 65]);
                const int drow = cvt_dstrow(J.perm, J.dstrow0 + n0 + n);
                *(u32x4*)(dst + (size_t)drow * J.K + k0 + 8 * c) = o;
            }
        }
        asm volatile("s_waitcnt lgkmcnt(0)" ::: "memory");
    }
#undef PRO_DECODE
    {
        const float* p = a->in[I_P]; bf16_t* pb = (bf16_t*)(a->ws + WS_PBF);
        const size_t n8 = (size_t)DEPTH * T * 256 / 8;
        for (size_t i = (size_t)blockIdx.x * 512 + tid; i < n8; i += (size_t)gridDim.x * 512) {
            const f32x4 v0 = *(const f32x4*)(p + i * 8), v1 = *(const f32x4*)(p + i * 8 + 4);
            *(u32x4*)(pb + i * 8) = pack8(v0, v1);
        }
    }
    if (blockIdx.x == 4 && tid < 512) { const int ev = tid >> 8, gi = (tid >> 6) & 3, d = tid & 63;
        const float* src = a->in[gi == 0 ? I_DAQN : gi == 1 ? I_DAKN : gi == 2 ? I_NSQN : I_NSKN];
        ((float*)(a->ws + WS_GAINS))[tid] = src[ev * 64 + d]; }
    if (blockIdx.x < 4 && tid < 256) {
        const int m = blockIdx.x; const float* pe = a->in[I_CMPPE] + (size_t)m * 2048; const float* w1 = a->in[I_CMPW1] + (size_t)m * 2048 * 256;
        float s = 0.f;
        for (int k = 0; k < 2048; ++k) s += pe[k] * w1[(size_t)k * 256 + tid];
        ((float*)(a->ws + WS_BIAS1))[m * 256 + tid] = s;
    }
}

DI float row_load_ss(const float* row, int lane, f32x4 (&v)[4]) {
    float ss = 0.f;
#pragma unroll
    for (int j = 0; j < 4; ++j) { v[j] = *(const f32x4*)(row + 4 * lane + 256 * j); ss += (v[j][0] * v[j][0] + v[j][1] * v[j][1]) + (v[j][2] * v[j][2] + v[j][3] * v[j][3]); }
    return wave_sum(ss);
}
DI void row_store_bf16(bf16_t* row, int lane, const f32x4 (&v)[4]) {
#pragma unroll
    for (int j = 0; j < 4; ++j) { u32x2 o; o.x = pk2(v[j][0], v[j][1]); o.y = pk2(v[j][2], v[j][3]); *(u32x2*)(row + 4 * lane + 256 * j) = o; }
}
template <int MODE>
DI void phase_norm(const int WID, ArgsP a, LAS unsigned char* lds, int layer, const float* Hin) {
    const int tid = opaque_tid(WID), lane = tid & 63, wv = __builtin_amdgcn_readfirstlane(tid >> 6);
    LAS float* wt = (LAS float*)lds;
    LAS int* bcl = (LAS int*)(lds + MISC_OFF + MO_WCNT); LAS int* ent = (LAS int*)(lds + MISC_OFF + MO_ENT); LAS float* gat = (LAS float*)(lds + MISC_OFF + MO_GAT);
    LAS float* lgb = (LAS float*)(lds + MISC_OFF + MO_RED);
    bf16_t* XN = (bf16_t*)(a->ws + WS_XN);
    const float* gain = a->in[MODE == 2 ? I_N2G : I_N1G] + layer * 1024;
    constexpr int NQ = MODE == 0 ? 24 : (MODE == 2 ? 32 : 0);
    if (NQ > 0) {
        const float* w = (MODE == 0) ? a->in[I_EVWIN] + (size_t)(layer >> 1) * 1024 * EVIN + 2816 : a->in[I_ROUTW] + (size_t)layer * 1024 * 32;
        const int ldw = (MODE == 0) ? EVIN : 32;
        for (int i = tid; i < 256 * 32; i += 512) { const int q = i & 31, g = i >> 5;
            if (q < NQ) { f32x4 v; v[0] = w[(size_t)(4 * g) * ldw + q]; v[1] = w[(size_t)(4 * g + 1) * ldw + q]; v[2] = w[(size_t)(4 * g + 2) * ldw + q]; v[3] = w[(size_t)(4 * g + 3) * ldw + q];
                *(LAS f32x4*)(wt + q * 1024 + 4 * (g ^ q)) = v; } }
    }
    f32x4 gn[4];
#pragma unroll
    for (int j = 0; j < 4; ++j) gn[j] = *(const f32x4*)(gain + 4 * lane + 256 * j);
    const float rbias = (MODE == 2) ? a->in[I_ROUTB][layer * 32 + (lane & 31)] : 0.f;
    __syncthreads();
    for (int vb = blockIdx.x; vb < NTB; vb += gridDim.x) {
        if (MODE == 2) { if (tid < 32) bcl[tid] = 0; }
        const int t0 = vb * 128 + wv * 16;
        f32x4 na[4], nb[4];
#pragma unroll
        for (int j = 0; j < 4; ++j) { na[j] = *(const f32x4*)(Hin + (size_t)t0 * 1024 + 4 * lane + 256 * j); nb[j] = *(const f32x4*)(Hin + (size_t)(t0 + 1) * 1024 + 4 * lane + 256 * j); }
#pragma unroll 1
        for (int it = 0; it < 8; ++it) {
            const int ta = t0 + 2 * it;
            f32x4 va[4], vc[4];
#pragma unroll
            for (int j = 0; j < 4; ++j) { va[j] = na[j]; vc[j] = nb[j]; }
            if (it < 7) {
#pragma unroll
                for (int j = 0; j < 4; ++j) { na[j] = *(const f32x4*)(Hin + (size_t)(ta + 2) * 1024 + 4 * lane + 256 * j); nb[j] = *(const f32x4*)(Hin + (size_t)(ta + 3) * 1024 + 4 * lane + 256 * j); }
            }
            float sa = 0.f, sb = 0.f;
#pragma unroll
            for (int j = 0; j < 4; ++j) { sa += (va[j][0] * va[j][0] + va[j][1] * va[j][1]) + (va[j][2] * va[j][2] + va[j][3] * va[j][3]); sb += (vc[j][0] * vc[j][0] + vc[j][1] * vc[j][1]) + (vc[j][2] * vc[j][2] + vc[j][3] * vc[j][3]); }
#pragma unroll
            for (int o = 1; o < 64; o <<= 1) { sa += shx(sa, o); sb += shx(sb, o); }
            const float ra = rsqrtf(sa * (1.0f / 1024.0f) + EPS), rb2 = rsqrtf(sb * (1.0f / 1024.0f) + EPS);
#pragma unroll
            for (int j = 0; j < 4; ++j) { va[j] = va[j] * ra * gn[j]; vc[j] = vc[j] * rb2 * gn[j]; }
            row_store_bf16(XN + (size_t)ta * 1024, lane, va); row_store_bf16(XN + (size_t)(ta + 1) * 1024, lane, vc);
            if (NQ > 0) {
                float x[64];
#pragma unroll
                for (int q = 0; q < 32; ++q) {
                    if (q < NQ) { float s0 = 0.f, s1 = 0.f;
#pragma unroll
                        for (int j = 0; j < 4; ++j) { const f32x4 ww = *(const LAS f32x4*)(wt + q * 1024 + 4 * ((lane + 64 * j) ^ q));
                            s0 += (va[j][0] * ww[0] + va[j][1] * ww[1]) + (va[j][2] * ww[2] + va[j][3] * ww[3]); s1 += (vc[j][0] * ww[0] + vc[j][1] * ww[1]) + (vc[j][2] * ww[2] + vc[j][3] * ww[3]); }
                        x[q] = s0; x[32 + q] = s1;
                        if ((q & 3) == 3) asm volatile("" ::: "memory");
                    } else { x[q] = 0.f; x[32 + q] = 0.f; }
                }
#define RS_STEP(N, BIT) _Pragma("unroll") for (int i = 0; i < (N); ++i) { const bool up = (lane & (BIT)) != 0; const float keep = up ? x[(N) + i] : x[i], send = up ? x[i] : x[(N) + i]; x[i] = keep + shx(send, (BIT)); }
                RS_STEP(32, 32) RS_STEP(16, 16) RS_STEP(8, 8) RS_STEP(4, 4) RS_STEP(2, 2) RS_STEP(1, 1)
#undef RS_STEP
                const float val = x[0];
                if (MODE == 0) { if ((lane & 31) < 24) ((float*)(a->ws + WS_GATES))[(size_t)(ta + (lane >> 5)) * 24 + (lane & 31)] = sigm(val); }
                if (MODE == 2) {
                    lgb[wv * 64 + lane] = val + rbias;
                    asm volatile("s_waitcnt lgkmcnt(0)" ::: "memory");
                    float lg[32];
#pragma unroll
                    for (int q4 = 0; q4 < 8; ++q4) { const f32x4 t4 = *(const LAS f32x4*)(lgb + wv * 64 + (lane & 32) + 4 * q4); lg[4 * q4] = t4[0]; lg[4 * q4 + 1] = t4[1]; lg[4 * q4 + 2] = t4[2]; lg[4 * q4 + 3] = t4[3]; }
                    unsigned used = 0u; int te[4]; float tv[4];
#pragma unroll
                    for (int k = 0; k < 4; ++k) { float best = -3.0e38f; int bi = 0;
#pragma unroll
                        for (int q = 0; q < 32; ++q) { const bool ok = !((used >> q) & 1u) && (lg[q] > best); best = ok ? lg[q] : best; bi = ok ? q : bi; }
                        used |= 1u << bi; te[k] = bi; tv[k] = best; }
                    float ex[4], sum = 0.f;
#pragma unroll
                    for (int k = 0; k < 4; ++k) { ex[k] = __expf(tv[k] - tv[0]); sum += ex[k]; }
                    const float rs = 1.0f / sum;
                    if ((lane & 31) == 0) {
                        const int eb = wv * 64 + (2 * it + (lane >> 5)) * 4;
#pragma unroll
                        for (int k = 0; k < 4; ++k) { ent[eb + k] = te[k]; gat[eb + k] = ex[k] * rs; }
                    }
                    asm volatile("s_waitcnt lgkmcnt(0)" ::: "memory");
                }
            }
        }
        if (MODE == 2) {
            __syncthreads();
            { const int e = ent[wv * 64 + lane];
              const int pos = __hip_atomic_fetch_add(bcl + e, 1, __ATOMIC_RELAXED, __HIP_MEMORY_SCOPE_WORKGROUP);
              const size_t idx = (size_t)(vb * 128 + wv * 16) * 4 + lane;
              ((int*)(a->ws + WS_TOPE))[idx] = e; ((int*)(a->ws + WS_POSB))[idx] = pos; ((float*)(a->ws + WS_GATEW))[idx] = gat[wv * 64 + lane]; }
            __syncthreads();
            if (tid < 32) ((int*)(a->ws + WS_BCNT))[((size_t)layer * NTB + vb) * 32 + tid] = bcl[tid];
            __syncthreads();
        }
    }
}
DI void moe_tables(const int WID, ArgsP a, LAS unsigned char* lds, int layer, int vb) {
    const int tid = opaque_tid(WID);
    LAS int* tot = (LAS int*)(lds + MISC_OFF + MO_TOT); LAS int* base = (LAS int*)(lds + MISC_OFF + MO_BASE); LAS int* ts = (LAS int*)(lds + MISC_OFF + MO_TS);
    LAS int* red = (LAS int*)(lds + MISC_OFF + MO_RED);
    const int* bc = (const int*)(a->ws + WS_BCNT) + (size_t)layer * NTB * 32;
    { const int e = tid & 31, part = tid >> 5; int st = 0, sp = 0;
      for (int blk = part; blk < NTB; blk += 16) { const int v = bc[blk * 32 + e]; st += v; sp += (blk < vb) ? v : 0; }
      red[part * 32 + e] = st; red[512 + part * 32 + e] = sp; }
    __syncthreads();
    if (tid < 32) { int st = 0, sp = 0;
#pragma unroll
        for (int p = 0; p < 16; ++p) { st += red[p * 32 + tid]; sp += red[512 + p * 32 + tid]; }
        tot[tid] = st; base[tid] = sp; }
    __syncthreads();
    if (tid == 0) { int acc = 0; for (int e = 0; e < 32; ++e) { ts[e] = acc; acc += (tot[e] + 255) >> 8; } ts[32] = acc; }
    __syncthreads();
}
DI void phase_moe_slots(const int WID, ArgsP a, LAS unsigned char* lds, int layer) {
    const int tid = opaque_tid(WID), lane = tid & 63, wv = tid >> 6;
    LAS int* base = (LAS int*)(lds + MISC_OFF + MO_BASE); LAS int* ts = (LAS int*)(lds + MISC_OFF + MO_TS);
    const bf16_t* XN = (const bf16_t*)(a->ws + WS_XN); unsigned char* XB = (unsigned char*)(a->ws + WS_XB);
    for (int vb = blockIdx.x; vb < NTB; vb += gridDim.x) {
        moe_tables(WID, a, lds, layer, vb);
#pragma unroll 1
        for (int i = 0; i < 16; ++i) {
            const int t = vb * 128 + wv * 16 + i;
            int dest = 0;
            if (lane < 4) { const int e = ((const int*)(a->ws + WS_TOPE))[(size_t)t * 4 + lane], pos = ((const int*)(a->ws + WS_POSB))[(size_t)t * 4 + lane];
                dest = ts[e] * 256 + base[e] + pos; ((int*)(a->ws + WS_DEST))[(size_t)t * 4 + lane] = dest; }
            const u32x4 r0 = *(const u32x4*)(XN + (size_t)t * 1024 + 8 * lane), r1 = *(const u32x4*)(XN + (size_t)t * 1024 + 512 + 8 * lane);
            u32x2 q0, q1;
            q0.x = pk4_fp8(bflo(r0.x), bfhi(r0.x), bflo(r0.y), bfhi(r0.y)); q0.y = pk4_fp8(bflo(r0.z), bfhi(r0.z), bflo(r0.w), bfhi(r0.w));
            q1.x = pk4_fp8(bflo(r1.x), bfhi(r1.x), bflo(r1.y), bfhi(r1.y)); q1.y = pk4_fp8(bflo(r1.z), bfhi(r1.z), bflo(r1.w), bfhi(r1.w));
#pragma unroll
            for (int k = 0; k < 4; ++k) { const int d = __builtin_amdgcn_readlane(dest, k); unsigned char* o = XB + (size_t)d * 1024; *(u32x2*)(o + 8 * lane) = q0; *(u32x2*)(o + 512 + 8 * lane) = q1; }
        }
        __syncthreads();
    }
}
DI void phase_combine(const int WID, ArgsP a, float* H) {
    const int tid = opaque_tid(WID), lane = tid & 63, wv = tid >> 6;
    const bf16_t* YB = (const bf16_t*)(a->ws + WS_YB); unsigned char* XN8 = (unsigned char*)(a->ws + WS_XN);
    for (int t = blockIdx.x * 8 + wv; t < T; t += gridDim.x * 8) {
        int dest = 0; float gw = 0.f;
        if (lane < 4) { dest = ((const int*)(a->ws + WS_DEST))[(size_t)t * 4 + lane]; gw = ((const float*)(a->ws + WS_GATEW))[(size_t)t * 4 + lane]; }
        f32x4 v[4];
#pragma unroll
        for (int j = 0; j < 4; ++j) v[j] = *(const f32x4*)(H + (size_t)t * 1024 + 4 * lane + 256 * j);
#pragma unroll
        for (int k = 0; k < 4; ++k) { const int d = __builtin_amdgcn_readlane(dest, k); const float g = __builtin_bit_cast(float, __builtin_amdgcn_readlane(__builtin_bit_cast(int, gw), k)); const bf16_t* y = YB + (size_t)d * 1024;
#pragma unroll
            for (int j = 0; j < 4; ++j) { const u32x2 w = *(const u32x2*)(y + 4 * lane + 256 * j); v[j][0] += g * bflo(w.x); v[j][1] += g * bfhi(w.x); v[j][2] += g * bflo(w.y); v[j][3] += g * bfhi(w.y); } }
        float ss = 0.f;
#pragma unroll
        for (int j = 0; j < 4; ++j) { *(f32x4*)(H + (size_t)t * 1024 + 4 * lane + 256 * j) = v[j]; ss += (v[j][0] * v[j][0] + v[j][1] * v[j][1]) + (v[j][2] * v[j][2] + v[j][3] * v[j][3]); }
        ss = wave_sum(ss);
        const float rstd = rsqrtf(ss * (1.0f / 1024.0f) + EPS);
#pragma unroll
        for (int j = 0; j < 4; ++j) v[j] = v[j] * rstd;
#pragma unroll
        for (int j = 0; j < 4; ++j) *(unsigned*)(XN8 + (size_t)t * 1024 + 4 * lane + 256 * j) = pk4_fp8(v[j][0], v[j][1], v[j][2], v[j][3]);
    }
}
DI void phase_cmp2(const int WID, ArgsP a, LAS unsigned char* lds, int ev) {
    const int tid = opaque_tid(WID), lane = tid & 63, wv = __builtin_amdgcn_readfirstlane(tid >> 6);
    const bf16_t* HID = (const bf16_t*)(a->ws + WS_HID); bf16_t* KCMP = (bf16_t*)(a->ws + WS_KCMP); bf16_t* VCMPT = (bf16_t*)(a->ws + WS_VCMPT);
    const float kg = a->in[I_NSKN][ev * 64 + lane];
    LAS float* wl = (LAS float*)lds;
    for (int i = tid; i < 2 * 256 * 64 / 4; i += 512) *(LAS f32x4*)(wl + 4 * i) = *(const f32x4*)(a->in[I_CMPW2] + (size_t)ev * 2 * 256 * 64 + 4 * i);
    __syncthreads();
    for (int gi = blockIdx.x * 8 + wv; gi < 2048; gi += gridDim.x * 8) {
        const int kv = gi >> 10, row0 = (gi & 1023) * 4;
        const bf16_t* hrow = HID + ((size_t)kv * 4096 + row0) * 256;
        const LAS float* w2 = wl + kv * 256 * 64 + lane;
        float s[4] = {0.f, 0.f, 0.f, 0.f};
#pragma unroll 2
        for (int k = 0; k < 256; k += 8) {
            u32x4 hw[4];
#pragma unroll
            for (int r = 0; r < 4; ++r) hw[r] = *(const u32x4*)(hrow + r * 256 + k);
            float wv8[8];
#pragma unroll
            for (int j = 0; j < 8; ++j) wv8[j] = w2[(k + j) * 64];
#pragma unroll
            for (int r = 0; r < 4; ++r)
                s[r] += bflo(hw[r].x) * wv8[0] + bfhi(hw[r].x) * wv8[1] + bflo(hw[r].y) * wv8[2] + bfhi(hw[r].y) * wv8[3] + bflo(hw[r].z) * wv8[4] + bfhi(hw[r].z) * wv8[5] + bflo(hw[r].w) * wv8[6] + bfhi(hw[r].w) * wv8[7];
        }
#pragma unroll
        for (int r = 0; r < 4; ++r) {
            const int row = row0 + r, bg = row >> 7, n = row & 127;
            float v = (n == 127) ? 0.f : s[r];
            if (kv == 0) { const float ss = wave_sum(v * v); const float o = v * rsqrtf(ss * (1.0f / 64.0f) + EPS) * kg;
                KCMP[((size_t)bg * 128 + n) * 64 + lane] = (bf16_t)(pk2(o, 0.f) & 0xffffu); }
            else VCMPT[((size_t)bg * 96 + lane) * 128 + n] = (bf16_t)(pk2(v, 0.f) & 0xffffu);
        }
    }
    for (int i = blockIdx.x * 512 + tid; i < 32 * 32 * 128; i += gridDim.x * 512) {
        const int n = i & 127, j = (i >> 7) & 31, bg = i >> 12;
        float o = 0.f;
        if (n < 127) { const int d = n - 4 * j; if (d >= 0 && d <= 2) o = 1.0f; else if (d == 3 || d == -1) o = 0.5f; }
        VCMPT[((size_t)bg * 96 + 64 + j) * 128 + n] = (bf16_t)(pk2(o, 0.f) & 0xffffu);
    }
}
DI void phase_topk(const int WID, ArgsP a) {
    const float* IMPH = (const float*)(a->ws + WS_IMPH); unsigned* SELM = (unsigned*)(a->ws + WS_SELM);
    for (int i = blockIdx.x * 512 + opaque_tid(WID); i < T * 2; i += gridDim.x * 512) {
        const int t = i >> 1, g = i & 1, b = t >> 11, s = t & 2047, cur = s >> 6;
        float sc[32];
#pragma unroll
        for (int j4 = 0; j4 < 8; ++j4) { f32x4 acc = {0.f, 0.f, 0.f, 0.f};
#pragma unroll
            for (int r = 0; r < 4; ++r) acc += *(const f32x4*)(IMPH + ((size_t)t * 8 + g * 4 + r) * 32 + 4 * j4);
#pragma unroll
            for (int q = 0; q < 4; ++q) sc[4 * j4 + q] = acc[q]; }
        unsigned mask;
        if (cur < 16) mask = (cur == 31) ? 0xffffffffu : ((2u << cur) - 1u);
        else {
#pragma unroll
            for (int j = 0; j < 32; ++j) { const bool forced = (j == 0) || (j == cur) || (j == cur - 1); sc[j] = (j > cur) ? NEGF : (sc[j] + (forced ? 1e4f : 0.f)); }
            mask = 0u;
#pragma unroll
            for (int j = 0; j < 32; ++j) { int rank = 0;
#pragma unroll
                for (int k = 0; k < 32; ++k) rank += ((sc[k] > sc[j]) || (sc[k] == sc[j] && k < j)) ? 1 : 0;
                mask |= (rank < 16) ? (1u << j) : 0u; }
        }
        SELM[((size_t)(b * 2 + g)) * 2048 + s] = mask;
    }
}
DI void phase_mixprep(const int WID, ArgsP a, int layer) {
    const int tid = opaque_tid(WID), lane = tid & 63, wv = tid >> 6, ev = layer >> 1;
    const float* dl = a->in[I_DALAM] + ev * 256;
    const float s1 = wave_sum(dl[lane] * dl[64 + lane]), s2 = wave_sum(dl[128 + lane] * dl[192 + lane]);
    const float lam_init = 0.8f - 0.6f * expf(-0.3f * (float)layer);
    const float lam = expf(s1) - expf(s2) + lam_init;
    const float* og = a->in[I_DAOUTG] + ev * 128;
    const bf16_t* OD = (const bf16_t*)(a->ws + WS_OD); const bf16_t* OC = (const bf16_t*)(a->ws + WS_OC); const bf16_t* OS = (const bf16_t*)(a->ws + WS_OS); const bf16_t* OW = (const bf16_t*)(a->ws + WS_OW);
    const float* GT = (const float*)(a->ws + WS_GATES); bf16_t* AMIX = (bf16_t*)(a->ws + WS_AMIX);
    const int h = lane >> 4, dv = (lane & 15) * 8;
    f32x4 g0 = *(const f32x4*)(og + dv), g1 = *(const f32x4*)(og + dv + 4);
    for (int t = blockIdx.x * 8 + wv; t < T; t += gridDim.x * 8) {
        { const u32x4 w1 = *(const u32x4*)(OD + (size_t)t * 1024 + h * 128 + dv), w2 = *(const u32x4*)(OD + (size_t)t * 1024 + (4 + h) * 128 + dv);
          f32x4 d0, d1;
          d0[0] = bflo(w1.x) - lam * bflo(w2.x); d0[1] = bfhi(w1.x) - lam * bfhi(w2.x); d0[2] = bflo(w1.y) - lam * bflo(w2.y); d0[3] = bfhi(w1.y) - lam * bfhi(w2.y);
          d1[0] = bflo(w1.z) - lam * bflo(w2.z); d1[1] = bfhi(w1.z) - lam * bfhi(w2.z); d1[2] = bflo(w1.w) - lam * bflo(w2.w); d1[3] = bfhi(w1.w) - lam * bfhi(w2.w);
          float ss = (d0[0] * d0[0] + d0[1] * d0[1]) + (d0[2] * d0[2] + d0[3] * d0[3]) + (d1[0] * d1[0] + d1[1] * d1[1]) + (d1[2] * d1[2] + d1[3] * d1[3]);
          ss += shx(ss, 1); ss += shx(ss, 2); ss += shx(ss, 4); ss += shx(ss, 8);
          const float rs = rsqrtf(ss * (1.0f / 128.0f) + EPS) * (1.0f - lam_init);
          *(u32x4*)(AMIX + (size_t)t * 1024 + h * 128 + dv) = pack8(d0 * rs * g0, d1 * rs * g1); }
        { const int hd = lane >> 3, dq = (lane & 7) * 8; const size_t o = (size_t)t * 512 + hd * 64 + dq;
          const float ga = GT[(size_t)t * 24 + hd * 3], gb = GT[(size_t)t * 24 + hd * 3 + 1], gc = GT[(size_t)t * 24 + hd * 3 + 2];
          const u32x4 c = *(const u32x4*)(OC + o), s = *(const u32x4*)(OS + o), w = *(const u32x4*)(OW + o);
          f32x4 r0, r1;
          r0[0] = ga * bflo(c.x) + gb * bflo(s.x) + gc * bflo(w.x); r0[1] = ga * bfhi(c.x) + gb * bfhi(s.x) + gc * bfhi(w.x);
          r0[2] = ga * bflo(c.y) + gb * bflo(s.y) + gc * bflo(w.y); r0[3] = ga * bfhi(c.y) + gb * bfhi(s.y) + gc * bfhi(w.y);
          r1[0] = ga * bflo(c.z) + gb * bflo(s.z) + gc * bflo(w.z); r1[1] = ga * bfhi(c.z) + gb * bfhi(s.z) + gc * bfhi(w.z);
          r1[2] = ga * bflo(c.w) + gb * bflo(s.w) + gc * bflo(w.w); r1[3] = ga * bfhi(c.w) + gb * bfhi(s.w) + gc * bfhi(w.w);
          *(u32x4*)(AMIX + (size_t)t * 1024 + 512 + hd * 64 + dq) = pack8(r0, r1); }
    }
}
DI void phase_scan(const int WID, ArgsP a) {
    const bf16_t* UT = (const bf16_t*)(a->ws + WS_UT); bf16_t* VS = (bf16_t*)(a->ws + WS_VS);
    for (int i = blockIdx.x * 512 + opaque_tid(WID); i < 64 * 512 * 32; i += gridDim.x * 512) {
        const int d8 = i & 31, f = (i >> 5) & 511, bh = i >> 14, h = bh & 3;
        const float dec = exp2f(256.0f * ret_lg2(h));
        f32x4 S0 = {0.f, 0.f, 0.f, 0.f}, S1 = S0;
        u32x4 un = *(const u32x4*)(UT + ((size_t)bh * 8) * 131072 + (size_t)f * 256 + 8 * d8);
#pragma unroll 1
        for (int n = 0; n < 8; ++n) {
            const size_t z = (size_t)bh * 8 + n;
            const u32x4 u = un;
            if (n < 7) un = *(const u32x4*)(UT + (z + 1) * 131072 + (size_t)f * 256 + 8 * d8);
            *(u32x4*)(VS + (z * 512 + f) * 512 + 256 + 8 * d8) = pack8(S0, S1);
            S0[0] = (S0[0] + bflo(u.x)) * dec; S0[1] = (S0[1] + bfhi(u.x)) * dec; S0[2] = (S0[2] + bflo(u.y)) * dec; S0[3] = (S0[3] + bfhi(u.y)) * dec;
            S1[0] = (S1[0] + bflo(u.z)) * dec; S1[1] = (S1[1] + bfhi(u.z)) * dec; S1[2] = (S1[2] + bflo(u.w)) * dec; S1[3] = (S1[3] + bfhi(u.w)) * dec;
        }
    }
}
DI void phase_normgate(const int WID, ArgsP a, int od) {
    const int tid = opaque_tid(WID), lane = tid & 63, wv = tid >> 6;
    const bf16_t* Y = (const bf16_t*)(a->ws + WS_Y); const bf16_t* GG = (const bf16_t*)(a->ws + WS_GG); bf16_t* YG = (bf16_t*)(a->ws + WS_YG);
    const float* og = a->in[I_RETG] + od * 512;
    const f32x4 g0 = *(const f32x4*)(og + 8 * lane), g1 = *(const f32x4*)(og + 8 * lane + 4);
    for (int t = blockIdx.x * 8 + wv; t < T; t += gridDim.x * 8) {
#pragma unroll
        for (int h = 0; h < 4; ++h) {
            const size_t o = (size_t)t * 2048 + h * 512 + 8 * lane;
            const u32x4 yw = *(const u32x4*)(Y + o), gw = *(const u32x4*)(GG + o);
            f32x4 y0 = {bflo(yw.x), bfhi(yw.x), bflo(yw.y), bfhi(yw.y)}, y1 = {bflo(yw.z), bfhi(yw.z), bflo(yw.w), bfhi(yw.w)};
            const f32x4 q0 = {bflo(gw.x), bfhi(gw.x), bflo(gw.y), bfhi(gw.y)}, q1 = {bflo(gw.z), bfhi(gw.z), bflo(gw.w), bfhi(gw.w)};
            float ss = (y0[0] * y0[0] + y0[1] * y0[1]) + (y0[2] * y0[2] + y0[3] * y0[3]) + (y1[0] * y1[0] + y1[1] * y1[1]) + (y1[2] * y1[2] + y1[3] * y1[3]);
            ss = wave_sum(ss);
            const float rs = rsqrtf(ss * (1.0f / 512.0f) + EPS);
            *(u32x4*)(YG + o) = pack8(y0 * rs * g0 * q0, y1 * rs * g1 * q1);
        }
    }
}
DI int snake_unit(int rnd, int G, int c) { return (rnd & 1) ? rnd * G + (G - 1 - c) : rnd * G + c; }
DI float absmax64(const float* g, int lane) { float m = fabsf(g[lane]);
#pragma unroll
    for (int o = 1; o < 64; o <<= 1) m = fmaxf(m, shx(m, o));
    return m; }
constexpr int CW_AQ = 8192;
template <int MODE>
DI void phase_attn(const int WID, ArgsP a, LAS unsigned char* lds, int ev) {
    const int tid = opaque_tid(WID), lane = tid & 63;
    const bf16_t* QD = (const bf16_t*)(a->ws + WS_QD); const bf16_t* KD = (const bf16_t*)(a->ws + WS_KD); const bf16_t* QN = (const bf16_t*)(a->ws + WS_QN);
    LAS int* ord = (LAS int*)(lds + MISC_OFF + MO_ENT); LAS int* cst = (LAS int*)(lds + MISC_OFF + MO_GAT); volatile LAS int* cur = (volatile LAS int*)(lds + MISC_OFF + MO_TOT);
    float sb2 = 0.f;
    if (MODE != 3) { const float gq = absmax64(a->in[MODE == 0 ? I_DAQN : I_NSQN] + ev * 64, lane), gk = absmax64(a->in[MODE == 0 ? I_DAKN : I_NSKN] + ev * 64, lane);
        sb2 = 16.0f * gq * gk + 28.0f; }
    if (tid < 64) { const int qb = tid >> 3, hd = tid & 7, q0 = qb * 256; int lo = 0, hi = 4 * qb + 4;
        if (MODE == 3) { lo = 0; hi = 2; }
        else { const float slope = (MODE == 0) ? exp2f(-2.0f * (float)((hd & 3) + 1)) : exp2f(-(float)(hd + 1)); const int dcut = (int)fminf(sb2 / slope + 1.0f, 100000.0f);
            const int kmin = q0 - dcut; lo = kmin > 0 ? (kmin >> 6) : 0;
            if (MODE == 2) { const int lk = q0 - 511; const int lw = lk > 0 ? (lk >> 6) : 0; lo = lw > lo ? lw : lo; } }
        cst[tid] = hi - lo; }
    __syncthreads();
    if (tid < 64) { const int mine = cst[tid]; int rank = 0;
        for (int j = 0; j < 64; ++j) { const int o = cst[j]; rank += (o > mine || (o == mine && j < tid)) ? 1 : 0; }
        ord[rank] = tid; }
    __syncthreads();
    unsigned* ctr = (unsigned*)(a->ws + WS_CTL) + CW_AQ + 64 * (ev * 4 + MODE);
    for (;;) {
        if (tid == 0) *cur = (int)__hip_atomic_fetch_add(ctr, 1u, __ATOMIC_RELAXED, __HIP_MEMORY_SCOPE_AGENT);
        __syncthreads();
        const int u = *cur; if (u >= 1024) break;
        const int combo = ord[u >> 4], b = u & 15, qb = combo >> 3, hd = combo & 7, q0 = qb * 256; const size_t t0 = (size_t)b * 2048 + q0;
        if (MODE == 0) {
            const float slope = exp2f(-2.0f * (float)((hd & 3) + 1)); const int dcut = (int)fminf(sb2 / slope + 1.0f, 100000.0f);
            attn_unit<128, 0>(WID, lds, QD + t0 * 512 + hd * 64, 512, KD + (size_t)b * 2048 * 512 + hd * 64, 512,
                              (const bf16_t*)(a->ws + WS_VAT) + (size_t)(b * 4 + (hd & 3)) * 128 * 2048, 2048, q0, slope, dcut, nullptr,
                              (bf16_t*)(a->ws + WS_OD) + t0 * 1024 + hd * 128, 1024, nullptr);
        } else if (MODE == 1 || MODE == 2) {
            const int g = hd >> 2; const float slope = exp2f(-(float)(hd + 1)); const int dcut = (int)fminf(sb2 / slope + 1.0f, 100000.0f);
            const bf16_t* Kb = (const bf16_t*)(a->ws + (MODE == 1 ? WS_KSB : WS_KWB)) + (size_t)(b * 2 + g) * 2048 * 64;
            const bf16_t* Vb = (const bf16_t*)(a->ws + (MODE == 1 ? WS_VST : WS_VWT)) + (size_t)(b * 2 + g) * 64 * 2048;
            attn_unit<64, MODE>(WID, lds, QN + t0 * 512 + hd * 64, 512, Kb, 64, Vb, 2048, q0, slope, dcut,
                                (const unsigned*)(a->ws + WS_SELM) + (size_t)(b * 2 + g) * 2048 + q0,
                                (bf16_t*)(a->ws + (MODE == 1 ? WS_OS : WS_OW)) + t0 * 512 + hd * 64, 512, nullptr);
        } else {
            const int g = hd >> 2;
            attn_unit<96, 3>(WID, lds, QN + t0 * 512 + hd * 64, 512, (const bf16_t*)(a->ws + WS_KCMP) + (size_t)(b * 2 + g) * 128 * 64, 64,
                             (const bf16_t*)(a->ws + WS_VCMPT) + (size_t)(b * 2 + g) * 96 * 128, 128, q0, 0.f, 0, nullptr,
                             (bf16_t*)(a->ws + WS_OC) + t0 * 512 + hd * 64, 512, (float*)(a->ws + WS_IMPH) + (t0 * 8 + hd) * 32);
        }
    }
}

constexpr int PPL = 15;
constexpr int NPHASE = 1 + DEPTH * PPL;
__global__ void __launch_bounds__(512, 2) mk_fwd(Args a_unused) {
    ArgsP a = opaque_args();
    extern __shared__ __attribute__((aligned(16))) unsigned char lds_raw[];
    LAS unsigned char* lds = (LAS unsigned char*)lds_raw;
    const int tid = threadIdx.x, G = gridDim.x, c = blockIdx.x;
    const int WID = __builtin_amdgcn_readfirstlane(tid >> 6);
    volatile LAS unsigned* misc = (volatile LAS unsigned*)(lds + MISC_OFF);
    if (tid < 4) misc[tid] = 0u;
    __syncthreads();
    unsigned* ctl = (unsigned*)(a->ws + WS_CTL);
    XcdBarrier bar; bar.bar = ctl + CW_BAR; bar.x = 0; bar.st = misc;
    const int ph_lo = a->ph_lo, ph_hi = a->ph_hi;
    const bool multi = (ph_hi - ph_lo) > 1;
    if (multi) bar = xcd_barrier_post(WID, ctl + CW_BAR, misc);
    bool first = true;
#define PHASE_BEGIN(k, id) if ((DBG_ONLY < 0 || DBG_ONLY == (id)) && (k) >= ph_lo && (k) < ph_hi && (k) <= DBG_LAST_PHASE) { if (!first) { xcd_barrier(WID, bar); if (PROBE_MASK >> 31) xcd_barrier(WID, bar); } first = false; \
        ArgsP a = opaque_args(); unsigned char* ws = a->ws; bf16_t* XN = (bf16_t*)(ws + WS_XN); float* H = a->out; const float* Hin = (layer == 0) ? a->in[I_X] : (const float*)H; \
        const LAS int* ts = (const LAS int*)(lds + MISC_OFF + MO_TS); (void)XN; (void)H; (void)Hin; (void)ts; \
        const bool probe_ = ((PROBE_MASK >> (id)) & 1u) != 0u; const unsigned long long pt0_ = probe_ ? __builtin_amdgcn_s_memrealtime() : 0ull;
#define PHASE_END if (probe_) { const unsigned long long pt1_ = __builtin_amdgcn_s_memrealtime(), pd_ = pt1_ - pt0_; while (__builtin_amdgcn_s_memrealtime() - pt1_ < pd_) __builtin_amdgcn_s_sleep(8); } }
    { const int layer = 0; PHASE_BEGIN(0, 0) phase_prologue(WID, a, lds); PHASE_END }
#pragma unroll 1
    for (int layer = 0; layer < DEPTH; ++layer) {
        const int pb = 1 + layer * PPL; const bool even = (layer & 1) == 0; const int ev = layer >> 1, od = layer >> 1;
        if (even) {
            PHASE_BEGIN(pb + 0, 1) phase_norm<0>(WID, a, lds, layer, Hin); PHASE_END
            PHASE_BEGIN(pb + 1, 2) {
                { ProbPlain P{XN, (const bf16_t*)(ws + WS_EVNAT) + (size_t)ev * 2048 * 1024, 1024, 1024, 1024}; pg8::Sched S; S.init(T / 256, 8, G, c);
                  EpiEvNat E{ws, (const float*)(ws + WS_GAINS) + ev * 256};
                  pg8::gemm_phase(WID, lds, P, S, E); }
                { ProbPlain P{(const bf16_t*)(ws + WS_EVSW) + (size_t)ev * 768 * 1024, XN, 1024, 1024, 1024}; pg8::Sched S; S.init(3, T / 256, G, c);
                  EpiEvSw E{ws};
                  pg8::gemm_phase(WID, lds, P, S, E); }
            } PHASE_END
            PHASE_BEGIN(pb + 2, 3) {
                { ProbCmp1 P{(const bf16_t*)(ws + WS_KCB), (const bf16_t*)(ws + WS_VCB), (const bf16_t*)(ws + WS_CMP1) + (size_t)ev * 2 * 256 * 2048, 1024, 2048, 2048}; pg8::Sched S; S.init(32, 1, G, c);
                  EpiCmp1 E{(bf16_t*)(ws + WS_HID), (const float*)(ws + WS_BIAS1) + ev * 512};
                  pg8::gemm_phase(WID, lds, P, S, E); }
                phase_attn<0>(WID, a, lds, ev);
                phase_attn<2>(WID, a, lds, ev);
            } PHASE_END
            PHASE_BEGIN(pb + 3, 4) phase_cmp2(WID, a, lds, ev); PHASE_END
            PHASE_BEGIN(pb + 4, 5) phase_attn<3>(WID, a, lds, ev); PHASE_END
            PHASE_BEGIN(pb + 5, 6) phase_topk(WID, a); PHASE_END
            PHASE_BEGIN(pb + 6, 7) phase_attn<1>(WID, a, lds, ev); PHASE_END
            PHASE_BEGIN(pb + 7, 8) phase_mixprep(WID, a, layer); PHASE_END
            PHASE_BEGIN(pb + 8, 9) {
                ProbPlain P{(const bf16_t*)(ws + WS_AMIX), (const bf16_t*)(ws + WS_EVOUT) + (size_t)ev * 1024 * 1024, 1024, 1024, 1024}; pg8::Sched S; S.init(T / 256, 4, G, c);
                EpiResid E{Hin, H}; pg8::gemm_phase(WID, lds, P, S, E);
            } PHASE_END
        } else {
            PHASE_BEGIN(pb + 0, 11) phase_norm<1>(WID, a, lds, layer, Hin); PHASE_END
            PHASE_BEGIN(pb + 1, 12) {
                { ProbPlain P{XN, (const bf16_t*)(ws + WS_ODNAT) + (size_t)od * 4096 * 1024, 1024, 1024, 1024}; pg8::Sched S; S.init(T / 256, 16, G, c);
                  EpiOdNat E{ws}; pg8::gemm_phase(WID, lds, P, S, E); }
                { ProbPlain P{(const bf16_t*)(ws + WS_ODSW) + (size_t)od * 3072 * 1024, XN, 1024, 1024, 1024}; pg8::Sched S; S.init(12, T / 256, G, c);
                  EpiOdSw E{ws}; pg8::gemm_phase(WID, lds, P, S, E); }
            } PHASE_END
            PHASE_BEGIN(pb + 2, 13) {
                { ProbUT P{(const bf16_t*)(ws + WS_VS), (const bf16_t*)(ws + WS_KT), 512, 256, 256}; SchedSeq S; S.init(G, c);
                  EpiUTScan E{(bf16_t*)(ws + WS_VS)}; pg8::gemm_phase(WID, lds, P, S, E); }
                { ProbAtt P{(const bf16_t*)(ws + WS_AQ), (const bf16_t*)(ws + WS_KP), 2048, 1024, 256}; pg8::Sched S; const int nb = G / 2 > 0 ? G / 2 : 1;
                  if (c >= nb || G < 2) S.init(512, 1, G < 2 ? 1 : G - nb, G < 2 ? 0 : c - nb); else S.init(0, 1, 1, 0);
                  EpiAtt E{(bf16_t*)(ws + WS_AQ)}; pg8::gemm_phase(WID, lds, P, S, E); }
            } PHASE_END
            PHASE_BEGIN(pb + 4, 15) {
                ProbY P{(const bf16_t*)(ws + WS_AQ), (const bf16_t*)(ws + WS_VS), 2048, 512, 512}; pg8::Sched S; S.init(512, 2, G, c);
                EpiY E{(bf16_t*)(ws + WS_Y)}; pg8::gemm_phase(WID, lds, P, S, E);
            } PHASE_END
            PHASE_BEGIN(pb + 5, 16) phase_normgate(WID, a, od); PHASE_END
            PHASE_BEGIN(pb + 8, 19) {
                ProbPlain P{(const bf16_t*)(ws + WS_YG), (const bf16_t*)(ws + WS_ODOUT) + (size_t)od * 1024 * 2048, 2048, 2048, 2048}; pg8::Sched S; S.init(T / 256, 4, G, c);
                EpiResid E{Hin, H}; pg8::gemm_phase(WID, lds, P, S, E);
            } PHASE_END
        }
        PHASE_BEGIN(pb + 9, 20) phase_norm<2>(WID, a, lds, layer, H); PHASE_END
        PHASE_BEGIN(pb + 10, 21) phase_moe_slots(WID, a, lds, layer); PHASE_END
        PHASE_BEGIN(pb + 11, 22) {
            moe_tables(WID, a, lds, layer, -1);
            { ProbMoe8 P{(const unsigned char*)(ws + WS_XB), (const unsigned char*)(ws + WS_WGU) + (size_t)layer * 32 * 2048 * 1024, ts, 2048, 512, 512, 512}; pg8::Sched S; S.init(ts[32], 8, G, c);
              EpiGU E{(unsigned char*)(ws + WS_ACT), a->in[I_BGU] + (size_t)layer * 32 * 2048, ts}; pg8::gemm_phase(WID, lds, P, S, E); }
            { ProbPlain P{(const bf16_t*)(ws + WS_PBF) + (size_t)layer * T * 256, (const bf16_t*)(ws + WS_WPP) + (size_t)layer * 1024 * 256, 256, 256, 256}; pg8::Sched S; S.init(T / 256, 4, G, c);
              EpiPP E{(bf16_t*)(ws + WS_PP)}; pg8::gemm_phase(WID, lds, P, S, E); }
        } PHASE_END
        PHASE_BEGIN(pb + 12, 23) {
            moe_tables(WID, a, lds, layer, -1);
            ProbMoe8 P{(const unsigned char*)(ws + WS_ACT), (const unsigned char*)(ws + WS_WDN) + (size_t)layer * 32 * 1024 * 1024, ts, 1024, 512, 512, 512}; pg8::Sched S; S.init(ts[32], 4, G, c);
            EpiDN E{(bf16_t*)(ws + WS_YB), a->in[I_BDN] + (size_t)layer * 32 * 1024, ts}; pg8::gemm_phase(WID, lds, P, S, E);
        } PHASE_END
        PHASE_BEGIN(pb + 13, 24) phase_combine(WID, a, H); PHASE_END
        PHASE_BEGIN(pb + 14, 25) {
            ProbPlain8 P{(const unsigned char*)(ws + WS_XN), (const unsigned char*)(ws + WS_WPG) + (size_t)layer * 1024 * 1024, 512, 512, 512}; pg8::Sched S; S.init(T / 256, 4, G, c);
            EpiPLE E{H, (const bf16_t*)(ws + WS_PP)}; pg8::gemm_phase(WID, lds, P, S, E);
        } PHASE_END
    }
#undef PHASE_BEGIN
#undef PHASE_END
}

extern "C" void kernel_launch(void* const* d_in, const int* in_sizes, int n_in, void* d_out, int out_size, void* d_ws, size_t ws_size, hipStream_t stream) {
    static int grid = 0;
    if (grid == 0) {
        if (n_in != 26 || out_size != T * D || ws_size < WS_END) { fprintf(stderr, "kernel_launch: unexpected problem (n_in %d, out %d, ws %zu < %zu); nothing launched\n", n_in, out_size, ws_size, (size_t)WS_END); grid = -1; return; }
        int dev = 0, cus = 0, per_cu = 0;
        if (hipGetDevice(&dev) != hipSuccess || hipDeviceGetAttribute(&cus, hipDeviceAttributeMultiprocessorCount, dev) != hipSuccess) { grid = -1; return; }
        if (hipFuncSetAttribute((const void*)mk_fwd, hipFuncAttributeMaxDynamicSharedMemorySize, LDS_BYTES) != hipSuccess) { fprintf(stderr, "kernel_launch: hipFuncSetAttribute failed\n"); grid = -1; return; }
        if (hipOccupancyMaxActiveBlocksPerMultiprocessor(&per_cu, (const void*)mk_fwd, 512, LDS_BYTES) != hipSuccess || per_cu < 1) fprintf(stderr, "kernel_launch: occupancy query reports %d\n", per_cu);
        (void)hipGetLastError();
        grid = cus > 256 ? 256 : cus;
    }
    if (grid < 0) return;
    (void)hipMemsetAsync((char*)d_ws + WS_CTL, 0, CTL_BYTES, stream);
    Args a; memset(&a, 0, sizeof(a));
    for (int i = 0; i < 26; ++i) a.in[i] = (const float*)d_in[i];
    a.out = (float*)d_out; a.ws = (unsigned char*)d_ws;
#if MK_SINGLE
    a.ph_lo = 0; a.ph_hi = NPHASE;
    hipLaunchKernelGGL(mk_fwd, dim3(grid), dim3(512), LDS_BYTES, stream, a);
#else
    for (int ph = 0; ph < NPHASE && ph <= DBG_LAST_PHASE; ++ph) {
        const int l = (ph - 1) / PPL, k = (ph - 1) % PPL;
        if (ph > 0 && (l & 1) && (k == 6 || k == 7)) continue;
        a.ph_lo = ph; a.ph_hi = ph + 1;
        hipLaunchKernelGGL(mk_fwd, dim3(grid), dim3(512), LDS_BYTES, stream, a);
    }
#endif
}
```

```cpp
#include <hip/hip_runtime.h>
#include <cstdio>
#include <cstdint>
#include <cstring>

#define LAS __attribute__((address_space(3)))
#define DI __device__ __forceinline__
typedef unsigned short bf16_t;
typedef short bf16x8 __attribute__((ext_vector_type(8)));
typedef short s16x4 __attribute__((ext_vector_type(4)));
typedef float f32x2 __attribute__((ext_vector_type(2)));
typedef float f32x4 __attribute__((ext_vector_type(4)));
typedef float f32x16 __attribute__((ext_vector_type(16)));
typedef unsigned u32x2 __attribute__((ext_vector_type(2)));
typedef unsigned u32x4 __attribute__((ext_vector_type(4)));
typedef __bf16 bfv2 __attribute__((ext_vector_type(2)));
typedef int i32x4 __attribute__((ext_vector_type(4)));
typedef int i32x8 __attribute__((ext_vector_type(8)));

#ifndef MK_SINGLE
#define MK_SINGLE 1
#endif
#ifndef DBG_ONLY
#define DBG_ONLY -1
#endif
#ifndef PROBE_MASK
#define PROBE_MASK 0u
#endif
#ifndef PROBE_ATT
#define PROBE_ATT 0
#endif
#ifndef PROBE_KREP
#define PROBE_KREP 1
#endif
#ifndef DBG_LAST_PHASE
#define DBG_LAST_PHASE 100000
#endif

constexpr int T = 32768, D = 1024, SEQ = 2048, NBATCH = 16, DEPTH = 4;
constexpr int EVIN = 2840, ODIN = 6144;
constexpr float EPS = 1e-6f, NEGF = -1e30f;
constexpr int NTB = 256;
constexpr int MOE_ROWS = (512 + 32) * 256;

constexpr size_t MiB = 1u << 20;
constexpr size_t WS_CTL = 0, CTL_BYTES = 1 * MiB;
constexpr int CW_BAR = 4096;
constexpr size_t WS_EVNAT = 2 * MiB, WS_EVSW = 10 * MiB, WS_EVOUT = 13 * MiB, WS_CMP1 = 17 * MiB, WS_ODNAT = 21 * MiB, WS_ODSW = 37 * MiB,
                 WS_ODOUT = 49 * MiB, WS_WPP = 57 * MiB, WS_WPG = 59 * MiB, WS_BIAS1 = 67 * MiB, WS_GAINS = 67 * MiB + 16384, WS_BCNT = 67 * MiB + 65536,
                 WS_WGU = 68 * MiB, WS_WDN = 580 * MiB;
constexpr size_t WS_XN = 840 * MiB, WS_PBF = 904 * MiB, WS_PP = 968 * MiB, WS_GATES = 1032 * MiB, WS_TOPE = 1035 * MiB, WS_POSB = 1036 * MiB,
                 WS_DEST = 1037 * MiB, WS_GATEW = 1038 * MiB, WS_SELM = 1039 * MiB;
constexpr size_t RA = 1040 * MiB;
constexpr size_t WS_QD = RA, WS_KD = RA + 32 * MiB, WS_QN = RA + 64 * MiB, WS_KCB = RA + 96 * MiB, WS_VCB = RA + 105 * MiB, WS_KSB = RA + 114 * MiB,
                 WS_KWB = RA + 122 * MiB, WS_VAT = RA + 130 * MiB, WS_VST = RA + 162 * MiB, WS_VWT = RA + 170 * MiB, WS_HID = RA + 178 * MiB,
                 WS_KCMP = RA + 182 * MiB, WS_VCMPT = RA + 183 * MiB, WS_OC = RA + 184 * MiB, WS_IMPH = RA + 216 * MiB, WS_OD = RA + 248 * MiB,
                 WS_OS = RA + 312 * MiB, WS_OW = RA + 344 * MiB, WS_AMIX = RA + 376 * MiB;
constexpr size_t WS_AQ = RA, WS_KP = RA + 128 * MiB, WS_KT = RA + 192 * MiB, WS_VS = RA + 256 * MiB, WS_GG = RA + 512 * MiB, WS_UT = RA + 640 * MiB,
                 WS_Y = RA + 896 * MiB, WS_YG = RA + 1024 * MiB;
constexpr size_t WS_XB = 2192 * MiB, WS_ACT = 2464 * MiB, WS_YB = 2736 * MiB, WS_END = 3008 * MiB;

constexpr int MISC_OFF = 139264, LDS_BYTES = 155648;
static_assert(MISC_OFF + 5888 + 4096 <= LDS_BYTES, "misc LDS words");
constexpr int MO_WCNT = 256, MO_ENT = 1280, MO_GAT = 3328, MO_TOT = 5376, MO_BASE = 5504, MO_TS = 5632, MO_RED = 5888;

DI int opaque_tid(int wid0) { int l; asm volatile("v_mbcnt_lo_u32_b32 %0, -1, 0\n\tv_mbcnt_hi_u32_b32 %0, -1, %0" : "=v"(l) :: "memory"); return (wid0 << 6) | l; }
DI int lane_now() { int l; asm volatile("v_mbcnt_lo_u32_b32 %0, -1, 0\n\tv_mbcnt_hi_u32_b32 %0, -1, %0" : "=v"(l)); return l; }
DI float shx(float v, int m) { return __builtin_bit_cast(float, __builtin_amdgcn_ds_bpermute((lane_now() ^ m) << 2, __builtin_bit_cast(int, v))); }
DI unsigned shxu(unsigned v, int m) { return (unsigned)__builtin_amdgcn_ds_bpermute((lane_now() ^ m) << 2, (int)v); }
DI unsigned pk2(float lo, float hi) { f32x2 v = {lo, hi}; return __builtin_bit_cast(unsigned, __builtin_convertvector(v, bfv2)); }
DI unsigned pk4_fp8(float a, float b, float c, float d) { int w = 0; w = __builtin_amdgcn_cvt_pk_fp8_f32(a, b, w, false); w = __builtin_amdgcn_cvt_pk_fp8_f32(c, d, w, true); return (unsigned)w; }
DI float bf2f(unsigned short b) { return __uint_as_float(((unsigned)b) << 16); }
DI float bflo(unsigned w) { return __uint_as_float(w << 16); }
DI float bfhi(unsigned w) { return __uint_as_float(w & 0xffff0000u); }
DI float wave_sum(float v) {
#pragma unroll
    for (int o = 1; o < 64; o <<= 1) v += shx(v, o);
    return v;
}
DI float sigm(float x) { return __builtin_amdgcn_rcpf(1.0f + __builtin_amdgcn_exp2f(-1.44269504089f * x)); }
DI u32x4 pack8(const f32x4& a, const f32x4& b) { u32x4 w; w.x = pk2(a[0], a[1]); w.y = pk2(a[2], a[3]); w.z = pk2(b[0], b[1]); w.w = pk2(b[2], b[3]); return w; }

#define XB_TMO      128
#define XB_XCNT(j)  (256  + 64 * (j))
#define XB_XSUB(j)  (1280 + 64 * (j))
#define XB_XGEN(j)  (2304 + 64 * (j))
#define XB_TOP      3328
#define XB_TOPGEN   3392
#define XCD_BAR_WORDS 3456
#define XB_SPIN_CAP (1u << 22)
DI unsigned xb_ld(unsigned* p)              { return __hip_atomic_load(p, __ATOMIC_RELAXED, __HIP_MEMORY_SCOPE_AGENT); }
DI unsigned xb_add(unsigned* p, unsigned v) { return __hip_atomic_fetch_add(p, v, __ATOMIC_RELAXED, __HIP_MEMORY_SCOPE_AGENT); }
DI unsigned xb_xcc_id() { return (unsigned)__builtin_amdgcn_s_getreg((3 << 11) | 20) & 0xFu; }
#define XB_SPIN(cond, bar) do { unsigned _sp = 0; while (cond) { __builtin_amdgcn_s_sleep(1); \
    if ((++_sp & 255u) == 0u) { if (xb_ld(&(bar)[XB_TMO])) break; if (_sp > XB_SPIN_CAP) { atomicAdd(&(bar)[XB_TMO], 1u); break; } } } } while (0)
struct XcdBarrier { unsigned* bar; unsigned x; volatile LAS unsigned* st; };
DI XcdBarrier xcd_barrier_post(const int WID, unsigned* bar, volatile LAS unsigned* st) {
    XcdBarrier b; b.bar = bar; b.x = xb_xcc_id(); b.st = st;
    if (opaque_tid(WID) == 0) (void)xb_add(&bar[XB_XCNT(b.x)], 1u);
    return b;
}
DI void xcd_barrier_complete(unsigned* bar, unsigned x, unsigned& nloc, unsigned& nx) {
    const unsigned G = gridDim.x * gridDim.y * gridDim.z;
    unsigned sum, cnt, mine, sp = 0u;
    for (;;) {
        sum = 0u; cnt = 0u; mine = 0u;
#pragma unroll
        for (unsigned j = 0; j < 16; ++j) { const unsigned c = xb_ld(&bar[XB_XCNT(j)]); sum += c; cnt += (c > 0u) ? 1u : 0u; mine = (j == x) ? c : mine; }
        if (sum == G) break;
        __builtin_amdgcn_s_sleep(1);
        if ((++sp & 255u) == 0u) { if (xb_ld(&bar[XB_TMO])) break; if (sp > XB_SPIN_CAP) { atomicAdd(&bar[XB_TMO], 1u); break; } }
    }
    nloc = mine > 0u ? mine : 1u; nx = cnt > 0u ? cnt : 1u;
}
DI void xcd_barrier(const int WID, const XcdBarrier& b) {
    asm volatile("s_waitcnt vmcnt(0)" ::: "memory");
    __syncthreads();
    if (opaque_tid(WID) == 0) {
        unsigned* bar = b.bar; asm volatile("" : "+s"(bar));
        __builtin_amdgcn_s_waitcnt(0);
        unsigned nloc = b.st[0], nx = b.st[1];
        if (nloc == 0u) { xcd_barrier_complete(bar, b.x, nloc, nx); b.st[0] = nloc; b.st[1] = nx; }
        const unsigned old = xb_add(&bar[XB_XSUB(b.x)], 1u);
        const unsigned gen = old / nloc;
        if (old + 1u == (gen + 1u) * nloc) {
            __builtin_amdgcn_fence(__ATOMIC_RELEASE, "agent");
            asm volatile("s_waitcnt vmcnt(0)" ::: "memory");
            const unsigned og = xb_add(&bar[XB_TOP], 1u);
            const unsigned tg = og / nx;
            if (og + 1u == (tg + 1u) * nx) xb_add(&bar[XB_TOPGEN], 1u);
            else XB_SPIN(xb_ld(&bar[XB_TOPGEN]) == tg, bar);
            __builtin_amdgcn_fence(__ATOMIC_ACQUIRE, "agent");
            xb_add(&bar[XB_XGEN(b.x)], 1u);
            asm volatile("s_waitcnt vmcnt(0)" ::: "memory");
        } else {
            XB_SPIN(xb_ld(&bar[XB_XGEN(b.x)]) == gen, bar);
            __builtin_amdgcn_fence(__ATOMIC_ACQUIRE, "agent");
            asm volatile("s_waitcnt vmcnt(0)" ::: "memory");
        }
    }
    __syncthreads();
}

namespace pg8 {
constexpr int BM = 256, BK = 64, HALF = 128, HTB = HALF * BK * 2, STAGE_BYTES = 8 * HTB, NXCD = 8, WGM = 8;
DI int lds_byte(int r, int c) { const int st = (r >> 4) * 2 + (c >> 5), rr = r & 15, cc = c & 31, ob = rr * 64 + cc * 2; return st * 1024 + (ob ^ (((ob >> 9) & 1) << 5)); }
DI void stage_rc(int b, int& R, int& C) { const int st = b / 1024, sb = b % 1024, swz = sb ^ (((sb >> 9) & 1) << 5); R = (st >> 1) * 16 + swz / 64; C = (st & 1) * 32 + (swz % 64) / 2; }
DI int perm32(int rho) { const int n = rho >> 4, i = rho & 15; return 8 * (i >> 2) + 4 * n + (i & 3); }
struct Unit { int pm, pn; };
struct Sched {
    int nM, nN, nwg, G, c;
    DI void init(int nM_, int nN_, int G_, int c_) { nM = nM_; nN = nN_; nwg = nM * nN; G = G_; c = c_; }
    DI bool next(int i, Unit& u) const {
        const long L = (long)i * G + c; if (L >= nwg) return false;
        int wgid = (int)L; { const int q = nwg / NXCD, r = nwg % NXCD, xcd = wgid % NXCD, off = wgid / NXCD; wgid = (xcd < r ? xcd * (q + 1) : r * (q + 1) + (xcd - r) * q) + off; }
        const int nig = WGM * nN, gid = wgid / nig, fm = gid * WGM, gsz = (nM - fm) < WGM ? (nM - fm) : WGM;
        u.pm = fm + ((wgid % nig) % gsz); u.pn = (wgid % nig) / gsz; return true;
    }
};
template <class Epi, class Prob, class SchedT>
DI void gemm_phase(const int WID, LAS unsigned char* lds, const Prob& P, const SchedT& S, const Epi& E) {
    const int tid = opaque_tid(WID), wid = __builtin_amdgcn_readfirstlane(tid >> 6), lane = tid & 63, wr = wid >> 2, wc = wid & 3, fr = lane & 15, fq = lane >> 4;
    const int K = P.K, nt = K / BK;
    constexpr int KREP = Epi::CARRY ? 1 : PROBE_KREP;
    unsigned voffA[2], voffB[2];
#pragma unroll
    for (int i = 0; i < 2; ++i) { int R, C; stage_rc(tid * 16 + i * 8192, R, C); const int Rb = Epi::PERM ? ((R & ~31) + perm32(R & 31)) : R;
        voffA[i] = (unsigned)(R * P.lda + C) * 2u; voffB[i] = (unsigned)(Rb * P.ldb + C) * 2u; }
    const size_t kstep = (size_t)(BK * 2);
    const size_t hstepA = (size_t)HALF * P.lda * 2, hstepB = (size_t)HALF * P.ldb * 2;
    const unsigned ldsw = (unsigned)wid * 1024u;
    const int aoff = lds_byte(wr * 64 + fr, fq * 8), boff = lds_byte(wc * 32 + fr, fq * 8);
#define PG8_SA(b, h) (((b) * 2 + (h)) * HTB)
#define PG8_SB(b, h) ((4 + (b) * 2 + (h)) * HTB)
#define PG8_STAGE(bufoff, gbase, voff) do { _Pragma("unroll") for (int _i = 0; _i < 2; ++_i) \
        __builtin_amdgcn_global_load_lds((const unsigned*)((const char*)(gbase) + (voff)[_i]), (LAS unsigned*)(lds + (bufoff) + ldsw + _i * 8192), 16, 0, 0); } while (0)
#define PG8_LD16(off) (*(const LAS i32x4*)(lds + (off)))
#define PG8_LDA(dst, b, h) do { _Pragma("unroll") for (int m = 0; m < 4; ++m) { const i32x4 lo_ = PG8_LD16(PG8_SA(b, h) + aoff + m * 2048), hi_ = PG8_LD16(PG8_SA(b, h) + aoff + m * 2048 + 1024); dst[m] = __builtin_shufflevector(lo_, hi_, 0, 1, 2, 3, 4, 5, 6, 7); } } while (0)
#define PG8_LDB(dst, b, h) do { _Pragma("unroll") for (int n = 0; n < 2; ++n) { const i32x4 lo_ = PG8_LD16(PG8_SB(b, h) + boff + n * 2048), hi_ = PG8_LD16(PG8_SB(b, h) + boff + n * 2048 + 1024); dst[n] = __builtin_shufflevector(lo_, hi_, 0, 1, 2, 3, 4, 5, 6, 7); } } while (0)
#define PG8_LOH(X) __builtin_bit_cast(bf16x8, __builtin_shufflevector((X), (X), 0, 1, 2, 3))
#define PG8_HIH(X) __builtin_bit_cast(bf16x8, __builtin_shufflevector((X), (X), 4, 5, 6, 7))
#define PG8_MMA(ai, bj, At, Bt) do { __builtin_amdgcn_s_setprio(1); \
        if constexpr (Prob::FP8) { _Pragma("unroll") for (int m = 0; m < 4; ++m) _Pragma("unroll") for (int n = 0; n < 2; ++n) \
            asm volatile("v_mfma_scale_f32_16x16x128_f8f6f4 %0, %1, %2, %0, %3, %3 op_sel_hi:[0,0,0]" : "+v"(acc[ai][bj][m][n]) : "v"(Bt[n]), "v"(At[m]), "v"(sc1)); } \
        else { _Pragma("unroll") for (int m = 0; m < 4; ++m) _Pragma("unroll") for (int n = 0; n < 2; ++n) { \
            acc[ai][bj][m][n] = __builtin_amdgcn_mfma_f32_16x16x32_bf16(PG8_LOH(Bt[n]), PG8_LOH(At[m]), acc[ai][bj][m][n], 0, 0, 0); \
            acc[ai][bj][m][n] = __builtin_amdgcn_mfma_f32_16x16x32_bf16(PG8_HIH(Bt[n]), PG8_HIH(At[m]), acc[ai][bj][m][n], 0, 0, 0); } } \
        __builtin_amdgcn_s_setprio(0); } while (0)
#define PG8_WAIT_V(n) asm volatile("s_waitcnt vmcnt(" #n ")" ::: "memory")
#define PG8_WAIT_L(n) asm volatile("s_waitcnt lgkmcnt(" #n ")" ::: "memory")
#define PG8_BAR __builtin_amdgcn_s_barrier()
#define PG8_SCHED __builtin_amdgcn_sched_barrier(0)
    Unit cur, nxt; int ui = 0;
    if (!S.next(0, cur)) return;
    f32x4 acc[2][2][4][2];
#pragma unroll
    for (int a = 0; a < 2; ++a)
#pragma unroll
        for (int b = 0; b < 2; ++b)
#pragma unroll
            for (int m = 0; m < 4; ++m)
#pragma unroll
                for (int n = 0; n < 2; ++n) acc[a][b][m][n] = (f32x4){0.f, 0.f, 0.f, 0.f};
    i32x8 At[4], B0[2], B1[2];
    const int sc1 = 0x7f7f7f7f;
    const char* cA = P.a_base(cur); const char* cB = P.b_base(cur);
    PG8_STAGE(PG8_SB(0, 0), cB, voffB); PG8_STAGE(PG8_SA(0, 0), cA, voffA); PG8_STAGE(PG8_SB(0, 1), cB + hstepB, voffB); PG8_STAGE(PG8_SA(0, 1), cA + hstepA, voffA);
    if (wr == 1) PG8_BAR;
    PG8_WAIT_V(4); PG8_BAR;
    PG8_STAGE(PG8_SB(1, 0), cB + kstep, voffB); PG8_STAGE(PG8_SA(1, 0), cA + kstep, voffA); PG8_STAGE(PG8_SB(1, 1), cB + hstepB + kstep, voffB);
    PG8_WAIT_V(6); PG8_BAR;
    for (;;) {
        const bool has_next = S.next(ui + 1, nxt);
        const char* nA = has_next ? P.a_base(nxt) : cA; const char* nB = has_next ? P.b_base(nxt) : cB;
        for (int rep_ = 0; rep_ < KREP; ++rep_)
        for (int t = 0; t < nt; t += 2) {
            const bool last = (t == nt - 2);
            const char* a1 = cA + (size_t)(t + 1) * kstep;
            const char* a2 = last ? (rep_ + 1 < KREP ? cA : nA) : cA + (size_t)(t + 2) * kstep; const char* b2 = last ? (rep_ + 1 < KREP ? cB : nB) : cB + (size_t)(t + 2) * kstep;
            const char* a3 = a2 + kstep; const char* b3 = b2 + kstep;
            PG8_LDB(B0, 0, 0); PG8_SCHED; PG8_LDA(At, 0, 0); PG8_STAGE(PG8_SA(1, 1), a1 + hstepA, voffA);
            PG8_WAIT_L(8); PG8_BAR; PG8_WAIT_L(0); PG8_MMA(0, 0, At, B0); PG8_BAR; PG8_SCHED;
            PG8_LDB(B1, 0, 1); PG8_STAGE(PG8_SB(0, 0), b2, voffB);
            PG8_BAR; PG8_WAIT_L(0); PG8_MMA(0, 1, At, B1); PG8_BAR;
            PG8_LDA(At, 0, 1); PG8_STAGE(PG8_SA(0, 0), a2, voffA);
            PG8_BAR; PG8_WAIT_L(0); PG8_MMA(1, 0, At, B0); PG8_BAR; PG8_SCHED;
            PG8_STAGE(PG8_SB(0, 1), b2 + hstepB, voffB);
            PG8_WAIT_V(6); PG8_BAR; PG8_MMA(1, 1, At, B1); PG8_BAR;
            PG8_LDB(B0, 1, 0); PG8_SCHED; PG8_LDA(At, 1, 0); PG8_STAGE(PG8_SA(0, 1), a2 + hstepA, voffA);
            PG8_WAIT_L(8); PG8_BAR; PG8_WAIT_L(0); PG8_MMA(0, 0, At, B0); PG8_BAR; PG8_SCHED;
            PG8_LDB(B1, 1, 1); PG8_STAGE(PG8_SB(1, 0), b3, voffB);
            PG8_BAR; PG8_WAIT_L(0); PG8_MMA(0, 1, At, B1); PG8_BAR;
            PG8_LDA(At, 1, 1); PG8_STAGE(PG8_SA(1, 0), a3, voffA);
            PG8_BAR; PG8_WAIT_L(0); PG8_MMA(1, 0, At, B0); PG8_BAR; PG8_SCHED;
            PG8_STAGE(PG8_SB(1, 1), b3 + hstepB, voffB);
            PG8_WAIT_V(6); PG8_BAR; PG8_MMA(1, 1, At, B1); PG8_BAR;
        }
        if constexpr (Prob::FP8) {
            asm volatile("s_nop 15\n\ts_nop 15" ::: "memory");
#pragma unroll
            for (int a_ = 0; a_ < 2; ++a_)
#pragma unroll
                for (int b_ = 0; b_ < 2; ++b_)
#pragma unroll
                    for (int m_ = 0; m_ < 4; ++m_)
#pragma unroll
                        for (int n_ = 0; n_ < 2; ++n_) asm volatile("" : "+v"(acc[a_][b_][m_][n_]));
        }
        if constexpr (KREP > 1) {
#pragma unroll
        for (int a_ = 0; a_ < 2; ++a_)
#pragma unroll
            for (int b_ = 0; b_ < 2; ++b_)
#pragma unroll
                for (int m_ = 0; m_ < 4; ++m_)
#pragma unroll
                    for (int n_ = 0; n_ < 2; ++n_) acc[a_][b_][m_][n_] *= (1.0f / KREP); }
        { const int t2_ = opaque_tid(WID); const int fr_ = t2_ & 15, fq_ = (t2_ >> 4) & 3; int wr_ = WID >> 2, wc_ = WID & 3; asm volatile("" : "+s"(wr_), "+s"(wc_));
          E(acc, cur, wr_, wc_, fr_, fq_); }
        if (!has_next) break;
        const float carry = Epi::carry(cur);
#pragma unroll
        for (int a = 0; a < 2; ++a)
#pragma unroll
            for (int b = 0; b < 2; ++b)
#pragma unroll
                for (int m = 0; m < 4; ++m)
#pragma unroll
                    for (int n = 0; n < 2; ++n) acc[a][b][m][n] = Epi::CARRY ? acc[a][b][m][n] * carry : (f32x4){0.f, 0.f, 0.f, 0.f};
        cur = nxt; cA = nA; cB = nB; ++ui;
    }
    PG8_WAIT_V(0);
    if (wr == 0) PG8_BAR;
    PG8_BAR;
#undef PG8_SA
#undef PG8_SB
#undef PG8_STAGE
#undef PG8_LDA
#undef PG8_LDB
#undef PG8_MMA
#undef PG8_LD16
#undef PG8_LOH
#undef PG8_HIH
#undef PG8_WAIT_V
#undef PG8_WAIT_L
#undef PG8_BAR
#undef PG8_SCHED
}
}
using pg8::Unit;
typedef f32x4 Acc[2][2][4][2];

struct ProbPlain { static constexpr bool FP8 = false; const bf16_t* A; const bf16_t* Bt; int lda, ldb, K;
    DI const char* a_base(const Unit& u) const { return (const char*)(A + (size_t)u.pm * 256 * lda); }
    DI const char* b_base(const Unit& u) const { return (const char*)(Bt + (size_t)u.pn * 256 * ldb); } };
struct ProbCmp1 { static constexpr bool FP8 = false; const bf16_t* KCB; const bf16_t* VCB; const bf16_t* W; int lda, ldb, K;
    DI const char* a_base(const Unit& u) const { const int kv = u.pm >> 4, rt = u.pm & 15; return (const char*)((kv ? VCB : KCB) + (size_t)rt * 256 * 1024); }
    DI const char* b_base(const Unit& u) const { const int kv = u.pm >> 4; return (const char*)(W + (size_t)kv * 256 * 2048); } };
struct ProbAtt { static constexpr bool FP8 = false; const bf16_t* AQ; const bf16_t* KP; int lda, ldb, K;
    DI const char* a_base(const Unit& u) const { const int z = u.pm, n = z & 7, h = (z >> 3) & 3, b = z >> 5; const size_t t0 = (size_t)b * 2048 + n * 256; return (const char*)(AQ + (t0 * 4 + h) * 512 + 256); }
    DI const char* b_base(const Unit& u) const { const int z = u.pm, n = z & 7, h = (z >> 3) & 3, b = z >> 5; const size_t t0 = (size_t)b * 2048 + n * 256; return (const char*)(KP + t0 * 1024 + h * 256); } };
struct ProbUT { static constexpr bool FP8 = false; const bf16_t* VS; const bf16_t* KT; int lda, ldb, K;
    DI const char* a_base(const Unit& u) const { const int z = u.pm >> 1, half = u.pm & 1; return (const char*)(VS + (size_t)z * 262144 + (size_t)half * 256 * 512); }
    DI const char* b_base(const Unit& u) const { const int z = u.pm >> 1; return (const char*)(KT + (size_t)z * 65536); } };
struct ProbY { static constexpr bool FP8 = false; const bf16_t* AQ; const bf16_t* VS; int lda, ldb, K;
    DI const char* a_base(const Unit& u) const { const int z = u.pm, n = z & 7, h = (z >> 3) & 3, b = z >> 5; const size_t t0 = (size_t)b * 2048 + n * 256; return (const char*)(AQ + (t0 * 4 + h) * 512); }
    DI const char* b_base(const Unit& u) const { return (const char*)(VS + (size_t)u.pm * 262144 + (size_t)u.pn * 256 * 512); } };
DI int moe_tile_expert(const LAS int* ts, int rt) { int e = 0;
#pragma unroll 8
    for (int i = 1; i < 32; ++i) e += (rt >= ts[i]) ? 1 : 0;
    return e; }
struct ProbMoe { static constexpr bool FP8 = false; const bf16_t* A; const bf16_t* W; const LAS int* ts; int nper; int lda, ldb, K;
    DI const char* a_base(const Unit& u) const { return (const char*)(A + (size_t)u.pm * 256 * 1024); }
    DI const char* b_base(const Unit& u) const { const int e = moe_tile_expert(ts, u.pm); return (const char*)(W + ((size_t)e * nper + (size_t)u.pn * 256) * 1024); } };

struct ProbPlain8 { static constexpr bool FP8 = true; const unsigned char* A; const unsigned char* Bt; int lda, ldb, K;
    DI const char* a_base(const Unit& u) const { return (const char*)(A + (size_t)u.pm * 256 * lda * 2); }
    DI const char* b_base(const Unit& u) const { return (const char*)(Bt + (size_t)u.pn * 256 * ldb * 2); } };
struct ProbMoe8 { static constexpr bool FP8 = true; const unsigned char* A; const unsigned char* W; const LAS int* ts; int nper; int lda, ldb, K;
    DI const char* a_base(const Unit& u) const { return (const char*)(A + (size_t)u.pm * 256 * 1024); }
    DI const char* b_base(const Unit& u) const { const int e = moe_tile_expert(ts, u.pm); return (const char*)(W + ((size_t)e * nper + (size_t)u.pn * 256) * 1024); } };

#define EPI_ROWS(ai, m) (128 * (ai) + 64 * wr + 16 * (m) + fr)
struct EpiEvNat { static constexpr bool CARRY = false; static DI float carry(const Unit&) { return 0.f; } static constexpr bool PERM = true;
    unsigned char* ws; const float* gains;
    DI void operator()(const Acc& acc, const Unit& u, int wr, int wc, int fr, int fq) const {
        const int pn = u.pn; const bool norm = (pn != 6);
        const int gi = pn < 2 ? 0 : pn < 4 ? 1 : pn < 6 ? 2 : 3;
        const float* g = gains + gi * 64;
        f32x4 gv[2][2];
#pragma unroll
        for (int bj = 0; bj < 2; ++bj)
#pragma unroll
            for (int n = 0; n < 2; ++n) { const f32x4 t4 = *(const f32x4*)(g + 32 * bj + 8 * fq + 4 * n); gv[bj][n] = norm ? t4 : (f32x4){1.f, 1.f, 1.f, 1.f}; }
        size_t boff; int rowmul, hoff; bool panel = false;
        if (pn < 2) { boff = WS_QD; rowmul = 512; hoff = (pn * 4 + wc) * 64; }
        else if (pn < 4) { boff = WS_KD; rowmul = 512; hoff = ((pn - 2) * 4 + wc) * 64; }
        else if (pn < 6) { boff = WS_QN; rowmul = 512; hoff = ((pn - 4) * 4 + wc) * 64; }
        else { panel = true; rowmul = 64; hoff = 0; boff = (pn == 6) ? (wc < 2 ? WS_KCB : WS_VCB) : (wc < 2 ? WS_KSB : WS_KWB); }
        bf16_t* base = (bf16_t*)(ws + boff);
#pragma unroll
        for (int ai = 0; ai < 2; ++ai)
#pragma unroll
            for (int m = 0; m < 4; ++m) {
                const int t = u.pm * 256 + EPI_ROWS(ai, m), b = t >> 11, sq = t & 2047;
                float ss = 0.f;
#pragma unroll
                for (int bj = 0; bj < 2; ++bj)
#pragma unroll
                    for (int n = 0; n < 2; ++n) { const f32x4 x = acc[ai][bj][m][n]; ss += (x[0] * x[0] + x[1] * x[1]) + (x[2] * x[2] + x[3] * x[3]); }
                ss += shx(ss, 16); ss += shx(ss, 32);
                const float rstd = norm ? rsqrtf(ss * (1.0f / 64.0f) + EPS) * ((pn < 2 || pn == 4 || pn == 5) ? 0.125f : 1.0f) : 1.0f;
                const size_t rowi = panel ? ((size_t)(b * 2 + (wc & 1)) * 2048 + sq) : (size_t)t;
#pragma unroll
                for (int bj = 0; bj < 2; ++bj) {
                    const f32x4 v0 = acc[ai][bj][m][0] * rstd * gv[bj][0], v1 = acc[ai][bj][m][1] * rstd * gv[bj][1];
                    *(u32x4*)(base + rowi * rowmul + hoff + 32 * bj + 8 * fq) = pack8(v0, v1);
                }
            }
    }
};
struct EpiEvSw { static constexpr bool CARRY = false; static DI float carry(const Unit&) { return 0.f; } static constexpr bool PERM = true;
    unsigned char* ws;
    DI void operator()(const Acc& acc, const Unit& u, int wr, int wc, int fr, int fq) const {
        const int b = u.pn >> 3, sb = (u.pn & 7) * 256;
#pragma unroll
        for (int ai = 0; ai < 2; ++ai)
#pragma unroll
            for (int m = 0; m < 4; ++m) {
                const int rl = EPI_ROWS(ai, m);
                size_t boff, rowi;
                if (u.pm < 2) { const int fg = u.pm * 256 + rl; boff = WS_VAT; rowi = (size_t)(b * 4 + (fg >> 7)) * 128 + (fg & 127); }
                else { const int r2 = rl & 127; boff = (rl < 128) ? WS_VST : WS_VWT; rowi = (size_t)(b * 2 + (r2 >> 6)) * 64 + (r2 & 63); }
                bf16_t* rowp = (bf16_t*)(ws + boff) + rowi * 2048;
#pragma unroll
                for (int bj = 0; bj < 2; ++bj) { const u32x4 pw = pack8(acc[ai][bj][m][0], acc[ai][bj][m][1]);
                    const int s0 = sb + 128 * bj + 32 * wc + 8 * fq; bf16_t* g16 = rowp + (s0 & ~15) + ((s0 & 8) ? 4 : 0);
                    *(u32x2*)g16 = (u32x2){pw.x, pw.y}; *(u32x2*)(g16 + 8) = (u32x2){pw.z, pw.w}; }
            }
    }
};
struct EpiCmp1 { static constexpr bool CARRY = false; static DI float carry(const Unit&) { return 0.f; } static constexpr bool PERM = true;
    bf16_t* HID; const float* bias1;
    DI void operator()(const Acc& acc, const Unit& u, int wr, int wc, int fr, int fq) const {
        const int kv = u.pm >> 4, rt = u.pm & 15;
#pragma unroll
        for (int bj = 0; bj < 2; ++bj) {
            const int col = 128 * bj + 32 * wc + 8 * fq;
            const f32x4 b0 = *(const f32x4*)(bias1 + kv * 256 + col), b1 = *(const f32x4*)(bias1 + kv * 256 + col + 4);
#pragma unroll
            for (int ai = 0; ai < 2; ++ai)
#pragma unroll
                for (int m = 0; m < 4; ++m) {
                    f32x4 v0 = acc[ai][bj][m][0] + b0, v1 = acc[ai][bj][m][1] + b1;
#pragma unroll
                    for (int j = 0; j < 4; ++j) { v0[j] = v0[j] * sigm(v0[j]); v1[j] = v1[j] * sigm(v1[j]); }
                    *(u32x4*)(HID + ((size_t)kv * 4096 + rt * 256 + EPI_ROWS(ai, m)) * 256 + col) = pack8(v0, v1);
                }
        }
    }
};
struct EpiResid { static constexpr bool CARRY = false; static DI float carry(const Unit&) { return 0.f; } static constexpr bool PERM = false;
    const float* Hin; float* Hout;
    DI void operator()(const Acc& acc, const Unit& u, int wr, int wc, int fr, int fq) const {
#pragma unroll
        for (int ai = 0; ai < 2; ++ai)
#pragma unroll
            for (int m = 0; m < 4; ++m) {
                const size_t off = (size_t)(u.pm * 256 + EPI_ROWS(ai, m)) * 1024 + u.pn * 256 + 32 * wc + 4 * fq;
#pragma unroll
                for (int bj = 0; bj < 2; ++bj)
#pragma unroll
                    for (int n = 0; n < 2; ++n) { const size_t o = off + 128 * bj + 16 * n; *(f32x4*)(Hout + o) = *(const f32x4*)(Hin + o) + acc[ai][bj][m][n]; }
            }
    }
};
DI float ret_lg2(int h) { return __log2f(1.0f - exp2f(-5.0f - (float)h)); }
struct EpiOdNat { static constexpr bool CARRY = false; static DI float carry(const Unit&) { return 0.f; } static constexpr bool PERM = true;
    unsigned char* ws;
    DI void operator()(const Acc& acc, const Unit& u, int wr, int wc, int fr, int fq) const {
        const int pn = u.pn; const int h = pn & 3; const float lg = ret_lg2(h);
        const size_t boff = pn < 4 ? WS_AQ : pn < 8 ? WS_KP : WS_GG;
        const int rowmul = pn < 4 ? 2048 : pn < 8 ? 1024 : 2048;
        const int coff = pn < 4 ? (h * 512 + 256) : pn < 8 ? (h * 256) : ((pn - 8) * 256);
        bf16_t* base = (bf16_t*)(ws + boff) + coff;
#pragma unroll
        for (int ai = 0; ai < 2; ++ai)
#pragma unroll
            for (int m = 0; m < 4; ++m) {
                const int cl = EPI_ROWS(ai, m); const size_t t = (size_t)u.pm * 256 + cl;
                float sc = 1.f;
                if (pn < 4) sc = exp2f(lg * (float)(cl + 1)); else if (pn < 8) sc = 0.0625f * exp2f(-lg * (float)(cl + 1));
#pragma unroll
                for (int bj = 0; bj < 2; ++bj) {
                    const int d = 128 * bj + 32 * wc + 8 * fq;
                    f32x4 v0 = acc[ai][bj][m][0] * sc, v1 = acc[ai][bj][m][1] * sc;
                    if (pn >= 8) {
#pragma unroll
                        for (int j = 0; j < 4; ++j) { v0[j] = v0[j] * sigm(v0[j]); v1[j] = v1[j] * sigm(v1[j]); } }
                    const u32x4 pw = pack8(v0, v1);
                    *(u32x4*)(base + t * rowmul + d) = pw;
                    if (pn >= 4 && pn < 8) {
                        bf16_t* kt = (bf16_t*)(ws + WS_KT) + ((size_t)((u.pm >> 3) * 4 + h) * 8 + (u.pm & 7)) * 65536 + (size_t)d * 256 + cl;
                        kt[0 * 256] = (bf16_t)(pw.x & 0xffffu); kt[1 * 256] = (bf16_t)(pw.x >> 16); kt[2 * 256] = (bf16_t)(pw.y & 0xffffu); kt[3 * 256] = (bf16_t)(pw.y >> 16);
                        kt[4 * 256] = (bf16_t)(pw.z & 0xffffu); kt[5 * 256] = (bf16_t)(pw.z >> 16); kt[6 * 256] = (bf16_t)(pw.w & 0xffffu); kt[7 * 256] = (bf16_t)(pw.w >> 16);
                    }
                }
            }
    }
};
struct EpiOdSw { static constexpr bool CARRY = false; static DI float carry(const Unit&) { return 0.f; } static constexpr bool PERM = true;
    unsigned char* ws;
    DI void operator()(const Acc& acc, const Unit& u, int wr, int wc, int fr, int fq) const {
        const int b = u.pn >> 3, n = u.pn & 7, h = u.pm >> 1;
        const size_t z = (size_t)(b * 4 + h) * 8 + n;
        bf16_t* base = (bf16_t*)(ws + WS_VS) + z * 262144 + (size_t)(u.pm & 1) * 256 * 512;
#pragma unroll
        for (int bj = 0; bj < 2; ++bj) {
            const int cl = 128 * bj + 32 * wc + 8 * fq;
#pragma unroll
            for (int ai = 0; ai < 2; ++ai)
#pragma unroll
                for (int m = 0; m < 4; ++m)
                    *(u32x4*)(base + (size_t)EPI_ROWS(ai, m) * 512 + cl) = pack8(acc[ai][bj][m][0], acc[ai][bj][m][1]);
        }
    }
};
struct EpiAtt { static constexpr bool CARRY = false; static DI float carry(const Unit&) { return 0.f; } static constexpr bool PERM = true;
    bf16_t* AQ;
    DI void operator()(const Acc& acc, const Unit& u, int wr, int wc, int fr, int fq) const {
        const int z = u.pm, n = z & 7, h = (z >> 3) & 3, b = z >> 5; const size_t t0 = (size_t)b * 2048 + n * 256;
#pragma unroll
        for (int ai = 0; ai < 2; ++ai)
#pragma unroll
            for (int m = 0; m < 4; ++m) {
                const int c = EPI_ROWS(ai, m);
#pragma unroll
                for (int bj = 0; bj < 2; ++bj) {
                    const int e0 = 128 * bj + 32 * wc + 8 * fq;
                    f32x4 v0 = acc[ai][bj][m][0], v1 = acc[ai][bj][m][1];
#pragma unroll
                    for (int j = 0; j < 4; ++j) { v0[j] = (c >= e0 + j) ? v0[j] : 0.f; v1[j] = (c >= e0 + 4 + j) ? v1[j] : 0.f; }
                    *(u32x4*)(AQ + ((t0 + c) * 4 + h) * 512 + e0) = pack8(v0, v1);
                }
            }
    }
};
struct EpiUT { static constexpr bool CARRY = false; static DI float carry(const Unit&) { return 0.f; } static constexpr bool PERM = true;
    bf16_t* UT;
    DI void operator()(const Acc& acc, const Unit& u, int wr, int wc, int fr, int fq) const {
        const size_t z = (size_t)(u.pm >> 1); const int half = u.pm & 1;
#pragma unroll
        for (int ai = 0; ai < 2; ++ai)
#pragma unroll
            for (int m = 0; m < 4; ++m) {
                bf16_t* rowp = UT + z * 131072 + (size_t)(half * 256 + EPI_ROWS(ai, m)) * 256 + 32 * wc + 8 * fq;
#pragma unroll
                for (int bj = 0; bj < 2; ++bj) *(u32x4*)(rowp + 128 * bj) = pack8(acc[ai][bj][m][0], acc[ai][bj][m][1]);
            }
    }
};
struct EpiUTScan { static constexpr bool CARRY = true; static constexpr bool PERM = true;
    static DI float carry(const Unit& u) { const int z = u.pm >> 1, n = z & 7, h = (z >> 3) & 3; return n == 7 ? 0.f : exp2f(256.0f * ret_lg2(h)); }
    bf16_t* VS;
    DI void operator()(const Acc& acc, const Unit& u, int wr, int wc, int fr, int fq) const {
        const size_t z = (size_t)(u.pm >> 1); const int half = u.pm & 1, n = (int)(z & 7), h = (int)((z >> 3) & 3);
        const float dec = exp2f(256.0f * ret_lg2(h));
#pragma unroll
        for (int ai = 0; ai < 2; ++ai)
#pragma unroll
            for (int m = 0; m < 4; ++m) {
                bf16_t* rowp = VS + (z * 512 + half * 256 + EPI_ROWS(ai, m)) * 512 + 256 + 32 * wc + 8 * fq;
#pragma unroll
                for (int bj = 0; bj < 2; ++bj) {
                    if (n == 0) { unsigned z0; asm volatile("v_mov_b32 %0, 0" : "=v"(z0)); *(u32x4*)(rowp + 128 * bj) = (u32x4){z0, z0, z0, z0}; }
                    if (n < 7) *(u32x4*)(rowp + (size_t)512 * 512 + 128 * bj) = pack8(acc[ai][bj][m][0] * dec, acc[ai][bj][m][1] * dec);
                }
            }
    }
};
struct SchedSeq { int nb, c;
    DI void init(int G, int c_) { nb = G / 2 > 0 ? G / 2 : 1; c = c_; }
    DI bool next(int i, Unit& u) const { if (c >= nb) return false; const int seq = c + (i >> 3) * nb; if (seq >= 128) return false;
        const int bh = seq >> 1, half = seq & 1, n = i & 7; u.pm = (bh * 8 + n) * 2 + half; u.pn = 0; return true; } };
struct EpiY { static constexpr bool CARRY = false; static DI float carry(const Unit&) { return 0.f; } static constexpr bool PERM = true;
    bf16_t* Y;
    DI void operator()(const Acc& acc, const Unit& u, int wr, int wc, int fr, int fq) const {
        const int z = u.pm, n = z & 7, h = (z >> 3) & 3, b = z >> 5; const size_t t0 = (size_t)b * 2048 + n * 256;
#pragma unroll
        for (int ai = 0; ai < 2; ++ai)
#pragma unroll
            for (int m = 0; m < 4; ++m) {
                bf16_t* rowp = Y + (t0 + EPI_ROWS(ai, m)) * 2048 + h * 512 + u.pn * 256 + 32 * wc + 8 * fq;
#pragma unroll
                for (int bj = 0; bj < 2; ++bj) *(u32x4*)(rowp + 128 * bj) = pack8(acc[ai][bj][m][0], acc[ai][bj][m][1]);
            }
    }
};
constexpr float W8_SCALE = 32.0f, WSC = 1.0f / W8_SCALE;
struct EpiGU { static constexpr bool CARRY = false; static DI float carry(const Unit&) { return 0.f; } static constexpr bool PERM = true;
    unsigned char* ACT; const float* bgu; const LAS int* ts;
    DI void operator()(const Acc& acc, const Unit& u, int wr, int wc, int fr, int fq) const {
        const int e = moe_tile_expert(ts, u.pm); const int w = 32 * wc + 8 * fq;
        const float* bp = bgu + (size_t)e * 2048 + 128 * u.pn + w;
        const f32x4 bg0 = *(const f32x4*)bp, bg1 = *(const f32x4*)(bp + 4), bl0 = *(const f32x4*)(bp + 1024), bl1 = *(const f32x4*)(bp + 1028);
#pragma unroll
        for (int ai = 0; ai < 2; ++ai)
#pragma unroll
            for (int m = 0; m < 4; ++m) {
                f32x4 g0 = acc[ai][0][m][0] * WSC + bg0, g1 = acc[ai][0][m][1] * WSC + bg1, l0 = acc[ai][1][m][0] * WSC + bl0, l1 = acc[ai][1][m][1] * WSC + bl1;
#pragma unroll
                for (int j = 0; j < 4; ++j) {
                    const float a = fminf(g0[j], 7.0f), c = fminf(g1[j], 7.0f);
                    const float la = fminf(fmaxf(l0[j], -7.0f), 7.0f), lc = fminf(fmaxf(l1[j], -7.0f), 7.0f);
                    g0[j] = a * sigm(1.702f * a) * (la + 1.0f); g1[j] = c * sigm(1.702f * c) * (lc + 1.0f); }
                u32x2 o8; o8.x = pk4_fp8(g0[0], g0[1], g0[2], g0[3]); o8.y = pk4_fp8(g1[0], g1[1], g1[2], g1[3]);
                *(u32x2*)(ACT + ((size_t)u.pm * 256 + EPI_ROWS(ai, m)) * 1024 + 128 * u.pn + w) = o8;
            }
    }
};
struct EpiDN { static constexpr bool CARRY = false; static DI float carry(const Unit&) { return 0.f; } static constexpr bool PERM = true;
    bf16_t* YB; const float* bdn; const LAS int* ts;
    DI void operator()(const Acc& acc, const Unit& u, int wr, int wc, int fr, int fq) const {
        const int e = moe_tile_expert(ts, u.pm);
#pragma unroll
        for (int bj = 0; bj < 2; ++bj) {
            const int col = 256 * u.pn + 128 * bj + 32 * wc + 8 * fq;
            const f32x4 b0 = *(const f32x4*)(bdn + (size_t)e * 1024 + col), b1 = *(const f32x4*)(bdn + (size_t)e * 1024 + col + 4);
#pragma unroll
            for (int ai = 0; ai < 2; ++ai)
#pragma unroll
                for (int m = 0; m < 4; ++m)
                    *(u32x4*)(YB + ((size_t)u.pm * 256 + EPI_ROWS(ai, m)) * 1024 + col) = pack8(acc[ai][bj][m][0] * (1.0f / 64.0f) + b0, acc[ai][bj][m][1] * (1.0f / 64.0f) + b1);
        }
    }
};
struct EpiPP { static constexpr bool CARRY = false; static DI float carry(const Unit&) { return 0.f; } static constexpr bool PERM = true;
    bf16_t* PP;
    DI void operator()(const Acc& acc, const Unit& u, int wr, int wc, int fr, int fq) const {
#pragma unroll
        for (int ai = 0; ai < 2; ++ai)
#pragma unroll
            for (int m = 0; m < 4; ++m) {
                bf16_t* rowp = PP + ((size_t)u.pm * 256 + EPI_ROWS(ai, m)) * 1024 + u.pn * 256 + 32 * wc + 8 * fq;
#pragma unroll
                for (int bj = 0; bj < 2; ++bj) *(u32x4*)(rowp + 128 * bj) = pack8(acc[ai][bj][m][0], acc[ai][bj][m][1]);
            }
    }
};
struct EpiPLE { static constexpr bool CARRY = false; static DI float carry(const Unit&) { return 0.f; } static constexpr bool PERM = false;
    float* H; const bf16_t* PP;
    DI void operator()(const Acc& acc, const Unit& u, int wr, int wc, int fr, int fq) const {
#pragma unroll
        for (int ai = 0; ai < 2; ++ai)
#pragma unroll
            for (int m = 0; m < 4; ++m) {
                const size_t off = (size_t)(u.pm * 256 + EPI_ROWS(ai, m)) * 1024 + u.pn * 256 + 32 * wc + 4 * fq;
#pragma unroll
                for (int bj = 0; bj < 2; ++bj)
#pragma unroll
                    for (int n = 0; n < 2; ++n) {
                        const size_t o = off + 128 * bj + 16 * n;
                        const u32x2 pw = *(const u32x2*)(PP + o); const f32x4 a = acc[ai][bj][m][n]; f32x4 hv = *(const f32x4*)(H + o);
                        hv[0] += sigm(a[0] * WSC) * bflo(pw.x); hv[1] += sigm(a[1] * WSC) * bfhi(pw.x); hv[2] += sigm(a[2] * WSC) * bflo(pw.y); hv[3] += sigm(a[3] * WSC) * bfhi(pw.y);
                        *(f32x4*)(H + o) = hv;
                    }
            }
    }
};

DI int vperm16(int key) { const int g = (key >> 2) & 3; const int ng = (g == 1) ? 2 : (g == 2) ? 1 : g; return (key & ~15) | (ng << 2) | (key & 3); }
template <int DV, int MODE>
DI void attn_unit(const int WID, LAS unsigned char* lds, const bf16_t* Qp, int ldq, const bf16_t* Kp, int ldk, const bf16_t* Vt, int ldvt, int q0, float slope, int dcut,
                  const unsigned* selp, bf16_t* Op, int ldo, float* impp) {
    constexpr int NRB = DV / 32;
    constexpr int KT_B = 64 * 128, VT_B = DV * 128, BUF_B = 2 * KT_B + 2 * VT_B;
    const int tid = opaque_tid(WID), w = __builtin_amdgcn_readfirstlane(tid >> 6), lane = tid & 63, r = lane & 31, hh = lane >> 5;
    const int qrow = q0 + 32 * w + r, qw_first = q0 + 32 * w, qw_last = qw_first + 31;
    const float LOG2E = 1.44269504089f;
    bf16x8 qf[4];
#pragma unroll
    for (int ks = 0; ks < 4; ++ks) qf[ks] = *(const bf16x8*)(Qp + (size_t)(32 * w + r) * ldq + 16 * ks + 8 * hh);
    unsigned selm = 0xffffffffu, orm = 0xffffffffu;
    if (MODE == 1) { selm = selp[32 * w + r]; orm = selm;
#pragma unroll
        for (int o = 1; o < 32; o <<= 1) orm |= shxu(orm, o); }
    const int nv = (MODE == 3) ? (qrow >= 31 ? ((qrow - 15) >> 4) : 0) : 0;
    const int nv_wmax = (MODE == 3) ? (qw_last >= 31 ? ((qw_last - 15) >> 4) : 0) : 0;
    int kt_lo = 0, kt_hi;
    if (MODE == 0 || MODE == 1) kt_hi = (q0 >> 6) + 4;
    else if (MODE == 2) { kt_hi = (q0 >> 6) + 4; const int lk = q0 - 511; kt_lo = lk > 0 ? (lk >> 6) : 0; }
    else kt_hi = 2;
    if (MODE != 3) { const int kmin = q0 - dcut; const int lo2 = kmin > 0 ? (kmin >> 6) : 0; kt_lo = lo2 > kt_lo ? lo2 : kt_lo; }
    f32x16 cb[2];
#pragma unroll
    for (int kk = 0; kk < 2; ++kk)
#pragma unroll
        for (int i = 0; i < 16; ++i) cb[kk][i] = (MODE == 3) ? 0.f : slope * (float)(32 * kk + 8 * (i >> 2) + (i & 3) + 4 * hh);
    f32x16 O[NRB];
#pragma unroll
    for (int rb = 0; rb < NRB; ++rb)
#pragma unroll
        for (int i = 0; i < 16; ++i) O[rb][i] = 0.f;
    float mrun = NEGF, lrun = 0.f;
    const int drow = tid >> 3, dpc = (tid & 7) ^ ((drow >> 1) & 7);
    const unsigned ldsw = (unsigned)w * 1024u;
#define AT_DMA(buf, sub, kt) do { const int kt_ = (kt) < 0 ? 0 : (kt); LAS unsigned char* b_ = lds + (buf) * BUF_B; \
        __builtin_amdgcn_global_load_lds((const unsigned*)(Kp + (size_t)(64 * kt_ + drow) * ldk + 8 * dpc), (LAS unsigned*)(b_ + (sub) * KT_B + ldsw), 16, 0, 0); \
        _Pragma("unroll") for (int i_ = 0; i_ < (DV + 63) / 64; ++i_) { if (64 * i_ + 64 <= DV || w < 4) \
            __builtin_amdgcn_global_load_lds((const unsigned*)(Vt + (size_t)(drow + 64 * i_) * ldvt + 64 * kt_ + 8 * dpc), (LAS unsigned*)(b_ + 2 * KT_B + (sub) * VT_B + i_ * 8192 + ldsw), 16, 0, 0); } } while (0)
    const int ntile = kt_hi - kt_lo, nstep = (ntile + 1) >> 1;
    AT_DMA(0, 0, kt_hi - 1); AT_DMA(0, 1, kt_hi - 2);
    asm volatile("s_waitcnt vmcnt(0)" ::: "memory");
    __syncthreads();
#if PROBE_ATT == 2
    AT_DMA(0, 0, kt_hi - 1); AT_DMA(0, 1, kt_hi - 2);
    asm volatile("s_waitcnt vmcnt(0)" ::: "memory");
    __syncthreads();
#endif
    const int sw = (r >> 1) & 7;
    for (int st = 0; st < nstep; ++st) {
        const int buf = st & 1;
        if (st + 1 < nstep) { AT_DMA(buf ^ 1, 0, kt_hi - 3 - 2 * st); AT_DMA(buf ^ 1, 1, kt_hi - 4 - 2 * st); }
#pragma unroll
        for (int sub = 0; sub < 2; ++sub) {
        const int kt = kt_hi - 1 - 2 * st - sub, key0 = 64 * kt;
        bool skip;
        if (MODE == 0) skip = key0 > qw_last;
        else if (MODE == 1) skip = (key0 > qw_last) || !((orm >> (kt & 31)) & 1u);
        else if (MODE == 2) skip = (key0 > qw_last) || (key0 + 63 < qw_first - 511);
        else skip = key0 >= nv_wmax;
        skip = skip || (kt < kt_lo);
        if (!skip) {
            const LAS unsigned char* kb = lds + buf * BUF_B + sub * KT_B; const LAS unsigned char* vb = lds + buf * BUF_B + 2 * KT_B + sub * VT_B;
            f32x16 S[2];
#pragma unroll
            for (int kk = 0; kk < 2; ++kk) {
                S[kk] = cb[kk];
#pragma unroll
                for (int ks = 0; ks < 4; ++ks) { const bf16x8 a = *(const LAS bf16x8*)(kb + (32 * kk + r) * 128 + (((2 * ks + hh) ^ sw) << 4));
                    S[kk] = __builtin_amdgcn_mfma_f32_32x32x16_bf16(a, qf[ks], S[kk], 0, 0, 0); }
            }
            const bool bnd = (MODE == 3) ? true : ((key0 + 63 > qw_first) || (MODE == 2 && key0 < qw_last - 511));
            if (bnd) {
                const int lim = (MODE == 3) ? (nv - key0 - 4 * hh) : (qrow - key0 - 4 * hh);
#pragma unroll
                for (int kk = 0; kk < 2; ++kk)
#pragma unroll
                    for (int i = 0; i < 16; ++i) { const int cki = 32 * kk + 8 * (i >> 2) + (i & 3);
                        bool valid;
                        if (MODE == 3) valid = cki < lim; else if (MODE == 2) valid = (cki <= lim) && (cki > lim - 512); else valid = cki <= lim;
                        S[kk][i] = valid ? S[kk][i] : NEGF; }
            }
            float mx = NEGF;
#pragma unroll
            for (int kk = 0; kk < 2; ++kk)
#pragma unroll
                for (int i = 0; i < 16; ++i) mx = fmaxf(mx, S[kk][i]);
            mx = fmaxf(mx, shx(mx, 32));
            const float off = (MODE == 3) ? 0.f : slope * (float)key0;
            mx += off;
            bool selok = true;
            if (MODE == 1) { selok = ((selm >> (kt & 31)) & 1u) != 0u; mx = selok ? mx : NEGF; }
            const float mnew = fmaxf(mrun, mx);
            const float meff = (mnew < -1e29f) ? 0.f : mnew;
            float c = (off - meff) * LOG2E;
            if (MODE == 1) c = selok ? c : NEGF;
            float ps = 0.f;
#pragma unroll
            for (int kk = 0; kk < 2; ++kk)
#pragma unroll
                for (int i = 0; i < 16; ++i) { const float p = __builtin_amdgcn_exp2f(__builtin_fmaf(S[kk][i], LOG2E, c)); S[kk][i] = p; ps += p; }
            if (__any(mnew > mrun)) {
                const float alpha = __builtin_amdgcn_exp2f((mrun - mnew) * LOG2E);
                lrun *= alpha;
#pragma unroll
                for (int rb = 0; rb < NRB; ++rb)
#pragma unroll
                    for (int i = 0; i < 16; ++i) O[rb][i] *= alpha;
            }
            mrun = mnew; lrun += ps;
#pragma unroll
            for (int kk = 0; kk < 2; ++kk)
#pragma unroll
                for (int s2 = 0; s2 < 2; ++s2) {
                    u32x4 pw; pw.x = pk2(S[kk][8 * s2 + 0], S[kk][8 * s2 + 1]); pw.y = pk2(S[kk][8 * s2 + 2], S[kk][8 * s2 + 3]);
                    pw.z = pk2(S[kk][8 * s2 + 4], S[kk][8 * s2 + 5]); pw.w = pk2(S[kk][8 * s2 + 6], S[kk][8 * s2 + 7]);
                    const bf16x8 pf = __builtin_bit_cast(bf16x8, pw);
#pragma unroll
                    for (int rb = 0; rb < NRB; ++rb) {
                        const bf16x8 a = *(const LAS bf16x8*)(vb + (32 * rb + r) * 128 + ((((2 * kk + s2) * 2 + hh) ^ sw) << 4));
                        O[rb] = __builtin_amdgcn_mfma_f32_32x32x16_bf16(a, pf, O[rb], 0, 0, 0);
                    }
                }
        }
        }
        asm volatile("s_waitcnt vmcnt(0)" ::: "memory");
        __syncthreads();
    }
#undef AT_DMA
    const float ltot = lrun + shx(lrun, 32);
    float inv = 1.0f / ltot;
    if (MODE == 3) inv = (nv > 0) ? inv : 0.f;
#if PROBE_ATT == 1
    for (int rep_ = 0; rep_ < 2; ++rep_) { asm volatile("" ::: "memory");
#endif
#pragma unroll
    for (int rb = 0; rb < NRB; ++rb)
#pragma unroll
        for (int g4 = 0; g4 < 4; ++g4) {
            const float a = O[rb][4 * g4] * inv, b = O[rb][4 * g4 + 1] * inv, c = O[rb][4 * g4 + 2] * inv, d = O[rb][4 * g4 + 3] * inv;
            const int dv = 32 * rb + 8 * g4 + 4 * hh;
            if (MODE == 3 && rb == 2) { *(f32x4*)(impp + (size_t)(32 * w + r) * 256 + (dv - 64)) = (f32x4){a, b, c, d}; }
            else { u32x2 o; o.x = pk2(a, b); o.y = pk2(c, d); *(u32x2*)(Op + (size_t)(32 * w + r) * ldo + dv) = o; }
        }
#if PROBE_ATT == 1
    }
#endif
}

struct Args { const float* in[26]; float* out; unsigned char* ws; int ph_lo, ph_hi; };
typedef const __attribute__((address_space(4))) Args* ArgsP;
DI ArgsP opaque_args() { auto p = __builtin_amdgcn_kernarg_segment_ptr(); asm volatile("" : "+s"(p)); return (ArgsP)p; }
enum { I_X = 0, I_P, I_N1G, I_N2G, I_EVWIN, I_EVWOUT, I_DAQN, I_DAKN, I_DALAM, I_DAOUTG, I_NSQN, I_NSKN, I_CMPPE, I_CMPW1, I_CMPW2, I_ODWIN, I_ODWOUT,
       I_RETG, I_ROUTW, I_ROUTB, I_WGU, I_BGU, I_WDN, I_BDN, I_PLEP, I_PLEG };

struct CvtJob { int in_idx, ldsrc, K, col0, ncols, dstrow0, perm, nmat; size_t src_stride, dst_off, dst_stride; int fp8, pad; };
constexpr int NJOBS = 19;
__constant__ CvtJob c_jobs[NJOBS] = {
    {I_EVWIN, EVIN, 1024, 0,    1024, 0,    1, 2, (size_t)1024 * EVIN, WS_EVNAT, (size_t)2048 * 1024, 0, 0},
    {I_EVWIN, EVIN, 1024, 1536, 512,  1024, 1, 2, (size_t)1024 * EVIN, WS_EVNAT, (size_t)2048 * 1024, 0, 0},
    {I_EVWIN, EVIN, 1024, 2048, 128,  1536, 1, 2, (size_t)1024 * EVIN, WS_EVNAT, (size_t)2048 * 1024, 0, 0},
    {I_EVWIN, EVIN, 1024, 2176, 128,  1664, 1, 2, (size_t)1024 * EVIN, WS_EVNAT, (size_t)2048 * 1024, 0, 0},
    {I_EVWIN, EVIN, 1024, 2304, 128,  1792, 1, 2, (size_t)1024 * EVIN, WS_EVNAT, (size_t)2048 * 1024, 0, 0},
    {I_EVWIN, EVIN, 1024, 2560, 128,  1920, 1, 2, (size_t)1024 * EVIN, WS_EVNAT, (size_t)2048 * 1024, 0, 0},
    {I_EVWIN, EVIN, 1024, 1024, 512,  0,    0, 2, (size_t)1024 * EVIN, WS_EVSW,  (size_t)768 * 1024, 0, 0},
    {I_EVWIN, EVIN, 1024, 2432, 128,  512,  0, 2, (size_t)1024 * EVIN, WS_EVSW,  (size_t)768 * 1024, 0, 0},
    {I_EVWIN, EVIN, 1024, 2688, 128,  640,  0, 2, (size_t)1024 * EVIN, WS_EVSW,  (size_t)768 * 1024, 0, 0},
    {I_EVWOUT, 1024, 1024, 0, 1024, 0, 0, 2, (size_t)1024 * 1024, WS_EVOUT, (size_t)1024 * 1024, 0, 0},
    {I_CMPW1, 256, 2048, 0, 256, 0, 0, 4, (size_t)2048 * 256, WS_CMP1, (size_t)256 * 2048, 0, 0},
    {I_ODWIN, ODIN, 1024, 0,    2048, 0,    0, 2, (size_t)1024 * ODIN, WS_ODNAT, (size_t)4096 * 1024, 0, 0},
    {I_ODWIN, ODIN, 1024, 4096, 2048, 2048, 0, 2, (size_t)1024 * ODIN, WS_ODNAT, (size_t)4096 * 1024, 0, 0},
    {I_ODWIN, ODIN, 1024, 2048, 2048, 0,    0, 2, (size_t)1024 * ODIN, WS_ODSW,  (size_t)2048 * 1024, 0, 0},
    {I_ODWOUT, 1024, 2048, 0, 1024, 0, 0, 2, (size_t)2048 * 1024, WS_ODOUT, (size_t)1024 * 2048, 0, 0},
    {I_WGU, 2048, 1024, 0, 2048, 0, 2, 128, (size_t)1024 * 2048, WS_WGU, (size_t)2048 * 1024, 32, 0},
    {I_WDN, 1024, 1024, 0, 1024, 0, 0, 128, (size_t)1024 * 1024, WS_WDN, (size_t)1024 * 1024, 64, 0},
    {I_PLEP, 1024, 256, 0, 1024, 0, 0, 4, (size_t)256 * 1024, WS_WPP, (size_t)1024 * 256, 0, 0},
    {I_PLEG, 1024, 1024, 0, 1024, 0, 0, 4, (size_t)1024 * 1024, WS_WPG, (size_t)1024 * 1024, 32, 0},
};
DI int cvt_dstrow(int perm, int L) {
    if (perm == 1) { const int pn = L >> 8, lc = L & 255; return pn * 256 + 128 * ((lc & 63) >> 5) + 32 * (lc >> 6) + (lc & 31); }
    if (perm == 2) { const int bj = L >> 10, cc = L & 1023; return 256 * (cc >> 7) + 128 * bj + (cc & 127); }
    return L;
}
DI void phase_prologue(const int WID, ArgsP a, LAS unsigned char* lds) {
    const int tid = opaque_tid(WID), lane = tid & 63, wv = tid >> 6;
    const int gw = blockIdx.x * 8 + wv, NGW = gridDim.x * 8;
    LAS float* scr = (LAS float*)(lds + wv * 16896);
    int total = 0;
    for (int j = 0; j < NJOBS; ++j) total += c_jobs[j].nmat * (c_jobs[j].K >> 6) * (c_jobs[j].ncols >> 6);
#define PRO_DECODE(IT, JJ, MAT, K0, N0, SRC, RS) do { int r_ = (IT), j_ = 0; \
        for (; j_ < NJOBS; ++j_) { const int n_ = c_jobs[j_].nmat * (c_jobs[j_].K >> 6) * (c_jobs[j_].ncols >> 6); if (r_ < n_) break; r_ -= n_; } \
        JJ = j_; const bool f8_ = c_jobs[j_].fp8 != 0; const int nkb_ = f8_ ? (c_jobs[j_].K >> 7) : (c_jobs[j_].K >> 6), nnb_ = f8_ ? (c_jobs[j_].ncols >> 5) : (c_jobs[j_].ncols >> 6), per_ = nkb_ * nnb_; \
        MAT = r_ / per_; const int rr_ = r_ % per_; K0 = (rr_ / nnb_) * (f8_ ? 128 : 64); N0 = (rr_ % nnb_) * (f8_ ? 32 : 64); const int ld_ = c_jobs[j_].ldsrc; \
        SRC = a->in[c_jobs[j_].in_idx] + (size_t)MAT * c_jobs[j_].src_stride + (size_t)K0 * ld_ + c_jobs[j_].col0 + N0 + (f8_ ? (lane & 31) + (lane >> 5) * ld_ : lane); RS = f8_ ? 2 * ld_ : ld_; } while (0)
    float tv[64];
    int jn = 0, matn = 0, k0n = 0, n0n = 0, rsn = 0; const float* srcn = nullptr;
    if (gw < total) { PRO_DECODE(gw, jn, matn, k0n, n0n, srcn, rsn);
#pragma unroll
        for (int i = 0; i < 64; ++i) tv[i] = srcn[(size_t)i * rsn]; }
    for (int it = gw; it < total; it += NGW) {
        const CvtJob J = c_jobs[jn]; const int mat = matn, k0 = k0n, n0 = n0n;
        { const int wb = J.fp8 ? (lane >> 5) * 33 + (lane & 31) : lane, wst = J.fp8 ? 66 : 65;
#pragma unroll
          for (int i = 0; i < 64; ++i) scr[wb + i * wst] = tv[i]; }
        if (it + NGW < total) { PRO_DECODE(it + NGW, jn, matn, k0n, n0n, srcn, rsn);
#pragma unroll
            for (int i = 0; i < 64; ++i) tv[i] = srcn[(size_t)i * rsn]; }
        asm volatile("s_waitcnt lgkmcnt(0)" ::: "memory");
        if (J.fp8) {
            unsigned char* dst = (unsigned char*)(a->ws + J.dst_off) + (size_t)mat * J.dst_stride;
            const int c = lane & 7, nsub = lane >> 3; const float W8_S = (float)J.fp8;
#pragma unroll
            for (int jj = 0; jj < 4; ++jj) {
                const int n = nsub + 8 * jj; const LAS float* s = scr + (16 * c) * 33 + n;
                u32x4 o;
                o.x = pk4_fp8(s[0] * W8_S, s[33] * W8_S, s[2 * 33] * W8_S, s[3 * 33] * W8_S); o.y = pk4_fp8(s[4 * 33] * W8_S, s[5 * 33] * W8_S, s[6 * 33] * W8_S, s[7 * 33] * W8_S);
                o.z = pk4_fp8(s[8 * 33] * W8_S, s[9 * 33] * W8_S, s[10 * 33] * W8_S, s[11 * 33] * W8_S); o.w = pk4_fp8(s[12 * 33] * W8_S, s[13 * 33] * W8_S, s[14 * 33] * W8_S, s[15 * 33] * W8_S);
                const int drow = cvt_dstrow(J.perm, J.dstrow0 + n0 + n);
                *(u32x4*)(dst + (size_t)drow * J.K + k0 + 16 * c) = o;
            }
        } else {
            bf16_t* dst = (bf16_t*)(a->ws + J.dst_off) + (size_t)mat * J.dst_stride;
            const int c = lane & 7, nsub = lane >> 3;
#pragma unroll
            for (int jj = 0; jj < 8; ++jj) {
                const int n = nsub + 8 * jj; const LAS float* s = scr + (8 * c) * 65 + n;
                u32x4 o; o.x = pk2(s[0], s[65]); o.y = pk2(s[2 * 65], s[3 * 65]); o.z = pk2(s[4 * 65], s[5 * 65]); o.w = pk2(s[6 * 65], s[7 * 65]);
                const int drow = cvt_dstrow(J.perm, J.dstrow0 + n0 + n);
                *(u32x4*)(dst + (size_t)drow * J.K + k0 + 8 * c) = o;
            }
        }
        asm volatile("s_waitcnt lgkmcnt(0)" ::: "memory");
    }
#undef PRO_DECODE
    {
        const float* p = a->in[I_P]; bf16_t* pb = (bf16_t*)(a->ws + WS_PBF);
        const size_t n8 = (size_t)DEPTH * T * 256 / 8;
        for (size_t i = (size_t)blockIdx.x * 512 + tid; i < n8; i += (size_t)gridDim.x * 512) {
            const f32x4 v0 = *(const f32x4*)(p + i * 8), v1 = *(const f32x4*)(p + i * 8 + 4);
            *(u32x4*)(pb + i * 8) = pack8(v0, v1);
        }
    }
    if (blockIdx.x == 4 && tid < 512) { const int ev = tid >> 8, gi = (tid >> 6) & 3, d = tid & 63;
        const float* src = a->in[gi == 0 ? I_DAQN : gi == 1 ? I_DAKN : gi == 2 ? I_NSQN : I_NSKN];
        ((float*)(a->ws + WS_GAINS))[tid] = src[ev * 64 + d]; }
    if (blockIdx.x < 4 && tid < 256) {
        const int m = blockIdx.x; const float* pe = a->in[I_CMPPE] + (size_t)m * 2048; const float* w1 = a->in[I_CMPW1] + (size_t)m * 2048 * 256;
        float s = 0.f;
        for (int k = 0; k < 2048; ++k) s += pe[k] * w1[(size_t)k * 256 + tid];
        ((float*)(a->ws + WS_BIAS1))[m * 256 + tid] = s;
    }
}

DI float row_load_ss(const float* row, int lane, f32x4 (&v)[4]) {
    float ss = 0.f;
#pragma unroll
    for (int j = 0; j < 4; ++j) { v[j] = *(const f32x4*)(row + 4 * lane + 256 * j); ss += (v[j][0] * v[j][0] + v[j][1] * v[j][1]) + (v[j][2] * v[j][2] + v[j][3] * v[j][3]); }
    return wave_sum(ss);
}
DI void row_store_bf16(bf16_t* row, int lane, const f32x4 (&v)[4]) {
#pragma unroll
    for (int j = 0; j < 4; ++j) { u32x2 o; o.x = pk2(v[j][0], v[j][1]); o.y = pk2(v[j][2], v[j][3]); *(u32x2*)(row + 4 * lane + 256 * j) = o; }
}
template <int MODE>
DI void phase_norm(const int WID, ArgsP a, LAS unsigned char* lds, int layer, const float* Hin) {
    const int tid = opaque_tid(WID), lane = tid & 63, wv = __builtin_amdgcn_readfirstlane(tid >> 6);
    LAS float* wt = (LAS float*)lds;
    LAS int* bcl = (LAS int*)(lds + MISC_OFF + MO_WCNT); LAS int* ent = (LAS int*)(lds + MISC_OFF + MO_ENT); LAS float* gat = (LAS float*)(lds + MISC_OFF + MO_GAT);
    LAS float* lgb = (LAS float*)(lds + MISC_OFF + MO_RED);
    bf16_t* XN = (bf16_t*)(a->ws + WS_XN);
    const float* gain = a->in[MODE == 2 ? I_N2G : I_N1G] + layer * 1024;
    constexpr int NQ = MODE == 0 ? 24 : (MODE == 2 ? 32 : 0);
    if (NQ > 0) {
        const float* w = (MODE == 0) ? a->in[I_EVWIN] + (size_t)(layer >> 1) * 1024 * EVIN + 2816 : a->in[I_ROUTW] + (size_t)layer * 1024 * 32;
        const int ldw = (MODE == 0) ? EVIN : 32;
        for (int i = tid; i < 256 * 32; i += 512) { const int q = i & 31, g = i >> 5;
            if (q < NQ) { f32x4 v; v[0] = w[(size_t)(4 * g) * ldw + q]; v[1] = w[(size_t)(4 * g + 1) * ldw + q]; v[2] = w[(size_t)(4 * g + 2) * ldw + q]; v[3] = w[(size_t)(4 * g + 3) * ldw + q];
                *(LAS f32x4*)(wt + q * 1024 + 4 * (g ^ q)) = v; } }
    }
    f32x4 gn[4];
#pragma unroll
    for (int j = 0; j < 4; ++j) gn[j] = *(const f32x4*)(gain + 4 * lane + 256 * j);
    const float rbias = (MODE == 2) ? a->in[I_ROUTB][layer * 32 + (lane & 31)] : 0.f;
    __syncthreads();
    for (int vb = blockIdx.x; vb < NTB; vb += gridDim.x) {
        if (MODE == 2) { if (tid < 32) bcl[tid] = 0; }
        const int t0 = vb * 128 + wv * 16;
        f32x4 na[4], nb[4];
#pragma unroll
        for (int j = 0; j < 4; ++j) { na[j] = *(const f32x4*)(Hin + (size_t)t0 * 1024 + 4 * lane + 256 * j); nb[j] = *(const f32x4*)(Hin + (size_t)(t0 + 1) * 1024 + 4 * lane + 256 * j); }
#pragma unroll 1
        for (int it = 0; it < 8; ++it) {
            const int ta = t0 + 2 * it;
            f32x4 va[4], vc[4];
#pragma unroll
            for (int j = 0; j < 4; ++j) { va[j] = na[j]; vc[j] = nb[j]; }
            if (it < 7) {
#pragma unroll
                for (int j = 0; j < 4; ++j) { na[j] = *(const f32x4*)(Hin + (size_t)(ta + 2) * 1024 + 4 * lane + 256 * j); nb[j] = *(const f32x4*)(Hin + (size_t)(ta + 3) * 1024 + 4 * lane + 256 * j); }
            }
            float sa = 0.f, sb = 0.f;
#pragma unroll
            for (int j = 0; j < 4; ++j) { sa += (va[j][0] * va[j][0] + va[j][1] * va[j][1]) + (va[j][2] * va[j][2] + va[j][3] * va[j][3]); sb += (vc[j][0] * vc[j][0] + vc[j][1] * vc[j][1]) + (vc[j][2] * vc[j][2] + vc[j][3] * vc[j][3]); }
#pragma unroll
            for (int o = 1; o < 64; o <<= 1) { sa += shx(sa, o); sb += shx(sb, o); }
            const float ra = rsqrtf(sa * (1.0f / 1024.0f) + EPS), rb2 = rsqrtf(sb * (1.0f / 1024.0f) + EPS);
#pragma unroll
            for (int j = 0; j < 4; ++j) { va[j] = va[j] * ra * gn[j]; vc[j] = vc[j] * rb2 * gn[j]; }
            row_store_bf16(XN + (size_t)ta * 1024, lane, va); row_store_bf16(XN + (size_t)(ta + 1) * 1024, lane, vc);
            if (NQ > 0) {
                float x[64];
#pragma unroll
                for (int q = 0; q < 32; ++q) {
                    if (q < NQ) { float s0 = 0.f, s1 = 0.f;
#pragma unroll
                        for (int j = 0; j < 4; ++j) { const f32x4 ww = *(const LAS f32x4*)(wt + q * 1024 + 4 * ((lane + 64 * j) ^ q));
                            s0 += (va[j][0] * ww[0] + va[j][1] * ww[1]) + (va[j][2] * ww[2] + va[j][3] * ww[3]); s1 += (vc[j][0] * ww[0] + vc[j][1] * ww[1]) + (vc[j][2] * ww[2] + vc[j][3] * ww[3]); }
                        x[q] = s0; x[32 + q] = s1;
                        if ((q & 3) == 3) asm volatile("" ::: "memory");
                    } else { x[q] = 0.f; x[32 + q] = 0.f; }
                }
#define RS_STEP(N, BIT) _Pragma("unroll") for (int i = 0; i < (N); ++i) { const bool up = (lane & (BIT)) != 0; const float keep = up ? x[(N) + i] : x[i], send = up ? x[i] : x[(N) + i]; x[i] = keep + shx(send, (BIT)); }
                RS_STEP(32, 32) RS_STEP(16, 16) RS_STEP(8, 8) RS_STEP(4, 4) RS_STEP(2, 2) RS_STEP(1, 1)
#undef RS_STEP
                const float val = x[0];
                if (MODE == 0) { if ((lane & 31) < 24) ((float*)(a->ws + WS_GATES))[(size_t)(ta + (lane >> 5)) * 24 + (lane & 31)] = sigm(val); }
                if (MODE == 2) {
                    lgb[wv * 64 + lane] = val + rbias;
                    asm volatile("s_waitcnt lgkmcnt(0)" ::: "memory");
                    float lg[32];
#pragma unroll
                    for (int q4 = 0; q4 < 8; ++q4) { const f32x4 t4 = *(const LAS f32x4*)(lgb + wv * 64 + (lane & 32) + 4 * q4); lg[4 * q4] = t4[0]; lg[4 * q4 + 1] = t4[1]; lg[4 * q4 + 2] = t4[2]; lg[4 * q4 + 3] = t4[3]; }
                    unsigned used = 0u; int te[4]; float tv[4];
#pragma unroll
                    for (int k = 0; k < 4; ++k) { float best = -3.0e38f; int bi = 0;
#pragma unroll
                        for (int q = 0; q < 32; ++q) { const bool ok = !((used >> q) & 1u) && (lg[q] > best); best = ok ? lg[q] : best; bi = ok ? q : bi; }
                        used |= 1u << bi; te[k] = bi; tv[k] = best; }
                    float ex[4], sum = 0.f;
#pragma unroll
                    for (int k = 0; k < 4; ++k) { ex[k] = __expf(tv[k] - tv[0]); sum += ex[k]; }
                    const float rs = 1.0f / sum;
                    if ((lane & 31) == 0) {
                        const int eb = wv * 64 + (2 * it + (lane >> 5)) * 4;
#pragma unroll
                        for (int k = 0; k < 4; ++k) { ent[eb + k] = te[k]; gat[eb + k] = ex[k] * rs; }
                    }
                    asm volatile("s_waitcnt lgkmcnt(0)" ::: "memory");
                }
            }
        }
        if (MODE == 2) {
            __syncthreads();
            { const int e = ent[wv * 64 + lane];
              const int pos = __hip_atomic_fetch_add(bcl + e, 1, __ATOMIC_RELAXED, __HIP_MEMORY_SCOPE_WORKGROUP);
              const size_t idx = (size_t)(vb * 128 + wv * 16) * 4 + lane;
              ((int*)(a->ws + WS_TOPE))[idx] = e; ((int*)(a->ws + WS_POSB))[idx] = pos; ((float*)(a->ws + WS_GATEW))[idx] = gat[wv * 64 + lane]; }
            __syncthreads();
            if (tid < 32) ((int*)(a->ws + WS_BCNT))[((size_t)layer * NTB + vb) * 32 + tid] = bcl[tid];
            __syncthreads();
        }
    }
}
DI void moe_tables(const int WID, ArgsP a, LAS unsigned char* lds, int layer, int vb) {
    const int tid = opaque_tid(WID);
    LAS int* tot = (LAS int*)(lds + MISC_OFF + MO_TOT); LAS int* base = (LAS int*)(lds + MISC_OFF + MO_BASE); LAS int* ts = (LAS int*)(lds + MISC_OFF + MO_TS);
    LAS int* red = (LAS int*)(lds + MISC_OFF + MO_RED);
    const int* bc = (const int*)(a->ws + WS_BCNT) + (size_t)layer * NTB * 32;
    { const int e = tid & 31, part = tid >> 5; int st = 0, sp = 0;
      for (int blk = part; blk < NTB; blk += 16) { const int v = bc[blk * 32 + e]; st += v; sp += (blk < vb) ? v : 0; }
      red[part * 32 + e] = st; red[512 + part * 32 + e] = sp; }
    __syncthreads();
    if (tid < 32) { int st = 0, sp = 0;
#pragma unroll
        for (int p = 0; p < 16; ++p) { st += red[p * 32 + tid]; sp += red[512 + p * 32 + tid]; }
        tot[tid] = st; base[tid] = sp; }
    __syncthreads();
    if (tid == 0) { int acc = 0; for (int e = 0; e < 32; ++e) { ts[e] = acc; acc += (tot[e] + 255) >> 8; } ts[32] = acc; }
    __syncthreads();
}
DI void phase_moe_slots(const int WID, ArgsP a, LAS unsigned char* lds, int layer) {
    const int tid = opaque_tid(WID), lane = tid & 63, wv = tid >> 6;
    LAS int* base = (LAS int*)(lds + MISC_OFF + MO_BASE); LAS int* ts = (LAS int*)(lds + MISC_OFF + MO_TS);
    const bf16_t* XN = (const bf16_t*)(a->ws + WS_XN); unsigned char* XB = (unsigned char*)(a->ws + WS_XB);
    for (int vb = blockIdx.x; vb < NTB; vb += gridDim.x) {
        moe_tables(WID, a, lds, layer, vb);
#pragma unroll 1
        for (int i = 0; i < 16; ++i) {
            const int t = vb * 128 + wv * 16 + i;
            int dest = 0;
            if (lane < 4) { const int e = ((const int*)(a->ws + WS_TOPE))[(size_t)t * 4 + lane], pos = ((const int*)(a->ws + WS_POSB))[(size_t)t * 4 + lane];
                dest = ts[e] * 256 + base[e] + pos; ((int*)(a->ws + WS_DEST))[(size_t)t * 4 + lane] = dest; }
            const u32x4 r0 = *(const u32x4*)(XN + (size_t)t * 1024 + 8 * lane), r1 = *(const u32x4*)(XN + (size_t)t * 1024 + 512 + 8 * lane);
            u32x2 q0, q1;
            q0.x = pk4_fp8(bflo(r0.x), bfhi(r0.x), bflo(r0.y), bfhi(r0.y)); q0.y = pk4_fp8(bflo(r0.z), bfhi(r0.z), bflo(r0.w), bfhi(r0.w));
            q1.x = pk4_fp8(bflo(r1.x), bfhi(r1.x), bflo(r1.y), bfhi(r1.y)); q1.y = pk4_fp8(bflo(r1.z), bfhi(r1.z), bflo(r1.w), bfhi(r1.w));
#pragma unroll
            for (int k = 0; k < 4; ++k) { const int d = __builtin_amdgcn_readlane(dest, k); unsigned char* o = XB + (size_t)d * 1024; *(u32x2*)(o + 8 * lane) = q0; *(u32x2*)(o + 512 + 8 * lane) = q1; }
        }
        __syncthreads();
    }
}
DI void phase_combine(const int WID, ArgsP a, float* H) {
    const int tid = opaque_tid(WID), lane = tid & 63, wv = tid >> 6;
    const bf16_t* YB = (const bf16_t*)(a->ws + WS_YB); unsigned char* XN8 = (unsigned char*)(a->ws + WS_XN);
    for (int t = blockIdx.x * 8 + wv; t < T; t += gridDim.x * 8) {
        int dest = 0; float gw = 0.f;
        if (lane < 4) { dest = ((const int*)(a->ws + WS_DEST))[(size_t)t * 4 + lane]; gw = ((const float*)(a->ws + WS_GATEW))[(size_t)t * 4 + lane]; }
        f32x4 v[4];
#pragma unroll
        for (int j = 0; j < 4; ++j) v[j] = *(const f32x4*)(H + (size_t)t * 1024 + 4 * lane + 256 * j);
#pragma unroll
        for (int k = 0; k < 4; ++k) { const int d = __builtin_amdgcn_readlane(dest, k); const float g = __builtin_bit_cast(float, __builtin_amdgcn_readlane(__builtin_bit_cast(int, gw), k)); const bf16_t* y = YB + (size_t)d * 1024;
#pragma unroll
            for (int j = 0; j < 4; ++j) { const u32x2 w = *(const u32x2*)(y + 4 * lane + 256 * j); v[j][0] += g * bflo(w.x); v[j][1] += g * bfhi(w.x); v[j][2] += g * bflo(w.y); v[j][3] += g * bfhi(w.y); } }
        float ss = 0.f;
#pragma unroll
        for (int j = 0; j < 4; ++j) { *(f32x4*)(H + (size_t)t * 1024 + 4 * lane + 256 * j) = v[j]; ss += (v[j][0] * v[j][0] + v[j][1] * v[j][1]) + (v[j][2] * v[j][2] + v[j][3] * v[j][3]); }
        ss = wave_sum(ss);
        const float rstd = rsqrtf(ss * (1.0f / 1024.0f) + EPS);
#pragma unroll
        for (int j = 0; j < 4; ++j) v[j] = v[j] * rstd;
#pragma unroll
        for (int j = 0; j < 4; ++j) *(unsigned*)(XN8 + (size_t)t * 1024 + 4 * lane + 256 * j) = pk4_fp8(v[j][0], v[j][1], v[j][2], v[j][3]);
    }
}
DI void phase_cmp2(const int WID, ArgsP a, LAS unsigned char* lds, int ev) {
    const int tid = opaque_tid(WID), lane = tid & 63, wv = __builtin_amdgcn_readfirstlane(tid >> 6);
    const bf16_t* HID = (const bf16_t*)(a->ws + WS_HID); bf16_t* KCMP = (bf16_t*)(a->ws + WS_KCMP); bf16_t* VCMPT = (bf16_t*)(a->ws + WS_VCMPT);
    const float kg = a->in[I_NSKN][ev * 64 + lane];
    LAS float* wl = (LAS float*)lds;
    for (int i = tid; i < 2 * 256 * 64 / 4; i += 512) *(LAS f32x4*)(wl + 4 * i) = *(const f32x4*)(a->in[I_CMPW2] + (size_t)ev * 2 * 256 * 64 + 4 * i);
    __syncthreads();
    for (int gi = blockIdx.x * 8 + wv; gi < 2048; gi += gridDim.x * 8) {
        const int kv = gi >> 10, row0 = (gi & 1023) * 4;
        const bf16_t* hrow = HID + ((size_t)kv * 4096 + row0) * 256;
        const LAS float* w2 = wl + kv * 256 * 64 + lane;
        float s[4] = {0.f, 0.f, 0.f, 0.f};
#pragma unroll 2
        for (int k = 0; k < 256; k += 8) {
            u32x4 hw[4];
#pragma unroll
            for (int r = 0; r < 4; ++r) hw[r] = *(const u32x4*)(hrow + r * 256 + k);
            float wv8[8];
#pragma unroll
            for (int j = 0; j < 8; ++j) wv8[j] = w2[(k + j) * 64];
#pragma unroll
            for (int r = 0; r < 4; ++r)
                s[r] += bflo(hw[r].x) * wv8[0] + bfhi(hw[r].x) * wv8[1] + bflo(hw[r].y) * wv8[2] + bfhi(hw[r].y) * wv8[3] + bflo(hw[r].z) * wv8[4] + bfhi(hw[r].z) * wv8[5] + bflo(hw[r].w) * wv8[6] + bfhi(hw[r].w) * wv8[7];
        }
#pragma unroll
        for (int r = 0; r < 4; ++r) {
            const int row = row0 + r, bg = row >> 7, n = row & 127;
            float v = (n == 127) ? 0.f : s[r];
            if (kv == 0) { const float ss = wave_sum(v * v); const float o = v * rsqrtf(ss * (1.0f / 64.0f) + EPS) * kg;
                KCMP[((size_t)bg * 128 + n) * 64 + lane] = (bf16_t)(pk2(o, 0.f) & 0xffffu); }
            else VCMPT[((size_t)bg * 96 + lane) * 128 + vperm16(n)] = (bf16_t)(pk2(v, 0.f) & 0xffffu);
        }
    }
    for (int i = blockIdx.x * 512 + tid; i < 32 * 32 * 128; i += gridDim.x * 512) {
        const int n = i & 127, j = (i >> 7) & 31, bg = i >> 12;
        float o = 0.f;
        if (n < 127) { const int d = n - 4 * j; if (d >= 0 && d <= 2) o = 1.0f; else if (d == 3 || d == -1) o = 0.5f; }
        VCMPT[((size_t)bg * 96 + 64 + j) * 128 + vperm16(n)] = (bf16_t)(pk2(o, 0.f) & 0xffffu);
    }
}
DI void topk_one(const float* IMPH, unsigned* SELM, int t, int g) {
    const int b = t >> 11, s = t & 2047, cur = s >> 6;
    unsigned mask;
    if (cur < 16) mask = (2u << cur) - 1u;
    else {
        float sc[32];
#pragma unroll
        for (int j4 = 0; j4 < 8; ++j4) { f32x4 acc = {0.f, 0.f, 0.f, 0.f};
#pragma unroll
            for (int r = 0; r < 4; ++r) acc += *(const f32x4*)(IMPH + ((size_t)t * 8 + g * 4 + r) * 32 + 4 * j4);
#pragma unroll
            for (int q = 0; q < 4; ++q) sc[4 * j4 + q] = acc[q]; }
#pragma unroll
        for (int j = 0; j < 32; ++j) { const bool forced = (j == 0) || (j == cur) || (j == cur - 1); sc[j] = (j > cur) ? NEGF : (sc[j] + (forced ? 1e4f : 0.f)); }
        mask = 0u;
#pragma unroll
        for (int j = 0; j < 32; ++j) { int rank = 0;
#pragma unroll
            for (int k = 0; k < 32; ++k) rank += ((sc[k] > sc[j]) || (sc[k] == sc[j] && k < j)) ? 1 : 0;
            mask |= (rank < 16) ? (1u << j) : 0u; }
    }
    SELM[((size_t)(b * 2 + g)) * 2048 + s] = mask;
}
DI void phase_topk(const int WID, ArgsP a) {
    for (int i = blockIdx.x * 512 + opaque_tid(WID); i < T * 2; i += gridDim.x * 512) topk_one((const float*)(a->ws + WS_IMPH), (unsigned*)(a->ws + WS_SELM), i >> 1, i & 1);
}
DI void phase_cmp_topk(const int WID, ArgsP a, LAS unsigned char* lds) {
    const bf16_t* QN = (const bf16_t*)(a->ws + WS_QN);
    float* IMPH = (float*)(a->ws + WS_IMPH);
    for (int u = blockIdx.x; u < 256; u += gridDim.x) {
        const int qb = 7 - (u >> 5), bg = u & 31, b = bg >> 1, g = bg & 1, q0 = qb * 256; const size_t t0 = (size_t)b * 2048 + q0;
#pragma unroll 1
        for (int r = 0; r < 4; ++r) { const int hd = g * 4 + r;
            attn_unit<96, 3>(WID, lds, QN + t0 * 512 + hd * 64, 512, (const bf16_t*)(a->ws + WS_KCMP) + (size_t)bg * 128 * 64, 64,
                             (const bf16_t*)(a->ws + WS_VCMPT) + (size_t)bg * 96 * 128, 128, q0, 0.f, 0, nullptr,
                             (bf16_t*)(a->ws + WS_OC) + t0 * 512 + hd * 64, 512, IMPH + (t0 * 8 + hd) * 32); }
        asm volatile("s_waitcnt vmcnt(0)" ::: "memory");
        __syncthreads();
        { const int tid = opaque_tid(WID); if (tid < 256) topk_one(IMPH, (unsigned*)(a->ws + WS_SELM), (int)t0 + tid, g); }
        __syncthreads();
    }
}
DI void phase_mixprep(const int WID, ArgsP a, int layer) {
    const int tid = opaque_tid(WID), lane = tid & 63, wv = tid >> 6, ev = layer >> 1;
    const float* dl = a->in[I_DALAM] + ev * 256;
    const float s1 = wave_sum(dl[lane] * dl[64 + lane]), s2 = wave_sum(dl[128 + lane] * dl[192 + lane]);
    const float lam_init = 0.8f - 0.6f * expf(-0.3f * (float)layer);
    const float lam = expf(s1) - expf(s2) + lam_init;
    const float* og = a->in[I_DAOUTG] + ev * 128;
    const bf16_t* OD = (const bf16_t*)(a->ws + WS_OD); const bf16_t* OC = (const bf16_t*)(a->ws + WS_OC); const bf16_t* OS = (const bf16_t*)(a->ws + WS_OS); const bf16_t* OW = (const bf16_t*)(a->ws + WS_OW);
    const float* GT = (const float*)(a->ws + WS_GATES); bf16_t* AMIX = (bf16_t*)(a->ws + WS_AMIX);
    const int h = lane >> 4, dv = (lane & 15) * 8;
    f32x4 g0 = *(const f32x4*)(og + dv), g1 = *(const f32x4*)(og + dv + 4);
    for (int t = blockIdx.x * 8 + wv; t < T; t += gridDim.x * 8) {
        { const u32x4 w1 = *(const u32x4*)(OD + (size_t)t * 1024 + h * 128 + dv), w2 = *(const u32x4*)(OD + (size_t)t * 1024 + (4 + h) * 128 + dv);
          f32x4 d0, d1;
          d0[0] = bflo(w1.x) - lam * bflo(w2.x); d0[1] = bfhi(w1.x) - lam * bfhi(w2.x); d0[2] = bflo(w1.y) - lam * bflo(w2.y); d0[3] = bfhi(w1.y) - lam * bfhi(w2.y);
          d1[0] = bflo(w1.z) - lam * bflo(w2.z); d1[1] = bfhi(w1.z) - lam * bfhi(w2.z); d1[2] = bflo(w1.w) - lam * bflo(w2.w); d1[3] = bfhi(w1.w) - lam * bfhi(w2.w);
          float ss = (d0[0] * d0[0] + d0[1] * d0[1]) + (d0[2] * d0[2] + d0[3] * d0[3]) + (d1[0] * d1[0] + d1[1] * d1[1]) + (d1[2] * d1[2] + d1[3] * d1[3]);
          ss += shx(ss, 1); ss += shx(ss, 2); ss += shx(ss, 4); ss += shx(ss, 8);
          const float rs = rsqrtf(ss * (1.0f / 128.0f) + EPS) * (1.0f - lam_init);
          *(u32x4*)(AMIX + (size_t)t * 1024 + h * 128 + dv) = pack8(d0 * rs * g0, d1 * rs * g1); }
        { const int hd = lane >> 3, dq = (lane & 7) * 8; const size_t o = (size_t)t * 512 + hd * 64 + dq;
          const float ga = GT[(size_t)t * 24 + hd * 3], gb = GT[(size_t)t * 24 + hd * 3 + 1], gc = GT[(size_t)t * 24 + hd * 3 + 2];
          const u32x4 c = *(const u32x4*)(OC + o), s = *(const u32x4*)(OS + o), w = *(const u32x4*)(OW + o);
          f32x4 r0, r1;
          r0[0] = ga * bflo(c.x) + gb * bflo(s.x) + gc * bflo(w.x); r0[1] = ga * bfhi(c.x) + gb * bfhi(s.x) + gc * bfhi(w.x);
          r0[2] = ga * bflo(c.y) + gb * bflo(s.y) + gc * bflo(w.y); r0[3] = ga * bfhi(c.y) + gb * bfhi(s.y) + gc * bfhi(w.y);
          r1[0] = ga * bflo(c.z) + gb * bflo(s.z) + gc * bflo(w.z); r1[1] = ga * bfhi(c.z) + gb * bfhi(s.z) + gc * bfhi(w.z);
          r1[2] = ga * bflo(c.w) + gb * bflo(s.w) + gc * bflo(w.w); r1[3] = ga * bfhi(c.w) + gb * bfhi(s.w) + gc * bfhi(w.w);
          *(u32x4*)(AMIX + (size_t)t * 1024 + 512 + hd * 64 + dq) = pack8(r0, r1); }
    }
}
DI void phase_scan(const int WID, ArgsP a) {
    const bf16_t* UT = (const bf16_t*)(a->ws + WS_UT); bf16_t* VS = (bf16_t*)(a->ws + WS_VS);
    for (int i = blockIdx.x * 512 + opaque_tid(WID); i < 64 * 512 * 32; i += gridDim.x * 512) {
        const int d8 = i & 31, f = (i >> 5) & 511, bh = i >> 14, h = bh & 3;
        const float dec = exp2f(256.0f * ret_lg2(h));
        f32x4 S0 = {0.f, 0.f, 0.f, 0.f}, S1 = S0;
        u32x4 un = *(const u32x4*)(UT + ((size_t)bh * 8) * 131072 + (size_t)f * 256 + 8 * d8);
#pragma unroll 1
        for (int n = 0; n < 8; ++n) {
            const size_t z = (size_t)bh * 8 + n;
            const u32x4 u = un;
            if (n < 7) un = *(const u32x4*)(UT + (z + 1) * 131072 + (size_t)f * 256 + 8 * d8);
            *(u32x4*)(VS + (z * 512 + f) * 512 + 256 + 8 * d8) = pack8(S0, S1);
            S0[0] = (S0[0] + bflo(u.x)) * dec; S0[1] = (S0[1] + bfhi(u.x)) * dec; S0[2] = (S0[2] + bflo(u.y)) * dec; S0[3] = (S0[3] + bfhi(u.y)) * dec;
            S1[0] = (S1[0] + bflo(u.z)) * dec; S1[1] = (S1[1] + bfhi(u.z)) * dec; S1[2] = (S1[2] + bflo(u.w)) * dec; S1[3] = (S1[3] + bfhi(u.w)) * dec;
        }
    }
}
DI void phase_normgate(const int WID, ArgsP a, int od) {
    const int tid = opaque_tid(WID), lane = tid & 63, wv = tid >> 6;
    const bf16_t* Y = (const bf16_t*)(a->ws + WS_Y); const bf16_t* GG = (const bf16_t*)(a->ws + WS_GG); bf16_t* YG = (bf16_t*)(a->ws + WS_YG);
    const float* og = a->in[I_RETG] + od * 512;
    const f32x4 g0 = *(const f32x4*)(og + 8 * lane), g1 = *(const f32x4*)(og + 8 * lane + 4);
    for (int t = blockIdx.x * 8 + wv; t < T; t += gridDim.x * 8) {
#pragma unroll
        for (int h = 0; h < 4; ++h) {
            const size_t o = (size_t)t * 2048 + h * 512 + 8 * lane;
            const u32x4 yw = *(const u32x4*)(Y + o), gw = *(const u32x4*)(GG + o);
            f32x4 y0 = {bflo(yw.x), bfhi(yw.x), bflo(yw.y), bfhi(yw.y)}, y1 = {bflo(yw.z), bfhi(yw.z), bflo(yw.w), bfhi(yw.w)};
            const f32x4 q0 = {bflo(gw.x), bfhi(gw.x), bflo(gw.y), bfhi(gw.y)}, q1 = {bflo(gw.z), bfhi(gw.z), bflo(gw.w), bfhi(gw.w)};
            float ss = (y0[0] * y0[0] + y0[1] * y0[1]) + (y0[2] * y0[2] + y0[3] * y0[3]) + (y1[0] * y1[0] + y1[1] * y1[1]) + (y1[2] * y1[2] + y1[3] * y1[3]);
            ss = wave_sum(ss);
            const float rs = rsqrtf(ss * (1.0f / 512.0f) + EPS);
            *(u32x4*)(YG + o) = pack8(y0 * rs * g0 * q0, y1 * rs * g1 * q1);
        }
    }
}
DI int snake_unit(int rnd, int G, int c) { return (rnd & 1) ? rnd * G + (G - 1 - c) : rnd * G + c; }
DI float absmax64(const float* g, int lane) { float m = fabsf(g[lane]);
#pragma unroll
    for (int o = 1; o < 64; o <<= 1) m = fmaxf(m, shx(m, o));
    return m; }
constexpr int CW_AQ = 8192;
template <int MODE>
DI void phase_attn(const int WID, ArgsP a, LAS unsigned char* lds, int ev) {
    const int tid = opaque_tid(WID), lane = tid & 63;
    const bf16_t* QD = (const bf16_t*)(a->ws + WS_QD); const bf16_t* KD = (const bf16_t*)(a->ws + WS_KD); const bf16_t* QN = (const bf16_t*)(a->ws + WS_QN);
    LAS int* ord = (LAS int*)(lds + MISC_OFF + MO_ENT); LAS int* cst = (LAS int*)(lds + MISC_OFF + MO_GAT); volatile LAS int* cur = (volatile LAS int*)(lds + MISC_OFF + MO_TOT);
    float sb2 = 0.f;
    if (MODE != 3) { const float gq = absmax64(a->in[MODE == 0 ? I_DAQN : I_NSQN] + ev * 64, lane), gk = absmax64(a->in[MODE == 0 ? I_DAKN : I_NSKN] + ev * 64, lane);
        sb2 = 16.0f * gq * gk + 28.0f; }
    if (tid < 64) { const int qb = tid >> 3, hd = tid & 7, q0 = qb * 256; int lo = 0, hi = 4 * qb + 4;
        if (MODE == 3) { lo = 0; hi = 2; }
        else { const float slope = (MODE == 0) ? exp2f(-2.0f * (float)((hd & 3) + 1)) : exp2f(-(float)(hd + 1)); const int dcut = (int)fminf(sb2 / slope + 1.0f, 100000.0f);
            const int kmin = q0 - dcut; lo = kmin > 0 ? (kmin >> 6) : 0;
            if (MODE == 2) { const int lk = q0 - 511; const int lw = lk > 0 ? (lk >> 6) : 0; lo = lw > lo ? lw : lo; } }
        cst[tid] = hi - lo; }
    __syncthreads();
    if (tid < 64) { const int mine = cst[tid]; int rank = 0;
        for (int j = 0; j < 64; ++j) { const int o = cst[j]; rank += (o > mine || (o == mine && j < tid)) ? 1 : 0; }
        ord[rank] = tid; }
    __syncthreads();
    unsigned* ctr = (unsigned*)(a->ws + WS_CTL) + CW_AQ + 64 * 8 * (ev * 4 + MODE);
    const int x0 = (int)(xb_xcc_id() & 7u);
    volatile LAS int* stl = (volatile LAS int*)(lds + MISC_OFF + MO_BASE);
    bool own = true; int nst = 0;
    for (;;) {
        if (tid < 64) {
            int uu_ = -1;
            if (own) { int v = 128; if (lane == 0) v = (int)__hip_atomic_fetch_add(ctr + 64 * x0, 1u, __ATOMIC_RELAXED, __HIP_MEMORY_SCOPE_AGENT);
                v = __builtin_amdgcn_readfirstlane(v); if (v < 128) uu_ = x0 * 128 + v; else own = false; }
            if (!own && uu_ < 0) {
                if (nst == 0) { int v = 128; const int xq_ = (x0 + lane) & 7;
                    if (lane >= 1 && lane < 8) v = (int)__hip_atomic_fetch_add(ctr + 64 * xq_, 1u, __ATOMIC_RELAXED, __HIP_MEMORY_SCOPE_AGENT);
                    const unsigned long long got = __ballot(v < 128); nst = __popcll(got);
                    if (v < 128) stl[__popcll(got & ((1ull << lane) - 1ull))] = xq_ * 128 + v;
                    asm volatile("s_waitcnt lgkmcnt(0)" ::: "memory"); }
                if (nst > 0) { --nst; uu_ = stl[nst]; }
            }
            if (lane == 0) *cur = uu_;
        }
        __syncthreads();
        const int uu = *cur; if (uu < 0) break;
        const int xq = uu >> 7, v = uu & 127, combo = ord[v >> 1], jb = v & 1, qb = combo >> 3, hd = combo & 7, q0 = qb * 256;
        const int b = (MODE == 0) ? (((xq - 2 * (hd & 3)) & 7) + 8 * jb) : (((xq - 4 * (hd >> 2)) & 7) + 8 * jb);
        const size_t t0 = (size_t)b * 2048 + q0;
        if (MODE == 0) {
            const float slope = exp2f(-2.0f * (float)((hd & 3) + 1)); const int dcut = (int)fminf(sb2 / slope + 1.0f, 100000.0f);
            attn_unit<128, 0>(WID, lds, QD + t0 * 512 + hd * 64, 512, KD + (size_t)b * 2048 * 512 + hd * 64, 512,
                              (const bf16_t*)(a->ws + WS_VAT) + (size_t)(b * 4 + (hd & 3)) * 128 * 2048, 2048, q0, slope, dcut, nullptr,
                              (bf16_t*)(a->ws + WS_OD) + t0 * 1024 + hd * 128, 1024, nullptr);
        } else if (MODE == 1 || MODE == 2) {
            const int g = hd >> 2; const float slope = exp2f(-(float)(hd + 1)); const int dcut = (int)fminf(sb2 / slope + 1.0f, 100000.0f);
            const bf16_t* Kb = (const bf16_t*)(a->ws + (MODE == 1 ? WS_KSB : WS_KWB)) + (size_t)(b * 2 + g) * 2048 * 64;
            const bf16_t* Vb = (const bf16_t*)(a->ws + (MODE == 1 ? WS_VST : WS_VWT)) + (size_t)(b * 2 + g) * 64 * 2048;
            attn_unit<64, MODE>(WID, lds, QN + t0 * 512 + hd * 64, 512, Kb, 64, Vb, 2048, q0, slope, dcut,
                                (const unsigned*)(a->ws + WS_SELM) + (size_t)(b * 2 + g) * 2048 + q0,
                                (bf16_t*)(a->ws + (MODE == 1 ? WS_OS : WS_OW)) + t0 * 512 + hd * 64, 512, nullptr);
        } else {
            const int g = hd >> 2;
            attn_unit<96, 3>(WID, lds, QN + t0 * 512 + hd * 64, 512, (const bf16_t*)(a->ws + WS_KCMP) + (size_t)(b * 2 + g) * 128 * 64, 64,
                             (const bf16_t*)(a->ws + WS_VCMPT) + (size_t)(b * 2 + g) * 96 * 128, 128, q0, 0.f, 0, nullptr,
                             (bf16_t*)(a->ws + WS_OC) + t0 * 512 + hd * 64, 512, (float*)(a->ws + WS_IMPH) + (t0 * 8 + hd) * 32);
        }
    }
}

constexpr int PPL = 15;
constexpr int NPHASE = 1 + DEPTH * PPL;
__global__ void __launch_bounds__(512, 2) mk_fwd(Args a_unused) {
    ArgsP a = opaque_args();
    extern __shared__ __attribute__((aligned(16))) unsigned char lds_raw[];
    LAS unsigned char* lds = (LAS unsigned char*)lds_raw;
    const int tid = threadIdx.x, G = gridDim.x, c = blockIdx.x;
    const int WID = __builtin_amdgcn_readfirstlane(tid >> 6);
    volatile LAS unsigned* misc = (volatile LAS unsigned*)(lds + MISC_OFF);
    if (tid < 4) misc[tid] = 0u;
    __syncthreads();
    unsigned* ctl = (unsigned*)(a->ws + WS_CTL);
    XcdBarrier bar; bar.bar = ctl + CW_BAR; bar.x = 0; bar.st = misc;
    const int ph_lo = a->ph_lo, ph_hi = a->ph_hi;
    const bool multi = (ph_hi - ph_lo) > 1;
    if (multi) bar = xcd_barrier_post(WID, ctl + CW_BAR, misc);
    bool first = true;
#define PHASE_BEGIN(k, id) if ((DBG_ONLY < 0 || DBG_ONLY == (id)) && (k) >= ph_lo && (k) < ph_hi && (k) <= DBG_LAST_PHASE) { if (!first) { xcd_barrier(WID, bar); if (PROBE_MASK >> 31) xcd_barrier(WID, bar); } first = false; \
        ArgsP a = opaque_args(); unsigned char* ws = a->ws; bf16_t* XN = (bf16_t*)(ws + WS_XN); float* H = a->out; const float* Hin = (layer == 0) ? a->in[I_X] : (const float*)H; \
        const LAS int* ts = (const LAS int*)(lds + MISC_OFF + MO_TS); (void)XN; (void)H; (void)Hin; (void)ts; \
        const bool probe_ = ((PROBE_MASK >> (id)) & 1u) != 0u; const unsigned long long pt0_ = probe_ ? __builtin_amdgcn_s_memrealtime() : 0ull;
#define PHASE_END if (probe_) { const unsigned long long pt1_ = __builtin_amdgcn_s_memrealtime(), pd_ = pt1_ - pt0_; while (__builtin_amdgcn_s_memrealtime() - pt1_ < pd_) __builtin_amdgcn_s_sleep(8); } }
    { const int layer = 0; PHASE_BEGIN(0, 0) phase_prologue(WID, a, lds); PHASE_END }
#pragma unroll 1
    for (int layer = 0; layer < DEPTH; ++layer) {
        const int pb = 1 + layer * PPL; const bool even = (layer & 1) == 0; const int ev = layer >> 1, od = layer >> 1;
        if (even) {
            PHASE_BEGIN(pb + 0, 1) phase_norm<0>(WID, a, lds, layer, Hin); PHASE_END
            PHASE_BEGIN(pb + 1, 2) {
                { ProbPlain P{XN, (const bf16_t*)(ws + WS_EVNAT) + (size_t)ev * 2048 * 1024, 1024, 1024, 1024}; pg8::Sched S; S.init(T / 256, 8, G, c);
                  EpiEvNat E{ws, (const float*)(ws + WS_GAINS) + ev * 256};
                  pg8::gemm_phase(WID, lds, P, S, E); }
                { ProbPlain P{(const bf16_t*)(ws + WS_EVSW) + (size_t)ev * 768 * 1024, XN, 1024, 1024, 1024}; pg8::Sched S; S.init(3, T / 256, G, c);
                  EpiEvSw E{ws};
                  pg8::gemm_phase(WID, lds, P, S, E); }
            } PHASE_END
            PHASE_BEGIN(pb + 2, 3) {
                { ProbCmp1 P{(const bf16_t*)(ws + WS_KCB), (const bf16_t*)(ws + WS_VCB), (const bf16_t*)(ws + WS_CMP1) + (size_t)ev * 2 * 256 * 2048, 1024, 2048, 2048}; pg8::Sched S; S.init(32, 1, G, c);
                  EpiCmp1 E{(bf16_t*)(ws + WS_HID), (const float*)(ws + WS_BIAS1) + ev * 512};
                  pg8::gemm_phase(WID, lds, P, S, E); }
                phase_attn<0>(WID, a, lds, ev);
                phase_attn<2>(WID, a, lds, ev);
            } PHASE_END
            PHASE_BEGIN(pb + 3, 4) phase_cmp2(WID, a, lds, ev); PHASE_END
            PHASE_BEGIN(pb + 4, 5) phase_attn<3>(WID, a, lds, ev); PHASE_END
            PHASE_BEGIN(pb + 5, 6) phase_topk(WID, a); PHASE_END
            PHASE_BEGIN(pb + 6, 7) phase_attn<1>(WID, a, lds, ev); PHASE_END
            PHASE_BEGIN(pb + 7, 8) phase_mixprep(WID, a, layer); PHASE_END
            PHASE_BEGIN(pb + 8, 9) {
                ProbPlain P{(const bf16_t*)(ws + WS_AMIX), (const bf16_t*)(ws + WS_EVOUT) + (size_t)ev * 1024 * 1024, 1024, 1024, 1024}; pg8::Sched S; S.init(T / 256, 4, G, c);
                EpiResid E{Hin, H}; pg8::gemm_phase(WID, lds, P, S, E);
            } PHASE_END
        } else {
            PHASE_BEGIN(pb + 0, 11) phase_norm<1>(WID, a, lds, layer, Hin); PHASE_END
            PHASE_BEGIN(pb + 1, 12) {
                { ProbPlain P{XN, (const bf16_t*)(ws + WS_ODNAT) + (size_t)od * 4096 * 1024, 1024, 1024, 1024}; pg8::Sched S; S.init(T / 256, 16, G, c);
                  EpiOdNat E{ws}; pg8::gemm_phase(WID, lds, P, S, E); }
                { ProbPlain P{(const bf16_t*)(ws + WS_ODSW) + (size_t)od * 2048 * 1024, XN, 1024, 1024, 1024}; pg8::Sched S; S.init(8, T / 256, G, c);
                  EpiOdSw E{ws}; pg8::gemm_phase(WID, lds, P, S, E); }
            } PHASE_END
            PHASE_BEGIN(pb + 2, 13) {
                { ProbUT P{(const bf16_t*)(ws + WS_VS), (const bf16_t*)(ws + WS_KT), 512, 256, 256}; SchedSeq S; S.init(G, c);
                  EpiUTScan E{(bf16_t*)(ws + WS_VS)}; pg8::gemm_phase(WID, lds, P, S, E); }
                { ProbAtt P{(const bf16_t*)(ws + WS_AQ), (const bf16_t*)(ws + WS_KP), 2048, 1024, 256}; pg8::Sched S; const int nb = G / 2 > 0 ? G / 2 : 1;
                  if (c >= nb || G < 2) S.init(512, 1, G < 2 ? 1 : G - nb, G < 2 ? 0 : c - nb); else S.init(0, 1, 1, 0);
                  EpiAtt E{(bf16_t*)(ws + WS_AQ)}; pg8::gemm_phase(WID, lds, P, S, E); }
            } PHASE_END
            PHASE_BEGIN(pb + 4, 15) {
                ProbY P{(const bf16_t*)(ws + WS_AQ), (const bf16_t*)(ws + WS_VS), 2048, 512, 512}; pg8::Sched S; S.init(512, 2, G, c);
                EpiY E{(bf16_t*)(ws + WS_Y)}; pg8::gemm_phase(WID, lds, P, S, E);
            } PHASE_END
            PHASE_BEGIN(pb + 5, 16) phase_normgate(WID, a, od); PHASE_END
            PHASE_BEGIN(pb + 8, 19) {
                ProbPlain P{(const bf16_t*)(ws + WS_YG), (const bf16_t*)(ws + WS_ODOUT) + (size_t)od * 1024 * 2048, 2048, 2048, 2048}; pg8::Sched S; S.init(T / 256, 4, G, c);
                EpiResid E{Hin, H}; pg8::gemm_phase(WID, lds, P, S, E);
            } PHASE_END
        }
        PHASE_BEGIN(pb + 9, 20) phase_norm<2>(WID, a, lds, layer, H); PHASE_END
        PHASE_BEGIN(pb + 10, 21) phase_moe_slots(WID, a, lds, layer); PHASE_END
        PHASE_BEGIN(pb + 11, 22) {
            moe_tables(WID, a, lds, layer, -1);
            { ProbMoe8 P{(const unsigned char*)(ws + WS_XB), (const unsigned char*)(ws + WS_WGU) + (size_t)layer * 32 * 2048 * 1024, ts, 2048, 512, 512, 512}; pg8::Sched S; S.init(ts[32], 8, G, c);
              EpiGU E{(unsigned char*)(ws + WS_ACT), a->in[I_BGU] + (size_t)layer * 32 * 2048, ts}; pg8::gemm_phase(WID, lds, P, S, E); }
            { ProbPlain P{(const bf16_t*)(ws + WS_PBF) + (size_t)layer * T * 256, (const bf16_t*)(ws + WS_WPP) + (size_t)layer * 1024 * 256, 256, 256, 256}; pg8::Sched S; S.init(T / 256, 4, G, c);
              EpiPP E{(bf16_t*)(ws + WS_PP)}; pg8::gemm_phase(WID, lds, P, S, E); }
        } PHASE_END
        PHASE_BEGIN(pb + 12, 23) {
            moe_tables(WID, a, lds, layer, -1);
            ProbMoe8 P{(const unsigned char*)(ws + WS_ACT), (const unsigned char*)(ws + WS_WDN) + (size_t)layer * 32 * 1024 * 1024, ts, 1024, 512, 512, 512}; pg8::Sched S; S.init(ts[32], 4, G, c);
            EpiDN E{(bf16_t*)(ws + WS_YB), a->in[I_BDN] + (size_t)layer * 32 * 1024, ts}; pg8::gemm_phase(WID, lds, P, S, E);
        } PHASE_END
        PHASE_BEGIN(pb + 13, 24) phase_combine(WID, a, H); PHASE_END
        PHASE_BEGIN(pb + 14, 25) {
            ProbPlain8 P{(const unsigned char*)(ws + WS_XN), (const unsigned char*)(ws + WS_WPG) + (size_t)layer * 1024 * 1024, 512, 512, 512}; pg8::Sched S; S.init(T / 256, 4, G, c);
            EpiPLE E{H, (const bf16_t*)(ws + WS_PP)}; pg8::gemm_phase(WID, lds, P, S, E);
        } PHASE_END
    }
#undef PHASE_BEGIN
#undef PHASE_END
}

extern "C" void kernel_launch(void* const* d_in, const int* in_sizes, int n_in, void* d_out, int out_size, void* d_ws, size_t ws_size, hipStream_t stream) {
    static int grid = 0;
    if (grid == 0) {
        if (n_in != 26 || out_size != T * D || ws_size < WS_END) { fprintf(stderr, "kernel_launch: unexpected problem (n_in %d, out %d, ws %zu < %zu); nothing launched\n", n_in, out_size, ws_size, (size_t)WS_END); grid = -1; return; }
        int dev = 0, cus = 0, per_cu = 0;
        if (hipGetDevice(&dev) != hipSuccess || hipDeviceGetAttribute(&cus, hipDeviceAttributeMultiprocessorCount, dev) != hipSuccess) { grid = -1; return; }
        if (hipFuncSetAttribute((const void*)mk_fwd, hipFuncAttributeMaxDynamicSharedMemorySize, LDS_BYTES) != hipSuccess) { fprintf(stderr, "kernel_launch: hipFuncSetAttribute failed\n"); grid = -1; return; }
        if (hipOccupancyMaxActiveBlocksPerMultiprocessor(&per_cu, (const void*)mk_fwd, 512, LDS_BYTES) != hipSuccess || per_cu < 1) fprintf(stderr, "kernel_launch: occupancy query reports %d\n", per_cu);
        (void)hipGetLastError();
        grid = cus > 256 ? 256 : cus;
    }
    if (grid < 0) return;
    (void)hipMemsetAsync((char*)d_ws + WS_CTL, 0, CTL_BYTES, stream);
    Args a; memset(&a, 0, sizeof(a));
    for (int i = 0; i < 26; ++i) a.in[i] = (const float*)d_in[i];
    a.out = (float*)d_out; a.ws = (unsigned char*)d_ws;
#if MK_SINGLE
    a.ph_lo = 0; a.ph_hi = NPHASE;
    hipLaunchKernelGGL(mk_fwd, dim3(grid), dim3(512), LDS_BYTES, stream, a);
#else
    for (int ph = 0; ph < NPHASE && ph <= DBG_LAST_PHASE; ++ph) {
        const int l = (ph - 1) / PPL, k = (ph - 1) % PPL;
        if (ph > 0 && (l & 1) && (k == 6 || k == 7)) continue;
        a.ph_lo = ph; a.ph_hi = ph + 1;
        hipLaunchKernelGGL(mk_fwd, dim3(grid), dim3(512), LDS_BYTES, stream, a);
    }
#endif
}
```

```cpp
#include <hip/hip_runtime.h>
#include <cstdio>
#include <cstdint>
#include <cstring>

#define LAS __attribute__((address_space(3)))
#define DI __device__ __forceinline__
typedef unsigned short bf16_t;
typedef short bf16x8 __attribute__((ext_vector_type(8)));
typedef short s16x4 __attribute__((ext_vector_type(4)));
typedef float f32x2 __attribute__((ext_vector_type(2)));
typedef float f32x4 __attribute__((ext_vector_type(4)));
typedef float f32x16 __attribute__((ext_vector_type(16)));
typedef unsigned u32x2 __attribute__((ext_vector_type(2)));
typedef unsigned u32x4 __attribute__((ext_vector_type(4)));
typedef __bf16 bfv2 __attribute__((ext_vector_type(2)));
typedef int i32x4 __attribute__((ext_vector_type(4)));
typedef int i32x8 __attribute__((ext_vector_type(8)));

#ifndef MK_SINGLE
#define MK_SINGLE 1
#endif
#ifndef DBG_ONLY
#define DBG_ONLY -1
#endif
#ifndef PROBE_MASK
#define PROBE_MASK 0u
#endif
#ifndef PROBE_ATT
#define PROBE_ATT 0
#endif
#ifndef PROBE_KREP
#define PROBE_KREP 1
#endif
#ifndef DBG_LAST_PHASE
#define DBG_LAST_PHASE 100000
#endif

constexpr int T = 32768, D = 1024, SEQ = 2048, NBATCH = 16, DEPTH = 4;
constexpr int EVIN = 2840, ODIN = 6144;
constexpr float EPS = 1e-6f, NEGF = -1e30f;
constexpr int NTB = 256;
constexpr int MOE_ROWS = (512 + 32) * 256;

constexpr size_t MiB = 1u << 20;
constexpr size_t WS_CTL = 0, CTL_BYTES = 1 * MiB;
constexpr int CW_BAR = 4096;
constexpr size_t WS_EVNAT = 2 * MiB, WS_EVSW = 10 * MiB, WS_EVOUT = 13 * MiB, WS_CMP1 = 17 * MiB, WS_ODNAT = 21 * MiB, WS_ODSW = 37 * MiB,
                 WS_ODOUT = 49 * MiB, WS_WPP = 57 * MiB, WS_WPG = 59 * MiB, WS_BIAS1 = 67 * MiB, WS_GAINS = 67 * MiB + 16384, WS_BCNT = 67 * MiB + 65536,
                 WS_WGU = 68 * MiB, WS_WDN = 580 * MiB;
constexpr size_t WS_XN = 840 * MiB, WS_PBF = 904 * MiB, WS_PP = 968 * MiB, WS_GATES = 1032 * MiB, WS_TOPE = 1035 * MiB, WS_POSB = 1036 * MiB,
                 WS_DEST = 1037 * MiB, WS_GATEW = 1038 * MiB, WS_SELM = 1039 * MiB;
constexpr size_t RA = 1040 * MiB;
constexpr size_t WS_QD = RA, WS_KD = RA + 32 * MiB, WS_QN = RA + 64 * MiB, WS_KCB = RA + 96 * MiB, WS_VCB = RA + 105 * MiB, WS_KSB = RA + 114 * MiB,
                 WS_KWB = RA + 122 * MiB, WS_VAT = RA + 130 * MiB, WS_VST = RA + 162 * MiB, WS_VWT = RA + 170 * MiB, WS_HID = RA + 178 * MiB,
                 WS_KCMP = RA + 182 * MiB, WS_VCMPT = RA + 183 * MiB, WS_OC = RA + 184 * MiB, WS_IMPH = RA + 216 * MiB, WS_OD = RA + 248 * MiB,
                 WS_OS = RA + 312 * MiB, WS_OW = RA + 344 * MiB, WS_AMIX = RA + 376 * MiB;
constexpr size_t WS_AQ = RA, WS_KP = RA + 128 * MiB, WS_KT = RA + 192 * MiB, WS_VS = RA + 256 * MiB, WS_GG = RA + 512 * MiB, WS_UT = RA + 640 * MiB,
                 WS_Y = RA + 896 * MiB, WS_YG = RA + 1024 * MiB;
constexpr size_t WS_XB = 2192 * MiB, WS_ACT = 2464 * MiB, WS_YB = 2736 * MiB, WS_END = 3008 * MiB;

constexpr int MISC_OFF = 139264, LDS_BYTES = 155648;
static_assert(MISC_OFF + 5888 + 4096 <= LDS_BYTES, "misc LDS words");
constexpr int MO_WCNT = 256, MO_ENT = 1280, MO_GAT = 3328, MO_TOT = 5376, MO_BASE = 5504, MO_TS = 5632, MO_RED = 5888;

DI int opaque_tid(int wid0) { int l; asm volatile("v_mbcnt_lo_u32_b32 %0, -1, 0\n\tv_mbcnt_hi_u32_b32 %0, -1, %0" : "=v"(l) :: "memory"); return (wid0 << 6) | l; }
DI int lane_now() { int l; asm volatile("v_mbcnt_lo_u32_b32 %0, -1, 0\n\tv_mbcnt_hi_u32_b32 %0, -1, %0" : "=v"(l)); return l; }
DI float shx(float v, int m) { return __builtin_bit_cast(float, __builtin_amdgcn_ds_bpermute((lane_now() ^ m) << 2, __builtin_bit_cast(int, v))); }
DI unsigned shxu(unsigned v, int m) { return (unsigned)__builtin_amdgcn_ds_bpermute((lane_now() ^ m) << 2, (int)v); }
DI unsigned pk2(float lo, float hi) { f32x2 v = {lo, hi}; return __builtin_bit_cast(unsigned, __builtin_convertvector(v, bfv2)); }
DI unsigned pk4_fp8(float a, float b, float c, float d) { int w = 0; w = __builtin_amdgcn_cvt_pk_fp8_f32(a, b, w, false); w = __builtin_amdgcn_cvt_pk_fp8_f32(c, d, w, true); return (unsigned)w; }
DI float bf2f(unsigned short b) { return __uint_as_float(((unsigned)b) << 16); }
DI float bflo(unsigned w) { return __uint_as_float(w << 16); }
DI float bfhi(unsigned w) { return __uint_as_float(w & 0xffff0000u); }
DI float wave_sum(float v) {
#pragma unroll
    for (int o = 1; o < 64; o <<= 1) v += shx(v, o);
    return v;
}
DI float sigm(float x) { return __builtin_amdgcn_rcpf(1.0f + __builtin_amdgcn_exp2f(-1.44269504089f * x)); }
DI u32x4 pack8(const f32x4& a, const f32x4& b) { u32x4 w; w.x = pk2(a[0], a[1]); w.y = pk2(a[2], a[3]); w.z = pk2(b[0], b[1]); w.w = pk2(b[2], b[3]); return w; }

#define XB_TMO      128
#define XB_XCNT(j)  (256  + 64 * (j))
#define XB_XSUB(j)  (1280 + 64 * (j))
#define XB_XGEN(j)  (2304 + 64 * (j))
#define XB_TOP      3328
#define XB_TOPGEN   3392
#define XCD_BAR_WORDS 3456
#define XB_SPIN_CAP (1u << 22)
DI unsigned xb_ld(unsigned* p)              { return __hip_atomic_load(p, __ATOMIC_RELAXED, __HIP_MEMORY_SCOPE_AGENT); }
DI unsigned xb_add(unsigned* p, unsigned v) { return __hip_atomic_fetch_add(p, v, __ATOMIC_RELAXED, __HIP_MEMORY_SCOPE_AGENT); }
DI unsigned xb_xcc_id() { return (unsigned)__builtin_amdgcn_s_getreg((3 << 11) | 20) & 0xFu; }
#define XB_SPIN(cond, bar) do { unsigned _sp = 0; while (cond) { __builtin_amdgcn_s_sleep(1); \
    if ((++_sp & 255u) == 0u) { if (xb_ld(&(bar)[XB_TMO])) break; if (_sp > XB_SPIN_CAP) { atomicAdd(&(bar)[XB_TMO], 1u); break; } } } } while (0)
struct XcdBarrier { unsigned* bar; unsigned x; volatile LAS unsigned* st; };
DI XcdBarrier xcd_barrier_post(const int WID, unsigned* bar, volatile LAS unsigned* st) {
    XcdBarrier b; b.bar = bar; b.x = xb_xcc_id(); b.st = st;
    if (opaque_tid(WID) == 0) (void)xb_add(&bar[XB_XCNT(b.x)], 1u);
    return b;
}
DI void xcd_barrier_complete(unsigned* bar, unsigned x, unsigned& nloc, unsigned& nx) {
    const unsigned G = gridDim.x * gridDim.y * gridDim.z;
    unsigned sum, cnt, mine, sp = 0u;
    for (;;) {
        sum = 0u; cnt = 0u; mine = 0u;
#pragma unroll
        for (unsigned j = 0; j < 16; ++j) { const unsigned c = xb_ld(&bar[XB_XCNT(j)]); sum += c; cnt += (c > 0u) ? 1u : 0u; mine = (j == x) ? c : mine; }
        if (sum == G) break;
        __builtin_amdgcn_s_sleep(1);
        if ((++sp & 255u) == 0u) { if (xb_ld(&bar[XB_TMO])) break; if (sp > XB_SPIN_CAP) { atomicAdd(&bar[XB_TMO], 1u); break; } }
    }
    nloc = mine > 0u ? mine : 1u; nx = cnt > 0u ? cnt : 1u;
}
DI void xcd_barrier(const int WID, const XcdBarrier& b) {
    asm volatile("s_waitcnt vmcnt(0)" ::: "memory");
    __syncthreads();
    if (opaque_tid(WID) == 0) {
        unsigned* bar = b.bar; asm volatile("" : "+s"(bar));
        __builtin_amdgcn_s_waitcnt(0);
        unsigned nloc = b.st[0], nx = b.st[1];
        if (nloc == 0u) { xcd_barrier_complete(bar, b.x, nloc, nx); b.st[0] = nloc; b.st[1] = nx; }
        const unsigned old = xb_add(&bar[XB_XSUB(b.x)], 1u);
        const unsigned gen = old / nloc;
        if (old + 1u == (gen + 1u) * nloc) {
            __builtin_amdgcn_fence(__ATOMIC_RELEASE, "agent");
            asm volatile("s_waitcnt vmcnt(0)" ::: "memory");
            const unsigned og = xb_add(&bar[XB_TOP], 1u);
            const unsigned tg = og / nx;
            if (og + 1u == (tg + 1u) * nx) xb_add(&bar[XB_TOPGEN], 1u);
            else XB_SPIN(xb_ld(&bar[XB_TOPGEN]) == tg, bar);
            __builtin_amdgcn_fence(__ATOMIC_ACQUIRE, "agent");
            xb_add(&bar[XB_XGEN(b.x)], 1u);
            asm volatile("s_waitcnt vmcnt(0)" ::: "memory");
        } else {
            XB_SPIN(xb_ld(&bar[XB_XGEN(b.x)]) == gen, bar);
            __builtin_amdgcn_fence(__ATOMIC_ACQUIRE, "agent");
            asm volatile("s_waitcnt vmcnt(0)" ::: "memory");
        }
    }
    __syncthreads();
}

namespace pg8 {
constexpr int BM = 256, BK = 64, HALF = 128, HTB = HALF * BK * 2, STAGE_BYTES = 8 * HTB, NXCD = 8, WGM = 8;
DI int lds_byte(int r, int c) { const int st = (r >> 4) * 2 + (c >> 5), rr = r & 15, cc = c & 31, ob = rr * 64 + cc * 2; return st * 1024 + (ob ^ (((ob >> 9) & 1) << 5)); }
DI void stage_rc(int b, int& R, int& C) { const int st = b / 1024, sb = b % 1024, swz = sb ^ (((sb >> 9) & 1) << 5); R = (st >> 1) * 16 + swz / 64; C = (st & 1) * 32 + (swz % 64) / 2; }
DI int perm32(int rho) { const int n = rho >> 4, i = rho & 15; return 8 * (i >> 2) + 4 * n + (i & 3); }
struct Unit { int pm, pn; };
struct Sched {
    int nM, nN, nwg, G, c;
    DI void init(int nM_, int nN_, int G_, int c_) { nM = nM_; nN = nN_; nwg = nM * nN; G = G_; c = c_; }
    DI bool next(int i, Unit& u) const {
        const long L = (long)i * G + c; if (L >= nwg) return false;
        int wgid = (int)L; { const int q = nwg / NXCD, r = nwg % NXCD, xcd = wgid % NXCD, off = wgid / NXCD; wgid = (xcd < r ? xcd * (q + 1) : r * (q + 1) + (xcd - r) * q) + off; }
        const int nig = WGM * nN, gid = wgid / nig, fm = gid * WGM, gsz = (nM - fm) < WGM ? (nM - fm) : WGM;
        u.pm = fm + ((wgid % nig) % gsz); u.pn = (wgid % nig) / gsz; return true;
    }
};
template <class Epi, class Prob, class SchedT>
DI void gemm_phase(const int WID, LAS unsigned char* lds, const Prob& P, const SchedT& S, const Epi& E) {
    const int tid = opaque_tid(WID), wid = __builtin_amdgcn_readfirstlane(tid >> 6), lane = tid & 63, wr = wid >> 2, wc = wid & 3, fr = lane & 15, fq = lane >> 4;
    const int K = P.K, nt = K / BK;
    constexpr int KREP = Epi::CARRY ? 1 : PROBE_KREP;
    unsigned voffA[2], voffB[2];
#pragma unroll
    for (int i = 0; i < 2; ++i) { int R, C; stage_rc(tid * 16 + i * 8192, R, C); const int Rb = Epi::PERM ? ((R & ~31) + perm32(R & 31)) : R;
        voffA[i] = (unsigned)(R * P.lda + C) * 2u; voffB[i] = (unsigned)(Rb * P.ldb + C) * 2u; }
    const size_t kstep = (size_t)(BK * 2);
    const size_t hstepA = (size_t)HALF * P.lda * 2, hstepB = (size_t)HALF * P.ldb * 2;
    const unsigned ldsw = (unsigned)wid * 1024u;
    const int aoff = lds_byte(wr * 64 + fr, fq * 8), boff = lds_byte(wc * 32 + fr, fq * 8);
#define PG8_SA(b, h) (((b) * 2 + (h)) * HTB)
#define PG8_SB(b, h) ((4 + (b) * 2 + (h)) * HTB)
#define PG8_STAGE(bufoff, gbase, voff) do { _Pragma("unroll") for (int _i = 0; _i < 2; ++_i) \
        __builtin_amdgcn_global_load_lds((const unsigned*)((const char*)(gbase) + (voff)[_i]), (LAS unsigned*)(lds + (bufoff) + ldsw + _i * 8192), 16, 0, 0); } while (0)
#define PG8_LD16(off) (*(const LAS i32x4*)(lds + (off)))
#define PG8_LDA(dst, b, h) do { _Pragma("unroll") for (int m = 0; m < 4; ++m) { const i32x4 lo_ = PG8_LD16(PG8_SA(b, h) + aoff + m * 2048), hi_ = PG8_LD16(PG8_SA(b, h) + aoff + m * 2048 + 1024); dst[m] = __builtin_shufflevector(lo_, hi_, 0, 1, 2, 3, 4, 5, 6, 7); } } while (0)
#define PG8_LDB(dst, b, h) do { _Pragma("unroll") for (int n = 0; n < 2; ++n) { const i32x4 lo_ = PG8_LD16(PG8_SB(b, h) + boff + n * 2048), hi_ = PG8_LD16(PG8_SB(b, h) + boff + n * 2048 + 1024); dst[n] = __builtin_shufflevector(lo_, hi_, 0, 1, 2, 3, 4, 5, 6, 7); } } while (0)
#define PG8_LOH(X) __builtin_bit_cast(bf16x8, __builtin_shufflevector((X), (X), 0, 1, 2, 3))
#define PG8_HIH(X) __builtin_bit_cast(bf16x8, __builtin_shufflevector((X), (X), 4, 5, 6, 7))
#define PG8_MMA(ai, bj, At, Bt) do { __builtin_amdgcn_s_setprio(1); \
        if constexpr (Prob::FP8) { _Pragma("unroll") for (int m = 0; m < 4; ++m) _Pragma("unroll") for (int n = 0; n < 2; ++n) \
            asm volatile("v_mfma_scale_f32_16x16x128_f8f6f4 %0, %1, %2, %0, %3, %3 op_sel_hi:[0,0,0]" : "+v"(acc[ai][bj][m][n]) : "v"(Bt[n]), "v"(At[m]), "v"(sc1)); } \
        else { _Pragma("unroll") for (int m = 0; m < 4; ++m) _Pragma("unroll") for (int n = 0; n < 2; ++n) { \
            acc[ai][bj][m][n] = __builtin_amdgcn_mfma_f32_16x16x32_bf16(PG8_LOH(Bt[n]), PG8_LOH(At[m]), acc[ai][bj][m][n], 0, 0, 0); \
            acc[ai][bj][m][n] = __builtin_amdgcn_mfma_f32_16x16x32_bf16(PG8_HIH(Bt[n]), PG8_HIH(At[m]), acc[ai][bj][m][n], 0, 0, 0); } } \
        __builtin_amdgcn_s_setprio(0); } while (0)
#define PG8_WAIT_V(n) asm volatile("s_waitcnt vmcnt(" #n ")" ::: "memory")
#define PG8_WAIT_L(n) asm volatile("s_waitcnt lgkmcnt(" #n ")" ::: "memory")
#define PG8_BAR __builtin_amdgcn_s_barrier()
#define PG8_SCHED __builtin_amdgcn_sched_barrier(0)
    Unit cur, nxt; int ui = 0;
    if (!S.next(0, cur)) return;
    f32x4 acc[2][2][4][2];
#pragma unroll
    for (int a = 0; a < 2; ++a)
#pragma unroll
        for (int b = 0; b < 2; ++b)
#pragma unroll
            for (int m = 0; m < 4; ++m)
#pragma unroll
                for (int n = 0; n < 2; ++n) acc[a][b][m][n] = (f32x4){0.f, 0.f, 0.f, 0.f};
    i32x8 At[4], B0[2], B1[2];
    const int sc1 = 0x7f7f7f7f;
    const char* cA = P.a_base(cur); const char* cB = P.b_base(cur);
    PG8_STAGE(PG8_SB(0, 0), cB, voffB); PG8_STAGE(PG8_SA(0, 0), cA, voffA); PG8_STAGE(PG8_SB(0, 1), cB + hstepB, voffB); PG8_STAGE(PG8_SA(0, 1), cA + hstepA, voffA);
    if (wr == 1) PG8_BAR;
    PG8_WAIT_V(4); PG8_BAR;
    PG8_STAGE(PG8_SB(1, 0), cB + kstep, voffB); PG8_STAGE(PG8_SA(1, 0), cA + kstep, voffA); PG8_STAGE(PG8_SB(1, 1), cB + hstepB + kstep, voffB);
    PG8_WAIT_V(6); PG8_BAR;
    for (;;) {
        const bool has_next = S.next(ui + 1, nxt);
        const char* nA = has_next ? P.a_base(nxt) : cA; const char* nB = has_next ? P.b_base(nxt) : cB;
        for (int rep_ = 0; rep_ < KREP; ++rep_)
        for (int t = 0; t < nt; t += 2) {
            const bool last = (t == nt - 2);
            if constexpr (Epi::HOOK) { if (last && rep_ + 1 == KREP) E.prefetch(cur, lds, wid, lane); }
            const char* a1 = cA + (size_t)(t + 1) * kstep;
            const char* a2 = last ? (rep_ + 1 < KREP ? cA : nA) : cA + (size_t)(t + 2) * kstep; const char* b2 = last ? (rep_ + 1 < KREP ? cB : nB) : cB + (size_t)(t + 2) * kstep;
            const char* a3 = a2 + kstep; const char* b3 = b2 + kstep;
            PG8_LDB(B0, 0, 0); PG8_SCHED; PG8_LDA(At, 0, 0); PG8_STAGE(PG8_SA(1, 1), a1 + hstepA, voffA);
            PG8_WAIT_L(8); PG8_BAR; PG8_WAIT_L(0); PG8_MMA(0, 0, At, B0); PG8_BAR; PG8_SCHED;
            PG8_LDB(B1, 0, 1); PG8_STAGE(PG8_SB(0, 0), b2, voffB);
            PG8_BAR; PG8_WAIT_L(0); PG8_MMA(0, 1, At, B1); PG8_BAR;
            PG8_LDA(At, 0, 1); PG8_STAGE(PG8_SA(0, 0), a2, voffA);
            PG8_BAR; PG8_WAIT_L(0); PG8_MMA(1, 0, At, B0); PG8_BAR; PG8_SCHED;
            PG8_STAGE(PG8_SB(0, 1), b2 + hstepB, voffB);
            PG8_WAIT_V(6); PG8_BAR; PG8_MMA(1, 1, At, B1); PG8_BAR;
            PG8_LDB(B0, 1, 0); PG8_SCHED; PG8_LDA(At, 1, 0); PG8_STAGE(PG8_SA(0, 1), a2 + hstepA, voffA);
            PG8_WAIT_L(8); PG8_BAR; PG8_WAIT_L(0); PG8_MMA(0, 0, At, B0); PG8_BAR; PG8_SCHED;
            PG8_LDB(B1, 1, 1); PG8_STAGE(PG8_SB(1, 0), b3, voffB);
            PG8_BAR; PG8_WAIT_L(0); PG8_MMA(0, 1, At, B1); PG8_BAR;
            PG8_LDA(At, 1, 1); PG8_STAGE(PG8_SA(1, 0), a3, voffA);
            PG8_BAR; PG8_WAIT_L(0); PG8_MMA(1, 0, At, B0); PG8_BAR; PG8_SCHED;
            PG8_STAGE(PG8_SB(1, 1), b3 + hstepB, voffB);
            PG8_WAIT_V(6); PG8_BAR; PG8_MMA(1, 1, At, B1); PG8_BAR;
        }
        if constexpr (Prob::FP8) {
            asm volatile("s_nop 15\n\ts_nop 15" ::: "memory");
#pragma unroll
            for (int a_ = 0; a_ < 2; ++a_)
#pragma unroll
                for (int b_ = 0; b_ < 2; ++b_)
#pragma unroll
                    for (int m_ = 0; m_ < 4; ++m_)
#pragma unroll
                        for (int n_ = 0; n_ < 2; ++n_) asm volatile("" : "+v"(acc[a_][b_][m_][n_]));
        }
        if constexpr (KREP > 1) {
#pragma unroll
        for (int a_ = 0; a_ < 2; ++a_)
#pragma unroll
            for (int b_ = 0; b_ < 2; ++b_)
#pragma unroll
                for (int m_ = 0; m_ < 4; ++m_)
#pragma unroll
                    for (int n_ = 0; n_ < 2; ++n_) acc[a_][b_][m_][n_] *= (1.0f / KREP); }
        { const int t2_ = opaque_tid(WID); const int fr_ = t2_ & 15, fq_ = (t2_ >> 4) & 3; int wr_ = WID >> 2, wc_ = WID & 3; asm volatile("" : "+s"(wr_), "+s"(wc_));
          E(acc, cur, wr_, wc_, fr_, fq_); }
        if (!has_next) break;
        const float carry = Epi::carry(cur);
#pragma unroll
        for (int a = 0; a < 2; ++a)
#pragma unroll
            for (int b = 0; b < 2; ++b)
#pragma unroll
                for (int m = 0; m < 4; ++m)
#pragma unroll
                    for (int n = 0; n < 2; ++n) acc[a][b][m][n] = Epi::CARRY ? acc[a][b][m][n] * carry : (f32x4){0.f, 0.f, 0.f, 0.f};
        cur = nxt; cA = nA; cB = nB; ++ui;
    }
    PG8_WAIT_V(0);
    if (wr == 0) PG8_BAR;
    PG8_BAR;
#undef PG8_SA
#undef PG8_SB
#undef PG8_STAGE
#undef PG8_LDA
#undef PG8_LDB
#undef PG8_MMA
#undef PG8_LD16
#undef PG8_LOH
#undef PG8_HIH
#undef PG8_WAIT_V
#undef PG8_WAIT_L
#undef PG8_BAR
#undef PG8_SCHED
}
}
using pg8::Unit;
typedef f32x4 Acc[2][2][4][2];

struct ProbPlain { static constexpr bool FP8 = false; const bf16_t* A; const bf16_t* Bt; int lda, ldb, K;
    DI const char* a_base(const Unit& u) const { return (const char*)(A + (size_t)u.pm * 256 * lda); }
    DI const char* b_base(const Unit& u) const { return (const char*)(Bt + (size_t)u.pn * 256 * ldb); } };
struct ProbCmp1 { static constexpr bool FP8 = false; const bf16_t* KCB; const bf16_t* VCB; const bf16_t* W; int lda, ldb, K;
    DI const char* a_base(const Unit& u) const { const int kv = u.pm >> 4, rt = u.pm & 15; return (const char*)((kv ? VCB : KCB) + (size_t)rt * 256 * 1024); }
    DI const char* b_base(const Unit& u) const { const int kv = u.pm >> 4; return (const char*)(W + (size_t)kv * 256 * 2048); } };
struct ProbAtt { static constexpr bool FP8 = false; const bf16_t* AQ; const bf16_t* KP; int lda, ldb, K;
    DI const char* a_base(const Unit& u) const { const int z = u.pm, n = z & 7, h = (z >> 3) & 3, b = z >> 5; const size_t t0 = (size_t)b * 2048 + n * 256; return (const char*)(AQ + (t0 * 4 + h) * 512 + 256); }
    DI const char* b_base(const Unit& u) const { const int z = u.pm, n = z & 7, h = (z >> 3) & 3, b = z >> 5; const size_t t0 = (size_t)b * 2048 + n * 256; return (const char*)(KP + t0 * 1024 + h * 256); } };
struct ProbUT { static constexpr bool FP8 = false; const bf16_t* VS; const bf16_t* KT; int lda, ldb, K;
    DI const char* a_base(const Unit& u) const { const int z = u.pm >> 1, half = u.pm & 1; return (const char*)(VS + (size_t)z * 262144 + (size_t)half * 256 * 512); }
    DI const char* b_base(const Unit& u) const { const int z = u.pm >> 1; return (const char*)(KT + (size_t)z * 65536); } };
struct ProbY { static constexpr bool FP8 = false; const bf16_t* AQ; const bf16_t* VS; int lda, ldb, K;
    DI const char* a_base(const Unit& u) const { const int z = u.pm, n = z & 7, h = (z >> 3) & 3, b = z >> 5; const size_t t0 = (size_t)b * 2048 + n * 256; return (const char*)(AQ + (t0 * 4 + h) * 512); }
    DI const char* b_base(const Unit& u) const { return (const char*)(VS + (size_t)u.pm * 262144 + (size_t)u.pn * 256 * 512); } };
DI int moe_tile_expert(const LAS int* ts, int rt) { int e = 0;
#pragma unroll 8
    for (int i = 1; i < 32; ++i) e += (rt >= ts[i]) ? 1 : 0;
    return e; }
struct ProbMoe { static constexpr bool FP8 = false; const bf16_t* A; const bf16_t* W; const LAS int* ts; int nper; int lda, ldb, K;
    DI const char* a_base(const Unit& u) const { return (const char*)(A + (size_t)u.pm * 256 * 1024); }
    DI const char* b_base(const Unit& u) const { const int e = moe_tile_expert(ts, u.pm); return (const char*)(W + ((size_t)e * nper + (size_t)u.pn * 256) * 1024); } };

struct ProbPlain8 { static constexpr bool FP8 = true; const unsigned char* A; const unsigned char* Bt; int lda, ldb, K;
    DI const char* a_base(const Unit& u) const { return (const char*)(A + (size_t)u.pm * 256 * lda * 2); }
    DI const char* b_base(const Unit& u) const { return (const char*)(Bt + (size_t)u.pn * 256 * ldb * 2); } };
struct ProbMoe8 { static constexpr bool FP8 = true; const unsigned char* A; const unsigned char* W; const LAS int* ts; int nper; int lda, ldb, K;
    DI const char* a_base(const Unit& u) const { return (const char*)(A + (size_t)u.pm * 256 * 1024); }
    DI const char* b_base(const Unit& u) const { const int e = moe_tile_expert(ts, u.pm); return (const char*)(W + ((size_t)e * nper + (size_t)u.pn * 256) * 1024); } };

#define EPI_ROWS(ai, m) (128 * (ai) + 64 * wr + 16 * (m) + fr)
struct EpiEvNat { static constexpr bool HOOK = false; static constexpr bool CARRY = false; static DI float carry(const Unit&) { return 0.f; } static constexpr bool PERM = true;
    unsigned char* ws; const float* gains;
    DI void operator()(const Acc& acc, const Unit& u, int wr, int wc, int fr, int fq) const {
        const int pn = u.pn; const bool norm = (pn != 6);
        const int gi = pn < 2 ? 0 : pn < 4 ? 1 : pn < 6 ? 2 : 3;
        const float* g = gains + gi * 64;
        f32x4 gv[2][2];
#pragma unroll
        for (int bj = 0; bj < 2; ++bj)
#pragma unroll
            for (int n = 0; n < 2; ++n) { const f32x4 t4 = *(const f32x4*)(g + 32 * bj + 8 * fq + 4 * n); gv[bj][n] = norm ? t4 : (f32x4){1.f, 1.f, 1.f, 1.f}; }
        size_t boff; int rowmul, hoff; bool panel = false;
        if (pn < 2) { boff = WS_QD; rowmul = 512; hoff = (pn * 4 + wc) * 64; }
        else if (pn < 4) { boff = WS_KD; rowmul = 512; hoff = ((pn - 2) * 4 + wc) * 64; }
        else if (pn < 6) { boff = WS_QN; rowmul = 512; hoff = ((pn - 4) * 4 + wc) * 64; }
        else { panel = true; rowmul = 64; hoff = 0; boff = (pn == 6) ? (wc < 2 ? WS_KCB : WS_VCB) : (wc < 2 ? WS_KSB : WS_KWB); }
        bf16_t* base = (bf16_t*)(ws + boff);
#pragma unroll
        for (int ai = 0; ai < 2; ++ai)
#pragma unroll
            for (int m = 0; m < 4; ++m) {
                const int t = u.pm * 256 + EPI_ROWS(ai, m), b = t >> 11, sq = t & 2047;
                float ss = 0.f;
#pragma unroll
                for (int bj = 0; bj < 2; ++bj)
#pragma unroll
                    for (int n = 0; n < 2; ++n) { const f32x4 x = acc[ai][bj][m][n]; ss += (x[0] * x[0] + x[1] * x[1]) + (x[2] * x[2] + x[3] * x[3]); }
                ss += shx(ss, 16); ss += shx(ss, 32);
                const float rstd = norm ? rsqrtf(ss * (1.0f / 64.0f) + EPS) * ((pn < 2 || pn == 4 || pn == 5) ? 0.125f : 1.0f) : 1.0f;
                const size_t rowi = panel ? ((size_t)(b * 2 + (wc & 1)) * 2048 + sq) : (size_t)t;
#pragma unroll
                for (int bj = 0; bj < 2; ++bj) {
                    const f32x4 v0 = acc[ai][bj][m][0] * rstd * gv[bj][0], v1 = acc[ai][bj][m][1] * rstd * gv[bj][1];
                    *(u32x4*)(base + rowi * rowmul + hoff + 32 * bj + 8 * fq) = pack8(v0, v1);
                }
            }
    }
};
struct EpiEvSw { static constexpr bool HOOK = false; static constexpr bool CARRY = false; static DI float carry(const Unit&) { return 0.f; } static constexpr bool PERM = true;
    unsigned char* ws;
    DI void operator()(const Acc& acc, const Unit& u, int wr, int wc, int fr, int fq) const {
        const int b = u.pn >> 3, sb = (u.pn & 7) * 256;
#pragma unroll
        for (int ai = 0; ai < 2; ++ai)
#pragma unroll
            for (int m = 0; m < 4; ++m) {
                const int rl = EPI_ROWS(ai, m);
                size_t boff, rowi;
                if (u.pm < 2) { const int fg = u.pm * 256 + rl; boff = WS_VAT; rowi = (size_t)(b * 4 + (fg >> 7)) * 128 + (fg & 127); }
                else { const int r2 = rl & 127; boff = (rl < 128) ? WS_VST : WS_VWT; rowi = (size_t)(b * 2 + (r2 >> 6)) * 64 + (r2 & 63); }
                bf16_t* rowp = (bf16_t*)(ws + boff) + rowi * 2048;
#pragma unroll
                for (int bj = 0; bj < 2; ++bj) { const u32x4 pw = pack8(acc[ai][bj][m][0], acc[ai][bj][m][1]);
                    const int s0 = sb + 128 * bj + 32 * wc + 8 * fq; bf16_t* g16 = rowp + (s0 & ~15) + ((s0 & 8) ? 4 : 0);
                    *(u32x2*)g16 = (u32x2){pw.x, pw.y}; *(u32x2*)(g16 + 8) = (u32x2){pw.z, pw.w}; }
            }
    }
};
struct EpiCmp1 { static constexpr bool HOOK = false; static constexpr bool CARRY = false; static DI float carry(const Unit&) { return 0.f; } static constexpr bool PERM = true;
    bf16_t* HID; const float* bias1;
    DI void operator()(const Acc& acc, const Unit& u, int wr, int wc, int fr, int fq) const {
        const int kv = u.pm >> 4, rt = u.pm & 15;
#pragma unroll
        for (int bj = 0; bj < 2; ++bj) {
            const int col = 128 * bj + 32 * wc + 8 * fq;
            const f32x4 b0 = *(const f32x4*)(bias1 + kv * 256 + col), b1 = *(const f32x4*)(bias1 + kv * 256 + col + 4);
#pragma unroll
            for (int ai = 0; ai < 2; ++ai)
#pragma unroll
                for (int m = 0; m < 4; ++m) {
                    f32x4 v0 = acc[ai][bj][m][0] + b0, v1 = acc[ai][bj][m][1] + b1;
#pragma unroll
                    for (int j = 0; j < 4; ++j) { v0[j] = v0[j] * sigm(v0[j]); v1[j] = v1[j] * sigm(v1[j]); }
                    *(u32x4*)(HID + ((size_t)kv * 4096 + rt * 256 + EPI_ROWS(ai, m)) * 256 + col) = pack8(v0, v1);
                }
        }
    }
};
struct EpiResid { static constexpr bool HOOK = false; static constexpr bool CARRY = false; static DI float carry(const Unit&) { return 0.f; } static constexpr bool PERM = false;
    const float* Hin; float* Hout;
    DI void operator()(const Acc& acc, const Unit& u, int wr, int wc, int fr, int fq) const {
#pragma unroll
        for (int ai = 0; ai < 2; ++ai)
#pragma unroll
            for (int m = 0; m < 4; ++m) {
                const size_t off = (size_t)(u.pm * 256 + EPI_ROWS(ai, m)) * 1024 + u.pn * 256 + 32 * wc + 4 * fq;
#pragma unroll
                for (int bj = 0; bj < 2; ++bj)
#pragma unroll
                    for (int n = 0; n < 2; ++n) { const size_t o = off + 128 * bj + 16 * n; *(f32x4*)(Hout + o) = *(const f32x4*)(Hin + o) + acc[ai][bj][m][n]; }
            }
    }
};
DI float ret_lg2(int h) { return __log2f(1.0f - exp2f(-5.0f - (float)h)); }
struct EpiOdNat { static constexpr bool HOOK = false; static constexpr bool CARRY = false; static DI float carry(const Unit&) { return 0.f; } static constexpr bool PERM = true;
    unsigned char* ws;
    DI void operator()(const Acc& acc, const Unit& u, int wr, int wc, int fr, int fq) const {
        const int pn = u.pn; const int h = pn & 3; const float lg = ret_lg2(h);
        const size_t boff = pn < 4 ? WS_AQ : pn < 8 ? WS_KP : WS_GG;
        const int rowmul = pn < 4 ? 2048 : pn < 8 ? 1024 : 2048;
        const int coff = pn < 4 ? (h * 512 + 256) : pn < 8 ? (h * 256) : ((pn - 8) * 256);
        bf16_t* base = (bf16_t*)(ws + boff) + coff;
#pragma unroll
        for (int ai = 0; ai < 2; ++ai)
#pragma unroll
            for (int m = 0; m < 4; ++m) {
                const int cl = EPI_ROWS(ai, m); const size_t t = (size_t)u.pm * 256 + cl;
                float sc = 1.f;
                if (pn < 4) sc = exp2f(lg * (float)(cl + 1)); else if (pn < 8) sc = 0.0625f * exp2f(-lg * (float)(cl + 1));
#pragma unroll
                for (int bj = 0; bj < 2; ++bj) {
                    const int d = 128 * bj + 32 * wc + 8 * fq;
                    f32x4 v0 = acc[ai][bj][m][0] * sc, v1 = acc[ai][bj][m][1] * sc;
                    if (pn >= 8) {
#pragma unroll
                        for (int j = 0; j < 4; ++j) { v0[j] = v0[j] * sigm(v0[j]); v1[j] = v1[j] * sigm(v1[j]); } }
                    const u32x4 pw = pack8(v0, v1);
                    *(u32x4*)(base + t * rowmul + d) = pw;
                    if (pn >= 4 && pn < 8) {
                        bf16_t* kt = (bf16_t*)(ws + WS_KT) + ((size_t)((u.pm >> 3) * 4 + h) * 8 + (u.pm & 7)) * 65536 + (size_t)d * 256 + cl;
                        kt[0 * 256] = (bf16_t)(pw.x & 0xffffu); kt[1 * 256] = (bf16_t)(pw.x >> 16); kt[2 * 256] = (bf16_t)(pw.y & 0xffffu); kt[3 * 256] = (bf16_t)(pw.y >> 16);
                        kt[4 * 256] = (bf16_t)(pw.z & 0xffffu); kt[5 * 256] = (bf16_t)(pw.z >> 16); kt[6 * 256] = (bf16_t)(pw.w & 0xffffu); kt[7 * 256] = (bf16_t)(pw.w >> 16);
                    }
                }
            }
    }
};
struct EpiOdSw { static constexpr bool HOOK = false; static constexpr bool CARRY = false; static DI float carry(const Unit&) { return 0.f; } static constexpr bool PERM = true;
    unsigned char* ws;
    DI void operator()(const Acc& acc, const Unit& u, int wr, int wc, int fr, int fq) const {
        const int b = u.pn >> 3, n = u.pn & 7, h = u.pm >> 1;
        const size_t z = (size_t)(b * 4 + h) * 8 + n;
        bf16_t* base = (bf16_t*)(ws + WS_VS) + z * 262144 + (size_t)(u.pm & 1) * 256 * 512;
#pragma unroll
        for (int bj = 0; bj < 2; ++bj) {
            const int cl = 128 * bj + 32 * wc + 8 * fq;
#pragma unroll
            for (int ai = 0; ai < 2; ++ai)
#pragma unroll
                for (int m = 0; m < 4; ++m)
                    *(u32x4*)(base + (size_t)EPI_ROWS(ai, m) * 512 + cl) = pack8(acc[ai][bj][m][0], acc[ai][bj][m][1]);
        }
    }
};
struct EpiAtt { static constexpr bool HOOK = false; static constexpr bool CARRY = false; static DI float carry(const Unit&) { return 0.f; } static constexpr bool PERM = true;
    bf16_t* AQ;
    DI void operator()(const Acc& acc, const Unit& u, int wr, int wc, int fr, int fq) const {
        const int z = u.pm, n = z & 7, h = (z >> 3) & 3, b = z >> 5; const size_t t0 = (size_t)b * 2048 + n * 256;
#pragma unroll
        for (int ai = 0; ai < 2; ++ai)
#pragma unroll
            for (int m = 0; m < 4; ++m) {
                const int c = EPI_ROWS(ai, m);
#pragma unroll
                for (int bj = 0; bj < 2; ++bj) {
                    const int e0 = 128 * bj + 32 * wc + 8 * fq;
                    f32x4 v0 = acc[ai][bj][m][0], v1 = acc[ai][bj][m][1];
#pragma unroll
                    for (int j = 0; j < 4; ++j) { v0[j] = (c >= e0 + j) ? v0[j] : 0.f; v1[j] = (c >= e0 + 4 + j) ? v1[j] : 0.f; }
                    *(u32x4*)(AQ + ((t0 + c) * 4 + h) * 512 + e0) = pack8(v0, v1);
                }
            }
    }
};
struct EpiUT { static constexpr bool HOOK = false; static constexpr bool CARRY = false; static DI float carry(const Unit&) { return 0.f; } static constexpr bool PERM = true;
    bf16_t* UT;
    DI void operator()(const Acc& acc, const Unit& u, int wr, int wc, int fr, int fq) const {
        const size_t z = (size_t)(u.pm >> 1); const int half = u.pm & 1;
#pragma unroll
        for (int ai = 0; ai < 2; ++ai)
#pragma unroll
            for (int m = 0; m < 4; ++m) {
                bf16_t* rowp = UT + z * 131072 + (size_t)(half * 256 + EPI_ROWS(ai, m)) * 256 + 32 * wc + 8 * fq;
#pragma unroll
                for (int bj = 0; bj < 2; ++bj) *(u32x4*)(rowp + 128 * bj) = pack8(acc[ai][bj][m][0], acc[ai][bj][m][1]);
            }
    }
};
struct EpiUTScan { static constexpr bool HOOK = false; static constexpr bool CARRY = true; static constexpr bool PERM = true;
    static DI float carry(const Unit& u) { const int z = u.pm >> 1, n = z & 7, h = (z >> 3) & 3; return n == 7 ? 0.f : exp2f(256.0f * ret_lg2(h)); }
    bf16_t* VS;
    DI void operator()(const Acc& acc, const Unit& u, int wr, int wc, int fr, int fq) const {
        const size_t z = (size_t)(u.pm >> 1); const int half = u.pm & 1, n = (int)(z & 7), h = (int)((z >> 3) & 3);
        const float dec = exp2f(256.0f * ret_lg2(h));
#pragma unroll
        for (int ai = 0; ai < 2; ++ai)
#pragma unroll
            for (int m = 0; m < 4; ++m) {
                bf16_t* rowp = VS + (z * 512 + half * 256 + EPI_ROWS(ai, m)) * 512 + 256 + 32 * wc + 8 * fq;
#pragma unroll
                for (int bj = 0; bj < 2; ++bj) {
                    if (n == 0) { unsigned z0; asm volatile("v_mov_b32 %0, 0" : "=v"(z0)); *(u32x4*)(rowp + 128 * bj) = (u32x4){z0, z0, z0, z0}; }
                    if (n < 7) *(u32x4*)(rowp + (size_t)512 * 512 + 128 * bj) = pack8(acc[ai][bj][m][0] * dec, acc[ai][bj][m][1] * dec);
                }
            }
    }
};
struct SchedSeq { int nb, c;
    DI void init(int G, int c_) { nb = G / 2 > 0 ? G / 2 : 1; c = c_; }
    DI bool next(int i, Unit& u) const { if (c >= nb) return false; const int seq = c + (i >> 3) * nb; if (seq >= 128) return false;
        const int bh = seq >> 1, half = seq & 1, n = i & 7; u.pm = (bh * 8 + n) * 2 + half; u.pn = 0; return true; } };
struct EpiY { static constexpr bool HOOK = false; static constexpr bool CARRY = false; static DI float carry(const Unit&) { return 0.f; } static constexpr bool PERM = true;
    bf16_t* Y;
    DI void operator()(const Acc& acc, const Unit& u, int wr, int wc, int fr, int fq) const {
        const int z = u.pm, n = z & 7, h = (z >> 3) & 3, b = z >> 5; const size_t t0 = (size_t)b * 2048 + n * 256;
#pragma unroll
        for (int ai = 0; ai < 2; ++ai)
#pragma unroll
            for (int m = 0; m < 4; ++m) {
                bf16_t* rowp = Y + (t0 + EPI_ROWS(ai, m)) * 2048 + h * 512 + u.pn * 256 + 32 * wc + 8 * fq;
#pragma unroll
                for (int bj = 0; bj < 2; ++bj) *(u32x4*)(rowp + 128 * bj) = pack8(acc[ai][bj][m][0], acc[ai][bj][m][1]);
            }
    }
};
constexpr float W8_SCALE = 32.0f, WSC = 1.0f / W8_SCALE;
struct EpiGU { static constexpr bool HOOK = true; static constexpr bool CARRY = false; static DI float carry(const Unit&) { return 0.f; } static constexpr bool PERM = true;
    unsigned char* ACT; const float* bgu; const LAS int* ts;
    DI void prefetch(const Unit& u, LAS unsigned char* lds, int wid, int lane) const {
        if (wid == 0) { const int e = moe_tile_expert(ts, u.pm); const int ln = lane_now();
            const float* src = bgu + (size_t)e * 2048 + 128 * u.pn + ((ln & 32) ? 1024 : 0) + 4 * (ln & 31);
            __builtin_amdgcn_global_load_lds((const unsigned*)src, (LAS unsigned*)(lds + MISC_OFF + MO_RED), 16, 0, 0); }
    }
    DI void operator()(const Acc& acc, const Unit& u, int wr, int wc, int fr, int fq) const {
        const int w = 32 * wc + 8 * fq;
        const LAS float* bl_ = (const LAS float*)(ts) - MO_TS / 4 + MO_RED / 4 + w;
        const f32x4 bg0 = *(const LAS f32x4*)bl_, bg1 = *(const LAS f32x4*)(bl_ + 4), bl0 = *(const LAS f32x4*)(bl_ + 128), bl1 = *(const LAS f32x4*)(bl_ + 132);
#pragma unroll
        for (int ai = 0; ai < 2; ++ai)
#pragma unroll
            for (int m = 0; m < 4; ++m) {
                f32x4 g0 = acc[ai][0][m][0] * WSC + bg0, g1 = acc[ai][0][m][1] * WSC + bg1, l0 = acc[ai][1][m][0] * WSC + bl0, l1 = acc[ai][1][m][1] * WSC + bl1;
#pragma unroll
                for (int j = 0; j < 4; ++j) {
                    const float a = fminf(g0[j], 7.0f), c = fminf(g1[j], 7.0f);
                    const float la = fminf(fmaxf(l0[j], -7.0f), 7.0f), lc = fminf(fmaxf(l1[j], -7.0f), 7.0f);
                    g0[j] = a * sigm(1.702f * a) * (la + 1.0f); g1[j] = c * sigm(1.702f * c) * (lc + 1.0f); }
                u32x2 o8; o8.x = pk4_fp8(g0[0], g0[1], g0[2], g0[3]); o8.y = pk4_fp8(g1[0], g1[1], g1[2], g1[3]);
                *(u32x2*)(ACT + ((size_t)u.pm * 256 + EPI_ROWS(ai, m)) * 1024 + 128 * u.pn + w) = o8;
            }
    }
};
struct EpiDN { static constexpr bool HOOK = true; static constexpr bool CARRY = false; static DI float carry(const Unit&) { return 0.f; } static constexpr bool PERM = true;
    bf16_t* YB; const float* bdn; const LAS int* ts;
    DI void prefetch(const Unit& u, LAS unsigned char* lds, int wid, int lane) const {
        if (wid == 0) { const int e = moe_tile_expert(ts, u.pm); const int ln = lane_now();
            __builtin_amdgcn_global_load_lds((const unsigned*)(bdn + (size_t)e * 1024 + 256 * u.pn + 4 * ln), (LAS unsigned*)(lds + MISC_OFF + MO_RED), 16, 0, 0); }
    }
    DI void operator()(const Acc& acc, const Unit& u, int wr, int wc, int fr, int fq) const {
        const LAS float* bl_ = (const LAS float*)(ts) - MO_TS / 4 + MO_RED / 4;
#pragma unroll
        for (int bj = 0; bj < 2; ++bj) {
            const int cl = 128 * bj + 32 * wc + 8 * fq, col = 256 * u.pn + cl;
            const f32x4 b0 = *(const LAS f32x4*)(bl_ + cl), b1 = *(const LAS f32x4*)(bl_ + cl + 4);
#pragma unroll
            for (int ai = 0; ai < 2; ++ai)
#pragma unroll
                for (int m = 0; m < 4; ++m)
                    *(u32x4*)(YB + ((size_t)u.pm * 256 + EPI_ROWS(ai, m)) * 1024 + col) = pack8(acc[ai][bj][m][0] * (1.0f / 64.0f) + b0, acc[ai][bj][m][1] * (1.0f / 64.0f) + b1);
        }
    }
};
struct EpiPP { static constexpr bool HOOK = false; static constexpr bool CARRY = false; static DI float carry(const Unit&) { return 0.f; } static constexpr bool PERM = true;
    bf16_t* PP;
    DI void operator()(const Acc& acc, const Unit& u, int wr, int wc, int fr, int fq) const {
#pragma unroll
        for (int ai = 0; ai < 2; ++ai)
#pragma unroll
            for (int m = 0; m < 4; ++m) {
                bf16_t* rowp = PP + ((size_t)u.pm * 256 + EPI_ROWS(ai, m)) * 1024 + u.pn * 256 + 32 * wc + 8 * fq;
#pragma unroll
                for (int bj = 0; bj < 2; ++bj) *(u32x4*)(rowp + 128 * bj) = pack8(acc[ai][bj][m][0], acc[ai][bj][m][1]);
            }
    }
};
struct EpiPLE { static constexpr bool HOOK = false; static constexpr bool CARRY = false; static DI float carry(const Unit&) { return 0.f; } static constexpr bool PERM = false;
    float* H; const bf16_t* PP;
    DI void operator()(const Acc& acc, const Unit& u, int wr, int wc, int fr, int fq) const {
#pragma unroll
        for (int ai = 0; ai < 2; ++ai)
#pragma unroll
            for (int m = 0; m < 4; ++m) {
                const size_t off = (size_t)(u.pm * 256 + EPI_ROWS(ai, m)) * 1024 + u.pn * 256 + 32 * wc + 4 * fq;
#pragma unroll
                for (int bj = 0; bj < 2; ++bj)
#pragma unroll
                    for (int n = 0; n < 2; ++n) {
                        const size_t o = off + 128 * bj + 16 * n;
                        const u32x2 pw = *(const u32x2*)(PP + o); const f32x4 a = acc[ai][bj][m][n]; f32x4 hv = *(const f32x4*)(H + o);
                        hv[0] += sigm(a[0] * WSC) * bflo(pw.x); hv[1] += sigm(a[1] * WSC) * bfhi(pw.x); hv[2] += sigm(a[2] * WSC) * bflo(pw.y); hv[3] += sigm(a[3] * WSC) * bfhi(pw.y);
                        *(f32x4*)(H + o) = hv;
                    }
            }
    }
};

DI int vperm16(int key) { const int g = (key >> 2) & 3; const int ng = (g == 1) ? 2 : (g == 2) ? 1 : g; return (key & ~15) | (ng << 2) | (key & 3); }
template <int DV, int MODE>
DI void attn_unit(const int WID, LAS unsigned char* lds, const bf16_t* Qp, int ldq, const bf16_t* Kp, int ldk, const bf16_t* Vt, int ldvt, int q0, float slope, int dcut,
                  const unsigned* selp, bf16_t* Op, int ldo, float* impp) {
    constexpr int NRB = DV / 32;
    constexpr int KT_B = 64 * 128, VT_B = DV * 128, BUF_B = 2 * KT_B + 2 * VT_B;
    const int tid = opaque_tid(WID), w = __builtin_amdgcn_readfirstlane(tid >> 6), lane = tid & 63, r = lane & 31, hh = lane >> 5;
    const int qrow = q0 + 32 * w + r, qw_first = q0 + 32 * w, qw_last = qw_first + 31;
    const float LOG2E = 1.44269504089f;
    bf16x8 qf[4];
#pragma unroll
    for (int ks = 0; ks < 4; ++ks) qf[ks] = *(const bf16x8*)(Qp + (size_t)(32 * w + r) * ldq + 16 * ks + 8 * hh);
    unsigned selm = 0xffffffffu, orm = 0xffffffffu;
    if (MODE == 1) { selm = selp[32 * w + r]; orm = selm;
#pragma unroll
        for (int o = 1; o < 32; o <<= 1) orm |= shxu(orm, o); }
    const int nv = (MODE == 3) ? (qrow >= 31 ? ((qrow - 15) >> 4) : 0) : 0;
    const int nv_wmax = (MODE == 3) ? (qw_last >= 31 ? ((qw_last - 15) >> 4) : 0) : 0;
    int kt_lo = 0, kt_hi;
    if (MODE == 0 || MODE == 1) kt_hi = (q0 >> 6) + 4;
    else if (MODE == 2) { kt_hi = (q0 >> 6) + 4; const int lk = q0 - 511; kt_lo = lk > 0 ? (lk >> 6) : 0; }
    else kt_hi = 2;
    if (MODE != 3) { const int kmin = q0 - dcut; const int lo2 = kmin > 0 ? (kmin >> 6) : 0; kt_lo = lo2 > kt_lo ? lo2 : kt_lo; }
    f32x16 cb[2];
#pragma unroll
    for (int kk = 0; kk < 2; ++kk)
#pragma unroll
        for (int i = 0; i < 16; ++i) cb[kk][i] = (MODE == 3) ? 0.f : slope * (float)(32 * kk + 8 * (i >> 2) + (i & 3) + 4 * hh);
    f32x16 O[NRB];
#pragma unroll
    for (int rb = 0; rb < NRB; ++rb)
#pragma unroll
        for (int i = 0; i < 16; ++i) O[rb][i] = 0.f;
    float mrun = NEGF, lrun = 0.f;
    const int drow = tid >> 3, dpc = (tid & 7) ^ ((drow >> 1) & 7);
    const unsigned ldsw = (unsigned)w * 1024u;
#define AT_DMA(buf, sub, kt) do { const int kt_ = (kt) < 0 ? 0 : (kt); LAS unsigned char* b_ = lds + (buf) * BUF_B; \
        __builtin_amdgcn_global_load_lds((const unsigned*)(Kp + (size_t)(64 * kt_ + drow) * ldk + 8 * dpc), (LAS unsigned*)(b_ + (sub) * KT_B + ldsw), 16, 0, 0); \
        _Pragma("unroll") for (int i_ = 0; i_ < (DV + 63) / 64; ++i_) { if (64 * i_ + 64 <= DV || w < 4) \
            __builtin_amdgcn_global_load_lds((const unsigned*)(Vt + (size_t)(drow + 64 * i_) * ldvt + 64 * kt_ + 8 * dpc), (LAS unsigned*)(b_ + 2 * KT_B + (sub) * VT_B + i_ * 8192 + ldsw), 16, 0, 0); } } while (0)
    const int ntile = kt_hi - kt_lo, nstep = (ntile + 1) >> 1;
    AT_DMA(0, 0, kt_hi - 1); AT_DMA(0, 1, kt_hi - 2);
    asm volatile("s_waitcnt vmcnt(0)" ::: "memory");
    __syncthreads();
#if PROBE_ATT == 2
    AT_DMA(0, 0, kt_hi - 1); AT_DMA(0, 1, kt_hi - 2);
    asm volatile("s_waitcnt vmcnt(0)" ::: "memory");
    __syncthreads();
#endif
    const int sw = (r >> 1) & 7;
    for (int st = 0; st < nstep; ++st) {
        const int buf = st & 1;
        if (st + 1 < nstep) { AT_DMA(buf ^ 1, 0, kt_hi - 3 - 2 * st); AT_DMA(buf ^ 1, 1, kt_hi - 4 - 2 * st); }
#pragma unroll
        for (int sub = 0; sub < 2; ++sub) {
        const int kt = kt_hi - 1 - 2 * st - sub, key0 = 64 * kt;
        bool skip;
        if (MODE == 0) skip = key0 > qw_last;
        else if (MODE == 1) skip = (key0 > qw_last) || !((orm >> (kt & 31)) & 1u);
        else if (MODE == 2) skip = (key0 > qw_last) || (key0 + 63 < qw_first - 511);
        else skip = key0 >= nv_wmax;
        skip = skip || (kt < kt_lo);
        if (!skip) {
            const LAS unsigned char* kb = lds + buf * BUF_B + sub * KT_B; const LAS unsigned char* vb = lds + buf * BUF_B + 2 * KT_B + sub * VT_B;
            f32x16 S[2];
#pragma unroll
            for (int kk = 0; kk < 2; ++kk) {
                S[kk] = cb[kk];
#pragma unroll
                for (int ks = 0; ks < 4; ++ks) { const bf16x8 a = *(const LAS bf16x8*)(kb + (32 * kk + r) * 128 + (((2 * ks + hh) ^ sw) << 4));
                    S[kk] = __builtin_amdgcn_mfma_f32_32x32x16_bf16(a, qf[ks], S[kk], 0, 0, 0); }
            }
            const bool bnd = (MODE == 3) ? true : ((key0 + 63 > qw_first) || (MODE == 2 && key0 < qw_last - 511));
            if (bnd) {
                const int lim = (MODE == 3) ? (nv - key0 - 4 * hh) : (qrow - key0 - 4 * hh);
#pragma unroll
                for (int kk = 0; kk < 2; ++kk)
#pragma unroll
                    for (int i = 0; i < 16; ++i) { const int cki = 32 * kk + 8 * (i >> 2) + (i & 3);
                        bool valid;
                        if (MODE == 3) valid = cki < lim; else if (MODE == 2) valid = (cki <= lim) && (cki > lim - 512); else valid = cki <= lim;
                        S[kk][i] = valid ? S[kk][i] : NEGF; }
            }
            float mx = NEGF;
#pragma unroll
            for (int kk = 0; kk < 2; ++kk)
#pragma unroll
                for (int i = 0; i < 16; ++i) mx = fmaxf(mx, S[kk][i]);
            mx = fmaxf(mx, shx(mx, 32));
            const float off = (MODE == 3) ? 0.f : slope * (float)key0;
            mx += off;
            bool selok = true;
            if (MODE == 1) { selok = ((selm >> (kt & 31)) & 1u) != 0u; mx = selok ? mx : NEGF; }
            const float mnew = fmaxf(mrun, mx);
            const float meff = (mnew < -1e29f) ? 0.f : mnew;
            float c = (off - meff) * LOG2E;
            if (MODE == 1) c = selok ? c : NEGF;
            float ps = 0.f;
#pragma unroll
            for (int kk = 0; kk < 2; ++kk)
#pragma unroll
                for (int i = 0; i < 16; ++i) { const float p = __builtin_amdgcn_exp2f(__builtin_fmaf(S[kk][i], LOG2E, c)); S[kk][i] = p; ps += p; }
            if (__any(mnew > mrun)) {
                const float alpha = __builtin_amdgcn_exp2f((mrun - mnew) * LOG2E);
                lrun *= alpha;
#pragma unroll
                for (int rb = 0; rb < NRB; ++rb)
#pragma unroll
                    for (int i = 0; i < 16; ++i) O[rb][i] *= alpha;
            }
            mrun = mnew; lrun += ps;
#pragma unroll
            for (int kk = 0; kk < 2; ++kk)
#pragma unroll
                for (int s2 = 0; s2 < 2; ++s2) {
                    u32x4 pw; pw.x = pk2(S[kk][8 * s2 + 0], S[kk][8 * s2 + 1]); pw.y = pk2(S[kk][8 * s2 + 2], S[kk][8 * s2 + 3]);
                    pw.z = pk2(S[kk][8 * s2 + 4], S[kk][8 * s2 + 5]); pw.w = pk2(S[kk][8 * s2 + 6], S[kk][8 * s2 + 7]);
                    const bf16x8 pf = __builtin_bit_cast(bf16x8, pw);
#pragma unroll
                    for (int rb = 0; rb < NRB; ++rb) {
                        const bf16x8 a = *(const LAS bf16x8*)(vb + (32 * rb + r) * 128 + ((((2 * kk + s2) * 2 + hh) ^ sw) << 4));
                        O[rb] = __builtin_amdgcn_mfma_f32_32x32x16_bf16(a, pf, O[rb], 0, 0, 0);
                    }
                }
        }
        }
        asm volatile("s_waitcnt vmcnt(0)" ::: "memory");
        __syncthreads();
    }
#undef AT_DMA
    const float ltot = lrun + shx(lrun, 32);
    float inv = 1.0f / ltot;
    if (MODE == 3) inv = (nv > 0) ? inv : 0.f;
#if PROBE_ATT == 1
    for (int rep_ = 0; rep_ < 2; ++rep_) { asm volatile("" ::: "memory");
#endif
#pragma unroll
    for (int rb = 0; rb < NRB; ++rb)
#pragma unroll
        for (int g4 = 0; g4 < 4; ++g4) {
            const float a = O[rb][4 * g4] * inv, b = O[rb][4 * g4 + 1] * inv, c = O[rb][4 * g4 + 2] * inv, d = O[rb][4 * g4 + 3] * inv;
            const int dv = 32 * rb + 8 * g4 + 4 * hh;
            if (MODE == 3 && rb == 2) { *(f32x4*)(impp + (size_t)(32 * w + r) * 256 + (dv - 64)) = (f32x4){a, b, c, d}; }
            else { u32x2 o; o.x = pk2(a, b); o.y = pk2(c, d); *(u32x2*)(Op + (size_t)(32 * w + r) * ldo + dv) = o; }
        }
#if PROBE_ATT == 1
    }
#endif
}

struct Args { const float* in[26]; float* out; unsigned char* ws; int ph_lo, ph_hi; };
typedef const __attribute__((address_space(4))) Args* ArgsP;
DI ArgsP opaque_args() { auto p = __builtin_amdgcn_kernarg_segment_ptr(); asm volatile("" : "+s"(p)); return (ArgsP)p; }
enum { I_X = 0, I_P, I_N1G, I_N2G, I_EVWIN, I_EVWOUT, I_DAQN, I_DAKN, I_DALAM, I_DAOUTG, I_NSQN, I_NSKN, I_CMPPE, I_CMPW1, I_CMPW2, I_ODWIN, I_ODWOUT,
       I_RETG, I_ROUTW, I_ROUTB, I_WGU, I_BGU, I_WDN, I_BDN, I_PLEP, I_PLEG };

struct CvtJob { int in_idx, ldsrc, K, col0, ncols, dstrow0, perm, nmat; size_t src_stride, dst_off, dst_stride; int fp8, pad; };
constexpr int NJOBS = 19;
__constant__ CvtJob c_jobs[NJOBS] = {
    {I_EVWIN, EVIN, 1024, 0,    1024, 0,    1, 2, (size_t)1024 * EVIN, WS_EVNAT, (size_t)2048 * 1024, 0, 0},
    {I_EVWIN, EVIN, 1024, 1536, 512,  1024, 1, 2, (size_t)1024 * EVIN, WS_EVNAT, (size_t)2048 * 1024, 0, 0},
    {I_EVWIN, EVIN, 1024, 2048, 128,  1536, 1, 2, (size_t)1024 * EVIN, WS_EVNAT, (size_t)2048 * 1024, 0, 0},
    {I_EVWIN, EVIN, 1024, 2176, 128,  1664, 1, 2, (size_t)1024 * EVIN, WS_EVNAT, (size_t)2048 * 1024, 0, 0},
    {I_EVWIN, EVIN, 1024, 2304, 128,  1792, 1, 2, (size_t)1024 * EVIN, WS_EVNAT, (size_t)2048 * 1024, 0, 0},
    {I_EVWIN, EVIN, 1024, 2560, 128,  1920, 1, 2, (size_t)1024 * EVIN, WS_EVNAT, (size_t)2048 * 1024, 0, 0},
    {I_EVWIN, EVIN, 1024, 1024, 512,  0,    0, 2, (size_t)1024 * EVIN, WS_EVSW,  (size_t)768 * 1024, 0, 0},
    {I_EVWIN, EVIN, 1024, 2432, 128,  512,  0, 2, (size_t)1024 * EVIN, WS_EVSW,  (size_t)768 * 1024, 0, 0},
    {I_EVWIN, EVIN, 1024, 2688, 128,  640,  0, 2, (size_t)1024 * EVIN, WS_EVSW,  (size_t)768 * 1024, 0, 0},
    {I_EVWOUT, 1024, 1024, 0, 1024, 0, 0, 2, (size_t)1024 * 1024, WS_EVOUT, (size_t)1024 * 1024, 0, 0},
    {I_CMPW1, 256, 2048, 0, 256, 0, 0, 4, (size_t)2048 * 256, WS_CMP1, (size_t)256 * 2048, 0, 0},
    {I_ODWIN, ODIN, 1024, 0,    2048, 0,    0, 2, (size_t)1024 * ODIN, WS_ODNAT, (size_t)4096 * 1024, 0, 0},
    {I_ODWIN, ODIN, 1024, 4096, 2048, 2048, 0, 2, (size_t)1024 * ODIN, WS_ODNAT, (size_t)4096 * 1024, 0, 0},
    {I_ODWIN, ODIN, 1024, 2048, 2048, 0,    0, 2, (size_t)1024 * ODIN, WS_ODSW,  (size_t)2048 * 1024, 0, 0},
    {I_ODWOUT, 1024, 2048, 0, 1024, 0, 0, 2, (size_t)2048 * 1024, WS_ODOUT, (size_t)1024 * 2048, 0, 0},
    {I_WGU, 2048, 1024, 0, 2048, 0, 2, 128, (size_t)1024 * 2048, WS_WGU, (size_t)2048 * 1024, 32, 0},
    {I_WDN, 1024, 1024, 0, 1024, 0, 0, 128, (size_t)1024 * 1024, WS_WDN, (size_t)1024 * 1024, 64, 0},
    {I_PLEP, 1024, 256, 0, 1024, 0, 0, 4, (size_t)256 * 1024, WS_WPP, (size_t)1024 * 256, 0, 0},
    {I_PLEG, 1024, 1024, 0, 1024, 0, 0, 4, (size_t)1024 * 1024, WS_WPG, (size_t)1024 * 1024, 32, 0},
};
DI int cvt_dstrow(int perm, int L) {
    if (perm == 1) { const int pn = L >> 8, lc = L & 255; return pn * 256 + 128 * ((lc & 63) >> 5) + 32 * (lc >> 6) + (lc & 31); }
    if (perm == 2) { const int bj = L >> 10, cc = L & 1023; return 256 * (cc >> 7) + 128 * bj + (cc & 127); }
    return L;
}
DI void phase_prologue(const int WID, ArgsP a, LAS unsigned char* lds) {
    const int tid = opaque_tid(WID), lane = tid & 63, wv = tid >> 6;
    const int gw = blockIdx.x * 8 + wv, NGW = gridDim.x * 8;
    LAS float* scr = (LAS float*)(lds + wv * 16896);
    int total = 0;
    for (int j = 0; j < NJOBS; ++j) total += c_jobs[j].nmat * (c_jobs[j].K >> 6) * (c_jobs[j].ncols >> 6);
#define PRO_DECODE(IT, JJ, MAT, K0, N0, SRC, RS) do { int r_ = (IT), j_ = 0; \
        for (; j_ < NJOBS; ++j_) { const int n_ = c_jobs[j_].nmat * (c_jobs[j_].K >> 6) * (c_jobs[j_].ncols >> 6); if (r_ < n_) break; r_ -= n_; } \
        JJ = j_; const bool f8_ = c_jobs[j_].fp8 != 0; const int nkb_ = f8_ ? (c_jobs[j_].K >> 7) : (c_jobs[j_].K >> 6), nnb_ = f8_ ? (c_jobs[j_].ncols >> 5) : (c_jobs[j_].ncols >> 6), per_ = nkb_ * nnb_; \
        MAT = r_ / per_; const int rr_ = r_ % per_; K0 = (rr_ / nnb_) * (f8_ ? 128 : 64); N0 = (rr_ % nnb_) * (f8_ ? 32 : 64); const int ld_ = c_jobs[j_].ldsrc; \
        SRC = a->in[c_jobs[j_].in_idx] + (size_t)MAT * c_jobs[j_].src_stride + (size_t)K0 * ld_ + c_jobs[j_].col0 + N0 + (f8_ ? (lane & 31) + (lane >> 5) * ld_ : lane); RS = f8_ ? 2 * ld_ : ld_; } while (0)
    float tv[64];
    int jn = 0, matn = 0, k0n = 0, n0n = 0, rsn = 0; const float* srcn = nullptr;
    if (gw < total) { PRO_DECODE(gw, jn, matn, k0n, n0n, srcn, rsn);
#pragma unroll
        for (int i = 0; i < 64; ++i) tv[i] = srcn[(size_t)i * rsn]; }
    for (int it = gw; it < total; it += NGW) {
        const CvtJob J = c_jobs[jn]; const int mat = matn, k0 = k0n, n0 = n0n;
        { const int wb = J.fp8 ? (lane >> 5) * 33 + (lane & 31) : lane, wst = J.fp8 ? 66 : 65;
#pragma unroll
          for (int i = 0; i < 64; ++i) scr[wb + i * wst] = tv[i]; }
        if (it + NGW < total) { PRO_DECODE(it + NGW, jn, matn, k0n, n0n, srcn, rsn);
#pragma unroll
            for (int i = 0; i < 64; ++i) tv[i] = srcn[(size_t)i * rsn]; }
        asm volatile("s_waitcnt lgkmcnt(0)" ::: "memory");
        if (J.fp8) {
            unsigned char* dst = (unsigned char*)(a->ws + J.dst_off) + (size_t)mat * J.dst_stride;
            const int c = lane & 7, nsub = lane >> 3; const float W8_S = (float)J.fp8;
#pragma unroll
            for (int jj = 0; jj < 4; ++jj) {
                const int n = nsub + 8 * jj; const LAS float* s = scr + (16 * c) * 33 + n;
                u32x4 o;
                o.x = pk4_fp8(s[0] * W8_S, s[33] * W8_S, s[2 * 33] * W8_S, s[3 * 33] * W8_S); o.y = pk4_fp8(s[4 * 33] * W8_S, s[5 * 33] * W8_S, s[6 * 33] * W8_S, s[7 * 33] * W8_S);
                o.z = pk4_fp8(s[8 * 33] * W8_S, s[9 * 33] * W8_S, s[10 * 33] * W8_S, s[11 * 33] * W8_S); o.w = pk4_fp8(s[12 * 33] * W8_S, s[13 * 33] * W8_S, s[14 * 33] * W8_S, s[15 * 33] * W8_S);
                const int drow = cvt_dstrow(J.perm, J.dstrow0 + n0 + n);
                *(u32x4*)(dst + (size_t)drow * J.K + k0 + 16 * c) = o;
            }
        } else {
            bf16_t* dst = (bf16_t*)(a->ws + J.dst_off) + (size_t)mat * J.dst_stride;
            const int c = lane & 7, nsub = lane >> 3;
#pragma unroll
            for (int jj = 0; jj < 8; ++jj) {
                const int n = nsub + 8 * jj; const LAS float* s = scr + (8 * c) * 65 + n;
                u32x4 o; o.x = pk2(s[0], s[65]); o.y = pk2(s[2 * 65], s[3 * 65]); o.z = pk2(s[4 * 65], s[5 * 65]); o.w = pk2(s[6 * 65], s[7 * 65]);
                const int drow = cvt_dstrow(J.perm, J.dstrow0 + n0 + n);
                *(u32x4*)(dst + (size_t)drow * J.K + k0 + 8 * c) = o;
            }
        }
        asm volatile("s_waitcnt lgkmcnt(0)" ::: "memory");
    }
#undef PRO_DECODE
    {
        const float* p = a->in[I_P]; bf16_t* pb = (bf16_t*)(a->ws + WS_PBF);
        const size_t n8 = (size_t)DEPTH * T * 256 / 8;
        for (size_t i = (size_t)blockIdx.x * 512 + tid; i < n8; i += (size_t)gridDim.x * 512) {
            const f32x4 v0 = *(const f32x4*)(p + i * 8), v1 = *(const f32x4*)(p + i * 8 + 4);
            *(u32x4*)(pb + i * 8) = pack8(v0, v1);
        }
    }
    if (blockIdx.x == 4 && tid < 512) { const int ev = tid >> 8, gi = (tid >> 6) & 3, d = tid & 63;
        const float* src = a->in[gi == 0 ? I_DAQN : gi == 1 ? I_DAKN : gi == 2 ? I_NSQN : I_NSKN];
        ((float*)(a->ws + WS_GAINS))[tid] = src[ev * 64 + d]; }
    if (blockIdx.x < 4 && tid < 256) {
        const int m = blockIdx.x; const float* pe = a->in[I_CMPPE] + (size_t)m * 2048; const float* w1 = a->in[I_CMPW1] + (size_t)m * 2048 * 256;
        float s = 0.f;
        for (int k = 0; k < 2048; ++k) s += pe[k] * w1[(size_t)k * 256 + tid];
        ((float*)(a->ws + WS_BIAS1))[m * 256 + tid] = s;
    }
}

DI float row_load_ss(const float* row, int lane, f32x4 (&v)[4]) {
    float ss = 0.f;
#pragma unroll
    for (int j = 0; j < 4; ++j) { v[j] = *(const f32x4*)(row + 4 * lane + 256 * j); ss += (v[j][0] * v[j][0] + v[j][1] * v[j][1]) + (v[j][2] * v[j][2] + v[j][3] * v[j][3]); }
    return wave_sum(ss);
}
DI void row_store_bf16(bf16_t* row, int lane, const f32x4 (&v)[4]) {
#pragma unroll
    for (int j = 0; j < 4; ++j) { u32x2 o; o.x = pk2(v[j][0], v[j][1]); o.y = pk2(v[j][2], v[j][3]); *(u32x2*)(row + 4 * lane + 256 * j) = o; }
}
template <int MODE>
DI void phase_norm(const int WID, ArgsP a, LAS unsigned char* lds, int layer, const float* Hin) {
    const int tid = opaque_tid(WID), lane = tid & 63, wv = __builtin_amdgcn_readfirstlane(tid >> 6);
    LAS float* wt = (LAS float*)lds;
    LAS int* bcl = (LAS int*)(lds + MISC_OFF + MO_WCNT); LAS int* ent = (LAS int*)(lds + MISC_OFF + MO_ENT); LAS float* gat = (LAS float*)(lds + MISC_OFF + MO_GAT);
    LAS float* lgb = (LAS float*)(lds + MISC_OFF + MO_RED);
    bf16_t* XN = (bf16_t*)(a->ws + WS_XN);
    const float* gain = a->in[MODE == 2 ? I_N2G : I_N1G] + layer * 1024;
    constexpr int NQ = MODE == 0 ? 24 : (MODE == 2 ? 32 : 0);
    if (NQ > 0) {
        const float* w = (MODE == 0) ? a->in[I_EVWIN] + (size_t)(layer >> 1) * 1024 * EVIN + 2816 : a->in[I_ROUTW] + (size_t)layer * 1024 * 32;
        const int ldw = (MODE == 0) ? EVIN : 32;
        for (int i = tid; i < 256 * 32; i += 512) { const int q = i & 31, g = i >> 5;
            if (q < NQ) { f32x4 v; v[0] = w[(size_t)(4 * g) * ldw + q]; v[1] = w[(size_t)(4 * g + 1) * ldw + q]; v[2] = w[(size_t)(4 * g + 2) * ldw + q]; v[3] = w[(size_t)(4 * g + 3) * ldw + q];
                *(LAS f32x4*)(wt + q * 1024 + 4 * (g ^ q)) = v; } }
    }
    f32x4 gn[4];
#pragma unroll
    for (int j = 0; j < 4; ++j) gn[j] = *(const f32x4*)(gain + 4 * lane + 256 * j);
    const float rbias = (MODE == 2) ? a->in[I_ROUTB][layer * 32 + (lane & 31)] : 0.f;
    __syncthreads();
    for (int vb = blockIdx.x; vb < NTB; vb += gridDim.x) {
        if (MODE == 2) { if (tid < 32) bcl[tid] = 0; }
        const int t0 = vb * 128 + wv * 16;
        f32x4 na[4], nb[4];
#pragma unroll
        for (int j = 0; j < 4; ++j) { na[j] = *(const f32x4*)(Hin + (size_t)t0 * 1024 + 4 * lane + 256 * j); nb[j] = *(const f32x4*)(Hin + (size_t)(t0 + 1) * 1024 + 4 * lane + 256 * j); }
#pragma unroll 1
        for (int it = 0; it < 8; ++it) {
            const int ta = t0 + 2 * it;
            f32x4 va[4], vc[4];
#pragma unroll
            for (int j = 0; j < 4; ++j) { va[j] = na[j]; vc[j] = nb[j]; }
            if (it < 7) {
#pragma unroll
                for (int j = 0; j < 4; ++j) { na[j] = *(const f32x4*)(Hin + (size_t)(ta + 2) * 1024 + 4 * lane + 256 * j); nb[j] = *(const f32x4*)(Hin + (size_t)(ta + 3) * 1024 + 4 * lane + 256 * j); }
            }
            float sa = 0.f, sb = 0.f;
#pragma unroll
            for (int j = 0; j < 4; ++j) { sa += (va[j][0] * va[j][0] + va[j][1] * va[j][1]) + (va[j][2] * va[j][2] + va[j][3] * va[j][3]); sb += (vc[j][0] * vc[j][0] + vc[j][1] * vc[j][1]) + (vc[j][2] * vc[j][2] + vc[j][3] * vc[j][3]); }
#pragma unroll
            for (int o = 1; o < 64; o <<= 1) { sa += shx(sa, o); sb += shx(sb, o); }
            const float ra = rsqrtf(sa * (1.0f / 1024.0f) + EPS), rb2 = rsqrtf(sb * (1.0f / 1024.0f) + EPS);
#pragma unroll
            for (int j = 0; j < 4; ++j) { va[j] = va[j] * ra * gn[j]; vc[j] = vc[j] * rb2 * gn[j]; }
            row_store_bf16(XN + (size_t)ta * 1024, lane, va); row_store_bf16(XN + (size_t)(ta + 1) * 1024, lane, vc);
            if (NQ > 0) {
                float x[64];
#pragma unroll
                for (int q = 0; q < 32; ++q) {
                    if (q < NQ) { float s0 = 0.f, s1 = 0.f;
#pragma unroll
                        for (int j = 0; j < 4; ++j) { const f32x4 ww = *(const LAS f32x4*)(wt + q * 1024 + 4 * ((lane + 64 * j) ^ q));
                            s0 += (va[j][0] * ww[0] + va[j][1] * ww[1]) + (va[j][2] * ww[2] + va[j][3] * ww[3]); s1 += (vc[j][0] * ww[0] + vc[j][1] * ww[1]) + (vc[j][2] * ww[2] + vc[j][3] * ww[3]); }
                        x[q] = s0; x[32 + q] = s1;
                        if ((q & 3) == 3) asm volatile("" ::: "memory");
                    } else { x[q] = 0.f; x[32 + q] = 0.f; }
                }
#define RS_STEP(N, BIT) _Pragma("unroll") for (int i = 0; i < (N); ++i) { const bool up = (lane & (BIT)) != 0; const float keep = up ? x[(N) + i] : x[i], send = up ? x[i] : x[(N) + i]; x[i] = keep + shx(send, (BIT)); }
                RS_STEP(32, 32) RS_STEP(16, 16) RS_STEP(8, 8) RS_STEP(4, 4) RS_STEP(2, 2) RS_STEP(1, 1)
#undef RS_STEP
                const float val = x[0];
                if (MODE == 0) { if ((lane & 31) < 24) ((float*)(a->ws + WS_GATES))[(size_t)(ta + (lane >> 5)) * 24 + (lane & 31)] = sigm(val); }
                if (MODE == 2) {
                    lgb[wv * 64 + lane] = val + rbias;
                    asm volatile("s_waitcnt lgkmcnt(0)" ::: "memory");
                    float lg[32];
#pragma unroll
                    for (int q4 = 0; q4 < 8; ++q4) { const f32x4 t4 = *(const LAS f32x4*)(lgb + wv * 64 + (lane & 32) + 4 * q4); lg[4 * q4] = t4[0]; lg[4 * q4 + 1] = t4[1]; lg[4 * q4 + 2] = t4[2]; lg[4 * q4 + 3] = t4[3]; }
                    unsigned used = 0u; int te[4]; float tv[4];
#pragma unroll
                    for (int k = 0; k < 4; ++k) { float best = -3.0e38f; int bi = 0;
#pragma unroll
                        for (int q = 0; q < 32; ++q) { const bool ok = !((used >> q) & 1u) && (lg[q] > best); best = ok ? lg[q] : best; bi = ok ? q : bi; }
                        used |= 1u << bi; te[k] = bi; tv[k] = best; }
                    float ex[4], sum = 0.f;
#pragma unroll
                    for (int k = 0; k < 4; ++k) { ex[k] = __expf(tv[k] - tv[0]); sum += ex[k]; }
                    const float rs = 1.0f / sum;
                    if ((lane & 31) == 0) {
                        const int eb = wv * 64 + (2 * it + (lane >> 5)) * 4;
#pragma unroll
                        for (int k = 0; k < 4; ++k) { ent[eb + k] = te[k]; gat[eb + k] = ex[k] * rs; }
                    }
                    asm volatile("s_waitcnt lgkmcnt(0)" ::: "memory");
                }
            }
        }
        if (MODE == 2) {
            __syncthreads();
            { const int e = ent[wv * 64 + lane];
              const int pos = __hip_atomic_fetch_add(bcl + e, 1, __ATOMIC_RELAXED, __HIP_MEMORY_SCOPE_WORKGROUP);
              const size_t idx = (size_t)(vb * 128 + wv * 16) * 4 + lane;
              ((int*)(a->ws + WS_TOPE))[idx] = e; ((int*)(a->ws + WS_POSB))[idx] = pos; ((float*)(a->ws + WS_GATEW))[idx] = gat[wv * 64 + lane]; }
            __syncthreads();
            if (tid < 32) ((int*)(a->ws + WS_BCNT))[((size_t)layer * NTB + vb) * 32 + tid] = bcl[tid];
            __syncthreads();
        }
    }
}
DI void moe_tables(const int WID, ArgsP a, LAS unsigned char* lds, int layer, int vb) {
    const int tid = opaque_tid(WID);
    LAS int* tot = (LAS int*)(lds + MISC_OFF + MO_TOT); LAS int* base = (LAS int*)(lds + MISC_OFF + MO_BASE); LAS int* ts = (LAS int*)(lds + MISC_OFF + MO_TS);
    LAS int* red = (LAS int*)(lds + MISC_OFF + MO_RED);
    const int* bc = (const int*)(a->ws + WS_BCNT) + (size_t)layer * NTB * 32;
    { const int e = tid & 31, part = tid >> 5; int st = 0, sp = 0;
      for (int blk = part; blk < NTB; blk += 16) { const int v = bc[blk * 32 + e]; st += v; sp += (blk < vb) ? v : 0; }
      red[part * 32 + e] = st; red[512 + part * 32 + e] = sp; }
    __syncthreads();
    if (tid < 32) { int st = 0, sp = 0;
#pragma unroll
        for (int p = 0; p < 16; ++p) { st += red[p * 32 + tid]; sp += red[512 + p * 32 + tid]; }
        tot[tid] = st; base[tid] = sp; }
    __syncthreads();
    if (tid == 0) { int acc = 0; for (int e = 0; e < 32; ++e) { ts[e] = acc; acc += (tot[e] + 255) >> 8; } ts[32] = acc; }
    __syncthreads();
}
DI void phase_moe_slots(const int WID, ArgsP a, LAS unsigned char* lds, int layer) {
    const int tid = opaque_tid(WID), lane = tid & 63, wv = tid >> 6;
    LAS int* base = (LAS int*)(lds + MISC_OFF + MO_BASE); LAS int* ts = (LAS int*)(lds + MISC_OFF + MO_TS);
    const bf16_t* XN = (const bf16_t*)(a->ws + WS_XN); unsigned char* XB = (unsigned char*)(a->ws + WS_XB);
    for (int vb = blockIdx.x; vb < NTB; vb += gridDim.x) {
        moe_tables(WID, a, lds, layer, vb);
#pragma unroll 1
        for (int i = 0; i < 16; ++i) {
            const int t = vb * 128 + wv * 16 + i;
            int dest = 0;
            if (lane < 4) { const int e = ((const int*)(a->ws + WS_TOPE))[(size_t)t * 4 + lane], pos = ((const int*)(a->ws + WS_POSB))[(size_t)t * 4 + lane];
                dest = ts[e] * 256 + base[e] + pos; ((int*)(a->ws + WS_DEST))[(size_t)t * 4 + lane] = dest; }
            const u32x4 r0 = *(const u32x4*)(XN + (size_t)t * 1024 + 8 * lane), r1 = *(const u32x4*)(XN + (size_t)t * 1024 + 512 + 8 * lane);
            u32x2 q0, q1;
            q0.x = pk4_fp8(bflo(r0.x), bfhi(r0.x), bflo(r0.y), bfhi(r0.y)); q0.y = pk4_fp8(bflo(r0.z), bfhi(r0.z), bflo(r0.w), bfhi(r0.w));
            q1.x = pk4_fp8(bflo(r1.x), bfhi(r1.x), bflo(r1.y), bfhi(r1.y)); q1.y = pk4_fp8(bflo(r1.z), bfhi(r1.z), bflo(r1.w), bfhi(r1.w));
#pragma unroll
            for (int k = 0; k < 4; ++k) { const int d = __builtin_amdgcn_readlane(dest, k); unsigned char* o = XB + (size_t)d * 1024; *(u32x2*)(o + 8 * lane) = q0; *(u32x2*)(o + 512 + 8 * lane) = q1; }
        }
        __syncthreads();
    }
}
DI void phase_combine(const int WID, ArgsP a, float* H) {
    const int tid = opaque_tid(WID), lane = tid & 63, wv = tid >> 6;
    const bf16_t* YB = (const bf16_t*)(a->ws + WS_YB); unsigned char* XN8 = (unsigned char*)(a->ws + WS_XN);
    for (int t = blockIdx.x * 8 + wv; t < T; t += gridDim.x * 8) {
        int dest = 0; float gw = 0.f;
        if (lane < 4) { dest = ((const int*)(a->ws + WS_DEST))[(size_t)t * 4 + lane]; gw = ((const float*)(a->ws + WS_GATEW))[(size_t)t * 4 + lane]; }
        f32x4 v[4];
#pragma unroll
        for (int j = 0; j < 4; ++j) v[j] = *(const f32x4*)(H + (size_t)t * 1024 + 4 * lane + 256 * j);
#pragma unroll
        for (int k = 0; k < 4; ++k) { const int d = __builtin_amdgcn_readlane(dest, k); const float g = __builtin_bit_cast(float, __builtin_amdgcn_readlane(__builtin_bit_cast(int, gw), k)); const bf16_t* y = YB + (size_t)d * 1024;
#pragma unroll
            for (int j = 0; j < 4; ++j) { const u32x2 w = *(const u32x2*)(y + 4 * lane + 256 * j); v[j][0] += g * bflo(w.x); v[j][1] += g * bfhi(w.x); v[j][2] += g * bflo(w.y); v[j][3] += g * bfhi(w.y); } }
        float ss = 0.f;
#pragma unroll
        for (int j = 0; j < 4; ++j) { *(f32x4*)(H + (size_t)t * 1024 + 4 * lane + 256 * j) = v[j]; ss += (v[j][0] * v[j][0] + v[j][1] * v[j][1]) + (v[j][2] * v[j][2] + v[j][3] * v[j][3]); }
        ss = wave_sum(ss);
        const float rstd = rsqrtf(ss * (1.0f / 1024.0f) + EPS);
#pragma unroll
        for (int j = 0; j < 4; ++j) v[j] = v[j] * rstd;
#pragma unroll
        for (int j = 0; j < 4; ++j) *(unsigned*)(XN8 + (size_t)t * 1024 + 4 * lane + 256 * j) = pk4_fp8(v[j][0], v[j][1], v[j][2], v[j][3]);
    }
}
DI void phase_cmp2(const int WID, ArgsP a, LAS unsigned char* lds, int ev) {
    const int tid = opaque_tid(WID), lane = tid & 63, wv = __builtin_amdgcn_readfirstlane(tid >> 6);
    const bf16_t* HID = (const bf16_t*)(a->ws + WS_HID); bf16_t* KCMP = (bf16_t*)(a->ws + WS_KCMP); bf16_t* VCMPT = (bf16_t*)(a->ws + WS_VCMPT);
    const float kg = a->in[I_NSKN][ev * 64 + lane];
    LAS float* wl = (LAS float*)lds;
    for (int i = tid; i < 2 * 256 * 64 / 4; i += 512) *(LAS f32x4*)(wl + 4 * i) = *(const f32x4*)(a->in[I_CMPW2] + (size_t)ev * 2 * 256 * 64 + 4 * i);
    __syncthreads();
    for (int gi = blockIdx.x * 8 + wv; gi < 2048; gi += gridDim.x * 8) {
        const int kv = gi >> 10, row0 = (gi & 1023) * 4;
        const bf16_t* hrow = HID + ((size_t)kv * 4096 + row0) * 256;
        const LAS float* w2 = wl + kv * 256 * 64 + lane;
        float s[4] = {0.f, 0.f, 0.f, 0.f};
#pragma unroll 2
        for (int k = 0; k < 256; k += 8) {
            u32x4 hw[4];
#pragma unroll
            for (int r = 0; r < 4; ++r) hw[r] = *(const u32x4*)(hrow + r * 256 + k);
            float wv8[8];
#pragma unroll
            for (int j = 0; j < 8; ++j) wv8[j] = w2[(k + j) * 64];
#pragma unroll
            for (int r = 0; r < 4; ++r)
                s[r] += bflo(hw[r].x) * wv8[0] + bfhi(hw[r].x) * wv8[1] + bflo(hw[r].y) * wv8[2] + bfhi(hw[r].y) * wv8[3] + bflo(hw[r].z) * wv8[4] + bfhi(hw[r].z) * wv8[5] + bflo(hw[r].w) * wv8[6] + bfhi(hw[r].w) * wv8[7];
        }
#pragma unroll
        for (int r = 0; r < 4; ++r) {
            const int row = row0 + r, bg = row >> 7, n = row & 127;
            float v = (n == 127) ? 0.f : s[r];
            if (kv == 0) { const float ss = wave_sum(v * v); const float o = v * rsqrtf(ss * (1.0f / 64.0f) + EPS) * kg;
                KCMP[((size_t)bg * 128 + n) * 64 + lane] = (bf16_t)(pk2(o, 0.f) & 0xffffu); }
            else VCMPT[((size_t)bg * 96 + lane) * 128 + vperm16(n)] = (bf16_t)(pk2(v, 0.f) & 0xffffu);
        }
    }
    for (int i = blockIdx.x * 512 + tid; i < 32 * 32 * 128; i += gridDim.x * 512) {
        const int n = i & 127, j = (i >> 7) & 31, bg = i >> 12;
        float o = 0.f;
        if (n < 127) { const int d = n - 4 * j; if (d >= 0 && d <= 2) o = 1.0f; else if (d == 3 || d == -1) o = 0.5f; }
        VCMPT[((size_t)bg * 96 + 64 + j) * 128 + vperm16(n)] = (bf16_t)(pk2(o, 0.f) & 0xffffu);
    }
}
DI void topk_one(const float* IMPH, unsigned* SELM, int t, int g) {
    const int b = t >> 11, s = t & 2047, cur = s >> 6;
    unsigned mask;
    if (cur < 16) mask = (2u << cur) - 1u;
    else {
        float sc[32];
#pragma unroll
        for (int j4 = 0; j4 < 8; ++j4) { f32x4 acc = {0.f, 0.f, 0.f, 0.f};
#pragma unroll
            for (int r = 0; r < 4; ++r) acc += *(const f32x4*)(IMPH + ((size_t)t * 8 + g * 4 + r) * 32 + 4 * j4);
#pragma unroll
            for (int q = 0; q < 4; ++q) sc[4 * j4 + q] = acc[q]; }
#pragma unroll
        for (int j = 0; j < 32; ++j) { const bool forced = (j == 0) || (j == cur) || (j == cur - 1); sc[j] = (j > cur) ? NEGF : (sc[j] + (forced ? 1e4f : 0.f)); }
        mask = 0u;
#pragma unroll
        for (int j = 0; j < 32; ++j) { int rank = 0;
#pragma unroll
            for (int k = 0; k < 32; ++k) rank += ((sc[k] > sc[j]) || (sc[k] == sc[j] && k < j)) ? 1 : 0;
            mask |= (rank < 16) ? (1u << j) : 0u; }
    }
    SELM[((size_t)(b * 2 + g)) * 2048 + s] = mask;
}
DI void phase_topk(const int WID, ArgsP a) {
    for (int i = blockIdx.x * 512 + opaque_tid(WID); i < T * 2; i += gridDim.x * 512) topk_one((const float*)(a->ws + WS_IMPH), (unsigned*)(a->ws + WS_SELM), i >> 1, i & 1);
}
DI void phase_cmp_topk(const int WID, ArgsP a, LAS unsigned char* lds) {
    const bf16_t* QN = (const bf16_t*)(a->ws + WS_QN);
    float* IMPH = (float*)(a->ws + WS_IMPH);
    for (int u = blockIdx.x; u < 256; u += gridDim.x) {
        const int qb = 7 - (u >> 5), bg = u & 31, b = bg >> 1, g = bg & 1, q0 = qb * 256; const size_t t0 = (size_t)b * 2048 + q0;
#pragma unroll 1
        for (int r = 0; r < 4; ++r) { const int hd = g * 4 + r;
            attn_unit<96, 3>(WID, lds, QN + t0 * 512 + hd * 64, 512, (const bf16_t*)(a->ws + WS_KCMP) + (size_t)bg * 128 * 64, 64,
                             (const bf16_t*)(a->ws + WS_VCMPT) + (size_t)bg * 96 * 128, 128, q0, 0.f, 0, nullptr,
                             (bf16_t*)(a->ws + WS_OC) + t0 * 512 + hd * 64, 512, IMPH + (t0 * 8 + hd) * 32); }
        asm volatile("s_waitcnt vmcnt(0)" ::: "memory");
        __syncthreads();
        { const int tid = opaque_tid(WID); if (tid < 256) topk_one(IMPH, (unsigned*)(a->ws + WS_SELM), (int)t0 + tid, g); }
        __syncthreads();
    }
}
DI void phase_mixprep(const int WID, ArgsP a, int layer) {
    const int tid = opaque_tid(WID), lane = tid & 63, wv = tid >> 6, ev = layer >> 1;
    const float* dl = a->in[I_DALAM] + ev * 256;
    const float s1 = wave_sum(dl[lane] * dl[64 + lane]), s2 = wave_sum(dl[128 + lane] * dl[192 + lane]);
    const float lam_init = 0.8f - 0.6f * expf(-0.3f * (float)layer);
    const float lam = expf(s1) - expf(s2) + lam_init;
    const float* og = a->in[I_DAOUTG] + ev * 128;
    const bf16_t* OD = (const bf16_t*)(a->ws + WS_OD); const bf16_t* OC = (const bf16_t*)(a->ws + WS_OC); const bf16_t* OS = (const bf16_t*)(a->ws + WS_OS); const bf16_t* OW = (const bf16_t*)(a->ws + WS_OW);
    const float* GT = (const float*)(a->ws + WS_GATES); bf16_t* AMIX = (bf16_t*)(a->ws + WS_AMIX);
    const int h = lane >> 4, dv = (lane & 15) * 8;
    f32x4 g0 = *(const f32x4*)(og + dv), g1 = *(const f32x4*)(og + dv + 4);
    for (int t = blockIdx.x * 8 + wv; t < T; t += gridDim.x * 8) {
        { const u32x4 w1 = *(const u32x4*)(OD + (size_t)t * 1024 + h * 128 + dv), w2 = *(const u32x4*)(OD + (size_t)t * 1024 + (4 + h) * 128 + dv);
          f32x4 d0, d1;
          d0[0] = bflo(w1.x) - lam * bflo(w2.x); d0[1] = bfhi(w1.x) - lam * bfhi(w2.x); d0[2] = bflo(w1.y) - lam * bflo(w2.y); d0[3] = bfhi(w1.y) - lam * bfhi(w2.y);
          d1[0] = bflo(w1.z) - lam * bflo(w2.z); d1[1] = bfhi(w1.z) - lam * bfhi(w2.z); d1[2] = bflo(w1.w) - lam * bflo(w2.w); d1[3] = bfhi(w1.w) - lam * bfhi(w2.w);
          float ss = (d0[0] * d0[0] + d0[1] * d0[1]) + (d0[2] * d0[2] + d0[3] * d0[3]) + (d1[0] * d1[0] + d1[1] * d1[1]) + (d1[2] * d1[2] + d1[3] * d1[3]);
          ss += shx(ss, 1); ss += shx(ss, 2); ss += shx(ss, 4); ss += shx(ss, 8);
          const float rs = rsqrtf(ss * (1.0f / 128.0f) + EPS) * (1.0f - lam_init);
          *(u32x4*)(AMIX + (size_t)t * 1024 + h * 128 + dv) = pack8(d0 * rs * g0, d1 * rs * g1); }
        { const int hd = lane >> 3, dq = (lane & 7) * 8; const size_t o = (size_t)t * 512 + hd * 64 + dq;
          const float ga = GT[(size_t)t * 24 + hd * 3], gb = GT[(size_t)t * 24 + hd * 3 + 1], gc = GT[(size_t)t * 24 + hd * 3 + 2];
          const u32x4 c = *(const u32x4*)(OC + o), s = *(const u32x4*)(OS + o), w = *(const u32x4*)(OW + o);
          f32x4 r0, r1;
          r0[0] = ga * bflo(c.x) + gb * bflo(s.x) + gc * bflo(w.x); r0[1] = ga * bfhi(c.x) + gb * bfhi(s.x) + gc * bfhi(w.x);
          r0[2] = ga * bflo(c.y) + gb * bflo(s.y) + gc * bflo(w.y); r0[3] = ga * bfhi(c.y) + gb * bfhi(s.y) + gc * bfhi(w.y);
          r1[0] = ga * bflo(c.z) + gb * bflo(s.z) + gc * bflo(w.z); r1[1] = ga * bfhi(c.z) + gb * bfhi(s.z) + gc * bfhi(w.z);
          r1[2] = ga * bflo(c.w) + gb * bflo(s.w) + gc * bflo(w.w); r1[3] = ga * bfhi(c.w) + gb * bfhi(s.w) + gc * bfhi(w.w);
          *(u32x4*)(AMIX + (size_t)t * 1024 + 512 + hd * 64 + dq) = pack8(r0, r1); }
    }
}
DI void phase_scan(const int WID, ArgsP a) {
    const bf16_t* UT = (const bf16_t*)(a->ws + WS_UT); bf16_t* VS = (bf16_t*)(a->ws + WS_VS);
    for (int i = blockIdx.x * 512 + opaque_tid(WID); i < 64 * 512 * 32; i += gridDim.x * 512) {
        const int d8 = i & 31, f = (i >> 5) & 511, bh = i >> 14, h = bh & 3;
        const float dec = exp2f(256.0f * ret_lg2(h));
        f32x4 S0 = {0.f, 0.f, 0.f, 0.f}, S1 = S0;
        u32x4 un = *(const u32x4*)(UT + ((size_t)bh * 8) * 131072 + (size_t)f * 256 + 8 * d8);
#pragma unroll 1
        for (int n = 0; n < 8; ++n) {
            const size_t z = (size_t)bh * 8 + n;
            const u32x4 u = un;
            if (n < 7) un = *(const u32x4*)(UT + (z + 1) * 131072 + (size_t)f * 256 + 8 * d8);
            *(u32x4*)(VS + (z * 512 + f) * 512 + 256 + 8 * d8) = pack8(S0, S1);
            S0[0] = (S0[0] + bflo(u.x)) * dec; S0[1] = (S0[1] + bfhi(u.x)) * dec; S0[2] = (S0[2] + bflo(u.y)) * dec; S0[3] = (S0[3] + bfhi(u.y)) * dec;
            S1[0] = (S1[0] + bflo(u.z)) * dec; S1[1] = (S1[1] + bfhi(u.z)) * dec; S1[2] = (S1[2] + bflo(u.w)) * dec; S1[3] = (S1[3] + bfhi(u.w)) * dec;
        }
    }
}
DI void phase_normgate(const int WID, ArgsP a, int od) {
    const int tid = opaque_tid(WID), lane = tid & 63, wv = tid >> 6;
    const bf16_t* Y = (const bf16_t*)(a->ws + WS_Y); const bf16_t* GG = (const bf16_t*)(a->ws + WS_GG); bf16_t* YG = (bf16_t*)(a->ws + WS_YG);
    const float* og = a->in[I_RETG] + od * 512;
    const f32x4 g0 = *(const f32x4*)(og + 8 * lane), g1 = *(const f32x4*)(og + 8 * lane + 4);
    for (int t = blockIdx.x * 8 + wv; t < T; t += gridDim.x * 8) {
#pragma unroll
        for (int h = 0; h < 4; ++h) {
            const size_t o = (size_t)t * 2048 + h * 512 + 8 * lane;
            const u32x4 yw = *(const u32x4*)(Y + o), gw = *(const u32x4*)(GG + o);
            f32x4 y0 = {bflo(yw.x), bfhi(yw.x), bflo(yw.y), bfhi(yw.y)}, y1 = {bflo(yw.z), bfhi(yw.z), bflo(yw.w), bfhi(yw.w)};
            const f32x4 q0 = {bflo(gw.x), bfhi(gw.x), bflo(gw.y), bfhi(gw.y)}, q1 = {bflo(gw.z), bfhi(gw.z), bflo(gw.w), bfhi(gw.w)};
            float ss = (y0[0] * y0[0] + y0[1] * y0[1]) + (y0[2] * y0[2] + y0[3] * y0[3]) + (y1[0] * y1[0] + y1[1] * y1[1]) + (y1[2] * y1[2] + y1[3] * y1[3]);
            ss = wave_sum(ss);
            const float rs = rsqrtf(ss * (1.0f / 512.0f) + EPS);
            *(u32x4*)(YG + o) = pack8(y0 * rs * g0 * q0, y1 * rs * g1 * q1);
        }
    }
}
DI int snake_unit(int rnd, int G, int c) { return (rnd & 1) ? rnd * G + (G - 1 - c) : rnd * G + c; }
DI float absmax64(const float* g, int lane) { float m = fabsf(g[lane]);
#pragma unroll
    for (int o = 1; o < 64; o <<= 1) m = fmaxf(m, shx(m, o));
    return m; }
constexpr int CW_AQ = 8192;
template <int MODE>
DI void phase_attn(const int WID, ArgsP a, LAS unsigned char* lds, int ev) {
    const int tid = opaque_tid(WID), lane = tid & 63;
    const bf16_t* QD = (const bf16_t*)(a->ws + WS_QD); const bf16_t* KD = (const bf16_t*)(a->ws + WS_KD); const bf16_t* QN = (const bf16_t*)(a->ws + WS_QN);
    LAS int* ord = (LAS int*)(lds + MISC_OFF + MO_ENT); LAS int* cst = (LAS int*)(lds + MISC_OFF + MO_GAT); volatile LAS int* cur = (volatile LAS int*)(lds + MISC_OFF + MO_TOT);
    float sb2 = 0.f;
    if (MODE != 3) { const float gq = absmax64(a->in[MODE == 0 ? I_DAQN : I_NSQN] + ev * 64, lane), gk = absmax64(a->in[MODE == 0 ? I_DAKN : I_NSKN] + ev * 64, lane);
        sb2 = 16.0f * gq * gk + 28.0f; }
    if (tid < 64) { const int qb = tid >> 3, hd = tid & 7, q0 = qb * 256; int lo = 0, hi = 4 * qb + 4;
        if (MODE == 3) { lo = 0; hi = 2; }
        else { const float slope = (MODE == 0) ? exp2f(-2.0f * (float)((hd & 3) + 1)) : exp2f(-(float)(hd + 1)); const int dcut = (int)fminf(sb2 / slope + 1.0f, 100000.0f);
            const int kmin = q0 - dcut; lo = kmin > 0 ? (kmin >> 6) : 0;
            if (MODE == 2) { const int lk = q0 - 511; const int lw = lk > 0 ? (lk >> 6) : 0; lo = lw > lo ? lw : lo; } }
        cst[tid] = hi - lo; }
    __syncthreads();
    if (tid < 64) { const int mine = cst[tid]; int rank = 0;
        for (int j = 0; j < 64; ++j) { const int o = cst[j]; rank += (o > mine || (o == mine && j < tid)) ? 1 : 0; }
        ord[rank] = tid; }
    __syncthreads();
    unsigned* ctr = (unsigned*)(a->ws + WS_CTL) + CW_AQ + 64 * 8 * (ev * 4 + MODE);
    const int x0 = (int)(xb_xcc_id() & 7u);
    volatile LAS int* stl = (volatile LAS int*)(lds + MISC_OFF + MO_BASE);
    bool own = true; int nst = 0;
    for (;;) {
        if (tid < 64) {
            int uu_ = -1;
            if (own) { int v = 128; if (lane == 0) v = (int)__hip_atomic_fetch_add(ctr + 64 * x0, 1u, __ATOMIC_RELAXED, __HIP_MEMORY_SCOPE_AGENT);
                v = __builtin_amdgcn_readfirstlane(v); if (v < 128) uu_ = x0 * 128 + v; else own = false; }
            if (!own && uu_ < 0) {
                if (nst == 0) { int v = 128; const int xq_ = (x0 + lane) & 7;
                    if (lane >= 1 && lane < 8) v = (int)__hip_atomic_fetch_add(ctr + 64 * xq_, 1u, __ATOMIC_RELAXED, __HIP_MEMORY_SCOPE_AGENT);
                    const unsigned long long got = __ballot(v < 128); nst = __popcll(got);
                    if (v < 128) stl[__popcll(got & ((1ull << lane) - 1ull))] = xq_ * 128 + v;
                    asm volatile("s_waitcnt lgkmcnt(0)" ::: "memory"); }
                if (nst > 0) { --nst; uu_ = stl[nst]; }
            }
            if (lane == 0) *cur = uu_;
        }
        __syncthreads();
        const int uu = *cur; if (uu < 0) break;
        const int xq = uu >> 7, v = uu & 127, combo = ord[v >> 1], jb = v & 1, qb = combo >> 3, hd = combo & 7, q0 = qb * 256;
        const int b = (MODE == 0) ? (((xq - 2 * (hd & 3)) & 7) + 8 * jb) : (((xq - 4 * (hd >> 2)) & 7) + 8 * jb);
        const size_t t0 = (size_t)b * 2048 + q0;
        if (MODE == 0) {
            const float slope = exp2f(-2.0f * (float)((hd & 3) + 1)); const int dcut = (int)fminf(sb2 / slope + 1.0f, 100000.0f);
            attn_unit<128, 0>(WID, lds, QD + t0 * 512 + hd * 64, 512, KD + (size_t)b * 2048 * 512 + hd * 64, 512,
                              (const bf16_t*)(a->ws + WS_VAT) + (size_t)(b * 4 + (hd & 3)) * 128 * 2048, 2048, q0, slope, dcut, nullptr,
                              (bf16_t*)(a->ws + WS_OD) + t0 * 1024 + hd * 128, 1024, nullptr);
        } else if (MODE == 1 || MODE == 2) {
            const int g = hd >> 2; const float slope = exp2f(-(float)(hd + 1)); const int dcut = (int)fminf(sb2 / slope + 1.0f, 100000.0f);
            const bf16_t* Kb = (const bf16_t*)(a->ws + (MODE == 1 ? WS_KSB : WS_KWB)) + (size_t)(b * 2 + g) * 2048 * 64;
            const bf16_t* Vb = (const bf16_t*)(a->ws + (MODE == 1 ? WS_VST : WS_VWT)) + (size_t)(b * 2 + g) * 64 * 2048;
            attn_unit<64, MODE>(WID, lds, QN + t0 * 512 + hd * 64, 512, Kb, 64, Vb, 2048, q0, slope, dcut,
                                (const unsigned*)(a->ws + WS_SELM) + (size_t)(b * 2 + g) * 2048 + q0,
                                (bf16_t*)(a->ws + (MODE == 1 ? WS_OS : WS_OW)) + t0 * 512 + hd * 64, 512, nullptr);
        } else {
            const int g = hd >> 2;
            attn_unit<96, 3>(WID, lds, QN + t0 * 512 + hd * 64, 512, (const bf16_t*)(a->ws + WS_KCMP) + (size_t)(b * 2 + g) * 128 * 64, 64,
                             (const bf16_t*)(a->ws + WS_VCMPT) + (size_t)(b * 2 + g) * 96 * 128, 128, q0, 0.f, 0, nullptr,
                             (bf16_t*)(a->ws + WS_OC) + t0 * 512 + hd * 64, 512, (float*)(a->ws + WS_IMPH) + (t0 * 8 + hd) * 32);
        }
    }
}

constexpr int PPL = 15;
constexpr int NPHASE = 1 + DEPTH * PPL;
__global__ void __launch_bounds__(512, 2) mk_fwd(Args a_unused) {
    ArgsP a = opaque_args();
    extern __shared__ __attribute__((aligned(16))) unsigned char lds_raw[];
    LAS unsigned char* lds = (LAS unsigned char*)lds_raw;
    const int tid = threadIdx.x, G = gridDim.x, c = blockIdx.x;
    const int WID = __builtin_amdgcn_readfirstlane(tid >> 6);
    volatile LAS unsigned* misc = (volatile LAS unsigned*)(lds + MISC_OFF);
    if (tid < 4) misc[tid] = 0u;
    __syncthreads();
    unsigned* ctl = (unsigned*)(a->ws + WS_CTL);
    XcdBarrier bar; bar.bar = ctl + CW_BAR; bar.x = 0; bar.st = misc;
    const int ph_lo = a->ph_lo, ph_hi = a->ph_hi;
    const bool multi = (ph_hi - ph_lo) > 1;
    if (multi) bar = xcd_barrier_post(WID, ctl + CW_BAR, misc);
    bool first = true;
#define PHASE_BEGIN(k, id) if ((DBG_ONLY < 0 || DBG_ONLY == (id)) && (k) >= ph_lo && (k) < ph_hi && (k) <= DBG_LAST_PHASE) { if (!first) { xcd_barrier(WID, bar); if (PROBE_MASK >> 31) xcd_barrier(WID, bar); } first = false; \
        ArgsP a = opaque_args(); unsigned char* ws = a->ws; bf16_t* XN = (bf16_t*)(ws + WS_XN); float* H = a->out; const float* Hin = (layer == 0) ? a->in[I_X] : (const float*)H; \
        const LAS int* ts = (const LAS int*)(lds + MISC_OFF + MO_TS); (void)XN; (void)H; (void)Hin; (void)ts; \
        const bool probe_ = ((PROBE_MASK >> (id)) & 1u) != 0u; const unsigned long long pt0_ = probe_ ? __builtin_amdgcn_s_memrealtime() : 0ull;
#define PHASE_END if (probe_) { const unsigned long long pt1_ = __builtin_amdgcn_s_memrealtime(), pd_ = pt1_ - pt0_; while (__builtin_amdgcn_s_memrealtime() - pt1_ < pd_) __builtin_amdgcn_s_sleep(8); } }
    { const int layer = 0; PHASE_BEGIN(0, 0) phase_prologue(WID, a, lds); PHASE_END }
#pragma unroll 1
    for (int layer = 0; layer < DEPTH; ++layer) {
        const int pb = 1 + layer * PPL; const bool even = (layer & 1) == 0; const int ev = layer >> 1, od = layer >> 1;
        if (even) {
            PHASE_BEGIN(pb + 0, 1) phase_norm<0>(WID, a, lds, layer, Hin); PHASE_END
            PHASE_BEGIN(pb + 1, 2) {
                { ProbPlain P{XN, (const bf16_t*)(ws + WS_EVNAT) + (size_t)ev * 2048 * 1024, 1024, 1024, 1024}; pg8::Sched S; S.init(T / 256, 8, G, c);
                  EpiEvNat E{ws, (const float*)(ws + WS_GAINS) + ev * 256};
                  pg8::gemm_phase(WID, lds, P, S, E); }
                { ProbPlain P{(const bf16_t*)(ws + WS_EVSW) + (size_t)ev * 768 * 1024, XN, 1024, 1024, 1024}; pg8::Sched S; S.init(3, T / 256, G, c);
                  EpiEvSw E{ws};
                  pg8::gemm_phase(WID, lds, P, S, E); }
            } PHASE_END
            PHASE_BEGIN(pb + 2, 3) {
                { ProbCmp1 P{(const bf16_t*)(ws + WS_KCB), (const bf16_t*)(ws + WS_VCB), (const bf16_t*)(ws + WS_CMP1) + (size_t)ev * 2 * 256 * 2048, 1024, 2048, 2048}; pg8::Sched S; S.init(32, 1, G, c);
                  EpiCmp1 E{(bf16_t*)(ws + WS_HID), (const float*)(ws + WS_BIAS1) + ev * 512};
                  pg8::gemm_phase(WID, lds, P, S, E); }
                phase_attn<0>(WID, a, lds, ev);
                phase_attn<2>(WID, a, lds, ev);
            } PHASE_END
            PHASE_BEGIN(pb + 3, 4) phase_cmp2(WID, a, lds, ev); PHASE_END
            PHASE_BEGIN(pb + 4, 5) phase_attn<3>(WID, a, lds, ev); PHASE_END
            PHASE_BEGIN(pb + 5, 6) phase_topk(WID, a); PHASE_END
            PHASE_BEGIN(pb + 6, 7) phase_attn<1>(WID, a, lds, ev); PHASE_END
            PHASE_BEGIN(pb + 7, 8) phase_mixprep(WID, a, layer); PHASE_END
            PHASE_BEGIN(pb + 8, 9) {
                ProbPlain P{(const bf16_t*)(ws + WS_AMIX), (const bf16_t*)(ws + WS_EVOUT) + (size_t)ev * 1024 * 1024, 1024, 1024, 1024}; pg8::Sched S; S.init(T / 256, 4, G, c);
                EpiResid E{Hin, H}; pg8::gemm_phase(WID, lds, P, S, E);
            } PHASE_END
        } else {
            PHASE_BEGIN(pb + 0, 11) phase_norm<1>(WID, a, lds, layer, Hin); PHASE_END
            PHASE_BEGIN(pb + 1, 12) {
                { ProbPlain P{XN, (const bf16_t*)(ws + WS_ODNAT) + (size_t)od * 4096 * 1024, 1024, 1024, 1024}; pg8::Sched S; S.init(T / 256, 16, G, c);
                  EpiOdNat E{ws}; pg8::gemm_phase(WID, lds, P, S, E); }
                { ProbPlain P{(const bf16_t*)(ws + WS_ODSW) + (size_t)od * 2048 * 1024, XN, 1024, 1024, 1024}; pg8::Sched S; S.init(8, T / 256, G, c);
                  EpiOdSw E{ws}; pg8::gemm_phase(WID, lds, P, S, E); }
            } PHASE_END
            PHASE_BEGIN(pb + 2, 13) {
                { ProbUT P{(const bf16_t*)(ws + WS_VS), (const bf16_t*)(ws + WS_KT), 512, 256, 256}; SchedSeq S; S.init(G, c);
                  EpiUTScan E{(bf16_t*)(ws + WS_VS)}; pg8::gemm_phase(WID, lds, P, S, E); }
                { ProbAtt P{(const bf16_t*)(ws + WS_AQ), (const bf16_t*)(ws + WS_KP), 2048, 1024, 256}; pg8::Sched S; const int nb = G / 2 > 0 ? G / 2 : 1;
                  if (c >= nb || G < 2) S.init(512, 1, G < 2 ? 1 : G - nb, G < 2 ? 0 : c - nb); else S.init(0, 1, 1, 0);
                  EpiAtt E{(bf16_t*)(ws + WS_AQ)}; pg8::gemm_phase(WID, lds, P, S, E); }
            } PHASE_END
            PHASE_BEGIN(pb + 4, 15) {
                ProbY P{(const bf16_t*)(ws + WS_AQ), (const bf16_t*)(ws + WS_VS), 2048, 512, 512}; pg8::Sched S; S.init(512, 2, G, c);
                EpiY E{(bf16_t*)(ws + WS_Y)}; pg8::gemm_phase(WID, lds, P, S, E);
            } PHASE_END
            PHASE_BEGIN(pb + 5, 16) phase_normgate(WID, a, od); PHASE_END
            PHASE_BEGIN(pb + 8, 19) {
                ProbPlain P{(const bf16_t*)(ws + WS_YG), (const bf16_t*)(ws + WS_ODOUT) + (size_t)od * 1024 * 2048, 2048, 2048, 2048}; pg8::Sched S; S.init(T / 256, 4, G, c);
                EpiResid E{Hin, H}; pg8::gemm_phase(WID, lds, P, S, E);
            } PHASE_END
        }
        PHASE_BEGIN(pb + 9, 20) phase_norm<2>(WID, a, lds, layer, H); PHASE_END
        PHASE_BEGIN(pb + 10, 21) phase_moe_slots(WID, a, lds, layer); PHASE_END
        PHASE_BEGIN(pb + 11, 22) {
            moe_tables(WID, a, lds, layer, -1);
            { ProbMoe8 P{(const unsigned char*)(ws + WS_XB), (const unsigned char*)(ws + WS_WGU) + (size_t)layer * 32 * 2048 * 1024, ts, 2048, 512, 512, 512}; pg8::Sched S; S.init(ts[32], 8, G, c);
              EpiGU E{(unsigned char*)(ws + WS_ACT), a->in[I_BGU] + (size_t)layer * 32 * 2048, ts}; pg8::gemm_phase(WID, lds, P, S, E); }
            { ProbPlain P{(const bf16_t*)(ws + WS_PBF) + (size_t)layer * T * 256, (const bf16_t*)(ws + WS_WPP) + (size_t)layer * 1024 * 256, 256, 256, 256}; pg8::Sched S; S.init(T / 256, 4, G, c);
              EpiPP E{(bf16_t*)(ws + WS_PP)}; pg8::gemm_phase(WID, lds, P, S, E); }
        } PHASE_END
        PHASE_BEGIN(pb + 12, 23) {
            moe_tables(WID, a, lds, layer, -1);
            ProbMoe8 P{(const unsigned char*)(ws + WS_ACT), (const unsigned char*)(ws + WS_WDN) + (size_t)layer * 32 * 1024 * 1024, ts, 1024, 512, 512, 512}; pg8::Sched S; S.init(ts[32], 4, G, c);
            EpiDN E{(bf16_t*)(ws + WS_YB), a->in[I_BDN] + (size_t)layer * 32 * 1024, ts}; pg8::gemm_phase(WID, lds, P, S, E);
        } PHASE_END
        PHASE_BEGIN(pb + 13, 24) phase_combine(WID, a, H); PHASE_END
        PHASE_BEGIN(pb + 14, 25) {
            ProbPlain8 P{(const unsigned char*)(ws + WS_XN), (const unsigned char*)(ws + WS_WPG) + (size_t)layer * 1024 * 1024, 512, 512, 512}; pg8::Sched S; S.init(T / 256, 4, G, c);
            EpiPLE E{H, (const bf16_t*)(ws + WS_PP)}; pg8::gemm_phase(WID, lds, P, S, E);
        } PHASE_END
    }
#undef PHASE_BEGIN
#undef PHASE_END
}

extern "C" void kernel_launch(void* const* d_in, const int* in_sizes, int n_in, void* d_out, int out_size, void* d_ws, size_t ws_size, hipStream_t stream) {
    static int grid = 0;
    if (grid == 0) {
        if (n_in != 26 || out_size != T * D || ws_size < WS_END) { fprintf(stderr, "kernel_launch: unexpected problem (n_in %d, out %d, ws %zu < %zu); nothing launched\n", n_in, out_size, ws_size, (size_t)WS_END); grid = -1; return; }
        int dev = 0, cus = 0, per_cu = 0;
        if (hipGetDevice(&dev) != hipSuccess || hipDeviceGetAttribute(&cus, hipDeviceAttributeMultiprocessorCount, dev) != hipSuccess) { grid = -1; return; }
        if (hipFuncSetAttribute((const void*)mk_fwd, hipFuncAttributeMaxDynamicSharedMemorySize, LDS_BYTES) != hipSuccess) { fprintf(stderr, "kernel_launch: hipFuncSetAttribute failed\n"); grid = -1; return; }
        if (hipOccupancyMaxActiveBlocksPerMultiprocessor(&per_cu, (const void*)mk_fwd, 512, LDS_BYTES) != hipSuccess || per_cu < 1) fprintf(stderr, "kernel_launch: occupancy query reports %d\n", per_cu);
        (void)hipGetLastError();
        grid = cus > 256 ? 256 : cus;
    }
    if (grid < 0) return;
    (void)hipMemsetAsync((char*)d_ws + WS_CTL, 0, CTL_BYTES, stream);
    Args a; memset(&a, 0, sizeof(a));
    for (int i = 0; i < 26; ++i) a.in[i] = (const float*)d_in[i];
    a.out = (float*)d_out; a.ws = (unsigned char*)d_ws;
#if MK_SINGLE
    a.ph_lo = 0; a.ph_hi = NPHASE;
    hipLaunchKernelGGL(mk_fwd, dim3(grid), dim3(512), LDS_BYTES, stream, a);
#else
    for (int ph = 0; ph < NPHASE && ph <= DBG_LAST_PHASE; ++ph) {
        const int l = (ph - 1) / PPL, k = (ph - 1) % PPL;
        if (ph > 0 && (l & 1) && (k == 6 || k == 7)) continue;
        a.ph_lo = ph; a.ph_hi = ph + 1;
        hipLaunchKernelGGL(mk_fwd, dim3(grid), dim3(512), LDS_BYTES, stream, a);
    }
#endif
}
```

```cpp
#include <hip/hip_runtime.h>
#include <cstdio>
#include <cstdint>
#include <cstring>

#define LAS __attribute__((address_space(3)))
#define DI __device__ __forceinline__
typedef unsigned short bf16_t;
typedef short bf16x8 __attribute__((ext_vector_type(8)));
typedef short s16x4 __attribute__((ext_vector_type(4)));
typedef float f32x2 __attribute__((ext_vector_type(2)));
typedef float f32x4 __attribute__((ext_vector_type(4)));
typedef float f32x16 __attribute__((ext_vector_type(16)));
typedef unsigned u32x2 __attribute__((ext_vector_type(2)));
typedef unsigned u32x4 __attribute__((ext_vector_type(4)));
typedef __bf16 bfv2 __attribute__((ext_vector_type(2)));
typedef int i32x4 __attribute__((ext_vector_type(4)));
typedef int i32x8 __attribute__((ext_vector_type(8)));

#ifndef MK_SINGLE
#define MK_SINGLE 1
#endif
#ifndef DBG_ONLY
#define DBG_ONLY -1
#endif
#ifndef PROBE_MASK
#define PROBE_MASK 0u
#endif
#ifndef PROBE_ATT
#define PROBE_ATT 0
#endif
#ifndef PROBE_EPI2
#define PROBE_EPI2 0
#endif
#ifndef PROBE_PRO
#define PROBE_PRO 0
#endif
#ifndef PROBE_KREP
#define PROBE_KREP 1
#endif
#ifndef DBG_LAST_PHASE
#define DBG_LAST_PHASE 100000
#endif

constexpr int T = 32768, D = 1024, SEQ = 2048, NBATCH = 16, DEPTH = 4;
constexpr int EVIN = 2840, ODIN = 6144;
constexpr float EPS = 1e-6f, NEGF = -1e30f;
constexpr int NTB = 256;
constexpr int MOE_ROWS = (512 + 32) * 256;

constexpr size_t MiB = 1u << 20;
constexpr size_t WS_CTL = 0, CTL_BYTES = 1 * MiB;
constexpr int CW_BAR = 4096;
constexpr size_t WS_EVNAT = 2 * MiB, WS_EVSW = 10 * MiB, WS_EVOUT = 13 * MiB, WS_CMP1 = 17 * MiB, WS_ODNAT = 21 * MiB, WS_ODSW = 37 * MiB,
                 WS_ODOUT = 49 * MiB, WS_WPP = 57 * MiB, WS_WPG = 59 * MiB, WS_BIAS1 = 67 * MiB, WS_GAINS = 67 * MiB + 16384, WS_BCNT = 67 * MiB + 65536,
                 WS_WGU = 68 * MiB, WS_WDN = 580 * MiB;
constexpr size_t WS_XN = 840 * MiB, WS_PBF = 904 * MiB, WS_PP = 968 * MiB, WS_GATES = 1032 * MiB, WS_TOPE = 1035 * MiB, WS_POSB = 1036 * MiB,
                 WS_DEST = 1037 * MiB, WS_GATEW = 1038 * MiB, WS_SELM = 1039 * MiB;
constexpr size_t RA = 1040 * MiB;
constexpr size_t WS_QD = RA, WS_KD = RA + 32 * MiB, WS_QN = RA + 64 * MiB, WS_KCB = RA + 96 * MiB, WS_VCB = RA + 105 * MiB, WS_KSB = RA + 114 * MiB,
                 WS_KWB = RA + 122 * MiB, WS_VAT = RA + 130 * MiB, WS_VST = RA + 162 * MiB, WS_VWT = RA + 170 * MiB, WS_HID = RA + 178 * MiB,
                 WS_KCMP = RA + 182 * MiB, WS_VCMPT = RA + 183 * MiB, WS_OC = RA + 184 * MiB, WS_IMPH = RA + 216 * MiB, WS_OD = RA + 248 * MiB,
                 WS_OS = RA + 312 * MiB, WS_OW = RA + 344 * MiB, WS_AMIX = RA + 376 * MiB;
constexpr size_t WS_AQ = RA, WS_KP = RA + 128 * MiB, WS_KT = RA + 192 * MiB, WS_VS = RA + 256 * MiB, WS_GG = RA + 512 * MiB, WS_UT = RA + 640 * MiB,
                 WS_Y = RA + 896 * MiB, WS_YG = RA + 1024 * MiB;
constexpr size_t WS_XB = 2192 * MiB, WS_ACT = 2464 * MiB, WS_YB = 2736 * MiB, WS_HB = 3008 * MiB, WS_END = 3072 * MiB;

constexpr int MISC_OFF = 139264, LDS_BYTES = 155648;
static_assert(MISC_OFF + 5888 + 4096 <= LDS_BYTES, "misc LDS words");
constexpr int MO_WCNT = 256, MO_ENT = 1280, MO_GAT = 3328, MO_TOT = 5376, MO_BASE = 5504, MO_TS = 5632, MO_RED = 5888;

DI int opaque_tid(int wid0) { int l; asm volatile("v_mbcnt_lo_u32_b32 %0, -1, 0\n\tv_mbcnt_hi_u32_b32 %0, -1, %0" : "=v"(l) :: "memory"); return (wid0 << 6) | l; }
DI int lane_now() { int l; asm volatile("v_mbcnt_lo_u32_b32 %0, -1, 0\n\tv_mbcnt_hi_u32_b32 %0, -1, %0" : "=v"(l)); return l; }
DI float shx(float v, int m) { return __builtin_bit_cast(float, __builtin_amdgcn_ds_bpermute((lane_now() ^ m) << 2, __builtin_bit_cast(int, v))); }
DI unsigned shxu(unsigned v, int m) { return (unsigned)__builtin_amdgcn_ds_bpermute((lane_now() ^ m) << 2, (int)v); }
DI unsigned pk2(float lo, float hi) { f32x2 v = {lo, hi}; return __builtin_bit_cast(unsigned, __builtin_convertvector(v, bfv2)); }
DI unsigned pk4_fp8(float a, float b, float c, float d) { int w = 0; w = __builtin_amdgcn_cvt_pk_fp8_f32(a, b, w, false); w = __builtin_amdgcn_cvt_pk_fp8_f32(c, d, w, true); return (unsigned)w; }
DI float bf2f(unsigned short b) { return __uint_as_float(((unsigned)b) << 16); }
DI float bflo(unsigned w) { return __uint_as_float(w << 16); }
DI float bfhi(unsigned w) { return __uint_as_float(w & 0xffff0000u); }
DI float wave_sum(float v) {
#pragma unroll
    for (int o = 1; o < 64; o <<= 1) v += shx(v, o);
    return v;
}
DI float sigm(float x) { return __builtin_amdgcn_rcpf(1.0f + __builtin_amdgcn_exp2f(-1.44269504089f * x)); }
DI u32x4 pack8(const f32x4& a, const f32x4& b) { u32x4 w; w.x = pk2(a[0], a[1]); w.y = pk2(a[2], a[3]); w.z = pk2(b[0], b[1]); w.w = pk2(b[2], b[3]); return w; }
DI f32x4 ld_h4(const void* base, bool hb, size_t i) {
    if (hb) { const u32x2 w = *(const u32x2*)((const bf16_t*)base + i); return (f32x4){bflo(w.x), bfhi(w.x), bflo(w.y), bfhi(w.y)}; }
    return *(const f32x4*)((const float*)base + i);
}

#define XB_TMO      128
#define XB_XCNT(j)  (256  + 64 * (j))
#define XB_XSUB(j)  (1280 + 64 * (j))
#define XB_XGEN(j)  (2304 + 64 * (j))
#define XB_TOP      3328
#define XB_TOPGEN   3392
#define XCD_BAR_WORDS 3456
#define XB_SPIN_CAP (1u << 22)
DI unsigned xb_ld(unsigned* p)              { return __hip_atomic_load(p, __ATOMIC_RELAXED, __HIP_MEMORY_SCOPE_AGENT); }
DI unsigned xb_add(unsigned* p, unsigned v) { return __hip_atomic_fetch_add(p, v, __ATOMIC_RELAXED, __HIP_MEMORY_SCOPE_AGENT); }
DI unsigned xb_xcc_id() { return (unsigned)__builtin_amdgcn_s_getreg((3 << 11) | 20) & 0xFu; }
#define XB_SPIN(cond, bar) do { unsigned _sp = 0; while (cond) { __builtin_amdgcn_s_sleep(1); \
    if ((++_sp & 255u) == 0u) { if (xb_ld(&(bar)[XB_TMO])) break; if (_sp > XB_SPIN_CAP) { atomicAdd(&(bar)[XB_TMO], 1u); break; } } } } while (0)
struct XcdBarrier { unsigned* bar; unsigned x; volatile LAS unsigned* st; };
DI XcdBarrier xcd_barrier_post(const int WID, unsigned* bar, volatile LAS unsigned* st) {
    XcdBarrier b; b.bar = bar; b.x = xb_xcc_id(); b.st = st;
    if (opaque_tid(WID) == 0) (void)xb_add(&bar[XB_XCNT(b.x)], 1u);
    return b;
}
DI void xcd_barrier_complete(unsigned* bar, unsigned x, unsigned& nloc, unsigned& nx) {
    const unsigned G = gridDim.x * gridDim.y * gridDim.z;
    unsigned sum, cnt, mine, sp = 0u;
    for (;;) {
        sum = 0u; cnt = 0u; mine = 0u;
#pragma unroll
        for (unsigned j = 0; j < 16; ++j) { const unsigned c = xb_ld(&bar[XB_XCNT(j)]); sum += c; cnt += (c > 0u) ? 1u : 0u; mine = (j == x) ? c : mine; }
        if (sum == G) break;
        __builtin_amdgcn_s_sleep(1);
        if ((++sp & 255u) == 0u) { if (xb_ld(&bar[XB_TMO])) break; if (sp > XB_SPIN_CAP) { atomicAdd(&bar[XB_TMO], 1u); break; } }
    }
    nloc = mine > 0u ? mine : 1u; nx = cnt > 0u ? cnt : 1u;
}
DI void xcd_barrier(const int WID, const XcdBarrier& b) {
    asm volatile("s_waitcnt vmcnt(0)" ::: "memory");
    __syncthreads();
    if (opaque_tid(WID) == 0) {
        unsigned* bar = b.bar; asm volatile("" : "+s"(bar));
        __builtin_amdgcn_s_waitcnt(0);
        unsigned nloc = b.st[0], nx = b.st[1];
        if (nloc == 0u) { xcd_barrier_complete(bar, b.x, nloc, nx); b.st[0] = nloc; b.st[1] = nx; }
        const unsigned old = xb_add(&bar[XB_XSUB(b.x)], 1u);
        const unsigned gen = old / nloc;
        if (old + 1u == (gen + 1u) * nloc) {
            __builtin_amdgcn_fence(__ATOMIC_RELEASE, "agent");
            asm volatile("s_waitcnt vmcnt(0)" ::: "memory");
            const unsigned og = xb_add(&bar[XB_TOP], 1u);
            const unsigned tg = og / nx;
            if (og + 1u == (tg + 1u) * nx) xb_add(&bar[XB_TOPGEN], 1u);
            else XB_SPIN(xb_ld(&bar[XB_TOPGEN]) == tg, bar);
            __builtin_amdgcn_fence(__ATOMIC_ACQUIRE, "agent");
            xb_add(&bar[XB_XGEN(b.x)], 1u);
            asm volatile("s_waitcnt vmcnt(0)" ::: "memory");
        } else {
            XB_SPIN(xb_ld(&bar[XB_XGEN(b.x)]) == gen, bar);
            __builtin_amdgcn_fence(__ATOMIC_ACQUIRE, "agent");
            asm volatile("s_waitcnt vmcnt(0)" ::: "memory");
        }
    }
    __syncthreads();
}

namespace pg8 {
constexpr int BM = 256, BK = 64, HALF = 128, HTB = HALF * BK * 2, STAGE_BYTES = 8 * HTB, NXCD = 8, WGM = 8;
DI int lds_byte(int r, int c) { const int st = (r >> 4) * 2 + (c >> 5), rr = r & 15, cc = c & 31, ob = rr * 64 + cc * 2; return st * 1024 + (ob ^ (((ob >> 9) & 1) << 5)); }
DI void stage_rc(int b, int& R, int& C) { const int st = b / 1024, sb = b % 1024, swz = sb ^ (((sb >> 9) & 1) << 5); R = (st >> 1) * 16 + swz / 64; C = (st & 1) * 32 + (swz % 64) / 2; }
DI int perm32(int rho) { const int n = rho >> 4, i = rho & 15; return 8 * (i >> 2) + 4 * n + (i & 3); }
struct Unit { int pm, pn; };
struct Sched {
    int nM, nN, nwg, G, c;
    DI void init(int nM_, int nN_, int G_, int c_) { nM = nM_; nN = nN_; nwg = nM * nN; G = G_; c = c_; }
    DI bool next(int i, Unit& u) const {
        const long L = (long)i * G + c; if (L >= nwg) return false;
        int wgid = (int)L; { const int q = nwg / NXCD, r = nwg % NXCD, xcd = wgid % NXCD, off = wgid / NXCD; wgid = (xcd < r ? xcd * (q + 1) : r * (q + 1) + (xcd - r) * q) + off; }
        const int nig = WGM * nN, gid = wgid / nig, fm = gid * WGM, gsz = (nM - fm) < WGM ? (nM - fm) : WGM;
        u.pm = fm + ((wgid % nig) % gsz); u.pn = (wgid % nig) / gsz; return true;
    }
};
template <class Epi, class Prob, class SchedT>
DI void gemm_phase(const int WID, LAS unsigned char* lds, const Prob& P, const SchedT& S, const Epi& E) {
    const int tid = opaque_tid(WID), wid = __builtin_amdgcn_readfirstlane(tid >> 6), lane = tid & 63, wr = wid >> 2, wc = wid & 3, fr = lane & 15, fq = lane >> 4;
    const int K = P.K, nt = K / BK;
    constexpr int KREP = Epi::CARRY ? 1 : PROBE_KREP;
    unsigned voffA[2], voffB[2];
#pragma unroll
    for (int i = 0; i < 2; ++i) { int R, C; stage_rc(tid * 16 + i * 8192, R, C); const int Rb = Epi::PERM ? ((R & ~31) + perm32(R & 31)) : R;
        voffA[i] = (unsigned)(R * P.lda + C) * 2u; voffB[i] = (unsigned)(Rb * P.ldb + C) * 2u; }
    const size_t kstep = (size_t)(BK * 2);
    const size_t hstepA = (size_t)HALF * P.lda * 2, hstepB = (size_t)HALF * P.ldb * 2;
    const unsigned ldsw = (unsigned)wid * 1024u;
    const int aoff = lds_byte(wr * 64 + fr, fq * 8), boff = lds_byte(wc * 32 + fr, fq * 8);
#define PG8_SA(b, h) (((b) * 2 + (h)) * HTB)
#define PG8_SB(b, h) ((4 + (b) * 2 + (h)) * HTB)
#define PG8_STAGE(bufoff, gbase, voff) do { _Pragma("unroll") for (int _i = 0; _i < 2; ++_i) \
        __builtin_amdgcn_global_load_lds((const unsigned*)((const char*)(gbase) + (voff)[_i]), (LAS unsigned*)(lds + (bufoff) + ldsw + _i * 8192), 16, 0, 0); } while (0)
#define PG8_LD16(off) (*(const LAS i32x4*)(lds + (off)))
#define PG8_LDA(dst, b, h) do { _Pragma("unroll") for (int m = 0; m < 4; ++m) { const i32x4 lo_ = PG8_LD16(PG8_SA(b, h) + aoff + m * 2048), hi_ = PG8_LD16(PG8_SA(b, h) + aoff + m * 2048 + 1024); dst[m] = __builtin_shufflevector(lo_, hi_, 0, 1, 2, 3, 4, 5, 6, 7); } } while (0)
#define PG8_LDB(dst, b, h) do { _Pragma("unroll") for (int n = 0; n < 2; ++n) { const i32x4 lo_ = PG8_LD16(PG8_SB(b, h) + boff + n * 2048), hi_ = PG8_LD16(PG8_SB(b, h) + boff + n * 2048 + 1024); dst[n] = __builtin_shufflevector(lo_, hi_, 0, 1, 2, 3, 4, 5, 6, 7); } } while (0)
#define PG8_LOH(X) __builtin_bit_cast(bf16x8, __builtin_shufflevector((X), (X), 0, 1, 2, 3))
#define PG8_HIH(X) __builtin_bit_cast(bf16x8, __builtin_shufflevector((X), (X), 4, 5, 6, 7))
#define PG8_MMA(ai, bj, At, Bt) do { __builtin_amdgcn_s_setprio(1); \
        if constexpr (Prob::FP8) { _Pragma("unroll") for (int m = 0; m < 4; ++m) _Pragma("unroll") for (int n = 0; n < 2; ++n) \
            asm volatile("v_mfma_scale_f32_16x16x128_f8f6f4 %0, %1, %2, %0, %3, %3 op_sel_hi:[0,0,0]" : "+v"(acc[ai][bj][m][n]) : "v"(Bt[n]), "v"(At[m]), "v"(sc1)); } \
        else { _Pragma("unroll") for (int m = 0; m < 4; ++m) _Pragma("unroll") for (int n = 0; n < 2; ++n) { \
            acc[ai][bj][m][n] = __builtin_amdgcn_mfma_f32_16x16x32_bf16(PG8_LOH(Bt[n]), PG8_LOH(At[m]), acc[ai][bj][m][n], 0, 0, 0); \
            acc[ai][bj][m][n] = __builtin_amdgcn_mfma_f32_16x16x32_bf16(PG8_HIH(Bt[n]), PG8_HIH(At[m]), acc[ai][bj][m][n], 0, 0, 0); } } \
        __builtin_amdgcn_s_setprio(0); } while (0)
#define PG8_WAIT_V(n) asm volatile("s_waitcnt vmcnt(" #n ")" ::: "memory")
#define PG8_WAIT_L(n) asm volatile("s_waitcnt lgkmcnt(" #n ")" ::: "memory")
#define PG8_BAR __builtin_amdgcn_s_barrier()
#define PG8_SCHED __builtin_amdgcn_sched_barrier(0)
    Unit cur, nxt; int ui = 0;
    if (!S.next(0, cur)) return;
    f32x4 acc[2][2][4][2];
#pragma unroll
    for (int a = 0; a < 2; ++a)
#pragma unroll
        for (int b = 0; b < 2; ++b)
#pragma unroll
            for (int m = 0; m < 4; ++m)
#pragma unroll
                for (int n = 0; n < 2; ++n) acc[a][b][m][n] = (f32x4){0.f, 0.f, 0.f, 0.f};
    i32x8 At[4], B0[2], B1[2];
    const int sc1 = 0x7f7f7f7f;
    const char* cA = P.a_base(cur); const char* cB = P.b_base(cur);
    PG8_STAGE(PG8_SB(0, 0), cB, voffB); PG8_STAGE(PG8_SA(0, 0), cA, voffA); PG8_STAGE(PG8_SB(0, 1), cB + hstepB, voffB); PG8_STAGE(PG8_SA(0, 1), cA + hstepA, voffA);
    if (wr == 1) PG8_BAR;
    PG8_WAIT_V(4); PG8_BAR;
    PG8_STAGE(PG8_SB(1, 0), cB + kstep, voffB); PG8_STAGE(PG8_SA(1, 0), cA + kstep, voffA); PG8_STAGE(PG8_SB(1, 1), cB + hstepB + kstep, voffB);
    PG8_WAIT_V(6); PG8_BAR;
    for (;;) {
        const bool has_next = S.next(ui + 1, nxt);
        const char* nA = has_next ? P.a_base(nxt) : cA; const char* nB = has_next ? P.b_base(nxt) : cB;
        for (int rep_ = 0; rep_ < KREP; ++rep_)
        for (int t = 0; t < nt; t += 2) {
            const bool last = (t == nt - 2);
            if constexpr (Epi::HOOK) { if (last && rep_ + 1 == KREP) E.prefetch(cur, lds, wid, lane); }
            const char* a1 = cA + (size_t)(t + 1) * kstep;
            const char* a2 = last ? (rep_ + 1 < KREP ? cA : nA) : cA + (size_t)(t + 2) * kstep; const char* b2 = last ? (rep_ + 1 < KREP ? cB : nB) : cB + (size_t)(t + 2) * kstep;
            const char* a3 = a2 + kstep; const char* b3 = b2 + kstep;
            PG8_LDB(B0, 0, 0); PG8_SCHED; PG8_LDA(At, 0, 0); PG8_STAGE(PG8_SA(1, 1), a1 + hstepA, voffA);
            PG8_WAIT_L(8); PG8_BAR; PG8_WAIT_L(0); PG8_MMA(0, 0, At, B0); PG8_BAR; PG8_SCHED;
            PG8_LDB(B1, 0, 1); PG8_STAGE(PG8_SB(0, 0), b2, voffB);
            PG8_BAR; PG8_WAIT_L(0); PG8_MMA(0, 1, At, B1); PG8_BAR;
            PG8_LDA(At, 0, 1); PG8_STAGE(PG8_SA(0, 0), a2, voffA);
            PG8_BAR; PG8_WAIT_L(0); PG8_MMA(1, 0, At, B0); PG8_BAR; PG8_SCHED;
            PG8_STAGE(PG8_SB(0, 1), b2 + hstepB, voffB);
            PG8_WAIT_V(6); PG8_BAR; PG8_MMA(1, 1, At, B1); PG8_BAR;
            PG8_LDB(B0, 1, 0); PG8_SCHED; PG8_LDA(At, 1, 0); PG8_STAGE(PG8_SA(0, 1), a2 + hstepA, voffA);
            PG8_WAIT_L(8); PG8_BAR; PG8_WAIT_L(0); PG8_MMA(0, 0, At, B0); PG8_BAR; PG8_SCHED;
            PG8_LDB(B1, 1, 1); PG8_STAGE(PG8_SB(1, 0), b3, voffB);
            PG8_BAR; PG8_WAIT_L(0); PG8_MMA(0, 1, At, B1); PG8_BAR;
            PG8_LDA(At, 1, 1); PG8_STAGE(PG8_SA(1, 0), a3, voffA);
            PG8_BAR; PG8_WAIT_L(0); PG8_MMA(1, 0, At, B0); PG8_BAR; PG8_SCHED;
            PG8_STAGE(PG8_SB(1, 1), b3 + hstepB, voffB);
            PG8_WAIT_V(6); PG8_BAR; PG8_MMA(1, 1, At, B1); PG8_BAR;
        }
        if constexpr (Prob::FP8) {
            asm volatile("s_nop 15\n\ts_nop 15" ::: "memory");
#pragma unroll
            for (int a_ = 0; a_ < 2; ++a_)
#pragma unroll
                for (int b_ = 0; b_ < 2; ++b_)
#pragma unroll
                    for (int m_ = 0; m_ < 4; ++m_)
#pragma unroll
                        for (int n_ = 0; n_ < 2; ++n_) asm volatile("" : "+v"(acc[a_][b_][m_][n_]));
        }
        if constexpr (KREP > 1) {
#pragma unroll
        for (int a_ = 0; a_ < 2; ++a_)
#pragma unroll
            for (int b_ = 0; b_ < 2; ++b_)
#pragma unroll
                for (int m_ = 0; m_ < 4; ++m_)
#pragma unroll
                    for (int n_ = 0; n_ < 2; ++n_) acc[a_][b_][m_][n_] *= (1.0f / KREP); }
        { const int t2_ = opaque_tid(WID); const int fr_ = t2_ & 15, fq_ = (t2_ >> 4) & 3; int wr_ = WID >> 2, wc_ = WID & 3; asm volatile("" : "+s"(wr_), "+s"(wc_));
          E(acc, cur, wr_, wc_, fr_, fq_);
#if PROBE_EPI2
          if constexpr (Epi::HOOK) { asm volatile("" ::: "memory"); E(acc, cur, wr_, wc_, fr_, fq_); }
#endif
        }
        if (!has_next) break;
        const float carry = Epi::carry(cur);
#pragma unroll
        for (int a = 0; a < 2; ++a)
#pragma unroll
            for (int b = 0; b < 2; ++b)
#pragma unroll
                for (int m = 0; m < 4; ++m)
#pragma unroll
                    for (int n = 0; n < 2; ++n) acc[a][b][m][n] = Epi::CARRY ? acc[a][b][m][n] * carry : (f32x4){0.f, 0.f, 0.f, 0.f};
        cur = nxt; cA = nA; cB = nB; ++ui;
    }
    PG8_WAIT_V(0);
    if (wr == 0) PG8_BAR;
    PG8_BAR;
#undef PG8_SA
#undef PG8_SB
#undef PG8_STAGE
#undef PG8_LDA
#undef PG8_LDB
#undef PG8_MMA
#undef PG8_LD16
#undef PG8_LOH
#undef PG8_HIH
#undef PG8_WAIT_V
#undef PG8_WAIT_L
#undef PG8_BAR
#undef PG8_SCHED
}
}
using pg8::Unit;
typedef f32x4 Acc[2][2][4][2];

struct ProbPlain { static constexpr bool FP8 = false; const bf16_t* A; const bf16_t* Bt; int lda, ldb, K;
    DI const char* a_base(const Unit& u) const { return (const char*)(A + (size_t)u.pm * 256 * lda); }
    DI const char* b_base(const Unit& u) const { return (const char*)(Bt + (size_t)u.pn * 256 * ldb); } };
struct ProbCmp1 { static constexpr bool FP8 = false; const bf16_t* KCB; const bf16_t* VCB; const bf16_t* W; int lda, ldb, K;
    DI const char* a_base(const Unit& u) const { const int kv = u.pm >> 4, rt = u.pm & 15; return (const char*)((kv ? VCB : KCB) + (size_t)rt * 256 * 1024); }
    DI const char* b_base(const Unit& u) const { const int kv = u.pm >> 4; return (const char*)(W + (size_t)kv * 256 * 2048); } };
struct ProbAtt { static constexpr bool FP8 = false; const bf16_t* AQ; const bf16_t* KP; int lda, ldb, K;
    DI const char* a_base(const Unit& u) const { const int z = u.pm, n = z & 7, h = (z >> 3) & 3, b = z >> 5; const size_t t0 = (size_t)b * 2048 + n * 256; return (const char*)(AQ + (t0 * 4 + h) * 512 + 256); }
    DI const char* b_base(const Unit& u) const { const int z = u.pm, n = z & 7, h = (z >> 3) & 3, b = z >> 5; const size_t t0 = (size_t)b * 2048 + n * 256; return (const char*)(KP + t0 * 1024 + h * 256); } };
struct ProbUT { static constexpr bool FP8 = false; const bf16_t* VS; const bf16_t* KT; int lda, ldb, K;
    DI const char* a_base(const Unit& u) const { const int z = u.pm >> 1, half = u.pm & 1; return (const char*)(VS + (size_t)z * 262144 + (size_t)half * 256 * 512); }
    DI const char* b_base(const Unit& u) const { const int z = u.pm >> 1; return (const char*)(KT + (size_t)z * 65536); } };
struct ProbY { static constexpr bool FP8 = false; const bf16_t* AQ; const bf16_t* VS; int lda, ldb, K;
    DI const char* a_base(const Unit& u) const { const int z = u.pm, n = z & 7, h = (z >> 3) & 3, b = z >> 5; const size_t t0 = (size_t)b * 2048 + n * 256; return (const char*)(AQ + (t0 * 4 + h) * 512); }
    DI const char* b_base(const Unit& u) const { return (const char*)(VS + (size_t)u.pm * 262144 + (size_t)u.pn * 256 * 512); } };
DI int moe_tile_expert(const LAS int* ts, int rt) { int e = 0;
#pragma unroll 8
    for (int i = 1; i < 32; ++i) e += (rt >= ts[i]) ? 1 : 0;
    return e; }
struct ProbMoe { static constexpr bool FP8 = false; const bf16_t* A; const bf16_t* W; const LAS int* ts; int nper; int lda, ldb, K;
    DI const char* a_base(const Unit& u) const { return (const char*)(A + (size_t)u.pm * 256 * 1024); }
    DI const char* b_base(const Unit& u) const { const int e = moe_tile_expert(ts, u.pm); return (const char*)(W + ((size_t)e * nper + (size_t)u.pn * 256) * 1024); } };

struct ProbPlain8 { static constexpr bool FP8 = true; const unsigned char* A; const unsigned char* Bt; int lda, ldb, K;
    DI const char* a_base(const Unit& u) const { return (const char*)(A + (size_t)u.pm * 256 * lda * 2); }
    DI const char* b_base(const Unit& u) const { return (const char*)(Bt + (size_t)u.pn * 256 * ldb * 2); } };
struct ProbMoe8 { static constexpr bool FP8 = true; const unsigned char* A; const unsigned char* W; const LAS int* ts; int nper; int lda, ldb, K;
    DI const char* a_base(const Unit& u) const { return (const char*)(A + (size_t)u.pm * 256 * 1024); }
    DI const char* b_base(const Unit& u) const { const int e = moe_tile_expert(ts, u.pm); return (const char*)(W + ((size_t)e * nper + (size_t)u.pn * 256) * 1024); } };

#define EPI_ROWS(ai, m) (128 * (ai) + 64 * wr + 16 * (m) + fr)
struct EpiEvNat { static constexpr bool HOOK = false; static constexpr bool CARRY = false; static DI float carry(const Unit&) { return 0.f; } static constexpr bool PERM = true;
    unsigned char* ws; const float* gains;
    DI void operator()(const Acc& acc, const Unit& u, int wr, int wc, int fr, int fq) const {
        const int pn = u.pn; const bool norm = (pn != 6);
        const int gi = pn < 2 ? 0 : pn < 4 ? 1 : pn < 6 ? 2 : 3;
        const float* g = gains + gi * 64;
        f32x4 gv[2][2];
#pragma unroll
        for (int bj = 0; bj < 2; ++bj)
#pragma unroll
            for (int n = 0; n < 2; ++n) { const f32x4 t4 = *(const f32x4*)(g + 32 * bj + 8 * fq + 4 * n); gv[bj][n] = norm ? t4 : (f32x4){1.f, 1.f, 1.f, 1.f}; }
        size_t boff; int rowmul, hoff; bool panel = false;
        if (pn < 2) { boff = WS_QD; rowmul = 512; hoff = (pn * 4 + wc) * 64; }
        else if (pn < 4) { boff = WS_KD; rowmul = 512; hoff = ((pn - 2) * 4 + wc) * 64; }
        else if (pn < 6) { boff = WS_QN; rowmul = 512; hoff = ((pn - 4) * 4 + wc) * 64; }
        else { panel = true; rowmul = 64; hoff = 0; boff = (pn == 6) ? (wc < 2 ? WS_KCB : WS_VCB) : (wc < 2 ? WS_KSB : WS_KWB); }
        bf16_t* base = (bf16_t*)(ws + boff);
#pragma unroll
        for (int ai = 0; ai < 2; ++ai)
#pragma unroll
            for (int m = 0; m < 4; ++m) {
                const int t = u.pm * 256 + EPI_ROWS(ai, m), b = t >> 11, sq = t & 2047;
                float ss = 0.f;
#pragma unroll
                for (int bj = 0; bj < 2; ++bj)
#pragma unroll
                    for (int n = 0; n < 2; ++n) { const f32x4 x = acc[ai][bj][m][n]; ss += (x[0] * x[0] + x[1] * x[1]) + (x[2] * x[2] + x[3] * x[3]); }
                ss += shx(ss, 16); ss += shx(ss, 32);
                const float rstd = norm ? rsqrtf(ss * (1.0f / 64.0f) + EPS) * ((pn < 2 || pn == 4 || pn == 5) ? 0.125f : 1.0f) : 1.0f;
                const size_t rowi = panel ? ((size_t)(b * 2 + (wc & 1)) * 2048 + sq) : (size_t)t;
#pragma unroll
                for (int bj = 0; bj < 2; ++bj) {
                    const f32x4 v0 = acc[ai][bj][m][0] * rstd * gv[bj][0], v1 = acc[ai][bj][m][1] * rstd * gv[bj][1];
                    *(u32x4*)(base + rowi * rowmul + hoff + 32 * bj + 8 * fq) = pack8(v0, v1);
                }
            }
    }
};
struct EpiEvSw { static constexpr bool HOOK = false; static constexpr bool CARRY = false; static DI float carry(const Unit&) { return 0.f; } static constexpr bool PERM = true;
    unsigned char* ws;
    DI void operator()(const Acc& acc, const Unit& u, int wr, int wc, int fr, int fq) const {
        const int b = u.pn >> 3, sb = (u.pn & 7) * 256;
#pragma unroll
        for (int ai = 0; ai < 2; ++ai)
#pragma unroll
            for (int m = 0; m < 4; ++m) {
                const int rl = EPI_ROWS(ai, m);
                size_t boff, rowi;
                if (u.pm < 2) { const int fg = u.pm * 256 + rl; boff = WS_VAT; rowi = (size_t)(b * 4 + (fg >> 7)) * 128 + (fg & 127); }
                else { const int r2 = rl & 127; boff = (rl < 128) ? WS_VST : WS_VWT; rowi = (size_t)(b * 2 + (r2 >> 6)) * 64 + (r2 & 63); }
                bf16_t* rowp = (bf16_t*)(ws + boff) + rowi * 2048;
#pragma unroll
                for (int bj = 0; bj < 2; ++bj) { const u32x4 pw = pack8(acc[ai][bj][m][0], acc[ai][bj][m][1]);
                    const int s0 = sb + 128 * bj + 32 * wc + 8 * fq; bf16_t* g16 = rowp + (s0 & ~15) + ((s0 & 8) ? 4 : 0);
                    *(u32x2*)g16 = (u32x2){pw.x, pw.y}; *(u32x2*)(g16 + 8) = (u32x2){pw.z, pw.w}; }
            }
    }
};
struct EpiCmp1 { static constexpr bool HOOK = false; static constexpr bool CARRY = false; static DI float carry(const Unit&) { return 0.f; } static constexpr bool PERM = true;
    bf16_t* HID; const float* bias1;
    DI void operator()(const Acc& acc, const Unit& u, int wr, int wc, int fr, int fq) const {
        const int kv = u.pm >> 4, rt = u.pm & 15;
#pragma unroll
        for (int bj = 0; bj < 2; ++bj) {
            const int col = 128 * bj + 32 * wc + 8 * fq;
            const f32x4 b0 = *(const f32x4*)(bias1 + kv * 256 + col), b1 = *(const f32x4*)(bias1 + kv * 256 + col + 4);
#pragma unroll
            for (int ai = 0; ai < 2; ++ai)
#pragma unroll
                for (int m = 0; m < 4; ++m) {
                    f32x4 v0 = acc[ai][bj][m][0] + b0, v1 = acc[ai][bj][m][1] + b1;
#pragma unroll
                    for (int j = 0; j < 4; ++j) { v0[j] = v0[j] * sigm(v0[j]); v1[j] = v1[j] * sigm(v1[j]); }
                    *(u32x4*)(HID + ((size_t)kv * 4096 + rt * 256 + EPI_ROWS(ai, m)) * 256 + col) = pack8(v0, v1);
                }
        }
    }
};
struct EpiResid { static constexpr bool HOOK = false; static constexpr bool CARRY = false; static DI float carry(const Unit&) { return 0.f; } static constexpr bool PERM = true;
    const void* Hin; bf16_t* Hout; bool hb;
    DI void operator()(const Acc& acc, const Unit& u, int wr, int wc, int fr, int fq) const {
#pragma unroll
        for (int ai = 0; ai < 2; ++ai)
#pragma unroll
            for (int m = 0; m < 4; ++m) {
                const size_t off = (size_t)(u.pm * 256 + EPI_ROWS(ai, m)) * 1024 + u.pn * 256 + 32 * wc + 8 * fq;
#pragma unroll
                for (int bj = 0; bj < 2; ++bj) { const size_t o = off + 128 * bj;
                    *(u32x4*)(Hout + o) = pack8(ld_h4(Hin, hb, o) + acc[ai][bj][m][0], ld_h4(Hin, hb, o + 4) + acc[ai][bj][m][1]); }
            }
    }
};
DI float ret_lg2(int h) { return __log2f(1.0f - exp2f(-5.0f - (float)h)); }
struct EpiOdNat { static constexpr bool HOOK = false; static constexpr bool CARRY = false; static DI float carry(const Unit&) { return 0.f; } static constexpr bool PERM = true;
    unsigned char* ws;
    DI void operator()(const Acc& acc, const Unit& u, int wr, int wc, int fr, int fq) const {
        const int pn = u.pn; const int h = pn & 3; const float lg = ret_lg2(h);
        const size_t boff = pn < 4 ? WS_AQ : pn < 8 ? WS_KP : WS_GG;
        const int rowmul = pn < 4 ? 2048 : pn < 8 ? 1024 : 2048;
        const int coff = pn < 4 ? (h * 512 + 256) : pn < 8 ? (h * 256) : ((pn - 8) * 256);
        bf16_t* base = (bf16_t*)(ws + boff) + coff;
#pragma unroll
        for (int ai = 0; ai < 2; ++ai)
#pragma unroll
            for (int m = 0; m < 4; ++m) {
                const int cl = EPI_ROWS(ai, m); const size_t t = (size_t)u.pm * 256 + cl;
                float sc = 1.f;
                if (pn < 4) sc = exp2f(lg * (float)(cl + 1)); else if (pn < 8) sc = 0.0625f * exp2f(-lg * (float)(cl + 1));
#pragma unroll
                for (int bj = 0; bj < 2; ++bj) {
                    const int d = 128 * bj + 32 * wc + 8 * fq;
                    f32x4 v0 = acc[ai][bj][m][0] * sc, v1 = acc[ai][bj][m][1] * sc;
                    if (pn >= 8) {
#pragma unroll
                        for (int j = 0; j < 4; ++j) { v0[j] = v0[j] * sigm(v0[j]); v1[j] = v1[j] * sigm(v1[j]); } }
                    const u32x4 pw = pack8(v0, v1);
                    *(u32x4*)(base + t * rowmul + d) = pw;
                    if (pn >= 4 && pn < 8) {
                        bf16_t* kt = (bf16_t*)(ws + WS_KT) + ((size_t)((u.pm >> 3) * 4 + h) * 8 + (u.pm & 7)) * 65536 + (size_t)d * 256 + cl;
                        kt[0 * 256] = (bf16_t)(pw.x & 0xffffu); kt[1 * 256] = (bf16_t)(pw.x >> 16); kt[2 * 256] = (bf16_t)(pw.y & 0xffffu); kt[3 * 256] = (bf16_t)(pw.y >> 16);
                        kt[4 * 256] = (bf16_t)(pw.z & 0xffffu); kt[5 * 256] = (bf16_t)(pw.z >> 16); kt[6 * 256] = (bf16_t)(pw.w & 0xffffu); kt[7 * 256] = (bf16_t)(pw.w >> 16);
                    }
                }
            }
    }
};
struct EpiOdSw { static constexpr bool HOOK = false; static constexpr bool CARRY = false; static DI float carry(const Unit&) { return 0.f; } static constexpr bool PERM = true;
    unsigned char* ws;
    DI void operator()(const Acc& acc, const Unit& u, int wr, int wc, int fr, int fq) const {
        const int b = u.pn >> 3, n = u.pn & 7, h = u.pm >> 1;
        const size_t z = (size_t)(b * 4 + h) * 8 + n;
        bf16_t* base = (bf16_t*)(ws + WS_VS) + z * 262144 + (size_t)(u.pm & 1) * 256 * 512;
#pragma unroll
        for (int bj = 0; bj < 2; ++bj) {
            const int cl = 128 * bj + 32 * wc + 8 * fq;
#pragma unroll
            for (int ai = 0; ai < 2; ++ai)
#pragma unroll
                for (int m = 0; m < 4; ++m)
                    *(u32x4*)(base + (size_t)EPI_ROWS(ai, m) * 512 + cl) = pack8(acc[ai][bj][m][0], acc[ai][bj][m][1]);
        }
    }
};
struct EpiAtt { static constexpr bool HOOK = false; static constexpr bool CARRY = false; static DI float carry(const Unit&) { return 0.f; } static constexpr bool PERM = true;
    bf16_t* AQ;
    DI void operator()(const Acc& acc, const Unit& u, int wr, int wc, int fr, int fq) const {
        const int z = u.pm, n = z & 7, h = (z >> 3) & 3, b = z >> 5; const size_t t0 = (size_t)b * 2048 + n * 256;
#pragma unroll
        for (int ai = 0; ai < 2; ++ai)
#pragma unroll
            for (int m = 0; m < 4; ++m) {
                const int c = EPI_ROWS(ai, m);
#pragma unroll
                for (int bj = 0; bj < 2; ++bj) {
                    const int e0 = 128 * bj + 32 * wc + 8 * fq;
                    f32x4 v0 = acc[ai][bj][m][0], v1 = acc[ai][bj][m][1];
#pragma unroll
                    for (int j = 0; j < 4; ++j) { v0[j] = (c >= e0 + j) ? v0[j] : 0.f; v1[j] = (c >= e0 + 4 + j) ? v1[j] : 0.f; }
                    *(u32x4*)(AQ + ((t0 + c) * 4 + h) * 512 + e0) = pack8(v0, v1);
                }
            }
    }
};
struct EpiUT { static constexpr bool HOOK = false; static constexpr bool CARRY = false; static DI float carry(const Unit&) { return 0.f; } static constexpr bool PERM = true;
    bf16_t* UT;
    DI void operator()(const Acc& acc, const Unit& u, int wr, int wc, int fr, int fq) const {
        const size_t z = (size_t)(u.pm >> 1); const int half = u.pm & 1;
#pragma unroll
        for (int ai = 0; ai < 2; ++ai)
#pragma unroll
            for (int m = 0; m < 4; ++m) {
                bf16_t* rowp = UT + z * 131072 + (size_t)(half * 256 + EPI_ROWS(ai, m)) * 256 + 32 * wc + 8 * fq;
#pragma unroll
                for (int bj = 0; bj < 2; ++bj) *(u32x4*)(rowp + 128 * bj) = pack8(acc[ai][bj][m][0], acc[ai][bj][m][1]);
            }
    }
};
struct EpiUTScan { static constexpr bool HOOK = false; static constexpr bool CARRY = true; static constexpr bool PERM = true;
    static DI float carry(const Unit& u) { const int z = u.pm >> 1, n = z & 7, h = (z >> 3) & 3; return n == 7 ? 0.f : exp2f(256.0f * ret_lg2(h)); }
    bf16_t* VS;
    DI void operator()(const Acc& acc, const Unit& u, int wr, int wc, int fr, int fq) const {
        const size_t z = (size_t)(u.pm >> 1); const int half = u.pm & 1, n = (int)(z & 7), h = (int)((z >> 3) & 3);
        const float dec = exp2f(256.0f * ret_lg2(h));
#pragma unroll
        for (int ai = 0; ai < 2; ++ai)
#pragma unroll
            for (int m = 0; m < 4; ++m) {
                bf16_t* rowp = VS + (z * 512 + half * 256 + EPI_ROWS(ai, m)) * 512 + 256 + 32 * wc + 8 * fq;
#pragma unroll
                for (int bj = 0; bj < 2; ++bj) {
                    if (n == 0) { unsigned z0; asm volatile("v_mov_b32 %0, 0" : "=v"(z0)); *(u32x4*)(rowp + 128 * bj) = (u32x4){z0, z0, z0, z0}; }
                    if (n < 7) *(u32x4*)(rowp + (size_t)512 * 512 + 128 * bj) = pack8(acc[ai][bj][m][0] * dec, acc[ai][bj][m][1] * dec);
                }
            }
    }
};
struct SchedSeq { int nb, c;
    DI void init(int G, int c_) { nb = G / 2 > 0 ? G / 2 : 1; c = c_; }
    DI bool next(int i, Unit& u) const { if (c >= nb) return false; const int seq = c + (i >> 3) * nb; if (seq >= 128) return false;
        const int bh = seq >> 1, half = seq & 1, n = i & 7; u.pm = (bh * 8 + n) * 2 + half; u.pn = 0; return true; } };
struct EpiY { static constexpr bool HOOK = false; static constexpr bool CARRY = false; static DI float carry(const Unit&) { return 0.f; } static constexpr bool PERM = true;
    bf16_t* Y;
    DI void operator()(const Acc& acc, const Unit& u, int wr, int wc, int fr, int fq) const {
        const int z = u.pm, n = z & 7, h = (z >> 3) & 3, b = z >> 5; const size_t t0 = (size_t)b * 2048 + n * 256;
#pragma unroll
        for (int ai = 0; ai < 2; ++ai)
#pragma unroll
            for (int m = 0; m < 4; ++m) {
                bf16_t* rowp = Y + (t0 + EPI_ROWS(ai, m)) * 2048 + h * 512 + u.pn * 256 + 32 * wc + 8 * fq;
#pragma unroll
                for (int bj = 0; bj < 2; ++bj) *(u32x4*)(rowp + 128 * bj) = pack8(acc[ai][bj][m][0], acc[ai][bj][m][1]);
            }
    }
};
constexpr float W8_SCALE = 32.0f, WSC = 1.0f / W8_SCALE;
struct EpiGU { static constexpr bool HOOK = true; static constexpr bool CARRY = false; static DI float carry(const Unit&) { return 0.f; } static constexpr bool PERM = true;
    unsigned char* ACT; const float* bgu; const LAS int* ts;
    DI void prefetch(const Unit& u, LAS unsigned char* lds, int wid, int lane) const {
        if (wid == 0) { const int e = moe_tile_expert(ts, u.pm); const int ln = lane_now();
            const float* src = bgu + (size_t)e * 2048 + 128 * u.pn + ((ln & 32) ? 1024 : 0) + 4 * (ln & 31);
            __builtin_amdgcn_global_load_lds((const unsigned*)src, (LAS unsigned*)(lds + MISC_OFF + MO_RED), 16, 0, 0); }
    }
    DI void operator()(const Acc& acc, const Unit& u, int wr, int wc, int fr, int fq) const {
        const int w = 32 * wc + 8 * fq;
        const LAS float* bl_ = (const LAS float*)(ts) - MO_TS / 4 + MO_RED / 4 + w;
        const f32x4 bg0 = *(const LAS f32x4*)bl_, bg1 = *(const LAS f32x4*)(bl_ + 4), bl0 = *(const LAS f32x4*)(bl_ + 128), bl1 = *(const LAS f32x4*)(bl_ + 132);
#pragma unroll
        for (int ai = 0; ai < 2; ++ai)
#pragma unroll
            for (int m = 0; m < 4; ++m) {
                f32x4 g0 = acc[ai][0][m][0] * WSC + bg0, g1 = acc[ai][0][m][1] * WSC + bg1, l0 = acc[ai][1][m][0] * WSC + bl0, l1 = acc[ai][1][m][1] * WSC + bl1;
#pragma unroll
                for (int j = 0; j < 4; ++j) {
                    const float a = fminf(g0[j], 7.0f), c = fminf(g1[j], 7.0f);
                    const float la = fminf(fmaxf(l0[j], -7.0f), 7.0f), lc = fminf(fmaxf(l1[j], -7.0f), 7.0f);
                    g0[j] = a * sigm(1.702f * a) * (la + 1.0f); g1[j] = c * sigm(1.702f * c) * (lc + 1.0f); }
                u32x2 o8; o8.x = pk4_fp8(g0[0], g0[1], g0[2], g0[3]); o8.y = pk4_fp8(g1[0], g1[1], g1[2], g1[3]);
                *(u32x2*)(ACT + ((size_t)u.pm * 256 + EPI_ROWS(ai, m)) * 1024 + 128 * u.pn + w) = o8;
            }
    }
};
struct EpiDN { static constexpr bool HOOK = true; static constexpr bool CARRY = false; static DI float carry(const Unit&) { return 0.f; } static constexpr bool PERM = true;
    bf16_t* YB; const float* bdn; const LAS int* ts;
    DI void prefetch(const Unit& u, LAS unsigned char* lds, int wid, int lane) const {
        if (wid == 0) { const int e = moe_tile_expert(ts, u.pm); const int ln = lane_now();
            __builtin_amdgcn_global_load_lds((const unsigned*)(bdn + (size_t)e * 1024 + 256 * u.pn + 4 * ln), (LAS unsigned*)(lds + MISC_OFF + MO_RED), 16, 0, 0); }
    }
    DI void operator()(const Acc& acc, const Unit& u, int wr, int wc, int fr, int fq) const {
        const LAS float* bl_ = (const LAS float*)(ts) - MO_TS / 4 + MO_RED / 4;
#pragma unroll
        for (int bj = 0; bj < 2; ++bj) {
            const int cl = 128 * bj + 32 * wc + 8 * fq, col = 256 * u.pn + cl;
            const f32x4 b0 = *(const LAS f32x4*)(bl_ + cl), b1 = *(const LAS f32x4*)(bl_ + cl + 4);
#pragma unroll
            for (int ai = 0; ai < 2; ++ai)
#pragma unroll
                for (int m = 0; m < 4; ++m)
                    *(u32x4*)(YB + ((size_t)u.pm * 256 + EPI_ROWS(ai, m)) * 1024 + col) = pack8(acc[ai][bj][m][0] * (1.0f / 64.0f) + b0, acc[ai][bj][m][1] * (1.0f / 64.0f) + b1);
        }
    }
};
struct EpiPP { static constexpr bool HOOK = false; static constexpr bool CARRY = false; static DI float carry(const Unit&) { return 0.f; } static constexpr bool PERM = true;
    bf16_t* PP;
    DI void operator()(const Acc& acc, const Unit& u, int wr, int wc, int fr, int fq) const {
#pragma unroll
        for (int ai = 0; ai < 2; ++ai)
#pragma unroll
            for (int m = 0; m < 4; ++m) {
                bf16_t* rowp = PP + ((size_t)u.pm * 256 + EPI_ROWS(ai, m)) * 1024 + u.pn * 256 + 32 * wc + 8 * fq;
#pragma unroll
                for (int bj = 0; bj < 2; ++bj) *(u32x4*)(rowp + 128 * bj) = pack8(acc[ai][bj][m][0], acc[ai][bj][m][1]);
            }
    }
};
struct EpiPLE { static constexpr bool HOOK = false; static constexpr bool CARRY = false; static DI float carry(const Unit&) { return 0.f; } static constexpr bool PERM = true;
    bf16_t* H; const bf16_t* PP; float* out;
    DI void operator()(const Acc& acc, const Unit& u, int wr, int wc, int fr, int fq) const {
#pragma unroll
        for (int ai = 0; ai < 2; ++ai)
#pragma unroll
            for (int m = 0; m < 4; ++m) {
                const size_t off = (size_t)(u.pm * 256 + EPI_ROWS(ai, m)) * 1024 + u.pn * 256 + 32 * wc + 8 * fq;
#pragma unroll
                for (int bj = 0; bj < 2; ++bj) { const size_t o = off + 128 * bj;
                    const u32x4 pw = *(const u32x4*)(PP + o), hw = *(const u32x4*)(H + o); const f32x4 a0 = acc[ai][bj][m][0], a1 = acc[ai][bj][m][1];
                    f32x4 h0 = {bflo(hw.x), bfhi(hw.x), bflo(hw.y), bfhi(hw.y)}, h1 = {bflo(hw.z), bfhi(hw.z), bflo(hw.w), bfhi(hw.w)};
                    h0[0] += sigm(a0[0] * WSC) * bflo(pw.x); h0[1] += sigm(a0[1] * WSC) * bfhi(pw.x); h0[2] += sigm(a0[2] * WSC) * bflo(pw.y); h0[3] += sigm(a0[3] * WSC) * bfhi(pw.y);
                    h1[0] += sigm(a1[0] * WSC) * bflo(pw.z); h1[1] += sigm(a1[1] * WSC) * bfhi(pw.z); h1[2] += sigm(a1[2] * WSC) * bflo(pw.w); h1[3] += sigm(a1[3] * WSC) * bfhi(pw.w);
                    if (out) { *(f32x4*)(out + o) = h0; *(f32x4*)(out + o + 4) = h1; } else *(u32x4*)(H + o) = pack8(h0, h1);
                }
            }
    }
};

DI int vperm16(int key) { const int g = (key >> 2) & 3; const int ng = (g == 1) ? 2 : (g == 2) ? 1 : g; return (key & ~15) | (ng << 2) | (key & 3); }
template <int DV, int MODE>
DI void attn_unit(const int WID, LAS unsigned char* lds, const bf16_t* Qp, int ldq, const bf16_t* Kp, int ldk, const bf16_t* Vt, int ldvt, int q0, float slope, int dcut,
                  const unsigned* selp, bf16_t* Op, int ldo, float* impp) {
    constexpr int NRB = DV / 32;
    constexpr int KT_B = 64 * 128, VT_B = DV * 128, BUF_B = 2 * KT_B + 2 * VT_B;
    const int tid = opaque_tid(WID), w = __builtin_amdgcn_readfirstlane(tid >> 6), lane = tid & 63, r = lane & 31, hh = lane >> 5;
    const int qrow = q0 + 32 * w + r, qw_first = q0 + 32 * w, qw_last = qw_first + 31;
    const float LOG2E = 1.44269504089f;
    bf16x8 qf[4];
#pragma unroll
    for (int ks = 0; ks < 4; ++ks) qf[ks] = *(const bf16x8*)(Qp + (size_t)(32 * w + r) * ldq + 16 * ks + 8 * hh);
    unsigned selm = 0xffffffffu, orm = 0xffffffffu;
    if (MODE == 1) { selm = selp[32 * w + r]; orm = selm;
#pragma unroll
        for (int o = 1; o < 32; o <<= 1) orm |= shxu(orm, o); }
    const int nv = (MODE == 3) ? (qrow >= 31 ? ((qrow - 15) >> 4) : 0) : 0;
    const int nv_wmax = (MODE == 3) ? (qw_last >= 31 ? ((qw_last - 15) >> 4) : 0) : 0;
    int kt_lo = 0, kt_hi;
    if (MODE == 0 || MODE == 1) kt_hi = (q0 >> 6) + 4;
    else if (MODE == 2) { kt_hi = (q0 >> 6) + 4; const int lk = q0 - 511; kt_lo = lk > 0 ? (lk >> 6) : 0; }
    else kt_hi = 2;
    if (MODE != 3) { const int kmin = q0 - dcut; const int lo2 = kmin > 0 ? (kmin >> 6) : 0; kt_lo = lo2 > kt_lo ? lo2 : kt_lo; }
    f32x16 cb[2];
#pragma unroll
    for (int kk = 0; kk < 2; ++kk)
#pragma unroll
        for (int i = 0; i < 16; ++i) cb[kk][i] = (MODE == 3) ? 0.f : slope * (float)(32 * kk + 8 * (i >> 2) + (i & 3) + 4 * hh);
    f32x16 O[NRB];
#pragma unroll
    for (int rb = 0; rb < NRB; ++rb)
#pragma unroll
        for (int i = 0; i < 16; ++i) O[rb][i] = 0.f;
    float mrun = NEGF, lrun = 0.f;
    const int drow = tid >> 3, dpc = (tid & 7) ^ ((drow >> 1) & 7);
    const unsigned ldsw = (unsigned)w * 1024u;
#define AT_DMA(buf, sub, kt) do { const int kt_ = (kt) < 0 ? 0 : (kt); LAS unsigned char* b_ = lds + (buf) * BUF_B; \
        __builtin_amdgcn_global_load_lds((const unsigned*)(Kp + (size_t)(64 * kt_ + drow) * ldk + 8 * dpc), (LAS unsigned*)(b_ + (sub) * KT_B + ldsw), 16, 0, 0); \
        _Pragma("unroll") for (int i_ = 0; i_ < (DV + 63) / 64; ++i_) { if (64 * i_ + 64 <= DV || w < 4) \
            __builtin_amdgcn_global_load_lds((const unsigned*)(Vt + (size_t)(drow + 64 * i_) * ldvt + 64 * kt_ + 8 * dpc), (LAS unsigned*)(b_ + 2 * KT_B + (sub) * VT_B + i_ * 8192 + ldsw), 16, 0, 0); } } while (0)
    const int ntile = kt_hi - kt_lo, nstep = (ntile + 1) >> 1;
    AT_DMA(0, 0, kt_hi - 1); AT_DMA(0, 1, kt_hi - 2);
    asm volatile("s_waitcnt vmcnt(0)" ::: "memory");
    __syncthreads();
#if PROBE_ATT == 2
    AT_DMA(0, 0, kt_hi - 1); AT_DMA(0, 1, kt_hi - 2);
    asm volatile("s_waitcnt vmcnt(0)" ::: "memory");
    __syncthreads();
#endif
    const int sw = (r >> 1) & 7;
    for (int st = 0; st < nstep; ++st) {
        const int buf = st & 1;
        if (st + 1 < nstep) { AT_DMA(buf ^ 1, 0, kt_hi - 3 - 2 * st); AT_DMA(buf ^ 1, 1, kt_hi - 4 - 2 * st); }
#pragma unroll
        for (int sub = 0; sub < 2; ++sub) {
        const int kt = kt_hi - 1 - 2 * st - sub, key0 = 64 * kt;
        bool skip;
        if (MODE == 0) skip = key0 > qw_last;
        else if (MODE == 1) skip = (key0 > qw_last) || !((orm >> (kt & 31)) & 1u);
        else if (MODE == 2) skip = (key0 > qw_last) || (key0 + 63 < qw_first - 511);
        else skip = key0 >= nv_wmax;
        skip = skip || (kt < kt_lo);
        if (!skip) {
            const LAS unsigned char* kb = lds + buf * BUF_B + sub * KT_B; const LAS unsigned char* vb = lds + buf * BUF_B + 2 * KT_B + sub * VT_B;
            f32x16 S[2];
#pragma unroll
            for (int kk = 0; kk < 2; ++kk) {
                S[kk] = cb[kk];
#pragma unroll
                for (int ks = 0; ks < 4; ++ks) { const bf16x8 a = *(const LAS bf16x8*)(kb + (32 * kk + r) * 128 + (((2 * ks + hh) ^ sw) << 4));
                    S[kk] = __builtin_amdgcn_mfma_f32_32x32x16_bf16(a, qf[ks], S[kk], 0, 0, 0); }
            }
            const bool bnd = (MODE == 3) ? true : ((key0 + 63 > qw_first) || (MODE == 2 && key0 < qw_last - 511));
            if (bnd) {
                const int lim = (MODE == 3) ? (nv - key0 - 4 * hh) : (qrow - key0 - 4 * hh);
#pragma unroll
                for (int kk = 0; kk < 2; ++kk)
#pragma unroll
                    for (int i = 0; i < 16; ++i) { const int cki = 32 * kk + 8 * (i >> 2) + (i & 3);
                        bool valid;
                        if (MODE == 3) valid = cki < lim; else if (MODE == 2) valid = (cki <= lim) && (cki > lim - 512); else valid = cki <= lim;
                        S[kk][i] = valid ? S[kk][i] : NEGF; }
            }
            float mx = NEGF;
#pragma unroll
            for (int kk = 0; kk < 2; ++kk)
#pragma unroll
                for (int i = 0; i < 16; ++i) mx = fmaxf(mx, S[kk][i]);
            mx = fmaxf(mx, shx(mx, 32));
            const float off = (MODE == 3) ? 0.f : slope * (float)key0;
            mx += off;
            bool selok = true;
            if (MODE == 1) { selok = ((selm >> (kt & 31)) & 1u) != 0u; mx = selok ? mx : NEGF; }
            const float mnew = fmaxf(mrun, mx);
            const float meff = (mnew < -1e29f) ? 0.f : mnew;
            float c = (off - meff) * LOG2E;
            if (MODE == 1) c = selok ? c : NEGF;
            float ps = 0.f;
#pragma unroll
            for (int kk = 0; kk < 2; ++kk)
#pragma unroll
                for (int i = 0; i < 16; ++i) { const float p = __builtin_amdgcn_exp2f(__builtin_fmaf(S[kk][i], LOG2E, c)); S[kk][i] = p; ps += p; }
            if (__any(mnew > mrun)) {
                const float alpha = __builtin_amdgcn_exp2f((mrun - mnew) * LOG2E);
                lrun *= alpha;
#pragma unroll
                for (int rb = 0; rb < NRB; ++rb)
#pragma unroll
                    for (int i = 0; i < 16; ++i) O[rb][i] *= alpha;
            }
            mrun = mnew; lrun += ps;
#pragma unroll
            for (int kk = 0; kk < 2; ++kk)
#pragma unroll
                for (int s2 = 0; s2 < 2; ++s2) {
                    u32x4 pw; pw.x = pk2(S[kk][8 * s2 + 0], S[kk][8 * s2 + 1]); pw.y = pk2(S[kk][8 * s2 + 2], S[kk][8 * s2 + 3]);
                    pw.z = pk2(S[kk][8 * s2 + 4], S[kk][8 * s2 + 5]); pw.w = pk2(S[kk][8 * s2 + 6], S[kk][8 * s2 + 7]);
                    const bf16x8 pf = __builtin_bit_cast(bf16x8, pw);
#pragma unroll
                    for (int rb = 0; rb < NRB; ++rb) {
                        const bf16x8 a = *(const LAS bf16x8*)(vb + (32 * rb + r) * 128 + ((((2 * kk + s2) * 2 + hh) ^ sw) << 4));
                        O[rb] = __builtin_amdgcn_mfma_f32_32x32x16_bf16(a, pf, O[rb], 0, 0, 0);
                    }
                }
        }
        }
        asm volatile("s_waitcnt vmcnt(0)" ::: "memory");
        __syncthreads();
    }
#undef AT_DMA
    const float ltot = lrun + shx(lrun, 32);
    float inv = 1.0f / ltot;
    if (MODE == 3) inv = (nv > 0) ? inv : 0.f;
#if PROBE_ATT == 1
    for (int rep_ = 0; rep_ < 2; ++rep_) { asm volatile("" ::: "memory");
#endif
#pragma unroll
    for (int rb = 0; rb < NRB; ++rb)
#pragma unroll
        for (int g4 = 0; g4 < 4; ++g4) {
            const float a = O[rb][4 * g4] * inv, b = O[rb][4 * g4 + 1] * inv, c = O[rb][4 * g4 + 2] * inv, d = O[rb][4 * g4 + 3] * inv;
            const int dv = 32 * rb + 8 * g4 + 4 * hh;
            if (MODE == 3 && rb == 2) { *(f32x4*)(impp + (size_t)(32 * w + r) * 256 + (dv - 64)) = (f32x4){a, b, c, d}; }
            else { u32x2 o; o.x = pk2(a, b); o.y = pk2(c, d); *(u32x2*)(Op + (size_t)(32 * w + r) * ldo + dv) = o; }
        }
#if PROBE_ATT == 1
    }
#endif
}

struct Args { const float* in[26]; float* out; unsigned char* ws; int ph_lo, ph_hi; };
typedef const __attribute__((address_space(4))) Args* ArgsP;
DI ArgsP opaque_args() { auto p = __builtin_amdgcn_kernarg_segment_ptr(); asm volatile("" : "+s"(p)); return (ArgsP)p; }
enum { I_X = 0, I_P, I_N1G, I_N2G, I_EVWIN, I_EVWOUT, I_DAQN, I_DAKN, I_DALAM, I_DAOUTG, I_NSQN, I_NSKN, I_CMPPE, I_CMPW1, I_CMPW2, I_ODWIN, I_ODWOUT,
       I_RETG, I_ROUTW, I_ROUTB, I_WGU, I_BGU, I_WDN, I_BDN, I_PLEP, I_PLEG };

struct CvtJob { int in_idx, ldsrc, K, col0, ncols, dstrow0, perm, nmat; size_t src_stride, dst_off, dst_stride; int fp8, pad; };
constexpr int NJOBS = 19;
__constant__ CvtJob c_jobs[NJOBS] = {
    {I_EVWIN, EVIN, 1024, 0,    1024, 0,    1, 2, (size_t)1024 * EVIN, WS_EVNAT, (size_t)2048 * 1024, 0, 0},
    {I_EVWIN, EVIN, 1024, 1536, 512,  1024, 1, 2, (size_t)1024 * EVIN, WS_EVNAT, (size_t)2048 * 1024, 0, 0},
    {I_EVWIN, EVIN, 1024, 2048, 128,  1536, 1, 2, (size_t)1024 * EVIN, WS_EVNAT, (size_t)2048 * 1024, 0, 0},
    {I_EVWIN, EVIN, 1024, 2176, 128,  1664, 1, 2, (size_t)1024 * EVIN, WS_EVNAT, (size_t)2048 * 1024, 0, 0},
    {I_EVWIN, EVIN, 1024, 2304, 128,  1792, 1, 2, (size_t)1024 * EVIN, WS_EVNAT, (size_t)2048 * 1024, 0, 0},
    {I_EVWIN, EVIN, 1024, 2560, 128,  1920, 1, 2, (size_t)1024 * EVIN, WS_EVNAT, (size_t)2048 * 1024, 0, 0},
    {I_EVWIN, EVIN, 1024, 1024, 512,  0,    0, 2, (size_t)1024 * EVIN, WS_EVSW,  (size_t)768 * 1024, 0, 0},
    {I_EVWIN, EVIN, 1024, 2432, 128,  512,  0, 2, (size_t)1024 * EVIN, WS_EVSW,  (size_t)768 * 1024, 0, 0},
    {I_EVWIN, EVIN, 1024, 2688, 128,  640,  0, 2, (size_t)1024 * EVIN, WS_EVSW,  (size_t)768 * 1024, 0, 0},
    {I_EVWOUT, 1024, 1024, 0, 1024, 0, 0, 2, (size_t)1024 * 1024, WS_EVOUT, (size_t)1024 * 1024, 0, 0},
    {I_CMPW1, 256, 2048, 0, 256, 0, 0, 4, (size_t)2048 * 256, WS_CMP1, (size_t)256 * 2048, 0, 0},
    {I_ODWIN, ODIN, 1024, 0,    2048, 0,    0, 2, (size_t)1024 * ODIN, WS_ODNAT, (size_t)4096 * 1024, 0, 0},
    {I_ODWIN, ODIN, 1024, 4096, 2048, 2048, 0, 2, (size_t)1024 * ODIN, WS_ODNAT, (size_t)4096 * 1024, 0, 0},
    {I_ODWIN, ODIN, 1024, 2048, 2048, 0,    0, 2, (size_t)1024 * ODIN, WS_ODSW,  (size_t)2048 * 1024, 0, 0},
    {I_ODWOUT, 1024, 2048, 0, 1024, 0, 0, 2, (size_t)2048 * 1024, WS_ODOUT, (size_t)1024 * 2048, 0, 0},
    {I_WGU, 2048, 1024, 0, 2048, 0, 2, 128, (size_t)1024 * 2048, WS_WGU, (size_t)2048 * 1024, 32, 0},
    {I_WDN, 1024, 1024, 0, 1024, 0, 0, 128, (size_t)1024 * 1024, WS_WDN, (size_t)1024 * 1024, 64, 0},
    {I_PLEP, 1024, 256, 0, 1024, 0, 0, 4, (size_t)256 * 1024, WS_WPP, (size_t)1024 * 256, 0, 0},
    {I_PLEG, 1024, 1024, 0, 1024, 0, 0, 4, (size_t)1024 * 1024, WS_WPG, (size_t)1024 * 1024, 32, 0},
};
DI int cvt_dstrow(int perm, int L) {
    if (perm == 1) { const int pn = L >> 8, lc = L & 255; return pn * 256 + 128 * ((lc & 63) >> 5) + 32 * (lc >> 6) + (lc & 31); }
    if (perm == 2) { const int bj = L >> 10, cc = L & 1023; return 256 * (cc >> 7) + 128 * bj + (cc & 127); }
    return L;
}
DI void phase_prologue(const int WID, ArgsP a, LAS unsigned char* lds) {
    const int tid = opaque_tid(WID), lane = tid & 63, wv = tid >> 6;
    const int gw = blockIdx.x * 8 + wv, NGW = gridDim.x * 8;
    LAS float* scr = (LAS float*)(lds + wv * 16896);
    int total = 0;
    for (int j = 0; j < NJOBS; ++j) total += c_jobs[j].nmat * (c_jobs[j].K >> 6) * (c_jobs[j].ncols >> 6);
#define PRO_DECODE(IT, JJ, MAT, K0, N0, SRC, RS) do { int r_ = (IT), j_ = 0; \
        for (; j_ < NJOBS; ++j_) { const int n_ = c_jobs[j_].nmat * (c_jobs[j_].K >> 6) * (c_jobs[j_].ncols >> 6); if (r_ < n_) break; r_ -= n_; } \
        JJ = j_; const bool f8_ = c_jobs[j_].fp8 != 0; const int nkb_ = f8_ ? (c_jobs[j_].K >> 7) : (c_jobs[j_].K >> 6), nnb_ = f8_ ? (c_jobs[j_].ncols >> 5) : (c_jobs[j_].ncols >> 6), per_ = nkb_ * nnb_; \
        MAT = r_ / per_; const int rr_ = r_ % per_; K0 = (rr_ / nnb_) * (f8_ ? 128 : 64); N0 = (rr_ % nnb_) * (f8_ ? 32 : 64); const int ld_ = c_jobs[j_].ldsrc; \
        SRC = a->in[c_jobs[j_].in_idx] + (size_t)MAT * c_jobs[j_].src_stride + (size_t)K0 * ld_ + c_jobs[j_].col0 + N0 + (f8_ ? (lane & 31) + (lane >> 5) * ld_ : lane); RS = f8_ ? 2 * ld_ : ld_; } while (0)
    float tv[64];
    int jn = 0, matn = 0, k0n = 0, n0n = 0, rsn = 0; const float* srcn = nullptr;
    if (gw < total) { PRO_DECODE(gw, jn, matn, k0n, n0n, srcn, rsn);
#pragma unroll
        for (int i = 0; i < 64; ++i) tv[i] = srcn[(size_t)i * rsn]; }
    for (int it = gw; it < total; it += NGW) {
        const CvtJob J = c_jobs[jn]; const int mat = matn, k0 = k0n, n0 = n0n;
        { const int wb = J.fp8 ? (lane >> 5) * 33 + (lane & 31) : lane, wst = J.fp8 ? 66 : 65;
#pragma unroll
          for (int i = 0; i < 64; ++i) scr[wb + i * wst] = tv[i]; }
        if (it + NGW < total) { PRO_DECODE(it + NGW, jn, matn, k0n, n0n, srcn, rsn);
#if PROBE_PRO == 2
            { float sink = 0.f;
#pragma unroll
              for (int i = 0; i < 64; ++i) sink += ((const volatile float*)srcn)[(size_t)i * rsn];
              asm volatile("" :: "v"(sink)); }
#endif
#pragma unroll
            for (int i = 0; i < 64; ++i) tv[i] = srcn[(size_t)i * rsn]; }
        asm volatile("s_waitcnt lgkmcnt(0)" ::: "memory");
        if (J.fp8) {
            unsigned char* dst = (unsigned char*)(a->ws + J.dst_off) + (size_t)mat * J.dst_stride;
            const int c = lane & 7, nsub = lane >> 3; const float W8_S = (float)J.fp8;
#pragma unroll
            for (int jj = 0; jj < 4; ++jj) {
                const int n = nsub + 8 * jj; const LAS float* s = scr + (16 * c) * 33 + n;
                u32x4 o;
                o.x = pk4_fp8(s[0] * W8_S, s[33] * W8_S, s[2 * 33] * W8_S, s[3 * 33] * W8_S); o.y = pk4_fp8(s[4 * 33] * W8_S, s[5 * 33] * W8_S, s[6 * 33] * W8_S, s[7 * 33] * W8_S);
                o.z = pk4_fp8(s[8 * 33] * W8_S, s[9 * 33] * W8_S, s[10 * 33] * W8_S, s[11 * 33] * W8_S); o.w = pk4_fp8(s[12 * 33] * W8_S, s[13 * 33] * W8_S, s[14 * 33] * W8_S, s[15 * 33] * W8_S);
                const int drow = cvt_dstrow(J.perm, J.dstrow0 + n0 + n);
                *(u32x4*)(dst + (size_t)drow * J.K + k0 + 16 * c) = o;
#if PROBE_PRO == 1
                asm volatile("" ::: "memory"); *(u32x4*)(dst + (size_t)drow * J.K + k0 + 16 * c) = o;
#endif
            }
        } else {
            bf16_t* dst = (bf16_t*)(a->ws + J.dst_off) + (size_t)mat * J.dst_stride;
            const int c = lane & 7, nsub = lane >> 3;
#pragma unroll
            for (int jj = 0; jj < 8; ++jj) {
                const int n = nsub + 8 * jj; const LAS float* s = scr + (8 * c) * 65 + n;
                u32x4 o; o.x = pk2(s[0], s[65]); o.y = pk2(s[2 * 65], s[3 * 65]); o.z = pk2(s[4 * 65], s[5 * 65]); o.w = pk2(s[6 * 65], s[7 * 65]);
                const int drow = cvt_dstrow(J.perm, J.dstrow0 + n0 + n);
                *(u32x4*)(dst + (size_t)drow * J.K + k0 + 8 * c) = o;
#if PROBE_PRO == 1
                asm volatile("" ::: "memory"); *(u32x4*)(dst + (size_t)drow * J.K + k0 + 8 * c) = o;
#endif
            }
        }
        asm volatile("s_waitcnt lgkmcnt(0)" ::: "memory");
    }
#undef PRO_DECODE
    {
        const float* p = a->in[I_P]; bf16_t* pb = (bf16_t*)(a->ws + WS_PBF);
        const size_t n8 = (size_t)DEPTH * T * 256 / 8;
        for (size_t i = (size_t)blockIdx.x * 512 + tid; i < n8; i += (size_t)gridDim.x * 512) {
            const f32x4 v0 = *(const f32x4*)(p + i * 8), v1 = *(const f32x4*)(p + i * 8 + 4);
            *(u32x4*)(pb + i * 8) = pack8(v0, v1);
        }
    }
    if (blockIdx.x == 4 && tid < 512) { const int ev = tid >> 8, gi = (tid >> 6) & 3, d = tid & 63;
        const float* src = a->in[gi == 0 ? I_DAQN : gi == 1 ? I_DAKN : gi == 2 ? I_NSQN : I_NSKN];
        ((float*)(a->ws + WS_GAINS))[tid] = src[ev * 64 + d]; }
    if (blockIdx.x < 4 && tid < 256) {
        const int m = blockIdx.x; const float* pe = a->in[I_CMPPE] + (size_t)m * 2048; const float* w1 = a->in[I_CMPW1] + (size_t)m * 2048 * 256;
        float s = 0.f;
        for (int k = 0; k < 2048; ++k) s += pe[k] * w1[(size_t)k * 256 + tid];
        ((float*)(a->ws + WS_BIAS1))[m * 256 + tid] = s;
    }
}

DI float row_load_ss(const float* row, int lane, f32x4 (&v)[4]) {
    float ss = 0.f;
#pragma unroll
    for (int j = 0; j < 4; ++j) { v[j] = *(const f32x4*)(row + 4 * lane + 256 * j); ss += (v[j][0] * v[j][0] + v[j][1] * v[j][1]) + (v[j][2] * v[j][2] + v[j][3] * v[j][3]); }
    return wave_sum(ss);
}
DI void row_store_bf16(bf16_t* row, int lane, const f32x4 (&v)[4]) {
#pragma unroll
    for (int j = 0; j < 4; ++j) { u32x2 o; o.x = pk2(v[j][0], v[j][1]); o.y = pk2(v[j][2], v[j][3]); *(u32x2*)(row + 4 * lane + 256 * j) = o; }
}
template <int MODE>
DI void phase_norm(const int WID, ArgsP a, LAS unsigned char* lds, int layer, const void* Hin, const bool hb) {
    const int tid = opaque_tid(WID), lane = tid & 63, wv = __builtin_amdgcn_readfirstlane(tid >> 6);
    LAS float* wt = (LAS float*)lds;
    LAS int* bcl = (LAS int*)(lds + MISC_OFF + MO_WCNT); LAS int* ent = (LAS int*)(lds + MISC_OFF + MO_ENT); LAS float* gat = (LAS float*)(lds + MISC_OFF + MO_GAT);
    LAS float* lgb = (LAS float*)(lds + MISC_OFF + MO_RED);
    bf16_t* XN = (bf16_t*)(a->ws + WS_XN);
    const float* gain = a->in[MODE == 2 ? I_N2G : I_N1G] + layer * 1024;
    constexpr int NQ = MODE == 0 ? 24 : (MODE == 2 ? 32 : 0);
    if (NQ > 0) {
        const float* w = (MODE == 0) ? a->in[I_EVWIN] + (size_t)(layer >> 1) * 1024 * EVIN + 2816 : a->in[I_ROUTW] + (size_t)layer * 1024 * 32;
        const int ldw = (MODE == 0) ? EVIN : 32;
        for (int i = tid; i < 256 * 32; i += 512) { const int q = i & 31, g = i >> 5;
            if (q < NQ) { f32x4 v; v[0] = w[(size_t)(4 * g) * ldw + q]; v[1] = w[(size_t)(4 * g + 1) * ldw + q]; v[2] = w[(size_t)(4 * g + 2) * ldw + q]; v[3] = w[(size_t)(4 * g + 3) * ldw + q];
                *(LAS f32x4*)(wt + q * 1024 + 4 * (g ^ q)) = v; } }
    }
    f32x4 gn[4];
#pragma unroll
    for (int j = 0; j < 4; ++j) gn[j] = *(const f32x4*)(gain + 4 * lane + 256 * j);
    const float rbias = (MODE == 2) ? a->in[I_ROUTB][layer * 32 + (lane & 31)] : 0.f;
    __syncthreads();
    for (int vb = blockIdx.x; vb < NTB; vb += gridDim.x) {
        if (MODE == 2) { if (tid < 32) bcl[tid] = 0; }
        const int t0 = vb * 128 + wv * 16;
        f32x4 na[4], nb[4];
#pragma unroll
        for (int j = 0; j < 4; ++j) { na[j] = ld_h4(Hin, hb, (size_t)t0 * 1024 + 4 * lane + 256 * j); nb[j] = ld_h4(Hin, hb, (size_t)(t0 + 1) * 1024 + 4 * lane + 256 * j); }
#pragma unroll 1
        for (int it = 0; it < 8; ++it) {
            const int ta = t0 + 2 * it;
            f32x4 va[4], vc[4];
#pragma unroll
            for (int j = 0; j < 4; ++j) { va[j] = na[j]; vc[j] = nb[j]; }
            if (it < 7) {
#pragma unroll
                for (int j = 0; j < 4; ++j) { na[j] = ld_h4(Hin, hb, (size_t)(ta + 2) * 1024 + 4 * lane + 256 * j); nb[j] = ld_h4(Hin, hb, (size_t)(ta + 3) * 1024 + 4 * lane + 256 * j); }
            }
            float sa = 0.f, sb = 0.f;
#pragma unroll
            for (int j = 0; j < 4; ++j) { sa += (va[j][0] * va[j][0] + va[j][1] * va[j][1]) + (va[j][2] * va[j][2] + va[j][3] * va[j][3]); sb += (vc[j][0] * vc[j][0] + vc[j][1] * vc[j][1]) + (vc[j][2] * vc[j][2] + vc[j][3] * vc[j][3]); }
#pragma unroll
            for (int o = 1; o < 64; o <<= 1) { sa += shx(sa, o); sb += shx(sb, o); }
            const float ra = rsqrtf(sa * (1.0f / 1024.0f) + EPS), rb2 = rsqrtf(sb * (1.0f / 1024.0f) + EPS);
#pragma unroll
            for (int j = 0; j < 4; ++j) { va[j] = va[j] * ra * gn[j]; vc[j] = vc[j] * rb2 * gn[j]; }
            row_store_bf16(XN + (size_t)ta * 1024, lane, va); row_store_bf16(XN + (size_t)(ta + 1) * 1024, lane, vc);
            if (NQ > 0) {
                float x[64];
#pragma unroll
                for (int q = 0; q < 32; ++q) {
                    if (q < NQ) { float s0 = 0.f, s1 = 0.f;
#pragma unroll
                        for (int j = 0; j < 4; ++j) { const f32x4 ww = *(const LAS f32x4*)(wt + q * 1024 + 4 * ((lane + 64 * j) ^ q));
                            s0 += (va[j][0] * ww[0] + va[j][1] * ww[1]) + (va[j][2] * ww[2] + va[j][3] * ww[3]); s1 += (vc[j][0] * ww[0] + vc[j][1] * ww[1]) + (vc[j][2] * ww[2] + vc[j][3] * ww[3]); }
                        x[q] = s0; x[32 + q] = s1;
                        if ((q & 3) == 3) asm volatile("" ::: "memory");
                    } else { x[q] = 0.f; x[32 + q] = 0.f; }
                }
#define RS_STEP(N, BIT) _Pragma("unroll") for (int i = 0; i < (N); ++i) { const bool up = (lane & (BIT)) != 0; const float keep = up ? x[(N) + i] : x[i], send = up ? x[i] : x[(N) + i]; x[i] = keep + shx(send, (BIT)); }
                RS_STEP(32, 32) RS_STEP(16, 16) RS_STEP(8, 8) RS_STEP(4, 4) RS_STEP(2, 2) RS_STEP(1, 1)
#undef RS_STEP
                const float val = x[0];
                if (MODE == 0) { if ((lane & 31) < 24) ((float*)(a->ws + WS_GATES))[(size_t)(ta + (lane >> 5)) * 24 + (lane & 31)] = sigm(val); }
                if (MODE == 2) {
                    lgb[wv * 64 + lane] = val + rbias;
                    asm volatile("s_waitcnt lgkmcnt(0)" ::: "memory");
                    float lg[32];
#pragma unroll
                    for (int q4 = 0; q4 < 8; ++q4) { const f32x4 t4 = *(const LAS f32x4*)(lgb + wv * 64 + (lane & 32) + 4 * q4); lg[4 * q4] = t4[0]; lg[4 * q4 + 1] = t4[1]; lg[4 * q4 + 2] = t4[2]; lg[4 * q4 + 3] = t4[3]; }
                    unsigned used = 0u; int te[4]; float tv[4];
#pragma unroll
                    for (int k = 0; k < 4; ++k) { float best = -3.0e38f; int bi = 0;
#pragma unroll
                        for (int q = 0; q < 32; ++q) { const bool ok = !((used >> q) & 1u) && (lg[q] > best); best = ok ? lg[q] : best; bi = ok ? q : bi; }
                        used |= 1u << bi; te[k] = bi; tv[k] = best; }
                    float ex[4], sum = 0.f;
#pragma unroll
                    for (int k = 0; k < 4; ++k) { ex[k] = __expf(tv[k] - tv[0]); sum += ex[k]; }
                    const float rs = 1.0f / sum;
                    if ((lane & 31) == 0) {
                        const int eb = wv * 64 + (2 * it + (lane >> 5)) * 4;
#pragma unroll
                        for (int k = 0; k < 4; ++k) { ent[eb + k] = te[k]; gat[eb + k] = ex[k] * rs; }
                    }
                    asm volatile("s_waitcnt lgkmcnt(0)" ::: "memory");
                }
            }
        }
        if (MODE == 2) {
            __syncthreads();
            { const int e = ent[wv * 64 + lane];
              const int pos = __hip_atomic_fetch_add(bcl + e, 1, __ATOMIC_RELAXED, __HIP_MEMORY_SCOPE_WORKGROUP);
              const size_t idx = (size_t)(vb * 128 + wv * 16) * 4 + lane;
              ((int*)(a->ws + WS_TOPE))[idx] = e; ((int*)(a->ws + WS_POSB))[idx] = pos; ((float*)(a->ws + WS_GATEW))[idx] = gat[wv * 64 + lane]; }
            __syncthreads();
            if (tid < 32) ((int*)(a->ws + WS_BCNT))[((size_t)layer * NTB + vb) * 32 + tid] = bcl[tid];
            __syncthreads();
        }
    }
}
DI void moe_tables(const int WID, ArgsP a, LAS unsigned char* lds, int layer, int vb) {
    const int tid = opaque_tid(WID);
    LAS int* tot = (LAS int*)(lds + MISC_OFF + MO_TOT); LAS int* base = (LAS int*)(lds + MISC_OFF + MO_BASE); LAS int* ts = (LAS int*)(lds + MISC_OFF + MO_TS);
    LAS int* red = (LAS int*)(lds + MISC_OFF + MO_RED);
    const int* bc = (const int*)(a->ws + WS_BCNT) + (size_t)layer * NTB * 32;
    { const int e = tid & 31, part = tid >> 5; int st = 0, sp = 0;
      for (int blk = part; blk < NTB; blk += 16) { const int v = bc[blk * 32 + e]; st += v; sp += (blk < vb) ? v : 0; }
      red[part * 32 + e] = st; red[512 + part * 32 + e] = sp; }
    __syncthreads();
    if (tid < 32) { int st = 0, sp = 0;
#pragma unroll
        for (int p = 0; p < 16; ++p) { st += red[p * 32 + tid]; sp += red[512 + p * 32 + tid]; }
        tot[tid] = st; base[tid] = sp; }
    __syncthreads();
    if (tid == 0) { int acc = 0; for (int e = 0; e < 32; ++e) { ts[e] = acc; acc += (tot[e] + 255) >> 8; } ts[32] = acc; }
    __syncthreads();
}
DI void phase_moe_slots(const int WID, ArgsP a, LAS unsigned char* lds, int layer) {
    const int tid = opaque_tid(WID), lane = tid & 63, wv = tid >> 6;
    LAS int* base = (LAS int*)(lds + MISC_OFF + MO_BASE); LAS int* ts = (LAS int*)(lds + MISC_OFF + MO_TS);
    const bf16_t* XN = (const bf16_t*)(a->ws + WS_XN); unsigned char* XB = (unsigned char*)(a->ws + WS_XB);
    for (int vb = blockIdx.x; vb < NTB; vb += gridDim.x) {
        moe_tables(WID, a, lds, layer, vb);
#pragma unroll 1
        for (int i = 0; i < 16; ++i) {
            const int t = vb * 128 + wv * 16 + i;
            int dest = 0;
            if (lane < 4) { const int e = ((const int*)(a->ws + WS_TOPE))[(size_t)t * 4 + lane], pos = ((const int*)(a->ws + WS_POSB))[(size_t)t * 4 + lane];
                dest = ts[e] * 256 + base[e] + pos; ((int*)(a->ws + WS_DEST))[(size_t)t * 4 + lane] = dest; }
            const u32x4 r0 = *(const u32x4*)(XN + (size_t)t * 1024 + 8 * lane), r1 = *(const u32x4*)(XN + (size_t)t * 1024 + 512 + 8 * lane);
            u32x2 q0, q1;
            q0.x = pk4_fp8(bflo(r0.x), bfhi(r0.x), bflo(r0.y), bfhi(r0.y)); q0.y = pk4_fp8(bflo(r0.z), bfhi(r0.z), bflo(r0.w), bfhi(r0.w));
            q1.x = pk4_fp8(bflo(r1.x), bfhi(r1.x), bflo(r1.y), bfhi(r1.y)); q1.y = pk4_fp8(bflo(r1.z), bfhi(r1.z), bflo(r1.w), bfhi(r1.w));
#pragma unroll
            for (int k = 0; k < 4; ++k) { const int d = __builtin_amdgcn_readlane(dest, k); unsigned char* o = XB + (size_t)d * 1024; *(u32x2*)(o + 8 * lane) = q0; *(u32x2*)(o + 512 + 8 * lane) = q1; }
        }
        __syncthreads();
    }
}
DI void phase_combine(const int WID, ArgsP a, bf16_t* H) {
    const int tid = opaque_tid(WID), lane = tid & 63, wv = tid >> 6;
    const bf16_t* YB = (const bf16_t*)(a->ws + WS_YB); unsigned char* XN8 = (unsigned char*)(a->ws + WS_XN);
    for (int t = blockIdx.x * 8 + wv; t < T; t += gridDim.x * 8) {
        int dest = 0; float gw = 0.f;
        if (lane < 4) { dest = ((const int*)(a->ws + WS_DEST))[(size_t)t * 4 + lane]; gw = ((const float*)(a->ws + WS_GATEW))[(size_t)t * 4 + lane]; }
        f32x4 v[4];
#pragma unroll
        for (int j = 0; j < 4; ++j) v[j] = ld_h4(H, true, (size_t)t * 1024 + 4 * lane + 256 * j);
#pragma unroll
        for (int k = 0; k < 4; ++k) { const int d = __builtin_amdgcn_readlane(dest, k); const float g = __builtin_bit_cast(float, __builtin_amdgcn_readlane(__builtin_bit_cast(int, gw), k)); const bf16_t* y = YB + (size_t)d * 1024;
#pragma unroll
            for (int j = 0; j < 4; ++j) { const u32x2 w = *(const u32x2*)(y + 4 * lane + 256 * j); v[j][0] += g * bflo(w.x); v[j][1] += g * bfhi(w.x); v[j][2] += g * bflo(w.y); v[j][3] += g * bfhi(w.y); } }
        float ss = 0.f;
#pragma unroll
        for (int j = 0; j < 4; ++j) { u32x2 hw; hw.x = pk2(v[j][0], v[j][1]); hw.y = pk2(v[j][2], v[j][3]); *(u32x2*)(H + (size_t)t * 1024 + 4 * lane + 256 * j) = hw; ss += (v[j][0] * v[j][0] + v[j][1] * v[j][1]) + (v[j][2] * v[j][2] + v[j][3] * v[j][3]); }
        ss = wave_sum(ss);
        const float rstd = rsqrtf(ss * (1.0f / 1024.0f) + EPS);
#pragma unroll
        for (int j = 0; j < 4; ++j) v[j] = v[j] * rstd;
#pragma unroll
        for (int j = 0; j < 4; ++j) *(unsigned*)(XN8 + (size_t)t * 1024 + 4 * lane + 256 * j) = pk4_fp8(v[j][0], v[j][1], v[j][2], v[j][3]);
    }
}
DI void phase_cmp2(const int WID, ArgsP a, LAS unsigned char* lds, int ev) {
    const int tid = opaque_tid(WID), lane = tid & 63, wv = __builtin_amdgcn_readfirstlane(tid >> 6);
    const bf16_t* HID = (const bf16_t*)(a->ws + WS_HID); bf16_t* KCMP = (bf16_t*)(a->ws + WS_KCMP); bf16_t* VCMPT = (bf16_t*)(a->ws + WS_VCMPT);
    const float kg = a->in[I_NSKN][ev * 64 + lane];
    LAS float* wl = (LAS float*)lds;
    for (int i = tid; i < 2 * 256 * 64 / 4; i += 512) *(LAS f32x4*)(wl + 4 * i) = *(const f32x4*)(a->in[I_CMPW2] + (size_t)ev * 2 * 256 * 64 + 4 * i);
    __syncthreads();
    for (int gi = blockIdx.x * 8 + wv; gi < 2048; gi += gridDim.x * 8) {
        const int kv = gi >> 10, row0 = (gi & 1023) * 4;
        const bf16_t* hrow = HID + ((size_t)kv * 4096 + row0) * 256;
        const LAS float* w2 = wl + kv * 256 * 64 + lane;
        float s[4] = {0.f, 0.f, 0.f, 0.f};
#pragma unroll 2
        for (int k = 0; k < 256; k += 8) {
            u32x4 hw[4];
#pragma unroll
            for (int r = 0; r < 4; ++r) hw[r] = *(const u32x4*)(hrow + r * 256 + k);
            float wv8[8];
#pragma unroll
            for (int j = 0; j < 8; ++j) wv8[j] = w2[(k + j) * 64];
#pragma unroll
            for (int r = 0; r < 4; ++r)
                s[r] += bflo(hw[r].x) * wv8[0] + bfhi(hw[r].x) * wv8[1] + bflo(hw[r].y) * wv8[2] + bfhi(hw[r].y) * wv8[3] + bflo(hw[r].z) * wv8[4] + bfhi(hw[r].z) * wv8[5] + bflo(hw[r].w) * wv8[6] + bfhi(hw[r].w) * wv8[7];
        }
#pragma unroll
        for (int r = 0; r < 4; ++r) {
            const int row = row0 + r, bg = row >> 7, n = row & 127;
            float v = (n == 127) ? 0.f : s[r];
            if (kv == 0) { const float ss = wave_sum(v * v); const float o = v * rsqrtf(ss * (1.0f / 64.0f) + EPS) * kg;
                KCMP[((size_t)bg * 128 + n) * 64 + lane] = (bf16_t)(pk2(o, 0.f) & 0xffffu); }
            else VCMPT[((size_t)bg * 96 + lane) * 128 + vperm16(n)] = (bf16_t)(pk2(v, 0.f) & 0xffffu);
        }
    }
    for (int i = blockIdx.x * 512 + tid; i < 32 * 32 * 128; i += gridDim.x * 512) {
        const int n = i & 127, j = (i >> 7) & 31, bg = i >> 12;
        float o = 0.f;
        if (n < 127) { const int d = n - 4 * j; if (d >= 0 && d <= 2) o = 1.0f; else if (d == 3 || d == -1) o = 0.5f; }
        VCMPT[((size_t)bg * 96 + 64 + j) * 128 + vperm16(n)] = (bf16_t)(pk2(o, 0.f) & 0xffffu);
    }
}
DI void topk_one(const float* IMPH, unsigned* SELM, int t, int g) {
    const int b = t >> 11, s = t & 2047, cur = s >> 6;
    unsigned mask;
    if (cur < 16) mask = (2u << cur) - 1u;
    else {
        float sc[32];
#pragma unroll
        for (int j4 = 0; j4 < 8; ++j4) { f32x4 acc = {0.f, 0.f, 0.f, 0.f};
#pragma unroll
            for (int r = 0; r < 4; ++r) acc += *(const f32x4*)(IMPH + ((size_t)t * 8 + g * 4 + r) * 32 + 4 * j4);
#pragma unroll
            for (int q = 0; q < 4; ++q) sc[4 * j4 + q] = acc[q]; }
#pragma unroll
        for (int j = 0; j < 32; ++j) { const bool forced = (j == 0) || (j == cur) || (j == cur - 1); sc[j] = (j > cur) ? NEGF : (sc[j] + (forced ? 1e4f : 0.f)); }
        mask = 0u;
#pragma unroll
        for (int j = 0; j < 32; ++j) { int rank = 0;
#pragma unroll
            for (int k = 0; k < 32; ++k) rank += ((sc[k] > sc[j]) || (sc[k] == sc[j] && k < j)) ? 1 : 0;
            mask |= (rank < 16) ? (1u << j) : 0u; }
    }
    SELM[((size_t)(b * 2 + g)) * 2048 + s] = mask;
}
DI void phase_topk(const int WID, ArgsP a) {
    for (int i = blockIdx.x * 512 + opaque_tid(WID); i < T * 2; i += gridDim.x * 512) topk_one((const float*)(a->ws + WS_IMPH), (unsigned*)(a->ws + WS_SELM), i >> 1, i & 1);
}
DI void phase_cmp_topk(const int WID, ArgsP a, LAS unsigned char* lds) {
    const bf16_t* QN = (const bf16_t*)(a->ws + WS_QN);
    float* IMPH = (float*)(a->ws + WS_IMPH);
    for (int u = blockIdx.x; u < 256; u += gridDim.x) {
        const int qb = 7 - (u >> 5), bg = u & 31, b = bg >> 1, g = bg & 1, q0 = qb * 256; const size_t t0 = (size_t)b * 2048 + q0;
#pragma unroll 1
        for (int r = 0; r < 4; ++r) { const int hd = g * 4 + r;
            attn_unit<96, 3>(WID, lds, QN + t0 * 512 + hd * 64, 512, (const bf16_t*)(a->ws + WS_KCMP) + (size_t)bg * 128 * 64, 64,
                             (const bf16_t*)(a->ws + WS_VCMPT) + (size_t)bg * 96 * 128, 128, q0, 0.f, 0, nullptr,
                             (bf16_t*)(a->ws + WS_OC) + t0 * 512 + hd * 64, 512, IMPH + (t0 * 8 + hd) * 32); }
        asm volatile("s_waitcnt vmcnt(0)" ::: "memory");
        __syncthreads();
        { const int tid = opaque_tid(WID); if (tid < 256) topk_one(IMPH, (unsigned*)(a->ws + WS_SELM), (int)t0 + tid, g); }
        __syncthreads();
    }
}
DI void phase_mixprep(const int WID, ArgsP a, int layer) {
    const int tid = opaque_tid(WID), lane = tid & 63, wv = tid >> 6, ev = layer >> 1;
    const float* dl = a->in[I_DALAM] + ev * 256;
    const float s1 = wave_sum(dl[lane] * dl[64 + lane]), s2 = wave_sum(dl[128 + lane] * dl[192 + lane]);
    const float lam_init = 0.8f - 0.6f * expf(-0.3f * (float)layer);
    const float lam = expf(s1) - expf(s2) + lam_init;
    const float* og = a->in[I_DAOUTG] + ev * 128;
    const bf16_t* OD = (const bf16_t*)(a->ws + WS_OD); const bf16_t* OC = (const bf16_t*)(a->ws + WS_OC); const bf16_t* OS = (const bf16_t*)(a->ws + WS_OS); const bf16_t* OW = (const bf16_t*)(a->ws + WS_OW);
    const float* GT = (const float*)(a->ws + WS_GATES); bf16_t* AMIX = (bf16_t*)(a->ws + WS_AMIX);
    const int h = lane >> 4, dv = (lane & 15) * 8;
    f32x4 g0 = *(const f32x4*)(og + dv), g1 = *(const f32x4*)(og + dv + 4);
    for (int t = blockIdx.x * 8 + wv; t < T; t += gridDim.x * 8) {
        { const u32x4 w1 = *(const u32x4*)(OD + (size_t)t * 1024 + h * 128 + dv), w2 = *(const u32x4*)(OD + (size_t)t * 1024 + (4 + h) * 128 + dv);
          f32x4 d0, d1;
          d0[0] = bflo(w1.x) - lam * bflo(w2.x); d0[1] = bfhi(w1.x) - lam * bfhi(w2.x); d0[2] = bflo(w1.y) - lam * bflo(w2.y); d0[3] = bfhi(w1.y) - lam * bfhi(w2.y);
          d1[0] = bflo(w1.z) - lam * bflo(w2.z); d1[1] = bfhi(w1.z) - lam * bfhi(w2.z); d1[2] = bflo(w1.w) - lam * bflo(w2.w); d1[3] = bfhi(w1.w) - lam * bfhi(w2.w);
          float ss = (d0[0] * d0[0] + d0[1] * d0[1]) + (d0[2] * d0[2] + d0[3] * d0[3]) + (d1[0] * d1[0] + d1[1] * d1[1]) + (d1[2] * d1[2] + d1[3] * d1[3]);
          ss += shx(ss, 1); ss += shx(ss, 2); ss += shx(ss, 4); ss += shx(ss, 8);
          const float rs = rsqrtf(ss * (1.0f / 128.0f) + EPS) * (1.0f - lam_init);
          *(u32x4*)(AMIX + (size_t)t * 1024 + h * 128 + dv) = pack8(d0 * rs * g0, d1 * rs * g1); }
        { const int hd = lane >> 3, dq = (lane & 7) * 8; const size_t o = (size_t)t * 512 + hd * 64 + dq;
          const float ga = GT[(size_t)t * 24 + hd * 3], gb = GT[(size_t)t * 24 + hd * 3 + 1], gc = GT[(size_t)t * 24 + hd * 3 + 2];
          const u32x4 c = *(const u32x4*)(OC + o), s = *(const u32x4*)(OS + o), w = *(const u32x4*)(OW + o);
          f32x4 r0, r1;
          r0[0] = ga * bflo(c.x) + gb * bflo(s.x) + gc * bflo(w.x); r0[1] = ga * bfhi(c.x) + gb * bfhi(s.x) + gc * bfhi(w.x);
          r0[2] = ga * bflo(c.y) + gb * bflo(s.y) + gc * bflo(w.y); r0[3] = ga * bfhi(c.y) + gb * bfhi(s.y) + gc * bfhi(w.y);
          r1[0] = ga * bflo(c.z) + gb * bflo(s.z) + gc * bflo(w.z); r1[1] = ga * bfhi(c.z) + gb * bfhi(s.z) + gc * bfhi(w.z);
          r1[2] = ga * bflo(c.w) + gb * bflo(s.w) + gc * bflo(w.w); r1[3] = ga * bfhi(c.w) + gb * bfhi(s.w) + gc * bfhi(w.w);
          *(u32x4*)(AMIX + (size_t)t * 1024 + 512 + hd * 64 + dq) = pack8(r0, r1); }
    }
}
DI void phase_scan(const int WID, ArgsP a) {
    const bf16_t* UT = (const bf16_t*)(a->ws + WS_UT); bf16_t* VS = (bf16_t*)(a->ws + WS_VS);
    for (int i = blockIdx.x * 512 + opaque_tid(WID); i < 64 * 512 * 32; i += gridDim.x * 512) {
        const int d8 = i & 31, f = (i >> 5) & 511, bh = i >> 14, h = bh & 3;
        const float dec = exp2f(256.0f * ret_lg2(h));
        f32x4 S0 = {0.f, 0.f, 0.f, 0.f}, S1 = S0;
        u32x4 un = *(const u32x4*)(UT + ((size_t)bh * 8) * 131072 + (size_t)f * 256 + 8 * d8);
#pragma unroll 1
        for (int n = 0; n < 8; ++n) {
            const size_t z = (size_t)bh * 8 + n;
            const u32x4 u = un;
            if (n < 7) un = *(const u32x4*)(UT + (z + 1) * 131072 + (size_t)f * 256 + 8 * d8);
            *(u32x4*)(VS + (z * 512 + f) * 512 + 256 + 8 * d8) = pack8(S0, S1);
            S0[0] = (S0[0] + bflo(u.x)) * dec; S0[1] = (S0[1] + bfhi(u.x)) * dec; S0[2] = (S0[2] + bflo(u.y)) * dec; S0[3] = (S0[3] + bfhi(u.y)) * dec;
            S1[0] = (S1[0] + bflo(u.z)) * dec; S1[1] = (S1[1] + bfhi(u.z)) * dec; S1[2] = (S1[2] + bflo(u.w)) * dec; S1[3] = (S1[3] + bfhi(u.w)) * dec;
        }
    }
}
DI void phase_normgate(const int WID, ArgsP a, int od) {
    const int tid = opaque_tid(WID), lane = tid & 63, wv = tid >> 6;
    const bf16_t* Y = (const bf16_t*)(a->ws + WS_Y); const bf16_t* GG = (const bf16_t*)(a->ws + WS_GG); bf16_t* YG = (bf16_t*)(a->ws + WS_YG);
    const float* og = a->in[I_RETG] + od * 512;
    const f32x4 g0 = *(const f32x4*)(og + 8 * lane), g1 = *(const f32x4*)(og + 8 * lane + 4);
    for (int t = blockIdx.x * 8 + wv; t < T; t += gridDim.x * 8) {
#pragma unroll
        for (int h = 0; h < 4; ++h) {
            const size_t o = (size_t)t * 2048 + h * 512 + 8 * lane;
            const u32x4 yw = *(const u32x4*)(Y + o), gw = *(const u32x4*)(GG + o);
            f32x4 y0 = {bflo(yw.x), bfhi(yw.x), bflo(yw.y), bfhi(yw.y)}, y1 = {bflo(yw.z), bfhi(yw.z), bflo(yw.w), bfhi(yw.w)};
            const f32x4 q0 = {bflo(gw.x), bfhi(gw.x), bflo(gw.y), bfhi(gw.y)}, q1 = {bflo(gw.z), bfhi(gw.z), bflo(gw.w), bfhi(gw.w)};
            float ss = (y0[0] * y0[0] + y0[1] * y0[1]) + (y0[2] * y0[2] + y0[3] * y0[3]) + (y1[0] * y1[0] + y1[1] * y1[1]) + (y1[2] * y1[2] + y1[3] * y1[3]);
            ss = wave_sum(ss);
            const float rs = rsqrtf(ss * (1.0f / 512.0f) + EPS);
            *(u32x4*)(YG + o) = pack8(y0 * rs * g0 * q0, y1 * rs * g1 * q1);
        }
    }
}
DI int snake_unit(int rnd, int G, int c) { return (rnd & 1) ? rnd * G + (G - 1 - c) : rnd * G + c; }
DI float absmax64(const float* g, int lane) { float m = fabsf(g[lane]);
#pragma unroll
    for (int o = 1; o < 64; o <<= 1) m = fmaxf(m, shx(m, o));
    return m; }
constexpr int CW_AQ = 8192;
template <int MODE>
DI void phase_attn(const int WID, ArgsP a, LAS unsigned char* lds, int ev) {
    const int tid = opaque_tid(WID), lane = tid & 63;
    const bf16_t* QD = (const bf16_t*)(a->ws + WS_QD); const bf16_t* KD = (const bf16_t*)(a->ws + WS_KD); const bf16_t* QN = (const bf16_t*)(a->ws + WS_QN);
    LAS int* ord = (LAS int*)(lds + MISC_OFF + MO_ENT); LAS int* cst = (LAS int*)(lds + MISC_OFF + MO_GAT); volatile LAS int* cur = (volatile LAS int*)(lds + MISC_OFF + MO_TOT);
    float sb2 = 0.f;
    if (MODE != 3) { const float gq = absmax64(a->in[MODE == 0 ? I_DAQN : I_NSQN] + ev * 64, lane), gk = absmax64(a->in[MODE == 0 ? I_DAKN : I_NSKN] + ev * 64, lane);
        sb2 = 16.0f * gq * gk + 28.0f; }
    if (tid < 64) { const int qb = tid >> 3, hd = tid & 7, q0 = qb * 256; int lo = 0, hi = 4 * qb + 4;
        if (MODE == 3) { lo = 0; hi = 2; }
        else { const float slope = (MODE == 0) ? exp2f(-2.0f * (float)((hd & 3) + 1)) : exp2f(-(float)(hd + 1)); const int dcut = (int)fminf(sb2 / slope + 1.0f, 100000.0f);
            const int kmin = q0 - dcut; lo = kmin > 0 ? (kmin >> 6) : 0;
            if (MODE == 2) { const int lk = q0 - 511; const int lw = lk > 0 ? (lk >> 6) : 0; lo = lw > lo ? lw : lo; } }
        cst[tid] = hi - lo; }
    __syncthreads();
    if (tid < 64) { const int mine = cst[tid]; int rank = 0;
        for (int j = 0; j < 64; ++j) { const int o = cst[j]; rank += (o > mine || (o == mine && j < tid)) ? 1 : 0; }
        ord[rank] = tid; }
    __syncthreads();
    unsigned* ctr = (unsigned*)(a->ws + WS_CTL) + CW_AQ + 64 * 8 * (ev * 4 + MODE);
    const int x0 = (int)(xb_xcc_id() & 7u);
    volatile LAS int* stl = (volatile LAS int*)(lds + MISC_OFF + MO_BASE);
    bool own = true; int nst = 0;
    for (;;) {
        if (tid < 64) {
            int uu_ = -1;
            if (own) { int v = 128; if (lane == 0) v = (int)__hip_atomic_fetch_add(ctr + 64 * x0, 1u, __ATOMIC_RELAXED, __HIP_MEMORY_SCOPE_AGENT);
                v = __builtin_amdgcn_readfirstlane(v); if (v < 128) uu_ = x0 * 128 + v; else own = false; }
            if (!own && uu_ < 0) {
                if (nst == 0) { int v = 128; const int xq_ = (x0 + lane) & 7;
                    if (lane >= 1 && lane < 8) v = (int)__hip_atomic_fetch_add(ctr + 64 * xq_, 1u, __ATOMIC_RELAXED, __HIP_MEMORY_SCOPE_AGENT);
                    const unsigned long long got = __ballot(v < 128); nst = __popcll(got);
                    if (v < 128) stl[__popcll(got & ((1ull << lane) - 1ull))] = xq_ * 128 + v;
                    asm volatile("s_waitcnt lgkmcnt(0)" ::: "memory"); }
                if (nst > 0) { --nst; uu_ = stl[nst]; }
            }
            if (lane == 0) *cur = uu_;
        }
        __syncthreads();
        const int uu = *cur; if (uu < 0) break;
        const int xq = uu >> 7, v = uu & 127, combo = ord[v >> 1], jb = v & 1, qb = combo >> 3, hd = combo & 7, q0 = qb * 256;
        const int b = (MODE == 0) ? (((xq - 2 * (hd & 3)) & 7) + 8 * jb) : (((xq - 4 * (hd >> 2)) & 7) + 8 * jb);
        const size_t t0 = (size_t)b * 2048 + q0;
        if (MODE == 0) {
            const float slope = exp2f(-2.0f * (float)((hd & 3) + 1)); const int dcut = (int)fminf(sb2 / slope + 1.0f, 100000.0f);
            attn_unit<128, 0>(WID, lds, QD + t0 * 512 + hd * 64, 512, KD + (size_t)b * 2048 * 512 + hd * 64, 512,
                              (const bf16_t*)(a->ws + WS_VAT) + (size_t)(b * 4 + (hd & 3)) * 128 * 2048, 2048, q0, slope, dcut, nullptr,
                              (bf16_t*)(a->ws + WS_OD) + t0 * 1024 + hd * 128, 1024, nullptr);
        } else if (MODE == 1 || MODE == 2) {
            const int g = hd >> 2; const float slope = exp2f(-(float)(hd + 1)); const int dcut = (int)fminf(sb2 / slope + 1.0f, 100000.0f);
            const bf16_t* Kb = (const bf16_t*)(a->ws + (MODE == 1 ? WS_KSB : WS_KWB)) + (size_t)(b * 2 + g) * 2048 * 64;
            const bf16_t* Vb = (const bf16_t*)(a->ws + (MODE == 1 ? WS_VST : WS_VWT)) + (size_t)(b * 2 + g) * 64 * 2048;
            attn_unit<64, MODE>(WID, lds, QN + t0 * 512 + hd * 64, 512, Kb, 64, Vb, 2048, q0, slope, dcut,
                                (const unsigned*)(a->ws + WS_SELM) + (size_t)(b * 2 + g) * 2048 + q0,
                                (bf16_t*)(a->ws + (MODE == 1 ? WS_OS : WS_OW)) + t0 * 512 + hd * 64, 512, nullptr);
        } else {
            const int g = hd >> 2;
            attn_unit<96, 3>(WID, lds, QN + t0 * 512 + hd * 64, 512, (const bf16_t*)(a->ws + WS_KCMP) + (size_t)(b * 2 + g) * 128 * 64, 64,
                             (const bf16_t*)(a->ws + WS_VCMPT) + (size_t)(b * 2 + g) * 96 * 128, 128, q0, 0.f, 0, nullptr,
                             (bf16_t*)(a->ws + WS_OC) + t0 * 512 + hd * 64, 512, (float*)(a->ws + WS_IMPH) + (t0 * 8 + hd) * 32);
        }
    }
}

constexpr int PPL = 15;
constexpr int NPHASE = 1 + DEPTH * PPL;
__global__ void __launch_bounds__(512, 2) mk_fwd(Args a_unused) {
    ArgsP a = opaque_args();
    extern __shared__ __attribute__((aligned(16))) unsigned char lds_raw[];
    LAS unsigned char* lds = (LAS unsigned char*)lds_raw;
    const int tid = threadIdx.x, G = gridDim.x, c = blockIdx.x;
    const int WID = __builtin_amdgcn_readfirstlane(tid >> 6);
    volatile LAS unsigned* misc = (volatile LAS unsigned*)(lds + MISC_OFF);
    if (tid < 4) misc[tid] = 0u;
    __syncthreads();
    unsigned* ctl = (unsigned*)(a->ws + WS_CTL);
    XcdBarrier bar; bar.bar = ctl + CW_BAR; bar.x = 0; bar.st = misc;
    const int ph_lo = a->ph_lo, ph_hi = a->ph_hi;
    const bool multi = (ph_hi - ph_lo) > 1;
    if (multi) bar = xcd_barrier_post(WID, ctl + CW_BAR, misc);
    bool first = true;
#define PHASE_BEGIN(k, id) if ((DBG_ONLY < 0 || DBG_ONLY == (id)) && (k) >= ph_lo && (k) < ph_hi && (k) <= DBG_LAST_PHASE) { if (!first) { xcd_barrier(WID, bar); if (PROBE_MASK >> 31) xcd_barrier(WID, bar); } first = false; \
        ArgsP a = opaque_args(); unsigned char* ws = a->ws; bf16_t* XN = (bf16_t*)(ws + WS_XN); bf16_t* H = (bf16_t*)(ws + WS_HB); const bool hb = layer != 0; const void* Hin = hb ? (const void*)H : (const void*)a->in[I_X]; \
        const LAS int* ts = (const LAS int*)(lds + MISC_OFF + MO_TS); (void)XN; (void)H; (void)Hin; (void)ts; (void)hb; \
        const bool probe_ = ((PROBE_MASK >> (id)) & 1u) != 0u; const unsigned long long pt0_ = probe_ ? __builtin_amdgcn_s_memrealtime() : 0ull;
#define PHASE_END if (probe_) { const unsigned long long pt1_ = __builtin_amdgcn_s_memrealtime(), pd_ = pt1_ - pt0_; while (__builtin_amdgcn_s_memrealtime() - pt1_ < pd_) __builtin_amdgcn_s_sleep(8); } }
    { const int layer = 0; PHASE_BEGIN(0, 0) phase_prologue(WID, a, lds); PHASE_END }
#pragma unroll 1
    for (int layer = 0; layer < DEPTH; ++layer) {
        const int pb = 1 + layer * PPL; const bool even = (layer & 1) == 0; const int ev = layer >> 1, od = layer >> 1;
        if (even) {
            PHASE_BEGIN(pb + 0, 1) phase_norm<0>(WID, a, lds, layer, Hin, hb); PHASE_END
            PHASE_BEGIN(pb + 1, 2) {
                { ProbPlain P{XN, (const bf16_t*)(ws + WS_EVNAT) + (size_t)ev * 2048 * 1024, 1024, 1024, 1024}; pg8::Sched S; S.init(T / 256, 8, G, c);
                  EpiEvNat E{ws, (const float*)(ws + WS_GAINS) + ev * 256};
                  pg8::gemm_phase(WID, lds, P, S, E); }
                { ProbPlain P{(const bf16_t*)(ws + WS_EVSW) + (size_t)ev * 768 * 1024, XN, 1024, 1024, 1024}; pg8::Sched S; S.init(3, T / 256, G, c);
                  EpiEvSw E{ws};
                  pg8::gemm_phase(WID, lds, P, S, E); }
            } PHASE_END
            PHASE_BEGIN(pb + 2, 3) {
                { ProbCmp1 P{(const bf16_t*)(ws + WS_KCB), (const bf16_t*)(ws + WS_VCB), (const bf16_t*)(ws + WS_CMP1) + (size_t)ev * 2 * 256 * 2048, 1024, 2048, 2048}; pg8::Sched S; S.init(32, 1, G, c);
                  EpiCmp1 E{(bf16_t*)(ws + WS_HID), (const float*)(ws + WS_BIAS1) + ev * 512};
                  pg8::gemm_phase(WID, lds, P, S, E); }
                phase_attn<0>(WID, a, lds, ev);
                phase_attn<2>(WID, a, lds, ev);
            } PHASE_END
            PHASE_BEGIN(pb + 3, 4) phase_cmp2(WID, a, lds, ev); PHASE_END
            PHASE_BEGIN(pb + 4, 5) phase_attn<3>(WID, a, lds, ev); PHASE_END
            PHASE_BEGIN(pb + 5, 6) phase_topk(WID, a); PHASE_END
            PHASE_BEGIN(pb + 6, 7) phase_attn<1>(WID, a, lds, ev); PHASE_END
            PHASE_BEGIN(pb + 7, 8) phase_mixprep(WID, a, layer); PHASE_END
            PHASE_BEGIN(pb + 8, 9) {
                ProbPlain P{(const bf16_t*)(ws + WS_AMIX), (const bf16_t*)(ws + WS_EVOUT) + (size_t)ev * 1024 * 1024, 1024, 1024, 1024}; pg8::Sched S; S.init(T / 256, 4, G, c);
                EpiResid E{Hin, H, hb}; pg8::gemm_phase(WID, lds, P, S, E);
            } PHASE_END
        } else {
            PHASE_BEGIN(pb + 0, 11) phase_norm<1>(WID, a, lds, layer, Hin, hb); PHASE_END
            PHASE_BEGIN(pb + 1, 12) {
                { ProbPlain P{XN, (const bf16_t*)(ws + WS_ODNAT) + (size_t)od * 4096 * 1024, 1024, 1024, 1024}; pg8::Sched S; S.init(T / 256, 16, G, c);
                  EpiOdNat E{ws}; pg8::gemm_phase(WID, lds, P, S, E); }
                { ProbPlain P{(const bf16_t*)(ws + WS_ODSW) + (size_t)od * 2048 * 1024, XN, 1024, 1024, 1024}; pg8::Sched S; S.init(8, T / 256, G, c);
                  EpiOdSw E{ws}; pg8::gemm_phase(WID, lds, P, S, E); }
            } PHASE_END
            PHASE_BEGIN(pb + 2, 13) {
                { ProbUT P{(const bf16_t*)(ws + WS_VS), (const bf16_t*)(ws + WS_KT), 512, 256, 256}; SchedSeq S; S.init(G, c);
                  EpiUTScan E{(bf16_t*)(ws + WS_VS)}; pg8::gemm_phase(WID, lds, P, S, E); }
                { ProbAtt P{(const bf16_t*)(ws + WS_AQ), (const bf16_t*)(ws + WS_KP), 2048, 1024, 256}; pg8::Sched S; const int nb = G / 2 > 0 ? G / 2 : 1;
                  if (c >= nb || G < 2) S.init(512, 1, G < 2 ? 1 : G - nb, G < 2 ? 0 : c - nb); else S.init(0, 1, 1, 0);
                  EpiAtt E{(bf16_t*)(ws + WS_AQ)}; pg8::gemm_phase(WID, lds, P, S, E); }
            } PHASE_END
            PHASE_BEGIN(pb + 4, 15) {
                ProbY P{(const bf16_t*)(ws + WS_AQ), (const bf16_t*)(ws + WS_VS), 2048, 512, 512}; pg8::Sched S; S.init(512, 2, G, c);
                EpiY E{(bf16_t*)(ws + WS_Y)}; pg8::gemm_phase(WID, lds, P, S, E);
            } PHASE_END
            PHASE_BEGIN(pb + 5, 16) phase_normgate(WID, a, od); PHASE_END
            PHASE_BEGIN(pb + 8, 19) {
                ProbPlain P{(const bf16_t*)(ws + WS_YG), (const bf16_t*)(ws + WS_ODOUT) + (size_t)od * 1024 * 2048, 2048, 2048, 2048}; pg8::Sched S; S.init(T / 256, 4, G, c);
                EpiResid E{Hin, H, hb}; pg8::gemm_phase(WID, lds, P, S, E);
            } PHASE_END
        }
        PHASE_BEGIN(pb + 9, 20) phase_norm<2>(WID, a, lds, layer, H, true); PHASE_END
        PHASE_BEGIN(pb + 10, 21) phase_moe_slots(WID, a, lds, layer); PHASE_END
        PHASE_BEGIN(pb + 11, 22) {
            moe_tables(WID, a, lds, layer, -1);
            { ProbMoe8 P{(const unsigned char*)(ws + WS_XB), (const unsigned char*)(ws + WS_WGU) + (size_t)layer * 32 * 2048 * 1024, ts, 2048, 512, 512, 512}; pg8::Sched S; S.init(ts[32], 8, G, c);
              EpiGU E{(unsigned char*)(ws + WS_ACT), a->in[I_BGU] + (size_t)layer * 32 * 2048, ts}; pg8::gemm_phase(WID, lds, P, S, E); }
            { ProbPlain P{(const bf16_t*)(ws + WS_PBF) + (size_t)layer * T * 256, (const bf16_t*)(ws + WS_WPP) + (size_t)layer * 1024 * 256, 256, 256, 256}; pg8::Sched S; S.init(T / 256, 4, G, c);
              EpiPP E{(bf16_t*)(ws + WS_PP)}; pg8::gemm_phase(WID, lds, P, S, E); }
        } PHASE_END
        PHASE_BEGIN(pb + 12, 23) {
            moe_tables(WID, a, lds, layer, -1);
            ProbMoe8 P{(const unsigned char*)(ws + WS_ACT), (const unsigned char*)(ws + WS_WDN) + (size_t)layer * 32 * 1024 * 1024, ts, 1024, 512, 512, 512}; pg8::Sched S; S.init(ts[32], 4, G, c);
            EpiDN E{(bf16_t*)(ws + WS_YB), a->in[I_BDN] + (size_t)layer * 32 * 1024, ts}; pg8::gemm_phase(WID, lds, P, S, E);
        } PHASE_END
        PHASE_BEGIN(pb + 13, 24) phase_combine(WID, a, H); PHASE_END
        PHASE_BEGIN(pb + 14, 25) {
            ProbPlain8 P{(const unsigned char*)(ws + WS_XN), (const unsigned char*)(ws + WS_WPG) + (size_t)layer * 1024 * 1024, 512, 512, 512}; pg8::Sched S; S.init(T / 256, 4, G, c);
            EpiPLE E{H, (const bf16_t*)(ws + WS_PP), (layer == DEPTH - 1) ? a->out : nullptr}; pg8::gemm_phase(WID, lds, P, S, E);
        } PHASE_END
    }
#undef PHASE_BEGIN
#undef PHASE_END
}

extern "C" void kernel_launch(void* const* d_in, const int* in_sizes, int n_in, void* d_out, int out_size, void* d_ws, size_t ws_size, hipStream_t stream) {
    static int grid = 0;
    if (grid == 0) {
        if (n_in != 26 || out_size != T * D || ws_size < WS_END) { fprintf(stderr, "kernel_launch: unexpected problem (n_in %d, out %d, ws %zu < %zu); nothing launched\n", n_in, out_size, ws_size, (size_t)WS_END); grid = -1; return; }
        int dev = 0, cus = 0, per_cu = 0;
        if (hipGetDevice(&dev) != hipSuccess || hipDeviceGetAttribute(&cus, hipDeviceAttributeMultiprocessorCount, dev) != hipSuccess) { grid = -1; return; }
        if (hipFuncSetAttribute((const void*)mk_fwd, hipFuncAttributeMaxDynamicSharedMemorySize, LDS_BYTES) != hipSuccess) { fprintf(stderr, "kernel_launch: hipFuncSetAttribute failed\n"); grid = -1; return; }
        if (hipOccupancyMaxActiveBlocksPerMultiprocessor(&per_cu, (const void*)mk_fwd, 512, LDS_BYTES) != hipSuccess || per_cu < 1) fprintf(stderr, "kernel_launch: occupancy query reports %d\n", per_cu);
        (void)hipGetLastError();
        grid = cus > 256 ? 256 : cus;
    }
    if (grid < 0) return;
    (void)hipMemsetAsync((char*)d_ws + WS_CTL, 0, CTL_BYTES, stream);
    Args a; memset(&a, 0, sizeof(a));
    for (int i = 0; i < 26; ++i) a.in[i] = (const float*)d_in[i];
    a.out = (float*)d_out; a.ws = (unsigned char*)d_ws;
#if MK_SINGLE
    a.ph_lo = 0; a.ph_hi = NPHASE;
    hipLaunchKernelGGL(mk_fwd, dim3(grid), dim3(512), LDS_BYTES, stream, a);
#else
    for (int ph = 0; ph < NPHASE && ph <= DBG_LAST_PHASE; ++ph) {
        const int l = (ph - 1) / PPL, k = (ph - 1) % PPL;
        if (ph > 0 && (l & 1) && (k == 6 || k == 7)) continue;
        a.ph_lo = ph; a.ph_hi = ph + 1;
        hipLaunchKernelGGL(mk_fwd, dim3(grid), dim3(512), LDS_BYTES, stream, a);
    }
#endif
}
```

```cpp
#include <hip/hip_runtime.h>
#include <cstdio>
#include <cstdint>
#include <cstring>

#define LAS __attribute__((address_space(3)))
#define DI __device__ __forceinline__
typedef unsigned short bf16_t;
typedef short bf16x8 __attribute__((ext_vector_type(8)));
typedef short s16x4 __attribute__((ext_vector_type(4)));
typedef float f32x2 __attribute__((ext_vector_type(2)));
typedef float f32x4 __attribute__((ext_vector_type(4)));
typedef float f32x16 __attribute__((ext_vector_type(16)));
typedef unsigned u32x2 __attribute__((ext_vector_type(2)));
typedef unsigned u32x4 __attribute__((ext_vector_type(4)));
typedef __bf16 bfv2 __attribute__((ext_vector_type(2)));
typedef int i32x4 __attribute__((ext_vector_type(4)));
typedef int i32x8 __attribute__((ext_vector_type(8)));

#ifndef MK_SINGLE
#define MK_SINGLE 1
#endif
#ifndef DBG_ONLY
#define DBG_ONLY -1
#endif
#ifndef PROBE_MASK
#define PROBE_MASK 0u
#endif
#ifndef PROBE_ATT
#define PROBE_ATT 0
#endif
#ifndef PROBE_EPI2
#define PROBE_EPI2 0
#endif
#ifndef PROBE_PRO
#define PROBE_PRO 0
#endif
#ifndef PROBE_KREP
#define PROBE_KREP 1
#endif
#ifndef DBG_LAST_PHASE
#define DBG_LAST_PHASE 100000
#endif

constexpr int T = 32768, D = 1024, SEQ = 2048, NBATCH = 16, DEPTH = 4;
constexpr int EVIN = 2840, ODIN = 6144;
constexpr float EPS = 1e-6f, NEGF = -1e30f;
constexpr int NTB = 256;
constexpr int MOE_ROWS = (512 + 32) * 256;

constexpr size_t MiB = 1u << 20;
constexpr size_t WS_CTL = 0, CTL_BYTES = 1 * MiB;
constexpr int CW_BAR = 4096;
constexpr size_t WS_EVNAT = 2 * MiB, WS_EVSW = 10 * MiB, WS_EVOUT = 13 * MiB, WS_CMP1 = 17 * MiB, WS_ODNAT = 21 * MiB, WS_ODSW = 37 * MiB,
                 WS_ODOUT = 49 * MiB, WS_WPP = 57 * MiB, WS_WPG = 59 * MiB, WS_BIAS1 = 67 * MiB, WS_GAINS = 67 * MiB + 16384, WS_BCNT = 67 * MiB + 65536,
                 WS_WGU = 68 * MiB, WS_WDN = 580 * MiB;
constexpr size_t WS_XN = 840 * MiB, WS_PBF = 904 * MiB, WS_PP = 968 * MiB, WS_GATES = 1032 * MiB, WS_TOPE = 1035 * MiB, WS_POSB = 1036 * MiB,
                 WS_DEST = 1037 * MiB, WS_GATEW = 1038 * MiB, WS_SELM = 1039 * MiB;
constexpr size_t RA = 1040 * MiB;
constexpr size_t WS_QD = RA, WS_KD = RA + 32 * MiB, WS_QN = RA + 64 * MiB, WS_KCB = RA + 96 * MiB, WS_VCB = RA + 105 * MiB, WS_KSB = RA + 114 * MiB,
                 WS_KWB = RA + 122 * MiB, WS_VAT = RA + 130 * MiB, WS_VST = RA + 162 * MiB, WS_VWT = RA + 170 * MiB, WS_HID = RA + 178 * MiB,
                 WS_KCMP = RA + 182 * MiB, WS_VCMPT = RA + 183 * MiB, WS_OC = RA + 184 * MiB, WS_IMPH = RA + 216 * MiB, WS_OD = RA + 248 * MiB,
                 WS_OS = RA + 312 * MiB, WS_OW = RA + 344 * MiB, WS_AMIX = RA + 376 * MiB;
constexpr size_t WS_AQ = RA, WS_KP = RA + 128 * MiB, WS_KT = RA + 192 * MiB, WS_VS = RA + 256 * MiB, WS_GG = RA + 512 * MiB, WS_UT = RA + 640 * MiB,
                 WS_Y = RA + 896 * MiB, WS_YG = RA + 1024 * MiB;
constexpr size_t WS_XB = 2192 * MiB, WS_ACT = 2464 * MiB, WS_YB = 2736 * MiB, WS_HB = 3008 * MiB, WS_END = 3072 * MiB;

constexpr int MISC_OFF = 139264, LDS_BYTES = 155648;
static_assert(MISC_OFF + 5888 + 4096 <= LDS_BYTES, "misc LDS words");
constexpr int MO_WCNT = 256, MO_ENT = 1280, MO_GAT = 3328, MO_TOT = 5376, MO_BASE = 5504, MO_TS = 5632, MO_RED = 5888;

DI int opaque_tid(int wid0) { int l; asm volatile("v_mbcnt_lo_u32_b32 %0, -1, 0\n\tv_mbcnt_hi_u32_b32 %0, -1, %0" : "=v"(l) :: "memory"); return (wid0 << 6) | l; }
DI int lane_now() { int l; asm volatile("v_mbcnt_lo_u32_b32 %0, -1, 0\n\tv_mbcnt_hi_u32_b32 %0, -1, %0" : "=v"(l)); return l; }
DI float shx(float v, int m) { return __builtin_bit_cast(float, __builtin_amdgcn_ds_bpermute((lane_now() ^ m) << 2, __builtin_bit_cast(int, v))); }
DI float shxl(float v, int m, int lane) { return __builtin_bit_cast(float, __builtin_amdgcn_ds_bpermute((lane ^ m) << 2, __builtin_bit_cast(int, v))); }
DI unsigned shxu(unsigned v, int m) { return (unsigned)__builtin_amdgcn_ds_bpermute((lane_now() ^ m) << 2, (int)v); }
DI unsigned pk2(float lo, float hi) { f32x2 v = {lo, hi}; return __builtin_bit_cast(unsigned, __builtin_convertvector(v, bfv2)); }
DI unsigned pk4_fp8(float a, float b, float c, float d) { int w = 0; w = __builtin_amdgcn_cvt_pk_fp8_f32(a, b, w, false); w = __builtin_amdgcn_cvt_pk_fp8_f32(c, d, w, true); return (unsigned)w; }
DI float bf2f(unsigned short b) { return __uint_as_float(((unsigned)b) << 16); }
DI float bflo(unsigned w) { return __uint_as_float(w << 16); }
DI float bfhi(unsigned w) { return __uint_as_float(w & 0xffff0000u); }
DI float wave_sum(float v) {
#pragma unroll
    for (int o = 1; o < 64; o <<= 1) v += shx(v, o);
    return v;
}
DI float sigm(float x) { return __builtin_amdgcn_rcpf(1.0f + __builtin_amdgcn_exp2f(-1.44269504089f * x)); }
DI u32x4 pack8(const f32x4& a, const f32x4& b) { u32x4 w; w.x = pk2(a[0], a[1]); w.y = pk2(a[2], a[3]); w.z = pk2(b[0], b[1]); w.w = pk2(b[2], b[3]); return w; }
DI f32x4 ld_h4(const void* base, bool hb, size_t i) {
    if (hb) { const u32x2 w = *(const u32x2*)((const bf16_t*)base + i); return (f32x4){bflo(w.x), bfhi(w.x), bflo(w.y), bfhi(w.y)}; }
    return *(const f32x4*)((const float*)base + i);
}

#define XB_TMO      128
#define XB_XCNT(j)  (256  + 64 * (j))
#define XB_XSUB(j)  (1280 + 64 * (j))
#define XB_XGEN(j)  (2304 + 64 * (j))
#define XB_TOP      3328
#define XB_TOPGEN   3392
#define XCD_BAR_WORDS 3456
#define XB_SPIN_CAP (1u << 22)
DI unsigned xb_ld(unsigned* p)              { return __hip_atomic_load(p, __ATOMIC_RELAXED, __HIP_MEMORY_SCOPE_AGENT); }
DI unsigned xb_add(unsigned* p, unsigned v) { return __hip_atomic_fetch_add(p, v, __ATOMIC_RELAXED, __HIP_MEMORY_SCOPE_AGENT); }
DI unsigned xb_xcc_id() { return (unsigned)__builtin_amdgcn_s_getreg((3 << 11) | 20) & 0xFu; }
#define XB_SPIN(cond, bar) do { unsigned _sp = 0; while (cond) { __builtin_amdgcn_s_sleep(1); \
    if ((++_sp & 255u) == 0u) { if (xb_ld(&(bar)[XB_TMO])) break; if (_sp > XB_SPIN_CAP) { atomicAdd(&(bar)[XB_TMO], 1u); break; } } } } while (0)
struct XcdBarrier { unsigned* bar; unsigned x; volatile LAS unsigned* st; };
DI XcdBarrier xcd_barrier_post(const int WID, unsigned* bar, volatile LAS unsigned* st) {
    XcdBarrier b; b.bar = bar; b.x = xb_xcc_id(); b.st = st;
    if (opaque_tid(WID) == 0) (void)xb_add(&bar[XB_XCNT(b.x)], 1u);
    return b;
}
DI void xcd_barrier_complete(unsigned* bar, unsigned x, unsigned& nloc, unsigned& nx) {
    const unsigned G = gridDim.x * gridDim.y * gridDim.z;
    unsigned sum, cnt, mine, sp = 0u;
    for (;;) {
        sum = 0u; cnt = 0u; mine = 0u;
#pragma unroll
        for (unsigned j = 0; j < 16; ++j) { const unsigned c = xb_ld(&bar[XB_XCNT(j)]); sum += c; cnt += (c > 0u) ? 1u : 0u; mine = (j == x) ? c : mine; }
        if (sum == G) break;
        __builtin_amdgcn_s_sleep(1);
        if ((++sp & 255u) == 0u) { if (xb_ld(&bar[XB_TMO])) break; if (sp > XB_SPIN_CAP) { atomicAdd(&bar[XB_TMO], 1u); break; } }
    }
    nloc = mine > 0u ? mine : 1u; nx = cnt > 0u ? cnt : 1u;
}
DI void xcd_barrier(const int WID, const XcdBarrier& b) {
    asm volatile("s_waitcnt vmcnt(0)" ::: "memory");
    __syncthreads();
    if (opaque_tid(WID) == 0) {
        unsigned* bar = b.bar; asm volatile("" : "+s"(bar));
        __builtin_amdgcn_s_waitcnt(0);
        unsigned nloc = b.st[0], nx = b.st[1];
        if (nloc == 0u) { xcd_barrier_complete(bar, b.x, nloc, nx); b.st[0] = nloc; b.st[1] = nx; }
        const unsigned old = xb_add(&bar[XB_XSUB(b.x)], 1u);
        const unsigned gen = old / nloc;
        if (old + 1u == (gen + 1u) * nloc) {
            __builtin_amdgcn_fence(__ATOMIC_RELEASE, "agent");
            asm volatile("s_waitcnt vmcnt(0)" ::: "memory");
            const unsigned og = xb_add(&bar[XB_TOP], 1u);
            const unsigned tg = og / nx;
            if (og + 1u == (tg + 1u) * nx) xb_add(&bar[XB_TOPGEN], 1u);
            else XB_SPIN(xb_ld(&bar[XB_TOPGEN]) == tg, bar);
            __builtin_amdgcn_fence(__ATOMIC_ACQUIRE, "agent");
            xb_add(&bar[XB_XGEN(b.x)], 1u);
            asm volatile("s_waitcnt vmcnt(0)" ::: "memory");
        } else {
            XB_SPIN(xb_ld(&bar[XB_XGEN(b.x)]) == gen, bar);
            __builtin_amdgcn_fence(__ATOMIC_ACQUIRE, "agent");
            asm volatile("s_waitcnt vmcnt(0)" ::: "memory");
        }
    }
    __syncthreads();
}

namespace pg8 {
constexpr int BM = 256, BK = 64, HALF = 128, HTB = HALF * BK * 2, STAGE_BYTES = 8 * HTB, NXCD = 8, WGM = 8;
DI int lds_byte(int r, int c) { const int st = (r >> 4) * 2 + (c >> 5), rr = r & 15, cc = c & 31, ob = rr * 64 + cc * 2; return st * 1024 + (ob ^ (((ob >> 9) & 1) << 5)); }
DI void stage_rc(int b, int& R, int& C) { const int st = b / 1024, sb = b % 1024, swz = sb ^ (((sb >> 9) & 1) << 5); R = (st >> 1) * 16 + swz / 64; C = (st & 1) * 32 + (swz % 64) / 2; }
DI int perm32(int rho) { const int n = rho >> 4, i = rho & 15; return 8 * (i >> 2) + 4 * n + (i & 3); }
struct Unit { int pm, pn; };
struct Sched {
    int nM, nN, nwg, G, c;
    DI void init(int nM_, int nN_, int G_, int c_) { nM = nM_; nN = nN_; nwg = nM * nN; G = G_; c = c_; }
    DI bool next(int i, Unit& u) const {
        const long L = (long)i * G + c; if (L >= nwg) return false;
        int wgid = (int)L; { const int q = nwg / NXCD, r = nwg % NXCD, xcd = wgid % NXCD, off = wgid / NXCD; wgid = (xcd < r ? xcd * (q + 1) : r * (q + 1) + (xcd - r) * q) + off; }
        const int nig = WGM * nN, gid = wgid / nig, fm = gid * WGM, gsz = (nM - fm) < WGM ? (nM - fm) : WGM;
        u.pm = fm + ((wgid % nig) % gsz); u.pn = (wgid % nig) / gsz; return true;
    }
};
template <class Epi, class Prob, class SchedT>
DI void gemm_phase(const int WID, LAS unsigned char* lds, const Prob& P, const SchedT& S, const Epi& E) {
    const int tid = opaque_tid(WID), wid = __builtin_amdgcn_readfirstlane(tid >> 6), lane = tid & 63, wr = wid >> 2, wc = wid & 3, fr = lane & 15, fq = lane >> 4;
    const int K = P.K, nt = K / BK;
    constexpr int KREP = Epi::CARRY ? 1 : PROBE_KREP;
    unsigned voffA[2], voffB[2];
#pragma unroll
    for (int i = 0; i < 2; ++i) { int R, C; stage_rc(tid * 16 + i * 8192, R, C); const int Rb = Epi::PERM ? ((R & ~31) + perm32(R & 31)) : R;
        voffA[i] = (unsigned)(R * P.lda + C) * 2u; voffB[i] = (unsigned)(Rb * P.ldb + C) * 2u; }
    const size_t kstep = (size_t)(BK * 2);
    const size_t hstepA = (size_t)HALF * P.lda * 2, hstepB = (size_t)HALF * P.ldb * 2;
    const unsigned ldsw = (unsigned)wid * 1024u;
    const int aoff = lds_byte(wr * 64 + fr, fq * 8), boff = lds_byte(wc * 32 + fr, fq * 8);
#define PG8_SA(b, h) (((b) * 2 + (h)) * HTB)
#define PG8_SB(b, h) ((4 + (b) * 2 + (h)) * HTB)
#define PG8_STAGE(bufoff, gbase, voff) do { _Pragma("unroll") for (int _i = 0; _i < 2; ++_i) \
        __builtin_amdgcn_global_load_lds((const unsigned*)((const char*)(gbase) + (voff)[_i]), (LAS unsigned*)(lds + (bufoff) + ldsw + _i * 8192), 16, 0, 0); } while (0)
#define PG8_LD16(off) (*(const LAS i32x4*)(lds + (off)))
#define PG8_LDA(dst, b, h) do { _Pragma("unroll") for (int m = 0; m < 4; ++m) { const i32x4 lo_ = PG8_LD16(PG8_SA(b, h) + aoff + m * 2048), hi_ = PG8_LD16(PG8_SA(b, h) + aoff + m * 2048 + 1024); dst[m] = __builtin_shufflevector(lo_, hi_, 0, 1, 2, 3, 4, 5, 6, 7); } } while (0)
#define PG8_LDB(dst, b, h) do { _Pragma("unroll") for (int n = 0; n < 2; ++n) { const i32x4 lo_ = PG8_LD16(PG8_SB(b, h) + boff + n * 2048), hi_ = PG8_LD16(PG8_SB(b, h) + boff + n * 2048 + 1024); dst[n] = __builtin_shufflevector(lo_, hi_, 0, 1, 2, 3, 4, 5, 6, 7); } } while (0)
#define PG8_LOH(X) __builtin_bit_cast(bf16x8, __builtin_shufflevector((X), (X), 0, 1, 2, 3))
#define PG8_HIH(X) __builtin_bit_cast(bf16x8, __builtin_shufflevector((X), (X), 4, 5, 6, 7))
#define PG8_MMA(ai, bj, At, Bt) do { __builtin_amdgcn_s_setprio(1); \
        if constexpr (Prob::FP8) { _Pragma("unroll") for (int m = 0; m < 4; ++m) _Pragma("unroll") for (int n = 0; n < 2; ++n) \
            asm volatile("v_mfma_scale_f32_16x16x128_f8f6f4 %0, %1, %2, %0, %3, %3 op_sel_hi:[0,0,0]" : "+v"(acc[ai][bj][m][n]) : "v"(Bt[n]), "v"(At[m]), "v"(sc1)); } \
        else { _Pragma("unroll") for (int m = 0; m < 4; ++m) _Pragma("unroll") for (int n = 0; n < 2; ++n) { \
            acc[ai][bj][m][n] = __builtin_amdgcn_mfma_f32_16x16x32_bf16(PG8_LOH(Bt[n]), PG8_LOH(At[m]), acc[ai][bj][m][n], 0, 0, 0); \
            acc[ai][bj][m][n] = __builtin_amdgcn_mfma_f32_16x16x32_bf16(PG8_HIH(Bt[n]), PG8_HIH(At[m]), acc[ai][bj][m][n], 0, 0, 0); } } \
        __builtin_amdgcn_s_setprio(0); } while (0)
#define PG8_WAIT_V(n) asm volatile("s_waitcnt vmcnt(" #n ")" ::: "memory")
#define PG8_WAIT_L(n) asm volatile("s_waitcnt lgkmcnt(" #n ")" ::: "memory")
#define PG8_BAR __builtin_amdgcn_s_barrier()
#define PG8_SCHED __builtin_amdgcn_sched_barrier(0)
    Unit cur, nxt; int ui = 0;
    if (!S.next(0, cur)) return;
    f32x4 acc[2][2][4][2];
#pragma unroll
    for (int a = 0; a < 2; ++a)
#pragma unroll
        for (int b = 0; b < 2; ++b)
#pragma unroll
            for (int m = 0; m < 4; ++m)
#pragma unroll
                for (int n = 0; n < 2; ++n) acc[a][b][m][n] = (f32x4){0.f, 0.f, 0.f, 0.f};
    i32x8 At[4], B0[2], B1[2];
    const int sc1 = 0x7f7f7f7f;
    const char* cA = P.a_base(cur); const char* cB = P.b_base(cur);
    PG8_STAGE(PG8_SB(0, 0), cB, voffB); PG8_STAGE(PG8_SA(0, 0), cA, voffA); PG8_STAGE(PG8_SB(0, 1), cB + hstepB, voffB); PG8_STAGE(PG8_SA(0, 1), cA + hstepA, voffA);
    if (wr == 1) PG8_BAR;
    PG8_WAIT_V(4); PG8_BAR;
    PG8_STAGE(PG8_SB(1, 0), cB + kstep, voffB); PG8_STAGE(PG8_SA(1, 0), cA + kstep, voffA); PG8_STAGE(PG8_SB(1, 1), cB + hstepB + kstep, voffB);
    PG8_WAIT_V(6); PG8_BAR;
    for (;;) {
        const bool has_next = S.next(ui + 1, nxt);
        const char* nA = has_next ? P.a_base(nxt) : cA; const char* nB = has_next ? P.b_base(nxt) : cB;
        for (int rep_ = 0; rep_ < KREP; ++rep_)
        for (int t = 0; t < nt; t += 2) {
            const bool last = (t == nt - 2);
            if constexpr (Epi::HOOK) { if (last && rep_ + 1 == KREP) E.prefetch(cur, lds, wid, lane); }
            const char* a1 = cA + (size_t)(t + 1) * kstep;
            const char* a2 = last ? (rep_ + 1 < KREP ? cA : nA) : cA + (size_t)(t + 2) * kstep; const char* b2 = last ? (rep_ + 1 < KREP ? cB : nB) : cB + (size_t)(t + 2) * kstep;
            const char* a3 = a2 + kstep; const char* b3 = b2 + kstep;
            PG8_LDB(B0, 0, 0); PG8_SCHED; PG8_LDA(At, 0, 0); PG8_STAGE(PG8_SA(1, 1), a1 + hstepA, voffA);
            PG8_WAIT_L(8); PG8_BAR; PG8_WAIT_L(0); PG8_MMA(0, 0, At, B0); PG8_BAR; PG8_SCHED;
            PG8_LDB(B1, 0, 1); PG8_STAGE(PG8_SB(0, 0), b2, voffB);
            PG8_BAR; PG8_WAIT_L(0); PG8_MMA(0, 1, At, B1); PG8_BAR;
            PG8_LDA(At, 0, 1); PG8_STAGE(PG8_SA(0, 0), a2, voffA);
            PG8_BAR; PG8_WAIT_L(0); PG8_MMA(1, 0, At, B0); PG8_BAR; PG8_SCHED;
            PG8_STAGE(PG8_SB(0, 1), b2 + hstepB, voffB);
            PG8_WAIT_V(6); PG8_BAR; PG8_MMA(1, 1, At, B1); PG8_BAR;
            PG8_LDB(B0, 1, 0); PG8_SCHED; PG8_LDA(At, 1, 0); PG8_STAGE(PG8_SA(0, 1), a2 + hstepA, voffA);
            PG8_WAIT_L(8); PG8_BAR; PG8_WAIT_L(0); PG8_MMA(0, 0, At, B0); PG8_BAR; PG8_SCHED;
            PG8_LDB(B1, 1, 1); PG8_STAGE(PG8_SB(1, 0), b3, voffB);
            PG8_BAR; PG8_WAIT_L(0); PG8_MMA(0, 1, At, B1); PG8_BAR;
            PG8_LDA(At, 1, 1); PG8_STAGE(PG8_SA(1, 0), a3, voffA);
            PG8_BAR; PG8_WAIT_L(0); PG8_MMA(1, 0, At, B0); PG8_BAR; PG8_SCHED;
            PG8_STAGE(PG8_SB(1, 1), b3 + hstepB, voffB);
            PG8_WAIT_V(6); PG8_BAR; PG8_MMA(1, 1, At, B1); PG8_BAR;
        }
        if constexpr (Prob::FP8) {
            asm volatile("s_nop 15\n\ts_nop 15" ::: "memory");
#pragma unroll
            for (int a_ = 0; a_ < 2; ++a_)
#pragma unroll
                for (int b_ = 0; b_ < 2; ++b_)
#pragma unroll
                    for (int m_ = 0; m_ < 4; ++m_)
#pragma unroll
                        for (int n_ = 0; n_ < 2; ++n_) asm volatile("" : "+v"(acc[a_][b_][m_][n_]));
        }
        if constexpr (KREP > 1) {
#pragma unroll
        for (int a_ = 0; a_ < 2; ++a_)
#pragma unroll
            for (int b_ = 0; b_ < 2; ++b_)
#pragma unroll
                for (int m_ = 0; m_ < 4; ++m_)
#pragma unroll
                    for (int n_ = 0; n_ < 2; ++n_) acc[a_][b_][m_][n_] *= (1.0f / KREP); }
        { const int t2_ = opaque_tid(WID); const int fr_ = t2_ & 15, fq_ = (t2_ >> 4) & 3; int wr_ = WID >> 2, wc_ = WID & 3; asm volatile("" : "+s"(wr_), "+s"(wc_));
          E(acc, cur, wr_, wc_, fr_, fq_);
#if PROBE_EPI2
          if constexpr (Epi::HOOK) { asm volatile("" ::: "memory"); E(acc, cur, wr_, wc_, fr_, fq_); }
#endif
        }
        if (!has_next) break;
        const float carry = Epi::carry(cur);
#pragma unroll
        for (int a = 0; a < 2; ++a)
#pragma unroll
            for (int b = 0; b < 2; ++b)
#pragma unroll
                for (int m = 0; m < 4; ++m)
#pragma unroll
                    for (int n = 0; n < 2; ++n) acc[a][b][m][n] = Epi::CARRY ? acc[a][b][m][n] * carry : (f32x4){0.f, 0.f, 0.f, 0.f};
        cur = nxt; cA = nA; cB = nB; ++ui;
    }
    PG8_WAIT_V(0);
    if (wr == 0) PG8_BAR;
    PG8_BAR;
#undef PG8_SA
#undef PG8_SB
#undef PG8_STAGE
#undef PG8_LDA
#undef PG8_LDB
#undef PG8_MMA
#undef PG8_LD16
#undef PG8_LOH
#undef PG8_HIH
#undef PG8_WAIT_V
#undef PG8_WAIT_L
#undef PG8_BAR
#undef PG8_SCHED
}
}
using pg8::Unit;
typedef f32x4 Acc[2][2][4][2];

struct ProbPlain { static constexpr bool FP8 = false; const bf16_t* A; const bf16_t* Bt; int lda, ldb, K;
    DI const char* a_base(const Unit& u) const { return (const char*)(A + (size_t)u.pm * 256 * lda); }
    DI const char* b_base(const Unit& u) const { return (const char*)(Bt + (size_t)u.pn * 256 * ldb); } };
struct ProbCmp1 { static constexpr bool FP8 = false; const bf16_t* KCB; const bf16_t* VCB; const bf16_t* W; int lda, ldb, K;
    DI const char* a_base(const Unit& u) const { const int kv = u.pm >> 4, rt = u.pm & 15; return (const char*)((kv ? VCB : KCB) + (size_t)rt * 256 * 1024); }
    DI const char* b_base(const Unit& u) const { const int kv = u.pm >> 4; return (const char*)(W + (size_t)kv * 256 * 2048); } };
struct ProbAtt { static constexpr bool FP8 = false; const bf16_t* AQ; const bf16_t* KP; int lda, ldb, K;
    DI const char* a_base(const Unit& u) const { const int z = u.pm, n = z & 7, h = (z >> 3) & 3, b = z >> 5; const size_t t0 = (size_t)b * 2048 + n * 256; return (const char*)(AQ + (t0 * 4 + h) * 512 + 256); }
    DI const char* b_base(const Unit& u) const { const int z = u.pm, n = z & 7, h = (z >> 3) & 3, b = z >> 5; const size_t t0 = (size_t)b * 2048 + n * 256; return (const char*)(KP + t0 * 1024 + h * 256); } };
struct ProbUT { static constexpr bool FP8 = false; const bf16_t* VS; const bf16_t* KT; int lda, ldb, K;
    DI const char* a_base(const Unit& u) const { const int z = u.pm >> 1, half = u.pm & 1; return (const char*)(VS + (size_t)z * 262144 + (size_t)half * 256 * 512); }
    DI const char* b_base(const Unit& u) const { const int z = u.pm >> 1; return (const char*)(KT + (size_t)z * 65536); } };
struct ProbY { static constexpr bool FP8 = false; const bf16_t* AQ; const bf16_t* VS; int lda, ldb, K;
    DI const char* a_base(const Unit& u) const { const int z = u.pm, n = z & 7, h = (z >> 3) & 3, b = z >> 5; const size_t t0 = (size_t)b * 2048 + n * 256; return (const char*)(AQ + (t0 * 4 + h) * 512); }
    DI const char* b_base(const Unit& u) const { return (const char*)(VS + (size_t)u.pm * 262144 + (size_t)u.pn * 256 * 512); } };
DI int moe_tile_expert(const LAS int* ts, int rt) { int e = 0;
#pragma unroll 8
    for (int i = 1; i < 32; ++i) e += (rt >= ts[i]) ? 1 : 0;
    return e; }
struct ProbMoe { static constexpr bool FP8 = false; const bf16_t* A; const bf16_t* W; const LAS int* ts; int nper; int lda, ldb, K;
    DI const char* a_base(const Unit& u) const { return (const char*)(A + (size_t)u.pm * 256 * 1024); }
    DI const char* b_base(const Unit& u) const { const int e = moe_tile_expert(ts, u.pm); return (const char*)(W + ((size_t)e * nper + (size_t)u.pn * 256) * 1024); } };

struct ProbPlain8 { static constexpr bool FP8 = true; const unsigned char* A; const unsigned char* Bt; int lda, ldb, K;
    DI const char* a_base(const Unit& u) const { return (const char*)(A + (size_t)u.pm * 256 * lda * 2); }
    DI const char* b_base(const Unit& u) const { return (const char*)(Bt + (size_t)u.pn * 256 * ldb * 2); } };
struct ProbMoe8 { static constexpr bool FP8 = true; const unsigned char* A; const unsigned char* W; const LAS int* ts; int nper; int lda, ldb, K;
    DI const char* a_base(const Unit& u) const { return (const char*)(A + (size_t)u.pm * 256 * 1024); }
    DI const char* b_base(const Unit& u) const { const int e = moe_tile_expert(ts, u.pm); return (const char*)(W + ((size_t)e * nper + (size_t)u.pn * 256) * 1024); } };

#define EPI_ROWS(ai, m) (128 * (ai) + 64 * wr + 16 * (m) + fr)
struct EpiEvNat { static constexpr bool HOOK = false; static constexpr bool CARRY = false; static DI float carry(const Unit&) { return 0.f; } static constexpr bool PERM = true;
    unsigned char* ws; const float* gains;
    DI void operator()(const Acc& acc, const Unit& u, int wr, int wc, int fr, int fq) const {
        const int pn = u.pn; const bool norm = (pn != 6);
        const int gi = pn < 2 ? 0 : pn < 4 ? 1 : pn < 6 ? 2 : 3;
        const float* g = gains + gi * 64;
        f32x4 gv[2][2];
#pragma unroll
        for (int bj = 0; bj < 2; ++bj)
#pragma unroll
            for (int n = 0; n < 2; ++n) { const f32x4 t4 = *(const f32x4*)(g + 32 * bj + 8 * fq + 4 * n); gv[bj][n] = norm ? t4 : (f32x4){1.f, 1.f, 1.f, 1.f}; }
        size_t boff; int rowmul, hoff; bool panel = false;
        if (pn < 2) { boff = WS_QD; rowmul = 512; hoff = (pn * 4 + wc) * 64; }
        else if (pn < 4) { boff = WS_KD; rowmul = 512; hoff = ((pn - 2) * 4 + wc) * 64; }
        else if (pn < 6) { boff = WS_QN; rowmul = 512; hoff = ((pn - 4) * 4 + wc) * 64; }
        else { panel = true; rowmul = 64; hoff = 0; boff = (pn == 6) ? (wc < 2 ? WS_KCB : WS_VCB) : (wc < 2 ? WS_KSB : WS_KWB); }
        bf16_t* base = (bf16_t*)(ws + boff);
#pragma unroll
        for (int ai = 0; ai < 2; ++ai)
#pragma unroll
            for (int m = 0; m < 4; ++m) {
                const int t = u.pm * 256 + EPI_ROWS(ai, m), b = t >> 11, sq = t & 2047;
                float ss = 0.f;
#pragma unroll
                for (int bj = 0; bj < 2; ++bj)
#pragma unroll
                    for (int n = 0; n < 2; ++n) { const f32x4 x = acc[ai][bj][m][n]; ss += (x[0] * x[0] + x[1] * x[1]) + (x[2] * x[2] + x[3] * x[3]); }
                ss += shx(ss, 16); ss += shx(ss, 32);
                const float rstd = norm ? rsqrtf(ss * (1.0f / 64.0f) + EPS) * ((pn < 2 || pn == 4 || pn == 5) ? 0.125f : 1.0f) : 1.0f;
                const size_t rowi = panel ? ((size_t)(b * 2 + (wc & 1)) * 2048 + sq) : (size_t)t;
#pragma unroll
                for (int bj = 0; bj < 2; ++bj) {
                    const f32x4 v0 = acc[ai][bj][m][0] * rstd * gv[bj][0], v1 = acc[ai][bj][m][1] * rstd * gv[bj][1];
                    *(u32x4*)(base + rowi * rowmul + hoff + 32 * bj + 8 * fq) = pack8(v0, v1);
                }
            }
    }
};
struct EpiEvSw { static constexpr bool HOOK = false; static constexpr bool CARRY = false; static DI float carry(const Unit&) { return 0.f; } static constexpr bool PERM = true;
    unsigned char* ws;
    DI void operator()(const Acc& acc, const Unit& u, int wr, int wc, int fr, int fq) const {
        const int b = u.pn >> 3, sb = (u.pn & 7) * 256;
#pragma unroll
        for (int ai = 0; ai < 2; ++ai)
#pragma unroll
            for (int m = 0; m < 4; ++m) {
                const int rl = EPI_ROWS(ai, m);
                size_t boff, rowi;
                if (u.pm < 2) { const int fg = u.pm * 256 + rl; boff = WS_VAT; rowi = (size_t)(b * 4 + (fg >> 7)) * 128 + (fg & 127); }
                else { const int r2 = rl & 127; boff = (rl < 128) ? WS_VST : WS_VWT; rowi = (size_t)(b * 2 + (r2 >> 6)) * 64 + (r2 & 63); }
                bf16_t* rowp = (bf16_t*)(ws + boff) + rowi * 2048;
#pragma unroll
                for (int bj = 0; bj < 2; ++bj) { const u32x4 pw = pack8(acc[ai][bj][m][0], acc[ai][bj][m][1]);
                    const int s0 = sb + 128 * bj + 32 * wc + 8 * fq; bf16_t* g16 = rowp + (s0 & ~15) + ((s0 & 8) ? 4 : 0);
                    *(u32x2*)g16 = (u32x2){pw.x, pw.y}; *(u32x2*)(g16 + 8) = (u32x2){pw.z, pw.w}; }
            }
    }
};
struct EpiCmp1 { static constexpr bool HOOK = false; static constexpr bool CARRY = false; static DI float carry(const Unit&) { return 0.f; } static constexpr bool PERM = true;
    bf16_t* HID; const float* bias1;
    DI void operator()(const Acc& acc, const Unit& u, int wr, int wc, int fr, int fq) const {
        const int kv = u.pm >> 4, rt = u.pm & 15;
#pragma unroll
        for (int bj = 0; bj < 2; ++bj) {
            const int col = 128 * bj + 32 * wc + 8 * fq;
            const f32x4 b0 = *(const f32x4*)(bias1 + kv * 256 + col), b1 = *(const f32x4*)(bias1 + kv * 256 + col + 4);
#pragma unroll
            for (int ai = 0; ai < 2; ++ai)
#pragma unroll
                for (int m = 0; m < 4; ++m) {
                    f32x4 v0 = acc[ai][bj][m][0] + b0, v1 = acc[ai][bj][m][1] + b1;
#pragma unroll
                    for (int j = 0; j < 4; ++j) { v0[j] = v0[j] * sigm(v0[j]); v1[j] = v1[j] * sigm(v1[j]); }
                    *(u32x4*)(HID + ((size_t)kv * 4096 + rt * 256 + EPI_ROWS(ai, m)) * 256 + col) = pack8(v0, v1);
                }
        }
    }
};
struct EpiResid { static constexpr bool HOOK = false; static constexpr bool CARRY = false; static DI float carry(const Unit&) { return 0.f; } static constexpr bool PERM = true;
    const void* Hin; bf16_t* Hout; bool hb;
    DI void operator()(const Acc& acc, const Unit& u, int wr, int wc, int fr, int fq) const {
#pragma unroll
        for (int ai = 0; ai < 2; ++ai)
#pragma unroll
            for (int m = 0; m < 4; ++m) {
                const size_t off = (size_t)(u.pm * 256 + EPI_ROWS(ai, m)) * 1024 + u.pn * 256 + 32 * wc + 8 * fq;
#pragma unroll
                for (int bj = 0; bj < 2; ++bj) { const size_t o = off + 128 * bj;
                    *(u32x4*)(Hout + o) = pack8(ld_h4(Hin, hb, o) + acc[ai][bj][m][0], ld_h4(Hin, hb, o + 4) + acc[ai][bj][m][1]); }
            }
    }
};
DI float ret_lg2(int h) { return __log2f(1.0f - exp2f(-5.0f - (float)h)); }
struct EpiOdNat { static constexpr bool HOOK = false; static constexpr bool CARRY = false; static DI float carry(const Unit&) { return 0.f; } static constexpr bool PERM = true;
    unsigned char* ws;
    DI void operator()(const Acc& acc, const Unit& u, int wr, int wc, int fr, int fq) const {
        const int pn = u.pn; const int h = pn & 3; const float lg = ret_lg2(h);
        const size_t boff = pn < 4 ? WS_AQ : pn < 8 ? WS_KP : WS_GG;
        const int rowmul = pn < 4 ? 2048 : pn < 8 ? 1024 : 2048;
        const int coff = pn < 4 ? (h * 512 + 256) : pn < 8 ? (h * 256) : ((pn - 8) * 256);
        bf16_t* base = (bf16_t*)(ws + boff) + coff;
#pragma unroll
        for (int ai = 0; ai < 2; ++ai)
#pragma unroll
            for (int m = 0; m < 4; ++m) {
                const int cl = EPI_ROWS(ai, m); const size_t t = (size_t)u.pm * 256 + cl;
                float sc = 1.f;
                if (pn < 4) sc = exp2f(lg * (float)(cl + 1)); else if (pn < 8) sc = 0.0625f * exp2f(-lg * (float)(cl + 1));
#pragma unroll
                for (int bj = 0; bj < 2; ++bj) {
                    const int d = 128 * bj + 32 * wc + 8 * fq;
                    f32x4 v0 = acc[ai][bj][m][0] * sc, v1 = acc[ai][bj][m][1] * sc;
                    if (pn >= 8) {
#pragma unroll
                        for (int j = 0; j < 4; ++j) { v0[j] = v0[j] * sigm(v0[j]); v1[j] = v1[j] * sigm(v1[j]); } }
                    const u32x4 pw = pack8(v0, v1);
                    *(u32x4*)(base + t * rowmul + d) = pw;
                    if (pn >= 4 && pn < 8) {
                        bf16_t* kt = (bf16_t*)(ws + WS_KT) + ((size_t)((u.pm >> 3) * 4 + h) * 8 + (u.pm & 7)) * 65536 + (size_t)d * 256 + cl;
                        kt[0 * 256] = (bf16_t)(pw.x & 0xffffu); kt[1 * 256] = (bf16_t)(pw.x >> 16); kt[2 * 256] = (bf16_t)(pw.y & 0xffffu); kt[3 * 256] = (bf16_t)(pw.y >> 16);
                        kt[4 * 256] = (bf16_t)(pw.z & 0xffffu); kt[5 * 256] = (bf16_t)(pw.z >> 16); kt[6 * 256] = (bf16_t)(pw.w & 0xffffu); kt[7 * 256] = (bf16_t)(pw.w >> 16);
                    }
                }
            }
    }
};
struct EpiOdSw { static constexpr bool HOOK = false; static constexpr bool CARRY = false; static DI float carry(const Unit&) { return 0.f; } static constexpr bool PERM = true;
    unsigned char* ws;
    DI void operator()(const Acc& acc, const Unit& u, int wr, int wc, int fr, int fq) const {
        const int b = u.pn >> 3, n = u.pn & 7, h = u.pm >> 1;
        const size_t z = (size_t)(b * 4 + h) * 8 + n;
        bf16_t* base = (bf16_t*)(ws + WS_VS) + z * 262144 + (size_t)(u.pm & 1) * 256 * 512;
#pragma unroll
        for (int bj = 0; bj < 2; ++bj) {
            const int cl = 128 * bj + 32 * wc + 8 * fq;
#pragma unroll
            for (int ai = 0; ai < 2; ++ai)
#pragma unroll
                for (int m = 0; m < 4; ++m)
                    *(u32x4*)(base + (size_t)EPI_ROWS(ai, m) * 512 + cl) = pack8(acc[ai][bj][m][0], acc[ai][bj][m][1]);
        }
    }
};
struct EpiAtt { static constexpr bool HOOK = false; static constexpr bool CARRY = false; static DI float carry(const Unit&) { return 0.f; } static constexpr bool PERM = true;
    bf16_t* AQ;
    DI void operator()(const Acc& acc, const Unit& u, int wr, int wc, int fr, int fq) const {
        const int z = u.pm, n = z & 7, h = (z >> 3) & 3, b = z >> 5; const size_t t0 = (size_t)b * 2048 + n * 256;
#pragma unroll
        for (int ai = 0; ai < 2; ++ai)
#pragma unroll
            for (int m = 0; m < 4; ++m) {
                const int c = EPI_ROWS(ai, m);
#pragma unroll
                for (int bj = 0; bj < 2; ++bj) {
                    const int e0 = 128 * bj + 32 * wc + 8 * fq;
                    f32x4 v0 = acc[ai][bj][m][0], v1 = acc[ai][bj][m][1];
#pragma unroll
                    for (int j = 0; j < 4; ++j) { v0[j] = (c >= e0 + j) ? v0[j] : 0.f; v1[j] = (c >= e0 + 4 + j) ? v1[j] : 0.f; }
                    *(u32x4*)(AQ + ((t0 + c) * 4 + h) * 512 + e0) = pack8(v0, v1);
                }
            }
    }
};
struct EpiUT { static constexpr bool HOOK = false; static constexpr bool CARRY = false; static DI float carry(const Unit&) { return 0.f; } static constexpr bool PERM = true;
    bf16_t* UT;
    DI void operator()(const Acc& acc, const Unit& u, int wr, int wc, int fr, int fq) const {
        const size_t z = (size_t)(u.pm >> 1); const int half = u.pm & 1;
#pragma unroll
        for (int ai = 0; ai < 2; ++ai)
#pragma unroll
            for (int m = 0; m < 4; ++m) {
                bf16_t* rowp = UT + z * 131072 + (size_t)(half * 256 + EPI_ROWS(ai, m)) * 256 + 32 * wc + 8 * fq;
#pragma unroll
                for (int bj = 0; bj < 2; ++bj) *(u32x4*)(rowp + 128 * bj) = pack8(acc[ai][bj][m][0], acc[ai][bj][m][1]);
            }
    }
};
struct EpiUTScan { static constexpr bool HOOK = false; static constexpr bool CARRY = true; static constexpr bool PERM = true;
    static DI float carry(const Unit& u) { const int z = u.pm >> 1, n = z & 7, h = (z >> 3) & 3; return n == 7 ? 0.f : exp2f(256.0f * ret_lg2(h)); }
    bf16_t* VS;
    DI void operator()(const Acc& acc, const Unit& u, int wr, int wc, int fr, int fq) const {
        const size_t z = (size_t)(u.pm >> 1); const int half = u.pm & 1, n = (int)(z & 7), h = (int)((z >> 3) & 3);
        const float dec = exp2f(256.0f * ret_lg2(h));
#pragma unroll
        for (int ai = 0; ai < 2; ++ai)
#pragma unroll
            for (int m = 0; m < 4; ++m) {
                bf16_t* rowp = VS + (z * 512 + half * 256 + EPI_ROWS(ai, m)) * 512 + 256 + 32 * wc + 8 * fq;
#pragma unroll
                for (int bj = 0; bj < 2; ++bj) {
                    if (n == 0) { unsigned z0; asm volatile("v_mov_b32 %0, 0" : "=v"(z0)); *(u32x4*)(rowp + 128 * bj) = (u32x4){z0, z0, z0, z0}; }
                    if (n < 7) *(u32x4*)(rowp + (size_t)512 * 512 + 128 * bj) = pack8(acc[ai][bj][m][0] * dec, acc[ai][bj][m][1] * dec);
                }
            }
    }
};
struct SchedSeq { int nb, c;
    DI void init(int G, int c_) { nb = G / 2 > 0 ? G / 2 : 1; c = c_; }
    DI bool next(int i, Unit& u) const { if (c >= nb) return false; const int seq = c + (i >> 3) * nb; if (seq >= 128) return false;
        const int bh = seq >> 1, half = seq & 1, n = i & 7; u.pm = (bh * 8 + n) * 2 + half; u.pn = 0; return true; } };
struct EpiY { static constexpr bool HOOK = false; static constexpr bool CARRY = false; static DI float carry(const Unit&) { return 0.f; } static constexpr bool PERM = true;
    bf16_t* Y;
    DI void operator()(const Acc& acc, const Unit& u, int wr, int wc, int fr, int fq) const {
        const int z = u.pm, n = z & 7, h = (z >> 3) & 3, b = z >> 5; const size_t t0 = (size_t)b * 2048 + n * 256;
#pragma unroll
        for (int ai = 0; ai < 2; ++ai)
#pragma unroll
            for (int m = 0; m < 4; ++m) {
                bf16_t* rowp = Y + (t0 + EPI_ROWS(ai, m)) * 2048 + h * 512 + u.pn * 256 + 32 * wc + 8 * fq;
#pragma unroll
                for (int bj = 0; bj < 2; ++bj) *(u32x4*)(rowp + 128 * bj) = pack8(acc[ai][bj][m][0], acc[ai][bj][m][1]);
            }
    }
};
constexpr float W8_SCALE = 32.0f, WSC = 1.0f / W8_SCALE;
struct EpiGU { static constexpr bool HOOK = true; static constexpr bool CARRY = false; static DI float carry(const Unit&) { return 0.f; } static constexpr bool PERM = true;
    unsigned char* ACT; const float* bgu; const LAS int* ts;
    DI void prefetch(const Unit& u, LAS unsigned char* lds, int wid, int lane) const {
        if (wid == 0) { const int e = moe_tile_expert(ts, u.pm); const int ln = lane_now();
            const float* src = bgu + (size_t)e * 2048 + 128 * u.pn + ((ln & 32) ? 1024 : 0) + 4 * (ln & 31);
            __builtin_amdgcn_global_load_lds((const unsigned*)src, (LAS unsigned*)(lds + MISC_OFF + MO_RED), 16, 0, 0); }
    }
    DI void operator()(const Acc& acc, const Unit& u, int wr, int wc, int fr, int fq) const {
        const int w = 32 * wc + 8 * fq;
        const LAS float* bl_ = (const LAS float*)(ts) - MO_TS / 4 + MO_RED / 4 + w;
        const f32x4 bg0 = *(const LAS f32x4*)bl_, bg1 = *(const LAS f32x4*)(bl_ + 4), bl0 = *(const LAS f32x4*)(bl_ + 128), bl1 = *(const LAS f32x4*)(bl_ + 132);
#pragma unroll
        for (int ai = 0; ai < 2; ++ai)
#pragma unroll
            for (int m = 0; m < 4; ++m) {
                f32x4 g0 = acc[ai][0][m][0] * WSC + bg0, g1 = acc[ai][0][m][1] * WSC + bg1, l0 = acc[ai][1][m][0] * WSC + bl0, l1 = acc[ai][1][m][1] * WSC + bl1;
#pragma unroll
                for (int j = 0; j < 4; ++j) {
                    const float a = fminf(g0[j], 7.0f), c = fminf(g1[j], 7.0f);
                    const float la = fminf(fmaxf(l0[j], -7.0f), 7.0f), lc = fminf(fmaxf(l1[j], -7.0f), 7.0f);
                    g0[j] = a * sigm(1.702f * a) * (la + 1.0f); g1[j] = c * sigm(1.702f * c) * (lc + 1.0f); }
                u32x2 o8; o8.x = pk4_fp8(g0[0], g0[1], g0[2], g0[3]); o8.y = pk4_fp8(g1[0], g1[1], g1[2], g1[3]);
                *(u32x2*)(ACT + ((size_t)u.pm * 256 + EPI_ROWS(ai, m)) * 1024 + 128 * u.pn + w) = o8;
            }
    }
};
struct EpiDN { static constexpr bool HOOK = true; static constexpr bool CARRY = false; static DI float carry(const Unit&) { return 0.f; } static constexpr bool PERM = true;
    bf16_t* YB; const float* bdn; const LAS int* ts;
    DI void prefetch(const Unit& u, LAS unsigned char* lds, int wid, int lane) const {
        if (wid == 0) { const int e = moe_tile_expert(ts, u.pm); const int ln = lane_now();
            __builtin_amdgcn_global_load_lds((const unsigned*)(bdn + (size_t)e * 1024 + 256 * u.pn + 4 * ln), (LAS unsigned*)(lds + MISC_OFF + MO_RED), 16, 0, 0); }
    }
    DI void operator()(const Acc& acc, const Unit& u, int wr, int wc, int fr, int fq) const {
        const LAS float* bl_ = (const LAS float*)(ts) - MO_TS / 4 + MO_RED / 4;
#pragma unroll
        for (int bj = 0; bj < 2; ++bj) {
            const int cl = 128 * bj + 32 * wc + 8 * fq, col = 256 * u.pn + cl;
            const f32x4 b0 = *(const LAS f32x4*)(bl_ + cl), b1 = *(const LAS f32x4*)(bl_ + cl + 4);
#pragma unroll
            for (int ai = 0; ai < 2; ++ai)
#pragma unroll
                for (int m = 0; m < 4; ++m)
                    *(u32x4*)(YB + ((size_t)u.pm * 256 + EPI_ROWS(ai, m)) * 1024 + col) = pack8(acc[ai][bj][m][0] * (1.0f / 64.0f) + b0, acc[ai][bj][m][1] * (1.0f / 64.0f) + b1);
        }
    }
};
struct EpiPP { static constexpr bool HOOK = false; static constexpr bool CARRY = false; static DI float carry(const Unit&) { return 0.f; } static constexpr bool PERM = true;
    bf16_t* PP;
    DI void operator()(const Acc& acc, const Unit& u, int wr, int wc, int fr, int fq) const {
#pragma unroll
        for (int ai = 0; ai < 2; ++ai)
#pragma unroll
            for (int m = 0; m < 4; ++m) {
                bf16_t* rowp = PP + ((size_t)u.pm * 256 + EPI_ROWS(ai, m)) * 1024 + u.pn * 256 + 32 * wc + 8 * fq;
#pragma unroll
                for (int bj = 0; bj < 2; ++bj) *(u32x4*)(rowp + 128 * bj) = pack8(acc[ai][bj][m][0], acc[ai][bj][m][1]);
            }
    }
};
struct EpiPLE { static constexpr bool HOOK = false; static constexpr bool CARRY = false; static DI float carry(const Unit&) { return 0.f; } static constexpr bool PERM = true;
    bf16_t* H; const bf16_t* PP; float* out;
    DI void operator()(const Acc& acc, const Unit& u, int wr, int wc, int fr, int fq) const {
#pragma unroll
        for (int ai = 0; ai < 2; ++ai)
#pragma unroll
            for (int m = 0; m < 4; ++m) {
                const size_t off = (size_t)(u.pm * 256 + EPI_ROWS(ai, m)) * 1024 + u.pn * 256 + 32 * wc + 8 * fq;
#pragma unroll
                for (int bj = 0; bj < 2; ++bj) { const size_t o = off + 128 * bj;
                    const u32x4 pw = *(const u32x4*)(PP + o), hw = *(const u32x4*)(H + o); const f32x4 a0 = acc[ai][bj][m][0], a1 = acc[ai][bj][m][1];
                    f32x4 h0 = {bflo(hw.x), bfhi(hw.x), bflo(hw.y), bfhi(hw.y)}, h1 = {bflo(hw.z), bfhi(hw.z), bflo(hw.w), bfhi(hw.w)};
                    h0[0] += sigm(a0[0] * WSC) * bflo(pw.x); h0[1] += sigm(a0[1] * WSC) * bfhi(pw.x); h0[2] += sigm(a0[2] * WSC) * bflo(pw.y); h0[3] += sigm(a0[3] * WSC) * bfhi(pw.y);
                    h1[0] += sigm(a1[0] * WSC) * bflo(pw.z); h1[1] += sigm(a1[1] * WSC) * bfhi(pw.z); h1[2] += sigm(a1[2] * WSC) * bflo(pw.w); h1[3] += sigm(a1[3] * WSC) * bfhi(pw.w);
                    if (out) { *(f32x4*)(out + o) = h0; *(f32x4*)(out + o + 4) = h1; } else *(u32x4*)(H + o) = pack8(h0, h1);
                }
            }
    }
};

DI int vperm16(int key) { const int g = (key >> 2) & 3; const int ng = (g == 1) ? 2 : (g == 2) ? 1 : g; return (key & ~15) | (ng << 2) | (key & 3); }
template <int DV, int MODE>
DI void attn_unit(const int WID, LAS unsigned char* lds, const bf16_t* Qp, int ldq, const bf16_t* Kp, int ldk, const bf16_t* Vt, int ldvt, int q0, float slope, int dcut,
                  const unsigned* selp, bf16_t* Op, int ldo, float* impp) {
    constexpr int NRB = DV / 32;
    constexpr int KT_B = 64 * 128, VT_B = DV * 128, BUF_B = 2 * KT_B + 2 * VT_B;
    const int tid = opaque_tid(WID), w = __builtin_amdgcn_readfirstlane(tid >> 6), lane = tid & 63, r = lane & 31, hh = lane >> 5;
    const int qrow = q0 + 32 * w + r, qw_first = q0 + 32 * w, qw_last = qw_first + 31;
    const float LOG2E = 1.44269504089f;
    bf16x8 qf[4];
#pragma unroll
    for (int ks = 0; ks < 4; ++ks) qf[ks] = *(const bf16x8*)(Qp + (size_t)(32 * w + r) * ldq + 16 * ks + 8 * hh);
    unsigned selm = 0xffffffffu, orm = 0xffffffffu;
    if (MODE == 1) { selm = selp[32 * w + r]; orm = selm;
#pragma unroll
        for (int o = 1; o < 32; o <<= 1) orm |= shxu(orm, o); }
    const int nv = (MODE == 3) ? (qrow >= 31 ? ((qrow - 15) >> 4) : 0) : 0;
    const int nv_wmax = (MODE == 3) ? (qw_last >= 31 ? ((qw_last - 15) >> 4) : 0) : 0;
    int kt_lo = 0, kt_hi;
    if (MODE == 0 || MODE == 1) kt_hi = (q0 >> 6) + 4;
    else if (MODE == 2) { kt_hi = (q0 >> 6) + 4; const int lk = q0 - 511; kt_lo = lk > 0 ? (lk >> 6) : 0; }
    else kt_hi = 2;
    if (MODE != 3) { const int kmin = q0 - dcut; const int lo2 = kmin > 0 ? (kmin >> 6) : 0; kt_lo = lo2 > kt_lo ? lo2 : kt_lo; }
    f32x16 cb[2];
#pragma unroll
    for (int kk = 0; kk < 2; ++kk)
#pragma unroll
        for (int i = 0; i < 16; ++i) cb[kk][i] = (MODE == 3) ? 0.f : slope * (float)(32 * kk + 8 * (i >> 2) + (i & 3) + 4 * hh);
    f32x16 O[NRB];
#pragma unroll
    for (int rb = 0; rb < NRB; ++rb)
#pragma unroll
        for (int i = 0; i < 16; ++i) O[rb][i] = 0.f;
    float mrun = NEGF, lrun = 0.f;
    const int drow = tid >> 3, dpc = (tid & 7) ^ ((drow >> 1) & 7);
    const unsigned ldsw = (unsigned)w * 1024u;
#define AT_DMA(buf, sub, kt) do { const int kt_ = (kt) < 0 ? 0 : (kt); LAS unsigned char* b_ = lds + (buf) * BUF_B; \
        __builtin_amdgcn_global_load_lds((const unsigned*)(Kp + (size_t)(64 * kt_ + drow) * ldk + 8 * dpc), (LAS unsigned*)(b_ + (sub) * KT_B + ldsw), 16, 0, 0); \
        _Pragma("unroll") for (int i_ = 0; i_ < (DV + 63) / 64; ++i_) { if (64 * i_ + 64 <= DV || w < 4) \
            __builtin_amdgcn_global_load_lds((const unsigned*)(Vt + (size_t)(drow + 64 * i_) * ldvt + 64 * kt_ + 8 * dpc), (LAS unsigned*)(b_ + 2 * KT_B + (sub) * VT_B + i_ * 8192 + ldsw), 16, 0, 0); } } while (0)
    const int ntile = kt_hi - kt_lo, nstep = (ntile + 1) >> 1;
    AT_DMA(0, 0, kt_hi - 1); AT_DMA(0, 1, kt_hi - 2);
    asm volatile("s_waitcnt vmcnt(0)" ::: "memory");
    __syncthreads();
#if PROBE_ATT == 2
    AT_DMA(0, 0, kt_hi - 1); AT_DMA(0, 1, kt_hi - 2);
    asm volatile("s_waitcnt vmcnt(0)" ::: "memory");
    __syncthreads();
#endif
    const int sw = (r >> 1) & 7;
    for (int st = 0; st < nstep; ++st) {
        const int buf = st & 1;
        if (st + 1 < nstep) { AT_DMA(buf ^ 1, 0, kt_hi - 3 - 2 * st); AT_DMA(buf ^ 1, 1, kt_hi - 4 - 2 * st); }
#pragma unroll
        for (int sub = 0; sub < 2; ++sub) {
        const int kt = kt_hi - 1 - 2 * st - sub, key0 = 64 * kt;
        bool skip;
        if (MODE == 0) skip = key0 > qw_last;
        else if (MODE == 1) skip = (key0 > qw_last) || !((orm >> (kt & 31)) & 1u);
        else if (MODE == 2) skip = (key0 > qw_last) || (key0 + 63 < qw_first - 511);
        else skip = key0 >= nv_wmax;
        skip = skip || (kt < kt_lo);
        if (!skip) {
            const LAS unsigned char* kb = lds + buf * BUF_B + sub * KT_B; const LAS unsigned char* vb = lds + buf * BUF_B + 2 * KT_B + sub * VT_B;
            f32x16 S[2];
#pragma unroll
            for (int kk = 0; kk < 2; ++kk) {
                S[kk] = cb[kk];
#pragma unroll
                for (int ks = 0; ks < 4; ++ks) { const bf16x8 a = *(const LAS bf16x8*)(kb + (32 * kk + r) * 128 + (((2 * ks + hh) ^ sw) << 4));
                    S[kk] = __builtin_amdgcn_mfma_f32_32x32x16_bf16(a, qf[ks], S[kk], 0, 0, 0); }
            }
            const bool bnd = (MODE == 3) ? true : ((key0 + 63 > qw_first) || (MODE == 2 && key0 < qw_last - 511));
            if (bnd) {
                const int lim = (MODE == 3) ? (nv - key0 - 4 * hh) : (qrow - key0 - 4 * hh);
#pragma unroll
                for (int kk = 0; kk < 2; ++kk)
#pragma unroll
                    for (int i = 0; i < 16; ++i) { const int cki = 32 * kk + 8 * (i >> 2) + (i & 3);
                        bool valid;
                        if (MODE == 3) valid = cki < lim; else if (MODE == 2) valid = (cki <= lim) && (cki > lim - 512); else valid = cki <= lim;
                        S[kk][i] = valid ? S[kk][i] : NEGF; }
            }
            float mx = NEGF;
#pragma unroll
            for (int kk = 0; kk < 2; ++kk)
#pragma unroll
                for (int i = 0; i < 16; ++i) mx = fmaxf(mx, S[kk][i]);
            mx = fmaxf(mx, shx(mx, 32));
            const float off = (MODE == 3) ? 0.f : slope * (float)key0;
            mx += off;
            bool selok = true;
            if (MODE == 1) { selok = ((selm >> (kt & 31)) & 1u) != 0u; mx = selok ? mx : NEGF; }
            const float mnew = fmaxf(mrun, mx);
            const float meff = (mnew < -1e29f) ? 0.f : mnew;
            float c = (off - meff) * LOG2E;
            if (MODE == 1) c = selok ? c : NEGF;
            float ps = 0.f;
#pragma unroll
            for (int kk = 0; kk < 2; ++kk)
#pragma unroll
                for (int i = 0; i < 16; ++i) { const float p = __builtin_amdgcn_exp2f(__builtin_fmaf(S[kk][i], LOG2E, c)); S[kk][i] = p; ps += p; }
            if (__any(mnew > mrun)) {
                const float alpha = __builtin_amdgcn_exp2f((mrun - mnew) * LOG2E);
                lrun *= alpha;
#pragma unroll
                for (int rb = 0; rb < NRB; ++rb)
#pragma unroll
                    for (int i = 0; i < 16; ++i) O[rb][i] *= alpha;
            }
            mrun = mnew; lrun += ps;
#pragma unroll
            for (int kk = 0; kk < 2; ++kk)
#pragma unroll
                for (int s2 = 0; s2 < 2; ++s2) {
                    u32x4 pw; pw.x = pk2(S[kk][8 * s2 + 0], S[kk][8 * s2 + 1]); pw.y = pk2(S[kk][8 * s2 + 2], S[kk][8 * s2 + 3]);
                    pw.z = pk2(S[kk][8 * s2 + 4], S[kk][8 * s2 + 5]); pw.w = pk2(S[kk][8 * s2 + 6], S[kk][8 * s2 + 7]);
                    const bf16x8 pf = __builtin_bit_cast(bf16x8, pw);
#pragma unroll
                    for (int rb = 0; rb < NRB; ++rb) {
                        const bf16x8 a = *(const LAS bf16x8*)(vb + (32 * rb + r) * 128 + ((((2 * kk + s2) * 2 + hh) ^ sw) << 4));
                        O[rb] = __builtin_amdgcn_mfma_f32_32x32x16_bf16(a, pf, O[rb], 0, 0, 0);
                    }
                }
        }
        }
        asm volatile("s_waitcnt vmcnt(0)" ::: "memory");
        __syncthreads();
    }
#undef AT_DMA
    const float ltot = lrun + shx(lrun, 32);
    float inv = 1.0f / ltot;
    if (MODE == 3) inv = (nv > 0) ? inv : 0.f;
#if PROBE_ATT == 1
    for (int rep_ = 0; rep_ < 2; ++rep_) { asm volatile("" ::: "memory");
#endif
#pragma unroll
    for (int rb = 0; rb < NRB; ++rb)
#pragma unroll
        for (int g4 = 0; g4 < 4; ++g4) {
            const float a = O[rb][4 * g4] * inv, b = O[rb][4 * g4 + 1] * inv, c = O[rb][4 * g4 + 2] * inv, d = O[rb][4 * g4 + 3] * inv;
            const int dv = 32 * rb + 8 * g4 + 4 * hh;
            if (MODE == 3 && rb == 2) { *(f32x4*)(impp + (size_t)(32 * w + r) * 256 + (dv - 64)) = (f32x4){a, b, c, d}; }
            else { u32x2 o; o.x = pk2(a, b); o.y = pk2(c, d); *(u32x2*)(Op + (size_t)(32 * w + r) * ldo + dv) = o; }
        }
#if PROBE_ATT == 1
    }
#endif
}

struct Args { const float* in[26]; float* out; unsigned char* ws; int ph_lo, ph_hi; };
typedef const __attribute__((address_space(4))) Args* ArgsP;
DI ArgsP opaque_args() { auto p = __builtin_amdgcn_kernarg_segment_ptr(); asm volatile("" : "+s"(p)); return (ArgsP)p; }
enum { I_X = 0, I_P, I_N1G, I_N2G, I_EVWIN, I_EVWOUT, I_DAQN, I_DAKN, I_DALAM, I_DAOUTG, I_NSQN, I_NSKN, I_CMPPE, I_CMPW1, I_CMPW2, I_ODWIN, I_ODWOUT,
       I_RETG, I_ROUTW, I_ROUTB, I_WGU, I_BGU, I_WDN, I_BDN, I_PLEP, I_PLEG };

struct CvtJob { int in_idx, ldsrc, K, col0, ncols, dstrow0, perm, nmat; size_t src_stride, dst_off, dst_stride; int fp8, pad; };
constexpr int NJOBS = 19;
__constant__ CvtJob c_jobs[NJOBS] = {
    {I_EVWIN, EVIN, 1024, 0,    1024, 0,    1, 2, (size_t)1024 * EVIN, WS_EVNAT, (size_t)2048 * 1024, 0, 0},
    {I_EVWIN, EVIN, 1024, 1536, 512,  1024, 1, 2, (size_t)1024 * EVIN, WS_EVNAT, (size_t)2048 * 1024, 0, 0},
    {I_EVWIN, EVIN, 1024, 2048, 128,  1536, 1, 2, (size_t)1024 * EVIN, WS_EVNAT, (size_t)2048 * 1024, 0, 0},
    {I_EVWIN, EVIN, 1024, 2176, 128,  1664, 1, 2, (size_t)1024 * EVIN, WS_EVNAT, (size_t)2048 * 1024, 0, 0},
    {I_EVWIN, EVIN, 1024, 2304, 128,  1792, 1, 2, (size_t)1024 * EVIN, WS_EVNAT, (size_t)2048 * 1024, 0, 0},
    {I_EVWIN, EVIN, 1024, 2560, 128,  1920, 1, 2, (size_t)1024 * EVIN, WS_EVNAT, (size_t)2048 * 1024, 0, 0},
    {I_EVWIN, EVIN, 1024, 1024, 512,  0,    0, 2, (size_t)1024 * EVIN, WS_EVSW,  (size_t)768 * 1024, 0, 0},
    {I_EVWIN, EVIN, 1024, 2432, 128,  512,  0, 2, (size_t)1024 * EVIN, WS_EVSW,  (size_t)768 * 1024, 0, 0},
    {I_EVWIN, EVIN, 1024, 2688, 128,  640,  0, 2, (size_t)1024 * EVIN, WS_EVSW,  (size_t)768 * 1024, 0, 0},
    {I_EVWOUT, 1024, 1024, 0, 1024, 0, 0, 2, (size_t)1024 * 1024, WS_EVOUT, (size_t)1024 * 1024, 0, 0},
    {I_CMPW1, 256, 2048, 0, 256, 0, 0, 4, (size_t)2048 * 256, WS_CMP1, (size_t)256 * 2048, 0, 0},
    {I_ODWIN, ODIN, 1024, 0,    2048, 0,    0, 2, (size_t)1024 * ODIN, WS_ODNAT, (size_t)4096 * 1024, 0, 0},
    {I_ODWIN, ODIN, 1024, 4096, 2048, 2048, 0, 2, (size_t)1024 * ODIN, WS_ODNAT, (size_t)4096 * 1024, 0, 0},
    {I_ODWIN, ODIN, 1024, 2048, 2048, 0,    0, 2, (size_t)1024 * ODIN, WS_ODSW,  (size_t)2048 * 1024, 0, 0},
    {I_ODWOUT, 1024, 2048, 0, 1024, 0, 0, 2, (size_t)2048 * 1024, WS_ODOUT, (size_t)1024 * 2048, 0, 0},
    {I_WGU, 2048, 1024, 0, 2048, 0, 2, 128, (size_t)1024 * 2048, WS_WGU, (size_t)2048 * 1024, 32, 0},
    {I_WDN, 1024, 1024, 0, 1024, 0, 0, 128, (size_t)1024 * 1024, WS_WDN, (size_t)1024 * 1024, 64, 0},
    {I_PLEP, 1024, 256, 0, 1024, 0, 0, 4, (size_t)256 * 1024, WS_WPP, (size_t)1024 * 256, 0, 0},
    {I_PLEG, 1024, 1024, 0, 1024, 0, 0, 4, (size_t)1024 * 1024, WS_WPG, (size_t)1024 * 1024, 32, 0},
};
DI int cvt_dstrow(int perm, int L) {
    if (perm == 1) { const int pn = L >> 8, lc = L & 255; return pn * 256 + 128 * ((lc & 63) >> 5) + 32 * (lc >> 6) + (lc & 31); }
    if (perm == 2) { const int bj = L >> 10, cc = L & 1023; return 256 * (cc >> 7) + 128 * bj + (cc & 127); }
    return L;
}
DI void phase_prologue(const int WID, ArgsP a, LAS unsigned char* lds) {
    const int tid = opaque_tid(WID), lane = tid & 63, wv = tid >> 6;
    const int gw = blockIdx.x * 8 + wv, NGW = gridDim.x * 8;
    LAS float* scr = (LAS float*)(lds + wv * 16896);
    int total = 0;
    for (int j = 0; j < NJOBS; ++j) total += c_jobs[j].nmat * (c_jobs[j].K >> 6) * (c_jobs[j].ncols >> 6);
#define PRO_DECODE(IT, JJ, MAT, K0, N0, SRC, RS) do { int r_ = (IT), j_ = 0; \
        for (; j_ < NJOBS; ++j_) { const int n_ = c_jobs[j_].nmat * (c_jobs[j_].K >> 6) * (c_jobs[j_].ncols >> 6); if (r_ < n_) break; r_ -= n_; } \
        JJ = j_; const bool f8_ = c_jobs[j_].fp8 != 0; const int nkb_ = f8_ ? (c_jobs[j_].K >> 7) : (c_jobs[j_].K >> 6), nnb_ = f8_ ? (c_jobs[j_].ncols >> 5) : (c_jobs[j_].ncols >> 6), per_ = nkb_ * nnb_; \
        MAT = r_ / per_; const int rr_ = r_ % per_; K0 = (rr_ / nnb_) * (f8_ ? 128 : 64); N0 = (rr_ % nnb_) * (f8_ ? 32 : 64); const int ld_ = c_jobs[j_].ldsrc; \
        SRC = a->in[c_jobs[j_].in_idx] + (size_t)MAT * c_jobs[j_].src_stride + (size_t)K0 * ld_ + c_jobs[j_].col0 + N0 + (f8_ ? (lane & 31) + (lane >> 5) * ld_ : lane); RS = f8_ ? 2 * ld_ : ld_; } while (0)
    float tv[64];
    int jn = 0, matn = 0, k0n = 0, n0n = 0, rsn = 0; const float* srcn = nullptr;
    if (gw < total) { PRO_DECODE(gw, jn, matn, k0n, n0n, srcn, rsn);
#pragma unroll
        for (int i = 0; i < 64; ++i) tv[i] = srcn[(size_t)i * rsn]; }
    for (int it = gw; it < total; it += NGW) {
        const CvtJob J = c_jobs[jn]; const int mat = matn, k0 = k0n, n0 = n0n;
        { const int wb = J.fp8 ? (lane >> 5) * 33 + (lane & 31) : lane, wst = J.fp8 ? 66 : 65;
#pragma unroll
          for (int i = 0; i < 64; ++i) scr[wb + i * wst] = tv[i]; }
        if (it + NGW < total) { PRO_DECODE(it + NGW, jn, matn, k0n, n0n, srcn, rsn);
#if PROBE_PRO == 2
            { float sink = 0.f;
#pragma unroll
              for (int i = 0; i < 64; ++i) sink += ((const volatile float*)srcn)[(size_t)i * rsn];
              asm volatile("" :: "v"(sink)); }
#endif
#pragma unroll
            for (int i = 0; i < 64; ++i) tv[i] = srcn[(size_t)i * rsn]; }
        asm volatile("s_waitcnt lgkmcnt(0)" ::: "memory");
        if (J.fp8) {
            unsigned char* dst = (unsigned char*)(a->ws + J.dst_off) + (size_t)mat * J.dst_stride;
            const int c = lane & 7, nsub = lane >> 3; const float W8_S = (float)J.fp8;
#pragma unroll
            for (int jj = 0; jj < 4; ++jj) {
                const int n = nsub + 8 * jj; const LAS float* s = scr + (16 * c) * 33 + n;
                u32x4 o;
                o.x = pk4_fp8(s[0] * W8_S, s[33] * W8_S, s[2 * 33] * W8_S, s[3 * 33] * W8_S); o.y = pk4_fp8(s[4 * 33] * W8_S, s[5 * 33] * W8_S, s[6 * 33] * W8_S, s[7 * 33] * W8_S);
                o.z = pk4_fp8(s[8 * 33] * W8_S, s[9 * 33] * W8_S, s[10 * 33] * W8_S, s[11 * 33] * W8_S); o.w = pk4_fp8(s[12 * 33] * W8_S, s[13 * 33] * W8_S, s[14 * 33] * W8_S, s[15 * 33] * W8_S);
                const int drow = cvt_dstrow(J.perm, J.dstrow0 + n0 + n);
                *(u32x4*)(dst + (size_t)drow * J.K + k0 + 16 * c) = o;
#if PROBE_PRO == 1
                asm volatile("" ::: "memory"); *(u32x4*)(dst + (size_t)drow * J.K + k0 + 16 * c) = o;
#endif
            }
        } else {
            bf16_t* dst = (bf16_t*)(a->ws + J.dst_off) + (size_t)mat * J.dst_stride;
            const int c = lane & 7, nsub = lane >> 3;
#pragma unroll
            for (int jj = 0; jj < 8; ++jj) {
                const int n = nsub + 8 * jj; const LAS float* s = scr + (8 * c) * 65 + n;
                u32x4 o; o.x = pk2(s[0], s[65]); o.y = pk2(s[2 * 65], s[3 * 65]); o.z = pk2(s[4 * 65], s[5 * 65]); o.w = pk2(s[6 * 65], s[7 * 65]);
                const int drow = cvt_dstrow(J.perm, J.dstrow0 + n0 + n);
                *(u32x4*)(dst + (size_t)drow * J.K + k0 + 8 * c) = o;
#if PROBE_PRO == 1
                asm volatile("" ::: "memory"); *(u32x4*)(dst + (size_t)drow * J.K + k0 + 8 * c) = o;
#endif
            }
        }
        asm volatile("s_waitcnt lgkmcnt(0)" ::: "memory");
    }
#undef PRO_DECODE
    {
        const float* p = a->in[I_P]; bf16_t* pb = (bf16_t*)(a->ws + WS_PBF);
        const size_t n8 = (size_t)DEPTH * T * 256 / 8;
        for (size_t i = (size_t)blockIdx.x * 512 + tid; i < n8; i += (size_t)gridDim.x * 512) {
            const f32x4 v0 = *(const f32x4*)(p + i * 8), v1 = *(const f32x4*)(p + i * 8 + 4);
            *(u32x4*)(pb + i * 8) = pack8(v0, v1);
        }
    }
    if (blockIdx.x == 4 && tid < 512) { const int ev = tid >> 8, gi = (tid >> 6) & 3, d = tid & 63;
        const float* src = a->in[gi == 0 ? I_DAQN : gi == 1 ? I_DAKN : gi == 2 ? I_NSQN : I_NSKN];
        ((float*)(a->ws + WS_GAINS))[tid] = src[ev * 64 + d]; }
    if (blockIdx.x < 4 && tid < 256) {
        const int m = blockIdx.x; const float* pe = a->in[I_CMPPE] + (size_t)m * 2048; const float* w1 = a->in[I_CMPW1] + (size_t)m * 2048 * 256;
        float s = 0.f;
        for (int k = 0; k < 2048; ++k) s += pe[k] * w1[(size_t)k * 256 + tid];
        ((float*)(a->ws + WS_BIAS1))[m * 256 + tid] = s;
    }
}

DI float row_load_ss(const float* row, int lane, f32x4 (&v)[4]) {
    float ss = 0.f;
#pragma unroll
    for (int j = 0; j < 4; ++j) { v[j] = *(const f32x4*)(row + 4 * lane + 256 * j); ss += (v[j][0] * v[j][0] + v[j][1] * v[j][1]) + (v[j][2] * v[j][2] + v[j][3] * v[j][3]); }
    return wave_sum(ss);
}
DI void row_store_bf16(bf16_t* row, int lane, const f32x4 (&v)[4]) {
#pragma unroll
    for (int j = 0; j < 4; ++j) { u32x2 o; o.x = pk2(v[j][0], v[j][1]); o.y = pk2(v[j][2], v[j][3]); *(u32x2*)(row + 4 * lane + 256 * j) = o; }
}
template <int MODE>
DI void phase_norm(const int WID, ArgsP a, LAS unsigned char* lds, int layer, const void* Hin, const bool hb) {
    const int tid = opaque_tid(WID), lane = tid & 63, wv = __builtin_amdgcn_readfirstlane(tid >> 6);
    LAS float* wt = (LAS float*)lds;
    LAS int* bcl = (LAS int*)(lds + MISC_OFF + MO_WCNT); LAS int* ent = (LAS int*)(lds + MISC_OFF + MO_ENT); LAS float* gat = (LAS float*)(lds + MISC_OFF + MO_GAT);
    LAS float* lgb = (LAS float*)(lds + MISC_OFF + MO_RED);
    bf16_t* XN = (bf16_t*)(a->ws + WS_XN);
    const float* gain = a->in[MODE == 2 ? I_N2G : I_N1G] + layer * 1024;
    constexpr int NQ = MODE == 0 ? 24 : (MODE == 2 ? 32 : 0);
    if (NQ > 0) {
        const float* w = (MODE == 0) ? a->in[I_EVWIN] + (size_t)(layer >> 1) * 1024 * EVIN + 2816 : a->in[I_ROUTW] + (size_t)layer * 1024 * 32;
        const int ldw = (MODE == 0) ? EVIN : 32;
        for (int i = tid; i < 256 * 32; i += 512) { const int q = i & 31, g = i >> 5;
            if (q < NQ) { f32x4 v; v[0] = w[(size_t)(4 * g) * ldw + q]; v[1] = w[(size_t)(4 * g + 1) * ldw + q]; v[2] = w[(size_t)(4 * g + 2) * ldw + q]; v[3] = w[(size_t)(4 * g + 3) * ldw + q];
                *(LAS f32x4*)(wt + q * 1024 + 4 * (g ^ q)) = v; } }
    }
    f32x4 gn[4];
#pragma unroll
    for (int j = 0; j < 4; ++j) gn[j] = *(const f32x4*)(gain + 4 * lane + 256 * j);
    const float rbias = (MODE == 2) ? a->in[I_ROUTB][layer * 32 + (lane & 31)] : 0.f;
    __syncthreads();
    for (int vb = blockIdx.x; vb < NTB; vb += gridDim.x) {
        if (MODE == 2) { if (tid < 32) bcl[tid] = 0; }
        const int t0 = vb * 128 + wv * 16;
        f32x4 na[4], nb[4];
#pragma unroll
        for (int j = 0; j < 4; ++j) { na[j] = ld_h4(Hin, hb, (size_t)t0 * 1024 + 4 * lane + 256 * j); nb[j] = ld_h4(Hin, hb, (size_t)(t0 + 1) * 1024 + 4 * lane + 256 * j); }
#pragma unroll 1
        for (int it = 0; it < 8; ++it) {
            const int ta = t0 + 2 * it;
            f32x4 va[4], vc[4];
#pragma unroll
            for (int j = 0; j < 4; ++j) { va[j] = na[j]; vc[j] = nb[j]; }
            if (it < 7) {
#pragma unroll
                for (int j = 0; j < 4; ++j) { na[j] = ld_h4(Hin, hb, (size_t)(ta + 2) * 1024 + 4 * lane + 256 * j); nb[j] = ld_h4(Hin, hb, (size_t)(ta + 3) * 1024 + 4 * lane + 256 * j); }
            }
            float sa = 0.f, sb = 0.f;
#pragma unroll
            for (int j = 0; j < 4; ++j) { sa += (va[j][0] * va[j][0] + va[j][1] * va[j][1]) + (va[j][2] * va[j][2] + va[j][3] * va[j][3]); sb += (vc[j][0] * vc[j][0] + vc[j][1] * vc[j][1]) + (vc[j][2] * vc[j][2] + vc[j][3] * vc[j][3]); }
#pragma unroll
            for (int o = 1; o < 64; o <<= 1) { sa += shxl(sa, o, lane); sb += shxl(sb, o, lane); }
            const float ra = rsqrtf(sa * (1.0f / 1024.0f) + EPS), rb2 = rsqrtf(sb * (1.0f / 1024.0f) + EPS);
#pragma unroll
            for (int j = 0; j < 4; ++j) { va[j] = va[j] * ra * gn[j]; vc[j] = vc[j] * rb2 * gn[j]; }
            row_store_bf16(XN + (size_t)ta * 1024, lane, va); row_store_bf16(XN + (size_t)(ta + 1) * 1024, lane, vc);
            if (NQ > 0) {
                float x[64];
#pragma unroll
                for (int q = 0; q < 32; ++q) {
                    if (q < NQ) { float s0 = 0.f, s1 = 0.f;
#pragma unroll
                        for (int j = 0; j < 4; ++j) { const f32x4 ww = *(const LAS f32x4*)(wt + q * 1024 + 4 * ((lane + 64 * j) ^ q));
                            s0 += (va[j][0] * ww[0] + va[j][1] * ww[1]) + (va[j][2] * ww[2] + va[j][3] * ww[3]); s1 += (vc[j][0] * ww[0] + vc[j][1] * ww[1]) + (vc[j][2] * ww[2] + vc[j][3] * ww[3]); }
                        x[q] = s0; x[32 + q] = s1;
                        if ((q & 3) == 3) asm volatile("" ::: "memory");
                    } else { x[q] = 0.f; x[32 + q] = 0.f; }
                }
#define RS_STEP(N, BIT) _Pragma("unroll") for (int i = 0; i < (N); ++i) { const bool up = (lane & (BIT)) != 0; const float keep = up ? x[(N) + i] : x[i], send = up ? x[i] : x[(N) + i]; x[i] = keep + shxl(send, (BIT), lane); }
                RS_STEP(32, 32) RS_STEP(16, 16) RS_STEP(8, 8) RS_STEP(4, 4) RS_STEP(2, 2) RS_STEP(1, 1)
#undef RS_STEP
                const float val = x[0];
                if (MODE == 0) { if ((lane & 31) < 24) ((float*)(a->ws + WS_GATES))[(size_t)(ta + (lane >> 5)) * 24 + (lane & 31)] = sigm(val); }
                if (MODE == 2) {
                    const float myv = val + rbias; const int mye = lane & 31;
                    lgb[wv * 64 + lane] = myv;
                    asm volatile("s_waitcnt lgkmcnt(0)" ::: "memory");
                    int rank = 0;
#pragma unroll
                    for (int q4 = 0; q4 < 8; ++q4) { const f32x4 t4 = *(const LAS f32x4*)(lgb + wv * 64 + (lane & 32) + 4 * q4);
#pragma unroll
                        for (int e = 0; e < 4; ++e) { const int j = 4 * q4 + e; rank += ((t4[e] > myv) || (t4[e] == myv && j < mye)) ? 1 : 0; } }
                    const int eb = wv * 64 + (2 * it + (lane >> 5)) * 4;
                    if (rank < 4) { ent[eb + rank] = mye; gat[eb + rank] = myv; }
                    asm volatile("s_waitcnt lgkmcnt(0)" ::: "memory");
                    const f32x4 tv = *(const LAS f32x4*)(gat + eb);
                    const float sum = 1.0f + __expf(tv[1] - tv[0]) + __expf(tv[2] - tv[0]) + __expf(tv[3] - tv[0]);
                    asm volatile("s_waitcnt lgkmcnt(0)" ::: "memory");
                    if (rank < 4) gat[eb + rank] = __expf(myv - tv[0]) / sum;
                    asm volatile("s_waitcnt lgkmcnt(0)" ::: "memory");
                }
            }
        }
        if (MODE == 2) {
            __syncthreads();
            { const int e = ent[wv * 64 + lane];
              const int pos = __hip_atomic_fetch_add(bcl + e, 1, __ATOMIC_RELAXED, __HIP_MEMORY_SCOPE_WORKGROUP);
              const size_t idx = (size_t)(vb * 128 + wv * 16) * 4 + lane;
              ((int*)(a->ws + WS_TOPE))[idx] = e; ((int*)(a->ws + WS_POSB))[idx] = pos; ((float*)(a->ws + WS_GATEW))[idx] = gat[wv * 64 + lane]; }
            __syncthreads();
            if (tid < 32) ((int*)(a->ws + WS_BCNT))[((size_t)layer * NTB + vb) * 32 + tid] = bcl[tid];
            __syncthreads();
        }
    }
}
DI void moe_tables(const int WID, ArgsP a, LAS unsigned char* lds, int layer, int vb) {
    const int tid = opaque_tid(WID);
    LAS int* tot = (LAS int*)(lds + MISC_OFF + MO_TOT); LAS int* base = (LAS int*)(lds + MISC_OFF + MO_BASE); LAS int* ts = (LAS int*)(lds + MISC_OFF + MO_TS);
    LAS int* red = (LAS int*)(lds + MISC_OFF + MO_RED);
    const int* bc = (const int*)(a->ws + WS_BCNT) + (size_t)layer * NTB * 32;
    { const int e = tid & 31, part = tid >> 5; int st = 0, sp = 0;
      for (int blk = part; blk < NTB; blk += 16) { const int v = bc[blk * 32 + e]; st += v; sp += (blk < vb) ? v : 0; }
      red[part * 32 + e] = st; red[512 + part * 32 + e] = sp; }
    __syncthreads();
    if (tid < 32) { int st = 0, sp = 0;
#pragma unroll
        for (int p = 0; p < 16; ++p) { st += red[p * 32 + tid]; sp += red[512 + p * 32 + tid]; }
        tot[tid] = st; base[tid] = sp; }
    __syncthreads();
    if (tid == 0) { int acc = 0; for (int e = 0; e < 32; ++e) { ts[e] = acc; acc += (tot[e] + 255) >> 8; } ts[32] = acc; }
    __syncthreads();
}
DI void phase_moe_slots(const int WID, ArgsP a, LAS unsigned char* lds, int layer) {
    const int tid = opaque_tid(WID), lane = tid & 63, wv = tid >> 6;
    LAS int* base = (LAS int*)(lds + MISC_OFF + MO_BASE); LAS int* ts = (LAS int*)(lds + MISC_OFF + MO_TS);
    const bf16_t* XN = (const bf16_t*)(a->ws + WS_XN); unsigned char* XB = (unsigned char*)(a->ws + WS_XB);
    for (int vb = blockIdx.x; vb < NTB; vb += gridDim.x) {
        moe_tables(WID, a, lds, layer, vb);
#pragma unroll 1
        for (int i = 0; i < 16; ++i) {
            const int t = vb * 128 + wv * 16 + i;
            int dest = 0;
            if (lane < 4) { const int e = ((const int*)(a->ws + WS_TOPE))[(size_t)t * 4 + lane], pos = ((const int*)(a->ws + WS_POSB))[(size_t)t * 4 + lane];
                dest = ts[e] * 256 + base[e] + pos; ((int*)(a->ws + WS_DEST))[(size_t)t * 4 + lane] = dest; }
            const u32x4 r0 = *(const u32x4*)(XN + (size_t)t * 1024 + 8 * lane), r1 = *(const u32x4*)(XN + (size_t)t * 1024 + 512 + 8 * lane);
            u32x2 q0, q1;
            q0.x = pk4_fp8(bflo(r0.x), bfhi(r0.x), bflo(r0.y), bfhi(r0.y)); q0.y = pk4_fp8(bflo(r0.z), bfhi(r0.z), bflo(r0.w), bfhi(r0.w));
            q1.x = pk4_fp8(bflo(r1.x), bfhi(r1.x), bflo(r1.y), bfhi(r1.y)); q1.y = pk4_fp8(bflo(r1.z), bfhi(r1.z), bflo(r1.w), bfhi(r1.w));
#pragma unroll
            for (int k = 0; k < 4; ++k) { const int d = __builtin_amdgcn_readlane(dest, k); unsigned char* o = XB + (size_t)d * 1024; *(u32x2*)(o + 8 * lane) = q0; *(u32x2*)(o + 512 + 8 * lane) = q1; }
        }
        __syncthreads();
    }
}
DI void phase_combine(const int WID, ArgsP a, bf16_t* H) {
    const int tid = opaque_tid(WID), lane = tid & 63, wv = tid >> 6;
    const bf16_t* YB = (const bf16_t*)(a->ws + WS_YB); unsigned char* XN8 = (unsigned char*)(a->ws + WS_XN);
    for (int t = blockIdx.x * 8 + wv; t < T; t += gridDim.x * 8) {
        int dest = 0; float gw = 0.f;
        if (lane < 4) { dest = ((const int*)(a->ws + WS_DEST))[(size_t)t * 4 + lane]; gw = ((const float*)(a->ws + WS_GATEW))[(size_t)t * 4 + lane]; }
        f32x4 v[4];
#pragma unroll
        for (int j = 0; j < 4; ++j) v[j] = ld_h4(H, true, (size_t)t * 1024 + 4 * lane + 256 * j);
#pragma unroll
        for (int k = 0; k < 4; ++k) { const int d = __builtin_amdgcn_readlane(dest, k); const float g = __builtin_bit_cast(float, __builtin_amdgcn_readlane(__builtin_bit_cast(int, gw), k)); const bf16_t* y = YB + (size_t)d * 1024;
#pragma unroll
            for (int j = 0; j < 4; ++j) { const u32x2 w = *(const u32x2*)(y + 4 * lane + 256 * j); v[j][0] += g * bflo(w.x); v[j][1] += g * bfhi(w.x); v[j][2] += g * bflo(w.y); v[j][3] += g * bfhi(w.y); } }
        float ss = 0.f;
#pragma unroll
        for (int j = 0; j < 4; ++j) { u32x2 hw; hw.x = pk2(v[j][0], v[j][1]); hw.y = pk2(v[j][2], v[j][3]); *(u32x2*)(H + (size_t)t * 1024 + 4 * lane + 256 * j) = hw; ss += (v[j][0] * v[j][0] + v[j][1] * v[j][1]) + (v[j][2] * v[j][2] + v[j][3] * v[j][3]); }
        ss = wave_sum(ss);
        const float rstd = rsqrtf(ss * (1.0f / 1024.0f) + EPS);
#pragma unroll
        for (int j = 0; j < 4; ++j) v[j] = v[j] * rstd;
#pragma unroll
        for (int j = 0; j < 4; ++j) *(unsigned*)(XN8 + (size_t)t * 1024 + 4 * lane + 256 * j) = pk4_fp8(v[j][0], v[j][1], v[j][2], v[j][3]);
    }
}
DI void phase_cmp2(const int WID, ArgsP a, LAS unsigned char* lds, int ev) {
    const int tid = opaque_tid(WID), lane = tid & 63, wv = __builtin_amdgcn_readfirstlane(tid >> 6);
    const bf16_t* HID = (const bf16_t*)(a->ws + WS_HID); bf16_t* KCMP = (bf16_t*)(a->ws + WS_KCMP); bf16_t* VCMPT = (bf16_t*)(a->ws + WS_VCMPT);
    const float kg = a->in[I_NSKN][ev * 64 + lane];
    LAS float* wl = (LAS float*)lds;
    for (int i = tid; i < 2 * 256 * 64 / 4; i += 512) *(LAS f32x4*)(wl + 4 * i) = *(const f32x4*)(a->in[I_CMPW2] + (size_t)ev * 2 * 256 * 64 + 4 * i);
    __syncthreads();
    for (int gi = blockIdx.x * 8 + wv; gi < 2048; gi += gridDim.x * 8) {
        const int kv = gi >> 10, row0 = (gi & 1023) * 4;
        const bf16_t* hrow = HID + ((size_t)kv * 4096 + row0) * 256;
        const LAS float* w2 = wl + kv * 256 * 64 + lane;
        float s[4] = {0.f, 0.f, 0.f, 0.f};
#pragma unroll 2
        for (int k = 0; k < 256; k += 8) {
            u32x4 hw[4];
#pragma unroll
            for (int r = 0; r < 4; ++r) hw[r] = *(const u32x4*)(hrow + r * 256 + k);
            float wv8[8];
#pragma unroll
            for (int j = 0; j < 8; ++j) wv8[j] = w2[(k + j) * 64];
#pragma unroll
            for (int r = 0; r < 4; ++r)
                s[r] += bflo(hw[r].x) * wv8[0] + bfhi(hw[r].x) * wv8[1] + bflo(hw[r].y) * wv8[2] + bfhi(hw[r].y) * wv8[3] + bflo(hw[r].z) * wv8[4] + bfhi(hw[r].z) * wv8[5] + bflo(hw[r].w) * wv8[6] + bfhi(hw[r].w) * wv8[7];
        }
#pragma unroll
        for (int r = 0; r < 4; ++r) {
            const int row = row0 + r, bg = row >> 7, n = row & 127;
            float v = (n == 127) ? 0.f : s[r];
            if (kv == 0) { const float ss = wave_sum(v * v); const float o = v * rsqrtf(ss * (1.0f / 64.0f) + EPS) * kg;
                KCMP[((size_t)bg * 128 + n) * 64 + lane] = (bf16_t)(pk2(o, 0.f) & 0xffffu); }
            else VCMPT[((size_t)bg * 96 + lane) * 128 + vperm16(n)] = (bf16_t)(pk2(v, 0.f) & 0xffffu);
        }
    }
    for (int i = blockIdx.x * 512 + tid; i < 32 * 32 * 128; i += gridDim.x * 512) {
        const int n = i & 127, j = (i >> 7) & 31, bg = i >> 12;
        float o = 0.f;
        if (n < 127) { const int d = n - 4 * j; if (d >= 0 && d <= 2) o = 1.0f; else if (d == 3 || d == -1) o = 0.5f; }
        VCMPT[((size_t)bg * 96 + 64 + j) * 128 + vperm16(n)] = (bf16_t)(pk2(o, 0.f) & 0xffffu);
    }
}
DI void topk_one(const float* IMPH, unsigned* SELM, int t, int g) {
    const int b = t >> 11, s = t & 2047, cur = s >> 6;
    unsigned mask;
    if (cur < 16) mask = (2u << cur) - 1u;
    else {
        float sc[32];
#pragma unroll
        for (int j4 = 0; j4 < 8; ++j4) { f32x4 acc = {0.f, 0.f, 0.f, 0.f};
#pragma unroll
            for (int r = 0; r < 4; ++r) acc += *(const f32x4*)(IMPH + ((size_t)t * 8 + g * 4 + r) * 32 + 4 * j4);
#pragma unroll
            for (int q = 0; q < 4; ++q) sc[4 * j4 + q] = acc[q]; }
#pragma unroll
        for (int j = 0; j < 32; ++j) { const bool forced = (j == 0) || (j == cur) || (j == cur - 1); sc[j] = (j > cur) ? NEGF : (sc[j] + (forced ? 1e4f : 0.f)); }
        mask = 0u;
#pragma unroll
        for (int j = 0; j < 32; ++j) { int rank = 0;
#pragma unroll
            for (int k = 0; k < 32; ++k) rank += ((sc[k] > sc[j]) || (sc[k] == sc[j] && k < j)) ? 1 : 0;
            mask |= (rank < 16) ? (1u << j) : 0u; }
    }
    SELM[((size_t)(b * 2 + g)) * 2048 + s] = mask;
}
DI void phase_topk(const int WID, ArgsP a) {
    for (int i = blockIdx.x * 512 + opaque_tid(WID); i < T * 2; i += gridDim.x * 512) topk_one((const float*)(a->ws + WS_IMPH), (unsigned*)(a->ws + WS_SELM), i >> 1, i & 1);
}
DI void phase_cmp_topk(const int WID, ArgsP a, LAS unsigned char* lds) {
    const bf16_t* QN = (const bf16_t*)(a->ws + WS_QN);
    float* IMPH = (float*)(a->ws + WS_IMPH);
    for (int u = blockIdx.x; u < 256; u += gridDim.x) {
        const int qb = 7 - (u >> 5), bg = u & 31, b = bg >> 1, g = bg & 1, q0 = qb * 256; const size_t t0 = (size_t)b * 2048 + q0;
#pragma unroll 1
        for (int r = 0; r < 4; ++r) { const int hd = g * 4 + r;
            attn_unit<96, 3>(WID, lds, QN + t0 * 512 + hd * 64, 512, (const bf16_t*)(a->ws + WS_KCMP) + (size_t)bg * 128 * 64, 64,
                             (const bf16_t*)(a->ws + WS_VCMPT) + (size_t)bg * 96 * 128, 128, q0, 0.f, 0, nullptr,
                             (bf16_t*)(a->ws + WS_OC) + t0 * 512 + hd * 64, 512, IMPH + (t0 * 8 + hd) * 32); }
        asm volatile("s_waitcnt vmcnt(0)" ::: "memory");
        __syncthreads();
        { const int tid = opaque_tid(WID); if (tid < 256) topk_one(IMPH, (unsigned*)(a->ws + WS_SELM), (int)t0 + tid, g); }
        __syncthreads();
    }
}
DI void phase_mixprep(const int WID, ArgsP a, int layer) {
    const int tid = opaque_tid(WID), lane = tid & 63, wv = tid >> 6, ev = layer >> 1;
    const float* dl = a->in[I_DALAM] + ev * 256;
    const float s1 = wave_sum(dl[lane] * dl[64 + lane]), s2 = wave_sum(dl[128 + lane] * dl[192 + lane]);
    const float lam_init = 0.8f - 0.6f * expf(-0.3f * (float)layer);
    const float lam = expf(s1) - expf(s2) + lam_init;
    const float* og = a->in[I_DAOUTG] + ev * 128;
    const bf16_t* OD = (const bf16_t*)(a->ws + WS_OD); const bf16_t* OC = (const bf16_t*)(a->ws + WS_OC); const bf16_t* OS = (const bf16_t*)(a->ws + WS_OS); const bf16_t* OW = (const bf16_t*)(a->ws + WS_OW);
    const float* GT = (const float*)(a->ws + WS_GATES); bf16_t* AMIX = (bf16_t*)(a->ws + WS_AMIX);
    const int h = lane >> 4, dv = (lane & 15) * 8;
    f32x4 g0 = *(const f32x4*)(og + dv), g1 = *(const f32x4*)(og + dv + 4);
    for (int t = blockIdx.x * 8 + wv; t < T; t += gridDim.x * 8) {
        { const u32x4 w1 = *(const u32x4*)(OD + (size_t)t * 1024 + h * 128 + dv), w2 = *(const u32x4*)(OD + (size_t)t * 1024 + (4 + h) * 128 + dv);
          f32x4 d0, d1;
          d0[0] = bflo(w1.x) - lam * bflo(w2.x); d0[1] = bfhi(w1.x) - lam * bfhi(w2.x); d0[2] = bflo(w1.y) - lam * bflo(w2.y); d0[3] = bfhi(w1.y) - lam * bfhi(w2.y);
          d1[0] = bflo(w1.z) - lam * bflo(w2.z); d1[1] = bfhi(w1.z) - lam * bfhi(w2.z); d1[2] = bflo(w1.w) - lam * bflo(w2.w); d1[3] = bfhi(w1.w) - lam * bfhi(w2.w);
          float ss = (d0[0] * d0[0] + d0[1] * d0[1]) + (d0[2] * d0[2] + d0[3] * d0[3]) + (d1[0] * d1[0] + d1[1] * d1[1]) + (d1[2] * d1[2] + d1[3] * d1[3]);
          ss += shx(ss, 1); ss += shx(ss, 2); ss += shx(ss, 4); ss += shx(ss, 8);
          const float rs = rsqrtf(ss * (1.0f / 128.0f) + EPS) * (1.0f - lam_init);
          *(u32x4*)(AMIX + (size_t)t * 1024 + h * 128 + dv) = pack8(d0 * rs * g0, d1 * rs * g1); }
        { const int hd = lane >> 3, dq = (lane & 7) * 8; const size_t o = (size_t)t * 512 + hd * 64 + dq;
          const float ga = GT[(size_t)t * 24 + hd * 3], gb = GT[(size_t)t * 24 + hd * 3 + 1], gc = GT[(size_t)t * 24 + hd * 3 + 2];
          const u32x4 c = *(const u32x4*)(OC + o), s = *(const u32x4*)(OS + o), w = *(const u32x4*)(OW + o);
          f32x4 r0, r1;
          r0[0] = ga * bflo(c.x) + gb * bflo(s.x) + gc * bflo(w.x); r0[1] = ga * bfhi(c.x) + gb * bfhi(s.x) + gc * bfhi(w.x);
          r0[2] = ga * bflo(c.y) + gb * bflo(s.y) + gc * bflo(w.y); r0[3] = ga * bfhi(c.y) + gb * bfhi(s.y) + gc * bfhi(w.y);
          r1[0] = ga * bflo(c.z) + gb * bflo(s.z) + gc * bflo(w.z); r1[1] = ga * bfhi(c.z) + gb * bfhi(s.z) + gc * bfhi(w.z);
          r1[2] = ga * bflo(c.w) + gb * bflo(s.w) + gc * bflo(w.w); r1[3] = ga * bfhi(c.w) + gb * bfhi(s.w) + gc * bfhi(w.w);
          *(u32x4*)(AMIX + (size_t)t * 1024 + 512 + hd * 64 + dq) = pack8(r0, r1); }
    }
}
DI void phase_scan(const int WID, ArgsP a) {
    const bf16_t* UT = (const bf16_t*)(a->ws + WS_UT); bf16_t* VS = (bf16_t*)(a->ws + WS_VS);
    for (int i = blockIdx.x * 512 + opaque_tid(WID); i < 64 * 512 * 32; i += gridDim.x * 512) {
        const int d8 = i & 31, f = (i >> 5) & 511, bh = i >> 14, h = bh & 3;
        const float dec = exp2f(256.0f * ret_lg2(h));
        f32x4 S0 = {0.f, 0.f, 0.f, 0.f}, S1 = S0;
        u32x4 un = *(const u32x4*)(UT + ((size_t)bh * 8) * 131072 + (size_t)f * 256 + 8 * d8);
#pragma unroll 1
        for (int n = 0; n < 8; ++n) {
            const size_t z = (size_t)bh * 8 + n;
            const u32x4 u = un;
            if (n < 7) un = *(const u32x4*)(UT + (z + 1) * 131072 + (size_t)f * 256 + 8 * d8);
            *(u32x4*)(VS + (z * 512 + f) * 512 + 256 + 8 * d8) = pack8(S0, S1);
            S0[0] = (S0[0] + bflo(u.x)) * dec; S0[1] = (S0[1] + bfhi(u.x)) * dec; S0[2] = (S0[2] + bflo(u.y)) * dec; S0[3] = (S0[3] + bfhi(u.y)) * dec;
            S1[0] = (S1[0] + bflo(u.z)) * dec; S1[1] = (S1[1] + bfhi(u.z)) * dec; S1[2] = (S1[2] + bflo(u.w)) * dec; S1[3] = (S1[3] + bfhi(u.w)) * dec;
        }
    }
}
DI void phase_normgate(const int WID, ArgsP a, int od) {
    const int tid = opaque_tid(WID), lane = tid & 63, wv = tid >> 6;
    const bf16_t* Y = (const bf16_t*)(a->ws + WS_Y); const bf16_t* GG = (const bf16_t*)(a->ws + WS_GG); bf16_t* YG = (bf16_t*)(a->ws + WS_YG);
    const float* og = a->in[I_RETG] + od * 512;
    const f32x4 g0 = *(const f32x4*)(og + 8 * lane), g1 = *(const f32x4*)(og + 8 * lane + 4);
    for (int t = blockIdx.x * 8 + wv; t < T; t += gridDim.x * 8) {
#pragma unroll
        for (int h = 0; h < 4; ++h) {
            const size_t o = (size_t)t * 2048 + h * 512 + 8 * lane;
            const u32x4 yw = *(const u32x4*)(Y + o), gw = *(const u32x4*)(GG + o);
            f32x4 y0 = {bflo(yw.x), bfhi(yw.x), bflo(yw.y), bfhi(yw.y)}, y1 = {bflo(yw.z), bfhi(yw.z), bflo(yw.w), bfhi(yw.w)};
            const f32x4 q0 = {bflo(gw.x), bfhi(gw.x), bflo(gw.y), bfhi(gw.y)}, q1 = {bflo(gw.z), bfhi(gw.z), bflo(gw.w), bfhi(gw.w)};
            float ss = (y0[0] * y0[0] + y0[1] * y0[1]) + (y0[2] * y0[2] + y0[3] * y0[3]) + (y1[0] * y1[0] + y1[1] * y1[1]) + (y1[2] * y1[2] + y1[3] * y1[3]);
            ss = wave_sum(ss);
            const float rs = rsqrtf(ss * (1.0f / 512.0f) + EPS);
            *(u32x4*)(YG + o) = pack8(y0 * rs * g0 * q0, y1 * rs * g1 * q1);
        }
    }
}
DI int snake_unit(int rnd, int G, int c) { return (rnd & 1) ? rnd * G + (G - 1 - c) : rnd * G + c; }
DI float absmax64(const float* g, int lane) { float m = fabsf(g[lane]);
#pragma unroll
    for (int o = 1; o < 64; o <<= 1) m = fmaxf(m, shx(m, o));
    return m; }
constexpr int CW_AQ = 8192;
template <int MODE>
DI void phase_attn(const int WID, ArgsP a, LAS unsigned char* lds, int ev) {
    const int tid = opaque_tid(WID), lane = tid & 63;
    const bf16_t* QD = (const bf16_t*)(a->ws + WS_QD); const bf16_t* KD = (const bf16_t*)(a->ws + WS_KD); const bf16_t* QN = (const bf16_t*)(a->ws + WS_QN);
    LAS int* ord = (LAS int*)(lds + MISC_OFF + MO_ENT); LAS int* cst = (LAS int*)(lds + MISC_OFF + MO_GAT); volatile LAS int* cur = (volatile LAS int*)(lds + MISC_OFF + MO_TOT);
    float sb2 = 0.f;
    if (MODE != 3) { const float gq = absmax64(a->in[MODE == 0 ? I_DAQN : I_NSQN] + ev * 64, lane), gk = absmax64(a->in[MODE == 0 ? I_DAKN : I_NSKN] + ev * 64, lane);
        sb2 = 16.0f * gq * gk + 28.0f; }
    if (tid < 64) { const int qb = tid >> 3, hd = tid & 7, q0 = qb * 256; int lo = 0, hi = 4 * qb + 4;
        if (MODE == 3) { lo = 0; hi = 2; }
        else { const float slope = (MODE == 0) ? exp2f(-2.0f * (float)((hd & 3) + 1)) : exp2f(-(float)(hd + 1)); const int dcut = (int)fminf(sb2 / slope + 1.0f, 100000.0f);
            const int kmin = q0 - dcut; lo = kmin > 0 ? (kmin >> 6) : 0;
            if (MODE == 2) { const int lk = q0 - 511; const int lw = lk > 0 ? (lk >> 6) : 0; lo = lw > lo ? lw : lo; } }
        cst[tid] = hi - lo; }
    __syncthreads();
    if (tid < 64) { const int mine = cst[tid]; int rank = 0;
        for (int j = 0; j < 64; ++j) { const int o = cst[j]; rank += (o > mine || (o == mine && j < tid)) ? 1 : 0; }
        ord[rank] = tid; }
    __syncthreads();
    unsigned* ctr = (unsigned*)(a->ws + WS_CTL) + CW_AQ + 64 * 8 * (ev * 4 + MODE);
    const int x0 = (int)(xb_xcc_id() & 7u);
    volatile LAS int* stl = (volatile LAS int*)(lds + MISC_OFF + MO_BASE);
    bool own = true; int nst = 0;
    for (;;) {
        if (tid < 64) {
            int uu_ = -1;
            if (own) { int v = 128; if (lane == 0) v = (int)__hip_atomic_fetch_add(ctr + 64 * x0, 1u, __ATOMIC_RELAXED, __HIP_MEMORY_SCOPE_AGENT);
                v = __builtin_amdgcn_readfirstlane(v); if (v < 128) uu_ = x0 * 128 + v; else own = false; }
            if (!own && uu_ < 0) {
                if (nst == 0) { int v = 128; const int xq_ = (x0 + lane) & 7;
                    if (lane >= 1 && lane < 8) v = (int)__hip_atomic_fetch_add(ctr + 64 * xq_, 1u, __ATOMIC_RELAXED, __HIP_MEMORY_SCOPE_AGENT);
                    const unsigned long long got = __ballot(v < 128); nst = __popcll(got);
                    if (v < 128) stl[__popcll(got & ((1ull << lane) - 1ull))] = xq_ * 128 + v;
                    asm volatile("s_waitcnt lgkmcnt(0)" ::: "memory"); }
                if (nst > 0) { --nst; uu_ = stl[nst]; }
            }
            if (lane == 0) *cur = uu_;
        }
        __syncthreads();
        const int uu = *cur; if (uu < 0) break;
        const int xq = uu >> 7, v = uu & 127, combo = ord[v >> 1], jb = v & 1, qb = combo >> 3, hd = combo & 7, q0 = qb * 256;
        const int b = (MODE == 0) ? (((xq - 2 * (hd & 3)) & 7) + 8 * jb) : (((xq - 4 * (hd >> 2)) & 7) + 8 * jb);
        const size_t t0 = (size_t)b * 2048 + q0;
        if (MODE == 0) {
            const float slope = exp2f(-2.0f * (float)((hd & 3) + 1)); const int dcut = (int)fminf(sb2 / slope + 1.0f, 100000.0f);
            attn_unit<128, 0>(WID, lds, QD + t0 * 512 + hd * 64, 512, KD + (size_t)b * 2048 * 512 + hd * 64, 512,
                              (const bf16_t*)(a->ws + WS_VAT) + (size_t)(b * 4 + (hd & 3)) * 128 * 2048, 2048, q0, slope, dcut, nullptr,
                              (bf16_t*)(a->ws + WS_OD) + t0 * 1024 + hd * 128, 1024, nullptr);
        } else if (MODE == 1 || MODE == 2) {
            const int g = hd >> 2; const float slope = exp2f(-(float)(hd + 1)); const int dcut = (int)fminf(sb2 / slope + 1.0f, 100000.0f);
            const bf16_t* Kb = (const bf16_t*)(a->ws + (MODE == 1 ? WS_KSB : WS_KWB)) + (size_t)(b * 2 + g) * 2048 * 64;
            const bf16_t* Vb = (const bf16_t*)(a->ws + (MODE == 1 ? WS_VST : WS_VWT)) + (size_t)(b * 2 + g) * 64 * 2048;
            attn_unit<64, MODE>(WID, lds, QN + t0 * 512 + hd * 64, 512, Kb, 64, Vb, 2048, q0, slope, dcut,
                                (const unsigned*)(a->ws + WS_SELM) + (size_t)(b * 2 + g) * 2048 + q0,
                                (bf16_t*)(a->ws + (MODE == 1 ? WS_OS : WS_OW)) + t0 * 512 + hd * 64, 512, nullptr);
        } else {
            const int g = hd >> 2;
            attn_unit<96, 3>(WID, lds, QN + t0 * 512 + hd * 64, 512, (const bf16_t*)(a->ws + WS_KCMP) + (size_t)(b * 2 + g) * 128 * 64, 64,
                             (const bf16_t*)(a->ws + WS_VCMPT) + (size_t)(b * 2 + g) * 96 * 128, 128, q0, 0.f, 0, nullptr,
                             (bf16_t*)(a->ws + WS_OC) + t0 * 512 + hd * 64, 512, (float*)(a->ws + WS_IMPH) + (t0 * 8 + hd) * 32);
        }
    }
}

constexpr int PPL = 15;
constexpr int NPHASE = 1 + DEPTH * PPL;
__global__ void __launch_bounds__(512, 2) mk_fwd(Args a_unused) {
    ArgsP a = opaque_args();
    extern __shared__ __attribute__((aligned(16))) unsigned char lds_raw[];
    LAS unsigned char* lds = (LAS unsigned char*)lds_raw;
    const int tid = threadIdx.x, G = gridDim.x, c = blockIdx.x;
    const int WID = __builtin_amdgcn_readfirstlane(tid >> 6);
    volatile LAS unsigned* misc = (volatile LAS unsigned*)(lds + MISC_OFF);
    if (tid < 4) misc[tid] = 0u;
    __syncthreads();
    unsigned* ctl = (unsigned*)(a->ws + WS_CTL);
    XcdBarrier bar; bar.bar = ctl + CW_BAR; bar.x = 0; bar.st = misc;
    const int ph_lo = a->ph_lo, ph_hi = a->ph_hi;
    const bool multi = (ph_hi - ph_lo) > 1;
    if (multi) bar = xcd_barrier_post(WID, ctl + CW_BAR, misc);
    bool first = true;
#define PHASE_BEGIN(k, id) if ((DBG_ONLY < 0 || DBG_ONLY == (id)) && (k) >= ph_lo && (k) < ph_hi && (k) <= DBG_LAST_PHASE) { if (!first) { xcd_barrier(WID, bar); if (PROBE_MASK >> 31) xcd_barrier(WID, bar); } first = false; \
        ArgsP a = opaque_args(); unsigned char* ws = a->ws; bf16_t* XN = (bf16_t*)(ws + WS_XN); bf16_t* H = (bf16_t*)(ws + WS_HB); const bool hb = layer != 0; const void* Hin = hb ? (const void*)H : (const void*)a->in[I_X]; \
        const LAS int* ts = (const LAS int*)(lds + MISC_OFF + MO_TS); (void)XN; (void)H; (void)Hin; (void)ts; (void)hb; \
        const bool probe_ = ((PROBE_MASK >> (id)) & 1u) != 0u; const unsigned long long pt0_ = probe_ ? __builtin_amdgcn_s_memrealtime() : 0ull;
#define PHASE_END if (probe_) { const unsigned long long pt1_ = __builtin_amdgcn_s_memrealtime(), pd_ = pt1_ - pt0_; while (__builtin_amdgcn_s_memrealtime() - pt1_ < pd_) __builtin_amdgcn_s_sleep(8); } }
    { const int layer = 0; PHASE_BEGIN(0, 0) phase_prologue(WID, a, lds); PHASE_END }
#pragma unroll 1
    for (int layer = 0; layer < DEPTH; ++layer) {
        const int pb = 1 + layer * PPL; const bool even = (layer & 1) == 0; const int ev = layer >> 1, od = layer >> 1;
        if (even) {
            PHASE_BEGIN(pb + 0, 1) phase_norm<0>(WID, a, lds, layer, Hin, hb); PHASE_END
            PHASE_BEGIN(pb + 1, 2) {
                { ProbPlain P{XN, (const bf16_t*)(ws + WS_EVNAT) + (size_t)ev * 2048 * 1024, 1024, 1024, 1024}; pg8::Sched S; S.init(T / 256, 8, G, c);
                  EpiEvNat E{ws, (const float*)(ws + WS_GAINS) + ev * 256};
                  pg8::gemm_phase(WID, lds, P, S, E); }
                { ProbPlain P{(const bf16_t*)(ws + WS_EVSW) + (size_t)ev * 768 * 1024, XN, 1024, 1024, 1024}; pg8::Sched S; S.init(3, T / 256, G, c);
                  EpiEvSw E{ws};
                  pg8::gemm_phase(WID, lds, P, S, E); }
            } PHASE_END
            PHASE_BEGIN(pb + 2, 3) {
                { ProbCmp1 P{(const bf16_t*)(ws + WS_KCB), (const bf16_t*)(ws + WS_VCB), (const bf16_t*)(ws + WS_CMP1) + (size_t)ev * 2 * 256 * 2048, 1024, 2048, 2048}; pg8::Sched S; S.init(32, 1, G, c);
                  EpiCmp1 E{(bf16_t*)(ws + WS_HID), (const float*)(ws + WS_BIAS1) + ev * 512};
                  pg8::gemm_phase(WID, lds, P, S, E); }
                phase_attn<0>(WID, a, lds, ev);
                phase_attn<2>(WID, a, lds, ev);
            } PHASE_END
            PHASE_BEGIN(pb + 3, 4) phase_cmp2(WID, a, lds, ev); PHASE_END
            PHASE_BEGIN(pb + 4, 5) phase_attn<3>(WID, a, lds, ev); PHASE_END
            PHASE_BEGIN(pb + 5, 6) phase_topk(WID, a); PHASE_END
            PHASE_BEGIN(pb + 6, 7) phase_attn<1>(WID, a, lds, ev); PHASE_END
            PHASE_BEGIN(pb + 7, 8) phase_mixprep(WID, a, layer); PHASE_END
            PHASE_BEGIN(pb + 8, 9) {
                ProbPlain P{(const bf16_t*)(ws + WS_AMIX), (const bf16_t*)(ws + WS_EVOUT) + (size_t)ev * 1024 * 1024, 1024, 1024, 1024}; pg8::Sched S; S.init(T / 256, 4, G, c);
                EpiResid E{Hin, H, hb}; pg8::gemm_phase(WID, lds, P, S, E);
            } PHASE_END
        } else {
            PHASE_BEGIN(pb + 0, 11) phase_norm<1>(WID, a, lds, layer, Hin, hb); PHASE_END
            PHASE_BEGIN(pb + 1, 12) {
                { ProbPlain P{XN, (const bf16_t*)(ws + WS_ODNAT) + (size_t)od * 4096 * 1024, 1024, 1024, 1024}; pg8::Sched S; S.init(T / 256, 16, G, c);
                  EpiOdNat E{ws}; pg8::gemm_phase(WID, lds, P, S, E); }
                { ProbPlain P{(const bf16_t*)(ws + WS_ODSW) + (size_t)od * 2048 * 1024, XN, 1024, 1024, 1024}; pg8::Sched S; S.init(8, T / 256, G, c);
                  EpiOdSw E{ws}; pg8::gemm_phase(WID, lds, P, S, E); }
            } PHASE_END
            PHASE_BEGIN(pb + 2, 13) {
                { ProbUT P{(const bf16_t*)(ws + WS_VS), (const bf16_t*)(ws + WS_KT), 512, 256, 256}; SchedSeq S; S.init(G, c);
                  EpiUTScan E{(bf16_t*)(ws + WS_VS)}; pg8::gemm_phase(WID, lds, P, S, E); }
                { ProbAtt P{(const bf16_t*)(ws + WS_AQ), (const bf16_t*)(ws + WS_KP), 2048, 1024, 256}; pg8::Sched S; const int nb = G / 2 > 0 ? G / 2 : 1;
                  if (c >= nb || G < 2) S.init(512, 1, G < 2 ? 1 : G - nb, G < 2 ? 0 : c - nb); else S.init(0, 1, 1, 0);
                  EpiAtt E{(bf16_t*)(ws + WS_AQ)}; pg8::gemm_phase(WID, lds, P, S, E); }
            } PHASE_END
            PHASE_BEGIN(pb + 4, 15) {
                ProbY P{(const bf16_t*)(ws + WS_AQ), (const bf16_t*)(ws + WS_VS), 2048, 512, 512}; pg8::Sched S; S.init(512, 2, G, c);
                EpiY E{(bf16_t*)(ws + WS_Y)}; pg8::gemm_phase(WID, lds, P, S, E);
            } PHASE_END
            PHASE_BEGIN(pb + 5, 16) phase_normgate(WID, a, od); PHASE_END
            PHASE_BEGIN(pb + 8, 19) {
                ProbPlain P{(const bf16_t*)(ws + WS_YG), (const bf16_t*)(ws + WS_ODOUT) + (size_t)od * 1024 * 2048, 2048, 2048, 2048}; pg8::Sched S; S.init(T / 256, 4, G, c);
                EpiResid E{Hin, H, hb}; pg8::gemm_phase(WID, lds, P, S, E);
            } PHASE_END
        }
        PHASE_BEGIN(pb + 9, 20) phase_norm<2>(WID, a, lds, layer, H, true); PHASE_END
        PHASE_BEGIN(pb + 10, 21) phase_moe_slots(WID, a, lds, layer); PHASE_END
        PHASE_BEGIN(pb + 11, 22) {
            moe_tables(WID, a, lds, layer, -1);
            { ProbMoe8 P{(const unsigned char*)(ws + WS_XB), (const unsigned char*)(ws + WS_WGU) + (size_t)layer * 32 * 2048 * 1024, ts, 2048, 512, 512, 512}; pg8::Sched S; S.init(ts[32], 8, G, c);
              EpiGU E{(unsigned char*)(ws + WS_ACT), a->in[I_BGU] + (size_t)layer * 32 * 2048, ts}; pg8::gemm_phase(WID, lds, P, S, E); }
            { ProbPlain P{(const bf16_t*)(ws + WS_PBF) + (size_t)layer * T * 256, (const bf16_t*)(ws + WS_WPP) + (size_t)layer * 1024 * 256, 256, 256, 256}; pg8::Sched S; S.init(T / 256, 4, G, c);
              EpiPP E{(bf16_t*)(ws + WS_PP)}; pg8::gemm_phase(WID, lds, P, S, E); }
        } PHASE_END
        PHASE_BEGIN(pb + 12, 23) {
            moe_tables(WID, a, lds, layer, -1);
            ProbMoe8 P{(const unsigned char*)(ws + WS_ACT), (const unsigned char*)(ws + WS_WDN) + (size_t)layer * 32 * 1024 * 1024, ts, 1024, 512, 512, 512}; pg8::Sched S; S.init(ts[32], 4, G, c);
            EpiDN E{(bf16_t*)(ws + WS_YB), a->in[I_BDN] + (size_t)layer * 32 * 1024, ts}; pg8::gemm_phase(WID, lds, P, S, E);
        } PHASE_END
        PHASE_BEGIN(pb + 13, 24) phase_combine(WID, a, H); PHASE_END
        PHASE_BEGIN(pb + 14, 25) {
            ProbPlain8 P{(const unsigned char*)(ws + WS_XN), (const unsigned char*)(ws + WS_WPG) + (size_t)layer * 1024 * 1024, 512, 512, 512}; pg8::Sched S; S.init(T / 256, 4, G, c);
            EpiPLE E{H, (const bf16_t*)(ws + WS_PP), (layer == DEPTH - 1) ? a->out : nullptr}; pg8::gemm_phase(WID, lds, P, S, E);
        } PHASE_END
    }
#undef PHASE_BEGIN
#undef PHASE_END
}

extern "C" void kernel_launch(void* const* d_in, const int* in_sizes, int n_in, void* d_out, int out_size, void* d_ws, size_t ws_size, hipStream_t stream) {
    static int grid = 0;
    if (grid == 0) {
        if (n_in != 26 || out_size != T * D || ws_size < WS_END) { fprintf(stderr, "kernel_launch: unexpected problem (n_in %d, out %d, ws %zu < %zu); nothing launched\n", n_in, out_size, ws_size, (size_t)WS_END); grid = -1; return; }
        int dev = 0, cus = 0, per_cu = 0;
        if (hipGetDevice(&dev) != hipSuccess || hipDeviceGetAttribute(&cus, hipDeviceAttributeMultiprocessorCount, dev) != hipSuccess) { grid = -1; return; }
        if (hipFuncSetAttribute((const void*)mk_fwd, hipFuncAttributeMaxDynamicSharedMemorySize, LDS_BYTES) != hipSuccess) { fprintf(stderr, "kernel_launch: hipFuncSetAttribute failed\n"); grid = -1; return; }
        if (hipOccupancyMaxActiveBlocksPerMultiprocessor(&per_cu, (const void*)mk_fwd, 512, LDS_BYTES) != hipSuccess || per_cu < 1) fprintf(stderr, "kernel_launch: occupancy query reports %d\n", per_cu);
        (void)hipGetLastError();
        grid = cus > 256 ? 256 : cus;
    }
    if (grid < 0) return;
    (void)hipMemsetAsync((char*)d_ws + WS_CTL, 0, CTL_BYTES, stream);
    Args a; memset(&a, 0, sizeof(a));
    for (int i = 0; i < 26; ++i) a.in[i] = (const float*)d_in[i];
    a.out = (float*)d_out; a.ws = (unsigned char*)d_ws;
#if MK_SINGLE
    a.ph_lo = 0; a.ph_hi = NPHASE;
    hipLaunchKernelGGL(mk_fwd, dim3(grid), dim3(512), LDS_BYTES, stream, a);
#else
    for (int ph = 0; ph < NPHASE && ph <= DBG_LAST_PHASE; ++ph) {
        const int l = (ph - 1) / PPL, k = (ph - 1) % PPL;
        if (ph > 0 && (l & 1) && (k == 6 || k == 7)) continue;
        a.ph_lo = ph; a.ph_hi = ph + 1;
        hipLaunchKernelGGL(mk_fwd, dim3(grid), dim3(512), LDS_BYTES, stream, a);
    }
#endif
}
```

```cpp
#include <hip/hip_runtime.h>
#include <cstdio>
#include <cstdint>
#include <cstring>

#define LAS __attribute__((address_space(3)))
#define DI __device__ __forceinline__
typedef unsigned short bf16_t;
typedef short bf16x8 __attribute__((ext_vector_type(8)));
typedef short s16x4 __attribute__((ext_vector_type(4)));
typedef float f32x2 __attribute__((ext_vector_type(2)));
typedef float f32x4 __attribute__((ext_vector_type(4)));
typedef float f32x16 __attribute__((ext_vector_type(16)));
typedef unsigned u32x2 __attribute__((ext_vector_type(2)));
typedef unsigned u32x4 __attribute__((ext_vector_type(4)));
typedef __bf16 bfv2 __attribute__((ext_vector_type(2)));
typedef int i32x4 __attribute__((ext_vector_type(4)));
typedef int i32x8 __attribute__((ext_vector_type(8)));

#ifndef MK_SINGLE
#define MK_SINGLE 1
#endif
#ifndef DBG_ONLY
#define DBG_ONLY -1
#endif
#ifndef PROBE_MASK
#define PROBE_MASK 0u
#endif
#ifndef PROBE_ATT
#define PROBE_ATT 0
#endif
#ifndef PROBE_EPI2
#define PROBE_EPI2 0
#endif
#ifndef PROBE_PRO
#define PROBE_PRO 0
#endif
#ifndef PROBE_KREP
#define PROBE_KREP 1
#endif
#ifndef DBG_LAST_PHASE
#define DBG_LAST_PHASE 100000
#endif

constexpr int T = 32768, D = 1024, SEQ = 2048, NBATCH = 16, DEPTH = 4;
constexpr int EVIN = 2840, ODIN = 6144;
constexpr float EPS = 1e-6f, NEGF = -1e30f;
constexpr int NTB = 256;
constexpr int MOE_ROWS = (512 + 32) * 256;

constexpr size_t MiB = 1u << 20;
constexpr size_t WS_CTL = 0, CTL_BYTES = 1 * MiB;
constexpr int CW_BAR = 4096;
constexpr size_t WS_EVNAT = 2 * MiB, WS_EVSW = 10 * MiB, WS_EVOUT = 13 * MiB, WS_CMP1 = 17 * MiB, WS_ODNAT = 21 * MiB, WS_ODSW = 37 * MiB,
                 WS_ODOUT = 49 * MiB, WS_WPP = 57 * MiB, WS_WPG = 59 * MiB, WS_BIAS1 = 67 * MiB, WS_GAINS = 67 * MiB + 16384, WS_BCNT = 67 * MiB + 65536,
                 WS_WGU = 68 * MiB, WS_WDN = 580 * MiB;
constexpr size_t WS_XN = 840 * MiB, WS_PBF = 904 * MiB, WS_PP = 968 * MiB, WS_GATES = 1032 * MiB, WS_TOPE = 1035 * MiB, WS_POSB = 1036 * MiB,
                 WS_DEST = 1037 * MiB, WS_GATEW = 1038 * MiB, WS_SELM = 1039 * MiB;
constexpr size_t RA = 1040 * MiB;
constexpr size_t WS_QD = RA, WS_KD = RA + 32 * MiB, WS_QN = RA + 64 * MiB, WS_KCB = RA + 96 * MiB, WS_VCB = RA + 105 * MiB, WS_KSB = RA + 114 * MiB,
                 WS_KWB = RA + 122 * MiB, WS_VAT = RA + 130 * MiB, WS_VST = RA + 162 * MiB, WS_VWT = RA + 170 * MiB, WS_HID = RA + 178 * MiB,
                 WS_KCMP = RA + 182 * MiB, WS_VCMPT = RA + 183 * MiB, WS_OC = RA + 184 * MiB, WS_IMPH = RA + 216 * MiB, WS_OD = RA + 248 * MiB,
                 WS_OS = RA + 312 * MiB, WS_OW = RA + 344 * MiB, WS_AMIX = RA + 376 * MiB;
constexpr size_t WS_AQ = RA, WS_KP = RA + 128 * MiB, WS_KT = RA + 192 * MiB, WS_VS = RA + 256 * MiB, WS_GG = RA + 512 * MiB, WS_UT = RA + 640 * MiB,
                 WS_Y = RA + 896 * MiB, WS_YG = RA + 1024 * MiB;
constexpr size_t WS_XB = 2192 * MiB, WS_ACT = 2464 * MiB, WS_YB = 2736 * MiB, WS_HB = 3008 * MiB, WS_END = 3072 * MiB;

constexpr int MISC_OFF = 139264, LDS_BYTES = 155648;
static_assert(MISC_OFF + 5888 + 4096 <= LDS_BYTES, "misc LDS words");
constexpr int MO_WCNT = 256, MO_ENT = 1280, MO_GAT = 3328, MO_TOT = 5376, MO_BASE = 5504, MO_TS = 5632, MO_RED = 5888;

DI int opaque_tid(int wid0) { int l; asm volatile("v_mbcnt_lo_u32_b32 %0, -1, 0\n\tv_mbcnt_hi_u32_b32 %0, -1, %0" : "=v"(l) :: "memory"); return (wid0 << 6) | l; }
DI int lane_now() { int l; asm volatile("v_mbcnt_lo_u32_b32 %0, -1, 0\n\tv_mbcnt_hi_u32_b32 %0, -1, %0" : "=v"(l)); return l; }
DI float shx(float v, int m) { return __builtin_bit_cast(float, __builtin_amdgcn_ds_bpermute((lane_now() ^ m) << 2, __builtin_bit_cast(int, v))); }
DI float shxl(float v, int m, int lane) { return __builtin_bit_cast(float, __builtin_amdgcn_ds_bpermute((lane ^ m) << 2, __builtin_bit_cast(int, v))); }
DI unsigned shxu(unsigned v, int m) { return (unsigned)__builtin_amdgcn_ds_bpermute((lane_now() ^ m) << 2, (int)v); }
DI unsigned pk2(float lo, float hi) { f32x2 v = {lo, hi}; return __builtin_bit_cast(unsigned, __builtin_convertvector(v, bfv2)); }
DI unsigned pk4_fp8(float a, float b, float c, float d) { int w = 0; w = __builtin_amdgcn_cvt_pk_fp8_f32(a, b, w, false); w = __builtin_amdgcn_cvt_pk_fp8_f32(c, d, w, true); return (unsigned)w; }
DI u32x2 pack8_fp8(const f32x4& a, const f32x4& b) { u32x2 w; w.x = pk4_fp8(a[0], a[1], a[2], a[3]); w.y = pk4_fp8(b[0], b[1], b[2], b[3]); return w; }
DI float bf2f(unsigned short b) { return __uint_as_float(((unsigned)b) << 16); }
DI float bflo(unsigned w) { return __uint_as_float(w << 16); }
DI float bfhi(unsigned w) { return __uint_as_float(w & 0xffff0000u); }
DI float wave_sum(float v) {
#pragma unroll
    for (int o = 1; o < 64; o <<= 1) v += shx(v, o);
    return v;
}
DI float sigm(float x) { return __builtin_amdgcn_rcpf(1.0f + __builtin_amdgcn_exp2f(-1.44269504089f * x)); }
DI u32x4 pack8(const f32x4& a, const f32x4& b) { u32x4 w; w.x = pk2(a[0], a[1]); w.y = pk2(a[2], a[3]); w.z = pk2(b[0], b[1]); w.w = pk2(b[2], b[3]); return w; }
DI f32x4 ld_h4(const void* base, bool hb, size_t i) {
    if (hb) { const u32x2 w = *(const u32x2*)((const bf16_t*)base + i); return (f32x4){bflo(w.x), bfhi(w.x), bflo(w.y), bfhi(w.y)}; }
    return *(const f32x4*)((const float*)base + i);
}

#define XB_TMO      128
#define XB_XCNT(j)  (256  + 64 * (j))
#define XB_XSUB(j)  (1280 + 64 * (j))
#define XB_XGEN(j)  (2304 + 64 * (j))
#define XB_TOP      3328
#define XB_TOPGEN   3392
#define XCD_BAR_WORDS 3456
#define XB_SPIN_CAP (1u << 22)
DI unsigned xb_ld(unsigned* p)              { return __hip_atomic_load(p, __ATOMIC_RELAXED, __HIP_MEMORY_SCOPE_AGENT); }
DI unsigned xb_add(unsigned* p, unsigned v) { return __hip_atomic_fetch_add(p, v, __ATOMIC_RELAXED, __HIP_MEMORY_SCOPE_AGENT); }
DI unsigned xb_xcc_id() { return (unsigned)__builtin_amdgcn_s_getreg((3 << 11) | 20) & 0xFu; }
#define XB_SPIN(cond, bar) do { unsigned _sp = 0; while (cond) { __builtin_amdgcn_s_sleep(1); \
    if ((++_sp & 255u) == 0u) { if (xb_ld(&(bar)[XB_TMO])) break; if (_sp > XB_SPIN_CAP) { atomicAdd(&(bar)[XB_TMO], 1u); break; } } } } while (0)
struct XcdBarrier { unsigned* bar; unsigned x; volatile LAS unsigned* st; };
DI XcdBarrier xcd_barrier_post(const int WID, unsigned* bar, volatile LAS unsigned* st) {
    XcdBarrier b; b.bar = bar; b.x = xb_xcc_id(); b.st = st;
    if (opaque_tid(WID) == 0) (void)xb_add(&bar[XB_XCNT(b.x)], 1u);
    return b;
}
DI void xcd_barrier_complete(unsigned* bar, unsigned x, unsigned& nloc, unsigned& nx) {
    const unsigned G = gridDim.x * gridDim.y * gridDim.z;
    unsigned sum, cnt, mine, sp = 0u;
    for (;;) {
        sum = 0u; cnt = 0u; mine = 0u;
#pragma unroll
        for (unsigned j = 0; j < 16; ++j) { const unsigned c = xb_ld(&bar[XB_XCNT(j)]); sum += c; cnt += (c > 0u) ? 1u : 0u; mine = (j == x) ? c : mine; }
        if (sum == G) break;
        __builtin_amdgcn_s_sleep(1);
        if ((++sp & 255u) == 0u) { if (xb_ld(&bar[XB_TMO])) break; if (sp > XB_SPIN_CAP) { atomicAdd(&bar[XB_TMO], 1u); break; } }
    }
    nloc = mine > 0u ? mine : 1u; nx = cnt > 0u ? cnt : 1u;
}
DI void xcd_barrier(const int WID, const XcdBarrier& b) {
    asm volatile("s_waitcnt vmcnt(0)" ::: "memory");
    __syncthreads();
    if (opaque_tid(WID) == 0) {
        unsigned* bar = b.bar; asm volatile("" : "+s"(bar));
        __builtin_amdgcn_s_waitcnt(0);
        unsigned nloc = b.st[0], nx = b.st[1];
        if (nloc == 0u) { xcd_barrier_complete(bar, b.x, nloc, nx); b.st[0] = nloc; b.st[1] = nx; }
        const unsigned old = xb_add(&bar[XB_XSUB(b.x)], 1u);
        const unsigned gen = old / nloc;
        if (old + 1u == (gen + 1u) * nloc) {
            __builtin_amdgcn_fence(__ATOMIC_RELEASE, "agent");
            asm volatile("s_waitcnt vmcnt(0)" ::: "memory");
            const unsigned og = xb_add(&bar[XB_TOP], 1u);
            const unsigned tg = og / nx;
            if (og + 1u == (tg + 1u) * nx) xb_add(&bar[XB_TOPGEN], 1u);
            else XB_SPIN(xb_ld(&bar[XB_TOPGEN]) == tg, bar);
            __builtin_amdgcn_fence(__ATOMIC_ACQUIRE, "agent");
            xb_add(&bar[XB_XGEN(b.x)], 1u);
            asm volatile("s_waitcnt vmcnt(0)" ::: "memory");
        } else {
            XB_SPIN(xb_ld(&bar[XB_XGEN(b.x)]) == gen, bar);
            __builtin_amdgcn_fence(__ATOMIC_ACQUIRE, "agent");
            asm volatile("s_waitcnt vmcnt(0)" ::: "memory");
        }
    }
    __syncthreads();
}

namespace pg8 {
constexpr int BM = 256, BK = 64, HALF = 128, HTB = HALF * BK * 2, STAGE_BYTES = 8 * HTB, NXCD = 8, WGM = 8;
DI int lds_byte(int r, int c) { const int st = (r >> 4) * 2 + (c >> 5), rr = r & 15, cc = c & 31, ob = rr * 64 + cc * 2; return st * 1024 + (ob ^ (((ob >> 9) & 1) << 5)); }
DI void stage_rc(int b, int& R, int& C) { const int st = b / 1024, sb = b % 1024, swz = sb ^ (((sb >> 9) & 1) << 5); R = (st >> 1) * 16 + swz / 64; C = (st & 1) * 32 + (swz % 64) / 2; }
DI int perm32(int rho) { const int n = rho >> 4, i = rho & 15; return 8 * (i >> 2) + 4 * n + (i & 3); }
struct Unit { int pm, pn; };
struct Sched {
    int nM, nN, nwg, G, c;
    DI void init(int nM_, int nN_, int G_, int c_) { nM = nM_; nN = nN_; nwg = nM * nN; G = G_; c = c_; }
    DI bool next(int i, Unit& u) const {
        const long L = (long)i * G + c; if (L >= nwg) return false;
        int wgid = (int)L; { const int q = nwg / NXCD, r = nwg % NXCD, xcd = wgid % NXCD, off = wgid / NXCD; wgid = (xcd < r ? xcd * (q + 1) : r * (q + 1) + (xcd - r) * q) + off; }
        const int nig = WGM * nN, gid = wgid / nig, fm = gid * WGM, gsz = (nM - fm) < WGM ? (nM - fm) : WGM;
        u.pm = fm + ((wgid % nig) % gsz); u.pn = (wgid % nig) / gsz; return true;
    }
};
template <class Epi, class Prob, class SchedT>
DI void gemm_phase(const int WID, LAS unsigned char* lds, const Prob& P, const SchedT& S, const Epi& E) {
    const int tid = opaque_tid(WID), wid = __builtin_amdgcn_readfirstlane(tid >> 6), lane = tid & 63, wr = wid >> 2, wc = wid & 3, fr = lane & 15, fq = lane >> 4;
    const int K = P.K, nt = K / BK;
    constexpr int KREP = Epi::CARRY ? 1 : PROBE_KREP;
    unsigned voffA[2], voffB[2];
#pragma unroll
    for (int i = 0; i < 2; ++i) { int R, C; stage_rc(tid * 16 + i * 8192, R, C); const int Rb = Epi::PERM ? ((R & ~31) + perm32(R & 31)) : R;
        voffA[i] = (unsigned)(R * P.lda + C) * 2u; voffB[i] = (unsigned)(Rb * P.ldb + C) * 2u; }
    const size_t kstep = (size_t)(BK * 2);
    const size_t hstepA = (size_t)HALF * P.lda * 2, hstepB = (size_t)HALF * P.ldb * 2;
    const unsigned ldsw = (unsigned)wid * 1024u;
    const int aoff = lds_byte(wr * 64 + fr, fq * 8), boff = lds_byte(wc * 32 + fr, fq * 8);
#define PG8_SA(b, h) (((b) * 2 + (h)) * HTB)
#define PG8_SB(b, h) ((4 + (b) * 2 + (h)) * HTB)
#define PG8_STAGE(bufoff, gbase, voff) do { _Pragma("unroll") for (int _i = 0; _i < 2; ++_i) \
        __builtin_amdgcn_global_load_lds((const unsigned*)((const char*)(gbase) + (voff)[_i]), (LAS unsigned*)(lds + (bufoff) + ldsw + _i * 8192), 16, 0, 0); } while (0)
#define PG8_LD16(off) (*(const LAS i32x4*)(lds + (off)))
#define PG8_LDA(dst, b, h) do { _Pragma("unroll") for (int m = 0; m < 4; ++m) { const i32x4 lo_ = PG8_LD16(PG8_SA(b, h) + aoff + m * 2048), hi_ = PG8_LD16(PG8_SA(b, h) + aoff + m * 2048 + 1024); dst[m] = __builtin_shufflevector(lo_, hi_, 0, 1, 2, 3, 4, 5, 6, 7); } } while (0)
#define PG8_LDB(dst, b, h) do { _Pragma("unroll") for (int n = 0; n < 2; ++n) { const i32x4 lo_ = PG8_LD16(PG8_SB(b, h) + boff + n * 2048), hi_ = PG8_LD16(PG8_SB(b, h) + boff + n * 2048 + 1024); dst[n] = __builtin_shufflevector(lo_, hi_, 0, 1, 2, 3, 4, 5, 6, 7); } } while (0)
#define PG8_LOH(X) __builtin_bit_cast(bf16x8, __builtin_shufflevector((X), (X), 0, 1, 2, 3))
#define PG8_HIH(X) __builtin_bit_cast(bf16x8, __builtin_shufflevector((X), (X), 4, 5, 6, 7))
#define PG8_MMA(ai, bj, At, Bt) do { __builtin_amdgcn_s_setprio(1); \
        if constexpr (Prob::FP8) { _Pragma("unroll") for (int m = 0; m < 4; ++m) _Pragma("unroll") for (int n = 0; n < 2; ++n) \
            asm volatile("v_mfma_scale_f32_16x16x128_f8f6f4 %0, %1, %2, %0, %3, %3 op_sel_hi:[0,0,0]" : "+v"(acc[ai][bj][m][n]) : "v"(Bt[n]), "v"(At[m]), "v"(sc1)); } \
        else { _Pragma("unroll") for (int m = 0; m < 4; ++m) _Pragma("unroll") for (int n = 0; n < 2; ++n) { \
            acc[ai][bj][m][n] = __builtin_amdgcn_mfma_f32_16x16x32_bf16(PG8_LOH(Bt[n]), PG8_LOH(At[m]), acc[ai][bj][m][n], 0, 0, 0); \
            acc[ai][bj][m][n] = __builtin_amdgcn_mfma_f32_16x16x32_bf16(PG8_HIH(Bt[n]), PG8_HIH(At[m]), acc[ai][bj][m][n], 0, 0, 0); } } \
        __builtin_amdgcn_s_setprio(0); } while (0)
#define PG8_WAIT_V(n) asm volatile("s_waitcnt vmcnt(" #n ")" ::: "memory")
#define PG8_WAIT_L(n) asm volatile("s_waitcnt lgkmcnt(" #n ")" ::: "memory")
#define PG8_BAR __builtin_amdgcn_s_barrier()
#define PG8_SCHED __builtin_amdgcn_sched_barrier(0)
    Unit cur, nxt; int ui = 0;
    if (!S.next(0, cur)) return;
    f32x4 acc[2][2][4][2];
#pragma unroll
    for (int a = 0; a < 2; ++a)
#pragma unroll
        for (int b = 0; b < 2; ++b)
#pragma unroll
            for (int m = 0; m < 4; ++m)
#pragma unroll
                for (int n = 0; n < 2; ++n) acc[a][b][m][n] = (f32x4){0.f, 0.f, 0.f, 0.f};
    i32x8 At[4], B0[2], B1[2];
    const int sc1 = 0x7f7f7f7f;
    const char* cA = P.a_base(cur); const char* cB = P.b_base(cur);
    PG8_STAGE(PG8_SB(0, 0), cB, voffB); PG8_STAGE(PG8_SA(0, 0), cA, voffA); PG8_STAGE(PG8_SB(0, 1), cB + hstepB, voffB); PG8_STAGE(PG8_SA(0, 1), cA + hstepA, voffA);
    if (wr == 1) PG8_BAR;
    PG8_WAIT_V(4); PG8_BAR;
    PG8_STAGE(PG8_SB(1, 0), cB + kstep, voffB); PG8_STAGE(PG8_SA(1, 0), cA + kstep, voffA); PG8_STAGE(PG8_SB(1, 1), cB + hstepB + kstep, voffB);
    PG8_WAIT_V(6); PG8_BAR;
    for (;;) {
        const bool has_next = S.next(ui + 1, nxt);
        const char* nA = has_next ? P.a_base(nxt) : cA; const char* nB = has_next ? P.b_base(nxt) : cB;
        for (int rep_ = 0; rep_ < KREP; ++rep_)
        for (int t = 0; t < nt; t += 2) {
            const bool last = (t == nt - 2);
            if constexpr (Epi::HOOK) { if (last && rep_ + 1 == KREP) E.prefetch(cur, lds, wid, lane); }
            const char* a1 = cA + (size_t)(t + 1) * kstep;
            const char* a2 = last ? (rep_ + 1 < KREP ? cA : nA) : cA + (size_t)(t + 2) * kstep; const char* b2 = last ? (rep_ + 1 < KREP ? cB : nB) : cB + (size_t)(t + 2) * kstep;
            const char* a3 = a2 + kstep; const char* b3 = b2 + kstep;
            PG8_LDB(B0, 0, 0); PG8_SCHED; PG8_LDA(At, 0, 0); PG8_STAGE(PG8_SA(1, 1), a1 + hstepA, voffA);
            PG8_WAIT_L(8); PG8_BAR; PG8_WAIT_L(0); PG8_MMA(0, 0, At, B0); PG8_BAR; PG8_SCHED;
            PG8_LDB(B1, 0, 1); PG8_STAGE(PG8_SB(0, 0), b2, voffB);
            PG8_BAR; PG8_WAIT_L(0); PG8_MMA(0, 1, At, B1); PG8_BAR;
            PG8_LDA(At, 0, 1); PG8_STAGE(PG8_SA(0, 0), a2, voffA);
            PG8_BAR; PG8_WAIT_L(0); PG8_MMA(1, 0, At, B0); PG8_BAR; PG8_SCHED;
            PG8_STAGE(PG8_SB(0, 1), b2 + hstepB, voffB);
            PG8_WAIT_V(6); PG8_BAR; PG8_MMA(1, 1, At, B1); PG8_BAR;
            PG8_LDB(B0, 1, 0); PG8_SCHED; PG8_LDA(At, 1, 0); PG8_STAGE(PG8_SA(0, 1), a2 + hstepA, voffA);
            PG8_WAIT_L(8); PG8_BAR; PG8_WAIT_L(0); PG8_MMA(0, 0, At, B0); PG8_BAR; PG8_SCHED;
            PG8_LDB(B1, 1, 1); PG8_STAGE(PG8_SB(1, 0), b3, voffB);
            PG8_BAR; PG8_WAIT_L(0); PG8_MMA(0, 1, At, B1); PG8_BAR;
            PG8_LDA(At, 1, 1); PG8_STAGE(PG8_SA(1, 0), a3, voffA);
            PG8_BAR; PG8_WAIT_L(0); PG8_MMA(1, 0, At, B0); PG8_BAR; PG8_SCHED;
            PG8_STAGE(PG8_SB(1, 1), b3 + hstepB, voffB);
            PG8_WAIT_V(6); PG8_BAR; PG8_MMA(1, 1, At, B1); PG8_BAR;
        }
        if constexpr (Prob::FP8) {
            asm volatile("s_nop 15\n\ts_nop 15" ::: "memory");
#pragma unroll
            for (int a_ = 0; a_ < 2; ++a_)
#pragma unroll
                for (int b_ = 0; b_ < 2; ++b_)
#pragma unroll
                    for (int m_ = 0; m_ < 4; ++m_)
#pragma unroll
                        for (int n_ = 0; n_ < 2; ++n_) asm volatile("" : "+v"(acc[a_][b_][m_][n_]));
        }
        if constexpr (KREP > 1) {
#pragma unroll
        for (int a_ = 0; a_ < 2; ++a_)
#pragma unroll
            for (int b_ = 0; b_ < 2; ++b_)
#pragma unroll
                for (int m_ = 0; m_ < 4; ++m_)
#pragma unroll
                    for (int n_ = 0; n_ < 2; ++n_) acc[a_][b_][m_][n_] *= (1.0f / KREP); }
        { const int t2_ = opaque_tid(WID); const int fr_ = t2_ & 15, fq_ = (t2_ >> 4) & 3; int wr_ = WID >> 2, wc_ = WID & 3; asm volatile("" : "+s"(wr_), "+s"(wc_));
          E(acc, cur, wr_, wc_, fr_, fq_);
#if PROBE_EPI2
          if constexpr (Epi::HOOK) { asm volatile("" ::: "memory"); E(acc, cur, wr_, wc_, fr_, fq_); }
#endif
        }
        if (!has_next) break;
        const float carry = Epi::carry(cur);
#pragma unroll
        for (int a = 0; a < 2; ++a)
#pragma unroll
            for (int b = 0; b < 2; ++b)
#pragma unroll
                for (int m = 0; m < 4; ++m)
#pragma unroll
                    for (int n = 0; n < 2; ++n) acc[a][b][m][n] = Epi::CARRY ? acc[a][b][m][n] * carry : (f32x4){0.f, 0.f, 0.f, 0.f};
        cur = nxt; cA = nA; cB = nB; ++ui;
    }
    PG8_WAIT_V(0);
    if (wr == 0) PG8_BAR;
    PG8_BAR;
#undef PG8_SA
#undef PG8_SB
#undef PG8_STAGE
#undef PG8_LDA
#undef PG8_LDB
#undef PG8_MMA
#undef PG8_LD16
#undef PG8_LOH
#undef PG8_HIH
#undef PG8_WAIT_V
#undef PG8_WAIT_L
#undef PG8_BAR
#undef PG8_SCHED
}
}
using pg8::Unit;
typedef f32x4 Acc[2][2][4][2];

struct ProbPlain { static constexpr bool FP8 = false; const bf16_t* A; const bf16_t* Bt; int lda, ldb, K;
    DI const char* a_base(const Unit& u) const { return (const char*)(A + (size_t)u.pm * 256 * lda); }
    DI const char* b_base(const Unit& u) const { return (const char*)(Bt + (size_t)u.pn * 256 * ldb); } };
struct ProbCmp1 { static constexpr bool FP8 = false; const bf16_t* KCB; const bf16_t* VCB; const bf16_t* W; int lda, ldb, K;
    DI const char* a_base(const Unit& u) const { const int kv = u.pm >> 4, rt = u.pm & 15; return (const char*)((kv ? VCB : KCB) + (size_t)rt * 256 * 1024); }
    DI const char* b_base(const Unit& u) const { const int kv = u.pm >> 4; return (const char*)(W + (size_t)kv * 256 * 2048); } };
struct ProbAtt { static constexpr bool FP8 = false; const bf16_t* AQ; const bf16_t* KP; int lda, ldb, K;
    DI const char* a_base(const Unit& u) const { const int z = u.pm, n = z & 7, h = (z >> 3) & 3, b = z >> 5; const size_t t0 = (size_t)b * 2048 + n * 256; return (const char*)(AQ + (t0 * 4 + h) * 512 + 256); }
    DI const char* b_base(const Unit& u) const { const int z = u.pm, n = z & 7, h = (z >> 3) & 3, b = z >> 5; const size_t t0 = (size_t)b * 2048 + n * 256; return (const char*)(KP + t0 * 1024 + h * 256); } };
struct ProbUT { static constexpr bool FP8 = false; const bf16_t* VS; const bf16_t* KT; int lda, ldb, K;
    DI const char* a_base(const Unit& u) const { const int z = u.pm >> 1, half = u.pm & 1; return (const char*)(VS + (size_t)z * 262144 + (size_t)half * 256 * 512); }
    DI const char* b_base(const Unit& u) const { const int z = u.pm >> 1; return (const char*)(KT + (size_t)z * 65536); } };
struct ProbY { static constexpr bool FP8 = false; const bf16_t* AQ; const bf16_t* VS; int lda, ldb, K;
    DI const char* a_base(const Unit& u) const { const int z = u.pm, n = z & 7, h = (z >> 3) & 3, b = z >> 5; const size_t t0 = (size_t)b * 2048 + n * 256; return (const char*)(AQ + (t0 * 4 + h) * 512); }
    DI const char* b_base(const Unit& u) const { return (const char*)(VS + (size_t)u.pm * 262144 + (size_t)u.pn * 256 * 512); } };
DI int moe_tile_expert(const LAS int* ts, int rt) { int e = 0;
#pragma unroll 8
    for (int i = 1; i < 32; ++i) e += (rt >= ts[i]) ? 1 : 0;
    return e; }
struct ProbMoe { static constexpr bool FP8 = false; const bf16_t* A; const bf16_t* W; const LAS int* ts; int nper; int lda, ldb, K;
    DI const char* a_base(const Unit& u) const { return (const char*)(A + (size_t)u.pm * 256 * 1024); }
    DI const char* b_base(const Unit& u) const { const int e = moe_tile_expert(ts, u.pm); return (const char*)(W + ((size_t)e * nper + (size_t)u.pn * 256) * 1024); } };

struct ProbPlain8 { static constexpr bool FP8 = true; const unsigned char* A; const unsigned char* Bt; int lda, ldb, K;
    DI const char* a_base(const Unit& u) const { return (const char*)(A + (size_t)u.pm * 256 * lda * 2); }
    DI const char* b_base(const Unit& u) const { return (const char*)(Bt + (size_t)u.pn * 256 * ldb * 2); } };
struct ProbMoe8 { static constexpr bool FP8 = true; const unsigned char* A; const unsigned char* W; const LAS int* ts; int nper; int lda, ldb, K;
    DI const char* a_base(const Unit& u) const { return (const char*)(A + (size_t)u.pm * 256 * 1024); }
    DI const char* b_base(const Unit& u) const { const int e = moe_tile_expert(ts, u.pm); return (const char*)(W + ((size_t)e * nper + (size_t)u.pn * 256) * 1024); } };

constexpr float A_SC = 4.0f;
constexpr float W8_SCALE = 32.0f, WSC = 1.0f / W8_SCALE;
#define EPI_ROWS(ai, m) (128 * (ai) + 64 * wr + 16 * (m) + fr)
struct EpiEvNat { static constexpr bool HOOK = false; static constexpr bool CARRY = false; static DI float carry(const Unit&) { return 0.f; } static constexpr bool PERM = true;
    unsigned char* ws; const float* gains;
    DI void operator()(const Acc& acc, const Unit& u, int wr, int wc, int fr, int fq) const {
        const int pn = u.pn; const bool norm = (pn != 6);
        const int gi = pn < 2 ? 0 : pn < 4 ? 1 : pn < 6 ? 2 : 3;
        const float* g = gains + gi * 64;
        f32x4 gv[2][2];
#pragma unroll
        for (int bj = 0; bj < 2; ++bj)
#pragma unroll
            for (int n = 0; n < 2; ++n) { const f32x4 t4 = *(const f32x4*)(g + 32 * bj + 8 * fq + 4 * n); gv[bj][n] = norm ? t4 : (f32x4){1.f, 1.f, 1.f, 1.f}; }
        size_t boff; int rowmul, hoff; bool panel = false;
        if (pn < 2) { boff = WS_QD; rowmul = 512; hoff = (pn * 4 + wc) * 64; }
        else if (pn < 4) { boff = WS_KD; rowmul = 512; hoff = ((pn - 2) * 4 + wc) * 64; }
        else if (pn < 6) { boff = WS_QN; rowmul = 512; hoff = ((pn - 4) * 4 + wc) * 64; }
        else { panel = true; rowmul = 64; hoff = 0; boff = (pn == 6) ? (wc < 2 ? WS_KCB : WS_VCB) : (wc < 2 ? WS_KSB : WS_KWB); }
        bf16_t* base = (bf16_t*)(ws + boff);
#pragma unroll
        for (int ai = 0; ai < 2; ++ai)
#pragma unroll
            for (int m = 0; m < 4; ++m) {
                const int t = u.pm * 256 + EPI_ROWS(ai, m), b = t >> 11, sq = t & 2047;
                float ss = 0.f;
#pragma unroll
                for (int bj = 0; bj < 2; ++bj)
#pragma unroll
                    for (int n = 0; n < 2; ++n) { const f32x4 x = acc[ai][bj][m][n]; ss += (x[0] * x[0] + x[1] * x[1]) + (x[2] * x[2] + x[3] * x[3]); }
                ss += shx(ss, 16); ss += shx(ss, 32);
                const float rstd = norm ? rsqrtf(ss * (1.0f / 64.0f) + EPS) * ((pn < 2 || pn == 4 || pn == 5) ? 0.125f : 1.0f) : 1.0f;
                const size_t rowi = panel ? ((size_t)(b * 2 + (wc & 1)) * 2048 + sq) : (size_t)t;
#pragma unroll
                for (int bj = 0; bj < 2; ++bj) {
                    const f32x4 v0 = acc[ai][bj][m][0] * rstd * gv[bj][0], v1 = acc[ai][bj][m][1] * rstd * gv[bj][1];
                    *(u32x4*)(base + rowi * rowmul + hoff + 32 * bj + 8 * fq) = pack8(v0, v1);
                }
            }
    }
};
struct EpiEvSw { static constexpr bool HOOK = false; static constexpr bool CARRY = false; static DI float carry(const Unit&) { return 0.f; } static constexpr bool PERM = true;
    unsigned char* ws;
    DI void operator()(const Acc& acc, const Unit& u, int wr, int wc, int fr, int fq) const {
        const int b = u.pn >> 3, sb = (u.pn & 7) * 256;
#pragma unroll
        for (int ai = 0; ai < 2; ++ai)
#pragma unroll
            for (int m = 0; m < 4; ++m) {
                const int rl = EPI_ROWS(ai, m);
                size_t boff, rowi;
                if (u.pm < 2) { const int fg = u.pm * 256 + rl; boff = WS_VAT; rowi = (size_t)(b * 4 + (fg >> 7)) * 128 + (fg & 127); }
                else { const int r2 = rl & 127; boff = (rl < 128) ? WS_VST : WS_VWT; rowi = (size_t)(b * 2 + (r2 >> 6)) * 64 + (r2 & 63); }
                bf16_t* rowp = (bf16_t*)(ws + boff) + rowi * 2048;
#pragma unroll
                for (int bj = 0; bj < 2; ++bj) { const u32x4 pw = pack8(acc[ai][bj][m][0], acc[ai][bj][m][1]);
                    const int s0 = sb + 128 * bj + 32 * wc + 8 * fq; bf16_t* g16 = rowp + (s0 & ~15) + ((s0 & 8) ? 4 : 0);
                    *(u32x2*)g16 = (u32x2){pw.x, pw.y}; *(u32x2*)(g16 + 8) = (u32x2){pw.z, pw.w}; }
            }
    }
};
struct EpiCmp1 { static constexpr bool HOOK = false; static constexpr bool CARRY = false; static DI float carry(const Unit&) { return 0.f; } static constexpr bool PERM = true;
    bf16_t* HID; const float* bias1;
    DI void operator()(const Acc& acc, const Unit& u, int wr, int wc, int fr, int fq) const {
        const int kv = u.pm >> 4, rt = u.pm & 15;
#pragma unroll
        for (int bj = 0; bj < 2; ++bj) {
            const int col = 128 * bj + 32 * wc + 8 * fq;
            const f32x4 b0 = *(const f32x4*)(bias1 + kv * 256 + col), b1 = *(const f32x4*)(bias1 + kv * 256 + col + 4);
#pragma unroll
            for (int ai = 0; ai < 2; ++ai)
#pragma unroll
                for (int m = 0; m < 4; ++m) {
                    f32x4 v0 = acc[ai][bj][m][0] + b0, v1 = acc[ai][bj][m][1] + b1;
#pragma unroll
                    for (int j = 0; j < 4; ++j) { v0[j] = v0[j] * sigm(v0[j]); v1[j] = v1[j] * sigm(v1[j]); }
                    *(u32x4*)(HID + ((size_t)kv * 4096 + rt * 256 + EPI_ROWS(ai, m)) * 256 + col) = pack8(v0, v1);
                }
        }
    }
};
struct EpiResid { static constexpr bool HOOK = false; static constexpr bool CARRY = false; static DI float carry(const Unit&) { return 0.f; } static constexpr bool PERM = true;
    const void* Hin; bf16_t* Hout; bool hb; float sc;
    DI void operator()(const Acc& acc, const Unit& u, int wr, int wc, int fr, int fq) const {
#pragma unroll
        for (int ai = 0; ai < 2; ++ai)
#pragma unroll
            for (int m = 0; m < 4; ++m) {
                const size_t off = (size_t)(u.pm * 256 + EPI_ROWS(ai, m)) * 1024 + u.pn * 256 + 32 * wc + 8 * fq;
#pragma unroll
                for (int bj = 0; bj < 2; ++bj) { const size_t o = off + 128 * bj;
                    *(u32x4*)(Hout + o) = pack8(ld_h4(Hin, hb, o) + acc[ai][bj][m][0] * sc, ld_h4(Hin, hb, o + 4) + acc[ai][bj][m][1] * sc); }
            }
    }
};
DI float ret_lg2(int h) { return __log2f(1.0f - exp2f(-5.0f - (float)h)); }
struct EpiOdNat { static constexpr bool HOOK = false; static constexpr bool CARRY = false; static DI float carry(const Unit&) { return 0.f; } static constexpr bool PERM = true;
    unsigned char* ws;
    DI void operator()(const Acc& acc, const Unit& u, int wr, int wc, int fr, int fq) const {
        const int pn = u.pn; const int h = pn & 3; const float lg = ret_lg2(h);
        const size_t boff = pn < 4 ? WS_AQ : pn < 8 ? WS_KP : WS_GG;
        const int rowmul = pn < 4 ? 2048 : pn < 8 ? 1024 : 2048;
        const int coff = pn < 4 ? (h * 512 + 256) : pn < 8 ? (h * 256) : ((pn - 8) * 256);
        bf16_t* base = (bf16_t*)(ws + boff) + coff;
#pragma unroll
        for (int ai = 0; ai < 2; ++ai)
#pragma unroll
            for (int m = 0; m < 4; ++m) {
                const int cl = EPI_ROWS(ai, m); const size_t t = (size_t)u.pm * 256 + cl;
                float sc = 1.f;
                if (pn < 4) sc = exp2f(lg * (float)(cl + 1)); else if (pn < 8) sc = 0.0625f * exp2f(-lg * (float)(cl + 1));
                sc *= WSC;
#pragma unroll
                for (int bj = 0; bj < 2; ++bj) {
                    const int d = 128 * bj + 32 * wc + 8 * fq;
                    f32x4 v0 = acc[ai][bj][m][0] * sc, v1 = acc[ai][bj][m][1] * sc;
                    if (pn >= 8) {
                        f32x4 e0 = v0 * -1.44269504089f, e1 = v1 * -1.44269504089f;
#pragma unroll
                        for (int j = 0; j < 4; ++j) { e0[j] = __builtin_amdgcn_exp2f(e0[j]); e1[j] = __builtin_amdgcn_exp2f(e1[j]); }
                        e0 = e0 + 1.0f; e1 = e1 + 1.0f;
#pragma unroll
                        for (int j = 0; j < 4; ++j) { e0[j] = __builtin_amdgcn_rcpf(e0[j]); e1[j] = __builtin_amdgcn_rcpf(e1[j]); }
                        v0 = v0 * e0; v1 = v1 * e1; }
                    const u32x4 pw = pack8(v0, v1);
                    *(u32x4*)(base + t * rowmul + d) = pw;
                    if (pn >= 4 && pn < 8) {
                        bf16_t* kt = (bf16_t*)(ws + WS_KT) + ((size_t)((u.pm >> 3) * 4 + h) * 8 + (u.pm & 7)) * 65536 + (size_t)d * 256 + cl;
                        kt[0 * 256] = (bf16_t)(pw.x & 0xffffu); kt[1 * 256] = (bf16_t)(pw.x >> 16); kt[2 * 256] = (bf16_t)(pw.y & 0xffffu); kt[3 * 256] = (bf16_t)(pw.y >> 16);
                        kt[4 * 256] = (bf16_t)(pw.z & 0xffffu); kt[5 * 256] = (bf16_t)(pw.z >> 16); kt[6 * 256] = (bf16_t)(pw.w & 0xffffu); kt[7 * 256] = (bf16_t)(pw.w >> 16);
                    }
                }
            }
    }
};
struct EpiOdSw { static constexpr bool HOOK = false; static constexpr bool CARRY = false; static DI float carry(const Unit&) { return 0.f; } static constexpr bool PERM = true;
    unsigned char* ws;
    DI void operator()(const Acc& acc, const Unit& u, int wr, int wc, int fr, int fq) const {
        const int b = u.pn >> 3, n = u.pn & 7, h = u.pm >> 1;
        const size_t z = (size_t)(b * 4 + h) * 8 + n;
        bf16_t* base = (bf16_t*)(ws + WS_VS) + z * 262144 + (size_t)(u.pm & 1) * 256 * 512;
#pragma unroll
        for (int bj = 0; bj < 2; ++bj) {
            const int cl = 128 * bj + 32 * wc + 8 * fq;
#pragma unroll
            for (int ai = 0; ai < 2; ++ai)
#pragma unroll
                for (int m = 0; m < 4; ++m)
                    *(u32x4*)(base + (size_t)EPI_ROWS(ai, m) * 512 + cl) = pack8(acc[ai][bj][m][0] * WSC, acc[ai][bj][m][1] * WSC);
        }
    }
};
struct EpiAtt { static constexpr bool HOOK = false; static constexpr bool CARRY = false; static DI float carry(const Unit&) { return 0.f; } static constexpr bool PERM = true;
    bf16_t* AQ;
    DI void operator()(const Acc& acc, const Unit& u, int wr, int wc, int fr, int fq) const {
        const int z = u.pm, n = z & 7, h = (z >> 3) & 3, b = z >> 5; const size_t t0 = (size_t)b * 2048 + n * 256;
#pragma unroll
        for (int ai = 0; ai < 2; ++ai)
#pragma unroll
            for (int m = 0; m < 4; ++m) {
                const int c = EPI_ROWS(ai, m);
#pragma unroll
                for (int bj = 0; bj < 2; ++bj) {
                    const int e0 = 128 * bj + 32 * wc + 8 * fq;
                    f32x4 v0 = acc[ai][bj][m][0], v1 = acc[ai][bj][m][1];
#pragma unroll
                    for (int j = 0; j < 4; ++j) { v0[j] = (c >= e0 + j) ? v0[j] : 0.f; v1[j] = (c >= e0 + 4 + j) ? v1[j] : 0.f; }
                    *(u32x4*)(AQ + ((t0 + c) * 4 + h) * 512 + e0) = pack8(v0, v1);
                }
            }
    }
};
struct EpiUT { static constexpr bool HOOK = false; static constexpr bool CARRY = false; static DI float carry(const Unit&) { return 0.f; } static constexpr bool PERM = true;
    bf16_t* UT;
    DI void operator()(const Acc& acc, const Unit& u, int wr, int wc, int fr, int fq) const {
        const size_t z = (size_t)(u.pm >> 1); const int half = u.pm & 1;
#pragma unroll
        for (int ai = 0; ai < 2; ++ai)
#pragma unroll
            for (int m = 0; m < 4; ++m) {
                bf16_t* rowp = UT + z * 131072 + (size_t)(half * 256 + EPI_ROWS(ai, m)) * 256 + 32 * wc + 8 * fq;
#pragma unroll
                for (int bj = 0; bj < 2; ++bj) *(u32x4*)(rowp + 128 * bj) = pack8(acc[ai][bj][m][0], acc[ai][bj][m][1]);
            }
    }
};
struct EpiUTScan { static constexpr bool HOOK = false; static constexpr bool CARRY = true; static constexpr bool PERM = true;
    static DI float carry(const Unit& u) { const int z = u.pm >> 1, n = z & 7, h = (z >> 3) & 3; return n == 7 ? 0.f : exp2f(256.0f * ret_lg2(h)); }
    bf16_t* VS;
    DI void operator()(const Acc& acc, const Unit& u, int wr, int wc, int fr, int fq) const {
        const size_t z = (size_t)(u.pm >> 1); const int half = u.pm & 1, n = (int)(z & 7), h = (int)((z >> 3) & 3);
        const float dec = exp2f(256.0f * ret_lg2(h));
#pragma unroll
        for (int ai = 0; ai < 2; ++ai)
#pragma unroll
            for (int m = 0; m < 4; ++m) {
                bf16_t* rowp = VS + (z * 512 + half * 256 + EPI_ROWS(ai, m)) * 512 + 256 + 32 * wc + 8 * fq;
#pragma unroll
                for (int bj = 0; bj < 2; ++bj) {
                    if (n == 0) { unsigned z0; asm volatile("v_mov_b32 %0, 0" : "=v"(z0)); *(u32x4*)(rowp + 128 * bj) = (u32x4){z0, z0, z0, z0}; }
                    if (n < 7) *(u32x4*)(rowp + (size_t)512 * 512 + 128 * bj) = pack8(acc[ai][bj][m][0] * dec, acc[ai][bj][m][1] * dec);
                }
            }
    }
};
struct SchedSeq { int nb, c;
    DI void init(int G, int c_) { nb = G / 2 > 0 ? G / 2 : 1; c = c_; }
    DI bool next(int i, Unit& u) const { if (c >= nb) return false; const int seq = c + (i >> 3) * nb; if (seq >= 128) return false;
        const int bh = seq >> 1, half = seq & 1, n = i & 7; u.pm = (bh * 8 + n) * 2 + half; u.pn = 0; return true; } };
struct EpiY { static constexpr bool HOOK = false; static constexpr bool CARRY = false; static DI float carry(const Unit&) { return 0.f; } static constexpr bool PERM = true;
    bf16_t* Y;
    DI void operator()(const Acc& acc, const Unit& u, int wr, int wc, int fr, int fq) const {
        const int z = u.pm, n = z & 7, h = (z >> 3) & 3, b = z >> 5; const size_t t0 = (size_t)b * 2048 + n * 256;
#pragma unroll
        for (int ai = 0; ai < 2; ++ai)
#pragma unroll
            for (int m = 0; m < 4; ++m) {
                bf16_t* rowp = Y + (t0 + EPI_ROWS(ai, m)) * 2048 + h * 512 + u.pn * 256 + 32 * wc + 8 * fq;
#pragma unroll
                for (int bj = 0; bj < 2; ++bj) *(u32x4*)(rowp + 128 * bj) = pack8(acc[ai][bj][m][0], acc[ai][bj][m][1]);
            }
    }
};
struct EpiGU { static constexpr bool HOOK = true; static constexpr bool CARRY = false; static DI float carry(const Unit&) { return 0.f; } static constexpr bool PERM = true;
    unsigned char* ACT; const float* bgu; const LAS int* ts;
    DI void prefetch(const Unit& u, LAS unsigned char* lds, int wid, int lane) const {
        if (wid == 0) { const int e = moe_tile_expert(ts, u.pm); const int ln = lane_now();
            const float* src = bgu + (size_t)e * 2048 + 128 * u.pn + ((ln & 32) ? 1024 : 0) + 4 * (ln & 31);
            __builtin_amdgcn_global_load_lds((const unsigned*)src, (LAS unsigned*)(lds + MISC_OFF + MO_RED), 16, 0, 0); }
    }
    DI void operator()(const Acc& acc, const Unit& u, int wr, int wc, int fr, int fq) const {
        const int w = 32 * wc + 8 * fq;
        const LAS float* bl_ = (const LAS float*)(ts) - MO_TS / 4 + MO_RED / 4 + w;
        const f32x4 bg0 = *(const LAS f32x4*)bl_, bg1 = *(const LAS f32x4*)(bl_ + 4), bl0 = *(const LAS f32x4*)(bl_ + 128), bl1 = *(const LAS f32x4*)(bl_ + 132);
#pragma unroll
        for (int ai = 0; ai < 2; ++ai)
#pragma unroll
            for (int m = 0; m < 4; ++m) {
                f32x4 g0 = acc[ai][0][m][0] * WSC + bg0, g1 = acc[ai][0][m][1] * WSC + bg1, l0 = acc[ai][1][m][0] * WSC + bl0, l1 = acc[ai][1][m][1] * WSC + bl1;
                const f32x4 seven = {7.f, 7.f, 7.f, 7.f}, mseven = {-7.f, -7.f, -7.f, -7.f};
                g0 = __builtin_elementwise_min(g0, seven); g1 = __builtin_elementwise_min(g1, seven);
                l0 = __builtin_elementwise_min(__builtin_elementwise_max(l0, mseven), seven); l1 = __builtin_elementwise_min(__builtin_elementwise_max(l1, mseven), seven);
                f32x4 e0 = g0 * (-1.702f * 1.44269504089f), e1 = g1 * (-1.702f * 1.44269504089f);
#pragma unroll
                for (int j = 0; j < 4; ++j) { e0[j] = __builtin_amdgcn_exp2f(e0[j]); e1[j] = __builtin_amdgcn_exp2f(e1[j]); }
                e0 = e0 + 1.0f; e1 = e1 + 1.0f;
#pragma unroll
                for (int j = 0; j < 4; ++j) { e0[j] = __builtin_amdgcn_rcpf(e0[j]); e1[j] = __builtin_amdgcn_rcpf(e1[j]); }
                g0 = g0 * e0 * (l0 + 1.0f); g1 = g1 * e1 * (l1 + 1.0f);
                u32x2 o8; o8.x = pk4_fp8(g0[0], g0[1], g0[2], g0[3]); o8.y = pk4_fp8(g1[0], g1[1], g1[2], g1[3]);
                *(u32x2*)(ACT + ((size_t)u.pm * 256 + EPI_ROWS(ai, m)) * 1024 + 128 * u.pn + w) = o8;
            }
    }
};
struct EpiDN { static constexpr bool HOOK = true; static constexpr bool CARRY = false; static DI float carry(const Unit&) { return 0.f; } static constexpr bool PERM = true;
    bf16_t* YB; const float* bdn; const LAS int* ts;
    DI void prefetch(const Unit& u, LAS unsigned char* lds, int wid, int lane) const {
        if (wid == 0) { const int e = moe_tile_expert(ts, u.pm); const int ln = lane_now();
            __builtin_amdgcn_global_load_lds((const unsigned*)(bdn + (size_t)e * 1024 + 256 * u.pn + 4 * ln), (LAS unsigned*)(lds + MISC_OFF + MO_RED), 16, 0, 0); }
    }
    DI void operator()(const Acc& acc, const Unit& u, int wr, int wc, int fr, int fq) const {
        const LAS float* bl_ = (const LAS float*)(ts) - MO_TS / 4 + MO_RED / 4;
#pragma unroll
        for (int bj = 0; bj < 2; ++bj) {
            const int cl = 128 * bj + 32 * wc + 8 * fq, col = 256 * u.pn + cl;
            const f32x4 b0 = *(const LAS f32x4*)(bl_ + cl), b1 = *(const LAS f32x4*)(bl_ + cl + 4);
#pragma unroll
            for (int ai = 0; ai < 2; ++ai)
#pragma unroll
                for (int m = 0; m < 4; ++m)
                    *(u32x4*)(YB + ((size_t)u.pm * 256 + EPI_ROWS(ai, m)) * 1024 + col) = pack8(acc[ai][bj][m][0] * (1.0f / 64.0f) + b0, acc[ai][bj][m][1] * (1.0f / 64.0f) + b1);
        }
    }
};
struct EpiPP { static constexpr bool HOOK = false; static constexpr bool CARRY = false; static DI float carry(const Unit&) { return 0.f; } static constexpr bool PERM = true;
    bf16_t* PP;
    DI void operator()(const Acc& acc, const Unit& u, int wr, int wc, int fr, int fq) const {
#pragma unroll
        for (int ai = 0; ai < 2; ++ai)
#pragma unroll
            for (int m = 0; m < 4; ++m) {
                bf16_t* rowp = PP + ((size_t)u.pm * 256 + EPI_ROWS(ai, m)) * 1024 + u.pn * 256 + 32 * wc + 8 * fq;
#pragma unroll
                for (int bj = 0; bj < 2; ++bj) *(u32x4*)(rowp + 128 * bj) = pack8(acc[ai][bj][m][0], acc[ai][bj][m][1]);
            }
    }
};
struct EpiPLE { static constexpr bool HOOK = false; static constexpr bool CARRY = false; static DI float carry(const Unit&) { return 0.f; } static constexpr bool PERM = true;
    bf16_t* H; const bf16_t* PP; float* out;
    DI void operator()(const Acc& acc, const Unit& u, int wr, int wc, int fr, int fq) const {
#pragma unroll
        for (int ai = 0; ai < 2; ++ai)
#pragma unroll
            for (int m = 0; m < 4; ++m) {
                const size_t off = (size_t)(u.pm * 256 + EPI_ROWS(ai, m)) * 1024 + u.pn * 256 + 32 * wc + 8 * fq;
#pragma unroll
                for (int bj = 0; bj < 2; ++bj) { const size_t o = off + 128 * bj;
                    const u32x4 pw = *(const u32x4*)(PP + o), hw = *(const u32x4*)(H + o); const f32x4 a0 = acc[ai][bj][m][0], a1 = acc[ai][bj][m][1];
                    f32x4 h0 = {bflo(hw.x), bfhi(hw.x), bflo(hw.y), bfhi(hw.y)}, h1 = {bflo(hw.z), bfhi(hw.z), bflo(hw.w), bfhi(hw.w)};
                    const f32x4 p0 = {bflo(pw.x), bfhi(pw.x), bflo(pw.y), bfhi(pw.y)}, p1 = {bflo(pw.z), bfhi(pw.z), bflo(pw.w), bfhi(pw.w)};
                    f32x4 e0 = a0 * (-WSC * 1.44269504089f), e1 = a1 * (-WSC * 1.44269504089f);
#pragma unroll
                    for (int j = 0; j < 4; ++j) { e0[j] = __builtin_amdgcn_exp2f(e0[j]); e1[j] = __builtin_amdgcn_exp2f(e1[j]); }
                    e0 = e0 + 1.0f; e1 = e1 + 1.0f;
#pragma unroll
                    for (int j = 0; j < 4; ++j) { e0[j] = __builtin_amdgcn_rcpf(e0[j]); e1[j] = __builtin_amdgcn_rcpf(e1[j]); }
                    h0 = h0 + e0 * p0; h1 = h1 + e1 * p1;
                    if (out) { *(f32x4*)(out + o) = h0; *(f32x4*)(out + o + 4) = h1; } else *(u32x4*)(H + o) = pack8(h0, h1);
                }
            }
    }
};

DI int vperm16(int key) { const int g = (key >> 2) & 3; const int ng = (g == 1) ? 2 : (g == 2) ? 1 : g; return (key & ~15) | (ng << 2) | (key & 3); }
template <int DV, int MODE>
DI void attn_unit(const int WID, LAS unsigned char* lds, const bf16_t* Qp, int ldq, const bf16_t* Kp, int ldk, const bf16_t* Vt, int ldvt, int q0, float slope, int dcut,
                  const unsigned* selp, bf16_t* Op, int ldo, float* impp) {
    constexpr int NRB = DV / 32;
    constexpr int KT_B = 64 * 128, VT_B = DV * 128, BUF_B = 2 * KT_B + 2 * VT_B;
    const int tid = opaque_tid(WID), w = __builtin_amdgcn_readfirstlane(tid >> 6), lane = tid & 63, r = lane & 31, hh = lane >> 5;
    const int qrow = q0 + 32 * w + r, qw_first = q0 + 32 * w, qw_last = qw_first + 31;
    const float LOG2E = 1.44269504089f;
    bf16x8 qf[4];
#pragma unroll
    for (int ks = 0; ks < 4; ++ks) qf[ks] = *(const bf16x8*)(Qp + (size_t)(32 * w + r) * ldq + 16 * ks + 8 * hh);
    unsigned selm = 0xffffffffu, orm = 0xffffffffu;
    if (MODE == 1) { selm = selp[32 * w + r]; orm = selm;
#pragma unroll
        for (int o = 1; o < 32; o <<= 1) orm |= shxu(orm, o); }
    const int nv = (MODE == 3) ? (qrow >= 31 ? ((qrow - 15) >> 4) : 0) : 0;
    const int nv_wmax = (MODE == 3) ? (qw_last >= 31 ? ((qw_last - 15) >> 4) : 0) : 0;
    int kt_lo = 0, kt_hi;
    if (MODE == 0 || MODE == 1) kt_hi = (q0 >> 6) + 4;
    else if (MODE == 2) { kt_hi = (q0 >> 6) + 4; const int lk = q0 - 511; kt_lo = lk > 0 ? (lk >> 6) : 0; }
    else kt_hi = 2;
    if (MODE != 3) { const int kmin = q0 - dcut; const int lo2 = kmin > 0 ? (kmin >> 6) : 0; kt_lo = lo2 > kt_lo ? lo2 : kt_lo; }
    f32x16 cb[2];
#pragma unroll
    for (int kk = 0; kk < 2; ++kk)
#pragma unroll
        for (int i = 0; i < 16; ++i) cb[kk][i] = (MODE == 3) ? 0.f : slope * (float)(32 * kk + 8 * (i >> 2) + (i & 3) + 4 * hh);
    f32x16 O[NRB];
#pragma unroll
    for (int rb = 0; rb < NRB; ++rb)
#pragma unroll
        for (int i = 0; i < 16; ++i) O[rb][i] = 0.f;
    float mrun = NEGF, lrun = 0.f;
    const int drow = tid >> 3, dpc = (tid & 7) ^ ((drow >> 1) & 7);
    const unsigned ldsw = (unsigned)w * 1024u;
#define AT_DMA(buf, sub, kt) do { const int kt_ = (kt) < 0 ? 0 : (kt); LAS unsigned char* b_ = lds + (buf) * BUF_B; \
        __builtin_amdgcn_global_load_lds((const unsigned*)(Kp + (size_t)(64 * kt_ + drow) * ldk + 8 * dpc), (LAS unsigned*)(b_ + (sub) * KT_B + ldsw), 16, 0, 0); \
        _Pragma("unroll") for (int i_ = 0; i_ < (DV + 63) / 64; ++i_) { if (64 * i_ + 64 <= DV || w < 4) \
            __builtin_amdgcn_global_load_lds((const unsigned*)(Vt + (size_t)(drow + 64 * i_) * ldvt + 64 * kt_ + 8 * dpc), (LAS unsigned*)(b_ + 2 * KT_B + (sub) * VT_B + i_ * 8192 + ldsw), 16, 0, 0); } } while (0)
    const int ntile = kt_hi - kt_lo, nstep = (ntile + 1) >> 1;
    AT_DMA(0, 0, kt_hi - 1); AT_DMA(0, 1, kt_hi - 2);
    asm volatile("s_waitcnt vmcnt(0)" ::: "memory");
    __syncthreads();
#if PROBE_ATT == 2
    AT_DMA(0, 0, kt_hi - 1); AT_DMA(0, 1, kt_hi - 2);
    asm volatile("s_waitcnt vmcnt(0)" ::: "memory");
    __syncthreads();
#endif
    const int sw = (r >> 1) & 7;
    for (int st = 0; st < nstep; ++st) {
        const int buf = st & 1;
        if (st + 1 < nstep) { AT_DMA(buf ^ 1, 0, kt_hi - 3 - 2 * st); AT_DMA(buf ^ 1, 1, kt_hi - 4 - 2 * st); }
#pragma unroll
        for (int sub = 0; sub < 2; ++sub) {
        const int kt = kt_hi - 1 - 2 * st - sub, key0 = 64 * kt;
        bool skip;
        if (MODE == 0) skip = key0 > qw_last;
        else if (MODE == 1) skip = (key0 > qw_last) || !((orm >> (kt & 31)) & 1u);
        else if (MODE == 2) skip = (key0 > qw_last) || (key0 + 63 < qw_first - 511);
        else skip = key0 >= nv_wmax;
        skip = skip || (kt < kt_lo);
        if (!skip) {
            const LAS unsigned char* kb = lds + buf * BUF_B + sub * KT_B; const LAS unsigned char* vb = lds + buf * BUF_B + 2 * KT_B + sub * VT_B;
            f32x16 S[2];
#pragma unroll
            for (int kk = 0; kk < 2; ++kk) {
                S[kk] = cb[kk];
#pragma unroll
                for (int ks = 0; ks < 4; ++ks) { const bf16x8 a = *(const LAS bf16x8*)(kb + (32 * kk + r) * 128 + (((2 * ks + hh) ^ sw) << 4));
                    S[kk] = __builtin_amdgcn_mfma_f32_32x32x16_bf16(a, qf[ks], S[kk], 0, 0, 0); }
            }
            const bool bnd = (MODE == 3) ? true : ((key0 + 63 > qw_first) || (MODE == 2 && key0 < qw_last - 511));
            if (bnd) {
                const int lim = (MODE == 3) ? (nv - key0 - 4 * hh) : (qrow - key0 - 4 * hh);
#pragma unroll
                for (int kk = 0; kk < 2; ++kk)
#pragma unroll
                    for (int i = 0; i < 16; ++i) { const int cki = 32 * kk + 8 * (i >> 2) + (i & 3);
                        bool valid;
                        if (MODE == 3) valid = cki < lim; else if (MODE == 2) valid = (cki <= lim) && (cki > lim - 512); else valid = cki <= lim;
                        S[kk][i] = valid ? S[kk][i] : NEGF; }
            }
            float mx = NEGF;
#pragma unroll
            for (int kk = 0; kk < 2; ++kk)
#pragma unroll
                for (int i = 0; i < 16; ++i) mx = fmaxf(mx, S[kk][i]);
            mx = fmaxf(mx, shx(mx, 32));
            const float off = (MODE == 3) ? 0.f : slope * (float)key0;
            mx += off;
            bool selok = true;
            if (MODE == 1) { selok = ((selm >> (kt & 31)) & 1u) != 0u; mx = selok ? mx : NEGF; }
            const float mnew = fmaxf(mrun, mx);
            const float meff = (mnew < -1e29f) ? 0.f : mnew;
            float c = (off - meff) * LOG2E;
            if (MODE == 1) c = selok ? c : NEGF;
#pragma unroll
            for (int kk = 0; kk < 2; ++kk) { f32x16 t = S[kk] * LOG2E + c;
#pragma unroll
                for (int i = 0; i < 16; ++i) t[i] = __builtin_amdgcn_exp2f(t[i]);
                S[kk] = t; }
            float ps;
            { typedef float f32x8 __attribute__((ext_vector_type(8)));
              const f32x16 su = S[0] + S[1];
              const f32x8 s8 = __builtin_shufflevector(su, su, 0, 1, 2, 3, 4, 5, 6, 7) + __builtin_shufflevector(su, su, 8, 9, 10, 11, 12, 13, 14, 15);
              const f32x4 s4 = __builtin_shufflevector(s8, s8, 0, 1, 2, 3) + __builtin_shufflevector(s8, s8, 4, 5, 6, 7);
              ps = (s4[0] + s4[1]) + (s4[2] + s4[3]); }
            if (__any(mnew > mrun)) {
                const float alpha = __builtin_amdgcn_exp2f((mrun - mnew) * LOG2E);
                lrun *= alpha;
#pragma unroll
                for (int rb = 0; rb < NRB; ++rb)
#pragma unroll
                    for (int i = 0; i < 16; ++i) O[rb][i] *= alpha;
            }
            mrun = mnew; lrun += ps;
#pragma unroll
            for (int kk = 0; kk < 2; ++kk)
#pragma unroll
                for (int s2 = 0; s2 < 2; ++s2) {
                    u32x4 pw; pw.x = pk2(S[kk][8 * s2 + 0], S[kk][8 * s2 + 1]); pw.y = pk2(S[kk][8 * s2 + 2], S[kk][8 * s2 + 3]);
                    pw.z = pk2(S[kk][8 * s2 + 4], S[kk][8 * s2 + 5]); pw.w = pk2(S[kk][8 * s2 + 6], S[kk][8 * s2 + 7]);
                    const bf16x8 pf = __builtin_bit_cast(bf16x8, pw);
#pragma unroll
                    for (int rb = 0; rb < NRB; ++rb) {
                        const bf16x8 a = *(const LAS bf16x8*)(vb + (32 * rb + r) * 128 + ((((2 * kk + s2) * 2 + hh) ^ sw) << 4));
                        O[rb] = __builtin_amdgcn_mfma_f32_32x32x16_bf16(a, pf, O[rb], 0, 0, 0);
                    }
                }
        }
        }
        asm volatile("s_waitcnt vmcnt(0)" ::: "memory");
        __syncthreads();
    }
#undef AT_DMA
    const float ltot = lrun + shx(lrun, 32);
    float inv = 1.0f / ltot;
    if (MODE == 3) inv = (nv > 0) ? inv : 0.f;
#if PROBE_ATT == 1
    for (int rep_ = 0; rep_ < 2; ++rep_) { asm volatile("" ::: "memory");
#endif
#pragma unroll
    for (int rb = 0; rb < NRB; ++rb)
#pragma unroll
        for (int g4 = 0; g4 < 4; ++g4) {
            const float a = O[rb][4 * g4] * inv, b = O[rb][4 * g4 + 1] * inv, c = O[rb][4 * g4 + 2] * inv, d = O[rb][4 * g4 + 3] * inv;
            const int dv = 32 * rb + 8 * g4 + 4 * hh;
            if (MODE == 3 && rb == 2) { *(f32x4*)(impp + (size_t)(32 * w + r) * 256 + (dv - 64)) = (f32x4){a, b, c, d}; }
            else { u32x2 o; o.x = pk2(a, b); o.y = pk2(c, d); *(u32x2*)(Op + (size_t)(32 * w + r) * ldo + dv) = o; }
        }
#if PROBE_ATT == 1
    }
#endif
}

DI void diff_unit(const int WID, LAS unsigned char* lds, const bf16_t* Q1p, const bf16_t* Q2p, const bf16_t* K1p, const bf16_t* K2p, const bf16_t* Vt, int q0, float slope, int dcut,
                  const float lam, const float oscale, const float* og, unsigned char* Ap) {
    constexpr int DV = 128, MODE = 0, ldq = 512, ldk = 512, ldvt = 2048;
    constexpr int NRB = DV / 32;
    constexpr int KT_B = 64 * 128, VT_B = DV * 128, BUF_B = 2 * KT_B + 2 * VT_B;
    const int tid = opaque_tid(WID), w = __builtin_amdgcn_readfirstlane(tid >> 6), lane = tid & 63, r = lane & 31, hh = lane >> 5;
    const int qrow = q0 + 32 * w + r, qw_first = q0 + 32 * w, qw_last = qw_first + 31;
    const float LOG2E = 1.44269504089f;
    unsigned selm = 0xffffffffu, orm = 0xffffffffu;
    const int nv = (MODE == 3) ? (qrow >= 31 ? ((qrow - 15) >> 4) : 0) : 0;
    const int nv_wmax = (MODE == 3) ? (qw_last >= 31 ? ((qw_last - 15) >> 4) : 0) : 0;
    int kt_lo = 0, kt_hi;
    if (MODE == 0 || MODE == 1) kt_hi = (q0 >> 6) + 4;
    else if (MODE == 2) { kt_hi = (q0 >> 6) + 4; const int lk = q0 - 511; kt_lo = lk > 0 ? (lk >> 6) : 0; }
    else kt_hi = 2;
    if (MODE != 3) { const int kmin = q0 - dcut; const int lo2 = kmin > 0 ? (kmin >> 6) : 0; kt_lo = lo2 > kt_lo ? lo2 : kt_lo; }
    f32x16 cb0;
#pragma unroll
    for (int i = 0; i < 16; ++i) cb0[i] = slope * (float)(8 * (i >> 2) + (i & 3) + 4 * hh);
    const float slope32 = 32.0f * slope;
    const int drow = tid >> 3, dpc = (tid & 7) ^ ((drow >> 1) & 7);
    const unsigned ldsw = (unsigned)w * 1024u;
#define AT_DMA(buf, sub, kt) do { const int kt_ = (kt) < 0 ? 0 : (kt); LAS unsigned char* b_ = lds + (buf) * BUF_B; \
        __builtin_amdgcn_global_load_lds((const unsigned*)(Kp + (size_t)(64 * kt_ + drow) * ldk + 8 * dpc), (LAS unsigned*)(b_ + (sub) * KT_B + ldsw), 16, 0, 0); \
        _Pragma("unroll") for (int i_ = 0; i_ < (DV + 63) / 64; ++i_) { if (64 * i_ + 64 <= DV || w < 4) \
            __builtin_amdgcn_global_load_lds((const unsigned*)(Vt + (size_t)(drow + 64 * i_) * ldvt + 64 * kt_ + 8 * dpc), (LAS unsigned*)(b_ + 2 * KT_B + (sub) * VT_B + i_ * 8192 + ldsw), 16, 0, 0); } } while (0)
    const int ntile = kt_hi - kt_lo, nstep = (ntile + 1) >> 1;
    const int sw = (r >> 1) & 7;
    u32x4 O1p[NRB][2];
#pragma unroll 1
    for (int pass = 0; pass < 2; ++pass) {
    const bf16_t* Qp = pass ? Q2p : Q1p; const bf16_t* Kp = pass ? K2p : K1p;
    bf16x8 qf[4];
#pragma unroll
    for (int ks = 0; ks < 4; ++ks) qf[ks] = *(const bf16x8*)(Qp + (size_t)(32 * w + r) * ldq + 16 * ks + 8 * hh);
    f32x16 O[NRB];
#pragma unroll
    for (int rb = 0; rb < NRB; ++rb)
#pragma unroll
        for (int i = 0; i < 16; ++i) O[rb][i] = 0.f;
    float mrun = NEGF, lrun = 0.f;
    AT_DMA(0, 0, kt_hi - 1); AT_DMA(0, 1, kt_hi - 2);
    asm volatile("s_waitcnt vmcnt(0)" ::: "memory");
    __syncthreads();
    for (int st = 0; st < nstep; ++st) {
        const int buf = st & 1;
        if (st + 1 < nstep) { AT_DMA(buf ^ 1, 0, kt_hi - 3 - 2 * st); AT_DMA(buf ^ 1, 1, kt_hi - 4 - 2 * st); }
#pragma unroll
        for (int sub = 0; sub < 2; ++sub) {
        const int kt = kt_hi - 1 - 2 * st - sub, key0 = 64 * kt;
        bool skip;
        if (MODE == 0) skip = key0 > qw_last;
        else if (MODE == 1) skip = (key0 > qw_last) || !((orm >> (kt & 31)) & 1u);
        else if (MODE == 2) skip = (key0 > qw_last) || (key0 + 63 < qw_first - 511);
        else skip = key0 >= nv_wmax;
        skip = skip || (kt < kt_lo);
        if (!skip) {
            const LAS unsigned char* kb = lds + buf * BUF_B + sub * KT_B; const LAS unsigned char* vb = lds + buf * BUF_B + 2 * KT_B + sub * VT_B;
            f32x16 S[2];
#pragma unroll
            for (int kk = 0; kk < 2; ++kk) {
                if (kk == 0) S[0] = cb0; else S[1] = cb0 + slope32;
#pragma unroll
                for (int ks = 0; ks < 4; ++ks) { const bf16x8 a = *(const LAS bf16x8*)(kb + (32 * kk + r) * 128 + (((2 * ks + hh) ^ sw) << 4));
                    S[kk] = __builtin_amdgcn_mfma_f32_32x32x16_bf16(a, qf[ks], S[kk], 0, 0, 0); }
            }
            const bool bnd = (MODE == 3) ? true : ((key0 + 63 > qw_first) || (MODE == 2 && key0 < qw_last - 511));
            if (bnd) {
                const int lim = (MODE == 3) ? (nv - key0 - 4 * hh) : (qrow - key0 - 4 * hh);
#pragma unroll
                for (int kk = 0; kk < 2; ++kk)
#pragma unroll
                    for (int i = 0; i < 16; ++i) { const int cki = 32 * kk + 8 * (i >> 2) + (i & 3);
                        bool valid;
                        if (MODE == 3) valid = cki < lim; else if (MODE == 2) valid = (cki <= lim) && (cki > lim - 512); else valid = cki <= lim;
                        S[kk][i] = valid ? S[kk][i] : NEGF; }
            }
            float mx = NEGF;
#pragma unroll
            for (int kk = 0; kk < 2; ++kk)
#pragma unroll
                for (int i = 0; i < 16; ++i) mx = fmaxf(mx, S[kk][i]);
            mx = fmaxf(mx, shx(mx, 32));
            const float off = (MODE == 3) ? 0.f : slope * (float)key0;
            mx += off;
            bool selok = true;
            if (MODE == 1) { selok = ((selm >> (kt & 31)) & 1u) != 0u; mx = selok ? mx : NEGF; }
            const float mnew = fmaxf(mrun, mx);
            const float meff = (mnew < -1e29f) ? 0.f : mnew;
            float c = (off - meff) * LOG2E;
            if (MODE == 1) c = selok ? c : NEGF;
#pragma unroll
            for (int kk = 0; kk < 2; ++kk) { f32x16 t = S[kk] * LOG2E + c;
#pragma unroll
                for (int i = 0; i < 16; ++i) t[i] = __builtin_amdgcn_exp2f(t[i]);
                S[kk] = t; }
            float ps;
            { typedef float f32x8 __attribute__((ext_vector_type(8)));
              const f32x16 su = S[0] + S[1];
              const f32x8 s8 = __builtin_shufflevector(su, su, 0, 1, 2, 3, 4, 5, 6, 7) + __builtin_shufflevector(su, su, 8, 9, 10, 11, 12, 13, 14, 15);
              const f32x4 s4 = __builtin_shufflevector(s8, s8, 0, 1, 2, 3) + __builtin_shufflevector(s8, s8, 4, 5, 6, 7);
              ps = (s4[0] + s4[1]) + (s4[2] + s4[3]); }
            if (__any(mnew > mrun)) {
                const float alpha = __builtin_amdgcn_exp2f((mrun - mnew) * LOG2E);
                lrun *= alpha;
#pragma unroll
                for (int rb = 0; rb < NRB; ++rb)
#pragma unroll
                    for (int i = 0; i < 16; ++i) O[rb][i] *= alpha;
            }
            mrun = mnew; lrun += ps;
#pragma unroll
            for (int kk = 0; kk < 2; ++kk)
#pragma unroll
                for (int s2 = 0; s2 < 2; ++s2) {
                    u32x4 pw; pw.x = pk2(S[kk][8 * s2 + 0], S[kk][8 * s2 + 1]); pw.y = pk2(S[kk][8 * s2 + 2], S[kk][8 * s2 + 3]);
                    pw.z = pk2(S[kk][8 * s2 + 4], S[kk][8 * s2 + 5]); pw.w = pk2(S[kk][8 * s2 + 6], S[kk][8 * s2 + 7]);
                    const bf16x8 pf = __builtin_bit_cast(bf16x8, pw);
#pragma unroll
                    for (int rb = 0; rb < NRB; ++rb) {
                        const bf16x8 a = *(const LAS bf16x8*)(vb + (32 * rb + r) * 128 + ((((2 * kk + s2) * 2 + hh) ^ sw) << 4));
                        O[rb] = __builtin_amdgcn_mfma_f32_32x32x16_bf16(a, pf, O[rb], 0, 0, 0);
                    }
                }
        }
        }
        asm volatile("s_waitcnt vmcnt(0)" ::: "memory");
        __syncthreads();
    }
#undef AT_DMA
    const float ltot = lrun + shx(lrun, 32);
    const float inv = 1.0f / ltot;
    if (pass == 0) {
#pragma unroll
        for (int rb = 0; rb < NRB; ++rb) { const f32x16 on = O[rb] * inv;
            O1p[rb][0] = (u32x4){pk2(on[0], on[1]), pk2(on[2], on[3]), pk2(on[4], on[5]), pk2(on[6], on[7])};
            O1p[rb][1] = (u32x4){pk2(on[8], on[9]), pk2(on[10], on[11]), pk2(on[12], on[13]), pk2(on[14], on[15])}; }
    } else {
        const float li = lam * inv; float ss = 0.f;
#pragma unroll
        for (int rb = 0; rb < NRB; ++rb) {
            const u32x4 p0 = O1p[rb][0], p1 = O1p[rb][1];
            const f32x16 o1 = {bflo(p0.x), bfhi(p0.x), bflo(p0.y), bfhi(p0.y), bflo(p0.z), bfhi(p0.z), bflo(p0.w), bfhi(p0.w), bflo(p1.x), bfhi(p1.x), bflo(p1.y), bfhi(p1.y), bflo(p1.z), bfhi(p1.z), bflo(p1.w), bfhi(p1.w)};
            O[rb] = o1 - O[rb] * li;
#pragma unroll
            for (int i = 0; i < 16; ++i) ss += O[rb][i] * O[rb][i];
        }
        ss += shx(ss, 32);
        const float rs = rsqrtf(ss * (1.0f / 128.0f) + EPS) * (oscale * A_SC);
        const int hg_ = lane_now() >> 5;
#pragma unroll
        for (int rb = 0; rb < NRB; ++rb)
#pragma unroll
            for (int g4 = 0; g4 < 4; ++g4) { const int dv = 32 * rb + 8 * g4 + 4 * hh; const f32x4 gg = *(const f32x4*)(og + 32 * rb + 8 * g4 + 4 * hg_);
                *(unsigned*)(Ap + (size_t)(32 * w + r) * 1024 + dv) = pk4_fp8(O[rb][4 * g4] * rs * gg[0], O[rb][4 * g4 + 1] * rs * gg[1], O[rb][4 * g4 + 2] * rs * gg[2], O[rb][4 * g4 + 3] * rs * gg[3]); }
    }
    }
}

template <int DV, int MODE>
DI void nsa_unit(const int WID, LAS unsigned char* lds, const bf16x8 (&qf)[4], const bf16_t* Kp, int ldk, const bf16_t* Vt, int ldvt, int q0, int g, float sb2,
                 const LAS unsigned* selp, f32x16 (&OB)[2], const float gate, LAS float* impp) {
    constexpr int NRB = DV / 32;
    constexpr int KT_B = 64 * 128, VT_B = DV * 128, BUF_B = 2 * KT_B + 2 * VT_B;
    const int tid = opaque_tid(WID), w = __builtin_amdgcn_readfirstlane(tid >> 6), lane = tid & 63, r = lane & 31, hh = lane >> 5;
    const int hr = w >> 1, qh = w & 1;
    const float slope = (MODE == 1) ? exp2f(-(float)(4 * g + hr + 1)) : 0.f;
    const int dcut = (MODE == 1) ? (int)fminf(sb2 / slope + 1.0f, 100000.0f) : 0, dcut_max = (MODE == 1) ? (int)fminf(sb2 * exp2f((float)(4 * g + 4)) + 1.0f, 100000.0f) : 0;
    const int qrow = q0 + 32 * qh + r, qw_first = q0 + 32 * qh, qw_last = qw_first + 31;
    const float LOG2E = 1.44269504089f;
    unsigned selm = 0xffffffffu, orm = 0xffffffffu;
    if (MODE == 1) { selm = selp[32 * qh + r]; orm = selm;
#pragma unroll
        for (int o = 1; o < 32; o <<= 1) orm |= shxu(orm, o); }
    const int nv = (MODE == 3) ? (qrow >= 31 ? ((qrow - 15) >> 4) : 0) : 0;
    const int nv_wmax = (MODE == 3) ? (qw_last >= 31 ? ((qw_last - 15) >> 4) : 0) : 0;
    int kt_lo = 0, kt_hi;
    if (MODE == 1) kt_hi = (q0 >> 6) + 1; else kt_hi = 2;
    if (MODE != 3) { const int kmin = q0 - dcut_max; const int lo2 = kmin > 0 ? (kmin >> 6) : 0; kt_lo = lo2 > kt_lo ? lo2 : kt_lo; }
    f32x16 cb[2];
#pragma unroll
    for (int kk = 0; kk < 2; ++kk)
#pragma unroll
        for (int i = 0; i < 16; ++i) cb[kk][i] = (MODE == 3) ? 0.f : slope * (float)(32 * kk + 8 * (i >> 2) + (i & 3) + 4 * hh);
    f32x16 O[NRB];
#pragma unroll
    for (int rb = 0; rb < NRB; ++rb)
#pragma unroll
        for (int i = 0; i < 16; ++i) O[rb][i] = 0.f;
    float mrun = NEGF, lrun = 0.f;
    const int drow = tid >> 3, dpc = (tid & 7) ^ ((drow >> 1) & 7);
    const unsigned ldsw = (unsigned)w * 1024u;
#define AT_DMA(buf, sub, kt) do { const int kt_ = (kt) < 0 ? 0 : (kt); LAS unsigned char* b_ = lds + (buf) * BUF_B; \
        __builtin_amdgcn_global_load_lds((const unsigned*)(Kp + (size_t)(64 * kt_ + drow) * ldk + 8 * dpc), (LAS unsigned*)(b_ + (sub) * KT_B + ldsw), 16, 0, 0); \
        _Pragma("unroll") for (int i_ = 0; i_ < (DV + 63) / 64; ++i_) { if (64 * i_ + 64 <= DV || w < 4) \
            __builtin_amdgcn_global_load_lds((const unsigned*)(Vt + (size_t)(drow + 64 * i_) * ldvt + 64 * kt_ + 8 * dpc), (LAS unsigned*)(b_ + 2 * KT_B + (sub) * VT_B + i_ * 8192 + ldsw), 16, 0, 0); } } while (0)
    const int ntile = kt_hi - kt_lo, nstep = (ntile + 1) >> 1;
    AT_DMA(0, 0, kt_hi - 1); AT_DMA(0, 1, kt_hi - 2);
    asm volatile("s_waitcnt vmcnt(0)" ::: "memory");
    __syncthreads();
    const int sw = (r >> 1) & 7;
    for (int st = 0; st < nstep; ++st) {
        const int buf = st & 1;
        if (st + 1 < nstep) { AT_DMA(buf ^ 1, 0, kt_hi - 3 - 2 * st); AT_DMA(buf ^ 1, 1, kt_hi - 4 - 2 * st); }
#pragma unroll
        for (int sub = 0; sub < 2; ++sub) {
        const int kt = kt_hi - 1 - 2 * st - sub, key0 = 64 * kt;
        bool skip;
        if (MODE == 0) skip = key0 > qw_last;
        else if (MODE == 1) skip = (key0 > qw_last) || !((orm >> (kt & 31)) & 1u) || (key0 + 63 < qw_first - dcut);
        else if (MODE == 2) skip = (key0 > qw_last) || (key0 + 63 < qw_first - 511);
        else skip = key0 >= nv_wmax;
        skip = skip || (kt < kt_lo);
        if (!skip) {
            const LAS unsigned char* kb = lds + buf * BUF_B + sub * KT_B; const LAS unsigned char* vb = lds + buf * BUF_B + 2 * KT_B + sub * VT_B;
            f32x16 S[2];
#pragma unroll
            for (int kk = 0; kk < 2; ++kk) {
                S[kk] = cb[kk];
#pragma unroll
                for (int ks = 0; ks < 4; ++ks) { const bf16x8 a = *(const LAS bf16x8*)(kb + (32 * kk + r) * 128 + (((2 * ks + hh) ^ sw) << 4));
                    S[kk] = __builtin_amdgcn_mfma_f32_32x32x16_bf16(a, qf[ks], S[kk], 0, 0, 0); }
            }
            const bool bnd = (MODE == 3) ? true : ((key0 + 63 > qw_first) || (MODE == 2 && key0 < qw_last - 511));
            if (bnd) {
                const int lim = (MODE == 3) ? (nv - key0 - 4 * hh) : (qrow - key0 - 4 * hh);
#pragma unroll
                for (int kk = 0; kk < 2; ++kk)
#pragma unroll
                    for (int i = 0; i < 16; ++i) { const int cki = 32 * kk + 8 * (i >> 2) + (i & 3);
                        bool valid;
                        if (MODE == 3) valid = cki < lim; else if (MODE == 2) valid = (cki <= lim) && (cki > lim - 512); else valid = cki <= lim;
                        S[kk][i] = valid ? S[kk][i] : NEGF; }
            }
            float mx = NEGF;
#pragma unroll
            for (int kk = 0; kk < 2; ++kk)
#pragma unroll
                for (int i = 0; i < 16; ++i) mx = fmaxf(mx, S[kk][i]);
            mx = fmaxf(mx, shx(mx, 32));
            const float off = (MODE == 3) ? 0.f : slope * (float)key0;
            mx += off;
            bool selok = true;
            if (MODE == 1) { selok = ((selm >> (kt & 31)) & 1u) != 0u; mx = selok ? mx : NEGF; }
            const float mnew = fmaxf(mrun, mx);
            const float meff = (mnew < -1e29f) ? 0.f : mnew;
            float c = (off - meff) * LOG2E;
            if (MODE == 1) c = selok ? c : NEGF;
#pragma unroll
            for (int kk = 0; kk < 2; ++kk) { f32x16 t = S[kk] * LOG2E + c;
#pragma unroll
                for (int i = 0; i < 16; ++i) t[i] = __builtin_amdgcn_exp2f(t[i]);
                S[kk] = t; }
            float ps;
            { typedef float f32x8 __attribute__((ext_vector_type(8)));
              const f32x16 su = S[0] + S[1];
              const f32x8 s8 = __builtin_shufflevector(su, su, 0, 1, 2, 3, 4, 5, 6, 7) + __builtin_shufflevector(su, su, 8, 9, 10, 11, 12, 13, 14, 15);
              const f32x4 s4 = __builtin_shufflevector(s8, s8, 0, 1, 2, 3) + __builtin_shufflevector(s8, s8, 4, 5, 6, 7);
              ps = (s4[0] + s4[1]) + (s4[2] + s4[3]); }
            if (__any(mnew > mrun)) {
                const float alpha = __builtin_amdgcn_exp2f((mrun - mnew) * LOG2E);
                lrun *= alpha;
#pragma unroll
                for (int rb = 0; rb < NRB; ++rb)
#pragma unroll
                    for (int i = 0; i < 16; ++i) O[rb][i] *= alpha;
            }
            mrun = mnew; lrun += ps;
#pragma unroll
            for (int kk = 0; kk < 2; ++kk)
#pragma unroll
                for (int s2 = 0; s2 < 2; ++s2) {
                    u32x4 pw; pw.x = pk2(S[kk][8 * s2 + 0], S[kk][8 * s2 + 1]); pw.y = pk2(S[kk][8 * s2 + 2], S[kk][8 * s2 + 3]);
                    pw.z = pk2(S[kk][8 * s2 + 4], S[kk][8 * s2 + 5]); pw.w = pk2(S[kk][8 * s2 + 6], S[kk][8 * s2 + 7]);
                    const bf16x8 pf = __builtin_bit_cast(bf16x8, pw);
#pragma unroll
                    for (int rb = 0; rb < NRB; ++rb) {
                        const bf16x8 a = *(const LAS bf16x8*)(vb + (32 * rb + r) * 128 + ((((2 * kk + s2) * 2 + hh) ^ sw) << 4));
                        O[rb] = __builtin_amdgcn_mfma_f32_32x32x16_bf16(a, pf, O[rb], 0, 0, 0);
                    }
                }
        }
        }
        asm volatile("s_waitcnt vmcnt(0)" ::: "memory");
        __syncthreads();
    }
#undef AT_DMA
    const float ltot = lrun + shx(lrun, 32);
    float inv = 1.0f / ltot;
    if (MODE == 3) inv = (nv > 0) ? inv : 0.f;
    const float gi = inv * gate;
#pragma unroll
    for (int rb = 0; rb < 2; ++rb) OB[rb] += O[rb] * gi;
    if (MODE == 3) {
#pragma unroll
        for (int g4 = 0; g4 < 4; ++g4)
            *(LAS f32x4*)(impp + (hr * 64 + 32 * qh + r) * 32 + 8 * g4 + 4 * hh) = (f32x4){O[2][4 * g4] * inv, O[2][4 * g4 + 1] * inv, O[2][4 * g4 + 2] * inv, O[2][4 * g4 + 3] * inv};
    }
}


struct Args { const float* in[26]; float* out; unsigned char* ws; int ph_lo, ph_hi; };
typedef const __attribute__((address_space(4))) Args* ArgsP;
DI ArgsP opaque_args() { auto p = __builtin_amdgcn_kernarg_segment_ptr(); asm volatile("" : "+s"(p)); return (ArgsP)p; }
enum { I_X = 0, I_P, I_N1G, I_N2G, I_EVWIN, I_EVWOUT, I_DAQN, I_DAKN, I_DALAM, I_DAOUTG, I_NSQN, I_NSKN, I_CMPPE, I_CMPW1, I_CMPW2, I_ODWIN, I_ODWOUT,
       I_RETG, I_ROUTW, I_ROUTB, I_WGU, I_BGU, I_WDN, I_BDN, I_PLEP, I_PLEG };

struct CvtJob { int in_idx, ldsrc, K, col0, ncols, dstrow0, perm, nmat; size_t src_stride, dst_off, dst_stride; int fp8, pad; };
constexpr int NJOBS = 19;
__constant__ CvtJob c_jobs[NJOBS] = {
    {I_EVWIN, EVIN, 1024, 0,    1024, 0,    1, 2, (size_t)1024 * EVIN, WS_EVNAT, (size_t)2048 * 1024, 0, 0},
    {I_EVWIN, EVIN, 1024, 1536, 512,  1024, 1, 2, (size_t)1024 * EVIN, WS_EVNAT, (size_t)2048 * 1024, 0, 0},
    {I_EVWIN, EVIN, 1024, 2048, 128,  1536, 1, 2, (size_t)1024 * EVIN, WS_EVNAT, (size_t)2048 * 1024, 0, 0},
    {I_EVWIN, EVIN, 1024, 2176, 128,  1664, 1, 2, (size_t)1024 * EVIN, WS_EVNAT, (size_t)2048 * 1024, 0, 0},
    {I_EVWIN, EVIN, 1024, 2304, 128,  1792, 1, 2, (size_t)1024 * EVIN, WS_EVNAT, (size_t)2048 * 1024, 0, 0},
    {I_EVWIN, EVIN, 1024, 2560, 128,  1920, 1, 2, (size_t)1024 * EVIN, WS_EVNAT, (size_t)2048 * 1024, 0, 0},
    {I_EVWIN, EVIN, 1024, 1024, 512,  0,    0, 2, (size_t)1024 * EVIN, WS_EVSW,  (size_t)768 * 1024, 0, 0},
    {I_EVWIN, EVIN, 1024, 2432, 128,  512,  0, 2, (size_t)1024 * EVIN, WS_EVSW,  (size_t)768 * 1024, 0, 0},
    {I_EVWIN, EVIN, 1024, 2688, 128,  640,  0, 2, (size_t)1024 * EVIN, WS_EVSW,  (size_t)768 * 1024, 0, 0},
    {I_EVWOUT, 1024, 1024, 0, 1024, 0, 0, 2, (size_t)1024 * 1024, WS_EVOUT, (size_t)1024 * 1024, 64, 0},
    {I_CMPW1, 256, 2048, 0, 256, 0, 0, 4, (size_t)2048 * 256, WS_CMP1, (size_t)256 * 2048, 0, 0},
    {I_ODWIN, ODIN, 1024, 0,    2048, 0,    0, 2, (size_t)1024 * ODIN, WS_ODNAT, (size_t)4096 * 1024, 32, 0},
    {I_ODWIN, ODIN, 1024, 4096, 2048, 2048, 0, 2, (size_t)1024 * ODIN, WS_ODNAT, (size_t)4096 * 1024, 32, 0},
    {I_ODWIN, ODIN, 1024, 2048, 2048, 0,    0, 2, (size_t)1024 * ODIN, WS_ODSW,  (size_t)2048 * 1024, 32, 0},
    {I_ODWOUT, 1024, 2048, 0, 1024, 0, 0, 2, (size_t)2048 * 1024, WS_ODOUT, (size_t)1024 * 2048, 128, 0},
    {I_WGU, 2048, 1024, 0, 2048, 0, 2, 128, (size_t)1024 * 2048, WS_WGU, (size_t)2048 * 1024, 32, 0},
    {I_WDN, 1024, 1024, 0, 1024, 0, 0, 128, (size_t)1024 * 1024, WS_WDN, (size_t)1024 * 1024, 64, 0},
    {I_PLEP, 1024, 256, 0, 1024, 0, 0, 4, (size_t)256 * 1024, WS_WPP, (size_t)1024 * 256, 0, 0},
    {I_PLEG, 1024, 1024, 0, 1024, 0, 0, 4, (size_t)1024 * 1024, WS_WPG, (size_t)1024 * 1024, 32, 0},
};
DI int cvt_dstrow(int perm, int L) {
    if (perm == 1) { const int pn = L >> 8, lc = L & 255; return pn * 256 + 128 * ((lc & 63) >> 5) + 32 * (lc >> 6) + (lc & 31); }
    if (perm == 2) { const int bj = L >> 10, cc = L & 1023; return 256 * (cc >> 7) + 128 * bj + (cc & 127); }
    return L;
}
DI void phase_prologue(const int WID, ArgsP a, LAS unsigned char* lds) {
    const int tid = opaque_tid(WID), lane = tid & 63, wv = tid >> 6;
    const int gw = blockIdx.x * 8 + wv, NGW = gridDim.x * 8;
    LAS float* scr = (LAS float*)(lds + wv * 16896);
    int total = 0;
    for (int j = 0; j < NJOBS; ++j) total += c_jobs[j].nmat * (c_jobs[j].K >> 6) * (c_jobs[j].ncols >> 6);
#define PRO_DECODE(IT, JJ, MAT, K0, N0, SRC, RS) do { int r_ = (IT), j_ = 0; \
        for (; j_ < NJOBS; ++j_) { const int n_ = c_jobs[j_].nmat * (c_jobs[j_].K >> 6) * (c_jobs[j_].ncols >> 6); if (r_ < n_) break; r_ -= n_; } \
        JJ = j_; const bool f8_ = c_jobs[j_].fp8 != 0; const int nkb_ = f8_ ? (c_jobs[j_].K >> 7) : (c_jobs[j_].K >> 6), nnb_ = f8_ ? (c_jobs[j_].ncols >> 5) : (c_jobs[j_].ncols >> 6), per_ = nkb_ * nnb_; \
        MAT = r_ / per_; const int rr_ = r_ % per_; K0 = (rr_ / nnb_) * (f8_ ? 128 : 64); N0 = (rr_ % nnb_) * (f8_ ? 32 : 64); const int ld_ = c_jobs[j_].ldsrc; \
        SRC = a->in[c_jobs[j_].in_idx] + (size_t)MAT * c_jobs[j_].src_stride + (size_t)K0 * ld_ + c_jobs[j_].col0 + N0 + (f8_ ? (lane & 31) + (lane >> 5) * ld_ : lane); RS = f8_ ? 2 * ld_ : ld_; } while (0)
    float tv[64];
    int jn = 0, matn = 0, k0n = 0, n0n = 0, rsn = 0; const float* srcn = nullptr;
    if (gw < total) { PRO_DECODE(gw, jn, matn, k0n, n0n, srcn, rsn);
#pragma unroll
        for (int i = 0; i < 64; ++i) tv[i] = srcn[(size_t)i * rsn]; }
    for (int it = gw; it < total; it += NGW) {
        const CvtJob J = c_jobs[jn]; const int mat = matn, k0 = k0n, n0 = n0n;
        { const int wb = J.fp8 ? (lane >> 5) * 33 + (lane & 31) : lane, wst = J.fp8 ? 66 : 65;
#pragma unroll
          for (int i = 0; i < 64; ++i) scr[wb + i * wst] = tv[i]; }
        if (it + NGW < total) { PRO_DECODE(it + NGW, jn, matn, k0n, n0n, srcn, rsn);
#if PROBE_PRO == 2
            { float sink = 0.f;
#pragma unroll
              for (int i = 0; i < 64; ++i) sink += ((const volatile float*)srcn)[(size_t)i * rsn];
              asm volatile("" :: "v"(sink)); }
#endif
#pragma unroll
            for (int i = 0; i < 64; ++i) tv[i] = srcn[(size_t)i * rsn]; }
        asm volatile("s_waitcnt lgkmcnt(0)" ::: "memory");
        if (J.fp8) {
            unsigned char* dst = (unsigned char*)(a->ws + J.dst_off) + (size_t)mat * J.dst_stride;
            const int c = lane & 7, nsub = lane >> 3; const float W8_S = (float)J.fp8;
#pragma unroll
            for (int jj = 0; jj < 4; ++jj) {
                const int n = nsub + 8 * jj; const LAS float* s = scr + (16 * c) * 33 + n;
                u32x4 o;
                o.x = pk4_fp8(s[0] * W8_S, s[33] * W8_S, s[2 * 33] * W8_S, s[3 * 33] * W8_S); o.y = pk4_fp8(s[4 * 33] * W8_S, s[5 * 33] * W8_S, s[6 * 33] * W8_S, s[7 * 33] * W8_S);
                o.z = pk4_fp8(s[8 * 33] * W8_S, s[9 * 33] * W8_S, s[10 * 33] * W8_S, s[11 * 33] * W8_S); o.w = pk4_fp8(s[12 * 33] * W8_S, s[13 * 33] * W8_S, s[14 * 33] * W8_S, s[15 * 33] * W8_S);
                const int drow = cvt_dstrow(J.perm, J.dstrow0 + n0 + n);
                *(u32x4*)(dst + (size_t)drow * J.K + k0 + 16 * c) = o;
#if PROBE_PRO == 1
                asm volatile("" ::: "memory"); *(u32x4*)(dst + (size_t)drow * J.K + k0 + 16 * c) = o;
#endif
            }
        } else {
            bf16_t* dst = (bf16_t*)(a->ws + J.dst_off) + (size_t)mat * J.dst_stride;
            const int c = lane & 7, nsub = lane >> 3;
#pragma unroll
            for (int jj = 0; jj < 8; ++jj) {
                const int n = nsub + 8 * jj; const LAS float* s = scr + (8 * c) * 65 + n;
                u32x4 o; o.x = pk2(s[0], s[65]); o.y = pk2(s[2 * 65], s[3 * 65]); o.z = pk2(s[4 * 65], s[5 * 65]); o.w = pk2(s[6 * 65], s[7 * 65]);
                const int drow = cvt_dstrow(J.perm, J.dstrow0 + n0 + n);
                *(u32x4*)(dst + (size_t)drow * J.K + k0 + 8 * c) = o;
#if PROBE_PRO == 1
                asm volatile("" ::: "memory"); *(u32x4*)(dst + (size_t)drow * J.K + k0 + 8 * c) = o;
#endif
            }
        }
        asm volatile("s_waitcnt lgkmcnt(0)" ::: "memory");
    }
#undef PRO_DECODE
    {
        const float* p = a->in[I_P]; bf16_t* pb = (bf16_t*)(a->ws + WS_PBF);
        const size_t n8 = (size_t)DEPTH * T * 256 / 8;
        for (size_t i = (size_t)blockIdx.x * 512 + tid; i < n8; i += (size_t)gridDim.x * 512) {
            const f32x4 v0 = *(const f32x4*)(p + i * 8), v1 = *(const f32x4*)(p + i * 8 + 4);
            *(u32x4*)(pb + i * 8) = pack8(v0, v1);
        }
    }
    if (blockIdx.x == 4 && tid < 512) { const int ev = tid >> 8, gi = (tid >> 6) & 3, d = tid & 63;
        const float* src = a->in[gi == 0 ? I_DAQN : gi == 1 ? I_DAKN : gi == 2 ? I_NSQN : I_NSKN];
        ((float*)(a->ws + WS_GAINS))[tid] = src[ev * 64 + d]; }
    if (blockIdx.x < 4 && tid < 256) {
        const int m = blockIdx.x; const float* pe = a->in[I_CMPPE] + (size_t)m * 2048; const float* w1 = a->in[I_CMPW1] + (size_t)m * 2048 * 256;
        float s = 0.f;
        for (int k = 0; k < 2048; ++k) s += pe[k] * w1[(size_t)k * 256 + tid];
        ((float*)(a->ws + WS_BIAS1))[m * 256 + tid] = s;
    }
}

DI float row_load_ss(const float* row, int lane, f32x4 (&v)[4]) {
    float ss = 0.f;
#pragma unroll
    for (int j = 0; j < 4; ++j) { v[j] = *(const f32x4*)(row + 4 * lane + 256 * j); ss += (v[j][0] * v[j][0] + v[j][1] * v[j][1]) + (v[j][2] * v[j][2] + v[j][3] * v[j][3]); }
    return wave_sum(ss);
}
DI void row_store_bf16(bf16_t* row, int lane, const f32x4 (&v)[4]) {
#pragma unroll
    for (int j = 0; j < 4; ++j) { u32x2 o; o.x = pk2(v[j][0], v[j][1]); o.y = pk2(v[j][2], v[j][3]); *(u32x2*)(row + 4 * lane + 256 * j) = o; }
}
template <int MODE>
DI void phase_norm(const int WID, ArgsP a, LAS unsigned char* lds, int layer, const void* Hin, const bool hb) {
    const int tid = opaque_tid(WID), lane = tid & 63, wv = __builtin_amdgcn_readfirstlane(tid >> 6);
    LAS float* wt = (LAS float*)lds;
    LAS int* bcl = (LAS int*)(lds + MISC_OFF + MO_WCNT); LAS int* ent = (LAS int*)(lds + MISC_OFF + MO_ENT); LAS float* gat = (LAS float*)(lds + MISC_OFF + MO_GAT);
    LAS float* lgb = (LAS float*)(lds + MISC_OFF + MO_RED);
    bf16_t* XN = (bf16_t*)(a->ws + WS_XN);
    const float* gain = a->in[MODE == 2 ? I_N2G : I_N1G] + layer * 1024;
    constexpr int NQ = MODE == 0 ? 24 : (MODE == 2 ? 32 : 0);
    if (NQ > 0) {
        const float* w = (MODE == 0) ? a->in[I_EVWIN] + (size_t)(layer >> 1) * 1024 * EVIN + 2816 : a->in[I_ROUTW] + (size_t)layer * 1024 * 32;
        const int ldw = (MODE == 0) ? EVIN : 32;
        for (int i = tid; i < 256 * 32; i += 512) { const int q = i & 31, g = i >> 5;
            if (q < NQ) { f32x4 v; v[0] = w[(size_t)(4 * g) * ldw + q]; v[1] = w[(size_t)(4 * g + 1) * ldw + q]; v[2] = w[(size_t)(4 * g + 2) * ldw + q]; v[3] = w[(size_t)(4 * g + 3) * ldw + q];
                *(LAS f32x4*)(wt + q * 1024 + 4 * (g ^ q)) = v; } }
    }
    f32x4 gn[4];
#pragma unroll
    for (int j = 0; j < 4; ++j) gn[j] = *(const f32x4*)(gain + 4 * lane + 256 * j);
    const float rbias = (MODE == 2) ? a->in[I_ROUTB][layer * 32 + (lane & 31)] : 0.f;
    __syncthreads();
    for (int vb = blockIdx.x; vb < NTB; vb += gridDim.x) {
        if (MODE == 2) { if (tid < 32) bcl[tid] = 0; }
        const int t0 = vb * 128 + wv * 16;
        f32x4 na[4], nb[4];
#pragma unroll
        for (int j = 0; j < 4; ++j) { na[j] = ld_h4(Hin, hb, (size_t)t0 * 1024 + 4 * lane + 256 * j); nb[j] = ld_h4(Hin, hb, (size_t)(t0 + 1) * 1024 + 4 * lane + 256 * j); }
#pragma unroll 1
        for (int it = 0; it < 8; ++it) {
            const int ta = t0 + 2 * it;
            f32x4 va[4], vc[4];
#pragma unroll
            for (int j = 0; j < 4; ++j) { va[j] = na[j]; vc[j] = nb[j]; }
            if (it < 7) {
#pragma unroll
                for (int j = 0; j < 4; ++j) { na[j] = ld_h4(Hin, hb, (size_t)(ta + 2) * 1024 + 4 * lane + 256 * j); nb[j] = ld_h4(Hin, hb, (size_t)(ta + 3) * 1024 + 4 * lane + 256 * j); }
            }
            float sa = 0.f, sb = 0.f;
#pragma unroll
            for (int j = 0; j < 4; ++j) { sa += (va[j][0] * va[j][0] + va[j][1] * va[j][1]) + (va[j][2] * va[j][2] + va[j][3] * va[j][3]); sb += (vc[j][0] * vc[j][0] + vc[j][1] * vc[j][1]) + (vc[j][2] * vc[j][2] + vc[j][3] * vc[j][3]); }
#pragma unroll
            for (int o = 1; o < 64; o <<= 1) { sa += shxl(sa, o, lane); sb += shxl(sb, o, lane); }
            const float ra = rsqrtf(sa * (1.0f / 1024.0f) + EPS), rb2 = rsqrtf(sb * (1.0f / 1024.0f) + EPS);
#pragma unroll
            for (int j = 0; j < 4; ++j) { va[j] = va[j] * ra * gn[j]; vc[j] = vc[j] * rb2 * gn[j]; }
            if (MODE == 1) {
                unsigned char* X8 = (unsigned char*)XN;
#pragma unroll
                for (int j = 0; j < 4; ++j) { *(unsigned*)(X8 + (size_t)ta * 1024 + 4 * lane + 256 * j) = pk4_fp8(va[j][0], va[j][1], va[j][2], va[j][3]);
                    *(unsigned*)(X8 + (size_t)(ta + 1) * 1024 + 4 * lane + 256 * j) = pk4_fp8(vc[j][0], vc[j][1], vc[j][2], vc[j][3]); }
            } else { row_store_bf16(XN + (size_t)ta * 1024, lane, va); row_store_bf16(XN + (size_t)(ta + 1) * 1024, lane, vc); }
            if (NQ > 0) {
                float x[64];
#pragma unroll
                for (int q = 0; q < 32; ++q) {
                    if (q < NQ) { f32x4 a0 = {0.f, 0.f, 0.f, 0.f}, a1 = a0;
#pragma unroll
                        for (int j = 0; j < 4; ++j) { const f32x4 ww = *(const LAS f32x4*)(wt + q * 1024 + 4 * ((lane + 64 * j) ^ q)); a0 += va[j] * ww; a1 += vc[j] * ww; }
                        x[q] = (a0[0] + a0[1]) + (a0[2] + a0[3]); x[32 + q] = (a1[0] + a1[1]) + (a1[2] + a1[3]);
                        if ((q & 3) == 3) asm volatile("" ::: "memory");
                    } else { x[q] = 0.f; x[32 + q] = 0.f; }
                }
#define RS_STEP(N, BIT) _Pragma("unroll") for (int i = 0; i < (N); ++i) { const bool up = (lane & (BIT)) != 0; const float keep = up ? x[(N) + i] : x[i], send = up ? x[i] : x[(N) + i]; x[i] = keep + shxl(send, (BIT), lane); }
                RS_STEP(32, 32) RS_STEP(16, 16) RS_STEP(8, 8) RS_STEP(4, 4) RS_STEP(2, 2) RS_STEP(1, 1)
#undef RS_STEP
                const float val = x[0];
                if (MODE == 0) { if ((lane & 31) < 24) ((float*)(a->ws + WS_GATES))[(size_t)(ta + (lane >> 5)) * 24 + (lane & 31)] = sigm(val); }
                if (MODE == 2) {
                    const float myv = val + rbias; const int mye = lane & 31;
                    lgb[wv * 64 + lane] = myv;
                    asm volatile("s_waitcnt lgkmcnt(0)" ::: "memory");
                    int rank = 0;
#pragma unroll
                    for (int q4 = 0; q4 < 8; ++q4) { const f32x4 t4 = *(const LAS f32x4*)(lgb + wv * 64 + (lane & 32) + 4 * q4);
#pragma unroll
                        for (int e = 0; e < 4; ++e) { const int j = 4 * q4 + e; rank += ((t4[e] > myv) || (t4[e] == myv && j < mye)) ? 1 : 0; } }
                    const int eb = wv * 64 + (2 * it + (lane >> 5)) * 4;
                    if (rank < 4) { ent[eb + rank] = mye; gat[eb + rank] = myv; }
                    asm volatile("s_waitcnt lgkmcnt(0)" ::: "memory");
                    const f32x4 tv = *(const LAS f32x4*)(gat + eb);
                    const float sum = 1.0f + __expf(tv[1] - tv[0]) + __expf(tv[2] - tv[0]) + __expf(tv[3] - tv[0]);
                    asm volatile("s_waitcnt lgkmcnt(0)" ::: "memory");
                    if (rank < 4) gat[eb + rank] = __expf(myv - tv[0]) / sum;
                    asm volatile("s_waitcnt lgkmcnt(0)" ::: "memory");
                }
            }
        }
        if (MODE == 2) {
            __syncthreads();
            { const int e = ent[wv * 64 + lane];
              const int pos = __hip_atomic_fetch_add(bcl + e, 1, __ATOMIC_RELAXED, __HIP_MEMORY_SCOPE_WORKGROUP);
              const size_t idx = (size_t)(vb * 128 + wv * 16) * 4 + lane;
              ((int*)(a->ws + WS_TOPE))[idx] = e; ((int*)(a->ws + WS_POSB))[idx] = pos; ((float*)(a->ws + WS_GATEW))[idx] = gat[wv * 64 + lane]; }
            __syncthreads();
            if (tid < 32) ((int*)(a->ws + WS_BCNT))[((size_t)layer * NTB + vb) * 32 + tid] = bcl[tid];
            __syncthreads();
        }
    }
}
template <int MODE>
DI void phase_norm_mm(const int WID, ArgsP a, LAS unsigned char* lds, int layer, const void* Hin, const bool hb) {
    const int tid = opaque_tid(WID), lane = tid & 63, wv = __builtin_amdgcn_readfirstlane(tid >> 6);
    const int r = lane & 15, kg = lane >> 4;
    LAS float* lgb = (LAS float*)(lds + 131072);
    LAS float* gl = (LAS float*)(lds + MISC_OFF + MO_RED);
    LAS int* bcl = (LAS int*)(lds + MISC_OFF + MO_WCNT); LAS int* ent = (LAS int*)(lds + MISC_OFF + MO_ENT); LAS float* gat = (LAS float*)(lds + MISC_OFF + MO_GAT);
    bf16_t* XN = (bf16_t*)(a->ws + WS_XN);
    const float* gain = a->in[MODE == 2 ? I_N2G : I_N1G] + layer * 1024;
    constexpr int NQ = MODE == 0 ? 24 : 32;
    {
        const float* w = (MODE == 0) ? a->in[I_EVWIN] + (size_t)(layer >> 1) * 1024 * EVIN + 2816 : a->in[I_ROUTW] + (size_t)layer * 1024 * 32;
        const int ldw = (MODE == 0) ? EVIN : 32;
#pragma unroll 2
        for (int i = tid; i < 4096; i += 512) { const int q = i & 31, c = i >> 5; const int qq = q < NQ ? q : NQ - 1;
            const f32x4 g0 = *(const f32x4*)(gain + 8 * c), g1 = *(const f32x4*)(gain + 8 * c + 4);
            const float* wp = w + (size_t)(8 * c) * ldw + qq;
            f32x4 v0, v1;
#pragma unroll
            for (int e = 0; e < 4; ++e) { v0[e] = wp[(size_t)e * ldw]; v1[e] = wp[(size_t)(4 + e) * ldw]; }
            v0 = v0 * g0; v1 = v1 * g1;
            if (q >= NQ) { v0 = (f32x4){0.f, 0.f, 0.f, 0.f}; v1 = v0; }
            const u32x4 hi = pack8(v0, v1);
            const f32x4 r0 = {v0[0] - bflo(hi.x), v0[1] - bfhi(hi.x), v0[2] - bflo(hi.y), v0[3] - bfhi(hi.y)};
            const f32x4 r1 = {v1[0] - bflo(hi.z), v1[1] - bfhi(hi.z), v1[2] - bflo(hi.w), v1[3] - bfhi(hi.w)};
            const int off = q * 2048 + ((c ^ (q & 15)) << 4);
            *(LAS u32x4*)(lds + off) = hi; *(LAS u32x4*)(lds + 65536 + off) = pack8(r0, r1); }
        if (tid < 256) *(LAS f32x4*)(gl + 4 * tid) = *(const f32x4*)(gain + 4 * tid);
    }
    f32x4 rb0 = {0.f, 0.f, 0.f, 0.f}, rb1 = rb0;
    if (MODE == 2) { rb0 = *(const f32x4*)(a->in[I_ROUTB] + layer * 32 + 4 * kg); rb1 = *(const f32x4*)(a->in[I_ROUTB] + layer * 32 + 16 + 4 * kg); }
    __syncthreads();
    for (int vb = blockIdx.x; vb < NTB; vb += gridDim.x) {
        if (MODE == 2) { if (tid < 32) bcl[tid] = 0; }
        const int t0 = vb * 128 + wv * 16;
        u32x4 hp[16][2];
        if (hb) { const bf16_t* src = (const bf16_t*)Hin + (size_t)(t0 + r) * 1024 + 16 * kg;
#pragma unroll
            for (int S = 0; S < 16; ++S) { hp[S][0] = *(const u32x4*)(src + 64 * S); hp[S][1] = *(const u32x4*)(src + 64 * S + 8); }
        } else { const float* src = (const float*)Hin + (size_t)(t0 + r) * 1024 + 16 * kg;
#pragma unroll
            for (int S = 0; S < 16; ++S) { const f32x4 x0 = *(const f32x4*)(src + 64 * S), x1 = *(const f32x4*)(src + 64 * S + 4), x2 = *(const f32x4*)(src + 64 * S + 8), x3 = *(const f32x4*)(src + 64 * S + 12);
                hp[S][0] = pack8(x0, x1); hp[S][1] = pack8(x2, x3); }
        }
        f32x4 acc0 = {0.f, 0.f, 0.f, 0.f}, acc1 = acc0;
        float ss = 0.f;
        const int ob = r * 2048;
#pragma unroll
        for (int S = 0; S < 16; ++S) {
#pragma unroll
            for (int hf = 0; hf < 2; ++hf) {
                const u32x4 hv = hp[S][hf];
#pragma unroll
                for (int e = 0; e < 4; ++e) { const float lo = bflo(hv[e]), hi = bfhi(hv[e]); ss = fmaf(lo, lo, ss); ss = fmaf(hi, hi, ss); }
                const bf16x8 hf8 = __builtin_bit_cast(bf16x8, hv);
                const int off = ob + (S >> 1) * 256 + ((((S & 1) * 8 + 2 * kg + hf) ^ r) << 4);
                acc0 = __builtin_amdgcn_mfma_f32_16x16x32_bf16(*(const LAS bf16x8*)(lds + off), hf8, acc0, 0, 0, 0);
                acc0 = __builtin_amdgcn_mfma_f32_16x16x32_bf16(*(const LAS bf16x8*)(lds + 65536 + off), hf8, acc0, 0, 0, 0);
                acc1 = __builtin_amdgcn_mfma_f32_16x16x32_bf16(*(const LAS bf16x8*)(lds + 32768 + off), hf8, acc1, 0, 0, 0);
                acc1 = __builtin_amdgcn_mfma_f32_16x16x32_bf16(*(const LAS bf16x8*)(lds + 98304 + off), hf8, acc1, 0, 0, 0);
            }
            asm volatile("" ::: "memory");
        }
        ss += shxl(ss, 16, lane); ss += shxl(ss, 32, lane);
        const float rs = rsqrtf(ss * (1.0f / 1024.0f) + EPS);
        { bf16_t* dst = XN + (size_t)(t0 + r) * 1024 + 16 * kg;
#pragma unroll
          for (int S = 0; S < 16; ++S) {
#pragma unroll
              for (int hf = 0; hf < 2; ++hf) { u32x4 hv = hp[S][hf];
                  asm volatile("" : "+v"(hv));
                  const f32x4 g0 = *(const LAS f32x4*)(gl + 64 * S + 16 * kg + 8 * hf), g1 = *(const LAS f32x4*)(gl + 64 * S + 16 * kg + 8 * hf + 4);
                  const f32x4 x0 = (f32x4){bflo(hv.x), bfhi(hv.x), bflo(hv.y), bfhi(hv.y)} * rs * g0, x1 = (f32x4){bflo(hv.z), bfhi(hv.z), bflo(hv.w), bfhi(hv.w)} * rs * g1;
                  *(u32x4*)(dst + 64 * S + 8 * hf) = pack8(x0, x1); }
              asm volatile("" ::: "memory"); } }
        const f32x4 v0 = acc0 * rs + rb0, v1 = acc1 * rs + rb1;
        if (MODE == 0) { float* G = (float*)(a->ws + WS_GATES) + (size_t)(t0 + r) * 24;
            *(f32x4*)(G + 4 * kg) = (f32x4){sigm(v0[0]), sigm(v0[1]), sigm(v0[2]), sigm(v0[3])};
            if (kg < 2) *(f32x4*)(G + 16 + 4 * kg) = (f32x4){sigm(v1[0]), sigm(v1[1]), sigm(v1[2]), sigm(v1[3])}; }
        if (MODE == 2) {
#pragma unroll 1
            for (int h = 0; h < 2; ++h) {
                if ((r >> 3) == h) { *(LAS f32x4*)(lgb + wv * 256 + (r & 7) * 32 + 4 * kg) = v0; *(LAS f32x4*)(lgb + wv * 256 + (r & 7) * 32 + 16 + 4 * kg) = v1; }
                asm volatile("s_waitcnt lgkmcnt(0)" ::: "memory");
#pragma unroll 1
                for (int it = 4 * h; it < 4 * h + 4; ++it) {
                    const int mye = lane & 31;
                    const LAS float* lrow = lgb + wv * 256 + ((2 * it + (lane >> 5)) & 7) * 32;
                    const float myv = lrow[mye];
                    int rank = 0;
#pragma unroll
                    for (int q4 = 0; q4 < 8; ++q4) { const f32x4 t4 = *(const LAS f32x4*)(lrow + 4 * q4);
#pragma unroll
                        for (int e = 0; e < 4; ++e) { const int j = 4 * q4 + e; rank += ((t4[e] > myv) || (t4[e] == myv && j < mye)) ? 1 : 0; } }
                    const int eb = wv * 64 + (2 * it + (lane >> 5)) * 4;
                    if (rank < 4) { ent[eb + rank] = mye; gat[eb + rank] = myv; }
                    asm volatile("s_waitcnt lgkmcnt(0)" ::: "memory");
                    const f32x4 tv = *(const LAS f32x4*)(gat + eb);
                    const float sum = 1.0f + __expf(tv[1] - tv[0]) + __expf(tv[2] - tv[0]) + __expf(tv[3] - tv[0]);
                    asm volatile("s_waitcnt lgkmcnt(0)" ::: "memory");
                    if (rank < 4) gat[eb + rank] = __expf(myv - tv[0]) / sum;
                    asm volatile("s_waitcnt lgkmcnt(0)" ::: "memory");
                }
            }
            __syncthreads();
            { const int e = ent[wv * 64 + lane];
              const int pos = __hip_atomic_fetch_add(bcl + e, 1, __ATOMIC_RELAXED, __HIP_MEMORY_SCOPE_WORKGROUP);
              const size_t idx = (size_t)(vb * 128 + wv * 16) * 4 + lane;
              ((int*)(a->ws + WS_TOPE))[idx] = e; ((int*)(a->ws + WS_POSB))[idx] = pos; ((float*)(a->ws + WS_GATEW))[idx] = gat[wv * 64 + lane]; }
            __syncthreads();
            if (tid < 32) ((int*)(a->ws + WS_BCNT))[((size_t)layer * NTB + vb) * 32 + tid] = bcl[tid];
            __syncthreads();
        }
    }
}
DI void moe_tables(const int WID, ArgsP a, LAS unsigned char* lds, int layer, int vb) {
    const int tid = opaque_tid(WID);
    LAS int* tot = (LAS int*)(lds + MISC_OFF + MO_TOT); LAS int* base = (LAS int*)(lds + MISC_OFF + MO_BASE); LAS int* ts = (LAS int*)(lds + MISC_OFF + MO_TS);
    LAS int* red = (LAS int*)(lds + MISC_OFF + MO_RED);
    const int* bc = (const int*)(a->ws + WS_BCNT) + (size_t)layer * NTB * 32;
    { const int e = tid & 31, part = tid >> 5; int st = 0, sp = 0;
      for (int blk = part; blk < NTB; blk += 16) { const int v = bc[blk * 32 + e]; st += v; sp += (blk < vb) ? v : 0; }
      red[part * 32 + e] = st; red[512 + part * 32 + e] = sp; }
    __syncthreads();
    if (tid < 32) { int st = 0, sp = 0;
#pragma unroll
        for (int p = 0; p < 16; ++p) { st += red[p * 32 + tid]; sp += red[512 + p * 32 + tid]; }
        tot[tid] = st; base[tid] = sp; }
    __syncthreads();
    if (tid == 0) { int acc = 0; for (int e = 0; e < 32; ++e) { ts[e] = acc; acc += (tot[e] + 255) >> 8; } ts[32] = acc; }
    __syncthreads();
}
DI void phase_moe_slots(const int WID, ArgsP a, LAS unsigned char* lds, int layer) {
    const int tid = opaque_tid(WID), lane = tid & 63, wv = tid >> 6;
    LAS int* base = (LAS int*)(lds + MISC_OFF + MO_BASE); LAS int* ts = (LAS int*)(lds + MISC_OFF + MO_TS);
    const bf16_t* XN = (const bf16_t*)(a->ws + WS_XN); unsigned char* XB = (unsigned char*)(a->ws + WS_XB);
    for (int vb = blockIdx.x; vb < NTB; vb += gridDim.x) {
        moe_tables(WID, a, lds, layer, vb);
#pragma unroll 1
        for (int i = 0; i < 16; ++i) {
            const int t = vb * 128 + wv * 16 + i;
            int dest = 0;
            if (lane < 4) { const int e = ((const int*)(a->ws + WS_TOPE))[(size_t)t * 4 + lane], pos = ((const int*)(a->ws + WS_POSB))[(size_t)t * 4 + lane];
                dest = ts[e] * 256 + base[e] + pos; ((int*)(a->ws + WS_DEST))[(size_t)t * 4 + lane] = dest; }
            const u32x4 r0 = *(const u32x4*)(XN + (size_t)t * 1024 + 8 * lane), r1 = *(const u32x4*)(XN + (size_t)t * 1024 + 512 + 8 * lane);
            u32x2 q0, q1;
            q0.x = pk4_fp8(bflo(r0.x), bfhi(r0.x), bflo(r0.y), bfhi(r0.y)); q0.y = pk4_fp8(bflo(r0.z), bfhi(r0.z), bflo(r0.w), bfhi(r0.w));
            q1.x = pk4_fp8(bflo(r1.x), bfhi(r1.x), bflo(r1.y), bfhi(r1.y)); q1.y = pk4_fp8(bflo(r1.z), bfhi(r1.z), bflo(r1.w), bfhi(r1.w));
#pragma unroll
            for (int k = 0; k < 4; ++k) { const int d = __builtin_amdgcn_readlane(dest, k); unsigned char* o = XB + (size_t)d * 1024; *(u32x2*)(o + 8 * lane) = q0; *(u32x2*)(o + 512 + 8 * lane) = q1; }
        }
        __syncthreads();
    }
}
DI void phase_combine(const int WID, ArgsP a, bf16_t* H) {
    const int tid = opaque_tid(WID), lane = tid & 63, wv = tid >> 6;
    const bf16_t* YB = (const bf16_t*)(a->ws + WS_YB); unsigned char* XN8 = (unsigned char*)(a->ws + WS_XN);
    const int G8 = gridDim.x * 8;
    const int* DEST = (const int*)(a->ws + WS_DEST); const float* GW = (const float*)(a->ws + WS_GATEW);
    int t = blockIdx.x * 8 + wv;
    int dA = 0, dB = 0; float gA = 0.f, gB = 0.f;
    if (lane < 4) { if (t < T) { dA = DEST[(size_t)t * 4 + lane]; gA = GW[(size_t)t * 4 + lane]; } if (t + G8 < T) { dB = DEST[(size_t)(t + G8) * 4 + lane]; gB = GW[(size_t)(t + G8) * 4 + lane]; } }
    for (; t < T; t += 2 * G8) {
        const int tA = t, tB = (t + G8 < T) ? t + G8 : t;
        const int cdA = dA, cdB = (t + G8 < T) ? dB : dA; const float cgA = gA, cgB = (t + G8 < T) ? gB : gA;
        u32x2 hA[4], hB[4], yA[4][4], yB[4][4];
#pragma unroll
        for (int j = 0; j < 4; ++j) { hA[j] = *(const u32x2*)(H + (size_t)tA * 1024 + 4 * lane + 256 * j); hB[j] = *(const u32x2*)(H + (size_t)tB * 1024 + 4 * lane + 256 * j); }
#pragma unroll
        for (int k = 0; k < 4; ++k) { const bf16_t* y = YB + (size_t)__builtin_amdgcn_readlane(cdA, k) * 1024 + 4 * lane;
#pragma unroll
            for (int j = 0; j < 4; ++j) yA[k][j] = *(const u32x2*)(y + 256 * j); }
#pragma unroll
        for (int k = 0; k < 4; ++k) { const bf16_t* y = YB + (size_t)__builtin_amdgcn_readlane(cdB, k) * 1024 + 4 * lane;
#pragma unroll
            for (int j = 0; j < 4; ++j) yB[k][j] = *(const u32x2*)(y + 256 * j); }
        { const int tn = t + 2 * G8;
          if (lane < 4) { if (tn < T) { dA = DEST[(size_t)tn * 4 + lane]; gA = GW[(size_t)tn * 4 + lane]; } if (tn + G8 < T) { dB = DEST[(size_t)(tn + G8) * 4 + lane]; gB = GW[(size_t)(tn + G8) * 4 + lane]; } } }
        asm volatile("" ::: "memory");
#pragma unroll
        for (int rr = 0; rr < 2; ++rr) {
            const int tt = rr ? tB : tA; const float cg = rr ? cgB : cgA;
            f32x4 v[4];
#pragma unroll
            for (int j = 0; j < 4; ++j) { const u32x2 w = rr ? hB[j] : hA[j]; v[j] = (f32x4){bflo(w.x), bfhi(w.x), bflo(w.y), bfhi(w.y)}; }
#pragma unroll
            for (int k = 0; k < 4; ++k) { const float g = __builtin_bit_cast(float, __builtin_amdgcn_readlane(__builtin_bit_cast(int, cg), k));
#pragma unroll
                for (int j = 0; j < 4; ++j) { const u32x2 w = rr ? yB[k][j] : yA[k][j]; v[j][0] += g * bflo(w.x); v[j][1] += g * bfhi(w.x); v[j][2] += g * bflo(w.y); v[j][3] += g * bfhi(w.y); } }
            float ss = 0.f;
#pragma unroll
            for (int j = 0; j < 4; ++j) { u32x2 hw; hw.x = pk2(v[j][0], v[j][1]); hw.y = pk2(v[j][2], v[j][3]); *(u32x2*)(H + (size_t)tt * 1024 + 4 * lane + 256 * j) = hw; ss += (v[j][0] * v[j][0] + v[j][1] * v[j][1]) + (v[j][2] * v[j][2] + v[j][3] * v[j][3]); }
#pragma unroll
            for (int o = 1; o < 64; o <<= 1) ss += shxl(ss, o, lane);
            const float rstd = rsqrtf(ss * (1.0f / 1024.0f) + EPS);
#pragma unroll
            for (int j = 0; j < 4; ++j) v[j] = v[j] * rstd;
#pragma unroll
            for (int j = 0; j < 4; ++j) *(unsigned*)(XN8 + (size_t)tt * 1024 + 4 * lane + 256 * j) = pk4_fp8(v[j][0], v[j][1], v[j][2], v[j][3]);
        }
    }
}
DI void phase_cmp2(const int WID, ArgsP a, LAS unsigned char* lds, int ev) {
    const int tid = opaque_tid(WID), lane = tid & 63, wv = __builtin_amdgcn_readfirstlane(tid >> 6);
    const bf16_t* HID = (const bf16_t*)(a->ws + WS_HID); bf16_t* KCMP = (bf16_t*)(a->ws + WS_KCMP); bf16_t* VCMPT = (bf16_t*)(a->ws + WS_VCMPT);
    const float kg = a->in[I_NSKN][ev * 64 + lane];
    LAS float* wl = (LAS float*)lds;
    for (int i = tid; i < 2 * 256 * 64 / 4; i += 512) *(LAS f32x4*)(wl + 4 * i) = *(const f32x4*)(a->in[I_CMPW2] + (size_t)ev * 2 * 256 * 64 + 4 * i);
    __syncthreads();
    for (int gi = blockIdx.x * 8 + wv; gi < 2048; gi += gridDim.x * 8) {
        const int kv = gi >> 10, row0 = (gi & 1023) * 4;
        const bf16_t* hrow = HID + ((size_t)kv * 4096 + row0) * 256;
        const LAS float* w2 = wl + kv * 256 * 64 + lane;
        float s[4] = {0.f, 0.f, 0.f, 0.f};
#pragma unroll 2
        for (int k = 0; k < 256; k += 8) {
            u32x4 hw[4];
#pragma unroll
            for (int r = 0; r < 4; ++r) hw[r] = *(const u32x4*)(hrow + r * 256 + k);
            float wv8[8];
#pragma unroll
            for (int j = 0; j < 8; ++j) wv8[j] = w2[(k + j) * 64];
#pragma unroll
            for (int r = 0; r < 4; ++r)
                s[r] += bflo(hw[r].x) * wv8[0] + bfhi(hw[r].x) * wv8[1] + bflo(hw[r].y) * wv8[2] + bfhi(hw[r].y) * wv8[3] + bflo(hw[r].z) * wv8[4] + bfhi(hw[r].z) * wv8[5] + bflo(hw[r].w) * wv8[6] + bfhi(hw[r].w) * wv8[7];
        }
#pragma unroll
        for (int r = 0; r < 4; ++r) {
            const int row = row0 + r, bg = row >> 7, n = row & 127;
            float v = (n == 127) ? 0.f : s[r];
            if (kv == 0) { const float ss = wave_sum(v * v); const float o = v * rsqrtf(ss * (1.0f / 64.0f) + EPS) * kg;
                KCMP[((size_t)bg * 128 + n) * 64 + lane] = (bf16_t)(pk2(o, 0.f) & 0xffffu); }
            else VCMPT[((size_t)bg * 96 + lane) * 128 + vperm16(n)] = (bf16_t)(pk2(v, 0.f) & 0xffffu);
        }
    }
    for (int i = blockIdx.x * 512 + tid; i < 32 * 32 * 128; i += gridDim.x * 512) {
        const int n = i & 127, j = (i >> 7) & 31, bg = i >> 12;
        float o = 0.f;
        if (n < 127) { const int d = n - 4 * j; if (d >= 0 && d <= 2) o = 1.0f; else if (d == 3 || d == -1) o = 0.5f; }
        VCMPT[((size_t)bg * 96 + 64 + j) * 128 + vperm16(n)] = (bf16_t)(pk2(o, 0.f) & 0xffffu);
    }
}
DI void topk_one(const float* IMPH, unsigned* SELM, int t, int g) {
    const int b = t >> 11, s = t & 2047, cur = s >> 6;
    unsigned mask;
    if (cur < 16) mask = (2u << cur) - 1u;
    else {
        float sc[32];
#pragma unroll
        for (int j4 = 0; j4 < 8; ++j4) { f32x4 acc = {0.f, 0.f, 0.f, 0.f};
#pragma unroll
            for (int r = 0; r < 4; ++r) acc += *(const f32x4*)(IMPH + ((size_t)t * 8 + g * 4 + r) * 32 + 4 * j4);
#pragma unroll
            for (int q = 0; q < 4; ++q) sc[4 * j4 + q] = acc[q]; }
#pragma unroll
        for (int j = 0; j < 32; ++j) { const bool forced = (j == 0) || (j == cur) || (j == cur - 1); sc[j] = (j > cur) ? NEGF : (sc[j] + (forced ? 1e4f : 0.f)); }
        mask = 0u;
#pragma unroll
        for (int j = 0; j < 32; ++j) { int rank = 0;
#pragma unroll
            for (int k = 0; k < 32; ++k) rank += ((sc[k] > sc[j]) || (sc[k] == sc[j] && k < j)) ? 1 : 0;
            mask |= (rank < 16) ? (1u << j) : 0u; }
    }
    SELM[((size_t)(b * 2 + g)) * 2048 + s] = mask;
}
DI void phase_topk(const int WID, ArgsP a) {
    for (int i = blockIdx.x * 512 + opaque_tid(WID); i < T * 2; i += gridDim.x * 512) topk_one((const float*)(a->ws + WS_IMPH), (unsigned*)(a->ws + WS_SELM), i >> 1, i & 1);
}
DI void phase_cmp_topk(const int WID, ArgsP a, LAS unsigned char* lds) {
    const bf16_t* QN = (const bf16_t*)(a->ws + WS_QN);
    float* IMPH = (float*)(a->ws + WS_IMPH);
    for (int u = blockIdx.x; u < 256; u += gridDim.x) {
        const int qb = 7 - (u >> 5), bg = u & 31, b = bg >> 1, g = bg & 1, q0 = qb * 256; const size_t t0 = (size_t)b * 2048 + q0;
#pragma unroll 1
        for (int r = 0; r < 4; ++r) { const int hd = g * 4 + r;
            attn_unit<96, 3>(WID, lds, QN + t0 * 512 + hd * 64, 512, (const bf16_t*)(a->ws + WS_KCMP) + (size_t)bg * 128 * 64, 64,
                             (const bf16_t*)(a->ws + WS_VCMPT) + (size_t)bg * 96 * 128, 128, q0, 0.f, 0, nullptr,
                             (bf16_t*)(a->ws + WS_OC) + t0 * 512 + hd * 64, 512, IMPH + (t0 * 8 + hd) * 32); }
        asm volatile("s_waitcnt vmcnt(0)" ::: "memory");
        __syncthreads();
        { const int tid = opaque_tid(WID); if (tid < 256) topk_one(IMPH, (unsigned*)(a->ws + WS_SELM), (int)t0 + tid, g); }
        __syncthreads();
    }
}
DI void phase_mixprep(const int WID, ArgsP a, int layer) {
    const int tid = opaque_tid(WID), lane = tid & 63, wv = tid >> 6, ev = layer >> 1;
    const float* dl = a->in[I_DALAM] + ev * 256;
    const float s1 = wave_sum(dl[lane] * dl[64 + lane]), s2 = wave_sum(dl[128 + lane] * dl[192 + lane]);
    const float lam_init = 0.8f - 0.6f * expf(-0.3f * (float)layer);
    const float lam = expf(s1) - expf(s2) + lam_init;
    const float* og = a->in[I_DAOUTG] + ev * 128;
    const bf16_t* OD = (const bf16_t*)(a->ws + WS_OD); const bf16_t* OC = (const bf16_t*)(a->ws + WS_OC); const bf16_t* OS = (const bf16_t*)(a->ws + WS_OS); const bf16_t* OW = (const bf16_t*)(a->ws + WS_OW);
    const float* GT = (const float*)(a->ws + WS_GATES); unsigned char* AMIX = (unsigned char*)(a->ws + WS_AMIX);
    const int h = lane >> 4, dv = (lane & 15) * 8;
    f32x4 g0 = *(const f32x4*)(og + dv), g1 = *(const f32x4*)(og + dv + 4);
    for (int t = blockIdx.x * 8 + wv; t < T; t += gridDim.x * 8) {
        { const u32x4 w1 = *(const u32x4*)(OD + (size_t)t * 1024 + h * 128 + dv), w2 = *(const u32x4*)(OD + (size_t)t * 1024 + (4 + h) * 128 + dv);
          f32x4 d0, d1;
          d0[0] = bflo(w1.x) - lam * bflo(w2.x); d0[1] = bfhi(w1.x) - lam * bfhi(w2.x); d0[2] = bflo(w1.y) - lam * bflo(w2.y); d0[3] = bfhi(w1.y) - lam * bfhi(w2.y);
          d1[0] = bflo(w1.z) - lam * bflo(w2.z); d1[1] = bfhi(w1.z) - lam * bfhi(w2.z); d1[2] = bflo(w1.w) - lam * bflo(w2.w); d1[3] = bfhi(w1.w) - lam * bfhi(w2.w);
          float ss = (d0[0] * d0[0] + d0[1] * d0[1]) + (d0[2] * d0[2] + d0[3] * d0[3]) + (d1[0] * d1[0] + d1[1] * d1[1]) + (d1[2] * d1[2] + d1[3] * d1[3]);
          ss += shx(ss, 1); ss += shx(ss, 2); ss += shx(ss, 4); ss += shx(ss, 8);
          const float rs = rsqrtf(ss * (1.0f / 128.0f) + EPS) * (1.0f - lam_init);
          *(u32x2*)(AMIX + (size_t)t * 1024 + h * 128 + dv) = pack8_fp8(d0 * (rs * A_SC) * g0, d1 * (rs * A_SC) * g1); }
    }
}
DI void phase_scan(const int WID, ArgsP a) {
    const bf16_t* UT = (const bf16_t*)(a->ws + WS_UT); bf16_t* VS = (bf16_t*)(a->ws + WS_VS);
    for (int i = blockIdx.x * 512 + opaque_tid(WID); i < 64 * 512 * 32; i += gridDim.x * 512) {
        const int d8 = i & 31, f = (i >> 5) & 511, bh = i >> 14, h = bh & 3;
        const float dec = exp2f(256.0f * ret_lg2(h));
        f32x4 S0 = {0.f, 0.f, 0.f, 0.f}, S1 = S0;
        u32x4 un = *(const u32x4*)(UT + ((size_t)bh * 8) * 131072 + (size_t)f * 256 + 8 * d8);
#pragma unroll 1
        for (int n = 0; n < 8; ++n) {
            const size_t z = (size_t)bh * 8 + n;
            const u32x4 u = un;
            if (n < 7) un = *(const u32x4*)(UT + (z + 1) * 131072 + (size_t)f * 256 + 8 * d8);
            *(u32x4*)(VS + (z * 512 + f) * 512 + 256 + 8 * d8) = pack8(S0, S1);
            S0[0] = (S0[0] + bflo(u.x)) * dec; S0[1] = (S0[1] + bfhi(u.x)) * dec; S0[2] = (S0[2] + bflo(u.y)) * dec; S0[3] = (S0[3] + bfhi(u.y)) * dec;
            S1[0] = (S1[0] + bflo(u.z)) * dec; S1[1] = (S1[1] + bfhi(u.z)) * dec; S1[2] = (S1[2] + bflo(u.w)) * dec; S1[3] = (S1[3] + bfhi(u.w)) * dec;
        }
    }
}
DI void phase_normgate(const int WID, ArgsP a, int od) {
    const int tid = opaque_tid(WID), lane = tid & 63, wv = tid >> 6;
    const bf16_t* Y = (const bf16_t*)(a->ws + WS_Y); const bf16_t* GG = (const bf16_t*)(a->ws + WS_GG); unsigned char* YG = (unsigned char*)(a->ws + WS_YG);
    const float* og = a->in[I_RETG] + od * 512;
    const f32x4 g0 = *(const f32x4*)(og + 8 * lane), g1 = *(const f32x4*)(og + 8 * lane + 4);
    for (int t = blockIdx.x * 8 + wv; t < T; t += gridDim.x * 8) {
#pragma unroll
        for (int h = 0; h < 4; ++h) {
            const size_t o = (size_t)t * 2048 + h * 512 + 8 * lane;
            const u32x4 yw = *(const u32x4*)(Y + o), gw = *(const u32x4*)(GG + o);
            f32x4 y0 = {bflo(yw.x), bfhi(yw.x), bflo(yw.y), bfhi(yw.y)}, y1 = {bflo(yw.z), bfhi(yw.z), bflo(yw.w), bfhi(yw.w)};
            const f32x4 q0 = {bflo(gw.x), bfhi(gw.x), bflo(gw.y), bfhi(gw.y)}, q1 = {bflo(gw.z), bfhi(gw.z), bflo(gw.w), bfhi(gw.w)};
            float ss = (y0[0] * y0[0] + y0[1] * y0[1]) + (y0[2] * y0[2] + y0[3] * y0[3]) + (y1[0] * y1[0] + y1[1] * y1[1]) + (y1[2] * y1[2] + y1[3] * y1[3]);
            ss = wave_sum(ss);
            const float rs = rsqrtf(ss * (1.0f / 512.0f) + EPS);
            *(u32x2*)(YG + o) = pack8_fp8(y0 * (rs * A_SC) * g0 * q0, y1 * (rs * A_SC) * g1 * q1);
        }
    }
}
DI int snake_unit(int rnd, int G, int c) { return (rnd & 1) ? rnd * G + (G - 1 - c) : rnd * G + c; }
DI float absmax64(const float* g, int lane) { float m = fabsf(g[lane]);
#pragma unroll
    for (int o = 1; o < 64; o <<= 1) m = fmaxf(m, shx(m, o));
    return m; }
constexpr int CW_AQ = 8192;
template <int MODE>
DI void phase_attn(const int WID, ArgsP a, LAS unsigned char* lds, int ev) {
    const int tid = opaque_tid(WID), lane = tid & 63;
    const bf16_t* QD = (const bf16_t*)(a->ws + WS_QD); const bf16_t* KD = (const bf16_t*)(a->ws + WS_KD); const bf16_t* QN = (const bf16_t*)(a->ws + WS_QN);
    LAS int* ord = (LAS int*)(lds + MISC_OFF + MO_ENT); LAS int* cst = (LAS int*)(lds + MISC_OFF + MO_GAT); volatile LAS int* cur = (volatile LAS int*)(lds + MISC_OFF + MO_TOT);
    float sb2 = 0.f;
    if (MODE != 3) { const float gq = absmax64(a->in[MODE == 0 ? I_DAQN : I_NSQN] + ev * 64, lane), gk = absmax64(a->in[MODE == 0 ? I_DAKN : I_NSKN] + ev * 64, lane);
        sb2 = 16.0f * gq * gk + 28.0f; }
    if (tid < 64) { const int qb = tid >> 3, hd = tid & 7, q0 = qb * 256; int lo = 0, hi = 4 * qb + 4;
        if (MODE == 3) { lo = 0; hi = 2; }
        else { const float slope = (MODE == 0) ? exp2f(-2.0f * (float)((hd & 3) + 1)) : exp2f(-(float)(hd + 1)); const int dcut = (int)fminf(sb2 / slope + 1.0f, 100000.0f);
            const int kmin = q0 - dcut; lo = kmin > 0 ? (kmin >> 6) : 0;
            if (MODE == 2) { const int lk = q0 - 511; const int lw = lk > 0 ? (lk >> 6) : 0; lo = lw > lo ? lw : lo; } }
        cst[tid] = hi - lo; }
    __syncthreads();
    if (tid < 64) { const int mine = cst[tid]; int rank = 0;
        for (int j = 0; j < 64; ++j) { const int o = cst[j]; rank += (o > mine || (o == mine && j < tid)) ? 1 : 0; }
        ord[rank] = tid; }
    __syncthreads();
    unsigned* ctr = (unsigned*)(a->ws + WS_CTL) + CW_AQ + 64 * 8 * (ev * 4 + MODE);
    const int x0 = (int)(xb_xcc_id() & 7u);
    volatile LAS int* stl = (volatile LAS int*)(lds + MISC_OFF + MO_BASE);
    bool own = true; int nst = 0;
    for (;;) {
        if (tid < 64) {
            int uu_ = -1;
            if (own) { int v = 128; if (lane == 0) v = (int)__hip_atomic_fetch_add(ctr + 64 * x0, 1u, __ATOMIC_RELAXED, __HIP_MEMORY_SCOPE_AGENT);
                v = __builtin_amdgcn_readfirstlane(v); if (v < 128) uu_ = x0 * 128 + v; else own = false; }
            if (!own && uu_ < 0) {
                if (nst == 0) { int v = 128; const int xq_ = (x0 + lane) & 7;
                    if (lane >= 1 && lane < 8) v = (int)__hip_atomic_fetch_add(ctr + 64 * xq_, 1u, __ATOMIC_RELAXED, __HIP_MEMORY_SCOPE_AGENT);
                    const unsigned long long got = __ballot(v < 128); nst = __popcll(got);
                    if (v < 128) stl[__popcll(got & ((1ull << lane) - 1ull))] = xq_ * 128 + v;
                    asm volatile("s_waitcnt lgkmcnt(0)" ::: "memory"); }
                if (nst > 0) { --nst; uu_ = stl[nst]; }
            }
            if (lane == 0) *cur = uu_;
        }
        __syncthreads();
        const int uu = *cur; if (uu < 0) break;
        const int xq = uu >> 7, v = uu & 127, combo = ord[v >> 1], jb = v & 1, qb = combo >> 3, hd = combo & 7, q0 = qb * 256;
        const int b = (MODE == 0) ? (((xq - 2 * (hd & 3)) & 7) + 8 * jb) : (((xq - 4 * (hd >> 2)) & 7) + 8 * jb);
        const size_t t0 = (size_t)b * 2048 + q0;
        if (MODE == 0) {
            const float slope = exp2f(-2.0f * (float)((hd & 3) + 1)); const int dcut = (int)fminf(sb2 / slope + 1.0f, 100000.0f);
            attn_unit<128, 0>(WID, lds, QD + t0 * 512 + hd * 64, 512, KD + (size_t)b * 2048 * 512 + hd * 64, 512,
                              (const bf16_t*)(a->ws + WS_VAT) + (size_t)(b * 4 + (hd & 3)) * 128 * 2048, 2048, q0, slope, dcut, nullptr,
                              (bf16_t*)(a->ws + WS_OD) + t0 * 1024 + hd * 128, 1024, nullptr);
        } else if (MODE == 1 || MODE == 2) {
            const int g = hd >> 2; const float slope = exp2f(-(float)(hd + 1)); const int dcut = (int)fminf(sb2 / slope + 1.0f, 100000.0f);
            const bf16_t* Kb = (const bf16_t*)(a->ws + (MODE == 1 ? WS_KSB : WS_KWB)) + (size_t)(b * 2 + g) * 2048 * 64;
            const bf16_t* Vb = (const bf16_t*)(a->ws + (MODE == 1 ? WS_VST : WS_VWT)) + (size_t)(b * 2 + g) * 64 * 2048;
            attn_unit<64, MODE>(WID, lds, QN + t0 * 512 + hd * 64, 512, Kb, 64, Vb, 2048, q0, slope, dcut,
                                (const unsigned*)(a->ws + WS_SELM) + (size_t)(b * 2 + g) * 2048 + q0,
                                (bf16_t*)(a->ws + (MODE == 1 ? WS_OS : WS_OW)) + t0 * 512 + hd * 64, 512, nullptr);
        } else {
            const int g = hd >> 2;
            attn_unit<96, 3>(WID, lds, QN + t0 * 512 + hd * 64, 512, (const bf16_t*)(a->ws + WS_KCMP) + (size_t)(b * 2 + g) * 128 * 64, 64,
                             (const bf16_t*)(a->ws + WS_VCMPT) + (size_t)(b * 2 + g) * 96 * 128, 128, q0, 0.f, 0, nullptr,
                             (bf16_t*)(a->ws + WS_OC) + t0 * 512 + hd * 64, 512, (float*)(a->ws + WS_IMPH) + (t0 * 8 + hd) * 32);
        }
    }
}

DI void phase_diff(const int WID, ArgsP a, LAS unsigned char* lds, int layer) {
    const int tid = opaque_tid(WID), lane = tid & 63, ev = layer >> 1;
    LAS int* ord = (LAS int*)(lds + MISC_OFF + MO_ENT); LAS int* cst = (LAS int*)(lds + MISC_OFF + MO_GAT); volatile LAS int* cur = (volatile LAS int*)(lds + MISC_OFF + MO_TOT);
    const float gq = absmax64(a->in[I_DAQN] + ev * 64, lane), gk = absmax64(a->in[I_DAKN] + ev * 64, lane);
    const float sb2 = 16.0f * gq * gk + 28.0f;
    const float* dl = a->in[I_DALAM] + ev * 256;
    const float s1 = wave_sum(dl[lane] * dl[64 + lane]), s2 = wave_sum(dl[128 + lane] * dl[192 + lane]);
    const float lam_init = 0.8f - 0.6f * expf(-0.3f * (float)layer);
    const float lam = expf(s1) - expf(s2) + lam_init;
    if (tid < 32) { const int qb = tid >> 2, h = tid & 3, q0 = qb * 256; const float slope = exp2f(-2.0f * (float)(h + 1)); const int dcut = (int)fminf(sb2 / slope + 1.0f, 100000.0f);
        const int kmin = q0 - dcut; const int lo = kmin > 0 ? (kmin >> 6) : 0; cst[tid] = 4 * qb + 4 - lo; }
    __syncthreads();
    if (tid < 32) { const int mine = cst[tid]; int rank = 0;
        for (int j = 0; j < 32; ++j) { const int o = cst[j]; rank += (o > mine || (o == mine && j < tid)) ? 1 : 0; }
        ord[rank] = tid; }
    __syncthreads();
    unsigned* ctr = (unsigned*)(a->ws + WS_CTL) + CW_AQ + 64 * 8 * (ev * 4 + 0);
    const bf16_t* QD = (const bf16_t*)(a->ws + WS_QD); const bf16_t* KD = (const bf16_t*)(a->ws + WS_KD);
    for (;;) {
        if (tid == 0) *cur = (int)__hip_atomic_fetch_add(ctr, 1u, __ATOMIC_RELAXED, __HIP_MEMORY_SCOPE_AGENT);
        __syncthreads();
        const int u = *cur; if (u >= 512) break;
        const int combo = ord[u >> 4], b = u & 15, qb = combo >> 2, h = combo & 3, q0 = qb * 256; const size_t t0 = (size_t)b * 2048 + q0;
        const float slope = exp2f(-2.0f * (float)(h + 1)); const int dcut = (int)fminf(sb2 / slope + 1.0f, 100000.0f);
        diff_unit(WID, lds, QD + t0 * 512 + h * 64, QD + t0 * 512 + (4 + h) * 64, KD + (size_t)b * 2048 * 512 + h * 64, KD + (size_t)b * 2048 * 512 + (4 + h) * 64,
                  (const bf16_t*)(a->ws + WS_VAT) + (size_t)(b * 4 + h) * 128 * 2048, q0, slope, dcut, lam, 1.0f - lam_init, a->in[I_DAOUTG] + ev * 128,
                  (unsigned char*)(a->ws + WS_AMIX) + t0 * 1024 + h * 128);
    }
}
DI void phase_nsa(const int WID, ArgsP a, LAS unsigned char* lds, int ev) {
    const int tid = opaque_tid(WID), lane = tid & 63, w = __builtin_amdgcn_readfirstlane(tid >> 6), r = lane & 31, hh = lane >> 5, hr = w >> 1, qh = w & 1;
    volatile LAS int* cur = (volatile LAS int*)(lds + MISC_OFF + MO_TOT);
    LAS float* impl = (LAS float*)(lds + 98304);
    LAS float* scs = (LAS float*)(lds + 131072);
    LAS unsigned* selml = (LAS unsigned*)(lds + MISC_OFF + MO_RED);
    const float gq = absmax64(a->in[I_NSQN] + ev * 64, lane), gk = absmax64(a->in[I_NSKN] + ev * 64, lane);
    const float sb2 = 16.0f * gq * gk + 28.0f;
    unsigned* ctr = (unsigned*)(a->ws + WS_CTL) + CW_AQ + 64 * 8 * (ev * 4 + 1);
    const bf16_t* QN = (const bf16_t*)(a->ws + WS_QN);
    for (;;) {
        if (tid == 0) *cur = (int)__hip_atomic_fetch_add(ctr, 1u, __ATOMIC_RELAXED, __HIP_MEMORY_SCOPE_AGENT);
        __syncthreads();
        const int u = *cur; if (u >= 1024) break;
        const int qb = 31 - (u >> 5), bg = u & 31, b = bg >> 1, g = bg & 1, q0 = qb * 64; const size_t t0 = (size_t)b * 2048 + q0;
        bf16x8 qf[4];
        { const bf16_t* Qw = QN + (t0 + 32 * qh + r) * 512 + (4 * g + hr) * 64;
#pragma unroll
          for (int ks = 0; ks < 4; ++ks) qf[ks] = *(const bf16x8*)(Qw + 16 * ks + 8 * hh); }
        const float* gp = (const float*)(a->ws + WS_GATES) + (t0 + 32 * qh + r) * 24 + (4 * g + hr) * 3;
        const float gate_c = gp[0], gate_s = gp[1], gate_w = gp[2];
        f32x16 OB[2];
#pragma unroll
        for (int rb = 0; rb < 2; ++rb)
#pragma unroll
            for (int i = 0; i < 16; ++i) OB[rb][i] = 0.f;
        nsa_unit<96, 3>(WID, lds, qf, (const bf16_t*)(a->ws + WS_KCMP) + (size_t)bg * 128 * 64, 64, (const bf16_t*)(a->ws + WS_VCMPT) + (size_t)bg * 96 * 128, 128, q0, g, sb2,
                        nullptr, OB, gate_c, impl);
        asm volatile("s_waitcnt lgkmcnt(0)" ::: "memory");
        __syncthreads();
        { const int qq = tid >> 3, pq = tid & 7;
          if (qb < 16) { if (pq == 0) selml[qq] = (2u << qb) - 1u; }
          else { f32x4 acc = {0.f, 0.f, 0.f, 0.f};
#pragma unroll
              for (int h2 = 0; h2 < 4; ++h2) acc += *(const LAS f32x4*)(impl + (h2 * 64 + qq) * 32 + 4 * pq);
#pragma unroll
              for (int e = 0; e < 4; ++e) { const int j = 4 * pq + e; const bool forced = (j == 0) || (j == qb) || (j == qb - 1); acc[e] = (j > qb) ? NEGF : (acc[e] + (forced ? 1e4f : 0.f)); }
              *(LAS f32x4*)(scs + qq * 32 + 4 * pq) = acc; }
          asm volatile("s_waitcnt lgkmcnt(0)" ::: "memory");
          __syncthreads();
          if (qb >= 16) { const f32x4 my = *(const LAS f32x4*)(scs + qq * 32 + 4 * pq); int rk[4] = {0, 0, 0, 0};
#pragma unroll
              for (int k4 = 0; k4 < 8; ++k4) { const f32x4 o4 = *(const LAS f32x4*)(scs + qq * 32 + 4 * k4);
#pragma unroll
                  for (int kk = 0; kk < 4; ++kk) { const int k = 4 * k4 + kk;
#pragma unroll
                      for (int e = 0; e < 4; ++e) { const int j = 4 * pq + e; rk[e] += ((o4[kk] > my[e]) || (o4[kk] == my[e] && k < j)) ? 1 : 0; } } }
              unsigned bits = 0u;
#pragma unroll
              for (int e = 0; e < 4; ++e) bits |= (rk[e] < 16) ? (1u << (4 * pq + e)) : 0u;
              bits |= shxu(bits, 1); bits |= shxu(bits, 2); bits |= shxu(bits, 4);
              if (pq == 0) selml[qq] = bits; }
          asm volatile("s_waitcnt lgkmcnt(0)" ::: "memory");
          __syncthreads(); }
        nsa_unit<64, 1>(WID, lds, qf, (const bf16_t*)(a->ws + WS_KSB) + (size_t)bg * 2048 * 64, 64, (const bf16_t*)(a->ws + WS_VST) + (size_t)bg * 64 * 2048, 2048, q0, g, sb2,
                        selml, OB, gate_s, nullptr);
        { const bf16_t* ow = (const bf16_t*)(a->ws + WS_OW) + (t0 + 32 * qh + r) * 512 + (4 * g + hr) * 64;
          unsigned char* am = (unsigned char*)(a->ws + WS_AMIX) + (t0 + 32 * qh + r) * 1024 + 512 + (4 * g + hr) * 64;
#pragma unroll
          for (int rb = 0; rb < 2; ++rb)
#pragma unroll
              for (int g4 = 0; g4 < 4; ++g4) { const int dv = 32 * rb + 8 * g4 + 4 * hh; const u32x2 wv = *(const u32x2*)(ow + dv);
                  const float o0 = OB[rb][4 * g4] + gate_w * bflo(wv.x), o1 = OB[rb][4 * g4 + 1] + gate_w * bfhi(wv.x), o2 = OB[rb][4 * g4 + 2] + gate_w * bflo(wv.y), o3 = OB[rb][4 * g4 + 3] + gate_w * bfhi(wv.y);
                  *(unsigned*)(am + dv) = pk4_fp8(o0 * A_SC, o1 * A_SC, o2 * A_SC, o3 * A_SC); } }
    }
}

constexpr int PPL = 15;
constexpr int NPHASE = 1 + DEPTH * PPL;
__global__ void __launch_bounds__(512, 2) mk_fwd(Args a_unused) {
    ArgsP a = opaque_args();
    extern __shared__ __attribute__((aligned(16))) unsigned char lds_raw[];
    LAS unsigned char* lds = (LAS unsigned char*)lds_raw;
    const int tid = threadIdx.x, G = gridDim.x, c = blockIdx.x;
    const int WID = __builtin_amdgcn_readfirstlane(tid >> 6);
    volatile LAS unsigned* misc = (volatile LAS unsigned*)(lds + MISC_OFF);
    if (tid < 4) misc[tid] = 0u;
    __syncthreads();
    unsigned* ctl = (unsigned*)(a->ws + WS_CTL);
    XcdBarrier bar; bar.bar = ctl + CW_BAR; bar.x = 0; bar.st = misc;
    const int ph_lo = a->ph_lo, ph_hi = a->ph_hi;
    const bool multi = (ph_hi - ph_lo) > 1;
    if (multi) bar = xcd_barrier_post(WID, ctl + CW_BAR, misc);
    bool first = true;
#define PHASE_BEGIN(k, id) if ((DBG_ONLY < 0 || DBG_ONLY == (id)) && (k) >= ph_lo && (k) < ph_hi && (k) <= DBG_LAST_PHASE) { if (!first) { xcd_barrier(WID, bar); if (PROBE_MASK >> 31) xcd_barrier(WID, bar); } first = false; \
        ArgsP a = opaque_args(); unsigned char* ws = a->ws; bf16_t* XN = (bf16_t*)(ws + WS_XN); bf16_t* H = (bf16_t*)(ws + WS_HB); const bool hb = layer != 0; const void* Hin = hb ? (const void*)H : (const void*)a->in[I_X]; \
        const LAS int* ts = (const LAS int*)(lds + MISC_OFF + MO_TS); (void)XN; (void)H; (void)Hin; (void)ts; (void)hb; \
        const bool probe_ = ((PROBE_MASK >> (id)) & 1u) != 0u; const unsigned long long pt0_ = probe_ ? __builtin_amdgcn_s_memrealtime() : 0ull;
#define PHASE_END if (probe_) { const unsigned long long pt1_ = __builtin_amdgcn_s_memrealtime(), pd_ = pt1_ - pt0_; while (__builtin_amdgcn_s_memrealtime() - pt1_ < pd_) __builtin_amdgcn_s_sleep(8); } }
    { const int layer = 0; PHASE_BEGIN(0, 0) phase_prologue(WID, a, lds); PHASE_END }
#pragma unroll 1
    for (int layer = 0; layer < DEPTH; ++layer) {
        const int pb = 1 + layer * PPL; const bool even = (layer & 1) == 0; const int ev = layer >> 1, od = layer >> 1;
        if (even) {
            PHASE_BEGIN(pb + 0, 1) phase_norm_mm<0>(WID, a, lds, layer, Hin, hb); PHASE_END
            PHASE_BEGIN(pb + 1, 2) {
                { ProbPlain P{XN, (const bf16_t*)(ws + WS_EVNAT) + (size_t)ev * 2048 * 1024, 1024, 1024, 1024}; pg8::Sched S; S.init(T / 256, 8, G, c);
                  EpiEvNat E{ws, (const float*)(ws + WS_GAINS) + ev * 256};
                  pg8::gemm_phase(WID, lds, P, S, E); }
                { ProbPlain P{(const bf16_t*)(ws + WS_EVSW) + (size_t)ev * 768 * 1024, XN, 1024, 1024, 1024}; pg8::Sched S; S.init(3, T / 256, G, c);
                  EpiEvSw E{ws};
                  pg8::gemm_phase(WID, lds, P, S, E); }
            } PHASE_END
            PHASE_BEGIN(pb + 2, 3) {
                { ProbCmp1 P{(const bf16_t*)(ws + WS_KCB), (const bf16_t*)(ws + WS_VCB), (const bf16_t*)(ws + WS_CMP1) + (size_t)ev * 2 * 256 * 2048, 1024, 2048, 2048}; pg8::Sched S; S.init(32, 1, G, c);
                  EpiCmp1 E{(bf16_t*)(ws + WS_HID), (const float*)(ws + WS_BIAS1) + ev * 512};
                  pg8::gemm_phase(WID, lds, P, S, E); }
                phase_diff(WID, a, lds, layer);
                phase_attn<2>(WID, a, lds, ev);
            } PHASE_END
            PHASE_BEGIN(pb + 3, 4) phase_cmp2(WID, a, lds, ev); PHASE_END
            PHASE_BEGIN(pb + 4, 5) phase_nsa(WID, a, lds, ev); PHASE_END
            PHASE_BEGIN(pb + 8, 9) {
                ProbPlain8 P{(const unsigned char*)(ws + WS_AMIX), (const unsigned char*)(ws + WS_EVOUT) + (size_t)ev * 1024 * 1024, 512, 512, 512}; pg8::Sched S; S.init(T / 256, 4, G, c);
                EpiResid E{Hin, H, hb, 1.0f / (A_SC * 64.0f)}; pg8::gemm_phase(WID, lds, P, S, E);
            } PHASE_END
        } else {
            PHASE_BEGIN(pb + 0, 11) phase_norm<1>(WID, a, lds, layer, Hin, hb); PHASE_END
            PHASE_BEGIN(pb + 1, 12) {
                { ProbPlain8 P{(const unsigned char*)XN, (const unsigned char*)(ws + WS_ODNAT) + (size_t)od * 4096 * 1024, 512, 512, 512}; pg8::Sched S; S.init(T / 256, 16, G, c);
                  EpiOdNat E{ws}; pg8::gemm_phase(WID, lds, P, S, E); }
                { ProbPlain8 P{(const unsigned char*)(ws + WS_ODSW) + (size_t)od * 2048 * 1024, (const unsigned char*)XN, 512, 512, 512}; pg8::Sched S; S.init(8, T / 256, G, c);
                  EpiOdSw E{ws}; pg8::gemm_phase(WID, lds, P, S, E); }
            } PHASE_END
            PHASE_BEGIN(pb + 2, 13) {
                { ProbUT P{(const bf16_t*)(ws + WS_VS), (const bf16_t*)(ws + WS_KT), 512, 256, 256}; SchedSeq S; S.init(G, c);
                  EpiUTScan E{(bf16_t*)(ws + WS_VS)}; pg8::gemm_phase(WID, lds, P, S, E); }
                { ProbAtt P{(const bf16_t*)(ws + WS_AQ), (const bf16_t*)(ws + WS_KP), 2048, 1024, 256}; pg8::Sched S; const int nb = G / 2 > 0 ? G / 2 : 1;
                  if (c >= nb || G < 2) S.init(512, 1, G < 2 ? 1 : G - nb, G < 2 ? 0 : c - nb); else S.init(0, 1, 1, 0);
                  EpiAtt E{(bf16_t*)(ws + WS_AQ)}; pg8::gemm_phase(WID, lds, P, S, E); }
            } PHASE_END
            PHASE_BEGIN(pb + 4, 15) {
                ProbY P{(const bf16_t*)(ws + WS_AQ), (const bf16_t*)(ws + WS_VS), 2048, 512, 512}; pg8::Sched S; S.init(512, 2, G, c);
                EpiY E{(bf16_t*)(ws + WS_Y)}; pg8::gemm_phase(WID, lds, P, S, E);
            } PHASE_END
            PHASE_BEGIN(pb + 5, 16) phase_normgate(WID, a, od); PHASE_END
            PHASE_BEGIN(pb + 8, 19) {
                ProbPlain8 P{(const unsigned char*)(ws + WS_YG), (const unsigned char*)(ws + WS_ODOUT) + (size_t)od * 1024 * 2048, 1024, 1024, 1024}; pg8::Sched S; S.init(T / 256, 4, G, c);
                EpiResid E{Hin, H, hb, 1.0f / (A_SC * 128.0f)}; pg8::gemm_phase(WID, lds, P, S, E);
            } PHASE_END
        }
        PHASE_BEGIN(pb + 9, 20) phase_norm_mm<2>(WID, a, lds, layer, H, true); PHASE_END
        PHASE_BEGIN(pb + 10, 21) phase_moe_slots(WID, a, lds, layer); PHASE_END
        PHASE_BEGIN(pb + 11, 22) {
            moe_tables(WID, a, lds, layer, -1);
            { ProbMoe8 P{(const unsigned char*)(ws + WS_XB), (const unsigned char*)(ws + WS_WGU) + (size_t)layer * 32 * 2048 * 1024, ts, 2048, 512, 512, 512}; pg8::Sched S; S.init(ts[32], 8, G, c);
              EpiGU E{(unsigned char*)(ws + WS_ACT), a->in[I_BGU] + (size_t)layer * 32 * 2048, ts}; pg8::gemm_phase(WID, lds, P, S, E); }
            { ProbPlain P{(const bf16_t*)(ws + WS_PBF) + (size_t)layer * T * 256, (const bf16_t*)(ws + WS_WPP) + (size_t)layer * 1024 * 256, 256, 256, 256}; pg8::Sched S; S.init(T / 256, 4, G, c);
              EpiPP E{(bf16_t*)(ws + WS_PP)}; pg8::gemm_phase(WID, lds, P, S, E); }
        } PHASE_END
        PHASE_BEGIN(pb + 12, 23) {
            moe_tables(WID, a, lds, layer, -1);
            ProbMoe8 P{(const unsigned char*)(ws + WS_ACT), (const unsigned char*)(ws + WS_WDN) + (size_t)layer * 32 * 1024 * 1024, ts, 1024, 512, 512, 512}; pg8::Sched S; S.init(ts[32], 4, G, c);
            EpiDN E{(bf16_t*)(ws + WS_YB), a->in[I_BDN] + (size_t)layer * 32 * 1024, ts}; pg8::gemm_phase(WID, lds, P, S, E);
        } PHASE_END
        PHASE_BEGIN(pb + 13, 24) phase_combine(WID, a, H); PHASE_END
        PHASE_BEGIN(pb + 14, 25) {
            ProbPlain8 P{(const unsigned char*)(ws + WS_XN), (const unsigned char*)(ws + WS_WPG) + (size_t)layer * 1024 * 1024, 512, 512, 512}; pg8::Sched S; S.init(T / 256, 4, G, c);
            EpiPLE E{H, (const bf16_t*)(ws + WS_PP), (layer == DEPTH - 1) ? a->out : nullptr}; pg8::gemm_phase(WID, lds, P, S, E);
        } PHASE_END
    }
#undef PHASE_BEGIN
#undef PHASE_END
}

extern "C" void kernel_launch(void* const* d_in, const int* in_sizes, int n_in, void* d_out, int out_size, void* d_ws, size_t ws_size, hipStream_t stream) {
    static int grid = 0;
    if (grid == 0) {
        if (n_in != 26 || out_size != T * D || ws_size < WS_END) { fprintf(stderr, "kernel_launch: unexpected problem (n_in %d, out %d, ws %zu < %zu); nothing launched\n", n_in, out_size, ws_size, (size_t)WS_END); grid = -1; return; }
        int dev = 0, cus = 0, per_cu = 0;
        if (hipGetDevice(&dev) != hipSuccess || hipDeviceGetAttribute(&cus, hipDeviceAttributeMultiprocessorCount, dev) != hipSuccess) { grid = -1; return; }
        if (hipFuncSetAttribute((const void*)mk_fwd, hipFuncAttributeMaxDynamicSharedMemorySize, LDS_BYTES) != hipSuccess) { fprintf(stderr, "kernel_launch: hipFuncSetAttribute failed\n"); grid = -1; return; }
        if (hipOccupancyMaxActiveBlocksPerMultiprocessor(&per_cu, (const void*)mk_fwd, 512, LDS_BYTES) != hipSuccess || per_cu < 1) fprintf(stderr, "kernel_launch: occupancy query reports %d\n", per_cu);
        (void)hipGetLastError();
        grid = cus > 256 ? 256 : cus;
    }
    if (grid < 0) return;
    (void)hipMemsetAsync((char*)d_ws + WS_CTL, 0, CTL_BYTES, stream);
    Args a; memset(&a, 0, sizeof(a));
    for (int i = 0; i < 26; ++i) a.in[i] = (const float*)d_in[i];
    a.out = (float*)d_out; a.ws = (unsigned char*)d_ws;
#if MK_SINGLE
    a.ph_lo = 0; a.ph_hi = NPHASE;
    hipLaunchKernelGGL(mk_fwd, dim3(grid), dim3(512), LDS_BYTES, stream, a);
#else
    for (int ph = 0; ph < NPHASE && ph <= DBG_LAST_PHASE; ++ph) {
        const int l = (ph - 1) / PPL, k = (ph - 1) % PPL;
        if (ph > 0 && (l & 1) && (k == 6 || k == 7)) continue;
        a.ph_lo = ph; a.ph_hi = ph + 1;
        hipLaunchKernelGGL(mk_fwd, dim3(grid), dim3(512), LDS_BYTES, stream, a);
    }
#endif
}
```

```cpp
#include <hip/hip_runtime.h>
#include <cstdio>
#include <cstdint>
#include <cstring>

#define LAS __attribute__((address_space(3)))
#define DI __device__ __forceinline__
typedef unsigned short bf16_t;
typedef short bf16x8 __attribute__((ext_vector_type(8)));
typedef short s16x4 __attribute__((ext_vector_type(4)));
typedef float f32x2 __attribute__((ext_vector_type(2)));
typedef float f32x4 __attribute__((ext_vector_type(4)));
typedef float f32x16 __attribute__((ext_vector_type(16)));
typedef unsigned u32x2 __attribute__((ext_vector_type(2)));
typedef unsigned u32x4 __attribute__((ext_vector_type(4)));
typedef __bf16 bfv2 __attribute__((ext_vector_type(2)));
typedef int i32x4 __attribute__((ext_vector_type(4)));
typedef int i32x8 __attribute__((ext_vector_type(8)));

#ifndef MK_SINGLE
#define MK_SINGLE 1
#endif
#ifndef DBG_ONLY
#define DBG_ONLY -1
#endif
#ifndef PROBE_MASK
#define PROBE_MASK 0u
#endif
#ifndef PROBE_ATT
#define PROBE_ATT 0
#endif
#ifndef PROBE_EPI2
#define PROBE_EPI2 0
#endif
#ifndef PROBE_PRO
#define PROBE_PRO 0
#endif
#ifndef PROBE_KREP
#define PROBE_KREP 1
#endif
#ifndef DBG_LAST_PHASE
#define DBG_LAST_PHASE 100000
#endif

constexpr int T = 32768, D = 1024, SEQ = 2048, NBATCH = 16, DEPTH = 4;
constexpr int EVIN = 2840, ODIN = 6144;
constexpr float EPS = 1e-6f, NEGF = -1e30f;
constexpr int NTB = 256;
constexpr int MOE_ROWS = (512 + 32) * 256;

constexpr size_t MiB = 1u << 20;
constexpr size_t WS_CTL = 0, CTL_BYTES = 1 * MiB;
constexpr int CW_BAR = 4096;
constexpr size_t WS_EVNAT = 2 * MiB, WS_EVSW = 10 * MiB, WS_EVOUT = 13 * MiB, WS_CMP1 = 17 * MiB, WS_ODNAT = 21 * MiB, WS_ODSW = 37 * MiB,
                 WS_ODOUT = 49 * MiB, WS_WPP = 57 * MiB, WS_WPG = 59 * MiB, WS_BIAS1 = 67 * MiB, WS_GAINS = 67 * MiB + 16384, WS_BCNT = 67 * MiB + 65536,
                 WS_WGU = 68 * MiB, WS_WDN = 580 * MiB;
constexpr size_t WS_XN = 840 * MiB, WS_PBF = 904 * MiB, WS_PP = 968 * MiB, WS_GATES = 1032 * MiB, WS_TOPE = 1035 * MiB, WS_POSB = 1036 * MiB,
                 WS_DEST = 1037 * MiB, WS_GATEW = 1038 * MiB, WS_SELM = 1039 * MiB;
constexpr size_t RA = 1040 * MiB;
constexpr size_t WS_QD = RA, WS_KD = RA + 32 * MiB, WS_QN = RA + 64 * MiB, WS_KCB = RA + 96 * MiB, WS_VCB = RA + 105 * MiB, WS_KSB = RA + 114 * MiB,
                 WS_KWB = RA + 122 * MiB, WS_VAT = RA + 130 * MiB, WS_VST = RA + 162 * MiB, WS_VWT = RA + 170 * MiB, WS_HID = RA + 178 * MiB,
                 WS_KCMP = RA + 182 * MiB, WS_VCMPT = RA + 183 * MiB, WS_OC = RA + 184 * MiB, WS_IMPH = RA + 216 * MiB, WS_OD = RA + 248 * MiB,
                 WS_OS = RA + 312 * MiB, WS_OW = RA + 344 * MiB, WS_AMIX = RA + 376 * MiB;
constexpr size_t WS_AQ = RA, WS_KP = RA + 128 * MiB, WS_KT = RA + 192 * MiB, WS_VS = RA + 256 * MiB, WS_GG = RA + 512 * MiB, WS_UT = RA + 640 * MiB,
                 WS_Y = RA + 896 * MiB, WS_YG = RA + 1024 * MiB;
constexpr size_t WS_TOK = 2192 * MiB  , WS_XB = 2192 * MiB, WS_ACT = 2464 * MiB, WS_YB = 2736 * MiB, WS_HB = 3008 * MiB, WS_END = 3072 * MiB;

constexpr int MISC_OFF = 139264, LDS_BYTES = 155648;
static_assert(MISC_OFF + 5888 + 4096 <= LDS_BYTES, "misc LDS words");
constexpr int MO_WCNT = 256, MO_ENT = 1280, MO_GAT = 3328, MO_TOT = 5376, MO_BASE = 5504, MO_TS = 5632, MO_RED = 5888, MO_GIDX = 10240;
static_assert(MISC_OFF + MO_GIDX + 1024 <= LDS_BYTES, "misc LDS words");

DI int opaque_tid(int wid0) { int l; asm volatile("v_mbcnt_lo_u32_b32 %0, -1, 0\n\tv_mbcnt_hi_u32_b32 %0, -1, %0" : "=v"(l) :: "memory"); return (wid0 << 6) | l; }
DI int lane_now() { int l; asm volatile("v_mbcnt_lo_u32_b32 %0, -1, 0\n\tv_mbcnt_hi_u32_b32 %0, -1, %0" : "=v"(l)); return l; }
DI float shx(float v, int m) { return __builtin_bit_cast(float, __builtin_amdgcn_ds_bpermute((lane_now() ^ m) << 2, __builtin_bit_cast(int, v))); }
DI float shxl(float v, int m, int lane) { return __builtin_bit_cast(float, __builtin_amdgcn_ds_bpermute((lane ^ m) << 2, __builtin_bit_cast(int, v))); }
DI unsigned shxu(unsigned v, int m) { return (unsigned)__builtin_amdgcn_ds_bpermute((lane_now() ^ m) << 2, (int)v); }
DI unsigned pk2(float lo, float hi) { f32x2 v = {lo, hi}; return __builtin_bit_cast(unsigned, __builtin_convertvector(v, bfv2)); }
DI unsigned pk4_fp8(float a, float b, float c, float d) { int w = 0; w = __builtin_amdgcn_cvt_pk_fp8_f32(a, b, w, false); w = __builtin_amdgcn_cvt_pk_fp8_f32(c, d, w, true); return (unsigned)w; }
DI u32x2 pack8_fp8(const f32x4& a, const f32x4& b) { u32x2 w; w.x = pk4_fp8(a[0], a[1], a[2], a[3]); w.y = pk4_fp8(b[0], b[1], b[2], b[3]); return w; }
DI float bf2f(unsigned short b) { return __uint_as_float(((unsigned)b) << 16); }
DI float bflo(unsigned w) { return __uint_as_float(w << 16); }
DI float bfhi(unsigned w) { return __uint_as_float(w & 0xffff0000u); }
DI float wave_sum(float v) {
#pragma unroll
    for (int o = 1; o < 64; o <<= 1) v += shx(v, o);
    return v;
}
DI float sigm(float x) { return __builtin_amdgcn_rcpf(1.0f + __builtin_amdgcn_exp2f(-1.44269504089f * x)); }
DI u32x4 pack8(const f32x4& a, const f32x4& b) { u32x4 w; w.x = pk2(a[0], a[1]); w.y = pk2(a[2], a[3]); w.z = pk2(b[0], b[1]); w.w = pk2(b[2], b[3]); return w; }
DI f32x4 ld_h4(const void* base, bool hb, size_t i) {
    if (hb) { const u32x2 w = *(const u32x2*)((const bf16_t*)base + i); return (f32x4){bflo(w.x), bfhi(w.x), bflo(w.y), bfhi(w.y)}; }
    return *(const f32x4*)((const float*)base + i);
}

#define XB_TMO      128
#define XB_XCNT(j)  (256  + 64 * (j))
#define XB_XSUB(j)  (1280 + 64 * (j))
#define XB_XGEN(j)  (2304 + 64 * (j))
#define XB_TOP      3328
#define XB_TOPGEN   3392
#define XCD_BAR_WORDS 3456
#define XB_SPIN_CAP (1u << 22)
DI unsigned xb_ld(unsigned* p)              { return __hip_atomic_load(p, __ATOMIC_RELAXED, __HIP_MEMORY_SCOPE_AGENT); }
DI unsigned xb_add(unsigned* p, unsigned v) { return __hip_atomic_fetch_add(p, v, __ATOMIC_RELAXED, __HIP_MEMORY_SCOPE_AGENT); }
DI unsigned xb_xcc_id() { return (unsigned)__builtin_amdgcn_s_getreg((3 << 11) | 20) & 0xFu; }
#define XB_SPIN(cond, bar) do { unsigned _sp = 0; while (cond) { __builtin_amdgcn_s_sleep(1); \
    if ((++_sp & 255u) == 0u) { if (xb_ld(&(bar)[XB_TMO])) break; if (_sp > XB_SPIN_CAP) { atomicAdd(&(bar)[XB_TMO], 1u); break; } } } } while (0)
struct XcdBarrier { unsigned* bar; unsigned x; volatile LAS unsigned* st; };
DI XcdBarrier xcd_barrier_post(const int WID, unsigned* bar, volatile LAS unsigned* st) {
    XcdBarrier b; b.bar = bar; b.x = xb_xcc_id(); b.st = st;
    if (opaque_tid(WID) == 0) (void)xb_add(&bar[XB_XCNT(b.x)], 1u);
    return b;
}
DI void xcd_barrier_complete(unsigned* bar, unsigned x, unsigned& nloc, unsigned& nx) {
    const unsigned G = gridDim.x * gridDim.y * gridDim.z;
    unsigned sum, cnt, mine, sp = 0u;
    for (;;) {
        sum = 0u; cnt = 0u; mine = 0u;
#pragma unroll
        for (unsigned j = 0; j < 16; ++j) { const unsigned c = xb_ld(&bar[XB_XCNT(j)]); sum += c; cnt += (c > 0u) ? 1u : 0u; mine = (j == x) ? c : mine; }
        if (sum == G) break;
        __builtin_amdgcn_s_sleep(1);
        if ((++sp & 255u) == 0u) { if (xb_ld(&bar[XB_TMO])) break; if (sp > XB_SPIN_CAP) { atomicAdd(&bar[XB_TMO], 1u); break; } }
    }
    nloc = mine > 0u ? mine : 1u; nx = cnt > 0u ? cnt : 1u;
}
DI void xcd_barrier(const int WID, const XcdBarrier& b) {
    asm volatile("s_waitcnt vmcnt(0)" ::: "memory");
    __syncthreads();
    if (opaque_tid(WID) == 0) {
        unsigned* bar = b.bar; asm volatile("" : "+s"(bar));
        __builtin_amdgcn_s_waitcnt(0);
        unsigned nloc = b.st[0], nx = b.st[1];
        if (nloc == 0u) { xcd_barrier_complete(bar, b.x, nloc, nx); b.st[0] = nloc; b.st[1] = nx; }
        const unsigned old = xb_add(&bar[XB_XSUB(b.x)], 1u);
        const unsigned gen = old / nloc;
        if (old + 1u == (gen + 1u) * nloc) {
            __builtin_amdgcn_fence(__ATOMIC_RELEASE, "agent");
            asm volatile("s_waitcnt vmcnt(0)" ::: "memory");
            const unsigned og = xb_add(&bar[XB_TOP], 1u);
            const unsigned tg = og / nx;
            if (og + 1u == (tg + 1u) * nx) xb_add(&bar[XB_TOPGEN], 1u);
            else XB_SPIN(xb_ld(&bar[XB_TOPGEN]) == tg, bar);
            __builtin_amdgcn_fence(__ATOMIC_ACQUIRE, "agent");
            xb_add(&bar[XB_XGEN(b.x)], 1u);
            asm volatile("s_waitcnt vmcnt(0)" ::: "memory");
        } else {
            XB_SPIN(xb_ld(&bar[XB_XGEN(b.x)]) == gen, bar);
            __builtin_amdgcn_fence(__ATOMIC_ACQUIRE, "agent");
            asm volatile("s_waitcnt vmcnt(0)" ::: "memory");
        }
    }
    __syncthreads();
}

namespace pg8 {
constexpr int BM = 256, BK = 64, HALF = 128, HTB = HALF * BK * 2, STAGE_BYTES = 8 * HTB, NXCD = 8, WGM = 8;
DI int lds_byte(int r, int c) { const int st = (r >> 4) * 2 + (c >> 5), rr = r & 15, cc = c & 31, ob = rr * 64 + cc * 2; return st * 1024 + (ob ^ (((ob >> 9) & 1) << 5)); }
DI void stage_rc(int b, int& R, int& C) { const int st = b / 1024, sb = b % 1024, swz = sb ^ (((sb >> 9) & 1) << 5); R = (st >> 1) * 16 + swz / 64; C = (st & 1) * 32 + (swz % 64) / 2; }
DI int perm32(int rho) { const int n = rho >> 4, i = rho & 15; return 8 * (i >> 2) + 4 * n + (i & 3); }
struct Unit { int pm, pn; };
struct Sched {
    int nM, nN, nwg, G, c;
    DI void init(int nM_, int nN_, int G_, int c_) { nM = nM_; nN = nN_; nwg = nM * nN; G = G_; c = c_; }
    DI bool next(int i, Unit& u) const {
        const long L = (long)i * G + c; if (L >= nwg) return false;
        int wgid = (int)L; { const int q = nwg / NXCD, r = nwg % NXCD, xcd = wgid % NXCD, off = wgid / NXCD; wgid = (xcd < r ? xcd * (q + 1) : r * (q + 1) + (xcd - r) * q) + off; }
        const int nig = WGM * nN, gid = wgid / nig, fm = gid * WGM, gsz = (nM - fm) < WGM ? (nM - fm) : WGM;
        u.pm = fm + ((wgid % nig) % gsz); u.pn = (wgid % nig) / gsz; return true;
    }
};
template <class Epi, class Prob, class SchedT>
DI void gemm_phase(const int WID, LAS unsigned char* lds, const Prob& P, const SchedT& S, const Epi& E) {
    const int tid = opaque_tid(WID), wid = __builtin_amdgcn_readfirstlane(tid >> 6), lane = tid & 63, wr = wid >> 2, wc = wid & 3, fr = lane & 15, fq = lane >> 4;
    const int K = P.K, nt = K / BK;
    constexpr int KREP = Epi::CARRY ? 1 : PROBE_KREP;
    unsigned voffA[2], voffB[2], voffG[2];
#pragma unroll
    for (int i = 0; i < 2; ++i) { int R, C; stage_rc(tid * 16 + i * 8192, R, C); const int Rb = Epi::PERM ? ((R & ~31) + perm32(R & 31)) : R;
        voffA[i] = (unsigned)(R * P.lda + C) * 2u; voffB[i] = (unsigned)(Rb * P.ldb + C) * 2u; voffG[i] = 0u; }
    const size_t kstep = (size_t)(BK * 2);
    const size_t hstepA = (size_t)HALF * P.lda * 2, hstepB = (size_t)HALF * P.ldb * 2;
    const unsigned ldsw = (unsigned)wid * 1024u;
    const int aoff = lds_byte(wr * 64 + fr, fq * 8), boff = lds_byte(wc * 32 + fr, fq * 8);
#define PG8_SA(b, h) (((b) * 2 + (h)) * HTB)
#define PG8_SB(b, h) ((4 + (b) * 2 + (h)) * HTB)
#define PG8_STAGE(bufoff, gbase, voff) do { _Pragma("unroll") for (int _i = 0; _i < 2; ++_i) \
        __builtin_amdgcn_global_load_lds((const unsigned*)((const char*)(gbase) + (voff)[_i]), (LAS unsigned*)(lds + (bufoff) + ldsw + _i * 8192), 16, 0, 0); } while (0)
#define PG8_STAGE_A(b, h, abase) do { if constexpr (Prob::GATHER) { if (h) PG8_STAGE(PG8_SA(b, h), abase, voffG); else PG8_STAGE(PG8_SA(b, h), abase, voffA); } \
        else PG8_STAGE(PG8_SA(b, h), (abase) + ((h) ? hstepA : (size_t)0), voffA); } while (0)
#define PG8_LD16(off) (*(const LAS i32x4*)(lds + (off)))
#define PG8_LDA(dst, b, h) do { _Pragma("unroll") for (int m = 0; m < 4; ++m) { const i32x4 lo_ = PG8_LD16(PG8_SA(b, h) + aoff + m * 2048), hi_ = PG8_LD16(PG8_SA(b, h) + aoff + m * 2048 + 1024); dst[m] = __builtin_shufflevector(lo_, hi_, 0, 1, 2, 3, 4, 5, 6, 7); } } while (0)
#define PG8_LDB(dst, b, h) do { _Pragma("unroll") for (int n = 0; n < 2; ++n) { const i32x4 lo_ = PG8_LD16(PG8_SB(b, h) + boff + n * 2048), hi_ = PG8_LD16(PG8_SB(b, h) + boff + n * 2048 + 1024); dst[n] = __builtin_shufflevector(lo_, hi_, 0, 1, 2, 3, 4, 5, 6, 7); } } while (0)
#define PG8_LOH(X) __builtin_bit_cast(bf16x8, __builtin_shufflevector((X), (X), 0, 1, 2, 3))
#define PG8_HIH(X) __builtin_bit_cast(bf16x8, __builtin_shufflevector((X), (X), 4, 5, 6, 7))
#define PG8_MMA(ai, bj, At, Bt) do { __builtin_amdgcn_s_setprio(1); \
        if constexpr (Prob::FP8) { _Pragma("unroll") for (int m = 0; m < 4; ++m) _Pragma("unroll") for (int n = 0; n < 2; ++n) \
            asm volatile("v_mfma_scale_f32_16x16x128_f8f6f4 %0, %1, %2, %0, %3, %3 op_sel_hi:[0,0,0]" : "+v"(acc[ai][bj][m][n]) : "v"(Bt[n]), "v"(At[m]), "v"(sc1)); } \
        else { _Pragma("unroll") for (int m = 0; m < 4; ++m) _Pragma("unroll") for (int n = 0; n < 2; ++n) { \
            acc[ai][bj][m][n] = __builtin_amdgcn_mfma_f32_16x16x32_bf16(PG8_LOH(Bt[n]), PG8_LOH(At[m]), acc[ai][bj][m][n], 0, 0, 0); \
            acc[ai][bj][m][n] = __builtin_amdgcn_mfma_f32_16x16x32_bf16(PG8_HIH(Bt[n]), PG8_HIH(At[m]), acc[ai][bj][m][n], 0, 0, 0); } } \
        __builtin_amdgcn_s_setprio(0); } while (0)
#define PG8_WAIT_V(n) asm volatile("s_waitcnt vmcnt(" #n ")" ::: "memory")
#define PG8_WAIT_L(n) asm volatile("s_waitcnt lgkmcnt(" #n ")" ::: "memory")
#define PG8_BAR __builtin_amdgcn_s_barrier()
#define PG8_SCHED __builtin_amdgcn_sched_barrier(0)
    Unit cur, nxt; int ui = 0;
    if (!S.next(0, cur)) return;
    f32x4 acc[2][2][4][2];
#pragma unroll
    for (int a = 0; a < 2; ++a)
#pragma unroll
        for (int b = 0; b < 2; ++b)
#pragma unroll
            for (int m = 0; m < 4; ++m)
#pragma unroll
                for (int n = 0; n < 2; ++n) acc[a][b][m][n] = (f32x4){0.f, 0.f, 0.f, 0.f};
    i32x8 At[4], B0[2], B1[2];
    const int sc1 = 0x7f7f7f7f;
    const char* cA = P.a_base(cur); const char* cB = P.b_base(cur);
    if constexpr (Prob::GATHER) {
#pragma unroll
        for (int i = 0; i < 2; ++i) { int R, C; stage_rc(tid * 16 + i * 8192, R, C);
            voffA[i] = (unsigned)P.TOK[(size_t)cur.pm * 256 + R] * 1024u + (unsigned)C * 2u; voffG[i] = (unsigned)P.TOK[(size_t)cur.pm * 256 + 128 + R] * 1024u + (unsigned)C * 2u; }
    }
    PG8_STAGE(PG8_SB(0, 0), cB, voffB); PG8_STAGE_A(0, 0, cA); PG8_STAGE(PG8_SB(0, 1), cB + hstepB, voffB); PG8_STAGE_A(0, 1, cA);
    if (wr == 1) PG8_BAR;
    PG8_WAIT_V(4); PG8_BAR;
    PG8_STAGE(PG8_SB(1, 0), cB + kstep, voffB); PG8_STAGE_A(1, 0, cA + kstep); PG8_STAGE(PG8_SB(1, 1), cB + hstepB + kstep, voffB);
    PG8_WAIT_V(6); PG8_BAR;
    for (;;) {
        const bool has_next = S.next(ui + 1, nxt);
        const char* nA = has_next ? P.a_base(nxt) : cA; const char* nB = has_next ? P.b_base(nxt) : cB;
        for (int rep_ = 0; rep_ < KREP; ++rep_)
        for (int t = 0; t < nt; t += 2) {
            const bool last = (t == nt - 2);
            if constexpr (Epi::HOOK) { if (last && rep_ + 1 == KREP) E.prefetch(cur, lds, wid, lane); }
            const char* a1 = cA + (size_t)(t + 1) * kstep;
            const char* a2 = last ? (rep_ + 1 < KREP ? cA : nA) : cA + (size_t)(t + 2) * kstep; const char* b2 = last ? (rep_ + 1 < KREP ? cB : nB) : cB + (size_t)(t + 2) * kstep;
            const char* a3 = a2 + kstep; const char* b3 = b2 + kstep;
            if constexpr (Prob::GATHER) {
                if (t == 0 && rep_ == 0 && has_next && wid == 0) __builtin_amdgcn_global_load_lds((const unsigned*)(P.TOK + (size_t)nxt.pm * 256 + 4 * lane_now()), (LAS unsigned*)(lds + MISC_OFF + MO_GIDX), 16, 0, 0);
                if (last && rep_ + 1 == KREP && has_next) { const int t3_ = opaque_tid(WID);
#pragma unroll
                    for (int i = 0; i < 2; ++i) { int R, C; stage_rc(t3_ * 16 + i * 8192, R, C); voffA[i] = (unsigned)(*(const LAS int*)(lds + MISC_OFF + MO_GIDX + 4 * R)) * 1024u + (unsigned)C * 2u; } }
            }
            PG8_LDB(B0, 0, 0); PG8_SCHED; PG8_LDA(At, 0, 0); PG8_STAGE_A(1, 1, a1);
            if constexpr (Prob::GATHER) {
                if (last && rep_ + 1 == KREP && has_next) { const int t3_ = opaque_tid(WID);
#pragma unroll
                    for (int i = 0; i < 2; ++i) { int R, C; stage_rc(t3_ * 16 + i * 8192, R, C); voffG[i] = (unsigned)(*(const LAS int*)(lds + MISC_OFF + MO_GIDX + 512 + 4 * R)) * 1024u + (unsigned)C * 2u; } }
            }
            PG8_WAIT_L(8); PG8_BAR; PG8_WAIT_L(0); PG8_MMA(0, 0, At, B0); PG8_BAR; PG8_SCHED;
            PG8_LDB(B1, 0, 1); PG8_STAGE(PG8_SB(0, 0), b2, voffB);
            PG8_BAR; PG8_WAIT_L(0); PG8_MMA(0, 1, At, B1); PG8_BAR;
            PG8_LDA(At, 0, 1); PG8_STAGE_A(0, 0, a2);
            PG8_BAR; PG8_WAIT_L(0); PG8_MMA(1, 0, At, B0); PG8_BAR; PG8_SCHED;
            PG8_STAGE(PG8_SB(0, 1), b2 + hstepB, voffB);
            PG8_WAIT_V(6); PG8_BAR; PG8_MMA(1, 1, At, B1); PG8_BAR;
            PG8_LDB(B0, 1, 0); PG8_SCHED; PG8_LDA(At, 1, 0); PG8_STAGE_A(0, 1, a2);
            PG8_WAIT_L(8); PG8_BAR; PG8_WAIT_L(0); PG8_MMA(0, 0, At, B0); PG8_BAR; PG8_SCHED;
            PG8_LDB(B1, 1, 1); PG8_STAGE(PG8_SB(1, 0), b3, voffB);
            PG8_BAR; PG8_WAIT_L(0); PG8_MMA(0, 1, At, B1); PG8_BAR;
            PG8_LDA(At, 1, 1); PG8_STAGE_A(1, 0, a3);
            PG8_BAR; PG8_WAIT_L(0); PG8_MMA(1, 0, At, B0); PG8_BAR; PG8_SCHED;
            PG8_STAGE(PG8_SB(1, 1), b3 + hstepB, voffB);
            PG8_WAIT_V(6); PG8_BAR; PG8_MMA(1, 1, At, B1); PG8_BAR;
        }
        if constexpr (Prob::FP8) {
            asm volatile("s_nop 15\n\ts_nop 15" ::: "memory");
#pragma unroll
            for (int a_ = 0; a_ < 2; ++a_)
#pragma unroll
                for (int b_ = 0; b_ < 2; ++b_)
#pragma unroll
                    for (int m_ = 0; m_ < 4; ++m_)
#pragma unroll
                        for (int n_ = 0; n_ < 2; ++n_) asm volatile("" : "+v"(acc[a_][b_][m_][n_]));
        }
        if constexpr (KREP > 1) {
#pragma unroll
        for (int a_ = 0; a_ < 2; ++a_)
#pragma unroll
            for (int b_ = 0; b_ < 2; ++b_)
#pragma unroll
                for (int m_ = 0; m_ < 4; ++m_)
#pragma unroll
                    for (int n_ = 0; n_ < 2; ++n_) acc[a_][b_][m_][n_] *= (1.0f / KREP); }
        { const int t2_ = opaque_tid(WID); const int fr_ = t2_ & 15, fq_ = (t2_ >> 4) & 3; int wr_ = WID >> 2, wc_ = WID & 3; asm volatile("" : "+s"(wr_), "+s"(wc_));
          E(acc, cur, wr_, wc_, fr_, fq_);
#if PROBE_EPI2
          if constexpr (Epi::HOOK) { asm volatile("" ::: "memory"); E(acc, cur, wr_, wc_, fr_, fq_); }
#endif
        }
        if (!has_next) break;
        const float carry = Epi::carry(cur);
#pragma unroll
        for (int a = 0; a < 2; ++a)
#pragma unroll
            for (int b = 0; b < 2; ++b)
#pragma unroll
                for (int m = 0; m < 4; ++m)
#pragma unroll
                    for (int n = 0; n < 2; ++n) acc[a][b][m][n] = Epi::CARRY ? acc[a][b][m][n] * carry : (f32x4){0.f, 0.f, 0.f, 0.f};
        cur = nxt; cA = nA; cB = nB; ++ui;
    }
    PG8_WAIT_V(0);
    if (wr == 0) PG8_BAR;
    PG8_BAR;
#undef PG8_SA
#undef PG8_SB
#undef PG8_STAGE
#undef PG8_STAGE_A
#undef PG8_LDA
#undef PG8_LDB
#undef PG8_MMA
#undef PG8_LD16
#undef PG8_LOH
#undef PG8_HIH
#undef PG8_WAIT_V
#undef PG8_WAIT_L
#undef PG8_BAR
#undef PG8_SCHED
}
}
using pg8::Unit;
typedef f32x4 Acc[2][2][4][2];

struct ProbPlain { static constexpr bool GATHER = false; static constexpr bool FP8 = false; const bf16_t* A; const bf16_t* Bt; int lda, ldb, K;
    DI const char* a_base(const Unit& u) const { return (const char*)(A + (size_t)u.pm * 256 * lda); }
    DI const char* b_base(const Unit& u) const { return (const char*)(Bt + (size_t)u.pn * 256 * ldb); } };
struct ProbCmp1 { static constexpr bool GATHER = false; static constexpr bool FP8 = false; const bf16_t* KCB; const bf16_t* VCB; const bf16_t* W; int lda, ldb, K;
    DI const char* a_base(const Unit& u) const { const int kv = u.pm >> 4, rt = u.pm & 15; return (const char*)((kv ? VCB : KCB) + (size_t)rt * 256 * 1024); }
    DI const char* b_base(const Unit& u) const { const int kv = u.pm >> 4; return (const char*)(W + (size_t)kv * 256 * 2048); } };
struct ProbAtt { static constexpr bool GATHER = false; static constexpr bool FP8 = false; const bf16_t* AQ; const bf16_t* KP; int lda, ldb, K;
    DI const char* a_base(const Unit& u) const { const int z = u.pm, n = z & 7, h = (z >> 3) & 3, b = z >> 5; const size_t t0 = (size_t)b * 2048 + n * 256; return (const char*)(AQ + (t0 * 4 + h) * 512 + 256); }
    DI const char* b_base(const Unit& u) const { const int z = u.pm, n = z & 7, h = (z >> 3) & 3, b = z >> 5; const size_t t0 = (size_t)b * 2048 + n * 256; return (const char*)(KP + t0 * 1024 + h * 256); } };
struct ProbUT { static constexpr bool GATHER = false; static constexpr bool FP8 = false; const bf16_t* VS; const bf16_t* KT; int lda, ldb, K;
    DI const char* a_base(const Unit& u) const { const int z = u.pm >> 1, half = u.pm & 1; return (const char*)(VS + (size_t)z * 262144 + (size_t)half * 256 * 512); }
    DI const char* b_base(const Unit& u) const { const int z = u.pm >> 1; return (const char*)(KT + (size_t)z * 65536); } };
struct ProbY { static constexpr bool GATHER = false; static constexpr bool FP8 = false; const bf16_t* AQ; const bf16_t* VS; int lda, ldb, K;
    DI const char* a_base(const Unit& u) const { const int z = u.pm, n = z & 7, h = (z >> 3) & 3, b = z >> 5; const size_t t0 = (size_t)b * 2048 + n * 256; return (const char*)(AQ + (t0 * 4 + h) * 512); }
    DI const char* b_base(const Unit& u) const { return (const char*)(VS + (size_t)u.pm * 262144 + (size_t)u.pn * 256 * 512); } };
DI int moe_tile_expert(const LAS int* ts, int rt) { int e = 0;
#pragma unroll 8
    for (int i = 1; i < 32; ++i) e += (rt >= ts[i]) ? 1 : 0;
    return e; }
struct ProbMoe { static constexpr bool GATHER = false; static constexpr bool FP8 = false; const bf16_t* A; const bf16_t* W; const LAS int* ts; int nper; int lda, ldb, K;
    DI const char* a_base(const Unit& u) const { return (const char*)(A + (size_t)u.pm * 256 * 1024); }
    DI const char* b_base(const Unit& u) const { const int e = moe_tile_expert(ts, u.pm); return (const char*)(W + ((size_t)e * nper + (size_t)u.pn * 256) * 1024); } };

struct ProbPlain8 { static constexpr bool GATHER = false; static constexpr bool FP8 = true; const unsigned char* A; const unsigned char* Bt; int lda, ldb, K;
    DI const char* a_base(const Unit& u) const { return (const char*)(A + (size_t)u.pm * 256 * lda * 2); }
    DI const char* b_base(const Unit& u) const { return (const char*)(Bt + (size_t)u.pn * 256 * ldb * 2); } };
struct ProbMoe8 { static constexpr bool GATHER = false; static constexpr bool FP8 = true; const unsigned char* A; const unsigned char* W; const LAS int* ts; int nper; int lda, ldb, K;
    DI const char* a_base(const Unit& u) const { return (const char*)(A + (size_t)u.pm * 256 * 1024); }
    DI const char* b_base(const Unit& u) const { const int e = moe_tile_expert(ts, u.pm); return (const char*)(W + ((size_t)e * nper + (size_t)u.pn * 256) * 1024); } };
struct ProbMoe8G { static constexpr bool GATHER = true; static constexpr bool FP8 = true; const unsigned char* A; const unsigned char* W; const LAS int* ts; const int* TOK; int nper; int lda, ldb, K;
    DI const char* a_base(const Unit&) const { return (const char*)A; }
    DI const char* b_base(const Unit& u) const { const int e = moe_tile_expert(ts, u.pm); return (const char*)(W + ((size_t)e * nper + (size_t)u.pn * 256) * 1024); } };

constexpr float A_SC = 4.0f;
constexpr float W8_SCALE = 32.0f, WSC = 1.0f / W8_SCALE;
#define EPI_ROWS(ai, m) (128 * (ai) + 64 * wr + 16 * (m) + fr)
struct EpiEvNat { static constexpr bool HOOK = false; static constexpr bool CARRY = false; static DI float carry(const Unit&) { return 0.f; } static constexpr bool PERM = true;
    unsigned char* ws; const float* gains;
    DI void operator()(const Acc& acc, const Unit& u, int wr, int wc, int fr, int fq) const {
        const int pn = u.pn; const bool norm = (pn != 6);
        const int gi = pn < 2 ? 0 : pn < 4 ? 1 : pn < 6 ? 2 : 3;
        const float* g = gains + gi * 64;
        f32x4 gv[2][2];
#pragma unroll
        for (int bj = 0; bj < 2; ++bj)
#pragma unroll
            for (int n = 0; n < 2; ++n) { const f32x4 t4 = *(const f32x4*)(g + 32 * bj + 8 * fq + 4 * n); gv[bj][n] = norm ? t4 : (f32x4){1.f, 1.f, 1.f, 1.f}; }
        size_t boff; int rowmul, hoff; bool panel = false;
        if (pn < 2) { boff = WS_QD; rowmul = 512; hoff = (pn * 4 + wc) * 64; }
        else if (pn < 4) { boff = WS_KD; rowmul = 512; hoff = ((pn - 2) * 4 + wc) * 64; }
        else if (pn < 6) { boff = WS_QN; rowmul = 512; hoff = ((pn - 4) * 4 + wc) * 64; }
        else { panel = true; rowmul = 64; hoff = 0; boff = (pn == 6) ? (wc < 2 ? WS_KCB : WS_VCB) : (wc < 2 ? WS_KSB : WS_KWB); }
        bf16_t* base = (bf16_t*)(ws + boff);
#pragma unroll
        for (int ai = 0; ai < 2; ++ai)
#pragma unroll
            for (int m = 0; m < 4; ++m) {
                const int t = u.pm * 256 + EPI_ROWS(ai, m), b = t >> 11, sq = t & 2047;
                float ss = 0.f;
#pragma unroll
                for (int bj = 0; bj < 2; ++bj)
#pragma unroll
                    for (int n = 0; n < 2; ++n) { const f32x4 x = acc[ai][bj][m][n]; ss += (x[0] * x[0] + x[1] * x[1]) + (x[2] * x[2] + x[3] * x[3]); }
                ss += shx(ss, 16); ss += shx(ss, 32);
                const float rstd = norm ? rsqrtf(ss * (1.0f / 64.0f) + EPS) * ((pn < 2 || pn == 4 || pn == 5) ? 0.125f : 1.0f) : 1.0f;
                const size_t rowi = panel ? ((size_t)(b * 2 + (wc & 1)) * 2048 + sq) : (size_t)t;
#pragma unroll
                for (int bj = 0; bj < 2; ++bj) {
                    const f32x4 v0 = acc[ai][bj][m][0] * rstd * gv[bj][0], v1 = acc[ai][bj][m][1] * rstd * gv[bj][1];
                    *(u32x4*)(base + rowi * rowmul + hoff + 32 * bj + 8 * fq) = pack8(v0, v1);
                }
            }
    }
};
struct EpiEvSw { static constexpr bool HOOK = false; static constexpr bool CARRY = false; static DI float carry(const Unit&) { return 0.f; } static constexpr bool PERM = true;
    unsigned char* ws;
    DI void operator()(const Acc& acc, const Unit& u, int wr, int wc, int fr, int fq) const {
        const int b = u.pn >> 3, sb = (u.pn & 7) * 256;
#pragma unroll
        for (int ai = 0; ai < 2; ++ai)
#pragma unroll
            for (int m = 0; m < 4; ++m) {
                const int rl = EPI_ROWS(ai, m);
                size_t boff, rowi;
                if (u.pm < 2) { const int fg = u.pm * 256 + rl; boff = WS_VAT; rowi = (size_t)(b * 4 + (fg >> 7)) * 128 + (fg & 127); }
                else { const int r2 = rl & 127; boff = (rl < 128) ? WS_VST : WS_VWT; rowi = (size_t)(b * 2 + (r2 >> 6)) * 64 + (r2 & 63); }
                bf16_t* rowp = (bf16_t*)(ws + boff) + rowi * 2048;
#pragma unroll
                for (int bj = 0; bj < 2; ++bj) { const u32x4 pw = pack8(acc[ai][bj][m][0], acc[ai][bj][m][1]);
                    const int s0 = sb + 128 * bj + 32 * wc + 8 * fq; bf16_t* g16 = rowp + (s0 & ~15) + ((s0 & 8) ? 4 : 0);
                    *(u32x2*)g16 = (u32x2){pw.x, pw.y}; *(u32x2*)(g16 + 8) = (u32x2){pw.z, pw.w}; }
            }
    }
};
struct EpiCmp1 { static constexpr bool HOOK = false; static constexpr bool CARRY = false; static DI float carry(const Unit&) { return 0.f; } static constexpr bool PERM = true;
    bf16_t* HID; const float* bias1;
    DI void operator()(const Acc& acc, const Unit& u, int wr, int wc, int fr, int fq) const {
        const int kv = u.pm >> 4, rt = u.pm & 15;
#pragma unroll
        for (int bj = 0; bj < 2; ++bj) {
            const int col = 128 * bj + 32 * wc + 8 * fq;
            const f32x4 b0 = *(const f32x4*)(bias1 + kv * 256 + col), b1 = *(const f32x4*)(bias1 + kv * 256 + col + 4);
#pragma unroll
            for (int ai = 0; ai < 2; ++ai)
#pragma unroll
                for (int m = 0; m < 4; ++m) {
                    f32x4 v0 = acc[ai][bj][m][0] + b0, v1 = acc[ai][bj][m][1] + b1;
#pragma unroll
                    for (int j = 0; j < 4; ++j) { v0[j] = v0[j] * sigm(v0[j]); v1[j] = v1[j] * sigm(v1[j]); }
                    *(u32x4*)(HID + ((size_t)kv * 4096 + rt * 256 + EPI_ROWS(ai, m)) * 256 + col) = pack8(v0, v1);
                }
        }
    }
};
struct EpiResid { static constexpr bool HOOK = false; static constexpr bool CARRY = false; static DI float carry(const Unit&) { return 0.f; } static constexpr bool PERM = true;
    const void* Hin; bf16_t* Hout; bool hb; float sc;
    DI void operator()(const Acc& acc, const Unit& u, int wr, int wc, int fr, int fq) const {
#pragma unroll
        for (int ai = 0; ai < 2; ++ai)
#pragma unroll
            for (int m = 0; m < 4; ++m) {
                const size_t off = (size_t)(u.pm * 256 + EPI_ROWS(ai, m)) * 1024 + u.pn * 256 + 32 * wc + 8 * fq;
#pragma unroll
                for (int bj = 0; bj < 2; ++bj) { const size_t o = off + 128 * bj;
                    *(u32x4*)(Hout + o) = pack8(ld_h4(Hin, hb, o) + acc[ai][bj][m][0] * sc, ld_h4(Hin, hb, o + 4) + acc[ai][bj][m][1] * sc); }
            }
    }
};
DI float ret_lg2(int h) { return __log2f(1.0f - exp2f(-5.0f - (float)h)); }
struct EpiOdNat { static constexpr bool HOOK = false; static constexpr bool CARRY = false; static DI float carry(const Unit&) { return 0.f; } static constexpr bool PERM = true;
    unsigned char* ws;
    DI void operator()(const Acc& acc, const Unit& u, int wr, int wc, int fr, int fq) const {
        const int pn = u.pn; const int h = pn & 3; const float lg = ret_lg2(h);
        const size_t boff = pn < 4 ? WS_AQ : pn < 8 ? WS_KP : WS_GG;
        const int rowmul = pn < 4 ? 2048 : pn < 8 ? 1024 : 2048;
        const int coff = pn < 4 ? (h * 512 + 256) : pn < 8 ? (h * 256) : ((pn - 8) * 256);
        bf16_t* base = (bf16_t*)(ws + boff) + coff;
#pragma unroll
        for (int ai = 0; ai < 2; ++ai)
#pragma unroll
            for (int m = 0; m < 4; ++m) {
                const int cl = EPI_ROWS(ai, m); const size_t t = (size_t)u.pm * 256 + cl;
                float sc = 1.f;
                if (pn < 4) sc = exp2f(lg * (float)(cl + 1)); else if (pn < 8) sc = 0.0625f * exp2f(-lg * (float)(cl + 1));
                sc *= WSC;
#pragma unroll
                for (int bj = 0; bj < 2; ++bj) {
                    const int d = 128 * bj + 32 * wc + 8 * fq;
                    f32x4 v0 = acc[ai][bj][m][0] * sc, v1 = acc[ai][bj][m][1] * sc;
                    if (pn >= 8) {
                        f32x4 e0 = v0 * -1.44269504089f, e1 = v1 * -1.44269504089f;
#pragma unroll
                        for (int j = 0; j < 4; ++j) { e0[j] = __builtin_amdgcn_exp2f(e0[j]); e1[j] = __builtin_amdgcn_exp2f(e1[j]); }
                        e0 = e0 + 1.0f; e1 = e1 + 1.0f;
#pragma unroll
                        for (int j = 0; j < 4; ++j) { e0[j] = __builtin_amdgcn_rcpf(e0[j]); e1[j] = __builtin_amdgcn_rcpf(e1[j]); }
                        v0 = v0 * e0; v1 = v1 * e1; }
                    const u32x4 pw = pack8(v0, v1);
                    *(u32x4*)(base + t * rowmul + d) = pw;
                    if (pn >= 4 && pn < 8) {
                        bf16_t* kt = (bf16_t*)(ws + WS_KT) + ((size_t)((u.pm >> 3) * 4 + h) * 8 + (u.pm & 7)) * 65536 + (size_t)d * 256 + cl;
                        kt[0 * 256] = (bf16_t)(pw.x & 0xffffu); kt[1 * 256] = (bf16_t)(pw.x >> 16); kt[2 * 256] = (bf16_t)(pw.y & 0xffffu); kt[3 * 256] = (bf16_t)(pw.y >> 16);
                        kt[4 * 256] = (bf16_t)(pw.z & 0xffffu); kt[5 * 256] = (bf16_t)(pw.z >> 16); kt[6 * 256] = (bf16_t)(pw.w & 0xffffu); kt[7 * 256] = (bf16_t)(pw.w >> 16);
                    }
                }
            }
    }
};
struct EpiOdSw { static constexpr bool HOOK = false; static constexpr bool CARRY = false; static DI float carry(const Unit&) { return 0.f; } static constexpr bool PERM = true;
    unsigned char* ws;
    DI void operator()(const Acc& acc, const Unit& u, int wr, int wc, int fr, int fq) const {
        const int b = u.pn >> 3, n = u.pn & 7, h = u.pm >> 1;
        const size_t z = (size_t)(b * 4 + h) * 8 + n;
        bf16_t* base = (bf16_t*)(ws + WS_VS) + z * 262144 + (size_t)(u.pm & 1) * 256 * 512;
#pragma unroll
        for (int bj = 0; bj < 2; ++bj) {
            const int cl = 128 * bj + 32 * wc + 8 * fq;
#pragma unroll
            for (int ai = 0; ai < 2; ++ai)
#pragma unroll
                for (int m = 0; m < 4; ++m)
                    *(u32x4*)(base + (size_t)EPI_ROWS(ai, m) * 512 + cl) = pack8(acc[ai][bj][m][0] * WSC, acc[ai][bj][m][1] * WSC);
        }
    }
};
struct EpiAtt { static constexpr bool HOOK = false; static constexpr bool CARRY = false; static DI float carry(const Unit&) { return 0.f; } static constexpr bool PERM = true;
    bf16_t* AQ;
    DI void operator()(const Acc& acc, const Unit& u, int wr, int wc, int fr, int fq) const {
        const int z = u.pm, n = z & 7, h = (z >> 3) & 3, b = z >> 5; const size_t t0 = (size_t)b * 2048 + n * 256;
#pragma unroll
        for (int ai = 0; ai < 2; ++ai)
#pragma unroll
            for (int m = 0; m < 4; ++m) {
                const int c = EPI_ROWS(ai, m);
#pragma unroll
                for (int bj = 0; bj < 2; ++bj) {
                    const int e0 = 128 * bj + 32 * wc + 8 * fq;
                    f32x4 v0 = acc[ai][bj][m][0], v1 = acc[ai][bj][m][1];
#pragma unroll
                    for (int j = 0; j < 4; ++j) { v0[j] = (c >= e0 + j) ? v0[j] : 0.f; v1[j] = (c >= e0 + 4 + j) ? v1[j] : 0.f; }
                    *(u32x4*)(AQ + ((t0 + c) * 4 + h) * 512 + e0) = pack8(v0, v1);
                }
            }
    }
};
struct EpiUT { static constexpr bool HOOK = false; static constexpr bool CARRY = false; static DI float carry(const Unit&) { return 0.f; } static constexpr bool PERM = true;
    bf16_t* UT;
    DI void operator()(const Acc& acc, const Unit& u, int wr, int wc, int fr, int fq) const {
        const size_t z = (size_t)(u.pm >> 1); const int half = u.pm & 1;
#pragma unroll
        for (int ai = 0; ai < 2; ++ai)
#pragma unroll
            for (int m = 0; m < 4; ++m) {
                bf16_t* rowp = UT + z * 131072 + (size_t)(half * 256 + EPI_ROWS(ai, m)) * 256 + 32 * wc + 8 * fq;
#pragma unroll
                for (int bj = 0; bj < 2; ++bj) *(u32x4*)(rowp + 128 * bj) = pack8(acc[ai][bj][m][0], acc[ai][bj][m][1]);
            }
    }
};
struct EpiUTScan { static constexpr bool HOOK = false; static constexpr bool CARRY = true; static constexpr bool PERM = true;
    static DI float carry(const Unit& u) { const int z = u.pm >> 1, n = z & 7, h = (z >> 3) & 3; return n == 7 ? 0.f : exp2f(256.0f * ret_lg2(h)); }
    bf16_t* VS;
    DI void operator()(const Acc& acc, const Unit& u, int wr, int wc, int fr, int fq) const {
        const size_t z = (size_t)(u.pm >> 1); const int half = u.pm & 1, n = (int)(z & 7), h = (int)((z >> 3) & 3);
        const float dec = exp2f(256.0f * ret_lg2(h));
#pragma unroll
        for (int ai = 0; ai < 2; ++ai)
#pragma unroll
            for (int m = 0; m < 4; ++m) {
                bf16_t* rowp = VS + (z * 512 + half * 256 + EPI_ROWS(ai, m)) * 512 + 256 + 32 * wc + 8 * fq;
#pragma unroll
                for (int bj = 0; bj < 2; ++bj) {
                    if (n == 0) { unsigned z0; asm volatile("v_mov_b32 %0, 0" : "=v"(z0)); *(u32x4*)(rowp + 128 * bj) = (u32x4){z0, z0, z0, z0}; }
                    if (n < 7) *(u32x4*)(rowp + (size_t)512 * 512 + 128 * bj) = pack8(acc[ai][bj][m][0] * dec, acc[ai][bj][m][1] * dec);
                }
            }
    }
};
struct SchedSeq { int nb, c;
    DI void init(int G, int c_) { nb = G / 2 > 0 ? G / 2 : 1; c = c_; }
    DI bool next(int i, Unit& u) const { if (c >= nb) return false; const int seq = c + (i >> 3) * nb; if (seq >= 128) return false;
        const int bh = seq >> 1, half = seq & 1, n = i & 7; u.pm = (bh * 8 + n) * 2 + half; u.pn = 0; return true; } };
struct EpiY { static constexpr bool HOOK = false; static constexpr bool CARRY = false; static DI float carry(const Unit&) { return 0.f; } static constexpr bool PERM = true;
    bf16_t* Y;
    DI void operator()(const Acc& acc, const Unit& u, int wr, int wc, int fr, int fq) const {
        const int z = u.pm, n = z & 7, h = (z >> 3) & 3, b = z >> 5; const size_t t0 = (size_t)b * 2048 + n * 256;
#pragma unroll
        for (int ai = 0; ai < 2; ++ai)
#pragma unroll
            for (int m = 0; m < 4; ++m) {
                bf16_t* rowp = Y + (t0 + EPI_ROWS(ai, m)) * 2048 + h * 512 + u.pn * 256 + 32 * wc + 8 * fq;
#pragma unroll
                for (int bj = 0; bj < 2; ++bj) *(u32x4*)(rowp + 128 * bj) = pack8(acc[ai][bj][m][0], acc[ai][bj][m][1]);
            }
    }
};
struct EpiGU { static constexpr bool HOOK = true; static constexpr bool CARRY = false; static DI float carry(const Unit&) { return 0.f; } static constexpr bool PERM = true;
    unsigned char* ACT; const float* bgu; const LAS int* ts;
    DI void prefetch(const Unit& u, LAS unsigned char* lds, int wid, int lane) const {
        if (wid == 0) { const int e = moe_tile_expert(ts, u.pm); const int ln = lane_now();
            const float* src = bgu + (size_t)e * 2048 + 128 * u.pn + ((ln & 32) ? 1024 : 0) + 4 * (ln & 31);
            __builtin_amdgcn_global_load_lds((const unsigned*)src, (LAS unsigned*)(lds + MISC_OFF + MO_RED), 16, 0, 0); }
    }
    DI void operator()(const Acc& acc, const Unit& u, int wr, int wc, int fr, int fq) const {
        const int w = 32 * wc + 8 * fq;
        const LAS float* bl_ = (const LAS float*)(ts) - MO_TS / 4 + MO_RED / 4 + w;
        const f32x4 bg0 = *(const LAS f32x4*)bl_, bg1 = *(const LAS f32x4*)(bl_ + 4), bl0 = *(const LAS f32x4*)(bl_ + 128), bl1 = *(const LAS f32x4*)(bl_ + 132);
#pragma unroll
        for (int ai = 0; ai < 2; ++ai)
#pragma unroll
            for (int m = 0; m < 4; ++m) {
                f32x4 g0 = acc[ai][0][m][0] * WSC + bg0, g1 = acc[ai][0][m][1] * WSC + bg1, l0 = acc[ai][1][m][0] * WSC + bl0, l1 = acc[ai][1][m][1] * WSC + bl1;
                const f32x4 seven = {7.f, 7.f, 7.f, 7.f}, mseven = {-7.f, -7.f, -7.f, -7.f};
                g0 = __builtin_elementwise_min(g0, seven); g1 = __builtin_elementwise_min(g1, seven);
                l0 = __builtin_elementwise_min(__builtin_elementwise_max(l0, mseven), seven); l1 = __builtin_elementwise_min(__builtin_elementwise_max(l1, mseven), seven);
                f32x4 e0 = g0 * (-1.702f * 1.44269504089f), e1 = g1 * (-1.702f * 1.44269504089f);
#pragma unroll
                for (int j = 0; j < 4; ++j) { e0[j] = __builtin_amdgcn_exp2f(e0[j]); e1[j] = __builtin_amdgcn_exp2f(e1[j]); }
                e0 = e0 + 1.0f; e1 = e1 + 1.0f;
#pragma unroll
                for (int j = 0; j < 4; ++j) { e0[j] = __builtin_amdgcn_rcpf(e0[j]); e1[j] = __builtin_amdgcn_rcpf(e1[j]); }
                g0 = g0 * e0 * (l0 + 1.0f); g1 = g1 * e1 * (l1 + 1.0f);
                u32x2 o8; o8.x = pk4_fp8(g0[0], g0[1], g0[2], g0[3]); o8.y = pk4_fp8(g1[0], g1[1], g1[2], g1[3]);
                *(u32x2*)(ACT + ((size_t)u.pm * 256 + EPI_ROWS(ai, m)) * 1024 + 128 * u.pn + w) = o8;
            }
    }
};
struct EpiDN { static constexpr bool HOOK = true; static constexpr bool CARRY = false; static DI float carry(const Unit&) { return 0.f; } static constexpr bool PERM = true;
    bf16_t* YB; const float* bdn; const LAS int* ts;
    DI void prefetch(const Unit& u, LAS unsigned char* lds, int wid, int lane) const {
        if (wid == 0) { const int e = moe_tile_expert(ts, u.pm); const int ln = lane_now();
            __builtin_amdgcn_global_load_lds((const unsigned*)(bdn + (size_t)e * 1024 + 256 * u.pn + 4 * ln), (LAS unsigned*)(lds + MISC_OFF + MO_RED), 16, 0, 0); }
    }
    DI void operator()(const Acc& acc, const Unit& u, int wr, int wc, int fr, int fq) const {
        const LAS float* bl_ = (const LAS float*)(ts) - MO_TS / 4 + MO_RED / 4;
#pragma unroll
        for (int bj = 0; bj < 2; ++bj) {
            const int cl = 128 * bj + 32 * wc + 8 * fq, col = 256 * u.pn + cl;
            const f32x4 b0 = *(const LAS f32x4*)(bl_ + cl), b1 = *(const LAS f32x4*)(bl_ + cl + 4);
#pragma unroll
            for (int ai = 0; ai < 2; ++ai)
#pragma unroll
                for (int m = 0; m < 4; ++m)
                    *(u32x4*)(YB + ((size_t)u.pm * 256 + EPI_ROWS(ai, m)) * 1024 + col) = pack8(acc[ai][bj][m][0] * (1.0f / 64.0f) + b0, acc[ai][bj][m][1] * (1.0f / 64.0f) + b1);
        }
    }
};
struct EpiPP { static constexpr bool HOOK = false; static constexpr bool CARRY = false; static DI float carry(const Unit&) { return 0.f; } static constexpr bool PERM = true;
    bf16_t* PP;
    DI void operator()(const Acc& acc, const Unit& u, int wr, int wc, int fr, int fq) const {
#pragma unroll
        for (int ai = 0; ai < 2; ++ai)
#pragma unroll
            for (int m = 0; m < 4; ++m) {
                bf16_t* rowp = PP + ((size_t)u.pm * 256 + EPI_ROWS(ai, m)) * 1024 + u.pn * 256 + 32 * wc + 8 * fq;
#pragma unroll
                for (int bj = 0; bj < 2; ++bj) *(u32x4*)(rowp + 128 * bj) = pack8(acc[ai][bj][m][0], acc[ai][bj][m][1]);
            }
    }
};
struct EpiPLE { static constexpr bool HOOK = false; static constexpr bool CARRY = false; static DI float carry(const Unit&) { return 0.f; } static constexpr bool PERM = true;
    bf16_t* H; const bf16_t* PP; float* out;
    DI void operator()(const Acc& acc, const Unit& u, int wr, int wc, int fr, int fq) const {
#pragma unroll
        for (int ai = 0; ai < 2; ++ai)
#pragma unroll
            for (int m = 0; m < 4; ++m) {
                const size_t off = (size_t)(u.pm * 256 + EPI_ROWS(ai, m)) * 1024 + u.pn * 256 + 32 * wc + 8 * fq;
#pragma unroll
                for (int bj = 0; bj < 2; ++bj) { const size_t o = off + 128 * bj;
                    const u32x4 pw = *(const u32x4*)(PP + o), hw = *(const u32x4*)(H + o); const f32x4 a0 = acc[ai][bj][m][0], a1 = acc[ai][bj][m][1];
                    f32x4 h0 = {bflo(hw.x), bfhi(hw.x), bflo(hw.y), bfhi(hw.y)}, h1 = {bflo(hw.z), bfhi(hw.z), bflo(hw.w), bfhi(hw.w)};
                    const f32x4 p0 = {bflo(pw.x), bfhi(pw.x), bflo(pw.y), bfhi(pw.y)}, p1 = {bflo(pw.z), bfhi(pw.z), bflo(pw.w), bfhi(pw.w)};
                    f32x4 e0 = a0 * (-WSC * 1.44269504089f), e1 = a1 * (-WSC * 1.44269504089f);
#pragma unroll
                    for (int j = 0; j < 4; ++j) { e0[j] = __builtin_amdgcn_exp2f(e0[j]); e1[j] = __builtin_amdgcn_exp2f(e1[j]); }
                    e0 = e0 + 1.0f; e1 = e1 + 1.0f;
#pragma unroll
                    for (int j = 0; j < 4; ++j) { e0[j] = __builtin_amdgcn_rcpf(e0[j]); e1[j] = __builtin_amdgcn_rcpf(e1[j]); }
                    h0 = h0 + e0 * p0; h1 = h1 + e1 * p1;
                    if (out) { *(f32x4*)(out + o) = h0; *(f32x4*)(out + o + 4) = h1; } else *(u32x4*)(H + o) = pack8(h0, h1);
                }
            }
    }
};

DI int vperm16(int key) { const int g = (key >> 2) & 3; const int ng = (g == 1) ? 2 : (g == 2) ? 1 : g; return (key & ~15) | (ng << 2) | (key & 3); }
template <int DV, int MODE>
DI void attn_unit(const int WID, LAS unsigned char* lds, const bf16_t* Qp, int ldq, const bf16_t* Kp, int ldk, const bf16_t* Vt, int ldvt, int q0, float slope, int dcut,
                  const unsigned* selp, bf16_t* Op, int ldo, float* impp) {
    constexpr int NRB = DV / 32;
    constexpr int KT_B = 64 * 128, VT_B = DV * 128, BUF_B = 2 * KT_B + 2 * VT_B;
    const int tid = opaque_tid(WID), w = __builtin_amdgcn_readfirstlane(tid >> 6), lane = tid & 63, r = lane & 31, hh = lane >> 5;
    const int qrow = q0 + 32 * w + r, qw_first = q0 + 32 * w, qw_last = qw_first + 31;
    const float LOG2E = 1.44269504089f;
    bf16x8 qf[4];
#pragma unroll
    for (int ks = 0; ks < 4; ++ks) qf[ks] = *(const bf16x8*)(Qp + (size_t)(32 * w + r) * ldq + 16 * ks + 8 * hh);
    unsigned selm = 0xffffffffu, orm = 0xffffffffu;
    if (MODE == 1) { selm = selp[32 * w + r]; orm = selm;
#pragma unroll
        for (int o = 1; o < 32; o <<= 1) orm |= shxu(orm, o); }
    const int nv = (MODE == 3) ? (qrow >= 31 ? ((qrow - 15) >> 4) : 0) : 0;
    const int nv_wmax = (MODE == 3) ? (qw_last >= 31 ? ((qw_last - 15) >> 4) : 0) : 0;
    int kt_lo = 0, kt_hi;
    if (MODE == 0 || MODE == 1) kt_hi = (q0 >> 6) + 4;
    else if (MODE == 2) { kt_hi = (q0 >> 6) + 4; const int lk = q0 - 511; kt_lo = lk > 0 ? (lk >> 6) : 0; }
    else kt_hi = 2;
    if (MODE != 3) { const int kmin = q0 - dcut; const int lo2 = kmin > 0 ? (kmin >> 6) : 0; kt_lo = lo2 > kt_lo ? lo2 : kt_lo; }
    f32x16 cb[2];
#pragma unroll
    for (int kk = 0; kk < 2; ++kk)
#pragma unroll
        for (int i = 0; i < 16; ++i) cb[kk][i] = (MODE == 3) ? 0.f : slope * (float)(32 * kk + 8 * (i >> 2) + (i & 3) + 4 * hh);
    f32x16 O[NRB];
#pragma unroll
    for (int rb = 0; rb < NRB; ++rb)
#pragma unroll
        for (int i = 0; i < 16; ++i) O[rb][i] = 0.f;
    float mrun = NEGF, lrun = 0.f;
    const int drow = tid >> 3, dpc = (tid & 7) ^ ((drow >> 1) & 7);
    const unsigned ldsw = (unsigned)w * 1024u;
#define AT_DMA(buf, sub, kt) do { const int kt_ = (kt) < 0 ? 0 : (kt); LAS unsigned char* b_ = lds + (buf) * BUF_B; \
        __builtin_amdgcn_global_load_lds((const unsigned*)(Kp + (size_t)(64 * kt_ + drow) * ldk + 8 * dpc), (LAS unsigned*)(b_ + (sub) * KT_B + ldsw), 16, 0, 0); \
        _Pragma("unroll") for (int i_ = 0; i_ < (DV + 63) / 64; ++i_) { if (64 * i_ + 64 <= DV || w < 4) \
            __builtin_amdgcn_global_load_lds((const unsigned*)(Vt + (size_t)(drow + 64 * i_) * ldvt + 64 * kt_ + 8 * dpc), (LAS unsigned*)(b_ + 2 * KT_B + (sub) * VT_B + i_ * 8192 + ldsw), 16, 0, 0); } } while (0)
    const int ntile = kt_hi - kt_lo, nstep = (ntile + 1) >> 1;
    AT_DMA(0, 0, kt_hi - 1); AT_DMA(0, 1, kt_hi - 2);
    asm volatile("s_waitcnt vmcnt(0)" ::: "memory");
    __syncthreads();
#if PROBE_ATT == 2
    AT_DMA(0, 0, kt_hi - 1); AT_DMA(0, 1, kt_hi - 2);
    asm volatile("s_waitcnt vmcnt(0)" ::: "memory");
    __syncthreads();
#endif
    const int sw = (r >> 1) & 7;
    for (int st = 0; st < nstep; ++st) {
        const int buf = st & 1;
        if (st + 1 < nstep) { AT_DMA(buf ^ 1, 0, kt_hi - 3 - 2 * st); AT_DMA(buf ^ 1, 1, kt_hi - 4 - 2 * st); }
#pragma unroll
        for (int sub = 0; sub < 2; ++sub) {
        const int kt = kt_hi - 1 - 2 * st - sub, key0 = 64 * kt;
        bool skip;
        if (MODE == 0) skip = key0 > qw_last;
        else if (MODE == 1) skip = (key0 > qw_last) || !((orm >> (kt & 31)) & 1u);
        else if (MODE == 2) skip = (key0 > qw_last) || (key0 + 63 < qw_first - 511);
        else skip = key0 >= nv_wmax;
        skip = skip || (kt < kt_lo);
        if (!skip) {
            const LAS unsigned char* kb = lds + buf * BUF_B + sub * KT_B; const LAS unsigned char* vb = lds + buf * BUF_B + 2 * KT_B + sub * VT_B;
            f32x16 S[2];
#pragma unroll
            for (int kk = 0; kk < 2; ++kk) {
                S[kk] = cb[kk];
#pragma unroll
                for (int ks = 0; ks < 4; ++ks) { const bf16x8 a = *(const LAS bf16x8*)(kb + (32 * kk + r) * 128 + (((2 * ks + hh) ^ sw) << 4));
                    S[kk] = __builtin_amdgcn_mfma_f32_32x32x16_bf16(a, qf[ks], S[kk], 0, 0, 0); }
            }
            const bool bnd = (MODE == 3) ? true : ((key0 + 63 > qw_first) || (MODE == 2 && key0 < qw_last - 511));
            if (bnd) {
                const int lim = (MODE == 3) ? (nv - key0 - 4 * hh) : (qrow - key0 - 4 * hh);
#pragma unroll
                for (int kk = 0; kk < 2; ++kk)
#pragma unroll
                    for (int i = 0; i < 16; ++i) { const int cki = 32 * kk + 8 * (i >> 2) + (i & 3);
                        bool valid;
                        if (MODE == 3) valid = cki < lim; else if (MODE == 2) valid = (cki <= lim) && (cki > lim - 512); else valid = cki <= lim;
                        S[kk][i] = valid ? S[kk][i] : NEGF; }
            }
            float mx = NEGF;
#pragma unroll
            for (int kk = 0; kk < 2; ++kk)
#pragma unroll
                for (int i = 0; i < 16; ++i) mx = fmaxf(mx, S[kk][i]);
            mx = fmaxf(mx, shx(mx, 32));
            const float off = (MODE == 3) ? 0.f : slope * (float)key0;
            mx += off;
            bool selok = true;
            if (MODE == 1) { selok = ((selm >> (kt & 31)) & 1u) != 0u; mx = selok ? mx : NEGF; }
            const float mnew = fmaxf(mrun, mx);
            const float meff = (mnew < -1e29f) ? 0.f : mnew;
            float c = (off - meff) * LOG2E;
            if (MODE == 1) c = selok ? c : NEGF;
#pragma unroll
            for (int kk = 0; kk < 2; ++kk) { f32x16 t = S[kk] * LOG2E + c;
#pragma unroll
                for (int i = 0; i < 16; ++i) t[i] = __builtin_amdgcn_exp2f(t[i]);
                S[kk] = t; }
            float ps;
            { typedef float f32x8 __attribute__((ext_vector_type(8)));
              const f32x16 su = S[0] + S[1];
              const f32x8 s8 = __builtin_shufflevector(su, su, 0, 1, 2, 3, 4, 5, 6, 7) + __builtin_shufflevector(su, su, 8, 9, 10, 11, 12, 13, 14, 15);
              const f32x4 s4 = __builtin_shufflevector(s8, s8, 0, 1, 2, 3) + __builtin_shufflevector(s8, s8, 4, 5, 6, 7);
              ps = (s4[0] + s4[1]) + (s4[2] + s4[3]); }
            if (__any(mnew > mrun)) {
                const float alpha = __builtin_amdgcn_exp2f((mrun - mnew) * LOG2E);
                lrun *= alpha;
#pragma unroll
                for (int rb = 0; rb < NRB; ++rb)
#pragma unroll
                    for (int i = 0; i < 16; ++i) O[rb][i] *= alpha;
            }
            mrun = mnew; lrun += ps;
#pragma unroll
            for (int kk = 0; kk < 2; ++kk)
#pragma unroll
                for (int s2 = 0; s2 < 2; ++s2) {
                    u32x4 pw; pw.x = pk2(S[kk][8 * s2 + 0], S[kk][8 * s2 + 1]); pw.y = pk2(S[kk][8 * s2 + 2], S[kk][8 * s2 + 3]);
                    pw.z = pk2(S[kk][8 * s2 + 4], S[kk][8 * s2 + 5]); pw.w = pk2(S[kk][8 * s2 + 6], S[kk][8 * s2 + 7]);
                    const bf16x8 pf = __builtin_bit_cast(bf16x8, pw);
#pragma unroll
                    for (int rb = 0; rb < NRB; ++rb) {
                        const bf16x8 a = *(const LAS bf16x8*)(vb + (32 * rb + r) * 128 + ((((2 * kk + s2) * 2 + hh) ^ sw) << 4));
                        O[rb] = __builtin_amdgcn_mfma_f32_32x32x16_bf16(a, pf, O[rb], 0, 0, 0);
                    }
                }
        }
        }
        asm volatile("s_waitcnt vmcnt(0)" ::: "memory");
        __syncthreads();
    }
#undef AT_DMA
    const float ltot = lrun + shx(lrun, 32);
    float inv = 1.0f / ltot;
    if (MODE == 3) inv = (nv > 0) ? inv : 0.f;
#if PROBE_ATT == 1
    for (int rep_ = 0; rep_ < 2; ++rep_) { asm volatile("" ::: "memory");
#endif
#pragma unroll
    for (int rb = 0; rb < NRB; ++rb)
#pragma unroll
        for (int g4 = 0; g4 < 4; ++g4) {
            const float a = O[rb][4 * g4] * inv, b = O[rb][4 * g4 + 1] * inv, c = O[rb][4 * g4 + 2] * inv, d = O[rb][4 * g4 + 3] * inv;
            const int dv = 32 * rb + 8 * g4 + 4 * hh;
            if (MODE == 3 && rb == 2) { *(f32x4*)(impp + (size_t)(32 * w + r) * 256 + (dv - 64)) = (f32x4){a, b, c, d}; }
            else { u32x2 o; o.x = pk2(a, b); o.y = pk2(c, d); *(u32x2*)(Op + (size_t)(32 * w + r) * ldo + dv) = o; }
        }
#if PROBE_ATT == 1
    }
#endif
}

DI void diff_unit(const int WID, LAS unsigned char* lds, const bf16_t* Q1p, const bf16_t* Q2p, const bf16_t* K1p, const bf16_t* K2p, const bf16_t* Vt, int q0, float slope, int dcut,
                  const float lam, const float oscale, const float* og, unsigned char* Ap) {
    constexpr int DV = 128, MODE = 0, ldq = 512, ldk = 512, ldvt = 2048;
    constexpr int NRB = DV / 32;
    constexpr int KT_B = 64 * 128, VT_B = DV * 128, BUF_B = 2 * KT_B + 2 * VT_B;
    const int tid = opaque_tid(WID), w = __builtin_amdgcn_readfirstlane(tid >> 6), lane = tid & 63, r = lane & 31, hh = lane >> 5;
    const int qrow = q0 + 32 * w + r, qw_first = q0 + 32 * w, qw_last = qw_first + 31;
    const float LOG2E = 1.44269504089f;
    unsigned selm = 0xffffffffu, orm = 0xffffffffu;
    const int nv = (MODE == 3) ? (qrow >= 31 ? ((qrow - 15) >> 4) : 0) : 0;
    const int nv_wmax = (MODE == 3) ? (qw_last >= 31 ? ((qw_last - 15) >> 4) : 0) : 0;
    int kt_lo = 0, kt_hi;
    if (MODE == 0 || MODE == 1) kt_hi = (q0 >> 6) + 4;
    else if (MODE == 2) { kt_hi = (q0 >> 6) + 4; const int lk = q0 - 511; kt_lo = lk > 0 ? (lk >> 6) : 0; }
    else kt_hi = 2;
    if (MODE != 3) { const int kmin = q0 - dcut; const int lo2 = kmin > 0 ? (kmin >> 6) : 0; kt_lo = lo2 > kt_lo ? lo2 : kt_lo; }
    f32x16 cb0;
#pragma unroll
    for (int i = 0; i < 16; ++i) cb0[i] = slope * (float)(8 * (i >> 2) + (i & 3) + 4 * hh);
    const float slope32 = 32.0f * slope;
    const int drow = tid >> 3, dpc = (tid & 7) ^ ((drow >> 1) & 7);
    const unsigned ldsw = (unsigned)w * 1024u;
#define AT_DMA(buf, sub, kt) do { const int kt_ = (kt) < 0 ? 0 : (kt); LAS unsigned char* b_ = lds + (buf) * BUF_B; \
        __builtin_amdgcn_global_load_lds((const unsigned*)(Kp + (size_t)(64 * kt_ + drow) * ldk + 8 * dpc), (LAS unsigned*)(b_ + (sub) * KT_B + ldsw), 16, 0, 0); \
        _Pragma("unroll") for (int i_ = 0; i_ < (DV + 63) / 64; ++i_) { if (64 * i_ + 64 <= DV || w < 4) \
            __builtin_amdgcn_global_load_lds((const unsigned*)(Vt + (size_t)(drow + 64 * i_) * ldvt + 64 * kt_ + 8 * dpc), (LAS unsigned*)(b_ + 2 * KT_B + (sub) * VT_B + i_ * 8192 + ldsw), 16, 0, 0); } } while (0)
    const int ntile = kt_hi - kt_lo, nstep = (ntile + 1) >> 1;
    const int sw = (r >> 1) & 7;
    u32x4 O1p[NRB][2];
#pragma unroll 1
    for (int pass = 0; pass < 2; ++pass) {
    const bf16_t* Qp = pass ? Q2p : Q1p; const bf16_t* Kp = pass ? K2p : K1p;
    bf16x8 qf[4];
#pragma unroll
    for (int ks = 0; ks < 4; ++ks) qf[ks] = *(const bf16x8*)(Qp + (size_t)(32 * w + r) * ldq + 16 * ks + 8 * hh);
    f32x16 O[NRB];
#pragma unroll
    for (int rb = 0; rb < NRB; ++rb)
#pragma unroll
        for (int i = 0; i < 16; ++i) O[rb][i] = 0.f;
    float mrun = NEGF, lrun = 0.f;
    AT_DMA(0, 0, kt_hi - 1); AT_DMA(0, 1, kt_hi - 2);
    asm volatile("s_waitcnt vmcnt(0)" ::: "memory");
    __syncthreads();
    for (int st = 0; st < nstep; ++st) {
        const int buf = st & 1;
        if (st + 1 < nstep) { AT_DMA(buf ^ 1, 0, kt_hi - 3 - 2 * st); AT_DMA(buf ^ 1, 1, kt_hi - 4 - 2 * st); }
#pragma unroll
        for (int sub = 0; sub < 2; ++sub) {
        const int kt = kt_hi - 1 - 2 * st - sub, key0 = 64 * kt;
        bool skip;
        if (MODE == 0) skip = key0 > qw_last;
        else if (MODE == 1) skip = (key0 > qw_last) || !((orm >> (kt & 31)) & 1u);
        else if (MODE == 2) skip = (key0 > qw_last) || (key0 + 63 < qw_first - 511);
        else skip = key0 >= nv_wmax;
        skip = skip || (kt < kt_lo);
        if (!skip) {
            const LAS unsigned char* kb = lds + buf * BUF_B + sub * KT_B; const LAS unsigned char* vb = lds + buf * BUF_B + 2 * KT_B + sub * VT_B;
            f32x16 S[2];
#pragma unroll
            for (int kk = 0; kk < 2; ++kk) {
                if (kk == 0) S[0] = cb0; else S[1] = cb0 + slope32;
#pragma unroll
                for (int ks = 0; ks < 4; ++ks) { const bf16x8 a = *(const LAS bf16x8*)(kb + (32 * kk + r) * 128 + (((2 * ks + hh) ^ sw) << 4));
                    S[kk] = __builtin_amdgcn_mfma_f32_32x32x16_bf16(a, qf[ks], S[kk], 0, 0, 0); }
            }
            const bool bnd = (MODE == 3) ? true : ((key0 + 63 > qw_first) || (MODE == 2 && key0 < qw_last - 511));
            if (bnd) {
                const int lim = (MODE == 3) ? (nv - key0 - 4 * hh) : (qrow - key0 - 4 * hh);
#pragma unroll
                for (int kk = 0; kk < 2; ++kk)
#pragma unroll
                    for (int i = 0; i < 16; ++i) { const int cki = 32 * kk + 8 * (i >> 2) + (i & 3);
                        bool valid;
                        if (MODE == 3) valid = cki < lim; else if (MODE == 2) valid = (cki <= lim) && (cki > lim - 512); else valid = cki <= lim;
                        S[kk][i] = valid ? S[kk][i] : NEGF; }
            }
            float mx = NEGF;
#pragma unroll
            for (int kk = 0; kk < 2; ++kk)
#pragma unroll
                for (int i = 0; i < 16; ++i) mx = fmaxf(mx, S[kk][i]);
            mx = fmaxf(mx, shx(mx, 32));
            const float off = (MODE == 3) ? 0.f : slope * (float)key0;
            mx += off;
            bool selok = true;
            if (MODE == 1) { selok = ((selm >> (kt & 31)) & 1u) != 0u; mx = selok ? mx : NEGF; }
            const float mnew = fmaxf(mrun, mx);
            const float meff = (mnew < -1e29f) ? 0.f : mnew;
            float c = (off - meff) * LOG2E;
            if (MODE == 1) c = selok ? c : NEGF;
#pragma unroll
            for (int kk = 0; kk < 2; ++kk) { f32x16 t = S[kk] * LOG2E + c;
#pragma unroll
                for (int i = 0; i < 16; ++i) t[i] = __builtin_amdgcn_exp2f(t[i]);
                S[kk] = t; }
            float ps;
            { typedef float f32x8 __attribute__((ext_vector_type(8)));
              const f32x16 su = S[0] + S[1];
              const f32x8 s8 = __builtin_shufflevector(su, su, 0, 1, 2, 3, 4, 5, 6, 7) + __builtin_shufflevector(su, su, 8, 9, 10, 11, 12, 13, 14, 15);
              const f32x4 s4 = __builtin_shufflevector(s8, s8, 0, 1, 2, 3) + __builtin_shufflevector(s8, s8, 4, 5, 6, 7);
              ps = (s4[0] + s4[1]) + (s4[2] + s4[3]); }
            if (__any(mnew > mrun)) {
                const float alpha = __builtin_amdgcn_exp2f((mrun - mnew) * LOG2E);
                lrun *= alpha;
#pragma unroll
                for (int rb = 0; rb < NRB; ++rb)
#pragma unroll
                    for (int i = 0; i < 16; ++i) O[rb][i] *= alpha;
            }
            mrun = mnew; lrun += ps;
#pragma unroll
            for (int kk = 0; kk < 2; ++kk)
#pragma unroll
                for (int s2 = 0; s2 < 2; ++s2) {
                    u32x4 pw; pw.x = pk2(S[kk][8 * s2 + 0], S[kk][8 * s2 + 1]); pw.y = pk2(S[kk][8 * s2 + 2], S[kk][8 * s2 + 3]);
                    pw.z = pk2(S[kk][8 * s2 + 4], S[kk][8 * s2 + 5]); pw.w = pk2(S[kk][8 * s2 + 6], S[kk][8 * s2 + 7]);
                    const bf16x8 pf = __builtin_bit_cast(bf16x8, pw);
#pragma unroll
                    for (int rb = 0; rb < NRB; ++rb) {
                        const bf16x8 a = *(const LAS bf16x8*)(vb + (32 * rb + r) * 128 + ((((2 * kk + s2) * 2 + hh) ^ sw) << 4));
                        O[rb] = __builtin_amdgcn_mfma_f32_32x32x16_bf16(a, pf, O[rb], 0, 0, 0);
                    }
                }
        }
        }
        asm volatile("s_waitcnt vmcnt(0)" ::: "memory");
        __syncthreads();
    }
#undef AT_DMA
    const float ltot = lrun + shx(lrun, 32);
    const float inv = 1.0f / ltot;
    if (pass == 0) {
#pragma unroll
        for (int rb = 0; rb < NRB; ++rb) { const f32x16 on = O[rb] * inv;
            O1p[rb][0] = (u32x4){pk2(on[0], on[1]), pk2(on[2], on[3]), pk2(on[4], on[5]), pk2(on[6], on[7])};
            O1p[rb][1] = (u32x4){pk2(on[8], on[9]), pk2(on[10], on[11]), pk2(on[12], on[13]), pk2(on[14], on[15])}; }
    } else {
        const float li = lam * inv; float ss = 0.f;
#pragma unroll
        for (int rb = 0; rb < NRB; ++rb) {
            const u32x4 p0 = O1p[rb][0], p1 = O1p[rb][1];
            const f32x16 o1 = {bflo(p0.x), bfhi(p0.x), bflo(p0.y), bfhi(p0.y), bflo(p0.z), bfhi(p0.z), bflo(p0.w), bfhi(p0.w), bflo(p1.x), bfhi(p1.x), bflo(p1.y), bfhi(p1.y), bflo(p1.z), bfhi(p1.z), bflo(p1.w), bfhi(p1.w)};
            O[rb] = o1 - O[rb] * li;
#pragma unroll
            for (int i = 0; i < 16; ++i) ss += O[rb][i] * O[rb][i];
        }
        ss += shx(ss, 32);
        const float rs = rsqrtf(ss * (1.0f / 128.0f) + EPS) * (oscale * A_SC);
        const int hg_ = lane_now() >> 5;
#pragma unroll
        for (int rb = 0; rb < NRB; ++rb)
#pragma unroll
            for (int g4 = 0; g4 < 4; ++g4) { const int dv = 32 * rb + 8 * g4 + 4 * hh; const f32x4 gg = *(const f32x4*)(og + 32 * rb + 8 * g4 + 4 * hg_);
                *(unsigned*)(Ap + (size_t)(32 * w + r) * 1024 + dv) = pk4_fp8(O[rb][4 * g4] * rs * gg[0], O[rb][4 * g4 + 1] * rs * gg[1], O[rb][4 * g4 + 2] * rs * gg[2], O[rb][4 * g4 + 3] * rs * gg[3]); }
    }
    }
}

template <int DV, int MODE>
DI void nsa_unit(const int WID, LAS unsigned char* lds, const bf16x8 (&qf)[4], const bf16_t* Kp, int ldk, const bf16_t* Vt, int ldvt, int q0, int g, float sb2,
                 const LAS unsigned* selp, f32x16 (&OB)[2], const float gate, LAS float* impp) {
    constexpr int NRB = DV / 32;
    constexpr int KT_B = 64 * 128, VT_B = DV * 128, BUF_B = 2 * KT_B + 2 * VT_B;
    const int tid = opaque_tid(WID), w = __builtin_amdgcn_readfirstlane(tid >> 6), lane = tid & 63, r = lane & 31, hh = lane >> 5;
    const int hr = w >> 1, qh = w & 1;
    const float slope = (MODE == 1) ? exp2f(-(float)(4 * g + hr + 1)) : 0.f;
    const int dcut = (MODE == 1) ? (int)fminf(sb2 / slope + 1.0f, 100000.0f) : 0, dcut_max = (MODE == 1) ? (int)fminf(sb2 * exp2f((float)(4 * g + 4)) + 1.0f, 100000.0f) : 0;
    const int qrow = q0 + 32 * qh + r, qw_first = q0 + 32 * qh, qw_last = qw_first + 31;
    const float LOG2E = 1.44269504089f;
    unsigned selm = 0xffffffffu, orm = 0xffffffffu;
    if (MODE == 1) { selm = selp[32 * qh + r]; orm = selm;
#pragma unroll
        for (int o = 1; o < 32; o <<= 1) orm |= shxu(orm, o); }
    const int nv = (MODE == 3) ? (qrow >= 31 ? ((qrow - 15) >> 4) : 0) : 0;
    const int nv_wmax = (MODE == 3) ? (qw_last >= 31 ? ((qw_last - 15) >> 4) : 0) : 0;
    int kt_lo = 0, kt_hi;
    if (MODE == 1) kt_hi = (q0 >> 6) + 1; else kt_hi = 2;
    if (MODE != 3) { const int kmin = q0 - dcut_max; const int lo2 = kmin > 0 ? (kmin >> 6) : 0; kt_lo = lo2 > kt_lo ? lo2 : kt_lo; }
    f32x16 cb[2];
#pragma unroll
    for (int kk = 0; kk < 2; ++kk)
#pragma unroll
        for (int i = 0; i < 16; ++i) cb[kk][i] = (MODE == 3) ? 0.f : slope * (float)(32 * kk + 8 * (i >> 2) + (i & 3) + 4 * hh);
    f32x16 O[NRB];
#pragma unroll
    for (int rb = 0; rb < NRB; ++rb)
#pragma unroll
        for (int i = 0; i < 16; ++i) O[rb][i] = 0.f;
    float mrun = NEGF, lrun = 0.f;
    const int drow = tid >> 3, dpc = (tid & 7) ^ ((drow >> 1) & 7);
    const unsigned ldsw = (unsigned)w * 1024u;
#define AT_DMA(buf, sub, kt) do { const int kt_ = (kt) < 0 ? 0 : (kt); LAS unsigned char* b_ = lds + (buf) * BUF_B; \
        __builtin_amdgcn_global_load_lds((const unsigned*)(Kp + (size_t)(64 * kt_ + drow) * ldk + 8 * dpc), (LAS unsigned*)(b_ + (sub) * KT_B + ldsw), 16, 0, 0); \
        _Pragma("unroll") for (int i_ = 0; i_ < (DV + 63) / 64; ++i_) { if (64 * i_ + 64 <= DV || w < 4) \
            __builtin_amdgcn_global_load_lds((const unsigned*)(Vt + (size_t)(drow + 64 * i_) * ldvt + 64 * kt_ + 8 * dpc), (LAS unsigned*)(b_ + 2 * KT_B + (sub) * VT_B + i_ * 8192 + ldsw), 16, 0, 0); } } while (0)
    const int ntile = kt_hi - kt_lo, nstep = (ntile + 1) >> 1;
    AT_DMA(0, 0, kt_hi - 1); AT_DMA(0, 1, kt_hi - 2);
    asm volatile("s_waitcnt vmcnt(0)" ::: "memory");
    __syncthreads();
    const int sw = (r >> 1) & 7;
    for (int st = 0; st < nstep; ++st) {
        const int buf = st & 1;
        if (st + 1 < nstep) { AT_DMA(buf ^ 1, 0, kt_hi - 3 - 2 * st); AT_DMA(buf ^ 1, 1, kt_hi - 4 - 2 * st); }
#pragma unroll
        for (int sub = 0; sub < 2; ++sub) {
        const int kt = kt_hi - 1 - 2 * st - sub, key0 = 64 * kt;
        bool skip;
        if (MODE == 0) skip = key0 > qw_last;
        else if (MODE == 1) skip = (key0 > qw_last) || !((orm >> (kt & 31)) & 1u) || (key0 + 63 < qw_first - dcut);
        else if (MODE == 2) skip = (key0 > qw_last) || (key0 + 63 < qw_first - 511);
        else skip = key0 >= nv_wmax;
        skip = skip || (kt < kt_lo);
        if (!skip) {
            const LAS unsigned char* kb = lds + buf * BUF_B + sub * KT_B; const LAS unsigned char* vb = lds + buf * BUF_B + 2 * KT_B + sub * VT_B;
            f32x16 S[2];
#pragma unroll
            for (int kk = 0; kk < 2; ++kk) {
                S[kk] = cb[kk];
#pragma unroll
                for (int ks = 0; ks < 4; ++ks) { const bf16x8 a = *(const LAS bf16x8*)(kb + (32 * kk + r) * 128 + (((2 * ks + hh) ^ sw) << 4));
                    S[kk] = __builtin_amdgcn_mfma_f32_32x32x16_bf16(a, qf[ks], S[kk], 0, 0, 0); }
            }
            const bool bnd = (MODE == 3) ? true : ((key0 + 63 > qw_first) || (MODE == 2 && key0 < qw_last - 511));
            if (bnd) {
                const int lim = (MODE == 3) ? (nv - key0 - 4 * hh) : (qrow - key0 - 4 * hh);
#pragma unroll
                for (int kk = 0; kk < 2; ++kk)
#pragma unroll
                    for (int i = 0; i < 16; ++i) { const int cki = 32 * kk + 8 * (i >> 2) + (i & 3);
                        bool valid;
                        if (MODE == 3) valid = cki < lim; else if (MODE == 2) valid = (cki <= lim) && (cki > lim - 512); else valid = cki <= lim;
                        S[kk][i] = valid ? S[kk][i] : NEGF; }
            }
            float mx = NEGF;
#pragma unroll
            for (int kk = 0; kk < 2; ++kk)
#pragma unroll
                for (int i = 0; i < 16; ++i) mx = fmaxf(mx, S[kk][i]);
            mx = fmaxf(mx, shx(mx, 32));
            const float off = (MODE == 3) ? 0.f : slope * (float)key0;
            mx += off;
            bool selok = true;
            if (MODE == 1) { selok = ((selm >> (kt & 31)) & 1u) != 0u; mx = selok ? mx : NEGF; }
            const float mnew = fmaxf(mrun, mx);
            const float meff = (mnew < -1e29f) ? 0.f : mnew;
            float c = (off - meff) * LOG2E;
            if (MODE == 1) c = selok ? c : NEGF;
#pragma unroll
            for (int kk = 0; kk < 2; ++kk) { f32x16 t = S[kk] * LOG2E + c;
#pragma unroll
                for (int i = 0; i < 16; ++i) t[i] = __builtin_amdgcn_exp2f(t[i]);
                S[kk] = t; }
            float ps;
            { typedef float f32x8 __attribute__((ext_vector_type(8)));
              const f32x16 su = S[0] + S[1];
              const f32x8 s8 = __builtin_shufflevector(su, su, 0, 1, 2, 3, 4, 5, 6, 7) + __builtin_shufflevector(su, su, 8, 9, 10, 11, 12, 13, 14, 15);
              const f32x4 s4 = __builtin_shufflevector(s8, s8, 0, 1, 2, 3) + __builtin_shufflevector(s8, s8, 4, 5, 6, 7);
              ps = (s4[0] + s4[1]) + (s4[2] + s4[3]); }
            if (__any(mnew > mrun)) {
                const float alpha = __builtin_amdgcn_exp2f((mrun - mnew) * LOG2E);
                lrun *= alpha;
#pragma unroll
                for (int rb = 0; rb < NRB; ++rb)
#pragma unroll
                    for (int i = 0; i < 16; ++i) O[rb][i] *= alpha;
            }
            mrun = mnew; lrun += ps;
#pragma unroll
            for (int kk = 0; kk < 2; ++kk)
#pragma unroll
                for (int s2 = 0; s2 < 2; ++s2) {
                    u32x4 pw; pw.x = pk2(S[kk][8 * s2 + 0], S[kk][8 * s2 + 1]); pw.y = pk2(S[kk][8 * s2 + 2], S[kk][8 * s2 + 3]);
                    pw.z = pk2(S[kk][8 * s2 + 4], S[kk][8 * s2 + 5]); pw.w = pk2(S[kk][8 * s2 + 6], S[kk][8 * s2 + 7]);
                    const bf16x8 pf = __builtin_bit_cast(bf16x8, pw);
#pragma unroll
                    for (int rb = 0; rb < NRB; ++rb) {
                        const bf16x8 a = *(const LAS bf16x8*)(vb + (32 * rb + r) * 128 + ((((2 * kk + s2) * 2 + hh) ^ sw) << 4));
                        O[rb] = __builtin_amdgcn_mfma_f32_32x32x16_bf16(a, pf, O[rb], 0, 0, 0);
                    }
                }
        }
        }
        asm volatile("s_waitcnt vmcnt(0)" ::: "memory");
        __syncthreads();
    }
#undef AT_DMA
    const float ltot = lrun + shx(lrun, 32);
    float inv = 1.0f / ltot;
    if (MODE == 3) inv = (nv > 0) ? inv : 0.f;
    const float gi = inv * gate;
#pragma unroll
    for (int rb = 0; rb < 2; ++rb) OB[rb] += O[rb] * gi;
    if (MODE == 3) {
#pragma unroll
        for (int g4 = 0; g4 < 4; ++g4)
            *(LAS f32x4*)(impp + (hr * 64 + 32 * qh + r) * 32 + 8 * g4 + 4 * hh) = (f32x4){O[2][4 * g4] * inv, O[2][4 * g4 + 1] * inv, O[2][4 * g4 + 2] * inv, O[2][4 * g4 + 3] * inv};
    }
}


struct Args { const float* in[26]; float* out; unsigned char* ws; int ph_lo, ph_hi; };
typedef const __attribute__((address_space(4))) Args* ArgsP;
DI ArgsP opaque_args() { auto p = __builtin_amdgcn_kernarg_segment_ptr(); asm volatile("" : "+s"(p)); return (ArgsP)p; }
enum { I_X = 0, I_P, I_N1G, I_N2G, I_EVWIN, I_EVWOUT, I_DAQN, I_DAKN, I_DALAM, I_DAOUTG, I_NSQN, I_NSKN, I_CMPPE, I_CMPW1, I_CMPW2, I_ODWIN, I_ODWOUT,
       I_RETG, I_ROUTW, I_ROUTB, I_WGU, I_BGU, I_WDN, I_BDN, I_PLEP, I_PLEG };

struct CvtJob { int in_idx, ldsrc, K, col0, ncols, dstrow0, perm, nmat; size_t src_stride, dst_off, dst_stride; int fp8, pad; };
constexpr int NJOBS = 19;
__constant__ CvtJob c_jobs[NJOBS] = {
    {I_EVWIN, EVIN, 1024, 0,    1024, 0,    1, 2, (size_t)1024 * EVIN, WS_EVNAT, (size_t)2048 * 1024, 0, 0},
    {I_EVWIN, EVIN, 1024, 1536, 512,  1024, 1, 2, (size_t)1024 * EVIN, WS_EVNAT, (size_t)2048 * 1024, 0, 0},
    {I_EVWIN, EVIN, 1024, 2048, 128,  1536, 1, 2, (size_t)1024 * EVIN, WS_EVNAT, (size_t)2048 * 1024, 0, 0},
    {I_EVWIN, EVIN, 1024, 2176, 128,  1664, 1, 2, (size_t)1024 * EVIN, WS_EVNAT, (size_t)2048 * 1024, 0, 0},
    {I_EVWIN, EVIN, 1024, 2304, 128,  1792, 1, 2, (size_t)1024 * EVIN, WS_EVNAT, (size_t)2048 * 1024, 0, 0},
    {I_EVWIN, EVIN, 1024, 2560, 128,  1920, 1, 2, (size_t)1024 * EVIN, WS_EVNAT, (size_t)2048 * 1024, 0, 0},
    {I_EVWIN, EVIN, 1024, 1024, 512,  0,    0, 2, (size_t)1024 * EVIN, WS_EVSW,  (size_t)768 * 1024, 0, 0},
    {I_EVWIN, EVIN, 1024, 2432, 128,  512,  0, 2, (size_t)1024 * EVIN, WS_EVSW,  (size_t)768 * 1024, 0, 0},
    {I_EVWIN, EVIN, 1024, 2688, 128,  640,  0, 2, (size_t)1024 * EVIN, WS_EVSW,  (size_t)768 * 1024, 0, 0},
    {I_EVWOUT, 1024, 1024, 0, 1024, 0, 0, 2, (size_t)1024 * 1024, WS_EVOUT, (size_t)1024 * 1024, 64, 0},
    {I_CMPW1, 256, 2048, 0, 256, 0, 0, 4, (size_t)2048 * 256, WS_CMP1, (size_t)256 * 2048, 0, 0},
    {I_ODWIN, ODIN, 1024, 0,    2048, 0,    0, 2, (size_t)1024 * ODIN, WS_ODNAT, (size_t)4096 * 1024, 32, 0},
    {I_ODWIN, ODIN, 1024, 4096, 2048, 2048, 0, 2, (size_t)1024 * ODIN, WS_ODNAT, (size_t)4096 * 1024, 32, 0},
    {I_ODWIN, ODIN, 1024, 2048, 2048, 0,    0, 2, (size_t)1024 * ODIN, WS_ODSW,  (size_t)2048 * 1024, 32, 0},
    {I_ODWOUT, 1024, 2048, 0, 1024, 0, 0, 2, (size_t)2048 * 1024, WS_ODOUT, (size_t)1024 * 2048, 128, 0},
    {I_WGU, 2048, 1024, 0, 2048, 0, 2, 128, (size_t)1024 * 2048, WS_WGU, (size_t)2048 * 1024, 32, 0},
    {I_WDN, 1024, 1024, 0, 1024, 0, 0, 128, (size_t)1024 * 1024, WS_WDN, (size_t)1024 * 1024, 64, 0},
    {I_PLEP, 1024, 256, 0, 1024, 0, 0, 4, (size_t)256 * 1024, WS_WPP, (size_t)1024 * 256, 0, 0},
    {I_PLEG, 1024, 1024, 0, 1024, 0, 0, 4, (size_t)1024 * 1024, WS_WPG, (size_t)1024 * 1024, 32, 0},
};
DI int cvt_dstrow(int perm, int L) {
    if (perm == 1) { const int pn = L >> 8, lc = L & 255; return pn * 256 + 128 * ((lc & 63) >> 5) + 32 * (lc >> 6) + (lc & 31); }
    if (perm == 2) { const int bj = L >> 10, cc = L & 1023; return 256 * (cc >> 7) + 128 * bj + (cc & 127); }
    return L;
}
DI void phase_prologue(const int WID, ArgsP a, LAS unsigned char* lds) {
    const int tid = opaque_tid(WID), lane = tid & 63, wv = tid >> 6;
    const int gw = blockIdx.x * 8 + wv, NGW = gridDim.x * 8;
    LAS float* scr = (LAS float*)(lds + wv * 16896);
    int total = 0;
    for (int j = 0; j < NJOBS; ++j) total += c_jobs[j].nmat * (c_jobs[j].K >> 6) * (c_jobs[j].ncols >> 6);
#define PRO_DECODE(IT, JJ, MAT, K0, N0, SRC, RS) do { int r_ = (IT), j_ = 0; \
        for (; j_ < NJOBS; ++j_) { const int n_ = c_jobs[j_].nmat * (c_jobs[j_].K >> 6) * (c_jobs[j_].ncols >> 6); if (r_ < n_) break; r_ -= n_; } \
        JJ = j_; const bool f8_ = c_jobs[j_].fp8 != 0; const int nkb_ = f8_ ? (c_jobs[j_].K >> 7) : (c_jobs[j_].K >> 6), nnb_ = f8_ ? (c_jobs[j_].ncols >> 5) : (c_jobs[j_].ncols >> 6), per_ = nkb_ * nnb_; \
        MAT = r_ / per_; const int rr_ = r_ % per_; K0 = (rr_ / nnb_) * (f8_ ? 128 : 64); N0 = (rr_ % nnb_) * (f8_ ? 32 : 64); const int ld_ = c_jobs[j_].ldsrc; \
        SRC = a->in[c_jobs[j_].in_idx] + (size_t)MAT * c_jobs[j_].src_stride + (size_t)K0 * ld_ + c_jobs[j_].col0 + N0 + (f8_ ? (lane & 31) + (lane >> 5) * ld_ : lane); RS = f8_ ? 2 * ld_ : ld_; } while (0)
    float tv[64];
    int jn = 0, matn = 0, k0n = 0, n0n = 0, rsn = 0; const float* srcn = nullptr;
    if (gw < total) { PRO_DECODE(gw, jn, matn, k0n, n0n, srcn, rsn);
#pragma unroll
        for (int i = 0; i < 64; ++i) tv[i] = srcn[(size_t)i * rsn]; }
    for (int it = gw; it < total; it += NGW) {
        const CvtJob J = c_jobs[jn]; const int mat = matn, k0 = k0n, n0 = n0n;
        { const int wb = J.fp8 ? (lane >> 5) * 33 + (lane & 31) : lane, wst = J.fp8 ? 66 : 65;
#pragma unroll
          for (int i = 0; i < 64; ++i) scr[wb + i * wst] = tv[i]; }
        if (it + NGW < total) { PRO_DECODE(it + NGW, jn, matn, k0n, n0n, srcn, rsn);
#if PROBE_PRO == 2
            { float sink = 0.f;
#pragma unroll
              for (int i = 0; i < 64; ++i) sink += ((const volatile float*)srcn)[(size_t)i * rsn];
              asm volatile("" :: "v"(sink)); }
#endif
#pragma unroll
            for (int i = 0; i < 64; ++i) tv[i] = srcn[(size_t)i * rsn]; }
        asm volatile("s_waitcnt lgkmcnt(0)" ::: "memory");
        if (J.fp8) {
            unsigned char* dst = (unsigned char*)(a->ws + J.dst_off) + (size_t)mat * J.dst_stride;
            const int c = lane & 7, nsub = lane >> 3; const float W8_S = (float)J.fp8;
#pragma unroll
            for (int jj = 0; jj < 4; ++jj) {
                const int n = nsub + 8 * jj; const LAS float* s = scr + (16 * c) * 33 + n;
                u32x4 o;
                o.x = pk4_fp8(s[0] * W8_S, s[33] * W8_S, s[2 * 33] * W8_S, s[3 * 33] * W8_S); o.y = pk4_fp8(s[4 * 33] * W8_S, s[5 * 33] * W8_S, s[6 * 33] * W8_S, s[7 * 33] * W8_S);
                o.z = pk4_fp8(s[8 * 33] * W8_S, s[9 * 33] * W8_S, s[10 * 33] * W8_S, s[11 * 33] * W8_S); o.w = pk4_fp8(s[12 * 33] * W8_S, s[13 * 33] * W8_S, s[14 * 33] * W8_S, s[15 * 33] * W8_S);
                const int drow = cvt_dstrow(J.perm, J.dstrow0 + n0 + n);
                *(u32x4*)(dst + (size_t)drow * J.K + k0 + 16 * c) = o;
#if PROBE_PRO == 1
                asm volatile("" ::: "memory"); *(u32x4*)(dst + (size_t)drow * J.K + k0 + 16 * c) = o;
#endif
            }
        } else {
            bf16_t* dst = (bf16_t*)(a->ws + J.dst_off) + (size_t)mat * J.dst_stride;
            const int c = lane & 7, nsub = lane >> 3;
#pragma unroll
            for (int jj = 0; jj < 8; ++jj) {
                const int n = nsub + 8 * jj; const LAS float* s = scr + (8 * c) * 65 + n;
                u32x4 o; o.x = pk2(s[0], s[65]); o.y = pk2(s[2 * 65], s[3 * 65]); o.z = pk2(s[4 * 65], s[5 * 65]); o.w = pk2(s[6 * 65], s[7 * 65]);
                const int drow = cvt_dstrow(J.perm, J.dstrow0 + n0 + n);
                *(u32x4*)(dst + (size_t)drow * J.K + k0 + 8 * c) = o;
#if PROBE_PRO == 1
                asm volatile("" ::: "memory"); *(u32x4*)(dst + (size_t)drow * J.K + k0 + 8 * c) = o;
#endif
            }
        }
        asm volatile("s_waitcnt lgkmcnt(0)" ::: "memory");
    }
#undef PRO_DECODE
    {
        const float* p = a->in[I_P]; bf16_t* pb = (bf16_t*)(a->ws + WS_PBF);
        const size_t n8 = (size_t)DEPTH * T * 256 / 8;
        for (size_t i = (size_t)blockIdx.x * 512 + tid; i < n8; i += (size_t)gridDim.x * 512) {
            const f32x4 v0 = *(const f32x4*)(p + i * 8), v1 = *(const f32x4*)(p + i * 8 + 4);
            *(u32x4*)(pb + i * 8) = pack8(v0, v1);
        }
    }
    if (blockIdx.x == 4 && tid < 512) { const int ev = tid >> 8, gi = (tid >> 6) & 3, d = tid & 63;
        const float* src = a->in[gi == 0 ? I_DAQN : gi == 1 ? I_DAKN : gi == 2 ? I_NSQN : I_NSKN];
        ((float*)(a->ws + WS_GAINS))[tid] = src[ev * 64 + d]; }
    if (blockIdx.x < 4 && tid < 256) {
        const int m = blockIdx.x; const float* pe = a->in[I_CMPPE] + (size_t)m * 2048; const float* w1 = a->in[I_CMPW1] + (size_t)m * 2048 * 256;
        float s = 0.f;
        for (int k = 0; k < 2048; ++k) s += pe[k] * w1[(size_t)k * 256 + tid];
        ((float*)(a->ws + WS_BIAS1))[m * 256 + tid] = s;
    }
}

DI float row_load_ss(const float* row, int lane, f32x4 (&v)[4]) {
    float ss = 0.f;
#pragma unroll
    for (int j = 0; j < 4; ++j) { v[j] = *(const f32x4*)(row + 4 * lane + 256 * j); ss += (v[j][0] * v[j][0] + v[j][1] * v[j][1]) + (v[j][2] * v[j][2] + v[j][3] * v[j][3]); }
    return wave_sum(ss);
}
DI void row_store_bf16(bf16_t* row, int lane, const f32x4 (&v)[4]) {
#pragma unroll
    for (int j = 0; j < 4; ++j) { u32x2 o; o.x = pk2(v[j][0], v[j][1]); o.y = pk2(v[j][2], v[j][3]); *(u32x2*)(row + 4 * lane + 256 * j) = o; }
}
template <int MODE>
DI void phase_norm(const int WID, ArgsP a, LAS unsigned char* lds, int layer, const void* Hin, const bool hb) {
    const int tid = opaque_tid(WID), lane = tid & 63, wv = __builtin_amdgcn_readfirstlane(tid >> 6);
    LAS float* wt = (LAS float*)lds;
    LAS int* bcl = (LAS int*)(lds + MISC_OFF + MO_WCNT); LAS int* ent = (LAS int*)(lds + MISC_OFF + MO_ENT); LAS float* gat = (LAS float*)(lds + MISC_OFF + MO_GAT);
    LAS float* lgb = (LAS float*)(lds + MISC_OFF + MO_RED);
    bf16_t* XN = (bf16_t*)(a->ws + WS_XN);
    const float* gain = a->in[MODE == 2 ? I_N2G : I_N1G] + layer * 1024;
    constexpr int NQ = MODE == 0 ? 24 : (MODE == 2 ? 32 : 0);
    if (NQ > 0) {
        const float* w = (MODE == 0) ? a->in[I_EVWIN] + (size_t)(layer >> 1) * 1024 * EVIN + 2816 : a->in[I_ROUTW] + (size_t)layer * 1024 * 32;
        const int ldw = (MODE == 0) ? EVIN : 32;
        for (int i = tid; i < 256 * 32; i += 512) { const int q = i & 31, g = i >> 5;
            if (q < NQ) { f32x4 v; v[0] = w[(size_t)(4 * g) * ldw + q]; v[1] = w[(size_t)(4 * g + 1) * ldw + q]; v[2] = w[(size_t)(4 * g + 2) * ldw + q]; v[3] = w[(size_t)(4 * g + 3) * ldw + q];
                *(LAS f32x4*)(wt + q * 1024 + 4 * (g ^ q)) = v; } }
    }
    f32x4 gn[4];
#pragma unroll
    for (int j = 0; j < 4; ++j) gn[j] = *(const f32x4*)(gain + 4 * lane + 256 * j);
    const float rbias = (MODE == 2) ? a->in[I_ROUTB][layer * 32 + (lane & 31)] : 0.f;
    __syncthreads();
    for (int vb = blockIdx.x; vb < NTB; vb += gridDim.x) {
        if (MODE == 2) { if (tid < 32) bcl[tid] = 0; }
        const int t0 = vb * 128 + wv * 16;
        f32x4 na[4], nb[4];
#pragma unroll
        for (int j = 0; j < 4; ++j) { na[j] = ld_h4(Hin, hb, (size_t)t0 * 1024 + 4 * lane + 256 * j); nb[j] = ld_h4(Hin, hb, (size_t)(t0 + 1) * 1024 + 4 * lane + 256 * j); }
#pragma unroll 1
        for (int it = 0; it < 8; ++it) {
            const int ta = t0 + 2 * it;
            f32x4 va[4], vc[4];
#pragma unroll
            for (int j = 0; j < 4; ++j) { va[j] = na[j]; vc[j] = nb[j]; }
            if (it < 7) {
#pragma unroll
                for (int j = 0; j < 4; ++j) { na[j] = ld_h4(Hin, hb, (size_t)(ta + 2) * 1024 + 4 * lane + 256 * j); nb[j] = ld_h4(Hin, hb, (size_t)(ta + 3) * 1024 + 4 * lane + 256 * j); }
            }
            float sa = 0.f, sb = 0.f;
#pragma unroll
            for (int j = 0; j < 4; ++j) { sa += (va[j][0] * va[j][0] + va[j][1] * va[j][1]) + (va[j][2] * va[j][2] + va[j][3] * va[j][3]); sb += (vc[j][0] * vc[j][0] + vc[j][1] * vc[j][1]) + (vc[j][2] * vc[j][2] + vc[j][3] * vc[j][3]); }
#pragma unroll
            for (int o = 1; o < 64; o <<= 1) { sa += shxl(sa, o, lane); sb += shxl(sb, o, lane); }
            const float ra = rsqrtf(sa * (1.0f / 1024.0f) + EPS), rb2 = rsqrtf(sb * (1.0f / 1024.0f) + EPS);
#pragma unroll
            for (int j = 0; j < 4; ++j) { va[j] = va[j] * ra * gn[j]; vc[j] = vc[j] * rb2 * gn[j]; }
            if (MODE == 1) {
                unsigned char* X8 = (unsigned char*)XN;
#pragma unroll
                for (int j = 0; j < 4; ++j) { *(unsigned*)(X8 + (size_t)ta * 1024 + 4 * lane + 256 * j) = pk4_fp8(va[j][0], va[j][1], va[j][2], va[j][3]);
                    *(unsigned*)(X8 + (size_t)(ta + 1) * 1024 + 4 * lane + 256 * j) = pk4_fp8(vc[j][0], vc[j][1], vc[j][2], vc[j][3]); }
            } else { row_store_bf16(XN + (size_t)ta * 1024, lane, va); row_store_bf16(XN + (size_t)(ta + 1) * 1024, lane, vc); }
            if (NQ > 0) {
                float x[64];
#pragma unroll
                for (int q = 0; q < 32; ++q) {
                    if (q < NQ) { f32x4 a0 = {0.f, 0.f, 0.f, 0.f}, a1 = a0;
#pragma unroll
                        for (int j = 0; j < 4; ++j) { const f32x4 ww = *(const LAS f32x4*)(wt + q * 1024 + 4 * ((lane + 64 * j) ^ q)); a0 += va[j] * ww; a1 += vc[j] * ww; }
                        x[q] = (a0[0] + a0[1]) + (a0[2] + a0[3]); x[32 + q] = (a1[0] + a1[1]) + (a1[2] + a1[3]);
                        if ((q & 3) == 3) asm volatile("" ::: "memory");
                    } else { x[q] = 0.f; x[32 + q] = 0.f; }
                }
#define RS_STEP(N, BIT) _Pragma("unroll") for (int i = 0; i < (N); ++i) { const bool up = (lane & (BIT)) != 0; const float keep = up ? x[(N) + i] : x[i], send = up ? x[i] : x[(N) + i]; x[i] = keep + shxl(send, (BIT), lane); }
                RS_STEP(32, 32) RS_STEP(16, 16) RS_STEP(8, 8) RS_STEP(4, 4) RS_STEP(2, 2) RS_STEP(1, 1)
#undef RS_STEP
                const float val = x[0];
                if (MODE == 0) { if ((lane & 31) < 24) ((float*)(a->ws + WS_GATES))[(size_t)(ta + (lane >> 5)) * 24 + (lane & 31)] = sigm(val); }
                if (MODE == 2) {
                    const float myv = val + rbias; const int mye = lane & 31;
                    lgb[wv * 64 + lane] = myv;
                    asm volatile("s_waitcnt lgkmcnt(0)" ::: "memory");
                    int rank = 0;
#pragma unroll
                    for (int q4 = 0; q4 < 8; ++q4) { const f32x4 t4 = *(const LAS f32x4*)(lgb + wv * 64 + (lane & 32) + 4 * q4);
#pragma unroll
                        for (int e = 0; e < 4; ++e) { const int j = 4 * q4 + e; rank += ((t4[e] > myv) || (t4[e] == myv && j < mye)) ? 1 : 0; } }
                    const int eb = wv * 64 + (2 * it + (lane >> 5)) * 4;
                    if (rank < 4) { ent[eb + rank] = mye; gat[eb + rank] = myv; }
                    asm volatile("s_waitcnt lgkmcnt(0)" ::: "memory");
                    const f32x4 tv = *(const LAS f32x4*)(gat + eb);
                    const float sum = 1.0f + __expf(tv[1] - tv[0]) + __expf(tv[2] - tv[0]) + __expf(tv[3] - tv[0]);
                    asm volatile("s_waitcnt lgkmcnt(0)" ::: "memory");
                    if (rank < 4) gat[eb + rank] = __expf(myv - tv[0]) / sum;
                    asm volatile("s_waitcnt lgkmcnt(0)" ::: "memory");
                }
            }
        }
        if (MODE == 2) {
            __syncthreads();
            { const int e = ent[wv * 64 + lane];
              const int pos = __hip_atomic_fetch_add(bcl + e, 1, __ATOMIC_RELAXED, __HIP_MEMORY_SCOPE_WORKGROUP);
              const size_t idx = (size_t)(vb * 128 + wv * 16) * 4 + lane;
              ((int*)(a->ws + WS_TOPE))[idx] = e; ((int*)(a->ws + WS_POSB))[idx] = pos; ((float*)(a->ws + WS_GATEW))[idx] = gat[wv * 64 + lane]; }
            __syncthreads();
            if (tid < 32) ((int*)(a->ws + WS_BCNT))[((size_t)layer * NTB + vb) * 32 + tid] = bcl[tid];
            __syncthreads();
        }
    }
}
template <int MODE>
DI void phase_norm_mm(const int WID, ArgsP a, LAS unsigned char* lds, int layer, const void* Hin, const bool hb) {
    const int tid = opaque_tid(WID), lane = tid & 63, wv = __builtin_amdgcn_readfirstlane(tid >> 6);
    const int r = lane & 15, kg = lane >> 4;
    LAS float* lgb = (LAS float*)(lds + 131072);
    LAS float* gl = (LAS float*)(lds + MISC_OFF + MO_RED);
    LAS int* bcl = (LAS int*)(lds + MISC_OFF + MO_WCNT); LAS int* ent = (LAS int*)(lds + MISC_OFF + MO_ENT); LAS float* gat = (LAS float*)(lds + MISC_OFF + MO_GAT);
    bf16_t* XN = (bf16_t*)(a->ws + WS_XN);
    const float* gain = a->in[MODE == 2 ? I_N2G : I_N1G] + layer * 1024;
    constexpr int NQ = MODE == 0 ? 24 : 32;
    {
        const float* w = (MODE == 0) ? a->in[I_EVWIN] + (size_t)(layer >> 1) * 1024 * EVIN + 2816 : a->in[I_ROUTW] + (size_t)layer * 1024 * 32;
        const int ldw = (MODE == 0) ? EVIN : 32;
#pragma unroll 2
        for (int i = tid; i < 4096; i += 512) { const int q = i & 31, c = i >> 5; const int qq = q < NQ ? q : NQ - 1;
            const f32x4 g0 = *(const f32x4*)(gain + 8 * c), g1 = *(const f32x4*)(gain + 8 * c + 4);
            const float* wp = w + (size_t)(8 * c) * ldw + qq;
            f32x4 v0, v1;
#pragma unroll
            for (int e = 0; e < 4; ++e) { v0[e] = wp[(size_t)e * ldw]; v1[e] = wp[(size_t)(4 + e) * ldw]; }
            v0 = v0 * g0; v1 = v1 * g1;
            if (q >= NQ) { v0 = (f32x4){0.f, 0.f, 0.f, 0.f}; v1 = v0; }
            const u32x4 hi = pack8(v0, v1);
            const f32x4 r0 = {v0[0] - bflo(hi.x), v0[1] - bfhi(hi.x), v0[2] - bflo(hi.y), v0[3] - bfhi(hi.y)};
            const f32x4 r1 = {v1[0] - bflo(hi.z), v1[1] - bfhi(hi.z), v1[2] - bflo(hi.w), v1[3] - bfhi(hi.w)};
            const int off = q * 2048 + ((c ^ (q & 15)) << 4);
            *(LAS u32x4*)(lds + off) = hi; *(LAS u32x4*)(lds + 65536 + off) = pack8(r0, r1); }
        if (tid < 256) *(LAS f32x4*)(gl + 4 * tid) = *(const f32x4*)(gain + 4 * tid);
    }
    f32x4 rb0 = {0.f, 0.f, 0.f, 0.f}, rb1 = rb0;
    if (MODE == 2) { rb0 = *(const f32x4*)(a->in[I_ROUTB] + layer * 32 + 4 * kg); rb1 = *(const f32x4*)(a->in[I_ROUTB] + layer * 32 + 16 + 4 * kg); }
    __syncthreads();
    for (int vb = blockIdx.x; vb < NTB; vb += gridDim.x) {
        if (MODE == 2) { if (tid < 32) bcl[tid] = 0; }
        const int t0 = vb * 128 + wv * 16;
        u32x4 hp[16][2];
        if (hb) { const bf16_t* src = (const bf16_t*)Hin + (size_t)(t0 + r) * 1024 + 16 * kg;
#pragma unroll
            for (int S = 0; S < 16; ++S) { hp[S][0] = *(const u32x4*)(src + 64 * S); hp[S][1] = *(const u32x4*)(src + 64 * S + 8); }
        } else { const float* src = (const float*)Hin + (size_t)(t0 + r) * 1024 + 16 * kg;
#pragma unroll
            for (int S = 0; S < 16; ++S) { const f32x4 x0 = *(const f32x4*)(src + 64 * S), x1 = *(const f32x4*)(src + 64 * S + 4), x2 = *(const f32x4*)(src + 64 * S + 8), x3 = *(const f32x4*)(src + 64 * S + 12);
                hp[S][0] = pack8(x0, x1); hp[S][1] = pack8(x2, x3); }
        }
        f32x4 acc0 = {0.f, 0.f, 0.f, 0.f}, acc1 = acc0;
        float ss = 0.f;
        const int ob = r * 2048;
#pragma unroll
        for (int S = 0; S < 16; ++S) {
#pragma unroll
            for (int hf = 0; hf < 2; ++hf) {
                const u32x4 hv = hp[S][hf];
#pragma unroll
                for (int e = 0; e < 4; ++e) { const float lo = bflo(hv[e]), hi = bfhi(hv[e]); ss = fmaf(lo, lo, ss); ss = fmaf(hi, hi, ss); }
                const bf16x8 hf8 = __builtin_bit_cast(bf16x8, hv);
                const int off = ob + (S >> 1) * 256 + ((((S & 1) * 8 + 2 * kg + hf) ^ r) << 4);
                acc0 = __builtin_amdgcn_mfma_f32_16x16x32_bf16(*(const LAS bf16x8*)(lds + off), hf8, acc0, 0, 0, 0);
                acc0 = __builtin_amdgcn_mfma_f32_16x16x32_bf16(*(const LAS bf16x8*)(lds + 65536 + off), hf8, acc0, 0, 0, 0);
                acc1 = __builtin_amdgcn_mfma_f32_16x16x32_bf16(*(const LAS bf16x8*)(lds + 32768 + off), hf8, acc1, 0, 0, 0);
                acc1 = __builtin_amdgcn_mfma_f32_16x16x32_bf16(*(const LAS bf16x8*)(lds + 98304 + off), hf8, acc1, 0, 0, 0);
            }
            asm volatile("" ::: "memory");
        }
        ss += shxl(ss, 16, lane); ss += shxl(ss, 32, lane);
        const float rs = rsqrtf(ss * (1.0f / 1024.0f) + EPS);
        { bf16_t* dst = XN + (size_t)(t0 + r) * 1024 + 16 * kg;
#pragma unroll
          for (int S = 0; S < 16; ++S) {
#pragma unroll
              for (int hf = 0; hf < 2; ++hf) { u32x4 hv = hp[S][hf];
                  asm volatile("" : "+v"(hv));
                  const f32x4 g0 = *(const LAS f32x4*)(gl + 64 * S + 16 * kg + 8 * hf), g1 = *(const LAS f32x4*)(gl + 64 * S + 16 * kg + 8 * hf + 4);
                  const f32x4 x0 = (f32x4){bflo(hv.x), bfhi(hv.x), bflo(hv.y), bfhi(hv.y)} * rs * g0, x1 = (f32x4){bflo(hv.z), bfhi(hv.z), bflo(hv.w), bfhi(hv.w)} * rs * g1;
                  if (MODE == 2) *(u32x2*)((unsigned char*)XN + (size_t)(t0 + r) * 1024 + 64 * S + 16 * kg + 8 * hf) = pack8_fp8(x0, x1);
                  else *(u32x4*)(dst + 64 * S + 8 * hf) = pack8(x0, x1); }
              asm volatile("" ::: "memory"); } }
        const f32x4 v0 = acc0 * rs + rb0, v1 = acc1 * rs + rb1;
        if (MODE == 0) { float* G = (float*)(a->ws + WS_GATES) + (size_t)(t0 + r) * 24;
            *(f32x4*)(G + 4 * kg) = (f32x4){sigm(v0[0]), sigm(v0[1]), sigm(v0[2]), sigm(v0[3])};
            if (kg < 2) *(f32x4*)(G + 16 + 4 * kg) = (f32x4){sigm(v1[0]), sigm(v1[1]), sigm(v1[2]), sigm(v1[3])}; }
        if (MODE == 2) {
#pragma unroll 1
            for (int h = 0; h < 2; ++h) {
                if ((r >> 3) == h) { *(LAS f32x4*)(lgb + wv * 256 + (r & 7) * 32 + 4 * kg) = v0; *(LAS f32x4*)(lgb + wv * 256 + (r & 7) * 32 + 16 + 4 * kg) = v1; }
                asm volatile("s_waitcnt lgkmcnt(0)" ::: "memory");
#pragma unroll 1
                for (int it = 4 * h; it < 4 * h + 4; ++it) {
                    const int mye = lane & 31;
                    const LAS float* lrow = lgb + wv * 256 + ((2 * it + (lane >> 5)) & 7) * 32;
                    const float myv = lrow[mye];
                    int rank = 0;
#pragma unroll
                    for (int q4 = 0; q4 < 8; ++q4) { const f32x4 t4 = *(const LAS f32x4*)(lrow + 4 * q4);
#pragma unroll
                        for (int e = 0; e < 4; ++e) { const int j = 4 * q4 + e; rank += ((t4[e] > myv) || (t4[e] == myv && j < mye)) ? 1 : 0; } }
                    const int eb = wv * 64 + (2 * it + (lane >> 5)) * 4;
                    if (rank < 4) { ent[eb + rank] = mye; gat[eb + rank] = myv; }
                    asm volatile("s_waitcnt lgkmcnt(0)" ::: "memory");
                    const f32x4 tv = *(const LAS f32x4*)(gat + eb);
                    const float sum = 1.0f + __expf(tv[1] - tv[0]) + __expf(tv[2] - tv[0]) + __expf(tv[3] - tv[0]);
                    asm volatile("s_waitcnt lgkmcnt(0)" ::: "memory");
                    if (rank < 4) gat[eb + rank] = __expf(myv - tv[0]) / sum;
                    asm volatile("s_waitcnt lgkmcnt(0)" ::: "memory");
                }
            }
            __syncthreads();
            { const int e = ent[wv * 64 + lane];
              const int pos = __hip_atomic_fetch_add(bcl + e, 1, __ATOMIC_RELAXED, __HIP_MEMORY_SCOPE_WORKGROUP);
              const size_t idx = (size_t)(vb * 128 + wv * 16) * 4 + lane;
              ((int*)(a->ws + WS_TOPE))[idx] = e; ((int*)(a->ws + WS_POSB))[idx] = pos; ((float*)(a->ws + WS_GATEW))[idx] = gat[wv * 64 + lane]; }
            __syncthreads();
            if (tid < 32) ((int*)(a->ws + WS_BCNT))[((size_t)layer * NTB + vb) * 32 + tid] = bcl[tid];
            __syncthreads();
        }
    }
}
DI void moe_tables(const int WID, ArgsP a, LAS unsigned char* lds, int layer, int vb) {
    const int tid = opaque_tid(WID);
    LAS int* tot = (LAS int*)(lds + MISC_OFF + MO_TOT); LAS int* base = (LAS int*)(lds + MISC_OFF + MO_BASE); LAS int* ts = (LAS int*)(lds + MISC_OFF + MO_TS);
    LAS int* red = (LAS int*)(lds + MISC_OFF + MO_RED);
    const int* bc = (const int*)(a->ws + WS_BCNT) + (size_t)layer * NTB * 32;
    { const int e = tid & 31, part = tid >> 5; int st = 0, sp = 0;
      for (int blk = part; blk < NTB; blk += 16) { const int v = bc[blk * 32 + e]; st += v; sp += (blk < vb) ? v : 0; }
      red[part * 32 + e] = st; red[512 + part * 32 + e] = sp; }
    __syncthreads();
    if (tid < 32) { int st = 0, sp = 0;
#pragma unroll
        for (int p = 0; p < 16; ++p) { st += red[p * 32 + tid]; sp += red[512 + p * 32 + tid]; }
        tot[tid] = st; base[tid] = sp; }
    __syncthreads();
    if (tid == 0) { int acc = 0; for (int e = 0; e < 32; ++e) { ts[e] = acc; acc += (tot[e] + 255) >> 8; } ts[32] = acc; }
    __syncthreads();
}
DI void phase_moe_slots(const int WID, ArgsP a, LAS unsigned char* lds, int layer) {
    const int tid = opaque_tid(WID);
    LAS int* base = (LAS int*)(lds + MISC_OFF + MO_BASE); LAS int* ts = (LAS int*)(lds + MISC_OFF + MO_TS); LAS int* tot = (LAS int*)(lds + MISC_OFF + MO_TOT);
    int* TOK = (int*)(a->ws + WS_TOK);
    for (int vb = blockIdx.x; vb < NTB; vb += gridDim.x) {
        moe_tables(WID, a, lds, layer, vb);
        { const int t = vb * 128 + (tid >> 2);
          const int e = ((const int*)(a->ws + WS_TOPE))[(size_t)vb * 512 + tid], pos = ((const int*)(a->ws + WS_POSB))[(size_t)vb * 512 + tid];
          const int dest = ts[e] * 256 + base[e] + pos; ((int*)(a->ws + WS_DEST))[(size_t)vb * 512 + tid] = dest; TOK[dest] = t; }
        if (vb < 32) { const int e = vb, lo = ts[e] * 256 + tot[e], hi = ts[e + 1] * 256;
            for (int i = lo + tid; i < hi; i += 512) TOK[i] = 0; }
        __syncthreads();
    }
}
DI void phase_combine(const int WID, ArgsP a, bf16_t* H) {
    const int tid = opaque_tid(WID), lane = tid & 63, wv = tid >> 6;
    const bf16_t* YB = (const bf16_t*)(a->ws + WS_YB); unsigned char* XN8 = (unsigned char*)(a->ws + WS_XN);
    const int G8 = gridDim.x * 8;
    const int* DEST = (const int*)(a->ws + WS_DEST); const float* GW = (const float*)(a->ws + WS_GATEW);
    int t = blockIdx.x * 8 + wv;
    int dA = 0, dB = 0; float gA = 0.f, gB = 0.f;
    if (lane < 4) { if (t < T) { dA = DEST[(size_t)t * 4 + lane]; gA = GW[(size_t)t * 4 + lane]; } if (t + G8 < T) { dB = DEST[(size_t)(t + G8) * 4 + lane]; gB = GW[(size_t)(t + G8) * 4 + lane]; } }
    for (; t < T; t += 2 * G8) {
        const int tA = t, tB = (t + G8 < T) ? t + G8 : t;
        const int cdA = dA, cdB = (t + G8 < T) ? dB : dA; const float cgA = gA, cgB = (t + G8 < T) ? gB : gA;
        u32x2 hA[4], hB[4], yA[4][4], yB[4][4];
#pragma unroll
        for (int j = 0; j < 4; ++j) { hA[j] = *(const u32x2*)(H + (size_t)tA * 1024 + 4 * lane + 256 * j); hB[j] = *(const u32x2*)(H + (size_t)tB * 1024 + 4 * lane + 256 * j); }
#pragma unroll
        for (int k = 0; k < 4; ++k) { const bf16_t* y = YB + (size_t)__builtin_amdgcn_readlane(cdA, k) * 1024 + 4 * lane;
#pragma unroll
            for (int j = 0; j < 4; ++j) yA[k][j] = *(const u32x2*)(y + 256 * j); }
#pragma unroll
        for (int k = 0; k < 4; ++k) { const bf16_t* y = YB + (size_t)__builtin_amdgcn_readlane(cdB, k) * 1024 + 4 * lane;
#pragma unroll
            for (int j = 0; j < 4; ++j) yB[k][j] = *(const u32x2*)(y + 256 * j); }
        { const int tn = t + 2 * G8;
          if (lane < 4) { if (tn < T) { dA = DEST[(size_t)tn * 4 + lane]; gA = GW[(size_t)tn * 4 + lane]; } if (tn + G8 < T) { dB = DEST[(size_t)(tn + G8) * 4 + lane]; gB = GW[(size_t)(tn + G8) * 4 + lane]; } } }
        asm volatile("" ::: "memory");
#pragma unroll
        for (int rr = 0; rr < 2; ++rr) {
            const int tt = rr ? tB : tA; const float cg = rr ? cgB : cgA;
            f32x4 v[4];
#pragma unroll
            for (int j = 0; j < 4; ++j) { const u32x2 w = rr ? hB[j] : hA[j]; v[j] = (f32x4){bflo(w.x), bfhi(w.x), bflo(w.y), bfhi(w.y)}; }
#pragma unroll
            for (int k = 0; k < 4; ++k) { const float g = __builtin_bit_cast(float, __builtin_amdgcn_readlane(__builtin_bit_cast(int, cg), k));
#pragma unroll
                for (int j = 0; j < 4; ++j) { const u32x2 w = rr ? yB[k][j] : yA[k][j]; v[j][0] += g * bflo(w.x); v[j][1] += g * bfhi(w.x); v[j][2] += g * bflo(w.y); v[j][3] += g * bfhi(w.y); } }
            float ss = 0.f;
#pragma unroll
            for (int j = 0; j < 4; ++j) { u32x2 hw; hw.x = pk2(v[j][0], v[j][1]); hw.y = pk2(v[j][2], v[j][3]); *(u32x2*)(H + (size_t)tt * 1024 + 4 * lane + 256 * j) = hw; ss += (v[j][0] * v[j][0] + v[j][1] * v[j][1]) + (v[j][2] * v[j][2] + v[j][3] * v[j][3]); }
#pragma unroll
            for (int o = 1; o < 64; o <<= 1) ss += shxl(ss, o, lane);
            const float rstd = rsqrtf(ss * (1.0f / 1024.0f) + EPS);
#pragma unroll
            for (int j = 0; j < 4; ++j) v[j] = v[j] * rstd;
#pragma unroll
            for (int j = 0; j < 4; ++j) *(unsigned*)(XN8 + (size_t)tt * 1024 + 4 * lane + 256 * j) = pk4_fp8(v[j][0], v[j][1], v[j][2], v[j][3]);
        }
    }
}
DI void phase_cmp2(const int WID, ArgsP a, LAS unsigned char* lds, int ev) {
    const int tid = opaque_tid(WID), lane = tid & 63, wv = __builtin_amdgcn_readfirstlane(tid >> 6);
    const bf16_t* HID = (const bf16_t*)(a->ws + WS_HID); bf16_t* KCMP = (bf16_t*)(a->ws + WS_KCMP); bf16_t* VCMPT = (bf16_t*)(a->ws + WS_VCMPT);
    const float kg = a->in[I_NSKN][ev * 64 + lane];
    LAS float* wl = (LAS float*)lds;
    for (int i = tid; i < 2 * 256 * 64 / 4; i += 512) *(LAS f32x4*)(wl + 4 * i) = *(const f32x4*)(a->in[I_CMPW2] + (size_t)ev * 2 * 256 * 64 + 4 * i);
    __syncthreads();
    for (int gi = blockIdx.x * 8 + wv; gi < 2048; gi += gridDim.x * 8) {
        const int kv = gi >> 10, row0 = (gi & 1023) * 4;
        const bf16_t* hrow = HID + ((size_t)kv * 4096 + row0) * 256;
        const LAS float* w2 = wl + kv * 256 * 64 + lane;
        float s[4] = {0.f, 0.f, 0.f, 0.f};
#pragma unroll 2
        for (int k = 0; k < 256; k += 8) {
            u32x4 hw[4];
#pragma unroll
            for (int r = 0; r < 4; ++r) hw[r] = *(const u32x4*)(hrow + r * 256 + k);
            float wv8[8];
#pragma unroll
            for (int j = 0; j < 8; ++j) wv8[j] = w2[(k + j) * 64];
#pragma unroll
            for (int r = 0; r < 4; ++r)
                s[r] += bflo(hw[r].x) * wv8[0] + bfhi(hw[r].x) * wv8[1] + bflo(hw[r].y) * wv8[2] + bfhi(hw[r].y) * wv8[3] + bflo(hw[r].z) * wv8[4] + bfhi(hw[r].z) * wv8[5] + bflo(hw[r].w) * wv8[6] + bfhi(hw[r].w) * wv8[7];
        }
#pragma unroll
        for (int r = 0; r < 4; ++r) {
            const int row = row0 + r, bg = row >> 7, n = row & 127;
            float v = (n == 127) ? 0.f : s[r];
            if (kv == 0) { const float ss = wave_sum(v * v); const float o = v * rsqrtf(ss * (1.0f / 64.0f) + EPS) * kg;
                KCMP[((size_t)bg * 128 + n) * 64 + lane] = (bf16_t)(pk2(o, 0.f) & 0xffffu); }
            else VCMPT[((size_t)bg * 96 + lane) * 128 + vperm16(n)] = (bf16_t)(pk2(v, 0.f) & 0xffffu);
        }
    }
    for (int i = blockIdx.x * 512 + tid; i < 32 * 32 * 128; i += gridDim.x * 512) {
        const int n = i & 127, j = (i >> 7) & 31, bg = i >> 12;
        float o = 0.f;
        if (n < 127) { const int d = n - 4 * j; if (d >= 0 && d <= 2) o = 1.0f; else if (d == 3 || d == -1) o = 0.5f; }
        VCMPT[((size_t)bg * 96 + 64 + j) * 128 + vperm16(n)] = (bf16_t)(pk2(o, 0.f) & 0xffffu);
    }
}
DI void topk_one(const float* IMPH, unsigned* SELM, int t, int g) {
    const int b = t >> 11, s = t & 2047, cur = s >> 6;
    unsigned mask;
    if (cur < 16) mask = (2u << cur) - 1u;
    else {
        float sc[32];
#pragma unroll
        for (int j4 = 0; j4 < 8; ++j4) { f32x4 acc = {0.f, 0.f, 0.f, 0.f};
#pragma unroll
            for (int r = 0; r < 4; ++r) acc += *(const f32x4*)(IMPH + ((size_t)t * 8 + g * 4 + r) * 32 + 4 * j4);
#pragma unroll
            for (int q = 0; q < 4; ++q) sc[4 * j4 + q] = acc[q]; }
#pragma unroll
        for (int j = 0; j < 32; ++j) { const bool forced = (j == 0) || (j == cur) || (j == cur - 1); sc[j] = (j > cur) ? NEGF : (sc[j] + (forced ? 1e4f : 0.f)); }
        mask = 0u;
#pragma unroll
        for (int j = 0; j < 32; ++j) { int rank = 0;
#pragma unroll
            for (int k = 0; k < 32; ++k) rank += ((sc[k] > sc[j]) || (sc[k] == sc[j] && k < j)) ? 1 : 0;
            mask |= (rank < 16) ? (1u << j) : 0u; }
    }
    SELM[((size_t)(b * 2 + g)) * 2048 + s] = mask;
}
DI void phase_topk(const int WID, ArgsP a) {
    for (int i = blockIdx.x * 512 + opaque_tid(WID); i < T * 2; i += gridDim.x * 512) topk_one((const float*)(a->ws + WS_IMPH), (unsigned*)(a->ws + WS_SELM), i >> 1, i & 1);
}
DI void phase_cmp_topk(const int WID, ArgsP a, LAS unsigned char* lds) {
    const bf16_t* QN = (const bf16_t*)(a->ws + WS_QN);
    float* IMPH = (float*)(a->ws + WS_IMPH);
    for (int u = blockIdx.x; u < 256; u += gridDim.x) {
        const int qb = 7 - (u >> 5), bg = u & 31, b = bg >> 1, g = bg & 1, q0 = qb * 256; const size_t t0 = (size_t)b * 2048 + q0;
#pragma unroll 1
        for (int r = 0; r < 4; ++r) { const int hd = g * 4 + r;
            attn_unit<96, 3>(WID, lds, QN + t0 * 512 + hd * 64, 512, (const bf16_t*)(a->ws + WS_KCMP) + (size_t)bg * 128 * 64, 64,
                             (const bf16_t*)(a->ws + WS_VCMPT) + (size_t)bg * 96 * 128, 128, q0, 0.f, 0, nullptr,
                             (bf16_t*)(a->ws + WS_OC) + t0 * 512 + hd * 64, 512, IMPH + (t0 * 8 + hd) * 32); }
        asm volatile("s_waitcnt vmcnt(0)" ::: "memory");
        __syncthreads();
        { const int tid = opaque_tid(WID); if (tid < 256) topk_one(IMPH, (unsigned*)(a->ws + WS_SELM), (int)t0 + tid, g); }
        __syncthreads();
    }
}
DI void phase_mixprep(const int WID, ArgsP a, int layer) {
    const int tid = opaque_tid(WID), lane = tid & 63, wv = tid >> 6, ev = layer >> 1;
    const float* dl = a->in[I_DALAM] + ev * 256;
    const float s1 = wave_sum(dl[lane] * dl[64 + lane]), s2 = wave_sum(dl[128 + lane] * dl[192 + lane]);
    const float lam_init = 0.8f - 0.6f * expf(-0.3f * (float)layer);
    const float lam = expf(s1) - expf(s2) + lam_init;
    const float* og = a->in[I_DAOUTG] + ev * 128;
    const bf16_t* OD = (const bf16_t*)(a->ws + WS_OD); const bf16_t* OC = (const bf16_t*)(a->ws + WS_OC); const bf16_t* OS = (const bf16_t*)(a->ws + WS_OS); const bf16_t* OW = (const bf16_t*)(a->ws + WS_OW);
    const float* GT = (const float*)(a->ws + WS_GATES); unsigned char* AMIX = (unsigned char*)(a->ws + WS_AMIX);
    const int h = lane >> 4, dv = (lane & 15) * 8;
    f32x4 g0 = *(const f32x4*)(og + dv), g1 = *(const f32x4*)(og + dv + 4);
    for (int t = blockIdx.x * 8 + wv; t < T; t += gridDim.x * 8) {
        { const u32x4 w1 = *(const u32x4*)(OD + (size_t)t * 1024 + h * 128 + dv), w2 = *(const u32x4*)(OD + (size_t)t * 1024 + (4 + h) * 128 + dv);
          f32x4 d0, d1;
          d0[0] = bflo(w1.x) - lam * bflo(w2.x); d0[1] = bfhi(w1.x) - lam * bfhi(w2.x); d0[2] = bflo(w1.y) - lam * bflo(w2.y); d0[3] = bfhi(w1.y) - lam * bfhi(w2.y);
          d1[0] = bflo(w1.z) - lam * bflo(w2.z); d1[1] = bfhi(w1.z) - lam * bfhi(w2.z); d1[2] = bflo(w1.w) - lam * bflo(w2.w); d1[3] = bfhi(w1.w) - lam * bfhi(w2.w);
          float ss = (d0[0] * d0[0] + d0[1] * d0[1]) + (d0[2] * d0[2] + d0[3] * d0[3]) + (d1[0] * d1[0] + d1[1] * d1[1]) + (d1[2] * d1[2] + d1[3] * d1[3]);
          ss += shx(ss, 1); ss += shx(ss, 2); ss += shx(ss, 4); ss += shx(ss, 8);
          const float rs = rsqrtf(ss * (1.0f / 128.0f) + EPS) * (1.0f - lam_init);
          *(u32x2*)(AMIX + (size_t)t * 1024 + h * 128 + dv) = pack8_fp8(d0 * (rs * A_SC) * g0, d1 * (rs * A_SC) * g1); }
    }
}
DI void phase_scan(const int WID, ArgsP a) {
    const bf16_t* UT = (const bf16_t*)(a->ws + WS_UT); bf16_t* VS = (bf16_t*)(a->ws + WS_VS);
    for (int i = blockIdx.x * 512 + opaque_tid(WID); i < 64 * 512 * 32; i += gridDim.x * 512) {
        const int d8 = i & 31, f = (i >> 5) & 511, bh = i >> 14, h = bh & 3;
        const float dec = exp2f(256.0f * ret_lg2(h));
        f32x4 S0 = {0.f, 0.f, 0.f, 0.f}, S1 = S0;
        u32x4 un = *(const u32x4*)(UT + ((size_t)bh * 8) * 131072 + (size_t)f * 256 + 8 * d8);
#pragma unroll 1
        for (int n = 0; n < 8; ++n) {
            const size_t z = (size_t)bh * 8 + n;
            const u32x4 u = un;
            if (n < 7) un = *(const u32x4*)(UT + (z + 1) * 131072 + (size_t)f * 256 + 8 * d8);
            *(u32x4*)(VS + (z * 512 + f) * 512 + 256 + 8 * d8) = pack8(S0, S1);
            S0[0] = (S0[0] + bflo(u.x)) * dec; S0[1] = (S0[1] + bfhi(u.x)) * dec; S0[2] = (S0[2] + bflo(u.y)) * dec; S0[3] = (S0[3] + bfhi(u.y)) * dec;
            S1[0] = (S1[0] + bflo(u.z)) * dec; S1[1] = (S1[1] + bfhi(u.z)) * dec; S1[2] = (S1[2] + bflo(u.w)) * dec; S1[3] = (S1[3] + bfhi(u.w)) * dec;
        }
    }
}
DI void phase_normgate(const int WID, ArgsP a, int od) {
    const int tid = opaque_tid(WID), lane = tid & 63, wv = tid >> 6;
    const bf16_t* Y = (const bf16_t*)(a->ws + WS_Y); const bf16_t* GG = (const bf16_t*)(a->ws + WS_GG); unsigned char* YG = (unsigned char*)(a->ws + WS_YG);
    const float* og = a->in[I_RETG] + od * 512;
    const f32x4 g0 = *(const f32x4*)(og + 8 * lane), g1 = *(const f32x4*)(og + 8 * lane + 4);
    for (int t = blockIdx.x * 8 + wv; t < T; t += gridDim.x * 8) {
#pragma unroll
        for (int h = 0; h < 4; ++h) {
            const size_t o = (size_t)t * 2048 + h * 512 + 8 * lane;
            const u32x4 yw = *(const u32x4*)(Y + o), gw = *(const u32x4*)(GG + o);
            f32x4 y0 = {bflo(yw.x), bfhi(yw.x), bflo(yw.y), bfhi(yw.y)}, y1 = {bflo(yw.z), bfhi(yw.z), bflo(yw.w), bfhi(yw.w)};
            const f32x4 q0 = {bflo(gw.x), bfhi(gw.x), bflo(gw.y), bfhi(gw.y)}, q1 = {bflo(gw.z), bfhi(gw.z), bflo(gw.w), bfhi(gw.w)};
            float ss = (y0[0] * y0[0] + y0[1] * y0[1]) + (y0[2] * y0[2] + y0[3] * y0[3]) + (y1[0] * y1[0] + y1[1] * y1[1]) + (y1[2] * y1[2] + y1[3] * y1[3]);
            ss = wave_sum(ss);
            const float rs = rsqrtf(ss * (1.0f / 512.0f) + EPS);
            *(u32x2*)(YG + o) = pack8_fp8(y0 * (rs * A_SC) * g0 * q0, y1 * (rs * A_SC) * g1 * q1);
        }
    }
}
DI int snake_unit(int rnd, int G, int c) { return (rnd & 1) ? rnd * G + (G - 1 - c) : rnd * G + c; }
DI float absmax64(const float* g, int lane) { float m = fabsf(g[lane]);
#pragma unroll
    for (int o = 1; o < 64; o <<= 1) m = fmaxf(m, shx(m, o));
    return m; }
constexpr int CW_AQ = 8192;
template <int MODE>
DI void phase_attn(const int WID, ArgsP a, LAS unsigned char* lds, int ev) {
    const int tid = opaque_tid(WID), lane = tid & 63;
    const bf16_t* QD = (const bf16_t*)(a->ws + WS_QD); const bf16_t* KD = (const bf16_t*)(a->ws + WS_KD); const bf16_t* QN = (const bf16_t*)(a->ws + WS_QN);
    LAS int* ord = (LAS int*)(lds + MISC_OFF + MO_ENT); LAS int* cst = (LAS int*)(lds + MISC_OFF + MO_GAT); volatile LAS int* cur = (volatile LAS int*)(lds + MISC_OFF + MO_TOT);
    float sb2 = 0.f;
    if (MODE != 3) { const float gq = absmax64(a->in[MODE == 0 ? I_DAQN : I_NSQN] + ev * 64, lane), gk = absmax64(a->in[MODE == 0 ? I_DAKN : I_NSKN] + ev * 64, lane);
        sb2 = 16.0f * gq * gk + 28.0f; }
    if (tid < 64) { const int qb = tid >> 3, hd = tid & 7, q0 = qb * 256; int lo = 0, hi = 4 * qb + 4;
        if (MODE == 3) { lo = 0; hi = 2; }
        else { const float slope = (MODE == 0) ? exp2f(-2.0f * (float)((hd & 3) + 1)) : exp2f(-(float)(hd + 1)); const int dcut = (int)fminf(sb2 / slope + 1.0f, 100000.0f);
            const int kmin = q0 - dcut; lo = kmin > 0 ? (kmin >> 6) : 0;
            if (MODE == 2) { const int lk = q0 - 511; const int lw = lk > 0 ? (lk >> 6) : 0; lo = lw > lo ? lw : lo; } }
        cst[tid] = hi - lo; }
    __syncthreads();
    if (tid < 64) { const int mine = cst[tid]; int rank = 0;
        for (int j = 0; j < 64; ++j) { const int o = cst[j]; rank += (o > mine || (o == mine && j < tid)) ? 1 : 0; }
        ord[rank] = tid; }
    __syncthreads();
    unsigned* ctr = (unsigned*)(a->ws + WS_CTL) + CW_AQ + 64 * 8 * (ev * 4 + MODE);
    const int x0 = (int)(xb_xcc_id() & 7u);
    volatile LAS int* stl = (volatile LAS int*)(lds + MISC_OFF + MO_BASE);
    bool own = true; int nst = 0;
    for (;;) {
        if (tid < 64) {
            int uu_ = -1;
            if (own) { int v = 128; if (lane == 0) v = (int)__hip_atomic_fetch_add(ctr + 64 * x0, 1u, __ATOMIC_RELAXED, __HIP_MEMORY_SCOPE_AGENT);
                v = __builtin_amdgcn_readfirstlane(v); if (v < 128) uu_ = x0 * 128 + v; else own = false; }
            if (!own && uu_ < 0) {
                if (nst == 0) { int v = 128; const int xq_ = (x0 + lane) & 7;
                    if (lane >= 1 && lane < 8) v = (int)__hip_atomic_fetch_add(ctr + 64 * xq_, 1u, __ATOMIC_RELAXED, __HIP_MEMORY_SCOPE_AGENT);
                    const unsigned long long got = __ballot(v < 128); nst = __popcll(got);
                    if (v < 128) stl[__popcll(got & ((1ull << lane) - 1ull))] = xq_ * 128 + v;
                    asm volatile("s_waitcnt lgkmcnt(0)" ::: "memory"); }
                if (nst > 0) { --nst; uu_ = stl[nst]; }
            }
            if (lane == 0) *cur = uu_;
        }
        __syncthreads();
        const int uu = *cur; if (uu < 0) break;
        const int xq = uu >> 7, v = uu & 127, combo = ord[v >> 1], jb = v & 1, qb = combo >> 3, hd = combo & 7, q0 = qb * 256;
        const int b = (MODE == 0) ? (((xq - 2 * (hd & 3)) & 7) + 8 * jb) : (((xq - 4 * (hd >> 2)) & 7) + 8 * jb);
        const size_t t0 = (size_t)b * 2048 + q0;
        if (MODE == 0) {
            const float slope = exp2f(-2.0f * (float)((hd & 3) + 1)); const int dcut = (int)fminf(sb2 / slope + 1.0f, 100000.0f);
            attn_unit<128, 0>(WID, lds, QD + t0 * 512 + hd * 64, 512, KD + (size_t)b * 2048 * 512 + hd * 64, 512,
                              (const bf16_t*)(a->ws + WS_VAT) + (size_t)(b * 4 + (hd & 3)) * 128 * 2048, 2048, q0, slope, dcut, nullptr,
                              (bf16_t*)(a->ws + WS_OD) + t0 * 1024 + hd * 128, 1024, nullptr);
        } else if (MODE == 1 || MODE == 2) {
            const int g = hd >> 2; const float slope = exp2f(-(float)(hd + 1)); const int dcut = (int)fminf(sb2 / slope + 1.0f, 100000.0f);
            const bf16_t* Kb = (const bf16_t*)(a->ws + (MODE == 1 ? WS_KSB : WS_KWB)) + (size_t)(b * 2 + g) * 2048 * 64;
            const bf16_t* Vb = (const bf16_t*)(a->ws + (MODE == 1 ? WS_VST : WS_VWT)) + (size_t)(b * 2 + g) * 64 * 2048;
            attn_unit<64, MODE>(WID, lds, QN + t0 * 512 + hd * 64, 512, Kb, 64, Vb, 2048, q0, slope, dcut,
                                (const unsigned*)(a->ws + WS_SELM) + (size_t)(b * 2 + g) * 2048 + q0,
                                (bf16_t*)(a->ws + (MODE == 1 ? WS_OS : WS_OW)) + t0 * 512 + hd * 64, 512, nullptr);
        } else {
            const int g = hd >> 2;
            attn_unit<96, 3>(WID, lds, QN + t0 * 512 + hd * 64, 512, (const bf16_t*)(a->ws + WS_KCMP) + (size_t)(b * 2 + g) * 128 * 64, 64,
                             (const bf16_t*)(a->ws + WS_VCMPT) + (size_t)(b * 2 + g) * 96 * 128, 128, q0, 0.f, 0, nullptr,
                             (bf16_t*)(a->ws + WS_OC) + t0 * 512 + hd * 64, 512, (float*)(a->ws + WS_IMPH) + (t0 * 8 + hd) * 32);
        }
    }
}

DI void phase_diff(const int WID, ArgsP a, LAS unsigned char* lds, int layer) {
    const int tid = opaque_tid(WID), lane = tid & 63, ev = layer >> 1;
    LAS int* ord = (LAS int*)(lds + MISC_OFF + MO_ENT); LAS int* cst = (LAS int*)(lds + MISC_OFF + MO_GAT); volatile LAS int* cur = (volatile LAS int*)(lds + MISC_OFF + MO_TOT);
    const float gq = absmax64(a->in[I_DAQN] + ev * 64, lane), gk = absmax64(a->in[I_DAKN] + ev * 64, lane);
    const float sb2 = 16.0f * gq * gk + 28.0f;
    const float* dl = a->in[I_DALAM] + ev * 256;
    const float s1 = wave_sum(dl[lane] * dl[64 + lane]), s2 = wave_sum(dl[128 + lane] * dl[192 + lane]);
    const float lam_init = 0.8f - 0.6f * expf(-0.3f * (float)layer);
    const float lam = expf(s1) - expf(s2) + lam_init;
    if (tid < 32) { const int qb = tid >> 2, h = tid & 3, q0 = qb * 256; const float slope = exp2f(-2.0f * (float)(h + 1)); const int dcut = (int)fminf(sb2 / slope + 1.0f, 100000.0f);
        const int kmin = q0 - dcut; const int lo = kmin > 0 ? (kmin >> 6) : 0; cst[tid] = 4 * qb + 4 - lo; }
    __syncthreads();
    if (tid < 32) { const int mine = cst[tid]; int rank = 0;
        for (int j = 0; j < 32; ++j) { const int o = cst[j]; rank += (o > mine || (o == mine && j < tid)) ? 1 : 0; }
        ord[rank] = tid; }
    __syncthreads();
    unsigned* ctr = (unsigned*)(a->ws + WS_CTL) + CW_AQ + 64 * 8 * (ev * 4 + 0);
    const bf16_t* QD = (const bf16_t*)(a->ws + WS_QD); const bf16_t* KD = (const bf16_t*)(a->ws + WS_KD);
    for (;;) {
        if (tid == 0) *cur = (int)__hip_atomic_fetch_add(ctr, 1u, __ATOMIC_RELAXED, __HIP_MEMORY_SCOPE_AGENT);
        __syncthreads();
        const int u = *cur; if (u >= 512) break;
        const int combo = ord[u >> 4], b = u & 15, qb = combo >> 2, h = combo & 3, q0 = qb * 256; const size_t t0 = (size_t)b * 2048 + q0;
        const float slope = exp2f(-2.0f * (float)(h + 1)); const int dcut = (int)fminf(sb2 / slope + 1.0f, 100000.0f);
        diff_unit(WID, lds, QD + t0 * 512 + h * 64, QD + t0 * 512 + (4 + h) * 64, KD + (size_t)b * 2048 * 512 + h * 64, KD + (size_t)b * 2048 * 512 + (4 + h) * 64,
                  (const bf16_t*)(a->ws + WS_VAT) + (size_t)(b * 4 + h) * 128 * 2048, q0, slope, dcut, lam, 1.0f - lam_init, a->in[I_DAOUTG] + ev * 128,
                  (unsigned char*)(a->ws + WS_AMIX) + t0 * 1024 + h * 128);
    }
}
DI void phase_nsa(const int WID, ArgsP a, LAS unsigned char* lds, int ev) {
    const int tid = opaque_tid(WID), lane = tid & 63, w = __builtin_amdgcn_readfirstlane(tid >> 6), r = lane & 31, hh = lane >> 5, hr = w >> 1, qh = w & 1;
    volatile LAS int* cur = (volatile LAS int*)(lds + MISC_OFF + MO_TOT);
    LAS float* impl = (LAS float*)(lds + 98304);
    LAS float* scs = (LAS float*)(lds + 131072);
    LAS unsigned* selml = (LAS unsigned*)(lds + MISC_OFF + MO_RED);
    const float gq = absmax64(a->in[I_NSQN] + ev * 64, lane), gk = absmax64(a->in[I_NSKN] + ev * 64, lane);
    const float sb2 = 16.0f * gq * gk + 28.0f;
    unsigned* ctr = (unsigned*)(a->ws + WS_CTL) + CW_AQ + 64 * 8 * (ev * 4 + 1);
    const bf16_t* QN = (const bf16_t*)(a->ws + WS_QN);
    for (;;) {
        if (tid == 0) *cur = (int)__hip_atomic_fetch_add(ctr, 1u, __ATOMIC_RELAXED, __HIP_MEMORY_SCOPE_AGENT);
        __syncthreads();
        const int u = *cur; if (u >= 1024) break;
        const int qb = 31 - (u >> 5), bg = u & 31, b = bg >> 1, g = bg & 1, q0 = qb * 64; const size_t t0 = (size_t)b * 2048 + q0;
        bf16x8 qf[4];
        { const bf16_t* Qw = QN + (t0 + 32 * qh + r) * 512 + (4 * g + hr) * 64;
#pragma unroll
          for (int ks = 0; ks < 4; ++ks) qf[ks] = *(const bf16x8*)(Qw + 16 * ks + 8 * hh); }
        const float* gp = (const float*)(a->ws + WS_GATES) + (t0 + 32 * qh + r) * 24 + (4 * g + hr) * 3;
        const float gate_c = gp[0], gate_s = gp[1], gate_w = gp[2];
        f32x16 OB[2];
#pragma unroll
        for (int rb = 0; rb < 2; ++rb)
#pragma unroll
            for (int i = 0; i < 16; ++i) OB[rb][i] = 0.f;
        nsa_unit<96, 3>(WID, lds, qf, (const bf16_t*)(a->ws + WS_KCMP) + (size_t)bg * 128 * 64, 64, (const bf16_t*)(a->ws + WS_VCMPT) + (size_t)bg * 96 * 128, 128, q0, g, sb2,
                        nullptr, OB, gate_c, impl);
        asm volatile("s_waitcnt lgkmcnt(0)" ::: "memory");
        __syncthreads();
        { const int qq = tid >> 3, pq = tid & 7;
          if (qb < 16) { if (pq == 0) selml[qq] = (2u << qb) - 1u; }
          else { f32x4 acc = {0.f, 0.f, 0.f, 0.f};
#pragma unroll
              for (int h2 = 0; h2 < 4; ++h2) acc += *(const LAS f32x4*)(impl + (h2 * 64 + qq) * 32 + 4 * pq);
#pragma unroll
              for (int e = 0; e < 4; ++e) { const int j = 4 * pq + e; const bool forced = (j == 0) || (j == qb) || (j == qb - 1); acc[e] = (j > qb) ? NEGF : (acc[e] + (forced ? 1e4f : 0.f)); }
              *(LAS f32x4*)(scs + qq * 32 + 4 * pq) = acc; }
          asm volatile("s_waitcnt lgkmcnt(0)" ::: "memory");
          __syncthreads();
          if (qb >= 16) { const f32x4 my = *(const LAS f32x4*)(scs + qq * 32 + 4 * pq); int rk[4] = {0, 0, 0, 0};
#pragma unroll
              for (int k4 = 0; k4 < 8; ++k4) { const f32x4 o4 = *(const LAS f32x4*)(scs + qq * 32 + 4 * k4);
#pragma unroll
                  for (int kk = 0; kk < 4; ++kk) { const int k = 4 * k4 + kk;
#pragma unroll
                      for (int e = 0; e < 4; ++e) { const int j = 4 * pq + e; rk[e] += ((o4[kk] > my[e]) || (o4[kk] == my[e] && k < j)) ? 1 : 0; } } }
              unsigned bits = 0u;
#pragma unroll
              for (int e = 0; e < 4; ++e) bits |= (rk[e] < 16) ? (1u << (4 * pq + e)) : 0u;
              bits |= shxu(bits, 1); bits |= shxu(bits, 2); bits |= shxu(bits, 4);
              if (pq == 0) selml[qq] = bits; }
          asm volatile("s_waitcnt lgkmcnt(0)" ::: "memory");
          __syncthreads(); }
        nsa_unit<64, 1>(WID, lds, qf, (const bf16_t*)(a->ws + WS_KSB) + (size_t)bg * 2048 * 64, 64, (const bf16_t*)(a->ws + WS_VST) + (size_t)bg * 64 * 2048, 2048, q0, g, sb2,
                        selml, OB, gate_s, nullptr);
        { const bf16_t* ow = (const bf16_t*)(a->ws + WS_OW) + (t0 + 32 * qh + r) * 512 + (4 * g + hr) * 64;
          unsigned char* am = (unsigned char*)(a->ws + WS_AMIX) + (t0 + 32 * qh + r) * 1024 + 512 + (4 * g + hr) * 64;
#pragma unroll
          for (int rb = 0; rb < 2; ++rb)
#pragma unroll
              for (int g4 = 0; g4 < 4; ++g4) { const int dv = 32 * rb + 8 * g4 + 4 * hh; const u32x2 wv = *(const u32x2*)(ow + dv);
                  const float o0 = OB[rb][4 * g4] + gate_w * bflo(wv.x), o1 = OB[rb][4 * g4 + 1] + gate_w * bfhi(wv.x), o2 = OB[rb][4 * g4 + 2] + gate_w * bflo(wv.y), o3 = OB[rb][4 * g4 + 3] + gate_w * bfhi(wv.y);
                  *(unsigned*)(am + dv) = pk4_fp8(o0 * A_SC, o1 * A_SC, o2 * A_SC, o3 * A_SC); } }
    }
}

constexpr int PPL = 15;
constexpr int NPHASE = 1 + DEPTH * PPL;
__global__ void __launch_bounds__(512, 2) mk_fwd(Args a_unused) {
    ArgsP a = opaque_args();
    extern __shared__ __attribute__((aligned(16))) unsigned char lds_raw[];
    LAS unsigned char* lds = (LAS unsigned char*)lds_raw;
    const int tid = threadIdx.x, G = gridDim.x, c = blockIdx.x;
    const int WID = __builtin_amdgcn_readfirstlane(tid >> 6);
    volatile LAS unsigned* misc = (volatile LAS unsigned*)(lds + MISC_OFF);
    if (tid < 4) misc[tid] = 0u;
    __syncthreads();
    unsigned* ctl = (unsigned*)(a->ws + WS_CTL);
    XcdBarrier bar; bar.bar = ctl + CW_BAR; bar.x = 0; bar.st = misc;
    const int ph_lo = a->ph_lo, ph_hi = a->ph_hi;
    const bool multi = (ph_hi - ph_lo) > 1;
    if (multi) bar = xcd_barrier_post(WID, ctl + CW_BAR, misc);
    bool first = true;
#define PHASE_BEGIN(k, id) if ((DBG_ONLY < 0 || DBG_ONLY == (id)) && (k) >= ph_lo && (k) < ph_hi && (k) <= DBG_LAST_PHASE) { if (!first) { xcd_barrier(WID, bar); if (PROBE_MASK >> 31) xcd_barrier(WID, bar); } first = false; \
        ArgsP a = opaque_args(); unsigned char* ws = a->ws; bf16_t* XN = (bf16_t*)(ws + WS_XN); bf16_t* H = (bf16_t*)(ws + WS_HB); const bool hb = layer != 0; const void* Hin = hb ? (const void*)H : (const void*)a->in[I_X]; \
        const LAS int* ts = (const LAS int*)(lds + MISC_OFF + MO_TS); (void)XN; (void)H; (void)Hin; (void)ts; (void)hb; \
        const bool probe_ = ((PROBE_MASK >> (id)) & 1u) != 0u; const unsigned long long pt0_ = probe_ ? __builtin_amdgcn_s_memrealtime() : 0ull;
#define PHASE_END if (probe_) { const unsigned long long pt1_ = __builtin_amdgcn_s_memrealtime(), pd_ = pt1_ - pt0_; while (__builtin_amdgcn_s_memrealtime() - pt1_ < pd_) __builtin_amdgcn_s_sleep(8); } }
    { const int layer = 0; PHASE_BEGIN(0, 0) phase_prologue(WID, a, lds); PHASE_END }
#pragma unroll 1
    for (int layer = 0; layer < DEPTH; ++layer) {
        const int pb = 1 + layer * PPL; const bool even = (layer & 1) == 0; const int ev = layer >> 1, od = layer >> 1;
        if (even) {
            PHASE_BEGIN(pb + 0, 1) phase_norm_mm<0>(WID, a, lds, layer, Hin, hb); PHASE_END
            PHASE_BEGIN(pb + 1, 2) {
                { ProbPlain P{XN, (const bf16_t*)(ws + WS_EVNAT) + (size_t)ev * 2048 * 1024, 1024, 1024, 1024}; pg8::Sched S; S.init(T / 256, 8, G, c);
                  EpiEvNat E{ws, (const float*)(ws + WS_GAINS) + ev * 256};
                  pg8::gemm_phase(WID, lds, P, S, E); }
                { ProbPlain P{(const bf16_t*)(ws + WS_EVSW) + (size_t)ev * 768 * 1024, XN, 1024, 1024, 1024}; pg8::Sched S; S.init(3, T / 256, G, c);
                  EpiEvSw E{ws};
                  pg8::gemm_phase(WID, lds, P, S, E); }
            } PHASE_END
            PHASE_BEGIN(pb + 2, 3) {
                { ProbCmp1 P{(const bf16_t*)(ws + WS_KCB), (const bf16_t*)(ws + WS_VCB), (const bf16_t*)(ws + WS_CMP1) + (size_t)ev * 2 * 256 * 2048, 1024, 2048, 2048}; pg8::Sched S; S.init(32, 1, G, c);
                  EpiCmp1 E{(bf16_t*)(ws + WS_HID), (const float*)(ws + WS_BIAS1) + ev * 512};
                  pg8::gemm_phase(WID, lds, P, S, E); }
                phase_diff(WID, a, lds, layer);
                phase_attn<2>(WID, a, lds, ev);
            } PHASE_END
            PHASE_BEGIN(pb + 3, 4) phase_cmp2(WID, a, lds, ev); PHASE_END
            PHASE_BEGIN(pb + 4, 5) phase_nsa(WID, a, lds, ev); PHASE_END
            PHASE_BEGIN(pb + 8, 9) {
                ProbPlain8 P{(const unsigned char*)(ws + WS_AMIX), (const unsigned char*)(ws + WS_EVOUT) + (size_t)ev * 1024 * 1024, 512, 512, 512}; pg8::Sched S; S.init(T / 256, 4, G, c);
                EpiResid E{Hin, H, hb, 1.0f / (A_SC * 64.0f)}; pg8::gemm_phase(WID, lds, P, S, E);
            } PHASE_END
        } else {
            PHASE_BEGIN(pb + 0, 11) phase_norm<1>(WID, a, lds, layer, Hin, hb); PHASE_END
            PHASE_BEGIN(pb + 1, 12) {
                { ProbPlain8 P{(const unsigned char*)XN, (const unsigned char*)(ws + WS_ODNAT) + (size_t)od * 4096 * 1024, 512, 512, 512}; pg8::Sched S; S.init(T / 256, 16, G, c);
                  EpiOdNat E{ws}; pg8::gemm_phase(WID, lds, P, S, E); }
                { ProbPlain8 P{(const unsigned char*)(ws + WS_ODSW) + (size_t)od * 2048 * 1024, (const unsigned char*)XN, 512, 512, 512}; pg8::Sched S; S.init(8, T / 256, G, c);
                  EpiOdSw E{ws}; pg8::gemm_phase(WID, lds, P, S, E); }
            } PHASE_END
            PHASE_BEGIN(pb + 2, 13) {
                { ProbUT P{(const bf16_t*)(ws + WS_VS), (const bf16_t*)(ws + WS_KT), 512, 256, 256}; SchedSeq S; S.init(G, c);
                  EpiUTScan E{(bf16_t*)(ws + WS_VS)}; pg8::gemm_phase(WID, lds, P, S, E); }
                { ProbAtt P{(const bf16_t*)(ws + WS_AQ), (const bf16_t*)(ws + WS_KP), 2048, 1024, 256}; pg8::Sched S; const int nb = G / 2 > 0 ? G / 2 : 1;
                  if (c >= nb || G < 2) S.init(512, 1, G < 2 ? 1 : G - nb, G < 2 ? 0 : c - nb); else S.init(0, 1, 1, 0);
                  EpiAtt E{(bf16_t*)(ws + WS_AQ)}; pg8::gemm_phase(WID, lds, P, S, E); }
            } PHASE_END
            PHASE_BEGIN(pb + 4, 15) {
                ProbY P{(const bf16_t*)(ws + WS_AQ), (const bf16_t*)(ws + WS_VS), 2048, 512, 512}; pg8::Sched S; S.init(512, 2, G, c);
                EpiY E{(bf16_t*)(ws + WS_Y)}; pg8::gemm_phase(WID, lds, P, S, E);
            } PHASE_END
            PHASE_BEGIN(pb + 5, 16) phase_normgate(WID, a, od); PHASE_END
            PHASE_BEGIN(pb + 8, 19) {
                ProbPlain8 P{(const unsigned char*)(ws + WS_YG), (const unsigned char*)(ws + WS_ODOUT) + (size_t)od * 1024 * 2048, 1024, 1024, 1024}; pg8::Sched S; S.init(T / 256, 4, G, c);
                EpiResid E{Hin, H, hb, 1.0f / (A_SC * 128.0f)}; pg8::gemm_phase(WID, lds, P, S, E);
            } PHASE_END
        }
        PHASE_BEGIN(pb + 9, 20) phase_norm_mm<2>(WID, a, lds, layer, H, true); PHASE_END
        PHASE_BEGIN(pb + 10, 21) phase_moe_slots(WID, a, lds, layer); PHASE_END
        PHASE_BEGIN(pb + 11, 22) {
            moe_tables(WID, a, lds, layer, -1);
            { ProbMoe8G P{(const unsigned char*)(ws + WS_XN), (const unsigned char*)(ws + WS_WGU) + (size_t)layer * 32 * 2048 * 1024, ts, (const int*)(ws + WS_TOK), 2048, 512, 512, 512}; pg8::Sched S; S.init(ts[32], 8, G, c);
              EpiGU E{(unsigned char*)(ws + WS_ACT), a->in[I_BGU] + (size_t)layer * 32 * 2048, ts}; pg8::gemm_phase(WID, lds, P, S, E); }
            { ProbPlain P{(const bf16_t*)(ws + WS_PBF) + (size_t)layer * T * 256, (const bf16_t*)(ws + WS_WPP) + (size_t)layer * 1024 * 256, 256, 256, 256}; pg8::Sched S; S.init(T / 256, 4, G, c);
              EpiPP E{(bf16_t*)(ws + WS_PP)}; pg8::gemm_phase(WID, lds, P, S, E); }
        } PHASE_END
        PHASE_BEGIN(pb + 12, 23) {
            moe_tables(WID, a, lds, layer, -1);
            ProbMoe8 P{(const unsigned char*)(ws + WS_ACT), (const unsigned char*)(ws + WS_WDN) + (size_t)layer * 32 * 1024 * 1024, ts, 1024, 512, 512, 512}; pg8::Sched S; S.init(ts[32], 4, G, c);
            EpiDN E{(bf16_t*)(ws + WS_YB), a->in[I_BDN] + (size_t)layer * 32 * 1024, ts}; pg8::gemm_phase(WID, lds, P, S, E);
        } PHASE_END
        PHASE_BEGIN(pb + 13, 24) phase_combine(WID, a, H); PHASE_END
        PHASE_BEGIN(pb + 14, 25) {
            ProbPlain8 P{(const unsigned char*)(ws + WS_XN), (const unsigned char*)(ws + WS_WPG) + (size_t)layer * 1024 * 1024, 512, 512, 512}; pg8::Sched S; S.init(T / 256, 4, G, c);
            EpiPLE E{H, (const bf16_t*)(ws + WS_PP), (layer == DEPTH - 1) ? a->out : nullptr}; pg8::gemm_phase(WID, lds, P, S, E);
        } PHASE_END
    }
#undef PHASE_BEGIN
#undef PHASE_END
}

extern "C" void kernel_launch(void* const* d_in, const int* in_sizes, int n_in, void* d_out, int out_size, void* d_ws, size_t ws_size, hipStream_t stream) {
    static int grid = 0;
    if (grid == 0) {
        if (n_in != 26 || out_size != T * D || ws_size < WS_END) { fprintf(stderr, "kernel_launch: unexpected problem (n_in %d, out %d, ws %zu < %zu); nothing launched\n", n_in, out_size, ws_size, (size_t)WS_END); grid = -1; return; }
        int dev = 0, cus = 0, per_cu = 0;
        if (hipGetDevice(&dev) != hipSuccess || hipDeviceGetAttribute(&cus, hipDeviceAttributeMultiprocessorCount, dev) != hipSuccess) { grid = -1; return; }
        if (hipFuncSetAttribute((const void*)mk_fwd, hipFuncAttributeMaxDynamicSharedMemorySize, LDS_BYTES) != hipSuccess) { fprintf(stderr, "kernel_launch: hipFuncSetAttribute failed\n"); grid = -1; return; }
        if (hipOccupancyMaxActiveBlocksPerMultiprocessor(&per_cu, (const void*)mk_fwd, 512, LDS_BYTES) != hipSuccess || per_cu < 1) fprintf(stderr, "kernel_launch: occupancy query reports %d\n", per_cu);
        (void)hipGetLastError();
        grid = cus > 256 ? 256 : cus;
    }
    if (grid < 0) return;
    (void)hipMemsetAsync((char*)d_ws + WS_CTL, 0, CTL_BYTES, stream);
    Args a; memset(&a, 0, sizeof(a));
    for (int i = 0; i < 26; ++i) a.in[i] = (const float*)d_in[i];
    a.out = (float*)d_out; a.ws = (unsigned char*)d_ws;
#if MK_SINGLE
    a.ph_lo = 0; a.ph_hi = NPHASE;
    hipLaunchKernelGGL(mk_fwd, dim3(grid), dim3(512), LDS_BYTES, stream, a);
#else
    for (int ph = 0; ph < NPHASE && ph <= DBG_LAST_PHASE; ++ph) {
        const int l = (ph - 1) / PPL, k = (ph - 1) % PPL;
        if (ph > 0 && (l & 1) && (k == 6 || k == 7)) continue;
        a.ph_lo = ph; a.ph_hi = ph + 1;
        hipLaunchKernelGGL(mk_fwd, dim3(grid), dim3(512), LDS_BYTES, stream, a);
    }
#endif
}
```

```cpp
#include <hip/hip_runtime.h>
#include <cstdio>
#include <cstdint>
#include <cstring>

#define LAS __attribute__((address_space(3)))
#define DI __device__ __forceinline__
typedef unsigned short bf16_t;
typedef short bf16x8 __attribute__((ext_vector_type(8)));
typedef short s16x4 __attribute__((ext_vector_type(4)));
typedef float f32x2 __attribute__((ext_vector_type(2)));
typedef float f32x4 __attribute__((ext_vector_type(4)));
typedef float f32x16 __attribute__((ext_vector_type(16)));
typedef unsigned u32x2 __attribute__((ext_vector_type(2)));
typedef unsigned u32x4 __attribute__((ext_vector_type(4)));
typedef __bf16 bfv2 __attribute__((ext_vector_type(2)));
typedef int i32x4 __attribute__((ext_vector_type(4)));
typedef int i32x8 __attribute__((ext_vector_type(8)));

#ifndef MK_SINGLE
#define MK_SINGLE 1
#endif
#ifndef DBG_ONLY
#define DBG_ONLY -1
#endif
#ifndef PROBE_MASK
#define PROBE_MASK 0u
#endif
#ifndef PROBE_ATT
#define PROBE_ATT 0
#endif
#ifndef PROBE_EPI2
#define PROBE_EPI2 0
#endif
#ifndef PROBE_PRO
#define PROBE_PRO 0
#endif
#ifndef PROBE_KREP
#define PROBE_KREP 1
#endif
#ifndef DBG_LAST_PHASE
#define DBG_LAST_PHASE 100000
#endif

constexpr int T = 32768, D = 1024, SEQ = 2048, NBATCH = 16, DEPTH = 4;
constexpr int EVIN = 2840, ODIN = 6144;
constexpr float EPS = 1e-6f, NEGF = -1e30f;
constexpr int NTB = 256;
constexpr int MOE_ROWS = (512 + 32) * 256;

constexpr size_t MiB = 1u << 20;
constexpr size_t WS_CTL = 0, CTL_BYTES = 1 * MiB;
constexpr int CW_BAR = 4096;
constexpr size_t WS_EVNAT = 2 * MiB, WS_EVSW = 10 * MiB, WS_EVOUT = 13 * MiB, WS_CMP1 = 17 * MiB, WS_ODNAT = 21 * MiB, WS_ODSW = 37 * MiB,
                 WS_ODOUT = 49 * MiB, WS_WPP = 57 * MiB, WS_WPG = 59 * MiB, WS_BIAS1 = 67 * MiB, WS_GAINS = 67 * MiB + 16384, WS_BCNT = 67 * MiB + 65536,
                 WS_WGU = 68 * MiB, WS_WDN = 580 * MiB;
constexpr size_t WS_XN = 840 * MiB, WS_PBF = 904 * MiB, WS_PP = 968 * MiB, WS_GATES = 1032 * MiB, WS_TOPE = 1035 * MiB, WS_POSB = 1036 * MiB,
                 WS_DEST = 1037 * MiB, WS_GATEW = 1038 * MiB, WS_SELM = 1039 * MiB;
constexpr size_t RA = 1040 * MiB;
constexpr size_t WS_QD = RA, WS_KD = RA + 32 * MiB, WS_QN = RA + 64 * MiB, WS_KCB = RA + 96 * MiB, WS_VCB = RA + 105 * MiB, WS_KSB = RA + 114 * MiB,
                 WS_KWB = RA + 122 * MiB, WS_VAT = RA + 130 * MiB, WS_VST = RA + 162 * MiB, WS_VWT = RA + 170 * MiB, WS_HID = RA + 178 * MiB,
                 WS_KCMP = RA + 182 * MiB, WS_VCMPT = RA + 183 * MiB, WS_OC = RA + 184 * MiB, WS_IMPH = RA + 216 * MiB, WS_OD = RA + 248 * MiB,
                 WS_OS = RA + 312 * MiB, WS_OW = RA + 344 * MiB, WS_AMIX = RA + 376 * MiB;
constexpr size_t WS_AQ = RA, WS_KP = RA + 128 * MiB, WS_KT = RA + 192 * MiB, WS_VS = RA + 256 * MiB, WS_GG = RA + 512 * MiB, WS_UT = RA + 640 * MiB,
                 WS_Y = RA + 896 * MiB, WS_YG = RA + 1024 * MiB;
constexpr size_t WS_TOK = 2192 * MiB  , WS_XB = 2192 * MiB, WS_ACT = 2464 * MiB, WS_YB = 2736 * MiB, WS_HB = 3008 * MiB, WS_END = 3072 * MiB;

constexpr int MISC_OFF = 139264, LDS_BYTES = 155648;
static_assert(MISC_OFF + 5888 + 4096 <= LDS_BYTES, "misc LDS words");
constexpr int MO_WCNT = 256, MO_ENT = 1280, MO_GAT = 3328, MO_TOT = 5376, MO_BASE = 5504, MO_TS = 5632, MO_RED = 5888, MO_GIDX = 10240;
static_assert(MISC_OFF + MO_GIDX + 1024 <= LDS_BYTES, "misc LDS words");

DI int opaque_tid(int wid0) { int l; asm volatile("v_mbcnt_lo_u32_b32 %0, -1, 0\n\tv_mbcnt_hi_u32_b32 %0, -1, %0" : "=v"(l) :: "memory"); return (wid0 << 6) | l; }
DI int lane_now() { int l; asm volatile("v_mbcnt_lo_u32_b32 %0, -1, 0\n\tv_mbcnt_hi_u32_b32 %0, -1, %0" : "=v"(l)); return l; }
DI float shx(float v, int m) { return __builtin_bit_cast(float, __builtin_amdgcn_ds_bpermute((lane_now() ^ m) << 2, __builtin_bit_cast(int, v))); }
DI float shxl(float v, int m, int lane) { return __builtin_bit_cast(float, __builtin_amdgcn_ds_bpermute((lane ^ m) << 2, __builtin_bit_cast(int, v))); }
DI unsigned shxu(unsigned v, int m) { return (unsigned)__builtin_amdgcn_ds_bpermute((lane_now() ^ m) << 2, (int)v); }
DI unsigned pk2(float lo, float hi) { f32x2 v = {lo, hi}; return __builtin_bit_cast(unsigned, __builtin_convertvector(v, bfv2)); }
DI unsigned pk4_fp8(float a, float b, float c, float d) { int w = 0; w = __builtin_amdgcn_cvt_pk_fp8_f32(a, b, w, false); w = __builtin_amdgcn_cvt_pk_fp8_f32(c, d, w, true); return (unsigned)w; }
DI u32x2 pack8_fp8(const f32x4& a, const f32x4& b) { u32x2 w; w.x = pk4_fp8(a[0], a[1], a[2], a[3]); w.y = pk4_fp8(b[0], b[1], b[2], b[3]); return w; }
DI float bf2f(unsigned short b) { return __uint_as_float(((unsigned)b) << 16); }
DI float bflo(unsigned w) { return __uint_as_float(w << 16); }
DI float bfhi(unsigned w) { return __uint_as_float(w & 0xffff0000u); }
DI float wave_sum(float v) {
#pragma unroll
    for (int o = 1; o < 64; o <<= 1) v += shx(v, o);
    return v;
}
DI float sigm(float x) { return __builtin_amdgcn_rcpf(1.0f + __builtin_amdgcn_exp2f(-1.44269504089f * x)); }
DI u32x4 pack8(const f32x4& a, const f32x4& b) { u32x4 w; w.x = pk2(a[0], a[1]); w.y = pk2(a[2], a[3]); w.z = pk2(b[0], b[1]); w.w = pk2(b[2], b[3]); return w; }
DI f32x4 ld_h4(const void* base, bool hb, size_t i) {
    if (hb) { const u32x2 w = *(const u32x2*)((const bf16_t*)base + i); return (f32x4){bflo(w.x), bfhi(w.x), bflo(w.y), bfhi(w.y)}; }
    return *(const f32x4*)((const float*)base + i);
}

#define XB_TMO      128
#define XB_XCNT(j)  (256  + 64 * (j))
#define XB_XSUB(j)  (1280 + 64 * (j))
#define XB_XGEN(j)  (2304 + 64 * (j))
#define XB_TOP      3328
#define XB_TOPGEN   3392
#define XCD_BAR_WORDS 3456
#define XB_SPIN_CAP (1u << 22)
DI unsigned xb_ld(unsigned* p)              { return __hip_atomic_load(p, __ATOMIC_RELAXED, __HIP_MEMORY_SCOPE_AGENT); }
DI unsigned xb_add(unsigned* p, unsigned v) { return __hip_atomic_fetch_add(p, v, __ATOMIC_RELAXED, __HIP_MEMORY_SCOPE_AGENT); }
DI unsigned xb_xcc_id() { return (unsigned)__builtin_amdgcn_s_getreg((3 << 11) | 20) & 0xFu; }
#define XB_SPIN(cond, bar) do { unsigned _sp = 0; while (cond) { __builtin_amdgcn_s_sleep(1); \
    if ((++_sp & 255u) == 0u) { if (xb_ld(&(bar)[XB_TMO])) break; if (_sp > XB_SPIN_CAP) { atomicAdd(&(bar)[XB_TMO], 1u); break; } } } } while (0)
struct XcdBarrier { unsigned* bar; unsigned x; volatile LAS unsigned* st; };
DI XcdBarrier xcd_barrier_post(const int WID, unsigned* bar, volatile LAS unsigned* st) {
    XcdBarrier b; b.bar = bar; b.x = xb_xcc_id(); b.st = st;
    if (opaque_tid(WID) == 0) (void)xb_add(&bar[XB_XCNT(b.x)], 1u);
    return b;
}
DI void xcd_barrier_complete(unsigned* bar, unsigned x, unsigned& nloc, unsigned& nx) {
    const unsigned G = gridDim.x * gridDim.y * gridDim.z;
    unsigned sum, cnt, mine, sp = 0u;
    for (;;) {
        sum = 0u; cnt = 0u; mine = 0u;
#pragma unroll
        for (unsigned j = 0; j < 16; ++j) { const unsigned c = xb_ld(&bar[XB_XCNT(j)]); sum += c; cnt += (c > 0u) ? 1u : 0u; mine = (j == x) ? c : mine; }
        if (sum == G) break;
        __builtin_amdgcn_s_sleep(1);
        if ((++sp & 255u) == 0u) { if (xb_ld(&bar[XB_TMO])) break; if (sp > XB_SPIN_CAP) { atomicAdd(&bar[XB_TMO], 1u); break; } }
    }
    nloc = mine > 0u ? mine : 1u; nx = cnt > 0u ? cnt : 1u;
}
DI void xcd_barrier(const int WID, const XcdBarrier& b) {
    asm volatile("s_waitcnt vmcnt(0)" ::: "memory");
    __syncthreads();
    if (opaque_tid(WID) == 0) {
        unsigned* bar = b.bar; asm volatile("" : "+s"(bar));
        __builtin_amdgcn_s_waitcnt(0);
        unsigned nloc = b.st[0], nx = b.st[1];
        if (nloc == 0u) { xcd_barrier_complete(bar, b.x, nloc, nx); b.st[0] = nloc; b.st[1] = nx; }
        const unsigned old = xb_add(&bar[XB_XSUB(b.x)], 1u);
        const unsigned gen = old / nloc;
        if (old + 1u == (gen + 1u) * nloc) {
            __builtin_amdgcn_fence(__ATOMIC_RELEASE, "agent");
            asm volatile("s_waitcnt vmcnt(0)" ::: "memory");
            const unsigned og = xb_add(&bar[XB_TOP], 1u);
            const unsigned tg = og / nx;
            if (og + 1u == (tg + 1u) * nx) xb_add(&bar[XB_TOPGEN], 1u);
            else XB_SPIN(xb_ld(&bar[XB_TOPGEN]) == tg, bar);
            __builtin_amdgcn_fence(__ATOMIC_ACQUIRE, "agent");
            xb_add(&bar[XB_XGEN(b.x)], 1u);
            asm volatile("s_waitcnt vmcnt(0)" ::: "memory");
        } else {
            XB_SPIN(xb_ld(&bar[XB_XGEN(b.x)]) == gen, bar);
            __builtin_amdgcn_fence(__ATOMIC_ACQUIRE, "agent");
            asm volatile("s_waitcnt vmcnt(0)" ::: "memory");
        }
    }
    __syncthreads();
}

namespace pg8 {
constexpr int BM = 256, BK = 64, HALF = 128, HTB = HALF * BK * 2, STAGE_BYTES = 8 * HTB, NXCD = 8, WGM = 8;
DI int lds_byte(int r, int c) { const int st = (r >> 4) * 2 + (c >> 5), rr = r & 15, cc = c & 31, ob = rr * 64 + cc * 2; return st * 1024 + (ob ^ (((ob >> 9) & 1) << 5)); }
DI void stage_rc(int b, int& R, int& C) { const int st = b / 1024, sb = b % 1024, swz = sb ^ (((sb >> 9) & 1) << 5); R = (st >> 1) * 16 + swz / 64; C = (st & 1) * 32 + (swz % 64) / 2; }
DI int perm32(int rho) { const int n = rho >> 4, i = rho & 15; return 8 * (i >> 2) + 4 * n + (i & 3); }
struct Unit { int pm, pn; };
struct Sched {
    int nM, nN, nwg, G, c;
    DI void init(int nM_, int nN_, int G_, int c_) { nM = nM_; nN = nN_; nwg = nM * nN; G = G_; c = c_; }
    DI bool next(int i, Unit& u) const {
        const long L = (long)i * G + c; if (L >= nwg) return false;
        int wgid = (int)L; { const int q = nwg / NXCD, r = nwg % NXCD, xcd = wgid % NXCD, off = wgid / NXCD; wgid = (xcd < r ? xcd * (q + 1) : r * (q + 1) + (xcd - r) * q) + off; }
        const int nig = WGM * nN, gid = wgid / nig, fm = gid * WGM, gsz = (nM - fm) < WGM ? (nM - fm) : WGM;
        u.pm = fm + ((wgid % nig) % gsz); u.pn = (wgid % nig) / gsz; return true;
    }
};
template <class Epi, class Prob, class SchedT>
DI void gemm_phase(const int WID, LAS unsigned char* lds, const Prob& P, const SchedT& S, const Epi& E) {
    const int tid = opaque_tid(WID), wid = __builtin_amdgcn_readfirstlane(tid >> 6), lane = tid & 63, wr = wid >> 2, wc = wid & 3, fr = lane & 15, fq = lane >> 4;
    const int K = P.K, nt = K / BK;
    constexpr int KREP = Epi::CARRY ? 1 : PROBE_KREP;
    unsigned voffA[2], voffB[2], voffG[2];
#pragma unroll
    for (int i = 0; i < 2; ++i) { int R, C; stage_rc(tid * 16 + i * 8192, R, C); const int Rb = Epi::PERM ? ((R & ~31) + perm32(R & 31)) : R;
        voffA[i] = (unsigned)(R * P.lda + C) * 2u; voffB[i] = (unsigned)(Rb * P.ldb + C) * 2u; voffG[i] = 0u; }
    const size_t kstep = (size_t)(BK * 2);
    const size_t hstepA = (size_t)HALF * P.lda * 2, hstepB = (size_t)HALF * P.ldb * 2;
    const unsigned ldsw = (unsigned)wid * 1024u;
    const int aoff = lds_byte(wr * 64 + fr, fq * 8), boff = lds_byte(wc * 32 + fr, fq * 8);
#define PG8_SA(b, h) (((b) * 2 + (h)) * HTB)
#define PG8_SB(b, h) ((4 + (b) * 2 + (h)) * HTB)
#define PG8_STAGE(bufoff, gbase, voff) do { _Pragma("unroll") for (int _i = 0; _i < 2; ++_i) \
        __builtin_amdgcn_global_load_lds((const unsigned*)((const char*)(gbase) + (voff)[_i]), (LAS unsigned*)(lds + (bufoff) + ldsw + _i * 8192), 16, 0, 0); } while (0)
#define PG8_STAGE_A(b, h, abase) do { if constexpr (Prob::GATHER) { if (h) PG8_STAGE(PG8_SA(b, h), abase, voffG); else PG8_STAGE(PG8_SA(b, h), abase, voffA); } \
        else PG8_STAGE(PG8_SA(b, h), (abase) + ((h) ? hstepA : (size_t)0), voffA); } while (0)
#define PG8_LD16(off) (*(const LAS i32x4*)(lds + (off)))
#define PG8_LDA(dst, b, h) do { _Pragma("unroll") for (int m = 0; m < 4; ++m) { const i32x4 lo_ = PG8_LD16(PG8_SA(b, h) + aoff + m * 2048), hi_ = PG8_LD16(PG8_SA(b, h) + aoff + m * 2048 + 1024); dst[m] = __builtin_shufflevector(lo_, hi_, 0, 1, 2, 3, 4, 5, 6, 7); } } while (0)
#define PG8_LDB(dst, b, h) do { _Pragma("unroll") for (int n = 0; n < 2; ++n) { const i32x4 lo_ = PG8_LD16(PG8_SB(b, h) + boff + n * 2048), hi_ = PG8_LD16(PG8_SB(b, h) + boff + n * 2048 + 1024); dst[n] = __builtin_shufflevector(lo_, hi_, 0, 1, 2, 3, 4, 5, 6, 7); } } while (0)
#define PG8_LOH(X) __builtin_bit_cast(bf16x8, __builtin_shufflevector((X), (X), 0, 1, 2, 3))
#define PG8_HIH(X) __builtin_bit_cast(bf16x8, __builtin_shufflevector((X), (X), 4, 5, 6, 7))
#define PG8_MMA(ai, bj, At, Bt) do { __builtin_amdgcn_s_setprio(1); \
        if constexpr (Prob::FP8) { _Pragma("unroll") for (int m = 0; m < 4; ++m) _Pragma("unroll") for (int n = 0; n < 2; ++n) \
            asm volatile("v_mfma_scale_f32_16x16x128_f8f6f4 %0, %1, %2, %0, %3, %3 op_sel_hi:[0,0,0]" : "+v"(acc[ai][bj][m][n]) : "v"(Bt[n]), "v"(At[m]), "v"(sc1)); } \
        else { _Pragma("unroll") for (int m = 0; m < 4; ++m) _Pragma("unroll") for (int n = 0; n < 2; ++n) { \
            acc[ai][bj][m][n] = __builtin_amdgcn_mfma_f32_16x16x32_bf16(PG8_LOH(Bt[n]), PG8_LOH(At[m]), acc[ai][bj][m][n], 0, 0, 0); \
            acc[ai][bj][m][n] = __builtin_amdgcn_mfma_f32_16x16x32_bf16(PG8_HIH(Bt[n]), PG8_HIH(At[m]), acc[ai][bj][m][n], 0, 0, 0); } } \
        __builtin_amdgcn_s_setprio(0); } while (0)
#define PG8_WAIT_V(n) asm volatile("s_waitcnt vmcnt(" #n ")" ::: "memory")
#define PG8_WAIT_L(n) asm volatile("s_waitcnt lgkmcnt(" #n ")" ::: "memory")
#define PG8_BAR __builtin_amdgcn_s_barrier()
#define PG8_SCHED __builtin_amdgcn_sched_barrier(0)
    Unit cur, nxt; int ui = 0;
    if (!S.next(0, cur)) return;
    f32x4 acc[2][2][4][2];
#pragma unroll
    for (int a = 0; a < 2; ++a)
#pragma unroll
        for (int b = 0; b < 2; ++b)
#pragma unroll
            for (int m = 0; m < 4; ++m)
#pragma unroll
                for (int n = 0; n < 2; ++n) acc[a][b][m][n] = (f32x4){0.f, 0.f, 0.f, 0.f};
    i32x8 At[4], B0[2], B1[2];
    const int sc1 = 0x7f7f7f7f;
    const char* cA = P.a_base(cur); const char* cB = P.b_base(cur);
    if constexpr (Prob::GATHER) {
#pragma unroll
        for (int i = 0; i < 2; ++i) { int R, C; stage_rc(tid * 16 + i * 8192, R, C);
            voffA[i] = (unsigned)P.TOK[(size_t)cur.pm * 256 + R] * 1024u + (unsigned)C * 2u; voffG[i] = (unsigned)P.TOK[(size_t)cur.pm * 256 + 128 + R] * 1024u + (unsigned)C * 2u; }
    }
    PG8_STAGE(PG8_SB(0, 0), cB, voffB); PG8_STAGE_A(0, 0, cA); PG8_STAGE(PG8_SB(0, 1), cB + hstepB, voffB); PG8_STAGE_A(0, 1, cA);
    if (wr == 1) PG8_BAR;
    PG8_WAIT_V(4); PG8_BAR;
    PG8_STAGE(PG8_SB(1, 0), cB + kstep, voffB); PG8_STAGE_A(1, 0, cA + kstep); PG8_STAGE(PG8_SB(1, 1), cB + hstepB + kstep, voffB);
    PG8_WAIT_V(6); PG8_BAR;
    for (;;) {
        const bool has_next = S.next(ui + 1, nxt);
        const char* nA = has_next ? P.a_base(nxt) : cA; const char* nB = has_next ? P.b_base(nxt) : cB;
        for (int rep_ = 0; rep_ < KREP; ++rep_)
        for (int t = 0; t < nt; t += 2) {
            const bool last = (t == nt - 2);
            if constexpr (Epi::HOOK) { if (last && rep_ + 1 == KREP) E.prefetch(cur, lds, wid, lane); }
            const char* a1 = cA + (size_t)(t + 1) * kstep;
            const char* a2 = last ? (rep_ + 1 < KREP ? cA : nA) : cA + (size_t)(t + 2) * kstep; const char* b2 = last ? (rep_ + 1 < KREP ? cB : nB) : cB + (size_t)(t + 2) * kstep;
            const char* a3 = a2 + kstep; const char* b3 = b2 + kstep;
            if constexpr (Prob::GATHER) {
                if (t == 0 && rep_ == 0 && has_next && wid == 0) __builtin_amdgcn_global_load_lds((const unsigned*)(P.TOK + (size_t)nxt.pm * 256 + 4 * lane_now()), (LAS unsigned*)(lds + MISC_OFF + MO_GIDX), 16, 0, 0);
                if (last && rep_ + 1 == KREP && has_next) { const int t3_ = opaque_tid(WID);
#pragma unroll
                    for (int i = 0; i < 2; ++i) { int R, C; stage_rc(t3_ * 16 + i * 8192, R, C); voffA[i] = (unsigned)(*(const LAS int*)(lds + MISC_OFF + MO_GIDX + 4 * R)) * 1024u + (unsigned)C * 2u; } }
            }
            PG8_LDB(B0, 0, 0); PG8_SCHED; PG8_LDA(At, 0, 0); PG8_STAGE_A(1, 1, a1);
            if constexpr (Prob::GATHER) {
                if (last && rep_ + 1 == KREP && has_next) { const int t3_ = opaque_tid(WID);
#pragma unroll
                    for (int i = 0; i < 2; ++i) { int R, C; stage_rc(t3_ * 16 + i * 8192, R, C); voffG[i] = (unsigned)(*(const LAS int*)(lds + MISC_OFF + MO_GIDX + 512 + 4 * R)) * 1024u + (unsigned)C * 2u; } }
            }
            PG8_WAIT_L(8); PG8_BAR; PG8_WAIT_L(0); PG8_MMA(0, 0, At, B0); PG8_BAR; PG8_SCHED;
            PG8_LDB(B1, 0, 1); PG8_STAGE(PG8_SB(0, 0), b2, voffB);
            PG8_BAR; PG8_WAIT_L(0); PG8_MMA(0, 1, At, B1); PG8_BAR;
            PG8_LDA(At, 0, 1); PG8_STAGE_A(0, 0, a2);
            PG8_BAR; PG8_WAIT_L(0); PG8_MMA(1, 0, At, B0); PG8_BAR; PG8_SCHED;
            PG8_STAGE(PG8_SB(0, 1), b2 + hstepB, voffB);
            PG8_WAIT_V(6); PG8_BAR; PG8_MMA(1, 1, At, B1); PG8_BAR;
            PG8_LDB(B0, 1, 0); PG8_SCHED; PG8_LDA(At, 1, 0); PG8_STAGE_A(0, 1, a2);
            PG8_WAIT_L(8); PG8_BAR; PG8_WAIT_L(0); PG8_MMA(0, 0, At, B0); PG8_BAR; PG8_SCHED;
            PG8_LDB(B1, 1, 1); PG8_STAGE(PG8_SB(1, 0), b3, voffB);
            PG8_BAR; PG8_WAIT_L(0); PG8_MMA(0, 1, At, B1); PG8_BAR;
            PG8_LDA(At, 1, 1); PG8_STAGE_A(1, 0, a3);
            PG8_BAR; PG8_WAIT_L(0); PG8_MMA(1, 0, At, B0); PG8_BAR; PG8_SCHED;
            PG8_STAGE(PG8_SB(1, 1), b3 + hstepB, voffB);
            PG8_WAIT_V(6); PG8_BAR; PG8_MMA(1, 1, At, B1); PG8_BAR;
        }
        if constexpr (Prob::FP8) {
            asm volatile("s_nop 15\n\ts_nop 15" ::: "memory");
#pragma unroll
            for (int a_ = 0; a_ < 2; ++a_)
#pragma unroll
                for (int b_ = 0; b_ < 2; ++b_)
#pragma unroll
                    for (int m_ = 0; m_ < 4; ++m_)
#pragma unroll
                        for (int n_ = 0; n_ < 2; ++n_) asm volatile("" : "+v"(acc[a_][b_][m_][n_]));
        }
        if constexpr (KREP > 1) {
#pragma unroll
        for (int a_ = 0; a_ < 2; ++a_)
#pragma unroll
            for (int b_ = 0; b_ < 2; ++b_)
#pragma unroll
                for (int m_ = 0; m_ < 4; ++m_)
#pragma unroll
                    for (int n_ = 0; n_ < 2; ++n_) acc[a_][b_][m_][n_] *= (1.0f / KREP); }
        { const int t2_ = opaque_tid(WID); const int fr_ = t2_ & 15, fq_ = (t2_ >> 4) & 3; int wr_ = WID >> 2, wc_ = WID & 3; asm volatile("" : "+s"(wr_), "+s"(wc_));
          E(acc, cur, wr_, wc_, fr_, fq_);
#if PROBE_EPI2
          if constexpr (Epi::HOOK) { asm volatile("" ::: "memory"); E(acc, cur, wr_, wc_, fr_, fq_); }
#endif
        }
        if (!has_next) break;
        const float carry = Epi::carry(cur);
#pragma unroll
        for (int a = 0; a < 2; ++a)
#pragma unroll
            for (int b = 0; b < 2; ++b)
#pragma unroll
                for (int m = 0; m < 4; ++m)
#pragma unroll
                    for (int n = 0; n < 2; ++n) acc[a][b][m][n] = Epi::CARRY ? acc[a][b][m][n] * carry : (f32x4){0.f, 0.f, 0.f, 0.f};
        cur = nxt; cA = nA; cB = nB; ++ui;
    }
    PG8_WAIT_V(0);
    if (wr == 0) PG8_BAR;
    PG8_BAR;
#undef PG8_SA
#undef PG8_SB
#undef PG8_STAGE
#undef PG8_STAGE_A
#undef PG8_LDA
#undef PG8_LDB
#undef PG8_MMA
#undef PG8_LD16
#undef PG8_LOH
#undef PG8_HIH
#undef PG8_WAIT_V
#undef PG8_WAIT_L
#undef PG8_BAR
#undef PG8_SCHED
}
}
using pg8::Unit;
typedef f32x4 Acc[2][2][4][2];

struct ProbPlain { static constexpr bool GATHER = false; static constexpr bool FP8 = false; const bf16_t* A; const bf16_t* Bt; int lda, ldb, K;
    DI const char* a_base(const Unit& u) const { return (const char*)(A + (size_t)u.pm * 256 * lda); }
    DI const char* b_base(const Unit& u) const { return (const char*)(Bt + (size_t)u.pn * 256 * ldb); } };
struct ProbCmp1 { static constexpr bool GATHER = false; static constexpr bool FP8 = false; const bf16_t* KCB; const bf16_t* VCB; const bf16_t* W; int lda, ldb, K;
    DI const char* a_base(const Unit& u) const { const int kv = u.pm >> 4, rt = u.pm & 15; return (const char*)((kv ? VCB : KCB) + (size_t)rt * 256 * 1024); }
    DI const char* b_base(const Unit& u) const { const int kv = u.pm >> 4; return (const char*)(W + (size_t)kv * 256 * 2048); } };
struct ProbAtt { static constexpr bool GATHER = false; static constexpr bool FP8 = false; const bf16_t* AQ; const bf16_t* KP; int lda, ldb, K;
    DI const char* a_base(const Unit& u) const { const int z = u.pm, n = z & 7, h = (z >> 3) & 3, b = z >> 5; const size_t t0 = (size_t)b * 2048 + n * 256; return (const char*)(AQ + (t0 * 4 + h) * 512 + 256); }
    DI const char* b_base(const Unit& u) const { const int z = u.pm, n = z & 7, h = (z >> 3) & 3, b = z >> 5; const size_t t0 = (size_t)b * 2048 + n * 256; return (const char*)(KP + t0 * 1024 + h * 256); } };
struct ProbUT { static constexpr bool GATHER = false; static constexpr bool FP8 = false; const bf16_t* VS; const bf16_t* KT; int lda, ldb, K;
    DI const char* a_base(const Unit& u) const { const int z = u.pm >> 1, half = u.pm & 1; return (const char*)(VS + (size_t)z * 262144 + (size_t)half * 256 * 512); }
    DI const char* b_base(const Unit& u) const { const int z = u.pm >> 1; return (const char*)(KT + (size_t)z * 65536); } };
struct ProbY { static constexpr bool GATHER = false; static constexpr bool FP8 = false; const bf16_t* AQ; const bf16_t* VS; int lda, ldb, K;
    DI const char* a_base(const Unit& u) const { const int z = u.pm, n = z & 7, h = (z >> 3) & 3, b = z >> 5; const size_t t0 = (size_t)b * 2048 + n * 256; return (const char*)(AQ + (t0 * 4 + h) * 512); }
    DI const char* b_base(const Unit& u) const { return (const char*)(VS + (size_t)u.pm * 262144 + (size_t)u.pn * 256 * 512); } };
DI int moe_tile_expert(const LAS int* ts, int rt) { int e = 0;
#pragma unroll 8
    for (int i = 1; i < 32; ++i) e += (rt >= ts[i]) ? 1 : 0;
    return e; }
struct ProbMoe { static constexpr bool GATHER = false; static constexpr bool FP8 = false; const bf16_t* A; const bf16_t* W; const LAS int* ts; int nper; int lda, ldb, K;
    DI const char* a_base(const Unit& u) const { return (const char*)(A + (size_t)u.pm * 256 * 1024); }
    DI const char* b_base(const Unit& u) const { const int e = moe_tile_expert(ts, u.pm); return (const char*)(W + ((size_t)e * nper + (size_t)u.pn * 256) * 1024); } };

struct ProbPlain8 { static constexpr bool GATHER = false; static constexpr bool FP8 = true; const unsigned char* A; const unsigned char* Bt; int lda, ldb, K;
    DI const char* a_base(const Unit& u) const { return (const char*)(A + (size_t)u.pm * 256 * lda * 2); }
    DI const char* b_base(const Unit& u) const { return (const char*)(Bt + (size_t)u.pn * 256 * ldb * 2); } };
struct ProbMoe8 { static constexpr bool GATHER = false; static constexpr bool FP8 = true; const unsigned char* A; const unsigned char* W; const LAS int* ts; int nper; int lda, ldb, K;
    DI const char* a_base(const Unit& u) const { return (const char*)(A + (size_t)u.pm * 256 * 1024); }
    DI const char* b_base(const Unit& u) const { const int e = moe_tile_expert(ts, u.pm); return (const char*)(W + ((size_t)e * nper + (size_t)u.pn * 256) * 1024); } };
struct ProbMoe8G { static constexpr bool GATHER = true; static constexpr bool FP8 = true; const unsigned char* A; const unsigned char* W; const LAS int* ts; const int* TOK; int nper; int lda, ldb, K;
    DI const char* a_base(const Unit&) const { return (const char*)A; }
    DI const char* b_base(const Unit& u) const { const int e = moe_tile_expert(ts, u.pm); return (const char*)(W + ((size_t)e * nper + (size_t)u.pn * 256) * 1024); } };

constexpr float A_SC = 4.0f;
constexpr float W8_SCALE = 32.0f, WSC = 1.0f / W8_SCALE;
#define EPI_ROWS(ai, m) (128 * (ai) + 64 * wr + 16 * (m) + fr)
struct EpiEvNat { static constexpr bool HOOK = false; static constexpr bool CARRY = false; static DI float carry(const Unit&) { return 0.f; } static constexpr bool PERM = true;
    unsigned char* ws; const float* gains;
    DI void operator()(const Acc& acc, const Unit& u, int wr, int wc, int fr, int fq) const {
        const int pn = u.pn; const bool norm = (pn != 6);
        const int gi = pn < 2 ? 0 : pn < 4 ? 1 : pn < 6 ? 2 : 3;
        const float* g = gains + gi * 64;
        f32x4 gv[2][2];
#pragma unroll
        for (int bj = 0; bj < 2; ++bj)
#pragma unroll
            for (int n = 0; n < 2; ++n) { const f32x4 t4 = *(const f32x4*)(g + 32 * bj + 8 * fq + 4 * n); gv[bj][n] = norm ? t4 : (f32x4){1.f, 1.f, 1.f, 1.f}; }
        size_t boff; int rowmul, hoff; bool panel = false;
        if (pn < 2) { boff = WS_QD; rowmul = 512; hoff = (pn * 4 + wc) * 64; }
        else if (pn < 4) { boff = WS_KD; rowmul = 512; hoff = ((pn - 2) * 4 + wc) * 64; }
        else if (pn < 6) { boff = WS_QN; rowmul = 512; hoff = ((pn - 4) * 4 + wc) * 64; }
        else { panel = true; rowmul = 64; hoff = 0; boff = (pn == 6) ? (wc < 2 ? WS_KCB : WS_VCB) : (wc < 2 ? WS_KSB : WS_KWB); }
        bf16_t* base = (bf16_t*)(ws + boff);
#pragma unroll
        for (int ai = 0; ai < 2; ++ai)
#pragma unroll
            for (int m = 0; m < 4; ++m) {
                const int t = u.pm * 256 + EPI_ROWS(ai, m), b = t >> 11, sq = t & 2047;
                float ss = 0.f;
#pragma unroll
                for (int bj = 0; bj < 2; ++bj)
#pragma unroll
                    for (int n = 0; n < 2; ++n) { const f32x4 x = acc[ai][bj][m][n]; ss += (x[0] * x[0] + x[1] * x[1]) + (x[2] * x[2] + x[3] * x[3]); }
                ss += shx(ss, 16); ss += shx(ss, 32);
                const float rstd = norm ? rsqrtf(ss * (1.0f / 64.0f) + EPS) * ((pn < 2 || pn == 4 || pn == 5) ? 0.125f : 1.0f) : 1.0f;
                const size_t rowi = panel ? ((size_t)(b * 2 + (wc & 1)) * 2048 + sq) : (size_t)t;
#pragma unroll
                for (int bj = 0; bj < 2; ++bj) {
                    const f32x4 v0 = acc[ai][bj][m][0] * rstd * gv[bj][0], v1 = acc[ai][bj][m][1] * rstd * gv[bj][1];
                    *(u32x4*)(base + rowi * rowmul + hoff + 32 * bj + 8 * fq) = pack8(v0, v1);
                }
            }
    }
};
struct EpiEvSw { static constexpr bool HOOK = false; static constexpr bool CARRY = false; static DI float carry(const Unit&) { return 0.f; } static constexpr bool PERM = true;
    unsigned char* ws;
    DI void operator()(const Acc& acc, const Unit& u, int wr, int wc, int fr, int fq) const {
        const int b = u.pn >> 3, sb = (u.pn & 7) * 256;
#pragma unroll
        for (int ai = 0; ai < 2; ++ai)
#pragma unroll
            for (int m = 0; m < 4; ++m) {
                const int rl = EPI_ROWS(ai, m);
                size_t boff, rowi;
                if (u.pm < 2) { const int fg = u.pm * 256 + rl; boff = WS_VAT; rowi = (size_t)(b * 4 + (fg >> 7)) * 128 + (fg & 127); }
                else { const int r2 = rl & 127; boff = (rl < 128) ? WS_VST : WS_VWT; rowi = (size_t)(b * 2 + (r2 >> 6)) * 64 + (r2 & 63); }
                bf16_t* rowp = (bf16_t*)(ws + boff) + rowi * 2048;
#pragma unroll
                for (int bj = 0; bj < 2; ++bj) { const u32x4 pw = pack8(acc[ai][bj][m][0], acc[ai][bj][m][1]);
                    const int s0 = sb + 128 * bj + 32 * wc + 8 * fq; bf16_t* g16 = rowp + (s0 & ~15) + ((s0 & 8) ? 4 : 0);
                    *(u32x2*)g16 = (u32x2){pw.x, pw.y}; *(u32x2*)(g16 + 8) = (u32x2){pw.z, pw.w}; }
            }
    }
};
struct EpiCmp1 { static constexpr bool HOOK = false; static constexpr bool CARRY = false; static DI float carry(const Unit&) { return 0.f; } static constexpr bool PERM = true;
    bf16_t* HID; const float* bias1;
    DI void operator()(const Acc& acc, const Unit& u, int wr, int wc, int fr, int fq) const {
        const int kv = u.pm >> 4, rt = u.pm & 15;
#pragma unroll
        for (int bj = 0; bj < 2; ++bj) {
            const int col = 128 * bj + 32 * wc + 8 * fq;
            const f32x4 b0 = *(const f32x4*)(bias1 + kv * 256 + col), b1 = *(const f32x4*)(bias1 + kv * 256 + col + 4);
#pragma unroll
            for (int ai = 0; ai < 2; ++ai)
#pragma unroll
                for (int m = 0; m < 4; ++m) {
                    f32x4 v0 = acc[ai][bj][m][0] + b0, v1 = acc[ai][bj][m][1] + b1;
#pragma unroll
                    for (int j = 0; j < 4; ++j) { v0[j] = v0[j] * sigm(v0[j]); v1[j] = v1[j] * sigm(v1[j]); }
                    *(u32x4*)(HID + ((size_t)kv * 4096 + rt * 256 + EPI_ROWS(ai, m)) * 256 + col) = pack8(v0, v1);
                }
        }
    }
};
struct EpiResid { static constexpr bool HOOK = false; static constexpr bool CARRY = false; static DI float carry(const Unit&) { return 0.f; } static constexpr bool PERM = true;
    const void* Hin; bf16_t* Hout; bool hb; float sc;
    DI void operator()(const Acc& acc, const Unit& u, int wr, int wc, int fr, int fq) const {
#pragma unroll
        for (int ai = 0; ai < 2; ++ai)
#pragma unroll
            for (int m = 0; m < 4; ++m) {
                const size_t off = (size_t)(u.pm * 256 + EPI_ROWS(ai, m)) * 1024 + u.pn * 256 + 32 * wc + 8 * fq;
#pragma unroll
                for (int bj = 0; bj < 2; ++bj) { const size_t o = off + 128 * bj;
                    *(u32x4*)(Hout + o) = pack8(ld_h4(Hin, hb, o) + acc[ai][bj][m][0] * sc, ld_h4(Hin, hb, o + 4) + acc[ai][bj][m][1] * sc); }
            }
    }
};
DI float ret_lg2(int h) { return __log2f(1.0f - exp2f(-5.0f - (float)h)); }
struct EpiOdNat { static constexpr bool HOOK = false; static constexpr bool CARRY = false; static DI float carry(const Unit&) { return 0.f; } static constexpr bool PERM = true;
    unsigned char* ws;
    DI void operator()(const Acc& acc, const Unit& u, int wr, int wc, int fr, int fq) const {
        const int pn = u.pn; const int h = pn & 3; const float lg = ret_lg2(h);
        const size_t boff = pn < 4 ? WS_AQ : pn < 8 ? WS_KP : WS_GG;
        const int rowmul = pn < 4 ? 2048 : pn < 8 ? 1024 : 2048;
        const int coff = pn < 4 ? (h * 512 + 256) : pn < 8 ? (h * 256) : ((pn - 8) * 256);
        bf16_t* base = (bf16_t*)(ws + boff) + coff;
#pragma unroll
        for (int ai = 0; ai < 2; ++ai)
#pragma unroll
            for (int m = 0; m < 4; ++m) {
                const int cl = EPI_ROWS(ai, m); const size_t t = (size_t)u.pm * 256 + cl;
                float sc = 1.f;
                if (pn < 4) sc = exp2f(lg * (float)(cl + 1)); else if (pn < 8) sc = 0.0625f * exp2f(-lg * (float)(cl + 1));
                sc *= WSC;
#pragma unroll
                for (int bj = 0; bj < 2; ++bj) {
                    const int d = 128 * bj + 32 * wc + 8 * fq;
                    f32x4 v0 = acc[ai][bj][m][0] * sc, v1 = acc[ai][bj][m][1] * sc;
                    if (pn >= 8) {
                        f32x4 e0 = v0 * -1.44269504089f, e1 = v1 * -1.44269504089f;
#pragma unroll
                        for (int j = 0; j < 4; ++j) { e0[j] = __builtin_amdgcn_exp2f(e0[j]); e1[j] = __builtin_amdgcn_exp2f(e1[j]); }
                        e0 = e0 + 1.0f; e1 = e1 + 1.0f;
#pragma unroll
                        for (int j = 0; j < 4; ++j) { e0[j] = __builtin_amdgcn_rcpf(e0[j]); e1[j] = __builtin_amdgcn_rcpf(e1[j]); }
                        v0 = v0 * e0; v1 = v1 * e1; }
                    const u32x4 pw = pack8(v0, v1);
                    *(u32x4*)(base + t * rowmul + d) = pw;
                    if (pn >= 4 && pn < 8) {
                        bf16_t* kt = (bf16_t*)(ws + WS_KT) + ((size_t)((u.pm >> 3) * 4 + h) * 8 + (u.pm & 7)) * 65536 + (size_t)d * 256 + cl;
                        kt[0 * 256] = (bf16_t)(pw.x & 0xffffu); kt[1 * 256] = (bf16_t)(pw.x >> 16); kt[2 * 256] = (bf16_t)(pw.y & 0xffffu); kt[3 * 256] = (bf16_t)(pw.y >> 16);
                        kt[4 * 256] = (bf16_t)(pw.z & 0xffffu); kt[5 * 256] = (bf16_t)(pw.z >> 16); kt[6 * 256] = (bf16_t)(pw.w & 0xffffu); kt[7 * 256] = (bf16_t)(pw.w >> 16);
                    }
                }
            }
    }
};
struct EpiOdSw { static constexpr bool HOOK = false; static constexpr bool CARRY = false; static DI float carry(const Unit&) { return 0.f; } static constexpr bool PERM = true;
    unsigned char* ws;
    DI void operator()(const Acc& acc, const Unit& u, int wr, int wc, int fr, int fq) const {
        const int b = u.pn >> 3, n = u.pn & 7, h = u.pm >> 1;
        const size_t z = (size_t)(b * 4 + h) * 8 + n;
        bf16_t* base = (bf16_t*)(ws + WS_VS) + z * 262144 + (size_t)(u.pm & 1) * 256 * 512;
#pragma unroll
        for (int bj = 0; bj < 2; ++bj) {
            const int cl = 128 * bj + 32 * wc + 8 * fq;
#pragma unroll
            for (int ai = 0; ai < 2; ++ai)
#pragma unroll
                for (int m = 0; m < 4; ++m)
                    *(u32x4*)(base + (size_t)EPI_ROWS(ai, m) * 512 + cl) = pack8(acc[ai][bj][m][0] * WSC, acc[ai][bj][m][1] * WSC);
        }
    }
};
struct EpiAtt { static constexpr bool HOOK = false; static constexpr bool CARRY = false; static DI float carry(const Unit&) { return 0.f; } static constexpr bool PERM = true;
    bf16_t* AQ;
    DI void operator()(const Acc& acc, const Unit& u, int wr, int wc, int fr, int fq) const {
        const int z = u.pm, n = z & 7, h = (z >> 3) & 3, b = z >> 5; const size_t t0 = (size_t)b * 2048 + n * 256;
#pragma unroll
        for (int ai = 0; ai < 2; ++ai)
#pragma unroll
            for (int m = 0; m < 4; ++m) {
                const int c = EPI_ROWS(ai, m);
#pragma unroll
                for (int bj = 0; bj < 2; ++bj) {
                    const int e0 = 128 * bj + 32 * wc + 8 * fq;
                    f32x4 v0 = acc[ai][bj][m][0], v1 = acc[ai][bj][m][1];
#pragma unroll
                    for (int j = 0; j < 4; ++j) { v0[j] = (c >= e0 + j) ? v0[j] : 0.f; v1[j] = (c >= e0 + 4 + j) ? v1[j] : 0.f; }
                    *(u32x4*)(AQ + ((t0 + c) * 4 + h) * 512 + e0) = pack8(v0, v1);
                }
            }
    }
};
struct EpiUT { static constexpr bool HOOK = false; static constexpr bool CARRY = false; static DI float carry(const Unit&) { return 0.f; } static constexpr bool PERM = true;
    bf16_t* UT;
    DI void operator()(const Acc& acc, const Unit& u, int wr, int wc, int fr, int fq) const {
        const size_t z = (size_t)(u.pm >> 1); const int half = u.pm & 1;
#pragma unroll
        for (int ai = 0; ai < 2; ++ai)
#pragma unroll
            for (int m = 0; m < 4; ++m) {
                bf16_t* rowp = UT + z * 131072 + (size_t)(half * 256 + EPI_ROWS(ai, m)) * 256 + 32 * wc + 8 * fq;
#pragma unroll
                for (int bj = 0; bj < 2; ++bj) *(u32x4*)(rowp + 128 * bj) = pack8(acc[ai][bj][m][0], acc[ai][bj][m][1]);
            }
    }
};
struct EpiUTScan { static constexpr bool HOOK = false; static constexpr bool CARRY = true; static constexpr bool PERM = true;
    static DI float carry(const Unit& u) { const int z = u.pm >> 1, n = z & 7, h = (z >> 3) & 3; return n == 7 ? 0.f : exp2f(256.0f * ret_lg2(h)); }
    bf16_t* VS;
    DI void operator()(const Acc& acc, const Unit& u, int wr, int wc, int fr, int fq) const {
        const size_t z = (size_t)(u.pm >> 1); const int half = u.pm & 1, n = (int)(z & 7), h = (int)((z >> 3) & 3);
        const float dec = exp2f(256.0f * ret_lg2(h));
#pragma unroll
        for (int ai = 0; ai < 2; ++ai)
#pragma unroll
            for (int m = 0; m < 4; ++m) {
                bf16_t* rowp = VS + (z * 512 + half * 256 + EPI_ROWS(ai, m)) * 512 + 256 + 32 * wc + 8 * fq;
#pragma unroll
                for (int bj = 0; bj < 2; ++bj) {
                    if (n == 0) { unsigned z0; asm volatile("v_mov_b32 %0, 0" : "=v"(z0)); *(u32x4*)(rowp + 128 * bj) = (u32x4){z0, z0, z0, z0}; }
                    if (n < 7) *(u32x4*)(rowp + (size_t)512 * 512 + 128 * bj) = pack8(acc[ai][bj][m][0] * dec, acc[ai][bj][m][1] * dec);
                }
            }
    }
};
struct SchedSeq { int nb, c;
    DI void init(int G, int c_) { nb = G / 2 > 0 ? G / 2 : 1; c = c_; }
    DI bool next(int i, Unit& u) const { if (c >= nb) return false; const int seq = c + (i >> 3) * nb; if (seq >= 128) return false;
        const int bh = seq >> 1, half = seq & 1, n = i & 7; u.pm = (bh * 8 + n) * 2 + half; u.pn = 0; return true; } };
struct EpiY { static constexpr bool HOOK = false; static constexpr bool CARRY = false; static DI float carry(const Unit&) { return 0.f; } static constexpr bool PERM = true;
    bf16_t* Y;
    DI void operator()(const Acc& acc, const Unit& u, int wr, int wc, int fr, int fq) const {
        const int z = u.pm, n = z & 7, h = (z >> 3) & 3, b = z >> 5; const size_t t0 = (size_t)b * 2048 + n * 256;
#pragma unroll
        for (int ai = 0; ai < 2; ++ai)
#pragma unroll
            for (int m = 0; m < 4; ++m) {
                bf16_t* rowp = Y + (t0 + EPI_ROWS(ai, m)) * 2048 + h * 512 + u.pn * 256 + 32 * wc + 8 * fq;
#pragma unroll
                for (int bj = 0; bj < 2; ++bj) *(u32x4*)(rowp + 128 * bj) = pack8(acc[ai][bj][m][0], acc[ai][bj][m][1]);
            }
    }
};
struct EpiGU { static constexpr bool HOOK = true; static constexpr bool CARRY = false; static DI float carry(const Unit&) { return 0.f; } static constexpr bool PERM = true;
    unsigned char* ACT; const float* bgu; const LAS int* ts;
    DI void prefetch(const Unit& u, LAS unsigned char* lds, int wid, int lane) const {
        if (wid == 0) { const int e = moe_tile_expert(ts, u.pm); const int ln = lane_now();
            const float* src = bgu + (size_t)e * 2048 + 128 * u.pn + ((ln & 32) ? 1024 : 0) + 4 * (ln & 31);
            __builtin_amdgcn_global_load_lds((const unsigned*)src, (LAS unsigned*)(lds + MISC_OFF + MO_RED), 16, 0, 0); }
    }
    DI void operator()(const Acc& acc, const Unit& u, int wr, int wc, int fr, int fq) const {
        const int w = 32 * wc + 8 * fq;
        const LAS float* bl_ = (const LAS float*)(ts) - MO_TS / 4 + MO_RED / 4 + w;
        const f32x4 bg0 = *(const LAS f32x4*)bl_, bg1 = *(const LAS f32x4*)(bl_ + 4), bl0 = *(const LAS f32x4*)(bl_ + 128), bl1 = *(const LAS f32x4*)(bl_ + 132);
#pragma unroll
        for (int ai = 0; ai < 2; ++ai)
#pragma unroll
            for (int m = 0; m < 4; ++m) {
                f32x4 g0 = acc[ai][0][m][0] * WSC + bg0, g1 = acc[ai][0][m][1] * WSC + bg1, l0 = acc[ai][1][m][0] * WSC + bl0, l1 = acc[ai][1][m][1] * WSC + bl1;
                const f32x4 seven = {7.f, 7.f, 7.f, 7.f}, mseven = {-7.f, -7.f, -7.f, -7.f};
                g0 = __builtin_elementwise_min(g0, seven); g1 = __builtin_elementwise_min(g1, seven);
                l0 = __builtin_elementwise_min(__builtin_elementwise_max(l0, mseven), seven); l1 = __builtin_elementwise_min(__builtin_elementwise_max(l1, mseven), seven);
                f32x4 e0 = g0 * (-1.702f * 1.44269504089f), e1 = g1 * (-1.702f * 1.44269504089f);
#pragma unroll
                for (int j = 0; j < 4; ++j) { e0[j] = __builtin_amdgcn_exp2f(e0[j]); e1[j] = __builtin_amdgcn_exp2f(e1[j]); }
                e0 = e0 + 1.0f; e1 = e1 + 1.0f;
#pragma unroll
                for (int j = 0; j < 4; ++j) { e0[j] = __builtin_amdgcn_rcpf(e0[j]); e1[j] = __builtin_amdgcn_rcpf(e1[j]); }
                g0 = g0 * e0 * (l0 + 1.0f); g1 = g1 * e1 * (l1 + 1.0f);
                u32x2 o8; o8.x = pk4_fp8(g0[0], g0[1], g0[2], g0[3]); o8.y = pk4_fp8(g1[0], g1[1], g1[2], g1[3]);
                *(u32x2*)(ACT + ((size_t)u.pm * 256 + EPI_ROWS(ai, m)) * 1024 + 128 * u.pn + w) = o8;
            }
    }
};
struct EpiDN { static constexpr bool HOOK = true; static constexpr bool CARRY = false; static DI float carry(const Unit&) { return 0.f; } static constexpr bool PERM = true;
    bf16_t* YB; const float* bdn; const LAS int* ts;
    DI void prefetch(const Unit& u, LAS unsigned char* lds, int wid, int lane) const {
        if (wid == 0) { const int e = moe_tile_expert(ts, u.pm); const int ln = lane_now();
            __builtin_amdgcn_global_load_lds((const unsigned*)(bdn + (size_t)e * 1024 + 256 * u.pn + 4 * ln), (LAS unsigned*)(lds + MISC_OFF + MO_RED), 16, 0, 0); }
    }
    DI void operator()(const Acc& acc, const Unit& u, int wr, int wc, int fr, int fq) const {
        const LAS float* bl_ = (const LAS float*)(ts) - MO_TS / 4 + MO_RED / 4;
#pragma unroll
        for (int bj = 0; bj < 2; ++bj) {
            const int cl = 128 * bj + 32 * wc + 8 * fq, col = 256 * u.pn + cl;
            const f32x4 b0 = *(const LAS f32x4*)(bl_ + cl), b1 = *(const LAS f32x4*)(bl_ + cl + 4);
#pragma unroll
            for (int ai = 0; ai < 2; ++ai)
#pragma unroll
                for (int m = 0; m < 4; ++m)
                    *(u32x4*)(YB + ((size_t)u.pm * 256 + EPI_ROWS(ai, m)) * 1024 + col) = pack8(acc[ai][bj][m][0] * (1.0f / 64.0f) + b0, acc[ai][bj][m][1] * (1.0f / 64.0f) + b1);
        }
    }
};
struct EpiPP { static constexpr bool HOOK = false; static constexpr bool CARRY = false; static DI float carry(const Unit&) { return 0.f; } static constexpr bool PERM = true;
    bf16_t* PP;
    DI void operator()(const Acc& acc, const Unit& u, int wr, int wc, int fr, int fq) const {
#pragma unroll
        for (int ai = 0; ai < 2; ++ai)
#pragma unroll
            for (int m = 0; m < 4; ++m) {
                bf16_t* rowp = PP + ((size_t)u.pm * 256 + EPI_ROWS(ai, m)) * 1024 + u.pn * 256 + 32 * wc + 8 * fq;
#pragma unroll
                for (int bj = 0; bj < 2; ++bj) *(u32x4*)(rowp + 128 * bj) = pack8(acc[ai][bj][m][0], acc[ai][bj][m][1]);
            }
    }
};
struct EpiPLE { static constexpr bool HOOK = false; static constexpr bool CARRY = false; static DI float carry(const Unit&) { return 0.f; } static constexpr bool PERM = true;
    bf16_t* H; const bf16_t* PP; float* out;
    DI void operator()(const Acc& acc, const Unit& u, int wr, int wc, int fr, int fq) const {
#pragma unroll
        for (int ai = 0; ai < 2; ++ai)
#pragma unroll
            for (int m = 0; m < 4; ++m) {
                const size_t off = (size_t)(u.pm * 256 + EPI_ROWS(ai, m)) * 1024 + u.pn * 256 + 32 * wc + 8 * fq;
#pragma unroll
                for (int bj = 0; bj < 2; ++bj) { const size_t o = off + 128 * bj;
                    const u32x4 pw = *(const u32x4*)(PP + o), hw = *(const u32x4*)(H + o); const f32x4 a0 = acc[ai][bj][m][0], a1 = acc[ai][bj][m][1];
                    f32x4 h0 = {bflo(hw.x), bfhi(hw.x), bflo(hw.y), bfhi(hw.y)}, h1 = {bflo(hw.z), bfhi(hw.z), bflo(hw.w), bfhi(hw.w)};
                    const f32x4 p0 = {bflo(pw.x), bfhi(pw.x), bflo(pw.y), bfhi(pw.y)}, p1 = {bflo(pw.z), bfhi(pw.z), bflo(pw.w), bfhi(pw.w)};
                    f32x4 e0 = a0 * (-WSC * 1.44269504089f), e1 = a1 * (-WSC * 1.44269504089f);
#pragma unroll
                    for (int j = 0; j < 4; ++j) { e0[j] = __builtin_amdgcn_exp2f(e0[j]); e1[j] = __builtin_amdgcn_exp2f(e1[j]); }
                    e0 = e0 + 1.0f; e1 = e1 + 1.0f;
#pragma unroll
                    for (int j = 0; j < 4; ++j) { e0[j] = __builtin_amdgcn_rcpf(e0[j]); e1[j] = __builtin_amdgcn_rcpf(e1[j]); }
                    h0 = h0 + e0 * p0; h1 = h1 + e1 * p1;
                    if (out) { *(f32x4*)(out + o) = h0; *(f32x4*)(out + o + 4) = h1; } else *(u32x4*)(H + o) = pack8(h0, h1);
                }
            }
    }
};

DI int vperm16(int key) { const int g = (key >> 2) & 3; const int ng = (g == 1) ? 2 : (g == 2) ? 1 : g; return (key & ~15) | (ng << 2) | (key & 3); }
template <int DV, int MODE>
DI void attn_unit(const int WID, LAS unsigned char* lds, const bf16_t* Qp, int ldq, const bf16_t* Kp, int ldk, const bf16_t* Vt, int ldvt, int q0, float slope, int dcut,
                  const unsigned* selp, bf16_t* Op, int ldo, float* impp) {
    constexpr int NRB = DV / 32;
    constexpr int KT_B = 64 * 128, VT_B = DV * 128, BUF_B = 2 * KT_B + 2 * VT_B;
    const int tid = opaque_tid(WID), w = __builtin_amdgcn_readfirstlane(tid >> 6), lane = tid & 63, r = lane & 31, hh = lane >> 5;
    const int qrow = q0 + 32 * w + r, qw_first = q0 + 32 * w, qw_last = qw_first + 31;
    const float LOG2E = 1.44269504089f;
    bf16x8 qf[4];
#pragma unroll
    for (int ks = 0; ks < 4; ++ks) qf[ks] = *(const bf16x8*)(Qp + (size_t)(32 * w + r) * ldq + 16 * ks + 8 * hh);
    unsigned selm = 0xffffffffu, orm = 0xffffffffu;
    if (MODE == 1) { selm = selp[32 * w + r]; orm = selm;
#pragma unroll
        for (int o = 1; o < 32; o <<= 1) orm |= shxu(orm, o); }
    const int nv = (MODE == 3) ? (qrow >= 31 ? ((qrow - 15) >> 4) : 0) : 0;
    const int nv_wmax = (MODE == 3) ? (qw_last >= 31 ? ((qw_last - 15) >> 4) : 0) : 0;
    int kt_lo = 0, kt_hi;
    if (MODE == 0 || MODE == 1) kt_hi = (q0 >> 6) + 4;
    else if (MODE == 2) { kt_hi = (q0 >> 6) + 4; const int lk = q0 - 511; kt_lo = lk > 0 ? (lk >> 6) : 0; }
    else kt_hi = 2;
    if (MODE != 3) { const int kmin = q0 - dcut; const int lo2 = kmin > 0 ? (kmin >> 6) : 0; kt_lo = lo2 > kt_lo ? lo2 : kt_lo; }
    f32x16 cb[2];
#pragma unroll
    for (int kk = 0; kk < 2; ++kk)
#pragma unroll
        for (int i = 0; i < 16; ++i) cb[kk][i] = (MODE == 3) ? 0.f : slope * (float)(32 * kk + 8 * (i >> 2) + (i & 3) + 4 * hh);
    f32x16 O[NRB];
#pragma unroll
    for (int rb = 0; rb < NRB; ++rb)
#pragma unroll
        for (int i = 0; i < 16; ++i) O[rb][i] = 0.f;
    float mrun = NEGF, lrun = 0.f;
    const int drow = tid >> 3, dpc = (tid & 7) ^ ((drow >> 1) & 7);
    const unsigned ldsw = (unsigned)w * 1024u;
#define AT_DMA(buf, sub, kt) do { const int kt_ = (kt) < 0 ? 0 : (kt); LAS unsigned char* b_ = lds + (buf) * BUF_B; \
        __builtin_amdgcn_global_load_lds((const unsigned*)(Kp + (size_t)(64 * kt_ + drow) * ldk + 8 * dpc), (LAS unsigned*)(b_ + (sub) * KT_B + ldsw), 16, 0, 0); \
        _Pragma("unroll") for (int i_ = 0; i_ < (DV + 63) / 64; ++i_) { if (64 * i_ + 64 <= DV || w < 4) \
            __builtin_amdgcn_global_load_lds((const unsigned*)(Vt + (size_t)(drow + 64 * i_) * ldvt + 64 * kt_ + 8 * dpc), (LAS unsigned*)(b_ + 2 * KT_B + (sub) * VT_B + i_ * 8192 + ldsw), 16, 0, 0); } } while (0)
    const int ntile = kt_hi - kt_lo, nstep = (ntile + 1) >> 1;
    AT_DMA(0, 0, kt_hi - 1); AT_DMA(0, 1, kt_hi - 2);
    asm volatile("s_waitcnt vmcnt(0)" ::: "memory");
    __syncthreads();
#if PROBE_ATT == 2
    AT_DMA(0, 0, kt_hi - 1); AT_DMA(0, 1, kt_hi - 2);
    asm volatile("s_waitcnt vmcnt(0)" ::: "memory");
    __syncthreads();
#endif
    const int sw = (r >> 1) & 7;
    for (int st = 0; st < nstep; ++st) {
        const int buf = st & 1;
        if (st + 1 < nstep) { AT_DMA(buf ^ 1, 0, kt_hi - 3 - 2 * st); AT_DMA(buf ^ 1, 1, kt_hi - 4 - 2 * st); }
#pragma unroll
        for (int sub = 0; sub < 2; ++sub) {
        const int kt = kt_hi - 1 - 2 * st - sub, key0 = 64 * kt;
        bool skip;
        if (MODE == 0) skip = key0 > qw_last;
        else if (MODE == 1) skip = (key0 > qw_last) || !((orm >> (kt & 31)) & 1u);
        else if (MODE == 2) skip = (key0 > qw_last) || (key0 + 63 < qw_first - 511);
        else skip = key0 >= nv_wmax;
        skip = skip || (kt < kt_lo);
        if (!skip) {
            const LAS unsigned char* kb = lds + buf * BUF_B + sub * KT_B; const LAS unsigned char* vb = lds + buf * BUF_B + 2 * KT_B + sub * VT_B;
            f32x16 S[2];
#pragma unroll
            for (int kk = 0; kk < 2; ++kk) {
                S[kk] = cb[kk];
#pragma unroll
                for (int ks = 0; ks < 4; ++ks) { const bf16x8 a = *(const LAS bf16x8*)(kb + (32 * kk + r) * 128 + (((2 * ks + hh) ^ sw) << 4));
                    S[kk] = __builtin_amdgcn_mfma_f32_32x32x16_bf16(a, qf[ks], S[kk], 0, 0, 0); }
            }
            const bool bnd = (MODE == 3) ? true : ((key0 + 63 > qw_first) || (MODE == 2 && key0 < qw_last - 511));
            if (bnd) {
                const int lim = (MODE == 3) ? (nv - key0 - 4 * hh) : (qrow - key0 - 4 * hh);
#pragma unroll
                for (int kk = 0; kk < 2; ++kk)
#pragma unroll
                    for (int i = 0; i < 16; ++i) { const int cki = 32 * kk + 8 * (i >> 2) + (i & 3);
                        bool valid;
                        if (MODE == 3) valid = cki < lim; else if (MODE == 2) valid = (cki <= lim) && (cki > lim - 512); else valid = cki <= lim;
                        S[kk][i] = valid ? S[kk][i] : NEGF; }
            }
            float mx = NEGF;
#pragma unroll
            for (int kk = 0; kk < 2; ++kk)
#pragma unroll
                for (int i = 0; i < 16; ++i) mx = fmaxf(mx, S[kk][i]);
            mx = fmaxf(mx, shx(mx, 32));
            const float off = (MODE == 3) ? 0.f : slope * (float)key0;
            mx += off;
            bool selok = true;
            if (MODE == 1) { selok = ((selm >> (kt & 31)) & 1u) != 0u; mx = selok ? mx : NEGF; }
            const float mnew = fmaxf(mrun, mx);
            const float meff = (mnew < -1e29f) ? 0.f : mnew;
            float c = (off - meff) * LOG2E;
            if (MODE == 1) c = selok ? c : NEGF;
#pragma unroll
            for (int kk = 0; kk < 2; ++kk) { f32x16 t = S[kk] * LOG2E + c;
#pragma unroll
                for (int i = 0; i < 16; ++i) t[i] = __builtin_amdgcn_exp2f(t[i]);
                S[kk] = t; }
            float ps;
            { typedef float f32x8 __attribute__((ext_vector_type(8)));
              const f32x16 su = S[0] + S[1];
              const f32x8 s8 = __builtin_shufflevector(su, su, 0, 1, 2, 3, 4, 5, 6, 7) + __builtin_shufflevector(su, su, 8, 9, 10, 11, 12, 13, 14, 15);
              const f32x4 s4 = __builtin_shufflevector(s8, s8, 0, 1, 2, 3) + __builtin_shufflevector(s8, s8, 4, 5, 6, 7);
              ps = (s4[0] + s4[1]) + (s4[2] + s4[3]); }
            if (__any(mnew > mrun)) {
                const float alpha = __builtin_amdgcn_exp2f((mrun - mnew) * LOG2E);
                lrun *= alpha;
#pragma unroll
                for (int rb = 0; rb < NRB; ++rb)
#pragma unroll
                    for (int i = 0; i < 16; ++i) O[rb][i] *= alpha;
            }
            mrun = mnew; lrun += ps;
#pragma unroll
            for (int kk = 0; kk < 2; ++kk)
#pragma unroll
                for (int s2 = 0; s2 < 2; ++s2) {
                    u32x4 pw; pw.x = pk2(S[kk][8 * s2 + 0], S[kk][8 * s2 + 1]); pw.y = pk2(S[kk][8 * s2 + 2], S[kk][8 * s2 + 3]);
                    pw.z = pk2(S[kk][8 * s2 + 4], S[kk][8 * s2 + 5]); pw.w = pk2(S[kk][8 * s2 + 6], S[kk][8 * s2 + 7]);
                    const bf16x8 pf = __builtin_bit_cast(bf16x8, pw);
#pragma unroll
                    for (int rb = 0; rb < NRB; ++rb) {
                        const bf16x8 a = *(const LAS bf16x8*)(vb + (32 * rb + r) * 128 + ((((2 * kk + s2) * 2 + hh) ^ sw) << 4));
                        O[rb] = __builtin_amdgcn_mfma_f32_32x32x16_bf16(a, pf, O[rb], 0, 0, 0);
                    }
                }
        }
        }
        asm volatile("s_waitcnt vmcnt(0)" ::: "memory");
        __syncthreads();
    }
#undef AT_DMA
    const float ltot = lrun + shx(lrun, 32);
    float inv = 1.0f / ltot;
    if (MODE == 3) inv = (nv > 0) ? inv : 0.f;
#if PROBE_ATT == 1
    for (int rep_ = 0; rep_ < 2; ++rep_) { asm volatile("" ::: "memory");
#endif
#pragma unroll
    for (int rb = 0; rb < NRB; ++rb)
#pragma unroll
        for (int g4 = 0; g4 < 4; ++g4) {
            const float a = O[rb][4 * g4] * inv, b = O[rb][4 * g4 + 1] * inv, c = O[rb][4 * g4 + 2] * inv, d = O[rb][4 * g4 + 3] * inv;
            const int dv = 32 * rb + 8 * g4 + 4 * hh;
            if (MODE == 3 && rb == 2) { *(f32x4*)(impp + (size_t)(32 * w + r) * 256 + (dv - 64)) = (f32x4){a, b, c, d}; }
            else { u32x2 o; o.x = pk2(a, b); o.y = pk2(c, d); *(u32x2*)(Op + (size_t)(32 * w + r) * ldo + dv) = o; }
        }
#if PROBE_ATT == 1
    }
#endif
}

DI void diff_unit(const int WID, LAS unsigned char* lds, const bf16_t* Q1p, const bf16_t* Q2p, const bf16_t* K1p, const bf16_t* K2p, const bf16_t* Vt, int q0, float slope, int dcut,
                  const float lam, const float oscale, const float* og, unsigned char* Ap) {
    constexpr int DV = 128, MODE = 0, ldq = 512, ldk = 512, ldvt = 2048;
    constexpr int NRB = DV / 32;
    constexpr int KT_B = 64 * 128, VT_B = DV * 128, BUF_B = 2 * KT_B + 2 * VT_B;
    const int tid = opaque_tid(WID), w = __builtin_amdgcn_readfirstlane(tid >> 6), lane = tid & 63, r = lane & 31, hh = lane >> 5;
    const int qrow = q0 + 32 * w + r, qw_first = q0 + 32 * w, qw_last = qw_first + 31;
    const float LOG2E = 1.44269504089f;
    unsigned selm = 0xffffffffu, orm = 0xffffffffu;
    const int nv = (MODE == 3) ? (qrow >= 31 ? ((qrow - 15) >> 4) : 0) : 0;
    const int nv_wmax = (MODE == 3) ? (qw_last >= 31 ? ((qw_last - 15) >> 4) : 0) : 0;
    int kt_lo = 0, kt_hi;
    if (MODE == 0 || MODE == 1) kt_hi = (q0 >> 6) + 4;
    else if (MODE == 2) { kt_hi = (q0 >> 6) + 4; const int lk = q0 - 511; kt_lo = lk > 0 ? (lk >> 6) : 0; }
    else kt_hi = 2;
    if (MODE != 3) { const int kmin = q0 - dcut; const int lo2 = kmin > 0 ? (kmin >> 6) : 0; kt_lo = lo2 > kt_lo ? lo2 : kt_lo; }
    f32x16 cb0;
#pragma unroll
    for (int i = 0; i < 16; ++i) cb0[i] = slope * (float)(8 * (i >> 2) + (i & 3) + 4 * hh);
    const float slope32 = 32.0f * slope;
    const int drow = tid >> 3, dpc = (tid & 7) ^ ((drow >> 1) & 7);
    const unsigned ldsw = (unsigned)w * 1024u;
#define AT_DMA(buf, sub, kt) do { const int kt_ = (kt) < 0 ? 0 : (kt); LAS unsigned char* b_ = lds + (buf) * BUF_B; \
        __builtin_amdgcn_global_load_lds((const unsigned*)(Kp + (size_t)(64 * kt_ + drow) * ldk + 8 * dpc), (LAS unsigned*)(b_ + (sub) * KT_B + ldsw), 16, 0, 0); \
        _Pragma("unroll") for (int i_ = 0; i_ < (DV + 63) / 64; ++i_) { if (64 * i_ + 64 <= DV || w < 4) \
            __builtin_amdgcn_global_load_lds((const unsigned*)(Vt + (size_t)(drow + 64 * i_) * ldvt + 64 * kt_ + 8 * dpc), (LAS unsigned*)(b_ + 2 * KT_B + (sub) * VT_B + i_ * 8192 + ldsw), 16, 0, 0); } } while (0)
    const int ntile = kt_hi - kt_lo, nstep = (ntile + 1) >> 1;
    const int sw = (r >> 1) & 7;
    u32x4 O1p[NRB][2];
#pragma unroll 1
    for (int pass = 0; pass < 2; ++pass) {
    const bf16_t* Qp = pass ? Q2p : Q1p; const bf16_t* Kp = pass ? K2p : K1p;
    bf16x8 qf[4];
#pragma unroll
    for (int ks = 0; ks < 4; ++ks) qf[ks] = *(const bf16x8*)(Qp + (size_t)(32 * w + r) * ldq + 16 * ks + 8 * hh);
    f32x16 O[NRB];
#pragma unroll
    for (int rb = 0; rb < NRB; ++rb)
#pragma unroll
        for (int i = 0; i < 16; ++i) O[rb][i] = 0.f;
    float mrun = NEGF, lrun = 0.f;
    AT_DMA(0, 0, kt_hi - 1); AT_DMA(0, 1, kt_hi - 2);
    asm volatile("s_waitcnt vmcnt(0)" ::: "memory");
    __syncthreads();
    for (int st = 0; st < nstep; ++st) {
        const int buf = st & 1;
        if (st + 1 < nstep) { AT_DMA(buf ^ 1, 0, kt_hi - 3 - 2 * st); AT_DMA(buf ^ 1, 1, kt_hi - 4 - 2 * st); }
#pragma unroll
        for (int sub = 0; sub < 2; ++sub) {
        const int kt = kt_hi - 1 - 2 * st - sub, key0 = 64 * kt;
        bool skip;
        if (MODE == 0) skip = key0 > qw_last;
        else if (MODE == 1) skip = (key0 > qw_last) || !((orm >> (kt & 31)) & 1u);
        else if (MODE == 2) skip = (key0 > qw_last) || (key0 + 63 < qw_first - 511);
        else skip = key0 >= nv_wmax;
        skip = skip || (kt < kt_lo);
        if (!skip) {
            const LAS unsigned char* kb = lds + buf * BUF_B + sub * KT_B; const LAS unsigned char* vb = lds + buf * BUF_B + 2 * KT_B + sub * VT_B;
            f32x16 S[2];
#pragma unroll
            for (int kk = 0; kk < 2; ++kk) {
                if (kk == 0) S[0] = cb0; else S[1] = cb0 + slope32;
#pragma unroll
                for (int ks = 0; ks < 4; ++ks) { const bf16x8 a = *(const LAS bf16x8*)(kb + (32 * kk + r) * 128 + (((2 * ks + hh) ^ sw) << 4));
                    S[kk] = __builtin_amdgcn_mfma_f32_32x32x16_bf16(a, qf[ks], S[kk], 0, 0, 0); }
            }
            const bool bnd = (MODE == 3) ? true : ((key0 + 63 > qw_first) || (MODE == 2 && key0 < qw_last - 511));
            if (bnd) {
                const int lim = (MODE == 3) ? (nv - key0 - 4 * hh) : (qrow - key0 - 4 * hh);
#pragma unroll
                for (int kk = 0; kk < 2; ++kk)
#pragma unroll
                    for (int i = 0; i < 16; ++i) { const int cki = 32 * kk + 8 * (i >> 2) + (i & 3);
                        bool valid;
                        if (MODE == 3) valid = cki < lim; else if (MODE == 2) valid = (cki <= lim) && (cki > lim - 512); else valid = cki <= lim;
                        S[kk][i] = valid ? S[kk][i] : NEGF; }
            }
            float mx = NEGF;
#pragma unroll
            for (int kk = 0; kk < 2; ++kk)
#pragma unroll
                for (int i = 0; i < 16; ++i) mx = fmaxf(mx, S[kk][i]);
            mx = fmaxf(mx, shx(mx, 32));
            const float off = (MODE == 3) ? 0.f : slope * (float)key0;
            mx += off;
            bool selok = true;
            if (MODE == 1) { selok = ((selm >> (kt & 31)) & 1u) != 0u; mx = selok ? mx : NEGF; }
            const float mnew = fmaxf(mrun, mx);
            const float meff = (mnew < -1e29f) ? 0.f : mnew;
            float c = (off - meff) * LOG2E;
            if (MODE == 1) c = selok ? c : NEGF;
#pragma unroll
            for (int kk = 0; kk < 2; ++kk) { f32x16 t = S[kk] * LOG2E + c;
#pragma unroll
                for (int i = 0; i < 16; ++i) t[i] = __builtin_amdgcn_exp2f(t[i]);
                S[kk] = t; }
            float ps;
            { typedef float f32x8 __attribute__((ext_vector_type(8)));
              const f32x16 su = S[0] + S[1];
              const f32x8 s8 = __builtin_shufflevector(su, su, 0, 1, 2, 3, 4, 5, 6, 7) + __builtin_shufflevector(su, su, 8, 9, 10, 11, 12, 13, 14, 15);
              const f32x4 s4 = __builtin_shufflevector(s8, s8, 0, 1, 2, 3) + __builtin_shufflevector(s8, s8, 4, 5, 6, 7);
              ps = (s4[0] + s4[1]) + (s4[2] + s4[3]); }
            if (__any(mnew > mrun)) {
                const float alpha = __builtin_amdgcn_exp2f((mrun - mnew) * LOG2E);
                lrun *= alpha;
#pragma unroll
                for (int rb = 0; rb < NRB; ++rb)
#pragma unroll
                    for (int i = 0; i < 16; ++i) O[rb][i] *= alpha;
            }
            mrun = mnew; lrun += ps;
#pragma unroll
            for (int kk = 0; kk < 2; ++kk)
#pragma unroll
                for (int s2 = 0; s2 < 2; ++s2) {
                    u32x4 pw; pw.x = pk2(S[kk][8 * s2 + 0], S[kk][8 * s2 + 1]); pw.y = pk2(S[kk][8 * s2 + 2], S[kk][8 * s2 + 3]);
                    pw.z = pk2(S[kk][8 * s2 + 4], S[kk][8 * s2 + 5]); pw.w = pk2(S[kk][8 * s2 + 6], S[kk][8 * s2 + 7]);
                    const bf16x8 pf = __builtin_bit_cast(bf16x8, pw);
#pragma unroll
                    for (int rb = 0; rb < NRB; ++rb) {
                        const bf16x8 a = *(const LAS bf16x8*)(vb + (32 * rb + r) * 128 + ((((2 * kk + s2) * 2 + hh) ^ sw) << 4));
                        O[rb] = __builtin_amdgcn_mfma_f32_32x32x16_bf16(a, pf, O[rb], 0, 0, 0);
                    }
                }
        }
        }
        asm volatile("s_waitcnt vmcnt(0)" ::: "memory");
        __syncthreads();
    }
#undef AT_DMA
    const float ltot = lrun + shx(lrun, 32);
    const float inv = 1.0f / ltot;
    if (pass == 0) {
#pragma unroll
        for (int rb = 0; rb < NRB; ++rb) { const f32x16 on = O[rb] * inv;
            O1p[rb][0] = (u32x4){pk2(on[0], on[1]), pk2(on[2], on[3]), pk2(on[4], on[5]), pk2(on[6], on[7])};
            O1p[rb][1] = (u32x4){pk2(on[8], on[9]), pk2(on[10], on[11]), pk2(on[12], on[13]), pk2(on[14], on[15])}; }
    } else {
        const float li = lam * inv; float ss = 0.f;
#pragma unroll
        for (int rb = 0; rb < NRB; ++rb) {
            const u32x4 p0 = O1p[rb][0], p1 = O1p[rb][1];
            const f32x16 o1 = {bflo(p0.x), bfhi(p0.x), bflo(p0.y), bfhi(p0.y), bflo(p0.z), bfhi(p0.z), bflo(p0.w), bfhi(p0.w), bflo(p1.x), bfhi(p1.x), bflo(p1.y), bfhi(p1.y), bflo(p1.z), bfhi(p1.z), bflo(p1.w), bfhi(p1.w)};
            O[rb] = o1 - O[rb] * li;
#pragma unroll
            for (int i = 0; i < 16; ++i) ss += O[rb][i] * O[rb][i];
        }
        ss += shx(ss, 32);
        const float rs = rsqrtf(ss * (1.0f / 128.0f) + EPS) * (oscale * A_SC);
        const int hg_ = lane_now() >> 5;
#pragma unroll
        for (int rb = 0; rb < NRB; ++rb)
#pragma unroll
            for (int g4 = 0; g4 < 4; ++g4) { const int dv = 32 * rb + 8 * g4 + 4 * hh; const f32x4 gg = *(const f32x4*)(og + 32 * rb + 8 * g4 + 4 * hg_);
                *(unsigned*)(Ap + (size_t)(32 * w + r) * 1024 + dv) = pk4_fp8(O[rb][4 * g4] * rs * gg[0], O[rb][4 * g4 + 1] * rs * gg[1], O[rb][4 * g4 + 2] * rs * gg[2], O[rb][4 * g4 + 3] * rs * gg[3]); }
    }
    }
}

template <int DV, int MODE>
DI void nsa_unit(const int WID, LAS unsigned char* lds, const bf16x8 (&qf)[4], const bf16_t* Kp, int ldk, const bf16_t* Vt, int ldvt, int q0, int g, float sb2,
                 const LAS unsigned* selp, f32x16 (&OB)[2], const float gate, LAS float* impp) {
    constexpr int NRB = DV / 32;
    constexpr int KT_B = 64 * 128, VT_B = DV * 128, BUF_B = 2 * KT_B + 2 * VT_B;
    const int tid = opaque_tid(WID), w = __builtin_amdgcn_readfirstlane(tid >> 6), lane = tid & 63, r = lane & 31, hh = lane >> 5;
    const int hr = w >> 1, qh = w & 1;
    const float slope = (MODE == 1) ? exp2f(-(float)(4 * g + hr + 1)) : 0.f;
    const int dcut = (MODE == 1) ? (int)fminf(sb2 / slope + 1.0f, 100000.0f) : 0, dcut_max = (MODE == 1) ? (int)fminf(sb2 * exp2f((float)(4 * g + 4)) + 1.0f, 100000.0f) : 0;
    const int qrow = q0 + 32 * qh + r, qw_first = q0 + 32 * qh, qw_last = qw_first + 31;
    const float LOG2E = 1.44269504089f;
    unsigned selm = 0xffffffffu, orm = 0xffffffffu;
    if (MODE == 1) { selm = selp[32 * qh + r]; orm = selm;
#pragma unroll
        for (int o = 1; o < 32; o <<= 1) orm |= shxu(orm, o); }
    const int nv = (MODE == 3) ? (qrow >= 31 ? ((qrow - 15) >> 4) : 0) : 0;
    const int nv_wmax = (MODE == 3) ? (qw_last >= 31 ? ((qw_last - 15) >> 4) : 0) : 0;
    int kt_lo = 0, kt_hi;
    if (MODE == 1) kt_hi = (q0 >> 6) + 1; else kt_hi = 2;
    if (MODE != 3) { const int kmin = q0 - dcut_max; const int lo2 = kmin > 0 ? (kmin >> 6) : 0; kt_lo = lo2 > kt_lo ? lo2 : kt_lo; }
    f32x16 cb[2];
#pragma unroll
    for (int kk = 0; kk < 2; ++kk)
#pragma unroll
        for (int i = 0; i < 16; ++i) cb[kk][i] = (MODE == 3) ? 0.f : slope * (float)(32 * kk + 8 * (i >> 2) + (i & 3) + 4 * hh);
    f32x16 O[NRB];
#pragma unroll
    for (int rb = 0; rb < NRB; ++rb)
#pragma unroll
        for (int i = 0; i < 16; ++i) O[rb][i] = 0.f;
    float mrun = NEGF, lrun = 0.f;
    const int drow = tid >> 3, dpc = (tid & 7) ^ ((drow >> 1) & 7);
    const unsigned ldsw = (unsigned)w * 1024u;
#define AT_DMA(buf, sub, kt) do { const int kt_ = (kt) < 0 ? 0 : (kt); LAS unsigned char* b_ = lds + (buf) * BUF_B; \
        __builtin_amdgcn_global_load_lds((const unsigned*)(Kp + (size_t)(64 * kt_ + drow) * ldk + 8 * dpc), (LAS unsigned*)(b_ + (sub) * KT_B + ldsw), 16, 0, 0); \
        _Pragma("unroll") for (int i_ = 0; i_ < (DV + 63) / 64; ++i_) { if (64 * i_ + 64 <= DV || w < 4) \
            __builtin_amdgcn_global_load_lds((const unsigned*)(Vt + (size_t)(drow + 64 * i_) * ldvt + 64 * kt_ + 8 * dpc), (LAS unsigned*)(b_ + 2 * KT_B + (sub) * VT_B + i_ * 8192 + ldsw), 16, 0, 0); } } while (0)
    const int ntile = kt_hi - kt_lo, nstep = (ntile + 1) >> 1;
    AT_DMA(0, 0, kt_hi - 1); AT_DMA(0, 1, kt_hi - 2);
    asm volatile("s_waitcnt vmcnt(0)" ::: "memory");
    __syncthreads();
    const int sw = (r >> 1) & 7;
    for (int st = 0; st < nstep; ++st) {
        const int buf = st & 1;
        if (st + 1 < nstep) { AT_DMA(buf ^ 1, 0, kt_hi - 3 - 2 * st); AT_DMA(buf ^ 1, 1, kt_hi - 4 - 2 * st); }
#pragma unroll
        for (int sub = 0; sub < 2; ++sub) {
        const int kt = kt_hi - 1 - 2 * st - sub, key0 = 64 * kt;
        bool skip;
        if (MODE == 0) skip = key0 > qw_last;
        else if (MODE == 1) skip = (key0 > qw_last) || !((orm >> (kt & 31)) & 1u) || (key0 + 63 < qw_first - dcut);
        else if (MODE == 2) skip = (key0 > qw_last) || (key0 + 63 < qw_first - 511);
        else skip = key0 >= nv_wmax;
        skip = skip || (kt < kt_lo);
        if (!skip) {
            const LAS unsigned char* kb = lds + buf * BUF_B + sub * KT_B; const LAS unsigned char* vb = lds + buf * BUF_B + 2 * KT_B + sub * VT_B;
            f32x16 S[2];
#pragma unroll
            for (int kk = 0; kk < 2; ++kk) {
                S[kk] = cb[kk];
#pragma unroll
                for (int ks = 0; ks < 4; ++ks) { const bf16x8 a = *(const LAS bf16x8*)(kb + (32 * kk + r) * 128 + (((2 * ks + hh) ^ sw) << 4));
                    S[kk] = __builtin_amdgcn_mfma_f32_32x32x16_bf16(a, qf[ks], S[kk], 0, 0, 0); }
            }
            const bool bnd = (MODE == 3) ? true : ((key0 + 63 > qw_first) || (MODE == 2 && key0 < qw_last - 511));
            if (bnd) {
                const int lim = (MODE == 3) ? (nv - key0 - 4 * hh) : (qrow - key0 - 4 * hh);
#pragma unroll
                for (int kk = 0; kk < 2; ++kk)
#pragma unroll
                    for (int i = 0; i < 16; ++i) { const int cki = 32 * kk + 8 * (i >> 2) + (i & 3);
                        bool valid;
                        if (MODE == 3) valid = cki < lim; else if (MODE == 2) valid = (cki <= lim) && (cki > lim - 512); else valid = cki <= lim;
                        S[kk][i] = valid ? S[kk][i] : NEGF; }
            }
            float mx = NEGF;
#pragma unroll
            for (int kk = 0; kk < 2; ++kk)
#pragma unroll
                for (int i = 0; i < 16; ++i) mx = fmaxf(mx, S[kk][i]);
            mx = fmaxf(mx, shx(mx, 32));
            const float off = (MODE == 3) ? 0.f : slope * (float)key0;
            mx += off;
            bool selok = true;
            if (MODE == 1) { selok = ((selm >> (kt & 31)) & 1u) != 0u; mx = selok ? mx : NEGF; }
            const float mnew = fmaxf(mrun, mx);
            const float meff = (mnew < -1e29f) ? 0.f : mnew;
            float c = (off - meff) * LOG2E;
            if (MODE == 1) c = selok ? c : NEGF;
#pragma unroll
            for (int kk = 0; kk < 2; ++kk) { f32x16 t = S[kk] * LOG2E + c;
#pragma unroll
                for (int i = 0; i < 16; ++i) t[i] = __builtin_amdgcn_exp2f(t[i]);
                S[kk] = t; }
            float ps;
            { typedef float f32x8 __attribute__((ext_vector_type(8)));
              const f32x16 su = S[0] + S[1];
              const f32x8 s8 = __builtin_shufflevector(su, su, 0, 1, 2, 3, 4, 5, 6, 7) + __builtin_shufflevector(su, su, 8, 9, 10, 11, 12, 13, 14, 15);
              const f32x4 s4 = __builtin_shufflevector(s8, s8, 0, 1, 2, 3) + __builtin_shufflevector(s8, s8, 4, 5, 6, 7);
              ps = (s4[0] + s4[1]) + (s4[2] + s4[3]); }
            if (__any(mnew > mrun)) {
                const float alpha = __builtin_amdgcn_exp2f((mrun - mnew) * LOG2E);
                lrun *= alpha;
#pragma unroll
                for (int rb = 0; rb < NRB; ++rb)
#pragma unroll
                    for (int i = 0; i < 16; ++i) O[rb][i] *= alpha;
            }
            mrun = mnew; lrun += ps;
#pragma unroll
            for (int kk = 0; kk < 2; ++kk)
#pragma unroll
                for (int s2 = 0; s2 < 2; ++s2) {
                    u32x4 pw; pw.x = pk2(S[kk][8 * s2 + 0], S[kk][8 * s2 + 1]); pw.y = pk2(S[kk][8 * s2 + 2], S[kk][8 * s2 + 3]);
                    pw.z = pk2(S[kk][8 * s2 + 4], S[kk][8 * s2 + 5]); pw.w = pk2(S[kk][8 * s2 + 6], S[kk][8 * s2 + 7]);
                    const bf16x8 pf = __builtin_bit_cast(bf16x8, pw);
#pragma unroll
                    for (int rb = 0; rb < NRB; ++rb) {
                        const bf16x8 a = *(const LAS bf16x8*)(vb + (32 * rb + r) * 128 + ((((2 * kk + s2) * 2 + hh) ^ sw) << 4));
                        O[rb] = __builtin_amdgcn_mfma_f32_32x32x16_bf16(a, pf, O[rb], 0, 0, 0);
                    }
                }
        }
        }
        asm volatile("s_waitcnt vmcnt(0)" ::: "memory");
        __syncthreads();
    }
#undef AT_DMA
    const float ltot = lrun + shx(lrun, 32);
    float inv = 1.0f / ltot;
    if (MODE == 3) inv = (nv > 0) ? inv : 0.f;
    const float gi = inv * gate;
#pragma unroll
    for (int rb = 0; rb < 2; ++rb) OB[rb] += O[rb] * gi;
    if (MODE == 3) {
#pragma unroll
        for (int g4 = 0; g4 < 4; ++g4)
            *(LAS f32x4*)(impp + (hr * 64 + 32 * qh + r) * 32 + 8 * g4 + 4 * hh) = (f32x4){O[2][4 * g4] * inv, O[2][4 * g4 + 1] * inv, O[2][4 * g4 + 2] * inv, O[2][4 * g4 + 3] * inv};
    }
}


struct Args { const float* in[26]; float* out; unsigned char* ws; int ph_lo, ph_hi; };
typedef const __attribute__((address_space(4))) Args* ArgsP;
DI ArgsP opaque_args() { auto p = __builtin_amdgcn_kernarg_segment_ptr(); asm volatile("" : "+s"(p)); return (ArgsP)p; }
enum { I_X = 0, I_P, I_N1G, I_N2G, I_EVWIN, I_EVWOUT, I_DAQN, I_DAKN, I_DALAM, I_DAOUTG, I_NSQN, I_NSKN, I_CMPPE, I_CMPW1, I_CMPW2, I_ODWIN, I_ODWOUT,
       I_RETG, I_ROUTW, I_ROUTB, I_WGU, I_BGU, I_WDN, I_BDN, I_PLEP, I_PLEG };

struct CvtJob { int in_idx, ldsrc, K, col0, ncols, dstrow0, perm, nmat; size_t src_stride, dst_off, dst_stride; int fp8, pad; };
constexpr int NJOBS = 19;
__constant__ CvtJob c_jobs[NJOBS] = {
    {I_EVWIN, EVIN, 1024, 0,    1024, 0,    1, 2, (size_t)1024 * EVIN, WS_EVNAT, (size_t)2048 * 1024, 0, 0},
    {I_EVWIN, EVIN, 1024, 1536, 512,  1024, 1, 2, (size_t)1024 * EVIN, WS_EVNAT, (size_t)2048 * 1024, 0, 0},
    {I_EVWIN, EVIN, 1024, 2048, 128,  1536, 1, 2, (size_t)1024 * EVIN, WS_EVNAT, (size_t)2048 * 1024, 0, 0},
    {I_EVWIN, EVIN, 1024, 2176, 128,  1664, 1, 2, (size_t)1024 * EVIN, WS_EVNAT, (size_t)2048 * 1024, 0, 0},
    {I_EVWIN, EVIN, 1024, 2304, 128,  1792, 1, 2, (size_t)1024 * EVIN, WS_EVNAT, (size_t)2048 * 1024, 0, 0},
    {I_EVWIN, EVIN, 1024, 2560, 128,  1920, 1, 2, (size_t)1024 * EVIN, WS_EVNAT, (size_t)2048 * 1024, 0, 0},
    {I_EVWIN, EVIN, 1024, 1024, 512,  0,    0, 2, (size_t)1024 * EVIN, WS_EVSW,  (size_t)768 * 1024, 0, 0},
    {I_EVWIN, EVIN, 1024, 2432, 128,  512,  0, 2, (size_t)1024 * EVIN, WS_EVSW,  (size_t)768 * 1024, 0, 0},
    {I_EVWIN, EVIN, 1024, 2688, 128,  640,  0, 2, (size_t)1024 * EVIN, WS_EVSW,  (size_t)768 * 1024, 0, 0},
    {I_EVWOUT, 1024, 1024, 0, 1024, 0, 0, 2, (size_t)1024 * 1024, WS_EVOUT, (size_t)1024 * 1024, 64, 0},
    {I_CMPW1, 256, 2048, 0, 256, 0, 0, 4, (size_t)2048 * 256, WS_CMP1, (size_t)256 * 2048, 0, 0},
    {I_ODWIN, ODIN, 1024, 0,    2048, 0,    0, 2, (size_t)1024 * ODIN, WS_ODNAT, (size_t)4096 * 1024, 32, 0},
    {I_ODWIN, ODIN, 1024, 4096, 2048, 2048, 0, 2, (size_t)1024 * ODIN, WS_ODNAT, (size_t)4096 * 1024, 32, 0},
    {I_ODWIN, ODIN, 1024, 2048, 2048, 0,    0, 2, (size_t)1024 * ODIN, WS_ODSW,  (size_t)2048 * 1024, 32, 0},
    {I_ODWOUT, 1024, 2048, 0, 1024, 0, 0, 2, (size_t)2048 * 1024, WS_ODOUT, (size_t)1024 * 2048, 128, 0},
    {I_WGU, 2048, 1024, 0, 2048, 0, 2, 128, (size_t)1024 * 2048, WS_WGU, (size_t)2048 * 1024, 32, 0},
    {I_WDN, 1024, 1024, 0, 1024, 0, 0, 128, (size_t)1024 * 1024, WS_WDN, (size_t)1024 * 1024, 64, 0},
    {I_PLEP, 1024, 256, 0, 1024, 0, 0, 4, (size_t)256 * 1024, WS_WPP, (size_t)1024 * 256, 0, 0},
    {I_PLEG, 1024, 1024, 0, 1024, 0, 0, 4, (size_t)1024 * 1024, WS_WPG, (size_t)1024 * 1024, 32, 0},
};
DI int cvt_dstrow(int perm, int L) {
    if (perm == 1) { const int pn = L >> 8, lc = L & 255; return pn * 256 + 128 * ((lc & 63) >> 5) + 32 * (lc >> 6) + (lc & 31); }
    if (perm == 2) { const int bj = L >> 10, cc = L & 1023; return 256 * (cc >> 7) + 128 * bj + (cc & 127); }
    return L;
}
DI void phase_prologue(const int WID, ArgsP a, LAS unsigned char* lds) {
    const int tid = opaque_tid(WID), lane = tid & 63, wv = tid >> 6;
    const int gw = blockIdx.x * 8 + wv, NGW = gridDim.x * 8;
    LAS float* scr = (LAS float*)(lds + wv * 16896);
    int total = 0;
    for (int j = 0; j < NJOBS; ++j) total += c_jobs[j].nmat * (c_jobs[j].K >> 6) * (c_jobs[j].ncols >> 6);
#define PRO_DECODE(IT, JJ, MAT, K0, N0, SRC, RS) do { int r_ = (IT), j_ = 0; \
        for (; j_ < NJOBS; ++j_) { const int n_ = c_jobs[j_].nmat * (c_jobs[j_].K >> 6) * (c_jobs[j_].ncols >> 6); if (r_ < n_) break; r_ -= n_; } \
        JJ = j_; const bool f8_ = c_jobs[j_].fp8 != 0; const int nkb_ = f8_ ? (c_jobs[j_].K >> 7) : (c_jobs[j_].K >> 6), nnb_ = f8_ ? (c_jobs[j_].ncols >> 5) : (c_jobs[j_].ncols >> 6), per_ = nkb_ * nnb_; \
        MAT = r_ / per_; const int rr_ = r_ % per_; K0 = (rr_ / nnb_) * (f8_ ? 128 : 64); N0 = (rr_ % nnb_) * (f8_ ? 32 : 64); const int ld_ = c_jobs[j_].ldsrc; \
        SRC = a->in[c_jobs[j_].in_idx] + (size_t)MAT * c_jobs[j_].src_stride + (size_t)K0 * ld_ + c_jobs[j_].col0 + N0 + (f8_ ? (lane & 31) + (lane >> 5) * ld_ : lane); RS = f8_ ? 2 * ld_ : ld_; } while (0)
    float tv[64];
    int jn = 0, matn = 0, k0n = 0, n0n = 0, rsn = 0; const float* srcn = nullptr;
    if (gw < total) { PRO_DECODE(gw, jn, matn, k0n, n0n, srcn, rsn);
#pragma unroll
        for (int i = 0; i < 64; ++i) tv[i] = srcn[(size_t)i * rsn]; }
    for (int it = gw; it < total; it += NGW) {
        const CvtJob J = c_jobs[jn]; const int mat = matn, k0 = k0n, n0 = n0n;
        { const int wb = J.fp8 ? (lane >> 5) * 33 + (lane & 31) : lane, wst = J.fp8 ? 66 : 65;
#pragma unroll
          for (int i = 0; i < 64; ++i) scr[wb + i * wst] = tv[i]; }
        if (it + NGW < total) { PRO_DECODE(it + NGW, jn, matn, k0n, n0n, srcn, rsn);
#if PROBE_PRO == 2
            { float sink = 0.f;
#pragma unroll
              for (int i = 0; i < 64; ++i) sink += ((const volatile float*)srcn)[(size_t)i * rsn];
              asm volatile("" :: "v"(sink)); }
#endif
#pragma unroll
            for (int i = 0; i < 64; ++i) tv[i] = srcn[(size_t)i * rsn]; }
        asm volatile("s_waitcnt lgkmcnt(0)" ::: "memory");
        if (J.fp8) {
            unsigned char* dst = (unsigned char*)(a->ws + J.dst_off) + (size_t)mat * J.dst_stride;
            const int c = lane & 7, nsub = lane >> 3; const float W8_S = (float)J.fp8;
#pragma unroll
            for (int jj = 0; jj < 4; ++jj) {
                const int n = nsub + 8 * jj; const LAS float* s = scr + (16 * c) * 33 + n;
                u32x4 o;
                o.x = pk4_fp8(s[0] * W8_S, s[33] * W8_S, s[2 * 33] * W8_S, s[3 * 33] * W8_S); o.y = pk4_fp8(s[4 * 33] * W8_S, s[5 * 33] * W8_S, s[6 * 33] * W8_S, s[7 * 33] * W8_S);
                o.z = pk4_fp8(s[8 * 33] * W8_S, s[9 * 33] * W8_S, s[10 * 33] * W8_S, s[11 * 33] * W8_S); o.w = pk4_fp8(s[12 * 33] * W8_S, s[13 * 33] * W8_S, s[14 * 33] * W8_S, s[15 * 33] * W8_S);
                const int drow = cvt_dstrow(J.perm, J.dstrow0 + n0 + n);
                *(u32x4*)(dst + (size_t)drow * J.K + k0 + 16 * c) = o;
#if PROBE_PRO == 1
                asm volatile("" ::: "memory"); *(u32x4*)(dst + (size_t)drow * J.K + k0 + 16 * c) = o;
#endif
            }
        } else {
            bf16_t* dst = (bf16_t*)(a->ws + J.dst_off) + (size_t)mat * J.dst_stride;
            const int c = lane & 7, nsub = lane >> 3;
#pragma unroll
            for (int jj = 0; jj < 8; ++jj) {
                const int n = nsub + 8 * jj; const LAS float* s = scr + (8 * c) * 65 + n;
                u32x4 o; o.x = pk2(s[0], s[65]); o.y = pk2(s[2 * 65], s[3 * 65]); o.z = pk2(s[4 * 65], s[5 * 65]); o.w = pk2(s[6 * 65], s[7 * 65]);
                const int drow = cvt_dstrow(J.perm, J.dstrow0 + n0 + n);
                *(u32x4*)(dst + (size_t)drow * J.K + k0 + 8 * c) = o;
#if PROBE_PRO == 1
                asm volatile("" ::: "memory"); *(u32x4*)(dst + (size_t)drow * J.K + k0 + 8 * c) = o;
#endif
            }
        }
        asm volatile("s_waitcnt lgkmcnt(0)" ::: "memory");
    }
#undef PRO_DECODE
    {
        const float* p = a->in[I_P]; bf16_t* pb = (bf16_t*)(a->ws + WS_PBF);
        const size_t n8 = (size_t)DEPTH * T * 256 / 8;
        const size_t st = (size_t)gridDim.x * 512;
        size_t i = (size_t)blockIdx.x * 512 + tid;
        for (; i + 3 * st < n8; i += 4 * st) {
            f32x4 v[4][2];
#pragma unroll
            for (int u = 0; u < 4; ++u) { v[u][0] = *(const f32x4*)(p + (i + u * st) * 8); v[u][1] = *(const f32x4*)(p + (i + u * st) * 8 + 4); }
#pragma unroll
            for (int u = 0; u < 4; ++u) *(u32x4*)(pb + (i + u * st) * 8) = pack8(v[u][0], v[u][1]);
        }
        for (; i < n8; i += st) { const f32x4 v0 = *(const f32x4*)(p + i * 8), v1 = *(const f32x4*)(p + i * 8 + 4); *(u32x4*)(pb + i * 8) = pack8(v0, v1); }
    }
    if (blockIdx.x == 4 && tid < 512) { const int ev = tid >> 8, gi = (tid >> 6) & 3, d = tid & 63;
        const float* src = a->in[gi == 0 ? I_DAQN : gi == 1 ? I_DAKN : gi == 2 ? I_NSQN : I_NSKN];
        ((float*)(a->ws + WS_GAINS))[tid] = src[ev * 64 + d]; }
    if (blockIdx.x < 4 && tid < 256) {
        const int m = blockIdx.x; const float* pe = a->in[I_CMPPE] + (size_t)m * 2048; const float* w1 = a->in[I_CMPW1] + (size_t)m * 2048 * 256;
        float s = 0.f;
        for (int k = 0; k < 2048; ++k) s += pe[k] * w1[(size_t)k * 256 + tid];
        ((float*)(a->ws + WS_BIAS1))[m * 256 + tid] = s;
    }
}

DI float row_load_ss(const float* row, int lane, f32x4 (&v)[4]) {
    float ss = 0.f;
#pragma unroll
    for (int j = 0; j < 4; ++j) { v[j] = *(const f32x4*)(row + 4 * lane + 256 * j); ss += (v[j][0] * v[j][0] + v[j][1] * v[j][1]) + (v[j][2] * v[j][2] + v[j][3] * v[j][3]); }
    return wave_sum(ss);
}
DI void row_store_bf16(bf16_t* row, int lane, const f32x4 (&v)[4]) {
#pragma unroll
    for (int j = 0; j < 4; ++j) { u32x2 o; o.x = pk2(v[j][0], v[j][1]); o.y = pk2(v[j][2], v[j][3]); *(u32x2*)(row + 4 * lane + 256 * j) = o; }
}
template <int MODE>
DI void phase_norm(const int WID, ArgsP a, LAS unsigned char* lds, int layer, const void* Hin, const bool hb) {
    const int tid = opaque_tid(WID), lane = tid & 63, wv = __builtin_amdgcn_readfirstlane(tid >> 6);
    LAS float* wt = (LAS float*)lds;
    LAS int* bcl = (LAS int*)(lds + MISC_OFF + MO_WCNT); LAS int* ent = (LAS int*)(lds + MISC_OFF + MO_ENT); LAS float* gat = (LAS float*)(lds + MISC_OFF + MO_GAT);
    LAS float* lgb = (LAS float*)(lds + MISC_OFF + MO_RED);
    bf16_t* XN = (bf16_t*)(a->ws + WS_XN);
    const float* gain = a->in[MODE == 2 ? I_N2G : I_N1G] + layer * 1024;
    constexpr int NQ = MODE == 0 ? 24 : (MODE == 2 ? 32 : 0);
    if (NQ > 0) {
        const float* w = (MODE == 0) ? a->in[I_EVWIN] + (size_t)(layer >> 1) * 1024 * EVIN + 2816 : a->in[I_ROUTW] + (size_t)layer * 1024 * 32;
        const int ldw = (MODE == 0) ? EVIN : 32;
        for (int i = tid; i < 256 * 32; i += 512) { const int q = i & 31, g = i >> 5;
            if (q < NQ) { f32x4 v; v[0] = w[(size_t)(4 * g) * ldw + q]; v[1] = w[(size_t)(4 * g + 1) * ldw + q]; v[2] = w[(size_t)(4 * g + 2) * ldw + q]; v[3] = w[(size_t)(4 * g + 3) * ldw + q];
                *(LAS f32x4*)(wt + q * 1024 + 4 * (g ^ q)) = v; } }
    }
    f32x4 gn[4];
#pragma unroll
    for (int j = 0; j < 4; ++j) gn[j] = *(const f32x4*)(gain + 4 * lane + 256 * j);
    const float rbias = (MODE == 2) ? a->in[I_ROUTB][layer * 32 + (lane & 31)] : 0.f;
    __syncthreads();
    for (int vb = blockIdx.x; vb < NTB; vb += gridDim.x) {
        if (MODE == 2) { if (tid < 32) bcl[tid] = 0; }
        const int t0 = vb * 128 + wv * 16;
        f32x4 na[4], nb[4];
#pragma unroll
        for (int j = 0; j < 4; ++j) { na[j] = ld_h4(Hin, hb, (size_t)t0 * 1024 + 4 * lane + 256 * j); nb[j] = ld_h4(Hin, hb, (size_t)(t0 + 1) * 1024 + 4 * lane + 256 * j); }
#pragma unroll 1
        for (int it = 0; it < 8; ++it) {
            const int ta = t0 + 2 * it;
            f32x4 va[4], vc[4];
#pragma unroll
            for (int j = 0; j < 4; ++j) { va[j] = na[j]; vc[j] = nb[j]; }
            if (it < 7) {
#pragma unroll
                for (int j = 0; j < 4; ++j) { na[j] = ld_h4(Hin, hb, (size_t)(ta + 2) * 1024 + 4 * lane + 256 * j); nb[j] = ld_h4(Hin, hb, (size_t)(ta + 3) * 1024 + 4 * lane + 256 * j); }
            }
            float sa = 0.f, sb = 0.f;
#pragma unroll
            for (int j = 0; j < 4; ++j) { sa += (va[j][0] * va[j][0] + va[j][1] * va[j][1]) + (va[j][2] * va[j][2] + va[j][3] * va[j][3]); sb += (vc[j][0] * vc[j][0] + vc[j][1] * vc[j][1]) + (vc[j][2] * vc[j][2] + vc[j][3] * vc[j][3]); }
#pragma unroll
            for (int o = 1; o < 64; o <<= 1) { sa += shxl(sa, o, lane); sb += shxl(sb, o, lane); }
            const float ra = rsqrtf(sa * (1.0f / 1024.0f) + EPS), rb2 = rsqrtf(sb * (1.0f / 1024.0f) + EPS);
#pragma unroll
            for (int j = 0; j < 4; ++j) { va[j] = va[j] * ra * gn[j]; vc[j] = vc[j] * rb2 * gn[j]; }
            if (MODE == 1) {
                unsigned char* X8 = (unsigned char*)XN;
#pragma unroll
                for (int j = 0; j < 4; ++j) { *(unsigned*)(X8 + (size_t)ta * 1024 + 4 * lane + 256 * j) = pk4_fp8(va[j][0], va[j][1], va[j][2], va[j][3]);
                    *(unsigned*)(X8 + (size_t)(ta + 1) * 1024 + 4 * lane + 256 * j) = pk4_fp8(vc[j][0], vc[j][1], vc[j][2], vc[j][3]); }
            } else { row_store_bf16(XN + (size_t)ta * 1024, lane, va); row_store_bf16(XN + (size_t)(ta + 1) * 1024, lane, vc); }
            if (NQ > 0) {
                float x[64];
#pragma unroll
                for (int q = 0; q < 32; ++q) {
                    if (q < NQ) { f32x4 a0 = {0.f, 0.f, 0.f, 0.f}, a1 = a0;
#pragma unroll
                        for (int j = 0; j < 4; ++j) { const f32x4 ww = *(const LAS f32x4*)(wt + q * 1024 + 4 * ((lane + 64 * j) ^ q)); a0 += va[j] * ww; a1 += vc[j] * ww; }
                        x[q] = (a0[0] + a0[1]) + (a0[2] + a0[3]); x[32 + q] = (a1[0] + a1[1]) + (a1[2] + a1[3]);
                        if ((q & 3) == 3) asm volatile("" ::: "memory");
                    } else { x[q] = 0.f; x[32 + q] = 0.f; }
                }
#define RS_STEP(N, BIT) _Pragma("unroll") for (int i = 0; i < (N); ++i) { const bool up = (lane & (BIT)) != 0; const float keep = up ? x[(N) + i] : x[i], send = up ? x[i] : x[(N) + i]; x[i] = keep + shxl(send, (BIT), lane); }
                RS_STEP(32, 32) RS_STEP(16, 16) RS_STEP(8, 8) RS_STEP(4, 4) RS_STEP(2, 2) RS_STEP(1, 1)
#undef RS_STEP
                const float val = x[0];
                if (MODE == 0) { if ((lane & 31) < 24) ((float*)(a->ws + WS_GATES))[(size_t)(ta + (lane >> 5)) * 24 + (lane & 31)] = sigm(val); }
                if (MODE == 2) {
                    const float myv = val + rbias; const int mye = lane & 31;
                    lgb[wv * 64 + lane] = myv;
                    asm volatile("s_waitcnt lgkmcnt(0)" ::: "memory");
                    int rank = 0;
#pragma unroll
                    for (int q4 = 0; q4 < 8; ++q4) { const f32x4 t4 = *(const LAS f32x4*)(lgb + wv * 64 + (lane & 32) + 4 * q4);
#pragma unroll
                        for (int e = 0; e < 4; ++e) { const int j = 4 * q4 + e; rank += ((t4[e] > myv) || (t4[e] == myv && j < mye)) ? 1 : 0; } }
                    const int eb = wv * 64 + (2 * it + (lane >> 5)) * 4;
                    if (rank < 4) { ent[eb + rank] = mye; gat[eb + rank] = myv; }
                    asm volatile("s_waitcnt lgkmcnt(0)" ::: "memory");
                    const f32x4 tv = *(const LAS f32x4*)(gat + eb);
                    const float sum = 1.0f + __expf(tv[1] - tv[0]) + __expf(tv[2] - tv[0]) + __expf(tv[3] - tv[0]);
                    asm volatile("s_waitcnt lgkmcnt(0)" ::: "memory");
                    if (rank < 4) gat[eb + rank] = __expf(myv - tv[0]) / sum;
                    asm volatile("s_waitcnt lgkmcnt(0)" ::: "memory");
                }
            }
        }
        if (MODE == 2) {
            __syncthreads();
            { const int e = ent[wv * 64 + lane];
              const int pos = __hip_atomic_fetch_add(bcl + e, 1, __ATOMIC_RELAXED, __HIP_MEMORY_SCOPE_WORKGROUP);
              const size_t idx = (size_t)(vb * 128 + wv * 16) * 4 + lane;
              ((int*)(a->ws + WS_TOPE))[idx] = e; ((int*)(a->ws + WS_POSB))[idx] = pos; ((float*)(a->ws + WS_GATEW))[idx] = gat[wv * 64 + lane]; }
            __syncthreads();
            if (tid < 32) ((int*)(a->ws + WS_BCNT))[((size_t)layer * NTB + vb) * 32 + tid] = bcl[tid];
            __syncthreads();
        }
    }
}
template <int MODE>
DI void phase_norm_mm(const int WID, ArgsP a, LAS unsigned char* lds, int layer, const void* Hin, const bool hb) {
    const int tid = opaque_tid(WID), lane = tid & 63, wv = __builtin_amdgcn_readfirstlane(tid >> 6);
    const int r = lane & 15, kg = lane >> 4;
    LAS float* lgb = (LAS float*)(lds + 131072);
    LAS float* gl = (LAS float*)(lds + MISC_OFF + MO_RED);
    LAS int* bcl = (LAS int*)(lds + MISC_OFF + MO_WCNT); LAS int* ent = (LAS int*)(lds + MISC_OFF + MO_ENT); LAS float* gat = (LAS float*)(lds + MISC_OFF + MO_GAT);
    bf16_t* XN = (bf16_t*)(a->ws + WS_XN);
    const float* gain = a->in[MODE == 2 ? I_N2G : I_N1G] + layer * 1024;
    constexpr int NQ = MODE == 0 ? 24 : 32;
    {
        const float* w = (MODE == 0) ? a->in[I_EVWIN] + (size_t)(layer >> 1) * 1024 * EVIN + 2816 : a->in[I_ROUTW] + (size_t)layer * 1024 * 32;
        const int ldw = (MODE == 0) ? EVIN : 32;
#pragma unroll 2
        for (int i = tid; i < 4096; i += 512) { const int q = i & 31, c = i >> 5; const int qq = q < NQ ? q : NQ - 1;
            const f32x4 g0 = *(const f32x4*)(gain + 8 * c), g1 = *(const f32x4*)(gain + 8 * c + 4);
            const float* wp = w + (size_t)(8 * c) * ldw + qq;
            f32x4 v0, v1;
#pragma unroll
            for (int e = 0; e < 4; ++e) { v0[e] = wp[(size_t)e * ldw]; v1[e] = wp[(size_t)(4 + e) * ldw]; }
            v0 = v0 * g0; v1 = v1 * g1;
            if (q >= NQ) { v0 = (f32x4){0.f, 0.f, 0.f, 0.f}; v1 = v0; }
            const u32x4 hi = pack8(v0, v1);
            const f32x4 r0 = {v0[0] - bflo(hi.x), v0[1] - bfhi(hi.x), v0[2] - bflo(hi.y), v0[3] - bfhi(hi.y)};
            const f32x4 r1 = {v1[0] - bflo(hi.z), v1[1] - bfhi(hi.z), v1[2] - bflo(hi.w), v1[3] - bfhi(hi.w)};
            const int off = q * 2048 + ((c ^ (q & 15)) << 4);
            *(LAS u32x4*)(lds + off) = hi; *(LAS u32x4*)(lds + 65536 + off) = pack8(r0, r1); }
        if (tid < 256) *(LAS f32x4*)(gl + 4 * tid) = *(const f32x4*)(gain + 4 * tid);
    }
    f32x4 rb0 = {0.f, 0.f, 0.f, 0.f}, rb1 = rb0;
    if (MODE == 2) { rb0 = *(const f32x4*)(a->in[I_ROUTB] + layer * 32 + 4 * kg); rb1 = *(const f32x4*)(a->in[I_ROUTB] + layer * 32 + 16 + 4 * kg); }
    __syncthreads();
    for (int vb = blockIdx.x; vb < NTB; vb += gridDim.x) {
        if (MODE == 2) { if (tid < 32) bcl[tid] = 0; }
        const int t0 = vb * 128 + wv * 16;
        u32x4 hp[16][2];
        if (hb) { const bf16_t* src = (const bf16_t*)Hin + (size_t)(t0 + r) * 1024 + 16 * kg;
#pragma unroll
            for (int S = 0; S < 16; ++S) { hp[S][0] = *(const u32x4*)(src + 64 * S); hp[S][1] = *(const u32x4*)(src + 64 * S + 8); }
        } else { const float* src = (const float*)Hin + (size_t)(t0 + r) * 1024 + 16 * kg;
#pragma unroll
            for (int S = 0; S < 16; ++S) { const f32x4 x0 = *(const f32x4*)(src + 64 * S), x1 = *(const f32x4*)(src + 64 * S + 4), x2 = *(const f32x4*)(src + 64 * S + 8), x3 = *(const f32x4*)(src + 64 * S + 12);
                hp[S][0] = pack8(x0, x1); hp[S][1] = pack8(x2, x3); }
        }
        f32x4 acc0 = {0.f, 0.f, 0.f, 0.f}, acc1 = acc0;
        float ss = 0.f;
        const int ob = r * 2048;
#pragma unroll
        for (int S = 0; S < 16; ++S) {
#pragma unroll
            for (int hf = 0; hf < 2; ++hf) {
                const u32x4 hv = hp[S][hf];
#pragma unroll
                for (int e = 0; e < 4; ++e) { const float lo = bflo(hv[e]), hi = bfhi(hv[e]); ss = fmaf(lo, lo, ss); ss = fmaf(hi, hi, ss); }
                const bf16x8 hf8 = __builtin_bit_cast(bf16x8, hv);
                const int off = ob + (S >> 1) * 256 + ((((S & 1) * 8 + 2 * kg + hf) ^ r) << 4);
                acc0 = __builtin_amdgcn_mfma_f32_16x16x32_bf16(*(const LAS bf16x8*)(lds + off), hf8, acc0, 0, 0, 0);
                acc0 = __builtin_amdgcn_mfma_f32_16x16x32_bf16(*(const LAS bf16x8*)(lds + 65536 + off), hf8, acc0, 0, 0, 0);
                acc1 = __builtin_amdgcn_mfma_f32_16x16x32_bf16(*(const LAS bf16x8*)(lds + 32768 + off), hf8, acc1, 0, 0, 0);
                acc1 = __builtin_amdgcn_mfma_f32_16x16x32_bf16(*(const LAS bf16x8*)(lds + 98304 + off), hf8, acc1, 0, 0, 0);
            }
            asm volatile("" ::: "memory");
        }
        ss += shxl(ss, 16, lane); ss += shxl(ss, 32, lane);
        const float rs = rsqrtf(ss * (1.0f / 1024.0f) + EPS);
        { bf16_t* dst = XN + (size_t)(t0 + r) * 1024 + 16 * kg;
#pragma unroll
          for (int S = 0; S < 16; ++S) {
#pragma unroll
              for (int hf = 0; hf < 2; ++hf) { u32x4 hv = hp[S][hf];
                  asm volatile("" : "+v"(hv));
                  const f32x4 g0 = *(const LAS f32x4*)(gl + 64 * S + 16 * kg + 8 * hf), g1 = *(const LAS f32x4*)(gl + 64 * S + 16 * kg + 8 * hf + 4);
                  const f32x4 x0 = (f32x4){bflo(hv.x), bfhi(hv.x), bflo(hv.y), bfhi(hv.y)} * rs * g0, x1 = (f32x4){bflo(hv.z), bfhi(hv.z), bflo(hv.w), bfhi(hv.w)} * rs * g1;
                  if (MODE == 2) *(u32x2*)((unsigned char*)XN + (size_t)(t0 + r) * 1024 + 64 * S + 16 * kg + 8 * hf) = pack8_fp8(x0, x1);
                  else *(u32x4*)(dst + 64 * S + 8 * hf) = pack8(x0, x1); }
              asm volatile("" ::: "memory"); } }
        const f32x4 v0 = acc0 * rs + rb0, v1 = acc1 * rs + rb1;
        if (MODE == 0) { float* G = (float*)(a->ws + WS_GATES) + (size_t)(t0 + r) * 24;
            *(f32x4*)(G + 4 * kg) = (f32x4){sigm(v0[0]), sigm(v0[1]), sigm(v0[2]), sigm(v0[3])};
            if (kg < 2) *(f32x4*)(G + 16 + 4 * kg) = (f32x4){sigm(v1[0]), sigm(v1[1]), sigm(v1[2]), sigm(v1[3])}; }
        if (MODE == 2) {
#pragma unroll 1
            for (int h = 0; h < 2; ++h) {
                if ((r >> 3) == h) { *(LAS f32x4*)(lgb + wv * 256 + (r & 7) * 32 + 4 * kg) = v0; *(LAS f32x4*)(lgb + wv * 256 + (r & 7) * 32 + 16 + 4 * kg) = v1; }
                asm volatile("s_waitcnt lgkmcnt(0)" ::: "memory");
#pragma unroll 1
                for (int it = 4 * h; it < 4 * h + 4; ++it) {
                    const int mye = lane & 31;
                    const LAS float* lrow = lgb + wv * 256 + ((2 * it + (lane >> 5)) & 7) * 32;
                    const float myv = lrow[mye];
                    int rank = 0;
#pragma unroll
                    for (int q4 = 0; q4 < 8; ++q4) { const f32x4 t4 = *(const LAS f32x4*)(lrow + 4 * q4);
#pragma unroll
                        for (int e = 0; e < 4; ++e) { const int j = 4 * q4 + e; rank += ((t4[e] > myv) || (t4[e] == myv && j < mye)) ? 1 : 0; } }
                    const int eb = wv * 64 + (2 * it + (lane >> 5)) * 4;
                    if (rank < 4) { ent[eb + rank] = mye; gat[eb + rank] = myv; }
                    asm volatile("s_waitcnt lgkmcnt(0)" ::: "memory");
                    const f32x4 tv = *(const LAS f32x4*)(gat + eb);
                    const float sum = 1.0f + __expf(tv[1] - tv[0]) + __expf(tv[2] - tv[0]) + __expf(tv[3] - tv[0]);
                    asm volatile("s_waitcnt lgkmcnt(0)" ::: "memory");
                    if (rank < 4) gat[eb + rank] = __expf(myv - tv[0]) / sum;
                    asm volatile("s_waitcnt lgkmcnt(0)" ::: "memory");
                }
            }
            __syncthreads();
            { const int e = ent[wv * 64 + lane];
              const int pos = __hip_atomic_fetch_add(bcl + e, 1, __ATOMIC_RELAXED, __HIP_MEMORY_SCOPE_WORKGROUP);
              const size_t idx = (size_t)(vb * 128 + wv * 16) * 4 + lane;
              ((int*)(a->ws + WS_TOPE))[idx] = e; ((int*)(a->ws + WS_POSB))[idx] = pos; ((float*)(a->ws + WS_GATEW))[idx] = gat[wv * 64 + lane]; }
            __syncthreads();
            if (tid < 32) ((int*)(a->ws + WS_BCNT))[((size_t)layer * NTB + vb) * 32 + tid] = bcl[tid];
            __syncthreads();
        }
    }
}
DI void moe_tables(const int WID, ArgsP a, LAS unsigned char* lds, int layer, int vb) {
    const int tid = opaque_tid(WID);
    LAS int* tot = (LAS int*)(lds + MISC_OFF + MO_TOT); LAS int* base = (LAS int*)(lds + MISC_OFF + MO_BASE); LAS int* ts = (LAS int*)(lds + MISC_OFF + MO_TS);
    LAS int* red = (LAS int*)(lds + MISC_OFF + MO_RED);
    const int* bc = (const int*)(a->ws + WS_BCNT) + (size_t)layer * NTB * 32;
    { const int e = tid & 31, part = tid >> 5; int st = 0, sp = 0;
      for (int blk = part; blk < NTB; blk += 16) { const int v = bc[blk * 32 + e]; st += v; sp += (blk < vb) ? v : 0; }
      red[part * 32 + e] = st; red[512 + part * 32 + e] = sp; }
    __syncthreads();
    if (tid < 32) { int st = 0, sp = 0;
#pragma unroll
        for (int p = 0; p < 16; ++p) { st += red[p * 32 + tid]; sp += red[512 + p * 32 + tid]; }
        tot[tid] = st; base[tid] = sp; }
    __syncthreads();
    if (tid == 0) { int acc = 0; for (int e = 0; e < 32; ++e) { ts[e] = acc; acc += (tot[e] + 255) >> 8; } ts[32] = acc; }
    __syncthreads();
}
DI void phase_moe_slots(const int WID, ArgsP a, LAS unsigned char* lds, int layer) {
    const int tid = opaque_tid(WID);
    LAS int* base = (LAS int*)(lds + MISC_OFF + MO_BASE); LAS int* ts = (LAS int*)(lds + MISC_OFF + MO_TS); LAS int* tot = (LAS int*)(lds + MISC_OFF + MO_TOT);
    int* TOK = (int*)(a->ws + WS_TOK);
    for (int vb = blockIdx.x; vb < NTB; vb += gridDim.x) {
        moe_tables(WID, a, lds, layer, vb);
        { const int t = vb * 128 + (tid >> 2);
          const int e = ((const int*)(a->ws + WS_TOPE))[(size_t)vb * 512 + tid], pos = ((const int*)(a->ws + WS_POSB))[(size_t)vb * 512 + tid];
          const int dest = ts[e] * 256 + base[e] + pos; ((int*)(a->ws + WS_DEST))[(size_t)vb * 512 + tid] = dest; TOK[dest] = t; }
        if (vb < 32) { const int e = vb, lo = ts[e] * 256 + tot[e], hi = ts[e + 1] * 256;
            for (int i = lo + tid; i < hi; i += 512) TOK[i] = 0; }
        __syncthreads();
    }
}
DI void phase_combine(const int WID, ArgsP a, bf16_t* H) {
    const int tid = opaque_tid(WID), lane = tid & 63, wv = tid >> 6;
    const bf16_t* YB = (const bf16_t*)(a->ws + WS_YB); unsigned char* XN8 = (unsigned char*)(a->ws + WS_XN);
    const int G8 = gridDim.x * 8;
    const int* DEST = (const int*)(a->ws + WS_DEST); const float* GW = (const float*)(a->ws + WS_GATEW);
    int t = blockIdx.x * 8 + wv;
    int dA = 0, dB = 0; float gA = 0.f, gB = 0.f;
    if (lane < 4) { if (t < T) { dA = DEST[(size_t)t * 4 + lane]; gA = GW[(size_t)t * 4 + lane]; } if (t + G8 < T) { dB = DEST[(size_t)(t + G8) * 4 + lane]; gB = GW[(size_t)(t + G8) * 4 + lane]; } }
    for (; t < T; t += 2 * G8) {
        const int tA = t, tB = (t + G8 < T) ? t + G8 : t;
        const int cdA = dA, cdB = (t + G8 < T) ? dB : dA; const float cgA = gA, cgB = (t + G8 < T) ? gB : gA;
        u32x2 hA[4], hB[4], yA[4][4], yB[4][4];
#pragma unroll
        for (int j = 0; j < 4; ++j) { hA[j] = *(const u32x2*)(H + (size_t)tA * 1024 + 4 * lane + 256 * j); hB[j] = *(const u32x2*)(H + (size_t)tB * 1024 + 4 * lane + 256 * j); }
#pragma unroll
        for (int k = 0; k < 4; ++k) { const bf16_t* y = YB + (size_t)__builtin_amdgcn_readlane(cdA, k) * 1024 + 4 * lane;
#pragma unroll
            for (int j = 0; j < 4; ++j) yA[k][j] = *(const u32x2*)(y + 256 * j); }
#pragma unroll
        for (int k = 0; k < 4; ++k) { const bf16_t* y = YB + (size_t)__builtin_amdgcn_readlane(cdB, k) * 1024 + 4 * lane;
#pragma unroll
            for (int j = 0; j < 4; ++j) yB[k][j] = *(const u32x2*)(y + 256 * j); }
        { const int tn = t + 2 * G8;
          if (lane < 4) { if (tn < T) { dA = DEST[(size_t)tn * 4 + lane]; gA = GW[(size_t)tn * 4 + lane]; } if (tn + G8 < T) { dB = DEST[(size_t)(tn + G8) * 4 + lane]; gB = GW[(size_t)(tn + G8) * 4 + lane]; } } }
        asm volatile("" ::: "memory");
#pragma unroll
        for (int rr = 0; rr < 2; ++rr) {
            const int tt = rr ? tB : tA; const float cg = rr ? cgB : cgA;
            f32x4 v[4];
#pragma unroll
            for (int j = 0; j < 4; ++j) { const u32x2 w = rr ? hB[j] : hA[j]; v[j] = (f32x4){bflo(w.x), bfhi(w.x), bflo(w.y), bfhi(w.y)}; }
#pragma unroll
            for (int k = 0; k < 4; ++k) { const float g = __builtin_bit_cast(float, __builtin_amdgcn_readlane(__builtin_bit_cast(int, cg), k));
#pragma unroll
                for (int j = 0; j < 4; ++j) { const u32x2 w = rr ? yB[k][j] : yA[k][j]; v[j][0] += g * bflo(w.x); v[j][1] += g * bfhi(w.x); v[j][2] += g * bflo(w.y); v[j][3] += g * bfhi(w.y); } }
            float ss = 0.f;
#pragma unroll
            for (int j = 0; j < 4; ++j) { u32x2 hw; hw.x = pk2(v[j][0], v[j][1]); hw.y = pk2(v[j][2], v[j][3]); *(u32x2*)(H + (size_t)tt * 1024 + 4 * lane + 256 * j) = hw; ss += (v[j][0] * v[j][0] + v[j][1] * v[j][1]) + (v[j][2] * v[j][2] + v[j][3] * v[j][3]); }
#pragma unroll
            for (int o = 1; o < 64; o <<= 1) ss += shxl(ss, o, lane);
            const float rstd = rsqrtf(ss * (1.0f / 1024.0f) + EPS);
#pragma unroll
            for (int j = 0; j < 4; ++j) v[j] = v[j] * rstd;
#pragma unroll
            for (int j = 0; j < 4; ++j) *(unsigned*)(XN8 + (size_t)tt * 1024 + 4 * lane + 256 * j) = pk4_fp8(v[j][0], v[j][1], v[j][2], v[j][3]);
        }
    }
}
DI void phase_cmp2(const int WID, ArgsP a, LAS unsigned char* lds, int ev) {
    const int tid = opaque_tid(WID), lane = tid & 63, wv = __builtin_amdgcn_readfirstlane(tid >> 6);
    const bf16_t* HID = (const bf16_t*)(a->ws + WS_HID); bf16_t* KCMP = (bf16_t*)(a->ws + WS_KCMP); bf16_t* VCMPT = (bf16_t*)(a->ws + WS_VCMPT);
    const float kg = a->in[I_NSKN][ev * 64 + lane];
    LAS float* wl = (LAS float*)lds;
    for (int i = tid; i < 2 * 256 * 64 / 4; i += 512) *(LAS f32x4*)(wl + 4 * i) = *(const f32x4*)(a->in[I_CMPW2] + (size_t)ev * 2 * 256 * 64 + 4 * i);
    __syncthreads();
    for (int gi = blockIdx.x * 8 + wv; gi < 2048; gi += gridDim.x * 8) {
        const int kv = gi >> 10, row0 = (gi & 1023) * 4;
        const bf16_t* hrow = HID + ((size_t)kv * 4096 + row0) * 256;
        const LAS float* w2 = wl + kv * 256 * 64 + lane;
        float s[4] = {0.f, 0.f, 0.f, 0.f};
#pragma unroll 2
        for (int k = 0; k < 256; k += 8) {
            u32x4 hw[4];
#pragma unroll
            for (int r = 0; r < 4; ++r) hw[r] = *(const u32x4*)(hrow + r * 256 + k);
            float wv8[8];
#pragma unroll
            for (int j = 0; j < 8; ++j) wv8[j] = w2[(k + j) * 64];
#pragma unroll
            for (int r = 0; r < 4; ++r)
                s[r] += bflo(hw[r].x) * wv8[0] + bfhi(hw[r].x) * wv8[1] + bflo(hw[r].y) * wv8[2] + bfhi(hw[r].y) * wv8[3] + bflo(hw[r].z) * wv8[4] + bfhi(hw[r].z) * wv8[5] + bflo(hw[r].w) * wv8[6] + bfhi(hw[r].w) * wv8[7];
        }
#pragma unroll
        for (int r = 0; r < 4; ++r) {
            const int row = row0 + r, bg = row >> 7, n = row & 127;
            float v = (n == 127) ? 0.f : s[r];
            if (kv == 0) { const float ss = wave_sum(v * v); const float o = v * rsqrtf(ss * (1.0f / 64.0f) + EPS) * kg;
                KCMP[((size_t)bg * 128 + n) * 64 + lane] = (bf16_t)(pk2(o, 0.f) & 0xffffu); }
            else VCMPT[((size_t)bg * 96 + lane) * 128 + vperm16(n)] = (bf16_t)(pk2(v, 0.f) & 0xffffu);
        }
    }
    for (int i = blockIdx.x * 512 + tid; i < 32 * 32 * 128; i += gridDim.x * 512) {
        const int n = i & 127, j = (i >> 7) & 31, bg = i >> 12;
        float o = 0.f;
        if (n < 127) { const int d = n - 4 * j; if (d >= 0 && d <= 2) o = 1.0f; else if (d == 3 || d == -1) o = 0.5f; }
        VCMPT[((size_t)bg * 96 + 64 + j) * 128 + vperm16(n)] = (bf16_t)(pk2(o, 0.f) & 0xffffu);
    }
}
DI void topk_one(const float* IMPH, unsigned* SELM, int t, int g) {
    const int b = t >> 11, s = t & 2047, cur = s >> 6;
    unsigned mask;
    if (cur < 16) mask = (2u << cur) - 1u;
    else {
        float sc[32];
#pragma unroll
        for (int j4 = 0; j4 < 8; ++j4) { f32x4 acc = {0.f, 0.f, 0.f, 0.f};
#pragma unroll
            for (int r = 0; r < 4; ++r) acc += *(const f32x4*)(IMPH + ((size_t)t * 8 + g * 4 + r) * 32 + 4 * j4);
#pragma unroll
            for (int q = 0; q < 4; ++q) sc[4 * j4 + q] = acc[q]; }
#pragma unroll
        for (int j = 0; j < 32; ++j) { const bool forced = (j == 0) || (j == cur) || (j == cur - 1); sc[j] = (j > cur) ? NEGF : (sc[j] + (forced ? 1e4f : 0.f)); }
        mask = 0u;
#pragma unroll
        for (int j = 0; j < 32; ++j) { int rank = 0;
#pragma unroll
            for (int k = 0; k < 32; ++k) rank += ((sc[k] > sc[j]) || (sc[k] == sc[j] && k < j)) ? 1 : 0;
            mask |= (rank < 16) ? (1u << j) : 0u; }
    }
    SELM[((size_t)(b * 2 + g)) * 2048 + s] = mask;
}
DI void phase_topk(const int WID, ArgsP a) {
    for (int i = blockIdx.x * 512 + opaque_tid(WID); i < T * 2; i += gridDim.x * 512) topk_one((const float*)(a->ws + WS_IMPH), (unsigned*)(a->ws + WS_SELM), i >> 1, i & 1);
}
DI void phase_cmp_topk(const int WID, ArgsP a, LAS unsigned char* lds) {
    const bf16_t* QN = (const bf16_t*)(a->ws + WS_QN);
    float* IMPH = (float*)(a->ws + WS_IMPH);
    for (int u = blockIdx.x; u < 256; u += gridDim.x) {
        const int qb = 7 - (u >> 5), bg = u & 31, b = bg >> 1, g = bg & 1, q0 = qb * 256; const size_t t0 = (size_t)b * 2048 + q0;
#pragma unroll 1
        for (int r = 0; r < 4; ++r) { const int hd = g * 4 + r;
            attn_unit<96, 3>(WID, lds, QN + t0 * 512 + hd * 64, 512, (const bf16_t*)(a->ws + WS_KCMP) + (size_t)bg * 128 * 64, 64,
                             (const bf16_t*)(a->ws + WS_VCMPT) + (size_t)bg * 96 * 128, 128, q0, 0.f, 0, nullptr,
                             (bf16_t*)(a->ws + WS_OC) + t0 * 512 + hd * 64, 512, IMPH + (t0 * 8 + hd) * 32); }
        asm volatile("s_waitcnt vmcnt(0)" ::: "memory");
        __syncthreads();
        { const int tid = opaque_tid(WID); if (tid < 256) topk_one(IMPH, (unsigned*)(a->ws + WS_SELM), (int)t0 + tid, g); }
        __syncthreads();
    }
}
DI void phase_mixprep(const int WID, ArgsP a, int layer) {
    const int tid = opaque_tid(WID), lane = tid & 63, wv = tid >> 6, ev = layer >> 1;
    const float* dl = a->in[I_DALAM] + ev * 256;
    const float s1 = wave_sum(dl[lane] * dl[64 + lane]), s2 = wave_sum(dl[128 + lane] * dl[192 + lane]);
    const float lam_init = 0.8f - 0.6f * expf(-0.3f * (float)layer);
    const float lam = expf(s1) - expf(s2) + lam_init;
    const float* og = a->in[I_DAOUTG] + ev * 128;
    const bf16_t* OD = (const bf16_t*)(a->ws + WS_OD); const bf16_t* OC = (const bf16_t*)(a->ws + WS_OC); const bf16_t* OS = (const bf16_t*)(a->ws + WS_OS); const bf16_t* OW = (const bf16_t*)(a->ws + WS_OW);
    const float* GT = (const float*)(a->ws + WS_GATES); unsigned char* AMIX = (unsigned char*)(a->ws + WS_AMIX);
    const int h = lane >> 4, dv = (lane & 15) * 8;
    f32x4 g0 = *(const f32x4*)(og + dv), g1 = *(const f32x4*)(og + dv + 4);
    for (int t = blockIdx.x * 8 + wv; t < T; t += gridDim.x * 8) {
        { const u32x4 w1 = *(const u32x4*)(OD + (size_t)t * 1024 + h * 128 + dv), w2 = *(const u32x4*)(OD + (size_t)t * 1024 + (4 + h) * 128 + dv);
          f32x4 d0, d1;
          d0[0] = bflo(w1.x) - lam * bflo(w2.x); d0[1] = bfhi(w1.x) - lam * bfhi(w2.x); d0[2] = bflo(w1.y) - lam * bflo(w2.y); d0[3] = bfhi(w1.y) - lam * bfhi(w2.y);
          d1[0] = bflo(w1.z) - lam * bflo(w2.z); d1[1] = bfhi(w1.z) - lam * bfhi(w2.z); d1[2] = bflo(w1.w) - lam * bflo(w2.w); d1[3] = bfhi(w1.w) - lam * bfhi(w2.w);
          float ss = (d0[0] * d0[0] + d0[1] * d0[1]) + (d0[2] * d0[2] + d0[3] * d0[3]) + (d1[0] * d1[0] + d1[1] * d1[1]) + (d1[2] * d1[2] + d1[3] * d1[3]);
          ss += shx(ss, 1); ss += shx(ss, 2); ss += shx(ss, 4); ss += shx(ss, 8);
          const float rs = rsqrtf(ss * (1.0f / 128.0f) + EPS) * (1.0f - lam_init);
          *(u32x2*)(AMIX + (size_t)t * 1024 + h * 128 + dv) = pack8_fp8(d0 * (rs * A_SC) * g0, d1 * (rs * A_SC) * g1); }
    }
}
DI void phase_scan(const int WID, ArgsP a) {
    const bf16_t* UT = (const bf16_t*)(a->ws + WS_UT); bf16_t* VS = (bf16_t*)(a->ws + WS_VS);
    for (int i = blockIdx.x * 512 + opaque_tid(WID); i < 64 * 512 * 32; i += gridDim.x * 512) {
        const int d8 = i & 31, f = (i >> 5) & 511, bh = i >> 14, h = bh & 3;
        const float dec = exp2f(256.0f * ret_lg2(h));
        f32x4 S0 = {0.f, 0.f, 0.f, 0.f}, S1 = S0;
        u32x4 un = *(const u32x4*)(UT + ((size_t)bh * 8) * 131072 + (size_t)f * 256 + 8 * d8);
#pragma unroll 1
        for (int n = 0; n < 8; ++n) {
            const size_t z = (size_t)bh * 8 + n;
            const u32x4 u = un;
            if (n < 7) un = *(const u32x4*)(UT + (z + 1) * 131072 + (size_t)f * 256 + 8 * d8);
            *(u32x4*)(VS + (z * 512 + f) * 512 + 256 + 8 * d8) = pack8(S0, S1);
            S0[0] = (S0[0] + bflo(u.x)) * dec; S0[1] = (S0[1] + bfhi(u.x)) * dec; S0[2] = (S0[2] + bflo(u.y)) * dec; S0[3] = (S0[3] + bfhi(u.y)) * dec;
            S1[0] = (S1[0] + bflo(u.z)) * dec; S1[1] = (S1[1] + bfhi(u.z)) * dec; S1[2] = (S1[2] + bflo(u.w)) * dec; S1[3] = (S1[3] + bfhi(u.w)) * dec;
        }
    }
}
DI void phase_normgate(const int WID, ArgsP a, int od) {
    const int tid = opaque_tid(WID), lane = tid & 63, wv = tid >> 6;
    const bf16_t* Y = (const bf16_t*)(a->ws + WS_Y); const bf16_t* GG = (const bf16_t*)(a->ws + WS_GG); unsigned char* YG = (unsigned char*)(a->ws + WS_YG);
    const float* og = a->in[I_RETG] + od * 512;
    const f32x4 g0 = *(const f32x4*)(og + 8 * lane), g1 = *(const f32x4*)(og + 8 * lane + 4);
    const int G8 = gridDim.x * 8;
    for (int t = blockIdx.x * 8 + wv; t < T; t += 2 * G8) {
        const int tB = (t + G8 < T) ? t + G8 : t;
        u32x4 yw[2][4], gw[2][4];
#pragma unroll
        for (int rr = 0; rr < 2; ++rr)
#pragma unroll
            for (int h = 0; h < 4; ++h) { const size_t o = (size_t)(rr ? tB : t) * 2048 + h * 512 + 8 * lane; yw[rr][h] = *(const u32x4*)(Y + o); gw[rr][h] = *(const u32x4*)(GG + o); }
        asm volatile("" ::: "memory");
#pragma unroll
        for (int rr = 0; rr < 2; ++rr)
#pragma unroll
            for (int h = 0; h < 4; ++h) {
                const size_t o = (size_t)(rr ? tB : t) * 2048 + h * 512 + 8 * lane;
                const u32x4 yv = yw[rr][h], gv = gw[rr][h];
                f32x4 y0 = {bflo(yv.x), bfhi(yv.x), bflo(yv.y), bfhi(yv.y)}, y1 = {bflo(yv.z), bfhi(yv.z), bflo(yv.w), bfhi(yv.w)};
                const f32x4 q0 = {bflo(gv.x), bfhi(gv.x), bflo(gv.y), bfhi(gv.y)}, q1 = {bflo(gv.z), bfhi(gv.z), bflo(gv.w), bfhi(gv.w)};
                float ss = (y0[0] * y0[0] + y0[1] * y0[1]) + (y0[2] * y0[2] + y0[3] * y0[3]) + (y1[0] * y1[0] + y1[1] * y1[1]) + (y1[2] * y1[2] + y1[3] * y1[3]);
#pragma unroll
                for (int o2 = 1; o2 < 64; o2 <<= 1) ss += shxl(ss, o2, lane);
                const float rs = rsqrtf(ss * (1.0f / 512.0f) + EPS);
                *(u32x2*)(YG + o) = pack8_fp8(y0 * (rs * A_SC) * g0 * q0, y1 * (rs * A_SC) * g1 * q1);
            }
    }
}
DI int snake_unit(int rnd, int G, int c) { return (rnd & 1) ? rnd * G + (G - 1 - c) : rnd * G + c; }
DI float absmax64(const float* g, int lane) { float m = fabsf(g[lane]);
#pragma unroll
    for (int o = 1; o < 64; o <<= 1) m = fmaxf(m, shx(m, o));
    return m; }
constexpr int CW_AQ = 8192;
template <int MODE>
DI void phase_attn(const int WID, ArgsP a, LAS unsigned char* lds, int ev) {
    const int tid = opaque_tid(WID), lane = tid & 63;
    const bf16_t* QD = (const bf16_t*)(a->ws + WS_QD); const bf16_t* KD = (const bf16_t*)(a->ws + WS_KD); const bf16_t* QN = (const bf16_t*)(a->ws + WS_QN);
    LAS int* ord = (LAS int*)(lds + MISC_OFF + MO_ENT); LAS int* cst = (LAS int*)(lds + MISC_OFF + MO_GAT); volatile LAS int* cur = (volatile LAS int*)(lds + MISC_OFF + MO_TOT);
    float sb2 = 0.f;
    if (MODE != 3) { const float gq = absmax64(a->in[MODE == 0 ? I_DAQN : I_NSQN] + ev * 64, lane), gk = absmax64(a->in[MODE == 0 ? I_DAKN : I_NSKN] + ev * 64, lane);
        sb2 = 16.0f * gq * gk + 28.0f; }
    if (tid < 64) { const int qb = tid >> 3, hd = tid & 7, q0 = qb * 256; int lo = 0, hi = 4 * qb + 4;
        if (MODE == 3) { lo = 0; hi = 2; }
        else { const float slope = (MODE == 0) ? exp2f(-2.0f * (float)((hd & 3) + 1)) : exp2f(-(float)(hd + 1)); const int dcut = (int)fminf(sb2 / slope + 1.0f, 100000.0f);
            const int kmin = q0 - dcut; lo = kmin > 0 ? (kmin >> 6) : 0;
            if (MODE == 2) { const int lk = q0 - 511; const int lw = lk > 0 ? (lk >> 6) : 0; lo = lw > lo ? lw : lo; } }
        cst[tid] = hi - lo; }
    __syncthreads();
    if (tid < 64) { const int mine = cst[tid]; int rank = 0;
        for (int j = 0; j < 64; ++j) { const int o = cst[j]; rank += (o > mine || (o == mine && j < tid)) ? 1 : 0; }
        ord[rank] = tid; }
    __syncthreads();
    unsigned* ctr = (unsigned*)(a->ws + WS_CTL) + CW_AQ + 64 * 8 * (ev * 4 + MODE);
    const int x0 = (int)(xb_xcc_id() & 7u);
    volatile LAS int* stl = (volatile LAS int*)(lds + MISC_OFF + MO_BASE);
    bool own = true; int nst = 0;
    for (;;) {
        if (tid < 64) {
            int uu_ = -1;
            if (own) { int v = 128; if (lane == 0) v = (int)__hip_atomic_fetch_add(ctr + 64 * x0, 1u, __ATOMIC_RELAXED, __HIP_MEMORY_SCOPE_AGENT);
                v = __builtin_amdgcn_readfirstlane(v); if (v < 128) uu_ = x0 * 128 + v; else own = false; }
            if (!own && uu_ < 0) {
                if (nst == 0) { int v = 128; const int xq_ = (x0 + lane) & 7;
                    if (lane >= 1 && lane < 8) v = (int)__hip_atomic_fetch_add(ctr + 64 * xq_, 1u, __ATOMIC_RELAXED, __HIP_MEMORY_SCOPE_AGENT);
                    const unsigned long long got = __ballot(v < 128); nst = __popcll(got);
                    if (v < 128) stl[__popcll(got & ((1ull << lane) - 1ull))] = xq_ * 128 + v;
                    asm volatile("s_waitcnt lgkmcnt(0)" ::: "memory"); }
                if (nst > 0) { --nst; uu_ = stl[nst]; }
            }
            if (lane == 0) *cur = uu_;
        }
        __syncthreads();
        const int uu = *cur; if (uu < 0) break;
        const int xq = uu >> 7, v = uu & 127, combo = ord[v >> 1], jb = v & 1, qb = combo >> 3, hd = combo & 7, q0 = qb * 256;
        const int b = (MODE == 0) ? (((xq - 2 * (hd & 3)) & 7) + 8 * jb) : (((xq - 4 * (hd >> 2)) & 7) + 8 * jb);
        const size_t t0 = (size_t)b * 2048 + q0;
        if (MODE == 0) {
            const float slope = exp2f(-2.0f * (float)((hd & 3) + 1)); const int dcut = (int)fminf(sb2 / slope + 1.0f, 100000.0f);
            attn_unit<128, 0>(WID, lds, QD + t0 * 512 + hd * 64, 512, KD + (size_t)b * 2048 * 512 + hd * 64, 512,
                              (const bf16_t*)(a->ws + WS_VAT) + (size_t)(b * 4 + (hd & 3)) * 128 * 2048, 2048, q0, slope, dcut, nullptr,
                              (bf16_t*)(a->ws + WS_OD) + t0 * 1024 + hd * 128, 1024, nullptr);
        } else if (MODE == 1 || MODE == 2) {
            const int g = hd >> 2; const float slope = exp2f(-(float)(hd + 1)); const int dcut = (int)fminf(sb2 / slope + 1.0f, 100000.0f);
            const bf16_t* Kb = (const bf16_t*)(a->ws + (MODE == 1 ? WS_KSB : WS_KWB)) + (size_t)(b * 2 + g) * 2048 * 64;
            const bf16_t* Vb = (const bf16_t*)(a->ws + (MODE == 1 ? WS_VST : WS_VWT)) + (size_t)(b * 2 + g) * 64 * 2048;
            attn_unit<64, MODE>(WID, lds, QN + t0 * 512 + hd * 64, 512, Kb, 64, Vb, 2048, q0, slope, dcut,
                                (const unsigned*)(a->ws + WS_SELM) + (size_t)(b * 2 + g) * 2048 + q0,
                                (bf16_t*)(a->ws + (MODE == 1 ? WS_OS : WS_OW)) + t0 * 512 + hd * 64, 512, nullptr);
        } else {
            const int g = hd >> 2;
            attn_unit<96, 3>(WID, lds, QN + t0 * 512 + hd * 64, 512, (const bf16_t*)(a->ws + WS_KCMP) + (size_t)(b * 2 + g) * 128 * 64, 64,
                             (const bf16_t*)(a->ws + WS_VCMPT) + (size_t)(b * 2 + g) * 96 * 128, 128, q0, 0.f, 0, nullptr,
                             (bf16_t*)(a->ws + WS_OC) + t0 * 512 + hd * 64, 512, (float*)(a->ws + WS_IMPH) + (t0 * 8 + hd) * 32);
        }
    }
}

DI void phase_diff(const int WID, ArgsP a, LAS unsigned char* lds, int layer) {
    const int tid = opaque_tid(WID), lane = tid & 63, ev = layer >> 1;
    LAS int* ord = (LAS int*)(lds + MISC_OFF + MO_ENT); LAS int* cst = (LAS int*)(lds + MISC_OFF + MO_GAT); volatile LAS int* cur = (volatile LAS int*)(lds + MISC_OFF + MO_TOT);
    const float gq = absmax64(a->in[I_DAQN] + ev * 64, lane), gk = absmax64(a->in[I_DAKN] + ev * 64, lane);
    const float sb2 = 16.0f * gq * gk + 28.0f;
    const float* dl = a->in[I_DALAM] + ev * 256;
    const float s1 = wave_sum(dl[lane] * dl[64 + lane]), s2 = wave_sum(dl[128 + lane] * dl[192 + lane]);
    const float lam_init = 0.8f - 0.6f * expf(-0.3f * (float)layer);
    const float lam = expf(s1) - expf(s2) + lam_init;
    if (tid < 32) { const int qb = tid >> 2, h = tid & 3, q0 = qb * 256; const float slope = exp2f(-2.0f * (float)(h + 1)); const int dcut = (int)fminf(sb2 / slope + 1.0f, 100000.0f);
        const int kmin = q0 - dcut; const int lo = kmin > 0 ? (kmin >> 6) : 0; cst[tid] = 4 * qb + 4 - lo; }
    __syncthreads();
    if (tid < 32) { const int mine = cst[tid]; int rank = 0;
        for (int j = 0; j < 32; ++j) { const int o = cst[j]; rank += (o > mine || (o == mine && j < tid)) ? 1 : 0; }
        ord[rank] = tid; }
    __syncthreads();
    unsigned* ctr = (unsigned*)(a->ws + WS_CTL) + CW_AQ + 64 * 8 * (ev * 4 + 0);
    const bf16_t* QD = (const bf16_t*)(a->ws + WS_QD); const bf16_t* KD = (const bf16_t*)(a->ws + WS_KD);
    for (;;) {
        if (tid == 0) *cur = (int)__hip_atomic_fetch_add(ctr, 1u, __ATOMIC_RELAXED, __HIP_MEMORY_SCOPE_AGENT);
        __syncthreads();
        const int u = *cur; if (u >= 512) break;
        const int combo = ord[u >> 4], b = u & 15, qb = combo >> 2, h = combo & 3, q0 = qb * 256; const size_t t0 = (size_t)b * 2048 + q0;
        const float slope = exp2f(-2.0f * (float)(h + 1)); const int dcut = (int)fminf(sb2 / slope + 1.0f, 100000.0f);
        diff_unit(WID, lds, QD + t0 * 512 + h * 64, QD + t0 * 512 + (4 + h) * 64, KD + (size_t)b * 2048 * 512 + h * 64, KD + (size_t)b * 2048 * 512 + (4 + h) * 64,
                  (const bf16_t*)(a->ws + WS_VAT) + (size_t)(b * 4 + h) * 128 * 2048, q0, slope, dcut, lam, 1.0f - lam_init, a->in[I_DAOUTG] + ev * 128,
                  (unsigned char*)(a->ws + WS_AMIX) + t0 * 1024 + h * 128);
    }
}
DI void phase_nsa(const int WID, ArgsP a, LAS unsigned char* lds, int ev) {
    const int tid = opaque_tid(WID), lane = tid & 63, w = __builtin_amdgcn_readfirstlane(tid >> 6), r = lane & 31, hh = lane >> 5, hr = w >> 1, qh = w & 1;
    volatile LAS int* cur = (volatile LAS int*)(lds + MISC_OFF + MO_TOT);
    LAS float* impl = (LAS float*)(lds + 98304);
    LAS float* scs = (LAS float*)(lds + 131072);
    LAS unsigned* selml = (LAS unsigned*)(lds + MISC_OFF + MO_RED);
    const float gq = absmax64(a->in[I_NSQN] + ev * 64, lane), gk = absmax64(a->in[I_NSKN] + ev * 64, lane);
    const float sb2 = 16.0f * gq * gk + 28.0f;
    unsigned* ctr = (unsigned*)(a->ws + WS_CTL) + CW_AQ + 64 * 8 * (ev * 4 + 1);
    const bf16_t* QN = (const bf16_t*)(a->ws + WS_QN);
    for (;;) {
        if (tid == 0) *cur = (int)__hip_atomic_fetch_add(ctr, 1u, __ATOMIC_RELAXED, __HIP_MEMORY_SCOPE_AGENT);
        __syncthreads();
        const int u = *cur; if (u >= 1024) break;
        const int qb = 31 - (u >> 5), bg = u & 31, b = bg >> 1, g = bg & 1, q0 = qb * 64; const size_t t0 = (size_t)b * 2048 + q0;
        bf16x8 qf[4];
        { const bf16_t* Qw = QN + (t0 + 32 * qh + r) * 512 + (4 * g + hr) * 64;
#pragma unroll
          for (int ks = 0; ks < 4; ++ks) qf[ks] = *(const bf16x8*)(Qw + 16 * ks + 8 * hh); }
        const float* gp = (const float*)(a->ws + WS_GATES) + (t0 + 32 * qh + r) * 24 + (4 * g + hr) * 3;
        const float gate_c = gp[0], gate_s = gp[1], gate_w = gp[2];
        f32x16 OB[2];
#pragma unroll
        for (int rb = 0; rb < 2; ++rb)
#pragma unroll
            for (int i = 0; i < 16; ++i) OB[rb][i] = 0.f;
        nsa_unit<96, 3>(WID, lds, qf, (const bf16_t*)(a->ws + WS_KCMP) + (size_t)bg * 128 * 64, 64, (const bf16_t*)(a->ws + WS_VCMPT) + (size_t)bg * 96 * 128, 128, q0, g, sb2,
                        nullptr, OB, gate_c, impl);
        asm volatile("s_waitcnt lgkmcnt(0)" ::: "memory");
        __syncthreads();
        { const int qq = tid >> 3, pq = tid & 7;
          if (qb < 16) { if (pq == 0) selml[qq] = (2u << qb) - 1u; }
          else { f32x4 acc = {0.f, 0.f, 0.f, 0.f};
#pragma unroll
              for (int h2 = 0; h2 < 4; ++h2) acc += *(const LAS f32x4*)(impl + (h2 * 64 + qq) * 32 + 4 * pq);
#pragma unroll
              for (int e = 0; e < 4; ++e) { const int j = 4 * pq + e; const bool forced = (j == 0) || (j == qb) || (j == qb - 1); acc[e] = (j > qb) ? NEGF : (acc[e] + (forced ? 1e4f : 0.f)); }
              *(LAS f32x4*)(scs + qq * 32 + 4 * pq) = acc; }
          asm volatile("s_waitcnt lgkmcnt(0)" ::: "memory");
          __syncthreads();
          if (qb >= 16) { const f32x4 my = *(const LAS f32x4*)(scs + qq * 32 + 4 * pq); int rk[4] = {0, 0, 0, 0};
#pragma unroll
              for (int k4 = 0; k4 < 8; ++k4) { const f32x4 o4 = *(const LAS f32x4*)(scs + qq * 32 + 4 * k4);
#pragma unroll
                  for (int kk = 0; kk < 4; ++kk) { const int k = 4 * k4 + kk;
#pragma unroll
                      for (int e = 0; e < 4; ++e) { const int j = 4 * pq + e; rk[e] += ((o4[kk] > my[e]) || (o4[kk] == my[e] && k < j)) ? 1 : 0; } } }
              unsigned bits = 0u;
#pragma unroll
              for (int e = 0; e < 4; ++e) bits |= (rk[e] < 16) ? (1u << (4 * pq + e)) : 0u;
              bits |= shxu(bits, 1); bits |= shxu(bits, 2); bits |= shxu(bits, 4);
              if (pq == 0) selml[qq] = bits; }
          asm volatile("s_waitcnt lgkmcnt(0)" ::: "memory");
          __syncthreads(); }
        nsa_unit<64, 1>(WID, lds, qf, (const bf16_t*)(a->ws + WS_KSB) + (size_t)bg * 2048 * 64, 64, (const bf16_t*)(a->ws + WS_VST) + (size_t)bg * 64 * 2048, 2048, q0, g, sb2,
                        selml, OB, gate_s, nullptr);
        { const bf16_t* ow = (const bf16_t*)(a->ws + WS_OW) + (t0 + 32 * qh + r) * 512 + (4 * g + hr) * 64;
          unsigned char* am = (unsigned char*)(a->ws + WS_AMIX) + (t0 + 32 * qh + r) * 1024 + 512 + (4 * g + hr) * 64;
#pragma unroll
          for (int rb = 0; rb < 2; ++rb)
#pragma unroll
              for (int g4 = 0; g4 < 4; ++g4) { const int dv = 32 * rb + 8 * g4 + 4 * hh; const u32x2 wv = *(const u32x2*)(ow + dv);
                  const float o0 = OB[rb][4 * g4] + gate_w * bflo(wv.x), o1 = OB[rb][4 * g4 + 1] + gate_w * bfhi(wv.x), o2 = OB[rb][4 * g4 + 2] + gate_w * bflo(wv.y), o3 = OB[rb][4 * g4 + 3] + gate_w * bfhi(wv.y);
                  *(unsigned*)(am + dv) = pk4_fp8(o0 * A_SC, o1 * A_SC, o2 * A_SC, o3 * A_SC); } }
    }
}

constexpr int PPL = 15;
constexpr int NPHASE = 1 + DEPTH * PPL;
__global__ void __launch_bounds__(512, 2) mk_fwd(Args a_unused) {
    ArgsP a = opaque_args();
    extern __shared__ __attribute__((aligned(16))) unsigned char lds_raw[];
    LAS unsigned char* lds = (LAS unsigned char*)lds_raw;
    const int tid = threadIdx.x, G = gridDim.x, c = blockIdx.x;
    const int WID = __builtin_amdgcn_readfirstlane(tid >> 6);
    volatile LAS unsigned* misc = (volatile LAS unsigned*)(lds + MISC_OFF);
    if (tid < 4) misc[tid] = 0u;
    __syncthreads();
    unsigned* ctl = (unsigned*)(a->ws + WS_CTL);
    XcdBarrier bar; bar.bar = ctl + CW_BAR; bar.x = 0; bar.st = misc;
    const int ph_lo = a->ph_lo, ph_hi = a->ph_hi;
    const bool multi = (ph_hi - ph_lo) > 1;
    if (multi) bar = xcd_barrier_post(WID, ctl + CW_BAR, misc);
    bool first = true;
#define PHASE_BEGIN(k, id) if ((DBG_ONLY < 0 || DBG_ONLY == (id)) && (k) >= ph_lo && (k) < ph_hi && (k) <= DBG_LAST_PHASE) { if (!first) { xcd_barrier(WID, bar); if (PROBE_MASK >> 31) xcd_barrier(WID, bar); } first = false; \
        ArgsP a = opaque_args(); unsigned char* ws = a->ws; bf16_t* XN = (bf16_t*)(ws + WS_XN); bf16_t* H = (bf16_t*)(ws + WS_HB); const bool hb = layer != 0; const void* Hin = hb ? (const void*)H : (const void*)a->in[I_X]; \
        const LAS int* ts = (const LAS int*)(lds + MISC_OFF + MO_TS); (void)XN; (void)H; (void)Hin; (void)ts; (void)hb; \
        const bool probe_ = ((PROBE_MASK >> (id)) & 1u) != 0u; const unsigned long long pt0_ = probe_ ? __builtin_amdgcn_s_memrealtime() : 0ull;
#define PHASE_END if (probe_) { const unsigned long long pt1_ = __builtin_amdgcn_s_memrealtime(), pd_ = pt1_ - pt0_; while (__builtin_amdgcn_s_memrealtime() - pt1_ < pd_) __builtin_amdgcn_s_sleep(8); } }
    { const int layer = 0; PHASE_BEGIN(0, 0) phase_prologue(WID, a, lds); PHASE_END }
#pragma unroll 1
    for (int layer = 0; layer < DEPTH; ++layer) {
        const int pb = 1 + layer * PPL; const bool even = (layer & 1) == 0; const int ev = layer >> 1, od = layer >> 1;
        if (even) {
            PHASE_BEGIN(pb + 0, 1) phase_norm_mm<0>(WID, a, lds, layer, Hin, hb); PHASE_END
            PHASE_BEGIN(pb + 1, 2) {
                { ProbPlain P{XN, (const bf16_t*)(ws + WS_EVNAT) + (size_t)ev * 2048 * 1024, 1024, 1024, 1024}; pg8::Sched S; S.init(T / 256, 8, G, c);
                  EpiEvNat E{ws, (const float*)(ws + WS_GAINS) + ev * 256};
                  pg8::gemm_phase(WID, lds, P, S, E); }
                { ProbPlain P{(const bf16_t*)(ws + WS_EVSW) + (size_t)ev * 768 * 1024, XN, 1024, 1024, 1024}; pg8::Sched S; S.init(3, T / 256, G, c);
                  EpiEvSw E{ws};
                  pg8::gemm_phase(WID, lds, P, S, E); }
            } PHASE_END
            PHASE_BEGIN(pb + 2, 3) {
                { ProbCmp1 P{(const bf16_t*)(ws + WS_KCB), (const bf16_t*)(ws + WS_VCB), (const bf16_t*)(ws + WS_CMP1) + (size_t)ev * 2 * 256 * 2048, 1024, 2048, 2048}; pg8::Sched S; S.init(32, 1, G, c);
                  EpiCmp1 E{(bf16_t*)(ws + WS_HID), (const float*)(ws + WS_BIAS1) + ev * 512};
                  pg8::gemm_phase(WID, lds, P, S, E); }
                phase_diff(WID, a, lds, layer);
                phase_attn<2>(WID, a, lds, ev);
            } PHASE_END
            PHASE_BEGIN(pb + 3, 4) phase_cmp2(WID, a, lds, ev); PHASE_END
            PHASE_BEGIN(pb + 4, 5) phase_nsa(WID, a, lds, ev); PHASE_END
            PHASE_BEGIN(pb + 8, 9) {
                ProbPlain8 P{(const unsigned char*)(ws + WS_AMIX), (const unsigned char*)(ws + WS_EVOUT) + (size_t)ev * 1024 * 1024, 512, 512, 512}; pg8::Sched S; S.init(T / 256, 4, G, c);
                EpiResid E{Hin, H, hb, 1.0f / (A_SC * 64.0f)}; pg8::gemm_phase(WID, lds, P, S, E);
            } PHASE_END
        } else {
            PHASE_BEGIN(pb + 0, 11) phase_norm<1>(WID, a, lds, layer, Hin, hb); PHASE_END
            PHASE_BEGIN(pb + 1, 12) {
                { ProbPlain8 P{(const unsigned char*)XN, (const unsigned char*)(ws + WS_ODNAT) + (size_t)od * 4096 * 1024, 512, 512, 512}; pg8::Sched S; S.init(T / 256, 16, G, c);
                  EpiOdNat E{ws}; pg8::gemm_phase(WID, lds, P, S, E); }
                { ProbPlain8 P{(const unsigned char*)(ws + WS_ODSW) + (size_t)od * 2048 * 1024, (const unsigned char*)XN, 512, 512, 512}; pg8::Sched S; S.init(8, T / 256, G, c);
                  EpiOdSw E{ws}; pg8::gemm_phase(WID, lds, P, S, E); }
            } PHASE_END
            PHASE_BEGIN(pb + 2, 13) {
                { ProbUT P{(const bf16_t*)(ws + WS_VS), (const bf16_t*)(ws + WS_KT), 512, 256, 256}; SchedSeq S; S.init(G, c);
                  EpiUTScan E{(bf16_t*)(ws + WS_VS)}; pg8::gemm_phase(WID, lds, P, S, E); }
                { ProbAtt P{(const bf16_t*)(ws + WS_AQ), (const bf16_t*)(ws + WS_KP), 2048, 1024, 256}; pg8::Sched S; const int nb = G / 2 > 0 ? G / 2 : 1;
                  if (c >= nb || G < 2) S.init(512, 1, G < 2 ? 1 : G - nb, G < 2 ? 0 : c - nb); else S.init(0, 1, 1, 0);
                  EpiAtt E{(bf16_t*)(ws + WS_AQ)}; pg8::gemm_phase(WID, lds, P, S, E); }
            } PHASE_END
            PHASE_BEGIN(pb + 4, 15) {
                ProbY P{(const bf16_t*)(ws + WS_AQ), (const bf16_t*)(ws + WS_VS), 2048, 512, 512}; pg8::Sched S; S.init(512, 2, G, c);
                EpiY E{(bf16_t*)(ws + WS_Y)}; pg8::gemm_phase(WID, lds, P, S, E);
            } PHASE_END
            PHASE_BEGIN(pb + 5, 16) phase_normgate(WID, a, od); PHASE_END
            PHASE_BEGIN(pb + 8, 19) {
                ProbPlain8 P{(const unsigned char*)(ws + WS_YG), (const unsigned char*)(ws + WS_ODOUT) + (size_t)od * 1024 * 2048, 1024, 1024, 1024}; pg8::Sched S; S.init(T / 256, 4, G, c);
                EpiResid E{Hin, H, hb, 1.0f / (A_SC * 128.0f)}; pg8::gemm_phase(WID, lds, P, S, E);
            } PHASE_END
        }
        PHASE_BEGIN(pb + 9, 20) phase_norm_mm<2>(WID, a, lds, layer, H, true); PHASE_END
        PHASE_BEGIN(pb + 10, 21) phase_moe_slots(WID, a, lds, layer); PHASE_END
        PHASE_BEGIN(pb + 11, 22) {
            moe_tables(WID, a, lds, layer, -1);
            { ProbMoe8G P{(const unsigned char*)(ws + WS_XN), (const unsigned char*)(ws + WS_WGU) + (size_t)layer * 32 * 2048 * 1024, ts, (const int*)(ws + WS_TOK), 2048, 512, 512, 512}; pg8::Sched S; S.init(ts[32], 8, G, c);
              EpiGU E{(unsigned char*)(ws + WS_ACT), a->in[I_BGU] + (size_t)layer * 32 * 2048, ts}; pg8::gemm_phase(WID, lds, P, S, E); }
            { ProbPlain P{(const bf16_t*)(ws + WS_PBF) + (size_t)layer * T * 256, (const bf16_t*)(ws + WS_WPP) + (size_t)layer * 1024 * 256, 256, 256, 256}; pg8::Sched S; S.init(T / 256, 4, G, c);
              EpiPP E{(bf16_t*)(ws + WS_PP)}; pg8::gemm_phase(WID, lds, P, S, E); }
        } PHASE_END
        PHASE_BEGIN(pb + 12, 23) {
            moe_tables(WID, a, lds, layer, -1);
            ProbMoe8 P{(const unsigned char*)(ws + WS_ACT), (const unsigned char*)(ws + WS_WDN) + (size_t)layer * 32 * 1024 * 1024, ts, 1024, 512, 512, 512}; pg8::Sched S; S.init(ts[32], 4, G, c);
            EpiDN E{(bf16_t*)(ws + WS_YB), a->in[I_BDN] + (size_t)layer * 32 * 1024, ts}; pg8::gemm_phase(WID, lds, P, S, E);
        } PHASE_END
        PHASE_BEGIN(pb + 13, 24) phase_combine(WID, a, H); PHASE_END
        PHASE_BEGIN(pb + 14, 25) {
            ProbPlain8 P{(const unsigned char*)(ws + WS_XN), (const unsigned char*)(ws + WS_WPG) + (size_t)layer * 1024 * 1024, 512, 512, 512}; pg8::Sched S; S.init(T / 256, 4, G, c);
            EpiPLE E{H, (const bf16_t*)(ws + WS_PP), (layer == DEPTH - 1) ? a->out : nullptr}; pg8::gemm_phase(WID, lds, P, S, E);
        } PHASE_END
    }
#undef PHASE_BEGIN
#undef PHASE_END
}

extern "C" void kernel_launch(void* const* d_in, const int* in_sizes, int n_in, void* d_out, int out_size, void* d_ws, size_t ws_size, hipStream_t stream) {
    static int grid = 0;
    if (grid == 0) {
        if (n_in != 26 || out_size != T * D || ws_size < WS_END) { fprintf(stderr, "kernel_launch: unexpected problem (n_in %d, out %d, ws %zu < %zu); nothing launched\n", n_in, out_size, ws_size, (size_t)WS_END); grid = -1; return; }
        int dev = 0, cus = 0, per_cu = 0;
        if (hipGetDevice(&dev) != hipSuccess || hipDeviceGetAttribute(&cus, hipDeviceAttributeMultiprocessorCount, dev) != hipSuccess) { grid = -1; return; }
        if (hipFuncSetAttribute((const void*)mk_fwd, hipFuncAttributeMaxDynamicSharedMemorySize, LDS_BYTES) != hipSuccess) { fprintf(stderr, "kernel_launch: hipFuncSetAttribute failed\n"); grid = -1; return; }
        if (hipOccupancyMaxActiveBlocksPerMultiprocessor(&per_cu, (const void*)mk_fwd, 512, LDS_BYTES) != hipSuccess || per_cu < 1) fprintf(stderr, "kernel_launch: occupancy query reports %d\n", per_cu);
        (void)hipGetLastError();
        grid = cus > 256 ? 256 : cus;
    }
    if (grid < 0) return;
    (void)hipMemsetAsync((char*)d_ws + WS_CTL, 0, CTL_BYTES, stream);
    Args a; memset(&a, 0, sizeof(a));
    for (int i = 0; i < 26; ++i) a.in[i] = (const float*)d_in[i];
    a.out = (float*)d_out; a.ws = (unsigned char*)d_ws;
#if MK_SINGLE
    a.ph_lo = 0; a.ph_hi = NPHASE;
    hipLaunchKernelGGL(mk_fwd, dim3(grid), dim3(512), LDS_BYTES, stream, a);
#else
    for (int ph = 0; ph < NPHASE && ph <= DBG_LAST_PHASE; ++ph) {
        const int l = (ph - 1) / PPL, k = (ph - 1) % PPL;
        if (ph > 0 && (l & 1) && (k == 6 || k == 7)) continue;
        a.ph_lo = ph; a.ph_hi = ph + 1;
        hipLaunchKernelGGL(mk_fwd, dim3(grid), dim3(512), LDS_BYTES, stream, a);
    }
#endif
}
```

```cpp
#include <hip/hip_runtime.h>
#include <cstdio>
#include <cstdint>
#include <cstring>

#define LAS __attribute__((address_space(3)))
#define DI __device__ __forceinline__
typedef unsigned short bf16_t;
typedef short bf16x8 __attribute__((ext_vector_type(8)));
typedef short s16x4 __attribute__((ext_vector_type(4)));
typedef float f32x2 __attribute__((ext_vector_type(2)));
typedef float f32x4 __attribute__((ext_vector_type(4)));
typedef float f32x16 __attribute__((ext_vector_type(16)));
typedef unsigned u32x2 __attribute__((ext_vector_type(2)));
typedef unsigned u32x4 __attribute__((ext_vector_type(4)));
typedef __bf16 bfv2 __attribute__((ext_vector_type(2)));
typedef int i32x4 __attribute__((ext_vector_type(4)));
typedef int i32x8 __attribute__((ext_vector_type(8)));

#ifndef MK_SINGLE
#define MK_SINGLE 1
#endif
#ifndef DBG_ONLY
#define DBG_ONLY -1
#endif
#ifndef PROBE_MASK
#define PROBE_MASK 0u
#endif
#ifndef PROBE_ATT
#define PROBE_ATT 0
#endif
#ifndef PROBE_EPI2
#define PROBE_EPI2 0
#endif
#ifndef PROBE_PRO
#define PROBE_PRO 0
#endif
#ifndef PROBE_KREP
#define PROBE_KREP 1
#endif
#ifndef DBG_LAST_PHASE
#define DBG_LAST_PHASE 100000
#endif

constexpr int T = 32768, D = 1024, SEQ = 2048, NBATCH = 16, DEPTH = 4;
constexpr int EVIN = 2840, ODIN = 6144;
constexpr float EPS = 1e-6f, NEGF = -1e30f;
constexpr int NTB = 256;
constexpr int MOE_ROWS = (512 + 32) * 256;

constexpr size_t MiB = 1u << 20;
constexpr size_t WS_CTL = 0, CTL_BYTES = 1 * MiB;
constexpr int CW_BAR = 4096;
constexpr size_t WS_EVNAT = 2 * MiB, WS_EVSW = 10 * MiB, WS_EVOUT = 13 * MiB, WS_CMP1 = 17 * MiB, WS_ODNAT = 21 * MiB, WS_ODSW = 37 * MiB,
                 WS_ODOUT = 49 * MiB, WS_WPP = 57 * MiB, WS_WPG = 59 * MiB, WS_BIAS1 = 67 * MiB, WS_GAINS = 67 * MiB + 16384, WS_BCNT = 67 * MiB + 65536,
                 WS_WGU = 68 * MiB, WS_WDN = 580 * MiB;
constexpr size_t WS_XN = 840 * MiB, WS_PBF = 904 * MiB, WS_PP = 968 * MiB, WS_GATES = 1032 * MiB, WS_TOPE = 1035 * MiB, WS_POSB = 1036 * MiB,
                 WS_DEST = 1037 * MiB, WS_GATEW = 1038 * MiB, WS_SELM = 1039 * MiB;
constexpr size_t RA = 1040 * MiB;
constexpr size_t WS_QD = RA, WS_KD = RA + 32 * MiB, WS_QN = RA + 64 * MiB, WS_KCB = RA + 96 * MiB, WS_VCB = RA + 105 * MiB, WS_KSB = RA + 114 * MiB,
                 WS_KWB = RA + 122 * MiB, WS_VAT = RA + 130 * MiB, WS_VST = RA + 162 * MiB, WS_VWT = RA + 170 * MiB, WS_HID = RA + 178 * MiB,
                 WS_KCMP = RA + 182 * MiB, WS_VCMPT = RA + 183 * MiB, WS_OC = RA + 184 * MiB, WS_IMPH = RA + 216 * MiB, WS_OD = RA + 248 * MiB,
                 WS_OS = RA + 312 * MiB, WS_OW = RA + 344 * MiB, WS_AMIX = RA + 376 * MiB;
constexpr size_t WS_AQ = RA, WS_KP = RA + 128 * MiB, WS_KT = RA + 192 * MiB, WS_VS = RA + 256 * MiB, WS_GG = RA + 512 * MiB, WS_UT = RA + 640 * MiB,
                 WS_Y = RA + 896 * MiB, WS_YG = RA + 1024 * MiB;
constexpr size_t WS_TOK = 2192 * MiB  , WS_XB = 2192 * MiB, WS_ACT = 2464 * MiB, WS_YB = 2736 * MiB, WS_HB = 3008 * MiB, WS_END = 3072 * MiB;

constexpr int MISC_OFF = 139264, LDS_BYTES = 155648;
static_assert(MISC_OFF + 5888 + 4096 <= LDS_BYTES, "misc LDS words");
constexpr int MO_WCNT = 256, MO_ENT = 1280, MO_GAT = 3328, MO_TOT = 5376, MO_BASE = 5504, MO_TS = 5632, MO_RED = 5888, MO_GIDX = 10240;
static_assert(MISC_OFF + MO_GIDX + 1024 <= LDS_BYTES, "misc LDS words");

DI int opaque_tid(int wid0) { int l; asm volatile("v_mbcnt_lo_u32_b32 %0, -1, 0\n\tv_mbcnt_hi_u32_b32 %0, -1, %0" : "=v"(l) :: "memory"); return (wid0 << 6) | l; }
DI int lane_now() { int l; asm volatile("v_mbcnt_lo_u32_b32 %0, -1, 0\n\tv_mbcnt_hi_u32_b32 %0, -1, %0" : "=v"(l)); return l; }
DI float shx(float v, int m) { return __builtin_bit_cast(float, __builtin_amdgcn_ds_bpermute((lane_now() ^ m) << 2, __builtin_bit_cast(int, v))); }
DI float shxl(float v, int m, int lane) { return __builtin_bit_cast(float, __builtin_amdgcn_ds_bpermute((lane ^ m) << 2, __builtin_bit_cast(int, v))); }
DI unsigned shxu(unsigned v, int m) { return (unsigned)__builtin_amdgcn_ds_bpermute((lane_now() ^ m) << 2, (int)v); }
DI unsigned pk2(float lo, float hi) { f32x2 v = {lo, hi}; return __builtin_bit_cast(unsigned, __builtin_convertvector(v, bfv2)); }
DI unsigned pk4_fp8(float a, float b, float c, float d) { int w = 0; w = __builtin_amdgcn_cvt_pk_fp8_f32(a, b, w, false); w = __builtin_amdgcn_cvt_pk_fp8_f32(c, d, w, true); return (unsigned)w; }
DI u32x2 pack8_fp8(const f32x4& a, const f32x4& b) { u32x2 w; w.x = pk4_fp8(a[0], a[1], a[2], a[3]); w.y = pk4_fp8(b[0], b[1], b[2], b[3]); return w; }
DI float bf2f(unsigned short b) { return __uint_as_float(((unsigned)b) << 16); }
DI float bflo(unsigned w) { return __uint_as_float(w << 16); }
DI float bfhi(unsigned w) { return __uint_as_float(w & 0xffff0000u); }
DI float wave_sum(float v) {
#pragma unroll
    for (int o = 1; o < 64; o <<= 1) v += shx(v, o);
    return v;
}
DI float sigm(float x) { return __builtin_amdgcn_rcpf(1.0f + __builtin_amdgcn_exp2f(-1.44269504089f * x)); }
DI u32x4 pack8(const f32x4& a, const f32x4& b) { u32x4 w; w.x = pk2(a[0], a[1]); w.y = pk2(a[2], a[3]); w.z = pk2(b[0], b[1]); w.w = pk2(b[2], b[3]); return w; }
DI f32x4 ld_h4(const void* base, bool hb, size_t i) {
    if (hb) { const u32x2 w = *(const u32x2*)((const bf16_t*)base + i); return (f32x4){bflo(w.x), bfhi(w.x), bflo(w.y), bfhi(w.y)}; }
    return *(const f32x4*)((const float*)base + i);
}

#define XB_TMO      128
#define XB_XCNT(j)  (256  + 64 * (j))
#define XB_XSUB(j)  (1280 + 64 * (j))
#define XB_XGEN(j)  (2304 + 64 * (j))
#define XB_TOP      3328
#define XB_TOPGEN   3392
#define XCD_BAR_WORDS 3456
#define XB_SPIN_CAP (1u << 22)
DI unsigned xb_ld(unsigned* p)              { return __hip_atomic_load(p, __ATOMIC_RELAXED, __HIP_MEMORY_SCOPE_AGENT); }
DI unsigned xb_add(unsigned* p, unsigned v) { return __hip_atomic_fetch_add(p, v, __ATOMIC_RELAXED, __HIP_MEMORY_SCOPE_AGENT); }
DI unsigned xb_xcc_id() { return (unsigned)__builtin_amdgcn_s_getreg((3 << 11) | 20) & 0xFu; }
#define XB_SPIN(cond, bar) do { unsigned _sp = 0; while (cond) { __builtin_amdgcn_s_sleep(1); \
    if ((++_sp & 255u) == 0u) { if (xb_ld(&(bar)[XB_TMO])) break; if (_sp > XB_SPIN_CAP) { atomicAdd(&(bar)[XB_TMO], 1u); break; } } } } while (0)
struct XcdBarrier { unsigned* bar; unsigned x; volatile LAS unsigned* st; };
DI XcdBarrier xcd_barrier_post(const int WID, unsigned* bar, volatile LAS unsigned* st) {
    XcdBarrier b; b.bar = bar; b.x = xb_xcc_id(); b.st = st;
    if (opaque_tid(WID) == 0) (void)xb_add(&bar[XB_XCNT(b.x)], 1u);
    return b;
}
DI void xcd_barrier_complete(unsigned* bar, unsigned x, unsigned& nloc, unsigned& nx) {
    const unsigned G = gridDim.x * gridDim.y * gridDim.z;
    unsigned sum, cnt, mine, sp = 0u;
    for (;;) {
        sum = 0u; cnt = 0u; mine = 0u;
#pragma unroll
        for (unsigned j = 0; j < 16; ++j) { const unsigned c = xb_ld(&bar[XB_XCNT(j)]); sum += c; cnt += (c > 0u) ? 1u : 0u; mine = (j == x) ? c : mine; }
        if (sum == G) break;
        __builtin_amdgcn_s_sleep(1);
        if ((++sp & 255u) == 0u) { if (xb_ld(&bar[XB_TMO])) break; if (sp > XB_SPIN_CAP) { atomicAdd(&bar[XB_TMO], 1u); break; } }
    }
    nloc = mine > 0u ? mine : 1u; nx = cnt > 0u ? cnt : 1u;
}
DI void xcd_barrier(const int WID, const XcdBarrier& b) {
    asm volatile("s_waitcnt vmcnt(0)" ::: "memory");
    __syncthreads();
    if (opaque_tid(WID) == 0) {
        unsigned* bar = b.bar; asm volatile("" : "+s"(bar));
        __builtin_amdgcn_s_waitcnt(0);
        unsigned nloc = b.st[0], nx = b.st[1];
        if (nloc == 0u) { xcd_barrier_complete(bar, b.x, nloc, nx); b.st[0] = nloc; b.st[1] = nx; }
        const unsigned old = xb_add(&bar[XB_XSUB(b.x)], 1u);
        const unsigned gen = old / nloc;
        if (old + 1u == (gen + 1u) * nloc) {
            __builtin_amdgcn_fence(__ATOMIC_RELEASE, "agent");
            asm volatile("s_waitcnt vmcnt(0)" ::: "memory");
            const unsigned og = xb_add(&bar[XB_TOP], 1u);
            const unsigned tg = og / nx;
            if (og + 1u == (tg + 1u) * nx) xb_add(&bar[XB_TOPGEN], 1u);
            else XB_SPIN(xb_ld(&bar[XB_TOPGEN]) == tg, bar);
            __builtin_amdgcn_fence(__ATOMIC_ACQUIRE, "agent");
            xb_add(&bar[XB_XGEN(b.x)], 1u);
            asm volatile("s_waitcnt vmcnt(0)" ::: "memory");
        } else {
            XB_SPIN(xb_ld(&bar[XB_XGEN(b.x)]) == gen, bar);
            __builtin_amdgcn_fence(__ATOMIC_ACQUIRE, "agent");
            asm volatile("s_waitcnt vmcnt(0)" ::: "memory");
        }
    }
    __syncthreads();
}

namespace pg8 {
constexpr int BM = 256, BK = 64, HALF = 128, HTB = HALF * BK * 2, STAGE_BYTES = 8 * HTB, NXCD = 8, WGM = 8;
DI int lds_byte(int r, int c) { const int st = (r >> 4) * 2 + (c >> 5), rr = r & 15, cc = c & 31, ob = rr * 64 + cc * 2; return st * 1024 + (ob ^ (((ob >> 9) & 1) << 5)); }
DI void stage_rc(int b, int& R, int& C) { const int st = b / 1024, sb = b % 1024, swz = sb ^ (((sb >> 9) & 1) << 5); R = (st >> 1) * 16 + swz / 64; C = (st & 1) * 32 + (swz % 64) / 2; }
DI int perm32(int rho) { const int n = rho >> 4, i = rho & 15; return 8 * (i >> 2) + 4 * n + (i & 3); }
struct Unit { int pm, pn; };
struct Sched {
    int nM, nN, nwg, G, c;
    DI void init(int nM_, int nN_, int G_, int c_) { nM = nM_; nN = nN_; nwg = nM * nN; G = G_; c = c_; }
    DI bool next(int i, Unit& u) const {
        const long L = (long)i * G + c; if (L >= nwg) return false;
        int wgid = (int)L; { const int q = nwg / NXCD, r = nwg % NXCD, xcd = wgid % NXCD, off = wgid / NXCD; wgid = (xcd < r ? xcd * (q + 1) : r * (q + 1) + (xcd - r) * q) + off; }
        const int nig = WGM * nN, gid = wgid / nig, fm = gid * WGM, gsz = (nM - fm) < WGM ? (nM - fm) : WGM;
        u.pm = fm + ((wgid % nig) % gsz); u.pn = (wgid % nig) / gsz; return true;
    }
};
template <class Epi, class Prob, class SchedT>
DI void gemm_phase(const int WID, LAS unsigned char* lds, const Prob& P, const SchedT& S, const Epi& E) {
    const int tid = opaque_tid(WID), wid = __builtin_amdgcn_readfirstlane(tid >> 6), lane = tid & 63, wr = wid >> 2, wc = wid & 3, fr = lane & 15, fq = lane >> 4;
    const int K = P.K, nt = K / BK;
    constexpr int KREP = Epi::CARRY ? 1 : PROBE_KREP;
    unsigned voffA[2], voffB[2], voffG[2];
#pragma unroll
    for (int i = 0; i < 2; ++i) { int R, C; stage_rc(tid * 16 + i * 8192, R, C); const int Rb = Epi::PERM ? ((R & ~31) + perm32(R & 31)) : R;
        voffA[i] = (unsigned)(R * P.lda + C) * 2u; voffB[i] = (unsigned)(Rb * P.ldb + C) * 2u; voffG[i] = 0u; }
    const size_t kstep = (size_t)(BK * 2);
    const size_t hstepA = (size_t)HALF * P.lda * 2, hstepB = (size_t)HALF * P.ldb * 2;
    const unsigned ldsw = (unsigned)wid * 1024u;
    const int aoff = lds_byte(wr * 64 + fr, fq * 8), boff = lds_byte(wc * 32 + fr, fq * 8);
#define PG8_SA(b, h) (((b) * 2 + (h)) * HTB)
#define PG8_SB(b, h) ((4 + (b) * 2 + (h)) * HTB)
#define PG8_STAGE(bufoff, gbase, voff) do { _Pragma("unroll") for (int _i = 0; _i < 2; ++_i) \
        __builtin_amdgcn_global_load_lds((const unsigned*)((const char*)(gbase) + (voff)[_i]), (LAS unsigned*)(lds + (bufoff) + ldsw + _i * 8192), 16, 0, 0); } while (0)
#define PG8_STAGE_A(b, h, abase) do { if constexpr (Prob::GATHER) { if (h) PG8_STAGE(PG8_SA(b, h), abase, voffG); else PG8_STAGE(PG8_SA(b, h), abase, voffA); } \
        else PG8_STAGE(PG8_SA(b, h), (abase) + ((h) ? hstepA : (size_t)0), voffA); } while (0)
#define PG8_LD16(off) (*(const LAS i32x4*)(lds + (off)))
#define PG8_LDA(dst, b, h) do { _Pragma("unroll") for (int m = 0; m < 4; ++m) { const i32x4 lo_ = PG8_LD16(PG8_SA(b, h) + aoff + m * 2048), hi_ = PG8_LD16(PG8_SA(b, h) + aoff + m * 2048 + 1024); dst[m] = __builtin_shufflevector(lo_, hi_, 0, 1, 2, 3, 4, 5, 6, 7); } } while (0)
#define PG8_LDB(dst, b, h) do { _Pragma("unroll") for (int n = 0; n < 2; ++n) { const i32x4 lo_ = PG8_LD16(PG8_SB(b, h) + boff + n * 2048), hi_ = PG8_LD16(PG8_SB(b, h) + boff + n * 2048 + 1024); dst[n] = __builtin_shufflevector(lo_, hi_, 0, 1, 2, 3, 4, 5, 6, 7); } } while (0)
#define PG8_LOH(X) __builtin_bit_cast(bf16x8, __builtin_shufflevector((X), (X), 0, 1, 2, 3))
#define PG8_HIH(X) __builtin_bit_cast(bf16x8, __builtin_shufflevector((X), (X), 4, 5, 6, 7))
#define PG8_MMA(ai, bj, At, Bt) do { __builtin_amdgcn_s_setprio(1); \
        if constexpr (Prob::FP8) { _Pragma("unroll") for (int m = 0; m < 4; ++m) _Pragma("unroll") for (int n = 0; n < 2; ++n) \
            asm volatile("v_mfma_scale_f32_16x16x128_f8f6f4 %0, %1, %2, %0, %3, %3 op_sel_hi:[0,0,0]" : "+v"(acc[ai][bj][m][n]) : "v"(Bt[n]), "v"(At[m]), "v"(sc1)); } \
        else { _Pragma("unroll") for (int m = 0; m < 4; ++m) _Pragma("unroll") for (int n = 0; n < 2; ++n) { \
            acc[ai][bj][m][n] = __builtin_amdgcn_mfma_f32_16x16x32_bf16(PG8_LOH(Bt[n]), PG8_LOH(At[m]), acc[ai][bj][m][n], 0, 0, 0); \
            acc[ai][bj][m][n] = __builtin_amdgcn_mfma_f32_16x16x32_bf16(PG8_HIH(Bt[n]), PG8_HIH(At[m]), acc[ai][bj][m][n], 0, 0, 0); } } \
        __builtin_amdgcn_s_setprio(0); } while (0)
#define PG8_WAIT_V(n) asm volatile("s_waitcnt vmcnt(" #n ")" ::: "memory")
#define PG8_WAIT_L(n) asm volatile("s_waitcnt lgkmcnt(" #n ")" ::: "memory")
#define PG8_BAR __builtin_amdgcn_s_barrier()
#define PG8_SCHED __builtin_amdgcn_sched_barrier(0)
    Unit cur, nxt; int ui = 0;
    if (!S.next(0, cur)) return;
    f32x4 acc[2][2][4][2];
#pragma unroll
    for (int a = 0; a < 2; ++a)
#pragma unroll
        for (int b = 0; b < 2; ++b)
#pragma unroll
            for (int m = 0; m < 4; ++m)
#pragma unroll
                for (int n = 0; n < 2; ++n) acc[a][b][m][n] = (f32x4){0.f, 0.f, 0.f, 0.f};
    i32x8 At[4], B0[2], B1[2];
    const int sc1 = 0x7f7f7f7f;
    const char* cA = P.a_base(cur); const char* cB = P.b_base(cur);
    if constexpr (Prob::GATHER) {
#pragma unroll
        for (int i = 0; i < 2; ++i) { int R, C; stage_rc(tid * 16 + i * 8192, R, C);
            voffA[i] = (unsigned)P.TOK[(size_t)cur.pm * 256 + R] * 1024u + (unsigned)C * 2u; voffG[i] = (unsigned)P.TOK[(size_t)cur.pm * 256 + 128 + R] * 1024u + (unsigned)C * 2u; }
    }
    PG8_STAGE(PG8_SB(0, 0), cB, voffB); PG8_STAGE_A(0, 0, cA); PG8_STAGE(PG8_SB(0, 1), cB + hstepB, voffB); PG8_STAGE_A(0, 1, cA);
    if (wr == 1) PG8_BAR;
    PG8_WAIT_V(4); PG8_BAR;
    PG8_STAGE(PG8_SB(1, 0), cB + kstep, voffB); PG8_STAGE_A(1, 0, cA + kstep); PG8_STAGE(PG8_SB(1, 1), cB + hstepB + kstep, voffB);
    PG8_WAIT_V(6); PG8_BAR;
    for (;;) {
        const bool has_next = S.next(ui + 1, nxt);
        const char* nA = has_next ? P.a_base(nxt) : cA; const char* nB = has_next ? P.b_base(nxt) : cB;
        for (int rep_ = 0; rep_ < KREP; ++rep_)
        for (int t = 0; t < nt; t += 2) {
            const bool last = (t == nt - 2);
            if constexpr (Epi::HOOK) { if (last && rep_ + 1 == KREP) E.prefetch(cur, lds, wid, lane); }
            const char* a1 = cA + (size_t)(t + 1) * kstep;
            const char* a2 = last ? (rep_ + 1 < KREP ? cA : nA) : cA + (size_t)(t + 2) * kstep; const char* b2 = last ? (rep_ + 1 < KREP ? cB : nB) : cB + (size_t)(t + 2) * kstep;
            const char* a3 = a2 + kstep; const char* b3 = b2 + kstep;
            if constexpr (Prob::GATHER) {
                if (t == 0 && rep_ == 0 && has_next && wid == 0) __builtin_amdgcn_global_load_lds((const unsigned*)(P.TOK + (size_t)nxt.pm * 256 + 4 * lane_now()), (LAS unsigned*)(lds + MISC_OFF + MO_GIDX), 16, 0, 0);
                if (last && rep_ + 1 == KREP && has_next) { const int t3_ = opaque_tid(WID);
#pragma unroll
                    for (int i = 0; i < 2; ++i) { int R, C; stage_rc(t3_ * 16 + i * 8192, R, C); voffA[i] = (unsigned)(*(const LAS int*)(lds + MISC_OFF + MO_GIDX + 4 * R)) * 1024u + (unsigned)C * 2u; } }
            }
            PG8_LDB(B0, 0, 0); PG8_SCHED; PG8_LDA(At, 0, 0); PG8_STAGE_A(1, 1, a1);
            if constexpr (Prob::GATHER) {
                if (last && rep_ + 1 == KREP && has_next) { const int t3_ = opaque_tid(WID);
#pragma unroll
                    for (int i = 0; i < 2; ++i) { int R, C; stage_rc(t3_ * 16 + i * 8192, R, C); voffG[i] = (unsigned)(*(const LAS int*)(lds + MISC_OFF + MO_GIDX + 512 + 4 * R)) * 1024u + (unsigned)C * 2u; } }
            }
            PG8_WAIT_L(8); PG8_BAR; PG8_WAIT_L(0); PG8_MMA(0, 0, At, B0); PG8_BAR; PG8_SCHED;
            PG8_LDB(B1, 0, 1); PG8_STAGE(PG8_SB(0, 0), b2, voffB);
            PG8_BAR; PG8_WAIT_L(0); PG8_MMA(0, 1, At, B1); PG8_BAR;
            PG8_LDA(At, 0, 1); PG8_STAGE_A(0, 0, a2);
            PG8_BAR; PG8_WAIT_L(0); PG8_MMA(1, 0, At, B0); PG8_BAR; PG8_SCHED;
            PG8_STAGE(PG8_SB(0, 1), b2 + hstepB, voffB);
            PG8_WAIT_V(6); PG8_BAR; PG8_MMA(1, 1, At, B1); PG8_BAR;
            PG8_LDB(B0, 1, 0); PG8_SCHED; PG8_LDA(At, 1, 0); PG8_STAGE_A(0, 1, a2);
            PG8_WAIT_L(8); PG8_BAR; PG8_WAIT_L(0); PG8_MMA(0, 0, At, B0); PG8_BAR; PG8_SCHED;
            PG8_LDB(B1, 1, 1); PG8_STAGE(PG8_SB(1, 0), b3, voffB);
            PG8_BAR; PG8_WAIT_L(0); PG8_MMA(0, 1, At, B1); PG8_BAR;
            PG8_LDA(At, 1, 1); PG8_STAGE_A(1, 0, a3);
            PG8_BAR; PG8_WAIT_L(0); PG8_MMA(1, 0, At, B0); PG8_BAR; PG8_SCHED;
            PG8_STAGE(PG8_SB(1, 1), b3 + hstepB, voffB);
            PG8_WAIT_V(6); PG8_BAR; PG8_MMA(1, 1, At, B1); PG8_BAR;
        }
        if constexpr (Prob::FP8) {
            asm volatile("s_nop 15\n\ts_nop 15" ::: "memory");
#pragma unroll
            for (int a_ = 0; a_ < 2; ++a_)
#pragma unroll
                for (int b_ = 0; b_ < 2; ++b_)
#pragma unroll
                    for (int m_ = 0; m_ < 4; ++m_)
#pragma unroll
                        for (int n_ = 0; n_ < 2; ++n_) asm volatile("" : "+v"(acc[a_][b_][m_][n_]));
        }
        if constexpr (KREP > 1) {
#pragma unroll
        for (int a_ = 0; a_ < 2; ++a_)
#pragma unroll
            for (int b_ = 0; b_ < 2; ++b_)
#pragma unroll
                for (int m_ = 0; m_ < 4; ++m_)
#pragma unroll
                    for (int n_ = 0; n_ < 2; ++n_) acc[a_][b_][m_][n_] *= (1.0f / KREP); }
        { const int t2_ = opaque_tid(WID); const int fr_ = t2_ & 15, fq_ = (t2_ >> 4) & 3; int wr_ = WID >> 2, wc_ = WID & 3; asm volatile("" : "+s"(wr_), "+s"(wc_));
          E(acc, cur, wr_, wc_, fr_, fq_);
#if PROBE_EPI2
          if constexpr (Epi::HOOK) { asm volatile("" ::: "memory"); E(acc, cur, wr_, wc_, fr_, fq_); }
#endif
        }
        if (!has_next) break;
        const float carry = Epi::carry(cur);
#pragma unroll
        for (int a = 0; a < 2; ++a)
#pragma unroll
            for (int b = 0; b < 2; ++b)
#pragma unroll
                for (int m = 0; m < 4; ++m)
#pragma unroll
                    for (int n = 0; n < 2; ++n) acc[a][b][m][n] = Epi::CARRY ? acc[a][b][m][n] * carry : (f32x4){0.f, 0.f, 0.f, 0.f};
        cur = nxt; cA = nA; cB = nB; ++ui;
    }
    PG8_WAIT_V(0);
    if (wr == 0) PG8_BAR;
    PG8_BAR;
#undef PG8_SA
#undef PG8_SB
#undef PG8_STAGE
#undef PG8_STAGE_A
#undef PG8_LDA
#undef PG8_LDB
#undef PG8_MMA
#undef PG8_LD16
#undef PG8_LOH
#undef PG8_HIH
#undef PG8_WAIT_V
#undef PG8_WAIT_L
#undef PG8_BAR
#undef PG8_SCHED
}
}
using pg8::Unit;
typedef f32x4 Acc[2][2][4][2];

struct ProbPlain { static constexpr bool GATHER = false; static constexpr bool FP8 = false; const bf16_t* A; const bf16_t* Bt; int lda, ldb, K;
    DI const char* a_base(const Unit& u) const { return (const char*)(A + (size_t)u.pm * 256 * lda); }
    DI const char* b_base(const Unit& u) const { return (const char*)(Bt + (size_t)u.pn * 256 * ldb); } };
struct ProbCmp1 { static constexpr bool GATHER = false; static constexpr bool FP8 = false; const bf16_t* KCB; const bf16_t* VCB; const bf16_t* W; int lda, ldb, K;
    DI const char* a_base(const Unit& u) const { const int kv = u.pm >> 4, rt = u.pm & 15; return (const char*)((kv ? VCB : KCB) + (size_t)rt * 256 * 1024); }
    DI const char* b_base(const Unit& u) const { const int kv = u.pm >> 4; return (const char*)(W + (size_t)kv * 256 * 2048); } };
struct ProbAtt { static constexpr bool GATHER = false; static constexpr bool FP8 = false; const bf16_t* AQ; const bf16_t* KP; int lda, ldb, K;
    DI const char* a_base(const Unit& u) const { const int z = u.pm, n = z & 7, h = (z >> 3) & 3, b = z >> 5; const size_t t0 = (size_t)b * 2048 + n * 256; return (const char*)(AQ + (t0 * 4 + h) * 512 + 256); }
    DI const char* b_base(const Unit& u) const { const int z = u.pm, n = z & 7, h = (z >> 3) & 3, b = z >> 5; const size_t t0 = (size_t)b * 2048 + n * 256; return (const char*)(KP + t0 * 1024 + h * 256); } };
struct ProbUT { static constexpr bool GATHER = false; static constexpr bool FP8 = false; const bf16_t* VS; const bf16_t* KT; int lda, ldb, K;
    DI const char* a_base(const Unit& u) const { const int z = u.pm >> 1, half = u.pm & 1; return (const char*)(VS + (size_t)z * 262144 + (size_t)half * 256 * 512); }
    DI const char* b_base(const Unit& u) const { const int z = u.pm >> 1; return (const char*)(KT + (size_t)z * 65536); } };
struct ProbY { static constexpr bool GATHER = false; static constexpr bool FP8 = false; const bf16_t* AQ; const bf16_t* VS; int lda, ldb, K;
    DI const char* a_base(const Unit& u) const { const int z = u.pm, n = z & 7, h = (z >> 3) & 3, b = z >> 5; const size_t t0 = (size_t)b * 2048 + n * 256; return (const char*)(AQ + (t0 * 4 + h) * 512); }
    DI const char* b_base(const Unit& u) const { return (const char*)(VS + (size_t)u.pm * 262144 + (size_t)u.pn * 256 * 512); } };
DI int moe_tile_expert(const LAS int* ts, int rt) { int e = 0;
#pragma unroll 8
    for (int i = 1; i < 32; ++i) e += (rt >= ts[i]) ? 1 : 0;
    return e; }
struct ProbMoe { static constexpr bool GATHER = false; static constexpr bool FP8 = false; const bf16_t* A; const bf16_t* W; const LAS int* ts; int nper; int lda, ldb, K;
    DI const char* a_base(const Unit& u) const { return (const char*)(A + (size_t)u.pm * 256 * 1024); }
    DI const char* b_base(const Unit& u) const { const int e = moe_tile_expert(ts, u.pm); return (const char*)(W + ((size_t)e * nper + (size_t)u.pn * 256) * 1024); } };

struct ProbPlain8 { static constexpr bool GATHER = false; static constexpr bool FP8 = true; const unsigned char* A; const unsigned char* Bt; int lda, ldb, K;
    DI const char* a_base(const Unit& u) const { return (const char*)(A + (size_t)u.pm * 256 * lda * 2); }
    DI const char* b_base(const Unit& u) const { return (const char*)(Bt + (size_t)u.pn * 256 * ldb * 2); } };
struct ProbMoe8 { static constexpr bool GATHER = false; static constexpr bool FP8 = true; const unsigned char* A; const unsigned char* W; const LAS int* ts; int nper; int lda, ldb, K;
    DI const char* a_base(const Unit& u) const { return (const char*)(A + (size_t)u.pm * 256 * 1024); }
    DI const char* b_base(const Unit& u) const { const int e = moe_tile_expert(ts, u.pm); return (const char*)(W + ((size_t)e * nper + (size_t)u.pn * 256) * 1024); } };
struct ProbMoe8G { static constexpr bool GATHER = true; static constexpr bool FP8 = true; const unsigned char* A; const unsigned char* W; const LAS int* ts; const int* TOK; int nper; int lda, ldb, K;
    DI const char* a_base(const Unit&) const { return (const char*)A; }
    DI const char* b_base(const Unit& u) const { const int e = moe_tile_expert(ts, u.pm); return (const char*)(W + ((size_t)e * nper + (size_t)u.pn * 256) * 1024); } };

constexpr float Y_SC = 8.0f;
constexpr float A_SC = 4.0f;
constexpr float W8_SCALE = 32.0f, WSC = 1.0f / W8_SCALE;
#define EPI_ROWS(ai, m) (128 * (ai) + 64 * wr + 16 * (m) + fr)
struct EpiEvNat { static constexpr bool HOOK = false; static constexpr bool CARRY = false; static DI float carry(const Unit&) { return 0.f; } static constexpr bool PERM = true;
    unsigned char* ws; const float* gains;
    DI void operator()(const Acc& acc, const Unit& u, int wr, int wc, int fr, int fq) const {
        const int pn = u.pn; const bool norm = (pn != 6);
        const int gi = pn < 2 ? 0 : pn < 4 ? 1 : pn < 6 ? 2 : 3;
        const float* g = gains + gi * 64;
        f32x4 gv[2][2];
#pragma unroll
        for (int bj = 0; bj < 2; ++bj)
#pragma unroll
            for (int n = 0; n < 2; ++n) { const f32x4 t4 = *(const f32x4*)(g + 32 * bj + 8 * fq + 4 * n); gv[bj][n] = norm ? t4 : (f32x4){1.f, 1.f, 1.f, 1.f}; }
        size_t boff; int rowmul, hoff; bool panel = false;
        if (pn < 2) { boff = WS_QD; rowmul = 512; hoff = (pn * 4 + wc) * 64; }
        else if (pn < 4) { boff = WS_KD; rowmul = 512; hoff = ((pn - 2) * 4 + wc) * 64; }
        else if (pn < 6) { boff = WS_QN; rowmul = 512; hoff = ((pn - 4) * 4 + wc) * 64; }
        else { panel = true; rowmul = 64; hoff = 0; boff = (pn == 6) ? (wc < 2 ? WS_KCB : WS_VCB) : (wc < 2 ? WS_KSB : WS_KWB); }
        bf16_t* base = (bf16_t*)(ws + boff);
#pragma unroll
        for (int ai = 0; ai < 2; ++ai)
#pragma unroll
            for (int m = 0; m < 4; ++m) {
                const int t = u.pm * 256 + EPI_ROWS(ai, m), b = t >> 11, sq = t & 2047;
                float ss = 0.f;
#pragma unroll
                for (int bj = 0; bj < 2; ++bj)
#pragma unroll
                    for (int n = 0; n < 2; ++n) { const f32x4 x = acc[ai][bj][m][n]; ss += (x[0] * x[0] + x[1] * x[1]) + (x[2] * x[2] + x[3] * x[3]); }
                ss += shx(ss, 16); ss += shx(ss, 32);
                const float rstd = norm ? rsqrtf(ss * (1.0f / 64.0f) + EPS) * ((pn < 2 || pn == 4 || pn == 5) ? 0.125f : 1.0f) : 1.0f;
                const size_t rowi = panel ? ((size_t)(b * 2 + (wc & 1)) * 2048 + sq) : (size_t)t;
#pragma unroll
                for (int bj = 0; bj < 2; ++bj) {
                    const f32x4 v0 = acc[ai][bj][m][0] * rstd * gv[bj][0], v1 = acc[ai][bj][m][1] * rstd * gv[bj][1];
                    *(u32x4*)(base + rowi * rowmul + hoff + 32 * bj + 8 * fq) = pack8(v0, v1);
                }
            }
    }
};
struct EpiEvSw { static constexpr bool HOOK = false; static constexpr bool CARRY = false; static DI float carry(const Unit&) { return 0.f; } static constexpr bool PERM = true;
    unsigned char* ws;
    DI void operator()(const Acc& acc, const Unit& u, int wr, int wc, int fr, int fq) const {
        const int b = u.pn >> 3, sb = (u.pn & 7) * 256;
#pragma unroll
        for (int ai = 0; ai < 2; ++ai)
#pragma unroll
            for (int m = 0; m < 4; ++m) {
                const int rl = EPI_ROWS(ai, m);
                size_t boff, rowi;
                if (u.pm < 2) { const int fg = u.pm * 256 + rl; boff = WS_VAT; rowi = (size_t)(b * 4 + (fg >> 7)) * 128 + (fg & 127); }
                else { const int r2 = rl & 127; boff = (rl < 128) ? WS_VST : WS_VWT; rowi = (size_t)(b * 2 + (r2 >> 6)) * 64 + (r2 & 63); }
                bf16_t* rowp = (bf16_t*)(ws + boff) + rowi * 2048;
#pragma unroll
                for (int bj = 0; bj < 2; ++bj) { const u32x4 pw = pack8(acc[ai][bj][m][0], acc[ai][bj][m][1]);
                    const int s0 = sb + 128 * bj + 32 * wc + 8 * fq; bf16_t* g16 = rowp + (s0 & ~15) + ((s0 & 8) ? 4 : 0);
                    *(u32x2*)g16 = (u32x2){pw.x, pw.y}; *(u32x2*)(g16 + 8) = (u32x2){pw.z, pw.w}; }
            }
    }
};
struct EpiCmp1 { static constexpr bool HOOK = false; static constexpr bool CARRY = false; static DI float carry(const Unit&) { return 0.f; } static constexpr bool PERM = true;
    bf16_t* HID; const float* bias1;
    DI void operator()(const Acc& acc, const Unit& u, int wr, int wc, int fr, int fq) const {
        const int kv = u.pm >> 4, rt = u.pm & 15;
#pragma unroll
        for (int bj = 0; bj < 2; ++bj) {
            const int col = 128 * bj + 32 * wc + 8 * fq;
            const f32x4 b0 = *(const f32x4*)(bias1 + kv * 256 + col), b1 = *(const f32x4*)(bias1 + kv * 256 + col + 4);
#pragma unroll
            for (int ai = 0; ai < 2; ++ai)
#pragma unroll
                for (int m = 0; m < 4; ++m) {
                    f32x4 v0 = acc[ai][bj][m][0] + b0, v1 = acc[ai][bj][m][1] + b1;
#pragma unroll
                    for (int j = 0; j < 4; ++j) { v0[j] = v0[j] * sigm(v0[j]); v1[j] = v1[j] * sigm(v1[j]); }
                    *(u32x4*)(HID + ((size_t)kv * 4096 + rt * 256 + EPI_ROWS(ai, m)) * 256 + col) = pack8(v0, v1);
                }
        }
    }
};
struct EpiResid { static constexpr bool HOOK = false; static constexpr bool CARRY = false; static DI float carry(const Unit&) { return 0.f; } static constexpr bool PERM = true;
    const void* Hin; bf16_t* Hout; bool hb; float sc;
    DI void operator()(const Acc& acc, const Unit& u, int wr, int wc, int fr, int fq) const {
#pragma unroll
        for (int ai = 0; ai < 2; ++ai)
#pragma unroll
            for (int m = 0; m < 4; ++m) {
                const size_t off = (size_t)(u.pm * 256 + EPI_ROWS(ai, m)) * 1024 + u.pn * 256 + 32 * wc + 8 * fq;
#pragma unroll
                for (int bj = 0; bj < 2; ++bj) { const size_t o = off + 128 * bj;
                    *(u32x4*)(Hout + o) = pack8(ld_h4(Hin, hb, o) + acc[ai][bj][m][0] * sc, ld_h4(Hin, hb, o + 4) + acc[ai][bj][m][1] * sc); }
            }
    }
};
DI float ret_lg2(int h) { return __log2f(1.0f - exp2f(-5.0f - (float)h)); }
struct EpiOdNat { static constexpr bool HOOK = false; static constexpr bool CARRY = false; static DI float carry(const Unit&) { return 0.f; } static constexpr bool PERM = true;
    unsigned char* ws;
    DI void operator()(const Acc& acc, const Unit& u, int wr, int wc, int fr, int fq) const {
        const int pn = u.pn; const int h = pn & 3; const float lg = ret_lg2(h);
        const size_t boff = pn < 4 ? WS_AQ : pn < 8 ? WS_KP : WS_GG;
        const int rowmul = pn < 4 ? 2048 : pn < 8 ? 1024 : 2048;
        const int coff = pn < 4 ? (h * 512 + 256) : pn < 8 ? (h * 256) : ((pn - 8) * 256);
        bf16_t* base = (bf16_t*)(ws + boff) + coff;
#pragma unroll
        for (int ai = 0; ai < 2; ++ai)
#pragma unroll
            for (int m = 0; m < 4; ++m) {
                const int cl = EPI_ROWS(ai, m); const size_t t = (size_t)u.pm * 256 + cl;
                float sc = 1.f;
                if (pn < 4) sc = exp2f(lg * (float)(cl + 1)); else if (pn < 8) sc = 0.0625f * exp2f(-lg * (float)(cl + 1));
                sc *= WSC;
#pragma unroll
                for (int bj = 0; bj < 2; ++bj) {
                    const int d = 128 * bj + 32 * wc + 8 * fq;
                    f32x4 v0 = acc[ai][bj][m][0] * sc, v1 = acc[ai][bj][m][1] * sc;
                    if (pn >= 8) {
                        f32x4 e0 = v0 * -1.44269504089f, e1 = v1 * -1.44269504089f;
#pragma unroll
                        for (int j = 0; j < 4; ++j) { e0[j] = __builtin_amdgcn_exp2f(e0[j]); e1[j] = __builtin_amdgcn_exp2f(e1[j]); }
                        e0 = e0 + 1.0f; e1 = e1 + 1.0f;
#pragma unroll
                        for (int j = 0; j < 4; ++j) { e0[j] = __builtin_amdgcn_rcpf(e0[j]); e1[j] = __builtin_amdgcn_rcpf(e1[j]); }
                        v0 = v0 * e0; v1 = v1 * e1; }
                    const u32x4 pw = pack8(v0, v1);
                    *(u32x4*)(base + t * rowmul + d) = pw;
                    if (pn >= 4 && pn < 8) {
                        bf16_t* kt = (bf16_t*)(ws + WS_KT) + ((size_t)((u.pm >> 3) * 4 + h) * 8 + (u.pm & 7)) * 65536 + (size_t)d * 256 + cl;
                        kt[0 * 256] = (bf16_t)(pw.x & 0xffffu); kt[1 * 256] = (bf16_t)(pw.x >> 16); kt[2 * 256] = (bf16_t)(pw.y & 0xffffu); kt[3 * 256] = (bf16_t)(pw.y >> 16);
                        kt[4 * 256] = (bf16_t)(pw.z & 0xffffu); kt[5 * 256] = (bf16_t)(pw.z >> 16); kt[6 * 256] = (bf16_t)(pw.w & 0xffffu); kt[7 * 256] = (bf16_t)(pw.w >> 16);
                    }
                }
            }
    }
};
struct EpiOdSw { static constexpr bool HOOK = false; static constexpr bool CARRY = false; static DI float carry(const Unit&) { return 0.f; } static constexpr bool PERM = true;
    unsigned char* ws;
    DI void operator()(const Acc& acc, const Unit& u, int wr, int wc, int fr, int fq) const {
        const int b = u.pn >> 3, n = u.pn & 7, h = u.pm >> 1;
        const size_t z = (size_t)(b * 4 + h) * 8 + n;
        bf16_t* base = (bf16_t*)(ws + WS_VS) + z * 262144 + (size_t)(u.pm & 1) * 256 * 512;
#pragma unroll
        for (int bj = 0; bj < 2; ++bj) {
            const int cl = 128 * bj + 32 * wc + 8 * fq;
#pragma unroll
            for (int ai = 0; ai < 2; ++ai)
#pragma unroll
                for (int m = 0; m < 4; ++m)
                    *(u32x4*)(base + (size_t)EPI_ROWS(ai, m) * 512 + cl) = pack8(acc[ai][bj][m][0] * WSC, acc[ai][bj][m][1] * WSC);
        }
    }
};
struct EpiAtt { static constexpr bool HOOK = false; static constexpr bool CARRY = false; static DI float carry(const Unit&) { return 0.f; } static constexpr bool PERM = true;
    bf16_t* AQ;
    DI void operator()(const Acc& acc, const Unit& u, int wr, int wc, int fr, int fq) const {
        const int z = u.pm, n = z & 7, h = (z >> 3) & 3, b = z >> 5; const size_t t0 = (size_t)b * 2048 + n * 256;
#pragma unroll
        for (int ai = 0; ai < 2; ++ai)
#pragma unroll
            for (int m = 0; m < 4; ++m) {
                const int c = EPI_ROWS(ai, m);
#pragma unroll
                for (int bj = 0; bj < 2; ++bj) {
                    const int e0 = 128 * bj + 32 * wc + 8 * fq;
                    f32x4 v0 = acc[ai][bj][m][0], v1 = acc[ai][bj][m][1];
#pragma unroll
                    for (int j = 0; j < 4; ++j) { v0[j] = (c >= e0 + j) ? v0[j] : 0.f; v1[j] = (c >= e0 + 4 + j) ? v1[j] : 0.f; }
                    *(u32x4*)(AQ + ((t0 + c) * 4 + h) * 512 + e0) = pack8(v0, v1);
                }
            }
    }
};
struct EpiUT { static constexpr bool HOOK = false; static constexpr bool CARRY = false; static DI float carry(const Unit&) { return 0.f; } static constexpr bool PERM = true;
    bf16_t* UT;
    DI void operator()(const Acc& acc, const Unit& u, int wr, int wc, int fr, int fq) const {
        const size_t z = (size_t)(u.pm >> 1); const int half = u.pm & 1;
#pragma unroll
        for (int ai = 0; ai < 2; ++ai)
#pragma unroll
            for (int m = 0; m < 4; ++m) {
                bf16_t* rowp = UT + z * 131072 + (size_t)(half * 256 + EPI_ROWS(ai, m)) * 256 + 32 * wc + 8 * fq;
#pragma unroll
                for (int bj = 0; bj < 2; ++bj) *(u32x4*)(rowp + 128 * bj) = pack8(acc[ai][bj][m][0], acc[ai][bj][m][1]);
            }
    }
};
struct EpiUTScan { static constexpr bool HOOK = false; static constexpr bool CARRY = true; static constexpr bool PERM = true;
    static DI float carry(const Unit& u) { const int z = u.pm >> 1, n = z & 7, h = (z >> 3) & 3; return n == 7 ? 0.f : exp2f(256.0f * ret_lg2(h)); }
    bf16_t* VS;
    DI void operator()(const Acc& acc, const Unit& u, int wr, int wc, int fr, int fq) const {
        const size_t z = (size_t)(u.pm >> 1); const int half = u.pm & 1, n = (int)(z & 7), h = (int)((z >> 3) & 3);
        const float dec = exp2f(256.0f * ret_lg2(h));
#pragma unroll
        for (int ai = 0; ai < 2; ++ai)
#pragma unroll
            for (int m = 0; m < 4; ++m) {
                bf16_t* rowp = VS + (z * 512 + half * 256 + EPI_ROWS(ai, m)) * 512 + 256 + 32 * wc + 8 * fq;
#pragma unroll
                for (int bj = 0; bj < 2; ++bj) {
                    if (n == 0) { unsigned z0; asm volatile("v_mov_b32 %0, 0" : "=v"(z0)); *(u32x4*)(rowp + 128 * bj) = (u32x4){z0, z0, z0, z0}; }
                    if (n < 7) *(u32x4*)(rowp + (size_t)512 * 512 + 128 * bj) = pack8(acc[ai][bj][m][0] * dec, acc[ai][bj][m][1] * dec);
                }
            }
    }
};
struct SchedSeq { int nb, c;
    DI void init(int G, int c_) { nb = G / 2 > 0 ? G / 2 : 1; c = c_; }
    DI bool next(int i, Unit& u) const { if (c >= nb) return false; const int seq = c + (i >> 3) * nb; if (seq >= 128) return false;
        const int bh = seq >> 1, half = seq & 1, n = i & 7; u.pm = (bh * 8 + n) * 2 + half; u.pn = 0; return true; } };
struct EpiY { static constexpr bool HOOK = false; static constexpr bool CARRY = false; static DI float carry(const Unit&) { return 0.f; } static constexpr bool PERM = true;
    bf16_t* Y;
    DI void operator()(const Acc& acc, const Unit& u, int wr, int wc, int fr, int fq) const {
        const int z = u.pm, n = z & 7, h = (z >> 3) & 3, b = z >> 5; const size_t t0 = (size_t)b * 2048 + n * 256;
#pragma unroll
        for (int ai = 0; ai < 2; ++ai)
#pragma unroll
            for (int m = 0; m < 4; ++m) {
                bf16_t* rowp = Y + (t0 + EPI_ROWS(ai, m)) * 2048 + h * 512 + u.pn * 256 + 32 * wc + 8 * fq;
#pragma unroll
                for (int bj = 0; bj < 2; ++bj) *(u32x4*)(rowp + 128 * bj) = pack8(acc[ai][bj][m][0], acc[ai][bj][m][1]);
            }
    }
};
struct EpiGU { static constexpr bool HOOK = true; static constexpr bool CARRY = false; static DI float carry(const Unit&) { return 0.f; } static constexpr bool PERM = true;
    unsigned char* ACT; const float* bgu; const LAS int* ts;
    DI void prefetch(const Unit& u, LAS unsigned char* lds, int wid, int lane) const {
        if (wid == 0) { const int e = moe_tile_expert(ts, u.pm); const int ln = lane_now();
            const float* src = bgu + (size_t)e * 2048 + 128 * u.pn + ((ln & 32) ? 1024 : 0) + 4 * (ln & 31);
            __builtin_amdgcn_global_load_lds((const unsigned*)src, (LAS unsigned*)(lds + MISC_OFF + MO_RED), 16, 0, 0); }
    }
    DI void operator()(const Acc& acc, const Unit& u, int wr, int wc, int fr, int fq) const {
        const int w = 32 * wc + 8 * fq;
        const LAS float* bl_ = (const LAS float*)(ts) - MO_TS / 4 + MO_RED / 4 + w;
        const f32x4 bg0 = *(const LAS f32x4*)bl_, bg1 = *(const LAS f32x4*)(bl_ + 4), bl0 = *(const LAS f32x4*)(bl_ + 128), bl1 = *(const LAS f32x4*)(bl_ + 132);
#pragma unroll
        for (int ai = 0; ai < 2; ++ai)
#pragma unroll
            for (int m = 0; m < 4; ++m) {
                f32x4 g0 = acc[ai][0][m][0] * WSC + bg0, g1 = acc[ai][0][m][1] * WSC + bg1, l0 = acc[ai][1][m][0] * WSC + bl0, l1 = acc[ai][1][m][1] * WSC + bl1;
                const f32x4 seven = {7.f, 7.f, 7.f, 7.f}, mseven = {-7.f, -7.f, -7.f, -7.f};
                g0 = __builtin_elementwise_min(g0, seven); g1 = __builtin_elementwise_min(g1, seven);
                l0 = __builtin_elementwise_min(__builtin_elementwise_max(l0, mseven), seven); l1 = __builtin_elementwise_min(__builtin_elementwise_max(l1, mseven), seven);
                f32x4 e0 = g0 * (-1.702f * 1.44269504089f), e1 = g1 * (-1.702f * 1.44269504089f);
#pragma unroll
                for (int j = 0; j < 4; ++j) { e0[j] = __builtin_amdgcn_exp2f(e0[j]); e1[j] = __builtin_amdgcn_exp2f(e1[j]); }
                e0 = e0 + 1.0f; e1 = e1 + 1.0f;
#pragma unroll
                for (int j = 0; j < 4; ++j) { e0[j] = __builtin_amdgcn_rcpf(e0[j]); e1[j] = __builtin_amdgcn_rcpf(e1[j]); }
                g0 = g0 * e0 * (l0 + 1.0f); g1 = g1 * e1 * (l1 + 1.0f);
                u32x2 o8; o8.x = pk4_fp8(g0[0], g0[1], g0[2], g0[3]); o8.y = pk4_fp8(g1[0], g1[1], g1[2], g1[3]);
                *(u32x2*)(ACT + ((size_t)u.pm * 256 + EPI_ROWS(ai, m)) * 1024 + 128 * u.pn + w) = o8;
            }
    }
};
struct EpiDN { static constexpr bool HOOK = true; static constexpr bool CARRY = false; static DI float carry(const Unit&) { return 0.f; } static constexpr bool PERM = true;
    unsigned char* YB; const float* bdn; const LAS int* ts;
    DI void prefetch(const Unit& u, LAS unsigned char* lds, int wid, int lane) const {
        if (wid == 0) { const int e = moe_tile_expert(ts, u.pm); const int ln = lane_now();
            __builtin_amdgcn_global_load_lds((const unsigned*)(bdn + (size_t)e * 1024 + 256 * u.pn + 4 * ln), (LAS unsigned*)(lds + MISC_OFF + MO_RED), 16, 0, 0); }
    }
    DI void operator()(const Acc& acc, const Unit& u, int wr, int wc, int fr, int fq) const {
        const LAS float* bl_ = (const LAS float*)(ts) - MO_TS / 4 + MO_RED / 4;
#pragma unroll
        for (int bj = 0; bj < 2; ++bj) {
            const int cl = 128 * bj + 32 * wc + 8 * fq, col = 256 * u.pn + cl;
            const f32x4 b0 = *(const LAS f32x4*)(bl_ + cl), b1 = *(const LAS f32x4*)(bl_ + cl + 4);
#pragma unroll
            for (int ai = 0; ai < 2; ++ai)
#pragma unroll
                for (int m = 0; m < 4; ++m)
                    *(u32x2*)(YB + ((size_t)u.pm * 256 + EPI_ROWS(ai, m)) * 1024 + col) = pack8_fp8(acc[ai][bj][m][0] * (Y_SC / 64.0f) + b0 * Y_SC, acc[ai][bj][m][1] * (Y_SC / 64.0f) + b1 * Y_SC);
        }
    }
};
struct EpiPP { static constexpr bool HOOK = false; static constexpr bool CARRY = false; static DI float carry(const Unit&) { return 0.f; } static constexpr bool PERM = true;
    bf16_t* PP;
    DI void operator()(const Acc& acc, const Unit& u, int wr, int wc, int fr, int fq) const {
#pragma unroll
        for (int ai = 0; ai < 2; ++ai)
#pragma unroll
            for (int m = 0; m < 4; ++m) {
                bf16_t* rowp = PP + ((size_t)u.pm * 256 + EPI_ROWS(ai, m)) * 1024 + u.pn * 256 + 32 * wc + 8 * fq;
#pragma unroll
                for (int bj = 0; bj < 2; ++bj) *(u32x4*)(rowp + 128 * bj) = pack8(acc[ai][bj][m][0], acc[ai][bj][m][1]);
            }
    }
};
struct EpiPLE { static constexpr bool HOOK = false; static constexpr bool CARRY = false; static DI float carry(const Unit&) { return 0.f; } static constexpr bool PERM = true;
    bf16_t* H; const bf16_t* PP; float* out;
    DI void operator()(const Acc& acc, const Unit& u, int wr, int wc, int fr, int fq) const {
#pragma unroll
        for (int ai = 0; ai < 2; ++ai)
#pragma unroll
            for (int m = 0; m < 4; ++m) {
                const size_t off = (size_t)(u.pm * 256 + EPI_ROWS(ai, m)) * 1024 + u.pn * 256 + 32 * wc + 8 * fq;
#pragma unroll
                for (int bj = 0; bj < 2; ++bj) { const size_t o = off + 128 * bj;
                    const u32x4 pw = *(const u32x4*)(PP + o), hw = *(const u32x4*)(H + o); const f32x4 a0 = acc[ai][bj][m][0], a1 = acc[ai][bj][m][1];
                    f32x4 h0 = {bflo(hw.x), bfhi(hw.x), bflo(hw.y), bfhi(hw.y)}, h1 = {bflo(hw.z), bfhi(hw.z), bflo(hw.w), bfhi(hw.w)};
                    const f32x4 p0 = {bflo(pw.x), bfhi(pw.x), bflo(pw.y), bfhi(pw.y)}, p1 = {bflo(pw.z), bfhi(pw.z), bflo(pw.w), bfhi(pw.w)};
                    f32x4 e0 = a0 * (-WSC * 1.44269504089f), e1 = a1 * (-WSC * 1.44269504089f);
#pragma unroll
                    for (int j = 0; j < 4; ++j) { e0[j] = __builtin_amdgcn_exp2f(e0[j]); e1[j] = __builtin_amdgcn_exp2f(e1[j]); }
                    e0 = e0 + 1.0f; e1 = e1 + 1.0f;
#pragma unroll
                    for (int j = 0; j < 4; ++j) { e0[j] = __builtin_amdgcn_rcpf(e0[j]); e1[j] = __builtin_amdgcn_rcpf(e1[j]); }
                    h0 = h0 + e0 * p0; h1 = h1 + e1 * p1;
                    if (out) { *(f32x4*)(out + o) = h0; *(f32x4*)(out + o + 4) = h1; } else *(u32x4*)(H + o) = pack8(h0, h1);
                }
            }
    }
};

DI int vperm16(int key) { const int g = (key >> 2) & 3; const int ng = (g == 1) ? 2 : (g == 2) ? 1 : g; return (key & ~15) | (ng << 2) | (key & 3); }
template <int DV, int MODE>
DI void attn_unit(const int WID, LAS unsigned char* lds, const bf16_t* Qp, int ldq, const bf16_t* Kp, int ldk, const bf16_t* Vt, int ldvt, int q0, float slope, int dcut,
                  const unsigned* selp, bf16_t* Op, int ldo, float* impp) {
    constexpr int NRB = DV / 32;
    constexpr int KT_B = 64 * 128, VT_B = DV * 128, BUF_B = 2 * KT_B + 2 * VT_B;
    const int tid = opaque_tid(WID), w = __builtin_amdgcn_readfirstlane(tid >> 6), lane = tid & 63, r = lane & 31, hh = lane >> 5;
    const int qrow = q0 + 32 * w + r, qw_first = q0 + 32 * w, qw_last = qw_first + 31;
    const float LOG2E = 1.44269504089f;
    bf16x8 qf[4];
#pragma unroll
    for (int ks = 0; ks < 4; ++ks) qf[ks] = *(const bf16x8*)(Qp + (size_t)(32 * w + r) * ldq + 16 * ks + 8 * hh);
    unsigned selm = 0xffffffffu, orm = 0xffffffffu;
    if (MODE == 1) { selm = selp[32 * w + r]; orm = selm;
#pragma unroll
        for (int o = 1; o < 32; o <<= 1) orm |= shxu(orm, o); }
    const int nv = (MODE == 3) ? (qrow >= 31 ? ((qrow - 15) >> 4) : 0) : 0;
    const int nv_wmax = (MODE == 3) ? (qw_last >= 31 ? ((qw_last - 15) >> 4) : 0) : 0;
    int kt_lo = 0, kt_hi;
    if (MODE == 0 || MODE == 1) kt_hi = (q0 >> 6) + 4;
    else if (MODE == 2) { kt_hi = (q0 >> 6) + 4; const int lk = q0 - 511; kt_lo = lk > 0 ? (lk >> 6) : 0; }
    else kt_hi = 2;
    if (MODE != 3) { const int kmin = q0 - dcut; const int lo2 = kmin > 0 ? (kmin >> 6) : 0; kt_lo = lo2 > kt_lo ? lo2 : kt_lo; }
    f32x16 cb[2];
#pragma unroll
    for (int kk = 0; kk < 2; ++kk)
#pragma unroll
        for (int i = 0; i < 16; ++i) cb[kk][i] = (MODE == 3) ? 0.f : slope * (float)(32 * kk + 8 * (i >> 2) + (i & 3) + 4 * hh);
    f32x16 O[NRB];
#pragma unroll
    for (int rb = 0; rb < NRB; ++rb)
#pragma unroll
        for (int i = 0; i < 16; ++i) O[rb][i] = 0.f;
    float mrun = NEGF, lrun = 0.f;
    const int drow = tid >> 3, dpc = (tid & 7) ^ ((drow >> 1) & 7);
    const unsigned ldsw = (unsigned)w * 1024u;
#define AT_DMA(buf, sub, kt) do { const int kt_ = (kt) < 0 ? 0 : (kt); LAS unsigned char* b_ = lds + (buf) * BUF_B; \
        __builtin_amdgcn_global_load_lds((const unsigned*)(Kp + (size_t)(64 * kt_ + drow) * ldk + 8 * dpc), (LAS unsigned*)(b_ + (sub) * KT_B + ldsw), 16, 0, 0); \
        _Pragma("unroll") for (int i_ = 0; i_ < (DV + 63) / 64; ++i_) { if (64 * i_ + 64 <= DV || w < 4) \
            __builtin_amdgcn_global_load_lds((const unsigned*)(Vt + (size_t)(drow + 64 * i_) * ldvt + 64 * kt_ + 8 * dpc), (LAS unsigned*)(b_ + 2 * KT_B + (sub) * VT_B + i_ * 8192 + ldsw), 16, 0, 0); } } while (0)
    const int ntile = kt_hi - kt_lo, nstep = (ntile + 1) >> 1;
    AT_DMA(0, 0, kt_hi - 1); AT_DMA(0, 1, kt_hi - 2);
    asm volatile("s_waitcnt vmcnt(0)" ::: "memory");
    __syncthreads();
#if PROBE_ATT == 2
    AT_DMA(0, 0, kt_hi - 1); AT_DMA(0, 1, kt_hi - 2);
    asm volatile("s_waitcnt vmcnt(0)" ::: "memory");
    __syncthreads();
#endif
    const int sw = (r >> 1) & 7;
    for (int st = 0; st < nstep; ++st) {
        const int buf = st & 1;
        if (st + 1 < nstep) { AT_DMA(buf ^ 1, 0, kt_hi - 3 - 2 * st); AT_DMA(buf ^ 1, 1, kt_hi - 4 - 2 * st); }
#pragma unroll
        for (int sub = 0; sub < 2; ++sub) {
        const int kt = kt_hi - 1 - 2 * st - sub, key0 = 64 * kt;
        bool skip;
        if (MODE == 0) skip = key0 > qw_last;
        else if (MODE == 1) skip = (key0 > qw_last) || !((orm >> (kt & 31)) & 1u);
        else if (MODE == 2) skip = (key0 > qw_last) || (key0 + 63 < qw_first - 511);
        else skip = key0 >= nv_wmax;
        skip = skip || (kt < kt_lo);
        if (!skip) {
            const LAS unsigned char* kb = lds + buf * BUF_B + sub * KT_B; const LAS unsigned char* vb = lds + buf * BUF_B + 2 * KT_B + sub * VT_B;
            f32x16 S[2];
#pragma unroll
            for (int kk = 0; kk < 2; ++kk) {
                S[kk] = cb[kk];
#pragma unroll
                for (int ks = 0; ks < 4; ++ks) { const bf16x8 a = *(const LAS bf16x8*)(kb + (32 * kk + r) * 128 + (((2 * ks + hh) ^ sw) << 4));
                    S[kk] = __builtin_amdgcn_mfma_f32_32x32x16_bf16(a, qf[ks], S[kk], 0, 0, 0); }
            }
            const bool bnd = (MODE == 3) ? true : ((key0 + 63 > qw_first) || (MODE == 2 && key0 < qw_last - 511));
            if (bnd) {
                const int lim = (MODE == 3) ? (nv - key0 - 4 * hh) : (qrow - key0 - 4 * hh);
#pragma unroll
                for (int kk = 0; kk < 2; ++kk)
#pragma unroll
                    for (int i = 0; i < 16; ++i) { const int cki = 32 * kk + 8 * (i >> 2) + (i & 3);
                        bool valid;
                        if (MODE == 3) valid = cki < lim; else if (MODE == 2) valid = (cki <= lim) && (cki > lim - 512); else valid = cki <= lim;
                        S[kk][i] = valid ? S[kk][i] : NEGF; }
            }
            float mx = NEGF;
#pragma unroll
            for (int kk = 0; kk < 2; ++kk)
#pragma unroll
                for (int i = 0; i < 16; ++i) mx = fmaxf(mx, S[kk][i]);
            mx = fmaxf(mx, shx(mx, 32));
            const float off = (MODE == 3) ? 0.f : slope * (float)key0;
            mx += off;
            bool selok = true;
            if (MODE == 1) { selok = ((selm >> (kt & 31)) & 1u) != 0u; mx = selok ? mx : NEGF; }
            const float mnew = fmaxf(mrun, mx);
            const float meff = (mnew < -1e29f) ? 0.f : mnew;
            float c = (off - meff) * LOG2E;
            if (MODE == 1) c = selok ? c : NEGF;
#pragma unroll
            for (int kk = 0; kk < 2; ++kk) { f32x16 t = S[kk] * LOG2E + c;
#pragma unroll
                for (int i = 0; i < 16; ++i) t[i] = __builtin_amdgcn_exp2f(t[i]);
                S[kk] = t; }
            float ps;
            { typedef float f32x8 __attribute__((ext_vector_type(8)));
              const f32x16 su = S[0] + S[1];
              const f32x8 s8 = __builtin_shufflevector(su, su, 0, 1, 2, 3, 4, 5, 6, 7) + __builtin_shufflevector(su, su, 8, 9, 10, 11, 12, 13, 14, 15);
              const f32x4 s4 = __builtin_shufflevector(s8, s8, 0, 1, 2, 3) + __builtin_shufflevector(s8, s8, 4, 5, 6, 7);
              ps = (s4[0] + s4[1]) + (s4[2] + s4[3]); }
            if (__any(mnew > mrun)) {
                const float alpha = __builtin_amdgcn_exp2f((mrun - mnew) * LOG2E);
                lrun *= alpha;
#pragma unroll
                for (int rb = 0; rb < NRB; ++rb)
#pragma unroll
                    for (int i = 0; i < 16; ++i) O[rb][i] *= alpha;
            }
            mrun = mnew; lrun += ps;
#pragma unroll
            for (int kk = 0; kk < 2; ++kk)
#pragma unroll
                for (int s2 = 0; s2 < 2; ++s2) {
                    u32x4 pw; pw.x = pk2(S[kk][8 * s2 + 0], S[kk][8 * s2 + 1]); pw.y = pk2(S[kk][8 * s2 + 2], S[kk][8 * s2 + 3]);
                    pw.z = pk2(S[kk][8 * s2 + 4], S[kk][8 * s2 + 5]); pw.w = pk2(S[kk][8 * s2 + 6], S[kk][8 * s2 + 7]);
                    const bf16x8 pf = __builtin_bit_cast(bf16x8, pw);
#pragma unroll
                    for (int rb = 0; rb < NRB; ++rb) {
                        const bf16x8 a = *(const LAS bf16x8*)(vb + (32 * rb + r) * 128 + ((((2 * kk + s2) * 2 + hh) ^ sw) << 4));
                        O[rb] = __builtin_amdgcn_mfma_f32_32x32x16_bf16(a, pf, O[rb], 0, 0, 0);
                    }
                }
        }
        }
        asm volatile("s_waitcnt vmcnt(0)" ::: "memory");
        __syncthreads();
    }
#undef AT_DMA
    const float ltot = lrun + shx(lrun, 32);
    float inv = 1.0f / ltot;
    if (MODE == 3) inv = (nv > 0) ? inv : 0.f;
#if PROBE_ATT == 1
    for (int rep_ = 0; rep_ < 2; ++rep_) { asm volatile("" ::: "memory");
#endif
#pragma unroll
    for (int rb = 0; rb < NRB; ++rb)
#pragma unroll
        for (int g4 = 0; g4 < 4; ++g4) {
            const float a = O[rb][4 * g4] * inv, b = O[rb][4 * g4 + 1] * inv, c = O[rb][4 * g4 + 2] * inv, d = O[rb][4 * g4 + 3] * inv;
            const int dv = 32 * rb + 8 * g4 + 4 * hh;
            if (MODE == 3 && rb == 2) { *(f32x4*)(impp + (size_t)(32 * w + r) * 256 + (dv - 64)) = (f32x4){a, b, c, d}; }
            else { u32x2 o; o.x = pk2(a, b); o.y = pk2(c, d); *(u32x2*)(Op + (size_t)(32 * w + r) * ldo + dv) = o; }
        }
#if PROBE_ATT == 1
    }
#endif
}

DI void diff_unit(const int WID, LAS unsigned char* lds, const bf16_t* Q1p, const bf16_t* Q2p, const bf16_t* K1p, const bf16_t* K2p, const bf16_t* Vt, int q0, float slope, int dcut,
                  const float lam, const float oscale, const float* og, unsigned char* Ap) {
    constexpr int DV = 128, MODE = 0, ldq = 512, ldk = 512, ldvt = 2048;
    constexpr int NRB = DV / 32;
    constexpr int KT_B = 64 * 128, VT_B = DV * 128, BUF_B = 2 * KT_B + 2 * VT_B;
    const int tid = opaque_tid(WID), w = __builtin_amdgcn_readfirstlane(tid >> 6), lane = tid & 63, r = lane & 31, hh = lane >> 5;
    const int qrow = q0 + 32 * w + r, qw_first = q0 + 32 * w, qw_last = qw_first + 31;
    const float LOG2E = 1.44269504089f;
    unsigned selm = 0xffffffffu, orm = 0xffffffffu;
    const int nv = (MODE == 3) ? (qrow >= 31 ? ((qrow - 15) >> 4) : 0) : 0;
    const int nv_wmax = (MODE == 3) ? (qw_last >= 31 ? ((qw_last - 15) >> 4) : 0) : 0;
    int kt_lo = 0, kt_hi;
    if (MODE == 0 || MODE == 1) kt_hi = (q0 >> 6) + 4;
    else if (MODE == 2) { kt_hi = (q0 >> 6) + 4; const int lk = q0 - 511; kt_lo = lk > 0 ? (lk >> 6) : 0; }
    else kt_hi = 2;
    if (MODE != 3) { const int kmin = q0 - dcut; const int lo2 = kmin > 0 ? (kmin >> 6) : 0; kt_lo = lo2 > kt_lo ? lo2 : kt_lo; }
    f32x16 cb0;
#pragma unroll
    for (int i = 0; i < 16; ++i) cb0[i] = slope * (float)(8 * (i >> 2) + (i & 3) + 4 * hh);
    const float slope32 = 32.0f * slope;
    const int drow = tid >> 3, dpc = (tid & 7) ^ ((drow >> 1) & 7);
    const unsigned ldsw = (unsigned)w * 1024u;
#define AT_DMA(buf, sub, kt) do { const int kt_ = (kt) < 0 ? 0 : (kt); LAS unsigned char* b_ = lds + (buf) * BUF_B; \
        __builtin_amdgcn_global_load_lds((const unsigned*)(Kp + (size_t)(64 * kt_ + drow) * ldk + 8 * dpc), (LAS unsigned*)(b_ + (sub) * KT_B + ldsw), 16, 0, 0); \
        _Pragma("unroll") for (int i_ = 0; i_ < (DV + 63) / 64; ++i_) { if (64 * i_ + 64 <= DV || w < 4) \
            __builtin_amdgcn_global_load_lds((const unsigned*)(Vt + (size_t)(drow + 64 * i_) * ldvt + 64 * kt_ + 8 * dpc), (LAS unsigned*)(b_ + 2 * KT_B + (sub) * VT_B + i_ * 8192 + ldsw), 16, 0, 0); } } while (0)
    const int ntile = kt_hi - kt_lo, nstep = (ntile + 1) >> 1;
    const int sw = (r >> 1) & 7;
    u32x4 O1p[NRB][2];
#pragma unroll 1
    for (int pass = 0; pass < 2; ++pass) {
    const bf16_t* Qp = pass ? Q2p : Q1p; const bf16_t* Kp = pass ? K2p : K1p;
    bf16x8 qf[4];
#pragma unroll
    for (int ks = 0; ks < 4; ++ks) qf[ks] = *(const bf16x8*)(Qp + (size_t)(32 * w + r) * ldq + 16 * ks + 8 * hh);
    f32x16 O[NRB];
#pragma unroll
    for (int rb = 0; rb < NRB; ++rb)
#pragma unroll
        for (int i = 0; i < 16; ++i) O[rb][i] = 0.f;
    float mrun = NEGF, lrun = 0.f;
    AT_DMA(0, 0, kt_hi - 1); AT_DMA(0, 1, kt_hi - 2);
    asm volatile("s_waitcnt vmcnt(0)" ::: "memory");
    __syncthreads();
    for (int st = 0; st < nstep; ++st) {
        const int buf = st & 1;
        if (st + 1 < nstep) { AT_DMA(buf ^ 1, 0, kt_hi - 3 - 2 * st); AT_DMA(buf ^ 1, 1, kt_hi - 4 - 2 * st); }
#pragma unroll
        for (int sub = 0; sub < 2; ++sub) {
        const int kt = kt_hi - 1 - 2 * st - sub, key0 = 64 * kt;
        bool skip;
        if (MODE == 0) skip = key0 > qw_last;
        else if (MODE == 1) skip = (key0 > qw_last) || !((orm >> (kt & 31)) & 1u);
        else if (MODE == 2) skip = (key0 > qw_last) || (key0 + 63 < qw_first - 511);
        else skip = key0 >= nv_wmax;
        skip = skip || (kt < kt_lo);
        if (!skip) {
            const LAS unsigned char* kb = lds + buf * BUF_B + sub * KT_B; const LAS unsigned char* vb = lds + buf * BUF_B + 2 * KT_B + sub * VT_B;
            f32x16 S[2];
#pragma unroll
            for (int kk = 0; kk < 2; ++kk) {
                if (kk == 0) S[0] = cb0; else S[1] = cb0 + slope32;
#pragma unroll
                for (int ks = 0; ks < 4; ++ks) { const bf16x8 a = *(const LAS bf16x8*)(kb + (32 * kk + r) * 128 + (((2 * ks + hh) ^ sw) << 4));
                    S[kk] = __builtin_amdgcn_mfma_f32_32x32x16_bf16(a, qf[ks], S[kk], 0, 0, 0); }
            }
            const bool bnd = (MODE == 3) ? true : ((key0 + 63 > qw_first) || (MODE == 2 && key0 < qw_last - 511));
            if (bnd) {
                const int lim = (MODE == 3) ? (nv - key0 - 4 * hh) : (qrow - key0 - 4 * hh);
#pragma unroll
                for (int kk = 0; kk < 2; ++kk)
#pragma unroll
                    for (int i = 0; i < 16; ++i) { const int cki = 32 * kk + 8 * (i >> 2) + (i & 3);
                        bool valid;
                        if (MODE == 3) valid = cki < lim; else if (MODE == 2) valid = (cki <= lim) && (cki > lim - 512); else valid = cki <= lim;
                        S[kk][i] = valid ? S[kk][i] : NEGF; }
            }
            float mx = NEGF;
#pragma unroll
            for (int kk = 0; kk < 2; ++kk)
#pragma unroll
                for (int i = 0; i < 16; ++i) mx = fmaxf(mx, S[kk][i]);
            mx = fmaxf(mx, shx(mx, 32));
            const float off = (MODE == 3) ? 0.f : slope * (float)key0;
            mx += off;
            bool selok = true;
            if (MODE == 1) { selok = ((selm >> (kt & 31)) & 1u) != 0u; mx = selok ? mx : NEGF; }
            const float mnew = fmaxf(mrun, mx);
            const float meff = (mnew < -1e29f) ? 0.f : mnew;
            float c = (off - meff) * LOG2E;
            if (MODE == 1) c = selok ? c : NEGF;
#pragma unroll
            for (int kk = 0; kk < 2; ++kk) { f32x16 t = S[kk] * LOG2E + c;
#pragma unroll
                for (int i = 0; i < 16; ++i) t[i] = __builtin_amdgcn_exp2f(t[i]);
                S[kk] = t; }
            float ps;
            { typedef float f32x8 __attribute__((ext_vector_type(8)));
              const f32x16 su = S[0] + S[1];
              const f32x8 s8 = __builtin_shufflevector(su, su, 0, 1, 2, 3, 4, 5, 6, 7) + __builtin_shufflevector(su, su, 8, 9, 10, 11, 12, 13, 14, 15);
              const f32x4 s4 = __builtin_shufflevector(s8, s8, 0, 1, 2, 3) + __builtin_shufflevector(s8, s8, 4, 5, 6, 7);
              ps = (s4[0] + s4[1]) + (s4[2] + s4[3]); }
            if (__any(mnew > mrun)) {
                const float alpha = __builtin_amdgcn_exp2f((mrun - mnew) * LOG2E);
                lrun *= alpha;
#pragma unroll
                for (int rb = 0; rb < NRB; ++rb)
#pragma unroll
                    for (int i = 0; i < 16; ++i) O[rb][i] *= alpha;
            }
            mrun = mnew; lrun += ps;
#pragma unroll
            for (int kk = 0; kk < 2; ++kk)
#pragma unroll
                for (int s2 = 0; s2 < 2; ++s2) {
                    u32x4 pw; pw.x = pk2(S[kk][8 * s2 + 0], S[kk][8 * s2 + 1]); pw.y = pk2(S[kk][8 * s2 + 2], S[kk][8 * s2 + 3]);
                    pw.z = pk2(S[kk][8 * s2 + 4], S[kk][8 * s2 + 5]); pw.w = pk2(S[kk][8 * s2 + 6], S[kk][8 * s2 + 7]);
                    const bf16x8 pf = __builtin_bit_cast(bf16x8, pw);
#pragma unroll
                    for (int rb = 0; rb < NRB; ++rb) {
                        const bf16x8 a = *(const LAS bf16x8*)(vb + (32 * rb + r) * 128 + ((((2 * kk + s2) * 2 + hh) ^ sw) << 4));
                        O[rb] = __builtin_amdgcn_mfma_f32_32x32x16_bf16(a, pf, O[rb], 0, 0, 0);
                    }
                }
        }
        }
        asm volatile("s_waitcnt vmcnt(0)" ::: "memory");
        __syncthreads();
    }
#undef AT_DMA
    const float ltot = lrun + shx(lrun, 32);
    const float inv = 1.0f / ltot;
    if (pass == 0) {
#pragma unroll
        for (int rb = 0; rb < NRB; ++rb) { const f32x16 on = O[rb] * inv;
            O1p[rb][0] = (u32x4){pk2(on[0], on[1]), pk2(on[2], on[3]), pk2(on[4], on[5]), pk2(on[6], on[7])};
            O1p[rb][1] = (u32x4){pk2(on[8], on[9]), pk2(on[10], on[11]), pk2(on[12], on[13]), pk2(on[14], on[15])}; }
    } else {
        const float li = lam * inv; float ss = 0.f;
#pragma unroll
        for (int rb = 0; rb < NRB; ++rb) {
            const u32x4 p0 = O1p[rb][0], p1 = O1p[rb][1];
            const f32x16 o1 = {bflo(p0.x), bfhi(p0.x), bflo(p0.y), bfhi(p0.y), bflo(p0.z), bfhi(p0.z), bflo(p0.w), bfhi(p0.w), bflo(p1.x), bfhi(p1.x), bflo(p1.y), bfhi(p1.y), bflo(p1.z), bfhi(p1.z), bflo(p1.w), bfhi(p1.w)};
            O[rb] = o1 - O[rb] * li;
#pragma unroll
            for (int i = 0; i < 16; ++i) ss += O[rb][i] * O[rb][i];
        }
        ss += shx(ss, 32);
        const float rs = rsqrtf(ss * (1.0f / 128.0f) + EPS) * (oscale * A_SC);
        const int hg_ = lane_now() >> 5;
#pragma unroll
        for (int rb = 0; rb < NRB; ++rb)
#pragma unroll
            for (int g4 = 0; g4 < 4; ++g4) { const int dv = 32 * rb + 8 * g4 + 4 * hh; const f32x4 gg = *(const f32x4*)(og + 32 * rb + 8 * g4 + 4 * hg_);
                *(unsigned*)(Ap + (size_t)(32 * w + r) * 1024 + dv) = pk4_fp8(O[rb][4 * g4] * rs * gg[0], O[rb][4 * g4 + 1] * rs * gg[1], O[rb][4 * g4 + 2] * rs * gg[2], O[rb][4 * g4 + 3] * rs * gg[3]); }
    }
    }
}

template <int DV, int MODE>
DI void nsa_unit(const int WID, LAS unsigned char* lds, const bf16x8 (&qf)[4], const bf16_t* Kp, int ldk, const bf16_t* Vt, int ldvt, int q0, int g, float sb2,
                 const LAS unsigned* selp, f32x16 (&OB)[2], const float gate, LAS float* impp) {
    constexpr int NRB = DV / 32;
    constexpr int KT_B = 64 * 128, VT_B = DV * 128, BUF_B = 2 * KT_B + 2 * VT_B;
    const int tid = opaque_tid(WID), w = __builtin_amdgcn_readfirstlane(tid >> 6), lane = tid & 63, r = lane & 31, hh = lane >> 5;
    const int hr = w >> 1, qh = w & 1;
    const float slope = (MODE == 1) ? exp2f(-(float)(4 * g + hr + 1)) : 0.f;
    const int dcut = (MODE == 1) ? (int)fminf(sb2 / slope + 1.0f, 100000.0f) : 0, dcut_max = (MODE == 1) ? (int)fminf(sb2 * exp2f((float)(4 * g + 4)) + 1.0f, 100000.0f) : 0;
    const int qrow = q0 + 32 * qh + r, qw_first = q0 + 32 * qh, qw_last = qw_first + 31;
    const float LOG2E = 1.44269504089f;
    unsigned selm = 0xffffffffu, orm = 0xffffffffu;
    if (MODE == 1) { selm = selp[32 * qh + r]; orm = selm;
#pragma unroll
        for (int o = 1; o < 32; o <<= 1) orm |= shxu(orm, o); }
    const int nv = (MODE == 3) ? (qrow >= 31 ? ((qrow - 15) >> 4) : 0) : 0;
    const int nv_wmax = (MODE == 3) ? (qw_last >= 31 ? ((qw_last - 15) >> 4) : 0) : 0;
    int kt_lo = 0, kt_hi;
    if (MODE == 1) kt_hi = (q0 >> 6) + 1; else kt_hi = 2;
    if (MODE != 3) { const int kmin = q0 - dcut_max; const int lo2 = kmin > 0 ? (kmin >> 6) : 0; kt_lo = lo2 > kt_lo ? lo2 : kt_lo; }
    f32x16 cb[2];
#pragma unroll
    for (int kk = 0; kk < 2; ++kk)
#pragma unroll
        for (int i = 0; i < 16; ++i) cb[kk][i] = (MODE == 3) ? 0.f : slope * (float)(32 * kk + 8 * (i >> 2) + (i & 3) + 4 * hh);
    f32x16 O[NRB];
#pragma unroll
    for (int rb = 0; rb < NRB; ++rb)
#pragma unroll
        for (int i = 0; i < 16; ++i) O[rb][i] = 0.f;
    float mrun = NEGF, lrun = 0.f;
    const int drow = tid >> 3, dpc = (tid & 7) ^ ((drow >> 1) & 7);
    const unsigned ldsw = (unsigned)w * 1024u;
#define AT_DMA(buf, sub, kt) do { const int kt_ = (kt) < 0 ? 0 : (kt); LAS unsigned char* b_ = lds + (buf) * BUF_B; \
        __builtin_amdgcn_global_load_lds((const unsigned*)(Kp + (size_t)(64 * kt_ + drow) * ldk + 8 * dpc), (LAS unsigned*)(b_ + (sub) * KT_B + ldsw), 16, 0, 0); \
        _Pragma("unroll") for (int i_ = 0; i_ < (DV + 63) / 64; ++i_) { if (64 * i_ + 64 <= DV || w < 4) \
            __builtin_amdgcn_global_load_lds((const unsigned*)(Vt + (size_t)(drow + 64 * i_) * ldvt + 64 * kt_ + 8 * dpc), (LAS unsigned*)(b_ + 2 * KT_B + (sub) * VT_B + i_ * 8192 + ldsw), 16, 0, 0); } } while (0)
    const int ntile = kt_hi - kt_lo, nstep = (ntile + 1) >> 1;
    AT_DMA(0, 0, kt_hi - 1); AT_DMA(0, 1, kt_hi - 2);
    asm volatile("s_waitcnt vmcnt(0)" ::: "memory");
    __syncthreads();
    const int sw = (r >> 1) & 7;
    for (int st = 0; st < nstep; ++st) {
        const int buf = st & 1;
        if (st + 1 < nstep) { AT_DMA(buf ^ 1, 0, kt_hi - 3 - 2 * st); AT_DMA(buf ^ 1, 1, kt_hi - 4 - 2 * st); }
#pragma unroll
        for (int sub = 0; sub < 2; ++sub) {
        const int kt = kt_hi - 1 - 2 * st - sub, key0 = 64 * kt;
        bool skip;
        if (MODE == 0) skip = key0 > qw_last;
        else if (MODE == 1) skip = (key0 > qw_last) || !((orm >> (kt & 31)) & 1u) || (key0 + 63 < qw_first - dcut);
        else if (MODE == 2) skip = (key0 > qw_last) || (key0 + 63 < qw_first - 511);
        else skip = key0 >= nv_wmax;
        skip = skip || (kt < kt_lo);
        if (!skip) {
            const LAS unsigned char* kb = lds + buf * BUF_B + sub * KT_B; const LAS unsigned char* vb = lds + buf * BUF_B + 2 * KT_B + sub * VT_B;
            f32x16 S[2];
#pragma unroll
            for (int kk = 0; kk < 2; ++kk) {
                S[kk] = cb[kk];
#pragma unroll
                for (int ks = 0; ks < 4; ++ks) { const bf16x8 a = *(const LAS bf16x8*)(kb + (32 * kk + r) * 128 + (((2 * ks + hh) ^ sw) << 4));
                    S[kk] = __builtin_amdgcn_mfma_f32_32x32x16_bf16(a, qf[ks], S[kk], 0, 0, 0); }
            }
            const bool bnd = (MODE == 3) ? true : ((key0 + 63 > qw_first) || (MODE == 2 && key0 < qw_last - 511));
            if (bnd) {
                const int lim = (MODE == 3) ? (nv - key0 - 4 * hh) : (qrow - key0 - 4 * hh);
#pragma unroll
                for (int kk = 0; kk < 2; ++kk)
#pragma unroll
                    for (int i = 0; i < 16; ++i) { const int cki = 32 * kk + 8 * (i >> 2) + (i & 3);
                        bool valid;
                        if (MODE == 3) valid = cki < lim; else if (MODE == 2) valid = (cki <= lim) && (cki > lim - 512); else valid = cki <= lim;
                        S[kk][i] = valid ? S[kk][i] : NEGF; }
            }
            float mx = NEGF;
#pragma unroll
            for (int kk = 0; kk < 2; ++kk)
#pragma unroll
                for (int i = 0; i < 16; ++i) mx = fmaxf(mx, S[kk][i]);
            mx = fmaxf(mx, shx(mx, 32));
            const float off = (MODE == 3) ? 0.f : slope * (float)key0;
            mx += off;
            bool selok = true;
            if (MODE == 1) { selok = ((selm >> (kt & 31)) & 1u) != 0u; mx = selok ? mx : NEGF; }
            const float mnew = fmaxf(mrun, mx);
            const float meff = (mnew < -1e29f) ? 0.f : mnew;
            float c = (off - meff) * LOG2E;
            if (MODE == 1) c = selok ? c : NEGF;
#pragma unroll
            for (int kk = 0; kk < 2; ++kk) { f32x16 t = S[kk] * LOG2E + c;
#pragma unroll
                for (int i = 0; i < 16; ++i) t[i] = __builtin_amdgcn_exp2f(t[i]);
                S[kk] = t; }
            float ps;
            { typedef float f32x8 __attribute__((ext_vector_type(8)));
              const f32x16 su = S[0] + S[1];
              const f32x8 s8 = __builtin_shufflevector(su, su, 0, 1, 2, 3, 4, 5, 6, 7) + __builtin_shufflevector(su, su, 8, 9, 10, 11, 12, 13, 14, 15);
              const f32x4 s4 = __builtin_shufflevector(s8, s8, 0, 1, 2, 3) + __builtin_shufflevector(s8, s8, 4, 5, 6, 7);
              ps = (s4[0] + s4[1]) + (s4[2] + s4[3]); }
            if (__any(mnew > mrun)) {
                const float alpha = __builtin_amdgcn_exp2f((mrun - mnew) * LOG2E);
                lrun *= alpha;
#pragma unroll
                for (int rb = 0; rb < NRB; ++rb)
#pragma unroll
                    for (int i = 0; i < 16; ++i) O[rb][i] *= alpha;
            }
            mrun = mnew; lrun += ps;
#pragma unroll
            for (int kk = 0; kk < 2; ++kk)
#pragma unroll
                for (int s2 = 0; s2 < 2; ++s2) {
                    u32x4 pw; pw.x = pk2(S[kk][8 * s2 + 0], S[kk][8 * s2 + 1]); pw.y = pk2(S[kk][8 * s2 + 2], S[kk][8 * s2 + 3]);
                    pw.z = pk2(S[kk][8 * s2 + 4], S[kk][8 * s2 + 5]); pw.w = pk2(S[kk][8 * s2 + 6], S[kk][8 * s2 + 7]);
                    const bf16x8 pf = __builtin_bit_cast(bf16x8, pw);
#pragma unroll
                    for (int rb = 0; rb < NRB; ++rb) {
                        const bf16x8 a = *(const LAS bf16x8*)(vb + (32 * rb + r) * 128 + ((((2 * kk + s2) * 2 + hh) ^ sw) << 4));
                        O[rb] = __builtin_amdgcn_mfma_f32_32x32x16_bf16(a, pf, O[rb], 0, 0, 0);
                    }
                }
        }
        }
        asm volatile("s_waitcnt vmcnt(0)" ::: "memory");
        __syncthreads();
    }
#undef AT_DMA
    const float ltot = lrun + shx(lrun, 32);
    float inv = 1.0f / ltot;
    if (MODE == 3) inv = (nv > 0) ? inv : 0.f;
    const float gi = inv * gate;
#pragma unroll
    for (int rb = 0; rb < 2; ++rb) OB[rb] += O[rb] * gi;
    if (MODE == 3) {
#pragma unroll
        for (int g4 = 0; g4 < 4; ++g4)
            *(LAS f32x4*)(impp + (hr * 64 + 32 * qh + r) * 32 + 8 * g4 + 4 * hh) = (f32x4){O[2][4 * g4] * inv, O[2][4 * g4 + 1] * inv, O[2][4 * g4 + 2] * inv, O[2][4 * g4 + 3] * inv};
    }
}


struct Args { const float* in[26]; float* out; unsigned char* ws; int ph_lo, ph_hi; };
typedef const __attribute__((address_space(4))) Args* ArgsP;
DI ArgsP opaque_args() { auto p = __builtin_amdgcn_kernarg_segment_ptr(); asm volatile("" : "+s"(p)); return (ArgsP)p; }
enum { I_X = 0, I_P, I_N1G, I_N2G, I_EVWIN, I_EVWOUT, I_DAQN, I_DAKN, I_DALAM, I_DAOUTG, I_NSQN, I_NSKN, I_CMPPE, I_CMPW1, I_CMPW2, I_ODWIN, I_ODWOUT,
       I_RETG, I_ROUTW, I_ROUTB, I_WGU, I_BGU, I_WDN, I_BDN, I_PLEP, I_PLEG };

struct CvtJob { int in_idx, ldsrc, K, col0, ncols, dstrow0, perm, nmat; size_t src_stride, dst_off, dst_stride; int fp8, pad; };
constexpr int NJOBS = 19;
__constant__ CvtJob c_jobs[NJOBS] = {
    {I_EVWIN, EVIN, 1024, 0,    1024, 0,    1, 2, (size_t)1024 * EVIN, WS_EVNAT, (size_t)2048 * 1024, 0, 0},
    {I_EVWIN, EVIN, 1024, 1536, 512,  1024, 1, 2, (size_t)1024 * EVIN, WS_EVNAT, (size_t)2048 * 1024, 0, 0},
    {I_EVWIN, EVIN, 1024, 2048, 128,  1536, 1, 2, (size_t)1024 * EVIN, WS_EVNAT, (size_t)2048 * 1024, 0, 0},
    {I_EVWIN, EVIN, 1024, 2176, 128,  1664, 1, 2, (size_t)1024 * EVIN, WS_EVNAT, (size_t)2048 * 1024, 0, 0},
    {I_EVWIN, EVIN, 1024, 2304, 128,  1792, 1, 2, (size_t)1024 * EVIN, WS_EVNAT, (size_t)2048 * 1024, 0, 0},
    {I_EVWIN, EVIN, 1024, 2560, 128,  1920, 1, 2, (size_t)1024 * EVIN, WS_EVNAT, (size_t)2048 * 1024, 0, 0},
    {I_EVWIN, EVIN, 1024, 1024, 512,  0,    0, 2, (size_t)1024 * EVIN, WS_EVSW,  (size_t)768 * 1024, 0, 0},
    {I_EVWIN, EVIN, 1024, 2432, 128,  512,  0, 2, (size_t)1024 * EVIN, WS_EVSW,  (size_t)768 * 1024, 0, 0},
    {I_EVWIN, EVIN, 1024, 2688, 128,  640,  0, 2, (size_t)1024 * EVIN, WS_EVSW,  (size_t)768 * 1024, 0, 0},
    {I_EVWOUT, 1024, 1024, 0, 1024, 0, 0, 2, (size_t)1024 * 1024, WS_EVOUT, (size_t)1024 * 1024, 64, 0},
    {I_CMPW1, 256, 2048, 0, 256, 0, 0, 4, (size_t)2048 * 256, WS_CMP1, (size_t)256 * 2048, 0, 0},
    {I_ODWIN, ODIN, 1024, 0,    2048, 0,    0, 2, (size_t)1024 * ODIN, WS_ODNAT, (size_t)4096 * 1024, 32, 0},
    {I_ODWIN, ODIN, 1024, 4096, 2048, 2048, 0, 2, (size_t)1024 * ODIN, WS_ODNAT, (size_t)4096 * 1024, 32, 0},
    {I_ODWIN, ODIN, 1024, 2048, 2048, 0,    0, 2, (size_t)1024 * ODIN, WS_ODSW,  (size_t)2048 * 1024, 32, 0},
    {I_ODWOUT, 1024, 2048, 0, 1024, 0, 0, 2, (size_t)2048 * 1024, WS_ODOUT, (size_t)1024 * 2048, 128, 0},
    {I_WGU, 2048, 1024, 0, 2048, 0, 2, 128, (size_t)1024 * 2048, WS_WGU, (size_t)2048 * 1024, 32, 0},
    {I_WDN, 1024, 1024, 0, 1024, 0, 0, 128, (size_t)1024 * 1024, WS_WDN, (size_t)1024 * 1024, 64, 0},
    {I_PLEP, 1024, 256, 0, 1024, 0, 0, 4, (size_t)256 * 1024, WS_WPP, (size_t)1024 * 256, 0, 0},
    {I_PLEG, 1024, 1024, 0, 1024, 0, 0, 4, (size_t)1024 * 1024, WS_WPG, (size_t)1024 * 1024, 32, 0},
};
DI int cvt_dstrow(int perm, int L) {
    if (perm == 1) { const int pn = L >> 8, lc = L & 255; return pn * 256 + 128 * ((lc & 63) >> 5) + 32 * (lc >> 6) + (lc & 31); }
    if (perm == 2) { const int bj = L >> 10, cc = L & 1023; return 256 * (cc >> 7) + 128 * bj + (cc & 127); }
    return L;
}
DI void phase_prologue(const int WID, ArgsP a, LAS unsigned char* lds) {
    const int tid = opaque_tid(WID), lane = tid & 63, wv = tid >> 6;
    const int gw = blockIdx.x * 8 + wv, NGW = gridDim.x * 8;
    LAS float* scr = (LAS float*)(lds + wv * 16896);
    int total = 0;
    for (int j = 0; j < NJOBS; ++j) total += c_jobs[j].nmat * (c_jobs[j].K >> 6) * (c_jobs[j].ncols >> 6);
#define PRO_DECODE(IT, JJ, MAT, K0, N0, SRC, RS) do { int r_ = (IT), j_ = 0; \
        for (; j_ < NJOBS; ++j_) { const int n_ = c_jobs[j_].nmat * (c_jobs[j_].K >> 6) * (c_jobs[j_].ncols >> 6); if (r_ < n_) break; r_ -= n_; } \
        JJ = j_; const bool f8_ = c_jobs[j_].fp8 != 0; const int nkb_ = f8_ ? (c_jobs[j_].K >> 7) : (c_jobs[j_].K >> 6), nnb_ = f8_ ? (c_jobs[j_].ncols >> 5) : (c_jobs[j_].ncols >> 6), per_ = nkb_ * nnb_; \
        MAT = r_ / per_; const int rr_ = r_ % per_; K0 = (rr_ / nnb_) * (f8_ ? 128 : 64); N0 = (rr_ % nnb_) * (f8_ ? 32 : 64); const int ld_ = c_jobs[j_].ldsrc; \
        SRC = a->in[c_jobs[j_].in_idx] + (size_t)MAT * c_jobs[j_].src_stride + (size_t)K0 * ld_ + c_jobs[j_].col0 + N0 + (f8_ ? (lane & 31) + (lane >> 5) * ld_ : lane); RS = f8_ ? 2 * ld_ : ld_; } while (0)
    float tv[64];
    int jn = 0, matn = 0, k0n = 0, n0n = 0, rsn = 0; const float* srcn = nullptr;
    if (gw < total) { PRO_DECODE(gw, jn, matn, k0n, n0n, srcn, rsn);
#pragma unroll
        for (int i = 0; i < 64; ++i) tv[i] = srcn[(size_t)i * rsn]; }
    for (int it = gw; it < total; it += NGW) {
        const CvtJob J = c_jobs[jn]; const int mat = matn, k0 = k0n, n0 = n0n;
        { const int wb = J.fp8 ? (lane >> 5) * 33 + (lane & 31) : lane, wst = J.fp8 ? 66 : 65;
#pragma unroll
          for (int i = 0; i < 64; ++i) scr[wb + i * wst] = tv[i]; }
        if (it + NGW < total) { PRO_DECODE(it + NGW, jn, matn, k0n, n0n, srcn, rsn);
#if PROBE_PRO == 2
            { float sink = 0.f;
#pragma unroll
              for (int i = 0; i < 64; ++i) sink += ((const volatile float*)srcn)[(size_t)i * rsn];
              asm volatile("" :: "v"(sink)); }
#endif
#pragma unroll
            for (int i = 0; i < 64; ++i) tv[i] = srcn[(size_t)i * rsn]; }
        asm volatile("s_waitcnt lgkmcnt(0)" ::: "memory");
        if (J.fp8) {
            unsigned char* dst = (unsigned char*)(a->ws + J.dst_off) + (size_t)mat * J.dst_stride;
            const int c = lane & 7, nsub = lane >> 3; const float W8_S = (float)J.fp8;
#pragma unroll
            for (int jj = 0; jj < 4; ++jj) {
                const int n = nsub + 8 * jj; const LAS float* s = scr + (16 * c) * 33 + n;
                u32x4 o;
                o.x = pk4_fp8(s[0] * W8_S, s[33] * W8_S, s[2 * 33] * W8_S, s[3 * 33] * W8_S); o.y = pk4_fp8(s[4 * 33] * W8_S, s[5 * 33] * W8_S, s[6 * 33] * W8_S, s[7 * 33] * W8_S);
                o.z = pk4_fp8(s[8 * 33] * W8_S, s[9 * 33] * W8_S, s[10 * 33] * W8_S, s[11 * 33] * W8_S); o.w = pk4_fp8(s[12 * 33] * W8_S, s[13 * 33] * W8_S, s[14 * 33] * W8_S, s[15 * 33] * W8_S);
                const int drow = cvt_dstrow(J.perm, J.dstrow0 + n0 + n);
                *(u32x4*)(dst + (size_t)drow * J.K + k0 + 16 * c) = o;
#if PROBE_PRO == 1
                asm volatile("" ::: "memory"); *(u32x4*)(dst + (size_t)drow * J.K + k0 + 16 * c) = o;
#endif
            }
        } else {
            bf16_t* dst = (bf16_t*)(a->ws + J.dst_off) + (size_t)mat * J.dst_stride;
            const int c = lane & 7, nsub = lane >> 3;
#pragma unroll
            for (int jj = 0; jj < 8; ++jj) {
                const int n = nsub + 8 * jj; const LAS float* s = scr + (8 * c) * 65 + n;
                u32x4 o; o.x = pk2(s[0], s[65]); o.y = pk2(s[2 * 65], s[3 * 65]); o.z = pk2(s[4 * 65], s[5 * 65]); o.w = pk2(s[6 * 65], s[7 * 65]);
                const int drow = cvt_dstrow(J.perm, J.dstrow0 + n0 + n);
                *(u32x4*)(dst + (size_t)drow * J.K + k0 + 8 * c) = o;
#if PROBE_PRO == 1
                asm volatile("" ::: "memory"); *(u32x4*)(dst + (size_t)drow * J.K + k0 + 8 * c) = o;
#endif
            }
        }
        asm volatile("s_waitcnt lgkmcnt(0)" ::: "memory");
    }
#undef PRO_DECODE
    {
        const float* p = a->in[I_P]; bf16_t* pb = (bf16_t*)(a->ws + WS_PBF);
        const size_t n8 = (size_t)DEPTH * T * 256 / 8;
        const size_t st = (size_t)gridDim.x * 512;
        size_t i = (size_t)blockIdx.x * 512 + tid;
        for (; i + 3 * st < n8; i += 4 * st) {
            f32x4 v[4][2];
#pragma unroll
            for (int u = 0; u < 4; ++u) { v[u][0] = *(const f32x4*)(p + (i + u * st) * 8); v[u][1] = *(const f32x4*)(p + (i + u * st) * 8 + 4); }
#pragma unroll
            for (int u = 0; u < 4; ++u) *(u32x4*)(pb + (i + u * st) * 8) = pack8(v[u][0], v[u][1]);
        }
        for (; i < n8; i += st) { const f32x4 v0 = *(const f32x4*)(p + i * 8), v1 = *(const f32x4*)(p + i * 8 + 4); *(u32x4*)(pb + i * 8) = pack8(v0, v1); }
    }
    if (blockIdx.x == 4 && tid < 512) { const int ev = tid >> 8, gi = (tid >> 6) & 3, d = tid & 63;
        const float* src = a->in[gi == 0 ? I_DAQN : gi == 1 ? I_DAKN : gi == 2 ? I_NSQN : I_NSKN];
        ((float*)(a->ws + WS_GAINS))[tid] = src[ev * 64 + d]; }
    if (blockIdx.x < 4 && tid < 256) {
        const int m = blockIdx.x; const float* pe = a->in[I_CMPPE] + (size_t)m * 2048; const float* w1 = a->in[I_CMPW1] + (size_t)m * 2048 * 256;
        float s = 0.f;
        for (int k = 0; k < 2048; ++k) s += pe[k] * w1[(size_t)k * 256 + tid];
        ((float*)(a->ws + WS_BIAS1))[m * 256 + tid] = s;
    }
}

DI float row_load_ss(const float* row, int lane, f32x4 (&v)[4]) {
    float ss = 0.f;
#pragma unroll
    for (int j = 0; j < 4; ++j) { v[j] = *(const f32x4*)(row + 4 * lane + 256 * j); ss += (v[j][0] * v[j][0] + v[j][1] * v[j][1]) + (v[j][2] * v[j][2] + v[j][3] * v[j][3]); }
    return wave_sum(ss);
}
DI void row_store_bf16(bf16_t* row, int lane, const f32x4 (&v)[4]) {
#pragma unroll
    for (int j = 0; j < 4; ++j) { u32x2 o; o.x = pk2(v[j][0], v[j][1]); o.y = pk2(v[j][2], v[j][3]); *(u32x2*)(row + 4 * lane + 256 * j) = o; }
}
template <int MODE>
DI void phase_norm(const int WID, ArgsP a, LAS unsigned char* lds, int layer, const void* Hin, const bool hb) {
    const int tid = opaque_tid(WID), lane = tid & 63, wv = __builtin_amdgcn_readfirstlane(tid >> 6);
    LAS float* wt = (LAS float*)lds;
    LAS int* bcl = (LAS int*)(lds + MISC_OFF + MO_WCNT); LAS int* ent = (LAS int*)(lds + MISC_OFF + MO_ENT); LAS float* gat = (LAS float*)(lds + MISC_OFF + MO_GAT);
    LAS float* lgb = (LAS float*)(lds + MISC_OFF + MO_RED);
    bf16_t* XN = (bf16_t*)(a->ws + WS_XN);
    const float* gain = a->in[MODE == 2 ? I_N2G : I_N1G] + layer * 1024;
    constexpr int NQ = MODE == 0 ? 24 : (MODE == 2 ? 32 : 0);
    if (NQ > 0) {
        const float* w = (MODE == 0) ? a->in[I_EVWIN] + (size_t)(layer >> 1) * 1024 * EVIN + 2816 : a->in[I_ROUTW] + (size_t)layer * 1024 * 32;
        const int ldw = (MODE == 0) ? EVIN : 32;
        for (int i = tid; i < 256 * 32; i += 512) { const int q = i & 31, g = i >> 5;
            if (q < NQ) { f32x4 v; v[0] = w[(size_t)(4 * g) * ldw + q]; v[1] = w[(size_t)(4 * g + 1) * ldw + q]; v[2] = w[(size_t)(4 * g + 2) * ldw + q]; v[3] = w[(size_t)(4 * g + 3) * ldw + q];
                *(LAS f32x4*)(wt + q * 1024 + 4 * (g ^ q)) = v; } }
    }
    f32x4 gn[4];
#pragma unroll
    for (int j = 0; j < 4; ++j) gn[j] = *(const f32x4*)(gain + 4 * lane + 256 * j);
    const float rbias = (MODE == 2) ? a->in[I_ROUTB][layer * 32 + (lane & 31)] : 0.f;
    __syncthreads();
    for (int vb = blockIdx.x; vb < NTB; vb += gridDim.x) {
        if (MODE == 2) { if (tid < 32) bcl[tid] = 0; }
        const int t0 = vb * 128 + wv * 16;
        f32x4 na[4], nb[4];
#pragma unroll
        for (int j = 0; j < 4; ++j) { na[j] = ld_h4(Hin, hb, (size_t)t0 * 1024 + 4 * lane + 256 * j); nb[j] = ld_h4(Hin, hb, (size_t)(t0 + 1) * 1024 + 4 * lane + 256 * j); }
#pragma unroll 1
        for (int it = 0; it < 8; ++it) {
            const int ta = t0 + 2 * it;
            f32x4 va[4], vc[4];
#pragma unroll
            for (int j = 0; j < 4; ++j) { va[j] = na[j]; vc[j] = nb[j]; }
            if (it < 7) {
#pragma unroll
                for (int j = 0; j < 4; ++j) { na[j] = ld_h4(Hin, hb, (size_t)(ta + 2) * 1024 + 4 * lane + 256 * j); nb[j] = ld_h4(Hin, hb, (size_t)(ta + 3) * 1024 + 4 * lane + 256 * j); }
            }
            float sa = 0.f, sb = 0.f;
#pragma unroll
            for (int j = 0; j < 4; ++j) { sa += (va[j][0] * va[j][0] + va[j][1] * va[j][1]) + (va[j][2] * va[j][2] + va[j][3] * va[j][3]); sb += (vc[j][0] * vc[j][0] + vc[j][1] * vc[j][1]) + (vc[j][2] * vc[j][2] + vc[j][3] * vc[j][3]); }
#pragma unroll
            for (int o = 1; o < 64; o <<= 1) { sa += shxl(sa, o, lane); sb += shxl(sb, o, lane); }
            const float ra = rsqrtf(sa * (1.0f / 1024.0f) + EPS), rb2 = rsqrtf(sb * (1.0f / 1024.0f) + EPS);
#pragma unroll
            for (int j = 0; j < 4; ++j) { va[j] = va[j] * ra * gn[j]; vc[j] = vc[j] * rb2 * gn[j]; }
            if (MODE == 1) {
                unsigned char* X8 = (unsigned char*)XN;
#pragma unroll
                for (int j = 0; j < 4; ++j) { *(unsigned*)(X8 + (size_t)ta * 1024 + 4 * lane + 256 * j) = pk4_fp8(va[j][0], va[j][1], va[j][2], va[j][3]);
                    *(unsigned*)(X8 + (size_t)(ta + 1) * 1024 + 4 * lane + 256 * j) = pk4_fp8(vc[j][0], vc[j][1], vc[j][2], vc[j][3]); }
            } else { row_store_bf16(XN + (size_t)ta * 1024, lane, va); row_store_bf16(XN + (size_t)(ta + 1) * 1024, lane, vc); }
            if (NQ > 0) {
                float x[64];
#pragma unroll
                for (int q = 0; q < 32; ++q) {
                    if (q < NQ) { f32x4 a0 = {0.f, 0.f, 0.f, 0.f}, a1 = a0;
#pragma unroll
                        for (int j = 0; j < 4; ++j) { const f32x4 ww = *(const LAS f32x4*)(wt + q * 1024 + 4 * ((lane + 64 * j) ^ q)); a0 += va[j] * ww; a1 += vc[j] * ww; }
                        x[q] = (a0[0] + a0[1]) + (a0[2] + a0[3]); x[32 + q] = (a1[0] + a1[1]) + (a1[2] + a1[3]);
                        if ((q & 3) == 3) asm volatile("" ::: "memory");
                    } else { x[q] = 0.f; x[32 + q] = 0.f; }
                }
#define RS_STEP(N, BIT) _Pragma("unroll") for (int i = 0; i < (N); ++i) { const bool up = (lane & (BIT)) != 0; const float keep = up ? x[(N) + i] : x[i], send = up ? x[i] : x[(N) + i]; x[i] = keep + shxl(send, (BIT), lane); }
                RS_STEP(32, 32) RS_STEP(16, 16) RS_STEP(8, 8) RS_STEP(4, 4) RS_STEP(2, 2) RS_STEP(1, 1)
#undef RS_STEP
                const float val = x[0];
                if (MODE == 0) { if ((lane & 31) < 24) ((float*)(a->ws + WS_GATES))[(size_t)(ta + (lane >> 5)) * 24 + (lane & 31)] = sigm(val); }
                if (MODE == 2) {
                    const float myv = val + rbias; const int mye = lane & 31;
                    lgb[wv * 64 + lane] = myv;
                    asm volatile("s_waitcnt lgkmcnt(0)" ::: "memory");
                    int rank = 0;
#pragma unroll
                    for (int q4 = 0; q4 < 8; ++q4) { const f32x4 t4 = *(const LAS f32x4*)(lgb + wv * 64 + (lane & 32) + 4 * q4);
#pragma unroll
                        for (int e = 0; e < 4; ++e) { const int j = 4 * q4 + e; rank += ((t4[e] > myv) || (t4[e] == myv && j < mye)) ? 1 : 0; } }
                    const int eb = wv * 64 + (2 * it + (lane >> 5)) * 4;
                    if (rank < 4) { ent[eb + rank] = mye; gat[eb + rank] = myv; }
                    asm volatile("s_waitcnt lgkmcnt(0)" ::: "memory");
                    const f32x4 tv = *(const LAS f32x4*)(gat + eb);
                    const float sum = 1.0f + __expf(tv[1] - tv[0]) + __expf(tv[2] - tv[0]) + __expf(tv[3] - tv[0]);
                    asm volatile("s_waitcnt lgkmcnt(0)" ::: "memory");
                    if (rank < 4) gat[eb + rank] = __expf(myv - tv[0]) / sum;
                    asm volatile("s_waitcnt lgkmcnt(0)" ::: "memory");
                }
            }
        }
        if (MODE == 2) {
            __syncthreads();
            { const int e = ent[wv * 64 + lane];
              const int pos = __hip_atomic_fetch_add(bcl + e, 1, __ATOMIC_RELAXED, __HIP_MEMORY_SCOPE_WORKGROUP);
              const size_t idx = (size_t)(vb * 128 + wv * 16) * 4 + lane;
              ((int*)(a->ws + WS_TOPE))[idx] = e; ((int*)(a->ws + WS_POSB))[idx] = pos; ((float*)(a->ws + WS_GATEW))[idx] = gat[wv * 64 + lane]; }
            __syncthreads();
            if (tid < 32) ((int*)(a->ws + WS_BCNT))[((size_t)layer * NTB + vb) * 32 + tid] = bcl[tid];
            __syncthreads();
        }
    }
}
template <int MODE>
DI void phase_norm_mm(const int WID, ArgsP a, LAS unsigned char* lds, int layer, const void* Hin, const bool hb) {
    const int tid = opaque_tid(WID), lane = tid & 63, wv = __builtin_amdgcn_readfirstlane(tid >> 6);
    const int r = lane & 15, kg = lane >> 4;
    LAS float* lgb = (LAS float*)(lds + 131072);
    LAS float* gl = (LAS float*)(lds + MISC_OFF + MO_RED);
    LAS int* bcl = (LAS int*)(lds + MISC_OFF + MO_WCNT); LAS int* ent = (LAS int*)(lds + MISC_OFF + MO_ENT); LAS float* gat = (LAS float*)(lds + MISC_OFF + MO_GAT);
    bf16_t* XN = (bf16_t*)(a->ws + WS_XN);
    const float* gain = a->in[MODE == 2 ? I_N2G : I_N1G] + layer * 1024;
    constexpr int NQ = MODE == 0 ? 24 : 32;
    {
        const float* w = (MODE == 0) ? a->in[I_EVWIN] + (size_t)(layer >> 1) * 1024 * EVIN + 2816 : a->in[I_ROUTW] + (size_t)layer * 1024 * 32;
        const int ldw = (MODE == 0) ? EVIN : 32;
#pragma unroll 2
        for (int i = tid; i < 4096; i += 512) { const int q = i & 31, c = i >> 5; const int qq = q < NQ ? q : NQ - 1;
            const f32x4 g0 = *(const f32x4*)(gain + 8 * c), g1 = *(const f32x4*)(gain + 8 * c + 4);
            const float* wp = w + (size_t)(8 * c) * ldw + qq;
            f32x4 v0, v1;
#pragma unroll
            for (int e = 0; e < 4; ++e) { v0[e] = wp[(size_t)e * ldw]; v1[e] = wp[(size_t)(4 + e) * ldw]; }
            v0 = v0 * g0; v1 = v1 * g1;
            if (q >= NQ) { v0 = (f32x4){0.f, 0.f, 0.f, 0.f}; v1 = v0; }
            const u32x4 hi = pack8(v0, v1);
            const f32x4 r0 = {v0[0] - bflo(hi.x), v0[1] - bfhi(hi.x), v0[2] - bflo(hi.y), v0[3] - bfhi(hi.y)};
            const f32x4 r1 = {v1[0] - bflo(hi.z), v1[1] - bfhi(hi.z), v1[2] - bflo(hi.w), v1[3] - bfhi(hi.w)};
            const int off = q * 2048 + ((c ^ (q & 15)) << 4);
            *(LAS u32x4*)(lds + off) = hi; *(LAS u32x4*)(lds + 65536 + off) = pack8(r0, r1); }
        if (tid < 256) *(LAS f32x4*)(gl + 4 * tid) = *(const f32x4*)(gain + 4 * tid);
    }
    f32x4 rb0 = {0.f, 0.f, 0.f, 0.f}, rb1 = rb0;
    if (MODE == 2) { rb0 = *(const f32x4*)(a->in[I_ROUTB] + layer * 32 + 4 * kg); rb1 = *(const f32x4*)(a->in[I_ROUTB] + layer * 32 + 16 + 4 * kg); }
    __syncthreads();
    for (int vb = blockIdx.x; vb < NTB; vb += gridDim.x) {
        if (MODE == 2) { if (tid < 32) bcl[tid] = 0; }
        const int t0 = vb * 128 + wv * 16;
        u32x4 hp[16][2];
        if (hb) { const bf16_t* src = (const bf16_t*)Hin + (size_t)(t0 + r) * 1024 + 16 * kg;
#pragma unroll
            for (int S = 0; S < 16; ++S) { hp[S][0] = *(const u32x4*)(src + 64 * S); hp[S][1] = *(const u32x4*)(src + 64 * S + 8); }
        } else { const float* src = (const float*)Hin + (size_t)(t0 + r) * 1024 + 16 * kg;
#pragma unroll
            for (int S = 0; S < 16; ++S) { const f32x4 x0 = *(const f32x4*)(src + 64 * S), x1 = *(const f32x4*)(src + 64 * S + 4), x2 = *(const f32x4*)(src + 64 * S + 8), x3 = *(const f32x4*)(src + 64 * S + 12);
                hp[S][0] = pack8(x0, x1); hp[S][1] = pack8(x2, x3); }
        }
        f32x4 acc0 = {0.f, 0.f, 0.f, 0.f}, acc1 = acc0;
        float ss = 0.f;
        const int ob = r * 2048;
#pragma unroll
        for (int S = 0; S < 16; ++S) {
#pragma unroll
            for (int hf = 0; hf < 2; ++hf) {
                const u32x4 hv = hp[S][hf];
#pragma unroll
                for (int e = 0; e < 4; ++e) { const float lo = bflo(hv[e]), hi = bfhi(hv[e]); ss = fmaf(lo, lo, ss); ss = fmaf(hi, hi, ss); }
                const bf16x8 hf8 = __builtin_bit_cast(bf16x8, hv);
                const int off = ob + (S >> 1) * 256 + ((((S & 1) * 8 + 2 * kg + hf) ^ r) << 4);
                acc0 = __builtin_amdgcn_mfma_f32_16x16x32_bf16(*(const LAS bf16x8*)(lds + off), hf8, acc0, 0, 0, 0);
                acc0 = __builtin_amdgcn_mfma_f32_16x16x32_bf16(*(const LAS bf16x8*)(lds + 65536 + off), hf8, acc0, 0, 0, 0);
                acc1 = __builtin_amdgcn_mfma_f32_16x16x32_bf16(*(const LAS bf16x8*)(lds + 32768 + off), hf8, acc1, 0, 0, 0);
                acc1 = __builtin_amdgcn_mfma_f32_16x16x32_bf16(*(const LAS bf16x8*)(lds + 98304 + off), hf8, acc1, 0, 0, 0);
            }
            asm volatile("" ::: "memory");
        }
        ss += shxl(ss, 16, lane); ss += shxl(ss, 32, lane);
        const float rs = rsqrtf(ss * (1.0f / 1024.0f) + EPS);
        { bf16_t* dst = XN + (size_t)(t0 + r) * 1024 + 16 * kg;
#pragma unroll
          for (int S = 0; S < 16; ++S) {
#pragma unroll
              for (int hf = 0; hf < 2; ++hf) { u32x4 hv = hp[S][hf];
                  asm volatile("" : "+v"(hv));
                  const f32x4 g0 = *(const LAS f32x4*)(gl + 64 * S + 16 * kg + 8 * hf), g1 = *(const LAS f32x4*)(gl + 64 * S + 16 * kg + 8 * hf + 4);
                  const f32x4 x0 = (f32x4){bflo(hv.x), bfhi(hv.x), bflo(hv.y), bfhi(hv.y)} * rs * g0, x1 = (f32x4){bflo(hv.z), bfhi(hv.z), bflo(hv.w), bfhi(hv.w)} * rs * g1;
                  if (MODE == 2) *(u32x2*)((unsigned char*)XN + (size_t)(t0 + r) * 1024 + 64 * S + 16 * kg + 8 * hf) = pack8_fp8(x0, x1);
                  else *(u32x4*)(dst + 64 * S + 8 * hf) = pack8(x0, x1); }
              asm volatile("" ::: "memory"); } }
        const f32x4 v0 = acc0 * rs + rb0, v1 = acc1 * rs + rb1;
        if (MODE == 0) { float* G = (float*)(a->ws + WS_GATES) + (size_t)(t0 + r) * 24;
            *(f32x4*)(G + 4 * kg) = (f32x4){sigm(v0[0]), sigm(v0[1]), sigm(v0[2]), sigm(v0[3])};
            if (kg < 2) *(f32x4*)(G + 16 + 4 * kg) = (f32x4){sigm(v1[0]), sigm(v1[1]), sigm(v1[2]), sigm(v1[3])}; }
        if (MODE == 2) {
#pragma unroll 1
            for (int h = 0; h < 2; ++h) {
                if ((r >> 3) == h) { *(LAS f32x4*)(lgb + wv * 256 + (r & 7) * 32 + 4 * kg) = v0; *(LAS f32x4*)(lgb + wv * 256 + (r & 7) * 32 + 16 + 4 * kg) = v1; }
                asm volatile("s_waitcnt lgkmcnt(0)" ::: "memory");
#pragma unroll 1
                for (int it = 4 * h; it < 4 * h + 4; ++it) {
                    const int mye = lane & 31;
                    const LAS float* lrow = lgb + wv * 256 + ((2 * it + (lane >> 5)) & 7) * 32;
                    const float myv = lrow[mye];
                    int rank = 0;
#pragma unroll
                    for (int q4 = 0; q4 < 8; ++q4) { const f32x4 t4 = *(const LAS f32x4*)(lrow + 4 * q4);
#pragma unroll
                        for (int e = 0; e < 4; ++e) { const int j = 4 * q4 + e; rank += ((t4[e] > myv) || (t4[e] == myv && j < mye)) ? 1 : 0; } }
                    const int eb = wv * 64 + (2 * it + (lane >> 5)) * 4;
                    if (rank < 4) { ent[eb + rank] = mye; gat[eb + rank] = myv; }
                    asm volatile("s_waitcnt lgkmcnt(0)" ::: "memory");
                    const f32x4 tv = *(const LAS f32x4*)(gat + eb);
                    const float sum = 1.0f + __expf(tv[1] - tv[0]) + __expf(tv[2] - tv[0]) + __expf(tv[3] - tv[0]);
                    asm volatile("s_waitcnt lgkmcnt(0)" ::: "memory");
                    if (rank < 4) gat[eb + rank] = __expf(myv - tv[0]) / sum;
                    asm volatile("s_waitcnt lgkmcnt(0)" ::: "memory");
                }
            }
            __syncthreads();
            { const int e = ent[wv * 64 + lane];
              const int pos = __hip_atomic_fetch_add(bcl + e, 1, __ATOMIC_RELAXED, __HIP_MEMORY_SCOPE_WORKGROUP);
              const size_t idx = (size_t)(vb * 128 + wv * 16) * 4 + lane;
              ((int*)(a->ws + WS_TOPE))[idx] = e; ((int*)(a->ws + WS_POSB))[idx] = pos; ((float*)(a->ws + WS_GATEW))[idx] = gat[wv * 64 + lane]; }
            __syncthreads();
            if (tid < 32) ((int*)(a->ws + WS_BCNT))[((size_t)layer * NTB + vb) * 32 + tid] = bcl[tid];
            __syncthreads();
        }
    }
}
DI void moe_tables(const int WID, ArgsP a, LAS unsigned char* lds, int layer, int vb) {
    const int tid = opaque_tid(WID);
    LAS int* tot = (LAS int*)(lds + MISC_OFF + MO_TOT); LAS int* base = (LAS int*)(lds + MISC_OFF + MO_BASE); LAS int* ts = (LAS int*)(lds + MISC_OFF + MO_TS);
    LAS int* red = (LAS int*)(lds + MISC_OFF + MO_RED);
    const int* bc = (const int*)(a->ws + WS_BCNT) + (size_t)layer * NTB * 32;
    { const int e = tid & 31, part = tid >> 5; int st = 0, sp = 0;
      for (int blk = part; blk < NTB; blk += 16) { const int v = bc[blk * 32 + e]; st += v; sp += (blk < vb) ? v : 0; }
      red[part * 32 + e] = st; red[512 + part * 32 + e] = sp; }
    __syncthreads();
    if (tid < 32) { int st = 0, sp = 0;
#pragma unroll
        for (int p = 0; p < 16; ++p) { st += red[p * 32 + tid]; sp += red[512 + p * 32 + tid]; }
        tot[tid] = st; base[tid] = sp; }
    __syncthreads();
    if (tid == 0) { int acc = 0; for (int e = 0; e < 32; ++e) { ts[e] = acc; acc += (tot[e] + 255) >> 8; } ts[32] = acc; }
    __syncthreads();
}
DI void phase_moe_slots(const int WID, ArgsP a, LAS unsigned char* lds, int layer) {
    const int tid = opaque_tid(WID);
    LAS int* base = (LAS int*)(lds + MISC_OFF + MO_BASE); LAS int* ts = (LAS int*)(lds + MISC_OFF + MO_TS); LAS int* tot = (LAS int*)(lds + MISC_OFF + MO_TOT);
    int* TOK = (int*)(a->ws + WS_TOK);
    for (int vb = blockIdx.x; vb < NTB; vb += gridDim.x) {
        moe_tables(WID, a, lds, layer, vb);
        { const int t = vb * 128 + (tid >> 2);
          const int e = ((const int*)(a->ws + WS_TOPE))[(size_t)vb * 512 + tid], pos = ((const int*)(a->ws + WS_POSB))[(size_t)vb * 512 + tid];
          const int dest = ts[e] * 256 + base[e] + pos; ((int*)(a->ws + WS_DEST))[(size_t)vb * 512 + tid] = dest; TOK[dest] = t; }
        if (vb < 32) { const int e = vb, lo = ts[e] * 256 + tot[e], hi = ts[e + 1] * 256;
            for (int i = lo + tid; i < hi; i += 512) TOK[i] = 0; }
        __syncthreads();
    }
}
DI void phase_combine(const int WID, ArgsP a, bf16_t* H) {
    const int tid = opaque_tid(WID), lane = tid & 63, wv = tid >> 6;
    const unsigned char* YB = (const unsigned char*)(a->ws + WS_YB); unsigned char* XN8 = (unsigned char*)(a->ws + WS_XN);
    const int G8 = gridDim.x * 8;
    const int* DEST = (const int*)(a->ws + WS_DEST); const float* GW = (const float*)(a->ws + WS_GATEW);
    int t = blockIdx.x * 8 + wv;
    int dA = 0, dB = 0; float gA = 0.f, gB = 0.f;
    if (lane < 4) { if (t < T) { dA = DEST[(size_t)t * 4 + lane]; gA = GW[(size_t)t * 4 + lane]; } if (t + G8 < T) { dB = DEST[(size_t)(t + G8) * 4 + lane]; gB = GW[(size_t)(t + G8) * 4 + lane]; } }
    for (; t < T; t += 2 * G8) {
        const int tA = t, tB = (t + G8 < T) ? t + G8 : t;
        const int cdA = dA, cdB = (t + G8 < T) ? dB : dA; const float cgA = gA, cgB = (t + G8 < T) ? gB : gA;
        u32x4 hA[2], hB[2], yA[4], yB[4];
#pragma unroll
        for (int j = 0; j < 2; ++j) { hA[j] = *(const u32x4*)(H + (size_t)tA * 1024 + 16 * lane + 8 * j); hB[j] = *(const u32x4*)(H + (size_t)tB * 1024 + 16 * lane + 8 * j); }
#pragma unroll
        for (int k = 0; k < 4; ++k) yA[k] = *(const u32x4*)(YB + (size_t)__builtin_amdgcn_readlane(cdA, k) * 1024 + 16 * lane);
#pragma unroll
        for (int k = 0; k < 4; ++k) yB[k] = *(const u32x4*)(YB + (size_t)__builtin_amdgcn_readlane(cdB, k) * 1024 + 16 * lane);
        { const int tn = t + 2 * G8;
          if (lane < 4) { if (tn < T) { dA = DEST[(size_t)tn * 4 + lane]; gA = GW[(size_t)tn * 4 + lane]; } if (tn + G8 < T) { dB = DEST[(size_t)(tn + G8) * 4 + lane]; gB = GW[(size_t)(tn + G8) * 4 + lane]; } } }
        asm volatile("" ::: "memory");
#pragma unroll
        for (int rr = 0; rr < 2; ++rr) {
            const int tt = rr ? tB : tA; const float cg = rr ? cgB : cgA;
            f32x2 v[8];
#pragma unroll
            for (int j = 0; j < 2; ++j) { const u32x4 w = rr ? hB[j] : hA[j];
#pragma unroll
                for (int q = 0; q < 4; ++q) v[4 * j + q] = (f32x2){bflo(w[q]), bfhi(w[q])}; }
#pragma unroll
            for (int k = 0; k < 4; ++k) { const float g = __builtin_bit_cast(float, __builtin_amdgcn_readlane(__builtin_bit_cast(int, cg), k)) * (1.0f / Y_SC);
                const u32x4 w = rr ? yB[k] : yA[k];
#pragma unroll
                for (int q = 0; q < 4; ++q) { v[2 * q] += g * __builtin_amdgcn_cvt_pk_f32_fp8((int)w[q], false); v[2 * q + 1] += g * __builtin_amdgcn_cvt_pk_f32_fp8((int)w[q], true); } }
            float ss = 0.f;
            u32x4 o0, o1;
#pragma unroll
            for (int q = 0; q < 4; ++q) { o0[q] = pk2(v[q][0], v[q][1]); o1[q] = pk2(v[4 + q][0], v[4 + q][1]); }
#pragma unroll
            for (int q = 0; q < 8; ++q) ss += v[q][0] * v[q][0] + v[q][1] * v[q][1];
            *(u32x4*)(H + (size_t)tt * 1024 + 16 * lane) = o0; *(u32x4*)(H + (size_t)tt * 1024 + 16 * lane + 8) = o1;
#pragma unroll
            for (int o = 1; o < 64; o <<= 1) ss += shxl(ss, o, lane);
            const float rstd = rsqrtf(ss * (1.0f / 1024.0f) + EPS);
            u32x4 x8;
#pragma unroll
            for (int q = 0; q < 4; ++q) x8[q] = pk4_fp8(v[2 * q][0] * rstd, v[2 * q][1] * rstd, v[2 * q + 1][0] * rstd, v[2 * q + 1][1] * rstd);
            *(u32x4*)(XN8 + (size_t)tt * 1024 + 16 * lane) = x8;
        }
    }
}
DI void phase_cmp2(const int WID, ArgsP a, LAS unsigned char* lds, int ev) {
    const int tid = opaque_tid(WID), lane = tid & 63, wv = __builtin_amdgcn_readfirstlane(tid >> 6);
    const bf16_t* HID = (const bf16_t*)(a->ws + WS_HID); bf16_t* KCMP = (bf16_t*)(a->ws + WS_KCMP); bf16_t* VCMPT = (bf16_t*)(a->ws + WS_VCMPT);
    const float kg = a->in[I_NSKN][ev * 64 + lane];
    LAS float* wl = (LAS float*)lds;
    for (int i = tid; i < 2 * 256 * 64 / 4; i += 512) *(LAS f32x4*)(wl + 4 * i) = *(const f32x4*)(a->in[I_CMPW2] + (size_t)ev * 2 * 256 * 64 + 4 * i);
    __syncthreads();
    for (int gi = blockIdx.x * 8 + wv; gi < 2048; gi += gridDim.x * 8) {
        const int kv = gi >> 10, row0 = (gi & 1023) * 4;
        const bf16_t* hrow = HID + ((size_t)kv * 4096 + row0) * 256;
        const LAS float* w2 = wl + kv * 256 * 64 + lane;
        float s[4] = {0.f, 0.f, 0.f, 0.f};
#pragma unroll 2
        for (int k = 0; k < 256; k += 8) {
            u32x4 hw[4];
#pragma unroll
            for (int r = 0; r < 4; ++r) hw[r] = *(const u32x4*)(hrow + r * 256 + k);
            float wv8[8];
#pragma unroll
            for (int j = 0; j < 8; ++j) wv8[j] = w2[(k + j) * 64];
#pragma unroll
            for (int r = 0; r < 4; ++r)
                s[r] += bflo(hw[r].x) * wv8[0] + bfhi(hw[r].x) * wv8[1] + bflo(hw[r].y) * wv8[2] + bfhi(hw[r].y) * wv8[3] + bflo(hw[r].z) * wv8[4] + bfhi(hw[r].z) * wv8[5] + bflo(hw[r].w) * wv8[6] + bfhi(hw[r].w) * wv8[7];
        }
#pragma unroll
        for (int r = 0; r < 4; ++r) {
            const int row = row0 + r, bg = row >> 7, n = row & 127;
            float v = (n == 127) ? 0.f : s[r];
            if (kv == 0) { const float ss = wave_sum(v * v); const float o = v * rsqrtf(ss * (1.0f / 64.0f) + EPS) * kg;
                KCMP[((size_t)bg * 128 + n) * 64 + lane] = (bf16_t)(pk2(o, 0.f) & 0xffffu); }
            else VCMPT[((size_t)bg * 96 + lane) * 128 + vperm16(n)] = (bf16_t)(pk2(v, 0.f) & 0xffffu);
        }
    }
    for (int i = blockIdx.x * 512 + tid; i < 32 * 32 * 128; i += gridDim.x * 512) {
        const int n = i & 127, j = (i >> 7) & 31, bg = i >> 12;
        float o = 0.f;
        if (n < 127) { const int d = n - 4 * j; if (d >= 0 && d <= 2) o = 1.0f; else if (d == 3 || d == -1) o = 0.5f; }
        VCMPT[((size_t)bg * 96 + 64 + j) * 128 + vperm16(n)] = (bf16_t)(pk2(o, 0.f) & 0xffffu);
    }
}
DI void topk_one(const float* IMPH, unsigned* SELM, int t, int g) {
    const int b = t >> 11, s = t & 2047, cur = s >> 6;
    unsigned mask;
    if (cur < 16) mask = (2u << cur) - 1u;
    else {
        float sc[32];
#pragma unroll
        for (int j4 = 0; j4 < 8; ++j4) { f32x4 acc = {0.f, 0.f, 0.f, 0.f};
#pragma unroll
            for (int r = 0; r < 4; ++r) acc += *(const f32x4*)(IMPH + ((size_t)t * 8 + g * 4 + r) * 32 + 4 * j4);
#pragma unroll
            for (int q = 0; q < 4; ++q) sc[4 * j4 + q] = acc[q]; }
#pragma unroll
        for (int j = 0; j < 32; ++j) { const bool forced = (j == 0) || (j == cur) || (j == cur - 1); sc[j] = (j > cur) ? NEGF : (sc[j] + (forced ? 1e4f : 0.f)); }
        mask = 0u;
#pragma unroll
        for (int j = 0; j < 32; ++j) { int rank = 0;
#pragma unroll
            for (int k = 0; k < 32; ++k) rank += ((sc[k] > sc[j]) || (sc[k] == sc[j] && k < j)) ? 1 : 0;
            mask |= (rank < 16) ? (1u << j) : 0u; }
    }
    SELM[((size_t)(b * 2 + g)) * 2048 + s] = mask;
}
DI void phase_topk(const int WID, ArgsP a) {
    for (int i = blockIdx.x * 512 + opaque_tid(WID); i < T * 2; i += gridDim.x * 512) topk_one((const float*)(a->ws + WS_IMPH), (unsigned*)(a->ws + WS_SELM), i >> 1, i & 1);
}
DI void phase_cmp_topk(const int WID, ArgsP a, LAS unsigned char* lds) {
    const bf16_t* QN = (const bf16_t*)(a->ws + WS_QN);
    float* IMPH = (float*)(a->ws + WS_IMPH);
    for (int u = blockIdx.x; u < 256; u += gridDim.x) {
        const int qb = 7 - (u >> 5), bg = u & 31, b = bg >> 1, g = bg & 1, q0 = qb * 256; const size_t t0 = (size_t)b * 2048 + q0;
#pragma unroll 1
        for (int r = 0; r < 4; ++r) { const int hd = g * 4 + r;
            attn_unit<96, 3>(WID, lds, QN + t0 * 512 + hd * 64, 512, (const bf16_t*)(a->ws + WS_KCMP) + (size_t)bg * 128 * 64, 64,
                             (const bf16_t*)(a->ws + WS_VCMPT) + (size_t)bg * 96 * 128, 128, q0, 0.f, 0, nullptr,
                             (bf16_t*)(a->ws + WS_OC) + t0 * 512 + hd * 64, 512, IMPH + (t0 * 8 + hd) * 32); }
        asm volatile("s_waitcnt vmcnt(0)" ::: "memory");
        __syncthreads();
        { const int tid = opaque_tid(WID); if (tid < 256) topk_one(IMPH, (unsigned*)(a->ws + WS_SELM), (int)t0 + tid, g); }
        __syncthreads();
    }
}
DI void phase_mixprep(const int WID, ArgsP a, int layer) {
    const int tid = opaque_tid(WID), lane = tid & 63, wv = tid >> 6, ev = layer >> 1;
    const float* dl = a->in[I_DALAM] + ev * 256;
    const float s1 = wave_sum(dl[lane] * dl[64 + lane]), s2 = wave_sum(dl[128 + lane] * dl[192 + lane]);
    const float lam_init = 0.8f - 0.6f * expf(-0.3f * (float)layer);
    const float lam = expf(s1) - expf(s2) + lam_init;
    const float* og = a->in[I_DAOUTG] + ev * 128;
    const bf16_t* OD = (const bf16_t*)(a->ws + WS_OD); const bf16_t* OC = (const bf16_t*)(a->ws + WS_OC); const bf16_t* OS = (const bf16_t*)(a->ws + WS_OS); const bf16_t* OW = (const bf16_t*)(a->ws + WS_OW);
    const float* GT = (const float*)(a->ws + WS_GATES); unsigned char* AMIX = (unsigned char*)(a->ws + WS_AMIX);
    const int h = lane >> 4, dv = (lane & 15) * 8;
    f32x4 g0 = *(const f32x4*)(og + dv), g1 = *(const f32x4*)(og + dv + 4);
    for (int t = blockIdx.x * 8 + wv; t < T; t += gridDim.x * 8) {
        { const u32x4 w1 = *(const u32x4*)(OD + (size_t)t * 1024 + h * 128 + dv), w2 = *(const u32x4*)(OD + (size_t)t * 1024 + (4 + h) * 128 + dv);
          f32x4 d0, d1;
          d0[0] = bflo(w1.x) - lam * bflo(w2.x); d0[1] = bfhi(w1.x) - lam * bfhi(w2.x); d0[2] = bflo(w1.y) - lam * bflo(w2.y); d0[3] = bfhi(w1.y) - lam * bfhi(w2.y);
          d1[0] = bflo(w1.z) - lam * bflo(w2.z); d1[1] = bfhi(w1.z) - lam * bfhi(w2.z); d1[2] = bflo(w1.w) - lam * bflo(w2.w); d1[3] = bfhi(w1.w) - lam * bfhi(w2.w);
          float ss = (d0[0] * d0[0] + d0[1] * d0[1]) + (d0[2] * d0[2] + d0[3] * d0[3]) + (d1[0] * d1[0] + d1[1] * d1[1]) + (d1[2] * d1[2] + d1[3] * d1[3]);
          ss += shx(ss, 1); ss += shx(ss, 2); ss += shx(ss, 4); ss += shx(ss, 8);
          const float rs = rsqrtf(ss * (1.0f / 128.0f) + EPS) * (1.0f - lam_init);
          *(u32x2*)(AMIX + (size_t)t * 1024 + h * 128 + dv) = pack8_fp8(d0 * (rs * A_SC) * g0, d1 * (rs * A_SC) * g1); }
    }
}
DI void phase_scan(const int WID, ArgsP a) {
    const bf16_t* UT = (const bf16_t*)(a->ws + WS_UT); bf16_t* VS = (bf16_t*)(a->ws + WS_VS);
    for (int i = blockIdx.x * 512 + opaque_tid(WID); i < 64 * 512 * 32; i += gridDim.x * 512) {
        const int d8 = i & 31, f = (i >> 5) & 511, bh = i >> 14, h = bh & 3;
        const float dec = exp2f(256.0f * ret_lg2(h));
        f32x4 S0 = {0.f, 0.f, 0.f, 0.f}, S1 = S0;
        u32x4 un = *(const u32x4*)(UT + ((size_t)bh * 8) * 131072 + (size_t)f * 256 + 8 * d8);
#pragma unroll 1
        for (int n = 0; n < 8; ++n) {
            const size_t z = (size_t)bh * 8 + n;
            const u32x4 u = un;
            if (n < 7) un = *(const u32x4*)(UT + (z + 1) * 131072 + (size_t)f * 256 + 8 * d8);
            *(u32x4*)(VS + (z * 512 + f) * 512 + 256 + 8 * d8) = pack8(S0, S1);
            S0[0] = (S0[0] + bflo(u.x)) * dec; S0[1] = (S0[1] + bfhi(u.x)) * dec; S0[2] = (S0[2] + bflo(u.y)) * dec; S0[3] = (S0[3] + bfhi(u.y)) * dec;
            S1[0] = (S1[0] + bflo(u.z)) * dec; S1[1] = (S1[1] + bfhi(u.z)) * dec; S1[2] = (S1[2] + bflo(u.w)) * dec; S1[3] = (S1[3] + bfhi(u.w)) * dec;
        }
    }
}
DI void phase_normgate(const int WID, ArgsP a, int od) {
    const int tid = opaque_tid(WID), lane = tid & 63, wv = tid >> 6;
    const bf16_t* Y = (const bf16_t*)(a->ws + WS_Y); const bf16_t* GG = (const bf16_t*)(a->ws + WS_GG); unsigned char* YG = (unsigned char*)(a->ws + WS_YG);
    const float* og = a->in[I_RETG] + od * 512;
    const f32x4 g0 = *(const f32x4*)(og + 8 * lane), g1 = *(const f32x4*)(og + 8 * lane + 4);
    const int G8 = gridDim.x * 8;
    for (int t = blockIdx.x * 8 + wv; t < T; t += 2 * G8) {
        const int tB = (t + G8 < T) ? t + G8 : t;
        u32x4 yw[2][4], gw[2][4];
#pragma unroll
        for (int rr = 0; rr < 2; ++rr)
#pragma unroll
            for (int h = 0; h < 4; ++h) { const size_t o = (size_t)(rr ? tB : t) * 2048 + h * 512 + 8 * lane; yw[rr][h] = *(const u32x4*)(Y + o); gw[rr][h] = *(const u32x4*)(GG + o); }
        asm volatile("" ::: "memory");
#pragma unroll
        for (int rr = 0; rr < 2; ++rr)
#pragma unroll
            for (int h = 0; h < 4; ++h) {
                const size_t o = (size_t)(rr ? tB : t) * 2048 + h * 512 + 8 * lane;
                const u32x4 yv = yw[rr][h], gv = gw[rr][h];
                f32x4 y0 = {bflo(yv.x), bfhi(yv.x), bflo(yv.y), bfhi(yv.y)}, y1 = {bflo(yv.z), bfhi(yv.z), bflo(yv.w), bfhi(yv.w)};
                const f32x4 q0 = {bflo(gv.x), bfhi(gv.x), bflo(gv.y), bfhi(gv.y)}, q1 = {bflo(gv.z), bfhi(gv.z), bflo(gv.w), bfhi(gv.w)};
                float ss = (y0[0] * y0[0] + y0[1] * y0[1]) + (y0[2] * y0[2] + y0[3] * y0[3]) + (y1[0] * y1[0] + y1[1] * y1[1]) + (y1[2] * y1[2] + y1[3] * y1[3]);
#pragma unroll
                for (int o2 = 1; o2 < 64; o2 <<= 1) ss += shxl(ss, o2, lane);
                const float rs = rsqrtf(ss * (1.0f / 512.0f) + EPS);
                *(u32x2*)(YG + o) = pack8_fp8(y0 * (rs * A_SC) * g0 * q0, y1 * (rs * A_SC) * g1 * q1);
            }
    }
}
DI int snake_unit(int rnd, int G, int c) { return (rnd & 1) ? rnd * G + (G - 1 - c) : rnd * G + c; }
DI float absmax64(const float* g, int lane) { float m = fabsf(g[lane]);
#pragma unroll
    for (int o = 1; o < 64; o <<= 1) m = fmaxf(m, shx(m, o));
    return m; }
constexpr int CW_AQ = 8192;
template <int MODE>
DI void phase_attn(const int WID, ArgsP a, LAS unsigned char* lds, int ev) {
    const int tid = opaque_tid(WID), lane = tid & 63;
    const bf16_t* QD = (const bf16_t*)(a->ws + WS_QD); const bf16_t* KD = (const bf16_t*)(a->ws + WS_KD); const bf16_t* QN = (const bf16_t*)(a->ws + WS_QN);
    LAS int* ord = (LAS int*)(lds + MISC_OFF + MO_ENT); LAS int* cst = (LAS int*)(lds + MISC_OFF + MO_GAT); volatile LAS int* cur = (volatile LAS int*)(lds + MISC_OFF + MO_TOT);
    float sb2 = 0.f;
    if (MODE != 3) { const float gq = absmax64(a->in[MODE == 0 ? I_DAQN : I_NSQN] + ev * 64, lane), gk = absmax64(a->in[MODE == 0 ? I_DAKN : I_NSKN] + ev * 64, lane);
        sb2 = 16.0f * gq * gk + 28.0f; }
    if (tid < 64) { const int qb = tid >> 3, hd = tid & 7, q0 = qb * 256; int lo = 0, hi = 4 * qb + 4;
        if (MODE == 3) { lo = 0; hi = 2; }
        else { const float slope = (MODE == 0) ? exp2f(-2.0f * (float)((hd & 3) + 1)) : exp2f(-(float)(hd + 1)); const int dcut = (int)fminf(sb2 / slope + 1.0f, 100000.0f);
            const int kmin = q0 - dcut; lo = kmin > 0 ? (kmin >> 6) : 0;
            if (MODE == 2) { const int lk = q0 - 511; const int lw = lk > 0 ? (lk >> 6) : 0; lo = lw > lo ? lw : lo; } }
        cst[tid] = hi - lo; }
    __syncthreads();
    if (tid < 64) { const int mine = cst[tid]; int rank = 0;
        for (int j = 0; j < 64; ++j) { const int o = cst[j]; rank += (o > mine || (o == mine && j < tid)) ? 1 : 0; }
        ord[rank] = tid; }
    __syncthreads();
    unsigned* ctr = (unsigned*)(a->ws + WS_CTL) + CW_AQ + 64 * 8 * (ev * 4 + MODE);
    const int x0 = (int)(xb_xcc_id() & 7u);
    volatile LAS int* stl = (volatile LAS int*)(lds + MISC_OFF + MO_BASE);
    bool own = true; int nst = 0;
    for (;;) {
        if (tid < 64) {
            int uu_ = -1;
            if (own) { int v = 128; if (lane == 0) v = (int)__hip_atomic_fetch_add(ctr + 64 * x0, 1u, __ATOMIC_RELAXED, __HIP_MEMORY_SCOPE_AGENT);
                v = __builtin_amdgcn_readfirstlane(v); if (v < 128) uu_ = x0 * 128 + v; else own = false; }
            if (!own && uu_ < 0) {
                if (nst == 0) { int v = 128; const int xq_ = (x0 + lane) & 7;
                    if (lane >= 1 && lane < 8) v = (int)__hip_atomic_fetch_add(ctr + 64 * xq_, 1u, __ATOMIC_RELAXED, __HIP_MEMORY_SCOPE_AGENT);
                    const unsigned long long got = __ballot(v < 128); nst = __popcll(got);
                    if (v < 128) stl[__popcll(got & ((1ull << lane) - 1ull))] = xq_ * 128 + v;
                    asm volatile("s_waitcnt lgkmcnt(0)" ::: "memory"); }
                if (nst > 0) { --nst; uu_ = stl[nst]; }
            }
            if (lane == 0) *cur = uu_;
        }
        __syncthreads();
        const int uu = *cur; if (uu < 0) break;
        const int xq = uu >> 7, v = uu & 127, combo = ord[v >> 1], jb = v & 1, qb = combo >> 3, hd = combo & 7, q0 = qb * 256;
        const int b = (MODE == 0) ? (((xq - 2 * (hd & 3)) & 7) + 8 * jb) : (((xq - 4 * (hd >> 2)) & 7) + 8 * jb);
        const size_t t0 = (size_t)b * 2048 + q0;
        if (MODE == 0) {
            const float slope = exp2f(-2.0f * (float)((hd & 3) + 1)); const int dcut = (int)fminf(sb2 / slope + 1.0f, 100000.0f);
            attn_unit<128, 0>(WID, lds, QD + t0 * 512 + hd * 64, 512, KD + (size_t)b * 2048 * 512 + hd * 64, 512,
                              (const bf16_t*)(a->ws + WS_VAT) + (size_t)(b * 4 + (hd & 3)) * 128 * 2048, 2048, q0, slope, dcut, nullptr,
                              (bf16_t*)(a->ws + WS_OD) + t0 * 1024 + hd * 128, 1024, nullptr);
        } else if (MODE == 1 || MODE == 2) {
            const int g = hd >> 2; const float slope = exp2f(-(float)(hd + 1)); const int dcut = (int)fminf(sb2 / slope + 1.0f, 100000.0f);
            const bf16_t* Kb = (const bf16_t*)(a->ws + (MODE == 1 ? WS_KSB : WS_KWB)) + (size_t)(b * 2 + g) * 2048 * 64;
            const bf16_t* Vb = (const bf16_t*)(a->ws + (MODE == 1 ? WS_VST : WS_VWT)) + (size_t)(b * 2 + g) * 64 * 2048;
            attn_unit<64, MODE>(WID, lds, QN + t0 * 512 + hd * 64, 512, Kb, 64, Vb, 2048, q0, slope, dcut,
                                (const unsigned*)(a->ws + WS_SELM) + (size_t)(b * 2 + g) * 2048 + q0,
                                (bf16_t*)(a->ws + (MODE == 1 ? WS_OS : WS_OW)) + t0 * 512 + hd * 64, 512, nullptr);
        } else {
            const int g = hd >> 2;
            attn_unit<96, 3>(WID, lds, QN + t0 * 512 + hd * 64, 512, (const bf16_t*)(a->ws + WS_KCMP) + (size_t)(b * 2 + g) * 128 * 64, 64,
                             (const bf16_t*)(a->ws + WS_VCMPT) + (size_t)(b * 2 + g) * 96 * 128, 128, q0, 0.f, 0, nullptr,
                             (bf16_t*)(a->ws + WS_OC) + t0 * 512 + hd * 64, 512, (float*)(a->ws + WS_IMPH) + (t0 * 8 + hd) * 32);
        }
    }
}

DI void phase_diff(const int WID, ArgsP a, LAS unsigned char* lds, int layer) {
    const int tid = opaque_tid(WID), lane = tid & 63, ev = layer >> 1;
    LAS int* ord = (LAS int*)(lds + MISC_OFF + MO_ENT); LAS int* cst = (LAS int*)(lds + MISC_OFF + MO_GAT); volatile LAS int* cur = (volatile LAS int*)(lds + MISC_OFF + MO_TOT);
    const float gq = absmax64(a->in[I_DAQN] + ev * 64, lane), gk = absmax64(a->in[I_DAKN] + ev * 64, lane);
    const float sb2 = 16.0f * gq * gk + 28.0f;
    const float* dl = a->in[I_DALAM] + ev * 256;
    const float s1 = wave_sum(dl[lane] * dl[64 + lane]), s2 = wave_sum(dl[128 + lane] * dl[192 + lane]);
    const float lam_init = 0.8f - 0.6f * expf(-0.3f * (float)layer);
    const float lam = expf(s1) - expf(s2) + lam_init;
    if (tid < 32) { const int qb = tid >> 2, h = tid & 3, q0 = qb * 256; const float slope = exp2f(-2.0f * (float)(h + 1)); const int dcut = (int)fminf(sb2 / slope + 1.0f, 100000.0f);
        const int kmin = q0 - dcut; const int lo = kmin > 0 ? (kmin >> 6) : 0; cst[tid] = 4 * qb + 4 - lo; }
    __syncthreads();
    if (tid < 32) { const int mine = cst[tid]; int rank = 0;
        for (int j = 0; j < 32; ++j) { const int o = cst[j]; rank += (o > mine || (o == mine && j < tid)) ? 1 : 0; }
        ord[rank] = tid; }
    __syncthreads();
    unsigned* ctr = (unsigned*)(a->ws + WS_CTL) + CW_AQ + 64 * 8 * (ev * 4 + 0);
    const bf16_t* QD = (const bf16_t*)(a->ws + WS_QD); const bf16_t* KD = (const bf16_t*)(a->ws + WS_KD);
    for (;;) {
        if (tid == 0) *cur = (int)__hip_atomic_fetch_add(ctr, 1u, __ATOMIC_RELAXED, __HIP_MEMORY_SCOPE_AGENT);
        __syncthreads();
        const int u = *cur; if (u >= 512) break;
        const int combo = ord[u >> 4], b = u & 15, qb = combo >> 2, h = combo & 3, q0 = qb * 256; const size_t t0 = (size_t)b * 2048 + q0;
        const float slope = exp2f(-2.0f * (float)(h + 1)); const int dcut = (int)fminf(sb2 / slope + 1.0f, 100000.0f);
        diff_unit(WID, lds, QD + t0 * 512 + h * 64, QD + t0 * 512 + (4 + h) * 64, KD + (size_t)b * 2048 * 512 + h * 64, KD + (size_t)b * 2048 * 512 + (4 + h) * 64,
                  (const bf16_t*)(a->ws + WS_VAT) + (size_t)(b * 4 + h) * 128 * 2048, q0, slope, dcut, lam, 1.0f - lam_init, a->in[I_DAOUTG] + ev * 128,
                  (unsigned char*)(a->ws + WS_AMIX) + t0 * 1024 + h * 128);
    }
}
DI void phase_nsa(const int WID, ArgsP a, LAS unsigned char* lds, int ev) {
    const int tid = opaque_tid(WID), lane = tid & 63, w = __builtin_amdgcn_readfirstlane(tid >> 6), r = lane & 31, hh = lane >> 5, hr = w >> 1, qh = w & 1;
    volatile LAS int* cur = (volatile LAS int*)(lds + MISC_OFF + MO_TOT);
    LAS float* impl = (LAS float*)(lds + 98304);
    LAS float* scs = (LAS float*)(lds + 131072);
    LAS unsigned* selml = (LAS unsigned*)(lds + MISC_OFF + MO_RED);
    const float gq = absmax64(a->in[I_NSQN] + ev * 64, lane), gk = absmax64(a->in[I_NSKN] + ev * 64, lane);
    const float sb2 = 16.0f * gq * gk + 28.0f;
    unsigned* ctr = (unsigned*)(a->ws + WS_CTL) + CW_AQ + 64 * 8 * (ev * 4 + 1);
    const bf16_t* QN = (const bf16_t*)(a->ws + WS_QN);
    for (;;) {
        if (tid == 0) *cur = (int)__hip_atomic_fetch_add(ctr, 1u, __ATOMIC_RELAXED, __HIP_MEMORY_SCOPE_AGENT);
        __syncthreads();
        const int u = *cur; if (u >= 1024) break;
        const int qb = 31 - (u >> 5), bg = u & 31, b = bg >> 1, g = bg & 1, q0 = qb * 64; const size_t t0 = (size_t)b * 2048 + q0;
        bf16x8 qf[4];
        { const bf16_t* Qw = QN + (t0 + 32 * qh + r) * 512 + (4 * g + hr) * 64;
#pragma unroll
          for (int ks = 0; ks < 4; ++ks) qf[ks] = *(const bf16x8*)(Qw + 16 * ks + 8 * hh); }
        const float* gp = (const float*)(a->ws + WS_GATES) + (t0 + 32 * qh + r) * 24 + (4 * g + hr) * 3;
        const float gate_c = gp[0], gate_s = gp[1], gate_w = gp[2];
        f32x16 OB[2];
#pragma unroll
        for (int rb = 0; rb < 2; ++rb)
#pragma unroll
            for (int i = 0; i < 16; ++i) OB[rb][i] = 0.f;
        nsa_unit<96, 3>(WID, lds, qf, (const bf16_t*)(a->ws + WS_KCMP) + (size_t)bg * 128 * 64, 64, (const bf16_t*)(a->ws + WS_VCMPT) + (size_t)bg * 96 * 128, 128, q0, g, sb2,
                        nullptr, OB, gate_c, impl);
        asm volatile("s_waitcnt lgkmcnt(0)" ::: "memory");
        __syncthreads();
        { const int qq = tid >> 3, pq = tid & 7;
          if (qb < 16) { if (pq == 0) selml[qq] = (2u << qb) - 1u; }
          else { f32x4 acc = {0.f, 0.f, 0.f, 0.f};
#pragma unroll
              for (int h2 = 0; h2 < 4; ++h2) acc += *(const LAS f32x4*)(impl + (h2 * 64 + qq) * 32 + 4 * pq);
#pragma unroll
              for (int e = 0; e < 4; ++e) { const int j = 4 * pq + e; const bool forced = (j == 0) || (j == qb) || (j == qb - 1); acc[e] = (j > qb) ? NEGF : (acc[e] + (forced ? 1e4f : 0.f)); }
              *(LAS f32x4*)(scs + qq * 32 + 4 * pq) = acc; }
          asm volatile("s_waitcnt lgkmcnt(0)" ::: "memory");
          __syncthreads();
          if (qb >= 16) { const f32x4 my = *(const LAS f32x4*)(scs + qq * 32 + 4 * pq); int rk[4] = {0, 0, 0, 0};
#pragma unroll
              for (int k4 = 0; k4 < 8; ++k4) { const f32x4 o4 = *(const LAS f32x4*)(scs + qq * 32 + 4 * k4);
#pragma unroll
                  for (int kk = 0; kk < 4; ++kk) { const int k = 4 * k4 + kk;
#pragma unroll
                      for (int e = 0; e < 4; ++e) { const int j = 4 * pq + e; rk[e] += ((o4[kk] > my[e]) || (o4[kk] == my[e] && k < j)) ? 1 : 0; } } }
              unsigned bits = 0u;
#pragma unroll
              for (int e = 0; e < 4; ++e) bits |= (rk[e] < 16) ? (1u << (4 * pq + e)) : 0u;
              bits |= shxu(bits, 1); bits |= shxu(bits, 2); bits |= shxu(bits, 4);
              if (pq == 0) selml[qq] = bits; }
          asm volatile("s_waitcnt lgkmcnt(0)" ::: "memory");
          __syncthreads(); }
        nsa_unit<64, 1>(WID, lds, qf, (const bf16_t*)(a->ws + WS_KSB) + (size_t)bg * 2048 * 64, 64, (const bf16_t*)(a->ws + WS_VST) + (size_t)bg * 64 * 2048, 2048, q0, g, sb2,
                        selml, OB, gate_s, nullptr);
        { const bf16_t* ow = (const bf16_t*)(a->ws + WS_OW) + (t0 + 32 * qh + r) * 512 + (4 * g + hr) * 64;
          unsigned char* am = (unsigned char*)(a->ws + WS_AMIX) + (t0 + 32 * qh + r) * 1024 + 512 + (4 * g + hr) * 64;
#pragma unroll
          for (int rb = 0; rb < 2; ++rb)
#pragma unroll
              for (int g4 = 0; g4 < 4; ++g4) { const int dv = 32 * rb + 8 * g4 + 4 * hh; const u32x2 wv = *(const u32x2*)(ow + dv);
                  const float o0 = OB[rb][4 * g4] + gate_w * bflo(wv.x), o1 = OB[rb][4 * g4 + 1] + gate_w * bfhi(wv.x), o2 = OB[rb][4 * g4 + 2] + gate_w * bflo(wv.y), o3 = OB[rb][4 * g4 + 3] + gate_w * bfhi(wv.y);
                  *(unsigned*)(am + dv) = pk4_fp8(o0 * A_SC, o1 * A_SC, o2 * A_SC, o3 * A_SC); } }
    }
}

constexpr int PPL = 15;
constexpr int NPHASE = 1 + DEPTH * PPL;
__global__ void __launch_bounds__(512, 2) mk_fwd(Args a_unused) {
    ArgsP a = opaque_args();
    extern __shared__ __attribute__((aligned(16))) unsigned char lds_raw[];
    LAS unsigned char* lds = (LAS unsigned char*)lds_raw;
    const int tid = threadIdx.x, G = gridDim.x, c = blockIdx.x;
    const int WID = __builtin_amdgcn_readfirstlane(tid >> 6);
    volatile LAS unsigned* misc = (volatile LAS unsigned*)(lds + MISC_OFF);
    if (tid < 4) misc[tid] = 0u;
    __syncthreads();
    unsigned* ctl = (unsigned*)(a->ws + WS_CTL);
    XcdBarrier bar; bar.bar = ctl + CW_BAR; bar.x = 0; bar.st = misc;
    const int ph_lo = a->ph_lo, ph_hi = a->ph_hi;
    const bool multi = (ph_hi - ph_lo) > 1;
    if (multi) bar = xcd_barrier_post(WID, ctl + CW_BAR, misc);
    bool first = true;
#define PHASE_BEGIN(k, id) if ((DBG_ONLY < 0 || DBG_ONLY == (id)) && (k) >= ph_lo && (k) < ph_hi && (k) <= DBG_LAST_PHASE) { if (!first) { xcd_barrier(WID, bar); if (PROBE_MASK >> 31) xcd_barrier(WID, bar); } first = false; \
        ArgsP a = opaque_args(); unsigned char* ws = a->ws; bf16_t* XN = (bf16_t*)(ws + WS_XN); bf16_t* H = (bf16_t*)(ws + WS_HB); const bool hb = layer != 0; const void* Hin = hb ? (const void*)H : (const void*)a->in[I_X]; \
        const LAS int* ts = (const LAS int*)(lds + MISC_OFF + MO_TS); (void)XN; (void)H; (void)Hin; (void)ts; (void)hb; \
        const bool probe_ = ((PROBE_MASK >> (id)) & 1u) != 0u; const unsigned long long pt0_ = probe_ ? __builtin_amdgcn_s_memrealtime() : 0ull;
#define PHASE_END if (probe_) { const unsigned long long pt1_ = __builtin_amdgcn_s_memrealtime(), pd_ = pt1_ - pt0_; while (__builtin_amdgcn_s_memrealtime() - pt1_ < pd_) __builtin_amdgcn_s_sleep(8); } }
    { const int layer = 0; PHASE_BEGIN(0, 0) phase_prologue(WID, a, lds); PHASE_END }
#pragma unroll 1
    for (int layer = 0; layer < DEPTH; ++layer) {
        const int pb = 1 + layer * PPL; const bool even = (layer & 1) == 0; const int ev = layer >> 1, od = layer >> 1;
        if (even) {
            PHASE_BEGIN(pb + 0, 1) phase_norm_mm<0>(WID, a, lds, layer, Hin, hb); PHASE_END
            PHASE_BEGIN(pb + 1, 2) {
                { ProbPlain P{XN, (const bf16_t*)(ws + WS_EVNAT) + (size_t)ev * 2048 * 1024, 1024, 1024, 1024}; pg8::Sched S; S.init(T / 256, 8, G, c);
                  EpiEvNat E{ws, (const float*)(ws + WS_GAINS) + ev * 256};
                  pg8::gemm_phase(WID, lds, P, S, E); }
                { ProbPlain P{(const bf16_t*)(ws + WS_EVSW) + (size_t)ev * 768 * 1024, XN, 1024, 1024, 1024}; pg8::Sched S; S.init(3, T / 256, G, c);
                  EpiEvSw E{ws};
                  pg8::gemm_phase(WID, lds, P, S, E); }
            } PHASE_END
            PHASE_BEGIN(pb + 2, 3) {
                { ProbCmp1 P{(const bf16_t*)(ws + WS_KCB), (const bf16_t*)(ws + WS_VCB), (const bf16_t*)(ws + WS_CMP1) + (size_t)ev * 2 * 256 * 2048, 1024, 2048, 2048}; pg8::Sched S; S.init(32, 1, G, c);
                  EpiCmp1 E{(bf16_t*)(ws + WS_HID), (const float*)(ws + WS_BIAS1) + ev * 512};
                  pg8::gemm_phase(WID, lds, P, S, E); }
                phase_diff(WID, a, lds, layer);
                phase_attn<2>(WID, a, lds, ev);
            } PHASE_END
            PHASE_BEGIN(pb + 3, 4) phase_cmp2(WID, a, lds, ev); PHASE_END
            PHASE_BEGIN(pb + 4, 5) phase_nsa(WID, a, lds, ev); PHASE_END
            PHASE_BEGIN(pb + 8, 9) {
                ProbPlain8 P{(const unsigned char*)(ws + WS_AMIX), (const unsigned char*)(ws + WS_EVOUT) + (size_t)ev * 1024 * 1024, 512, 512, 512}; pg8::Sched S; S.init(T / 256, 4, G, c);
                EpiResid E{Hin, H, hb, 1.0f / (A_SC * 64.0f)}; pg8::gemm_phase(WID, lds, P, S, E);
            } PHASE_END
        } else {
            PHASE_BEGIN(pb + 0, 11) phase_norm<1>(WID, a, lds, layer, Hin, hb); PHASE_END
            PHASE_BEGIN(pb + 1, 12) {
                { ProbPlain8 P{(const unsigned char*)XN, (const unsigned char*)(ws + WS_ODNAT) + (size_t)od * 4096 * 1024, 512, 512, 512}; pg8::Sched S; S.init(T / 256, 16, G, c);
                  EpiOdNat E{ws}; pg8::gemm_phase(WID, lds, P, S, E); }
                { ProbPlain8 P{(const unsigned char*)(ws + WS_ODSW) + (size_t)od * 2048 * 1024, (const unsigned char*)XN, 512, 512, 512}; pg8::Sched S; S.init(8, T / 256, G, c);
                  EpiOdSw E{ws}; pg8::gemm_phase(WID, lds, P, S, E); }
            } PHASE_END
            PHASE_BEGIN(pb + 2, 13) {
                { ProbUT P{(const bf16_t*)(ws + WS_VS), (const bf16_t*)(ws + WS_KT), 512, 256, 256}; SchedSeq S; S.init(G, c);
                  EpiUTScan E{(bf16_t*)(ws + WS_VS)}; pg8::gemm_phase(WID, lds, P, S, E); }
                { ProbAtt P{(const bf16_t*)(ws + WS_AQ), (const bf16_t*)(ws + WS_KP), 2048, 1024, 256}; pg8::Sched S; const int nb = G / 2 > 0 ? G / 2 : 1;
                  if (c >= nb || G < 2) S.init(512, 1, G < 2 ? 1 : G - nb, G < 2 ? 0 : c - nb); else S.init(0, 1, 1, 0);
                  EpiAtt E{(bf16_t*)(ws + WS_AQ)}; pg8::gemm_phase(WID, lds, P, S, E); }
            } PHASE_END
            PHASE_BEGIN(pb + 4, 15) {
                ProbY P{(const bf16_t*)(ws + WS_AQ), (const bf16_t*)(ws + WS_VS), 2048, 512, 512}; pg8::Sched S; S.init(512, 2, G, c);
                EpiY E{(bf16_t*)(ws + WS_Y)}; pg8::gemm_phase(WID, lds, P, S, E);
            } PHASE_END
            PHASE_BEGIN(pb + 5, 16) phase_normgate(WID, a, od); PHASE_END
            PHASE_BEGIN(pb + 8, 19) {
                ProbPlain8 P{(const unsigned char*)(ws + WS_YG), (const unsigned char*)(ws + WS_ODOUT) + (size_t)od * 1024 * 2048, 1024, 1024, 1024}; pg8::Sched S; S.init(T / 256, 4, G, c);
                EpiResid E{Hin, H, hb, 1.0f / (A_SC * 128.0f)}; pg8::gemm_phase(WID, lds, P, S, E);
            } PHASE_END
        }
        PHASE_BEGIN(pb + 9, 20) phase_norm_mm<2>(WID, a, lds, layer, H, true); PHASE_END
        PHASE_BEGIN(pb + 10, 21) phase_moe_slots(WID, a, lds, layer); PHASE_END
        PHASE_BEGIN(pb + 11, 22) {
            moe_tables(WID, a, lds, layer, -1);
            { ProbMoe8G P{(const unsigned char*)(ws + WS_XN), (const unsigned char*)(ws + WS_WGU) + (size_t)layer * 32 * 2048 * 1024, ts, (const int*)(ws + WS_TOK), 2048, 512, 512, 512}; pg8::Sched S; S.init(ts[32], 8, G, c);
              EpiGU E{(unsigned char*)(ws + WS_ACT), a->in[I_BGU] + (size_t)layer * 32 * 2048, ts}; pg8::gemm_phase(WID, lds, P, S, E); }
            { ProbPlain P{(const bf16_t*)(ws + WS_PBF) + (size_t)layer * T * 256, (const bf16_t*)(ws + WS_WPP) + (size_t)layer * 1024 * 256, 256, 256, 256}; pg8::Sched S; S.init(T / 256, 4, G, c);
              EpiPP E{(bf16_t*)(ws + WS_PP)}; pg8::gemm_phase(WID, lds, P, S, E); }
        } PHASE_END
        PHASE_BEGIN(pb + 12, 23) {
            moe_tables(WID, a, lds, layer, -1);
            ProbMoe8 P{(const unsigned char*)(ws + WS_ACT), (const unsigned char*)(ws + WS_WDN) + (size_t)layer * 32 * 1024 * 1024, ts, 1024, 512, 512, 512}; pg8::Sched S; S.init(ts[32], 4, G, c);
            EpiDN E{(unsigned char*)(ws + WS_YB), a->in[I_BDN] + (size_t)layer * 32 * 1024, ts}; pg8::gemm_phase(WID, lds, P, S, E);
        } PHASE_END
        PHASE_BEGIN(pb + 13, 24) phase_combine(WID, a, H); PHASE_END
        PHASE_BEGIN(pb + 14, 25) {
            ProbPlain8 P{(const unsigned char*)(ws + WS_XN), (const unsigned char*)(ws + WS_WPG) + (size_t)layer * 1024 * 1024, 512, 512, 512}; pg8::Sched S; S.init(T / 256, 4, G, c);
            EpiPLE E{H, (const bf16_t*)(ws + WS_PP), (layer == DEPTH - 1) ? a->out : nullptr}; pg8::gemm_phase(WID, lds, P, S, E);
        } PHASE_END
    }
#undef PHASE_BEGIN
#undef PHASE_END
}

extern "C" void kernel_launch(void* const* d_in, const int* in_sizes, int n_in, void* d_out, int out_size, void* d_ws, size_t ws_size, hipStream_t stream) {
    static int grid = 0;
    if (grid == 0) {
        if (n_in != 26 || out_size != T * D || ws_size < WS_END) { fprintf(stderr, "kernel_launch: unexpected problem (n_in %d, out %d, ws %zu < %zu); nothing launched\n", n_in, out_size, ws_size, (size_t)WS_END); grid = -1; return; }
        int dev = 0, cus = 0, per_cu = 0;
        if (hipGetDevice(&dev) != hipSuccess || hipDeviceGetAttribute(&cus, hipDeviceAttributeMultiprocessorCount, dev) != hipSuccess) { grid = -1; return; }
        if (hipFuncSetAttribute((const void*)mk_fwd, hipFuncAttributeMaxDynamicSharedMemorySize, LDS_BYTES) != hipSuccess) { fprintf(stderr, "kernel_launch: hipFuncSetAttribute failed\n"); grid = -1; return; }
        if (hipOccupancyMaxActiveBlocksPerMultiprocessor(&per_cu, (const void*)mk_fwd, 512, LDS_BYTES) != hipSuccess || per_cu < 1) fprintf(stderr, "kernel_launch: occupancy query reports %d\n", per_cu);
        (void)hipGetLastError();
        grid = cus > 256 ? 256 : cus;
    }
    if (grid < 0) return;
    (void)hipMemsetAsync((char*)d_ws + WS_CTL, 0, CTL_BYTES, stream);
    Args a; memset(&a, 0, sizeof(a));
    for (int i = 0; i < 26; ++i) a.in[i] = (const float*)d_in[i];
    a.out = (float*)d_out; a.ws = (unsigned char*)d_ws;
#if MK_SINGLE
    a.ph_lo = 0; a.ph_hi = NPHASE;
    hipLaunchKernelGGL(mk_fwd, dim3(grid), dim3(512), LDS_BYTES, stream, a);
#else
    for (int ph = 0; ph < NPHASE && ph <= DBG_LAST_PHASE; ++ph) {
        const int l = (ph - 1) / PPL, k = (ph - 1) % PPL;
        if (ph > 0 && (l & 1) && (k == 6 || k == 7)) continue;
        a.ph_lo = ph; a.ph_hi = ph + 1;
        hipLaunchKernelGGL(mk_fwd, dim3(grid), dim3(512), LDS_BYTES, stream, a);
    }
#endif
}
```

```cpp
#include <hip/hip_runtime.h>
#include <cstdio>
#include <cstdint>
#include <cstring>

#define LAS __attribute__((address_space(3)))
#define DI __device__ __forceinline__
typedef unsigned short bf16_t;
typedef short bf16x8 __attribute__((ext_vector_type(8)));
typedef short s16x4 __attribute__((ext_vector_type(4)));
typedef float f32x2 __attribute__((ext_vector_type(2)));
typedef float f32x4 __attribute__((ext_vector_type(4)));
typedef float f32x16 __attribute__((ext_vector_type(16)));
typedef unsigned u32x2 __attribute__((ext_vector_type(2)));
typedef unsigned u32x4 __attribute__((ext_vector_type(4)));
typedef __bf16 bfv2 __attribute__((ext_vector_type(2)));
typedef int i32x4 __attribute__((ext_vector_type(4)));
typedef int i32x8 __attribute__((ext_vector_type(8)));

#ifndef MK_SINGLE
#define MK_SINGLE 1
#endif
#ifndef DBG_ONLY
#define DBG_ONLY -1
#endif
#ifndef PROBE_MASK
#define PROBE_MASK 0u
#endif
#ifndef PROBE_ATT
#define PROBE_ATT 0
#endif
#ifndef PROBE_EPI2
#define PROBE_EPI2 0
#endif
#ifndef PROBE_PRO
#define PROBE_PRO 0
#endif
#ifndef PROBE_KREP
#define PROBE_KREP 1
#endif
#ifndef DBG_LAST_PHASE
#define DBG_LAST_PHASE 100000
#endif

constexpr int T = 32768, D = 1024, SEQ = 2048, NBATCH = 16, DEPTH = 4;
constexpr int EVIN = 2840, ODIN = 6144;
constexpr float EPS = 1e-6f, NEGF = -1e30f;
constexpr int NTB = 256;
constexpr int MOE_ROWS = (512 + 32) * 256;

constexpr size_t MiB = 1u << 20;
constexpr size_t WS_CTL = 0, CTL_BYTES = 1 * MiB;
constexpr int CW_BAR = 4096;
constexpr size_t WS_EVNAT = 2 * MiB, WS_EVSW = 10 * MiB, WS_EVOUT = 13 * MiB, WS_CMP1 = 17 * MiB, WS_ODNAT = 21 * MiB, WS_ODSW = 37 * MiB,
                 WS_ODOUT = 49 * MiB, WS_WPP = 57 * MiB, WS_WPG = 59 * MiB, WS_BIAS1 = 67 * MiB, WS_GAINS = 67 * MiB + 16384, WS_BCNT = 67 * MiB + 65536,
                 WS_WGU = 68 * MiB, WS_WDN = 580 * MiB;
constexpr size_t WS_XN = 840 * MiB, WS_PBF = 904 * MiB, WS_PP = 968 * MiB, WS_GATES = 1032 * MiB, WS_TOPE = 1035 * MiB, WS_POSB = 1036 * MiB,
                 WS_DEST = 1037 * MiB, WS_GATEW = 1038 * MiB, WS_SELM = 1039 * MiB;
constexpr size_t RA = 1040 * MiB;
constexpr size_t WS_QD = RA, WS_KD = RA + 32 * MiB, WS_QN = RA + 64 * MiB, WS_KCB = RA + 96 * MiB, WS_VCB = RA + 105 * MiB, WS_KSB = RA + 114 * MiB,
                 WS_KWB = RA + 122 * MiB, WS_VAT = RA + 130 * MiB, WS_VST = RA + 162 * MiB, WS_VWT = RA + 170 * MiB, WS_HID = RA + 178 * MiB,
                 WS_KCMP = RA + 182 * MiB, WS_VCMPT = RA + 183 * MiB, WS_OC = RA + 184 * MiB, WS_IMPH = RA + 216 * MiB, WS_OD = RA + 248 * MiB,
                 WS_OS = RA + 312 * MiB, WS_OW = RA + 344 * MiB, WS_AMIX = RA + 376 * MiB;
constexpr size_t WS_AQ = RA, WS_KP = RA + 128 * MiB, WS_KT = RA + 192 * MiB, WS_VS = RA + 256 * MiB, WS_GG = RA + 512 * MiB, WS_UT = RA + 640 * MiB,
                 WS_Y = RA + 896 * MiB, WS_YG = RA + 1024 * MiB;
constexpr size_t WS_TOK = 2192 * MiB  , WS_XB = 2192 * MiB, WS_ACT = 2464 * MiB, WS_YB = 2736 * MiB, WS_HB = 3008 * MiB, WS_END = 3072 * MiB;

constexpr int MISC_OFF = 139264, LDS_BYTES = 155648;
static_assert(MISC_OFF + 5888 + 4096 <= LDS_BYTES, "misc LDS words");
constexpr int MO_WCNT = 256, MO_ENT = 1280, MO_GAT = 3328, MO_TOT = 5376, MO_BASE = 5504, MO_TS = 5632, MO_RED = 5888, MO_GIDX = 10240;
static_assert(MISC_OFF + MO_GIDX + 1024 <= LDS_BYTES, "misc LDS words");

DI int opaque_tid(int wid0) { int l; asm volatile("v_mbcnt_lo_u32_b32 %0, -1, 0\n\tv_mbcnt_hi_u32_b32 %0, -1, %0" : "=v"(l) :: "memory"); return (wid0 << 6) | l; }
DI int lane_now() { int l; asm volatile("v_mbcnt_lo_u32_b32 %0, -1, 0\n\tv_mbcnt_hi_u32_b32 %0, -1, %0" : "=v"(l)); return l; }
DI float shx(float v, int m) { return __builtin_bit_cast(float, __builtin_amdgcn_ds_bpermute((lane_now() ^ m) << 2, __builtin_bit_cast(int, v))); }
DI float shxl(float v, int m, int lane) { return __builtin_bit_cast(float, __builtin_amdgcn_ds_bpermute((lane ^ m) << 2, __builtin_bit_cast(int, v))); }
DI unsigned shxu(unsigned v, int m) { return (unsigned)__builtin_amdgcn_ds_bpermute((lane_now() ^ m) << 2, (int)v); }
DI unsigned pk2(float lo, float hi) { f32x2 v = {lo, hi}; return __builtin_bit_cast(unsigned, __builtin_convertvector(v, bfv2)); }
DI unsigned pk4_fp8(float a, float b, float c, float d) { int w = 0; w = __builtin_amdgcn_cvt_pk_fp8_f32(a, b, w, false); w = __builtin_amdgcn_cvt_pk_fp8_f32(c, d, w, true); return (unsigned)w; }
DI u32x2 pack8_fp8(const f32x4& a, const f32x4& b) { u32x2 w; w.x = pk4_fp8(a[0], a[1], a[2], a[3]); w.y = pk4_fp8(b[0], b[1], b[2], b[3]); return w; }
DI float bf2f(unsigned short b) { return __uint_as_float(((unsigned)b) << 16); }
DI float bflo(unsigned w) { return __uint_as_float(w << 16); }
DI float bfhi(unsigned w) { return __uint_as_float(w & 0xffff0000u); }
DI float wave_sum(float v) {
#pragma unroll
    for (int o = 1; o < 64; o <<= 1) v += shx(v, o);
    return v;
}
DI float sigm(float x) { return __builtin_amdgcn_rcpf(1.0f + __builtin_amdgcn_exp2f(-1.44269504089f * x)); }
DI u32x4 pack8(const f32x4& a, const f32x4& b) { u32x4 w; w.x = pk2(a[0], a[1]); w.y = pk2(a[2], a[3]); w.z = pk2(b[0], b[1]); w.w = pk2(b[2], b[3]); return w; }
DI f32x4 ld_h4(const void* base, bool hb, size_t i) {
    if (hb) { const u32x2 w = *(const u32x2*)((const bf16_t*)base + i); return (f32x4){bflo(w.x), bfhi(w.x), bflo(w.y), bfhi(w.y)}; }
    return *(const f32x4*)((const float*)base + i);
}

#define XB_TMO      128
#define XB_XCNT(j)  (256  + 64 * (j))
#define XB_XSUB(j)  (1280 + 64 * (j))
#define XB_XGEN(j)  (2304 + 64 * (j))
#define XB_TOP      3328
#define XB_TOPGEN   3392
#define XCD_BAR_WORDS 3456
#define XB_SPIN_CAP (1u << 22)
DI unsigned xb_ld(unsigned* p)              { return __hip_atomic_load(p, __ATOMIC_RELAXED, __HIP_MEMORY_SCOPE_AGENT); }
DI unsigned xb_add(unsigned* p, unsigned v) { return __hip_atomic_fetch_add(p, v, __ATOMIC_RELAXED, __HIP_MEMORY_SCOPE_AGENT); }
DI unsigned xb_xcc_id() { return (unsigned)__builtin_amdgcn_s_getreg((3 << 11) | 20) & 0xFu; }
#define XB_SPIN(cond, bar) do { unsigned _sp = 0; while (cond) { __builtin_amdgcn_s_sleep(1); \
    if ((++_sp & 255u) == 0u) { if (xb_ld(&(bar)[XB_TMO])) break; if (_sp > XB_SPIN_CAP) { atomicAdd(&(bar)[XB_TMO], 1u); break; } } } } while (0)
struct XcdBarrier { unsigned* bar; unsigned x; volatile LAS unsigned* st; };
DI XcdBarrier xcd_barrier_post(const int WID, unsigned* bar, volatile LAS unsigned* st) {
    XcdBarrier b; b.bar = bar; b.x = xb_xcc_id(); b.st = st;
    if (opaque_tid(WID) == 0) (void)xb_add(&bar[XB_XCNT(b.x)], 1u);
    return b;
}
DI void xcd_barrier_complete(unsigned* bar, unsigned x, unsigned& nloc, unsigned& nx) {
    const unsigned G = gridDim.x * gridDim.y * gridDim.z;
    unsigned sum, cnt, mine, sp = 0u;
    for (;;) {
        sum = 0u; cnt = 0u; mine = 0u;
#pragma unroll
        for (unsigned j = 0; j < 16; ++j) { const unsigned c = xb_ld(&bar[XB_XCNT(j)]); sum += c; cnt += (c > 0u) ? 1u : 0u; mine = (j == x) ? c : mine; }
        if (sum == G) break;
        __builtin_amdgcn_s_sleep(1);
        if ((++sp & 255u) == 0u) { if (xb_ld(&bar[XB_TMO])) break; if (sp > XB_SPIN_CAP) { atomicAdd(&bar[XB_TMO], 1u); break; } }
    }
    nloc = mine > 0u ? mine : 1u; nx = cnt > 0u ? cnt : 1u;
}
DI void xcd_barrier(const int WID, const XcdBarrier& b) {
    asm volatile("s_waitcnt vmcnt(0)" ::: "memory");
    __syncthreads();
    if (opaque_tid(WID) == 0) {
        unsigned* bar = b.bar; asm volatile("" : "+s"(bar));
        __builtin_amdgcn_s_waitcnt(0);
        unsigned nloc = b.st[0], nx = b.st[1];
        if (nloc == 0u) { xcd_barrier_complete(bar, b.x, nloc, nx); b.st[0] = nloc; b.st[1] = nx; }
        const unsigned old = xb_add(&bar[XB_XSUB(b.x)], 1u);
        const unsigned gen = old / nloc;
        if (old + 1u == (gen + 1u) * nloc) {
            __builtin_amdgcn_fence(__ATOMIC_RELEASE, "agent");
            asm volatile("s_waitcnt vmcnt(0)" ::: "memory");
            const unsigned og = xb_add(&bar[XB_TOP], 1u);
            const unsigned tg = og / nx;
            if (og + 1u == (tg + 1u) * nx) xb_add(&bar[XB_TOPGEN], 1u);
            else XB_SPIN(xb_ld(&bar[XB_TOPGEN]) == tg, bar);
            __builtin_amdgcn_fence(__ATOMIC_ACQUIRE, "agent");
            xb_add(&bar[XB_XGEN(b.x)], 1u);
            asm volatile("s_waitcnt vmcnt(0)" ::: "memory");
        } else {
            XB_SPIN(xb_ld(&bar[XB_XGEN(b.x)]) == gen, bar);
            __builtin_amdgcn_fence(__ATOMIC_ACQUIRE, "agent");
            asm volatile("s_waitcnt vmcnt(0)" ::: "memory");
        }
    }
    __syncthreads();
}

namespace pg8 {
constexpr int BM = 256, BK = 64, HALF = 128, HTB = HALF * BK * 2, STAGE_BYTES = 8 * HTB, NXCD = 8, WGM = 8;
DI int lds_byte(int r, int c) { const int st = (r >> 4) * 2 + (c >> 5), rr = r & 15, cc = c & 31, ob = rr * 64 + cc * 2; return st * 1024 + (ob ^ (((ob >> 9) & 1) << 5)); }
DI void stage_rc(int b, int& R, int& C) { const int st = b / 1024, sb = b % 1024, swz = sb ^ (((sb >> 9) & 1) << 5); R = (st >> 1) * 16 + swz / 64; C = (st & 1) * 32 + (swz % 64) / 2; }
DI int perm32(int rho) { const int n = rho >> 4, i = rho & 15; return 8 * (i >> 2) + 4 * n + (i & 3); }
struct Unit { int pm, pn; };
struct Sched {
    int nM, nN, nwg, G, c;
    DI void init(int nM_, int nN_, int G_, int c_) { nM = nM_; nN = nN_; nwg = nM * nN; G = G_; c = c_; }
    DI bool next(int i, Unit& u) const {
        const long L = (long)i * G + c; if (L >= nwg) return false;
        int wgid = (int)L; { const int q = nwg / NXCD, r = nwg % NXCD, xcd = wgid % NXCD, off = wgid / NXCD; wgid = (xcd < r ? xcd * (q + 1) : r * (q + 1) + (xcd - r) * q) + off; }
        const int nig = WGM * nN, gid = wgid / nig, fm = gid * WGM, gsz = (nM - fm) < WGM ? (nM - fm) : WGM;
        u.pm = fm + ((wgid % nig) % gsz); u.pn = (wgid % nig) / gsz; return true;
    }
};
template <class Epi, class Prob, class SchedT>
DI void gemm_phase(const int WID, LAS unsigned char* lds, const Prob& P, const SchedT& S, const Epi& E) {
    const int tid = opaque_tid(WID), wid = __builtin_amdgcn_readfirstlane(tid >> 6), lane = tid & 63, wr = wid >> 2, wc = wid & 3, fr = lane & 15, fq = lane >> 4;
    const int K = P.K, nt = K / BK;
    constexpr int KREP = Epi::CARRY ? 1 : PROBE_KREP;
    unsigned voffA[2], voffB[2], voffG[2];
#pragma unroll
    for (int i = 0; i < 2; ++i) { int R, C; stage_rc(tid * 16 + i * 8192, R, C); const int Rb = Epi::PERM ? ((R & ~31) + perm32(R & 31)) : R;
        voffA[i] = (unsigned)(R * P.lda + C) * 2u; voffB[i] = (unsigned)(Rb * P.ldb + C) * 2u; voffG[i] = 0u; }
    const size_t kstep = (size_t)(BK * 2);
    const size_t hstepA = (size_t)HALF * P.lda * 2, hstepB = (size_t)HALF * P.ldb * 2;
    const unsigned ldsw = (unsigned)wid * 1024u;
    const int aoff = lds_byte(wr * 64 + fr, fq * 8), boff = lds_byte(wc * 32 + fr, fq * 8);
#define PG8_SA(b, h) (((b) * 2 + (h)) * HTB)
#define PG8_SB(b, h) ((4 + (b) * 2 + (h)) * HTB)
#define PG8_STAGE(bufoff, gbase, voff) do { _Pragma("unroll") for (int _i = 0; _i < 2; ++_i) \
        __builtin_amdgcn_global_load_lds((const unsigned*)((const char*)(gbase) + (voff)[_i]), (LAS unsigned*)(lds + (bufoff) + ldsw + _i * 8192), 16, 0, 0); } while (0)
#define PG8_STAGE_A(b, h, abase) do { if constexpr (Prob::GATHER) { if (h) PG8_STAGE(PG8_SA(b, h), abase, voffG); else PG8_STAGE(PG8_SA(b, h), abase, voffA); } \
        else PG8_STAGE(PG8_SA(b, h), (abase) + ((h) ? hstepA : (size_t)0), voffA); } while (0)
#define PG8_LD16(off) (*(const LAS i32x4*)(lds + (off)))
#define PG8_LDA(dst, b, h) do { _Pragma("unroll") for (int m = 0; m < 4; ++m) { const i32x4 lo_ = PG8_LD16(PG8_SA(b, h) + aoff + m * 2048), hi_ = PG8_LD16(PG8_SA(b, h) + aoff + m * 2048 + 1024); dst[m] = __builtin_shufflevector(lo_, hi_, 0, 1, 2, 3, 4, 5, 6, 7); } } while (0)
#define PG8_LDB(dst, b, h) do { _Pragma("unroll") for (int n = 0; n < 2; ++n) { const i32x4 lo_ = PG8_LD16(PG8_SB(b, h) + boff + n * 2048), hi_ = PG8_LD16(PG8_SB(b, h) + boff + n * 2048 + 1024); dst[n] = __builtin_shufflevector(lo_, hi_, 0, 1, 2, 3, 4, 5, 6, 7); } } while (0)
#define PG8_LOH(X) __builtin_bit_cast(bf16x8, __builtin_shufflevector((X), (X), 0, 1, 2, 3))
#define PG8_HIH(X) __builtin_bit_cast(bf16x8, __builtin_shufflevector((X), (X), 4, 5, 6, 7))
#define PG8_MMA(ai, bj, At, Bt) do { __builtin_amdgcn_s_setprio(1); \
        if constexpr (Prob::FP8) { _Pragma("unroll") for (int m = 0; m < 4; ++m) _Pragma("unroll") for (int n = 0; n < 2; ++n) \
            asm volatile("v_mfma_scale_f32_16x16x128_f8f6f4 %0, %1, %2, %0, %3, %3 op_sel_hi:[0,0,0]" : "+v"(acc[ai][bj][m][n]) : "v"(Bt[n]), "v"(At[m]), "v"(sc1)); } \
        else { _Pragma("unroll") for (int m = 0; m < 4; ++m) _Pragma("unroll") for (int n = 0; n < 2; ++n) { \
            acc[ai][bj][m][n] = __builtin_amdgcn_mfma_f32_16x16x32_bf16(PG8_LOH(Bt[n]), PG8_LOH(At[m]), acc[ai][bj][m][n], 0, 0, 0); \
            acc[ai][bj][m][n] = __builtin_amdgcn_mfma_f32_16x16x32_bf16(PG8_HIH(Bt[n]), PG8_HIH(At[m]), acc[ai][bj][m][n], 0, 0, 0); } } \
        __builtin_amdgcn_s_setprio(0); } while (0)
#define PG8_WAIT_V(n) asm volatile("s_waitcnt vmcnt(" #n ")" ::: "memory")
#define PG8_WAIT_L(n) asm volatile("s_waitcnt lgkmcnt(" #n ")" ::: "memory")
#define PG8_BAR __builtin_amdgcn_s_barrier()
#define PG8_SCHED __builtin_amdgcn_sched_barrier(0)
    Unit cur, nxt; int ui = 0;
    if (!S.next(0, cur)) return;
    f32x4 acc[2][2][4][2];
#pragma unroll
    for (int a = 0; a < 2; ++a)
#pragma unroll
        for (int b = 0; b < 2; ++b)
#pragma unroll
            for (int m = 0; m < 4; ++m)
#pragma unroll
                for (int n = 0; n < 2; ++n) acc[a][b][m][n] = (f32x4){0.f, 0.f, 0.f, 0.f};
    i32x8 At[4], B0[2], B1[2];
    const int sc1 = 0x7f7f7f7f;
    const char* cA = P.a_base(cur); const char* cB = P.b_base(cur);
    if constexpr (Prob::GATHER) {
#pragma unroll
        for (int i = 0; i < 2; ++i) { int R, C; stage_rc(tid * 16 + i * 8192, R, C);
            voffA[i] = (unsigned)P.TOK[(size_t)cur.pm * 256 + R] * 1024u + (unsigned)C * 2u; voffG[i] = (unsigned)P.TOK[(size_t)cur.pm * 256 + 128 + R] * 1024u + (unsigned)C * 2u; }
    }
    PG8_STAGE(PG8_SB(0, 0), cB, voffB); PG8_STAGE_A(0, 0, cA); PG8_STAGE(PG8_SB(0, 1), cB + hstepB, voffB); PG8_STAGE_A(0, 1, cA);
    if (wr == 1) PG8_BAR;
    PG8_WAIT_V(4); PG8_BAR;
    PG8_STAGE(PG8_SB(1, 0), cB + kstep, voffB); PG8_STAGE_A(1, 0, cA + kstep); PG8_STAGE(PG8_SB(1, 1), cB + hstepB + kstep, voffB);
    PG8_WAIT_V(6); PG8_BAR;
    for (;;) {
        const bool has_next = S.next(ui + 1, nxt);
        const char* nA = has_next ? P.a_base(nxt) : cA; const char* nB = has_next ? P.b_base(nxt) : cB;
        for (int rep_ = 0; rep_ < KREP; ++rep_)
        for (int t = 0; t < nt; t += 2) {
            const bool last = (t == nt - 2);
            if constexpr (Epi::HOOK) { if (last && rep_ + 1 == KREP) E.prefetch(cur, lds, wid, lane); }
            const char* a1 = cA + (size_t)(t + 1) * kstep;
            const char* a2 = last ? (rep_ + 1 < KREP ? cA : nA) : cA + (size_t)(t + 2) * kstep; const char* b2 = last ? (rep_ + 1 < KREP ? cB : nB) : cB + (size_t)(t + 2) * kstep;
            const char* a3 = a2 + kstep; const char* b3 = b2 + kstep;
            if constexpr (Prob::GATHER) {
                if (t == 0 && rep_ == 0 && has_next && wid == 0) __builtin_amdgcn_global_load_lds((const unsigned*)(P.TOK + (size_t)nxt.pm * 256 + 4 * lane_now()), (LAS unsigned*)(lds + MISC_OFF + MO_GIDX), 16, 0, 0);
                if (last && rep_ + 1 == KREP && has_next) { const int t3_ = opaque_tid(WID);
#pragma unroll
                    for (int i = 0; i < 2; ++i) { int R, C; stage_rc(t3_ * 16 + i * 8192, R, C); voffA[i] = (unsigned)(*(const LAS int*)(lds + MISC_OFF + MO_GIDX + 4 * R)) * 1024u + (unsigned)C * 2u; } }
            }
            PG8_LDB(B0, 0, 0); PG8_SCHED; PG8_LDA(At, 0, 0); PG8_STAGE_A(1, 1, a1);
            if constexpr (Prob::GATHER) {
                if (last && rep_ + 1 == KREP && has_next) { const int t3_ = opaque_tid(WID);
#pragma unroll
                    for (int i = 0; i < 2; ++i) { int R, C; stage_rc(t3_ * 16 + i * 8192, R, C); voffG[i] = (unsigned)(*(const LAS int*)(lds + MISC_OFF + MO_GIDX + 512 + 4 * R)) * 1024u + (unsigned)C * 2u; } }
            }
            PG8_WAIT_L(8); PG8_BAR; PG8_WAIT_L(0); PG8_MMA(0, 0, At, B0); PG8_BAR; PG8_SCHED;
            PG8_LDB(B1, 0, 1); PG8_STAGE(PG8_SB(0, 0), b2, voffB);
            PG8_BAR; PG8_WAIT_L(0); PG8_MMA(0, 1, At, B1); PG8_BAR;
            PG8_LDA(At, 0, 1); PG8_STAGE_A(0, 0, a2);
            PG8_BAR; PG8_WAIT_L(0); PG8_MMA(1, 0, At, B0); PG8_BAR; PG8_SCHED;
            PG8_STAGE(PG8_SB(0, 1), b2 + hstepB, voffB);
            PG8_WAIT_V(6); PG8_BAR; PG8_MMA(1, 1, At, B1); PG8_BAR;
            PG8_LDB(B0, 1, 0); PG8_SCHED; PG8_LDA(At, 1, 0); PG8_STAGE_A(0, 1, a2);
            PG8_WAIT_L(8); PG8_BAR; PG8_WAIT_L(0); PG8_MMA(0, 0, At, B0); PG8_BAR; PG8_SCHED;
            PG8_LDB(B1, 1, 1); PG8_STAGE(PG8_SB(1, 0), b3, voffB);
            PG8_BAR; PG8_WAIT_L(0); PG8_MMA(0, 1, At, B1); PG8_BAR;
            PG8_LDA(At, 1, 1); PG8_STAGE_A(1, 0, a3);
            PG8_BAR; PG8_WAIT_L(0); PG8_MMA(1, 0, At, B0); PG8_BAR; PG8_SCHED;
            PG8_STAGE(PG8_SB(1, 1), b3 + hstepB, voffB);
            PG8_WAIT_V(6); PG8_BAR; PG8_MMA(1, 1, At, B1); PG8_BAR;
        }
        if constexpr (Prob::FP8) {
            asm volatile("s_nop 15\n\ts_nop 15" ::: "memory");
#pragma unroll
            for (int a_ = 0; a_ < 2; ++a_)
#pragma unroll
                for (int b_ = 0; b_ < 2; ++b_)
#pragma unroll
                    for (int m_ = 0; m_ < 4; ++m_)
#pragma unroll
                        for (int n_ = 0; n_ < 2; ++n_) asm volatile("" : "+v"(acc[a_][b_][m_][n_]));
        }
        if constexpr (KREP > 1) {
#pragma unroll
        for (int a_ = 0; a_ < 2; ++a_)
#pragma unroll
            for (int b_ = 0; b_ < 2; ++b_)
#pragma unroll
                for (int m_ = 0; m_ < 4; ++m_)
#pragma unroll
                    for (int n_ = 0; n_ < 2; ++n_) acc[a_][b_][m_][n_] *= (1.0f / KREP); }
        { const int t2_ = opaque_tid(WID); const int fr_ = t2_ & 15, fq_ = (t2_ >> 4) & 3; int wr_ = WID >> 2, wc_ = WID & 3; asm volatile("" : "+s"(wr_), "+s"(wc_));
          E(acc, cur, wr_, wc_, fr_, fq_);
#if PROBE_EPI2
          if constexpr (Epi::HOOK) { asm volatile("" ::: "memory"); E(acc, cur, wr_, wc_, fr_, fq_); }
#endif
        }
        if (!has_next) break;
        const float carry = Epi::carry(cur);
#pragma unroll
        for (int a = 0; a < 2; ++a)
#pragma unroll
            for (int b = 0; b < 2; ++b)
#pragma unroll
                for (int m = 0; m < 4; ++m)
#pragma unroll
                    for (int n = 0; n < 2; ++n) acc[a][b][m][n] = Epi::CARRY ? acc[a][b][m][n] * carry : (f32x4){0.f, 0.f, 0.f, 0.f};
        cur = nxt; cA = nA; cB = nB; ++ui;
    }
    PG8_WAIT_V(0);
    if (wr == 0) PG8_BAR;
    PG8_BAR;
#undef PG8_SA
#undef PG8_SB
#undef PG8_STAGE
#undef PG8_STAGE_A
#undef PG8_LDA
#undef PG8_LDB
#undef PG8_MMA
#undef PG8_LD16
#undef PG8_LOH
#undef PG8_HIH
#undef PG8_WAIT_V
#undef PG8_WAIT_L
#undef PG8_BAR
#undef PG8_SCHED
}
}
using pg8::Unit;
typedef f32x4 Acc[2][2][4][2];

struct ProbPlain { static constexpr bool GATHER = false; static constexpr bool FP8 = false; const bf16_t* A; const bf16_t* Bt; int lda, ldb, K;
    DI const char* a_base(const Unit& u) const { return (const char*)(A + (size_t)u.pm * 256 * lda); }
    DI const char* b_base(const Unit& u) const { return (const char*)(Bt + (size_t)u.pn * 256 * ldb); } };
struct ProbCmp1 { static constexpr bool GATHER = false; static constexpr bool FP8 = false; const bf16_t* KCB; const bf16_t* VCB; const bf16_t* W; int lda, ldb, K;
    DI const char* a_base(const Unit& u) const { const int kv = u.pm >> 4, rt = u.pm & 15; return (const char*)((kv ? VCB : KCB) + (size_t)rt * 256 * 1024); }
    DI const char* b_base(const Unit& u) const { const int kv = u.pm >> 4; return (const char*)(W + (size_t)kv * 256 * 2048); } };
struct ProbAtt { static constexpr bool GATHER = false; static constexpr bool FP8 = false; const bf16_t* AQ; const bf16_t* KP; int lda, ldb, K;
    DI const char* a_base(const Unit& u) const { const int z = u.pm, n = z & 7, h = (z >> 3) & 3, b = z >> 5; const size_t t0 = (size_t)b * 2048 + n * 256; return (const char*)(AQ + (t0 * 4 + h) * 512 + 256); }
    DI const char* b_base(const Unit& u) const { const int z = u.pm, n = z & 7, h = (z >> 3) & 3, b = z >> 5; const size_t t0 = (size_t)b * 2048 + n * 256; return (const char*)(KP + t0 * 1024 + h * 256); } };
struct ProbUT { static constexpr bool GATHER = false; static constexpr bool FP8 = false; const bf16_t* VS; const bf16_t* KT; int lda, ldb, K;
    DI const char* a_base(const Unit& u) const { const int z = u.pm >> 1, half = u.pm & 1; return (const char*)(VS + (size_t)z * 262144 + (size_t)half * 256 * 512); }
    DI const char* b_base(const Unit& u) const { const int z = u.pm >> 1; return (const char*)(KT + (size_t)z * 65536); } };
struct ProbY { static constexpr bool GATHER = false; static constexpr bool FP8 = false; const bf16_t* AQ; const bf16_t* VS; int lda, ldb, K;
    DI const char* a_base(const Unit& u) const { const int z = u.pm, n = z & 7, h = (z >> 3) & 3, b = z >> 5; const size_t t0 = (size_t)b * 2048 + n * 256; return (const char*)(AQ + (t0 * 4 + h) * 512); }
    DI const char* b_base(const Unit& u) const { return (const char*)(VS + (size_t)u.pm * 262144 + (size_t)u.pn * 256 * 512); } };
DI int moe_tile_expert(const LAS int* ts, int rt) { int e = 0;
#pragma unroll 8
    for (int i = 1; i < 32; ++i) e += (rt >= ts[i]) ? 1 : 0;
    return e; }
struct ProbMoe { static constexpr bool GATHER = false; static constexpr bool FP8 = false; const bf16_t* A; const bf16_t* W; const LAS int* ts; int nper; int lda, ldb, K;
    DI const char* a_base(const Unit& u) const { return (const char*)(A + (size_t)u.pm * 256 * 1024); }
    DI const char* b_base(const Unit& u) const { const int e = moe_tile_expert(ts, u.pm); return (const char*)(W + ((size_t)e * nper + (size_t)u.pn * 256) * 1024); } };

struct ProbPlain8 { static constexpr bool GATHER = false; static constexpr bool FP8 = true; const unsigned char* A; const unsigned char* Bt; int lda, ldb, K;
    DI const char* a_base(const Unit& u) const { return (const char*)(A + (size_t)u.pm * 256 * lda * 2); }
    DI const char* b_base(const Unit& u) const { return (const char*)(Bt + (size_t)u.pn * 256 * ldb * 2); } };
struct ProbMoe8 { static constexpr bool GATHER = false; static constexpr bool FP8 = true; const unsigned char* A; const unsigned char* W; const LAS int* ts; int nper; int lda, ldb, K;
    DI const char* a_base(const Unit& u) const { return (const char*)(A + (size_t)u.pm * 256 * 1024); }
    DI const char* b_base(const Unit& u) const { const int e = moe_tile_expert(ts, u.pm); return (const char*)(W + ((size_t)e * nper + (size_t)u.pn * 256) * 1024); } };
struct ProbMoe8G { static constexpr bool GATHER = true; static constexpr bool FP8 = true; const unsigned char* A; const unsigned char* W; const LAS int* ts; const int* TOK; int nper; int lda, ldb, K;
    DI const char* a_base(const Unit&) const { return (const char*)A; }
    DI const char* b_base(const Unit& u) const { const int e = moe_tile_expert(ts, u.pm); return (const char*)(W + ((size_t)e * nper + (size_t)u.pn * 256) * 1024); } };

constexpr float RY_SC = 4.0f, RG_SC = 16.0f;
constexpr float Y_SC = 8.0f;
constexpr float A_SC = 4.0f;
constexpr float W8_SCALE = 32.0f, WSC = 1.0f / W8_SCALE;
#define EPI_ROWS(ai, m) (128 * (ai) + 64 * wr + 16 * (m) + fr)
struct EpiEvNat { static constexpr bool HOOK = false; static constexpr bool CARRY = false; static DI float carry(const Unit&) { return 0.f; } static constexpr bool PERM = true;
    unsigned char* ws; const float* gains;
    DI void operator()(const Acc& acc, const Unit& u, int wr, int wc, int fr, int fq) const {
        const int pn = u.pn; const bool norm = (pn != 6);
        const int gi = pn < 2 ? 0 : pn < 4 ? 1 : pn < 6 ? 2 : 3;
        const float* g = gains + gi * 64;
        f32x4 gv[2][2];
#pragma unroll
        for (int bj = 0; bj < 2; ++bj)
#pragma unroll
            for (int n = 0; n < 2; ++n) { const f32x4 t4 = *(const f32x4*)(g + 32 * bj + 8 * fq + 4 * n); gv[bj][n] = norm ? t4 : (f32x4){1.f, 1.f, 1.f, 1.f}; }
        size_t boff; int rowmul, hoff; bool panel = false;
        if (pn < 2) { boff = WS_QD; rowmul = 512; hoff = (pn * 4 + wc) * 64; }
        else if (pn < 4) { boff = WS_KD; rowmul = 512; hoff = ((pn - 2) * 4 + wc) * 64; }
        else if (pn < 6) { boff = WS_QN; rowmul = 512; hoff = ((pn - 4) * 4 + wc) * 64; }
        else { panel = true; rowmul = 64; hoff = 0; boff = (pn == 6) ? (wc < 2 ? WS_KCB : WS_VCB) : (wc < 2 ? WS_KSB : WS_KWB); }
        bf16_t* base = (bf16_t*)(ws + boff);
#pragma unroll
        for (int ai = 0; ai < 2; ++ai)
#pragma unroll
            for (int m = 0; m < 4; ++m) {
                const int t = u.pm * 256 + EPI_ROWS(ai, m), b = t >> 11, sq = t & 2047;
                float ss = 0.f;
#pragma unroll
                for (int bj = 0; bj < 2; ++bj)
#pragma unroll
                    for (int n = 0; n < 2; ++n) { const f32x4 x = acc[ai][bj][m][n]; ss += (x[0] * x[0] + x[1] * x[1]) + (x[2] * x[2] + x[3] * x[3]); }
                ss += shx(ss, 16); ss += shx(ss, 32);
                const float rstd = norm ? rsqrtf(ss * (1.0f / 64.0f) + EPS) * ((pn < 2 || pn == 4 || pn == 5) ? 0.125f : 1.0f) : 1.0f;
                const size_t rowi = panel ? ((size_t)(b * 2 + (wc & 1)) * 2048 + sq) : (size_t)t;
#pragma unroll
                for (int bj = 0; bj < 2; ++bj) {
                    const f32x4 v0 = acc[ai][bj][m][0] * rstd * gv[bj][0], v1 = acc[ai][bj][m][1] * rstd * gv[bj][1];
                    *(u32x4*)(base + rowi * rowmul + hoff + 32 * bj + 8 * fq) = pack8(v0, v1);
                }
            }
    }
};
struct EpiEvSw { static constexpr bool HOOK = false; static constexpr bool CARRY = false; static DI float carry(const Unit&) { return 0.f; } static constexpr bool PERM = true;
    unsigned char* ws;
    DI void operator()(const Acc& acc, const Unit& u, int wr, int wc, int fr, int fq) const {
        const int b = u.pn >> 3, sb = (u.pn & 7) * 256;
#pragma unroll
        for (int ai = 0; ai < 2; ++ai)
#pragma unroll
            for (int m = 0; m < 4; ++m) {
                const int rl = EPI_ROWS(ai, m);
                size_t boff, rowi;
                if (u.pm < 2) { const int fg = u.pm * 256 + rl; boff = WS_VAT; rowi = (size_t)(b * 4 + (fg >> 7)) * 128 + (fg & 127); }
                else { const int r2 = rl & 127; boff = (rl < 128) ? WS_VST : WS_VWT; rowi = (size_t)(b * 2 + (r2 >> 6)) * 64 + (r2 & 63); }
                bf16_t* rowp = (bf16_t*)(ws + boff) + rowi * 2048;
#pragma unroll
                for (int bj = 0; bj < 2; ++bj) { const u32x4 pw = pack8(acc[ai][bj][m][0], acc[ai][bj][m][1]);
                    const int s0 = sb + 128 * bj + 32 * wc + 8 * fq; bf16_t* g16 = rowp + (s0 & ~15) + ((s0 & 8) ? 4 : 0);
                    *(u32x2*)g16 = (u32x2){pw.x, pw.y}; *(u32x2*)(g16 + 8) = (u32x2){pw.z, pw.w}; }
            }
    }
};
struct EpiCmp1 { static constexpr bool HOOK = false; static constexpr bool CARRY = false; static DI float carry(const Unit&) { return 0.f; } static constexpr bool PERM = true;
    bf16_t* HID; const float* bias1;
    DI void operator()(const Acc& acc, const Unit& u, int wr, int wc, int fr, int fq) const {
        const int kv = u.pm >> 4, rt = u.pm & 15;
#pragma unroll
        for (int bj = 0; bj < 2; ++bj) {
            const int col = 128 * bj + 32 * wc + 8 * fq;
            const f32x4 b0 = *(const f32x4*)(bias1 + kv * 256 + col), b1 = *(const f32x4*)(bias1 + kv * 256 + col + 4);
#pragma unroll
            for (int ai = 0; ai < 2; ++ai)
#pragma unroll
                for (int m = 0; m < 4; ++m) {
                    f32x4 v0 = acc[ai][bj][m][0] + b0, v1 = acc[ai][bj][m][1] + b1;
#pragma unroll
                    for (int j = 0; j < 4; ++j) { v0[j] = v0[j] * sigm(v0[j]); v1[j] = v1[j] * sigm(v1[j]); }
                    *(u32x4*)(HID + ((size_t)kv * 4096 + rt * 256 + EPI_ROWS(ai, m)) * 256 + col) = pack8(v0, v1);
                }
        }
    }
};
struct EpiResid { static constexpr bool HOOK = false; static constexpr bool CARRY = false; static DI float carry(const Unit&) { return 0.f; } static constexpr bool PERM = true;
    const void* Hin; bf16_t* Hout; bool hb; float sc;
    DI void operator()(const Acc& acc, const Unit& u, int wr, int wc, int fr, int fq) const {
#pragma unroll
        for (int ai = 0; ai < 2; ++ai)
#pragma unroll
            for (int m = 0; m < 4; ++m) {
                const size_t off = (size_t)(u.pm * 256 + EPI_ROWS(ai, m)) * 1024 + u.pn * 256 + 32 * wc + 8 * fq;
#pragma unroll
                for (int bj = 0; bj < 2; ++bj) { const size_t o = off + 128 * bj;
                    *(u32x4*)(Hout + o) = pack8(ld_h4(Hin, hb, o) + acc[ai][bj][m][0] * sc, ld_h4(Hin, hb, o + 4) + acc[ai][bj][m][1] * sc); }
            }
    }
};
DI float ret_lg2(int h) { return __log2f(1.0f - exp2f(-5.0f - (float)h)); }
struct EpiOdNat { static constexpr bool HOOK = false; static constexpr bool CARRY = false; static DI float carry(const Unit&) { return 0.f; } static constexpr bool PERM = true;
    unsigned char* ws;
    DI void operator()(const Acc& acc, const Unit& u, int wr, int wc, int fr, int fq) const {
        const int pn = u.pn; const int h = pn & 3; const float lg = ret_lg2(h);
        const size_t boff = pn < 4 ? WS_AQ : pn < 8 ? WS_KP : WS_GG;
        const int rowmul = pn < 4 ? 2048 : pn < 8 ? 1024 : 2048;
        const int coff = pn < 4 ? (h * 512 + 256) : pn < 8 ? (h * 256) : ((pn - 8) * 256);
        bf16_t* base = (bf16_t*)(ws + boff) + coff;
#pragma unroll
        for (int ai = 0; ai < 2; ++ai)
#pragma unroll
            for (int m = 0; m < 4; ++m) {
                const int cl = EPI_ROWS(ai, m); const size_t t = (size_t)u.pm * 256 + cl;
                float sc = 1.f;
                if (pn < 4) sc = exp2f(lg * (float)(cl + 1)); else if (pn < 8) sc = 0.0625f * exp2f(-lg * (float)(cl + 1));
                sc *= WSC;
#pragma unroll
                for (int bj = 0; bj < 2; ++bj) {
                    const int d = 128 * bj + 32 * wc + 8 * fq;
                    f32x4 v0 = acc[ai][bj][m][0] * sc, v1 = acc[ai][bj][m][1] * sc;
                    if (pn >= 8) {
                        f32x4 e0 = v0 * -1.44269504089f, e1 = v1 * -1.44269504089f;
#pragma unroll
                        for (int j = 0; j < 4; ++j) { e0[j] = __builtin_amdgcn_exp2f(e0[j]); e1[j] = __builtin_amdgcn_exp2f(e1[j]); }
                        e0 = e0 + 1.0f; e1 = e1 + 1.0f;
#pragma unroll
                        for (int j = 0; j < 4; ++j) { e0[j] = __builtin_amdgcn_rcpf(e0[j]); e1[j] = __builtin_amdgcn_rcpf(e1[j]); }
                        v0 = v0 * e0; v1 = v1 * e1;
                        *(u32x2*)(ws + WS_GG + t * 2048 + (size_t)((pn - 8) * 256 + d)) = pack8_fp8(v0 * RG_SC, v1 * RG_SC);
                        continue; }
                    const u32x4 pw = pack8(v0, v1);
                    *(u32x4*)(base + t * rowmul + d) = pw;
                    if (pn >= 4 && pn < 8) {
                        bf16_t* kt = (bf16_t*)(ws + WS_KT) + ((size_t)((u.pm >> 3) * 4 + h) * 8 + (u.pm & 7)) * 65536 + (size_t)d * 256 + cl;
                        kt[0 * 256] = (bf16_t)(pw.x & 0xffffu); kt[1 * 256] = (bf16_t)(pw.x >> 16); kt[2 * 256] = (bf16_t)(pw.y & 0xffffu); kt[3 * 256] = (bf16_t)(pw.y >> 16);
                        kt[4 * 256] = (bf16_t)(pw.z & 0xffffu); kt[5 * 256] = (bf16_t)(pw.z >> 16); kt[6 * 256] = (bf16_t)(pw.w & 0xffffu); kt[7 * 256] = (bf16_t)(pw.w >> 16);
                    }
                }
            }
    }
};
struct EpiOdSw { static constexpr bool HOOK = false; static constexpr bool CARRY = false; static DI float carry(const Unit&) { return 0.f; } static constexpr bool PERM = true;
    unsigned char* ws;
    DI void operator()(const Acc& acc, const Unit& u, int wr, int wc, int fr, int fq) const {
        const int b = u.pn >> 3, n = u.pn & 7, h = u.pm >> 1;
        const size_t z = (size_t)(b * 4 + h) * 8 + n;
        bf16_t* base = (bf16_t*)(ws + WS_VS) + z * 262144 + (size_t)(u.pm & 1) * 256 * 512;
#pragma unroll
        for (int bj = 0; bj < 2; ++bj) {
            const int cl = 128 * bj + 32 * wc + 8 * fq;
#pragma unroll
            for (int ai = 0; ai < 2; ++ai)
#pragma unroll
                for (int m = 0; m < 4; ++m)
                    *(u32x4*)(base + (size_t)EPI_ROWS(ai, m) * 512 + cl) = pack8(acc[ai][bj][m][0] * WSC, acc[ai][bj][m][1] * WSC);
        }
    }
};
struct EpiAtt { static constexpr bool HOOK = false; static constexpr bool CARRY = false; static DI float carry(const Unit&) { return 0.f; } static constexpr bool PERM = true;
    bf16_t* AQ;
    DI void operator()(const Acc& acc, const Unit& u, int wr, int wc, int fr, int fq) const {
        const int z = u.pm, n = z & 7, h = (z >> 3) & 3, b = z >> 5; const size_t t0 = (size_t)b * 2048 + n * 256;
#pragma unroll
        for (int ai = 0; ai < 2; ++ai)
#pragma unroll
            for (int m = 0; m < 4; ++m) {
                const int c = EPI_ROWS(ai, m);
#pragma unroll
                for (int bj = 0; bj < 2; ++bj) {
                    const int e0 = 128 * bj + 32 * wc + 8 * fq;
                    f32x4 v0 = acc[ai][bj][m][0], v1 = acc[ai][bj][m][1];
#pragma unroll
                    for (int j = 0; j < 4; ++j) { v0[j] = (c >= e0 + j) ? v0[j] : 0.f; v1[j] = (c >= e0 + 4 + j) ? v1[j] : 0.f; }
                    *(u32x4*)(AQ + ((t0 + c) * 4 + h) * 512 + e0) = pack8(v0, v1);
                }
            }
    }
};
struct EpiUT { static constexpr bool HOOK = false; static constexpr bool CARRY = false; static DI float carry(const Unit&) { return 0.f; } static constexpr bool PERM = true;
    bf16_t* UT;
    DI void operator()(const Acc& acc, const Unit& u, int wr, int wc, int fr, int fq) const {
        const size_t z = (size_t)(u.pm >> 1); const int half = u.pm & 1;
#pragma unroll
        for (int ai = 0; ai < 2; ++ai)
#pragma unroll
            for (int m = 0; m < 4; ++m) {
                bf16_t* rowp = UT + z * 131072 + (size_t)(half * 256 + EPI_ROWS(ai, m)) * 256 + 32 * wc + 8 * fq;
#pragma unroll
                for (int bj = 0; bj < 2; ++bj) *(u32x4*)(rowp + 128 * bj) = pack8(acc[ai][bj][m][0], acc[ai][bj][m][1]);
            }
    }
};
struct EpiUTScan { static constexpr bool HOOK = false; static constexpr bool CARRY = true; static constexpr bool PERM = true;
    static DI float carry(const Unit& u) { const int z = u.pm >> 1, n = z & 7, h = (z >> 3) & 3; return n == 7 ? 0.f : exp2f(256.0f * ret_lg2(h)); }
    bf16_t* VS;
    DI void operator()(const Acc& acc, const Unit& u, int wr, int wc, int fr, int fq) const {
        const size_t z = (size_t)(u.pm >> 1); const int half = u.pm & 1, n = (int)(z & 7), h = (int)((z >> 3) & 3);
        const float dec = exp2f(256.0f * ret_lg2(h));
#pragma unroll
        for (int ai = 0; ai < 2; ++ai)
#pragma unroll
            for (int m = 0; m < 4; ++m) {
                bf16_t* rowp = VS + (z * 512 + half * 256 + EPI_ROWS(ai, m)) * 512 + 256 + 32 * wc + 8 * fq;
#pragma unroll
                for (int bj = 0; bj < 2; ++bj) {
                    if (n == 0) { unsigned z0; asm volatile("v_mov_b32 %0, 0" : "=v"(z0)); *(u32x4*)(rowp + 128 * bj) = (u32x4){z0, z0, z0, z0}; }
                    if (n < 7) *(u32x4*)(rowp + (size_t)512 * 512 + 128 * bj) = pack8(acc[ai][bj][m][0] * dec, acc[ai][bj][m][1] * dec);
                }
            }
    }
};
struct SchedSeq { int nb, c;
    DI void init(int G, int c_) { nb = G / 2 > 0 ? G / 2 : 1; c = c_; }
    DI bool next(int i, Unit& u) const { if (c >= nb) return false; const int seq = c + (i >> 3) * nb; if (seq >= 128) return false;
        const int bh = seq >> 1, half = seq & 1, n = i & 7; u.pm = (bh * 8 + n) * 2 + half; u.pn = 0; return true; } };
struct EpiY { static constexpr bool HOOK = false; static constexpr bool CARRY = false; static DI float carry(const Unit&) { return 0.f; } static constexpr bool PERM = true;
    unsigned char* Y;
    DI void operator()(const Acc& acc, const Unit& u, int wr, int wc, int fr, int fq) const {
        const int z = u.pm, n = z & 7, h = (z >> 3) & 3, b = z >> 5; const size_t t0 = (size_t)b * 2048 + n * 256;
#pragma unroll
        for (int ai = 0; ai < 2; ++ai)
#pragma unroll
            for (int m = 0; m < 4; ++m) {
                unsigned char* rowp = Y + (t0 + EPI_ROWS(ai, m)) * 2048 + h * 512 + u.pn * 256 + 32 * wc + 8 * fq;
#pragma unroll
                for (int bj = 0; bj < 2; ++bj) *(u32x2*)(rowp + 128 * bj) = pack8_fp8(acc[ai][bj][m][0] * RY_SC, acc[ai][bj][m][1] * RY_SC);
            }
    }
};
struct EpiGU { static constexpr bool HOOK = true; static constexpr bool CARRY = false; static DI float carry(const Unit&) { return 0.f; } static constexpr bool PERM = true;
    unsigned char* ACT; const float* bgu; const LAS int* ts;
    DI void prefetch(const Unit& u, LAS unsigned char* lds, int wid, int lane) const {
        if (wid == 0) { const int e = moe_tile_expert(ts, u.pm); const int ln = lane_now();
            const float* src = bgu + (size_t)e * 2048 + 128 * u.pn + ((ln & 32) ? 1024 : 0) + 4 * (ln & 31);
            __builtin_amdgcn_global_load_lds((const unsigned*)src, (LAS unsigned*)(lds + MISC_OFF + MO_RED), 16, 0, 0); }
    }
    DI void operator()(const Acc& acc, const Unit& u, int wr, int wc, int fr, int fq) const {
        const int w = 32 * wc + 8 * fq;
        const LAS float* bl_ = (const LAS float*)(ts) - MO_TS / 4 + MO_RED / 4 + w;
        const f32x4 bg0 = *(const LAS f32x4*)bl_, bg1 = *(const LAS f32x4*)(bl_ + 4), bl0 = *(const LAS f32x4*)(bl_ + 128), bl1 = *(const LAS f32x4*)(bl_ + 132);
#pragma unroll
        for (int ai = 0; ai < 2; ++ai)
#pragma unroll
            for (int m = 0; m < 4; ++m) {
                f32x4 g0 = acc[ai][0][m][0] * WSC + bg0, g1 = acc[ai][0][m][1] * WSC + bg1, l0 = acc[ai][1][m][0] * WSC + bl0, l1 = acc[ai][1][m][1] * WSC + bl1;
                const f32x4 seven = {7.f, 7.f, 7.f, 7.f}, mseven = {-7.f, -7.f, -7.f, -7.f};
                g0 = __builtin_elementwise_min(g0, seven); g1 = __builtin_elementwise_min(g1, seven);
                l0 = __builtin_elementwise_min(__builtin_elementwise_max(l0, mseven), seven); l1 = __builtin_elementwise_min(__builtin_elementwise_max(l1, mseven), seven);
                f32x4 e0 = g0 * (-1.702f * 1.44269504089f), e1 = g1 * (-1.702f * 1.44269504089f);
#pragma unroll
                for (int j = 0; j < 4; ++j) { e0[j] = __builtin_amdgcn_exp2f(e0[j]); e1[j] = __builtin_amdgcn_exp2f(e1[j]); }
                e0 = e0 + 1.0f; e1 = e1 + 1.0f;
#pragma unroll
                for (int j = 0; j < 4; ++j) { e0[j] = __builtin_amdgcn_rcpf(e0[j]); e1[j] = __builtin_amdgcn_rcpf(e1[j]); }
                g0 = g0 * e0 * (l0 + 1.0f); g1 = g1 * e1 * (l1 + 1.0f);
                u32x2 o8; o8.x = pk4_fp8(g0[0], g0[1], g0[2], g0[3]); o8.y = pk4_fp8(g1[0], g1[1], g1[2], g1[3]);
                *(u32x2*)(ACT + ((size_t)u.pm * 256 + EPI_ROWS(ai, m)) * 1024 + 128 * u.pn + w) = o8;
            }
    }
};
struct EpiDN { static constexpr bool HOOK = true; static constexpr bool CARRY = false; static DI float carry(const Unit&) { return 0.f; } static constexpr bool PERM = true;
    unsigned char* YB; const float* bdn; const LAS int* ts;
    DI void prefetch(const Unit& u, LAS unsigned char* lds, int wid, int lane) const {
        if (wid == 0) { const int e = moe_tile_expert(ts, u.pm); const int ln = lane_now();
            __builtin_amdgcn_global_load_lds((const unsigned*)(bdn + (size_t)e * 1024 + 256 * u.pn + 4 * ln), (LAS unsigned*)(lds + MISC_OFF + MO_RED), 16, 0, 0); }
    }
    DI void operator()(const Acc& acc, const Unit& u, int wr, int wc, int fr, int fq) const {
        const LAS float* bl_ = (const LAS float*)(ts) - MO_TS / 4 + MO_RED / 4;
#pragma unroll
        for (int bj = 0; bj < 2; ++bj) {
            const int cl = 128 * bj + 32 * wc + 8 * fq, col = 256 * u.pn + cl;
            const f32x4 b0 = *(const LAS f32x4*)(bl_ + cl), b1 = *(const LAS f32x4*)(bl_ + cl + 4);
#pragma unroll
            for (int ai = 0; ai < 2; ++ai)
#pragma unroll
                for (int m = 0; m < 4; ++m)
                    *(u32x2*)(YB + ((size_t)u.pm * 256 + EPI_ROWS(ai, m)) * 1024 + col) = pack8_fp8(acc[ai][bj][m][0] * (Y_SC / 64.0f) + b0 * Y_SC, acc[ai][bj][m][1] * (Y_SC / 64.0f) + b1 * Y_SC);
        }
    }
};
struct EpiPP { static constexpr bool HOOK = false; static constexpr bool CARRY = false; static DI float carry(const Unit&) { return 0.f; } static constexpr bool PERM = true;
    bf16_t* PP;
    DI void operator()(const Acc& acc, const Unit& u, int wr, int wc, int fr, int fq) const {
#pragma unroll
        for (int ai = 0; ai < 2; ++ai)
#pragma unroll
            for (int m = 0; m < 4; ++m) {
                bf16_t* rowp = PP + ((size_t)u.pm * 256 + EPI_ROWS(ai, m)) * 1024 + u.pn * 256 + 32 * wc + 8 * fq;
#pragma unroll
                for (int bj = 0; bj < 2; ++bj) *(u32x4*)(rowp + 128 * bj) = pack8(acc[ai][bj][m][0], acc[ai][bj][m][1]);
            }
    }
};
struct EpiPLE { static constexpr bool HOOK = false; static constexpr bool CARRY = false; static DI float carry(const Unit&) { return 0.f; } static constexpr bool PERM = true;
    bf16_t* H; const bf16_t* PP; float* out;
    DI void operator()(const Acc& acc, const Unit& u, int wr, int wc, int fr, int fq) const {
#pragma unroll
        for (int ai = 0; ai < 2; ++ai)
#pragma unroll
            for (int m = 0; m < 4; ++m) {
                const size_t off = (size_t)(u.pm * 256 + EPI_ROWS(ai, m)) * 1024 + u.pn * 256 + 32 * wc + 8 * fq;
#pragma unroll
                for (int bj = 0; bj < 2; ++bj) { const size_t o = off + 128 * bj;
                    const u32x4 pw = *(const u32x4*)(PP + o), hw = *(const u32x4*)(H + o); const f32x4 a0 = acc[ai][bj][m][0], a1 = acc[ai][bj][m][1];
                    f32x4 h0 = {bflo(hw.x), bfhi(hw.x), bflo(hw.y), bfhi(hw.y)}, h1 = {bflo(hw.z), bfhi(hw.z), bflo(hw.w), bfhi(hw.w)};
                    const f32x4 p0 = {bflo(pw.x), bfhi(pw.x), bflo(pw.y), bfhi(pw.y)}, p1 = {bflo(pw.z), bfhi(pw.z), bflo(pw.w), bfhi(pw.w)};
                    f32x4 e0 = a0 * (-WSC * 1.44269504089f), e1 = a1 * (-WSC * 1.44269504089f);
#pragma unroll
                    for (int j = 0; j < 4; ++j) { e0[j] = __builtin_amdgcn_exp2f(e0[j]); e1[j] = __builtin_amdgcn_exp2f(e1[j]); }
                    e0 = e0 + 1.0f; e1 = e1 + 1.0f;
#pragma unroll
                    for (int j = 0; j < 4; ++j) { e0[j] = __builtin_amdgcn_rcpf(e0[j]); e1[j] = __builtin_amdgcn_rcpf(e1[j]); }
                    h0 = h0 + e0 * p0; h1 = h1 + e1 * p1;
                    if (out) { *(f32x4*)(out + o) = h0; *(f32x4*)(out + o + 4) = h1; } else *(u32x4*)(H + o) = pack8(h0, h1);
                }
            }
    }
};

DI int vperm16(int key) { const int g = (key >> 2) & 3; const int ng = (g == 1) ? 2 : (g == 2) ? 1 : g; return (key & ~15) | (ng << 2) | (key & 3); }
template <int DV, int MODE>
DI void attn_unit(const int WID, LAS unsigned char* lds, const bf16_t* Qp, int ldq, const bf16_t* Kp, int ldk, const bf16_t* Vt, int ldvt, int q0, float slope, int dcut,
                  const unsigned* selp, bf16_t* Op, int ldo, float* impp) {
    constexpr int NRB = DV / 32;
    constexpr int KT_B = 64 * 128, VT_B = DV * 128, BUF_B = 2 * KT_B + 2 * VT_B;
    const int tid = opaque_tid(WID), w = __builtin_amdgcn_readfirstlane(tid >> 6), lane = tid & 63, r = lane & 31, hh = lane >> 5;
    const int qrow = q0 + 32 * w + r, qw_first = q0 + 32 * w, qw_last = qw_first + 31;
    const float LOG2E = 1.44269504089f;
    bf16x8 qf[4];
#pragma unroll
    for (int ks = 0; ks < 4; ++ks) qf[ks] = *(const bf16x8*)(Qp + (size_t)(32 * w + r) * ldq + 16 * ks + 8 * hh);
    unsigned selm = 0xffffffffu, orm = 0xffffffffu;
    if (MODE == 1) { selm = selp[32 * w + r]; orm = selm;
#pragma unroll
        for (int o = 1; o < 32; o <<= 1) orm |= shxu(orm, o); }
    const int nv = (MODE == 3) ? (qrow >= 31 ? ((qrow - 15) >> 4) : 0) : 0;
    const int nv_wmax = (MODE == 3) ? (qw_last >= 31 ? ((qw_last - 15) >> 4) : 0) : 0;
    int kt_lo = 0, kt_hi;
    if (MODE == 0 || MODE == 1) kt_hi = (q0 >> 6) + 4;
    else if (MODE == 2) { kt_hi = (q0 >> 6) + 4; const int lk = q0 - 511; kt_lo = lk > 0 ? (lk >> 6) : 0; }
    else kt_hi = 2;
    if (MODE != 3) { const int kmin = q0 - dcut; const int lo2 = kmin > 0 ? (kmin >> 6) : 0; kt_lo = lo2 > kt_lo ? lo2 : kt_lo; }
    f32x16 cb[2];
#pragma unroll
    for (int kk = 0; kk < 2; ++kk)
#pragma unroll
        for (int i = 0; i < 16; ++i) cb[kk][i] = (MODE == 3) ? 0.f : slope * (float)(32 * kk + 8 * (i >> 2) + (i & 3) + 4 * hh);
    f32x16 O[NRB];
#pragma unroll
    for (int rb = 0; rb < NRB; ++rb)
#pragma unroll
        for (int i = 0; i < 16; ++i) O[rb][i] = 0.f;
    float mrun = NEGF, lrun = 0.f;
    const int drow = tid >> 3, dpc = (tid & 7) ^ ((drow >> 1) & 7);
    const unsigned ldsw = (unsigned)w * 1024u;
#define AT_DMA(buf, sub, kt) do { const int kt_ = (kt) < 0 ? 0 : (kt); LAS unsigned char* b_ = lds + (buf) * BUF_B; \
        __builtin_amdgcn_global_load_lds((const unsigned*)(Kp + (size_t)(64 * kt_ + drow) * ldk + 8 * dpc), (LAS unsigned*)(b_ + (sub) * KT_B + ldsw), 16, 0, 0); \
        _Pragma("unroll") for (int i_ = 0; i_ < (DV + 63) / 64; ++i_) { if (64 * i_ + 64 <= DV || w < 4) \
            __builtin_amdgcn_global_load_lds((const unsigned*)(Vt + (size_t)(drow + 64 * i_) * ldvt + 64 * kt_ + 8 * dpc), (LAS unsigned*)(b_ + 2 * KT_B + (sub) * VT_B + i_ * 8192 + ldsw), 16, 0, 0); } } while (0)
    const int ntile = kt_hi - kt_lo, nstep = (ntile + 1) >> 1;
    AT_DMA(0, 0, kt_hi - 1); AT_DMA(0, 1, kt_hi - 2);
    asm volatile("s_waitcnt vmcnt(0)" ::: "memory");
    __syncthreads();
#if PROBE_ATT == 2
    AT_DMA(0, 0, kt_hi - 1); AT_DMA(0, 1, kt_hi - 2);
    asm volatile("s_waitcnt vmcnt(0)" ::: "memory");
    __syncthreads();
#endif
    const int sw = (r >> 1) & 7;
    for (int st = 0; st < nstep; ++st) {
        const int buf = st & 1;
        if (st + 1 < nstep) { AT_DMA(buf ^ 1, 0, kt_hi - 3 - 2 * st); AT_DMA(buf ^ 1, 1, kt_hi - 4 - 2 * st); }
#pragma unroll
        for (int sub = 0; sub < 2; ++sub) {
        const int kt = kt_hi - 1 - 2 * st - sub, key0 = 64 * kt;
        bool skip;
        if (MODE == 0) skip = key0 > qw_last;
        else if (MODE == 1) skip = (key0 > qw_last) || !((orm >> (kt & 31)) & 1u);
        else if (MODE == 2) skip = (key0 > qw_last) || (key0 + 63 < qw_first - 511);
        else skip = key0 >= nv_wmax;
        skip = skip || (kt < kt_lo);
        if (!skip) {
            const LAS unsigned char* kb = lds + buf * BUF_B + sub * KT_B; const LAS unsigned char* vb = lds + buf * BUF_B + 2 * KT_B + sub * VT_B;
            f32x16 S[2];
#pragma unroll
            for (int kk = 0; kk < 2; ++kk) {
                S[kk] = cb[kk];
#pragma unroll
                for (int ks = 0; ks < 4; ++ks) { const bf16x8 a = *(const LAS bf16x8*)(kb + (32 * kk + r) * 128 + (((2 * ks + hh) ^ sw) << 4));
                    S[kk] = __builtin_amdgcn_mfma_f32_32x32x16_bf16(a, qf[ks], S[kk], 0, 0, 0); }
            }
            const bool bnd = (MODE == 3) ? true : ((key0 + 63 > qw_first) || (MODE == 2 && key0 < qw_last - 511));
            if (bnd) {
                const int lim = (MODE == 3) ? (nv - key0 - 4 * hh) : (qrow - key0 - 4 * hh);
#pragma unroll
                for (int kk = 0; kk < 2; ++kk)
#pragma unroll
                    for (int i = 0; i < 16; ++i) { const int cki = 32 * kk + 8 * (i >> 2) + (i & 3);
                        bool valid;
                        if (MODE == 3) valid = cki < lim; else if (MODE == 2) valid = (cki <= lim) && (cki > lim - 512); else valid = cki <= lim;
                        S[kk][i] = valid ? S[kk][i] : NEGF; }
            }
            float mx = NEGF;
#pragma unroll
            for (int kk = 0; kk < 2; ++kk)
#pragma unroll
                for (int i = 0; i < 16; ++i) mx = fmaxf(mx, S[kk][i]);
            mx = fmaxf(mx, shx(mx, 32));
            const float off = (MODE == 3) ? 0.f : slope * (float)key0;
            mx += off;
            bool selok = true;
            if (MODE == 1) { selok = ((selm >> (kt & 31)) & 1u) != 0u; mx = selok ? mx : NEGF; }
            const float mnew = fmaxf(mrun, mx);
            const float meff = (mnew < -1e29f) ? 0.f : mnew;
            float c = (off - meff) * LOG2E;
            if (MODE == 1) c = selok ? c : NEGF;
#pragma unroll
            for (int kk = 0; kk < 2; ++kk) { f32x16 t = S[kk] * LOG2E + c;
#pragma unroll
                for (int i = 0; i < 16; ++i) t[i] = __builtin_amdgcn_exp2f(t[i]);
                S[kk] = t; }
            float ps;
            { typedef float f32x8 __attribute__((ext_vector_type(8)));
              const f32x16 su = S[0] + S[1];
              const f32x8 s8 = __builtin_shufflevector(su, su, 0, 1, 2, 3, 4, 5, 6, 7) + __builtin_shufflevector(su, su, 8, 9, 10, 11, 12, 13, 14, 15);
              const f32x4 s4 = __builtin_shufflevector(s8, s8, 0, 1, 2, 3) + __builtin_shufflevector(s8, s8, 4, 5, 6, 7);
              ps = (s4[0] + s4[1]) + (s4[2] + s4[3]); }
            if (__any(mnew > mrun)) {
                const float alpha = __builtin_amdgcn_exp2f((mrun - mnew) * LOG2E);
                lrun *= alpha;
#pragma unroll
                for (int rb = 0; rb < NRB; ++rb)
#pragma unroll
                    for (int i = 0; i < 16; ++i) O[rb][i] *= alpha;
            }
            mrun = mnew; lrun += ps;
#pragma unroll
            for (int kk = 0; kk < 2; ++kk)
#pragma unroll
                for (int s2 = 0; s2 < 2; ++s2) {
                    u32x4 pw; pw.x = pk2(S[kk][8 * s2 + 0], S[kk][8 * s2 + 1]); pw.y = pk2(S[kk][8 * s2 + 2], S[kk][8 * s2 + 3]);
                    pw.z = pk2(S[kk][8 * s2 + 4], S[kk][8 * s2 + 5]); pw.w = pk2(S[kk][8 * s2 + 6], S[kk][8 * s2 + 7]);
                    const bf16x8 pf = __builtin_bit_cast(bf16x8, pw);
#pragma unroll
                    for (int rb = 0; rb < NRB; ++rb) {
                        const bf16x8 a = *(const LAS bf16x8*)(vb + (32 * rb + r) * 128 + ((((2 * kk + s2) * 2 + hh) ^ sw) << 4));
                        O[rb] = __builtin_amdgcn_mfma_f32_32x32x16_bf16(a, pf, O[rb], 0, 0, 0);
                    }
                }
        }
        }
        asm volatile("s_waitcnt vmcnt(0)" ::: "memory");
        __syncthreads();
    }
#undef AT_DMA
    const float ltot = lrun + shx(lrun, 32);
    float inv = 1.0f / ltot;
    if (MODE == 3) inv = (nv > 0) ? inv : 0.f;
#if PROBE_ATT == 1
    for (int rep_ = 0; rep_ < 2; ++rep_) { asm volatile("" ::: "memory");
#endif
#pragma unroll
    for (int rb = 0; rb < NRB; ++rb)
#pragma unroll
        for (int g4 = 0; g4 < 4; ++g4) {
            const float a = O[rb][4 * g4] * inv, b = O[rb][4 * g4 + 1] * inv, c = O[rb][4 * g4 + 2] * inv, d = O[rb][4 * g4 + 3] * inv;
            const int dv = 32 * rb + 8 * g4 + 4 * hh;
            if (MODE == 3 && rb == 2) { *(f32x4*)(impp + (size_t)(32 * w + r) * 256 + (dv - 64)) = (f32x4){a, b, c, d}; }
            else { u32x2 o; o.x = pk2(a, b); o.y = pk2(c, d); *(u32x2*)(Op + (size_t)(32 * w + r) * ldo + dv) = o; }
        }
#if PROBE_ATT == 1
    }
#endif
}

DI void diff_unit(const int WID, LAS unsigned char* lds, const bf16_t* Q1p, const bf16_t* Q2p, const bf16_t* K1p, const bf16_t* K2p, const bf16_t* Vt, int q0, float slope, int dcut,
                  const float lam, const float oscale, const float* og, unsigned char* Ap) {
    constexpr int DV = 128, MODE = 0, ldq = 512, ldk = 512, ldvt = 2048;
    constexpr int NRB = DV / 32;
    constexpr int KT_B = 64 * 128, VT_B = DV * 128, BUF_B = 2 * KT_B + 2 * VT_B;
    const int tid = opaque_tid(WID), w = __builtin_amdgcn_readfirstlane(tid >> 6), lane = tid & 63, r = lane & 31, hh = lane >> 5;
    const int qrow = q0 + 32 * w + r, qw_first = q0 + 32 * w, qw_last = qw_first + 31;
    const float LOG2E = 1.44269504089f;
    unsigned selm = 0xffffffffu, orm = 0xffffffffu;
    const int nv = (MODE == 3) ? (qrow >= 31 ? ((qrow - 15) >> 4) : 0) : 0;
    const int nv_wmax = (MODE == 3) ? (qw_last >= 31 ? ((qw_last - 15) >> 4) : 0) : 0;
    int kt_lo = 0, kt_hi;
    if (MODE == 0 || MODE == 1) kt_hi = (q0 >> 6) + 4;
    else if (MODE == 2) { kt_hi = (q0 >> 6) + 4; const int lk = q0 - 511; kt_lo = lk > 0 ? (lk >> 6) : 0; }
    else kt_hi = 2;
    if (MODE != 3) { const int kmin = q0 - dcut; const int lo2 = kmin > 0 ? (kmin >> 6) : 0; kt_lo = lo2 > kt_lo ? lo2 : kt_lo; }
    f32x16 cb0;
#pragma unroll
    for (int i = 0; i < 16; ++i) cb0[i] = slope * (float)(8 * (i >> 2) + (i & 3) + 4 * hh);
    const float slope32 = 32.0f * slope;
    const int drow = tid >> 3, dpc = (tid & 7) ^ ((drow >> 1) & 7);
    const unsigned ldsw = (unsigned)w * 1024u;
#define AT_DMA(buf, sub, kt) do { const int kt_ = (kt) < 0 ? 0 : (kt); LAS unsigned char* b_ = lds + (buf) * BUF_B; \
        __builtin_amdgcn_global_load_lds((const unsigned*)(Kp + (size_t)(64 * kt_ + drow) * ldk + 8 * dpc), (LAS unsigned*)(b_ + (sub) * KT_B + ldsw), 16, 0, 0); \
        _Pragma("unroll") for (int i_ = 0; i_ < (DV + 63) / 64; ++i_) { if (64 * i_ + 64 <= DV || w < 4) \
            __builtin_amdgcn_global_load_lds((const unsigned*)(Vt + (size_t)(drow + 64 * i_) * ldvt + 64 * kt_ + 8 * dpc), (LAS unsigned*)(b_ + 2 * KT_B + (sub) * VT_B + i_ * 8192 + ldsw), 16, 0, 0); } } while (0)
    const int ntile = kt_hi - kt_lo, nstep = (ntile + 1) >> 1;
    const int sw = (r >> 1) & 7;
    u32x4 O1p[NRB][2];
#pragma unroll 1
    for (int pass = 0; pass < 2; ++pass) {
    const bf16_t* Qp = pass ? Q2p : Q1p; const bf16_t* Kp = pass ? K2p : K1p;
    bf16x8 qf[4];
#pragma unroll
    for (int ks = 0; ks < 4; ++ks) qf[ks] = *(const bf16x8*)(Qp + (size_t)(32 * w + r) * ldq + 16 * ks + 8 * hh);
    f32x16 O[NRB];
#pragma unroll
    for (int rb = 0; rb < NRB; ++rb)
#pragma unroll
        for (int i = 0; i < 16; ++i) O[rb][i] = 0.f;
    float mrun = NEGF, lrun = 0.f;
    AT_DMA(0, 0, kt_hi - 1); AT_DMA(0, 1, kt_hi - 2);
    asm volatile("s_waitcnt vmcnt(0)" ::: "memory");
    __syncthreads();
    for (int st = 0; st < nstep; ++st) {
        const int buf = st & 1;
        if (st + 1 < nstep) { AT_DMA(buf ^ 1, 0, kt_hi - 3 - 2 * st); AT_DMA(buf ^ 1, 1, kt_hi - 4 - 2 * st); }
#pragma unroll
        for (int sub = 0; sub < 2; ++sub) {
        const int kt = kt_hi - 1 - 2 * st - sub, key0 = 64 * kt;
        bool skip;
        if (MODE == 0) skip = key0 > qw_last;
        else if (MODE == 1) skip = (key0 > qw_last) || !((orm >> (kt & 31)) & 1u);
        else if (MODE == 2) skip = (key0 > qw_last) || (key0 + 63 < qw_first - 511);
        else skip = key0 >= nv_wmax;
        skip = skip || (kt < kt_lo);
        if (!skip) {
            const LAS unsigned char* kb = lds + buf * BUF_B + sub * KT_B; const LAS unsigned char* vb = lds + buf * BUF_B + 2 * KT_B + sub * VT_B;
            f32x16 S[2];
#pragma unroll
            for (int kk = 0; kk < 2; ++kk) {
                if (kk == 0) S[0] = cb0; else S[1] = cb0 + slope32;
#pragma unroll
                for (int ks = 0; ks < 4; ++ks) { const bf16x8 a = *(const LAS bf16x8*)(kb + (32 * kk + r) * 128 + (((2 * ks + hh) ^ sw) << 4));
                    S[kk] = __builtin_amdgcn_mfma_f32_32x32x16_bf16(a, qf[ks], S[kk], 0, 0, 0); }
            }
            const bool bnd = (MODE == 3) ? true : ((key0 + 63 > qw_first) || (MODE == 2 && key0 < qw_last - 511));
            if (bnd) {
                const int lim = (MODE == 3) ? (nv - key0 - 4 * hh) : (qrow - key0 - 4 * hh);
#pragma unroll
                for (int kk = 0; kk < 2; ++kk)
#pragma unroll
                    for (int i = 0; i < 16; ++i) { const int cki = 32 * kk + 8 * (i >> 2) + (i & 3);
                        bool valid;
                        if (MODE == 3) valid = cki < lim; else if (MODE == 2) valid = (cki <= lim) && (cki > lim - 512); else valid = cki <= lim;
                        S[kk][i] = valid ? S[kk][i] : NEGF; }
            }
            float mx = NEGF;
#pragma unroll
            for (int kk = 0; kk < 2; ++kk)
#pragma unroll
                for (int i = 0; i < 16; ++i) mx = fmaxf(mx, S[kk][i]);
            mx = fmaxf(mx, shx(mx, 32));
            const float off = (MODE == 3) ? 0.f : slope * (float)key0;
            mx += off;
            bool selok = true;
            if (MODE == 1) { selok = ((selm >> (kt & 31)) & 1u) != 0u; mx = selok ? mx : NEGF; }
            const float mnew = fmaxf(mrun, mx);
            const float meff = (mnew < -1e29f) ? 0.f : mnew;
            float c = (off - meff) * LOG2E;
            if (MODE == 1) c = selok ? c : NEGF;
#pragma unroll
            for (int kk = 0; kk < 2; ++kk) { f32x16 t = S[kk] * LOG2E + c;
#pragma unroll
                for (int i = 0; i < 16; ++i) t[i] = __builtin_amdgcn_exp2f(t[i]);
                S[kk] = t; }
            float ps;
            { typedef float f32x8 __attribute__((ext_vector_type(8)));
              const f32x16 su = S[0] + S[1];
              const f32x8 s8 = __builtin_shufflevector(su, su, 0, 1, 2, 3, 4, 5, 6, 7) + __builtin_shufflevector(su, su, 8, 9, 10, 11, 12, 13, 14, 15);
              const f32x4 s4 = __builtin_shufflevector(s8, s8, 0, 1, 2, 3) + __builtin_shufflevector(s8, s8, 4, 5, 6, 7);
              ps = (s4[0] + s4[1]) + (s4[2] + s4[3]); }
            if (__any(mnew > mrun)) {
                const float alpha = __builtin_amdgcn_exp2f((mrun - mnew) * LOG2E);
                lrun *= alpha;
#pragma unroll
                for (int rb = 0; rb < NRB; ++rb)
#pragma unroll
                    for (int i = 0; i < 16; ++i) O[rb][i] *= alpha;
            }
            mrun = mnew; lrun += ps;
#pragma unroll
            for (int kk = 0; kk < 2; ++kk)
#pragma unroll
                for (int s2 = 0; s2 < 2; ++s2) {
                    u32x4 pw; pw.x = pk2(S[kk][8 * s2 + 0], S[kk][8 * s2 + 1]); pw.y = pk2(S[kk][8 * s2 + 2], S[kk][8 * s2 + 3]);
                    pw.z = pk2(S[kk][8 * s2 + 4], S[kk][8 * s2 + 5]); pw.w = pk2(S[kk][8 * s2 + 6], S[kk][8 * s2 + 7]);
                    const bf16x8 pf = __builtin_bit_cast(bf16x8, pw);
#pragma unroll
                    for (int rb = 0; rb < NRB; ++rb) {
                        const bf16x8 a = *(const LAS bf16x8*)(vb + (32 * rb + r) * 128 + ((((2 * kk + s2) * 2 + hh) ^ sw) << 4));
                        O[rb] = __builtin_amdgcn_mfma_f32_32x32x16_bf16(a, pf, O[rb], 0, 0, 0);
                    }
                }
        }
        }
        asm volatile("s_waitcnt vmcnt(0)" ::: "memory");
        __syncthreads();
    }
#undef AT_DMA
    const float ltot = lrun + shx(lrun, 32);
    const float inv = 1.0f / ltot;
    if (pass == 0) {
#pragma unroll
        for (int rb = 0; rb < NRB; ++rb) { const f32x16 on = O[rb] * inv;
            O1p[rb][0] = (u32x4){pk2(on[0], on[1]), pk2(on[2], on[3]), pk2(on[4], on[5]), pk2(on[6], on[7])};
            O1p[rb][1] = (u32x4){pk2(on[8], on[9]), pk2(on[10], on[11]), pk2(on[12], on[13]), pk2(on[14], on[15])}; }
    } else {
        const float li = lam * inv; float ss = 0.f;
#pragma unroll
        for (int rb = 0; rb < NRB; ++rb) {
            const u32x4 p0 = O1p[rb][0], p1 = O1p[rb][1];
            const f32x16 o1 = {bflo(p0.x), bfhi(p0.x), bflo(p0.y), bfhi(p0.y), bflo(p0.z), bfhi(p0.z), bflo(p0.w), bfhi(p0.w), bflo(p1.x), bfhi(p1.x), bflo(p1.y), bfhi(p1.y), bflo(p1.z), bfhi(p1.z), bflo(p1.w), bfhi(p1.w)};
            O[rb] = o1 - O[rb] * li;
#pragma unroll
            for (int i = 0; i < 16; ++i) ss += O[rb][i] * O[rb][i];
        }
        ss += shx(ss, 32);
        const float rs = rsqrtf(ss * (1.0f / 128.0f) + EPS) * (oscale * A_SC);
        const int hg_ = lane_now() >> 5;
#pragma unroll
        for (int rb = 0; rb < NRB; ++rb)
#pragma unroll
            for (int g4 = 0; g4 < 4; ++g4) { const int dv = 32 * rb + 8 * g4 + 4 * hh; const f32x4 gg = *(const f32x4*)(og + 32 * rb + 8 * g4 + 4 * hg_);
                *(unsigned*)(Ap + (size_t)(32 * w + r) * 1024 + dv) = pk4_fp8(O[rb][4 * g4] * rs * gg[0], O[rb][4 * g4 + 1] * rs * gg[1], O[rb][4 * g4 + 2] * rs * gg[2], O[rb][4 * g4 + 3] * rs * gg[3]); }
    }
    }
}

template <int DV, int MODE>
DI void nsa_unit(const int WID, LAS unsigned char* lds, const bf16x8 (&qf)[4], const bf16_t* Kp, int ldk, const bf16_t* Vt, int ldvt, int q0, int g, float sb2,
                 const LAS unsigned* selp, f32x16 (&OB)[2], const float gate, LAS float* impp) {
    constexpr int NRB = DV / 32;
    constexpr int KT_B = 64 * 128, VT_B = DV * 128, BUF_B = 2 * KT_B + 2 * VT_B;
    const int tid = opaque_tid(WID), w = __builtin_amdgcn_readfirstlane(tid >> 6), lane = tid & 63, r = lane & 31, hh = lane >> 5;
    const int hr = w >> 1, qh = w & 1;
    const float slope = (MODE == 1) ? exp2f(-(float)(4 * g + hr + 1)) : 0.f;
    const int dcut = (MODE == 1) ? (int)fminf(sb2 / slope + 1.0f, 100000.0f) : 0, dcut_max = (MODE == 1) ? (int)fminf(sb2 * exp2f((float)(4 * g + 4)) + 1.0f, 100000.0f) : 0;
    const int qrow = q0 + 32 * qh + r, qw_first = q0 + 32 * qh, qw_last = qw_first + 31;
    const float LOG2E = 1.44269504089f;
    unsigned selm = 0xffffffffu, orm = 0xffffffffu;
    if (MODE == 1) { selm = selp[32 * qh + r]; orm = selm;
#pragma unroll
        for (int o = 1; o < 32; o <<= 1) orm |= shxu(orm, o); }
    const int nv = (MODE == 3) ? (qrow >= 31 ? ((qrow - 15) >> 4) : 0) : 0;
    const int nv_wmax = (MODE == 3) ? (qw_last >= 31 ? ((qw_last - 15) >> 4) : 0) : 0;
    int kt_lo = 0, kt_hi;
    if (MODE == 1) kt_hi = (q0 >> 6) + 1; else kt_hi = 2;
    if (MODE != 3) { const int kmin = q0 - dcut_max; const int lo2 = kmin > 0 ? (kmin >> 6) : 0; kt_lo = lo2 > kt_lo ? lo2 : kt_lo; }
    f32x16 cb[2];
#pragma unroll
    for (int kk = 0; kk < 2; ++kk)
#pragma unroll
        for (int i = 0; i < 16; ++i) cb[kk][i] = (MODE == 3) ? 0.f : slope * (float)(32 * kk + 8 * (i >> 2) + (i & 3) + 4 * hh);
    f32x16 O[NRB];
#pragma unroll
    for (int rb = 0; rb < NRB; ++rb)
#pragma unroll
        for (int i = 0; i < 16; ++i) O[rb][i] = 0.f;
    float mrun = NEGF, lrun = 0.f;
    const int drow = tid >> 3, dpc = (tid & 7) ^ ((drow >> 1) & 7);
    const unsigned ldsw = (unsigned)w * 1024u;
#define AT_DMA(buf, sub, kt) do { const int kt_ = (kt) < 0 ? 0 : (kt); LAS unsigned char* b_ = lds + (buf) * BUF_B; \
        __builtin_amdgcn_global_load_lds((const unsigned*)(Kp + (size_t)(64 * kt_ + drow) * ldk + 8 * dpc), (LAS unsigned*)(b_ + (sub) * KT_B + ldsw), 16, 0, 0); \
        _Pragma("unroll") for (int i_ = 0; i_ < (DV + 63) / 64; ++i_) { if (64 * i_ + 64 <= DV || w < 4) \
            __builtin_amdgcn_global_load_lds((const unsigned*)(Vt + (size_t)(drow + 64 * i_) * ldvt + 64 * kt_ + 8 * dpc), (LAS unsigned*)(b_ + 2 * KT_B + (sub) * VT_B + i_ * 8192 + ldsw), 16, 0, 0); } } while (0)
    const int ntile = kt_hi - kt_lo, nstep = (ntile + 1) >> 1;
    AT_DMA(0, 0, kt_hi - 1); AT_DMA(0, 1, kt_hi - 2);
    asm volatile("s_waitcnt vmcnt(0)" ::: "memory");
    __syncthreads();
    const int sw = (r >> 1) & 7;
    for (int st = 0; st < nstep; ++st) {
        const int buf = st & 1;
        if (st + 1 < nstep) { AT_DMA(buf ^ 1, 0, kt_hi - 3 - 2 * st); AT_DMA(buf ^ 1, 1, kt_hi - 4 - 2 * st); }
#pragma unroll
        for (int sub = 0; sub < 2; ++sub) {
        const int kt = kt_hi - 1 - 2 * st - sub, key0 = 64 * kt;
        bool skip;
        if (MODE == 0) skip = key0 > qw_last;
        else if (MODE == 1) skip = (key0 > qw_last) || !((orm >> (kt & 31)) & 1u) || (key0 + 63 < qw_first - dcut);
        else if (MODE == 2) skip = (key0 > qw_last) || (key0 + 63 < qw_first - 511);
        else skip = key0 >= nv_wmax;
        skip = skip || (kt < kt_lo);
        if (!skip) {
            const LAS unsigned char* kb = lds + buf * BUF_B + sub * KT_B; const LAS unsigned char* vb = lds + buf * BUF_B + 2 * KT_B + sub * VT_B;
            f32x16 S[2];
#pragma unroll
            for (int kk = 0; kk < 2; ++kk) {
                S[kk] = cb[kk];
#pragma unroll
                for (int ks = 0; ks < 4; ++ks) { const bf16x8 a = *(const LAS bf16x8*)(kb + (32 * kk + r) * 128 + (((2 * ks + hh) ^ sw) << 4));
                    S[kk] = __builtin_amdgcn_mfma_f32_32x32x16_bf16(a, qf[ks], S[kk], 0, 0, 0); }
            }
            const bool bnd = (MODE == 3) ? true : ((key0 + 63 > qw_first) || (MODE == 2 && key0 < qw_last - 511));
            if (bnd) {
                const int lim = (MODE == 3) ? (nv - key0 - 4 * hh) : (qrow - key0 - 4 * hh);
#pragma unroll
                for (int kk = 0; kk < 2; ++kk)
#pragma unroll
                    for (int i = 0; i < 16; ++i) { const int cki = 32 * kk + 8 * (i >> 2) + (i & 3);
                        bool valid;
                        if (MODE == 3) valid = cki < lim; else if (MODE == 2) valid = (cki <= lim) && (cki > lim - 512); else valid = cki <= lim;
                        S[kk][i] = valid ? S[kk][i] : NEGF; }
            }
            float mx = NEGF;
#pragma unroll
            for (int kk = 0; kk < 2; ++kk)
#pragma unroll
                for (int i = 0; i < 16; ++i) mx = fmaxf(mx, S[kk][i]);
            mx = fmaxf(mx, shx(mx, 32));
            const float off = (MODE == 3) ? 0.f : slope * (float)key0;
            mx += off;
            bool selok = true;
            if (MODE == 1) { selok = ((selm >> (kt & 31)) & 1u) != 0u; mx = selok ? mx : NEGF; }
            const float mnew = fmaxf(mrun, mx);
            const float meff = (mnew < -1e29f) ? 0.f : mnew;
            float c = (off - meff) * LOG2E;
            if (MODE == 1) c = selok ? c : NEGF;
#pragma unroll
            for (int kk = 0; kk < 2; ++kk) { f32x16 t = S[kk] * LOG2E + c;
#pragma unroll
                for (int i = 0; i < 16; ++i) t[i] = __builtin_amdgcn_exp2f(t[i]);
                S[kk] = t; }
            float ps;
            { typedef float f32x8 __attribute__((ext_vector_type(8)));
              const f32x16 su = S[0] + S[1];
              const f32x8 s8 = __builtin_shufflevector(su, su, 0, 1, 2, 3, 4, 5, 6, 7) + __builtin_shufflevector(su, su, 8, 9, 10, 11, 12, 13, 14, 15);
              const f32x4 s4 = __builtin_shufflevector(s8, s8, 0, 1, 2, 3) + __builtin_shufflevector(s8, s8, 4, 5, 6, 7);
              ps = (s4[0] + s4[1]) + (s4[2] + s4[3]); }
            if (__any(mnew > mrun)) {
                const float alpha = __builtin_amdgcn_exp2f((mrun - mnew) * LOG2E);
                lrun *= alpha;
#pragma unroll
                for (int rb = 0; rb < NRB; ++rb)
#pragma unroll
                    for (int i = 0; i < 16; ++i) O[rb][i] *= alpha;
            }
            mrun = mnew; lrun += ps;
#pragma unroll
            for (int kk = 0; kk < 2; ++kk)
#pragma unroll
                for (int s2 = 0; s2 < 2; ++s2) {
                    u32x4 pw; pw.x = pk2(S[kk][8 * s2 + 0], S[kk][8 * s2 + 1]); pw.y = pk2(S[kk][8 * s2 + 2], S[kk][8 * s2 + 3]);
                    pw.z = pk2(S[kk][8 * s2 + 4], S[kk][8 * s2 + 5]); pw.w = pk2(S[kk][8 * s2 + 6], S[kk][8 * s2 + 7]);
                    const bf16x8 pf = __builtin_bit_cast(bf16x8, pw);
#pragma unroll
                    for (int rb = 0; rb < NRB; ++rb) {
                        const bf16x8 a = *(const LAS bf16x8*)(vb + (32 * rb + r) * 128 + ((((2 * kk + s2) * 2 + hh) ^ sw) << 4));
                        O[rb] = __builtin_amdgcn_mfma_f32_32x32x16_bf16(a, pf, O[rb], 0, 0, 0);
                    }
                }
        }
        }
        asm volatile("s_waitcnt vmcnt(0)" ::: "memory");
        __syncthreads();
    }
#undef AT_DMA
    const float ltot = lrun + shx(lrun, 32);
    float inv = 1.0f / ltot;
    if (MODE == 3) inv = (nv > 0) ? inv : 0.f;
    const float gi = inv * gate;
#pragma unroll
    for (int rb = 0; rb < 2; ++rb) OB[rb] += O[rb] * gi;
    if (MODE == 3) {
#pragma unroll
        for (int g4 = 0; g4 < 4; ++g4)
            *(LAS f32x4*)(impp + (hr * 64 + 32 * qh + r) * 32 + 8 * g4 + 4 * hh) = (f32x4){O[2][4 * g4] * inv, O[2][4 * g4 + 1] * inv, O[2][4 * g4 + 2] * inv, O[2][4 * g4 + 3] * inv};
    }
}


struct Args { const float* in[26]; float* out; unsigned char* ws; int ph_lo, ph_hi; };
typedef const __attribute__((address_space(4))) Args* ArgsP;
DI ArgsP opaque_args() { auto p = __builtin_amdgcn_kernarg_segment_ptr(); asm volatile("" : "+s"(p)); return (ArgsP)p; }
enum { I_X = 0, I_P, I_N1G, I_N2G, I_EVWIN, I_EVWOUT, I_DAQN, I_DAKN, I_DALAM, I_DAOUTG, I_NSQN, I_NSKN, I_CMPPE, I_CMPW1, I_CMPW2, I_ODWIN, I_ODWOUT,
       I_RETG, I_ROUTW, I_ROUTB, I_WGU, I_BGU, I_WDN, I_BDN, I_PLEP, I_PLEG };

struct CvtJob { int in_idx, ldsrc, K, col0, ncols, dstrow0, perm, nmat; size_t src_stride, dst_off, dst_stride; int fp8, pad; };
constexpr int NJOBS = 19;
__constant__ CvtJob c_jobs[NJOBS] = {
    {I_EVWIN, EVIN, 1024, 0,    1024, 0,    1, 2, (size_t)1024 * EVIN, WS_EVNAT, (size_t)2048 * 1024, 0, 0},
    {I_EVWIN, EVIN, 1024, 1536, 512,  1024, 1, 2, (size_t)1024 * EVIN, WS_EVNAT, (size_t)2048 * 1024, 0, 0},
    {I_EVWIN, EVIN, 1024, 2048, 128,  1536, 1, 2, (size_t)1024 * EVIN, WS_EVNAT, (size_t)2048 * 1024, 0, 0},
    {I_EVWIN, EVIN, 1024, 2176, 128,  1664, 1, 2, (size_t)1024 * EVIN, WS_EVNAT, (size_t)2048 * 1024, 0, 0},
    {I_EVWIN, EVIN, 1024, 2304, 128,  1792, 1, 2, (size_t)1024 * EVIN, WS_EVNAT, (size_t)2048 * 1024, 0, 0},
    {I_EVWIN, EVIN, 1024, 2560, 128,  1920, 1, 2, (size_t)1024 * EVIN, WS_EVNAT, (size_t)2048 * 1024, 0, 0},
    {I_EVWIN, EVIN, 1024, 1024, 512,  0,    0, 2, (size_t)1024 * EVIN, WS_EVSW,  (size_t)768 * 1024, 0, 0},
    {I_EVWIN, EVIN, 1024, 2432, 128,  512,  0, 2, (size_t)1024 * EVIN, WS_EVSW,  (size_t)768 * 1024, 0, 0},
    {I_EVWIN, EVIN, 1024, 2688, 128,  640,  0, 2, (size_t)1024 * EVIN, WS_EVSW,  (size_t)768 * 1024, 0, 0},
    {I_EVWOUT, 1024, 1024, 0, 1024, 0, 0, 2, (size_t)1024 * 1024, WS_EVOUT, (size_t)1024 * 1024, 64, 0},
    {I_CMPW1, 256, 2048, 0, 256, 0, 0, 4, (size_t)2048 * 256, WS_CMP1, (size_t)256 * 2048, 0, 0},
    {I_ODWIN, ODIN, 1024, 0,    2048, 0,    0, 2, (size_t)1024 * ODIN, WS_ODNAT, (size_t)4096 * 1024, 32, 0},
    {I_ODWIN, ODIN, 1024, 4096, 2048, 2048, 0, 2, (size_t)1024 * ODIN, WS_ODNAT, (size_t)4096 * 1024, 32, 0},
    {I_ODWIN, ODIN, 1024, 2048, 2048, 0,    0, 2, (size_t)1024 * ODIN, WS_ODSW,  (size_t)2048 * 1024, 32, 0},
    {I_ODWOUT, 1024, 2048, 0, 1024, 0, 0, 2, (size_t)2048 * 1024, WS_ODOUT, (size_t)1024 * 2048, 128, 0},
    {I_WGU, 2048, 1024, 0, 2048, 0, 2, 128, (size_t)1024 * 2048, WS_WGU, (size_t)2048 * 1024, 32, 0},
    {I_WDN, 1024, 1024, 0, 1024, 0, 0, 128, (size_t)1024 * 1024, WS_WDN, (size_t)1024 * 1024, 64, 0},
    {I_PLEP, 1024, 256, 0, 1024, 0, 0, 4, (size_t)256 * 1024, WS_WPP, (size_t)1024 * 256, 0, 0},
    {I_PLEG, 1024, 1024, 0, 1024, 0, 0, 4, (size_t)1024 * 1024, WS_WPG, (size_t)1024 * 1024, 32, 0},
};
DI int cvt_dstrow(int perm, int L) {
    if (perm == 1) { const int pn = L >> 8, lc = L & 255; return pn * 256 + 128 * ((lc & 63) >> 5) + 32 * (lc >> 6) + (lc & 31); }
    if (perm == 2) { const int bj = L >> 10, cc = L & 1023; return 256 * (cc >> 7) + 128 * bj + (cc & 127); }
    return L;
}
DI void phase_prologue(const int WID, ArgsP a, LAS unsigned char* lds) {
    const int tid = opaque_tid(WID), lane = tid & 63, wv = tid >> 6;
    const int gw = blockIdx.x * 8 + wv, NGW = gridDim.x * 8;
    LAS float* scr = (LAS float*)(lds + wv * 16896);
    int total = 0;
    for (int j = 0; j < NJOBS; ++j) total += c_jobs[j].nmat * (c_jobs[j].K >> 6) * (c_jobs[j].ncols >> 6);
#define PRO_DECODE(IT, JJ, MAT, K0, N0, SRC, RS) do { int r_ = (IT), j_ = 0; \
        for (; j_ < NJOBS; ++j_) { const int n_ = c_jobs[j_].nmat * (c_jobs[j_].K >> 6) * (c_jobs[j_].ncols >> 6); if (r_ < n_) break; r_ -= n_; } \
        JJ = j_; const bool f8_ = c_jobs[j_].fp8 != 0; const int nkb_ = f8_ ? (c_jobs[j_].K >> 7) : (c_jobs[j_].K >> 6), nnb_ = f8_ ? (c_jobs[j_].ncols >> 5) : (c_jobs[j_].ncols >> 6), per_ = nkb_ * nnb_; \
        MAT = r_ / per_; const int rr_ = r_ % per_; K0 = (rr_ / nnb_) * (f8_ ? 128 : 64); N0 = (rr_ % nnb_) * (f8_ ? 32 : 64); const int ld_ = c_jobs[j_].ldsrc; \
        SRC = a->in[c_jobs[j_].in_idx] + (size_t)MAT * c_jobs[j_].src_stride + (size_t)K0 * ld_ + c_jobs[j_].col0 + N0 + (f8_ ? (lane & 31) + (lane >> 5) * ld_ : lane); RS = f8_ ? 2 * ld_ : ld_; } while (0)
    float tv[64];
    int jn = 0, matn = 0, k0n = 0, n0n = 0, rsn = 0; const float* srcn = nullptr;
    if (gw < total) { PRO_DECODE(gw, jn, matn, k0n, n0n, srcn, rsn);
#pragma unroll
        for (int i = 0; i < 64; ++i) tv[i] = srcn[(size_t)i * rsn]; }
    for (int it = gw; it < total; it += NGW) {
        const CvtJob J = c_jobs[jn]; const int mat = matn, k0 = k0n, n0 = n0n;
        { const int wb = J.fp8 ? (lane >> 5) * 33 + (lane & 31) : lane, wst = J.fp8 ? 66 : 65;
#pragma unroll
          for (int i = 0; i < 64; ++i) scr[wb + i * wst] = tv[i]; }
        if (it + NGW < total) { PRO_DECODE(it + NGW, jn, matn, k0n, n0n, srcn, rsn);
#if PROBE_PRO == 2
            { float sink = 0.f;
#pragma unroll
              for (int i = 0; i < 64; ++i) sink += ((const volatile float*)srcn)[(size_t)i * rsn];
              asm volatile("" :: "v"(sink)); }
#endif
#pragma unroll
            for (int i = 0; i < 64; ++i) tv[i] = srcn[(size_t)i * rsn]; }
        asm volatile("s_waitcnt lgkmcnt(0)" ::: "memory");
        if (J.fp8) {
            unsigned char* dst = (unsigned char*)(a->ws + J.dst_off) + (size_t)mat * J.dst_stride;
            const int c = lane & 7, nsub = lane >> 3; const float W8_S = (float)J.fp8;
#pragma unroll
            for (int jj = 0; jj < 4; ++jj) {
                const int n = nsub + 8 * jj; const LAS float* s = scr + (16 * c) * 33 + n;
                u32x4 o;
                o.x = pk4_fp8(s[0] * W8_S, s[33] * W8_S, s[2 * 33] * W8_S, s[3 * 33] * W8_S); o.y = pk4_fp8(s[4 * 33] * W8_S, s[5 * 33] * W8_S, s[6 * 33] * W8_S, s[7 * 33] * W8_S);
                o.z = pk4_fp8(s[8 * 33] * W8_S, s[9 * 33] * W8_S, s[10 * 33] * W8_S, s[11 * 33] * W8_S); o.w = pk4_fp8(s[12 * 33] * W8_S, s[13 * 33] * W8_S, s[14 * 33] * W8_S, s[15 * 33] * W8_S);
                const int drow = cvt_dstrow(J.perm, J.dstrow0 + n0 + n);
                *(u32x4*)(dst + (size_t)drow * J.K + k0 + 16 * c) = o;
#if PROBE_PRO == 1
                asm volatile("" ::: "memory"); *(u32x4*)(dst + (size_t)drow * J.K + k0 + 16 * c) = o;
#endif
            }
        } else {
            bf16_t* dst = (bf16_t*)(a->ws + J.dst_off) + (size_t)mat * J.dst_stride;
            const int c = lane & 7, nsub = lane >> 3;
#pragma unroll
            for (int jj = 0; jj < 8; ++jj) {
                const int n = nsub + 8 * jj; const LAS float* s = scr + (8 * c) * 65 + n;
                u32x4 o; o.x = pk2(s[0], s[65]); o.y = pk2(s[2 * 65], s[3 * 65]); o.z = pk2(s[4 * 65], s[5 * 65]); o.w = pk2(s[6 * 65], s[7 * 65]);
                const int drow = cvt_dstrow(J.perm, J.dstrow0 + n0 + n);
                *(u32x4*)(dst + (size_t)drow * J.K + k0 + 8 * c) = o;
#if PROBE_PRO == 1
                asm volatile("" ::: "memory"); *(u32x4*)(dst + (size_t)drow * J.K + k0 + 8 * c) = o;
#endif
            }
        }
        asm volatile("s_waitcnt lgkmcnt(0)" ::: "memory");
    }
#undef PRO_DECODE
    {
        const float* p = a->in[I_P]; bf16_t* pb = (bf16_t*)(a->ws + WS_PBF);
        const size_t n8 = (size_t)DEPTH * T * 256 / 8;
        const size_t st = (size_t)gridDim.x * 512;
        size_t i = (size_t)blockIdx.x * 512 + tid;
        for (; i + 3 * st < n8; i += 4 * st) {
            f32x4 v[4][2];
#pragma unroll
            for (int u = 0; u < 4; ++u) { v[u][0] = *(const f32x4*)(p + (i + u * st) * 8); v[u][1] = *(const f32x4*)(p + (i + u * st) * 8 + 4); }
#pragma unroll
            for (int u = 0; u < 4; ++u) *(u32x4*)(pb + (i + u * st) * 8) = pack8(v[u][0], v[u][1]);
        }
        for (; i < n8; i += st) { const f32x4 v0 = *(const f32x4*)(p + i * 8), v1 = *(const f32x4*)(p + i * 8 + 4); *(u32x4*)(pb + i * 8) = pack8(v0, v1); }
    }
    if (blockIdx.x == 4 && tid < 512) { const int ev = tid >> 8, gi = (tid >> 6) & 3, d = tid & 63;
        const float* src = a->in[gi == 0 ? I_DAQN : gi == 1 ? I_DAKN : gi == 2 ? I_NSQN : I_NSKN];
        ((float*)(a->ws + WS_GAINS))[tid] = src[ev * 64 + d]; }
    if (blockIdx.x < 4 && tid < 256) {
        const int m = blockIdx.x; const float* pe = a->in[I_CMPPE] + (size_t)m * 2048; const float* w1 = a->in[I_CMPW1] + (size_t)m * 2048 * 256;
        float s = 0.f;
        for (int k = 0; k < 2048; ++k) s += pe[k] * w1[(size_t)k * 256 + tid];
        ((float*)(a->ws + WS_BIAS1))[m * 256 + tid] = s;
    }
}

DI float row_load_ss(const float* row, int lane, f32x4 (&v)[4]) {
    float ss = 0.f;
#pragma unroll
    for (int j = 0; j < 4; ++j) { v[j] = *(const f32x4*)(row + 4 * lane + 256 * j); ss += (v[j][0] * v[j][0] + v[j][1] * v[j][1]) + (v[j][2] * v[j][2] + v[j][3] * v[j][3]); }
    return wave_sum(ss);
}
DI void row_store_bf16(bf16_t* row, int lane, const f32x4 (&v)[4]) {
#pragma unroll
    for (int j = 0; j < 4; ++j) { u32x2 o; o.x = pk2(v[j][0], v[j][1]); o.y = pk2(v[j][2], v[j][3]); *(u32x2*)(row + 4 * lane + 256 * j) = o; }
}
template <int MODE>
DI void phase_norm(const int WID, ArgsP a, LAS unsigned char* lds, int layer, const void* Hin, const bool hb) {
    const int tid = opaque_tid(WID), lane = tid & 63, wv = __builtin_amdgcn_readfirstlane(tid >> 6);
    LAS float* wt = (LAS float*)lds;
    LAS int* bcl = (LAS int*)(lds + MISC_OFF + MO_WCNT); LAS int* ent = (LAS int*)(lds + MISC_OFF + MO_ENT); LAS float* gat = (LAS float*)(lds + MISC_OFF + MO_GAT);
    LAS float* lgb = (LAS float*)(lds + MISC_OFF + MO_RED);
    bf16_t* XN = (bf16_t*)(a->ws + WS_XN);
    const float* gain = a->in[MODE == 2 ? I_N2G : I_N1G] + layer * 1024;
    constexpr int NQ = MODE == 0 ? 24 : (MODE == 2 ? 32 : 0);
    if (NQ > 0) {
        const float* w = (MODE == 0) ? a->in[I_EVWIN] + (size_t)(layer >> 1) * 1024 * EVIN + 2816 : a->in[I_ROUTW] + (size_t)layer * 1024 * 32;
        const int ldw = (MODE == 0) ? EVIN : 32;
        for (int i = tid; i < 256 * 32; i += 512) { const int q = i & 31, g = i >> 5;
            if (q < NQ) { f32x4 v; v[0] = w[(size_t)(4 * g) * ldw + q]; v[1] = w[(size_t)(4 * g + 1) * ldw + q]; v[2] = w[(size_t)(4 * g + 2) * ldw + q]; v[3] = w[(size_t)(4 * g + 3) * ldw + q];
                *(LAS f32x4*)(wt + q * 1024 + 4 * (g ^ q)) = v; } }
    }
    f32x4 gn[4];
#pragma unroll
    for (int j = 0; j < 4; ++j) gn[j] = *(const f32x4*)(gain + 4 * lane + 256 * j);
    const float rbias = (MODE == 2) ? a->in[I_ROUTB][layer * 32 + (lane & 31)] : 0.f;
    __syncthreads();
    for (int vb = blockIdx.x; vb < NTB; vb += gridDim.x) {
        if (MODE == 2) { if (tid < 32) bcl[tid] = 0; }
        const int t0 = vb * 128 + wv * 16;
        f32x4 na[4], nb[4];
#pragma unroll
        for (int j = 0; j < 4; ++j) { na[j] = ld_h4(Hin, hb, (size_t)t0 * 1024 + 4 * lane + 256 * j); nb[j] = ld_h4(Hin, hb, (size_t)(t0 + 1) * 1024 + 4 * lane + 256 * j); }
#pragma unroll 1
        for (int it = 0; it < 8; ++it) {
            const int ta = t0 + 2 * it;
            f32x4 va[4], vc[4];
#pragma unroll
            for (int j = 0; j < 4; ++j) { va[j] = na[j]; vc[j] = nb[j]; }
            if (it < 7) {
#pragma unroll
                for (int j = 0; j < 4; ++j) { na[j] = ld_h4(Hin, hb, (size_t)(ta + 2) * 1024 + 4 * lane + 256 * j); nb[j] = ld_h4(Hin, hb, (size_t)(ta + 3) * 1024 + 4 * lane + 256 * j); }
            }
            float sa = 0.f, sb = 0.f;
#pragma unroll
            for (int j = 0; j < 4; ++j) { sa += (va[j][0] * va[j][0] + va[j][1] * va[j][1]) + (va[j][2] * va[j][2] + va[j][3] * va[j][3]); sb += (vc[j][0] * vc[j][0] + vc[j][1] * vc[j][1]) + (vc[j][2] * vc[j][2] + vc[j][3] * vc[j][3]); }
#pragma unroll
            for (int o = 1; o < 64; o <<= 1) { sa += shxl(sa, o, lane); sb += shxl(sb, o, lane); }
            const float ra = rsqrtf(sa * (1.0f / 1024.0f) + EPS), rb2 = rsqrtf(sb * (1.0f / 1024.0f) + EPS);
#pragma unroll
            for (int j = 0; j < 4; ++j) { va[j] = va[j] * ra * gn[j]; vc[j] = vc[j] * rb2 * gn[j]; }
            if (MODE == 1) {
                unsigned char* X8 = (unsigned char*)XN;
#pragma unroll
                for (int j = 0; j < 4; ++j) { *(unsigned*)(X8 + (size_t)ta * 1024 + 4 * lane + 256 * j) = pk4_fp8(va[j][0], va[j][1], va[j][2], va[j][3]);
                    *(unsigned*)(X8 + (size_t)(ta + 1) * 1024 + 4 * lane + 256 * j) = pk4_fp8(vc[j][0], vc[j][1], vc[j][2], vc[j][3]); }
            } else { row_store_bf16(XN + (size_t)ta * 1024, lane, va); row_store_bf16(XN + (size_t)(ta + 1) * 1024, lane, vc); }
            if (NQ > 0) {
                float x[64];
#pragma unroll
                for (int q = 0; q < 32; ++q) {
                    if (q < NQ) { f32x4 a0 = {0.f, 0.f, 0.f, 0.f}, a1 = a0;
#pragma unroll
                        for (int j = 0; j < 4; ++j) { const f32x4 ww = *(const LAS f32x4*)(wt + q * 1024 + 4 * ((lane + 64 * j) ^ q)); a0 += va[j] * ww; a1 += vc[j] * ww; }
                        x[q] = (a0[0] + a0[1]) + (a0[2] + a0[3]); x[32 + q] = (a1[0] + a1[1]) + (a1[2] + a1[3]);
                        if ((q & 3) == 3) asm volatile("" ::: "memory");
                    } else { x[q] = 0.f; x[32 + q] = 0.f; }
                }
#define RS_STEP(N, BIT) _Pragma("unroll") for (int i = 0; i < (N); ++i) { const bool up = (lane & (BIT)) != 0; const float keep = up ? x[(N) + i] : x[i], send = up ? x[i] : x[(N) + i]; x[i] = keep + shxl(send, (BIT), lane); }
                RS_STEP(32, 32) RS_STEP(16, 16) RS_STEP(8, 8) RS_STEP(4, 4) RS_STEP(2, 2) RS_STEP(1, 1)
#undef RS_STEP
                const float val = x[0];
                if (MODE == 0) { if ((lane & 31) < 24) ((float*)(a->ws + WS_GATES))[(size_t)(ta + (lane >> 5)) * 24 + (lane & 31)] = sigm(val); }
                if (MODE == 2) {
                    const float myv = val + rbias; const int mye = lane & 31;
                    lgb[wv * 64 + lane] = myv;
                    asm volatile("s_waitcnt lgkmcnt(0)" ::: "memory");
                    int rank = 0;
#pragma unroll
                    for (int q4 = 0; q4 < 8; ++q4) { const f32x4 t4 = *(const LAS f32x4*)(lgb + wv * 64 + (lane & 32) + 4 * q4);
#pragma unroll
                        for (int e = 0; e < 4; ++e) { const int j = 4 * q4 + e; rank += ((t4[e] > myv) || (t4[e] == myv && j < mye)) ? 1 : 0; } }
                    const int eb = wv * 64 + (2 * it + (lane >> 5)) * 4;
                    if (rank < 4) { ent[eb + rank] = mye; gat[eb + rank] = myv; }
                    asm volatile("s_waitcnt lgkmcnt(0)" ::: "memory");
                    const f32x4 tv = *(const LAS f32x4*)(gat + eb);
                    const float sum = 1.0f + __expf(tv[1] - tv[0]) + __expf(tv[2] - tv[0]) + __expf(tv[3] - tv[0]);
                    asm volatile("s_waitcnt lgkmcnt(0)" ::: "memory");
                    if (rank < 4) gat[eb + rank] = __expf(myv - tv[0]) / sum;
                    asm volatile("s_waitcnt lgkmcnt(0)" ::: "memory");
                }
            }
        }
        if (MODE == 2) {
            __syncthreads();
            { const int e = ent[wv * 64 + lane];
              const int pos = __hip_atomic_fetch_add(bcl + e, 1, __ATOMIC_RELAXED, __HIP_MEMORY_SCOPE_WORKGROUP);
              const size_t idx = (size_t)(vb * 128 + wv * 16) * 4 + lane;
              ((int*)(a->ws + WS_TOPE))[idx] = e; ((int*)(a->ws + WS_POSB))[idx] = pos; ((float*)(a->ws + WS_GATEW))[idx] = gat[wv * 64 + lane]; }
            __syncthreads();
            if (tid < 32) ((int*)(a->ws + WS_BCNT))[((size_t)layer * NTB + vb) * 32 + tid] = bcl[tid];
            __syncthreads();
        }
    }
}
template <int MODE>
DI void phase_norm_mm(const int WID, ArgsP a, LAS unsigned char* lds, int layer, const void* Hin, const bool hb) {
    const int tid = opaque_tid(WID), lane = tid & 63, wv = __builtin_amdgcn_readfirstlane(tid >> 6);
    const int r = lane & 15, kg = lane >> 4;
    LAS float* lgb = (LAS float*)(lds + 131072);
    LAS float* gl = (LAS float*)(lds + MISC_OFF + MO_RED);
    LAS int* bcl = (LAS int*)(lds + MISC_OFF + MO_WCNT); LAS int* ent = (LAS int*)(lds + MISC_OFF + MO_ENT); LAS float* gat = (LAS float*)(lds + MISC_OFF + MO_GAT);
    bf16_t* XN = (bf16_t*)(a->ws + WS_XN);
    const float* gain = a->in[MODE == 2 ? I_N2G : I_N1G] + layer * 1024;
    constexpr int NQ = MODE == 0 ? 24 : 32;
    {
        const float* w = (MODE == 0) ? a->in[I_EVWIN] + (size_t)(layer >> 1) * 1024 * EVIN + 2816 : a->in[I_ROUTW] + (size_t)layer * 1024 * 32;
        const int ldw = (MODE == 0) ? EVIN : 32;
#pragma unroll 2
        for (int i = tid; i < 4096; i += 512) { const int q = i & 31, c = i >> 5; const int qq = q < NQ ? q : NQ - 1;
            const f32x4 g0 = *(const f32x4*)(gain + 8 * c), g1 = *(const f32x4*)(gain + 8 * c + 4);
            const float* wp = w + (size_t)(8 * c) * ldw + qq;
            f32x4 v0, v1;
#pragma unroll
            for (int e = 0; e < 4; ++e) { v0[e] = wp[(size_t)e * ldw]; v1[e] = wp[(size_t)(4 + e) * ldw]; }
            v0 = v0 * g0; v1 = v1 * g1;
            if (q >= NQ) { v0 = (f32x4){0.f, 0.f, 0.f, 0.f}; v1 = v0; }
            const u32x4 hi = pack8(v0, v1);
            const f32x4 r0 = {v0[0] - bflo(hi.x), v0[1] - bfhi(hi.x), v0[2] - bflo(hi.y), v0[3] - bfhi(hi.y)};
            const f32x4 r1 = {v1[0] - bflo(hi.z), v1[1] - bfhi(hi.z), v1[2] - bflo(hi.w), v1[3] - bfhi(hi.w)};
            const int off = q * 2048 + ((c ^ (q & 15)) << 4);
            *(LAS u32x4*)(lds + off) = hi; *(LAS u32x4*)(lds + 65536 + off) = pack8(r0, r1); }
        if (tid < 256) *(LAS f32x4*)(gl + 4 * tid) = *(const f32x4*)(gain + 4 * tid);
    }
    f32x4 rb0 = {0.f, 0.f, 0.f, 0.f}, rb1 = rb0;
    if (MODE == 2) { rb0 = *(const f32x4*)(a->in[I_ROUTB] + layer * 32 + 4 * kg); rb1 = *(const f32x4*)(a->in[I_ROUTB] + layer * 32 + 16 + 4 * kg); }
    __syncthreads();
    for (int vb = blockIdx.x; vb < NTB; vb += gridDim.x) {
        if (MODE == 2) { if (tid < 32) bcl[tid] = 0; }
        const int t0 = vb * 128 + wv * 16;
        u32x4 hp[16][2];
        if (hb) { const bf16_t* src = (const bf16_t*)Hin + (size_t)(t0 + r) * 1024 + 16 * kg;
#pragma unroll
            for (int S = 0; S < 16; ++S) { hp[S][0] = *(const u32x4*)(src + 64 * S); hp[S][1] = *(const u32x4*)(src + 64 * S + 8); }
        } else { const float* src = (const float*)Hin + (size_t)(t0 + r) * 1024 + 16 * kg;
#pragma unroll
            for (int S = 0; S < 16; ++S) { const f32x4 x0 = *(const f32x4*)(src + 64 * S), x1 = *(const f32x4*)(src + 64 * S + 4), x2 = *(const f32x4*)(src + 64 * S + 8), x3 = *(const f32x4*)(src + 64 * S + 12);
                hp[S][0] = pack8(x0, x1); hp[S][1] = pack8(x2, x3); }
        }
        f32x4 acc0 = {0.f, 0.f, 0.f, 0.f}, acc1 = acc0;
        float ss = 0.f;
        const int ob = r * 2048;
#pragma unroll
        for (int S = 0; S < 16; ++S) {
#pragma unroll
            for (int hf = 0; hf < 2; ++hf) {
                const u32x4 hv = hp[S][hf];
#pragma unroll
                for (int e = 0; e < 4; ++e) { const float lo = bflo(hv[e]), hi = bfhi(hv[e]); ss = fmaf(lo, lo, ss); ss = fmaf(hi, hi, ss); }
                const bf16x8 hf8 = __builtin_bit_cast(bf16x8, hv);
                const int off = ob + (S >> 1) * 256 + ((((S & 1) * 8 + 2 * kg + hf) ^ r) << 4);
                acc0 = __builtin_amdgcn_mfma_f32_16x16x32_bf16(*(const LAS bf16x8*)(lds + off), hf8, acc0, 0, 0, 0);
                acc0 = __builtin_amdgcn_mfma_f32_16x16x32_bf16(*(const LAS bf16x8*)(lds + 65536 + off), hf8, acc0, 0, 0, 0);
                acc1 = __builtin_amdgcn_mfma_f32_16x16x32_bf16(*(const LAS bf16x8*)(lds + 32768 + off), hf8, acc1, 0, 0, 0);
                acc1 = __builtin_amdgcn_mfma_f32_16x16x32_bf16(*(const LAS bf16x8*)(lds + 98304 + off), hf8, acc1, 0, 0, 0);
            }
            asm volatile("" ::: "memory");
        }
        ss += shxl(ss, 16, lane); ss += shxl(ss, 32, lane);
        const float rs = rsqrtf(ss * (1.0f / 1024.0f) + EPS);
        { bf16_t* dst = XN + (size_t)(t0 + r) * 1024 + 16 * kg;
#pragma unroll
          for (int S = 0; S < 16; ++S) {
#pragma unroll
              for (int hf = 0; hf < 2; ++hf) { u32x4 hv = hp[S][hf];
                  asm volatile("" : "+v"(hv));
                  const f32x4 g0 = *(const LAS f32x4*)(gl + 64 * S + 16 * kg + 8 * hf), g1 = *(const LAS f32x4*)(gl + 64 * S + 16 * kg + 8 * hf + 4);
                  const f32x4 x0 = (f32x4){bflo(hv.x), bfhi(hv.x), bflo(hv.y), bfhi(hv.y)} * rs * g0, x1 = (f32x4){bflo(hv.z), bfhi(hv.z), bflo(hv.w), bfhi(hv.w)} * rs * g1;
                  if (MODE == 2) *(u32x2*)((unsigned char*)XN + (size_t)(t0 + r) * 1024 + 64 * S + 16 * kg + 8 * hf) = pack8_fp8(x0, x1);
                  else *(u32x4*)(dst + 64 * S + 8 * hf) = pack8(x0, x1); }
              asm volatile("" ::: "memory"); } }
        const f32x4 v0 = acc0 * rs + rb0, v1 = acc1 * rs + rb1;
        if (MODE == 0) { float* G = (float*)(a->ws + WS_GATES) + (size_t)(t0 + r) * 24;
            *(f32x4*)(G + 4 * kg) = (f32x4){sigm(v0[0]), sigm(v0[1]), sigm(v0[2]), sigm(v0[3])};
            if (kg < 2) *(f32x4*)(G + 16 + 4 * kg) = (f32x4){sigm(v1[0]), sigm(v1[1]), sigm(v1[2]), sigm(v1[3])}; }
        if (MODE == 2) {
#pragma unroll 1
            for (int h = 0; h < 2; ++h) {
                if ((r >> 3) == h) { *(LAS f32x4*)(lgb + wv * 256 + (r & 7) * 32 + 4 * kg) = v0; *(LAS f32x4*)(lgb + wv * 256 + (r & 7) * 32 + 16 + 4 * kg) = v1; }
                asm volatile("s_waitcnt lgkmcnt(0)" ::: "memory");
#pragma unroll 1
                for (int it = 4 * h; it < 4 * h + 4; ++it) {
                    const int mye = lane & 31;
                    const LAS float* lrow = lgb + wv * 256 + ((2 * it + (lane >> 5)) & 7) * 32;
                    const float myv = lrow[mye];
                    int rank = 0;
#pragma unroll
                    for (int q4 = 0; q4 < 8; ++q4) { const f32x4 t4 = *(const LAS f32x4*)(lrow + 4 * q4);
#pragma unroll
                        for (int e = 0; e < 4; ++e) { const int j = 4 * q4 + e; rank += ((t4[e] > myv) || (t4[e] == myv && j < mye)) ? 1 : 0; } }
                    const int eb = wv * 64 + (2 * it + (lane >> 5)) * 4;
                    if (rank < 4) { ent[eb + rank] = mye; gat[eb + rank] = myv; }
                    asm volatile("s_waitcnt lgkmcnt(0)" ::: "memory");
                    const f32x4 tv = *(const LAS f32x4*)(gat + eb);
                    const float sum = 1.0f + __expf(tv[1] - tv[0]) + __expf(tv[2] - tv[0]) + __expf(tv[3] - tv[0]);
                    asm volatile("s_waitcnt lgkmcnt(0)" ::: "memory");
                    if (rank < 4) gat[eb + rank] = __expf(myv - tv[0]) / sum;
                    asm volatile("s_waitcnt lgkmcnt(0)" ::: "memory");
                }
            }
            __syncthreads();
            { const int e = ent[wv * 64 + lane];
              const int pos = __hip_atomic_fetch_add(bcl + e, 1, __ATOMIC_RELAXED, __HIP_MEMORY_SCOPE_WORKGROUP);
              const size_t idx = (size_t)(vb * 128 + wv * 16) * 4 + lane;
              ((int*)(a->ws + WS_TOPE))[idx] = e; ((int*)(a->ws + WS_POSB))[idx] = pos; ((float*)(a->ws + WS_GATEW))[idx] = gat[wv * 64 + lane]; }
            __syncthreads();
            if (tid < 32) ((int*)(a->ws + WS_BCNT))[((size_t)layer * NTB + vb) * 32 + tid] = bcl[tid];
            __syncthreads();
        }
    }
}
DI void moe_tables(const int WID, ArgsP a, LAS unsigned char* lds, int layer, int vb) {
    const int tid = opaque_tid(WID);
    LAS int* tot = (LAS int*)(lds + MISC_OFF + MO_TOT); LAS int* base = (LAS int*)(lds + MISC_OFF + MO_BASE); LAS int* ts = (LAS int*)(lds + MISC_OFF + MO_TS);
    LAS int* red = (LAS int*)(lds + MISC_OFF + MO_RED);
    const int* bc = (const int*)(a->ws + WS_BCNT) + (size_t)layer * NTB * 32;
    { const int e = tid & 31, part = tid >> 5; int st = 0, sp = 0;
      for (int blk = part; blk < NTB; blk += 16) { const int v = bc[blk * 32 + e]; st += v; sp += (blk < vb) ? v : 0; }
      red[part * 32 + e] = st; red[512 + part * 32 + e] = sp; }
    __syncthreads();
    if (tid < 32) { int st = 0, sp = 0;
#pragma unroll
        for (int p = 0; p < 16; ++p) { st += red[p * 32 + tid]; sp += red[512 + p * 32 + tid]; }
        tot[tid] = st; base[tid] = sp; }
    __syncthreads();
    if (tid == 0) { int acc = 0; for (int e = 0; e < 32; ++e) { ts[e] = acc; acc += (tot[e] + 255) >> 8; } ts[32] = acc; }
    __syncthreads();
}
DI void phase_moe_slots(const int WID, ArgsP a, LAS unsigned char* lds, int layer) {
    const int tid = opaque_tid(WID);
    LAS int* base = (LAS int*)(lds + MISC_OFF + MO_BASE); LAS int* ts = (LAS int*)(lds + MISC_OFF + MO_TS); LAS int* tot = (LAS int*)(lds + MISC_OFF + MO_TOT);
    int* TOK = (int*)(a->ws + WS_TOK);
    for (int vb = blockIdx.x; vb < NTB; vb += gridDim.x) {
        moe_tables(WID, a, lds, layer, vb);
        { const int t = vb * 128 + (tid >> 2);
          const int e = ((const int*)(a->ws + WS_TOPE))[(size_t)vb * 512 + tid], pos = ((const int*)(a->ws + WS_POSB))[(size_t)vb * 512 + tid];
          const int dest = ts[e] * 256 + base[e] + pos; ((int*)(a->ws + WS_DEST))[(size_t)vb * 512 + tid] = dest; TOK[dest] = t; }
        if (vb < 32) { const int e = vb, lo = ts[e] * 256 + tot[e], hi = ts[e + 1] * 256;
            for (int i = lo + tid; i < hi; i += 512) TOK[i] = 0; }
        __syncthreads();
    }
}
DI void phase_combine(const int WID, ArgsP a, bf16_t* H) {
    const int tid = opaque_tid(WID), lane = tid & 63, wv = tid >> 6;
    const unsigned char* YB = (const unsigned char*)(a->ws + WS_YB); unsigned char* XN8 = (unsigned char*)(a->ws + WS_XN);
    const int G8 = gridDim.x * 8;
    const int* DEST = (const int*)(a->ws + WS_DEST); const float* GW = (const float*)(a->ws + WS_GATEW);
    int t = blockIdx.x * 8 + wv;
    int dA = 0, dB = 0; float gA = 0.f, gB = 0.f;
    if (lane < 4) { if (t < T) { dA = DEST[(size_t)t * 4 + lane]; gA = GW[(size_t)t * 4 + lane]; } if (t + G8 < T) { dB = DEST[(size_t)(t + G8) * 4 + lane]; gB = GW[(size_t)(t + G8) * 4 + lane]; } }
    for (; t < T; t += 2 * G8) {
        const int tA = t, tB = (t + G8 < T) ? t + G8 : t;
        const int cdA = dA, cdB = (t + G8 < T) ? dB : dA; const float cgA = gA, cgB = (t + G8 < T) ? gB : gA;
        u32x4 hA[2], hB[2], yA[4], yB[4];
#pragma unroll
        for (int j = 0; j < 2; ++j) { hA[j] = *(const u32x4*)(H + (size_t)tA * 1024 + 16 * lane + 8 * j); hB[j] = *(const u32x4*)(H + (size_t)tB * 1024 + 16 * lane + 8 * j); }
#pragma unroll
        for (int k = 0; k < 4; ++k) yA[k] = *(const u32x4*)(YB + (size_t)__builtin_amdgcn_readlane(cdA, k) * 1024 + 16 * lane);
#pragma unroll
        for (int k = 0; k < 4; ++k) yB[k] = *(const u32x4*)(YB + (size_t)__builtin_amdgcn_readlane(cdB, k) * 1024 + 16 * lane);
        { const int tn = t + 2 * G8;
          if (lane < 4) { if (tn < T) { dA = DEST[(size_t)tn * 4 + lane]; gA = GW[(size_t)tn * 4 + lane]; } if (tn + G8 < T) { dB = DEST[(size_t)(tn + G8) * 4 + lane]; gB = GW[(size_t)(tn + G8) * 4 + lane]; } } }
        asm volatile("" ::: "memory");
#pragma unroll
        for (int rr = 0; rr < 2; ++rr) {
            const int tt = rr ? tB : tA; const float cg = rr ? cgB : cgA;
            f32x2 v[8];
#pragma unroll
            for (int j = 0; j < 2; ++j) { const u32x4 w = rr ? hB[j] : hA[j];
#pragma unroll
                for (int q = 0; q < 4; ++q) v[4 * j + q] = (f32x2){bflo(w[q]), bfhi(w[q])}; }
#pragma unroll
            for (int k = 0; k < 4; ++k) { const float g = __builtin_bit_cast(float, __builtin_amdgcn_readlane(__builtin_bit_cast(int, cg), k)) * (1.0f / Y_SC);
                const u32x4 w = rr ? yB[k] : yA[k];
#pragma unroll
                for (int q = 0; q < 4; ++q) { v[2 * q] += g * __builtin_amdgcn_cvt_pk_f32_fp8((int)w[q], false); v[2 * q + 1] += g * __builtin_amdgcn_cvt_pk_f32_fp8((int)w[q], true); } }
            float ss = 0.f;
            u32x4 o0, o1;
#pragma unroll
            for (int q = 0; q < 4; ++q) { o0[q] = pk2(v[q][0], v[q][1]); o1[q] = pk2(v[4 + q][0], v[4 + q][1]); }
#pragma unroll
            for (int q = 0; q < 8; ++q) ss += v[q][0] * v[q][0] + v[q][1] * v[q][1];
            *(u32x4*)(H + (size_t)tt * 1024 + 16 * lane) = o0; *(u32x4*)(H + (size_t)tt * 1024 + 16 * lane + 8) = o1;
#pragma unroll
            for (int o = 1; o < 64; o <<= 1) ss += shxl(ss, o, lane);
            const float rstd = rsqrtf(ss * (1.0f / 1024.0f) + EPS);
            u32x4 x8;
#pragma unroll
            for (int q = 0; q < 4; ++q) x8[q] = pk4_fp8(v[2 * q][0] * rstd, v[2 * q][1] * rstd, v[2 * q + 1][0] * rstd, v[2 * q + 1][1] * rstd);
            *(u32x4*)(XN8 + (size_t)tt * 1024 + 16 * lane) = x8;
        }
    }
}
DI void phase_cmp2(const int WID, ArgsP a, LAS unsigned char* lds, int ev) {
    const int tid = opaque_tid(WID), lane = tid & 63, wv = __builtin_amdgcn_readfirstlane(tid >> 6);
    const bf16_t* HID = (const bf16_t*)(a->ws + WS_HID); bf16_t* KCMP = (bf16_t*)(a->ws + WS_KCMP); bf16_t* VCMPT = (bf16_t*)(a->ws + WS_VCMPT);
    const float kg = a->in[I_NSKN][ev * 64 + lane];
    LAS float* wl = (LAS float*)lds;
    for (int i = tid; i < 2 * 256 * 64 / 4; i += 512) *(LAS f32x4*)(wl + 4 * i) = *(const f32x4*)(a->in[I_CMPW2] + (size_t)ev * 2 * 256 * 64 + 4 * i);
    __syncthreads();
    for (int gi = blockIdx.x * 8 + wv; gi < 2048; gi += gridDim.x * 8) {
        const int kv = gi >> 10, row0 = (gi & 1023) * 4;
        const bf16_t* hrow = HID + ((size_t)kv * 4096 + row0) * 256;
        const LAS float* w2 = wl + kv * 256 * 64 + lane;
        float s[4] = {0.f, 0.f, 0.f, 0.f};
#pragma unroll 2
        for (int k = 0; k < 256; k += 8) {
            u32x4 hw[4];
#pragma unroll
            for (int r = 0; r < 4; ++r) hw[r] = *(const u32x4*)(hrow + r * 256 + k);
            float wv8[8];
#pragma unroll
            for (int j = 0; j < 8; ++j) wv8[j] = w2[(k + j) * 64];
#pragma unroll
            for (int r = 0; r < 4; ++r)
                s[r] += bflo(hw[r].x) * wv8[0] + bfhi(hw[r].x) * wv8[1] + bflo(hw[r].y) * wv8[2] + bfhi(hw[r].y) * wv8[3] + bflo(hw[r].z) * wv8[4] + bfhi(hw[r].z) * wv8[5] + bflo(hw[r].w) * wv8[6] + bfhi(hw[r].w) * wv8[7];
        }
#pragma unroll
        for (int r = 0; r < 4; ++r) {
            const int row = row0 + r, bg = row >> 7, n = row & 127;
            float v = (n == 127) ? 0.f : s[r];
            if (kv == 0) { const float ss = wave_sum(v * v); const float o = v * rsqrtf(ss * (1.0f / 64.0f) + EPS) * kg;
                KCMP[((size_t)bg * 128 + n) * 64 + lane] = (bf16_t)(pk2(o, 0.f) & 0xffffu); }
            else VCMPT[((size_t)bg * 96 + lane) * 128 + vperm16(n)] = (bf16_t)(pk2(v, 0.f) & 0xffffu);
        }
    }
    for (int i = blockIdx.x * 512 + tid; i < 32 * 32 * 128; i += gridDim.x * 512) {
        const int n = i & 127, j = (i >> 7) & 31, bg = i >> 12;
        float o = 0.f;
        if (n < 127) { const int d = n - 4 * j; if (d >= 0 && d <= 2) o = 1.0f; else if (d == 3 || d == -1) o = 0.5f; }
        VCMPT[((size_t)bg * 96 + 64 + j) * 128 + vperm16(n)] = (bf16_t)(pk2(o, 0.f) & 0xffffu);
    }
}
DI void topk_one(const float* IMPH, unsigned* SELM, int t, int g) {
    const int b = t >> 11, s = t & 2047, cur = s >> 6;
    unsigned mask;
    if (cur < 16) mask = (2u << cur) - 1u;
    else {
        float sc[32];
#pragma unroll
        for (int j4 = 0; j4 < 8; ++j4) { f32x4 acc = {0.f, 0.f, 0.f, 0.f};
#pragma unroll
            for (int r = 0; r < 4; ++r) acc += *(const f32x4*)(IMPH + ((size_t)t * 8 + g * 4 + r) * 32 + 4 * j4);
#pragma unroll
            for (int q = 0; q < 4; ++q) sc[4 * j4 + q] = acc[q]; }
#pragma unroll
        for (int j = 0; j < 32; ++j) { const bool forced = (j == 0) || (j == cur) || (j == cur - 1); sc[j] = (j > cur) ? NEGF : (sc[j] + (forced ? 1e4f : 0.f)); }
        mask = 0u;
#pragma unroll
        for (int j = 0; j < 32; ++j) { int rank = 0;
#pragma unroll
            for (int k = 0; k < 32; ++k) rank += ((sc[k] > sc[j]) || (sc[k] == sc[j] && k < j)) ? 1 : 0;
            mask |= (rank < 16) ? (1u << j) : 0u; }
    }
    SELM[((size_t)(b * 2 + g)) * 2048 + s] = mask;
}
DI void phase_topk(const int WID, ArgsP a) {
    for (int i = blockIdx.x * 512 + opaque_tid(WID); i < T * 2; i += gridDim.x * 512) topk_one((const float*)(a->ws + WS_IMPH), (unsigned*)(a->ws + WS_SELM), i >> 1, i & 1);
}
DI void phase_cmp_topk(const int WID, ArgsP a, LAS unsigned char* lds) {
    const bf16_t* QN = (const bf16_t*)(a->ws + WS_QN);
    float* IMPH = (float*)(a->ws + WS_IMPH);
    for (int u = blockIdx.x; u < 256; u += gridDim.x) {
        const int qb = 7 - (u >> 5), bg = u & 31, b = bg >> 1, g = bg & 1, q0 = qb * 256; const size_t t0 = (size_t)b * 2048 + q0;
#pragma unroll 1
        for (int r = 0; r < 4; ++r) { const int hd = g * 4 + r;
            attn_unit<96, 3>(WID, lds, QN + t0 * 512 + hd * 64, 512, (const bf16_t*)(a->ws + WS_KCMP) + (size_t)bg * 128 * 64, 64,
                             (const bf16_t*)(a->ws + WS_VCMPT) + (size_t)bg * 96 * 128, 128, q0, 0.f, 0, nullptr,
                             (bf16_t*)(a->ws + WS_OC) + t0 * 512 + hd * 64, 512, IMPH + (t0 * 8 + hd) * 32); }
        asm volatile("s_waitcnt vmcnt(0)" ::: "memory");
        __syncthreads();
        { const int tid = opaque_tid(WID); if (tid < 256) topk_one(IMPH, (unsigned*)(a->ws + WS_SELM), (int)t0 + tid, g); }
        __syncthreads();
    }
}
DI void phase_mixprep(const int WID, ArgsP a, int layer) {
    const int tid = opaque_tid(WID), lane = tid & 63, wv = tid >> 6, ev = layer >> 1;
    const float* dl = a->in[I_DALAM] + ev * 256;
    const float s1 = wave_sum(dl[lane] * dl[64 + lane]), s2 = wave_sum(dl[128 + lane] * dl[192 + lane]);
    const float lam_init = 0.8f - 0.6f * expf(-0.3f * (float)layer);
    const float lam = expf(s1) - expf(s2) + lam_init;
    const float* og = a->in[I_DAOUTG] + ev * 128;
    const bf16_t* OD = (const bf16_t*)(a->ws + WS_OD); const bf16_t* OC = (const bf16_t*)(a->ws + WS_OC); const bf16_t* OS = (const bf16_t*)(a->ws + WS_OS); const bf16_t* OW = (const bf16_t*)(a->ws + WS_OW);
    const float* GT = (const float*)(a->ws + WS_GATES); unsigned char* AMIX = (unsigned char*)(a->ws + WS_AMIX);
    const int h = lane >> 4, dv = (lane & 15) * 8;
    f32x4 g0 = *(const f32x4*)(og + dv), g1 = *(const f32x4*)(og + dv + 4);
    for (int t = blockIdx.x * 8 + wv; t < T; t += gridDim.x * 8) {
        { const u32x4 w1 = *(const u32x4*)(OD + (size_t)t * 1024 + h * 128 + dv), w2 = *(const u32x4*)(OD + (size_t)t * 1024 + (4 + h) * 128 + dv);
          f32x4 d0, d1;
          d0[0] = bflo(w1.x) - lam * bflo(w2.x); d0[1] = bfhi(w1.x) - lam * bfhi(w2.x); d0[2] = bflo(w1.y) - lam * bflo(w2.y); d0[3] = bfhi(w1.y) - lam * bfhi(w2.y);
          d1[0] = bflo(w1.z) - lam * bflo(w2.z); d1[1] = bfhi(w1.z) - lam * bfhi(w2.z); d1[2] = bflo(w1.w) - lam * bflo(w2.w); d1[3] = bfhi(w1.w) - lam * bfhi(w2.w);
          float ss = (d0[0] * d0[0] + d0[1] * d0[1]) + (d0[2] * d0[2] + d0[3] * d0[3]) + (d1[0] * d1[0] + d1[1] * d1[1]) + (d1[2] * d1[2] + d1[3] * d1[3]);
          ss += shx(ss, 1); ss += shx(ss, 2); ss += shx(ss, 4); ss += shx(ss, 8);
          const float rs = rsqrtf(ss * (1.0f / 128.0f) + EPS) * (1.0f - lam_init);
          *(u32x2*)(AMIX + (size_t)t * 1024 + h * 128 + dv) = pack8_fp8(d0 * (rs * A_SC) * g0, d1 * (rs * A_SC) * g1); }
    }
}
DI void phase_scan(const int WID, ArgsP a) {
    const bf16_t* UT = (const bf16_t*)(a->ws + WS_UT); bf16_t* VS = (bf16_t*)(a->ws + WS_VS);
    for (int i = blockIdx.x * 512 + opaque_tid(WID); i < 64 * 512 * 32; i += gridDim.x * 512) {
        const int d8 = i & 31, f = (i >> 5) & 511, bh = i >> 14, h = bh & 3;
        const float dec = exp2f(256.0f * ret_lg2(h));
        f32x4 S0 = {0.f, 0.f, 0.f, 0.f}, S1 = S0;
        u32x4 un = *(const u32x4*)(UT + ((size_t)bh * 8) * 131072 + (size_t)f * 256 + 8 * d8);
#pragma unroll 1
        for (int n = 0; n < 8; ++n) {
            const size_t z = (size_t)bh * 8 + n;
            const u32x4 u = un;
            if (n < 7) un = *(const u32x4*)(UT + (z + 1) * 131072 + (size_t)f * 256 + 8 * d8);
            *(u32x4*)(VS + (z * 512 + f) * 512 + 256 + 8 * d8) = pack8(S0, S1);
            S0[0] = (S0[0] + bflo(u.x)) * dec; S0[1] = (S0[1] + bfhi(u.x)) * dec; S0[2] = (S0[2] + bflo(u.y)) * dec; S0[3] = (S0[3] + bfhi(u.y)) * dec;
            S1[0] = (S1[0] + bflo(u.z)) * dec; S1[1] = (S1[1] + bfhi(u.z)) * dec; S1[2] = (S1[2] + bflo(u.w)) * dec; S1[3] = (S1[3] + bfhi(u.w)) * dec;
        }
    }
}
DI void phase_normgate(const int WID, ArgsP a, int od) {
    const int tid = opaque_tid(WID), lane = tid & 63, wv = tid >> 6;
    const unsigned char* Y = (const unsigned char*)(a->ws + WS_Y); const unsigned char* GG = (const unsigned char*)(a->ws + WS_GG); unsigned char* YG = (unsigned char*)(a->ws + WS_YG);
    const float* og = a->in[I_RETG] + od * 512;
    const f32x4 g0 = *(const f32x4*)(og + 8 * lane) * (A_SC / RG_SC), g1 = *(const f32x4*)(og + 8 * lane + 4) * (A_SC / RG_SC);
    const int G8 = gridDim.x * 8;
    for (int t = blockIdx.x * 8 + wv; t < T; t += 2 * G8) {
        const int tB = (t + G8 < T) ? t + G8 : t;
        u32x2 yw[2][4], gw[2][4];
#pragma unroll
        for (int rr = 0; rr < 2; ++rr)
#pragma unroll
            for (int h = 0; h < 4; ++h) { const size_t o = (size_t)(rr ? tB : t) * 2048 + h * 512 + 8 * lane; yw[rr][h] = *(const u32x2*)(Y + o); gw[rr][h] = *(const u32x2*)(GG + o); }
        asm volatile("" ::: "memory");
#pragma unroll
        for (int rr = 0; rr < 2; ++rr)
#pragma unroll
            for (int h = 0; h < 4; ++h) {
                const size_t o = (size_t)(rr ? tB : t) * 2048 + h * 512 + 8 * lane;
                const u32x2 yv = yw[rr][h], gv = gw[rr][h];
                const f32x2 ya = __builtin_amdgcn_cvt_pk_f32_fp8((int)yv.x, false), yb = __builtin_amdgcn_cvt_pk_f32_fp8((int)yv.x, true), yc = __builtin_amdgcn_cvt_pk_f32_fp8((int)yv.y, false), yd = __builtin_amdgcn_cvt_pk_f32_fp8((int)yv.y, true);
                const f32x2 qa = __builtin_amdgcn_cvt_pk_f32_fp8((int)gv.x, false), qb = __builtin_amdgcn_cvt_pk_f32_fp8((int)gv.x, true), qc = __builtin_amdgcn_cvt_pk_f32_fp8((int)gv.y, false), qd = __builtin_amdgcn_cvt_pk_f32_fp8((int)gv.y, true);
                const f32x4 y0 = (f32x4){ya[0], ya[1], yb[0], yb[1]} * (1.0f / RY_SC), y1 = (f32x4){yc[0], yc[1], yd[0], yd[1]} * (1.0f / RY_SC);
                const f32x4 q0 = {qa[0], qa[1], qb[0], qb[1]}, q1 = {qc[0], qc[1], qd[0], qd[1]};
                float ss = (y0[0] * y0[0] + y0[1] * y0[1]) + (y0[2] * y0[2] + y0[3] * y0[3]) + (y1[0] * y1[0] + y1[1] * y1[1]) + (y1[2] * y1[2] + y1[3] * y1[3]);
#pragma unroll
                for (int o2 = 1; o2 < 64; o2 <<= 1) ss += shxl(ss, o2, lane);
                const float rs = rsqrtf(ss * (1.0f / 512.0f) + EPS);
                *(u32x2*)(YG + o) = pack8_fp8(y0 * rs * g0 * q0, y1 * rs * g1 * q1);
            }
    }
}
DI int snake_unit(int rnd, int G, int c) { return (rnd & 1) ? rnd * G + (G - 1 - c) : rnd * G + c; }
DI float absmax64(const float* g, int lane) { float m = fabsf(g[lane]);
#pragma unroll
    for (int o = 1; o < 64; o <<= 1) m = fmaxf(m, shx(m, o));
    return m; }
constexpr int CW_AQ = 8192;
template <int MODE>
DI void phase_attn(const int WID, ArgsP a, LAS unsigned char* lds, int ev) {
    const int tid = opaque_tid(WID), lane = tid & 63;
    const bf16_t* QD = (const bf16_t*)(a->ws + WS_QD); const bf16_t* KD = (const bf16_t*)(a->ws + WS_KD); const bf16_t* QN = (const bf16_t*)(a->ws + WS_QN);
    LAS int* ord = (LAS int*)(lds + MISC_OFF + MO_ENT); LAS int* cst = (LAS int*)(lds + MISC_OFF + MO_GAT); volatile LAS int* cur = (volatile LAS int*)(lds + MISC_OFF + MO_TOT);
    float sb2 = 0.f;
    if (MODE != 3) { const float gq = absmax64(a->in[MODE == 0 ? I_DAQN : I_NSQN] + ev * 64, lane), gk = absmax64(a->in[MODE == 0 ? I_DAKN : I_NSKN] + ev * 64, lane);
        sb2 = 16.0f * gq * gk + 28.0f; }
    if (tid < 64) { const int qb = tid >> 3, hd = tid & 7, q0 = qb * 256; int lo = 0, hi = 4 * qb + 4;
        if (MODE == 3) { lo = 0; hi = 2; }
        else { const float slope = (MODE == 0) ? exp2f(-2.0f * (float)((hd & 3) + 1)) : exp2f(-(float)(hd + 1)); const int dcut = (int)fminf(sb2 / slope + 1.0f, 100000.0f);
            const int kmin = q0 - dcut; lo = kmin > 0 ? (kmin >> 6) : 0;
            if (MODE == 2) { const int lk = q0 - 511; const int lw = lk > 0 ? (lk >> 6) : 0; lo = lw > lo ? lw : lo; } }
        cst[tid] = hi - lo; }
    __syncthreads();
    if (tid < 64) { const int mine = cst[tid]; int rank = 0;
        for (int j = 0; j < 64; ++j) { const int o = cst[j]; rank += (o > mine || (o == mine && j < tid)) ? 1 : 0; }
        ord[rank] = tid; }
    __syncthreads();
    unsigned* ctr = (unsigned*)(a->ws + WS_CTL) + CW_AQ + 64 * 8 * (ev * 4 + MODE);
    const int x0 = (int)(xb_xcc_id() & 7u);
    volatile LAS int* stl = (volatile LAS int*)(lds + MISC_OFF + MO_BASE);
    bool own = true; int nst = 0;
    for (;;) {
        if (tid < 64) {
            int uu_ = -1;
            if (own) { int v = 128; if (lane == 0) v = (int)__hip_atomic_fetch_add(ctr + 64 * x0, 1u, __ATOMIC_RELAXED, __HIP_MEMORY_SCOPE_AGENT);
                v = __builtin_amdgcn_readfirstlane(v); if (v < 128) uu_ = x0 * 128 + v; else own = false; }
            if (!own && uu_ < 0) {
                if (nst == 0) { int v = 128; const int xq_ = (x0 + lane) & 7;
                    if (lane >= 1 && lane < 8) v = (int)__hip_atomic_fetch_add(ctr + 64 * xq_, 1u, __ATOMIC_RELAXED, __HIP_MEMORY_SCOPE_AGENT);
                    const unsigned long long got = __ballot(v < 128); nst = __popcll(got);
                    if (v < 128) stl[__popcll(got & ((1ull << lane) - 1ull))] = xq_ * 128 + v;
                    asm volatile("s_waitcnt lgkmcnt(0)" ::: "memory"); }
                if (nst > 0) { --nst; uu_ = stl[nst]; }
            }
            if (lane == 0) *cur = uu_;
        }
        __syncthreads();
        const int uu = *cur; if (uu < 0) break;
        const int xq = uu >> 7, v = uu & 127, combo = ord[v >> 1], jb = v & 1, qb = combo >> 3, hd = combo & 7, q0 = qb * 256;
        const int b = (MODE == 0) ? (((xq - 2 * (hd & 3)) & 7) + 8 * jb) : (((xq - 4 * (hd >> 2)) & 7) + 8 * jb);
        const size_t t0 = (size_t)b * 2048 + q0;
        if (MODE == 0) {
            const float slope = exp2f(-2.0f * (float)((hd & 3) + 1)); const int dcut = (int)fminf(sb2 / slope + 1.0f, 100000.0f);
            attn_unit<128, 0>(WID, lds, QD + t0 * 512 + hd * 64, 512, KD + (size_t)b * 2048 * 512 + hd * 64, 512,
                              (const bf16_t*)(a->ws + WS_VAT) + (size_t)(b * 4 + (hd & 3)) * 128 * 2048, 2048, q0, slope, dcut, nullptr,
                              (bf16_t*)(a->ws + WS_OD) + t0 * 1024 + hd * 128, 1024, nullptr);
        } else if (MODE == 1 || MODE == 2) {
            const int g = hd >> 2; const float slope = exp2f(-(float)(hd + 1)); const int dcut = (int)fminf(sb2 / slope + 1.0f, 100000.0f);
            const bf16_t* Kb = (const bf16_t*)(a->ws + (MODE == 1 ? WS_KSB : WS_KWB)) + (size_t)(b * 2 + g) * 2048 * 64;
            const bf16_t* Vb = (const bf16_t*)(a->ws + (MODE == 1 ? WS_VST : WS_VWT)) + (size_t)(b * 2 + g) * 64 * 2048;
            attn_unit<64, MODE>(WID, lds, QN + t0 * 512 + hd * 64, 512, Kb, 64, Vb, 2048, q0, slope, dcut,
                                (const unsigned*)(a->ws + WS_SELM) + (size_t)(b * 2 + g) * 2048 + q0,
                                (bf16_t*)(a->ws + (MODE == 1 ? WS_OS : WS_OW)) + t0 * 512 + hd * 64, 512, nullptr);
        } else {
            const int g = hd >> 2;
            attn_unit<96, 3>(WID, lds, QN + t0 * 512 + hd * 64, 512, (const bf16_t*)(a->ws + WS_KCMP) + (size_t)(b * 2 + g) * 128 * 64, 64,
                             (const bf16_t*)(a->ws + WS_VCMPT) + (size_t)(b * 2 + g) * 96 * 128, 128, q0, 0.f, 0, nullptr,
                             (bf16_t*)(a->ws + WS_OC) + t0 * 512 + hd * 64, 512, (float*)(a->ws + WS_IMPH) + (t0 * 8 + hd) * 32);
        }
    }
}

DI void phase_diff(const int WID, ArgsP a, LAS unsigned char* lds, int layer) {
    const int tid = opaque_tid(WID), lane = tid & 63, ev = layer >> 1;
    LAS int* ord = (LAS int*)(lds + MISC_OFF + MO_ENT); LAS int* cst = (LAS int*)(lds + MISC_OFF + MO_GAT); volatile LAS int* cur = (volatile LAS int*)(lds + MISC_OFF + MO_TOT);
    const float gq = absmax64(a->in[I_DAQN] + ev * 64, lane), gk = absmax64(a->in[I_DAKN] + ev * 64, lane);
    const float sb2 = 16.0f * gq * gk + 28.0f;
    const float* dl = a->in[I_DALAM] + ev * 256;
    const float s1 = wave_sum(dl[lane] * dl[64 + lane]), s2 = wave_sum(dl[128 + lane] * dl[192 + lane]);
    const float lam_init = 0.8f - 0.6f * expf(-0.3f * (float)layer);
    const float lam = expf(s1) - expf(s2) + lam_init;
    if (tid < 32) { const int qb = tid >> 2, h = tid & 3, q0 = qb * 256; const float slope = exp2f(-2.0f * (float)(h + 1)); const int dcut = (int)fminf(sb2 / slope + 1.0f, 100000.0f);
        const int kmin = q0 - dcut; const int lo = kmin > 0 ? (kmin >> 6) : 0; cst[tid] = 4 * qb + 4 - lo; }
    __syncthreads();
    if (tid < 32) { const int mine = cst[tid]; int rank = 0;
        for (int j = 0; j < 32; ++j) { const int o = cst[j]; rank += (o > mine || (o == mine && j < tid)) ? 1 : 0; }
        ord[rank] = tid; }
    __syncthreads();
    unsigned* ctr = (unsigned*)(a->ws + WS_CTL) + CW_AQ + 64 * 8 * (ev * 4 + 0);
    const bf16_t* QD = (const bf16_t*)(a->ws + WS_QD); const bf16_t* KD = (const bf16_t*)(a->ws + WS_KD);
    for (;;) {
        if (tid == 0) *cur = (int)__hip_atomic_fetch_add(ctr, 1u, __ATOMIC_RELAXED, __HIP_MEMORY_SCOPE_AGENT);
        __syncthreads();
        const int u = *cur; if (u >= 512) break;
        const int combo = ord[u >> 4], b = u & 15, qb = combo >> 2, h = combo & 3, q0 = qb * 256; const size_t t0 = (size_t)b * 2048 + q0;
        const float slope = exp2f(-2.0f * (float)(h + 1)); const int dcut = (int)fminf(sb2 / slope + 1.0f, 100000.0f);
        diff_unit(WID, lds, QD + t0 * 512 + h * 64, QD + t0 * 512 + (4 + h) * 64, KD + (size_t)b * 2048 * 512 + h * 64, KD + (size_t)b * 2048 * 512 + (4 + h) * 64,
                  (const bf16_t*)(a->ws + WS_VAT) + (size_t)(b * 4 + h) * 128 * 2048, q0, slope, dcut, lam, 1.0f - lam_init, a->in[I_DAOUTG] + ev * 128,
                  (unsigned char*)(a->ws + WS_AMIX) + t0 * 1024 + h * 128);
    }
}
DI void phase_nsa(const int WID, ArgsP a, LAS unsigned char* lds, int ev) {
    const int tid = opaque_tid(WID), lane = tid & 63, w = __builtin_amdgcn_readfirstlane(tid >> 6), r = lane & 31, hh = lane >> 5, hr = w >> 1, qh = w & 1;
    volatile LAS int* cur = (volatile LAS int*)(lds + MISC_OFF + MO_TOT);
    LAS float* impl = (LAS float*)(lds + 98304);
    LAS float* scs = (LAS float*)(lds + 131072);
    LAS unsigned* selml = (LAS unsigned*)(lds + MISC_OFF + MO_RED);
    const float gq = absmax64(a->in[I_NSQN] + ev * 64, lane), gk = absmax64(a->in[I_NSKN] + ev * 64, lane);
    const float sb2 = 16.0f * gq * gk + 28.0f;
    unsigned* ctr = (unsigned*)(a->ws + WS_CTL) + CW_AQ + 64 * 8 * (ev * 4 + 1);
    const bf16_t* QN = (const bf16_t*)(a->ws + WS_QN);
    for (;;) {
        if (tid == 0) *cur = (int)__hip_atomic_fetch_add(ctr, 1u, __ATOMIC_RELAXED, __HIP_MEMORY_SCOPE_AGENT);
        __syncthreads();
        const int u = *cur; if (u >= 1024) break;
        const int qb = 31 - (u >> 5), bg = u & 31, b = bg >> 1, g = bg & 1, q0 = qb * 64; const size_t t0 = (size_t)b * 2048 + q0;
        bf16x8 qf[4];
        { const bf16_t* Qw = QN + (t0 + 32 * qh + r) * 512 + (4 * g + hr) * 64;
#pragma unroll
          for (int ks = 0; ks < 4; ++ks) qf[ks] = *(const bf16x8*)(Qw + 16 * ks + 8 * hh); }
        const float* gp = (const float*)(a->ws + WS_GATES) + (t0 + 32 * qh + r) * 24 + (4 * g + hr) * 3;
        const float gate_c = gp[0], gate_s = gp[1], gate_w = gp[2];
        f32x16 OB[2];
#pragma unroll
        for (int rb = 0; rb < 2; ++rb)
#pragma unroll
            for (int i = 0; i < 16; ++i) OB[rb][i] = 0.f;
        nsa_unit<96, 3>(WID, lds, qf, (const bf16_t*)(a->ws + WS_KCMP) + (size_t)bg * 128 * 64, 64, (const bf16_t*)(a->ws + WS_VCMPT) + (size_t)bg * 96 * 128, 128, q0, g, sb2,
                        nullptr, OB, gate_c, impl);
        asm volatile("s_waitcnt lgkmcnt(0)" ::: "memory");
        __syncthreads();
        { const int qq = tid >> 3, pq = tid & 7;
          if (qb < 16) { if (pq == 0) selml[qq] = (2u << qb) - 1u; }
          else { f32x4 acc = {0.f, 0.f, 0.f, 0.f};
#pragma unroll
              for (int h2 = 0; h2 < 4; ++h2) acc += *(const LAS f32x4*)(impl + (h2 * 64 + qq) * 32 + 4 * pq);
#pragma unroll
              for (int e = 0; e < 4; ++e) { const int j = 4 * pq + e; const bool forced = (j == 0) || (j == qb) || (j == qb - 1); acc[e] = (j > qb) ? NEGF : (acc[e] + (forced ? 1e4f : 0.f)); }
              *(LAS f32x4*)(scs + qq * 32 + 4 * pq) = acc; }
          asm volatile("s_waitcnt lgkmcnt(0)" ::: "memory");
          __syncthreads();
          if (qb >= 16) { const f32x4 my = *(const LAS f32x4*)(scs + qq * 32 + 4 * pq); int rk[4] = {0, 0, 0, 0};
#pragma unroll
              for (int k4 = 0; k4 < 8; ++k4) { const f32x4 o4 = *(const LAS f32x4*)(scs + qq * 32 + 4 * k4);
#pragma unroll
                  for (int kk = 0; kk < 4; ++kk) { const int k = 4 * k4 + kk;
#pragma unroll
                      for (int e = 0; e < 4; ++e) { const int j = 4 * pq + e; rk[e] += ((o4[kk] > my[e]) || (o4[kk] == my[e] && k < j)) ? 1 : 0; } } }
              unsigned bits = 0u;
#pragma unroll
              for (int e = 0; e < 4; ++e) bits |= (rk[e] < 16) ? (1u << (4 * pq + e)) : 0u;
              bits |= shxu(bits, 1); bits |= shxu(bits, 2); bits |= shxu(bits, 4);
              if (pq == 0) selml[qq] = bits; }
          asm volatile("s_waitcnt lgkmcnt(0)" ::: "memory");
          __syncthreads(); }
        nsa_unit<64, 1>(WID, lds, qf, (const bf16_t*)(a->ws + WS_KSB) + (size_t)bg * 2048 * 64, 64, (const bf16_t*)(a->ws + WS_VST) + (size_t)bg * 64 * 2048, 2048, q0, g, sb2,
                        selml, OB, gate_s, nullptr);
        { const bf16_t* ow = (const bf16_t*)(a->ws + WS_OW) + (t0 + 32 * qh + r) * 512 + (4 * g + hr) * 64;
          unsigned char* am = (unsigned char*)(a->ws + WS_AMIX) + (t0 + 32 * qh + r) * 1024 + 512 + (4 * g + hr) * 64;
#pragma unroll
          for (int rb = 0; rb < 2; ++rb)
#pragma unroll
              for (int g4 = 0; g4 < 4; ++g4) { const int dv = 32 * rb + 8 * g4 + 4 * hh; const u32x2 wv = *(const u32x2*)(ow + dv);
                  const float o0 = OB[rb][4 * g4] + gate_w * bflo(wv.x), o1 = OB[rb][4 * g4 + 1] + gate_w * bfhi(wv.x), o2 = OB[rb][4 * g4 + 2] + gate_w * bflo(wv.y), o3 = OB[rb][4 * g4 + 3] + gate_w * bfhi(wv.y);
                  *(unsigned*)(am + dv) = pk4_fp8(o0 * A_SC, o1 * A_SC, o2 * A_SC, o3 * A_SC); } }
    }
}

constexpr int PPL = 15;
constexpr int NPHASE = 1 + DEPTH * PPL;
__global__ void __launch_bounds__(512, 2) mk_fwd(Args a_unused) {
    ArgsP a = opaque_args();
    extern __shared__ __attribute__((aligned(16))) unsigned char lds_raw[];
    LAS unsigned char* lds = (LAS unsigned char*)lds_raw;
    const int tid = threadIdx.x, G = gridDim.x, c = blockIdx.x;
    const int WID = __builtin_amdgcn_readfirstlane(tid >> 6);
    volatile LAS unsigned* misc = (volatile LAS unsigned*)(lds + MISC_OFF);
    if (tid < 4) misc[tid] = 0u;
    __syncthreads();
    unsigned* ctl = (unsigned*)(a->ws + WS_CTL);
    XcdBarrier bar; bar.bar = ctl + CW_BAR; bar.x = 0; bar.st = misc;
    const int ph_lo = a->ph_lo, ph_hi = a->ph_hi;
    const bool multi = (ph_hi - ph_lo) > 1;
    if (multi) bar = xcd_barrier_post(WID, ctl + CW_BAR, misc);
    bool first = true;
#define PHASE_BEGIN(k, id) if ((DBG_ONLY < 0 || DBG_ONLY == (id)) && (k) >= ph_lo && (k) < ph_hi && (k) <= DBG_LAST_PHASE) { if (!first) { xcd_barrier(WID, bar); if (PROBE_MASK >> 31) xcd_barrier(WID, bar); } first = false; \
        ArgsP a = opaque_args(); unsigned char* ws = a->ws; bf16_t* XN = (bf16_t*)(ws + WS_XN); bf16_t* H = (bf16_t*)(ws + WS_HB); const bool hb = layer != 0; const void* Hin = hb ? (const void*)H : (const void*)a->in[I_X]; \
        const LAS int* ts = (const LAS int*)(lds + MISC_OFF + MO_TS); (void)XN; (void)H; (void)Hin; (void)ts; (void)hb; \
        const bool probe_ = ((PROBE_MASK >> (id)) & 1u) != 0u; const unsigned long long pt0_ = probe_ ? __builtin_amdgcn_s_memrealtime() : 0ull;
#define PHASE_END if (probe_) { const unsigned long long pt1_ = __builtin_amdgcn_s_memrealtime(), pd_ = pt1_ - pt0_; while (__builtin_amdgcn_s_memrealtime() - pt1_ < pd_) __builtin_amdgcn_s_sleep(8); } }
    { const int layer = 0; PHASE_BEGIN(0, 0) phase_prologue(WID, a, lds); PHASE_END }
#pragma unroll 1
    for (int layer = 0; layer < DEPTH; ++layer) {
        const int pb = 1 + layer * PPL; const bool even = (layer & 1) == 0; const int ev = layer >> 1, od = layer >> 1;
        if (even) {
            PHASE_BEGIN(pb + 0, 1) phase_norm_mm<0>(WID, a, lds, layer, Hin, hb); PHASE_END
            PHASE_BEGIN(pb + 1, 2) {
                { ProbPlain P{XN, (const bf16_t*)(ws + WS_EVNAT) + (size_t)ev * 2048 * 1024, 1024, 1024, 1024}; pg8::Sched S; S.init(T / 256, 8, G, c);
                  EpiEvNat E{ws, (const float*)(ws + WS_GAINS) + ev * 256};
                  pg8::gemm_phase(WID, lds, P, S, E); }
                { ProbPlain P{(const bf16_t*)(ws + WS_EVSW) + (size_t)ev * 768 * 1024, XN, 1024, 1024, 1024}; pg8::Sched S; S.init(3, T / 256, G, c);
                  EpiEvSw E{ws};
                  pg8::gemm_phase(WID, lds, P, S, E); }
            } PHASE_END
            PHASE_BEGIN(pb + 2, 3) {
                { ProbCmp1 P{(const bf16_t*)(ws + WS_KCB), (const bf16_t*)(ws + WS_VCB), (const bf16_t*)(ws + WS_CMP1) + (size_t)ev * 2 * 256 * 2048, 1024, 2048, 2048}; pg8::Sched S; S.init(32, 1, G, c);
                  EpiCmp1 E{(bf16_t*)(ws + WS_HID), (const float*)(ws + WS_BIAS1) + ev * 512};
                  pg8::gemm_phase(WID, lds, P, S, E); }
                phase_diff(WID, a, lds, layer);
                phase_attn<2>(WID, a, lds, ev);
            } PHASE_END
            PHASE_BEGIN(pb + 3, 4) phase_cmp2(WID, a, lds, ev); PHASE_END
            PHASE_BEGIN(pb + 4, 5) phase_nsa(WID, a, lds, ev); PHASE_END
            PHASE_BEGIN(pb + 8, 9) {
                ProbPlain8 P{(const unsigned char*)(ws + WS_AMIX), (const unsigned char*)(ws + WS_EVOUT) + (size_t)ev * 1024 * 1024, 512, 512, 512}; pg8::Sched S; S.init(T / 256, 4, G, c);
                EpiResid E{Hin, H, hb, 1.0f / (A_SC * 64.0f)}; pg8::gemm_phase(WID, lds, P, S, E);
            } PHASE_END
        } else {
            PHASE_BEGIN(pb + 0, 11) phase_norm<1>(WID, a, lds, layer, Hin, hb); PHASE_END
            PHASE_BEGIN(pb + 1, 12) {
                { ProbPlain8 P{(const unsigned char*)XN, (const unsigned char*)(ws + WS_ODNAT) + (size_t)od * 4096 * 1024, 512, 512, 512}; pg8::Sched S; S.init(T / 256, 16, G, c);
                  EpiOdNat E{ws}; pg8::gemm_phase(WID, lds, P, S, E); }
                { ProbPlain8 P{(const unsigned char*)(ws + WS_ODSW) + (size_t)od * 2048 * 1024, (const unsigned char*)XN, 512, 512, 512}; pg8::Sched S; S.init(8, T / 256, G, c);
                  EpiOdSw E{ws}; pg8::gemm_phase(WID, lds, P, S, E); }
            } PHASE_END
            PHASE_BEGIN(pb + 2, 13) {
                { ProbUT P{(const bf16_t*)(ws + WS_VS), (const bf16_t*)(ws + WS_KT), 512, 256, 256}; SchedSeq S; S.init(G, c);
                  EpiUTScan E{(bf16_t*)(ws + WS_VS)}; pg8::gemm_phase(WID, lds, P, S, E); }
                { ProbAtt P{(const bf16_t*)(ws + WS_AQ), (const bf16_t*)(ws + WS_KP), 2048, 1024, 256}; pg8::Sched S; const int nb = G / 2 > 0 ? G / 2 : 1;
                  if (c >= nb || G < 2) S.init(512, 1, G < 2 ? 1 : G - nb, G < 2 ? 0 : c - nb); else S.init(0, 1, 1, 0);
                  EpiAtt E{(bf16_t*)(ws + WS_AQ)}; pg8::gemm_phase(WID, lds, P, S, E); }
            } PHASE_END
            PHASE_BEGIN(pb + 4, 15) {
                ProbY P{(const bf16_t*)(ws + WS_AQ), (const bf16_t*)(ws + WS_VS), 2048, 512, 512}; pg8::Sched S; S.init(512, 2, G, c);
                EpiY E{(unsigned char*)(ws + WS_Y)}; pg8::gemm_phase(WID, lds, P, S, E);
            } PHASE_END
            PHASE_BEGIN(pb + 5, 16) phase_normgate(WID, a, od); PHASE_END
            PHASE_BEGIN(pb + 8, 19) {
                ProbPlain8 P{(const unsigned char*)(ws + WS_YG), (const unsigned char*)(ws + WS_ODOUT) + (size_t)od * 1024 * 2048, 1024, 1024, 1024}; pg8::Sched S; S.init(T / 256, 4, G, c);
                EpiResid E{Hin, H, hb, 1.0f / (A_SC * 128.0f)}; pg8::gemm_phase(WID, lds, P, S, E);
            } PHASE_END
        }
        PHASE_BEGIN(pb + 9, 20) phase_norm_mm<2>(WID, a, lds, layer, H, true); PHASE_END
        PHASE_BEGIN(pb + 10, 21) phase_moe_slots(WID, a, lds, layer); PHASE_END
        PHASE_BEGIN(pb + 11, 22) {
            moe_tables(WID, a, lds, layer, -1);
            { ProbMoe8G P{(const unsigned char*)(ws + WS_XN), (const unsigned char*)(ws + WS_WGU) + (size_t)layer * 32 * 2048 * 1024, ts, (const int*)(ws + WS_TOK), 2048, 512, 512, 512}; pg8::Sched S; S.init(ts[32], 8, G, c);
              EpiGU E{(unsigned char*)(ws + WS_ACT), a->in[I_BGU] + (size_t)layer * 32 * 2048, ts}; pg8::gemm_phase(WID, lds, P, S, E); }
            { ProbPlain P{(const bf16_t*)(ws + WS_PBF) + (size_t)layer * T * 256, (const bf16_t*)(ws + WS_WPP) + (size_t)layer * 1024 * 256, 256, 256, 256}; pg8::Sched S; S.init(T / 256, 4, G, c);
              EpiPP E{(bf16_t*)(ws + WS_PP)}; pg8::gemm_phase(WID, lds, P, S, E); }
        } PHASE_END
        PHASE_BEGIN(pb + 12, 23) {
            moe_tables(WID, a, lds, layer, -1);
            ProbMoe8 P{(const unsigned char*)(ws + WS_ACT), (const unsigned char*)(ws + WS_WDN) + (size_t)layer * 32 * 1024 * 1024, ts, 1024, 512, 512, 512}; pg8::Sched S; S.init(ts[32], 4, G, c);
            EpiDN E{(unsigned char*)(ws + WS_YB), a->in[I_BDN] + (size_t)layer * 32 * 1024, ts}; pg8::gemm_phase(WID, lds, P, S, E);
        } PHASE_END
        PHASE_BEGIN(pb + 13, 24) phase_combine(WID, a, H); PHASE_END
        PHASE_BEGIN(pb + 14, 25) {
            ProbPlain8 P{(const unsigned char*)(ws + WS_XN), (const unsigned char*)(ws + WS_WPG) + (size_t)layer * 1024 * 1024, 512, 512, 512}; pg8::Sched S; S.init(T / 256, 4, G, c);
            EpiPLE E{H, (const bf16_t*)(ws + WS_PP), (layer == DEPTH - 1) ? a->out : nullptr}; pg8::gemm_phase(WID, lds, P, S, E);
        } PHASE_END
    }
#undef PHASE_BEGIN
#undef PHASE_END
}

extern "C" void kernel_launch(void* const* d_in, const int* in_sizes, int n_in, void* d_out, int out_size, void* d_ws, size_t ws_size, hipStream_t stream) {
    static int grid = 0;
    if (grid == 0) {
        if (n_in != 26 || out_size != T * D || ws_size < WS_END) { fprintf(stderr, "kernel_launch: unexpected problem (n_in %d, out %d, ws %zu < %zu); nothing launched\n", n_in, out_size, ws_size, (size_t)WS_END); grid = -1; return; }
        int dev = 0, cus = 0, per_cu = 0;
        if (hipGetDevice(&dev) != hipSuccess || hipDeviceGetAttribute(&cus, hipDeviceAttributeMultiprocessorCount, dev) != hipSuccess) { grid = -1; return; }
        if (hipFuncSetAttribute((const void*)mk_fwd, hipFuncAttributeMaxDynamicSharedMemorySize, LDS_BYTES) != hipSuccess) { fprintf(stderr, "kernel_launch: hipFuncSetAttribute failed\n"); grid = -1; return; }
        if (hipOccupancyMaxActiveBlocksPerMultiprocessor(&per_cu, (const void*)mk_fwd, 512, LDS_BYTES) != hipSuccess || per_cu < 1) fprintf(stderr, "kernel_launch: occupancy query reports %d\n", per_cu);
        (void)hipGetLastError();
        grid = cus > 256 ? 256 : cus;
    }
    if (grid < 0) return;
    (void)hipMemsetAsync((char*)d_ws + WS_CTL, 0, CTL_BYTES, stream);
    Args a; memset(&a, 0, sizeof(a));
    for (int i = 0; i < 26; ++i) a.in[i] = (const float*)d_in[i];
    a.out = (float*)d_out; a.ws = (unsigned char*)d_ws;
#if MK_SINGLE
    a.ph_lo = 0; a.ph_hi = NPHASE;
    hipLaunchKernelGGL(mk_fwd, dim3(grid), dim3(512), LDS_BYTES, stream, a);
#else
    for (int ph = 0; ph < NPHASE && ph <= DBG_LAST_PHASE; ++ph) {
        const int l = (ph - 1) / PPL, k = (ph - 1) % PPL;
        if (ph > 0 && (l & 1) && (k == 6 || k == 7)) continue;
        a.ph_lo = ph; a.ph_hi = ph + 1;
        hipLaunchKernelGGL(mk_fwd, dim3(grid), dim3(512), LDS_BYTES, stream, a);
    }
#endif
}
```
